# Optimizing an MI355X kernel written in HIP

```python
import jax, jax.numpy as jnp
from jax import lax
import numpy as np

D_MODEL = 1024
BATCH = 2
SEQ = 8192
DEPTH = 4

GLA_HEADS = 4
GLA_DK = 48
GLA_DV = 96
GLA_RANK = 16
GLA_TAU = 16.0
HG_HEADS = 4
HG_DK = 64
HG_DV = 64
RET_HEADS = 4
RET_DK = 48
RET_DV = 96
GLA_QK = GLA_HEADS * GLA_DK
GLA_V = GLA_HEADS * GLA_DV
HG_K = HG_HEADS * HG_DK
HG_V = HG_HEADS * HG_DV
RET_QK = RET_HEADS * RET_DK
RET_V = RET_HEADS * RET_DV
D_MIX = GLA_V + HG_V + RET_V
D_IN = 2 * GLA_QK + 2 * GLA_V + GLA_RANK + 2 * HG_K + 2 * HG_V + 2 * RET_QK + 2 * RET_V
IN_WIDTHS = (GLA_QK, GLA_QK, GLA_V, GLA_V, GLA_RANK, HG_K, HG_K, HG_V, HG_V, RET_QK, RET_QK, RET_V, RET_V)
CHUNK = 64
ROPE_BASE = 10000.0
N_EXPERTS = 32
TOP_K = 4
D_FF = D_MODEL
SWIGLU_LIMIT = 7.0
SWIGLU_ALPHA = 1.702
MOE_BLOCK = 512
EPS = 1e-6

kernel_name = "hybrid_gla_hgrn2_retention_moe_adaln"


def rmsnorm(x, w):
    x32 = x.astype(jnp.float32)
    y = x32 * lax.rsqrt(jnp.mean(x32 * x32, axis=-1, keepdims=True) + EPS)
    return (y * w.astype(jnp.float32)).astype(x.dtype)


def split_heads(t, n_heads):
    b, l, hd = t.shape
    return t.reshape(b, l, n_heads, hd // n_heads).transpose(0, 2, 1, 3)


def merge_heads(t):
    b, h, l, d = t.shape
    return t.transpose(0, 2, 1, 3).reshape(b, l, h * d)


def head_rmsnorm(o, w):
    h, d = o.shape[1], o.shape[3]
    o32 = o.astype(jnp.float32)
    y = o32 * lax.rsqrt(jnp.mean(o32 * o32, axis=-1, keepdims=True) + EPS)
    return (y * w.astype(jnp.float32).reshape(h, 1, d)).astype(o.dtype)


def head_layernorm(o):
    o32 = o.astype(jnp.float32)
    mu = jnp.mean(o32, axis=-1, keepdims=True)
    var = jnp.mean(jnp.square(o32 - mu), axis=-1, keepdims=True)
    return ((o32 - mu) * lax.rsqrt(var + EPS)).astype(o.dtype)


def apply_rotary(t, cos, sin):
    half = t.shape[-1] // 2
    t1, t2 = t[..., :half], t[..., half:]
    return jnp.concatenate([t1 * cos - t2 * sin, t2 * cos + t1 * sin], axis=-1)


def chunked_gated_recurrence(q, k, v, log_a):
    out_dtype = v.dtype
    b, h, l, dk = q.shape
    dv = v.shape[-1]
    n = l // CHUNK

    def chunks(t):
        return t.astype(jnp.float32).reshape(b, h, n, CHUNK, t.shape[-1]).transpose(2, 0, 1, 3, 4)

    qc, kc, vc, gc = chunks(q), chunks(k), chunks(v), chunks(log_a)
    causal = jnp.tril(jnp.ones((CHUNK, CHUNK), dtype=bool))[:, :, None]

    def step(state, inp):
        qi, ki, vi, gi = inp
        cum = jnp.cumsum(gi, axis=-2)
        o_inter = jnp.einsum('bhcd,bhde->bhce', qi * jnp.exp(cum), state)
        diff = cum[:, :, :, None, :] - cum[:, :, None, :, :]
        decay = jnp.exp(jnp.where(causal, diff, -jnp.inf))
        scores = jnp.einsum('bhid,bhjd,bhijd->bhij', qi, ki, decay)
        o = o_inter + jnp.einsum('bhij,bhje->bhie', scores, vi)
        last = cum[:, :, -1:, :]
        new_state = jnp.exp(last[:, :, 0, :])[..., None] * state + jnp.einsum(
            'bhcd,bhce->bhde', ki * jnp.exp(last - cum), vi)
        return new_state, o

    s0 = jnp.zeros((b, h, dk, dv), jnp.float32)
    _, o = lax.scan(step, s0, (qc, kc, vc, gc))
    return o.transpose(1, 2, 0, 3, 4).reshape(b, h, l, dv).astype(out_dtype)


def chunked_retention(q, k, v):
    out_dtype = v.dtype
    b, h, l, dk = q.shape
    dv = v.shape[-1]
    n = l // CHUNK
    log_gamma = jnp.log(1.0 - jnp.exp2(-5.0 - jnp.arange(h, dtype=jnp.float32)))
    idx = jnp.arange(CHUNK, dtype=jnp.float32)
    rel = idx[:, None] - idx[None, :]
    dmat = jnp.where(rel >= 0, jnp.exp(log_gamma[:, None, None] * jnp.maximum(rel, 0.0)), 0.0)
    qc = q.astype(jnp.float32).reshape(b, h, n, CHUNK, dk)
    kc = k.astype(jnp.float32).reshape(b, h, n, CHUNK, dk)
    vc = v.astype(jnp.float32).reshape(b, h, n, CHUNK, dv)
    scores = jnp.einsum('bhnid,bhnjd->bhnij', qc, kc) * dmat[None, :, None]
    o_intra = jnp.einsum('bhnij,bhnje->bhnie', scores, vc)
    k_decay = jnp.exp(log_gamma[:, None] * (CHUNK - 1.0 - idx))
    kv = jnp.einsum('bhnjd,bhnje->bhnde', kc * k_decay[None, :, None, :, None], vc)
    chunk_decay = jnp.exp(log_gamma * CHUNK)[None, :, None, None]

    def step(state, kv_n):
        return chunk_decay * state + kv_n, state

    s0 = jnp.zeros((b, h, dk, dv), jnp.float32)
    _, s_prev = lax.scan(step, s0, kv.transpose(2, 0, 1, 3, 4))
    s_prev = s_prev.transpose(1, 2, 0, 3, 4)
    q_decay = jnp.exp(log_gamma[:, None] * (idx + 1.0))
    o_inter = jnp.einsum('bhnid,bhnde->bhnie', qc * q_decay[None, :, None, :, None], s_prev)
    return (o_intra + o_inter).reshape(b, h, l, dv).astype(out_dtype)


def hybrid_mixer(h, w_in, gla_wa2, gla_ba2, lb, gla_norm_w, hg_norm_w, w_out, cos, sin):
    proj = h @ w_in
    parts = []
    start = 0
    for wd in IN_WIDTHS:
        parts.append(proj[..., start:start + wd])
        start += wd
    gq, gk, gv, gg, ga, hq, hf, hi, hg, rq, rk, rv, rg = parts

    log_alpha = jax.nn.log_sigmoid((ga @ gla_wa2 + gla_ba2).astype(jnp.float32)) / GLA_TAU
    o_gla = chunked_gated_recurrence(split_heads(gq, GLA_HEADS) * (GLA_DK ** -0.5),
                                     split_heads(gk, GLA_HEADS),
                                     split_heads(gv, GLA_HEADS),
                                     split_heads(log_alpha, GLA_HEADS))
    o_gla = merge_heads(head_rmsnorm(o_gla, gla_norm_w)) * jax.nn.silu(gg)

    log_f = jnp.logaddexp(jnp.log(lb), jnp.log1p(-lb) + jax.nn.log_sigmoid(hf.astype(jnp.float32)))
    k_hg = -jnp.expm1(log_f)
    o_hg = chunked_gated_recurrence(split_heads(hq, HG_HEADS),
                                    split_heads(k_hg.astype(hq.dtype), HG_HEADS),
                                    split_heads(hi, HG_HEADS),
                                    split_heads(log_f, HG_HEADS))
    o_hg = merge_heads(head_rmsnorm(o_hg, hg_norm_w)) * jax.nn.sigmoid(hg)

    q_r = apply_rotary(split_heads(rq, RET_HEADS), cos, sin) * (RET_DK ** -0.5)
    k_r = apply_rotary(split_heads(rk, RET_HEADS), cos, sin)
    o_ret = chunked_retention(q_r, k_r, split_heads(rv, RET_HEADS))
    o_ret = merge_heads(head_layernorm(o_ret)) * jax.nn.silu(rg)

    return jnp.concatenate([o_gla, o_hg, o_ret], axis=-1) @ w_out


def moe_ffn(h, w_r, b_r, w_gu, b_gu, w_dn, b_dn):
    b, l, d = h.shape
    t = b * l
    xf = h.reshape(t, d)
    logits = (xf @ w_r + b_r).astype(jnp.float32)
    top_v, top_e = lax.top_k(logits, TOP_K)
    top_w = jax.nn.softmax(top_v, axis=-1)
    n_assign = t * TOP_K
    flat_e = top_e.reshape(-1)
    flat_t = jnp.repeat(jnp.arange(t, dtype=jnp.int32), TOP_K)
    flat_w = top_w.reshape(-1)
    order = jnp.argsort(flat_e)
    se, st, sw = flat_e[order], flat_t[order], flat_w[order]
    counts = jnp.bincount(flat_e, length=N_EXPERTS)
    padded = (counts + MOE_BLOCK - 1) // MOE_BLOCK * MOE_BLOCK
    starts = jnp.cumsum(counts) - counts
    pends = jnp.cumsum(padded)
    pstarts = pends - padded
    dest = pstarts[se] + jnp.arange(n_assign) - starts[se]
    n_blocks = (n_assign + MOE_BLOCK - 1) // MOE_BLOCK + N_EXPERTS
    p = n_blocks * MOE_BLOCK
    buf_t = jnp.zeros((p,), jnp.int32).at[dest].set(st)
    buf_w = jnp.zeros((p,), h.dtype).at[dest].set(sw.astype(h.dtype))
    block_start = jnp.arange(n_blocks) * MOE_BLOCK
    block_e = jnp.minimum(jnp.searchsorted(pends, block_start, side='right'), N_EXPERTS - 1)

    def expert_block(args):
        tok, e = args
        xb = xf[tok]
        gu = xb @ w_gu[e] + b_gu[e]
        gate = jnp.minimum(gu[:, :D_FF], SWIGLU_LIMIT)
        up = jnp.clip(gu[:, D_FF:], -SWIGLU_LIMIT, SWIGLU_LIMIT)
        act = (up + 1.0) * gate * jax.nn.sigmoid(SWIGLU_ALPHA * gate)
        return act @ w_dn[e] + b_dn[e]

    yb = lax.map(expert_block, (buf_t.reshape(n_blocks, MOE_BLOCK), block_e))
    y = jnp.zeros((t, d), h.dtype).at[buf_t].add(yb.reshape(p, d) * buf_w[:, None])
    return y.reshape(b, l, d)


def setup_inputs(seed: int = 0) -> dict:
    key = jax.random.key(seed)
    ks = jax.random.split(key, 24)
    f32 = jnp.float32
    nrm = lambda k, shape, s: jax.random.normal(k, shape, f32) * s
    x = nrm(ks[0], (BATCH, SEQ, D_MODEL), 1.0)
    c = nrm(ks[1], (BATCH, D_MODEL), 1.0)
    offset = jax.random.randint(ks[2], (BATCH, 1), 0, 1024, dtype=jnp.int32)
    positions = jnp.arange(SEQ, dtype=jnp.int32)[None, :] + offset
    return {
        "x": x,
        "c": c,
        "positions": positions,
        "w_mod": nrm(ks[3], (DEPTH, D_MODEL, 6 * D_MODEL), 0.5 * D_MODEL ** -0.5),
        "b_mod": nrm(ks[4], (DEPTH, 6 * D_MODEL), 0.02),
        "norm1_w": 1.0 + nrm(ks[5], (DEPTH, D_MODEL), 0.02),
        "w_in": nrm(ks[6], (DEPTH, D_MODEL, D_IN), D_MODEL ** -0.5),
        "gla_wa2": nrm(ks[7], (DEPTH, GLA_RANK, GLA_QK), GLA_RANK ** -0.5),
        "gla_ba2": nrm(ks[8], (DEPTH, GLA_QK), 0.1),
        "hg_lb": nrm(ks[9], (DEPTH, HG_K), 0.1),
        "gla_norm_w": 1.0 + nrm(ks[10], (DEPTH, GLA_V), 0.02),
        "hg_norm_w": 1.0 + nrm(ks[11], (DEPTH, HG_V), 0.02),
        "w_out": nrm(ks[12], (DEPTH, D_MIX, D_MODEL), D_MIX ** -0.5),
        "norm2_w": 1.0 + nrm(ks[13], (DEPTH, D_MODEL), 0.02),
        "w_r": nrm(ks[14], (DEPTH, D_MODEL, N_EXPERTS), D_MODEL ** -0.5),
        "b_r": nrm(ks[15], (DEPTH, N_EXPERTS), 0.01),
        "w_gu": nrm(ks[16], (DEPTH, N_EXPERTS, D_MODEL, 2 * D_FF), D_MODEL ** -0.5),
        "b_gu": nrm(ks[17], (DEPTH, N_EXPERTS, 2 * D_FF), 0.01),
        "w_dn": nrm(ks[18], (DEPTH, N_EXPERTS, D_FF, D_MODEL), D_FF ** -0.5),
        "b_dn": nrm(ks[19], (DEPTH, N_EXPERTS, D_MODEL), 0.01),
        "final_norm_w": 1.0 + nrm(ks[20], (D_MODEL,), 0.02),
    }


def reference(x, c, positions, w_mod, b_mod, norm1_w, w_in, gla_wa2, gla_ba2, hg_lb,
              gla_norm_w, hg_norm_w, w_out, norm2_w, w_r, b_r, w_gu, b_gu, w_dn, b_dn,
              final_norm_w):
    c_act = jax.nn.silu(c)
    half = RET_DK // 2
    inv_freq = ROPE_BASE ** (-jnp.arange(half, dtype=jnp.float32) / half)
    ang = positions.astype(jnp.float32)[..., None] * inv_freq
    cos = jnp.cos(ang)[:, None].astype(x.dtype)
    sin = jnp.sin(ang)[:, None].astype(x.dtype)
    lb_all = jnp.cumsum(jax.nn.softmax(hg_lb.astype(jnp.float32), axis=0), axis=0)
    lb_all = lb_all - lb_all[0:1]

    for layer in range(DEPTH):
        mod = (c_act @ w_mod[layer] + b_mod[layer])[:, None, :]
        sh1, sc1, g1, sh2, sc2, g2 = jnp.split(mod, 6, axis=-1)
        h = rmsnorm(x, norm1_w[layer]) * (1.0 + sc1) + sh1
        x = x + g1 * hybrid_mixer(h, w_in[layer], gla_wa2[layer], gla_ba2[layer], lb_all[layer],
                                  gla_norm_w[layer], hg_norm_w[layer], w_out[layer], cos, sin)
        h = rmsnorm(x, norm2_w[layer]) * (1.0 + sc2) + sh2
        x = x + g2 * moe_ffn(h, w_r[layer], b_r[layer], w_gu[layer], b_gu[layer],
                             w_dn[layer], b_dn[layer])
    return rmsnorm(x, final_norm_w)
```

```cpp
#include <hip/hip_runtime.h>
#include <cstdio>
#include <cstdint>
namespace pg8 {
#define PG8_LAS __attribute__((address_space(3)))
typedef unsigned short bf16_t;
typedef short bf16x8 __attribute__((ext_vector_type(8)));
typedef float f32x4 __attribute__((ext_vector_type(4)));
typedef unsigned u32x4 __attribute__((ext_vector_type(4)));
constexpr int BM = 256, BK = 64, HALF = 128, HTB = HALF * BK * 2  , STAGE_BYTES = 8 * HTB, NXCD = 8, WGM = 8;

__host__ __device__ __forceinline__ int lds_byte(int r, int c) { const int st = (r >> 4) * 2 + (c >> 5), rr = r & 15, cc = c & 31, ob = rr * 64 + cc * 2; return st * 1024 + (ob ^ (((ob >> 9) & 1) << 5)); }
__host__ __device__ __forceinline__ void stage_rc(int b, int& R, int& C) { const int st = b / 1024, sb = b % 1024, swz = sb ^ (((sb >> 9) & 1) << 5); R = (st >> 1) * 16 + swz / 64; C = (st & 1) * 32 + (swz % 64) / 2; }
__host__ __device__ __forceinline__ int perm32(int rho) { const int n = rho >> 4, i = rho & 15; return 8 * (i >> 2) + 4 * n + (i & 3); }

struct Unit { int pm, pn, e, pl; };
struct Gemm { const bf16_t* A; const bf16_t* Bt; int M, N, K; };

struct StaticOrder {
    int nM, nN, nwg, G, c;
    __host__ __device__ void init(int M, int N, int G_, int c_) { nM = M / BM; nN = N / BM; nwg = nM * nN; G = G_; c = c_; }
    __host__ __device__ bool next(int i, Unit& u) const {
        const long L = (long)i * G + c; if (L >= nwg) return false;
        int wgid = (int)L; { const int q = nwg / NXCD, r = nwg % NXCD, xcd = wgid % NXCD, off = wgid / NXCD; wgid = (xcd < r ? xcd * (q + 1) : r * (q + 1) + (xcd - r) * q) + off; }
        const int nig = WGM * nN, gid = wgid / nig, fm = gid * WGM, gsz = (nM - fm) < WGM ? (nM - fm) : WGM;
        u.pm = fm + ((wgid % nig) % gsz); u.pn = (wgid % nig) / gsz; u.e = 0; u.pl = u.pn; return true;
    }
    __device__ __forceinline__ void a_ready(const Unit&) const {}
    __device__ __forceinline__ void done(const Unit&) const {}
};

__device__ __forceinline__ unsigned cvt_pk_bf16(float lo, float hi) { unsigned r; asm volatile("v_cvt_pk_bf16_f32 %0, %1, %2" : "=v"(r) : "v"(lo), "v"(hi)); return r; }

struct EpiBf16Plain {
    static constexpr bool PERM = true, AFTER_DRAIN = false;
    bf16_t* O; int ldc;
    __device__ __forceinline__ void operator()(const f32x4 (&acc)[2][2][4][2], const Unit& u, int wr, int wc, int fr, int fq) const {
        const int row0 = u.pm * BM + wr * 64 + fr; const int col0 = u.pn * BM + wc * 32 + 8 * fq;
#pragma unroll
        for (int ai = 0; ai < 2; ++ai)
#pragma unroll
            for (int m = 0; m < 4; ++m) { bf16_t* rowp = O + (size_t)(row0 + ai * HALF + m * 16) * ldc + col0;
#pragma unroll
                for (int bj = 0; bj < 2; ++bj) { const f32x4 v0 = acc[ai][bj][m][0], v1 = acc[ai][bj][m][1];
                    u32x4 w; w.x = cvt_pk_bf16(v0[0], v0[1]); w.y = cvt_pk_bf16(v0[2], v0[3]); w.z = cvt_pk_bf16(v1[0], v1[1]); w.w = cvt_pk_bf16(v1[2], v1[3]);
                    *(u32x4*)(rowp + bj * HALF) = w; } }
    }
};
struct EpiResGate {
    static constexpr bool PERM = false, AFTER_DRAIN = false;
    const float* base; float* out; int ldc; const float* gate; int gpitch; int rows_per_batch;
    __device__ __forceinline__ void operator()(const f32x4 (&acc)[2][2][4][2], const Unit& u, int wr, int wc, int fr, int fq) const {
        const int row0 = u.pm * BM + wr * 64 + fr, col0 = u.pn * BM + wc * 32 + 4 * fq;
        const float* gp = gate + (size_t)((u.pm * BM) / rows_per_batch) * gpitch + col0;
        f32x4 gv[2][2];
#pragma unroll
        for (int bj = 0; bj < 2; ++bj)
#pragma unroll
            for (int n = 0; n < 2; ++n) gv[bj][n] = *(const f32x4*)(gp + bj * HALF + n * 16);
#pragma unroll
        for (int ai = 0; ai < 2; ++ai)
#pragma unroll
            for (int m = 0; m < 4; ++m) { const size_t off = (size_t)(row0 + ai * HALF + m * 16) * ldc + col0;
#pragma unroll
                for (int bj = 0; bj < 2; ++bj)
#pragma unroll
                    for (int n = 0; n < 2; ++n) { const f32x4 bs = *(const f32x4*)(base + off + bj * HALF + n * 16);
                        *(f32x4*)(out + off + bj * HALF + n * 16) = bs + gv[bj][n] * acc[ai][bj][m][n]; }
                asm volatile("" ::: "memory"); }
    }
};
struct EpiSwiglu {
    static constexpr bool PERM = true, AFTER_DRAIN = false;
    bf16_t* O; int ldc; const float* bias;
    __device__ __forceinline__ float act1(float g, float up) const {
        g = fminf(g, 7.0f); up = fminf(fmaxf(up, -7.0f), 7.0f);
        const float s = 1.0f / (1.0f + __expf(-1.702f * g));
        return (up + 1.0f) * g * s;
    }
    __device__ __forceinline__ void operator()(const f32x4 (&acc)[2][2][4][2], const Unit& u, int wr, int wc, int fr, int fq) const {
        const int row0 = u.pm * BM + wr * 64 + fr; const int jj0 = wc * 32 + 8 * fq; const int col0 = u.pl * HALF + jj0;
        const float* bp = bias + (size_t)u.e * 2048 + col0;
        f32x4 bg[2], bu[2];
#pragma unroll
        for (int n = 0; n < 2; ++n) { bg[n] = *(const f32x4*)(bp + 4 * n); bu[n] = *(const f32x4*)(bp + 1024 + 4 * n); }
#pragma unroll
        for (int ai = 0; ai < 2; ++ai)
#pragma unroll
            for (int m = 0; m < 4; ++m) { bf16_t* rowp = O + (size_t)(row0 + ai * HALF + m * 16) * ldc + col0;
                f32x4 r[2];
#pragma unroll
                for (int n = 0; n < 2; ++n) { const f32x4 g = acc[ai][0][m][n] + bg[n], up = acc[ai][1][m][n] + bu[n];
#pragma unroll
                    for (int j = 0; j < 4; ++j) r[n][j] = act1(g[j], up[j]); }
                u32x4 w; w.x = cvt_pk_bf16(r[0][0], r[0][1]); w.y = cvt_pk_bf16(r[0][2], r[0][3]); w.z = cvt_pk_bf16(r[1][0], r[1][1]); w.w = cvt_pk_bf16(r[1][2], r[1][3]);
                *(u32x4*)rowp = w; }
    }
};
struct EpiBf16Bias {
    static constexpr bool PERM = true, AFTER_DRAIN = false;
    bf16_t* O; int ldc; const float* bias; int bpitch;
    __device__ __forceinline__ void operator()(const f32x4 (&acc)[2][2][4][2], const Unit& u, int wr, int wc, int fr, int fq) const {
        const int row0 = u.pm * BM + wr * 64 + fr; const int col0 = u.pl * BM + wc * 32 + 8 * fq;
        const float* bp = bias + (size_t)u.e * bpitch + col0;
        f32x4 bv[2][2];
#pragma unroll
        for (int bj = 0; bj < 2; ++bj)
#pragma unroll
            for (int n = 0; n < 2; ++n) bv[bj][n] = *(const f32x4*)(bp + bj * HALF + 4 * n);
#pragma unroll
        for (int ai = 0; ai < 2; ++ai)
#pragma unroll
            for (int m = 0; m < 4; ++m) { bf16_t* rowp = O + (size_t)(row0 + ai * HALF + m * 16) * ldc + col0;
#pragma unroll
                for (int bj = 0; bj < 2; ++bj) { const f32x4 v0 = acc[ai][bj][m][0] + bv[bj][0], v1 = acc[ai][bj][m][1] + bv[bj][1];
                    u32x4 w; w.x = cvt_pk_bf16(v0[0], v0[1]); w.y = cvt_pk_bf16(v0[2], v0[3]); w.z = cvt_pk_bf16(v1[0], v1[1]); w.w = cvt_pk_bf16(v1[2], v1[3]);
                    *(u32x4*)(rowp + bj * HALF) = w; } }
    }
};
struct MoeOrder {
    int nN, G, c, nunits; const PG8_LAS int* tile_e;
    __device__ __forceinline__ bool next(int i, Unit& u) const {
        const int L = i * G + c; if (L >= nunits) return false;
        const int pm = L / nN, pl = L - pm * nN, e = __builtin_amdgcn_readfirstlane(tile_e[pm]);
        u.pm = pm; u.pl = pl; u.e = e; u.pn = e * nN + pl; return true;
    }
    __device__ __forceinline__ void a_ready(const Unit&) const {}
    __device__ __forceinline__ void done(const Unit&) const {}
};
template <class Epi, class Sched, bool ALIGN_EPI = false, bool SP2 = false>
__device__ __forceinline__ void gemm_phase(PG8_LAS unsigned char* lds, const Gemm g, const Sched& S, const Epi& E) {
    int tid_ = threadIdx.x; asm volatile("" : "+v"(tid_)); const int tid = tid_, wid = __builtin_amdgcn_readfirstlane(tid >> 6), lane = tid & 63, wr = wid >> 2, wc = wid & 3, fr = lane & 15, fq = lane >> 4;
    const int K = g.K, nt = K / BK;
    unsigned voffA[2], voffB[2];
#pragma unroll
    for (int i = 0; i < 2; ++i) { int R, C; stage_rc(tid * 16 + i * 8192, R, C); const int Rb = Epi::PERM ? ((R & ~31) + perm32(R & 31)) : R;
        voffA[i] = (unsigned)(R * K + C) * 2u; voffB[i] = (unsigned)(Rb * K + C) * 2u; }
    const size_t kstep = (size_t)(BK * 2);
    const size_t hstep = (size_t)HALF * K * 2;
    const size_t tstep = 2 * hstep;
    const unsigned ldsw = (unsigned)wid * 1024u;
    const int aoff = lds_byte(wr * 64 + fr, fq * 8), boff = lds_byte(wc * 32 + fr, fq * 8);
#define PG8_SA(b, h) (((b) * 2 + (h)) * HTB)
#define PG8_SB(b, h) ((4 + (b) * 2 + (h)) * HTB)
#define PG8_STAGE(bufoff, gbase, voff) do { _Pragma("unroll") for (int _i = 0; _i < 2; ++_i) \
        __builtin_amdgcn_global_load_lds((const unsigned*)((const char*)(gbase) + (voff)[_i]), (PG8_LAS unsigned*)(lds + (bufoff) + ldsw + _i * 8192), 16, 0, 0); } while (0)
#define PG8_LDA(dst, b, h) do { _Pragma("unroll") for (int m = 0; m < 4; ++m) _Pragma("unroll") for (int k = 0; k < 2; ++k) dst[m][k] = *(const PG8_LAS bf16x8*)(lds + PG8_SA(b, h) + aoff + m * 2048 + k * 1024); } while (0)
#define PG8_LDB(dst, b, h) do { _Pragma("unroll") for (int n = 0; n < 2; ++n) _Pragma("unroll") for (int k = 0; k < 2; ++k) dst[n][k] = *(const PG8_LAS bf16x8*)(lds + PG8_SB(b, h) + boff + n * 2048 + k * 1024); } while (0)
#define PG8_MMA(ai, bj, At, Bt) do { __builtin_amdgcn_s_setprio(1); _Pragma("unroll") for (int m = 0; m < 4; ++m) _Pragma("unroll") for (int n = 0; n < 2; ++n) _Pragma("unroll") for (int k = 0; k < 2; ++k) \
        acc[ai][bj][m][n] = __builtin_amdgcn_mfma_f32_16x16x32_bf16(Bt[n][k], At[m][k], acc[ai][bj][m][n], 0, 0, 0); __builtin_amdgcn_s_setprio(0); } while (0)
#define PG8_WAIT_V(n) asm volatile("s_waitcnt vmcnt(" #n ")" ::: "memory")
#define PG8_WAIT_L(n) asm volatile("s_waitcnt lgkmcnt(" #n ")" ::: "memory")
#define PG8_BAR __builtin_amdgcn_s_barrier()
#define PG8_SCHED __builtin_amdgcn_sched_barrier(0)
    Unit cur, nxt; int ui = 0;
    if (!S.next(0, cur)) return;
    f32x4 acc[2][2][4][2];
#pragma unroll
    for (int a = 0; a < 2; ++a)
#pragma unroll
        for (int b = 0; b < 2; ++b)
#pragma unroll
            for (int m = 0; m < 4; ++m)
#pragma unroll
                for (int n = 0; n < 2; ++n) acc[a][b][m][n] = (f32x4){0.f, 0.f, 0.f, 0.f};
    bf16x8 At[4][2], B0[2][2], B1[2][2];
    const char* cA = (const char*)g.A + (size_t)cur.pm * tstep; const char* cB = (const char*)g.Bt + (size_t)cur.pn * tstep;
    S.a_ready(cur);
    if constexpr (SP2) {
        PG8_STAGE(PG8_SB(0, 0), cB, voffB); PG8_STAGE(PG8_SB(0, 1), cB + hstep, voffB); PG8_STAGE(PG8_SA(0, 0), cA, voffA); PG8_STAGE(PG8_SA(0, 1), cA + hstep, voffA);
        if (wr == 1) PG8_BAR;
        PG8_WAIT_V(2); PG8_BAR;
        PG8_STAGE(PG8_SB(1, 0), cB + kstep, voffB); PG8_STAGE(PG8_SA(1, 0), cA + kstep, voffA); PG8_STAGE(PG8_SB(1, 1), cB + hstep + kstep, voffB);
        PG8_WAIT_V(6); PG8_BAR;
    } else {
        PG8_STAGE(PG8_SB(0, 0), cB, voffB); PG8_STAGE(PG8_SA(0, 0), cA, voffA); PG8_STAGE(PG8_SB(0, 1), cB + hstep, voffB); PG8_STAGE(PG8_SA(0, 1), cA + hstep, voffA);
        if (wr == 1) PG8_BAR;
        PG8_WAIT_V(4); PG8_BAR;
        PG8_STAGE(PG8_SB(1, 0), cB + kstep, voffB); PG8_STAGE(PG8_SA(1, 0), cA + kstep, voffA); PG8_STAGE(PG8_SB(1, 1), cB + hstep + kstep, voffB);
        PG8_WAIT_V(6); PG8_BAR;
    }
    for (;;) {
        const bool has_next = S.next(ui + 1, nxt);
        const char* nA = has_next ? (const char*)g.A + (size_t)nxt.pm * tstep : cA; const char* nB = has_next ? (const char*)g.Bt + (size_t)nxt.pn * tstep : cB;
        for (int t = 0; t < nt; t += 2) {
            const bool last = (t == nt - 2);
            const char* a1 = cA + (size_t)(t + 1) * kstep;
            const char* a2 = last ? nA : cA + (size_t)(t + 2) * kstep; const char* b2 = last ? nB : cB + (size_t)(t + 2) * kstep;
            const char* a3 = a2 + kstep; const char* b3 = b2 + kstep;
            if (last && has_next) S.a_ready(nxt);
            if constexpr (SP2) {
            PG8_LDB(B0, 0, 0); PG8_LDB(B1, 0, 1); PG8_SCHED; PG8_LDA(At, 0, 0); PG8_STAGE(PG8_SA(1, 1), a1 + hstep, voffA);
            PG8_WAIT_V(8); PG8_WAIT_L(0); PG8_BAR; PG8_MMA(0, 0, At, B0); PG8_MMA(0, 1, At, B1); PG8_BAR; PG8_SCHED;
            PG8_LDA(At, 0, 1); PG8_STAGE(PG8_SB(0, 0), b2, voffB); PG8_STAGE(PG8_SB(0, 1), b2 + hstep, voffB); PG8_STAGE(PG8_SA(0, 0), a2, voffA);
            PG8_WAIT_V(8); PG8_WAIT_L(0); PG8_BAR; PG8_MMA(1, 0, At, B0); PG8_MMA(1, 1, At, B1); PG8_BAR; PG8_SCHED;
            PG8_LDB(B0, 1, 0); PG8_LDB(B1, 1, 1); PG8_SCHED; PG8_LDA(At, 1, 0); PG8_STAGE(PG8_SA(0, 1), a2 + hstep, voffA);
            PG8_WAIT_V(8); PG8_WAIT_L(0); PG8_BAR; PG8_MMA(0, 0, At, B0); PG8_MMA(0, 1, At, B1); PG8_BAR; PG8_SCHED;
            PG8_LDA(At, 1, 1); PG8_STAGE(PG8_SB(1, 0), b3, voffB); PG8_STAGE(PG8_SB(1, 1), b3 + hstep, voffB); PG8_STAGE(PG8_SA(1, 0), a3, voffA);
            PG8_WAIT_V(8); PG8_WAIT_L(0); PG8_BAR; PG8_MMA(1, 0, At, B0); PG8_MMA(1, 1, At, B1); PG8_BAR; PG8_SCHED;
            } else {
            PG8_LDB(B0, 0, 0); PG8_SCHED; PG8_LDA(At, 0, 0); PG8_STAGE(PG8_SA(1, 1), a1 + hstep, voffA);
            PG8_WAIT_L(8); PG8_BAR; PG8_WAIT_L(0); PG8_MMA(0, 0, At, B0); PG8_BAR; PG8_SCHED;
            PG8_LDB(B1, 0, 1); PG8_STAGE(PG8_SB(0, 0), b2, voffB);
            PG8_BAR; PG8_WAIT_L(0); PG8_MMA(0, 1, At, B1); PG8_BAR;
            PG8_LDA(At, 0, 1); PG8_STAGE(PG8_SA(0, 0), a2, voffA);
            PG8_BAR; PG8_WAIT_L(0); PG8_MMA(1, 0, At, B0); PG8_BAR; PG8_SCHED;
            PG8_STAGE(PG8_SB(0, 1), b2 + hstep, voffB);
            PG8_WAIT_V(6); PG8_BAR; PG8_MMA(1, 1, At, B1); PG8_BAR;
            PG8_LDB(B0, 1, 0); PG8_SCHED; PG8_LDA(At, 1, 0); PG8_STAGE(PG8_SA(0, 1), a2 + hstep, voffA);
            PG8_WAIT_L(8); PG8_BAR; PG8_WAIT_L(0); PG8_MMA(0, 0, At, B0); PG8_BAR; PG8_SCHED;
            PG8_LDB(B1, 1, 1); PG8_STAGE(PG8_SB(1, 0), b3, voffB);
            PG8_BAR; PG8_WAIT_L(0); PG8_MMA(0, 1, At, B1); PG8_BAR;
            PG8_LDA(At, 1, 1); PG8_STAGE(PG8_SA(1, 0), a3, voffA);
            PG8_BAR; PG8_WAIT_L(0); PG8_MMA(1, 0, At, B0); PG8_BAR; PG8_SCHED;
            PG8_STAGE(PG8_SB(1, 1), b3 + hstep, voffB);
            PG8_WAIT_V(6); PG8_BAR; PG8_MMA(1, 1, At, B1); PG8_BAR;
            }
        }
        if constexpr (ALIGN_EPI) { if (wr == 0) PG8_BAR; }
        if constexpr (!Epi::AFTER_DRAIN) { E(acc, cur, wr, wc, fr, fq); S.done(cur); }
        if (!has_next) break;
#pragma unroll
        for (int a = 0; a < 2; ++a)
#pragma unroll
            for (int b = 0; b < 2; ++b)
#pragma unroll
                for (int m = 0; m < 4; ++m)
#pragma unroll
                    for (int n = 0; n < 2; ++n) acc[a][b][m][n] = (f32x4){0.f, 0.f, 0.f, 0.f};
        cur = nxt; cA = nA; cB = nB; ++ui;
        if constexpr (ALIGN_EPI) { if (wr == 1) PG8_BAR; }
    }
    PG8_WAIT_V(0);
    if constexpr (!ALIGN_EPI) { if (wr == 0) PG8_BAR; }
    PG8_BAR;
    if constexpr (Epi::AFTER_DRAIN) { E.fused(acc, cur, wr, wc, fr, fq, lds, wid, lane); S.done(cur); }
#undef PG8_SA
#undef PG8_SB
#undef PG8_STAGE
#undef PG8_LDA
#undef PG8_LDB
#undef PG8_MMA
#undef PG8_WAIT_V
#undef PG8_WAIT_L
#undef PG8_BAR
#undef PG8_SCHED
}
}

constexpr int NWAVES = 8, NTHR = 512;
constexpr int BATCH = 2, SEQ = 8192, D = 1024, DEPTH = 4, MTOK = BATCH * SEQ;
constexpr int DIN = 3344, NPROJ = 3328, SRC_GA = 1152;
constexpr int C_GQ = 0, C_GK = 192, C_GV = 384, C_GG = 768, C_HQ = 1152, C_HF = 1408, C_HI = 1664, C_HG = 1920, C_RQ = 2176, C_RK = 2368, C_RV = 2560, C_RG = 2944;
constexpr int NE = 32, FFN = 1024;
constexpr int CH = 64, NCH = SEQ / CH, NUNIT = BATCH * NCH;
constexpr int ST_GLA = 0, ST_HG = 4 * 48 * 96, ST_RET = ST_HG + 4 * 64 * 64, ST_TOT = ST_RET + 4 * 48 * 96;
constexpr int NDV = 448;
constexpr int MAXROWS = 65536 + NE * 256, MAXRT = MAXROWS / 256;
constexpr float EPS = 1e-6f;
constexpr int NPHASE = 42;

constexpr size_t MiB = 1u << 20;
constexpr size_t WS_CTL = 0, CTL_ZERO_BYTES = 65536;
constexpr size_t WS_MOD = 1 * MiB;
constexpr size_t WS_ROPE = 2 * MiB;
constexpr size_t WS_LB = 5 * MiB;
constexpr size_t WS_WIN = 8 * MiB;
constexpr size_t WS_WOUT = 34 * MiB;
constexpr size_t WS_WGU = 42 * MiB;
constexpr size_t WS_WDN = 554 * MiB;
constexpr size_t WS_X = 810 * MiB;
constexpr size_t WS_H = 874 * MiB;
constexpr size_t WS_GA = 906 * MiB;
constexpr size_t WS_PROJ = 907 * MiB;
constexpr size_t WS_U = 1011 * MiB;
constexpr size_t WS_DVEC = 1063 * MiB;
constexpr size_t WS_SP = 1064 * MiB;
constexpr size_t WS_MIX = 1090 * MiB;
constexpr size_t WS_TOPE = 1122 * MiB;
constexpr size_t WS_TOPW = WS_TOPE + 256 * 1024;
constexpr size_t WS_SLOT = WS_TOPW + 256 * 1024;
constexpr size_t WS_A1 = 1123 * MiB;
constexpr size_t WS_ACT = 1267 * MiB;
constexpr size_t WS_Y = 1411 * MiB;
constexpr size_t WS_END = 1555 * MiB;
static_assert(WS_WIN + (size_t)DEPTH * NPROJ * D * 2 <= WS_WOUT && WS_PROJ + (size_t)MTOK * NPROJ * 2 <= WS_U && WS_U + (size_t)NUNIT * ST_TOT * 4 <= WS_DVEC && WS_SP + (size_t)NUNIT * ST_TOT * 2 <= WS_MIX && WS_A1 + (size_t)MAXROWS * D * 2 <= WS_ACT, "ws map");
constexpr int CW_TMO = 0, CW_CODE = 1, CW_BAR = 4096, CW_CNT = 8192, CW_FILL = 8192 + 256;
constexpr int RING_BYTES = 131072;
constexpr int MISC_OFF = 147456, LDS_BYTES = MISC_OFF + 4096;
constexpr int MW_BAR = 0, MW_CNT = 16, MW_PST = 48, MW_HIST = 96, MW_BASE = 128, MW_TILE = 192, MW_NRT = 480, MW_SLOTS = 512;

#define GAS __attribute__((address_space(1)))
#define LAS __attribute__((address_space(3)))
typedef unsigned v4u __attribute__((ext_vector_type(4)));
typedef float f32x4 __attribute__((ext_vector_type(4)));
typedef short bf16x8 __attribute__((ext_vector_type(8)));
typedef GAS unsigned gu32;
typedef GAS unsigned long long gu64;
#define RLX_AGENT __ATOMIC_RELAXED, __HIP_MEMORY_SCOPE_AGENT
#define LDS_WAIT() asm volatile("s_waitcnt lgkmcnt(0)" ::: "memory")
#define VM_WAIT() asm volatile("s_waitcnt vmcnt(0)" ::: "memory")
__device__ __forceinline__ unsigned long long rt() { return __builtin_amdgcn_s_memrealtime(); }
typedef unsigned short bf16;
__device__ __forceinline__ unsigned f2bf(float f) { unsigned u = __builtin_bit_cast(unsigned, f); return (u + 0x7fffu + ((u >> 16) & 1u)) >> 16; }
__device__ __forceinline__ unsigned pk2(float lo, float hi) { return f2bf(lo) | (f2bf(hi) << 16); }
__device__ __forceinline__ float bf2f(bf16 b) { return __builtin_bit_cast(float, (unsigned)b << 16); }
#define XB_TMO      128
#define XB_XCNT(j)  (256  + 64 * (j))
#define XB_XSUB(j)  (1280 + 64 * (j))
#define XB_XGEN(j)  (2304 + 64 * (j))
#define XB_TOP      3328
#define XB_TOPGEN   3392
#define XCD_BAR_WORDS 3456
#define XB_SPIN_CAP (1u << 18)

__device__ __forceinline__ unsigned xb_ld(unsigned* p)              { return __hip_atomic_load(p, __ATOMIC_RELAXED, __HIP_MEMORY_SCOPE_AGENT); }
__device__ __forceinline__ unsigned xb_add(unsigned* p, unsigned v) { return __hip_atomic_fetch_add(p, v, __ATOMIC_RELAXED, __HIP_MEMORY_SCOPE_AGENT); }
__device__ __forceinline__ unsigned xb_xcc_id() { return (unsigned)__builtin_amdgcn_s_getreg((3 << 11) | 20) & 0xFu; }
#define XB_SPIN(cond, bar) do { unsigned _sp = 0; while (cond) { __builtin_amdgcn_s_sleep(1); \
    if ((++_sp & 255u) == 0u) { if (xb_ld(&(bar)[XB_TMO])) break; if (_sp > XB_SPIN_CAP) { atomicAdd(&(bar)[XB_TMO], 1u); break; } } } } while (0)

struct XcdBarrier {
    unsigned* bar; unsigned x;
    volatile LAS unsigned* st;
};

__device__ __forceinline__ XcdBarrier xcd_barrier_post(unsigned* bar, volatile LAS unsigned* st) {
    XcdBarrier b; b.bar = bar; b.x = xb_xcc_id(); b.st = st;
    if (threadIdx.x == 0) (void)xb_add(&bar[XB_XCNT(b.x)], 1u);
    return b;
}
__device__ __forceinline__ void xcd_barrier_complete(unsigned* bar, unsigned x, unsigned& nloc, unsigned& nx) {
    const unsigned G = gridDim.x * gridDim.y * gridDim.z;
    unsigned sum, cnt, mine, sp = 0u;
    for (;;) {
        sum = 0u; cnt = 0u; mine = 0u;
#pragma unroll
        for (unsigned j = 0; j < 16; ++j) { const unsigned c = xb_ld(&bar[XB_XCNT(j)]); sum += c; cnt += (c > 0u) ? 1u : 0u; mine = (j == x) ? c : mine; }
        if (sum == G) break;
        __builtin_amdgcn_s_sleep(1);
        if ((++sp & 255u) == 0u) { if (xb_ld(&bar[XB_TMO])) break; if (sp > XB_SPIN_CAP) { atomicAdd(&bar[XB_TMO], 1u); break; } }
    }
    nloc = mine > 0u ? mine : 1u; nx = cnt > 0u ? cnt : 1u;
}

__device__ __forceinline__ void xcd_barrier(const XcdBarrier& b) {
    asm volatile("s_waitcnt vmcnt(0)" ::: "memory");
    __syncthreads();
    if (threadIdx.x == 0) {
        unsigned* bar = b.bar;
        __builtin_amdgcn_s_waitcnt(0);
        unsigned nloc = b.st[0], nx = b.st[1];
        if (nloc == 0u) { xcd_barrier_complete(bar, b.x, nloc, nx); b.st[0] = nloc; b.st[1] = nx; }
        const unsigned old = xb_add(&bar[XB_XSUB(b.x)], 1u);
        const unsigned gen = old / nloc;
        if (old + 1u == (gen + 1u) * nloc) {
            __builtin_amdgcn_fence(__ATOMIC_RELEASE, "agent");
            asm volatile("s_waitcnt vmcnt(0)" ::: "memory");
            const unsigned og = xb_add(&bar[XB_TOP], 1u);
            const unsigned tg = og / nx;
            if (og + 1u == (tg + 1u) * nx) xb_add(&bar[XB_TOPGEN], 1u);
            else XB_SPIN(xb_ld(&bar[XB_TOPGEN]) == tg, bar);
            __builtin_amdgcn_fence(__ATOMIC_ACQUIRE, "agent");
            xb_add(&bar[XB_XGEN(b.x)], 1u);
            asm volatile("s_waitcnt vmcnt(0)" ::: "memory");
        } else {
            XB_SPIN(xb_ld(&bar[XB_XGEN(b.x)]) == gen, bar);
            __builtin_amdgcn_fence(__ATOMIC_ACQUIRE, "agent");
            asm volatile("s_waitcnt vmcnt(0)" ::: "memory");
        }
    }
    __syncthreads();
}

__device__ __forceinline__ float wave_sum(float v) {
#pragma unroll
    for (int o = 1; o < 64; o <<= 1) v += __shfl_xor(v, o);
    return v;
}
__device__ __forceinline__ float log_sigmoid_f(float x) { return fminf(x, 0.f) - log1pf(expf(-fabsf(x))); }
__device__ __forceinline__ float silu_f(float x) { return x / (1.0f + expf(-x)); }
__device__ __forceinline__ float sigmoid_f(float x) { return 1.0f / (1.0f + expf(-x)); }
__device__ __forceinline__ pg8::bf16x8 ldfrag(const LAS bf16* base, int stride, int r0, int k0, int lane) {
    return *(const LAS pg8::bf16x8*)(base + (r0 + (lane & 15)) * stride + k0 + 8 * (lane >> 4));
}

struct Args {
    const float* x; const float* c; const int* pos; const float* w_mod; const float* b_mod; const float* norm1_w; const float* w_in; const float* gla_wa2; const float* gla_ba2; const float* hg_lb;
    const float* gla_norm_w; const float* hg_norm_w; const float* w_out; const float* norm2_w; const float* w_r; const float* b_r; const float* w_gu; const float* b_gu; const float* w_dn; const float* b_dn;
    const float* final_norm_w; float* out; unsigned char* ws; int ph_lo, ph_hi;
};

__device__ __forceinline__ void transpose_block(const float* src, int ld, bf16* dst, LAS float* scr, int lane) {
#pragma unroll 8
    for (int i = 0; i < 32; ++i) { const int kk = 2 * i + (lane >> 5); scr[kk * 33 + (lane & 31)] = src[(size_t)kk * ld + (lane & 31)]; }
    LDS_WAIT(); asm volatile("" ::: "memory");
    const int c = lane & 7;
#pragma unroll
    for (int j = 0; j < 4; ++j) { const int n = (lane >> 3) + 8 * j; const LAS float* s = scr + (8 * c) * 33 + n;
        v4u o; o.x = pk2(s[0 * 33], s[1 * 33]); o.y = pk2(s[2 * 33], s[3 * 33]); o.z = pk2(s[4 * 33], s[5 * 33]); o.w = pk2(s[6 * 33], s[7 * 33]);
        *(GAS v4u*)(dst + (size_t)n * D + 8 * c) = o; }
    LDS_WAIT(); asm volatile("" ::: "memory");
}
constexpr int IT_IN = 16 * (NPROJ / 32), IT_OUT = 16 * 32, IT_GU = NE * 16 * 64, IT_DN = NE * 16 * 32, IT_LAYER = IT_IN + IT_OUT + IT_GU + IT_DN, IT_ALL = DEPTH * IT_LAYER;
__device__ __forceinline__ void p0_prologue(const Args& a, LAS unsigned char* lds, int vcu, int G, int tid, int lane, int wave) {
    unsigned char* ws = a.ws;
    bf16* WIN = (bf16*)(ws + WS_WIN); bf16* WOUT = (bf16*)(ws + WS_WOUT); bf16* WGU = (bf16*)(ws + WS_WGU); bf16* WDN = (bf16*)(ws + WS_WDN);
    LAS float* scr = (LAS float*)(lds + wave * 16384);
    const int gw = vcu * NWAVES + wave, NGW = G * NWAVES;
    for (int it = gw; it < IT_ALL; it += NGW) {
        const int l = it / IT_LAYER; int r = it - l * IT_LAYER;
        if (r < IT_IN) { const int kb = r / (NPROJ / 32), nb = r % (NPROJ / 32), n0 = 32 * nb, sc = n0 + (n0 >= SRC_GA ? 16 : 0);
            transpose_block(a.w_in + ((size_t)l * D + 64 * kb) * DIN + sc, DIN, WIN + ((size_t)l * NPROJ + n0) * D + 64 * kb, scr, lane); continue; }
        r -= IT_IN;
        if (r < IT_OUT) { const int kb = r / 32, nb = r % 32;
            transpose_block(a.w_out + ((size_t)l * D + 64 * kb) * D + 32 * nb, D, WOUT + ((size_t)l * D + 32 * nb) * D + 64 * kb, scr, lane); continue; }
        r -= IT_OUT;
        if (r < IT_GU) { const int e = r / 1024, r2 = r % 1024, kb = r2 / 64, nb = r2 % 64, cc = 32 * nb;
            const int row = (cc < 1024) ? 256 * (cc / 128) + (cc % 128) : 256 * ((cc - 1024) / 128) + 128 + ((cc - 1024) % 128);
            transpose_block(a.w_gu + (((size_t)l * NE + e) * D + 64 * kb) * 2048 + cc, 2048, WGU + (((size_t)l * NE + e) * 2048 + row) * D + 64 * kb, scr, lane); continue; }
        r -= IT_GU;
        { const int e = r / 512, r2 = r % 512, kb = r2 / 32, nb = r2 % 32;
            transpose_block(a.w_dn + (((size_t)l * NE + e) * FFN + 64 * kb) * D + 32 * nb, D, WDN + (((size_t)l * NE + e) * D + 32 * nb) * D + 64 * kb, scr, lane); }
    }
    __syncthreads();
    {
        LAS float* cact = (LAS float*)lds;
        LAS float* red = (LAS float*)(lds + 8192);
        for (int i = tid; i < 2 * D; i += NTHR) cact[i] = silu_f(a.c[i]);
        __syncthreads();
        float* MOD = (float*)(ws + WS_MOD);
        for (int it = vcu; it < DEPTH * 96; it += G) {
            const int l = it / 96, n0 = (it % 96) * 64;
            const float* wp = a.w_mod + ((size_t)l * D + 128 * wave) * 6144 + n0 + lane;
            float a0 = 0.f, a1 = 0.f;
#pragma unroll 8
            for (int k = 0; k < 128; ++k) { const float w = wp[(size_t)k * 6144]; a0 += cact[128 * wave + k] * w; a1 += cact[D + 128 * wave + k] * w; }
            red[(wave * 2 + 0) * 64 + lane] = a0; red[(wave * 2 + 1) * 64 + lane] = a1;
            __syncthreads();
            if (tid < 128) { const int b = tid >> 6, ln = tid & 63; float s = a.b_mod[l * 6144 + n0 + ln];
#pragma unroll
                for (int w = 0; w < 8; ++w) s += red[(w * 2 + b) * 64 + ln];
                MOD[((size_t)l * 2 + b) * 6144 + n0 + ln] = s; }
            __syncthreads();
        }
    }
    {
        float* ROPE = (float*)(ws + WS_ROPE);
        for (int i = vcu * NTHR + tid; i < MTOK * 24; i += G * NTHR) { const int t = i / 24, f = i % 24;
            const float inv = (float)pow(10000.0, -(double)f / 24.0); const float ang = (float)a.pos[t] * inv;
            ROPE[(size_t)t * 48 + f] = cosf(ang); ROPE[(size_t)t * 48 + 24 + f] = sinf(ang); }
    }
    if (vcu == 0 && tid < 256) {
        float v[4], mx = -3.0e38f; for (int l = 0; l < 4; ++l) { v[l] = a.hg_lb[l * 256 + tid]; mx = fmaxf(mx, v[l]); }
        float s = 0.f; for (int l = 0; l < 4; ++l) { v[l] = expf(v[l] - mx); s += v[l]; }
        float* LB = (float*)(ws + WS_LB); float cs = 0.f, first = 0.f;
        for (int l = 0; l < 4; ++l) { cs += v[l] / s; if (l == 0) first = cs; LB[l * 256 + tid] = cs - first; }
    }
}

__device__ __forceinline__ void moe_combine_row(f32x4 (&v)[4], int m, const bf16* Y, const int* SLOT, const float* TOPW, const float* g2, int lane) {
    const int4 sl = *(const int4*)(SLOT + (size_t)m * 4); const f32x4 tw = *(const f32x4*)(TOPW + (size_t)m * 4);
    const int s[4] = {sl.x, sl.y, sl.z, sl.w};
    f32x4 acc[4];
#pragma unroll
    for (int j = 0; j < 4; ++j) acc[j] = (f32x4){0.f, 0.f, 0.f, 0.f};
#pragma unroll
    for (int k = 0; k < 4; ++k) { const bf16* yr = Y + (size_t)s[k] * D + 4 * lane; const float w = tw[k];
#pragma unroll
        for (int j = 0; j < 4; ++j) { const uint2 p = *(const uint2*)(yr + 256 * j);
            acc[j][0] += w * __builtin_bit_cast(float, p.x << 16); acc[j][1] += w * __builtin_bit_cast(float, p.x & 0xffff0000u);
            acc[j][2] += w * __builtin_bit_cast(float, p.y << 16); acc[j][3] += w * __builtin_bit_cast(float, p.y & 0xffff0000u); } }
#pragma unroll
    for (int j = 0; j < 4; ++j) { const f32x4 g = *(const f32x4*)(g2 + 4 * lane + 256 * j); v[j] = v[j] + g * acc[j]; }
}
__device__ __forceinline__ float row_rstd(const f32x4 (&v)[4]) {
    float s = 0.f;
#pragma unroll
    for (int j = 0; j < 4; ++j) s += (v[j][0] * v[j][0] + v[j][1] * v[j][1]) + (v[j][2] * v[j][2] + v[j][3] * v[j][3]);
    return 1.0f / sqrtf(wave_sum(s) * (1.0f / D) + EPS);
}
__device__ __forceinline__ void modulate_row(f32x4 (&v)[4], float rstd, const float* nw, const float* sc, const float* sh, bf16* hrow, int lane) {
#pragma unroll
    for (int j = 0; j < 4; ++j) { const int c0 = 4 * lane + 256 * j; const f32x4 w = *(const f32x4*)(nw + c0), s1 = *(const f32x4*)(sc + c0), s0 = *(const f32x4*)(sh + c0);
        v[j] = v[j] * rstd * w * (s1 + 1.0f) + s0;
        uint2 p; p.x = pk2(v[j][0], v[j][1]); p.y = pk2(v[j][2], v[j][3]); *(uint2*)(hrow + c0) = p; }
}

__device__ __forceinline__ void p1_rows(const Args& a, int layer, LAS unsigned char* lds, int vcu, int G, int tid, int lane, int wave) {
    unsigned char* ws = a.ws;
    float* X = (float*)(ws + WS_X); bf16* H = (bf16*)(ws + WS_H); float* GA = (float*)(ws + WS_GA); const float* MOD = (const float*)(ws + WS_MOD);
    LAS float* gaw = (LAS float*)lds;
    for (int i = tid; i < D * 16; i += NTHR) { const int k = i >> 4, r = i & 15; const int p = ((k >> 8) * 4 + (k & 3)) * 64 + ((k >> 2) & 63);
        gaw[p * 20 + r] = a.w_in[((size_t)layer * D + k) * DIN + SRC_GA + r]; }
    __syncthreads();
    const float* xin = (layer == 0) ? a.x : X;
    const float* n1w = a.norm1_w + layer * D;
    for (int m = (vcu * NWAVES + wave); m < MTOK; m += G * NWAVES) {
        const int b = m / SEQ; f32x4 v[4];
#pragma unroll
        for (int j = 0; j < 4; ++j) v[j] = *(const f32x4*)(xin + (size_t)m * D + 4 * lane + 256 * j);
        if (layer > 0) {
            moe_combine_row(v, m, (const bf16*)(ws + WS_Y), (const int*)(ws + WS_SLOT), (const float*)(ws + WS_TOPW), MOD + ((size_t)(layer - 1) * 2 + b) * 6144 + 5 * D, lane);
#pragma unroll
            for (int j = 0; j < 4; ++j) *(f32x4*)(X + (size_t)m * D + 4 * lane + 256 * j) = v[j];
        }
        const float rstd = row_rstd(v);
        const float* mp = MOD + ((size_t)layer * 2 + b) * 6144;
        modulate_row(v, rstd, n1w, mp + 1 * D, mp + 0 * D, H + (size_t)m * D, lane);
        float g[16];
#pragma unroll
        for (int r = 0; r < 16; ++r) g[r] = 0.f;
#pragma unroll
        for (int j = 0; j < 4; ++j)
#pragma unroll
            for (int c = 0; c < 4; ++c) { const LAS f32x4* wp = (const LAS f32x4*)(gaw + ((j * 4 + c) * 64 + lane) * 20); const float hv = v[j][c];
#pragma unroll
                for (int q = 0; q < 4; ++q) { const f32x4 w = wp[q]; g[4 * q + 0] += hv * w[0]; g[4 * q + 1] += hv * w[1]; g[4 * q + 2] += hv * w[2]; g[4 * q + 3] += hv * w[3]; }
                if (c & 1) asm volatile("" ::: "memory"); }
        float mine = 0.f;
#pragma unroll
        for (int r = 0; r < 16; ++r) { const float s = wave_sum(g[r]); mine = (lane == r) ? s : mine; }
        if (lane < 16) GA[(size_t)m * 16 + lane] = mine;
    }
}

__device__ __forceinline__ void p5_rows(const Args& a, int layer, LAS unsigned char* lds, volatile LAS unsigned* MISC, gu32* ctl, int vcu, int G, int tid, int lane, int wave) {
    unsigned char* ws = a.ws;
    const float* X = (const float*)(ws + WS_X); bf16* H = (bf16*)(ws + WS_H); const float* MOD = (const float*)(ws + WS_MOD);
    int* TOPE = (int*)(ws + WS_TOPE); float* TOPW = (float*)(ws + WS_TOPW);
    LAS float* rw = (LAS float*)lds;
    for (int i = tid; i < D * NE; i += NTHR) { const int k = i >> 5, e = i & 31; const int p = ((k >> 8) * 4 + (k & 3)) * 64 + ((k >> 2) & 63);
        rw[p * 36 + e] = a.w_r[((size_t)layer * D + k) * NE + e]; }
    if (tid < NE) MISC[MW_HIST + tid] = 0u;
    __syncthreads();
    const float* n2w = a.norm2_w + layer * D;
    const float br = (lane < NE) ? a.b_r[layer * NE + lane] : 0.f;
    for (int m = (vcu * NWAVES + wave); m < MTOK; m += G * NWAVES) {
        const int b = m / SEQ; f32x4 v[4];
#pragma unroll
        for (int j = 0; j < 4; ++j) v[j] = *(const f32x4*)(X + (size_t)m * D + 4 * lane + 256 * j);
        const float rstd = row_rstd(v);
        const float* mp = MOD + ((size_t)layer * 2 + b) * 6144;
        modulate_row(v, rstd, n2w, mp + 4 * D, mp + 3 * D, H + (size_t)m * D, lane);
        float g[NE];
#pragma unroll
        for (int e = 0; e < NE; ++e) g[e] = 0.f;
#pragma unroll
        for (int j = 0; j < 4; ++j)
#pragma unroll
            for (int c = 0; c < 4; ++c) { const LAS f32x4* wp = (const LAS f32x4*)(rw + ((j * 4 + c) * 64 + lane) * 36); const float hv = v[j][c];
#pragma unroll
                for (int q = 0; q < 8; ++q) { const f32x4 w = wp[q]; g[4 * q + 0] += hv * w[0]; g[4 * q + 1] += hv * w[1]; g[4 * q + 2] += hv * w[2]; g[4 * q + 3] += hv * w[3]; }
                asm volatile("" ::: "memory"); }
        float logit = -3.0e38f;
#pragma unroll
        for (int e = 0; e < NE; ++e) { const float s = wave_sum(g[e]); logit = (lane == e) ? s + br : logit; }
        float tv[4]; int te[4];
#pragma unroll
        for (int r = 0; r < 4; ++r) {
            float mx = logit;
#pragma unroll
            for (int o = 1; o < 64; o <<= 1) mx = fmaxf(mx, __shfl_xor(mx, o));
            const unsigned long long bal = __ballot(logit == mx && lane < NE);
            const int idx = __ffsll((long long)bal) - 1;
            tv[r] = mx; te[r] = idx; if (lane == idx) logit = -3.0e38f;
        }
        const float e1 = expf(tv[1] - tv[0]), e2 = expf(tv[2] - tv[0]), e3 = expf(tv[3] - tv[0]); const float inv = 1.0f / (1.0f + e1 + e2 + e3);
        if (lane == 0) { *(int4*)(TOPE + (size_t)m * 4) = make_int4(te[0], te[1], te[2], te[3]); *(f32x4*)(TOPW + (size_t)m * 4) = (f32x4){inv, e1 * inv, e2 * inv, e3 * inv}; }
        if (lane < 4) { const int ee = (lane == 0) ? te[0] : (lane == 1) ? te[1] : (lane == 2) ? te[2] : te[3]; __hip_atomic_fetch_add((LAS unsigned*)&MISC[MW_HIST + ee], 1u, __ATOMIC_RELAXED, __HIP_MEMORY_SCOPE_WORKGROUP); }
    }
    __syncthreads();
    if (tid < NE) { const unsigned h = MISC[MW_HIST + tid]; if (h) atomicAdd((unsigned*)(ctl + CW_CNT + layer * NE + tid), h); }
}

__device__ __forceinline__ void final_rows(const Args& a, int vcu, int G, int lane, int wave) {
    unsigned char* ws = a.ws; const float* X = (const float*)(ws + WS_X); const float* MOD = (const float*)(ws + WS_MOD);
    for (int m = (vcu * NWAVES + wave); m < MTOK; m += G * NWAVES) {
        const int b = m / SEQ; f32x4 v[4];
#pragma unroll
        for (int j = 0; j < 4; ++j) v[j] = *(const f32x4*)(X + (size_t)m * D + 4 * lane + 256 * j);
        moe_combine_row(v, m, (const bf16*)(ws + WS_Y), (const int*)(ws + WS_SLOT), (const float*)(ws + WS_TOPW), MOD + ((size_t)(DEPTH - 1) * 2 + b) * 6144 + 5 * D, lane);
        const float rstd = row_rstd(v);
#pragma unroll
        for (int j = 0; j < 4; ++j) { const int c0 = 4 * lane + 256 * j; const f32x4 w = *(const f32x4*)(a.final_norm_w + c0); *(f32x4*)(a.out + (size_t)m * D + c0) = v[j] * rstd * w; }
    }
}

__device__ __noinline__ void moe_tables(gu32* ctl, int layer, volatile LAS unsigned* MISC, int tid) {
    if (tid < NE) MISC[MW_CNT + tid] = __hip_atomic_load(ctl + CW_CNT + layer * NE + tid, RLX_AGENT);
    __syncthreads();
    if (tid == 0) { unsigned p = 0;
        for (int e = 0; e < NE; ++e) { MISC[MW_PST + e] = p; const unsigned nt = (MISC[MW_CNT + e] + 255u) >> 8; for (unsigned t = 0; t < nt; ++t) MISC[MW_TILE + (p >> 8) + t] = (unsigned)e; p += nt << 8; }
        MISC[MW_PST + NE] = p; MISC[MW_NRT] = p >> 8; }
    __syncthreads();
}
__device__ __forceinline__ void p6_dispatch(const Args& a, int layer, volatile LAS unsigned* MISC, gu32* ctl, int vcu, int G, int tid, int lane, int wave) {
    unsigned char* ws = a.ws; const int* TOPE = (const int*)(ws + WS_TOPE); int* SLOT = (int*)(ws + WS_SLOT); const bf16* H = (const bf16*)(ws + WS_H); bf16* A1 = (bf16*)(ws + WS_A1);
    moe_tables(ctl, layer, MISC, tid);
    for (int t0 = vcu * 64; t0 < MTOK; t0 += G * 64) {
        if (tid < NE) MISC[MW_HIST + tid] = 0u;
        __syncthreads();
        int e = 0; unsigned r = 0;
        if (tid < 256) { e = TOPE[(size_t)t0 * 4 + tid]; r = __hip_atomic_fetch_add((LAS unsigned*)&MISC[MW_HIST + e], 1u, __ATOMIC_RELAXED, __HIP_MEMORY_SCOPE_WORKGROUP); }
        __syncthreads();
        if (tid < NE) { const unsigned h = MISC[MW_HIST + tid]; MISC[MW_BASE + tid] = h ? atomicAdd((unsigned*)(ctl + CW_FILL + layer * NE + tid), h) : 0u; }
        __syncthreads();
        if (tid < 256) { const int slot = (int)(MISC[MW_PST + e] + MISC[MW_BASE + e] + r); SLOT[(size_t)t0 * 4 + tid] = slot; MISC[MW_SLOTS + tid] = (unsigned)slot; }
        __syncthreads();
        for (int i = wave * 32; i < wave * 32 + 32; ++i) { const int slot = (int)MISC[MW_SLOTS + i]; const int t = t0 + (i >> 2);
            const v4u* src = (const v4u*)(H + (size_t)t * D); v4u* dst = (v4u*)(A1 + (size_t)slot * D);
            dst[lane] = src[lane]; dst[lane + 64] = src[lane + 64]; }
        __syncthreads();
    }
}

constexpr int L_QS = 0, L_KS = 16640, L_GS = 33280, L_OS = 0  , L_VT = 49920, L_KT = 63744, L_QT = 72960, L_AM = 82176, L_ST = 91392, L_GA = 105216, L_WA = 109312;
constexpr int FP = 65, BP = 72, OP = 97;
template <int TYPE> struct MixCfg { static constexpr int DK = (TYPE == 1) ? 64 : 48, DV = (TYPE == 1) ? 64 : 96; };

template <int TYPE, bool NEEDQ>
__device__ __forceinline__ void mix_load(const Args& a, int layer, int h, int row0, LAS unsigned char* lds, int tid, int lane, int wave) {
    constexpr int DK = MixCfg<TYPE>::DK, DV = MixCfg<TYPE>::DV;
    unsigned char* ws = a.ws; const bf16* PROJ = (const bf16*)(ws + WS_PROJ);
    LAS float* Qs = (LAS float*)(lds + L_QS); LAS float* Ks = (LAS float*)(lds + L_KS); LAS float* Gs = (LAS float*)(lds + L_GS); LAS bf16* VT = (LAS bf16*)(lds + L_VT);
    const LAS float* GAs = (const LAS float*)(lds + L_GA); const LAS float* WAs = (const LAS float*)(lds + L_WA);
    for (int idx = tid; idx < CH * DK; idx += NTHR) { const int t = idx / DK, d = idx - t * DK; const bf16* pr = PROJ + (size_t)(row0 + t) * NPROJ;
        float q = 0.f, k, g;
        if constexpr (TYPE == 0) {
            k = bf2f(pr[C_GK + h * 48 + d]); if (NEEDQ) q = bf2f(pr[C_GQ + h * 48 + d]) * 0.14433756729740643f;
            float pre = a.gla_ba2[layer * 192 + h * 48 + d];
#pragma unroll
            for (int r = 0; r < 16; ++r) pre += GAs[t * 16 + r] * WAs[r * 192 + h * 48 + d];
            g = log_sigmoid_f(pre) * (1.0f / 16.0f);
        } else if constexpr (TYPE == 1) {
            const float hf = bf2f(pr[C_HF + h * 64 + d]); const float ls = log_sigmoid_f(hf); const float lbv = ((const float*)(ws + WS_LB))[layer * 256 + h * 64 + d];
            const float la = logf(lbv), lb2 = log1pf(-lbv) + ls;
            const float mx = fmaxf(la, lb2); g = mx + log1pf(expf(-fabsf(la - lb2)));
            k = -expm1f(g); if (NEEDQ) q = bf2f(pr[C_HQ + h * 64 + d]);
        } else {
            const float* rp = (const float*)(ws + WS_ROPE) + (size_t)(row0 + t) * 48; const int f = (d < 24) ? d : d - 24; const float cs = rp[f], sn = rp[24 + f];
            const int d2 = (d < 24) ? d + 24 : d - 24; const float sg = (d < 24) ? -1.f : 1.f;
            k = bf2f(pr[C_RK + h * 48 + d]) * cs + sg * bf2f(pr[C_RK + h * 48 + d2]) * sn;
            if (NEEDQ) q = (bf2f(pr[C_RQ + h * 48 + d]) * cs + sg * bf2f(pr[C_RQ + h * 48 + d2]) * sn) * 0.14433756729740643f;
            g = logf(1.0f - exp2f(-5.0f - (float)h));
        }
        if (NEEDQ) Qs[t * FP + d] = q;
        Ks[t * FP + d] = k; Gs[t * FP + d] = g; }
    constexpr int CV = (TYPE == 0) ? C_GV : (TYPE == 1) ? C_HI : C_RV;
    for (int idx = tid; idx < CH * DV; idx += NTHR) { const int j = idx / DV, e = idx - j * DV; VT[e * BP + j] = PROJ[(size_t)(row0 + j) * NPROJ + CV + h * DV + e]; }
    __syncthreads();
    for (int d = wave; d < DK; d += NWAVES) { float v = Gs[lane * FP + d];
#pragma unroll
        for (int o = 1; o < 64; o <<= 1) { const float t = __shfl_up(v, o); if (lane >= o) v += t; }
        Gs[lane * FP + d] = v; }
    __syncthreads();
}

template <int TYPE>
__device__ __forceinline__ void mix_summary_head(const Args& a, int layer, int h, int unit, LAS unsigned char* lds, int tid, int lane, int wave) {
    constexpr int DK = MixCfg<TYPE>::DK, DV = MixCfg<TYPE>::DV, STOFF = (TYPE == 0) ? ST_GLA : (TYPE == 1) ? ST_HG : ST_RET;
    unsigned char* ws = a.ws; float* U = (float*)(ws + WS_U) + (size_t)unit * ST_TOT + STOFF + h * DK * DV; float* DVEC = (float*)(ws + WS_DVEC) + (size_t)unit * NDV;
    const int row0 = unit * CH;
    mix_load<TYPE, false>(a, layer, h, row0, lds, tid, lane, wave);
    const LAS float* Ks = (const LAS float*)(lds + L_KS); const LAS float* Gs = (const LAS float*)(lds + L_GS); LAS bf16* VT = (LAS bf16*)(lds + L_VT); LAS bf16* KT = (LAS bf16*)(lds + L_KT);
    for (int idx = tid; idx < CH * DK; idx += NTHR) { const int d = idx >> 6, j = idx & 63; KT[d * BP + j] = (bf16)f2bf(Ks[j * FP + d] * __expf(Gs[63 * FP + d] - Gs[j * FP + d])); }
    if (TYPE != 2 && tid < DK) DVEC[(TYPE == 0 ? 0 : 192) + h * DK + tid] = expf(Gs[63 * FP + tid]);
    __syncthreads();
    constexpr int TD = DK / 16, NT = (DV / 16) * TD;
    for (int ti = wave; ti < NT; ti += NWAVES) { const int te = ti / TD, td = ti - te * TD; f32x4 acc = {0.f, 0.f, 0.f, 0.f};
#pragma unroll
        for (int kk = 0; kk < 2; ++kk) acc = __builtin_amdgcn_mfma_f32_16x16x32_bf16(ldfrag(VT, BP, te * 16, kk * 32, lane), ldfrag(KT, BP, td * 16, kk * 32, lane), acc, 0, 0, 0);
#pragma unroll
        for (int r = 0; r < 4; ++r) U[(te * 16 + (lane >> 4) * 4 + r) * DK + td * 16 + (lane & 15)] = acc[r]; }
    __syncthreads();
}
__device__ __forceinline__ void mix_stage_ga(const Args& a, int layer, int row0, LAS unsigned char* lds, int tid) {
    LAS float* GAs = (LAS float*)(lds + L_GA); LAS float* WAs = (LAS float*)(lds + L_WA); const float* GA = (const float*)(a.ws + WS_GA);
    for (int i = tid; i < CH * 16; i += NTHR) GAs[i] = GA[(size_t)row0 * 16 + i];
    for (int i = tid; i < 16 * 192; i += NTHR) WAs[i] = a.gla_wa2[layer * 16 * 192 + i];
    __syncthreads();
}
__device__ __forceinline__ void p3a_summaries(const Args& a, int layer, LAS unsigned char* lds, int vcu, int G, int tid, int lane, int wave) {
    for (int unit = vcu; unit < NUNIT; unit += G) {
        mix_stage_ga(a, layer, unit * CH, lds, tid);
        for (int h = 0; h < 4; ++h) mix_summary_head<0>(a, layer, h, unit, lds, tid, lane, wave);
        for (int h = 0; h < 4; ++h) mix_summary_head<1>(a, layer, h, unit, lds, tid, lane, wave);
        for (int h = 0; h < 4; ++h) mix_summary_head<2>(a, layer, h, unit, lds, tid, lane, wave);
    }
}

__device__ __forceinline__ void p3b_scan(const Args& a, int vcu, int G, int tid) {
    unsigned char* ws = a.ws; const float* U = (const float*)(ws + WS_U); const float* DVEC = (const float*)(ws + WS_DVEC); bf16* SP = (bf16*)(ws + WS_SP);
    for (int gid = vcu * NTHR + tid; gid < BATCH * ST_TOT; gid += G * NTHR) {
        const int b = gid / ST_TOT, el = gid - b * ST_TOT;
        int di = -1; float cdec = 0.f;
        if (el < ST_HG) { const int h = el / 4608, d = (el - h * 4608) % 48; di = h * 48 + d; }
        else if (el < ST_RET) { const int r = el - ST_HG, h = r / 4096, d = r % 64; di = 192 + h * 64 + d; }
        else { const int h = (el - ST_RET) / 4608; cdec = expf(64.0f * logf(1.0f - exp2f(-5.0f - (float)h))); }
        const float* up = U + (size_t)b * NCH * ST_TOT + el; const float* dp = DVEC + (size_t)b * NCH * NDV + (di < 0 ? 0 : di); bf16* sp = SP + (size_t)b * NCH * ST_TOT + el;
        float s = 0.f;
        for (int n0 = 0; n0 < NCH; n0 += 8) { float u[8], dc[8];
#pragma unroll
            for (int i = 0; i < 8; ++i) { u[i] = up[(size_t)(n0 + i) * ST_TOT]; dc[i] = (di < 0) ? cdec : dp[(size_t)(n0 + i) * NDV]; }
#pragma unroll
            for (int i = 0; i < 8; ++i) { sp[(size_t)(n0 + i) * ST_TOT] = (bf16)f2bf(s); s = dc[i] * s + u[i]; } }
    }
}

template <int TYPE>
__device__ __forceinline__ void mix_output_head(const Args& a, int layer, int h, int unit, LAS unsigned char* lds, int tid, int lane, int wave) {
    constexpr int DK = MixCfg<TYPE>::DK, DV = MixCfg<TYPE>::DV, STOFF = (TYPE == 0) ? ST_GLA : (TYPE == 1) ? ST_HG : ST_RET;
    unsigned char* ws = a.ws; const bf16* SPp = (const bf16*)(ws + WS_SP) + (size_t)unit * ST_TOT + STOFF + h * DK * DV; const bf16* PROJ = (const bf16*)(ws + WS_PROJ); bf16* MIX = (bf16*)(ws + WS_MIX);
    const int row0 = unit * CH;
    mix_load<TYPE, true>(a, layer, h, row0, lds, tid, lane, wave);
    const LAS float* Qs = (const LAS float*)(lds + L_QS); const LAS float* Ks = (const LAS float*)(lds + L_KS); const LAS float* Gs = (const LAS float*)(lds + L_GS);
    LAS bf16* VT = (LAS bf16*)(lds + L_VT); LAS bf16* QT = (LAS bf16*)(lds + L_QT); LAS bf16* AM = (LAS bf16*)(lds + L_AM); LAS bf16* ST = (LAS bf16*)(lds + L_ST); LAS float* Os = (LAS float*)(lds + L_OS);
    {
        const int bi = tid >> 5, bj = tid & 31; float acc[4][2];
#pragma unroll
        for (int x = 0; x < 4; ++x) { acc[x][0] = 0.f; acc[x][1] = 0.f; }
        if (2 * bj <= 4 * bi + 3) {
#pragma unroll 2
            for (int d = 0; d < DK; ++d) { float qv[4], ci[4], kv[2], cj[2];
#pragma unroll
                for (int x = 0; x < 4; ++x) { qv[x] = Qs[(4 * bi + x) * FP + d]; ci[x] = Gs[(4 * bi + x) * FP + d]; }
#pragma unroll
                for (int y = 0; y < 2; ++y) { kv[y] = Ks[(2 * bj + y) * FP + d]; cj[y] = Gs[(2 * bj + y) * FP + d]; }
#pragma unroll
                for (int x = 0; x < 4; ++x)
#pragma unroll
                    for (int y = 0; y < 2; ++y) acc[x][y] += qv[x] * kv[y] * __expf(fminf(ci[x] - cj[y], 0.f)); }
        }
#pragma unroll
        for (int x = 0; x < 4; ++x) { const int i = 4 * bi + x; const float v0 = (2 * bj <= i) ? acc[x][0] : 0.f, v1 = (2 * bj + 1 <= i) ? acc[x][1] : 0.f; *(LAS unsigned*)(AM + i * BP + 2 * bj) = pk2(v0, v1); }
    }
    for (int idx = tid; idx < CH * 64; idx += NTHR) { const int i = idx >> 6, d = idx & 63; QT[i * BP + d] = (d < DK) ? (bf16)f2bf(Qs[i * FP + d] * __expf(Gs[i * FP + d])) : (bf16)0; }
    for (int idx = tid; idx < DV * 64; idx += NTHR) { const int e = idx >> 6, d = idx & 63; ST[e * BP + d] = (d < DK) ? SPp[e * DK + d] : (bf16)0; }
    __syncthreads();
    constexpr int TE = DV / 16, NT = 4 * TE, NIT = NT / NWAVES; static_assert(NT % NWAVES == 0, "tiles per wave");
    f32x4 accs[NIT];
#pragma unroll
    for (int it = 0; it < NIT; ++it) { const int ti = wave + NWAVES * it, tr = ti / TE, te = ti - tr * TE; f32x4 acc = {0.f, 0.f, 0.f, 0.f};
#pragma unroll
        for (int kk = 0; kk < 2; ++kk) acc = __builtin_amdgcn_mfma_f32_16x16x32_bf16(ldfrag(QT, BP, tr * 16, kk * 32, lane), ldfrag(ST, BP, te * 16, kk * 32, lane), acc, 0, 0, 0);
#pragma unroll
        for (int kk = 0; kk < 2; ++kk) acc = __builtin_amdgcn_mfma_f32_16x16x32_bf16(ldfrag(AM, BP, tr * 16, kk * 32, lane), ldfrag(VT, BP, te * 16, kk * 32, lane), acc, 0, 0, 0);
        accs[it] = acc; }
    __syncthreads();
#pragma unroll
    for (int it = 0; it < NIT; ++it) { const int ti = wave + NWAVES * it, tr = ti / TE, te = ti - tr * TE; const f32x4 acc = accs[it];
#pragma unroll
        for (int r = 0; r < 4; ++r) Os[(tr * 16 + (lane >> 4) * 4 + r) * OP + te * 16 + (lane & 15)] = acc[r]; }
    __syncthreads();
    {
        const int row = tid >> 3, sub = tid & 7; constexpr int NEL = DV / 8; float o[NEL]; float s1 = 0.f, s2 = 0.f;
#pragma unroll
        for (int m = 0; m < NEL; ++m) { o[m] = Os[row * OP + sub + 8 * m]; s1 += o[m]; s2 += o[m] * o[m]; }
#pragma unroll
        for (int x = 1; x < 8; x <<= 1) { s1 += __shfl_xor(s1, x); s2 += __shfl_xor(s2, x); }
        const bf16* pr = PROJ + (size_t)(row0 + row) * NPROJ; bf16* mo = MIX + (size_t)(row0 + row) * D;
        if constexpr (TYPE == 2) { const float mean = s1 * (1.0f / DV); float var = 0.f;
#pragma unroll
            for (int m = 0; m < NEL; ++m) { const float dd = o[m] - mean; var += dd * dd; }
#pragma unroll
            for (int x = 1; x < 8; x <<= 1) var += __shfl_xor(var, x);
            const float rstd = 1.0f / sqrtf(var * (1.0f / DV) + EPS);
#pragma unroll
            for (int m = 0; m < NEL; ++m) { const int e = sub + 8 * m; mo[640 + h * 96 + e] = (bf16)f2bf((o[m] - mean) * rstd * silu_f(bf2f(pr[C_RG + h * 96 + e]))); }
        } else { const float rstd = 1.0f / sqrtf(s2 * (1.0f / DV) + EPS);
#pragma unroll
            for (int m = 0; m < NEL; ++m) { const int e = sub + 8 * m;
                if constexpr (TYPE == 0) mo[h * 96 + e] = (bf16)f2bf(o[m] * rstd * a.gla_norm_w[layer * 384 + h * 96 + e] * silu_f(bf2f(pr[C_GG + h * 96 + e])));
                else mo[384 + h * 64 + e] = (bf16)f2bf(o[m] * rstd * a.hg_norm_w[layer * 256 + h * 64 + e] * sigmoid_f(bf2f(pr[C_HG + h * 64 + e]))); }
        }
    }
    __syncthreads();
}
__device__ __forceinline__ void p3c_outputs(const Args& a, int layer, LAS unsigned char* lds, int vcu, int G, int tid, int lane, int wave) {
    for (int unit = vcu; unit < NUNIT; unit += G) {
        mix_stage_ga(a, layer, unit * CH, lds, tid);
        for (int h = 0; h < 4; ++h) mix_output_head<0>(a, layer, h, unit, lds, tid, lane, wave);
        for (int h = 0; h < 4; ++h) mix_output_head<1>(a, layer, h, unit, lds, tid, lane, wave);
        for (int h = 0; h < 4; ++h) mix_output_head<2>(a, layer, h, unit, lds, tid, lane, wave);
    }
}

constexpr int MW_ARGS = 800;
__device__ __forceinline__ const void* ld_argp(const volatile LAS unsigned* T, int i) {
    const unsigned lo = __builtin_amdgcn_readfirstlane(T[2 * i]), hi = __builtin_amdgcn_readfirstlane(T[2 * i + 1]);
    return (const void*)(((unsigned long long)hi << 32) | lo);
}
__device__ __forceinline__ Args load_args(LAS unsigned char* lds) {
    const volatile LAS unsigned* T = (const volatile LAS unsigned*)(lds + MISC_OFF) + MW_ARGS;
    Args a;
    a.x = (const float*)ld_argp(T, 0); a.c = (const float*)ld_argp(T, 1); a.pos = (const int*)ld_argp(T, 2); a.w_mod = (const float*)ld_argp(T, 3); a.b_mod = (const float*)ld_argp(T, 4);
    a.norm1_w = (const float*)ld_argp(T, 5); a.w_in = (const float*)ld_argp(T, 6); a.gla_wa2 = (const float*)ld_argp(T, 7); a.gla_ba2 = (const float*)ld_argp(T, 8); a.hg_lb = (const float*)ld_argp(T, 9);
    a.gla_norm_w = (const float*)ld_argp(T, 10); a.hg_norm_w = (const float*)ld_argp(T, 11); a.w_out = (const float*)ld_argp(T, 12); a.norm2_w = (const float*)ld_argp(T, 13); a.w_r = (const float*)ld_argp(T, 14);
    a.b_r = (const float*)ld_argp(T, 15); a.w_gu = (const float*)ld_argp(T, 16); a.b_gu = (const float*)ld_argp(T, 17); a.w_dn = (const float*)ld_argp(T, 18); a.b_dn = (const float*)ld_argp(T, 19);
    a.final_norm_w = (const float*)ld_argp(T, 20); a.out = (float*)ld_argp(T, 21); a.ws = (unsigned char*)ld_argp(T, 22); a.ph_lo = 0; a.ph_hi = 0;
    return a;
}
#define PH_CTX() const Args args = load_args(lds); volatile LAS unsigned* MISC = (volatile LAS unsigned*)(lds + MISC_OFF); int tid_ = threadIdx.x; asm volatile("" : "+v"(tid_)); const int tid = tid_, lane = tid & 63, wave = __builtin_amdgcn_readfirstlane(tid >> 6); \
    const int G = gridDim.x; const int bx = blockIdx.x; const int vcu = (G % 8 == 0) ? (bx % 8) * (G / 8) + bx / 8 : bx; unsigned char* ws = args.ws; gu32* ctl = (gu32*)(ws + WS_CTL); \
    (void)MISC; (void)lane; (void)wave; (void)vcu; (void)ctl; (void)bx; (void)tid
__device__ __forceinline__ void ph_p0(LAS unsigned char* lds) { PH_CTX(); p0_prologue(args, lds, vcu, G, tid, lane, wave); }
__device__ __forceinline__ void ph_p1(LAS unsigned char* lds, int layer_) { int layer = __builtin_amdgcn_readfirstlane(layer_); asm volatile("" : "+s"(layer)); PH_CTX(); p1_rows(args, layer, lds, vcu, G, tid, lane, wave); }
__device__ __forceinline__ void ph_p2(LAS unsigned char* lds, int layer_) { int layer = __builtin_amdgcn_readfirstlane(layer_); asm volatile("" : "+s"(layer)); PH_CTX();
    pg8::Gemm g{(const bf16*)(ws + WS_H), (const bf16*)(ws + WS_WIN) + (size_t)layer * NPROJ * D, MTOK, NPROJ, D}; pg8::StaticOrder S; S.init(MTOK, NPROJ, G, bx);
    pg8::EpiBf16Plain E{(bf16*)(ws + WS_PROJ), NPROJ};
    pg8::gemm_phase<pg8::EpiBf16Plain, pg8::StaticOrder, true, true>(lds, g, S, E); }
__device__ __forceinline__ void ph_p3a(LAS unsigned char* lds, int layer_) { int layer = __builtin_amdgcn_readfirstlane(layer_); asm volatile("" : "+s"(layer)); PH_CTX(); p3a_summaries(args, layer, lds, vcu, G, tid, lane, wave); }
__device__ __forceinline__ void ph_p3b(LAS unsigned char* lds) { PH_CTX(); p3b_scan(args, vcu, G, tid); }
__device__ __forceinline__ void ph_p3c(LAS unsigned char* lds, int layer_) { int layer = __builtin_amdgcn_readfirstlane(layer_); asm volatile("" : "+s"(layer)); PH_CTX(); p3c_outputs(args, layer, lds, vcu, G, tid, lane, wave); }
__device__ __forceinline__ void ph_p4(LAS unsigned char* lds, int layer_) { int layer = __builtin_amdgcn_readfirstlane(layer_); asm volatile("" : "+s"(layer)); PH_CTX();
    pg8::Gemm g{(const bf16*)(ws + WS_MIX), (const bf16*)(ws + WS_WOUT) + (size_t)layer * D * D, MTOK, D, D}; pg8::StaticOrder S; S.init(MTOK, D, G, bx);
    pg8::EpiResGate E{(layer == 0) ? args.x : (const float*)(ws + WS_X), (float*)(ws + WS_X), D, (const float*)(ws + WS_MOD) + (size_t)layer * 2 * 6144 + 2 * D, 6144, SEQ};
    pg8::gemm_phase<pg8::EpiResGate, pg8::StaticOrder, true, true>(lds, g, S, E); }
__device__ __forceinline__ void ph_p5(LAS unsigned char* lds, int layer_) { int layer = __builtin_amdgcn_readfirstlane(layer_); asm volatile("" : "+s"(layer)); PH_CTX(); p5_rows(args, layer, lds, MISC, ctl, vcu, G, tid, lane, wave); }
__device__ __forceinline__ void ph_p6(LAS unsigned char* lds, int layer_) { int layer = __builtin_amdgcn_readfirstlane(layer_); asm volatile("" : "+s"(layer)); PH_CTX(); p6_dispatch(args, layer, MISC, ctl, vcu, G, tid, lane, wave); }
__device__ __forceinline__ void ph_p7(LAS unsigned char* lds, int layer_) { int layer = __builtin_amdgcn_readfirstlane(layer_); asm volatile("" : "+s"(layer)); PH_CTX();
    moe_tables(ctl, layer, MISC, tid);
    const int nrt = __builtin_amdgcn_readfirstlane((int)MISC[MW_NRT]);
    pg8::Gemm g{(const bf16*)(ws + WS_A1), (const bf16*)(ws + WS_WGU) + (size_t)layer * NE * 2048 * D, nrt * 256, NE * 2048, D};
    pg8::MoeOrder S{8, G, vcu, nrt * 8, (const LAS int*)(lds + MISC_OFF + 4 * MW_TILE)};
    pg8::EpiSwiglu E{(bf16*)(ws + WS_ACT), FFN, args.b_gu + (size_t)layer * NE * 2048};
    pg8::gemm_phase<pg8::EpiSwiglu, pg8::MoeOrder, true, true>(lds, g, S, E); }
__device__ __forceinline__ void ph_p8(LAS unsigned char* lds, int layer_) { int layer = __builtin_amdgcn_readfirstlane(layer_); asm volatile("" : "+s"(layer)); PH_CTX();
    moe_tables(ctl, layer, MISC, tid);
    const int nrt = __builtin_amdgcn_readfirstlane((int)MISC[MW_NRT]);
    pg8::Gemm g{(const bf16*)(ws + WS_ACT), (const bf16*)(ws + WS_WDN) + (size_t)layer * NE * D * FFN, nrt * 256, NE * D, FFN};
    pg8::MoeOrder S{4, G, vcu, nrt * 4, (const LAS int*)(lds + MISC_OFF + 4 * MW_TILE)};
    pg8::EpiBf16Bias E{(bf16*)(ws + WS_Y), D, args.b_dn + (size_t)layer * NE * D, D};
    pg8::gemm_phase<pg8::EpiBf16Bias, pg8::MoeOrder, true, true>(lds, g, S, E); }
__device__ __forceinline__ void ph_final(LAS unsigned char* lds) { PH_CTX(); final_rows(args, vcu, G, lane, wave); }

__global__ void __launch_bounds__(NTHR, 2) hybrid_fwd(Args args) {
    extern __shared__ __attribute__((aligned(16))) unsigned char lds_raw[];
    LAS unsigned char* lds = (LAS unsigned char*)lds_raw;
    volatile LAS unsigned* MISC = (volatile LAS unsigned*)(lds + MISC_OFF);
    const int tid = threadIdx.x;
    gu32* ctl = (gu32*)(args.ws + WS_CTL);
    for (int u = tid; u < (LDS_BYTES - MISC_OFF) / 4; u += NTHR) MISC[u] = 0u;
    __syncthreads();
    if (tid == 0) {
#define ST_ARG(i, p) do { const unsigned long long v_ = (unsigned long long)(p); MISC[MW_ARGS + 2 * (i)] = (unsigned)v_; MISC[MW_ARGS + 2 * (i) + 1] = (unsigned)(v_ >> 32); } while (0)
        ST_ARG(0, args.x); ST_ARG(1, args.c); ST_ARG(2, args.pos); ST_ARG(3, args.w_mod); ST_ARG(4, args.b_mod); ST_ARG(5, args.norm1_w); ST_ARG(6, args.w_in); ST_ARG(7, args.gla_wa2); ST_ARG(8, args.gla_ba2);
        ST_ARG(9, args.hg_lb); ST_ARG(10, args.gla_norm_w); ST_ARG(11, args.hg_norm_w); ST_ARG(12, args.w_out); ST_ARG(13, args.norm2_w); ST_ARG(14, args.w_r); ST_ARG(15, args.b_r); ST_ARG(16, args.w_gu);
        ST_ARG(17, args.b_gu); ST_ARG(18, args.w_dn); ST_ARG(19, args.b_dn); ST_ARG(20, args.final_norm_w); ST_ARG(21, args.out); ST_ARG(22, args.ws);
#undef ST_ARG
    }
    __syncthreads();
    const int lo = args.ph_lo, hi = args.ph_hi;
    const bool multi = (hi - lo) > 1;
    XcdBarrier bar; bar.bar = (unsigned*)(ctl + CW_BAR); bar.x = 0; bar.st = nullptr;
    if (multi) bar = xcd_barrier_post((unsigned*)(ctl + CW_BAR), MISC + MW_BAR);
#define IN(k) (lo <= (k) && (k) < hi)
#define SEAM(k) do { if (IN(k) && IN((k) + 1)) xcd_barrier(bar); } while (0)

    if (IN(0)) ph_p0(lds);
    SEAM(0);
    for (int layer = 0; layer < DEPTH; ++layer) {
        const int pb = 1 + 10 * layer;
        if (IN(pb + 0)) ph_p1(lds, layer);
        SEAM(pb + 0);
        if (IN(pb + 1)) ph_p2(lds, layer);
        SEAM(pb + 1);
        if (IN(pb + 2)) ph_p3a(lds, layer);
        SEAM(pb + 2);
        if (IN(pb + 3)) ph_p3b(lds);
        SEAM(pb + 3);
        if (IN(pb + 4)) ph_p3c(lds, layer);
        SEAM(pb + 4);
        if (IN(pb + 5)) ph_p4(lds, layer);
        SEAM(pb + 5);
        if (IN(pb + 6)) ph_p5(lds, layer);
        SEAM(pb + 6);
        if (IN(pb + 7)) ph_p6(lds, layer);
        SEAM(pb + 7);
        if (IN(pb + 8)) ph_p7(lds, layer);
        SEAM(pb + 8);
        if (IN(pb + 9)) ph_p8(lds, layer);
        SEAM(pb + 9);
    }
    if (IN(NPHASE - 1)) ph_final(lds);
#undef IN
#undef SEAM
}

#ifndef MK_SINGLE
#define MK_SINGLE 0
#endif
extern "C" void kernel_launch(void* const* d_in, const int* in_sizes, int n_in, void* d_out, int out_size, void* d_ws, size_t ws_size, hipStream_t stream) {
    static int grid = 0;
    if (grid == 0) {
        if (n_in != 21 || in_sizes[0] != MTOK * D || out_size != MTOK * D || ws_size < WS_END) { fprintf(stderr, "kernel_launch: unexpected problem shape (n_in %d, in0 %d, out %d, ws %zu)\n", n_in, n_in > 0 ? in_sizes[0] : -1, out_size, ws_size); grid = -1; return; }
        int dev = 0, cus = 0, per_cu = 0;
        if (hipGetDevice(&dev) != hipSuccess || hipDeviceGetAttribute(&cus, hipDeviceAttributeMultiprocessorCount, dev) != hipSuccess) { grid = -1; return; }
        if (hipFuncSetAttribute((const void*)hybrid_fwd, hipFuncAttributeMaxDynamicSharedMemorySize, LDS_BYTES) != hipSuccess) { fprintf(stderr, "kernel_launch: hipFuncSetAttribute failed\n"); grid = -1; return; }
        if (hipOccupancyMaxActiveBlocksPerMultiprocessor(&per_cu, (const void*)hybrid_fwd, NTHR, LDS_BYTES) != hipSuccess || per_cu < 1) fprintf(stderr, "kernel_launch: occupancy query says %d\n", per_cu);
        (void)hipGetLastError();
        grid = cus;
    }
    if (grid < 0) return;
    (void)hipMemsetAsync((char*)d_ws + WS_CTL, 0, CTL_ZERO_BYTES, stream);
    Args a{};
    a.x = (const float*)d_in[0]; a.c = (const float*)d_in[1]; a.pos = (const int*)d_in[2]; a.w_mod = (const float*)d_in[3]; a.b_mod = (const float*)d_in[4]; a.norm1_w = (const float*)d_in[5];
    a.w_in = (const float*)d_in[6]; a.gla_wa2 = (const float*)d_in[7]; a.gla_ba2 = (const float*)d_in[8]; a.hg_lb = (const float*)d_in[9]; a.gla_norm_w = (const float*)d_in[10]; a.hg_norm_w = (const float*)d_in[11];
    a.w_out = (const float*)d_in[12]; a.norm2_w = (const float*)d_in[13]; a.w_r = (const float*)d_in[14]; a.b_r = (const float*)d_in[15]; a.w_gu = (const float*)d_in[16]; a.b_gu = (const float*)d_in[17];
    a.w_dn = (const float*)d_in[18]; a.b_dn = (const float*)d_in[19]; a.final_norm_w = (const float*)d_in[20]; a.out = (float*)d_out; a.ws = (unsigned char*)d_ws;
#if MK_SINGLE
    a.ph_lo = 0; a.ph_hi = NPHASE;
    hipLaunchKernelGGL(hybrid_fwd, dim3(grid), dim3(NTHR), LDS_BYTES, stream, a);
#else
    for (int p = 0; p < NPHASE; ++p) { a.ph_lo = p; a.ph_hi = p + 1; hipLaunchKernelGGL(hybrid_fwd, dim3(grid), dim3(NTHR), LDS_BYTES, stream, a); }
#endif
}
```

```cpp
#include <hip/hip_runtime.h>
#include <cstdio>
#include <cstdint>
namespace pg8 {
#define PG8_LAS __attribute__((address_space(3)))
typedef unsigned short bf16_t;
typedef short bf16x8 __attribute__((ext_vector_type(8)));
typedef float f32x4 __attribute__((ext_vector_type(4)));
typedef unsigned u32x4 __attribute__((ext_vector_type(4)));
constexpr int BM = 256, BK = 64, HALF = 128, HTB = HALF * BK * 2  , STAGE_BYTES = 8 * HTB, NXCD = 8, WGM = 8;

__host__ __device__ __forceinline__ int lds_byte(int r, int c) { const int st = (r >> 4) * 2 + (c >> 5), rr = r & 15, cc = c & 31, ob = rr * 64 + cc * 2; return st * 1024 + (ob ^ (((ob >> 9) & 1) << 5)); }
__host__ __device__ __forceinline__ void stage_rc(int b, int& R, int& C) { const int st = b / 1024, sb = b % 1024, swz = sb ^ (((sb >> 9) & 1) << 5); R = (st >> 1) * 16 + swz / 64; C = (st & 1) * 32 + (swz % 64) / 2; }
__host__ __device__ __forceinline__ int perm32(int rho) { const int n = rho >> 4, i = rho & 15; return 8 * (i >> 2) + 4 * n + (i & 3); }

struct Unit { int pm, pn, e, pl; };
struct Gemm { const bf16_t* A; const bf16_t* Bt; int M, N, K; };

struct StaticOrder {
    int nM, nN, nwg, G, c;
    __host__ __device__ void init(int M, int N, int G_, int c_) { nM = M / BM; nN = N / BM; nwg = nM * nN; G = G_; c = c_; }
    __host__ __device__ bool next(int i, Unit& u) const {
        const long L = (long)i * G + c; if (L >= nwg) return false;
        int wgid = (int)L; { const int q = nwg / NXCD, r = nwg % NXCD, xcd = wgid % NXCD, off = wgid / NXCD; wgid = (xcd < r ? xcd * (q + 1) : r * (q + 1) + (xcd - r) * q) + off; }
        const int nig = WGM * nN, gid = wgid / nig, fm = gid * WGM, gsz = (nM - fm) < WGM ? (nM - fm) : WGM;
        u.pm = fm + ((wgid % nig) % gsz); u.pn = (wgid % nig) / gsz; u.e = 0; u.pl = u.pn; return true;
    }
    __device__ __forceinline__ void a_ready(const Unit&) const {}
    __device__ __forceinline__ void done(const Unit&) const {}
};

__device__ __forceinline__ unsigned cvt_pk_bf16(float lo, float hi) { unsigned r; asm volatile("v_cvt_pk_bf16_f32 %0, %1, %2" : "=v"(r) : "v"(lo), "v"(hi)); return r; }

struct EpiBf16Plain {
    static constexpr bool PERM = true, AFTER_DRAIN = false;
    bf16_t* O; int ldc;
    __device__ __forceinline__ void operator()(const f32x4 (&acc)[2][2][4][2], const Unit& u, int wr, int wc, int fr, int fq) const {
        const int row0 = u.pm * BM + wr * 64 + fr; const int col0 = u.pn * BM + wc * 32 + 8 * fq;
#pragma unroll
        for (int ai = 0; ai < 2; ++ai)
#pragma unroll
            for (int m = 0; m < 4; ++m) { bf16_t* rowp = O + (size_t)(row0 + ai * HALF + m * 16) * ldc + col0;
#pragma unroll
                for (int bj = 0; bj < 2; ++bj) { const f32x4 v0 = acc[ai][bj][m][0], v1 = acc[ai][bj][m][1];
                    u32x4 w; w.x = cvt_pk_bf16(v0[0], v0[1]); w.y = cvt_pk_bf16(v0[2], v0[3]); w.z = cvt_pk_bf16(v1[0], v1[1]); w.w = cvt_pk_bf16(v1[2], v1[3]);
                    *(u32x4*)(rowp + bj * HALF) = w; } }
    }
};
struct EpiResGate {
    static constexpr bool PERM = false, AFTER_DRAIN = false;
    const float* base; float* out; int ldc; const float* gate; int gpitch; int rows_per_batch;
    __device__ __forceinline__ void operator()(const f32x4 (&acc)[2][2][4][2], const Unit& u, int wr, int wc, int fr, int fq) const {
        const int row0 = u.pm * BM + wr * 64 + fr, col0 = u.pn * BM + wc * 32 + 4 * fq;
        const float* gp = gate + (size_t)((u.pm * BM) / rows_per_batch) * gpitch + col0;
        f32x4 gv[2][2];
#pragma unroll
        for (int bj = 0; bj < 2; ++bj)
#pragma unroll
            for (int n = 0; n < 2; ++n) gv[bj][n] = *(const f32x4*)(gp + bj * HALF + n * 16);
#pragma unroll
        for (int ai = 0; ai < 2; ++ai)
#pragma unroll
            for (int m = 0; m < 4; ++m) { const size_t off = (size_t)(row0 + ai * HALF + m * 16) * ldc + col0;
#pragma unroll
                for (int bj = 0; bj < 2; ++bj)
#pragma unroll
                    for (int n = 0; n < 2; ++n) { const f32x4 bs = *(const f32x4*)(base + off + bj * HALF + n * 16);
                        *(f32x4*)(out + off + bj * HALF + n * 16) = bs + gv[bj][n] * acc[ai][bj][m][n]; }
                asm volatile("" ::: "memory"); }
    }
};
struct EpiSwiglu {
    static constexpr bool PERM = true, AFTER_DRAIN = false;
    bf16_t* O; int ldc; const float* bias;
    __device__ __forceinline__ float act1(float g, float up) const {
        g = fminf(g, 7.0f); up = fminf(fmaxf(up, -7.0f), 7.0f);
        const float s = 1.0f / (1.0f + __expf(-1.702f * g));
        return (up + 1.0f) * g * s;
    }
    __device__ __forceinline__ void operator()(const f32x4 (&acc)[2][2][4][2], const Unit& u, int wr, int wc, int fr, int fq) const {
        const int row0 = u.pm * BM + wr * 64 + fr; const int jj0 = wc * 32 + 8 * fq; const int col0 = u.pl * HALF + jj0;
        const float* bp = bias + (size_t)u.e * 2048 + col0;
        f32x4 bg[2], bu[2];
#pragma unroll
        for (int n = 0; n < 2; ++n) { bg[n] = *(const f32x4*)(bp + 4 * n); bu[n] = *(const f32x4*)(bp + 1024 + 4 * n); }
#pragma unroll
        for (int ai = 0; ai < 2; ++ai)
#pragma unroll
            for (int m = 0; m < 4; ++m) { bf16_t* rowp = O + (size_t)(row0 + ai * HALF + m * 16) * ldc + col0;
                f32x4 r[2];
#pragma unroll
                for (int n = 0; n < 2; ++n) { const f32x4 g = acc[ai][0][m][n] + bg[n], up = acc[ai][1][m][n] + bu[n];
#pragma unroll
                    for (int j = 0; j < 4; ++j) r[n][j] = act1(g[j], up[j]); }
                u32x4 w; w.x = cvt_pk_bf16(r[0][0], r[0][1]); w.y = cvt_pk_bf16(r[0][2], r[0][3]); w.z = cvt_pk_bf16(r[1][0], r[1][1]); w.w = cvt_pk_bf16(r[1][2], r[1][3]);
                *(u32x4*)rowp = w; }
    }
};
struct EpiBf16Bias {
    static constexpr bool PERM = true, AFTER_DRAIN = false;
    bf16_t* O; int ldc; const float* bias; int bpitch;
    __device__ __forceinline__ void operator()(const f32x4 (&acc)[2][2][4][2], const Unit& u, int wr, int wc, int fr, int fq) const {
        const int row0 = u.pm * BM + wr * 64 + fr; const int col0 = u.pl * BM + wc * 32 + 8 * fq;
        const float* bp = bias + (size_t)u.e * bpitch + col0;
        f32x4 bv[2][2];
#pragma unroll
        for (int bj = 0; bj < 2; ++bj)
#pragma unroll
            for (int n = 0; n < 2; ++n) bv[bj][n] = *(const f32x4*)(bp + bj * HALF + 4 * n);
#pragma unroll
        for (int ai = 0; ai < 2; ++ai)
#pragma unroll
            for (int m = 0; m < 4; ++m) { bf16_t* rowp = O + (size_t)(row0 + ai * HALF + m * 16) * ldc + col0;
#pragma unroll
                for (int bj = 0; bj < 2; ++bj) { const f32x4 v0 = acc[ai][bj][m][0] + bv[bj][0], v1 = acc[ai][bj][m][1] + bv[bj][1];
                    u32x4 w; w.x = cvt_pk_bf16(v0[0], v0[1]); w.y = cvt_pk_bf16(v0[2], v0[3]); w.z = cvt_pk_bf16(v1[0], v1[1]); w.w = cvt_pk_bf16(v1[2], v1[3]);
                    *(u32x4*)(rowp + bj * HALF) = w; } }
    }
};
struct MoeOrder {
    int nN, G, c, nunits; const PG8_LAS int* tile_e;
    __device__ __forceinline__ bool next(int i, Unit& u) const {
        const int L = i * G + c; if (L >= nunits) return false;
        const int pm = L / nN, pl = L - pm * nN, e = __builtin_amdgcn_readfirstlane(tile_e[pm]);
        u.pm = pm; u.pl = pl; u.e = e; u.pn = e * nN + pl; return true;
    }
    __device__ __forceinline__ void a_ready(const Unit&) const {}
    __device__ __forceinline__ void done(const Unit&) const {}
};
template <class Epi, class Sched, bool ALIGN_EPI = false, bool SP2 = false>
__device__ __forceinline__ void gemm_phase(PG8_LAS unsigned char* lds, const Gemm g, const Sched& S, const Epi& E) {
    int tid_ = threadIdx.x; asm volatile("" : "+v"(tid_)); const int tid = tid_, wid = __builtin_amdgcn_readfirstlane(tid >> 6), lane = tid & 63, wr = wid >> 2, wc = wid & 3, fr = lane & 15, fq = lane >> 4;
    const int K = g.K, nt = K / BK;
    unsigned voffA[2], voffB[2];
#pragma unroll
    for (int i = 0; i < 2; ++i) { int R, C; stage_rc(tid * 16 + i * 8192, R, C); const int Rb = Epi::PERM ? ((R & ~31) + perm32(R & 31)) : R;
        voffA[i] = (unsigned)(R * K + C) * 2u; voffB[i] = (unsigned)(Rb * K + C) * 2u; }
    const size_t kstep = (size_t)(BK * 2);
    const size_t hstep = (size_t)HALF * K * 2;
    const size_t tstep = 2 * hstep;
    const unsigned ldsw = (unsigned)wid * 1024u;
    const int aoff = lds_byte(wr * 64 + fr, fq * 8), boff = lds_byte(wc * 32 + fr, fq * 8);
#define PG8_SA(b, h) (((b) * 2 + (h)) * HTB)
#define PG8_SB(b, h) ((4 + (b) * 2 + (h)) * HTB)
#define PG8_STAGE(bufoff, gbase, voff) do { _Pragma("unroll") for (int _i = 0; _i < 2; ++_i) \
        __builtin_amdgcn_global_load_lds((const unsigned*)((const char*)(gbase) + (voff)[_i]), (PG8_LAS unsigned*)(lds + (bufoff) + ldsw + _i * 8192), 16, 0, 0); } while (0)
#define PG8_LDA(dst, b, h) do { _Pragma("unroll") for (int m = 0; m < 4; ++m) _Pragma("unroll") for (int k = 0; k < 2; ++k) dst[m][k] = *(const PG8_LAS bf16x8*)(lds + PG8_SA(b, h) + aoff + m * 2048 + k * 1024); } while (0)
#define PG8_LDB(dst, b, h) do { _Pragma("unroll") for (int n = 0; n < 2; ++n) _Pragma("unroll") for (int k = 0; k < 2; ++k) dst[n][k] = *(const PG8_LAS bf16x8*)(lds + PG8_SB(b, h) + boff + n * 2048 + k * 1024); } while (0)
#define PG8_MMA(ai, bj, At, Bt) do { __builtin_amdgcn_s_setprio(1); _Pragma("unroll") for (int m = 0; m < 4; ++m) _Pragma("unroll") for (int n = 0; n < 2; ++n) _Pragma("unroll") for (int k = 0; k < 2; ++k) \
        acc[ai][bj][m][n] = __builtin_amdgcn_mfma_f32_16x16x32_bf16(Bt[n][k], At[m][k], acc[ai][bj][m][n], 0, 0, 0); __builtin_amdgcn_s_setprio(0); } while (0)
#define PG8_WAIT_V(n) asm volatile("s_waitcnt vmcnt(" #n ")" ::: "memory")
#define PG8_WAIT_L(n) asm volatile("s_waitcnt lgkmcnt(" #n ")" ::: "memory")
#define PG8_BAR __builtin_amdgcn_s_barrier()
#define PG8_SCHED __builtin_amdgcn_sched_barrier(0)
    Unit cur, nxt; int ui = 0;
    if (!S.next(0, cur)) return;
    f32x4 acc[2][2][4][2];
#pragma unroll
    for (int a = 0; a < 2; ++a)
#pragma unroll
        for (int b = 0; b < 2; ++b)
#pragma unroll
            for (int m = 0; m < 4; ++m)
#pragma unroll
                for (int n = 0; n < 2; ++n) acc[a][b][m][n] = (f32x4){0.f, 0.f, 0.f, 0.f};
    bf16x8 At[4][2], B0[2][2], B1[2][2];
    const char* cA = (const char*)g.A + (size_t)cur.pm * tstep; const char* cB = (const char*)g.Bt + (size_t)cur.pn * tstep;
    S.a_ready(cur);
    if constexpr (SP2) {
        PG8_STAGE(PG8_SB(0, 0), cB, voffB); PG8_STAGE(PG8_SB(0, 1), cB + hstep, voffB); PG8_STAGE(PG8_SA(0, 0), cA, voffA); PG8_STAGE(PG8_SA(0, 1), cA + hstep, voffA);
        if (wr == 1) PG8_BAR;
        PG8_WAIT_V(2); PG8_BAR;
        PG8_STAGE(PG8_SB(1, 0), cB + kstep, voffB); PG8_STAGE(PG8_SA(1, 0), cA + kstep, voffA); PG8_STAGE(PG8_SB(1, 1), cB + hstep + kstep, voffB);
        PG8_WAIT_V(6); PG8_BAR;
    } else {
        PG8_STAGE(PG8_SB(0, 0), cB, voffB); PG8_STAGE(PG8_SA(0, 0), cA, voffA); PG8_STAGE(PG8_SB(0, 1), cB + hstep, voffB); PG8_STAGE(PG8_SA(0, 1), cA + hstep, voffA);
        if (wr == 1) PG8_BAR;
        PG8_WAIT_V(4); PG8_BAR;
        PG8_STAGE(PG8_SB(1, 0), cB + kstep, voffB); PG8_STAGE(PG8_SA(1, 0), cA + kstep, voffA); PG8_STAGE(PG8_SB(1, 1), cB + hstep + kstep, voffB);
        PG8_WAIT_V(6); PG8_BAR;
    }
    for (;;) {
        const bool has_next = S.next(ui + 1, nxt);
        const char* nA = has_next ? (const char*)g.A + (size_t)nxt.pm * tstep : cA; const char* nB = has_next ? (const char*)g.Bt + (size_t)nxt.pn * tstep : cB;
        for (int t = 0; t < nt; t += 2) {
            const bool last = (t == nt - 2);
            const char* a1 = cA + (size_t)(t + 1) * kstep;
            const char* a2 = last ? nA : cA + (size_t)(t + 2) * kstep; const char* b2 = last ? nB : cB + (size_t)(t + 2) * kstep;
            const char* a3 = a2 + kstep; const char* b3 = b2 + kstep;
            if (last && has_next) S.a_ready(nxt);
            if constexpr (SP2) {
            PG8_LDB(B0, 0, 0); PG8_LDB(B1, 0, 1); PG8_SCHED; PG8_LDA(At, 0, 0); PG8_STAGE(PG8_SA(1, 1), a1 + hstep, voffA);
            PG8_WAIT_V(8); PG8_WAIT_L(0); PG8_BAR; PG8_MMA(0, 0, At, B0); PG8_MMA(0, 1, At, B1); PG8_BAR; PG8_SCHED;
            PG8_LDA(At, 0, 1); PG8_STAGE(PG8_SB(0, 0), b2, voffB); PG8_STAGE(PG8_SB(0, 1), b2 + hstep, voffB); PG8_STAGE(PG8_SA(0, 0), a2, voffA);
            PG8_WAIT_V(8); PG8_WAIT_L(0); PG8_BAR; PG8_MMA(1, 0, At, B0); PG8_MMA(1, 1, At, B1); PG8_BAR; PG8_SCHED;
            PG8_LDB(B0, 1, 0); PG8_LDB(B1, 1, 1); PG8_SCHED; PG8_LDA(At, 1, 0); PG8_STAGE(PG8_SA(0, 1), a2 + hstep, voffA);
            PG8_WAIT_V(8); PG8_WAIT_L(0); PG8_BAR; PG8_MMA(0, 0, At, B0); PG8_MMA(0, 1, At, B1); PG8_BAR; PG8_SCHED;
            PG8_LDA(At, 1, 1); PG8_STAGE(PG8_SB(1, 0), b3, voffB); PG8_STAGE(PG8_SB(1, 1), b3 + hstep, voffB); PG8_STAGE(PG8_SA(1, 0), a3, voffA);
            PG8_WAIT_V(8); PG8_WAIT_L(0); PG8_BAR; PG8_MMA(1, 0, At, B0); PG8_MMA(1, 1, At, B1); PG8_BAR; PG8_SCHED;
            } else {
            PG8_LDB(B0, 0, 0); PG8_SCHED; PG8_LDA(At, 0, 0); PG8_STAGE(PG8_SA(1, 1), a1 + hstep, voffA);
            PG8_WAIT_L(8); PG8_BAR; PG8_WAIT_L(0); PG8_MMA(0, 0, At, B0); PG8_BAR; PG8_SCHED;
            PG8_LDB(B1, 0, 1); PG8_STAGE(PG8_SB(0, 0), b2, voffB);
            PG8_BAR; PG8_WAIT_L(0); PG8_MMA(0, 1, At, B1); PG8_BAR;
            PG8_LDA(At, 0, 1); PG8_STAGE(PG8_SA(0, 0), a2, voffA);
            PG8_BAR; PG8_WAIT_L(0); PG8_MMA(1, 0, At, B0); PG8_BAR; PG8_SCHED;
            PG8_STAGE(PG8_SB(0, 1), b2 + hstep, voffB);
            PG8_WAIT_V(6); PG8_BAR; PG8_MMA(1, 1, At, B1); PG8_BAR;
            PG8_LDB(B0, 1, 0); PG8_SCHED; PG8_LDA(At, 1, 0); PG8_STAGE(PG8_SA(0, 1), a2 + hstep, voffA);
            PG8_WAIT_L(8); PG8_BAR; PG8_WAIT_L(0); PG8_MMA(0, 0, At, B0); PG8_BAR; PG8_SCHED;
            PG8_LDB(B1, 1, 1); PG8_STAGE(PG8_SB(1, 0), b3, voffB);
            PG8_BAR; PG8_WAIT_L(0); PG8_MMA(0, 1, At, B1); PG8_BAR;
            PG8_LDA(At, 1, 1); PG8_STAGE(PG8_SA(1, 0), a3, voffA);
            PG8_BAR; PG8_WAIT_L(0); PG8_MMA(1, 0, At, B0); PG8_BAR; PG8_SCHED;
            PG8_STAGE(PG8_SB(1, 1), b3 + hstep, voffB);
            PG8_WAIT_V(6); PG8_BAR; PG8_MMA(1, 1, At, B1); PG8_BAR;
            }
        }
        if constexpr (ALIGN_EPI) { if (wr == 0) PG8_BAR; }
        if constexpr (!Epi::AFTER_DRAIN) { E(acc, cur, wr, wc, fr, fq); S.done(cur); }
        if (!has_next) break;
#pragma unroll
        for (int a = 0; a < 2; ++a)
#pragma unroll
            for (int b = 0; b < 2; ++b)
#pragma unroll
                for (int m = 0; m < 4; ++m)
#pragma unroll
                    for (int n = 0; n < 2; ++n) acc[a][b][m][n] = (f32x4){0.f, 0.f, 0.f, 0.f};
        cur = nxt; cA = nA; cB = nB; ++ui;
        if constexpr (ALIGN_EPI) { if (wr == 1) PG8_BAR; }
    }
    PG8_WAIT_V(0);
    if constexpr (!ALIGN_EPI) { if (wr == 0) PG8_BAR; }
    PG8_BAR;
    if constexpr (Epi::AFTER_DRAIN) { E.fused(acc, cur, wr, wc, fr, fq, lds, wid, lane); S.done(cur); }
#undef PG8_SA
#undef PG8_SB
#undef PG8_STAGE
#undef PG8_LDA
#undef PG8_LDB
#undef PG8_MMA
#undef PG8_WAIT_V
#undef PG8_WAIT_L
#undef PG8_BAR
#undef PG8_SCHED
}
}

constexpr int NWAVES = 8, NTHR = 512;
constexpr int BATCH = 2, SEQ = 8192, D = 1024, DEPTH = 4, MTOK = BATCH * SEQ;
constexpr int DIN = 3344, NPROJ = 3328, SRC_GA = 1152;
constexpr int C_GQ = 0, C_GK = 192, C_GV = 384, C_GG = 768, C_HQ = 1152, C_HF = 1408, C_HI = 1664, C_HG = 1920, C_RQ = 2176, C_RK = 2368, C_RV = 2560, C_RG = 2944;
constexpr int NE = 32, FFN = 1024;
constexpr int CH = 64, NCH = SEQ / CH, NUNIT = BATCH * NCH;
constexpr int ST_GLA = 0, ST_HG = 4 * 48 * 96, ST_RET = ST_HG + 4 * 64 * 64, ST_TOT = ST_RET + 4 * 48 * 96;
constexpr int NDV = 448;
constexpr int MAXROWS = 65536 + NE * 256, MAXRT = MAXROWS / 256;
constexpr float EPS = 1e-6f;
constexpr int NPHASE = 42;

constexpr size_t MiB = 1u << 20;
constexpr size_t WS_CTL = 0, CTL_ZERO_BYTES = 65536;
constexpr size_t WS_MOD = 1 * MiB;
constexpr size_t WS_ROPE = 2 * MiB;
constexpr size_t WS_LB = 5 * MiB;
constexpr size_t WS_WIN = 8 * MiB;
constexpr size_t WS_WOUT = 34 * MiB;
constexpr size_t WS_WGU = 42 * MiB;
constexpr size_t WS_WDN = 554 * MiB;
constexpr size_t WS_X = 810 * MiB;
constexpr size_t WS_H = 874 * MiB;
constexpr size_t WS_GA = 906 * MiB;
constexpr size_t WS_PROJ = 907 * MiB;
constexpr size_t WS_U = 1011 * MiB;
constexpr size_t WS_DVEC = 1063 * MiB;
constexpr size_t WS_SP = 1064 * MiB;
constexpr size_t WS_MIX = 1090 * MiB;
constexpr size_t WS_TOPE = 1122 * MiB;
constexpr size_t WS_TOPW = WS_TOPE + 256 * 1024;
constexpr size_t WS_SLOT = WS_TOPW + 256 * 1024;
constexpr size_t WS_A1 = 1123 * MiB;
constexpr size_t WS_ACT = 1267 * MiB;
constexpr size_t WS_Y = 1411 * MiB;
constexpr size_t WS_END = 1555 * MiB;
static_assert(WS_WIN + (size_t)DEPTH * NPROJ * D * 2 <= WS_WOUT && WS_PROJ + (size_t)MTOK * NPROJ * 2 <= WS_U && WS_U + (size_t)NUNIT * ST_TOT * 4 <= WS_DVEC && WS_SP + (size_t)NUNIT * ST_TOT * 2 <= WS_MIX && WS_A1 + (size_t)MAXROWS * D * 2 <= WS_ACT, "ws map");
constexpr int CW_TMO = 0, CW_CODE = 1, CW_BAR = 4096, CW_CNT = 8192, CW_FILL = 8192 + 256;
constexpr int RING_BYTES = 131072;
constexpr int MISC_OFF = 147456, LDS_BYTES = MISC_OFF + 4096;
constexpr int MW_BAR = 0, MW_CNT = 16, MW_PST = 48, MW_HIST = 96, MW_BASE = 128, MW_TILE = 192, MW_NRT = 480, MW_SLOTS = 512;

#define GAS __attribute__((address_space(1)))
#define LAS __attribute__((address_space(3)))
typedef unsigned v4u __attribute__((ext_vector_type(4)));
typedef float f32x4 __attribute__((ext_vector_type(4)));
typedef short bf16x8 __attribute__((ext_vector_type(8)));
typedef GAS unsigned gu32;
typedef GAS unsigned long long gu64;
#define RLX_AGENT __ATOMIC_RELAXED, __HIP_MEMORY_SCOPE_AGENT
#define LDS_WAIT() asm volatile("s_waitcnt lgkmcnt(0)" ::: "memory")
#define VM_WAIT() asm volatile("s_waitcnt vmcnt(0)" ::: "memory")
__device__ __forceinline__ unsigned long long rt() { return __builtin_amdgcn_s_memrealtime(); }
typedef unsigned short bf16;
__device__ __forceinline__ unsigned f2bf(float f) { unsigned u = __builtin_bit_cast(unsigned, f); return (u + 0x7fffu + ((u >> 16) & 1u)) >> 16; }
__device__ __forceinline__ unsigned pk2(float lo, float hi) { return f2bf(lo) | (f2bf(hi) << 16); }
__device__ __forceinline__ float bf2f(bf16 b) { return __builtin_bit_cast(float, (unsigned)b << 16); }
#define XB_TMO      128
#define XB_XCNT(j)  (256  + 64 * (j))
#define XB_XSUB(j)  (1280 + 64 * (j))
#define XB_XGEN(j)  (2304 + 64 * (j))
#define XB_TOP      3328
#define XB_TOPGEN   3392
#define XCD_BAR_WORDS 3456
#define XB_SPIN_CAP (1u << 18)

__device__ __forceinline__ unsigned xb_ld(unsigned* p)              { return __hip_atomic_load(p, __ATOMIC_RELAXED, __HIP_MEMORY_SCOPE_AGENT); }
__device__ __forceinline__ unsigned xb_add(unsigned* p, unsigned v) { return __hip_atomic_fetch_add(p, v, __ATOMIC_RELAXED, __HIP_MEMORY_SCOPE_AGENT); }
__device__ __forceinline__ unsigned xb_xcc_id() { return (unsigned)__builtin_amdgcn_s_getreg((3 << 11) | 20) & 0xFu; }
#define XB_SPIN(cond, bar) do { unsigned _sp = 0; while (cond) { __builtin_amdgcn_s_sleep(1); \
    if ((++_sp & 255u) == 0u) { if (xb_ld(&(bar)[XB_TMO])) break; if (_sp > XB_SPIN_CAP) { atomicAdd(&(bar)[XB_TMO], 1u); break; } } } } while (0)

struct XcdBarrier {
    unsigned* bar; unsigned x;
    volatile LAS unsigned* st;
};

__device__ __forceinline__ XcdBarrier xcd_barrier_post(unsigned* bar, volatile LAS unsigned* st) {
    XcdBarrier b; b.bar = bar; b.x = xb_xcc_id(); b.st = st;
    if (threadIdx.x == 0) (void)xb_add(&bar[XB_XCNT(b.x)], 1u);
    return b;
}
__device__ __forceinline__ void xcd_barrier_complete(unsigned* bar, unsigned x, unsigned& nloc, unsigned& nx) {
    const unsigned G = gridDim.x * gridDim.y * gridDim.z;
    unsigned sum, cnt, mine, sp = 0u;
    for (;;) {
        sum = 0u; cnt = 0u; mine = 0u;
#pragma unroll
        for (unsigned j = 0; j < 16; ++j) { const unsigned c = xb_ld(&bar[XB_XCNT(j)]); sum += c; cnt += (c > 0u) ? 1u : 0u; mine = (j == x) ? c : mine; }
        if (sum == G) break;
        __builtin_amdgcn_s_sleep(1);
        if ((++sp & 255u) == 0u) { if (xb_ld(&bar[XB_TMO])) break; if (sp > XB_SPIN_CAP) { atomicAdd(&bar[XB_TMO], 1u); break; } }
    }
    nloc = mine > 0u ? mine : 1u; nx = cnt > 0u ? cnt : 1u;
}

__device__ __forceinline__ void xcd_barrier(const XcdBarrier& b) {
    asm volatile("s_waitcnt vmcnt(0)" ::: "memory");
    __syncthreads();
    if (threadIdx.x == 0) {
        unsigned* bar = b.bar;
        __builtin_amdgcn_s_waitcnt(0);
        unsigned nloc = b.st[0], nx = b.st[1];
        if (nloc == 0u) { xcd_barrier_complete(bar, b.x, nloc, nx); b.st[0] = nloc; b.st[1] = nx; }
        const unsigned old = xb_add(&bar[XB_XSUB(b.x)], 1u);
        const unsigned gen = old / nloc;
        if (old + 1u == (gen + 1u) * nloc) {
            __builtin_amdgcn_fence(__ATOMIC_RELEASE, "agent");
            asm volatile("s_waitcnt vmcnt(0)" ::: "memory");
            const unsigned og = xb_add(&bar[XB_TOP], 1u);
            const unsigned tg = og / nx;
            if (og + 1u == (tg + 1u) * nx) xb_add(&bar[XB_TOPGEN], 1u);
            else XB_SPIN(xb_ld(&bar[XB_TOPGEN]) == tg, bar);
            __builtin_amdgcn_fence(__ATOMIC_ACQUIRE, "agent");
            xb_add(&bar[XB_XGEN(b.x)], 1u);
            asm volatile("s_waitcnt vmcnt(0)" ::: "memory");
        } else {
            XB_SPIN(xb_ld(&bar[XB_XGEN(b.x)]) == gen, bar);
            __builtin_amdgcn_fence(__ATOMIC_ACQUIRE, "agent");
            asm volatile("s_waitcnt vmcnt(0)" ::: "memory");
        }
    }
    __syncthreads();
}

__device__ __forceinline__ float wave_sum(float v) {
#pragma unroll
    for (int o = 1; o < 64; o <<= 1) v += __shfl_xor(v, o);
    return v;
}
__device__ __forceinline__ float log_sigmoid_f(float x) { return fminf(x, 0.f) - log1pf(expf(-fabsf(x))); }
__device__ __forceinline__ float silu_f(float x) { return x / (1.0f + expf(-x)); }
__device__ __forceinline__ float sigmoid_f(float x) { return 1.0f / (1.0f + expf(-x)); }
__device__ __forceinline__ pg8::bf16x8 ldfrag(const LAS bf16* base, int stride, int r0, int k0, int lane) {
    return *(const LAS pg8::bf16x8*)(base + (r0 + (lane & 15)) * stride + k0 + 8 * (lane >> 4));
}

struct Args {
    const float* x; const float* c; const int* pos; const float* w_mod; const float* b_mod; const float* norm1_w; const float* w_in; const float* gla_wa2; const float* gla_ba2; const float* hg_lb;
    const float* gla_norm_w; const float* hg_norm_w; const float* w_out; const float* norm2_w; const float* w_r; const float* b_r; const float* w_gu; const float* b_gu; const float* w_dn; const float* b_dn;
    const float* final_norm_w; float* out; unsigned char* ws; int ph_lo, ph_hi;
};

__device__ __forceinline__ void transpose_block(const float* src, int ld, bf16* dst, LAS float* scr, int lane) {
#pragma unroll 8
    for (int i = 0; i < 32; ++i) { const int kk = 2 * i + (lane >> 5); scr[kk * 33 + (lane & 31)] = src[(size_t)kk * ld + (lane & 31)]; }
    LDS_WAIT(); asm volatile("" ::: "memory");
    const int c = lane & 7;
#pragma unroll
    for (int j = 0; j < 4; ++j) { const int n = (lane >> 3) + 8 * j; const LAS float* s = scr + (8 * c) * 33 + n;
        v4u o; o.x = pk2(s[0 * 33], s[1 * 33]); o.y = pk2(s[2 * 33], s[3 * 33]); o.z = pk2(s[4 * 33], s[5 * 33]); o.w = pk2(s[6 * 33], s[7 * 33]);
        *(GAS v4u*)(dst + (size_t)n * D + 8 * c) = o; }
    LDS_WAIT(); asm volatile("" ::: "memory");
}
constexpr int IT_IN = 16 * (NPROJ / 32), IT_OUT = 16 * 32, IT_GU = NE * 16 * 64, IT_DN = NE * 16 * 32, IT_LAYER = IT_IN + IT_OUT + IT_GU + IT_DN, IT_ALL = DEPTH * IT_LAYER;
__device__ __forceinline__ void p0_prologue(const Args& a, LAS unsigned char* lds, int vcu, int G, int tid, int lane, int wave) {
    unsigned char* ws = a.ws;
    bf16* WIN = (bf16*)(ws + WS_WIN); bf16* WOUT = (bf16*)(ws + WS_WOUT); bf16* WGU = (bf16*)(ws + WS_WGU); bf16* WDN = (bf16*)(ws + WS_WDN);
    LAS float* scr = (LAS float*)(lds + wave * 16384);
    const int gw = vcu * NWAVES + wave, NGW = G * NWAVES;
    for (int it = gw; it < IT_ALL; it += NGW) {
        const int l = it / IT_LAYER; int r = it - l * IT_LAYER;
        if (r < IT_IN) { const int kb = r / (NPROJ / 32), nb = r % (NPROJ / 32), n0 = 32 * nb, sc = n0 + (n0 >= SRC_GA ? 16 : 0);
            transpose_block(a.w_in + ((size_t)l * D + 64 * kb) * DIN + sc, DIN, WIN + ((size_t)l * NPROJ + n0) * D + 64 * kb, scr, lane); continue; }
        r -= IT_IN;
        if (r < IT_OUT) { const int kb = r / 32, nb = r % 32;
            transpose_block(a.w_out + ((size_t)l * D + 64 * kb) * D + 32 * nb, D, WOUT + ((size_t)l * D + 32 * nb) * D + 64 * kb, scr, lane); continue; }
        r -= IT_OUT;
        if (r < IT_GU) { const int e = r / 1024, r2 = r % 1024, kb = r2 / 64, nb = r2 % 64, cc = 32 * nb;
            const int row = (cc < 1024) ? 256 * (cc / 128) + (cc % 128) : 256 * ((cc - 1024) / 128) + 128 + ((cc - 1024) % 128);
            transpose_block(a.w_gu + (((size_t)l * NE + e) * D + 64 * kb) * 2048 + cc, 2048, WGU + (((size_t)l * NE + e) * 2048 + row) * D + 64 * kb, scr, lane); continue; }
        r -= IT_GU;
        { const int e = r / 512, r2 = r % 512, kb = r2 / 32, nb = r2 % 32;
            transpose_block(a.w_dn + (((size_t)l * NE + e) * FFN + 64 * kb) * D + 32 * nb, D, WDN + (((size_t)l * NE + e) * D + 32 * nb) * D + 64 * kb, scr, lane); }
    }
    __syncthreads();
    {
        LAS float* cact = (LAS float*)lds;
        LAS float* red = (LAS float*)(lds + 8192);
        for (int i = tid; i < 2 * D; i += NTHR) cact[i] = silu_f(a.c[i]);
        __syncthreads();
        float* MOD = (float*)(ws + WS_MOD);
        for (int it = vcu; it < DEPTH * 96; it += G) {
            const int l = it / 96, n0 = (it % 96) * 64;
            const float* wp = a.w_mod + ((size_t)l * D + 128 * wave) * 6144 + n0 + lane;
            float a0 = 0.f, a1 = 0.f;
#pragma unroll 8
            for (int k = 0; k < 128; ++k) { const float w = wp[(size_t)k * 6144]; a0 += cact[128 * wave + k] * w; a1 += cact[D + 128 * wave + k] * w; }
            red[(wave * 2 + 0) * 64 + lane] = a0; red[(wave * 2 + 1) * 64 + lane] = a1;
            __syncthreads();
            if (tid < 128) { const int b = tid >> 6, ln = tid & 63; float s = a.b_mod[l * 6144 + n0 + ln];
#pragma unroll
                for (int w = 0; w < 8; ++w) s += red[(w * 2 + b) * 64 + ln];
                MOD[((size_t)l * 2 + b) * 6144 + n0 + ln] = s; }
            __syncthreads();
        }
    }
    {
        float* ROPE = (float*)(ws + WS_ROPE);
        for (int i = vcu * NTHR + tid; i < MTOK * 24; i += G * NTHR) { const int t = i / 24, f = i % 24;
            const float inv = (float)pow(10000.0, -(double)f / 24.0); const float ang = (float)a.pos[t] * inv;
            ROPE[(size_t)t * 48 + f] = cosf(ang); ROPE[(size_t)t * 48 + 24 + f] = sinf(ang); }
    }
    if (vcu == 0 && tid < 256) {
        float v[4], mx = -3.0e38f; for (int l = 0; l < 4; ++l) { v[l] = a.hg_lb[l * 256 + tid]; mx = fmaxf(mx, v[l]); }
        float s = 0.f; for (int l = 0; l < 4; ++l) { v[l] = expf(v[l] - mx); s += v[l]; }
        float* LB = (float*)(ws + WS_LB); float cs = 0.f, first = 0.f;
        for (int l = 0; l < 4; ++l) { cs += v[l] / s; if (l == 0) first = cs; LB[l * 256 + tid] = cs - first; }
    }
}

__device__ __forceinline__ void moe_combine_row(f32x4 (&v)[4], int m, const bf16* Y, const int* SLOT, const float* TOPW, const float* g2, int lane) {
    const int4 sl = *(const int4*)(SLOT + (size_t)m * 4); const f32x4 tw = *(const f32x4*)(TOPW + (size_t)m * 4);
    const int s[4] = {sl.x, sl.y, sl.z, sl.w};
    f32x4 acc[4];
#pragma unroll
    for (int j = 0; j < 4; ++j) acc[j] = (f32x4){0.f, 0.f, 0.f, 0.f};
#pragma unroll
    for (int k = 0; k < 4; ++k) { const bf16* yr = Y + (size_t)s[k] * D + 4 * lane; const float w = tw[k];
#pragma unroll
        for (int j = 0; j < 4; ++j) { const uint2 p = *(const uint2*)(yr + 256 * j);
            acc[j][0] += w * __builtin_bit_cast(float, p.x << 16); acc[j][1] += w * __builtin_bit_cast(float, p.x & 0xffff0000u);
            acc[j][2] += w * __builtin_bit_cast(float, p.y << 16); acc[j][3] += w * __builtin_bit_cast(float, p.y & 0xffff0000u); } }
#pragma unroll
    for (int j = 0; j < 4; ++j) { const f32x4 g = *(const f32x4*)(g2 + 4 * lane + 256 * j); v[j] = v[j] + g * acc[j]; }
}
__device__ __forceinline__ float row_rstd(const f32x4 (&v)[4]) {
    float s = 0.f;
#pragma unroll
    for (int j = 0; j < 4; ++j) s += (v[j][0] * v[j][0] + v[j][1] * v[j][1]) + (v[j][2] * v[j][2] + v[j][3] * v[j][3]);
    return 1.0f / sqrtf(wave_sum(s) * (1.0f / D) + EPS);
}
__device__ __forceinline__ void modulate_row(f32x4 (&v)[4], float rstd, const float* nw, const float* sc, const float* sh, bf16* hrow, int lane) {
#pragma unroll
    for (int j = 0; j < 4; ++j) { const int c0 = 4 * lane + 256 * j; const f32x4 w = *(const f32x4*)(nw + c0), s1 = *(const f32x4*)(sc + c0), s0 = *(const f32x4*)(sh + c0);
        v[j] = v[j] * rstd * w * (s1 + 1.0f) + s0;
        uint2 p; p.x = pk2(v[j][0], v[j][1]); p.y = pk2(v[j][2], v[j][3]); *(uint2*)(hrow + c0) = p; }
}

__device__ __forceinline__ void p1_rows(const Args& a, int layer, LAS unsigned char* lds, int vcu, int G, int tid, int lane, int wave) {
    unsigned char* ws = a.ws;
    float* X = (float*)(ws + WS_X); bf16* H = (bf16*)(ws + WS_H); float* GA = (float*)(ws + WS_GA); const float* MOD = (const float*)(ws + WS_MOD);
    LAS float* gaw = (LAS float*)lds;
    for (int i = tid; i < D * 16; i += NTHR) { const int k = i >> 4, r = i & 15; const int p = ((k >> 8) * 4 + (k & 3)) * 64 + ((k >> 2) & 63);
        gaw[p * 20 + r] = a.w_in[((size_t)layer * D + k) * DIN + SRC_GA + r]; }
    __syncthreads();
    const float* xin = (layer == 0) ? a.x : X;
    const float* n1w = a.norm1_w + layer * D;
    for (int m = (vcu * NWAVES + wave); m < MTOK; m += G * NWAVES) {
        const int b = m / SEQ; f32x4 v[4];
#pragma unroll
        for (int j = 0; j < 4; ++j) v[j] = *(const f32x4*)(xin + (size_t)m * D + 4 * lane + 256 * j);
        if (layer > 0) {
            moe_combine_row(v, m, (const bf16*)(ws + WS_Y), (const int*)(ws + WS_SLOT), (const float*)(ws + WS_TOPW), MOD + ((size_t)(layer - 1) * 2 + b) * 6144 + 5 * D, lane);
#pragma unroll
            for (int j = 0; j < 4; ++j) *(f32x4*)(X + (size_t)m * D + 4 * lane + 256 * j) = v[j];
        }
        const float rstd = row_rstd(v);
        const float* mp = MOD + ((size_t)layer * 2 + b) * 6144;
        modulate_row(v, rstd, n1w, mp + 1 * D, mp + 0 * D, H + (size_t)m * D, lane);
        float g[16];
#pragma unroll
        for (int r = 0; r < 16; ++r) g[r] = 0.f;
#pragma unroll
        for (int j = 0; j < 4; ++j)
#pragma unroll
            for (int c = 0; c < 4; ++c) { const LAS f32x4* wp = (const LAS f32x4*)(gaw + ((j * 4 + c) * 64 + lane) * 20); const float hv = v[j][c];
#pragma unroll
                for (int q = 0; q < 4; ++q) { const f32x4 w = wp[q]; g[4 * q + 0] += hv * w[0]; g[4 * q + 1] += hv * w[1]; g[4 * q + 2] += hv * w[2]; g[4 * q + 3] += hv * w[3]; }
                if (c & 1) asm volatile("" ::: "memory"); }
        float mine = 0.f;
#pragma unroll
        for (int r = 0; r < 16; ++r) { const float s = wave_sum(g[r]); mine = (lane == r) ? s : mine; }
        if (lane < 16) GA[(size_t)m * 16 + lane] = mine;
    }
}

__device__ __forceinline__ void p5_rows(const Args& a, int layer, LAS unsigned char* lds, volatile LAS unsigned* MISC, gu32* ctl, int vcu, int G, int tid, int lane, int wave) {
    unsigned char* ws = a.ws;
    const float* X = (const float*)(ws + WS_X); bf16* H = (bf16*)(ws + WS_H); const float* MOD = (const float*)(ws + WS_MOD);
    int* TOPE = (int*)(ws + WS_TOPE); float* TOPW = (float*)(ws + WS_TOPW);
    LAS float* rw = (LAS float*)lds;
    for (int i = tid; i < D * NE; i += NTHR) { const int k = i >> 5, e = i & 31; const int p = ((k >> 8) * 4 + (k & 3)) * 64 + ((k >> 2) & 63);
        rw[p * 36 + e] = a.w_r[((size_t)layer * D + k) * NE + e]; }
    if (tid < NE) MISC[MW_HIST + tid] = 0u;
    __syncthreads();
    const float* n2w = a.norm2_w + layer * D;
    const float br = (lane < NE) ? a.b_r[layer * NE + lane] : 0.f;
    for (int m = (vcu * NWAVES + wave); m < MTOK; m += G * NWAVES) {
        const int b = m / SEQ; f32x4 v[4];
#pragma unroll
        for (int j = 0; j < 4; ++j) v[j] = *(const f32x4*)(X + (size_t)m * D + 4 * lane + 256 * j);
        const float rstd = row_rstd(v);
        const float* mp = MOD + ((size_t)layer * 2 + b) * 6144;
        modulate_row(v, rstd, n2w, mp + 4 * D, mp + 3 * D, H + (size_t)m * D, lane);
        float g[NE];
#pragma unroll
        for (int e = 0; e < NE; ++e) g[e] = 0.f;
#pragma unroll
        for (int j = 0; j < 4; ++j)
#pragma unroll
            for (int c = 0; c < 4; ++c) { const LAS f32x4* wp = (const LAS f32x4*)(rw + ((j * 4 + c) * 64 + lane) * 36); const float hv = v[j][c];
#pragma unroll
                for (int q = 0; q < 8; ++q) { const f32x4 w = wp[q]; g[4 * q + 0] += hv * w[0]; g[4 * q + 1] += hv * w[1]; g[4 * q + 2] += hv * w[2]; g[4 * q + 3] += hv * w[3]; }
                asm volatile("" ::: "memory"); }
        float logit = -3.0e38f;
#pragma unroll
        for (int e = 0; e < NE; ++e) { const float s = wave_sum(g[e]); logit = (lane == e) ? s + br : logit; }
        float tv[4]; int te[4];
#pragma unroll
        for (int r = 0; r < 4; ++r) {
            float mx = logit;
#pragma unroll
            for (int o = 1; o < 64; o <<= 1) mx = fmaxf(mx, __shfl_xor(mx, o));
            const unsigned long long bal = __ballot(logit == mx && lane < NE);
            const int idx = __ffsll((long long)bal) - 1;
            tv[r] = mx; te[r] = idx; if (lane == idx) logit = -3.0e38f;
        }
        const float e1 = expf(tv[1] - tv[0]), e2 = expf(tv[2] - tv[0]), e3 = expf(tv[3] - tv[0]); const float inv = 1.0f / (1.0f + e1 + e2 + e3);
        if (lane == 0) { *(int4*)(TOPE + (size_t)m * 4) = make_int4(te[0], te[1], te[2], te[3]); *(f32x4*)(TOPW + (size_t)m * 4) = (f32x4){inv, e1 * inv, e2 * inv, e3 * inv}; }
        if (lane < 4) { const int ee = (lane == 0) ? te[0] : (lane == 1) ? te[1] : (lane == 2) ? te[2] : te[3]; __hip_atomic_fetch_add((LAS unsigned*)&MISC[MW_HIST + ee], 1u, __ATOMIC_RELAXED, __HIP_MEMORY_SCOPE_WORKGROUP); }
    }
    __syncthreads();
    if (tid < NE) { const unsigned h = MISC[MW_HIST + tid]; if (h) atomicAdd((unsigned*)(ctl + CW_CNT + layer * NE + tid), h); }
}

__device__ __forceinline__ void final_rows(const Args& a, int vcu, int G, int lane, int wave) {
    unsigned char* ws = a.ws; const float* X = (const float*)(ws + WS_X); const float* MOD = (const float*)(ws + WS_MOD);
    for (int m = (vcu * NWAVES + wave); m < MTOK; m += G * NWAVES) {
        const int b = m / SEQ; f32x4 v[4];
#pragma unroll
        for (int j = 0; j < 4; ++j) v[j] = *(const f32x4*)(X + (size_t)m * D + 4 * lane + 256 * j);
        moe_combine_row(v, m, (const bf16*)(ws + WS_Y), (const int*)(ws + WS_SLOT), (const float*)(ws + WS_TOPW), MOD + ((size_t)(DEPTH - 1) * 2 + b) * 6144 + 5 * D, lane);
        const float rstd = row_rstd(v);
#pragma unroll
        for (int j = 0; j < 4; ++j) { const int c0 = 4 * lane + 256 * j; const f32x4 w = *(const f32x4*)(a.final_norm_w + c0); *(f32x4*)(a.out + (size_t)m * D + c0) = v[j] * rstd * w; }
    }
}

__device__ __noinline__ void moe_tables(gu32* ctl, int layer, volatile LAS unsigned* MISC, int tid) {
    if (tid < NE) MISC[MW_CNT + tid] = __hip_atomic_load(ctl + CW_CNT + layer * NE + tid, RLX_AGENT);
    __syncthreads();
    if (tid == 0) { unsigned p = 0;
        for (int e = 0; e < NE; ++e) { MISC[MW_PST + e] = p; const unsigned nt = (MISC[MW_CNT + e] + 255u) >> 8; for (unsigned t = 0; t < nt; ++t) MISC[MW_TILE + (p >> 8) + t] = (unsigned)e; p += nt << 8; }
        MISC[MW_PST + NE] = p; MISC[MW_NRT] = p >> 8; }
    __syncthreads();
}
__device__ __forceinline__ void p6_dispatch(const Args& a, int layer, volatile LAS unsigned* MISC, gu32* ctl, int vcu, int G, int tid, int lane, int wave) {
    unsigned char* ws = a.ws; const int* TOPE = (const int*)(ws + WS_TOPE); int* SLOT = (int*)(ws + WS_SLOT); const bf16* H = (const bf16*)(ws + WS_H); bf16* A1 = (bf16*)(ws + WS_A1);
    moe_tables(ctl, layer, MISC, tid);
    for (int t0 = vcu * 64; t0 < MTOK; t0 += G * 64) {
        if (tid < NE) MISC[MW_HIST + tid] = 0u;
        __syncthreads();
        int e = 0; unsigned r = 0;
        if (tid < 256) { e = TOPE[(size_t)t0 * 4 + tid]; r = __hip_atomic_fetch_add((LAS unsigned*)&MISC[MW_HIST + e], 1u, __ATOMIC_RELAXED, __HIP_MEMORY_SCOPE_WORKGROUP); }
        __syncthreads();
        if (tid < NE) { const unsigned h = MISC[MW_HIST + tid]; MISC[MW_BASE + tid] = h ? atomicAdd((unsigned*)(ctl + CW_FILL + layer * NE + tid), h) : 0u; }
        __syncthreads();
        if (tid < 256) { const int slot = (int)(MISC[MW_PST + e] + MISC[MW_BASE + e] + r); SLOT[(size_t)t0 * 4 + tid] = slot; MISC[MW_SLOTS + tid] = (unsigned)slot; }
        __syncthreads();
        for (int i = wave * 32; i < wave * 32 + 32; ++i) { const int slot = (int)MISC[MW_SLOTS + i]; const int t = t0 + (i >> 2);
            const v4u* src = (const v4u*)(H + (size_t)t * D); v4u* dst = (v4u*)(A1 + (size_t)slot * D);
            dst[lane] = src[lane]; dst[lane + 64] = src[lane + 64]; }
        __syncthreads();
    }
}

constexpr int L_QS = 0, L_KS = 16640, L_GS = 33280, L_OS = 0  , L_VT = 49920, L_KT = 63744, L_QT = 72960, L_AM = 82176, L_ST = 91392, L_GA = 105216, L_WA = 109312;
constexpr int FP = 65, BP = 72, OP = 97;
template <int TYPE> struct MixCfg { static constexpr int DK = (TYPE == 1) ? 64 : 48, DV = (TYPE == 1) ? 64 : 96; };

template <int TYPE, bool NEEDQ>
__device__ __forceinline__ void mix_load(const Args& a, int layer, int h, int row0, LAS unsigned char* lds, int tid, int lane, int wave) {
    constexpr int DK = MixCfg<TYPE>::DK, DV = MixCfg<TYPE>::DV;
    unsigned char* ws = a.ws; const bf16* PROJ = (const bf16*)(ws + WS_PROJ);
    LAS float* Qs = (LAS float*)(lds + L_QS); LAS float* Ks = (LAS float*)(lds + L_KS); LAS float* Gs = (LAS float*)(lds + L_GS); LAS bf16* VT = (LAS bf16*)(lds + L_VT);
    const LAS float* GAs = (const LAS float*)(lds + L_GA); const LAS float* WAs = (const LAS float*)(lds + L_WA);
    for (int idx = tid; idx < CH * DK; idx += NTHR) { const int t = idx / DK, d = idx - t * DK; const bf16* pr = PROJ + (size_t)(row0 + t) * NPROJ;
        float q = 0.f, k, g;
        if constexpr (TYPE == 0) {
            k = bf2f(pr[C_GK + h * 48 + d]); if (NEEDQ) q = bf2f(pr[C_GQ + h * 48 + d]) * 0.14433756729740643f;
            float pre = a.gla_ba2[layer * 192 + h * 48 + d];
#pragma unroll
            for (int r = 0; r < 16; ++r) pre += GAs[t * 16 + r] * WAs[r * 192 + h * 48 + d];
            g = log_sigmoid_f(pre) * (1.0f / 16.0f);
        } else if constexpr (TYPE == 1) {
            const float hf = bf2f(pr[C_HF + h * 64 + d]); const float ls = log_sigmoid_f(hf); const float lbv = ((const float*)(ws + WS_LB))[layer * 256 + h * 64 + d];
            const float la = logf(lbv), lb2 = log1pf(-lbv) + ls;
            const float mx = fmaxf(la, lb2); g = mx + log1pf(expf(-fabsf(la - lb2)));
            k = -expm1f(g); if (NEEDQ) q = bf2f(pr[C_HQ + h * 64 + d]);
        } else {
            const float* rp = (const float*)(ws + WS_ROPE) + (size_t)(row0 + t) * 48; const int f = (d < 24) ? d : d - 24; const float cs = rp[f], sn = rp[24 + f];
            const int d2 = (d < 24) ? d + 24 : d - 24; const float sg = (d < 24) ? -1.f : 1.f;
            k = bf2f(pr[C_RK + h * 48 + d]) * cs + sg * bf2f(pr[C_RK + h * 48 + d2]) * sn;
            if (NEEDQ) q = (bf2f(pr[C_RQ + h * 48 + d]) * cs + sg * bf2f(pr[C_RQ + h * 48 + d2]) * sn) * 0.14433756729740643f;
            g = logf(1.0f - exp2f(-5.0f - (float)h));
        }
        if (NEEDQ) Qs[t * FP + d] = q;
        Ks[t * FP + d] = k; Gs[t * FP + d] = g; }
    constexpr int CV = (TYPE == 0) ? C_GV : (TYPE == 1) ? C_HI : C_RV;
    for (int idx = tid; idx < CH * DV; idx += NTHR) { const int j = idx / DV, e = idx - j * DV; VT[e * BP + j] = PROJ[(size_t)(row0 + j) * NPROJ + CV + h * DV + e]; }
    __syncthreads();
    for (int d = wave; d < DK; d += NWAVES) { float v = Gs[lane * FP + d];
#pragma unroll
        for (int o = 1; o < 64; o <<= 1) { const float t = __shfl_up(v, o); if (lane >= o) v += t; }
        Gs[lane * FP + d] = v; }
    __syncthreads();
}

template <int TYPE>
__device__ __forceinline__ void mix_summary_head(const Args& a, int layer, int h, int unit, LAS unsigned char* lds, int tid, int lane, int wave) {
    constexpr int DK = MixCfg<TYPE>::DK, DV = MixCfg<TYPE>::DV, STOFF = (TYPE == 0) ? ST_GLA : (TYPE == 1) ? ST_HG : ST_RET;
    unsigned char* ws = a.ws; float* U = (float*)(ws + WS_U) + (size_t)unit * ST_TOT + STOFF + h * DK * DV; float* DVEC = (float*)(ws + WS_DVEC) + (size_t)unit * NDV;
    const int row0 = unit * CH;
    mix_load<TYPE, false>(a, layer, h, row0, lds, tid, lane, wave);
    const LAS float* Ks = (const LAS float*)(lds + L_KS); const LAS float* Gs = (const LAS float*)(lds + L_GS); LAS bf16* VT = (LAS bf16*)(lds + L_VT); LAS bf16* KT = (LAS bf16*)(lds + L_KT);
    for (int idx = tid; idx < CH * DK; idx += NTHR) { const int d = idx >> 6, j = idx & 63; KT[d * BP + j] = (bf16)f2bf(Ks[j * FP + d] * __expf(Gs[63 * FP + d] - Gs[j * FP + d])); }
    if (TYPE != 2 && tid < DK) DVEC[(TYPE == 0 ? 0 : 192) + h * DK + tid] = expf(Gs[63 * FP + tid]);
    __syncthreads();
    constexpr int TD = DK / 16, NT = (DV / 16) * TD;
    for (int ti = wave; ti < NT; ti += NWAVES) { const int te = ti / TD, td = ti - te * TD; f32x4 acc = {0.f, 0.f, 0.f, 0.f};
#pragma unroll
        for (int kk = 0; kk < 2; ++kk) acc = __builtin_amdgcn_mfma_f32_16x16x32_bf16(ldfrag(VT, BP, te * 16, kk * 32, lane), ldfrag(KT, BP, td * 16, kk * 32, lane), acc, 0, 0, 0);
#pragma unroll
        for (int r = 0; r < 4; ++r) U[(te * 16 + (lane >> 4) * 4 + r) * DK + td * 16 + (lane & 15)] = acc[r]; }
    __syncthreads();
}
__device__ __forceinline__ void mix_stage_ga(const Args& a, int layer, int row0, LAS unsigned char* lds, int tid) {
    LAS float* GAs = (LAS float*)(lds + L_GA); LAS float* WAs = (LAS float*)(lds + L_WA); const float* GA = (const float*)(a.ws + WS_GA);
    for (int i = tid; i < CH * 16; i += NTHR) GAs[i] = GA[(size_t)row0 * 16 + i];
    for (int i = tid; i < 16 * 192; i += NTHR) WAs[i] = a.gla_wa2[layer * 16 * 192 + i];
    __syncthreads();
}
__device__ __forceinline__ void p3a_summaries(const Args& a, int layer, LAS unsigned char* lds, int vcu, int G, int tid, int lane, int wave) {
    for (int unit = vcu; unit < NUNIT; unit += G) {
        mix_stage_ga(a, layer, unit * CH, lds, tid);
        for (int h = 0; h < 4; ++h) mix_summary_head<0>(a, layer, h, unit, lds, tid, lane, wave);
        for (int h = 0; h < 4; ++h) mix_summary_head<1>(a, layer, h, unit, lds, tid, lane, wave);
        for (int h = 0; h < 4; ++h) mix_summary_head<2>(a, layer, h, unit, lds, tid, lane, wave);
    }
}

__device__ __forceinline__ void p3b_scan(const Args& a, int vcu, int G, int tid) {
    unsigned char* ws = a.ws; const float* U = (const float*)(ws + WS_U); const float* DVEC = (const float*)(ws + WS_DVEC); bf16* SP = (bf16*)(ws + WS_SP);
    for (int gid = vcu * NTHR + tid; gid < BATCH * ST_TOT; gid += G * NTHR) {
        const int b = gid / ST_TOT, el = gid - b * ST_TOT;
        int di = -1; float cdec = 0.f;
        if (el < ST_HG) { const int h = el / 4608, d = (el - h * 4608) % 48; di = h * 48 + d; }
        else if (el < ST_RET) { const int r = el - ST_HG, h = r / 4096, d = r % 64; di = 192 + h * 64 + d; }
        else { const int h = (el - ST_RET) / 4608; cdec = expf(64.0f * logf(1.0f - exp2f(-5.0f - (float)h))); }
        const float* up = U + (size_t)b * NCH * ST_TOT + el; const float* dp = DVEC + (size_t)b * NCH * NDV + (di < 0 ? 0 : di); bf16* sp = SP + (size_t)b * NCH * ST_TOT + el;
        float s = 0.f;
        for (int n0 = 0; n0 < NCH; n0 += 8) { float u[8], dc[8];
#pragma unroll
            for (int i = 0; i < 8; ++i) { u[i] = up[(size_t)(n0 + i) * ST_TOT]; dc[i] = (di < 0) ? cdec : dp[(size_t)(n0 + i) * NDV]; }
#pragma unroll
            for (int i = 0; i < 8; ++i) { sp[(size_t)(n0 + i) * ST_TOT] = (bf16)f2bf(s); s = dc[i] * s + u[i]; } }
    }
}

template <int TYPE>
__device__ __forceinline__ void mix_output_head(const Args& a, int layer, int h, int unit, LAS unsigned char* lds, int tid, int lane, int wave) {
    constexpr int DK = MixCfg<TYPE>::DK, DV = MixCfg<TYPE>::DV, STOFF = (TYPE == 0) ? ST_GLA : (TYPE == 1) ? ST_HG : ST_RET;
    unsigned char* ws = a.ws; const bf16* SPp = (const bf16*)(ws + WS_SP) + (size_t)unit * ST_TOT + STOFF + h * DK * DV; const bf16* PROJ = (const bf16*)(ws + WS_PROJ); bf16* MIX = (bf16*)(ws + WS_MIX);
    const int row0 = unit * CH;
    mix_load<TYPE, true>(a, layer, h, row0, lds, tid, lane, wave);
    const LAS float* Qs = (const LAS float*)(lds + L_QS); const LAS float* Ks = (const LAS float*)(lds + L_KS); const LAS float* Gs = (const LAS float*)(lds + L_GS);
    LAS bf16* VT = (LAS bf16*)(lds + L_VT); LAS bf16* QT = (LAS bf16*)(lds + L_QT); LAS bf16* AM = (LAS bf16*)(lds + L_AM); LAS bf16* ST = (LAS bf16*)(lds + L_ST); LAS float* Os = (LAS float*)(lds + L_OS);
    {
        const int bi = tid >> 5, bj = tid & 31; float acc[4][2];
#pragma unroll
        for (int x = 0; x < 4; ++x) { acc[x][0] = 0.f; acc[x][1] = 0.f; }
        if (2 * bj <= 4 * bi + 3) {
#pragma unroll 2
            for (int d = 0; d < DK; ++d) { float qv[4], ci[4], kv[2], cj[2];
#pragma unroll
                for (int x = 0; x < 4; ++x) { qv[x] = Qs[(4 * bi + x) * FP + d]; ci[x] = Gs[(4 * bi + x) * FP + d]; }
#pragma unroll
                for (int y = 0; y < 2; ++y) { kv[y] = Ks[(2 * bj + y) * FP + d]; cj[y] = Gs[(2 * bj + y) * FP + d]; }
#pragma unroll
                for (int x = 0; x < 4; ++x)
#pragma unroll
                    for (int y = 0; y < 2; ++y) acc[x][y] += qv[x] * kv[y] * __expf(fminf(ci[x] - cj[y], 0.f)); }
        }
#pragma unroll
        for (int x = 0; x < 4; ++x) { const int i = 4 * bi + x; const float v0 = (2 * bj <= i) ? acc[x][0] : 0.f, v1 = (2 * bj + 1 <= i) ? acc[x][1] : 0.f; *(LAS unsigned*)(AM + i * BP + 2 * bj) = pk2(v0, v1); }
    }
    for (int idx = tid; idx < CH * 64; idx += NTHR) { const int i = idx >> 6, d = idx & 63; QT[i * BP + d] = (d < DK) ? (bf16)f2bf(Qs[i * FP + d] * __expf(Gs[i * FP + d])) : (bf16)0; }
    for (int idx = tid; idx < DV * 64; idx += NTHR) { const int e = idx >> 6, d = idx & 63; ST[e * BP + d] = (d < DK) ? SPp[e * DK + d] : (bf16)0; }
    __syncthreads();
    constexpr int TE = DV / 16, NT = 4 * TE, NIT = NT / NWAVES; static_assert(NT % NWAVES == 0, "tiles per wave");
    f32x4 accs[NIT];
#pragma unroll
    for (int it = 0; it < NIT; ++it) { const int ti = wave + NWAVES * it, tr = ti / TE, te = ti - tr * TE; f32x4 acc = {0.f, 0.f, 0.f, 0.f};
#pragma unroll
        for (int kk = 0; kk < 2; ++kk) acc = __builtin_amdgcn_mfma_f32_16x16x32_bf16(ldfrag(QT, BP, tr * 16, kk * 32, lane), ldfrag(ST, BP, te * 16, kk * 32, lane), acc, 0, 0, 0);
#pragma unroll
        for (int kk = 0; kk < 2; ++kk) acc = __builtin_amdgcn_mfma_f32_16x16x32_bf16(ldfrag(AM, BP, tr * 16, kk * 32, lane), ldfrag(VT, BP, te * 16, kk * 32, lane), acc, 0, 0, 0);
        accs[it] = acc; }
    __syncthreads();
#pragma unroll
    for (int it = 0; it < NIT; ++it) { const int ti = wave + NWAVES * it, tr = ti / TE, te = ti - tr * TE; const f32x4 acc = accs[it];
#pragma unroll
        for (int r = 0; r < 4; ++r) Os[(tr * 16 + (lane >> 4) * 4 + r) * OP + te * 16 + (lane & 15)] = acc[r]; }
    __syncthreads();
    {
        const int row = tid >> 3, sub = tid & 7; constexpr int NEL = DV / 8; float o[NEL]; float s1 = 0.f, s2 = 0.f;
#pragma unroll
        for (int m = 0; m < NEL; ++m) { o[m] = Os[row * OP + sub + 8 * m]; s1 += o[m]; s2 += o[m] * o[m]; }
#pragma unroll
        for (int x = 1; x < 8; x <<= 1) { s1 += __shfl_xor(s1, x); s2 += __shfl_xor(s2, x); }
        const bf16* pr = PROJ + (size_t)(row0 + row) * NPROJ; bf16* mo = MIX + (size_t)(row0 + row) * D;
        if constexpr (TYPE == 2) { const float mean = s1 * (1.0f / DV); float var = 0.f;
#pragma unroll
            for (int m = 0; m < NEL; ++m) { const float dd = o[m] - mean; var += dd * dd; }
#pragma unroll
            for (int x = 1; x < 8; x <<= 1) var += __shfl_xor(var, x);
            const float rstd = 1.0f / sqrtf(var * (1.0f / DV) + EPS);
#pragma unroll
            for (int m = 0; m < NEL; ++m) { const int e = sub + 8 * m; mo[640 + h * 96 + e] = (bf16)f2bf((o[m] - mean) * rstd * silu_f(bf2f(pr[C_RG + h * 96 + e]))); }
        } else { const float rstd = 1.0f / sqrtf(s2 * (1.0f / DV) + EPS);
#pragma unroll
            for (int m = 0; m < NEL; ++m) { const int e = sub + 8 * m;
                if constexpr (TYPE == 0) mo[h * 96 + e] = (bf16)f2bf(o[m] * rstd * a.gla_norm_w[layer * 384 + h * 96 + e] * silu_f(bf2f(pr[C_GG + h * 96 + e])));
                else mo[384 + h * 64 + e] = (bf16)f2bf(o[m] * rstd * a.hg_norm_w[layer * 256 + h * 64 + e] * sigmoid_f(bf2f(pr[C_HG + h * 64 + e]))); }
        }
    }
    __syncthreads();
}
__device__ __forceinline__ void p3c_outputs(const Args& a, int layer, LAS unsigned char* lds, int vcu, int G, int tid, int lane, int wave) {
    for (int unit = vcu; unit < NUNIT; unit += G) {
        mix_stage_ga(a, layer, unit * CH, lds, tid);
        for (int h = 0; h < 4; ++h) mix_output_head<0>(a, layer, h, unit, lds, tid, lane, wave);
        for (int h = 0; h < 4; ++h) mix_output_head<1>(a, layer, h, unit, lds, tid, lane, wave);
        for (int h = 0; h < 4; ++h) mix_output_head<2>(a, layer, h, unit, lds, tid, lane, wave);
    }
}

constexpr int MW_ARGS = 800;
__device__ __forceinline__ const void* ld_argp(const volatile LAS unsigned* T, int i) {
    const unsigned lo = __builtin_amdgcn_readfirstlane(T[2 * i]), hi = __builtin_amdgcn_readfirstlane(T[2 * i + 1]);
    return (const void*)(((unsigned long long)hi << 32) | lo);
}
__device__ __forceinline__ Args load_args(LAS unsigned char* lds) {
    const volatile LAS unsigned* T = (const volatile LAS unsigned*)(lds + MISC_OFF) + MW_ARGS;
    Args a;
    a.x = (const float*)ld_argp(T, 0); a.c = (const float*)ld_argp(T, 1); a.pos = (const int*)ld_argp(T, 2); a.w_mod = (const float*)ld_argp(T, 3); a.b_mod = (const float*)ld_argp(T, 4);
    a.norm1_w = (const float*)ld_argp(T, 5); a.w_in = (const float*)ld_argp(T, 6); a.gla_wa2 = (const float*)ld_argp(T, 7); a.gla_ba2 = (const float*)ld_argp(T, 8); a.hg_lb = (const float*)ld_argp(T, 9);
    a.gla_norm_w = (const float*)ld_argp(T, 10); a.hg_norm_w = (const float*)ld_argp(T, 11); a.w_out = (const float*)ld_argp(T, 12); a.norm2_w = (const float*)ld_argp(T, 13); a.w_r = (const float*)ld_argp(T, 14);
    a.b_r = (const float*)ld_argp(T, 15); a.w_gu = (const float*)ld_argp(T, 16); a.b_gu = (const float*)ld_argp(T, 17); a.w_dn = (const float*)ld_argp(T, 18); a.b_dn = (const float*)ld_argp(T, 19);
    a.final_norm_w = (const float*)ld_argp(T, 20); a.out = (float*)ld_argp(T, 21); a.ws = (unsigned char*)ld_argp(T, 22); a.ph_lo = 0; a.ph_hi = 0;
    return a;
}
#define PH_CTX() const Args args = load_args(lds); volatile LAS unsigned* MISC = (volatile LAS unsigned*)(lds + MISC_OFF); int tid_ = threadIdx.x; asm volatile("" : "+v"(tid_)); const int tid = tid_, lane = tid & 63, wave = __builtin_amdgcn_readfirstlane(tid >> 6); \
    const int G = gridDim.x; const int bx = blockIdx.x; const int vcu = (G % 8 == 0) ? (bx % 8) * (G / 8) + bx / 8 : bx; unsigned char* ws = args.ws; gu32* ctl = (gu32*)(ws + WS_CTL); \
    (void)MISC; (void)lane; (void)wave; (void)vcu; (void)ctl; (void)bx; (void)tid
__device__ __forceinline__ void ph_p0(LAS unsigned char* lds) { PH_CTX(); p0_prologue(args, lds, vcu, G, tid, lane, wave); }
__device__ __forceinline__ void ph_p1(LAS unsigned char* lds, int layer_) { int layer = __builtin_amdgcn_readfirstlane(layer_); asm volatile("" : "+s"(layer)); PH_CTX(); p1_rows(args, layer, lds, vcu, G, tid, lane, wave); }
__device__ __forceinline__ void ph_p2(LAS unsigned char* lds, int layer_) { int layer = __builtin_amdgcn_readfirstlane(layer_); asm volatile("" : "+s"(layer)); PH_CTX();
    pg8::Gemm g{(const bf16*)(ws + WS_H), (const bf16*)(ws + WS_WIN) + (size_t)layer * NPROJ * D, MTOK, NPROJ, D}; pg8::StaticOrder S; S.init(MTOK, NPROJ, G, bx);
    pg8::EpiBf16Plain E{(bf16*)(ws + WS_PROJ), NPROJ};
    pg8::gemm_phase<pg8::EpiBf16Plain, pg8::StaticOrder, true, true>(lds, g, S, E); }
__device__ __forceinline__ void ph_p3a(LAS unsigned char* lds, int layer_) { int layer = __builtin_amdgcn_readfirstlane(layer_); asm volatile("" : "+s"(layer)); PH_CTX(); p3a_summaries(args, layer, lds, vcu, G, tid, lane, wave); }
__device__ __forceinline__ void ph_p3b(LAS unsigned char* lds) { PH_CTX(); p3b_scan(args, vcu, G, tid); }
__device__ __forceinline__ void ph_p3c(LAS unsigned char* lds, int layer_) { int layer = __builtin_amdgcn_readfirstlane(layer_); asm volatile("" : "+s"(layer)); PH_CTX(); p3c_outputs(args, layer, lds, vcu, G, tid, lane, wave); }
__device__ __forceinline__ void ph_p4(LAS unsigned char* lds, int layer_) { int layer = __builtin_amdgcn_readfirstlane(layer_); asm volatile("" : "+s"(layer)); PH_CTX();
    pg8::Gemm g{(const bf16*)(ws + WS_MIX), (const bf16*)(ws + WS_WOUT) + (size_t)layer * D * D, MTOK, D, D}; pg8::StaticOrder S; S.init(MTOK, D, G, bx);
    pg8::EpiResGate E{(layer == 0) ? args.x : (const float*)(ws + WS_X), (float*)(ws + WS_X), D, (const float*)(ws + WS_MOD) + (size_t)layer * 2 * 6144 + 2 * D, 6144, SEQ};
    pg8::gemm_phase<pg8::EpiResGate, pg8::StaticOrder, true, true>(lds, g, S, E); }
__device__ __forceinline__ void ph_p5(LAS unsigned char* lds, int layer_) { int layer = __builtin_amdgcn_readfirstlane(layer_); asm volatile("" : "+s"(layer)); PH_CTX(); p5_rows(args, layer, lds, MISC, ctl, vcu, G, tid, lane, wave); }
__device__ __forceinline__ void ph_p6(LAS unsigned char* lds, int layer_) { int layer = __builtin_amdgcn_readfirstlane(layer_); asm volatile("" : "+s"(layer)); PH_CTX(); p6_dispatch(args, layer, MISC, ctl, vcu, G, tid, lane, wave); }
__device__ __forceinline__ void ph_p7(LAS unsigned char* lds, int layer_) { int layer = __builtin_amdgcn_readfirstlane(layer_); asm volatile("" : "+s"(layer)); PH_CTX();
    moe_tables(ctl, layer, MISC, tid);
    const int nrt = __builtin_amdgcn_readfirstlane((int)MISC[MW_NRT]);
    pg8::Gemm g{(const bf16*)(ws + WS_A1), (const bf16*)(ws + WS_WGU) + (size_t)layer * NE * 2048 * D, nrt * 256, NE * 2048, D};
    pg8::MoeOrder S{8, G, vcu, nrt * 8, (const LAS int*)(lds + MISC_OFF + 4 * MW_TILE)};
    pg8::EpiSwiglu E{(bf16*)(ws + WS_ACT), FFN, args.b_gu + (size_t)layer * NE * 2048};
    pg8::gemm_phase<pg8::EpiSwiglu, pg8::MoeOrder, true, true>(lds, g, S, E); }
__device__ __forceinline__ void ph_p8(LAS unsigned char* lds, int layer_) { int layer = __builtin_amdgcn_readfirstlane(layer_); asm volatile("" : "+s"(layer)); PH_CTX();
    moe_tables(ctl, layer, MISC, tid);
    const int nrt = __builtin_amdgcn_readfirstlane((int)MISC[MW_NRT]);
    pg8::Gemm g{(const bf16*)(ws + WS_ACT), (const bf16*)(ws + WS_WDN) + (size_t)layer * NE * D * FFN, nrt * 256, NE * D, FFN};
    pg8::MoeOrder S{4, G, vcu, nrt * 4, (const LAS int*)(lds + MISC_OFF + 4 * MW_TILE)};
    pg8::EpiBf16Bias E{(bf16*)(ws + WS_Y), D, args.b_dn + (size_t)layer * NE * D, D};
    pg8::gemm_phase<pg8::EpiBf16Bias, pg8::MoeOrder, true, true>(lds, g, S, E); }
__device__ __forceinline__ void ph_final(LAS unsigned char* lds) { PH_CTX(); final_rows(args, vcu, G, lane, wave); }

__global__ void __launch_bounds__(NTHR, 2) hybrid_fwd(Args args) {
    extern __shared__ __attribute__((aligned(16))) unsigned char lds_raw[];
    LAS unsigned char* lds = (LAS unsigned char*)lds_raw;
    volatile LAS unsigned* MISC = (volatile LAS unsigned*)(lds + MISC_OFF);
    const int tid = threadIdx.x;
    gu32* ctl = (gu32*)(args.ws + WS_CTL);
    for (int u = tid; u < (LDS_BYTES - MISC_OFF) / 4; u += NTHR) MISC[u] = 0u;
    __syncthreads();
    if (tid == 0) {
#define ST_ARG(i, p) do { const unsigned long long v_ = (unsigned long long)(p); MISC[MW_ARGS + 2 * (i)] = (unsigned)v_; MISC[MW_ARGS + 2 * (i) + 1] = (unsigned)(v_ >> 32); } while (0)
        ST_ARG(0, args.x); ST_ARG(1, args.c); ST_ARG(2, args.pos); ST_ARG(3, args.w_mod); ST_ARG(4, args.b_mod); ST_ARG(5, args.norm1_w); ST_ARG(6, args.w_in); ST_ARG(7, args.gla_wa2); ST_ARG(8, args.gla_ba2);
        ST_ARG(9, args.hg_lb); ST_ARG(10, args.gla_norm_w); ST_ARG(11, args.hg_norm_w); ST_ARG(12, args.w_out); ST_ARG(13, args.norm2_w); ST_ARG(14, args.w_r); ST_ARG(15, args.b_r); ST_ARG(16, args.w_gu);
        ST_ARG(17, args.b_gu); ST_ARG(18, args.w_dn); ST_ARG(19, args.b_dn); ST_ARG(20, args.final_norm_w); ST_ARG(21, args.out); ST_ARG(22, args.ws);
#undef ST_ARG
    }
    __syncthreads();
    const int lo = args.ph_lo, hi = args.ph_hi;
    const bool multi = (hi - lo) > 1;
    XcdBarrier bar; bar.bar = (unsigned*)(ctl + CW_BAR); bar.x = 0; bar.st = nullptr;
    if (multi) bar = xcd_barrier_post((unsigned*)(ctl + CW_BAR), MISC + MW_BAR);
#define IN(k) (lo <= (k) && (k) < hi)
#define SEAM(k) do { if (IN(k) && IN((k) + 1)) xcd_barrier(bar); } while (0)

    if (IN(0)) ph_p0(lds);
    SEAM(0);
    for (int layer = 0; layer < DEPTH; ++layer) {
        const int pb = 1 + 10 * layer;
        if (IN(pb + 0)) ph_p1(lds, layer);
        SEAM(pb + 0);
        if (IN(pb + 1)) ph_p2(lds, layer);
        SEAM(pb + 1);
        if (IN(pb + 2)) ph_p3a(lds, layer);
        SEAM(pb + 2);
        if (IN(pb + 3)) ph_p3b(lds);
        SEAM(pb + 3);
        if (IN(pb + 4)) ph_p3c(lds, layer);
        SEAM(pb + 4);
        if (IN(pb + 5)) ph_p4(lds, layer);
        SEAM(pb + 5);
        if (IN(pb + 6)) ph_p5(lds, layer);
        SEAM(pb + 6);
        if (IN(pb + 7)) ph_p6(lds, layer);
        SEAM(pb + 7);
        if (IN(pb + 8)) ph_p7(lds, layer);
        SEAM(pb + 8);
        if (IN(pb + 9)) ph_p8(lds, layer);
        SEAM(pb + 9);
    }
    if (IN(NPHASE - 1)) ph_final(lds);
#undef IN
#undef SEAM
}

#ifndef MK_SINGLE
#define MK_SINGLE 1
#endif
extern "C" void kernel_launch(void* const* d_in, const int* in_sizes, int n_in, void* d_out, int out_size, void* d_ws, size_t ws_size, hipStream_t stream) {
    static int grid = 0;
    if (grid == 0) {
        if (n_in != 21 || in_sizes[0] != MTOK * D || out_size != MTOK * D || ws_size < WS_END) { fprintf(stderr, "kernel_launch: unexpected problem shape (n_in %d, in0 %d, out %d, ws %zu)\n", n_in, n_in > 0 ? in_sizes[0] : -1, out_size, ws_size); grid = -1; return; }
        int dev = 0, cus = 0, per_cu = 0;
        if (hipGetDevice(&dev) != hipSuccess || hipDeviceGetAttribute(&cus, hipDeviceAttributeMultiprocessorCount, dev) != hipSuccess) { grid = -1; return; }
        if (hipFuncSetAttribute((const void*)hybrid_fwd, hipFuncAttributeMaxDynamicSharedMemorySize, LDS_BYTES) != hipSuccess) { fprintf(stderr, "kernel_launch: hipFuncSetAttribute failed\n"); grid = -1; return; }
        if (hipOccupancyMaxActiveBlocksPerMultiprocessor(&per_cu, (const void*)hybrid_fwd, NTHR, LDS_BYTES) != hipSuccess || per_cu < 1) fprintf(stderr, "kernel_launch: occupancy query says %d\n", per_cu);
        (void)hipGetLastError();
        grid = cus;
    }
    if (grid < 0) return;
    (void)hipMemsetAsync((char*)d_ws + WS_CTL, 0, CTL_ZERO_BYTES, stream);
    Args a{};
    a.x = (const float*)d_in[0]; a.c = (const float*)d_in[1]; a.pos = (const int*)d_in[2]; a.w_mod = (const float*)d_in[3]; a.b_mod = (const float*)d_in[4]; a.norm1_w = (const float*)d_in[5];
    a.w_in = (const float*)d_in[6]; a.gla_wa2 = (const float*)d_in[7]; a.gla_ba2 = (const float*)d_in[8]; a.hg_lb = (const float*)d_in[9]; a.gla_norm_w = (const float*)d_in[10]; a.hg_norm_w = (const float*)d_in[11];
    a.w_out = (const float*)d_in[12]; a.norm2_w = (const float*)d_in[13]; a.w_r = (const float*)d_in[14]; a.b_r = (const float*)d_in[15]; a.w_gu = (const float*)d_in[16]; a.b_gu = (const float*)d_in[17];
    a.w_dn = (const float*)d_in[18]; a.b_dn = (const float*)d_in[19]; a.final_norm_w = (const float*)d_in[20]; a.out = (float*)d_out; a.ws = (unsigned char*)d_ws;
#if MK_SINGLE
    a.ph_lo = 0; a.ph_hi = NPHASE;
    hipLaunchKernelGGL(hybrid_fwd, dim3(grid), dim3(NTHR), LDS_BYTES, stream, a);
#else
    for (int p = 0; p < NPHASE; ++p) { a.ph_lo = p; a.ph_hi = p + 1; hipLaunchKernelGGL(hybrid_fwd, dim3(grid), dim3(NTHR), LDS_BYTES, stream, a); }
#endif
}
```

```cpp
#include <hip/hip_runtime.h>
#include <cstdio>
#include <cstdint>
namespace pg8 {
#define PG8_LAS __attribute__((address_space(3)))
typedef unsigned short bf16_t;
typedef short bf16x8 __attribute__((ext_vector_type(8)));
typedef float f32x4 __attribute__((ext_vector_type(4)));
typedef unsigned u32x4 __attribute__((ext_vector_type(4)));
constexpr int BM = 256, BK = 64, HALF = 128, HTB = HALF * BK * 2  , STAGE_BYTES = 8 * HTB, NXCD = 8, WGM = 8;

__host__ __device__ __forceinline__ int lds_byte(int r, int c) { const int st = (r >> 4) * 2 + (c >> 5), rr = r & 15, cc = c & 31, ob = rr * 64 + cc * 2; return st * 1024 + (ob ^ (((ob >> 9) & 1) << 5)); }
__host__ __device__ __forceinline__ void stage_rc(int b, int& R, int& C) { const int st = b / 1024, sb = b % 1024, swz = sb ^ (((sb >> 9) & 1) << 5); R = (st >> 1) * 16 + swz / 64; C = (st & 1) * 32 + (swz % 64) / 2; }
__host__ __device__ __forceinline__ int perm32(int rho) { const int n = rho >> 4, i = rho & 15; return 8 * (i >> 2) + 4 * n + (i & 3); }

struct Unit { int pm, pn, e, pl; };
struct Gemm { const bf16_t* A; const bf16_t* Bt; int M, N, K; };

struct StaticOrder {
    int nM, nN, nwg, G, c;
    __host__ __device__ void init(int M, int N, int G_, int c_) { nM = M / BM; nN = N / BM; nwg = nM * nN; G = G_; c = c_; }
    __host__ __device__ bool next(int i, Unit& u) const {
        const long L = (long)i * G + c; if (L >= nwg) return false;
        int wgid = (int)L; { const int q = nwg / NXCD, r = nwg % NXCD, xcd = wgid % NXCD, off = wgid / NXCD; wgid = (xcd < r ? xcd * (q + 1) : r * (q + 1) + (xcd - r) * q) + off; }
        const int nig = WGM * nN, gid = wgid / nig, fm = gid * WGM, gsz = (nM - fm) < WGM ? (nM - fm) : WGM;
        u.pm = fm + ((wgid % nig) % gsz); u.pn = (wgid % nig) / gsz; u.e = 0; u.pl = u.pn; return true;
    }
    __device__ __forceinline__ void a_ready(const Unit&) const {}
    __device__ __forceinline__ void done(const Unit&) const {}
};

__device__ __forceinline__ unsigned cvt_pk_bf16(float lo, float hi) { unsigned r; asm volatile("v_cvt_pk_bf16_f32 %0, %1, %2" : "=v"(r) : "v"(lo), "v"(hi)); return r; }

struct EpiBf16Plain {
    static constexpr bool PERM = true, AFTER_DRAIN = false;
    bf16_t* O; int ldc;
    __device__ __forceinline__ void operator()(const f32x4 (&acc)[2][2][4][2], const Unit& u, int wr, int wc, int fr, int fq) const {
        const int row0 = u.pm * BM + wr * 64 + fr; const int col0 = u.pn * BM + wc * 32 + 8 * fq;
#pragma unroll
        for (int ai = 0; ai < 2; ++ai)
#pragma unroll
            for (int m = 0; m < 4; ++m) { bf16_t* rowp = O + (size_t)(row0 + ai * HALF + m * 16) * ldc + col0;
#pragma unroll
                for (int bj = 0; bj < 2; ++bj) { const f32x4 v0 = acc[ai][bj][m][0], v1 = acc[ai][bj][m][1];
                    u32x4 w; w.x = cvt_pk_bf16(v0[0], v0[1]); w.y = cvt_pk_bf16(v0[2], v0[3]); w.z = cvt_pk_bf16(v1[0], v1[1]); w.w = cvt_pk_bf16(v1[2], v1[3]);
                    *(u32x4*)(rowp + bj * HALF) = w; } }
    }
};
struct EpiResGate {
    static constexpr bool PERM = false, AFTER_DRAIN = false;
    const float* base; float* out; int ldc; const float* gate; int gpitch; int rows_per_batch;
    __device__ __forceinline__ void operator()(const f32x4 (&acc)[2][2][4][2], const Unit& u, int wr, int wc, int fr, int fq) const {
        const int row0 = u.pm * BM + wr * 64 + fr, col0 = u.pn * BM + wc * 32 + 4 * fq;
        const float* gp = gate + (size_t)((u.pm * BM) / rows_per_batch) * gpitch + col0;
        f32x4 gv[2][2];
#pragma unroll
        for (int bj = 0; bj < 2; ++bj)
#pragma unroll
            for (int n = 0; n < 2; ++n) gv[bj][n] = *(const f32x4*)(gp + bj * HALF + n * 16);
#pragma unroll
        for (int ai = 0; ai < 2; ++ai)
#pragma unroll
            for (int m = 0; m < 4; ++m) { const size_t off = (size_t)(row0 + ai * HALF + m * 16) * ldc + col0;
#pragma unroll
                for (int bj = 0; bj < 2; ++bj)
#pragma unroll
                    for (int n = 0; n < 2; ++n) { const f32x4 bs = *(const f32x4*)(base + off + bj * HALF + n * 16);
                        *(f32x4*)(out + off + bj * HALF + n * 16) = bs + gv[bj][n] * acc[ai][bj][m][n]; }
                asm volatile("" ::: "memory"); }
    }
};
struct EpiSwiglu {
    static constexpr bool PERM = true, AFTER_DRAIN = false;
    bf16_t* O; int ldc; const float* bias;
    __device__ __forceinline__ float act1(float g, float up) const {
        g = fminf(g, 7.0f); up = fminf(fmaxf(up, -7.0f), 7.0f);
        const float s = 1.0f / (1.0f + __expf(-1.702f * g));
        return (up + 1.0f) * g * s;
    }
    __device__ __forceinline__ void operator()(const f32x4 (&acc)[2][2][4][2], const Unit& u, int wr, int wc, int fr, int fq) const {
        const int row0 = u.pm * BM + wr * 64 + fr; const int jj0 = wc * 32 + 8 * fq; const int col0 = u.pl * HALF + jj0;
        const float* bp = bias + (size_t)u.e * 2048 + col0;
        f32x4 bg[2], bu[2];
#pragma unroll
        for (int n = 0; n < 2; ++n) { bg[n] = *(const f32x4*)(bp + 4 * n); bu[n] = *(const f32x4*)(bp + 1024 + 4 * n); }
#pragma unroll
        for (int ai = 0; ai < 2; ++ai)
#pragma unroll
            for (int m = 0; m < 4; ++m) { bf16_t* rowp = O + (size_t)(row0 + ai * HALF + m * 16) * ldc + col0;
                f32x4 r[2];
#pragma unroll
                for (int n = 0; n < 2; ++n) { const f32x4 g = acc[ai][0][m][n] + bg[n], up = acc[ai][1][m][n] + bu[n];
#pragma unroll
                    for (int j = 0; j < 4; ++j) r[n][j] = act1(g[j], up[j]); }
                u32x4 w; w.x = cvt_pk_bf16(r[0][0], r[0][1]); w.y = cvt_pk_bf16(r[0][2], r[0][3]); w.z = cvt_pk_bf16(r[1][0], r[1][1]); w.w = cvt_pk_bf16(r[1][2], r[1][3]);
                *(u32x4*)rowp = w; }
    }
};
struct EpiBf16Bias {
    static constexpr bool PERM = true, AFTER_DRAIN = false;
    bf16_t* O; int ldc; const float* bias; int bpitch;
    __device__ __forceinline__ void operator()(const f32x4 (&acc)[2][2][4][2], const Unit& u, int wr, int wc, int fr, int fq) const {
        const int row0 = u.pm * BM + wr * 64 + fr; const int col0 = u.pl * BM + wc * 32 + 8 * fq;
        const float* bp = bias + (size_t)u.e * bpitch + col0;
        f32x4 bv[2][2];
#pragma unroll
        for (int bj = 0; bj < 2; ++bj)
#pragma unroll
            for (int n = 0; n < 2; ++n) bv[bj][n] = *(const f32x4*)(bp + bj * HALF + 4 * n);
#pragma unroll
        for (int ai = 0; ai < 2; ++ai)
#pragma unroll
            for (int m = 0; m < 4; ++m) { bf16_t* rowp = O + (size_t)(row0 + ai * HALF + m * 16) * ldc + col0;
#pragma unroll
                for (int bj = 0; bj < 2; ++bj) { const f32x4 v0 = acc[ai][bj][m][0] + bv[bj][0], v1 = acc[ai][bj][m][1] + bv[bj][1];
                    u32x4 w; w.x = cvt_pk_bf16(v0[0], v0[1]); w.y = cvt_pk_bf16(v0[2], v0[3]); w.z = cvt_pk_bf16(v1[0], v1[1]); w.w = cvt_pk_bf16(v1[2], v1[3]);
                    *(u32x4*)(rowp + bj * HALF) = w; } }
    }
};
struct MoeOrder {
    int nN, G, c, nunits; const PG8_LAS int* tile_e;
    __device__ __forceinline__ bool next(int i, Unit& u) const {
        const int L = i * G + c; if (L >= nunits) return false;
        const int pm = L / nN, pl = L - pm * nN, e = __builtin_amdgcn_readfirstlane(tile_e[pm]);
        u.pm = pm; u.pl = pl; u.e = e; u.pn = e * nN + pl; return true;
    }
    __device__ __forceinline__ void a_ready(const Unit&) const {}
    __device__ __forceinline__ void done(const Unit&) const {}
};
template <class Epi, class Sched, bool ALIGN_EPI = false, bool SP2 = false>
__device__ __forceinline__ void gemm_phase(PG8_LAS unsigned char* lds, const Gemm g, const Sched& S, const Epi& E) {
    int tid_ = threadIdx.x; asm volatile("" : "+v"(tid_)); const int tid = tid_, wid = __builtin_amdgcn_readfirstlane(tid >> 6), lane = tid & 63, wr = wid >> 2, wc = wid & 3, fr = lane & 15, fq = lane >> 4;
    const int K = g.K, nt = K / BK;
    unsigned voffA[2], voffB[2];
#pragma unroll
    for (int i = 0; i < 2; ++i) { int R, C; stage_rc(tid * 16 + i * 8192, R, C); const int Rb = Epi::PERM ? ((R & ~31) + perm32(R & 31)) : R;
        voffA[i] = (unsigned)(R * K + C) * 2u; voffB[i] = (unsigned)(Rb * K + C) * 2u; }
    const size_t kstep = (size_t)(BK * 2);
    const size_t hstep = (size_t)HALF * K * 2;
    const size_t tstep = 2 * hstep;
    const unsigned ldsw = (unsigned)wid * 1024u;
    const int aoff = lds_byte(wr * 64 + fr, fq * 8), boff = lds_byte(wc * 32 + fr, fq * 8);
#define PG8_SA(b, h) (((b) * 2 + (h)) * HTB)
#define PG8_SB(b, h) ((4 + (b) * 2 + (h)) * HTB)
#define PG8_STAGE(bufoff, gbase, voff) do { _Pragma("unroll") for (int _i = 0; _i < 2; ++_i) \
        __builtin_amdgcn_global_load_lds((const unsigned*)((const char*)(gbase) + (voff)[_i]), (PG8_LAS unsigned*)(lds + (bufoff) + ldsw + _i * 8192), 16, 0, 0); } while (0)
#define PG8_LDA(dst, b, h) do { _Pragma("unroll") for (int m = 0; m < 4; ++m) _Pragma("unroll") for (int k = 0; k < 2; ++k) dst[m][k] = *(const PG8_LAS bf16x8*)(lds + PG8_SA(b, h) + aoff + m * 2048 + k * 1024); } while (0)
#define PG8_LDB(dst, b, h) do { _Pragma("unroll") for (int n = 0; n < 2; ++n) _Pragma("unroll") for (int k = 0; k < 2; ++k) dst[n][k] = *(const PG8_LAS bf16x8*)(lds + PG8_SB(b, h) + boff + n * 2048 + k * 1024); } while (0)
#define PG8_MMA(ai, bj, At, Bt) do { __builtin_amdgcn_s_setprio(1); _Pragma("unroll") for (int m = 0; m < 4; ++m) _Pragma("unroll") for (int n = 0; n < 2; ++n) _Pragma("unroll") for (int k = 0; k < 2; ++k) \
        acc[ai][bj][m][n] = __builtin_amdgcn_mfma_f32_16x16x32_bf16(Bt[n][k], At[m][k], acc[ai][bj][m][n], 0, 0, 0); __builtin_amdgcn_s_setprio(0); } while (0)
#define PG8_WAIT_V(n) asm volatile("s_waitcnt vmcnt(" #n ")" ::: "memory")
#define PG8_WAIT_L(n) asm volatile("s_waitcnt lgkmcnt(" #n ")" ::: "memory")
#define PG8_BAR __builtin_amdgcn_s_barrier()
#define PG8_SCHED __builtin_amdgcn_sched_barrier(0)
    Unit cur, nxt; int ui = 0;
    if (!S.next(0, cur)) return;
    f32x4 acc[2][2][4][2];
#pragma unroll
    for (int a = 0; a < 2; ++a)
#pragma unroll
        for (int b = 0; b < 2; ++b)
#pragma unroll
            for (int m = 0; m < 4; ++m)
#pragma unroll
                for (int n = 0; n < 2; ++n) acc[a][b][m][n] = (f32x4){0.f, 0.f, 0.f, 0.f};
    bf16x8 At[4][2], B0[2][2], B1[2][2];
    const char* cA = (const char*)g.A + (size_t)cur.pm * tstep; const char* cB = (const char*)g.Bt + (size_t)cur.pn * tstep;
    S.a_ready(cur);
    if constexpr (SP2) {
        PG8_STAGE(PG8_SB(0, 0), cB, voffB); PG8_STAGE(PG8_SB(0, 1), cB + hstep, voffB); PG8_STAGE(PG8_SA(0, 0), cA, voffA); PG8_STAGE(PG8_SA(0, 1), cA + hstep, voffA);
        if (wr == 1) PG8_BAR;
        PG8_WAIT_V(2); PG8_BAR;
        PG8_STAGE(PG8_SB(1, 0), cB + kstep, voffB); PG8_STAGE(PG8_SA(1, 0), cA + kstep, voffA); PG8_STAGE(PG8_SB(1, 1), cB + hstep + kstep, voffB);
        PG8_WAIT_V(6); PG8_BAR;
    } else {
        PG8_STAGE(PG8_SB(0, 0), cB, voffB); PG8_STAGE(PG8_SA(0, 0), cA, voffA); PG8_STAGE(PG8_SB(0, 1), cB + hstep, voffB); PG8_STAGE(PG8_SA(0, 1), cA + hstep, voffA);
        if (wr == 1) PG8_BAR;
        PG8_WAIT_V(4); PG8_BAR;
        PG8_STAGE(PG8_SB(1, 0), cB + kstep, voffB); PG8_STAGE(PG8_SA(1, 0), cA + kstep, voffA); PG8_STAGE(PG8_SB(1, 1), cB + hstep + kstep, voffB);
        PG8_WAIT_V(6); PG8_BAR;
    }
    for (;;) {
        const bool has_next = S.next(ui + 1, nxt);
        const char* nA = has_next ? (const char*)g.A + (size_t)nxt.pm * tstep : cA; const char* nB = has_next ? (const char*)g.Bt + (size_t)nxt.pn * tstep : cB;
        for (int t = 0; t < nt; t += 2) {
            const bool last = (t == nt - 2);
            const char* a1 = cA + (size_t)(t + 1) * kstep;
            const char* a2 = last ? nA : cA + (size_t)(t + 2) * kstep; const char* b2 = last ? nB : cB + (size_t)(t + 2) * kstep;
            const char* a3 = a2 + kstep; const char* b3 = b2 + kstep;
            if (last && has_next) S.a_ready(nxt);
            if constexpr (SP2) {
            PG8_LDB(B0, 0, 0); PG8_LDB(B1, 0, 1); PG8_SCHED; PG8_LDA(At, 0, 0); PG8_STAGE(PG8_SA(1, 1), a1 + hstep, voffA);
            PG8_WAIT_V(8); PG8_WAIT_L(0); PG8_BAR; PG8_MMA(0, 0, At, B0); PG8_MMA(0, 1, At, B1); PG8_BAR; PG8_SCHED;
            PG8_LDA(At, 0, 1); PG8_STAGE(PG8_SB(0, 0), b2, voffB); PG8_STAGE(PG8_SB(0, 1), b2 + hstep, voffB); PG8_STAGE(PG8_SA(0, 0), a2, voffA);
            PG8_WAIT_V(8); PG8_WAIT_L(0); PG8_BAR; PG8_MMA(1, 0, At, B0); PG8_MMA(1, 1, At, B1); PG8_BAR; PG8_SCHED;
            PG8_LDB(B0, 1, 0); PG8_LDB(B1, 1, 1); PG8_SCHED; PG8_LDA(At, 1, 0); PG8_STAGE(PG8_SA(0, 1), a2 + hstep, voffA);
            PG8_WAIT_V(8); PG8_WAIT_L(0); PG8_BAR; PG8_MMA(0, 0, At, B0); PG8_MMA(0, 1, At, B1); PG8_BAR; PG8_SCHED;
            PG8_LDA(At, 1, 1); PG8_STAGE(PG8_SB(1, 0), b3, voffB); PG8_STAGE(PG8_SB(1, 1), b3 + hstep, voffB); PG8_STAGE(PG8_SA(1, 0), a3, voffA);
            PG8_WAIT_V(8); PG8_WAIT_L(0); PG8_BAR; PG8_MMA(1, 0, At, B0); PG8_MMA(1, 1, At, B1); PG8_BAR; PG8_SCHED;
            } else {
            PG8_LDB(B0, 0, 0); PG8_SCHED; PG8_LDA(At, 0, 0); PG8_STAGE(PG8_SA(1, 1), a1 + hstep, voffA);
            PG8_WAIT_L(8); PG8_BAR; PG8_WAIT_L(0); PG8_MMA(0, 0, At, B0); PG8_BAR; PG8_SCHED;
            PG8_LDB(B1, 0, 1); PG8_STAGE(PG8_SB(0, 0), b2, voffB);
            PG8_BAR; PG8_WAIT_L(0); PG8_MMA(0, 1, At, B1); PG8_BAR;
            PG8_LDA(At, 0, 1); PG8_STAGE(PG8_SA(0, 0), a2, voffA);
            PG8_BAR; PG8_WAIT_L(0); PG8_MMA(1, 0, At, B0); PG8_BAR; PG8_SCHED;
            PG8_STAGE(PG8_SB(0, 1), b2 + hstep, voffB);
            PG8_WAIT_V(6); PG8_BAR; PG8_MMA(1, 1, At, B1); PG8_BAR;
            PG8_LDB(B0, 1, 0); PG8_SCHED; PG8_LDA(At, 1, 0); PG8_STAGE(PG8_SA(0, 1), a2 + hstep, voffA);
            PG8_WAIT_L(8); PG8_BAR; PG8_WAIT_L(0); PG8_MMA(0, 0, At, B0); PG8_BAR; PG8_SCHED;
            PG8_LDB(B1, 1, 1); PG8_STAGE(PG8_SB(1, 0), b3, voffB);
            PG8_BAR; PG8_WAIT_L(0); PG8_MMA(0, 1, At, B1); PG8_BAR;
            PG8_LDA(At, 1, 1); PG8_STAGE(PG8_SA(1, 0), a3, voffA);
            PG8_BAR; PG8_WAIT_L(0); PG8_MMA(1, 0, At, B0); PG8_BAR; PG8_SCHED;
            PG8_STAGE(PG8_SB(1, 1), b3 + hstep, voffB);
            PG8_WAIT_V(6); PG8_BAR; PG8_MMA(1, 1, At, B1); PG8_BAR;
            }
        }
        if constexpr (ALIGN_EPI) { if (wr == 0) PG8_BAR; }
        if constexpr (!Epi::AFTER_DRAIN) { E(acc, cur, wr, wc, fr, fq); S.done(cur); }
        if (!has_next) break;
#pragma unroll
        for (int a = 0; a < 2; ++a)
#pragma unroll
            for (int b = 0; b < 2; ++b)
#pragma unroll
                for (int m = 0; m < 4; ++m)
#pragma unroll
                    for (int n = 0; n < 2; ++n) acc[a][b][m][n] = (f32x4){0.f, 0.f, 0.f, 0.f};
        cur = nxt; cA = nA; cB = nB; ++ui;
        if constexpr (ALIGN_EPI) { if (wr == 1) PG8_BAR; }
    }
    PG8_WAIT_V(0);
    if constexpr (!ALIGN_EPI) { if (wr == 0) PG8_BAR; }
    PG8_BAR;
    if constexpr (Epi::AFTER_DRAIN) { E.fused(acc, cur, wr, wc, fr, fq, lds, wid, lane); S.done(cur); }
#undef PG8_SA
#undef PG8_SB
#undef PG8_STAGE
#undef PG8_LDA
#undef PG8_LDB
#undef PG8_MMA
#undef PG8_WAIT_V
#undef PG8_WAIT_L
#undef PG8_BAR
#undef PG8_SCHED
}
}

constexpr int NWAVES = 8, NTHR = 512;
constexpr int BATCH = 2, SEQ = 8192, D = 1024, DEPTH = 4, MTOK = BATCH * SEQ;
constexpr int DIN = 3344, NPROJ = 3328, SRC_GA = 1152;
constexpr int C_GQ = 0, C_GK = 192, C_GV = 384, C_GG = 768, C_HQ = 1152, C_HF = 1408, C_HI = 1664, C_HG = 1920, C_RQ = 2176, C_RK = 2368, C_RV = 2560, C_RG = 2944;
constexpr int NE = 32, FFN = 1024;
constexpr int CH = 64, NCH = SEQ / CH, NUNIT = BATCH * NCH;
constexpr int ST_GLA = 0, ST_HG = 4 * 48 * 96, ST_RET = ST_HG + 4 * 64 * 64, ST_TOT = ST_RET + 4 * 48 * 96;
constexpr int NDV = 448;
constexpr int MAXROWS = 65536 + NE * 256, MAXRT = MAXROWS / 256;
constexpr float EPS = 1e-6f;
constexpr int NPHASE = 42;

constexpr size_t MiB = 1u << 20;
constexpr size_t WS_CTL = 0, CTL_ZERO_BYTES = 65536;
constexpr size_t WS_MOD = 1 * MiB;
constexpr size_t WS_ROPE = 2 * MiB;
constexpr size_t WS_LB = 5 * MiB;
constexpr size_t WS_WIN = 8 * MiB;
constexpr size_t WS_WOUT = 34 * MiB;
constexpr size_t WS_WGU = 42 * MiB;
constexpr size_t WS_WDN = 554 * MiB;
constexpr size_t WS_X = 810 * MiB;
constexpr size_t WS_H = 874 * MiB;
constexpr size_t WS_GA = 906 * MiB;
constexpr size_t WS_PROJ = 907 * MiB;
constexpr size_t WS_U = 1011 * MiB;
constexpr size_t WS_DVEC = 1063 * MiB;
constexpr size_t WS_SP = 1064 * MiB;
constexpr size_t WS_MIX = 1090 * MiB;
constexpr size_t WS_TOPE = 1122 * MiB;
constexpr size_t WS_TOPW = WS_TOPE + 256 * 1024;
constexpr size_t WS_SLOT = WS_TOPW + 256 * 1024;
constexpr size_t WS_A1 = 1123 * MiB;
constexpr size_t WS_ACT = 1267 * MiB;
constexpr size_t WS_Y = 1411 * MiB;
constexpr size_t WS_END = 1555 * MiB;
static_assert(WS_WIN + (size_t)DEPTH * NPROJ * D * 2 <= WS_WOUT && WS_PROJ + (size_t)MTOK * NPROJ * 2 <= WS_U && WS_U + (size_t)NUNIT * ST_TOT * 4 <= WS_DVEC && WS_SP + (size_t)NUNIT * ST_TOT * 2 <= WS_MIX && WS_A1 + (size_t)MAXROWS * D * 2 <= WS_ACT, "ws map");
constexpr int CW_TMO = 0, CW_CODE = 1, CW_BAR = 4096, CW_CNT = 8192, CW_FILL = 8192 + 256;
constexpr int RING_BYTES = 131072;
constexpr int MISC_OFF = 147456, LDS_BYTES = MISC_OFF + 4096;
constexpr int MW_BAR = 0, MW_CNT = 16, MW_PST = 48, MW_HIST = 96, MW_BASE = 128, MW_TILE = 192, MW_NRT = 480, MW_SLOTS = 512;

#define GAS __attribute__((address_space(1)))
#define LAS __attribute__((address_space(3)))
typedef unsigned v4u __attribute__((ext_vector_type(4)));
typedef float f32x4 __attribute__((ext_vector_type(4)));
typedef short bf16x8 __attribute__((ext_vector_type(8)));
typedef GAS unsigned gu32;
typedef GAS unsigned long long gu64;
#define RLX_AGENT __ATOMIC_RELAXED, __HIP_MEMORY_SCOPE_AGENT
#define LDS_WAIT() asm volatile("s_waitcnt lgkmcnt(0)" ::: "memory")
#define VM_WAIT() asm volatile("s_waitcnt vmcnt(0)" ::: "memory")
__device__ __forceinline__ unsigned long long rt() { return __builtin_amdgcn_s_memrealtime(); }
typedef unsigned short bf16;
__device__ __forceinline__ unsigned f2bf(float f) { unsigned u = __builtin_bit_cast(unsigned, f); return (u + 0x7fffu + ((u >> 16) & 1u)) >> 16; }
__device__ __forceinline__ unsigned pk2(float lo, float hi) { return f2bf(lo) | (f2bf(hi) << 16); }
__device__ __forceinline__ float bf2f(bf16 b) { return __builtin_bit_cast(float, (unsigned)b << 16); }
#define XB_TMO      128
#define XB_XCNT(j)  (256  + 64 * (j))
#define XB_XSUB(j)  (1280 + 64 * (j))
#define XB_XGEN(j)  (2304 + 64 * (j))
#define XB_TOP      3328
#define XB_TOPGEN   3392
#define XCD_BAR_WORDS 3456
#define XB_SPIN_CAP (1u << 18)

__device__ __forceinline__ unsigned xb_ld(unsigned* p)              { return __hip_atomic_load(p, __ATOMIC_RELAXED, __HIP_MEMORY_SCOPE_AGENT); }
__device__ __forceinline__ unsigned xb_add(unsigned* p, unsigned v) { return __hip_atomic_fetch_add(p, v, __ATOMIC_RELAXED, __HIP_MEMORY_SCOPE_AGENT); }
__device__ __forceinline__ unsigned xb_xcc_id() { return (unsigned)__builtin_amdgcn_s_getreg((3 << 11) | 20) & 0xFu; }
#define XB_SPIN(cond, bar) do { unsigned _sp = 0; while (cond) { __builtin_amdgcn_s_sleep(1); \
    if ((++_sp & 255u) == 0u) { if (xb_ld(&(bar)[XB_TMO])) break; if (_sp > XB_SPIN_CAP) { atomicAdd(&(bar)[XB_TMO], 1u); break; } } } } while (0)

struct XcdBarrier {
    unsigned* bar; unsigned x;
    volatile LAS unsigned* st;
};

__device__ __forceinline__ XcdBarrier xcd_barrier_post(unsigned* bar, volatile LAS unsigned* st) {
    XcdBarrier b; b.bar = bar; b.x = xb_xcc_id(); b.st = st;
    if (threadIdx.x == 0) (void)xb_add(&bar[XB_XCNT(b.x)], 1u);
    return b;
}
__device__ __forceinline__ void xcd_barrier_complete(unsigned* bar, unsigned x, unsigned& nloc, unsigned& nx) {
    const unsigned G = gridDim.x * gridDim.y * gridDim.z;
    unsigned sum, cnt, mine, sp = 0u;
    for (;;) {
        sum = 0u; cnt = 0u; mine = 0u;
#pragma unroll
        for (unsigned j = 0; j < 16; ++j) { const unsigned c = xb_ld(&bar[XB_XCNT(j)]); sum += c; cnt += (c > 0u) ? 1u : 0u; mine = (j == x) ? c : mine; }
        if (sum == G) break;
        __builtin_amdgcn_s_sleep(1);
        if ((++sp & 255u) == 0u) { if (xb_ld(&bar[XB_TMO])) break; if (sp > XB_SPIN_CAP) { atomicAdd(&bar[XB_TMO], 1u); break; } }
    }
    nloc = mine > 0u ? mine : 1u; nx = cnt > 0u ? cnt : 1u;
}

__device__ __forceinline__ void xcd_barrier(const XcdBarrier& b) {
    asm volatile("s_waitcnt vmcnt(0)" ::: "memory");
    __syncthreads();
    if (threadIdx.x == 0) {
        unsigned* bar = b.bar;
        __builtin_amdgcn_s_waitcnt(0);
        unsigned nloc = b.st[0], nx = b.st[1];
        if (nloc == 0u) { xcd_barrier_complete(bar, b.x, nloc, nx); b.st[0] = nloc; b.st[1] = nx; }
        const unsigned old = xb_add(&bar[XB_XSUB(b.x)], 1u);
        const unsigned gen = old / nloc;
        if (old + 1u == (gen + 1u) * nloc) {
            __builtin_amdgcn_fence(__ATOMIC_RELEASE, "agent");
            asm volatile("s_waitcnt vmcnt(0)" ::: "memory");
            const unsigned og = xb_add(&bar[XB_TOP], 1u);
            const unsigned tg = og / nx;
            if (og + 1u == (tg + 1u) * nx) xb_add(&bar[XB_TOPGEN], 1u);
            else XB_SPIN(xb_ld(&bar[XB_TOPGEN]) == tg, bar);
            __builtin_amdgcn_fence(__ATOMIC_ACQUIRE, "agent");
            xb_add(&bar[XB_XGEN(b.x)], 1u);
            asm volatile("s_waitcnt vmcnt(0)" ::: "memory");
        } else {
            XB_SPIN(xb_ld(&bar[XB_XGEN(b.x)]) == gen, bar);
            __builtin_amdgcn_fence(__ATOMIC_ACQUIRE, "agent");
            asm volatile("s_waitcnt vmcnt(0)" ::: "memory");
        }
    }
    __syncthreads();
}

__device__ __forceinline__ float wave_sum(float v) {
#pragma unroll
    for (int o = 1; o < 64; o <<= 1) v += __shfl_xor(v, o);
    return v;
}
__device__ __forceinline__ float log_sigmoid_f(float x) { return fminf(x, 0.f) - log1pf(expf(-fabsf(x))); }
__device__ __forceinline__ float silu_f(float x) { return x / (1.0f + expf(-x)); }
__device__ __forceinline__ float sigmoid_f(float x) { return 1.0f / (1.0f + expf(-x)); }
__device__ __forceinline__ pg8::bf16x8 ldfrag(const LAS bf16* base, int stride, int r0, int k0, int lane) {
    return *(const LAS pg8::bf16x8*)(base + (r0 + (lane & 15)) * stride + k0 + 8 * (lane >> 4));
}

struct Args {
    const float* x; const float* c; const int* pos; const float* w_mod; const float* b_mod; const float* norm1_w; const float* w_in; const float* gla_wa2; const float* gla_ba2; const float* hg_lb;
    const float* gla_norm_w; const float* hg_norm_w; const float* w_out; const float* norm2_w; const float* w_r; const float* b_r; const float* w_gu; const float* b_gu; const float* w_dn; const float* b_dn;
    const float* final_norm_w; float* out; unsigned char* ws; int ph_lo, ph_hi;
};

__device__ __forceinline__ void transpose_block64(const float* src, int ld, bf16* dst, LAS float* scr, int lane) {
    const int r = lane >> 4, c4 = (lane & 15) * 4;
    f32x4 v[16];
#pragma unroll
    for (int i = 0; i < 16; ++i) v[i] = *(const f32x4*)(src + (size_t)(4 * i + r) * ld + c4);
#pragma unroll
    for (int i = 0; i < 16; ++i) { LAS float* w = scr + (4 * i + r) * 65 + c4; w[0] = v[i][0]; w[1] = v[i][1]; w[2] = v[i][2]; w[3] = v[i][3]; }
    LDS_WAIT(); asm volatile("" ::: "memory");
    const int kc = lane & 7;
#pragma unroll
    for (int jj = 0; jj < 8; ++jj) { const int n = (lane >> 3) + 8 * jj; const LAS float* s = scr + (8 * kc) * 65 + n;
        v4u o; o.x = pk2(s[0 * 65], s[1 * 65]); o.y = pk2(s[2 * 65], s[3 * 65]); o.z = pk2(s[4 * 65], s[5 * 65]); o.w = pk2(s[6 * 65], s[7 * 65]);
        *(GAS v4u*)(dst + (size_t)n * D + 8 * kc) = o; }
    LDS_WAIT(); asm volatile("" ::: "memory");
}
constexpr int IT_IN = 16 * (NPROJ / 64), IT_OUT = 16 * 16, IT_GU = NE * 16 * 32, IT_DN = NE * 16 * 16, IT_LAYER = IT_IN + IT_OUT + IT_GU + IT_DN, IT_ALL = DEPTH * IT_LAYER;
__device__ __forceinline__ void p0_prologue(const Args& a, LAS unsigned char* lds, int vcu, int G, int tid, int lane, int wave) {
    unsigned char* ws = a.ws;
    bf16* WIN = (bf16*)(ws + WS_WIN); bf16* WOUT = (bf16*)(ws + WS_WOUT); bf16* WGU = (bf16*)(ws + WS_WGU); bf16* WDN = (bf16*)(ws + WS_WDN);
    LAS float* scr = (LAS float*)(lds + wave * 16640);
    const int gw = vcu * NWAVES + wave, NGW = G * NWAVES;
    for (int it = gw; it < IT_ALL; it += NGW) {
        const int l = it / IT_LAYER; int r = it - l * IT_LAYER;
        if (r < IT_IN) { const int kb = r / (NPROJ / 64), nb = r % (NPROJ / 64), n0 = 64 * nb, sc = n0 + (n0 >= SRC_GA ? 16 : 0);
            transpose_block64(a.w_in + ((size_t)l * D + 64 * kb) * DIN + sc, DIN, WIN + ((size_t)l * NPROJ + n0) * D + 64 * kb, scr, lane); continue; }
        r -= IT_IN;
        if (r < IT_OUT) { const int kb = r / 16, nb = r % 16;
            transpose_block64(a.w_out + ((size_t)l * D + 64 * kb) * D + 64 * nb, D, WOUT + ((size_t)l * D + 64 * nb) * D + 64 * kb, scr, lane); continue; }
        r -= IT_OUT;
        if (r < IT_GU) { const int e = r / 512, r2 = r % 512, kb = r2 / 32, nb = r2 % 32, cc = 64 * nb;
            const int row = (cc < 1024) ? 256 * (cc / 128) + (cc % 128) : 256 * ((cc - 1024) / 128) + 128 + ((cc - 1024) % 128);
            transpose_block64(a.w_gu + (((size_t)l * NE + e) * D + 64 * kb) * 2048 + cc, 2048, WGU + (((size_t)l * NE + e) * 2048 + row) * D + 64 * kb, scr, lane); continue; }
        r -= IT_GU;
        { const int e = r / 256, r2 = r % 256, kb = r2 / 16, nb = r2 % 16;
            transpose_block64(a.w_dn + (((size_t)l * NE + e) * FFN + 64 * kb) * D + 64 * nb, D, WDN + (((size_t)l * NE + e) * D + 64 * nb) * D + 64 * kb, scr, lane); }
    }
    __syncthreads();
    {
        LAS float* cact = (LAS float*)lds;
        LAS float* red = (LAS float*)(lds + 8192);
        for (int i = tid; i < 2 * D; i += NTHR) cact[i] = silu_f(a.c[i]);
        __syncthreads();
        float* MOD = (float*)(ws + WS_MOD);
        for (int it = vcu; it < DEPTH * 96; it += G) {
            const int l = it / 96, n0 = (it % 96) * 64;
            const float* wp = a.w_mod + ((size_t)l * D + 128 * wave) * 6144 + n0 + lane;
            float a0 = 0.f, a1 = 0.f;
#pragma unroll 8
            for (int k = 0; k < 128; ++k) { const float w = wp[(size_t)k * 6144]; a0 += cact[128 * wave + k] * w; a1 += cact[D + 128 * wave + k] * w; }
            red[(wave * 2 + 0) * 64 + lane] = a0; red[(wave * 2 + 1) * 64 + lane] = a1;
            __syncthreads();
            if (tid < 128) { const int b = tid >> 6, ln = tid & 63; float s = a.b_mod[l * 6144 + n0 + ln];
#pragma unroll
                for (int w = 0; w < 8; ++w) s += red[(w * 2 + b) * 64 + ln];
                MOD[((size_t)l * 2 + b) * 6144 + n0 + ln] = s; }
            __syncthreads();
        }
    }
    {
        float* ROPE = (float*)(ws + WS_ROPE);
        for (int i = vcu * NTHR + tid; i < MTOK * 24; i += G * NTHR) { const int t = i / 24, f = i % 24;
            const float inv = (float)pow(10000.0, -(double)f / 24.0); const float ang = (float)a.pos[t] * inv;
            ROPE[(size_t)t * 48 + f] = cosf(ang); ROPE[(size_t)t * 48 + 24 + f] = sinf(ang); }
    }
    if (vcu == 0 && tid < 256) {
        float v[4], mx = -3.0e38f; for (int l = 0; l < 4; ++l) { v[l] = a.hg_lb[l * 256 + tid]; mx = fmaxf(mx, v[l]); }
        float s = 0.f; for (int l = 0; l < 4; ++l) { v[l] = expf(v[l] - mx); s += v[l]; }
        float* LB = (float*)(ws + WS_LB); float cs = 0.f, first = 0.f;
        for (int l = 0; l < 4; ++l) { cs += v[l] / s; if (l == 0) first = cs; LB[l * 256 + tid] = cs - first; }
    }
}

__device__ __forceinline__ void moe_combine_row(f32x4 (&v)[4], int m, const bf16* Y, const int* SLOT, const float* TOPW, const float* g2, int lane) {
    const int4 sl = *(const int4*)(SLOT + (size_t)m * 4); const f32x4 tw = *(const f32x4*)(TOPW + (size_t)m * 4);
    const int s[4] = {sl.x, sl.y, sl.z, sl.w};
    f32x4 acc[4];
#pragma unroll
    for (int j = 0; j < 4; ++j) acc[j] = (f32x4){0.f, 0.f, 0.f, 0.f};
#pragma unroll
    for (int k = 0; k < 4; ++k) { const bf16* yr = Y + (size_t)s[k] * D + 4 * lane; const float w = tw[k];
#pragma unroll
        for (int j = 0; j < 4; ++j) { const uint2 p = *(const uint2*)(yr + 256 * j);
            acc[j][0] += w * __builtin_bit_cast(float, p.x << 16); acc[j][1] += w * __builtin_bit_cast(float, p.x & 0xffff0000u);
            acc[j][2] += w * __builtin_bit_cast(float, p.y << 16); acc[j][3] += w * __builtin_bit_cast(float, p.y & 0xffff0000u); } }
#pragma unroll
    for (int j = 0; j < 4; ++j) { const f32x4 g = *(const f32x4*)(g2 + 4 * lane + 256 * j); v[j] = v[j] + g * acc[j]; }
}
__device__ __forceinline__ float row_rstd(const f32x4 (&v)[4]) {
    float s = 0.f;
#pragma unroll
    for (int j = 0; j < 4; ++j) s += (v[j][0] * v[j][0] + v[j][1] * v[j][1]) + (v[j][2] * v[j][2] + v[j][3] * v[j][3]);
    return 1.0f / sqrtf(wave_sum(s) * (1.0f / D) + EPS);
}
__device__ __forceinline__ void modulate_row(f32x4 (&v)[4], float rstd, const float* nw, const float* sc, const float* sh, bf16* hrow, int lane) {
#pragma unroll
    for (int j = 0; j < 4; ++j) { const int c0 = 4 * lane + 256 * j; const f32x4 w = *(const f32x4*)(nw + c0), s1 = *(const f32x4*)(sc + c0), s0 = *(const f32x4*)(sh + c0);
        v[j] = v[j] * rstd * w * (s1 + 1.0f) + s0;
        uint2 p; p.x = pk2(v[j][0], v[j][1]); p.y = pk2(v[j][2], v[j][3]); *(uint2*)(hrow + c0) = p; }
}

__device__ __forceinline__ void p1_rows(const Args& a, int layer, LAS unsigned char* lds, int vcu, int G, int tid, int lane, int wave) {
    unsigned char* ws = a.ws;
    float* X = (float*)(ws + WS_X); bf16* H = (bf16*)(ws + WS_H); float* GA = (float*)(ws + WS_GA); const float* MOD = (const float*)(ws + WS_MOD);
    LAS float* gaw = (LAS float*)lds;
    for (int i = tid; i < D * 16; i += NTHR) { const int k = i >> 4, r = i & 15; const int p = ((k >> 8) * 4 + (k & 3)) * 64 + ((k >> 2) & 63);
        gaw[p * 20 + r] = a.w_in[((size_t)layer * D + k) * DIN + SRC_GA + r]; }
    __syncthreads();
    const float* xin = (layer == 0) ? a.x : X;
    const float* n1w = a.norm1_w + layer * D;
    for (int m = (vcu * NWAVES + wave); m < MTOK; m += G * NWAVES) {
        const int b = m / SEQ; f32x4 v[4];
#pragma unroll
        for (int j = 0; j < 4; ++j) v[j] = *(const f32x4*)(xin + (size_t)m * D + 4 * lane + 256 * j);
        if (layer > 0) {
            moe_combine_row(v, m, (const bf16*)(ws + WS_Y), (const int*)(ws + WS_SLOT), (const float*)(ws + WS_TOPW), MOD + ((size_t)(layer - 1) * 2 + b) * 6144 + 5 * D, lane);
#pragma unroll
            for (int j = 0; j < 4; ++j) *(f32x4*)(X + (size_t)m * D + 4 * lane + 256 * j) = v[j];
        }
        const float rstd = row_rstd(v);
        const float* mp = MOD + ((size_t)layer * 2 + b) * 6144;
        modulate_row(v, rstd, n1w, mp + 1 * D, mp + 0 * D, H + (size_t)m * D, lane);
        float g[16];
#pragma unroll
        for (int r = 0; r < 16; ++r) g[r] = 0.f;
#pragma unroll
        for (int j = 0; j < 4; ++j)
#pragma unroll
            for (int c = 0; c < 4; ++c) { const LAS f32x4* wp = (const LAS f32x4*)(gaw + ((j * 4 + c) * 64 + lane) * 20); const float hv = v[j][c];
#pragma unroll
                for (int q = 0; q < 4; ++q) { const f32x4 w = wp[q]; g[4 * q + 0] += hv * w[0]; g[4 * q + 1] += hv * w[1]; g[4 * q + 2] += hv * w[2]; g[4 * q + 3] += hv * w[3]; }
                if (c & 1) asm volatile("" ::: "memory"); }
        float mine = 0.f;
#pragma unroll
        for (int r = 0; r < 16; ++r) { const float s = wave_sum(g[r]); mine = (lane == r) ? s : mine; }
        if (lane < 16) GA[(size_t)m * 16 + lane] = mine;
    }
}

__device__ __forceinline__ void p5_rows(const Args& a, int layer, LAS unsigned char* lds, volatile LAS unsigned* MISC, gu32* ctl, int vcu, int G, int tid, int lane, int wave) {
    unsigned char* ws = a.ws;
    const float* X = (const float*)(ws + WS_X); bf16* H = (bf16*)(ws + WS_H); const float* MOD = (const float*)(ws + WS_MOD);
    int* TOPE = (int*)(ws + WS_TOPE); float* TOPW = (float*)(ws + WS_TOPW);
    LAS float* rw = (LAS float*)lds;
    for (int i = tid; i < D * NE; i += NTHR) { const int k = i >> 5, e = i & 31; const int p = ((k >> 8) * 4 + (k & 3)) * 64 + ((k >> 2) & 63);
        rw[p * 36 + e] = a.w_r[((size_t)layer * D + k) * NE + e]; }
    if (tid < NE) MISC[MW_HIST + tid] = 0u;
    __syncthreads();
    const float* n2w = a.norm2_w + layer * D;
    const float br = (lane < NE) ? a.b_r[layer * NE + lane] : 0.f;
    for (int m = (vcu * NWAVES + wave); m < MTOK; m += G * NWAVES) {
        const int b = m / SEQ; f32x4 v[4];
#pragma unroll
        for (int j = 0; j < 4; ++j) v[j] = *(const f32x4*)(X + (size_t)m * D + 4 * lane + 256 * j);
        const float rstd = row_rstd(v);
        const float* mp = MOD + ((size_t)layer * 2 + b) * 6144;
        modulate_row(v, rstd, n2w, mp + 4 * D, mp + 3 * D, H + (size_t)m * D, lane);
        float g[NE];
#pragma unroll
        for (int e = 0; e < NE; ++e) g[e] = 0.f;
#pragma unroll
        for (int j = 0; j < 4; ++j)
#pragma unroll
            for (int c = 0; c < 4; ++c) { const LAS f32x4* wp = (const LAS f32x4*)(rw + ((j * 4 + c) * 64 + lane) * 36); const float hv = v[j][c];
#pragma unroll
                for (int q = 0; q < 8; ++q) { const f32x4 w = wp[q]; g[4 * q + 0] += hv * w[0]; g[4 * q + 1] += hv * w[1]; g[4 * q + 2] += hv * w[2]; g[4 * q + 3] += hv * w[3]; }
                asm volatile("" ::: "memory"); }
        float logit = -3.0e38f;
#pragma unroll
        for (int e = 0; e < NE; ++e) { const float s = wave_sum(g[e]); logit = (lane == e) ? s + br : logit; }
        float tv[4]; int te[4];
#pragma unroll
        for (int r = 0; r < 4; ++r) {
            float mx = logit;
#pragma unroll
            for (int o = 1; o < 64; o <<= 1) mx = fmaxf(mx, __shfl_xor(mx, o));
            const unsigned long long bal = __ballot(logit == mx && lane < NE);
            const int idx = __ffsll((long long)bal) - 1;
            tv[r] = mx; te[r] = idx; if (lane == idx) logit = -3.0e38f;
        }
        const float e1 = expf(tv[1] - tv[0]), e2 = expf(tv[2] - tv[0]), e3 = expf(tv[3] - tv[0]); const float inv = 1.0f / (1.0f + e1 + e2 + e3);
        if (lane == 0) { *(int4*)(TOPE + (size_t)m * 4) = make_int4(te[0], te[1], te[2], te[3]); *(f32x4*)(TOPW + (size_t)m * 4) = (f32x4){inv, e1 * inv, e2 * inv, e3 * inv}; }
        if (lane < 4) { const int ee = (lane == 0) ? te[0] : (lane == 1) ? te[1] : (lane == 2) ? te[2] : te[3]; __hip_atomic_fetch_add((LAS unsigned*)&MISC[MW_HIST + ee], 1u, __ATOMIC_RELAXED, __HIP_MEMORY_SCOPE_WORKGROUP); }
    }
    __syncthreads();
    if (tid < NE) { const unsigned h = MISC[MW_HIST + tid]; if (h) atomicAdd((unsigned*)(ctl + CW_CNT + layer * NE + tid), h); }
}

__device__ __forceinline__ void final_rows(const Args& a, int vcu, int G, int lane, int wave) {
    unsigned char* ws = a.ws; const float* X = (const float*)(ws + WS_X); const float* MOD = (const float*)(ws + WS_MOD);
    for (int m = (vcu * NWAVES + wave); m < MTOK; m += G * NWAVES) {
        const int b = m / SEQ; f32x4 v[4];
#pragma unroll
        for (int j = 0; j < 4; ++j) v[j] = *(const f32x4*)(X + (size_t)m * D + 4 * lane + 256 * j);
        moe_combine_row(v, m, (const bf16*)(ws + WS_Y), (const int*)(ws + WS_SLOT), (const float*)(ws + WS_TOPW), MOD + ((size_t)(DEPTH - 1) * 2 + b) * 6144 + 5 * D, lane);
        const float rstd = row_rstd(v);
#pragma unroll
        for (int j = 0; j < 4; ++j) { const int c0 = 4 * lane + 256 * j; const f32x4 w = *(const f32x4*)(a.final_norm_w + c0); *(f32x4*)(a.out + (size_t)m * D + c0) = v[j] * rstd * w; }
    }
}

__device__ __noinline__ void moe_tables(gu32* ctl, int layer, volatile LAS unsigned* MISC, int tid) {
    if (tid < NE) MISC[MW_CNT + tid] = __hip_atomic_load(ctl + CW_CNT + layer * NE + tid, RLX_AGENT);
    __syncthreads();
    if (tid == 0) { unsigned p = 0;
        for (int e = 0; e < NE; ++e) { MISC[MW_PST + e] = p; const unsigned nt = (MISC[MW_CNT + e] + 255u) >> 8; for (unsigned t = 0; t < nt; ++t) MISC[MW_TILE + (p >> 8) + t] = (unsigned)e; p += nt << 8; }
        MISC[MW_PST + NE] = p; MISC[MW_NRT] = p >> 8; }
    __syncthreads();
}
__device__ __forceinline__ void p6_dispatch(const Args& a, int layer, volatile LAS unsigned* MISC, gu32* ctl, int vcu, int G, int tid, int lane, int wave) {
    unsigned char* ws = a.ws; const int* TOPE = (const int*)(ws + WS_TOPE); int* SLOT = (int*)(ws + WS_SLOT); const bf16* H = (const bf16*)(ws + WS_H); bf16* A1 = (bf16*)(ws + WS_A1);
    moe_tables(ctl, layer, MISC, tid);
    for (int t0 = vcu * 64; t0 < MTOK; t0 += G * 64) {
        if (tid < NE) MISC[MW_HIST + tid] = 0u;
        __syncthreads();
        int e = 0; unsigned r = 0;
        if (tid < 256) { e = TOPE[(size_t)t0 * 4 + tid]; r = __hip_atomic_fetch_add((LAS unsigned*)&MISC[MW_HIST + e], 1u, __ATOMIC_RELAXED, __HIP_MEMORY_SCOPE_WORKGROUP); }
        __syncthreads();
        if (tid < NE) { const unsigned h = MISC[MW_HIST + tid]; MISC[MW_BASE + tid] = h ? atomicAdd((unsigned*)(ctl + CW_FILL + layer * NE + tid), h) : 0u; }
        __syncthreads();
        if (tid < 256) { const int slot = (int)(MISC[MW_PST + e] + MISC[MW_BASE + e] + r); SLOT[(size_t)t0 * 4 + tid] = slot; MISC[MW_SLOTS + tid] = (unsigned)slot; }
        __syncthreads();
        for (int i = wave * 32; i < wave * 32 + 32; ++i) { const int slot = (int)MISC[MW_SLOTS + i]; const int t = t0 + (i >> 2);
            const v4u* src = (const v4u*)(H + (size_t)t * D); v4u* dst = (v4u*)(A1 + (size_t)slot * D);
            dst[lane] = src[lane]; dst[lane + 64] = src[lane + 64]; }
        __syncthreads();
    }
}

constexpr int L_QS = 0, L_KS = 16640, L_GS = 33280, L_OS = 0  , L_VT = 49920, L_KT = 63744, L_QT = 72960, L_AM = 82176, L_ST = 91392, L_GA = 105216, L_WA = 109312;
constexpr int FP = 65, BP = 72, OP = 97;
template <int TYPE> struct MixCfg { static constexpr int DK = (TYPE == 1) ? 64 : 48, DV = (TYPE == 1) ? 64 : 96; };

template <int TYPE, bool NEEDQ>
__device__ __forceinline__ void mix_load(const Args& a, int layer, int h, int row0, LAS unsigned char* lds, int tid, int lane, int wave) {
    constexpr int DK = MixCfg<TYPE>::DK, DV = MixCfg<TYPE>::DV;
    unsigned char* ws = a.ws; const bf16* PROJ = (const bf16*)(ws + WS_PROJ);
    LAS float* Qs = (LAS float*)(lds + L_QS); LAS float* Ks = (LAS float*)(lds + L_KS); LAS float* Gs = (LAS float*)(lds + L_GS); LAS bf16* VT = (LAS bf16*)(lds + L_VT);
    const LAS float* GAs = (const LAS float*)(lds + L_GA); const LAS float* WAs = (const LAS float*)(lds + L_WA);
    for (int idx = tid; idx < CH * DK; idx += NTHR) { const int t = idx / DK, d = idx - t * DK; const bf16* pr = PROJ + (size_t)(row0 + t) * NPROJ;
        float q = 0.f, k, g;
        if constexpr (TYPE == 0) {
            k = bf2f(pr[C_GK + h * 48 + d]); if (NEEDQ) q = bf2f(pr[C_GQ + h * 48 + d]) * 0.14433756729740643f;
            float pre = a.gla_ba2[layer * 192 + h * 48 + d];
#pragma unroll
            for (int r = 0; r < 16; ++r) pre += GAs[t * 16 + r] * WAs[r * 192 + h * 48 + d];
            g = log_sigmoid_f(pre) * (1.0f / 16.0f);
        } else if constexpr (TYPE == 1) {
            const float hf = bf2f(pr[C_HF + h * 64 + d]); const float ls = log_sigmoid_f(hf); const float lbv = ((const float*)(ws + WS_LB))[layer * 256 + h * 64 + d];
            const float la = logf(lbv), lb2 = log1pf(-lbv) + ls;
            const float mx = fmaxf(la, lb2); g = mx + log1pf(expf(-fabsf(la - lb2)));
            k = -expm1f(g); if (NEEDQ) q = bf2f(pr[C_HQ + h * 64 + d]);
        } else {
            const float* rp = (const float*)(ws + WS_ROPE) + (size_t)(row0 + t) * 48; const int f = (d < 24) ? d : d - 24; const float cs = rp[f], sn = rp[24 + f];
            const int d2 = (d < 24) ? d + 24 : d - 24; const float sg = (d < 24) ? -1.f : 1.f;
            k = bf2f(pr[C_RK + h * 48 + d]) * cs + sg * bf2f(pr[C_RK + h * 48 + d2]) * sn;
            if (NEEDQ) q = (bf2f(pr[C_RQ + h * 48 + d]) * cs + sg * bf2f(pr[C_RQ + h * 48 + d2]) * sn) * 0.14433756729740643f;
            g = logf(1.0f - exp2f(-5.0f - (float)h));
        }
        if (NEEDQ) Qs[t * FP + d] = q;
        Ks[t * FP + d] = k; Gs[t * FP + d] = g; }
    constexpr int CV = (TYPE == 0) ? C_GV : (TYPE == 1) ? C_HI : C_RV;
    for (int idx = tid; idx < CH * DV; idx += NTHR) { const int j = idx / DV, e = idx - j * DV; VT[e * BP + j] = PROJ[(size_t)(row0 + j) * NPROJ + CV + h * DV + e]; }
    __syncthreads();
    for (int d = wave; d < DK; d += NWAVES) { float v = Gs[lane * FP + d];
#pragma unroll
        for (int o = 1; o < 64; o <<= 1) { const float t = __shfl_up(v, o); if (lane >= o) v += t; }
        Gs[lane * FP + d] = v; }
    __syncthreads();
}

template <int TYPE>
__device__ __forceinline__ void mix_summary_head(const Args& a, int layer, int h, int unit, LAS unsigned char* lds, int tid, int lane, int wave) {
    constexpr int DK = MixCfg<TYPE>::DK, DV = MixCfg<TYPE>::DV, STOFF = (TYPE == 0) ? ST_GLA : (TYPE == 1) ? ST_HG : ST_RET;
    unsigned char* ws = a.ws; float* U = (float*)(ws + WS_U) + (size_t)unit * ST_TOT + STOFF + h * DK * DV; float* DVEC = (float*)(ws + WS_DVEC) + (size_t)unit * NDV;
    const int row0 = unit * CH;
    mix_load<TYPE, false>(a, layer, h, row0, lds, tid, lane, wave);
    const LAS float* Ks = (const LAS float*)(lds + L_KS); const LAS float* Gs = (const LAS float*)(lds + L_GS); LAS bf16* VT = (LAS bf16*)(lds + L_VT); LAS bf16* KT = (LAS bf16*)(lds + L_KT);
    for (int idx = tid; idx < CH * DK; idx += NTHR) { const int d = idx >> 6, j = idx & 63; KT[d * BP + j] = (bf16)f2bf(Ks[j * FP + d] * __expf(Gs[63 * FP + d] - Gs[j * FP + d])); }
    if (TYPE != 2 && tid < DK) DVEC[(TYPE == 0 ? 0 : 192) + h * DK + tid] = expf(Gs[63 * FP + tid]);
    __syncthreads();
    constexpr int TD = DK / 16, NT = (DV / 16) * TD;
    for (int ti = wave; ti < NT; ti += NWAVES) { const int te = ti / TD, td = ti - te * TD; f32x4 acc = {0.f, 0.f, 0.f, 0.f};
#pragma unroll
        for (int kk = 0; kk < 2; ++kk) acc = __builtin_amdgcn_mfma_f32_16x16x32_bf16(ldfrag(VT, BP, te * 16, kk * 32, lane), ldfrag(KT, BP, td * 16, kk * 32, lane), acc, 0, 0, 0);
#pragma unroll
        for (int r = 0; r < 4; ++r) U[(te * 16 + (lane >> 4) * 4 + r) * DK + td * 16 + (lane & 15)] = acc[r]; }
    __syncthreads();
}
__device__ __forceinline__ void mix_stage_ga(const Args& a, int layer, int row0, LAS unsigned char* lds, int tid) {
    LAS float* GAs = (LAS float*)(lds + L_GA); LAS float* WAs = (LAS float*)(lds + L_WA); const float* GA = (const float*)(a.ws + WS_GA);
    for (int i = tid; i < CH * 16; i += NTHR) GAs[i] = GA[(size_t)row0 * 16 + i];
    for (int i = tid; i < 16 * 192; i += NTHR) WAs[i] = a.gla_wa2[layer * 16 * 192 + i];
    __syncthreads();
}
__device__ __forceinline__ void p3a_summaries(const Args& a, int layer, LAS unsigned char* lds, int vcu, int G, int tid, int lane, int wave) {
    for (int unit = vcu; unit < NUNIT; unit += G) {
        mix_stage_ga(a, layer, unit * CH, lds, tid);
        for (int h = 0; h < 4; ++h) mix_summary_head<0>(a, layer, h, unit, lds, tid, lane, wave);
        for (int h = 0; h < 4; ++h) mix_summary_head<1>(a, layer, h, unit, lds, tid, lane, wave);
        for (int h = 0; h < 4; ++h) mix_summary_head<2>(a, layer, h, unit, lds, tid, lane, wave);
    }
}

__device__ __forceinline__ void p3b_scan(const Args& a, int vcu, int G, int tid) {
    unsigned char* ws = a.ws; const float* U = (const float*)(ws + WS_U); const float* DVEC = (const float*)(ws + WS_DVEC); bf16* SP = (bf16*)(ws + WS_SP);
    for (int gid = vcu * NTHR + tid; gid < BATCH * ST_TOT; gid += G * NTHR) {
        const int b = gid / ST_TOT, el = gid - b * ST_TOT;
        int di = -1; float cdec = 0.f;
        if (el < ST_HG) { const int h = el / 4608, d = (el - h * 4608) % 48; di = h * 48 + d; }
        else if (el < ST_RET) { const int r = el - ST_HG, h = r / 4096, d = r % 64; di = 192 + h * 64 + d; }
        else { const int h = (el - ST_RET) / 4608; cdec = expf(64.0f * logf(1.0f - exp2f(-5.0f - (float)h))); }
        const float* up = U + (size_t)b * NCH * ST_TOT + el; const float* dp = DVEC + (size_t)b * NCH * NDV + (di < 0 ? 0 : di); bf16* sp = SP + (size_t)b * NCH * ST_TOT + el;
        float s = 0.f;
        for (int n0 = 0; n0 < NCH; n0 += 8) { float u[8], dc[8];
#pragma unroll
            for (int i = 0; i < 8; ++i) { u[i] = up[(size_t)(n0 + i) * ST_TOT]; dc[i] = (di < 0) ? cdec : dp[(size_t)(n0 + i) * NDV]; }
#pragma unroll
            for (int i = 0; i < 8; ++i) { sp[(size_t)(n0 + i) * ST_TOT] = (bf16)f2bf(s); s = dc[i] * s + u[i]; } }
    }
}

template <int TYPE>
__device__ __forceinline__ void mix_output_head(const Args& a, int layer, int h, int unit, LAS unsigned char* lds, int tid, int lane, int wave) {
    constexpr int DK = MixCfg<TYPE>::DK, DV = MixCfg<TYPE>::DV, STOFF = (TYPE == 0) ? ST_GLA : (TYPE == 1) ? ST_HG : ST_RET;
    unsigned char* ws = a.ws; const bf16* SPp = (const bf16*)(ws + WS_SP) + (size_t)unit * ST_TOT + STOFF + h * DK * DV; const bf16* PROJ = (const bf16*)(ws + WS_PROJ); bf16* MIX = (bf16*)(ws + WS_MIX);
    const int row0 = unit * CH;
    mix_load<TYPE, true>(a, layer, h, row0, lds, tid, lane, wave);
    const LAS float* Qs = (const LAS float*)(lds + L_QS); const LAS float* Ks = (const LAS float*)(lds + L_KS); const LAS float* Gs = (const LAS float*)(lds + L_GS);
    LAS bf16* VT = (LAS bf16*)(lds + L_VT); LAS bf16* QT = (LAS bf16*)(lds + L_QT); LAS bf16* AM = (LAS bf16*)(lds + L_AM); LAS bf16* ST = (LAS bf16*)(lds + L_ST); LAS float* Os = (LAS float*)(lds + L_OS);
    {
        const int bi = tid >> 5, bj = tid & 31; float acc[4][2];
#pragma unroll
        for (int x = 0; x < 4; ++x) { acc[x][0] = 0.f; acc[x][1] = 0.f; }
        if (2 * bj <= 4 * bi + 3) {
#pragma unroll 2
            for (int d = 0; d < DK; ++d) { float qv[4], ci[4], kv[2], cj[2];
#pragma unroll
                for (int x = 0; x < 4; ++x) { qv[x] = Qs[(4 * bi + x) * FP + d]; ci[x] = Gs[(4 * bi + x) * FP + d]; }
#pragma unroll
                for (int y = 0; y < 2; ++y) { kv[y] = Ks[(2 * bj + y) * FP + d]; cj[y] = Gs[(2 * bj + y) * FP + d]; }
#pragma unroll
                for (int x = 0; x < 4; ++x)
#pragma unroll
                    for (int y = 0; y < 2; ++y) acc[x][y] += qv[x] * kv[y] * __expf(fminf(ci[x] - cj[y], 0.f)); }
        }
#pragma unroll
        for (int x = 0; x < 4; ++x) { const int i = 4 * bi + x; const float v0 = (2 * bj <= i) ? acc[x][0] : 0.f, v1 = (2 * bj + 1 <= i) ? acc[x][1] : 0.f; *(LAS unsigned*)(AM + i * BP + 2 * bj) = pk2(v0, v1); }
    }
    for (int idx = tid; idx < CH * 64; idx += NTHR) { const int i = idx >> 6, d = idx & 63; QT[i * BP + d] = (d < DK) ? (bf16)f2bf(Qs[i * FP + d] * __expf(Gs[i * FP + d])) : (bf16)0; }
    for (int idx = tid; idx < DV * 64; idx += NTHR) { const int e = idx >> 6, d = idx & 63; ST[e * BP + d] = (d < DK) ? SPp[e * DK + d] : (bf16)0; }
    __syncthreads();
    constexpr int TE = DV / 16, NT = 4 * TE, NIT = NT / NWAVES; static_assert(NT % NWAVES == 0, "tiles per wave");
    f32x4 accs[NIT];
#pragma unroll
    for (int it = 0; it < NIT; ++it) { const int ti = wave + NWAVES * it, tr = ti / TE, te = ti - tr * TE; f32x4 acc = {0.f, 0.f, 0.f, 0.f};
#pragma unroll
        for (int kk = 0; kk < 2; ++kk) acc = __builtin_amdgcn_mfma_f32_16x16x32_bf16(ldfrag(QT, BP, tr * 16, kk * 32, lane), ldfrag(ST, BP, te * 16, kk * 32, lane), acc, 0, 0, 0);
#pragma unroll
        for (int kk = 0; kk < 2; ++kk) acc = __builtin_amdgcn_mfma_f32_16x16x32_bf16(ldfrag(AM, BP, tr * 16, kk * 32, lane), ldfrag(VT, BP, te * 16, kk * 32, lane), acc, 0, 0, 0);
        accs[it] = acc; }
    __syncthreads();
#pragma unroll
    for (int it = 0; it < NIT; ++it) { const int ti = wave + NWAVES * it, tr = ti / TE, te = ti - tr * TE; const f32x4 acc = accs[it];
#pragma unroll
        for (int r = 0; r < 4; ++r) Os[(tr * 16 + (lane >> 4) * 4 + r) * OP + te * 16 + (lane & 15)] = acc[r]; }
    __syncthreads();
    {
        const int row = tid >> 3, sub = tid & 7; constexpr int NEL = DV / 8; float o[NEL]; float s1 = 0.f, s2 = 0.f;
#pragma unroll
        for (int m = 0; m < NEL; ++m) { o[m] = Os[row * OP + sub + 8 * m]; s1 += o[m]; s2 += o[m] * o[m]; }
#pragma unroll
        for (int x = 1; x < 8; x <<= 1) { s1 += __shfl_xor(s1, x); s2 += __shfl_xor(s2, x); }
        const bf16* pr = PROJ + (size_t)(row0 + row) * NPROJ; bf16* mo = MIX + (size_t)(row0 + row) * D;
        if constexpr (TYPE == 2) { const float mean = s1 * (1.0f / DV); float var = 0.f;
#pragma unroll
            for (int m = 0; m < NEL; ++m) { const float dd = o[m] - mean; var += dd * dd; }
#pragma unroll
            for (int x = 1; x < 8; x <<= 1) var += __shfl_xor(var, x);
            const float rstd = 1.0f / sqrtf(var * (1.0f / DV) + EPS);
#pragma unroll
            for (int m = 0; m < NEL; ++m) { const int e = sub + 8 * m; mo[640 + h * 96 + e] = (bf16)f2bf((o[m] - mean) * rstd * silu_f(bf2f(pr[C_RG + h * 96 + e]))); }
        } else { const float rstd = 1.0f / sqrtf(s2 * (1.0f / DV) + EPS);
#pragma unroll
            for (int m = 0; m < NEL; ++m) { const int e = sub + 8 * m;
                if constexpr (TYPE == 0) mo[h * 96 + e] = (bf16)f2bf(o[m] * rstd * a.gla_norm_w[layer * 384 + h * 96 + e] * silu_f(bf2f(pr[C_GG + h * 96 + e])));
                else mo[384 + h * 64 + e] = (bf16)f2bf(o[m] * rstd * a.hg_norm_w[layer * 256 + h * 64 + e] * sigmoid_f(bf2f(pr[C_HG + h * 64 + e]))); }
        }
    }
    __syncthreads();
}
__device__ __forceinline__ void p3c_outputs(const Args& a, int layer, LAS unsigned char* lds, int vcu, int G, int tid, int lane, int wave) {
    for (int unit = vcu; unit < NUNIT; unit += G) {
        mix_stage_ga(a, layer, unit * CH, lds, tid);
        for (int h = 0; h < 4; ++h) mix_output_head<0>(a, layer, h, unit, lds, tid, lane, wave);
        for (int h = 0; h < 4; ++h) mix_output_head<1>(a, layer, h, unit, lds, tid, lane, wave);
        for (int h = 0; h < 4; ++h) mix_output_head<2>(a, layer, h, unit, lds, tid, lane, wave);
    }
}

constexpr int MW_ARGS = 800;
__device__ __forceinline__ const void* ld_argp(const volatile LAS unsigned* T, int i) {
    const unsigned lo = __builtin_amdgcn_readfirstlane(T[2 * i]), hi = __builtin_amdgcn_readfirstlane(T[2 * i + 1]);
    return (const void*)(((unsigned long long)hi << 32) | lo);
}
__device__ __forceinline__ Args load_args(LAS unsigned char* lds) {
    const volatile LAS unsigned* T = (const volatile LAS unsigned*)(lds + MISC_OFF) + MW_ARGS;
    Args a;
    a.x = (const float*)ld_argp(T, 0); a.c = (const float*)ld_argp(T, 1); a.pos = (const int*)ld_argp(T, 2); a.w_mod = (const float*)ld_argp(T, 3); a.b_mod = (const float*)ld_argp(T, 4);
    a.norm1_w = (const float*)ld_argp(T, 5); a.w_in = (const float*)ld_argp(T, 6); a.gla_wa2 = (const float*)ld_argp(T, 7); a.gla_ba2 = (const float*)ld_argp(T, 8); a.hg_lb = (const float*)ld_argp(T, 9);
    a.gla_norm_w = (const float*)ld_argp(T, 10); a.hg_norm_w = (const float*)ld_argp(T, 11); a.w_out = (const float*)ld_argp(T, 12); a.norm2_w = (const float*)ld_argp(T, 13); a.w_r = (const float*)ld_argp(T, 14);
    a.b_r = (const float*)ld_argp(T, 15); a.w_gu = (const float*)ld_argp(T, 16); a.b_gu = (const float*)ld_argp(T, 17); a.w_dn = (const float*)ld_argp(T, 18); a.b_dn = (const float*)ld_argp(T, 19);
    a.final_norm_w = (const float*)ld_argp(T, 20); a.out = (float*)ld_argp(T, 21); a.ws = (unsigned char*)ld_argp(T, 22); a.ph_lo = 0; a.ph_hi = 0;
    return a;
}
#define PH_CTX() { unsigned l_ = (unsigned)(size_t)lds; asm volatile("" : "+s"(l_)); lds = (LAS unsigned char*)(size_t)l_; } const Args args = load_args(lds); volatile LAS unsigned* MISC = (volatile LAS unsigned*)(lds + MISC_OFF); int tid_ = threadIdx.x; asm volatile("" : "+v"(tid_)); const int tid = tid_, lane = tid & 63, wave = __builtin_amdgcn_readfirstlane(tid >> 6); \
    const int G = gridDim.x; const int bx = blockIdx.x; const int vcu = (G % 8 == 0) ? (bx % 8) * (G / 8) + bx / 8 : bx; unsigned char* ws = args.ws; gu32* ctl = (gu32*)(ws + WS_CTL); \
    (void)MISC; (void)lane; (void)wave; (void)vcu; (void)ctl; (void)bx; (void)tid
__device__ __forceinline__ void ph_p0(LAS unsigned char* lds) { PH_CTX(); p0_prologue(args, lds, vcu, G, tid, lane, wave); }
__device__ __forceinline__ void ph_p1(LAS unsigned char* lds, int layer_) { int layer = __builtin_amdgcn_readfirstlane(layer_); asm volatile("" : "+s"(layer)); PH_CTX(); p1_rows(args, layer, lds, vcu, G, tid, lane, wave); }
__device__ __forceinline__ void ph_p2(LAS unsigned char* lds, int layer_) { int layer = __builtin_amdgcn_readfirstlane(layer_); asm volatile("" : "+s"(layer)); PH_CTX();
    pg8::Gemm g{(const bf16*)(ws + WS_H), (const bf16*)(ws + WS_WIN) + (size_t)layer * NPROJ * D, MTOK, NPROJ, D}; pg8::StaticOrder S; S.init(MTOK, NPROJ, G, bx);
    pg8::EpiBf16Plain E{(bf16*)(ws + WS_PROJ), NPROJ};
    pg8::gemm_phase<pg8::EpiBf16Plain, pg8::StaticOrder, true, true>(lds, g, S, E); }
__device__ __forceinline__ void ph_p3a(LAS unsigned char* lds, int layer_) { int layer = __builtin_amdgcn_readfirstlane(layer_); asm volatile("" : "+s"(layer)); PH_CTX(); p3a_summaries(args, layer, lds, vcu, G, tid, lane, wave); }
__device__ __forceinline__ void ph_p3b(LAS unsigned char* lds) { PH_CTX(); p3b_scan(args, vcu, G, tid); }
__device__ __forceinline__ void ph_p3c(LAS unsigned char* lds, int layer_) { int layer = __builtin_amdgcn_readfirstlane(layer_); asm volatile("" : "+s"(layer)); PH_CTX(); p3c_outputs(args, layer, lds, vcu, G, tid, lane, wave); }
__device__ __forceinline__ void ph_p4(LAS unsigned char* lds, int layer_) { int layer = __builtin_amdgcn_readfirstlane(layer_); asm volatile("" : "+s"(layer)); PH_CTX();
    pg8::Gemm g{(const bf16*)(ws + WS_MIX), (const bf16*)(ws + WS_WOUT) + (size_t)layer * D * D, MTOK, D, D}; pg8::StaticOrder S; S.init(MTOK, D, G, bx);
    pg8::EpiResGate E{(layer == 0) ? args.x : (const float*)(ws + WS_X), (float*)(ws + WS_X), D, (const float*)(ws + WS_MOD) + (size_t)layer * 2 * 6144 + 2 * D, 6144, SEQ};
    pg8::gemm_phase<pg8::EpiResGate, pg8::StaticOrder, true, true>(lds, g, S, E); }
__device__ __forceinline__ void ph_p5(LAS unsigned char* lds, int layer_) { int layer = __builtin_amdgcn_readfirstlane(layer_); asm volatile("" : "+s"(layer)); PH_CTX(); p5_rows(args, layer, lds, MISC, ctl, vcu, G, tid, lane, wave); }
__device__ __forceinline__ void ph_p6(LAS unsigned char* lds, int layer_) { int layer = __builtin_amdgcn_readfirstlane(layer_); asm volatile("" : "+s"(layer)); PH_CTX(); p6_dispatch(args, layer, MISC, ctl, vcu, G, tid, lane, wave); }
__device__ __forceinline__ void ph_p7(LAS unsigned char* lds, int layer_) { int layer = __builtin_amdgcn_readfirstlane(layer_); asm volatile("" : "+s"(layer)); PH_CTX();
    moe_tables(ctl, layer, MISC, tid);
    const int nrt = __builtin_amdgcn_readfirstlane((int)MISC[MW_NRT]);
    pg8::Gemm g{(const bf16*)(ws + WS_A1), (const bf16*)(ws + WS_WGU) + (size_t)layer * NE * 2048 * D, nrt * 256, NE * 2048, D};
    pg8::MoeOrder S{8, G, vcu, nrt * 8, (const LAS int*)(lds + MISC_OFF + 4 * MW_TILE)};
    pg8::EpiSwiglu E{(bf16*)(ws + WS_ACT), FFN, args.b_gu + (size_t)layer * NE * 2048};
    pg8::gemm_phase<pg8::EpiSwiglu, pg8::MoeOrder, true, true>(lds, g, S, E); }
__device__ __forceinline__ void ph_p8(LAS unsigned char* lds, int layer_) { int layer = __builtin_amdgcn_readfirstlane(layer_); asm volatile("" : "+s"(layer)); PH_CTX();
    moe_tables(ctl, layer, MISC, tid);
    const int nrt = __builtin_amdgcn_readfirstlane((int)MISC[MW_NRT]);
    pg8::Gemm g{(const bf16*)(ws + WS_ACT), (const bf16*)(ws + WS_WDN) + (size_t)layer * NE * D * FFN, nrt * 256, NE * D, FFN};
    pg8::MoeOrder S{4, G, vcu, nrt * 4, (const LAS int*)(lds + MISC_OFF + 4 * MW_TILE)};
    pg8::EpiBf16Bias E{(bf16*)(ws + WS_Y), D, args.b_dn + (size_t)layer * NE * D, D};
    pg8::gemm_phase<pg8::EpiBf16Bias, pg8::MoeOrder, true, true>(lds, g, S, E); }
__device__ __forceinline__ void ph_final(LAS unsigned char* lds) { PH_CTX(); final_rows(args, vcu, G, lane, wave); }

#ifndef DBL_MASK
#define DBL_MASK 0
#endif
#if DBL_MASK
__device__ __forceinline__ int opaque_i(int v) { asm volatile("" : "+s"(v)); return v; }
#define RUN(bit, call) do { const int nrep_ = opaque_i(1 + ((DBL_MASK >> (bit)) & 1)); _Pragma("unroll 1") for (int rep_ = 0; rep_ < nrep_; ++rep_) { call; } } while (0)
#else
#define RUN(bit, call) do { call; } while (0)
#endif
__global__ void __launch_bounds__(NTHR, 2) hybrid_fwd(Args args) {
    extern __shared__ __attribute__((aligned(16))) unsigned char lds_raw[];
    LAS unsigned char* lds = (LAS unsigned char*)lds_raw;
    volatile LAS unsigned* MISC = (volatile LAS unsigned*)(lds + MISC_OFF);
    const int tid = threadIdx.x;
    gu32* ctl = (gu32*)(args.ws + WS_CTL);
    for (int u = tid; u < (LDS_BYTES - MISC_OFF) / 4; u += NTHR) MISC[u] = 0u;
    __syncthreads();
    if (tid == 0) {
#define ST_ARG(i, p) do { const unsigned long long v_ = (unsigned long long)(p); MISC[MW_ARGS + 2 * (i)] = (unsigned)v_; MISC[MW_ARGS + 2 * (i) + 1] = (unsigned)(v_ >> 32); } while (0)
        ST_ARG(0, args.x); ST_ARG(1, args.c); ST_ARG(2, args.pos); ST_ARG(3, args.w_mod); ST_ARG(4, args.b_mod); ST_ARG(5, args.norm1_w); ST_ARG(6, args.w_in); ST_ARG(7, args.gla_wa2); ST_ARG(8, args.gla_ba2);
        ST_ARG(9, args.hg_lb); ST_ARG(10, args.gla_norm_w); ST_ARG(11, args.hg_norm_w); ST_ARG(12, args.w_out); ST_ARG(13, args.norm2_w); ST_ARG(14, args.w_r); ST_ARG(15, args.b_r); ST_ARG(16, args.w_gu);
        ST_ARG(17, args.b_gu); ST_ARG(18, args.w_dn); ST_ARG(19, args.b_dn); ST_ARG(20, args.final_norm_w); ST_ARG(21, args.out); ST_ARG(22, args.ws);
#undef ST_ARG
    }
    __syncthreads();
    const int lo = args.ph_lo, hi = args.ph_hi;
    const bool multi = (hi - lo) > 1;
    XcdBarrier bar; bar.bar = (unsigned*)(ctl + CW_BAR); bar.x = 0; bar.st = nullptr;
    if (multi) bar = xcd_barrier_post((unsigned*)(ctl + CW_BAR), MISC + MW_BAR);
#define IN(k) (lo <= (k) && (k) < hi)
#define SEAM(k) do { if (IN(k) && IN((k) + 1)) xcd_barrier(bar); } while (0)

    if (IN(0)) RUN(0, ph_p0(lds));
    SEAM(0);
    for (int layer = 0; layer < DEPTH; ++layer) {
        const int pb = 1 + 10 * layer;
        if (IN(pb + 0)) RUN(1, ph_p1(lds, layer));
        SEAM(pb + 0);
        if (IN(pb + 1)) RUN(2, ph_p2(lds, layer));
        SEAM(pb + 1);
        if (IN(pb + 2)) RUN(3, ph_p3a(lds, layer));
        SEAM(pb + 2);
        if (IN(pb + 3)) RUN(4, ph_p3b(lds));
        SEAM(pb + 3);
        if (IN(pb + 4)) RUN(5, ph_p3c(lds, layer));
        SEAM(pb + 4);
        if (IN(pb + 5)) RUN(6, ph_p4(lds, layer));
        SEAM(pb + 5);
        if (IN(pb + 6)) RUN(7, ph_p5(lds, layer));
        SEAM(pb + 6);
        if (IN(pb + 7)) RUN(8, ph_p6(lds, layer));
        SEAM(pb + 7);
        if (IN(pb + 8)) RUN(9, ph_p7(lds, layer));
        SEAM(pb + 8);
        if (IN(pb + 9)) RUN(10, ph_p8(lds, layer));
        SEAM(pb + 9);
    }
    if (IN(NPHASE - 1)) ph_final(lds);
#undef IN
#undef SEAM
}

#ifndef MK_SINGLE
#define MK_SINGLE 1
#endif
extern "C" void kernel_launch(void* const* d_in, const int* in_sizes, int n_in, void* d_out, int out_size, void* d_ws, size_t ws_size, hipStream_t stream) {
    static int grid = 0;
    if (grid == 0) {
        if (n_in != 21 || in_sizes[0] != MTOK * D || out_size != MTOK * D || ws_size < WS_END) { fprintf(stderr, "kernel_launch: unexpected problem shape (n_in %d, in0 %d, out %d, ws %zu)\n", n_in, n_in > 0 ? in_sizes[0] : -1, out_size, ws_size); grid = -1; return; }
        int dev = 0, cus = 0, per_cu = 0;
        if (hipGetDevice(&dev) != hipSuccess || hipDeviceGetAttribute(&cus, hipDeviceAttributeMultiprocessorCount, dev) != hipSuccess) { grid = -1; return; }
        if (hipFuncSetAttribute((const void*)hybrid_fwd, hipFuncAttributeMaxDynamicSharedMemorySize, LDS_BYTES) != hipSuccess) { fprintf(stderr, "kernel_launch: hipFuncSetAttribute failed\n"); grid = -1; return; }
        if (hipOccupancyMaxActiveBlocksPerMultiprocessor(&per_cu, (const void*)hybrid_fwd, NTHR, LDS_BYTES) != hipSuccess || per_cu < 1) fprintf(stderr, "kernel_launch: occupancy query says %d\n", per_cu);
        (void)hipGetLastError();
        grid = cus;
    }
    if (grid < 0) return;
    (void)hipMemsetAsync((char*)d_ws + WS_CTL, 0, CTL_ZERO_BYTES, stream);
    Args a{};
    a.x = (const float*)d_in[0]; a.c = (const float*)d_in[1]; a.pos = (const int*)d_in[2]; a.w_mod = (const float*)d_in[3]; a.b_mod = (const float*)d_in[4]; a.norm1_w = (const float*)d_in[5];
    a.w_in = (const float*)d_in[6]; a.gla_wa2 = (const float*)d_in[7]; a.gla_ba2 = (const float*)d_in[8]; a.hg_lb = (const float*)d_in[9]; a.gla_norm_w = (const float*)d_in[10]; a.hg_norm_w = (const float*)d_in[11];
    a.w_out = (const float*)d_in[12]; a.norm2_w = (const float*)d_in[13]; a.w_r = (const float*)d_in[14]; a.b_r = (const float*)d_in[15]; a.w_gu = (const float*)d_in[16]; a.b_gu = (const float*)d_in[17];
    a.w_dn = (const float*)d_in[18]; a.b_dn = (const float*)d_in[19]; a.final_norm_w = (const float*)d_in[20]; a.out = (float*)d_out; a.ws = (unsigned char*)d_ws;
#if MK_SINGLE
    a.ph_lo = 0; a.ph_hi = NPHASE;
    hipLaunchKernelGGL(hybrid_fwd, dim3(grid), dim3(NTHR), LDS_BYTES, stream, a);
#else
    for (int p = 0; p < NPHASE; ++p) { a.ph_lo = p; a.ph_hi = p + 1; hipLaunchKernelGGL(hybrid_fwd, dim3(grid), dim3(NTHR), LDS_BYTES, stream, a); }
#endif
}
```

```cpp
#include <hip/hip_runtime.h>
#include <cstdio>
#include <cstdint>
namespace pg8 {
#define PG8_LAS __attribute__((address_space(3)))
typedef unsigned short bf16_t;
typedef short bf16x8 __attribute__((ext_vector_type(8)));
typedef float f32x4 __attribute__((ext_vector_type(4)));
typedef unsigned u32x4 __attribute__((ext_vector_type(4)));
constexpr int BM = 256, BK = 64, HALF = 128, HTB = HALF * BK * 2  , STAGE_BYTES = 8 * HTB, NXCD = 8, WGM = 8;

__host__ __device__ __forceinline__ int lds_byte(int r, int c) { const int st = (r >> 4) * 2 + (c >> 5), rr = r & 15, cc = c & 31, ob = rr * 64 + cc * 2; return st * 1024 + (ob ^ (((ob >> 9) & 1) << 5)); }
__host__ __device__ __forceinline__ void stage_rc(int b, int& R, int& C) { const int st = b / 1024, sb = b % 1024, swz = sb ^ (((sb >> 9) & 1) << 5); R = (st >> 1) * 16 + swz / 64; C = (st & 1) * 32 + (swz % 64) / 2; }
__host__ __device__ __forceinline__ int perm32(int rho) { const int n = rho >> 4, i = rho & 15; return 8 * (i >> 2) + 4 * n + (i & 3); }

struct Unit { int pm, pn, e, pl; };
struct Gemm { const bf16_t* A; const bf16_t* Bt; int M, N, K; };

struct StaticOrder {
    int nM, nN, nwg, G, c;
    __host__ __device__ void init(int M, int N, int G_, int c_) { nM = M / BM; nN = N / BM; nwg = nM * nN; G = G_; c = c_; }
    __host__ __device__ bool next(int i, Unit& u) const {
        const long L = (long)i * G + c; if (L >= nwg) return false;
        int wgid = (int)L; { const int q = nwg / NXCD, r = nwg % NXCD, xcd = wgid % NXCD, off = wgid / NXCD; wgid = (xcd < r ? xcd * (q + 1) : r * (q + 1) + (xcd - r) * q) + off; }
        const int nig = WGM * nN, gid = wgid / nig, fm = gid * WGM, gsz = (nM - fm) < WGM ? (nM - fm) : WGM;
        u.pm = fm + ((wgid % nig) % gsz); u.pn = (wgid % nig) / gsz; u.e = 0; u.pl = u.pn; return true;
    }
    __device__ __forceinline__ void a_ready(const Unit&) const {}
    __device__ __forceinline__ void done(const Unit&) const {}
};

__device__ __forceinline__ unsigned cvt_pk_bf16(float lo, float hi) { unsigned r; asm volatile("v_cvt_pk_bf16_f32 %0, %1, %2" : "=v"(r) : "v"(lo), "v"(hi)); return r; }

struct EpiBf16Plain {
    static constexpr bool PERM = true, AFTER_DRAIN = false;
    bf16_t* O; int ldc;
    __device__ __forceinline__ void operator()(const f32x4 (&acc)[2][2][4][2], const Unit& u, int wr, int wc, int fr, int fq) const {
        const int row0 = u.pm * BM + wr * 64 + fr; const int col0 = u.pn * BM + wc * 32 + 8 * fq;
#pragma unroll
        for (int ai = 0; ai < 2; ++ai)
#pragma unroll
            for (int m = 0; m < 4; ++m) { bf16_t* rowp = O + (size_t)(row0 + ai * HALF + m * 16) * ldc + col0;
#pragma unroll
                for (int bj = 0; bj < 2; ++bj) { const f32x4 v0 = acc[ai][bj][m][0], v1 = acc[ai][bj][m][1];
                    u32x4 w; w.x = cvt_pk_bf16(v0[0], v0[1]); w.y = cvt_pk_bf16(v0[2], v0[3]); w.z = cvt_pk_bf16(v1[0], v1[1]); w.w = cvt_pk_bf16(v1[2], v1[3]);
                    *(u32x4*)(rowp + bj * HALF) = w; } }
    }
};
struct EpiResGate {
    static constexpr bool PERM = false, AFTER_DRAIN = false;
    const float* base; float* out; int ldc; const float* gate; int gpitch; int rows_per_batch;
    __device__ __forceinline__ void operator()(const f32x4 (&acc)[2][2][4][2], const Unit& u, int wr, int wc, int fr, int fq) const {
        const int row0 = u.pm * BM + wr * 64 + fr, col0 = u.pn * BM + wc * 32 + 4 * fq;
        const float* gp = gate + (size_t)((u.pm * BM) / rows_per_batch) * gpitch + col0;
        f32x4 gv[2][2];
#pragma unroll
        for (int bj = 0; bj < 2; ++bj)
#pragma unroll
            for (int n = 0; n < 2; ++n) gv[bj][n] = *(const f32x4*)(gp + bj * HALF + n * 16);
#pragma unroll
        for (int ai = 0; ai < 2; ++ai)
#pragma unroll
            for (int m = 0; m < 4; ++m) { const size_t off = (size_t)(row0 + ai * HALF + m * 16) * ldc + col0;
#pragma unroll
                for (int bj = 0; bj < 2; ++bj)
#pragma unroll
                    for (int n = 0; n < 2; ++n) { const f32x4 bs = *(const f32x4*)(base + off + bj * HALF + n * 16);
                        *(f32x4*)(out + off + bj * HALF + n * 16) = bs + gv[bj][n] * acc[ai][bj][m][n]; }
                asm volatile("" ::: "memory"); }
    }
};
struct EpiSwiglu {
    static constexpr bool PERM = true, AFTER_DRAIN = false;
    bf16_t* O; int ldc; const float* bias;
    __device__ __forceinline__ float act1(float g, float up) const {
        g = fminf(g, 7.0f); up = fminf(fmaxf(up, -7.0f), 7.0f);
        const float s = 1.0f / (1.0f + __expf(-1.702f * g));
        return (up + 1.0f) * g * s;
    }
    __device__ __forceinline__ void operator()(const f32x4 (&acc)[2][2][4][2], const Unit& u, int wr, int wc, int fr, int fq) const {
        const int row0 = u.pm * BM + wr * 64 + fr; const int jj0 = wc * 32 + 8 * fq; const int col0 = u.pl * HALF + jj0;
        const float* bp = bias + (size_t)u.e * 2048 + col0;
        f32x4 bg[2], bu[2];
#pragma unroll
        for (int n = 0; n < 2; ++n) { bg[n] = *(const f32x4*)(bp + 4 * n); bu[n] = *(const f32x4*)(bp + 1024 + 4 * n); }
#pragma unroll
        for (int ai = 0; ai < 2; ++ai)
#pragma unroll
            for (int m = 0; m < 4; ++m) { bf16_t* rowp = O + (size_t)(row0 + ai * HALF + m * 16) * ldc + col0;
                f32x4 r[2];
#pragma unroll
                for (int n = 0; n < 2; ++n) { const f32x4 g = acc[ai][0][m][n] + bg[n], up = acc[ai][1][m][n] + bu[n];
#pragma unroll
                    for (int j = 0; j < 4; ++j) r[n][j] = act1(g[j], up[j]); }
                u32x4 w; w.x = cvt_pk_bf16(r[0][0], r[0][1]); w.y = cvt_pk_bf16(r[0][2], r[0][3]); w.z = cvt_pk_bf16(r[1][0], r[1][1]); w.w = cvt_pk_bf16(r[1][2], r[1][3]);
                *(u32x4*)rowp = w; }
    }
};
struct EpiBf16Bias {
    static constexpr bool PERM = true, AFTER_DRAIN = false;
    bf16_t* O; int ldc; const float* bias; int bpitch;
    __device__ __forceinline__ void operator()(const f32x4 (&acc)[2][2][4][2], const Unit& u, int wr, int wc, int fr, int fq) const {
        const int row0 = u.pm * BM + wr * 64 + fr; const int col0 = u.pl * BM + wc * 32 + 8 * fq;
        const float* bp = bias + (size_t)u.e * bpitch + col0;
        f32x4 bv[2][2];
#pragma unroll
        for (int bj = 0; bj < 2; ++bj)
#pragma unroll
            for (int n = 0; n < 2; ++n) bv[bj][n] = *(const f32x4*)(bp + bj * HALF + 4 * n);
#pragma unroll
        for (int ai = 0; ai < 2; ++ai)
#pragma unroll
            for (int m = 0; m < 4; ++m) { bf16_t* rowp = O + (size_t)(row0 + ai * HALF + m * 16) * ldc + col0;
#pragma unroll
                for (int bj = 0; bj < 2; ++bj) { const f32x4 v0 = acc[ai][bj][m][0] + bv[bj][0], v1 = acc[ai][bj][m][1] + bv[bj][1];
                    u32x4 w; w.x = cvt_pk_bf16(v0[0], v0[1]); w.y = cvt_pk_bf16(v0[2], v0[3]); w.z = cvt_pk_bf16(v1[0], v1[1]); w.w = cvt_pk_bf16(v1[2], v1[3]);
                    *(u32x4*)(rowp + bj * HALF) = w; } }
    }
};
struct MoeOrder {
    int nN, G, c, nunits; const PG8_LAS int* tile_e;
    __device__ __forceinline__ bool next(int i, Unit& u) const {
        const int L = i * G + c; if (L >= nunits) return false;
        const int pm = L / nN, pl = L - pm * nN, e = __builtin_amdgcn_readfirstlane(tile_e[pm]);
        u.pm = pm; u.pl = pl; u.e = e; u.pn = e * nN + pl; return true;
    }
    __device__ __forceinline__ void a_ready(const Unit&) const {}
    __device__ __forceinline__ void done(const Unit&) const {}
};
template <class Epi, class Sched, bool ALIGN_EPI = false, bool SP2 = false>
__device__ __forceinline__ void gemm_phase(PG8_LAS unsigned char* lds, const Gemm g, const Sched& S, const Epi& E) {
    int tid_ = threadIdx.x; asm volatile("" : "+v"(tid_)); const int tid = tid_, wid = __builtin_amdgcn_readfirstlane(tid >> 6), lane = tid & 63, wr = wid >> 2, wc = wid & 3, fr = lane & 15, fq = lane >> 4;
    const int K = g.K, nt = K / BK;
    unsigned voffA[2], voffB[2];
#pragma unroll
    for (int i = 0; i < 2; ++i) { int R, C; stage_rc(tid * 16 + i * 8192, R, C); const int Rb = Epi::PERM ? ((R & ~31) + perm32(R & 31)) : R;
        voffA[i] = (unsigned)(R * K + C) * 2u; voffB[i] = (unsigned)(Rb * K + C) * 2u; }
    const size_t kstep = (size_t)(BK * 2);
    const size_t hstep = (size_t)HALF * K * 2;
    const size_t tstep = 2 * hstep;
    const unsigned ldsw = (unsigned)wid * 1024u;
    const int aoff = lds_byte(wr * 64 + fr, fq * 8), boff = lds_byte(wc * 32 + fr, fq * 8);
#define PG8_SA(b, h) (((b) * 2 + (h)) * HTB)
#define PG8_SB(b, h) ((4 + (b) * 2 + (h)) * HTB)
#define PG8_STAGE(bufoff, gbase, voff) do { _Pragma("unroll") for (int _i = 0; _i < 2; ++_i) \
        __builtin_amdgcn_global_load_lds((const unsigned*)((const char*)(gbase) + (voff)[_i]), (PG8_LAS unsigned*)(lds + (bufoff) + ldsw + _i * 8192), 16, 0, 0); } while (0)
#define PG8_LDA(dst, b, h) do { _Pragma("unroll") for (int m = 0; m < 4; ++m) _Pragma("unroll") for (int k = 0; k < 2; ++k) dst[m][k] = *(const PG8_LAS bf16x8*)(lds + PG8_SA(b, h) + aoff + m * 2048 + k * 1024); } while (0)
#define PG8_LDB(dst, b, h) do { _Pragma("unroll") for (int n = 0; n < 2; ++n) _Pragma("unroll") for (int k = 0; k < 2; ++k) dst[n][k] = *(const PG8_LAS bf16x8*)(lds + PG8_SB(b, h) + boff + n * 2048 + k * 1024); } while (0)
#define PG8_MMA(ai, bj, At, Bt) do { __builtin_amdgcn_s_setprio(1); _Pragma("unroll") for (int m = 0; m < 4; ++m) _Pragma("unroll") for (int n = 0; n < 2; ++n) _Pragma("unroll") for (int k = 0; k < 2; ++k) \
        acc[ai][bj][m][n] = __builtin_amdgcn_mfma_f32_16x16x32_bf16(Bt[n][k], At[m][k], acc[ai][bj][m][n], 0, 0, 0); __builtin_amdgcn_s_setprio(0); } while (0)
#define PG8_WAIT_V(n) asm volatile("s_waitcnt vmcnt(" #n ")" ::: "memory")
#define PG8_WAIT_L(n) asm volatile("s_waitcnt lgkmcnt(" #n ")" ::: "memory")
#define PG8_BAR __builtin_amdgcn_s_barrier()
#define PG8_SCHED __builtin_amdgcn_sched_barrier(0)
    Unit cur, nxt; int ui = 0;
    if (!S.next(0, cur)) return;
    f32x4 acc[2][2][4][2];
#pragma unroll
    for (int a = 0; a < 2; ++a)
#pragma unroll
        for (int b = 0; b < 2; ++b)
#pragma unroll
            for (int m = 0; m < 4; ++m)
#pragma unroll
                for (int n = 0; n < 2; ++n) acc[a][b][m][n] = (f32x4){0.f, 0.f, 0.f, 0.f};
    bf16x8 At[4][2], B0[2][2], B1[2][2];
    const char* cA = (const char*)g.A + (size_t)cur.pm * tstep; const char* cB = (const char*)g.Bt + (size_t)cur.pn * tstep;
    S.a_ready(cur);
    if constexpr (SP2) {
        PG8_STAGE(PG8_SB(0, 0), cB, voffB); PG8_STAGE(PG8_SB(0, 1), cB + hstep, voffB); PG8_STAGE(PG8_SA(0, 0), cA, voffA); PG8_STAGE(PG8_SA(0, 1), cA + hstep, voffA);
        if (wr == 1) PG8_BAR;
        PG8_WAIT_V(2); PG8_BAR;
        PG8_STAGE(PG8_SB(1, 0), cB + kstep, voffB); PG8_STAGE(PG8_SA(1, 0), cA + kstep, voffA); PG8_STAGE(PG8_SB(1, 1), cB + hstep + kstep, voffB);
        PG8_WAIT_V(6); PG8_BAR;
    } else {
        PG8_STAGE(PG8_SB(0, 0), cB, voffB); PG8_STAGE(PG8_SA(0, 0), cA, voffA); PG8_STAGE(PG8_SB(0, 1), cB + hstep, voffB); PG8_STAGE(PG8_SA(0, 1), cA + hstep, voffA);
        if (wr == 1) PG8_BAR;
        PG8_WAIT_V(4); PG8_BAR;
        PG8_STAGE(PG8_SB(1, 0), cB + kstep, voffB); PG8_STAGE(PG8_SA(1, 0), cA + kstep, voffA); PG8_STAGE(PG8_SB(1, 1), cB + hstep + kstep, voffB);
        PG8_WAIT_V(6); PG8_BAR;
    }
    for (;;) {
        const bool has_next = S.next(ui + 1, nxt);
        const char* nA = has_next ? (const char*)g.A + (size_t)nxt.pm * tstep : cA; const char* nB = has_next ? (const char*)g.Bt + (size_t)nxt.pn * tstep : cB;
        for (int t = 0; t < nt; t += 2) {
            const bool last = (t == nt - 2);
            const char* a1 = cA + (size_t)(t + 1) * kstep;
            const char* a2 = last ? nA : cA + (size_t)(t + 2) * kstep; const char* b2 = last ? nB : cB + (size_t)(t + 2) * kstep;
            const char* a3 = a2 + kstep; const char* b3 = b2 + kstep;
            if (last && has_next) S.a_ready(nxt);
            if constexpr (SP2) {
            PG8_LDB(B0, 0, 0); PG8_LDB(B1, 0, 1); PG8_SCHED; PG8_LDA(At, 0, 0); PG8_STAGE(PG8_SA(1, 1), a1 + hstep, voffA);
            PG8_WAIT_V(8); PG8_WAIT_L(0); PG8_BAR; PG8_MMA(0, 0, At, B0); PG8_MMA(0, 1, At, B1); PG8_BAR; PG8_SCHED;
            PG8_LDA(At, 0, 1); PG8_STAGE(PG8_SB(0, 0), b2, voffB); PG8_STAGE(PG8_SB(0, 1), b2 + hstep, voffB); PG8_STAGE(PG8_SA(0, 0), a2, voffA);
            PG8_WAIT_V(8); PG8_WAIT_L(0); PG8_BAR; PG8_MMA(1, 0, At, B0); PG8_MMA(1, 1, At, B1); PG8_BAR; PG8_SCHED;
            PG8_LDB(B0, 1, 0); PG8_LDB(B1, 1, 1); PG8_SCHED; PG8_LDA(At, 1, 0); PG8_STAGE(PG8_SA(0, 1), a2 + hstep, voffA);
            PG8_WAIT_V(8); PG8_WAIT_L(0); PG8_BAR; PG8_MMA(0, 0, At, B0); PG8_MMA(0, 1, At, B1); PG8_BAR; PG8_SCHED;
            PG8_LDA(At, 1, 1); PG8_STAGE(PG8_SB(1, 0), b3, voffB); PG8_STAGE(PG8_SB(1, 1), b3 + hstep, voffB); PG8_STAGE(PG8_SA(1, 0), a3, voffA);
            PG8_WAIT_V(8); PG8_WAIT_L(0); PG8_BAR; PG8_MMA(1, 0, At, B0); PG8_MMA(1, 1, At, B1); PG8_BAR; PG8_SCHED;
            } else {
            PG8_LDB(B0, 0, 0); PG8_SCHED; PG8_LDA(At, 0, 0); PG8_STAGE(PG8_SA(1, 1), a1 + hstep, voffA);
            PG8_WAIT_L(8); PG8_BAR; PG8_WAIT_L(0); PG8_MMA(0, 0, At, B0); PG8_BAR; PG8_SCHED;
            PG8_LDB(B1, 0, 1); PG8_STAGE(PG8_SB(0, 0), b2, voffB);
            PG8_BAR; PG8_WAIT_L(0); PG8_MMA(0, 1, At, B1); PG8_BAR;
            PG8_LDA(At, 0, 1); PG8_STAGE(PG8_SA(0, 0), a2, voffA);
            PG8_BAR; PG8_WAIT_L(0); PG8_MMA(1, 0, At, B0); PG8_BAR; PG8_SCHED;
            PG8_STAGE(PG8_SB(0, 1), b2 + hstep, voffB);
            PG8_WAIT_V(6); PG8_BAR; PG8_MMA(1, 1, At, B1); PG8_BAR;
            PG8_LDB(B0, 1, 0); PG8_SCHED; PG8_LDA(At, 1, 0); PG8_STAGE(PG8_SA(0, 1), a2 + hstep, voffA);
            PG8_WAIT_L(8); PG8_BAR; PG8_WAIT_L(0); PG8_MMA(0, 0, At, B0); PG8_BAR; PG8_SCHED;
            PG8_LDB(B1, 1, 1); PG8_STAGE(PG8_SB(1, 0), b3, voffB);
            PG8_BAR; PG8_WAIT_L(0); PG8_MMA(0, 1, At, B1); PG8_BAR;
            PG8_LDA(At, 1, 1); PG8_STAGE(PG8_SA(1, 0), a3, voffA);
            PG8_BAR; PG8_WAIT_L(0); PG8_MMA(1, 0, At, B0); PG8_BAR; PG8_SCHED;
            PG8_STAGE(PG8_SB(1, 1), b3 + hstep, voffB);
            PG8_WAIT_V(6); PG8_BAR; PG8_MMA(1, 1, At, B1); PG8_BAR;
            }
        }
        if constexpr (ALIGN_EPI) { if (wr == 0) PG8_BAR; }
        if constexpr (!Epi::AFTER_DRAIN) { E(acc, cur, wr, wc, fr, fq); S.done(cur); }
        if (!has_next) break;
#pragma unroll
        for (int a = 0; a < 2; ++a)
#pragma unroll
            for (int b = 0; b < 2; ++b)
#pragma unroll
                for (int m = 0; m < 4; ++m)
#pragma unroll
                    for (int n = 0; n < 2; ++n) acc[a][b][m][n] = (f32x4){0.f, 0.f, 0.f, 0.f};
        cur = nxt; cA = nA; cB = nB; ++ui;
        if constexpr (ALIGN_EPI) { if (wr == 1) PG8_BAR; }
    }
    PG8_WAIT_V(0);
    if constexpr (!ALIGN_EPI) { if (wr == 0) PG8_BAR; }
    PG8_BAR;
    if constexpr (Epi::AFTER_DRAIN) { E.fused(acc, cur, wr, wc, fr, fq, lds, wid, lane); S.done(cur); }
#undef PG8_SA
#undef PG8_SB
#undef PG8_STAGE
#undef PG8_LDA
#undef PG8_LDB
#undef PG8_MMA
#undef PG8_WAIT_V
#undef PG8_WAIT_L
#undef PG8_BAR
#undef PG8_SCHED
}
}

constexpr int NWAVES = 8, NTHR = 512;
constexpr int BATCH = 2, SEQ = 8192, D = 1024, DEPTH = 4, MTOK = BATCH * SEQ;
constexpr int DIN = 3344, NPROJ = 3328, SRC_GA = 1152;
constexpr int C_GQ = 0, C_GK = 192, C_GV = 384, C_GG = 768, C_HQ = 1152, C_HF = 1408, C_HI = 1664, C_HG = 1920, C_RQ = 2176, C_RK = 2368, C_RV = 2560, C_RG = 2944;
constexpr int NE = 32, FFN = 1024;
constexpr int CH = 64, NCH = SEQ / CH, NUNIT = BATCH * NCH;
constexpr int ST_GLA = 0, ST_HG = 4 * 48 * 96, ST_RET = ST_HG + 4 * 64 * 64, ST_TOT = ST_RET + 4 * 48 * 96;
constexpr int NDV = 448;
constexpr int MAXROWS = 65536 + NE * 256, MAXRT = MAXROWS / 256;
constexpr float EPS = 1e-6f;
constexpr int NPHASE = 42;

constexpr size_t MiB = 1u << 20;
constexpr size_t WS_CTL = 0, CTL_ZERO_BYTES = 65536;
constexpr size_t WS_MOD = 1 * MiB;
constexpr size_t WS_ROPE = 2 * MiB;
constexpr size_t WS_LB = 5 * MiB;
constexpr size_t WS_WIN = 8 * MiB;
constexpr size_t WS_WOUT = 34 * MiB;
constexpr size_t WS_WGU = 42 * MiB;
constexpr size_t WS_WDN = 554 * MiB;
constexpr size_t WS_X = 810 * MiB;
constexpr size_t WS_H = 874 * MiB;
constexpr size_t WS_GA = 906 * MiB;
constexpr size_t WS_PROJ = 907 * MiB;
constexpr size_t WS_U = 1011 * MiB;
constexpr size_t WS_DVEC = 1063 * MiB;
constexpr size_t WS_SP = 1064 * MiB;
constexpr size_t WS_MIX = 1090 * MiB;
constexpr size_t WS_TOPE = 1122 * MiB;
constexpr size_t WS_TOPW = WS_TOPE + 256 * 1024;
constexpr size_t WS_SLOT = WS_TOPW + 256 * 1024;
constexpr size_t WS_A1 = 1123 * MiB;
constexpr size_t WS_ACT = 1267 * MiB;
constexpr size_t WS_Y = 1411 * MiB;
constexpr size_t WS_CUM = 1555 * MiB;
constexpr size_t WS_END = 1583 * MiB;
static_assert(WS_WIN + (size_t)DEPTH * NPROJ * D * 2 <= WS_WOUT && WS_PROJ + (size_t)MTOK * NPROJ * 2 <= WS_U && WS_U + (size_t)NUNIT * ST_TOT * 4 <= WS_DVEC && WS_SP + (size_t)NUNIT * ST_TOT * 2 <= WS_MIX && WS_A1 + (size_t)MAXROWS * D * 2 <= WS_ACT, "ws map");
constexpr int CW_TMO = 0, CW_CODE = 1, CW_BAR = 4096, CW_CNT = 8192, CW_FILL = 8192 + 256;
constexpr int RING_BYTES = 131072;
constexpr int MISC_OFF = 147456, LDS_BYTES = MISC_OFF + 4096;
constexpr int MW_BAR = 0, MW_CNT = 16, MW_PST = 48, MW_HIST = 96, MW_BASE = 128, MW_TILE = 192, MW_NRT = 480, MW_SLOTS = 512;

#define GAS __attribute__((address_space(1)))
#define LAS __attribute__((address_space(3)))
typedef unsigned v4u __attribute__((ext_vector_type(4)));
typedef float f32x4 __attribute__((ext_vector_type(4)));
typedef short bf16x8 __attribute__((ext_vector_type(8)));
typedef GAS unsigned gu32;
typedef GAS unsigned long long gu64;
#define RLX_AGENT __ATOMIC_RELAXED, __HIP_MEMORY_SCOPE_AGENT
#define LDS_WAIT() asm volatile("s_waitcnt lgkmcnt(0)" ::: "memory")
#define VM_WAIT() asm volatile("s_waitcnt vmcnt(0)" ::: "memory")
__device__ __forceinline__ unsigned long long rt() { return __builtin_amdgcn_s_memrealtime(); }
typedef unsigned short bf16;
__device__ __forceinline__ unsigned f2bf(float f) { unsigned u = __builtin_bit_cast(unsigned, f); return (u + 0x7fffu + ((u >> 16) & 1u)) >> 16; }
__device__ __forceinline__ unsigned pk2(float lo, float hi) { return f2bf(lo) | (f2bf(hi) << 16); }
__device__ __forceinline__ float bf2f(bf16 b) { return __builtin_bit_cast(float, (unsigned)b << 16); }
#define XB_TMO      128
#define XB_XCNT(j)  (256  + 64 * (j))
#define XB_XSUB(j)  (1280 + 64 * (j))
#define XB_XGEN(j)  (2304 + 64 * (j))
#define XB_TOP      3328
#define XB_TOPGEN   3392
#define XCD_BAR_WORDS 3456
#define XB_SPIN_CAP (1u << 18)

__device__ __forceinline__ unsigned xb_ld(unsigned* p)              { return __hip_atomic_load(p, __ATOMIC_RELAXED, __HIP_MEMORY_SCOPE_AGENT); }
__device__ __forceinline__ unsigned xb_add(unsigned* p, unsigned v) { return __hip_atomic_fetch_add(p, v, __ATOMIC_RELAXED, __HIP_MEMORY_SCOPE_AGENT); }
__device__ __forceinline__ unsigned xb_xcc_id() { return (unsigned)__builtin_amdgcn_s_getreg((3 << 11) | 20) & 0xFu; }
#define XB_SPIN(cond, bar) do { unsigned _sp = 0; while (cond) { __builtin_amdgcn_s_sleep(1); \
    if ((++_sp & 255u) == 0u) { if (xb_ld(&(bar)[XB_TMO])) break; if (_sp > XB_SPIN_CAP) { atomicAdd(&(bar)[XB_TMO], 1u); break; } } } } while (0)

struct XcdBarrier {
    unsigned* bar; unsigned x;
    volatile LAS unsigned* st;
};

__device__ __forceinline__ XcdBarrier xcd_barrier_post(unsigned* bar, volatile LAS unsigned* st) {
    XcdBarrier b; b.bar = bar; b.x = xb_xcc_id(); b.st = st;
    if (threadIdx.x == 0) (void)xb_add(&bar[XB_XCNT(b.x)], 1u);
    return b;
}
__device__ __forceinline__ void xcd_barrier_complete(unsigned* bar, unsigned x, unsigned& nloc, unsigned& nx) {
    const unsigned G = gridDim.x * gridDim.y * gridDim.z;
    unsigned sum, cnt, mine, sp = 0u;
    for (;;) {
        sum = 0u; cnt = 0u; mine = 0u;
#pragma unroll
        for (unsigned j = 0; j < 16; ++j) { const unsigned c = xb_ld(&bar[XB_XCNT(j)]); sum += c; cnt += (c > 0u) ? 1u : 0u; mine = (j == x) ? c : mine; }
        if (sum == G) break;
        __builtin_amdgcn_s_sleep(1);
        if ((++sp & 255u) == 0u) { if (xb_ld(&bar[XB_TMO])) break; if (sp > XB_SPIN_CAP) { atomicAdd(&bar[XB_TMO], 1u); break; } }
    }
    nloc = mine > 0u ? mine : 1u; nx = cnt > 0u ? cnt : 1u;
}

__device__ __forceinline__ void xcd_barrier(const XcdBarrier& b) {
    asm volatile("s_waitcnt vmcnt(0)" ::: "memory");
    __syncthreads();
    if (threadIdx.x == 0) {
        unsigned* bar = b.bar;
        __builtin_amdgcn_s_waitcnt(0);
        unsigned nloc = b.st[0], nx = b.st[1];
        if (nloc == 0u) { xcd_barrier_complete(bar, b.x, nloc, nx); b.st[0] = nloc; b.st[1] = nx; }
        const unsigned old = xb_add(&bar[XB_XSUB(b.x)], 1u);
        const unsigned gen = old / nloc;
        if (old + 1u == (gen + 1u) * nloc) {
            __builtin_amdgcn_fence(__ATOMIC_RELEASE, "agent");
            asm volatile("s_waitcnt vmcnt(0)" ::: "memory");
            const unsigned og = xb_add(&bar[XB_TOP], 1u);
            const unsigned tg = og / nx;
            if (og + 1u == (tg + 1u) * nx) xb_add(&bar[XB_TOPGEN], 1u);
            else XB_SPIN(xb_ld(&bar[XB_TOPGEN]) == tg, bar);
            __builtin_amdgcn_fence(__ATOMIC_ACQUIRE, "agent");
            xb_add(&bar[XB_XGEN(b.x)], 1u);
            asm volatile("s_waitcnt vmcnt(0)" ::: "memory");
        } else {
            XB_SPIN(xb_ld(&bar[XB_XGEN(b.x)]) == gen, bar);
            __builtin_amdgcn_fence(__ATOMIC_ACQUIRE, "agent");
            asm volatile("s_waitcnt vmcnt(0)" ::: "memory");
        }
    }
    __syncthreads();
}

__device__ __forceinline__ float wave_sum(float v) {
#pragma unroll
    for (int o = 1; o < 64; o <<= 1) v += __shfl_xor(v, o);
    return v;
}
__device__ __forceinline__ float log_sigmoid_f(float x) { return fminf(x, 0.f) - log1pf(expf(-fabsf(x))); }
__device__ __forceinline__ float silu_f(float x) { return x / (1.0f + expf(-x)); }
__device__ __forceinline__ float sigmoid_f(float x) { return 1.0f / (1.0f + expf(-x)); }
__device__ __forceinline__ pg8::bf16x8 ldfrag(const LAS bf16* base, int stride, int r0, int k0, int lane) {
    return *(const LAS pg8::bf16x8*)(base + (r0 + (lane & 15)) * stride + k0 + 8 * (lane >> 4));
}

struct Args {
    const float* x; const float* c; const int* pos; const float* w_mod; const float* b_mod; const float* norm1_w; const float* w_in; const float* gla_wa2; const float* gla_ba2; const float* hg_lb;
    const float* gla_norm_w; const float* hg_norm_w; const float* w_out; const float* norm2_w; const float* w_r; const float* b_r; const float* w_gu; const float* b_gu; const float* w_dn; const float* b_dn;
    const float* final_norm_w; float* out; unsigned char* ws; int ph_lo, ph_hi;
};

__device__ __forceinline__ void transpose_block64(const float* src, int ld, bf16* dst, LAS float* scr, int lane) {
    const int r = lane >> 4, c4 = (lane & 15) * 4;
    f32x4 v[16];
#pragma unroll
    for (int i = 0; i < 16; ++i) v[i] = *(const f32x4*)(src + (size_t)(4 * i + r) * ld + c4);
#pragma unroll
    for (int i = 0; i < 16; ++i) { LAS float* w = scr + (4 * i + r) * 65 + c4; w[0] = v[i][0]; w[1] = v[i][1]; w[2] = v[i][2]; w[3] = v[i][3]; }
    LDS_WAIT(); asm volatile("" ::: "memory");
    const int kc = lane & 7;
#pragma unroll
    for (int jj = 0; jj < 8; ++jj) { const int n = (lane >> 3) + 8 * jj; const LAS float* s = scr + (8 * kc) * 65 + n;
        v4u o; o.x = pk2(s[0 * 65], s[1 * 65]); o.y = pk2(s[2 * 65], s[3 * 65]); o.z = pk2(s[4 * 65], s[5 * 65]); o.w = pk2(s[6 * 65], s[7 * 65]);
        *(GAS v4u*)(dst + (size_t)n * D + 8 * kc) = o; }
    LDS_WAIT(); asm volatile("" ::: "memory");
}
constexpr int IT_IN = 16 * (NPROJ / 64), IT_OUT = 16 * 16, IT_GU = NE * 16 * 32, IT_DN = NE * 16 * 16, IT_LAYER = IT_IN + IT_OUT + IT_GU + IT_DN, IT_ALL = DEPTH * IT_LAYER;
__device__ __forceinline__ void p0_prologue(const Args& a, LAS unsigned char* lds, int vcu, int G, int tid, int lane, int wave) {
    unsigned char* ws = a.ws;
    bf16* WIN = (bf16*)(ws + WS_WIN); bf16* WOUT = (bf16*)(ws + WS_WOUT); bf16* WGU = (bf16*)(ws + WS_WGU); bf16* WDN = (bf16*)(ws + WS_WDN);
    LAS float* scr = (LAS float*)(lds + wave * 16640);
    const int gw = vcu * NWAVES + wave, NGW = G * NWAVES;
    for (int it = gw; it < IT_ALL; it += NGW) {
        const int l = it / IT_LAYER; int r = it - l * IT_LAYER;
        if (r < IT_IN) { const int kb = r / (NPROJ / 64), nb = r % (NPROJ / 64), n0 = 64 * nb, sc = n0 + (n0 >= SRC_GA ? 16 : 0);
            transpose_block64(a.w_in + ((size_t)l * D + 64 * kb) * DIN + sc, DIN, WIN + ((size_t)l * NPROJ + n0) * D + 64 * kb, scr, lane); continue; }
        r -= IT_IN;
        if (r < IT_OUT) { const int kb = r / 16, nb = r % 16;
            transpose_block64(a.w_out + ((size_t)l * D + 64 * kb) * D + 64 * nb, D, WOUT + ((size_t)l * D + 64 * nb) * D + 64 * kb, scr, lane); continue; }
        r -= IT_OUT;
        if (r < IT_GU) { const int e = r / 512, r2 = r % 512, kb = r2 / 32, nb = r2 % 32, cc = 64 * nb;
            const int row = (cc < 1024) ? 256 * (cc / 128) + (cc % 128) : 256 * ((cc - 1024) / 128) + 128 + ((cc - 1024) % 128);
            transpose_block64(a.w_gu + (((size_t)l * NE + e) * D + 64 * kb) * 2048 + cc, 2048, WGU + (((size_t)l * NE + e) * 2048 + row) * D + 64 * kb, scr, lane); continue; }
        r -= IT_GU;
        { const int e = r / 256, r2 = r % 256, kb = r2 / 16, nb = r2 % 16;
            transpose_block64(a.w_dn + (((size_t)l * NE + e) * FFN + 64 * kb) * D + 64 * nb, D, WDN + (((size_t)l * NE + e) * D + 64 * nb) * D + 64 * kb, scr, lane); }
    }
    __syncthreads();
    {
        LAS float* cact = (LAS float*)lds;
        LAS float* red = (LAS float*)(lds + 8192);
        for (int i = tid; i < 2 * D; i += NTHR) cact[i] = silu_f(a.c[i]);
        __syncthreads();
        float* MOD = (float*)(ws + WS_MOD);
        for (int it = vcu; it < DEPTH * 96; it += G) {
            const int l = it / 96, n0 = (it % 96) * 64;
            const float* wp = a.w_mod + ((size_t)l * D + 128 * wave) * 6144 + n0 + lane;
            float a0 = 0.f, a1 = 0.f;
#pragma unroll 8
            for (int k = 0; k < 128; ++k) { const float w = wp[(size_t)k * 6144]; a0 += cact[128 * wave + k] * w; a1 += cact[D + 128 * wave + k] * w; }
            red[(wave * 2 + 0) * 64 + lane] = a0; red[(wave * 2 + 1) * 64 + lane] = a1;
            __syncthreads();
            if (tid < 128) { const int b = tid >> 6, ln = tid & 63; float s = a.b_mod[l * 6144 + n0 + ln];
#pragma unroll
                for (int w = 0; w < 8; ++w) s += red[(w * 2 + b) * 64 + ln];
                MOD[((size_t)l * 2 + b) * 6144 + n0 + ln] = s; }
            __syncthreads();
        }
    }
    {
        float* ROPE = (float*)(ws + WS_ROPE);
        for (int i = vcu * NTHR + tid; i < MTOK * 24; i += G * NTHR) { const int t = i / 24, f = i % 24;
            const float inv = (float)pow(10000.0, -(double)f / 24.0); const float ang = (float)a.pos[t] * inv;
            ROPE[(size_t)t * 48 + f] = cosf(ang); ROPE[(size_t)t * 48 + 24 + f] = sinf(ang); }
    }
    if (vcu == 0 && tid < 256) {
        float v[4], mx = -3.0e38f; for (int l = 0; l < 4; ++l) { v[l] = a.hg_lb[l * 256 + tid]; mx = fmaxf(mx, v[l]); }
        float s = 0.f; for (int l = 0; l < 4; ++l) { v[l] = expf(v[l] - mx); s += v[l]; }
        float* LB = (float*)(ws + WS_LB); float cs = 0.f, first = 0.f;
        for (int l = 0; l < 4; ++l) { cs += v[l] / s; if (l == 0) first = cs; LB[l * 256 + tid] = cs - first; }
    }
}

__device__ __forceinline__ void moe_combine_row(f32x4 (&v)[4], int m, const bf16* Y, const int* SLOT, const float* TOPW, const float* g2, int lane) {
    const int4 sl = *(const int4*)(SLOT + (size_t)m * 4); const f32x4 tw = *(const f32x4*)(TOPW + (size_t)m * 4);
    const int s[4] = {sl.x, sl.y, sl.z, sl.w};
    f32x4 acc[4];
#pragma unroll
    for (int j = 0; j < 4; ++j) acc[j] = (f32x4){0.f, 0.f, 0.f, 0.f};
#pragma unroll
    for (int k = 0; k < 4; ++k) { const bf16* yr = Y + (size_t)s[k] * D + 4 * lane; const float w = tw[k];
#pragma unroll
        for (int j = 0; j < 4; ++j) { const uint2 p = *(const uint2*)(yr + 256 * j);
            acc[j][0] += w * __builtin_bit_cast(float, p.x << 16); acc[j][1] += w * __builtin_bit_cast(float, p.x & 0xffff0000u);
            acc[j][2] += w * __builtin_bit_cast(float, p.y << 16); acc[j][3] += w * __builtin_bit_cast(float, p.y & 0xffff0000u); } }
#pragma unroll
    for (int j = 0; j < 4; ++j) { const f32x4 g = *(const f32x4*)(g2 + 4 * lane + 256 * j); v[j] = v[j] + g * acc[j]; }
}
__device__ __forceinline__ float row_rstd(const f32x4 (&v)[4]) {
    float s = 0.f;
#pragma unroll
    for (int j = 0; j < 4; ++j) s += (v[j][0] * v[j][0] + v[j][1] * v[j][1]) + (v[j][2] * v[j][2] + v[j][3] * v[j][3]);
    return 1.0f / sqrtf(wave_sum(s) * (1.0f / D) + EPS);
}
__device__ __forceinline__ void modulate_row(f32x4 (&v)[4], float rstd, const float* nw, const float* sc, const float* sh, bf16* hrow, int lane) {
#pragma unroll
    for (int j = 0; j < 4; ++j) { const int c0 = 4 * lane + 256 * j; const f32x4 w = *(const f32x4*)(nw + c0), s1 = *(const f32x4*)(sc + c0), s0 = *(const f32x4*)(sh + c0);
        v[j] = v[j] * rstd * w * (s1 + 1.0f) + s0;
        uint2 p; p.x = pk2(v[j][0], v[j][1]); p.y = pk2(v[j][2], v[j][3]); *(uint2*)(hrow + c0) = p; }
}

__device__ __forceinline__ void p1_rows(const Args& a, int layer, LAS unsigned char* lds, int vcu, int G, int tid, int lane, int wave) {
    unsigned char* ws = a.ws;
    float* X = (float*)(ws + WS_X); bf16* H = (bf16*)(ws + WS_H); float* GA = (float*)(ws + WS_GA); const float* MOD = (const float*)(ws + WS_MOD);
    LAS float* gaw = (LAS float*)lds;
    for (int i = tid; i < D * 16; i += NTHR) { const int k = i >> 4, r = i & 15; const int p = ((k >> 8) * 4 + (k & 3)) * 64 + ((k >> 2) & 63);
        gaw[p * 20 + r] = a.w_in[((size_t)layer * D + k) * DIN + SRC_GA + r]; }
    __syncthreads();
    const float* xin = (layer == 0) ? a.x : X;
    const float* n1w = a.norm1_w + layer * D;
    for (int m = (vcu * NWAVES + wave); m < MTOK; m += G * NWAVES) {
        const int b = m / SEQ; f32x4 v[4];
#pragma unroll
        for (int j = 0; j < 4; ++j) v[j] = *(const f32x4*)(xin + (size_t)m * D + 4 * lane + 256 * j);
        if (layer > 0) {
            moe_combine_row(v, m, (const bf16*)(ws + WS_Y), (const int*)(ws + WS_SLOT), (const float*)(ws + WS_TOPW), MOD + ((size_t)(layer - 1) * 2 + b) * 6144 + 5 * D, lane);
#pragma unroll
            for (int j = 0; j < 4; ++j) *(f32x4*)(X + (size_t)m * D + 4 * lane + 256 * j) = v[j];
        }
        const float rstd = row_rstd(v);
        const float* mp = MOD + ((size_t)layer * 2 + b) * 6144;
        modulate_row(v, rstd, n1w, mp + 1 * D, mp + 0 * D, H + (size_t)m * D, lane);
        float g[16];
#pragma unroll
        for (int r = 0; r < 16; ++r) g[r] = 0.f;
#pragma unroll
        for (int j = 0; j < 4; ++j)
#pragma unroll
            for (int c = 0; c < 4; ++c) { const LAS f32x4* wp = (const LAS f32x4*)(gaw + ((j * 4 + c) * 64 + lane) * 20); const float hv = v[j][c];
#pragma unroll
                for (int q = 0; q < 4; ++q) { const f32x4 w = wp[q]; g[4 * q + 0] += hv * w[0]; g[4 * q + 1] += hv * w[1]; g[4 * q + 2] += hv * w[2]; g[4 * q + 3] += hv * w[3]; }
                if (c & 1) asm volatile("" ::: "memory"); }
        float mine = 0.f;
#pragma unroll
        for (int r = 0; r < 16; ++r) { const float s = wave_sum(g[r]); mine = (lane == r) ? s : mine; }
        if (lane < 16) GA[(size_t)m * 16 + lane] = mine;
    }
}

__device__ __forceinline__ void p5_rows(const Args& a, int layer, LAS unsigned char* lds, volatile LAS unsigned* MISC, gu32* ctl, int vcu, int G, int tid, int lane, int wave) {
    unsigned char* ws = a.ws;
    const float* X = (const float*)(ws + WS_X); bf16* H = (bf16*)(ws + WS_H); const float* MOD = (const float*)(ws + WS_MOD);
    int* TOPE = (int*)(ws + WS_TOPE); float* TOPW = (float*)(ws + WS_TOPW);
    LAS float* rw = (LAS float*)lds;
    for (int i = tid; i < D * NE; i += NTHR) { const int k = i >> 5, e = i & 31; const int p = ((k >> 8) * 4 + (k & 3)) * 64 + ((k >> 2) & 63);
        rw[p * 36 + e] = a.w_r[((size_t)layer * D + k) * NE + e]; }
    if (tid < NE) MISC[MW_HIST + tid] = 0u;
    __syncthreads();
    const float* n2w = a.norm2_w + layer * D;
    const float br = (lane < NE) ? a.b_r[layer * NE + lane] : 0.f;
    for (int m = (vcu * NWAVES + wave); m < MTOK; m += G * NWAVES) {
        const int b = m / SEQ; f32x4 v[4];
#pragma unroll
        for (int j = 0; j < 4; ++j) v[j] = *(const f32x4*)(X + (size_t)m * D + 4 * lane + 256 * j);
        const float rstd = row_rstd(v);
        const float* mp = MOD + ((size_t)layer * 2 + b) * 6144;
        modulate_row(v, rstd, n2w, mp + 4 * D, mp + 3 * D, H + (size_t)m * D, lane);
        float g[NE];
#pragma unroll
        for (int e = 0; e < NE; ++e) g[e] = 0.f;
#pragma unroll
        for (int j = 0; j < 4; ++j)
#pragma unroll
            for (int c = 0; c < 4; ++c) { const LAS f32x4* wp = (const LAS f32x4*)(rw + ((j * 4 + c) * 64 + lane) * 36); const float hv = v[j][c];
#pragma unroll
                for (int q = 0; q < 8; ++q) { const f32x4 w = wp[q]; g[4 * q + 0] += hv * w[0]; g[4 * q + 1] += hv * w[1]; g[4 * q + 2] += hv * w[2]; g[4 * q + 3] += hv * w[3]; }
                asm volatile("" ::: "memory"); }
        float logit = -3.0e38f;
#pragma unroll
        for (int e = 0; e < NE; ++e) { const float s = wave_sum(g[e]); logit = (lane == e) ? s + br : logit; }
        float tv[4]; int te[4];
#pragma unroll
        for (int r = 0; r < 4; ++r) {
            float mx = logit;
#pragma unroll
            for (int o = 1; o < 64; o <<= 1) mx = fmaxf(mx, __shfl_xor(mx, o));
            const unsigned long long bal = __ballot(logit == mx && lane < NE);
            const int idx = __ffsll((long long)bal) - 1;
            tv[r] = mx; te[r] = idx; if (lane == idx) logit = -3.0e38f;
        }
        const float e1 = expf(tv[1] - tv[0]), e2 = expf(tv[2] - tv[0]), e3 = expf(tv[3] - tv[0]); const float inv = 1.0f / (1.0f + e1 + e2 + e3);
        if (lane == 0) { *(int4*)(TOPE + (size_t)m * 4) = make_int4(te[0], te[1], te[2], te[3]); *(f32x4*)(TOPW + (size_t)m * 4) = (f32x4){inv, e1 * inv, e2 * inv, e3 * inv}; }
        if (lane < 4) { const int ee = (lane == 0) ? te[0] : (lane == 1) ? te[1] : (lane == 2) ? te[2] : te[3]; __hip_atomic_fetch_add((LAS unsigned*)&MISC[MW_HIST + ee], 1u, __ATOMIC_RELAXED, __HIP_MEMORY_SCOPE_WORKGROUP); }
    }
    __syncthreads();
    if (tid < NE) { const unsigned h = MISC[MW_HIST + tid]; if (h) atomicAdd((unsigned*)(ctl + CW_CNT + layer * NE + tid), h); }
}

__device__ __forceinline__ void final_rows(const Args& a, int vcu, int G, int lane, int wave) {
    unsigned char* ws = a.ws; const float* X = (const float*)(ws + WS_X); const float* MOD = (const float*)(ws + WS_MOD);
    for (int m = (vcu * NWAVES + wave); m < MTOK; m += G * NWAVES) {
        const int b = m / SEQ; f32x4 v[4];
#pragma unroll
        for (int j = 0; j < 4; ++j) v[j] = *(const f32x4*)(X + (size_t)m * D + 4 * lane + 256 * j);
        moe_combine_row(v, m, (const bf16*)(ws + WS_Y), (const int*)(ws + WS_SLOT), (const float*)(ws + WS_TOPW), MOD + ((size_t)(DEPTH - 1) * 2 + b) * 6144 + 5 * D, lane);
        const float rstd = row_rstd(v);
#pragma unroll
        for (int j = 0; j < 4; ++j) { const int c0 = 4 * lane + 256 * j; const f32x4 w = *(const f32x4*)(a.final_norm_w + c0); *(f32x4*)(a.out + (size_t)m * D + c0) = v[j] * rstd * w; }
    }
}

__device__ __noinline__ void moe_tables(gu32* ctl, int layer, volatile LAS unsigned* MISC, int tid) {
    if (tid < NE) MISC[MW_CNT + tid] = __hip_atomic_load(ctl + CW_CNT + layer * NE + tid, RLX_AGENT);
    __syncthreads();
    if (tid == 0) { unsigned p = 0;
        for (int e = 0; e < NE; ++e) { MISC[MW_PST + e] = p; const unsigned nt = (MISC[MW_CNT + e] + 255u) >> 8; for (unsigned t = 0; t < nt; ++t) MISC[MW_TILE + (p >> 8) + t] = (unsigned)e; p += nt << 8; }
        MISC[MW_PST + NE] = p; MISC[MW_NRT] = p >> 8; }
    __syncthreads();
}
__device__ __forceinline__ void p6_dispatch(const Args& a, int layer, volatile LAS unsigned* MISC, gu32* ctl, int vcu, int G, int tid, int lane, int wave) {
    unsigned char* ws = a.ws; const int* TOPE = (const int*)(ws + WS_TOPE); int* SLOT = (int*)(ws + WS_SLOT); const bf16* H = (const bf16*)(ws + WS_H); bf16* A1 = (bf16*)(ws + WS_A1);
    moe_tables(ctl, layer, MISC, tid);
    for (int t0 = vcu * 64; t0 < MTOK; t0 += G * 64) {
        if (tid < NE) MISC[MW_HIST + tid] = 0u;
        __syncthreads();
        int e = 0; unsigned r = 0;
        if (tid < 256) { e = TOPE[(size_t)t0 * 4 + tid]; r = __hip_atomic_fetch_add((LAS unsigned*)&MISC[MW_HIST + e], 1u, __ATOMIC_RELAXED, __HIP_MEMORY_SCOPE_WORKGROUP); }
        __syncthreads();
        if (tid < NE) { const unsigned h = MISC[MW_HIST + tid]; MISC[MW_BASE + tid] = h ? atomicAdd((unsigned*)(ctl + CW_FILL + layer * NE + tid), h) : 0u; }
        __syncthreads();
        if (tid < 256) { const int slot = (int)(MISC[MW_PST + e] + MISC[MW_BASE + e] + r); SLOT[(size_t)t0 * 4 + tid] = slot; MISC[MW_SLOTS + tid] = (unsigned)slot; }
        __syncthreads();
        for (int i = wave * 32; i < wave * 32 + 32; ++i) { const int slot = (int)MISC[MW_SLOTS + i]; const int t = t0 + (i >> 2);
            const v4u* src = (const v4u*)(H + (size_t)t * D); v4u* dst = (v4u*)(A1 + (size_t)slot * D);
            dst[lane] = src[lane]; dst[lane + 64] = src[lane + 64]; }
        __syncthreads();
    }
}

constexpr int BP = 72;
template <int TYPE> struct MixCfg { static constexpr int DK = (TYPE == 1) ? 64 : 48, DV = (TYPE == 1) ? 64 : 96, NC = 4 * DK, NV = 4 * DV;
    static constexpr int STOFF = (TYPE == 0) ? ST_GLA : (TYPE == 1) ? ST_HG : ST_RET, COFF = (TYPE == 0) ? 0 : 192;
    static constexpr int CQ = (TYPE == 0) ? C_GQ : (TYPE == 1) ? C_HQ : C_RQ, CK = (TYPE == 0) ? C_GK : (TYPE == 1) ? C_HF : C_RK, CV = (TYPE == 0) ? C_GV : (TYPE == 1) ? C_HI : C_RV, CG = (TYPE == 0) ? C_GG : (TYPE == 1) ? C_HG : C_RG;
    static constexpr int MIXOFF = (TYPE == 0) ? 0 : (TYPE == 1) ? 384 : 640; };
__device__ __forceinline__ float fast_logsig(float x) { x = fmaxf(x, -80.f); return -__logf(1.0f + __expf(-x)); }
__device__ __forceinline__ float ret_lg(int h) { return logf(1.0f - exp2f(-5.0f - (float)h)); }

template <int NV>
__device__ __forceinline__ void stage_vt(const bf16* pv  , LAS bf16* VT, int tid) {
    for (int idx = tid; idx < 2 * NV; idx += NTHR) { const int e = idx % NV, hf = idx / NV; const bf16* p = pv + (size_t)(32 * hf) * NPROJ + e;
#pragma unroll
        for (int q = 0; q < 4; ++q) { unsigned short b[8];
#pragma unroll
            for (int j = 0; j < 8; ++j) b[j] = p[(size_t)(8 * q + j) * NPROJ];
            v4u w; w.x = b[0] | ((unsigned)b[1] << 16); w.y = b[2] | ((unsigned)b[3] << 16); w.z = b[4] | ((unsigned)b[5] << 16); w.w = b[6] | ((unsigned)b[7] << 16);
            *(LAS v4u*)(VT + e * BP + 32 * hf + 8 * q) = w; } }
}

constexpr int LA_KT = 0, LA_VT = 36864, LA_TOT = 92160, LA_GA = 94208;
template <int TYPE>
__device__ __forceinline__ void mixa_batch(const Args& a, int layer, int unit, LAS unsigned char* lds, int tid, int lane, int wave) {
    typedef MixCfg<TYPE> C; constexpr int DK = C::DK, DV = C::DV, NC = C::NC, NV = C::NV;
    unsigned char* ws = a.ws; const bf16* PROJ = (const bf16*)(ws + WS_PROJ); float* CUM = (float*)(ws + WS_CUM); float* DVEC = (float*)(ws + WS_DVEC) + (size_t)unit * NDV;
    float* U = (float*)(ws + WS_U) + (size_t)unit * ST_TOT + C::STOFF;
    LAS bf16* KT = (LAS bf16*)(lds + LA_KT); LAS bf16* VT = (LAS bf16*)(lds + LA_VT); LAS float* TOT = (LAS float*)(lds + LA_TOT); const LAS float* GAs = (const LAS float*)(lds + LA_GA);
    const int row0 = unit * CH;
    const bool act = tid < 2 * NC; const int c = act ? tid % NC : 0, half = act ? tid / NC : 0, h = c / DK, d = c - h * DK;
    float cum[32]; float tot = 0.f;
    float w2[16], b2 = 0.f, lbv = 0.f, lg = 0.f, sg = 0.f; int f = 0, d2 = 0;
    if (act) {
        if constexpr (TYPE == 0) { b2 = a.gla_ba2[layer * 192 + c];
#pragma unroll
            for (int r = 0; r < 16; ++r) w2[r] = a.gla_wa2[(layer * 16 + r) * 192 + c]; }
        if constexpr (TYPE == 1) lbv = ((const float*)(ws + WS_LB))[layer * 256 + c];
        if constexpr (TYPE == 2) { lg = ret_lg(h); f = (d < 24) ? d : d - 24; d2 = (d < 24) ? d + 24 : d - 24; sg = (d < 24) ? -1.f : 1.f; }
#pragma unroll
        for (int i = 0; i < 32; ++i) { const int t = 32 * half + i; const bf16* pr = PROJ + (size_t)(row0 + t) * NPROJ; float g;
            if constexpr (TYPE == 0) { float pre = b2;
#pragma unroll
                for (int r = 0; r < 16; ++r) pre += GAs[t * 16 + r] * w2[r];
                g = fast_logsig(pre) * (1.0f / 16.0f); }
            else if constexpr (TYPE == 1) { const float hf = fminf(fmaxf(bf2f(pr[C_HF + c]), -80.f), 80.f); const float sgm = 1.0f / (1.0f + __expf(-hf));
                g = __logf(lbv + (1.0f - lbv) * sgm); }
            else g = lg;
            tot += g; cum[i] = tot;
            if ((i & 7) == 7) asm volatile("" ::: "memory"); }
        TOT[c * 2 + half] = tot;
    }
    stage_vt<NV>(PROJ + (size_t)row0 * NPROJ + C::CV, VT, tid);
    __syncthreads();
    if (act) { const float t0 = TOT[c * 2], t1 = TOT[c * 2 + 1]; const float off = half ? t0 : 0.f, last = t0 + t1;
#pragma unroll
        for (int q = 0; q < 4; ++q) { float kt[8];
#pragma unroll
            for (int j = 0; j < 8; ++j) { const int i = 8 * q + j; const float cm = cum[i] + off; const size_t row = (size_t)(row0 + 32 * half + i); const bf16* pr = PROJ + row * NPROJ; float k;
                if constexpr (TYPE == 0) k = bf2f(pr[C_GK + c]);
                else if constexpr (TYPE == 1) k = 1.0f - __expf(cum[i] - (i > 0 ? cum[i - 1] : 0.f));
                else { const float* rp = (const float*)(ws + WS_ROPE) + row * 48; k = bf2f(pr[C_RK + h * 48 + d]) * rp[f] + sg * bf2f(pr[C_RK + h * 48 + d2]) * rp[24 + f]; }
                if constexpr (TYPE != 2) CUM[row * NDV + C::COFF + c] = cm;
                kt[j] = k * __expf(last - cm); }
            v4u w; w.x = pk2(kt[0], kt[1]); w.y = pk2(kt[2], kt[3]); w.z = pk2(kt[4], kt[5]); w.w = pk2(kt[6], kt[7]);
            *(LAS v4u*)(KT + c * BP + 32 * half + 8 * q) = w;
            asm volatile("" ::: "memory"); }
        if (TYPE != 2 && half == 0) DVEC[C::COFF + c] = __expf(last);
    }
    __syncthreads();
    constexpr int TD = DK / 16, NT = (DV / 16) * TD;
    for (int ti = wave; ti < 4 * NT; ti += NWAVES) { const int hh = ti / NT, tr = ti - hh * NT, te = tr / TD, td = tr - te * TD; f32x4 acc = {0.f, 0.f, 0.f, 0.f};
#pragma unroll
        for (int kk = 0; kk < 2; ++kk) acc = __builtin_amdgcn_mfma_f32_16x16x32_bf16(ldfrag(VT, BP, hh * DV + te * 16, kk * 32, lane), ldfrag(KT, BP, hh * DK + td * 16, kk * 32, lane), acc, 0, 0, 0);
        float* Uh = U + hh * DK * DV;
#pragma unroll
        for (int r = 0; r < 4; ++r) Uh[(te * 16 + (lane >> 4) * 4 + r) * DK + td * 16 + (lane & 15)] = acc[r]; }
    __syncthreads();
}
__device__ __forceinline__ void p3a_summaries(const Args& a, int layer, LAS unsigned char* lds, int vcu, int G, int tid, int lane, int wave) {
    for (int unit = vcu; unit < NUNIT; unit += G) {
        { LAS float* GAs = (LAS float*)(lds + LA_GA); const float* GA = (const float*)(a.ws + WS_GA); for (int i = tid; i < CH * 16; i += NTHR) GAs[i] = GA[(size_t)unit * CH * 16 + i]; }
        __syncthreads();
        mixa_batch<0>(a, layer, unit, lds, tid, lane, wave);
        mixa_batch<1>(a, layer, unit, lds, tid, lane, wave);
        mixa_batch<2>(a, layer, unit, lds, tid, lane, wave);
    }
}

__device__ __forceinline__ void p3b_scan(const Args& a, int vcu, int G, int tid) {
    unsigned char* ws = a.ws; const float* U = (const float*)(ws + WS_U); const float* DVEC = (const float*)(ws + WS_DVEC); bf16* SP = (bf16*)(ws + WS_SP);
    for (int gid = vcu * NTHR + tid; gid < BATCH * ST_TOT; gid += G * NTHR) {
        const int b = gid / ST_TOT, el = gid - b * ST_TOT;
        int di = -1; float cdec = 0.f;
        if (el < ST_HG) { const int h = el / 4608, d = (el - h * 4608) % 48; di = h * 48 + d; }
        else if (el < ST_RET) { const int r = el - ST_HG, h = r / 4096, d = r % 64; di = 192 + h * 64 + d; }
        else { const int h = (el - ST_RET) / 4608; cdec = expf(64.0f * logf(1.0f - exp2f(-5.0f - (float)h))); }
        const float* up = U + (size_t)b * NCH * ST_TOT + el; const float* dp = DVEC + (size_t)b * NCH * NDV + (di < 0 ? 0 : di); bf16* sp = SP + (size_t)b * NCH * ST_TOT + el;
        float s = 0.f;
        for (int n0 = 0; n0 < NCH; n0 += 8) { float u[8], dc[8];
#pragma unroll
            for (int i = 0; i < 8; ++i) { u[i] = up[(size_t)(n0 + i) * ST_TOT]; dc[i] = (di < 0) ? cdec : dp[(size_t)(n0 + i) * NDV]; }
#pragma unroll
            for (int i = 0; i < 8; ++i) { sp[(size_t)(n0 + i) * ST_TOT] = (bf16)f2bf(s); s = dc[i] * s + u[i]; } }
    }
}

constexpr int LC_VT = 0, LC_ST = 55296, LC_AB = 110592;
template <int TYPE, bool ISQ>
__device__ __forceinline__ void mix_frag(const Args& a, int h, size_t row, int t, int d0, float (&x)[8], float (&cm)[8]) {
    typedef MixCfg<TYPE> C; constexpr int DK = C::DK;
    unsigned char* ws = a.ws; const bf16* pr = (const bf16*)(ws + WS_PROJ) + row * NPROJ;
    if constexpr (TYPE == 0) {
        const v4u p = *(const v4u*)(pr + (ISQ ? C_GQ : C_GK) + h * DK + d0); const unsigned pw[4] = {p.x, p.y, p.z, p.w};
        const float* cp = (const float*)(ws + WS_CUM) + row * NDV + h * DK + d0; const f32x4 c0 = *(const f32x4*)cp, c1 = *(const f32x4*)(cp + 4);
#pragma unroll
        for (int j = 0; j < 4; ++j) { x[2 * j] = __builtin_bit_cast(float, pw[j] << 16); x[2 * j + 1] = __builtin_bit_cast(float, pw[j] & 0xffff0000u); cm[j] = c0[j]; cm[4 + j] = c1[j]; }
        if (ISQ) {
#pragma unroll
            for (int j = 0; j < 8; ++j) x[j] *= 0.14433756729740643f; }
    } else if constexpr (TYPE == 1) {
        const float* cp = (const float*)(ws + WS_CUM) + row * NDV + 192 + h * DK + d0; const f32x4 c0 = *(const f32x4*)cp, c1 = *(const f32x4*)(cp + 4);
#pragma unroll
        for (int j = 0; j < 4; ++j) { cm[j] = c0[j]; cm[4 + j] = c1[j]; }
        if (ISQ) { const v4u p = *(const v4u*)(pr + C_HQ + h * DK + d0); const unsigned pw[4] = {p.x, p.y, p.z, p.w};
#pragma unroll
            for (int j = 0; j < 4; ++j) { x[2 * j] = __builtin_bit_cast(float, pw[j] << 16); x[2 * j + 1] = __builtin_bit_cast(float, pw[j] & 0xffff0000u); } }
        else { f32x4 p0 = {0.f, 0.f, 0.f, 0.f}, p1 = {0.f, 0.f, 0.f, 0.f}; if (t > 0) { p0 = *(const f32x4*)(cp - NDV); p1 = *(const f32x4*)(cp - NDV + 4); }
#pragma unroll
            for (int j = 0; j < 4; ++j) { x[j] = -expm1f(c0[j] - p0[j]); x[4 + j] = -expm1f(c1[j] - p1[j]); } }
    } else {
        const int f0 = (d0 < 24) ? d0 : d0 - 24, dp = (d0 < 24) ? d0 + 24 : d0 - 24; const float sg = (d0 < 24) ? -1.f : 1.f;
        const int cb = (ISQ ? C_RQ : C_RK) + h * DK; const v4u p = *(const v4u*)(pr + cb + d0), pp = *(const v4u*)(pr + cb + dp); const unsigned pw[4] = {p.x, p.y, p.z, p.w}, qw[4] = {pp.x, pp.y, pp.z, pp.w};
        const float* rp = (const float*)(ws + WS_ROPE) + row * 48; const f32x4 cs0 = *(const f32x4*)(rp + f0), cs1 = *(const f32x4*)(rp + f0 + 4), sn0 = *(const f32x4*)(rp + 24 + f0), sn1 = *(const f32x4*)(rp + 24 + f0 + 4);
        const float cmv = (float)(t + 1) * ret_lg(h);
#pragma unroll
        for (int j = 0; j < 4; ++j) { const float xa = __builtin_bit_cast(float, pw[j] << 16), xb = __builtin_bit_cast(float, pw[j] & 0xffff0000u), ya = __builtin_bit_cast(float, qw[j] << 16), yb = __builtin_bit_cast(float, qw[j] & 0xffff0000u);
            const float ca = (j < 2) ? cs0[2 * j] : cs1[2 * j - 4], cb2 = (j < 2) ? cs0[2 * j + 1] : cs1[2 * j - 3], sa = (j < 2) ? sn0[2 * j] : sn1[2 * j - 4], sb = (j < 2) ? sn0[2 * j + 1] : sn1[2 * j - 3];
            x[2 * j] = xa * ca + sg * ya * sa; x[2 * j + 1] = xb * cb2 + sg * yb * sb; cm[2 * j] = cmv; cm[2 * j + 1] = cmv; }
        if (ISQ) {
#pragma unroll
            for (int j = 0; j < 8; ++j) x[j] *= 0.14433756729740643f; }
    }
}
__device__ __forceinline__ pg8::bf16x8 pack8(const float (&v)[8]) { v4u w; w.x = pk2(v[0], v[1]); w.y = pk2(v[2], v[3]); w.z = pk2(v[4], v[5]); w.w = pk2(v[6], v[7]); return __builtin_bit_cast(pg8::bf16x8, w); }

template <int TYPE>
__device__ __forceinline__ void mixc_batch(const Args& a, int layer, int unit, LAS unsigned char* lds, int tid, int lane, int wave) {
    typedef MixCfg<TYPE> C; constexpr int DK = C::DK, DV = C::DV, NV = C::NV, TE = DV / 16;
    unsigned char* ws = a.ws; const bf16* PROJ = (const bf16*)(ws + WS_PROJ); bf16* MIX = (bf16*)(ws + WS_MIX);
    LAS bf16* VT = (LAS bf16*)(lds + LC_VT); LAS bf16* ST = (LAS bf16*)(lds + LC_ST); LAS bf16* AB = (LAS bf16*)(lds + LC_AB) + wave * 16 * BP;
    const int row0 = unit * CH;
    stage_vt<NV>(PROJ + (size_t)row0 * NPROJ + C::CV, VT, tid);
    { const bf16* SPu = (const bf16*)(ws + WS_SP) + (size_t)unit * ST_TOT + C::STOFF;
        for (int idx = tid; idx < NV * 8; idx += NTHR) { const int er = idx >> 3, ch = idx & 7; v4u w = {0u, 0u, 0u, 0u}; if (ch * 8 < DK) w = *(const v4u*)(SPu + (size_t)er * DK + ch * 8); *(LAS v4u*)(ST + er * BP + ch * 8) = w; } }
    __syncthreads();
    const int h = wave >> 1, hsel = wave & 1, r = lane & 15, g = lane >> 4;
    const LAS bf16* STh = ST + h * DV * BP; const LAS bf16* VTh = VT + h * DV * BP;
    const float* CUMp = (const float*)(ws + WS_CUM);
    for (int ib = 0; ib < 2; ++ib) { const int I = ib ? 3 - hsel : hsel;
        pg8::bf16x8 qh[2], qt[2]; float refv[2][8];
#pragma unroll
        for (int s = 0; s < 2; ++s) { const int d0 = 32 * s + 8 * g; const bool valid = d0 < DK; const int d0c = valid ? d0 : 0;
            float x[8], cm[8]; mix_frag<TYPE, true>(a, h, (size_t)(row0 + 16 * I + r), 16 * I + r, d0c, x, cm);
            if constexpr (TYPE == 2) {
#pragma unroll
                for (int j = 0; j < 8; ++j) refv[s][j] = (float)(16 * I) * ret_lg(h);
            } else { if (I > 0) { const float* cp = CUMp + (size_t)(row0 + 16 * I - 1) * NDV + C::COFF + h * DK + d0c; const f32x4 c0 = *(const f32x4*)cp, c1 = *(const f32x4*)(cp + 4);
#pragma unroll
                    for (int j = 0; j < 4; ++j) { refv[s][j] = c0[j]; refv[s][4 + j] = c1[j]; } }
                else {
#pragma unroll
                    for (int j = 0; j < 8; ++j) refv[s][j] = 0.f; } }
            float xh[8], xt[8];
#pragma unroll
            for (int j = 0; j < 8; ++j) { xh[j] = valid ? x[j] * __expf(cm[j] - refv[s][j]) : 0.f; xt[j] = valid ? x[j] * __expf(cm[j]) : 0.f; }
            qh[s] = pack8(xh); qt[s] = pack8(xt); }
        for (int J = 0; J <= I; ++J) { f32x4 acc = {0.f, 0.f, 0.f, 0.f};
#pragma unroll
            for (int s = 0; s < 2; ++s) { const int d0 = 32 * s + 8 * g; const bool valid = d0 < DK; const int d0c = valid ? d0 : 0;
                float x[8], cm[8]; mix_frag<TYPE, false>(a, h, (size_t)(row0 + 16 * J + r), 16 * J + r, d0c, x, cm);
                float xk[8];
#pragma unroll
                for (int j = 0; j < 8; ++j) xk[j] = valid ? x[j] * __expf(fminf(refv[s][j] - cm[j], 80.f)) : 0.f;
                acc = __builtin_amdgcn_mfma_f32_16x16x32_bf16(qh[s], pack8(xk), acc, 0, 0, 0); }
#pragma unroll
            for (int q = 0; q < 4; ++q) { const int i = 4 * g + q; const float v = (J < I || r <= i) ? acc[q] : 0.f; AB[i * BP + 16 * J + r] = (bf16)f2bf(v); } }
        if ((I & 1) == 0) {
#pragma unroll
            for (int q = 0; q < 4; ++q) AB[(4 * g + q) * BP + 16 * (I + 1) + r] = (bf16)0; }
        asm volatile("s_waitcnt lgkmcnt(0)" ::: "memory");
        const pg8::bf16x8 ah0 = *(const LAS pg8::bf16x8*)(AB + r * BP + 8 * g), ah1 = *(const LAS pg8::bf16x8*)(AB + r * BP + 32 + 8 * g);
        f32x4 o[TE];
#pragma unroll
        for (int te = 0; te < TE; ++te) { f32x4 acc = {0.f, 0.f, 0.f, 0.f};
            acc = __builtin_amdgcn_mfma_f32_16x16x32_bf16(qt[0], ldfrag(STh, BP, te * 16, 0, lane), acc, 0, 0, 0);
            acc = __builtin_amdgcn_mfma_f32_16x16x32_bf16(qt[1], ldfrag(STh, BP, te * 16, 32, lane), acc, 0, 0, 0);
            acc = __builtin_amdgcn_mfma_f32_16x16x32_bf16(ah0, ldfrag(VTh, BP, te * 16, 0, lane), acc, 0, 0, 0);
            if (I >= 2) acc = __builtin_amdgcn_mfma_f32_16x16x32_bf16(ah1, ldfrag(VTh, BP, te * 16, 32, lane), acc, 0, 0, 0);
            o[te] = acc; }
#pragma unroll
        for (int q = 0; q < 4; ++q) { float s1 = 0.f, s2 = 0.f;
#pragma unroll
            for (int te = 0; te < TE; ++te) { s1 += o[te][q]; s2 += o[te][q] * o[te][q]; }
#pragma unroll
            for (int m = 1; m < 16; m <<= 1) { s1 += __shfl_xor(s1, m); s2 += __shfl_xor(s2, m); }
            const size_t row = (size_t)(row0 + 16 * I + 4 * g + q); const bf16* pr = PROJ + row * NPROJ + C::CG + h * DV; bf16* mo = MIX + row * D + C::MIXOFF + h * DV;
            float mean = 0.f, rstd;
            if constexpr (TYPE == 2) { mean = s1 * (1.0f / DV); rstd = 1.0f / sqrtf(fmaxf(s2 * (1.0f / DV) - mean * mean, 0.f) + EPS); }
            else rstd = 1.0f / sqrtf(s2 * (1.0f / DV) + EPS);
#pragma unroll
            for (int te = 0; te < TE; ++te) { const int e = te * 16 + r; const float gt = bf2f(pr[e]); float v;
                if constexpr (TYPE == 0) v = o[te][q] * rstd * a.gla_norm_w[layer * 384 + h * 96 + e] * (gt / (1.0f + __expf(-gt)));
                else if constexpr (TYPE == 1) v = o[te][q] * rstd * a.hg_norm_w[layer * 256 + h * 64 + e] * (1.0f / (1.0f + __expf(-gt)));
                else v = (o[te][q] - mean) * rstd * (gt / (1.0f + __expf(-gt)));
                mo[e] = (bf16)f2bf(v); } }
    }
    __syncthreads();
}
__device__ __forceinline__ void p3c_outputs(const Args& a, int layer, LAS unsigned char* lds, int vcu, int G, int tid, int lane, int wave) {
    for (int unit = vcu; unit < NUNIT; unit += G) {
        mixc_batch<0>(a, layer, unit, lds, tid, lane, wave);
        mixc_batch<1>(a, layer, unit, lds, tid, lane, wave);
        mixc_batch<2>(a, layer, unit, lds, tid, lane, wave);
    }
}

constexpr int MW_ARGS = 800;
__device__ __forceinline__ const void* ld_argp(const volatile LAS unsigned* T, int i) {
    const unsigned lo = __builtin_amdgcn_readfirstlane(T[2 * i]), hi = __builtin_amdgcn_readfirstlane(T[2 * i + 1]);
    return (const void*)(((unsigned long long)hi << 32) | lo);
}
__device__ __forceinline__ Args load_args(LAS unsigned char* lds) {
    const volatile LAS unsigned* T = (const volatile LAS unsigned*)(lds + MISC_OFF) + MW_ARGS;
    Args a;
    a.x = (const float*)ld_argp(T, 0); a.c = (const float*)ld_argp(T, 1); a.pos = (const int*)ld_argp(T, 2); a.w_mod = (const float*)ld_argp(T, 3); a.b_mod = (const float*)ld_argp(T, 4);
    a.norm1_w = (const float*)ld_argp(T, 5); a.w_in = (const float*)ld_argp(T, 6); a.gla_wa2 = (const float*)ld_argp(T, 7); a.gla_ba2 = (const float*)ld_argp(T, 8); a.hg_lb = (const float*)ld_argp(T, 9);
    a.gla_norm_w = (const float*)ld_argp(T, 10); a.hg_norm_w = (const float*)ld_argp(T, 11); a.w_out = (const float*)ld_argp(T, 12); a.norm2_w = (const float*)ld_argp(T, 13); a.w_r = (const float*)ld_argp(T, 14);
    a.b_r = (const float*)ld_argp(T, 15); a.w_gu = (const float*)ld_argp(T, 16); a.b_gu = (const float*)ld_argp(T, 17); a.w_dn = (const float*)ld_argp(T, 18); a.b_dn = (const float*)ld_argp(T, 19);
    a.final_norm_w = (const float*)ld_argp(T, 20); a.out = (float*)ld_argp(T, 21); a.ws = (unsigned char*)ld_argp(T, 22); a.ph_lo = 0; a.ph_hi = 0;
    return a;
}
#define PH_CTX() { unsigned l_ = (unsigned)(size_t)lds; asm volatile("" : "+s"(l_)); lds = (LAS unsigned char*)(size_t)l_; } const Args args = load_args(lds); volatile LAS unsigned* MISC = (volatile LAS unsigned*)(lds + MISC_OFF); int tid_ = threadIdx.x; asm volatile("" : "+v"(tid_)); const int tid = tid_, lane = tid & 63, wave = __builtin_amdgcn_readfirstlane(tid >> 6); \
    const int G = gridDim.x; const int bx = blockIdx.x; const int vcu = (G % 8 == 0) ? (bx % 8) * (G / 8) + bx / 8 : bx; unsigned char* ws = args.ws; gu32* ctl = (gu32*)(ws + WS_CTL); \
    (void)MISC; (void)lane; (void)wave; (void)vcu; (void)ctl; (void)bx; (void)tid
__device__ __forceinline__ void ph_p0(LAS unsigned char* lds) { PH_CTX(); p0_prologue(args, lds, vcu, G, tid, lane, wave); }
__device__ __forceinline__ void ph_p1(LAS unsigned char* lds, int layer_) { int layer = __builtin_amdgcn_readfirstlane(layer_); asm volatile("" : "+s"(layer)); PH_CTX(); p1_rows(args, layer, lds, vcu, G, tid, lane, wave); }
__device__ __forceinline__ void ph_p2(LAS unsigned char* lds, int layer_) { int layer = __builtin_amdgcn_readfirstlane(layer_); asm volatile("" : "+s"(layer)); PH_CTX();
    pg8::Gemm g{(const bf16*)(ws + WS_H), (const bf16*)(ws + WS_WIN) + (size_t)layer * NPROJ * D, MTOK, NPROJ, D}; pg8::StaticOrder S; S.init(MTOK, NPROJ, G, bx);
    pg8::EpiBf16Plain E{(bf16*)(ws + WS_PROJ), NPROJ};
    pg8::gemm_phase<pg8::EpiBf16Plain, pg8::StaticOrder, true, true>(lds, g, S, E); }
__device__ __forceinline__ void ph_p3a(LAS unsigned char* lds, int layer_) { int layer = __builtin_amdgcn_readfirstlane(layer_); asm volatile("" : "+s"(layer)); PH_CTX(); p3a_summaries(args, layer, lds, vcu, G, tid, lane, wave); }
__device__ __forceinline__ void ph_p3b(LAS unsigned char* lds) { PH_CTX(); p3b_scan(args, vcu, G, tid); }
__device__ __forceinline__ void ph_p3c(LAS unsigned char* lds, int layer_) { int layer = __builtin_amdgcn_readfirstlane(layer_); asm volatile("" : "+s"(layer)); PH_CTX(); p3c_outputs(args, layer, lds, vcu, G, tid, lane, wave); }
__device__ __forceinline__ void ph_p4(LAS unsigned char* lds, int layer_) { int layer = __builtin_amdgcn_readfirstlane(layer_); asm volatile("" : "+s"(layer)); PH_CTX();
    pg8::Gemm g{(const bf16*)(ws + WS_MIX), (const bf16*)(ws + WS_WOUT) + (size_t)layer * D * D, MTOK, D, D}; pg8::StaticOrder S; S.init(MTOK, D, G, bx);
    pg8::EpiResGate E{(layer == 0) ? args.x : (const float*)(ws + WS_X), (float*)(ws + WS_X), D, (const float*)(ws + WS_MOD) + (size_t)layer * 2 * 6144 + 2 * D, 6144, SEQ};
    pg8::gemm_phase<pg8::EpiResGate, pg8::StaticOrder, true, true>(lds, g, S, E); }
__device__ __forceinline__ void ph_p5(LAS unsigned char* lds, int layer_) { int layer = __builtin_amdgcn_readfirstlane(layer_); asm volatile("" : "+s"(layer)); PH_CTX(); p5_rows(args, layer, lds, MISC, ctl, vcu, G, tid, lane, wave); }
__device__ __forceinline__ void ph_p6(LAS unsigned char* lds, int layer_) { int layer = __builtin_amdgcn_readfirstlane(layer_); asm volatile("" : "+s"(layer)); PH_CTX(); p6_dispatch(args, layer, MISC, ctl, vcu, G, tid, lane, wave); }
__device__ __forceinline__ void ph_p7(LAS unsigned char* lds, int layer_) { int layer = __builtin_amdgcn_readfirstlane(layer_); asm volatile("" : "+s"(layer)); PH_CTX();
    moe_tables(ctl, layer, MISC, tid);
    const int nrt = __builtin_amdgcn_readfirstlane((int)MISC[MW_NRT]);
    pg8::Gemm g{(const bf16*)(ws + WS_A1), (const bf16*)(ws + WS_WGU) + (size_t)layer * NE * 2048 * D, nrt * 256, NE * 2048, D};
    pg8::MoeOrder S{8, G, vcu, nrt * 8, (const LAS int*)(lds + MISC_OFF + 4 * MW_TILE)};
    pg8::EpiSwiglu E{(bf16*)(ws + WS_ACT), FFN, args.b_gu + (size_t)layer * NE * 2048};
    pg8::gemm_phase<pg8::EpiSwiglu, pg8::MoeOrder, true, true>(lds, g, S, E); }
__device__ __forceinline__ void ph_p8(LAS unsigned char* lds, int layer_) { int layer = __builtin_amdgcn_readfirstlane(layer_); asm volatile("" : "+s"(layer)); PH_CTX();
    moe_tables(ctl, layer, MISC, tid);
    const int nrt = __builtin_amdgcn_readfirstlane((int)MISC[MW_NRT]);
    pg8::Gemm g{(const bf16*)(ws + WS_ACT), (const bf16*)(ws + WS_WDN) + (size_t)layer * NE * D * FFN, nrt * 256, NE * D, FFN};
    pg8::MoeOrder S{4, G, vcu, nrt * 4, (const LAS int*)(lds + MISC_OFF + 4 * MW_TILE)};
    pg8::EpiBf16Bias E{(bf16*)(ws + WS_Y), D, args.b_dn + (size_t)layer * NE * D, D};
    pg8::gemm_phase<pg8::EpiBf16Bias, pg8::MoeOrder, true, true>(lds, g, S, E); }
__device__ __forceinline__ void ph_final(LAS unsigned char* lds) { PH_CTX(); final_rows(args, vcu, G, lane, wave); }

#ifndef DBL_MASK
#define DBL_MASK 0
#endif
#if DBL_MASK
__device__ __forceinline__ int opaque_i(int v) { asm volatile("" : "+s"(v)); return v; }
#define RUN(bit, call) do { const int nrep_ = opaque_i(1 + ((DBL_MASK >> (bit)) & 1)); _Pragma("unroll 1") for (int rep_ = 0; rep_ < nrep_; ++rep_) { call; } } while (0)
#else
#define RUN(bit, call) do { call; } while (0)
#endif
__global__ void __launch_bounds__(NTHR, 2) hybrid_fwd(Args args) {
    extern __shared__ __attribute__((aligned(16))) unsigned char lds_raw[];
    LAS unsigned char* lds = (LAS unsigned char*)lds_raw;
    volatile LAS unsigned* MISC = (volatile LAS unsigned*)(lds + MISC_OFF);
    const int tid = threadIdx.x;
    gu32* ctl = (gu32*)(args.ws + WS_CTL);
    for (int u = tid; u < (LDS_BYTES - MISC_OFF) / 4; u += NTHR) MISC[u] = 0u;
    __syncthreads();
    if (tid == 0) {
#define ST_ARG(i, p) do { const unsigned long long v_ = (unsigned long long)(p); MISC[MW_ARGS + 2 * (i)] = (unsigned)v_; MISC[MW_ARGS + 2 * (i) + 1] = (unsigned)(v_ >> 32); } while (0)
        ST_ARG(0, args.x); ST_ARG(1, args.c); ST_ARG(2, args.pos); ST_ARG(3, args.w_mod); ST_ARG(4, args.b_mod); ST_ARG(5, args.norm1_w); ST_ARG(6, args.w_in); ST_ARG(7, args.gla_wa2); ST_ARG(8, args.gla_ba2);
        ST_ARG(9, args.hg_lb); ST_ARG(10, args.gla_norm_w); ST_ARG(11, args.hg_norm_w); ST_ARG(12, args.w_out); ST_ARG(13, args.norm2_w); ST_ARG(14, args.w_r); ST_ARG(15, args.b_r); ST_ARG(16, args.w_gu);
        ST_ARG(17, args.b_gu); ST_ARG(18, args.w_dn); ST_ARG(19, args.b_dn); ST_ARG(20, args.final_norm_w); ST_ARG(21, args.out); ST_ARG(22, args.ws);
#undef ST_ARG
    }
    __syncthreads();
    const int lo = args.ph_lo, hi = args.ph_hi;
    const bool multi = (hi - lo) > 1;
    XcdBarrier bar; bar.bar = (unsigned*)(ctl + CW_BAR); bar.x = 0; bar.st = nullptr;
    if (multi) bar = xcd_barrier_post((unsigned*)(ctl + CW_BAR), MISC + MW_BAR);
#define IN(k) (lo <= (k) && (k) < hi)
#define SEAM(k) do { if (IN(k) && IN((k) + 1)) xcd_barrier(bar); } while (0)

    if (IN(0)) RUN(0, ph_p0(lds));
    SEAM(0);
    for (int layer = 0; layer < DEPTH; ++layer) {
        const int pb = 1 + 10 * layer;
        if (IN(pb + 0)) RUN(1, ph_p1(lds, layer));
        SEAM(pb + 0);
        if (IN(pb + 1)) RUN(2, ph_p2(lds, layer));
        SEAM(pb + 1);
        if (IN(pb + 2)) RUN(3, ph_p3a(lds, layer));
        SEAM(pb + 2);
        if (IN(pb + 3)) RUN(4, ph_p3b(lds));
        SEAM(pb + 3);
        if (IN(pb + 4)) RUN(5, ph_p3c(lds, layer));
        SEAM(pb + 4);
        if (IN(pb + 5)) RUN(6, ph_p4(lds, layer));
        SEAM(pb + 5);
        if (IN(pb + 6)) RUN(7, ph_p5(lds, layer));
        SEAM(pb + 6);
        if (IN(pb + 7)) RUN(8, ph_p6(lds, layer));
        SEAM(pb + 7);
        if (IN(pb + 8)) RUN(9, ph_p7(lds, layer));
        SEAM(pb + 8);
        if (IN(pb + 9)) RUN(10, ph_p8(lds, layer));
        SEAM(pb + 9);
    }
    if (IN(NPHASE - 1)) ph_final(lds);
#undef IN
#undef SEAM
}

#ifndef MK_SINGLE
#define MK_SINGLE 1
#endif
extern "C" void kernel_launch(void* const* d_in, const int* in_sizes, int n_in, void* d_out, int out_size, void* d_ws, size_t ws_size, hipStream_t stream) {
    static int grid = 0;
    if (grid == 0) {
        if (n_in != 21 || in_sizes[0] != MTOK * D || out_size != MTOK * D || ws_size < WS_END) { fprintf(stderr, "kernel_launch: unexpected problem shape (n_in %d, in0 %d, out %d, ws %zu)\n", n_in, n_in > 0 ? in_sizes[0] : -1, out_size, ws_size); grid = -1; return; }
        int dev = 0, cus = 0, per_cu = 0;
        if (hipGetDevice(&dev) != hipSuccess || hipDeviceGetAttribute(&cus, hipDeviceAttributeMultiprocessorCount, dev) != hipSuccess) { grid = -1; return; }
        if (hipFuncSetAttribute((const void*)hybrid_fwd, hipFuncAttributeMaxDynamicSharedMemorySize, LDS_BYTES) != hipSuccess) { fprintf(stderr, "kernel_launch: hipFuncSetAttribute failed\n"); grid = -1; return; }
        if (hipOccupancyMaxActiveBlocksPerMultiprocessor(&per_cu, (const void*)hybrid_fwd, NTHR, LDS_BYTES) != hipSuccess || per_cu < 1) fprintf(stderr, "kernel_launch: occupancy query says %d\n", per_cu);
        (void)hipGetLastError();
        grid = cus;
    }
    if (grid < 0) return;
    (void)hipMemsetAsync((char*)d_ws + WS_CTL, 0, CTL_ZERO_BYTES, stream);
    Args a{};
    a.x = (const float*)d_in[0]; a.c = (const float*)d_in[1]; a.pos = (const int*)d_in[2]; a.w_mod = (const float*)d_in[3]; a.b_mod = (const float*)d_in[4]; a.norm1_w = (const float*)d_in[5];
    a.w_in = (const float*)d_in[6]; a.gla_wa2 = (const float*)d_in[7]; a.gla_ba2 = (const float*)d_in[8]; a.hg_lb = (const float*)d_in[9]; a.gla_norm_w = (const float*)d_in[10]; a.hg_norm_w = (const float*)d_in[11];
    a.w_out = (const float*)d_in[12]; a.norm2_w = (const float*)d_in[13]; a.w_r = (const float*)d_in[14]; a.b_r = (const float*)d_in[15]; a.w_gu = (const float*)d_in[16]; a.b_gu = (const float*)d_in[17];
    a.w_dn = (const float*)d_in[18]; a.b_dn = (const float*)d_in[19]; a.final_norm_w = (const float*)d_in[20]; a.out = (float*)d_out; a.ws = (unsigned char*)d_ws;
#if MK_SINGLE
    a.ph_lo = 0; a.ph_hi = NPHASE;
    hipLaunchKernelGGL(hybrid_fwd, dim3(grid), dim3(NTHR), LDS_BYTES, stream, a);
#else
    for (int p = 0; p < NPHASE; ++p) { a.ph_lo = p; a.ph_hi = p + 1; hipLaunchKernelGGL(hybrid_fwd, dim3(grid), dim3(NTHR), LDS_BYTES, stream, a); }
#endif
}
```

```cpp
#include <hip/hip_runtime.h>
#include <cstdio>
#include <cstdint>
namespace pg8 {
#define PG8_LAS __attribute__((address_space(3)))
typedef unsigned short bf16_t;
typedef short bf16x8 __attribute__((ext_vector_type(8)));
typedef float f32x4 __attribute__((ext_vector_type(4)));
typedef unsigned u32x4 __attribute__((ext_vector_type(4)));
constexpr int BM = 256, BK = 64, HALF = 128, HTB = HALF * BK * 2  , STAGE_BYTES = 8 * HTB, NXCD = 8, WGM = 8;

__host__ __device__ __forceinline__ int lds_byte(int r, int c) { const int st = (r >> 4) * 2 + (c >> 5), rr = r & 15, cc = c & 31, ob = rr * 64 + cc * 2; return st * 1024 + (ob ^ (((ob >> 9) & 1) << 5)); }
__host__ __device__ __forceinline__ void stage_rc(int b, int& R, int& C) { const int st = b / 1024, sb = b % 1024, swz = sb ^ (((sb >> 9) & 1) << 5); R = (st >> 1) * 16 + swz / 64; C = (st & 1) * 32 + (swz % 64) / 2; }
__host__ __device__ __forceinline__ int perm32(int rho) { const int n = rho >> 4, i = rho & 15; return 8 * (i >> 2) + 4 * n + (i & 3); }

struct Unit { int pm, pn, e, pl; };
struct Gemm { const bf16_t* A; const bf16_t* Bt; int M, N, K; };

struct StaticOrder {
    int nM, nN, nwg, G, c;
    __host__ __device__ void init(int M, int N, int G_, int c_) { nM = M / BM; nN = N / BM; nwg = nM * nN; G = G_; c = c_; }
    __host__ __device__ bool next(int i, Unit& u) const {
        const long L = (long)i * G + c; if (L >= nwg) return false;
        int wgid = (int)L; { const int q = nwg / NXCD, r = nwg % NXCD, xcd = wgid % NXCD, off = wgid / NXCD; wgid = (xcd < r ? xcd * (q + 1) : r * (q + 1) + (xcd - r) * q) + off; }
        const int nig = WGM * nN, gid = wgid / nig, fm = gid * WGM, gsz = (nM - fm) < WGM ? (nM - fm) : WGM;
        u.pm = fm + ((wgid % nig) % gsz); u.pn = (wgid % nig) / gsz; u.e = 0; u.pl = u.pn; return true;
    }
    __device__ __forceinline__ void a_ready(const Unit&) const {}
    __device__ __forceinline__ void done(const Unit&) const {}
};

__device__ __forceinline__ unsigned cvt_pk_bf16(float lo, float hi) { unsigned r; asm volatile("v_cvt_pk_bf16_f32 %0, %1, %2" : "=v"(r) : "v"(lo), "v"(hi)); return r; }

struct EpiBf16Plain {
    static constexpr bool PERM = true, AFTER_DRAIN = false;
    bf16_t* O; int ldc;
    __device__ __forceinline__ void operator()(const f32x4 (&acc)[2][2][4][2], const Unit& u, int wr, int wc, int fr, int fq) const {
        const int row0 = u.pm * BM + wr * 64 + fr; const int col0 = u.pn * BM + wc * 32 + 8 * fq;
#pragma unroll
        for (int ai = 0; ai < 2; ++ai)
#pragma unroll
            for (int m = 0; m < 4; ++m) { bf16_t* rowp = O + (size_t)(row0 + ai * HALF + m * 16) * ldc + col0;
#pragma unroll
                for (int bj = 0; bj < 2; ++bj) { const f32x4 v0 = acc[ai][bj][m][0], v1 = acc[ai][bj][m][1];
                    u32x4 w; w.x = cvt_pk_bf16(v0[0], v0[1]); w.y = cvt_pk_bf16(v0[2], v0[3]); w.z = cvt_pk_bf16(v1[0], v1[1]); w.w = cvt_pk_bf16(v1[2], v1[3]);
                    *(u32x4*)(rowp + bj * HALF) = w; } }
    }
};
struct EpiResGate {
    static constexpr bool PERM = false, AFTER_DRAIN = false;
    const float* base; float* out; int ldc; const float* gate; int gpitch; int rows_per_batch;
    __device__ __forceinline__ void operator()(const f32x4 (&acc)[2][2][4][2], const Unit& u, int wr, int wc, int fr, int fq) const {
        const int row0 = u.pm * BM + wr * 64 + fr, col0 = u.pn * BM + wc * 32 + 4 * fq;
        const float* gp = gate + (size_t)((u.pm * BM) / rows_per_batch) * gpitch + col0;
        f32x4 gv[2][2];
#pragma unroll
        for (int bj = 0; bj < 2; ++bj)
#pragma unroll
            for (int n = 0; n < 2; ++n) gv[bj][n] = *(const f32x4*)(gp + bj * HALF + n * 16);
#pragma unroll
        for (int ai = 0; ai < 2; ++ai)
#pragma unroll
            for (int m = 0; m < 4; ++m) { const size_t off = (size_t)(row0 + ai * HALF + m * 16) * ldc + col0;
#pragma unroll
                for (int bj = 0; bj < 2; ++bj)
#pragma unroll
                    for (int n = 0; n < 2; ++n) { const f32x4 bs = *(const f32x4*)(base + off + bj * HALF + n * 16);
                        *(f32x4*)(out + off + bj * HALF + n * 16) = bs + gv[bj][n] * acc[ai][bj][m][n]; }
                asm volatile("" ::: "memory"); }
    }
};
struct EpiSwiglu {
    static constexpr bool PERM = true, AFTER_DRAIN = false;
    bf16_t* O; int ldc; const float* bias;
    __device__ __forceinline__ float act1(float g, float up) const {
        g = fminf(g, 7.0f); up = fminf(fmaxf(up, -7.0f), 7.0f);
        const float s = 1.0f / (1.0f + __expf(-1.702f * g));
        return (up + 1.0f) * g * s;
    }
    __device__ __forceinline__ void operator()(const f32x4 (&acc)[2][2][4][2], const Unit& u, int wr, int wc, int fr, int fq) const {
        const int row0 = u.pm * BM + wr * 64 + fr; const int jj0 = wc * 32 + 8 * fq; const int col0 = u.pl * HALF + jj0;
        const float* bp = bias + (size_t)u.e * 2048 + col0;
        f32x4 bg[2], bu[2];
#pragma unroll
        for (int n = 0; n < 2; ++n) { bg[n] = *(const f32x4*)(bp + 4 * n); bu[n] = *(const f32x4*)(bp + 1024 + 4 * n); }
#pragma unroll
        for (int ai = 0; ai < 2; ++ai)
#pragma unroll
            for (int m = 0; m < 4; ++m) { bf16_t* rowp = O + (size_t)(row0 + ai * HALF + m * 16) * ldc + col0;
                f32x4 r[2];
#pragma unroll
                for (int n = 0; n < 2; ++n) { const f32x4 g = acc[ai][0][m][n] + bg[n], up = acc[ai][1][m][n] + bu[n];
#pragma unroll
                    for (int j = 0; j < 4; ++j) r[n][j] = act1(g[j], up[j]); }
                u32x4 w; w.x = cvt_pk_bf16(r[0][0], r[0][1]); w.y = cvt_pk_bf16(r[0][2], r[0][3]); w.z = cvt_pk_bf16(r[1][0], r[1][1]); w.w = cvt_pk_bf16(r[1][2], r[1][3]);
                *(u32x4*)rowp = w; }
    }
};
struct EpiBf16Bias {
    static constexpr bool PERM = true, AFTER_DRAIN = false;
    bf16_t* O; int ldc; const float* bias; int bpitch;
    __device__ __forceinline__ void operator()(const f32x4 (&acc)[2][2][4][2], const Unit& u, int wr, int wc, int fr, int fq) const {
        const int row0 = u.pm * BM + wr * 64 + fr; const int col0 = u.pl * BM + wc * 32 + 8 * fq;
        const float* bp = bias + (size_t)u.e * bpitch + col0;
        f32x4 bv[2][2];
#pragma unroll
        for (int bj = 0; bj < 2; ++bj)
#pragma unroll
            for (int n = 0; n < 2; ++n) bv[bj][n] = *(const f32x4*)(bp + bj * HALF + 4 * n);
#pragma unroll
        for (int ai = 0; ai < 2; ++ai)
#pragma unroll
            for (int m = 0; m < 4; ++m) { bf16_t* rowp = O + (size_t)(row0 + ai * HALF + m * 16) * ldc + col0;
#pragma unroll
                for (int bj = 0; bj < 2; ++bj) { const f32x4 v0 = acc[ai][bj][m][0] + bv[bj][0], v1 = acc[ai][bj][m][1] + bv[bj][1];
                    u32x4 w; w.x = cvt_pk_bf16(v0[0], v0[1]); w.y = cvt_pk_bf16(v0[2], v0[3]); w.z = cvt_pk_bf16(v1[0], v1[1]); w.w = cvt_pk_bf16(v1[2], v1[3]);
                    *(u32x4*)(rowp + bj * HALF) = w; } }
    }
};
struct MoeOrder {
    int nN, G, c, nunits; const PG8_LAS int* tile_e;
    __device__ __forceinline__ bool next(int i, Unit& u) const {
        const int L = i * G + c; if (L >= nunits) return false;
        const int pm = L / nN, pl = L - pm * nN, e = __builtin_amdgcn_readfirstlane(tile_e[pm]);
        u.pm = pm; u.pl = pl; u.e = e; u.pn = e * nN + pl; return true;
    }
    __device__ __forceinline__ void a_ready(const Unit&) const {}
    __device__ __forceinline__ void done(const Unit&) const {}
};
template <class Epi, class Sched, bool ALIGN_EPI = false, bool SP2 = false>
__device__ __forceinline__ void gemm_phase(PG8_LAS unsigned char* lds, const Gemm g, const Sched& S, const Epi& E) {
    int tid_ = threadIdx.x; asm volatile("" : "+v"(tid_)); const int tid = tid_, wid = __builtin_amdgcn_readfirstlane(tid >> 6), lane = tid & 63, wr = wid >> 2, wc = wid & 3, fr = lane & 15, fq = lane >> 4;
    const int K = g.K, nt = K / BK;
    unsigned voffA[2], voffB[2];
#pragma unroll
    for (int i = 0; i < 2; ++i) { int R, C; stage_rc(tid * 16 + i * 8192, R, C); const int Rb = Epi::PERM ? ((R & ~31) + perm32(R & 31)) : R;
        voffA[i] = (unsigned)(R * K + C) * 2u; voffB[i] = (unsigned)(Rb * K + C) * 2u; }
    const size_t kstep = (size_t)(BK * 2);
    const size_t hstep = (size_t)HALF * K * 2;
    const size_t tstep = 2 * hstep;
    const unsigned ldsw = (unsigned)wid * 1024u;
    const int aoff = lds_byte(wr * 64 + fr, fq * 8), boff = lds_byte(wc * 32 + fr, fq * 8);
#define PG8_SA(b, h) (((b) * 2 + (h)) * HTB)
#define PG8_SB(b, h) ((4 + (b) * 2 + (h)) * HTB)
#define PG8_STAGE(bufoff, gbase, voff) do { _Pragma("unroll") for (int _i = 0; _i < 2; ++_i) \
        __builtin_amdgcn_global_load_lds((const unsigned*)((const char*)(gbase) + (voff)[_i]), (PG8_LAS unsigned*)(lds + (bufoff) + ldsw + _i * 8192), 16, 0, 0); } while (0)
#define PG8_LDA(dst, b, h) do { _Pragma("unroll") for (int m = 0; m < 4; ++m) _Pragma("unroll") for (int k = 0; k < 2; ++k) dst[m][k] = *(const PG8_LAS bf16x8*)(lds + PG8_SA(b, h) + aoff + m * 2048 + k * 1024); } while (0)
#define PG8_LDB(dst, b, h) do { _Pragma("unroll") for (int n = 0; n < 2; ++n) _Pragma("unroll") for (int k = 0; k < 2; ++k) dst[n][k] = *(const PG8_LAS bf16x8*)(lds + PG8_SB(b, h) + boff + n * 2048 + k * 1024); } while (0)
#define PG8_MMA(ai, bj, At, Bt) do { __builtin_amdgcn_s_setprio(1); _Pragma("unroll") for (int m = 0; m < 4; ++m) _Pragma("unroll") for (int n = 0; n < 2; ++n) _Pragma("unroll") for (int k = 0; k < 2; ++k) \
        acc[ai][bj][m][n] = __builtin_amdgcn_mfma_f32_16x16x32_bf16(Bt[n][k], At[m][k], acc[ai][bj][m][n], 0, 0, 0); __builtin_amdgcn_s_setprio(0); } while (0)
#define PG8_WAIT_V(n) asm volatile("s_waitcnt vmcnt(" #n ")" ::: "memory")
#define PG8_WAIT_L(n) asm volatile("s_waitcnt lgkmcnt(" #n ")" ::: "memory")
#define PG8_BAR __builtin_amdgcn_s_barrier()
#define PG8_SCHED __builtin_amdgcn_sched_barrier(0)
    Unit cur, nxt; int ui = 0;
    if (!S.next(0, cur)) return;
    f32x4 acc[2][2][4][2];
#pragma unroll
    for (int a = 0; a < 2; ++a)
#pragma unroll
        for (int b = 0; b < 2; ++b)
#pragma unroll
            for (int m = 0; m < 4; ++m)
#pragma unroll
                for (int n = 0; n < 2; ++n) acc[a][b][m][n] = (f32x4){0.f, 0.f, 0.f, 0.f};
    bf16x8 At[4][2], B0[2][2], B1[2][2];
    const char* cA = (const char*)g.A + (size_t)cur.pm * tstep; const char* cB = (const char*)g.Bt + (size_t)cur.pn * tstep;
    S.a_ready(cur);
    if constexpr (SP2) {
        PG8_STAGE(PG8_SB(0, 0), cB, voffB); PG8_STAGE(PG8_SB(0, 1), cB + hstep, voffB); PG8_STAGE(PG8_SA(0, 0), cA, voffA); PG8_STAGE(PG8_SA(0, 1), cA + hstep, voffA);
        if (wr == 1) PG8_BAR;
        PG8_WAIT_V(2); PG8_BAR;
        PG8_STAGE(PG8_SB(1, 0), cB + kstep, voffB); PG8_STAGE(PG8_SA(1, 0), cA + kstep, voffA); PG8_STAGE(PG8_SB(1, 1), cB + hstep + kstep, voffB);
        PG8_WAIT_V(6); PG8_BAR;
    } else {
        PG8_STAGE(PG8_SB(0, 0), cB, voffB); PG8_STAGE(PG8_SA(0, 0), cA, voffA); PG8_STAGE(PG8_SB(0, 1), cB + hstep, voffB); PG8_STAGE(PG8_SA(0, 1), cA + hstep, voffA);
        if (wr == 1) PG8_BAR;
        PG8_WAIT_V(4); PG8_BAR;
        PG8_STAGE(PG8_SB(1, 0), cB + kstep, voffB); PG8_STAGE(PG8_SA(1, 0), cA + kstep, voffA); PG8_STAGE(PG8_SB(1, 1), cB + hstep + kstep, voffB);
        PG8_WAIT_V(6); PG8_BAR;
    }
    for (;;) {
        const bool has_next = S.next(ui + 1, nxt);
        const char* nA = has_next ? (const char*)g.A + (size_t)nxt.pm * tstep : cA; const char* nB = has_next ? (const char*)g.Bt + (size_t)nxt.pn * tstep : cB;
        for (int t = 0; t < nt; t += 2) {
            const bool last = (t == nt - 2);
            const char* a1 = cA + (size_t)(t + 1) * kstep;
            const char* a2 = last ? nA : cA + (size_t)(t + 2) * kstep; const char* b2 = last ? nB : cB + (size_t)(t + 2) * kstep;
            const char* a3 = a2 + kstep; const char* b3 = b2 + kstep;
            if (last && has_next) S.a_ready(nxt);
            if constexpr (SP2) {
            PG8_LDB(B0, 0, 0); PG8_LDB(B1, 0, 1); PG8_SCHED; PG8_LDA(At, 0, 0); PG8_STAGE(PG8_SA(1, 1), a1 + hstep, voffA);
            PG8_WAIT_V(8); PG8_WAIT_L(0); PG8_BAR; PG8_MMA(0, 0, At, B0); PG8_MMA(0, 1, At, B1); PG8_BAR; PG8_SCHED;
            PG8_LDA(At, 0, 1); PG8_STAGE(PG8_SB(0, 0), b2, voffB); PG8_STAGE(PG8_SB(0, 1), b2 + hstep, voffB); PG8_STAGE(PG8_SA(0, 0), a2, voffA);
            PG8_WAIT_V(8); PG8_WAIT_L(0); PG8_BAR; PG8_MMA(1, 0, At, B0); PG8_MMA(1, 1, At, B1); PG8_BAR; PG8_SCHED;
            PG8_LDB(B0, 1, 0); PG8_LDB(B1, 1, 1); PG8_SCHED; PG8_LDA(At, 1, 0); PG8_STAGE(PG8_SA(0, 1), a2 + hstep, voffA);
            PG8_WAIT_V(8); PG8_WAIT_L(0); PG8_BAR; PG8_MMA(0, 0, At, B0); PG8_MMA(0, 1, At, B1); PG8_BAR; PG8_SCHED;
            PG8_LDA(At, 1, 1); PG8_STAGE(PG8_SB(1, 0), b3, voffB); PG8_STAGE(PG8_SB(1, 1), b3 + hstep, voffB); PG8_STAGE(PG8_SA(1, 0), a3, voffA);
            PG8_WAIT_V(8); PG8_WAIT_L(0); PG8_BAR; PG8_MMA(1, 0, At, B0); PG8_MMA(1, 1, At, B1); PG8_BAR; PG8_SCHED;
            } else {
            PG8_LDB(B0, 0, 0); PG8_SCHED; PG8_LDA(At, 0, 0); PG8_STAGE(PG8_SA(1, 1), a1 + hstep, voffA);
            PG8_WAIT_L(8); PG8_BAR; PG8_WAIT_L(0); PG8_MMA(0, 0, At, B0); PG8_BAR; PG8_SCHED;
            PG8_LDB(B1, 0, 1); PG8_STAGE(PG8_SB(0, 0), b2, voffB);
            PG8_BAR; PG8_WAIT_L(0); PG8_MMA(0, 1, At, B1); PG8_BAR;
            PG8_LDA(At, 0, 1); PG8_STAGE(PG8_SA(0, 0), a2, voffA);
            PG8_BAR; PG8_WAIT_L(0); PG8_MMA(1, 0, At, B0); PG8_BAR; PG8_SCHED;
            PG8_STAGE(PG8_SB(0, 1), b2 + hstep, voffB);
            PG8_WAIT_V(6); PG8_BAR; PG8_MMA(1, 1, At, B1); PG8_BAR;
            PG8_LDB(B0, 1, 0); PG8_SCHED; PG8_LDA(At, 1, 0); PG8_STAGE(PG8_SA(0, 1), a2 + hstep, voffA);
            PG8_WAIT_L(8); PG8_BAR; PG8_WAIT_L(0); PG8_MMA(0, 0, At, B0); PG8_BAR; PG8_SCHED;
            PG8_LDB(B1, 1, 1); PG8_STAGE(PG8_SB(1, 0), b3, voffB);
            PG8_BAR; PG8_WAIT_L(0); PG8_MMA(0, 1, At, B1); PG8_BAR;
            PG8_LDA(At, 1, 1); PG8_STAGE(PG8_SA(1, 0), a3, voffA);
            PG8_BAR; PG8_WAIT_L(0); PG8_MMA(1, 0, At, B0); PG8_BAR; PG8_SCHED;
            PG8_STAGE(PG8_SB(1, 1), b3 + hstep, voffB);
            PG8_WAIT_V(6); PG8_BAR; PG8_MMA(1, 1, At, B1); PG8_BAR;
            }
        }
        if constexpr (ALIGN_EPI) { if (wr == 0) PG8_BAR; }
        if constexpr (!Epi::AFTER_DRAIN) { E(acc, cur, wr, wc, fr, fq); S.done(cur); }
        if (!has_next) break;
#pragma unroll
        for (int a = 0; a < 2; ++a)
#pragma unroll
            for (int b = 0; b < 2; ++b)
#pragma unroll
                for (int m = 0; m < 4; ++m)
#pragma unroll
                    for (int n = 0; n < 2; ++n) acc[a][b][m][n] = (f32x4){0.f, 0.f, 0.f, 0.f};
        cur = nxt; cA = nA; cB = nB; ++ui;
        if constexpr (ALIGN_EPI) { if (wr == 1) PG8_BAR; }
    }
    PG8_WAIT_V(0);
    if constexpr (!ALIGN_EPI) { if (wr == 0) PG8_BAR; }
    PG8_BAR;
    if constexpr (Epi::AFTER_DRAIN) { E.fused(acc, cur, wr, wc, fr, fq, lds, wid, lane); S.done(cur); }
#undef PG8_SA
#undef PG8_SB
#undef PG8_STAGE
#undef PG8_LDA
#undef PG8_LDB
#undef PG8_MMA
#undef PG8_WAIT_V
#undef PG8_WAIT_L
#undef PG8_BAR
#undef PG8_SCHED
}
}

constexpr int NWAVES = 8, NTHR = 512;
constexpr int BATCH = 2, SEQ = 8192, D = 1024, DEPTH = 4, MTOK = BATCH * SEQ;
constexpr int DIN = 3344, NPROJ = 3328, SRC_GA = 1152;
constexpr int C_GQ = 0, C_GK = 192, C_GV = 384, C_GG = 768, C_HQ = 1152, C_HF = 1408, C_HI = 1664, C_HG = 1920, C_RQ = 2176, C_RK = 2368, C_RV = 2560, C_RG = 2944;
constexpr int NE = 32, FFN = 1024;
constexpr int CH = 64, NCH = SEQ / CH, NUNIT = BATCH * NCH;
constexpr int ST_GLA = 0, ST_HG = 4 * 48 * 96, ST_RET = ST_HG + 4 * 64 * 64, ST_TOT = ST_RET + 4 * 48 * 96;
constexpr int NDV = 448;
constexpr int MAXROWS = 65536 + NE * 256, MAXRT = MAXROWS / 256;
constexpr float EPS = 1e-6f;
constexpr int NPHASE = 42;

constexpr size_t MiB = 1u << 20;
constexpr size_t WS_CTL = 0, CTL_ZERO_BYTES = 65536;
constexpr size_t WS_MOD = 1 * MiB;
constexpr size_t WS_ROPE = 2 * MiB;
constexpr size_t WS_LB = 5 * MiB;
constexpr size_t WS_WIN = 8 * MiB;
constexpr size_t WS_WOUT = 34 * MiB;
constexpr size_t WS_WGU = 42 * MiB;
constexpr size_t WS_WDN = 554 * MiB;
constexpr size_t WS_X = 810 * MiB;
constexpr size_t WS_H = 874 * MiB;
constexpr size_t WS_GA = 906 * MiB;
constexpr size_t WS_PROJ = 907 * MiB;
constexpr size_t WS_U = 1011 * MiB;
constexpr size_t WS_DVEC = 1063 * MiB;
constexpr size_t WS_SP = 1064 * MiB;
constexpr size_t WS_MIX = 1090 * MiB;
constexpr size_t WS_TOPE = 1122 * MiB;
constexpr size_t WS_TOPW = WS_TOPE + 256 * 1024;
constexpr size_t WS_SLOT = WS_TOPW + 256 * 1024;
constexpr size_t WS_A1 = 1123 * MiB;
constexpr size_t WS_ACT = 1267 * MiB;
constexpr size_t WS_Y = 1411 * MiB;
constexpr size_t WS_CUM = 1555 * MiB;
constexpr size_t WS_END = 1583 * MiB;
static_assert(WS_WIN + (size_t)DEPTH * NPROJ * D * 2 <= WS_WOUT && WS_PROJ + (size_t)MTOK * NPROJ * 2 <= WS_U && WS_U + (size_t)NUNIT * ST_TOT * 4 <= WS_DVEC && WS_SP + (size_t)NUNIT * ST_TOT * 2 <= WS_MIX && WS_A1 + (size_t)MAXROWS * D * 2 <= WS_ACT, "ws map");
constexpr int CW_TMO = 0, CW_CODE = 1, CW_BAR = 4096, CW_CNT = 8192, CW_FILL = 8192 + 256;
constexpr int RING_BYTES = 131072;
constexpr int MISC_OFF = 147456, LDS_BYTES = MISC_OFF + 4096;
constexpr int MW_BAR = 0, MW_CNT = 16, MW_PST = 48, MW_HIST = 96, MW_BASE = 128, MW_TILE = 192, MW_NRT = 480, MW_SLOTS = 512;

#define GAS __attribute__((address_space(1)))
#define LAS __attribute__((address_space(3)))
typedef unsigned v4u __attribute__((ext_vector_type(4)));
typedef float f32x4 __attribute__((ext_vector_type(4)));
typedef short bf16x8 __attribute__((ext_vector_type(8)));
typedef GAS unsigned gu32;
typedef GAS unsigned long long gu64;
#define RLX_AGENT __ATOMIC_RELAXED, __HIP_MEMORY_SCOPE_AGENT
#define LDS_WAIT() asm volatile("s_waitcnt lgkmcnt(0)" ::: "memory")
#define VM_WAIT() asm volatile("s_waitcnt vmcnt(0)" ::: "memory")
__device__ __forceinline__ unsigned long long rt() { return __builtin_amdgcn_s_memrealtime(); }
typedef unsigned short bf16;
__device__ __forceinline__ unsigned f2bf(float f) { unsigned u = __builtin_bit_cast(unsigned, f); return (u + 0x7fffu + ((u >> 16) & 1u)) >> 16; }
__device__ __forceinline__ unsigned pk2(float lo, float hi) { return f2bf(lo) | (f2bf(hi) << 16); }
__device__ __forceinline__ float bf2f(bf16 b) { return __builtin_bit_cast(float, (unsigned)b << 16); }
#define XB_TMO      128
#define XB_XCNT(j)  (256  + 64 * (j))
#define XB_XSUB(j)  (1280 + 64 * (j))
#define XB_XGEN(j)  (2304 + 64 * (j))
#define XB_TOP      3328
#define XB_TOPGEN   3392
#define XCD_BAR_WORDS 3456
#define XB_SPIN_CAP (1u << 18)

__device__ __forceinline__ unsigned xb_ld(unsigned* p)              { return __hip_atomic_load(p, __ATOMIC_RELAXED, __HIP_MEMORY_SCOPE_AGENT); }
__device__ __forceinline__ unsigned xb_add(unsigned* p, unsigned v) { return __hip_atomic_fetch_add(p, v, __ATOMIC_RELAXED, __HIP_MEMORY_SCOPE_AGENT); }
__device__ __forceinline__ unsigned xb_xcc_id() { return (unsigned)__builtin_amdgcn_s_getreg((3 << 11) | 20) & 0xFu; }
#define XB_SPIN(cond, bar) do { unsigned _sp = 0; while (cond) { __builtin_amdgcn_s_sleep(1); \
    if ((++_sp & 255u) == 0u) { if (xb_ld(&(bar)[XB_TMO])) break; if (_sp > XB_SPIN_CAP) { atomicAdd(&(bar)[XB_TMO], 1u); break; } } } } while (0)

struct XcdBarrier {
    unsigned* bar; unsigned x;
    volatile LAS unsigned* st;
};

__device__ __forceinline__ XcdBarrier xcd_barrier_post(unsigned* bar, volatile LAS unsigned* st) {
    XcdBarrier b; b.bar = bar; b.x = xb_xcc_id(); b.st = st;
    if (threadIdx.x == 0) (void)xb_add(&bar[XB_XCNT(b.x)], 1u);
    return b;
}
__device__ __forceinline__ void xcd_barrier_complete(unsigned* bar, unsigned x, unsigned& nloc, unsigned& nx) {
    const unsigned G = gridDim.x * gridDim.y * gridDim.z;
    unsigned sum, cnt, mine, sp = 0u;
    for (;;) {
        sum = 0u; cnt = 0u; mine = 0u;
#pragma unroll
        for (unsigned j = 0; j < 16; ++j) { const unsigned c = xb_ld(&bar[XB_XCNT(j)]); sum += c; cnt += (c > 0u) ? 1u : 0u; mine = (j == x) ? c : mine; }
        if (sum == G) break;
        __builtin_amdgcn_s_sleep(1);
        if ((++sp & 255u) == 0u) { if (xb_ld(&bar[XB_TMO])) break; if (sp > XB_SPIN_CAP) { atomicAdd(&bar[XB_TMO], 1u); break; } }
    }
    nloc = mine > 0u ? mine : 1u; nx = cnt > 0u ? cnt : 1u;
}

__device__ __forceinline__ void xcd_barrier(const XcdBarrier& b) {
    asm volatile("s_waitcnt vmcnt(0)" ::: "memory");
    __syncthreads();
    if (threadIdx.x == 0) {
        unsigned* bar = b.bar;
        __builtin_amdgcn_s_waitcnt(0);
        unsigned nloc = b.st[0], nx = b.st[1];
        if (nloc == 0u) { xcd_barrier_complete(bar, b.x, nloc, nx); b.st[0] = nloc; b.st[1] = nx; }
        const unsigned old = xb_add(&bar[XB_XSUB(b.x)], 1u);
        const unsigned gen = old / nloc;
        if (old + 1u == (gen + 1u) * nloc) {
            __builtin_amdgcn_fence(__ATOMIC_RELEASE, "agent");
            asm volatile("s_waitcnt vmcnt(0)" ::: "memory");
            const unsigned og = xb_add(&bar[XB_TOP], 1u);
            const unsigned tg = og / nx;
            if (og + 1u == (tg + 1u) * nx) xb_add(&bar[XB_TOPGEN], 1u);
            else XB_SPIN(xb_ld(&bar[XB_TOPGEN]) == tg, bar);
            __builtin_amdgcn_fence(__ATOMIC_ACQUIRE, "agent");
            xb_add(&bar[XB_XGEN(b.x)], 1u);
            asm volatile("s_waitcnt vmcnt(0)" ::: "memory");
        } else {
            XB_SPIN(xb_ld(&bar[XB_XGEN(b.x)]) == gen, bar);
            __builtin_amdgcn_fence(__ATOMIC_ACQUIRE, "agent");
            asm volatile("s_waitcnt vmcnt(0)" ::: "memory");
        }
    }
    __syncthreads();
}

__device__ __forceinline__ float wave_sum(float v) {
#pragma unroll
    for (int o = 1; o < 64; o <<= 1) v += __shfl_xor(v, o);
    return v;
}
__device__ __forceinline__ float log_sigmoid_f(float x) { return fminf(x, 0.f) - log1pf(expf(-fabsf(x))); }
__device__ __forceinline__ float silu_f(float x) { return x / (1.0f + expf(-x)); }
__device__ __forceinline__ float sigmoid_f(float x) { return 1.0f / (1.0f + expf(-x)); }
__device__ __forceinline__ pg8::bf16x8 ldfrag(const LAS bf16* base, int stride, int r0, int k0, int lane) {
    return *(const LAS pg8::bf16x8*)(base + (r0 + (lane & 15)) * stride + k0 + 8 * (lane >> 4));
}
__device__ __forceinline__ pg8::bf16x8 pack8(const float (&v)[8]) { v4u w; w.x = pk2(v[0], v[1]); w.y = pk2(v[2], v[3]); w.z = pk2(v[4], v[5]); w.w = pk2(v[6], v[7]); return __builtin_bit_cast(pg8::bf16x8, w); }

struct Args {
    const float* x; const float* c; const int* pos; const float* w_mod; const float* b_mod; const float* norm1_w; const float* w_in; const float* gla_wa2; const float* gla_ba2; const float* hg_lb;
    const float* gla_norm_w; const float* hg_norm_w; const float* w_out; const float* norm2_w; const float* w_r; const float* b_r; const float* w_gu; const float* b_gu; const float* w_dn; const float* b_dn;
    const float* final_norm_w; float* out; unsigned char* ws; int ph_lo, ph_hi;
};

__device__ __forceinline__ void transpose_block64(const float* src, int ld, bf16* dst, LAS float* scr, int lane) {
    const int r = lane >> 4, c4 = (lane & 15) * 4;
    f32x4 v[16];
#pragma unroll
    for (int i = 0; i < 16; ++i) v[i] = *(const f32x4*)(src + (size_t)(4 * i + r) * ld + c4);
#pragma unroll
    for (int i = 0; i < 16; ++i) { LAS float* w = scr + (4 * i + r) * 65 + c4; w[0] = v[i][0]; w[1] = v[i][1]; w[2] = v[i][2]; w[3] = v[i][3]; }
    LDS_WAIT(); asm volatile("" ::: "memory");
    const int kc = lane & 7;
#pragma unroll
    for (int jj = 0; jj < 8; ++jj) { const int n = (lane >> 3) + 8 * jj; const LAS float* s = scr + (8 * kc) * 65 + n;
        v4u o; o.x = pk2(s[0 * 65], s[1 * 65]); o.y = pk2(s[2 * 65], s[3 * 65]); o.z = pk2(s[4 * 65], s[5 * 65]); o.w = pk2(s[6 * 65], s[7 * 65]);
        *(GAS v4u*)(dst + (size_t)n * D + 8 * kc) = o; }
    LDS_WAIT(); asm volatile("" ::: "memory");
}
constexpr int IT_IN = 16 * (NPROJ / 64), IT_OUT = 16 * 16, IT_GU = NE * 16 * 32, IT_DN = NE * 16 * 16, IT_LAYER = IT_IN + IT_OUT + IT_GU + IT_DN, IT_ALL = DEPTH * IT_LAYER;
__device__ __forceinline__ void p0_prologue(const Args& a, LAS unsigned char* lds, int vcu, int G, int tid, int lane, int wave) {
    unsigned char* ws = a.ws;
    bf16* WIN = (bf16*)(ws + WS_WIN); bf16* WOUT = (bf16*)(ws + WS_WOUT); bf16* WGU = (bf16*)(ws + WS_WGU); bf16* WDN = (bf16*)(ws + WS_WDN);
    LAS float* scr = (LAS float*)(lds + wave * 16640);
    const int gw = vcu * NWAVES + wave, NGW = G * NWAVES;
    for (int it = gw; it < IT_ALL; it += NGW) {
        const int l = it / IT_LAYER; int r = it - l * IT_LAYER;
        if (r < IT_IN) { const int kb = r / (NPROJ / 64), nb = r % (NPROJ / 64), n0 = 64 * nb, sc = n0 + (n0 >= SRC_GA ? 16 : 0);
            transpose_block64(a.w_in + ((size_t)l * D + 64 * kb) * DIN + sc, DIN, WIN + ((size_t)l * NPROJ + n0) * D + 64 * kb, scr, lane); continue; }
        r -= IT_IN;
        if (r < IT_OUT) { const int kb = r / 16, nb = r % 16;
            transpose_block64(a.w_out + ((size_t)l * D + 64 * kb) * D + 64 * nb, D, WOUT + ((size_t)l * D + 64 * nb) * D + 64 * kb, scr, lane); continue; }
        r -= IT_OUT;
        if (r < IT_GU) { const int e = r / 512, r2 = r % 512, kb = r2 / 32, nb = r2 % 32, cc = 64 * nb;
            const int row = (cc < 1024) ? 256 * (cc / 128) + (cc % 128) : 256 * ((cc - 1024) / 128) + 128 + ((cc - 1024) % 128);
            transpose_block64(a.w_gu + (((size_t)l * NE + e) * D + 64 * kb) * 2048 + cc, 2048, WGU + (((size_t)l * NE + e) * 2048 + row) * D + 64 * kb, scr, lane); continue; }
        r -= IT_GU;
        { const int e = r / 256, r2 = r % 256, kb = r2 / 16, nb = r2 % 16;
            transpose_block64(a.w_dn + (((size_t)l * NE + e) * FFN + 64 * kb) * D + 64 * nb, D, WDN + (((size_t)l * NE + e) * D + 64 * nb) * D + 64 * kb, scr, lane); }
    }
    __syncthreads();
    {
        LAS float* cact = (LAS float*)lds;
        LAS float* red = (LAS float*)(lds + 8192);
        for (int i = tid; i < 2 * D; i += NTHR) cact[i] = silu_f(a.c[i]);
        __syncthreads();
        float* MOD = (float*)(ws + WS_MOD);
        for (int it = vcu; it < DEPTH * 96; it += G) {
            const int l = it / 96, n0 = (it % 96) * 64;
            const float* wp = a.w_mod + ((size_t)l * D + 128 * wave) * 6144 + n0 + lane;
            float a0 = 0.f, a1 = 0.f;
#pragma unroll 8
            for (int k = 0; k < 128; ++k) { const float w = wp[(size_t)k * 6144]; a0 += cact[128 * wave + k] * w; a1 += cact[D + 128 * wave + k] * w; }
            red[(wave * 2 + 0) * 64 + lane] = a0; red[(wave * 2 + 1) * 64 + lane] = a1;
            __syncthreads();
            if (tid < 128) { const int b = tid >> 6, ln = tid & 63; float s = a.b_mod[l * 6144 + n0 + ln];
#pragma unroll
                for (int w = 0; w < 8; ++w) s += red[(w * 2 + b) * 64 + ln];
                MOD[((size_t)l * 2 + b) * 6144 + n0 + ln] = s; }
            __syncthreads();
        }
    }
    {
        float* ROPE = (float*)(ws + WS_ROPE);
        for (int i = vcu * NTHR + tid; i < MTOK * 24; i += G * NTHR) { const int t = i / 24, f = i % 24;
            const float inv = (float)pow(10000.0, -(double)f / 24.0); const float ang = (float)a.pos[t] * inv;
            ROPE[(size_t)t * 48 + f] = cosf(ang); ROPE[(size_t)t * 48 + 24 + f] = sinf(ang); }
    }
    if (vcu == 0 && tid < 256) {
        float v[4], mx = -3.0e38f; for (int l = 0; l < 4; ++l) { v[l] = a.hg_lb[l * 256 + tid]; mx = fmaxf(mx, v[l]); }
        float s = 0.f; for (int l = 0; l < 4; ++l) { v[l] = expf(v[l] - mx); s += v[l]; }
        float* LB = (float*)(ws + WS_LB); float cs = 0.f, first = 0.f;
        for (int l = 0; l < 4; ++l) { cs += v[l] / s; if (l == 0) first = cs; LB[l * 256 + tid] = cs - first; }
    }
}

__device__ __forceinline__ void moe_combine_row(f32x4 (&v)[4], int m, const bf16* Y, const int* SLOT, const float* TOPW, const float* g2, int lane) {
    const int4 sl = *(const int4*)(SLOT + (size_t)m * 4); const f32x4 tw = *(const f32x4*)(TOPW + (size_t)m * 4);
    const int s[4] = {sl.x, sl.y, sl.z, sl.w};
    f32x4 acc[4];
#pragma unroll
    for (int j = 0; j < 4; ++j) acc[j] = (f32x4){0.f, 0.f, 0.f, 0.f};
#pragma unroll
    for (int k = 0; k < 4; ++k) { const bf16* yr = Y + (size_t)s[k] * D + 4 * lane; const float w = tw[k];
#pragma unroll
        for (int j = 0; j < 4; ++j) { const uint2 p = *(const uint2*)(yr + 256 * j);
            acc[j][0] += w * __builtin_bit_cast(float, p.x << 16); acc[j][1] += w * __builtin_bit_cast(float, p.x & 0xffff0000u);
            acc[j][2] += w * __builtin_bit_cast(float, p.y << 16); acc[j][3] += w * __builtin_bit_cast(float, p.y & 0xffff0000u); } }
#pragma unroll
    for (int j = 0; j < 4; ++j) { const f32x4 g = *(const f32x4*)(g2 + 4 * lane + 256 * j); v[j] = v[j] + g * acc[j]; }
}
__device__ __forceinline__ float row_rstd(const f32x4 (&v)[4]) {
    float s = 0.f;
#pragma unroll
    for (int j = 0; j < 4; ++j) s += (v[j][0] * v[j][0] + v[j][1] * v[j][1]) + (v[j][2] * v[j][2] + v[j][3] * v[j][3]);
    return 1.0f / sqrtf(wave_sum(s) * (1.0f / D) + EPS);
}
__device__ __forceinline__ void modulate_row(f32x4 (&v)[4], float rstd, const float* nw, const float* sc, const float* sh, bf16* hrow, int lane) {
#pragma unroll
    for (int j = 0; j < 4; ++j) { const int c0 = 4 * lane + 256 * j; const f32x4 w = *(const f32x4*)(nw + c0), s1 = *(const f32x4*)(sc + c0), s0 = *(const f32x4*)(sh + c0);
        v[j] = v[j] * rstd * w * (s1 + 1.0f) + s0;
        uint2 p; p.x = pk2(v[j][0], v[j][1]); p.y = pk2(v[j][2], v[j][3]); *(uint2*)(hrow + c0) = p; }
}


constexpr int WP = 1032;
constexpr int LR_WHI = 0, LR_PART = 132096, LR_SSX = 140288, LR_RSTD = 140544, LR_BIAS = 140800, LR_RED = 140928;
template <int NEO>
__device__ __forceinline__ void rows_mfma(const Args& a, int layer, LAS unsigned char* lds, volatile LAS unsigned* MISC, gu32* ctl, int vcu, int G, int tid, int lane, int wave) {
    constexpr bool P5 = (NEO == 32); constexpr int NET = NEO / 16;
    unsigned char* ws = a.ws; float* X = (float*)(ws + WS_X); bf16* H = (bf16*)(ws + WS_H); const float* MOD = (const float*)(ws + WS_MOD);
    LAS bf16* Whi = (LAS bf16*)(lds + LR_WHI); LAS bf16* Wlo = Whi + NEO * WP; LAS float* part = (LAS float*)(lds + LR_PART); LAS float* ssx = (LAS float*)(lds + LR_SSX);
    LAS float* rstds = (LAS float*)(lds + LR_RSTD); LAS float* biasl = (LAS float*)(lds + LR_BIAS); LAS float* red = (LAS float*)(lds + LR_RED);
    const float* nw = (P5 ? a.norm2_w : a.norm1_w) + layer * D;
    const float* Wsrc = P5 ? a.w_r + (size_t)layer * D * NE : a.w_in + (size_t)layer * D * DIN + SRC_GA; const int wld = P5 ? NE : DIN;
    if (P5) { if (tid < NE) MISC[MW_HIST + tid] = 0u; }
    for (int row0 = vcu * 64; row0 < MTOK; row0 += G * 64) {
        const int b = row0 / SEQ; const float* mp = MOD + ((size_t)layer * 2 + b) * 6144; const float* scp = mp + (P5 ? 4 : 1) * D; const float* shp = mp + (P5 ? 3 : 0) * D;
        for (int idx = tid; idx < D * NEO; idx += NTHR) { const int k = idx / NEO, e = idx % NEO; const float w = Wsrc[(size_t)k * wld + e] * nw[k] * (1.0f + scp[k]);
            const unsigned hi = f2bf(w); const float wl = w - __builtin_bit_cast(float, hi << 16); Whi[e * WP + k] = (bf16)hi; Wlo[e * WP + k] = (bf16)f2bf(wl); }
        { const int e = tid % NEO, pt = tid / NEO; constexpr int NPT = NTHR / NEO, KP = D / NPT; float sacc = 0.f;
            for (int k = pt * KP; k < pt * KP + KP; ++k) sacc += shp[k] * Wsrc[(size_t)k * wld + e];
            red[pt * NEO + e] = sacc; }
        const float* xin = X;
        if (!P5) { if (layer == 0) xin = a.x;
            else { for (int rr = 0; rr < 8; ++rr) { const int m = row0 + 8 * wave + rr; f32x4 v[4];
#pragma unroll
                    for (int j = 0; j < 4; ++j) v[j] = *(const f32x4*)(X + (size_t)m * D + 4 * lane + 256 * j);
                    moe_combine_row(v, m, (const bf16*)(ws + WS_Y), (const int*)(ws + WS_SLOT), (const float*)(ws + WS_TOPW), MOD + ((size_t)(layer - 1) * 2 + b) * 6144 + 5 * D, lane);
#pragma unroll
                    for (int j = 0; j < 4; ++j) *(f32x4*)(X + (size_t)m * D + 4 * lane + 256 * j) = v[j]; }
                asm volatile("s_waitcnt vmcnt(0)" ::: "memory"); } }
        __syncthreads();
        if (tid < NEO) { constexpr int NPT = NTHR / NEO; float sacc = P5 ? a.b_r[layer * NE + tid] : 0.f; for (int q = 0; q < NPT; ++q) sacc += red[q * NEO + tid]; biasl[tid] = sacc; }
        const int rg = wave >> 1, kh = wave & 1, r = lane & 15, g = lane >> 4;
        { const float* xr = xin + (size_t)(row0 + 16 * rg + r) * D; f32x4 acc[NET]; float ss = 0.f;
#pragma unroll
            for (int et = 0; et < NET; ++et) acc[et] = (f32x4){0.f, 0.f, 0.f, 0.f};
#pragma unroll 4
            for (int s = 16 * kh; s < 16 * kh + 16; ++s) { const int k0 = 32 * s + 8 * g; const f32x4 x0 = *(const f32x4*)(xr + k0), x1 = *(const f32x4*)(xr + k0 + 4);
                ss += (x0[0] * x0[0] + x0[1] * x0[1]) + (x0[2] * x0[2] + x0[3] * x0[3]) + (x1[0] * x1[0] + x1[1] * x1[1]) + (x1[2] * x1[2] + x1[3] * x1[3]);
                float xv[8] = {x0[0], x0[1], x0[2], x0[3], x1[0], x1[1], x1[2], x1[3]}, xl[8];
#pragma unroll
                for (int j = 0; j < 8; ++j) xl[j] = xv[j] - __builtin_bit_cast(float, f2bf(xv[j]) << 16);
                const pg8::bf16x8 ahi = pack8(xv), alo = pack8(xl);
#pragma unroll
                for (int et = 0; et < NET; ++et) { const pg8::bf16x8 whi = ldfrag(Whi, WP, 16 * et, 32 * s, lane), wlo = ldfrag(Wlo, WP, 16 * et, 32 * s, lane);
                    acc[et] = __builtin_amdgcn_mfma_f32_16x16x32_bf16(ahi, whi, acc[et], 0, 0, 0); acc[et] = __builtin_amdgcn_mfma_f32_16x16x32_bf16(alo, whi, acc[et], 0, 0, 0);
                    acc[et] = __builtin_amdgcn_mfma_f32_16x16x32_bf16(ahi, wlo, acc[et], 0, 0, 0); } }
            ss += __shfl_xor(ss, 16); ss += __shfl_xor(ss, 32);
            if (kh == 1) {
#pragma unroll
                for (int et = 0; et < NET; ++et)
#pragma unroll
                    for (int q = 0; q < 4; ++q) part[(rg * 16 + 4 * g + q) * 32 + 16 * et + r] = acc[et][q];
                if (g == 0) ssx[rg * 16 + r] = ss; }
            __syncthreads();
            if (kh == 0) { const float sst = ss + ssx[rg * 16 + r]; if (g == 0) rstds[rg * 16 + r] = 1.0f / sqrtf(sst * (1.0f / D) + EPS);
                asm volatile("s_waitcnt lgkmcnt(0)" ::: "memory");
#pragma unroll
                for (int et = 0; et < NET; ++et)
#pragma unroll
                    for (int q = 0; q < 4; ++q) { const int i = rg * 16 + 4 * g + q, e = 16 * et + r; const float v = rstds[i] * (acc[et][q] + part[i * 32 + e]) + biasl[e];
                        if (P5) part[i * 32 + e] = v; else ((float*)(ws + WS_GA))[(size_t)(row0 + i) * 16 + e] = v; }
                if (P5) { asm volatile("s_waitcnt lgkmcnt(0)" ::: "memory");
                    if (lane < 16) { const int i = rg * 16 + lane, m = row0 + i; float lv[NE];
#pragma unroll
                        for (int e = 0; e < NE; ++e) lv[e] = part[i * 32 + e];
                        float tv[4]; int te[4];
#pragma unroll
                        for (int t = 0; t < 4; ++t) { float best = -3.0e38f; int bi = 0;
#pragma unroll
                            for (int e = 0; e < NE; ++e) if (lv[e] > best) { best = lv[e]; bi = e; }
#pragma unroll
                            for (int e = 0; e < NE; ++e) if (e == bi) lv[e] = -3.0e38f;
                            tv[t] = best; te[t] = bi; }
                        const float e1 = expf(tv[1] - tv[0]), e2 = expf(tv[2] - tv[0]), e3 = expf(tv[3] - tv[0]); const float inv = 1.0f / (1.0f + e1 + e2 + e3);
                        *(int4*)((int*)(ws + WS_TOPE) + (size_t)m * 4) = make_int4(te[0], te[1], te[2], te[3]); *(f32x4*)((float*)(ws + WS_TOPW) + (size_t)m * 4) = (f32x4){inv, e1 * inv, e2 * inv, e3 * inv};
#pragma unroll
                        for (int t = 0; t < 4; ++t) __hip_atomic_fetch_add((LAS unsigned*)&MISC[MW_HIST + te[t]], 1u, __ATOMIC_RELAXED, __HIP_MEMORY_SCOPE_WORKGROUP); } } }
            __syncthreads(); }
        for (int rr = 0; rr < 8; ++rr) { const int i = 8 * wave + rr, m = row0 + i; f32x4 v[4];
#pragma unroll
            for (int j = 0; j < 4; ++j) v[j] = *(const f32x4*)(xin + (size_t)m * D + 4 * lane + 256 * j);
            modulate_row(v, rstds[i], nw, scp, shp, H + (size_t)m * D, lane); }
        __syncthreads();
    }
    if (P5) { if (tid < NE) { const unsigned hcnt = MISC[MW_HIST + tid]; if (hcnt) atomicAdd((unsigned*)(ctl + CW_CNT + layer * NE + tid), hcnt); } }
}

__device__ __forceinline__ void final_rows(const Args& a, int vcu, int G, int lane, int wave) {
    unsigned char* ws = a.ws; const float* X = (const float*)(ws + WS_X); const float* MOD = (const float*)(ws + WS_MOD);
    for (int m = (vcu * NWAVES + wave); m < MTOK; m += G * NWAVES) {
        const int b = m / SEQ; f32x4 v[4];
#pragma unroll
        for (int j = 0; j < 4; ++j) v[j] = *(const f32x4*)(X + (size_t)m * D + 4 * lane + 256 * j);
        moe_combine_row(v, m, (const bf16*)(ws + WS_Y), (const int*)(ws + WS_SLOT), (const float*)(ws + WS_TOPW), MOD + ((size_t)(DEPTH - 1) * 2 + b) * 6144 + 5 * D, lane);
        const float rstd = row_rstd(v);
#pragma unroll
        for (int j = 0; j < 4; ++j) { const int c0 = 4 * lane + 256 * j; const f32x4 w = *(const f32x4*)(a.final_norm_w + c0); *(f32x4*)(a.out + (size_t)m * D + c0) = v[j] * rstd * w; }
    }
}

__device__ __noinline__ void moe_tables(gu32* ctl, int layer, volatile LAS unsigned* MISC, int tid) {
    if (tid < NE) MISC[MW_CNT + tid] = __hip_atomic_load(ctl + CW_CNT + layer * NE + tid, RLX_AGENT);
    __syncthreads();
    if (tid == 0) { unsigned p = 0;
        for (int e = 0; e < NE; ++e) { MISC[MW_PST + e] = p; const unsigned nt = (MISC[MW_CNT + e] + 255u) >> 8; for (unsigned t = 0; t < nt; ++t) MISC[MW_TILE + (p >> 8) + t] = (unsigned)e; p += nt << 8; }
        MISC[MW_PST + NE] = p; MISC[MW_NRT] = p >> 8; }
    __syncthreads();
}
__device__ __forceinline__ void p6_dispatch(const Args& a, int layer, volatile LAS unsigned* MISC, gu32* ctl, int vcu, int G, int tid, int lane, int wave) {
    unsigned char* ws = a.ws; const int* TOPE = (const int*)(ws + WS_TOPE); int* SLOT = (int*)(ws + WS_SLOT); const bf16* H = (const bf16*)(ws + WS_H); bf16* A1 = (bf16*)(ws + WS_A1);
    moe_tables(ctl, layer, MISC, tid);
    for (int t0 = vcu * 64; t0 < MTOK; t0 += G * 64) {
        if (tid < NE) MISC[MW_HIST + tid] = 0u;
        __syncthreads();
        int e = 0; unsigned r = 0;
        if (tid < 256) { e = TOPE[(size_t)t0 * 4 + tid]; r = __hip_atomic_fetch_add((LAS unsigned*)&MISC[MW_HIST + e], 1u, __ATOMIC_RELAXED, __HIP_MEMORY_SCOPE_WORKGROUP); }
        __syncthreads();
        if (tid < NE) { const unsigned h = MISC[MW_HIST + tid]; MISC[MW_BASE + tid] = h ? atomicAdd((unsigned*)(ctl + CW_FILL + layer * NE + tid), h) : 0u; }
        __syncthreads();
        if (tid < 256) { const int slot = (int)(MISC[MW_PST + e] + MISC[MW_BASE + e] + r); SLOT[(size_t)t0 * 4 + tid] = slot; MISC[MW_SLOTS + tid] = (unsigned)slot; }
        __syncthreads();
        for (int i = wave * 32; i < wave * 32 + 32; ++i) { const int slot = (int)MISC[MW_SLOTS + i]; const int t = t0 + (i >> 2);
            const v4u* src = (const v4u*)(H + (size_t)t * D); v4u* dst = (v4u*)(A1 + (size_t)slot * D);
            dst[lane] = src[lane]; dst[lane + 64] = src[lane + 64]; }
        __syncthreads();
    }
}

constexpr int BP = 72;
template <int TYPE> struct MixCfg { static constexpr int DK = (TYPE == 1) ? 64 : 48, DV = (TYPE == 1) ? 64 : 96, NC = 4 * DK, NV = 4 * DV;
    static constexpr int STOFF = (TYPE == 0) ? ST_GLA : (TYPE == 1) ? ST_HG : ST_RET, COFF = (TYPE == 0) ? 0 : 192;
    static constexpr int CQ = (TYPE == 0) ? C_GQ : (TYPE == 1) ? C_HQ : C_RQ, CK = (TYPE == 0) ? C_GK : (TYPE == 1) ? C_HF : C_RK, CV = (TYPE == 0) ? C_GV : (TYPE == 1) ? C_HI : C_RV, CG = (TYPE == 0) ? C_GG : (TYPE == 1) ? C_HG : C_RG;
    static constexpr int MIXOFF = (TYPE == 0) ? 0 : (TYPE == 1) ? 384 : 640; };
__device__ __forceinline__ float fast_logsig(float x) { x = fmaxf(x, -80.f); return -__logf(1.0f + __expf(-x)); }
__device__ __forceinline__ float ret_lg(int h) { return logf(1.0f - exp2f(-5.0f - (float)h)); }

template <int NV>
__device__ __forceinline__ void stage_vt(const bf16* pv  , LAS bf16* VT, int tid) {
    for (int idx = tid; idx < 2 * NV; idx += NTHR) { const int e = idx % NV, hf = idx / NV; const bf16* p = pv + (size_t)(32 * hf) * NPROJ + e;
#pragma unroll
        for (int q = 0; q < 4; ++q) { unsigned short b[8];
#pragma unroll
            for (int j = 0; j < 8; ++j) b[j] = p[(size_t)(8 * q + j) * NPROJ];
            v4u w; w.x = b[0] | ((unsigned)b[1] << 16); w.y = b[2] | ((unsigned)b[3] << 16); w.z = b[4] | ((unsigned)b[5] << 16); w.w = b[6] | ((unsigned)b[7] << 16);
            *(LAS v4u*)(VT + e * BP + 32 * hf + 8 * q) = w; } }
}

constexpr int LA_KT = 0, LA_VT = 36864, LA_TOT = 92160, LA_GA = 94208;
template <int TYPE>
__device__ __forceinline__ void mixa_batch(const Args& a, int layer, int unit, LAS unsigned char* lds, int tid, int lane, int wave) {
    typedef MixCfg<TYPE> C; constexpr int DK = C::DK, DV = C::DV, NC = C::NC, NV = C::NV;
    unsigned char* ws = a.ws; const bf16* PROJ = (const bf16*)(ws + WS_PROJ); float* CUM = (float*)(ws + WS_CUM); float* DVEC = (float*)(ws + WS_DVEC) + (size_t)unit * NDV;
    float* U = (float*)(ws + WS_U) + (size_t)unit * ST_TOT + C::STOFF;
    LAS bf16* KT = (LAS bf16*)(lds + LA_KT); LAS bf16* VT = (LAS bf16*)(lds + LA_VT); LAS float* TOT = (LAS float*)(lds + LA_TOT); const LAS float* GAs = (const LAS float*)(lds + LA_GA);
    const int row0 = unit * CH;
    const bool act = tid < 2 * NC; const int c = act ? tid % NC : 0, half = act ? tid / NC : 0, h = c / DK, d = c - h * DK;
    float cum[32]; float tot = 0.f;
    float w2[16], b2 = 0.f, lbv = 0.f, lg = 0.f, sg = 0.f; int f = 0, d2 = 0;
    if (act) {
        if constexpr (TYPE == 0) { b2 = a.gla_ba2[layer * 192 + c];
#pragma unroll
            for (int r = 0; r < 16; ++r) w2[r] = a.gla_wa2[(layer * 16 + r) * 192 + c]; }
        if constexpr (TYPE == 1) lbv = ((const float*)(ws + WS_LB))[layer * 256 + c];
        if constexpr (TYPE == 2) { lg = ret_lg(h); f = (d < 24) ? d : d - 24; d2 = (d < 24) ? d + 24 : d - 24; sg = (d < 24) ? -1.f : 1.f; }
#pragma unroll
        for (int i = 0; i < 32; ++i) { const int t = 32 * half + i; const bf16* pr = PROJ + (size_t)(row0 + t) * NPROJ; float g;
            if constexpr (TYPE == 0) { float pre = b2;
#pragma unroll
                for (int r = 0; r < 16; ++r) pre += GAs[t * 16 + r] * w2[r];
                g = fast_logsig(pre) * (1.0f / 16.0f); }
            else if constexpr (TYPE == 1) { const float hf = fminf(fmaxf(bf2f(pr[C_HF + c]), -80.f), 80.f); const float sgm = 1.0f / (1.0f + __expf(-hf));
                g = __logf(lbv + (1.0f - lbv) * sgm); }
            else g = lg;
            tot += g; cum[i] = tot;
            if ((i & 7) == 7) asm volatile("" ::: "memory"); }
        TOT[c * 2 + half] = tot;
    }
    stage_vt<NV>(PROJ + (size_t)row0 * NPROJ + C::CV, VT, tid);
    __syncthreads();
    if (act) { const float t0 = TOT[c * 2], t1 = TOT[c * 2 + 1]; const float off = half ? t0 : 0.f, last = t0 + t1;
#pragma unroll
        for (int q = 0; q < 4; ++q) { float kt[8];
#pragma unroll
            for (int j = 0; j < 8; ++j) { const int i = 8 * q + j; const float cm = cum[i] + off; const size_t row = (size_t)(row0 + 32 * half + i); const bf16* pr = PROJ + row * NPROJ; float k;
                if constexpr (TYPE == 0) k = bf2f(pr[C_GK + c]);
                else if constexpr (TYPE == 1) k = 1.0f - __expf(cum[i] - (i > 0 ? cum[i - 1] : 0.f));
                else { const float* rp = (const float*)(ws + WS_ROPE) + row * 48; k = bf2f(pr[C_RK + h * 48 + d]) * rp[f] + sg * bf2f(pr[C_RK + h * 48 + d2]) * rp[24 + f]; }
                if constexpr (TYPE != 2) CUM[row * NDV + C::COFF + c] = cm;
                kt[j] = k * __expf(last - cm); }
            v4u w; w.x = pk2(kt[0], kt[1]); w.y = pk2(kt[2], kt[3]); w.z = pk2(kt[4], kt[5]); w.w = pk2(kt[6], kt[7]);
            *(LAS v4u*)(KT + c * BP + 32 * half + 8 * q) = w;
            asm volatile("" ::: "memory"); }
        if (TYPE != 2 && half == 0) DVEC[C::COFF + c] = __expf(last);
    }
    __syncthreads();
    constexpr int TD = DK / 16, NT = (DV / 16) * TD;
    for (int ti = wave; ti < 4 * NT; ti += NWAVES) { const int hh = ti / NT, tr = ti - hh * NT, te = tr / TD, td = tr - te * TD; f32x4 acc = {0.f, 0.f, 0.f, 0.f};
#pragma unroll
        for (int kk = 0; kk < 2; ++kk) acc = __builtin_amdgcn_mfma_f32_16x16x32_bf16(ldfrag(VT, BP, hh * DV + te * 16, kk * 32, lane), ldfrag(KT, BP, hh * DK + td * 16, kk * 32, lane), acc, 0, 0, 0);
        float* Uh = U + hh * DK * DV;
#pragma unroll
        for (int r = 0; r < 4; ++r) Uh[(te * 16 + (lane >> 4) * 4 + r) * DK + td * 16 + (lane & 15)] = acc[r]; }
    __syncthreads();
}
__device__ __forceinline__ void p3a_summaries(const Args& a, int layer, LAS unsigned char* lds, int vcu, int G, int tid, int lane, int wave) {
    for (int unit = vcu; unit < NUNIT; unit += G) {
        { LAS float* GAs = (LAS float*)(lds + LA_GA); const float* GA = (const float*)(a.ws + WS_GA); for (int i = tid; i < CH * 16; i += NTHR) GAs[i] = GA[(size_t)unit * CH * 16 + i]; }
        __syncthreads();
        mixa_batch<0>(a, layer, unit, lds, tid, lane, wave);
        mixa_batch<1>(a, layer, unit, lds, tid, lane, wave);
        mixa_batch<2>(a, layer, unit, lds, tid, lane, wave);
    }
}

__device__ __forceinline__ void p3b_scan(const Args& a, int vcu, int G, int tid) {
    unsigned char* ws = a.ws; const float* U = (const float*)(ws + WS_U); const float* DVEC = (const float*)(ws + WS_DVEC); bf16* SP = (bf16*)(ws + WS_SP);
    for (int gid = vcu * NTHR + tid; gid < BATCH * ST_TOT; gid += G * NTHR) {
        const int b = gid / ST_TOT, el = gid - b * ST_TOT;
        int di = -1; float cdec = 0.f;
        if (el < ST_HG) { const int h = el / 4608, d = (el - h * 4608) % 48; di = h * 48 + d; }
        else if (el < ST_RET) { const int r = el - ST_HG, h = r / 4096, d = r % 64; di = 192 + h * 64 + d; }
        else { const int h = (el - ST_RET) / 4608; cdec = expf(64.0f * logf(1.0f - exp2f(-5.0f - (float)h))); }
        const float* up = U + (size_t)b * NCH * ST_TOT + el; const float* dp = DVEC + (size_t)b * NCH * NDV + (di < 0 ? 0 : di); bf16* sp = SP + (size_t)b * NCH * ST_TOT + el;
        float s = 0.f;
        for (int n0 = 0; n0 < NCH; n0 += 8) { float u[8], dc[8];
#pragma unroll
            for (int i = 0; i < 8; ++i) { u[i] = up[(size_t)(n0 + i) * ST_TOT]; dc[i] = (di < 0) ? cdec : dp[(size_t)(n0 + i) * NDV]; }
#pragma unroll
            for (int i = 0; i < 8; ++i) { sp[(size_t)(n0 + i) * ST_TOT] = (bf16)f2bf(s); s = dc[i] * s + u[i]; } }
    }
}

constexpr int LC_VT = 0, LC_ST = 55296, LC_AB = 110592;
template <int TYPE, bool ISQ>
__device__ __forceinline__ void mix_frag(const Args& a, int h, size_t row, int t, int d0, float (&x)[8], float (&cm)[8]) {
    typedef MixCfg<TYPE> C; constexpr int DK = C::DK;
    unsigned char* ws = a.ws; const bf16* pr = (const bf16*)(ws + WS_PROJ) + row * NPROJ;
    if constexpr (TYPE == 0) {
        const v4u p = *(const v4u*)(pr + (ISQ ? C_GQ : C_GK) + h * DK + d0); const unsigned pw[4] = {p.x, p.y, p.z, p.w};
        const float* cp = (const float*)(ws + WS_CUM) + row * NDV + h * DK + d0; const f32x4 c0 = *(const f32x4*)cp, c1 = *(const f32x4*)(cp + 4);
#pragma unroll
        for (int j = 0; j < 4; ++j) { x[2 * j] = __builtin_bit_cast(float, pw[j] << 16); x[2 * j + 1] = __builtin_bit_cast(float, pw[j] & 0xffff0000u); cm[j] = c0[j]; cm[4 + j] = c1[j]; }
        if (ISQ) {
#pragma unroll
            for (int j = 0; j < 8; ++j) x[j] *= 0.14433756729740643f; }
    } else if constexpr (TYPE == 1) {
        const float* cp = (const float*)(ws + WS_CUM) + row * NDV + 192 + h * DK + d0; const f32x4 c0 = *(const f32x4*)cp, c1 = *(const f32x4*)(cp + 4);
#pragma unroll
        for (int j = 0; j < 4; ++j) { cm[j] = c0[j]; cm[4 + j] = c1[j]; }
        if (ISQ) { const v4u p = *(const v4u*)(pr + C_HQ + h * DK + d0); const unsigned pw[4] = {p.x, p.y, p.z, p.w};
#pragma unroll
            for (int j = 0; j < 4; ++j) { x[2 * j] = __builtin_bit_cast(float, pw[j] << 16); x[2 * j + 1] = __builtin_bit_cast(float, pw[j] & 0xffff0000u); } }
        else { f32x4 p0 = {0.f, 0.f, 0.f, 0.f}, p1 = {0.f, 0.f, 0.f, 0.f}; if (t > 0) { p0 = *(const f32x4*)(cp - NDV); p1 = *(const f32x4*)(cp - NDV + 4); }
#pragma unroll
            for (int j = 0; j < 4; ++j) { x[j] = -expm1f(c0[j] - p0[j]); x[4 + j] = -expm1f(c1[j] - p1[j]); } }
    } else {
        const int f0 = (d0 < 24) ? d0 : d0 - 24, dp = (d0 < 24) ? d0 + 24 : d0 - 24; const float sg = (d0 < 24) ? -1.f : 1.f;
        const int cb = (ISQ ? C_RQ : C_RK) + h * DK; const v4u p = *(const v4u*)(pr + cb + d0), pp = *(const v4u*)(pr + cb + dp); const unsigned pw[4] = {p.x, p.y, p.z, p.w}, qw[4] = {pp.x, pp.y, pp.z, pp.w};
        const float* rp = (const float*)(ws + WS_ROPE) + row * 48; const f32x4 cs0 = *(const f32x4*)(rp + f0), cs1 = *(const f32x4*)(rp + f0 + 4), sn0 = *(const f32x4*)(rp + 24 + f0), sn1 = *(const f32x4*)(rp + 24 + f0 + 4);
        const float cmv = (float)(t + 1) * ret_lg(h);
#pragma unroll
        for (int j = 0; j < 4; ++j) { const float xa = __builtin_bit_cast(float, pw[j] << 16), xb = __builtin_bit_cast(float, pw[j] & 0xffff0000u), ya = __builtin_bit_cast(float, qw[j] << 16), yb = __builtin_bit_cast(float, qw[j] & 0xffff0000u);
            const float ca = (j < 2) ? cs0[2 * j] : cs1[2 * j - 4], cb2 = (j < 2) ? cs0[2 * j + 1] : cs1[2 * j - 3], sa = (j < 2) ? sn0[2 * j] : sn1[2 * j - 4], sb = (j < 2) ? sn0[2 * j + 1] : sn1[2 * j - 3];
            x[2 * j] = xa * ca + sg * ya * sa; x[2 * j + 1] = xb * cb2 + sg * yb * sb; cm[2 * j] = cmv; cm[2 * j + 1] = cmv; }
        if (ISQ) {
#pragma unroll
            for (int j = 0; j < 8; ++j) x[j] *= 0.14433756729740643f; }
    }
}

template <int TYPE>
__device__ __forceinline__ void mixc_batch(const Args& a, int layer, int unit, LAS unsigned char* lds, int tid, int lane, int wave) {
    typedef MixCfg<TYPE> C; constexpr int DK = C::DK, DV = C::DV, NV = C::NV, TE = DV / 16;
    unsigned char* ws = a.ws; const bf16* PROJ = (const bf16*)(ws + WS_PROJ); bf16* MIX = (bf16*)(ws + WS_MIX);
    LAS bf16* VT = (LAS bf16*)(lds + LC_VT); LAS bf16* ST = (LAS bf16*)(lds + LC_ST); LAS bf16* AB = (LAS bf16*)(lds + LC_AB) + wave * 16 * BP;
    const int row0 = unit * CH;
    stage_vt<NV>(PROJ + (size_t)row0 * NPROJ + C::CV, VT, tid);
    { const bf16* SPu = (const bf16*)(ws + WS_SP) + (size_t)unit * ST_TOT + C::STOFF;
        for (int idx = tid; idx < NV * 8; idx += NTHR) { const int er = idx >> 3, ch = idx & 7; v4u w = {0u, 0u, 0u, 0u}; if (ch * 8 < DK) w = *(const v4u*)(SPu + (size_t)er * DK + ch * 8); *(LAS v4u*)(ST + er * BP + ch * 8) = w; } }
    __syncthreads();
    const int h = wave >> 1, hsel = wave & 1, r = lane & 15, g = lane >> 4;
    const LAS bf16* STh = ST + h * DV * BP; const LAS bf16* VTh = VT + h * DV * BP;
    const float* CUMp = (const float*)(ws + WS_CUM);
    for (int ib = 0; ib < 2; ++ib) { const int I = ib ? 3 - hsel : hsel;
        pg8::bf16x8 qh[2], qt[2]; float refv[2][8];
#pragma unroll
        for (int s = 0; s < 2; ++s) { const int d0 = 32 * s + 8 * g; const bool valid = d0 < DK; const int d0c = valid ? d0 : 0;
            float x[8], cm[8]; mix_frag<TYPE, true>(a, h, (size_t)(row0 + 16 * I + r), 16 * I + r, d0c, x, cm);
            if constexpr (TYPE == 2) {
#pragma unroll
                for (int j = 0; j < 8; ++j) refv[s][j] = (float)(16 * I) * ret_lg(h);
            } else { if (I > 0) { const float* cp = CUMp + (size_t)(row0 + 16 * I - 1) * NDV + C::COFF + h * DK + d0c; const f32x4 c0 = *(const f32x4*)cp, c1 = *(const f32x4*)(cp + 4);
#pragma unroll
                    for (int j = 0; j < 4; ++j) { refv[s][j] = c0[j]; refv[s][4 + j] = c1[j]; } }
                else {
#pragma unroll
                    for (int j = 0; j < 8; ++j) refv[s][j] = 0.f; } }
            float xh[8], xt[8];
#pragma unroll
            for (int j = 0; j < 8; ++j) { xh[j] = valid ? x[j] * __expf(cm[j] - refv[s][j]) : 0.f; xt[j] = valid ? x[j] * __expf(cm[j]) : 0.f; }
            qh[s] = pack8(xh); qt[s] = pack8(xt); }
        for (int J = 0; J <= I; ++J) { f32x4 acc = {0.f, 0.f, 0.f, 0.f};
#pragma unroll
            for (int s = 0; s < 2; ++s) { const int d0 = 32 * s + 8 * g; const bool valid = d0 < DK; const int d0c = valid ? d0 : 0;
                float x[8], cm[8]; mix_frag<TYPE, false>(a, h, (size_t)(row0 + 16 * J + r), 16 * J + r, d0c, x, cm);
                float xk[8];
#pragma unroll
                for (int j = 0; j < 8; ++j) xk[j] = valid ? x[j] * __expf(fminf(refv[s][j] - cm[j], 80.f)) : 0.f;
                acc = __builtin_amdgcn_mfma_f32_16x16x32_bf16(qh[s], pack8(xk), acc, 0, 0, 0); }
#pragma unroll
            for (int q = 0; q < 4; ++q) { const int i = 4 * g + q; const float v = (J < I || r <= i) ? acc[q] : 0.f; AB[i * BP + 16 * J + r] = (bf16)f2bf(v); } }
        if ((I & 1) == 0) {
#pragma unroll
            for (int q = 0; q < 4; ++q) AB[(4 * g + q) * BP + 16 * (I + 1) + r] = (bf16)0; }
        asm volatile("s_waitcnt lgkmcnt(0)" ::: "memory");
        const pg8::bf16x8 ah0 = *(const LAS pg8::bf16x8*)(AB + r * BP + 8 * g), ah1 = *(const LAS pg8::bf16x8*)(AB + r * BP + 32 + 8 * g);
        f32x4 o[TE];
#pragma unroll
        for (int te = 0; te < TE; ++te) { f32x4 acc = {0.f, 0.f, 0.f, 0.f};
            acc = __builtin_amdgcn_mfma_f32_16x16x32_bf16(qt[0], ldfrag(STh, BP, te * 16, 0, lane), acc, 0, 0, 0);
            acc = __builtin_amdgcn_mfma_f32_16x16x32_bf16(qt[1], ldfrag(STh, BP, te * 16, 32, lane), acc, 0, 0, 0);
            acc = __builtin_amdgcn_mfma_f32_16x16x32_bf16(ah0, ldfrag(VTh, BP, te * 16, 0, lane), acc, 0, 0, 0);
            if (I >= 2) acc = __builtin_amdgcn_mfma_f32_16x16x32_bf16(ah1, ldfrag(VTh, BP, te * 16, 32, lane), acc, 0, 0, 0);
            o[te] = acc; }
#pragma unroll
        for (int q = 0; q < 4; ++q) { float s1 = 0.f, s2 = 0.f;
#pragma unroll
            for (int te = 0; te < TE; ++te) { s1 += o[te][q]; s2 += o[te][q] * o[te][q]; }
#pragma unroll
            for (int m = 1; m < 16; m <<= 1) { s1 += __shfl_xor(s1, m); s2 += __shfl_xor(s2, m); }
            const size_t row = (size_t)(row0 + 16 * I + 4 * g + q); const bf16* pr = PROJ + row * NPROJ + C::CG + h * DV; bf16* mo = MIX + row * D + C::MIXOFF + h * DV;
            float mean = 0.f, rstd;
            if constexpr (TYPE == 2) { mean = s1 * (1.0f / DV); rstd = 1.0f / sqrtf(fmaxf(s2 * (1.0f / DV) - mean * mean, 0.f) + EPS); }
            else rstd = 1.0f / sqrtf(s2 * (1.0f / DV) + EPS);
#pragma unroll
            for (int te = 0; te < TE; ++te) { const int e = te * 16 + r; const float gt = bf2f(pr[e]); float v;
                if constexpr (TYPE == 0) v = o[te][q] * rstd * a.gla_norm_w[layer * 384 + h * 96 + e] * (gt / (1.0f + __expf(-gt)));
                else if constexpr (TYPE == 1) v = o[te][q] * rstd * a.hg_norm_w[layer * 256 + h * 64 + e] * (1.0f / (1.0f + __expf(-gt)));
                else v = (o[te][q] - mean) * rstd * (gt / (1.0f + __expf(-gt)));
                mo[e] = (bf16)f2bf(v); } }
    }
    __syncthreads();
}
__device__ __forceinline__ void p3c_outputs(const Args& a, int layer, LAS unsigned char* lds, int vcu, int G, int tid, int lane, int wave) {
    for (int unit = vcu; unit < NUNIT; unit += G) {
        mixc_batch<0>(a, layer, unit, lds, tid, lane, wave);
        mixc_batch<1>(a, layer, unit, lds, tid, lane, wave);
        mixc_batch<2>(a, layer, unit, lds, tid, lane, wave);
    }
}

constexpr int MW_ARGS = 800;
__device__ __forceinline__ const void* ld_argp(const volatile LAS unsigned* T, int i) {
    const unsigned lo = __builtin_amdgcn_readfirstlane(T[2 * i]), hi = __builtin_amdgcn_readfirstlane(T[2 * i + 1]);
    return (const void*)(((unsigned long long)hi << 32) | lo);
}
__device__ __forceinline__ Args load_args(LAS unsigned char* lds) {
    const volatile LAS unsigned* T = (const volatile LAS unsigned*)(lds + MISC_OFF) + MW_ARGS;
    Args a;
    a.x = (const float*)ld_argp(T, 0); a.c = (const float*)ld_argp(T, 1); a.pos = (const int*)ld_argp(T, 2); a.w_mod = (const float*)ld_argp(T, 3); a.b_mod = (const float*)ld_argp(T, 4);
    a.norm1_w = (const float*)ld_argp(T, 5); a.w_in = (const float*)ld_argp(T, 6); a.gla_wa2 = (const float*)ld_argp(T, 7); a.gla_ba2 = (const float*)ld_argp(T, 8); a.hg_lb = (const float*)ld_argp(T, 9);
    a.gla_norm_w = (const float*)ld_argp(T, 10); a.hg_norm_w = (const float*)ld_argp(T, 11); a.w_out = (const float*)ld_argp(T, 12); a.norm2_w = (const float*)ld_argp(T, 13); a.w_r = (const float*)ld_argp(T, 14);
    a.b_r = (const float*)ld_argp(T, 15); a.w_gu = (const float*)ld_argp(T, 16); a.b_gu = (const float*)ld_argp(T, 17); a.w_dn = (const float*)ld_argp(T, 18); a.b_dn = (const float*)ld_argp(T, 19);
    a.final_norm_w = (const float*)ld_argp(T, 20); a.out = (float*)ld_argp(T, 21); a.ws = (unsigned char*)ld_argp(T, 22); a.ph_lo = 0; a.ph_hi = 0;
    return a;
}
#define PH_CTX() { unsigned l_ = (unsigned)(size_t)lds; asm volatile("" : "+s"(l_)); lds = (LAS unsigned char*)(size_t)l_; } const Args args = load_args(lds); volatile LAS unsigned* MISC = (volatile LAS unsigned*)(lds + MISC_OFF); int tid_ = threadIdx.x; asm volatile("" : "+v"(tid_)); const int tid = tid_, lane = tid & 63, wave = __builtin_amdgcn_readfirstlane(tid >> 6); \
    const int G = gridDim.x; const int bx = blockIdx.x; const int vcu = (G % 8 == 0) ? (bx % 8) * (G / 8) + bx / 8 : bx; unsigned char* ws = args.ws; gu32* ctl = (gu32*)(ws + WS_CTL); \
    (void)MISC; (void)lane; (void)wave; (void)vcu; (void)ctl; (void)bx; (void)tid
__device__ __forceinline__ void ph_p0(LAS unsigned char* lds) { PH_CTX(); p0_prologue(args, lds, vcu, G, tid, lane, wave); }
__device__ __forceinline__ void ph_p1(LAS unsigned char* lds, int layer_) { int layer = __builtin_amdgcn_readfirstlane(layer_); asm volatile("" : "+s"(layer)); PH_CTX(); rows_mfma<16>(args, layer, lds, MISC, ctl, vcu, G, tid, lane, wave); }
__device__ __forceinline__ void ph_p2(LAS unsigned char* lds, int layer_) { int layer = __builtin_amdgcn_readfirstlane(layer_); asm volatile("" : "+s"(layer)); PH_CTX();
    pg8::Gemm g{(const bf16*)(ws + WS_H), (const bf16*)(ws + WS_WIN) + (size_t)layer * NPROJ * D, MTOK, NPROJ, D}; pg8::StaticOrder S; S.init(MTOK, NPROJ, G, bx);
    pg8::EpiBf16Plain E{(bf16*)(ws + WS_PROJ), NPROJ};
    pg8::gemm_phase<pg8::EpiBf16Plain, pg8::StaticOrder, true, true>(lds, g, S, E); }
__device__ __forceinline__ void ph_p3a(LAS unsigned char* lds, int layer_) { int layer = __builtin_amdgcn_readfirstlane(layer_); asm volatile("" : "+s"(layer)); PH_CTX(); p3a_summaries(args, layer, lds, vcu, G, tid, lane, wave); }
__device__ __forceinline__ void ph_p3b(LAS unsigned char* lds) { PH_CTX(); p3b_scan(args, vcu, G, tid); }
__device__ __forceinline__ void ph_p3c(LAS unsigned char* lds, int layer_) { int layer = __builtin_amdgcn_readfirstlane(layer_); asm volatile("" : "+s"(layer)); PH_CTX(); p3c_outputs(args, layer, lds, vcu, G, tid, lane, wave); }
__device__ __forceinline__ void ph_p4(LAS unsigned char* lds, int layer_) { int layer = __builtin_amdgcn_readfirstlane(layer_); asm volatile("" : "+s"(layer)); PH_CTX();
    pg8::Gemm g{(const bf16*)(ws + WS_MIX), (const bf16*)(ws + WS_WOUT) + (size_t)layer * D * D, MTOK, D, D}; pg8::StaticOrder S; S.init(MTOK, D, G, bx);
    pg8::EpiResGate E{(layer == 0) ? args.x : (const float*)(ws + WS_X), (float*)(ws + WS_X), D, (const float*)(ws + WS_MOD) + (size_t)layer * 2 * 6144 + 2 * D, 6144, SEQ};
    pg8::gemm_phase<pg8::EpiResGate, pg8::StaticOrder, true, true>(lds, g, S, E); }
__device__ __forceinline__ void ph_p5(LAS unsigned char* lds, int layer_) { int layer = __builtin_amdgcn_readfirstlane(layer_); asm volatile("" : "+s"(layer)); PH_CTX(); rows_mfma<32>(args, layer, lds, MISC, ctl, vcu, G, tid, lane, wave); }
__device__ __forceinline__ void ph_p6(LAS unsigned char* lds, int layer_) { int layer = __builtin_amdgcn_readfirstlane(layer_); asm volatile("" : "+s"(layer)); PH_CTX(); p6_dispatch(args, layer, MISC, ctl, vcu, G, tid, lane, wave); }
__device__ __forceinline__ void ph_p7(LAS unsigned char* lds, int layer_) { int layer = __builtin_amdgcn_readfirstlane(layer_); asm volatile("" : "+s"(layer)); PH_CTX();
    moe_tables(ctl, layer, MISC, tid);
    const int nrt = __builtin_amdgcn_readfirstlane((int)MISC[MW_NRT]);
    pg8::Gemm g{(const bf16*)(ws + WS_A1), (const bf16*)(ws + WS_WGU) + (size_t)layer * NE * 2048 * D, nrt * 256, NE * 2048, D};
    pg8::MoeOrder S{8, G, vcu, nrt * 8, (const LAS int*)(lds + MISC_OFF + 4 * MW_TILE)};
    pg8::EpiSwiglu E{(bf16*)(ws + WS_ACT), FFN, args.b_gu + (size_t)layer * NE * 2048};
    pg8::gemm_phase<pg8::EpiSwiglu, pg8::MoeOrder, true, true>(lds, g, S, E); }
__device__ __forceinline__ void ph_p8(LAS unsigned char* lds, int layer_) { int layer = __builtin_amdgcn_readfirstlane(layer_); asm volatile("" : "+s"(layer)); PH_CTX();
    moe_tables(ctl, layer, MISC, tid);
    const int nrt = __builtin_amdgcn_readfirstlane((int)MISC[MW_NRT]);
    pg8::Gemm g{(const bf16*)(ws + WS_ACT), (const bf16*)(ws + WS_WDN) + (size_t)layer * NE * D * FFN, nrt * 256, NE * D, FFN};
    pg8::MoeOrder S{4, G, vcu, nrt * 4, (const LAS int*)(lds + MISC_OFF + 4 * MW_TILE)};
    pg8::EpiBf16Bias E{(bf16*)(ws + WS_Y), D, args.b_dn + (size_t)layer * NE * D, D};
    pg8::gemm_phase<pg8::EpiBf16Bias, pg8::MoeOrder, true, true>(lds, g, S, E); }
__device__ __forceinline__ void ph_final(LAS unsigned char* lds) { PH_CTX(); final_rows(args, vcu, G, lane, wave); }

#ifndef DBL_MASK
#define DBL_MASK 0
#endif
#if DBL_MASK
#define RUN(bit, call) do { if ((DBL_MASK >> (bit)) & 1) { const unsigned long long t0_ = __builtin_amdgcn_s_memrealtime(); call; const unsigned long long t1_ = __builtin_amdgcn_s_memrealtime(); \
        while (__builtin_amdgcn_s_memrealtime() - t1_ < t1_ - t0_) __builtin_amdgcn_s_sleep(8); } else { call; } } while (0)
#else
#define RUN(bit, call) do { call; } while (0)
#endif
__global__ void __launch_bounds__(NTHR, 2) hybrid_fwd(Args args) {
    extern __shared__ __attribute__((aligned(16))) unsigned char lds_raw[];
    LAS unsigned char* lds = (LAS unsigned char*)lds_raw;
    volatile LAS unsigned* MISC = (volatile LAS unsigned*)(lds + MISC_OFF);
    const int tid = threadIdx.x;
    gu32* ctl = (gu32*)(args.ws + WS_CTL);
    for (int u = tid; u < (LDS_BYTES - MISC_OFF) / 4; u += NTHR) MISC[u] = 0u;
    __syncthreads();
    if (tid == 0) {
#define ST_ARG(i, p) do { const unsigned long long v_ = (unsigned long long)(p); MISC[MW_ARGS + 2 * (i)] = (unsigned)v_; MISC[MW_ARGS + 2 * (i) + 1] = (unsigned)(v_ >> 32); } while (0)
        ST_ARG(0, args.x); ST_ARG(1, args.c); ST_ARG(2, args.pos); ST_ARG(3, args.w_mod); ST_ARG(4, args.b_mod); ST_ARG(5, args.norm1_w); ST_ARG(6, args.w_in); ST_ARG(7, args.gla_wa2); ST_ARG(8, args.gla_ba2);
        ST_ARG(9, args.hg_lb); ST_ARG(10, args.gla_norm_w); ST_ARG(11, args.hg_norm_w); ST_ARG(12, args.w_out); ST_ARG(13, args.norm2_w); ST_ARG(14, args.w_r); ST_ARG(15, args.b_r); ST_ARG(16, args.w_gu);
        ST_ARG(17, args.b_gu); ST_ARG(18, args.w_dn); ST_ARG(19, args.b_dn); ST_ARG(20, args.final_norm_w); ST_ARG(21, args.out); ST_ARG(22, args.ws);
#undef ST_ARG
    }
    __syncthreads();
    const int lo = args.ph_lo, hi = args.ph_hi;
    const bool multi = (hi - lo) > 1;
    XcdBarrier bar; bar.bar = (unsigned*)(ctl + CW_BAR); bar.x = 0; bar.st = nullptr;
    if (multi) bar = xcd_barrier_post((unsigned*)(ctl + CW_BAR), MISC + MW_BAR);
#define IN(k) (lo <= (k) && (k) < hi)
#define SEAM(k) do { if (IN(k) && IN((k) + 1)) xcd_barrier(bar); } while (0)

    if (IN(0)) RUN(0, ph_p0(lds));
    SEAM(0);
    for (int layer = 0; layer < DEPTH; ++layer) {
        const int pb = 1 + 10 * layer;
        if (IN(pb + 0)) RUN(1, ph_p1(lds, layer));
        SEAM(pb + 0);
        if (IN(pb + 1)) RUN(2, ph_p2(lds, layer));
        SEAM(pb + 1);
        if (IN(pb + 2)) RUN(3, ph_p3a(lds, layer));
        SEAM(pb + 2);
        if (IN(pb + 3)) RUN(4, ph_p3b(lds));
        SEAM(pb + 3);
        if (IN(pb + 4)) RUN(5, ph_p3c(lds, layer));
        SEAM(pb + 4);
        if (IN(pb + 5)) RUN(6, ph_p4(lds, layer));
        SEAM(pb + 5);
        if (IN(pb + 6)) RUN(7, ph_p5(lds, layer));
        SEAM(pb + 6);
        if (IN(pb + 7)) RUN(8, ph_p6(lds, layer));
        SEAM(pb + 7);
        if (IN(pb + 8)) RUN(9, ph_p7(lds, layer));
        SEAM(pb + 8);
        if (IN(pb + 9)) RUN(10, ph_p8(lds, layer));
        SEAM(pb + 9);
    }
    if (IN(NPHASE - 1)) RUN(11, ph_final(lds));
#undef IN
#undef SEAM
}

#ifndef MK_SINGLE
#define MK_SINGLE 1
#endif
extern "C" void kernel_launch(void* const* d_in, const int* in_sizes, int n_in, void* d_out, int out_size, void* d_ws, size_t ws_size, hipStream_t stream) {
    static int grid = 0;
    if (grid == 0) {
        if (n_in != 21 || in_sizes[0] != MTOK * D || out_size != MTOK * D || ws_size < WS_END) { fprintf(stderr, "kernel_launch: unexpected problem shape (n_in %d, in0 %d, out %d, ws %zu)\n", n_in, n_in > 0 ? in_sizes[0] : -1, out_size, ws_size); grid = -1; return; }
        int dev = 0, cus = 0, per_cu = 0;
        if (hipGetDevice(&dev) != hipSuccess || hipDeviceGetAttribute(&cus, hipDeviceAttributeMultiprocessorCount, dev) != hipSuccess) { grid = -1; return; }
        if (hipFuncSetAttribute((const void*)hybrid_fwd, hipFuncAttributeMaxDynamicSharedMemorySize, LDS_BYTES) != hipSuccess) { fprintf(stderr, "kernel_launch: hipFuncSetAttribute failed\n"); grid = -1; return; }
        if (hipOccupancyMaxActiveBlocksPerMultiprocessor(&per_cu, (const void*)hybrid_fwd, NTHR, LDS_BYTES) != hipSuccess || per_cu < 1) fprintf(stderr, "kernel_launch: occupancy query says %d\n", per_cu);
        (void)hipGetLastError();
        grid = cus;
    }
    if (grid < 0) return;
    (void)hipMemsetAsync((char*)d_ws + WS_CTL, 0, CTL_ZERO_BYTES, stream);
    Args a{};
    a.x = (const float*)d_in[0]; a.c = (const float*)d_in[1]; a.pos = (const int*)d_in[2]; a.w_mod = (const float*)d_in[3]; a.b_mod = (const float*)d_in[4]; a.norm1_w = (const float*)d_in[5];
    a.w_in = (const float*)d_in[6]; a.gla_wa2 = (const float*)d_in[7]; a.gla_ba2 = (const float*)d_in[8]; a.hg_lb = (const float*)d_in[9]; a.gla_norm_w = (const float*)d_in[10]; a.hg_norm_w = (const float*)d_in[11];
    a.w_out = (const float*)d_in[12]; a.norm2_w = (const float*)d_in[13]; a.w_r = (const float*)d_in[14]; a.b_r = (const float*)d_in[15]; a.w_gu = (const float*)d_in[16]; a.b_gu = (const float*)d_in[17];
    a.w_dn = (const float*)d_in[18]; a.b_dn = (const float*)d_in[19]; a.final_norm_w = (const float*)d_in[20]; a.out = (float*)d_out; a.ws = (unsigned char*)d_ws;
#if MK_SINGLE
    a.ph_lo = 0; a.ph_hi = NPHASE;
    hipLaunchKernelGGL(hybrid_fwd, dim3(grid), dim3(NTHR), LDS_BYTES, stream, a);
#else
    for (int p = 0; p < NPHASE; ++p) { a.ph_lo = p; a.ph_hi = p + 1; hipLaunchKernelGGL(hybrid_fwd, dim3(grid), dim3(NTHR), LDS_BYTES, stream, a); }
#endif
}
```

```cpp
#include <hip/hip_runtime.h>
#include <cstdio>
#include <cstdint>
namespace pg8 {
#define PG8_LAS __attribute__((address_space(3)))
typedef unsigned short bf16_t;
typedef short bf16x8 __attribute__((ext_vector_type(8)));
typedef float f32x4 __attribute__((ext_vector_type(4)));
typedef unsigned u32x4 __attribute__((ext_vector_type(4)));
constexpr int BM = 256, BK = 64, HALF = 128, HTB = HALF * BK * 2  , STAGE_BYTES = 8 * HTB, NXCD = 8, WGM = 8;

__host__ __device__ __forceinline__ int lds_byte(int r, int c) { const int st = (r >> 4) * 2 + (c >> 5), rr = r & 15, cc = c & 31, ob = rr * 64 + cc * 2; return st * 1024 + (ob ^ (((ob >> 9) & 1) << 5)); }
__host__ __device__ __forceinline__ void stage_rc(int b, int& R, int& C) { const int st = b / 1024, sb = b % 1024, swz = sb ^ (((sb >> 9) & 1) << 5); R = (st >> 1) * 16 + swz / 64; C = (st & 1) * 32 + (swz % 64) / 2; }
__host__ __device__ __forceinline__ int perm32(int rho) { const int n = rho >> 4, i = rho & 15; return 8 * (i >> 2) + 4 * n + (i & 3); }

struct Unit { int pm, pn, e, pl; };
struct Gemm { const bf16_t* A; const bf16_t* Bt; int M, N, K; };

struct StaticOrder {
    int nM, nN, nwg, G, c;
    __host__ __device__ void init(int M, int N, int G_, int c_) { nM = M / BM; nN = N / BM; nwg = nM * nN; G = G_; c = c_; }
    __host__ __device__ bool next(int i, Unit& u) const {
        const long L = (long)i * G + c; if (L >= nwg) return false;
        int wgid = (int)L; { const int q = nwg / NXCD, r = nwg % NXCD, xcd = wgid % NXCD, off = wgid / NXCD; wgid = (xcd < r ? xcd * (q + 1) : r * (q + 1) + (xcd - r) * q) + off; }
        const int nig = WGM * nN, gid = wgid / nig, fm = gid * WGM, gsz = (nM - fm) < WGM ? (nM - fm) : WGM;
        u.pm = fm + ((wgid % nig) % gsz); u.pn = (wgid % nig) / gsz; u.e = 0; u.pl = u.pn; return true;
    }
    __device__ __forceinline__ void a_ready(const Unit&) const {}
    __device__ __forceinline__ void done(const Unit&) const {}
};

__device__ __forceinline__ unsigned cvt_pk_bf16(float lo, float hi) { unsigned r; asm volatile("v_cvt_pk_bf16_f32 %0, %1, %2" : "=v"(r) : "v"(lo), "v"(hi)); return r; }

struct EpiBf16Plain {
    static constexpr bool PERM = true, AFTER_DRAIN = false;
    bf16_t* O; int ldc;
    __device__ __forceinline__ void operator()(const f32x4 (&acc)[2][2][4][2], const Unit& u, int wr, int wc, int fr, int fq) const {
        const int row0 = u.pm * BM + wr * 64 + fr; const int col0 = u.pn * BM + wc * 32 + 8 * fq;
#pragma unroll
        for (int ai = 0; ai < 2; ++ai)
#pragma unroll
            for (int m = 0; m < 4; ++m) { bf16_t* rowp = O + (size_t)(row0 + ai * HALF + m * 16) * ldc + col0;
#pragma unroll
                for (int bj = 0; bj < 2; ++bj) { const f32x4 v0 = acc[ai][bj][m][0], v1 = acc[ai][bj][m][1];
                    u32x4 w; w.x = cvt_pk_bf16(v0[0], v0[1]); w.y = cvt_pk_bf16(v0[2], v0[3]); w.z = cvt_pk_bf16(v1[0], v1[1]); w.w = cvt_pk_bf16(v1[2], v1[3]);
                    *(u32x4*)(rowp + bj * HALF) = w; } }
    }
};
struct EpiResGate {
    static constexpr bool PERM = false, AFTER_DRAIN = false;
    const float* base; float* out; int ldc; const float* gate; int gpitch; int rows_per_batch;
    __device__ __forceinline__ void operator()(const f32x4 (&acc)[2][2][4][2], const Unit& u, int wr, int wc, int fr, int fq) const {
        const int row0 = u.pm * BM + wr * 64 + fr, col0 = u.pn * BM + wc * 32 + 4 * fq;
        const float* gp = gate + (size_t)((u.pm * BM) / rows_per_batch) * gpitch + col0;
        f32x4 gv[2][2];
#pragma unroll
        for (int bj = 0; bj < 2; ++bj)
#pragma unroll
            for (int n = 0; n < 2; ++n) gv[bj][n] = *(const f32x4*)(gp + bj * HALF + n * 16);
#pragma unroll
        for (int ai = 0; ai < 2; ++ai)
#pragma unroll
            for (int m = 0; m < 4; ++m) { const size_t off = (size_t)(row0 + ai * HALF + m * 16) * ldc + col0;
#pragma unroll
                for (int bj = 0; bj < 2; ++bj)
#pragma unroll
                    for (int n = 0; n < 2; ++n) { const f32x4 bs = *(const f32x4*)(base + off + bj * HALF + n * 16);
                        *(f32x4*)(out + off + bj * HALF + n * 16) = bs + gv[bj][n] * acc[ai][bj][m][n]; }
                asm volatile("" ::: "memory"); }
    }
};
struct EpiSwiglu {
    static constexpr bool PERM = true, AFTER_DRAIN = false;
    bf16_t* O; int ldc; const float* bias;
    __device__ __forceinline__ float act1(float g, float up) const {
        g = fminf(g, 7.0f); up = fminf(fmaxf(up, -7.0f), 7.0f);
        const float s = 1.0f / (1.0f + __expf(-1.702f * g));
        return (up + 1.0f) * g * s;
    }
    __device__ __forceinline__ void operator()(const f32x4 (&acc)[2][2][4][2], const Unit& u, int wr, int wc, int fr, int fq) const {
        const int row0 = u.pm * BM + wr * 64 + fr; const int jj0 = wc * 32 + 8 * fq; const int col0 = u.pl * HALF + jj0;
        const float* bp = bias + (size_t)u.e * 2048 + col0;
        f32x4 bg[2], bu[2];
#pragma unroll
        for (int n = 0; n < 2; ++n) { bg[n] = *(const f32x4*)(bp + 4 * n); bu[n] = *(const f32x4*)(bp + 1024 + 4 * n); }
#pragma unroll
        for (int ai = 0; ai < 2; ++ai)
#pragma unroll
            for (int m = 0; m < 4; ++m) { bf16_t* rowp = O + (size_t)(row0 + ai * HALF + m * 16) * ldc + col0;
                f32x4 r[2];
#pragma unroll
                for (int n = 0; n < 2; ++n) { const f32x4 g = acc[ai][0][m][n] + bg[n], up = acc[ai][1][m][n] + bu[n];
#pragma unroll
                    for (int j = 0; j < 4; ++j) r[n][j] = act1(g[j], up[j]); }
                u32x4 w; w.x = cvt_pk_bf16(r[0][0], r[0][1]); w.y = cvt_pk_bf16(r[0][2], r[0][3]); w.z = cvt_pk_bf16(r[1][0], r[1][1]); w.w = cvt_pk_bf16(r[1][2], r[1][3]);
                *(u32x4*)rowp = w; }
    }
};
struct EpiBf16Bias {
    static constexpr bool PERM = true, AFTER_DRAIN = false;
    bf16_t* O; int ldc; const float* bias; int bpitch;
    __device__ __forceinline__ void operator()(const f32x4 (&acc)[2][2][4][2], const Unit& u, int wr, int wc, int fr, int fq) const {
        const int row0 = u.pm * BM + wr * 64 + fr; const int col0 = u.pl * BM + wc * 32 + 8 * fq;
        const float* bp = bias + (size_t)u.e * bpitch + col0;
        f32x4 bv[2][2];
#pragma unroll
        for (int bj = 0; bj < 2; ++bj)
#pragma unroll
            for (int n = 0; n < 2; ++n) bv[bj][n] = *(const f32x4*)(bp + bj * HALF + 4 * n);
#pragma unroll
        for (int ai = 0; ai < 2; ++ai)
#pragma unroll
            for (int m = 0; m < 4; ++m) { bf16_t* rowp = O + (size_t)(row0 + ai * HALF + m * 16) * ldc + col0;
#pragma unroll
                for (int bj = 0; bj < 2; ++bj) { const f32x4 v0 = acc[ai][bj][m][0] + bv[bj][0], v1 = acc[ai][bj][m][1] + bv[bj][1];
                    u32x4 w; w.x = cvt_pk_bf16(v0[0], v0[1]); w.y = cvt_pk_bf16(v0[2], v0[3]); w.z = cvt_pk_bf16(v1[0], v1[1]); w.w = cvt_pk_bf16(v1[2], v1[3]);
                    *(u32x4*)(rowp + bj * HALF) = w; } }
    }
};
struct MoeOrder {
    int nN, G, c, nunits; const PG8_LAS int* tile_e;
    __device__ __forceinline__ bool next(int i, Unit& u) const {
        const int L = i * G + c; if (L >= nunits) return false;
        const int pm = L / nN, pl = L - pm * nN, e = __builtin_amdgcn_readfirstlane(tile_e[pm]);
        u.pm = pm; u.pl = pl; u.e = e; u.pn = e * nN + pl; return true;
    }
    __device__ __forceinline__ void a_ready(const Unit&) const {}
    __device__ __forceinline__ void done(const Unit&) const {}
};
template <class Epi, class Sched, bool ALIGN_EPI = false, bool SP2 = false>
__device__ __forceinline__ void gemm_phase(PG8_LAS unsigned char* lds, const Gemm g, const Sched& S, const Epi& E) {
    int tid_ = threadIdx.x; asm volatile("" : "+v"(tid_)); const int tid = tid_, wid = __builtin_amdgcn_readfirstlane(tid >> 6), lane = tid & 63, wr = wid >> 2, wc = wid & 3, fr = lane & 15, fq = lane >> 4;
    const int K = g.K, nt = K / BK;
    unsigned voffA[2], voffB[2];
#pragma unroll
    for (int i = 0; i < 2; ++i) { int R, C; stage_rc(tid * 16 + i * 8192, R, C); const int Rb = Epi::PERM ? ((R & ~31) + perm32(R & 31)) : R;
        voffA[i] = (unsigned)(R * K + C) * 2u; voffB[i] = (unsigned)(Rb * K + C) * 2u; }
    const size_t kstep = (size_t)(BK * 2);
    const size_t hstep = (size_t)HALF * K * 2;
    const size_t tstep = 2 * hstep;
    const unsigned ldsw = (unsigned)wid * 1024u;
    const int aoff = lds_byte(wr * 64 + fr, fq * 8), boff = lds_byte(wc * 32 + fr, fq * 8);
#define PG8_SA(b, h) (((b) * 2 + (h)) * HTB)
#define PG8_SB(b, h) ((4 + (b) * 2 + (h)) * HTB)
#define PG8_STAGE(bufoff, gbase, voff) do { _Pragma("unroll") for (int _i = 0; _i < 2; ++_i) \
        __builtin_amdgcn_global_load_lds((const unsigned*)((const char*)(gbase) + (voff)[_i]), (PG8_LAS unsigned*)(lds + (bufoff) + ldsw + _i * 8192), 16, 0, 0); } while (0)
#define PG8_LDA(dst, b, h) do { _Pragma("unroll") for (int m = 0; m < 4; ++m) _Pragma("unroll") for (int k = 0; k < 2; ++k) dst[m][k] = *(const PG8_LAS bf16x8*)(lds + PG8_SA(b, h) + aoff + m * 2048 + k * 1024); } while (0)
#define PG8_LDB(dst, b, h) do { _Pragma("unroll") for (int n = 0; n < 2; ++n) _Pragma("unroll") for (int k = 0; k < 2; ++k) dst[n][k] = *(const PG8_LAS bf16x8*)(lds + PG8_SB(b, h) + boff + n * 2048 + k * 1024); } while (0)
#define PG8_MMA(ai, bj, At, Bt) do { __builtin_amdgcn_s_setprio(1); _Pragma("unroll") for (int m = 0; m < 4; ++m) _Pragma("unroll") for (int n = 0; n < 2; ++n) _Pragma("unroll") for (int k = 0; k < 2; ++k) \
        acc[ai][bj][m][n] = __builtin_amdgcn_mfma_f32_16x16x32_bf16(Bt[n][k], At[m][k], acc[ai][bj][m][n], 0, 0, 0); __builtin_amdgcn_s_setprio(0); } while (0)
#define PG8_WAIT_V(n) asm volatile("s_waitcnt vmcnt(" #n ")" ::: "memory")
#define PG8_WAIT_L(n) asm volatile("s_waitcnt lgkmcnt(" #n ")" ::: "memory")
#define PG8_BAR __builtin_amdgcn_s_barrier()
#define PG8_SCHED __builtin_amdgcn_sched_barrier(0)
    Unit cur, nxt; int ui = 0;
    if (!S.next(0, cur)) return;
    f32x4 acc[2][2][4][2];
#pragma unroll
    for (int a = 0; a < 2; ++a)
#pragma unroll
        for (int b = 0; b < 2; ++b)
#pragma unroll
            for (int m = 0; m < 4; ++m)
#pragma unroll
                for (int n = 0; n < 2; ++n) acc[a][b][m][n] = (f32x4){0.f, 0.f, 0.f, 0.f};
    bf16x8 At[4][2], B0[2][2], B1[2][2];
    const char* cA = (const char*)g.A + (size_t)cur.pm * tstep; const char* cB = (const char*)g.Bt + (size_t)cur.pn * tstep;
    S.a_ready(cur);
    if constexpr (SP2) {
        PG8_STAGE(PG8_SB(0, 0), cB, voffB); PG8_STAGE(PG8_SB(0, 1), cB + hstep, voffB); PG8_STAGE(PG8_SA(0, 0), cA, voffA); PG8_STAGE(PG8_SA(0, 1), cA + hstep, voffA);
        if (wr == 1) PG8_BAR;
        PG8_WAIT_V(2); PG8_BAR;
        PG8_STAGE(PG8_SB(1, 0), cB + kstep, voffB); PG8_STAGE(PG8_SA(1, 0), cA + kstep, voffA); PG8_STAGE(PG8_SB(1, 1), cB + hstep + kstep, voffB);
        PG8_WAIT_V(6); PG8_BAR;
    } else {
        PG8_STAGE(PG8_SB(0, 0), cB, voffB); PG8_STAGE(PG8_SA(0, 0), cA, voffA); PG8_STAGE(PG8_SB(0, 1), cB + hstep, voffB); PG8_STAGE(PG8_SA(0, 1), cA + hstep, voffA);
        if (wr == 1) PG8_BAR;
        PG8_WAIT_V(4); PG8_BAR;
        PG8_STAGE(PG8_SB(1, 0), cB + kstep, voffB); PG8_STAGE(PG8_SA(1, 0), cA + kstep, voffA); PG8_STAGE(PG8_SB(1, 1), cB + hstep + kstep, voffB);
        PG8_WAIT_V(6); PG8_BAR;
    }
    for (;;) {
        const bool has_next = S.next(ui + 1, nxt);
        const char* nA = has_next ? (const char*)g.A + (size_t)nxt.pm * tstep : cA; const char* nB = has_next ? (const char*)g.Bt + (size_t)nxt.pn * tstep : cB;
        for (int t = 0; t < nt; t += 2) {
            const bool last = (t == nt - 2);
            const char* a1 = cA + (size_t)(t + 1) * kstep;
            const char* a2 = last ? nA : cA + (size_t)(t + 2) * kstep; const char* b2 = last ? nB : cB + (size_t)(t + 2) * kstep;
            const char* a3 = a2 + kstep; const char* b3 = b2 + kstep;
            if (last && has_next) S.a_ready(nxt);
            if constexpr (SP2) {
            PG8_LDB(B0, 0, 0); PG8_LDB(B1, 0, 1); PG8_SCHED; PG8_LDA(At, 0, 0); PG8_STAGE(PG8_SA(1, 1), a1 + hstep, voffA);
            PG8_WAIT_V(8); PG8_WAIT_L(0); PG8_BAR; PG8_MMA(0, 0, At, B0); PG8_MMA(0, 1, At, B1); PG8_BAR; PG8_SCHED;
            PG8_LDA(At, 0, 1); PG8_STAGE(PG8_SB(0, 0), b2, voffB); PG8_STAGE(PG8_SB(0, 1), b2 + hstep, voffB); PG8_STAGE(PG8_SA(0, 0), a2, voffA);
            PG8_WAIT_V(8); PG8_WAIT_L(0); PG8_BAR; PG8_MMA(1, 0, At, B0); PG8_MMA(1, 1, At, B1); PG8_BAR; PG8_SCHED;
            PG8_LDB(B0, 1, 0); PG8_LDB(B1, 1, 1); PG8_SCHED; PG8_LDA(At, 1, 0); PG8_STAGE(PG8_SA(0, 1), a2 + hstep, voffA);
            PG8_WAIT_V(8); PG8_WAIT_L(0); PG8_BAR; PG8_MMA(0, 0, At, B0); PG8_MMA(0, 1, At, B1); PG8_BAR; PG8_SCHED;
            PG8_LDA(At, 1, 1); PG8_STAGE(PG8_SB(1, 0), b3, voffB); PG8_STAGE(PG8_SB(1, 1), b3 + hstep, voffB); PG8_STAGE(PG8_SA(1, 0), a3, voffA);
            PG8_WAIT_V(8); PG8_WAIT_L(0); PG8_BAR; PG8_MMA(1, 0, At, B0); PG8_MMA(1, 1, At, B1); PG8_BAR; PG8_SCHED;
            } else {
            PG8_LDB(B0, 0, 0); PG8_SCHED; PG8_LDA(At, 0, 0); PG8_STAGE(PG8_SA(1, 1), a1 + hstep, voffA);
            PG8_WAIT_L(8); PG8_BAR; PG8_WAIT_L(0); PG8_MMA(0, 0, At, B0); PG8_BAR; PG8_SCHED;
            PG8_LDB(B1, 0, 1); PG8_STAGE(PG8_SB(0, 0), b2, voffB);
            PG8_BAR; PG8_WAIT_L(0); PG8_MMA(0, 1, At, B1); PG8_BAR;
            PG8_LDA(At, 0, 1); PG8_STAGE(PG8_SA(0, 0), a2, voffA);
            PG8_BAR; PG8_WAIT_L(0); PG8_MMA(1, 0, At, B0); PG8_BAR; PG8_SCHED;
            PG8_STAGE(PG8_SB(0, 1), b2 + hstep, voffB);
            PG8_WAIT_V(6); PG8_BAR; PG8_MMA(1, 1, At, B1); PG8_BAR;
            PG8_LDB(B0, 1, 0); PG8_SCHED; PG8_LDA(At, 1, 0); PG8_STAGE(PG8_SA(0, 1), a2 + hstep, voffA);
            PG8_WAIT_L(8); PG8_BAR; PG8_WAIT_L(0); PG8_MMA(0, 0, At, B0); PG8_BAR; PG8_SCHED;
            PG8_LDB(B1, 1, 1); PG8_STAGE(PG8_SB(1, 0), b3, voffB);
            PG8_BAR; PG8_WAIT_L(0); PG8_MMA(0, 1, At, B1); PG8_BAR;
            PG8_LDA(At, 1, 1); PG8_STAGE(PG8_SA(1, 0), a3, voffA);
            PG8_BAR; PG8_WAIT_L(0); PG8_MMA(1, 0, At, B0); PG8_BAR; PG8_SCHED;
            PG8_STAGE(PG8_SB(1, 1), b3 + hstep, voffB);
            PG8_WAIT_V(6); PG8_BAR; PG8_MMA(1, 1, At, B1); PG8_BAR;
            }
        }
        if constexpr (ALIGN_EPI) { if (wr == 0) PG8_BAR; }
        if constexpr (!Epi::AFTER_DRAIN) { E(acc, cur, wr, wc, fr, fq); S.done(cur); }
        if (!has_next) break;
#pragma unroll
        for (int a = 0; a < 2; ++a)
#pragma unroll
            for (int b = 0; b < 2; ++b)
#pragma unroll
                for (int m = 0; m < 4; ++m)
#pragma unroll
                    for (int n = 0; n < 2; ++n) acc[a][b][m][n] = (f32x4){0.f, 0.f, 0.f, 0.f};
        cur = nxt; cA = nA; cB = nB; ++ui;
        if constexpr (ALIGN_EPI) { if (wr == 1) PG8_BAR; }
    }
    PG8_WAIT_V(0);
    if constexpr (!ALIGN_EPI) { if (wr == 0) PG8_BAR; }
    PG8_BAR;
    if constexpr (Epi::AFTER_DRAIN) { E.fused(acc, cur, wr, wc, fr, fq, lds, wid, lane); S.done(cur); }
#undef PG8_SA
#undef PG8_SB
#undef PG8_STAGE
#undef PG8_LDA
#undef PG8_LDB
#undef PG8_MMA
#undef PG8_WAIT_V
#undef PG8_WAIT_L
#undef PG8_BAR
#undef PG8_SCHED
}
}

constexpr int NWAVES = 8, NTHR = 512;
constexpr int BATCH = 2, SEQ = 8192, D = 1024, DEPTH = 4, MTOK = BATCH * SEQ;
constexpr int DIN = 3344, NPROJ = 3328, SRC_GA = 1152;
constexpr int C_GQ = 0, C_GK = 192, C_GV = 384, C_GG = 768, C_HQ = 1152, C_HF = 1408, C_HI = 1664, C_HG = 1920, C_RQ = 2176, C_RK = 2368, C_RV = 2560, C_RG = 2944;
constexpr int NE = 32, FFN = 1024;
constexpr int CH = 64, NCH = SEQ / CH, NUNIT = BATCH * NCH;
constexpr int ST_GLA = 0, ST_HG = 4 * 48 * 96, ST_RET = ST_HG + 4 * 64 * 64, ST_TOT = ST_RET + 4 * 48 * 96;
constexpr int NDV = 448;
constexpr int MAXROWS = 65536 + NE * 256, MAXRT = MAXROWS / 256;
constexpr float EPS = 1e-6f;
constexpr int NPHASE = 42;

constexpr size_t MiB = 1u << 20;
constexpr size_t WS_CTL = 0, CTL_ZERO_BYTES = 65536;
constexpr size_t WS_MOD = 1 * MiB;
constexpr size_t WS_ROPE = 2 * MiB;
constexpr size_t WS_LB = 5 * MiB;
constexpr size_t WS_WIN = 8 * MiB;
constexpr size_t WS_WOUT = 34 * MiB;
constexpr size_t WS_WGU = 42 * MiB;
constexpr size_t WS_WDN = 554 * MiB;
constexpr size_t WS_X = 810 * MiB;
constexpr size_t WS_H = 874 * MiB;
constexpr size_t WS_GA = 906 * MiB;
constexpr size_t WS_PROJ = 907 * MiB;
constexpr size_t WS_U = 1011 * MiB;
constexpr size_t WS_DVEC = 1063 * MiB;
constexpr size_t WS_SP = 1064 * MiB;
constexpr size_t WS_MIX = 1090 * MiB;
constexpr size_t WS_TOPE = 1122 * MiB;
constexpr size_t WS_TOPW = WS_TOPE + 256 * 1024;
constexpr size_t WS_SLOT = WS_TOPW + 256 * 1024;
constexpr size_t WS_A1 = 1123 * MiB;
constexpr size_t WS_ACT = 1267 * MiB;
constexpr size_t WS_Y = 1411 * MiB;
constexpr size_t WS_CUM = 1555 * MiB;
constexpr size_t WS_END = 1583 * MiB;
static_assert(WS_WIN + (size_t)DEPTH * NPROJ * D * 2 <= WS_WOUT && WS_PROJ + (size_t)MTOK * NPROJ * 2 <= WS_U && WS_U + (size_t)NUNIT * ST_TOT * 4 <= WS_DVEC && WS_SP + (size_t)NUNIT * ST_TOT * 2 <= WS_MIX && WS_A1 + (size_t)MAXROWS * D * 2 <= WS_ACT, "ws map");
constexpr int CW_TMO = 0, CW_CODE = 1, CW_BAR = 4096, CW_CNT = 8192, CW_FILL = 8192 + 256;
constexpr int RING_BYTES = 131072;
constexpr int MISC_OFF = 147456, LDS_BYTES = MISC_OFF + 4096;
constexpr int MW_BAR = 0, MW_CNT = 16, MW_PST = 48, MW_HIST = 96, MW_BASE = 128, MW_TILE = 192, MW_NRT = 480, MW_SLOTS = 512;

#define GAS __attribute__((address_space(1)))
#define LAS __attribute__((address_space(3)))
typedef unsigned v4u __attribute__((ext_vector_type(4)));
typedef float f32x4 __attribute__((ext_vector_type(4)));
typedef short bf16x8 __attribute__((ext_vector_type(8)));
typedef GAS unsigned gu32;
typedef GAS unsigned long long gu64;
#define RLX_AGENT __ATOMIC_RELAXED, __HIP_MEMORY_SCOPE_AGENT
#define LDS_WAIT() asm volatile("s_waitcnt lgkmcnt(0)" ::: "memory")
#define VM_WAIT() asm volatile("s_waitcnt vmcnt(0)" ::: "memory")
__device__ __forceinline__ unsigned long long rt() { return __builtin_amdgcn_s_memrealtime(); }
typedef unsigned short bf16;
__device__ __forceinline__ unsigned f2bf(float f) { unsigned u = __builtin_bit_cast(unsigned, f); return (u + 0x7fffu + ((u >> 16) & 1u)) >> 16; }
__device__ __forceinline__ unsigned pk2(float lo, float hi) { return f2bf(lo) | (f2bf(hi) << 16); }
__device__ __forceinline__ float bf2f(bf16 b) { return __builtin_bit_cast(float, (unsigned)b << 16); }
#define XB_TMO      128
#define XB_XCNT(j)  (256  + 64 * (j))
#define XB_XSUB(j)  (1280 + 64 * (j))
#define XB_XGEN(j)  (2304 + 64 * (j))
#define XB_TOP      3328
#define XB_TOPGEN   3392
#define XCD_BAR_WORDS 3456
#define XB_SPIN_CAP (1u << 18)

__device__ __forceinline__ unsigned xb_ld(unsigned* p)              { return __hip_atomic_load(p, __ATOMIC_RELAXED, __HIP_MEMORY_SCOPE_AGENT); }
__device__ __forceinline__ unsigned xb_add(unsigned* p, unsigned v) { return __hip_atomic_fetch_add(p, v, __ATOMIC_RELAXED, __HIP_MEMORY_SCOPE_AGENT); }
__device__ __forceinline__ unsigned xb_xcc_id() { return (unsigned)__builtin_amdgcn_s_getreg((3 << 11) | 20) & 0xFu; }
#define XB_SPIN(cond, bar) do { unsigned _sp = 0; while (cond) { __builtin_amdgcn_s_sleep(1); \
    if ((++_sp & 255u) == 0u) { if (xb_ld(&(bar)[XB_TMO])) break; if (_sp > XB_SPIN_CAP) { atomicAdd(&(bar)[XB_TMO], 1u); break; } } } } while (0)

struct XcdBarrier {
    unsigned* bar; unsigned x;
    volatile LAS unsigned* st;
};

__device__ __forceinline__ XcdBarrier xcd_barrier_post(unsigned* bar, volatile LAS unsigned* st) {
    XcdBarrier b; b.bar = bar; b.x = xb_xcc_id(); b.st = st;
    if (threadIdx.x == 0) (void)xb_add(&bar[XB_XCNT(b.x)], 1u);
    return b;
}
__device__ __forceinline__ void xcd_barrier_complete(unsigned* bar, unsigned x, unsigned& nloc, unsigned& nx) {
    const unsigned G = gridDim.x * gridDim.y * gridDim.z;
    unsigned sum, cnt, mine, sp = 0u;
    for (;;) {
        sum = 0u; cnt = 0u; mine = 0u;
#pragma unroll
        for (unsigned j = 0; j < 16; ++j) { const unsigned c = xb_ld(&bar[XB_XCNT(j)]); sum += c; cnt += (c > 0u) ? 1u : 0u; mine = (j == x) ? c : mine; }
        if (sum == G) break;
        __builtin_amdgcn_s_sleep(1);
        if ((++sp & 255u) == 0u) { if (xb_ld(&bar[XB_TMO])) break; if (sp > XB_SPIN_CAP) { atomicAdd(&bar[XB_TMO], 1u); break; } }
    }
    nloc = mine > 0u ? mine : 1u; nx = cnt > 0u ? cnt : 1u;
}

__device__ __forceinline__ void xcd_barrier(const XcdBarrier& b) {
    asm volatile("s_waitcnt vmcnt(0)" ::: "memory");
    __syncthreads();
    if (threadIdx.x == 0) {
        unsigned* bar = b.bar;
        __builtin_amdgcn_s_waitcnt(0);
        unsigned nloc = b.st[0], nx = b.st[1];
        if (nloc == 0u) { xcd_barrier_complete(bar, b.x, nloc, nx); b.st[0] = nloc; b.st[1] = nx; }
        const unsigned old = xb_add(&bar[XB_XSUB(b.x)], 1u);
        const unsigned gen = old / nloc;
        if (old + 1u == (gen + 1u) * nloc) {
            __builtin_amdgcn_fence(__ATOMIC_RELEASE, "agent");
            asm volatile("s_waitcnt vmcnt(0)" ::: "memory");
            const unsigned og = xb_add(&bar[XB_TOP], 1u);
            const unsigned tg = og / nx;
            if (og + 1u == (tg + 1u) * nx) xb_add(&bar[XB_TOPGEN], 1u);
            else XB_SPIN(xb_ld(&bar[XB_TOPGEN]) == tg, bar);
            __builtin_amdgcn_fence(__ATOMIC_ACQUIRE, "agent");
            xb_add(&bar[XB_XGEN(b.x)], 1u);
            asm volatile("s_waitcnt vmcnt(0)" ::: "memory");
        } else {
            XB_SPIN(xb_ld(&bar[XB_XGEN(b.x)]) == gen, bar);
            __builtin_amdgcn_fence(__ATOMIC_ACQUIRE, "agent");
            asm volatile("s_waitcnt vmcnt(0)" ::: "memory");
        }
    }
    __syncthreads();
}

__device__ __forceinline__ float wave_sum(float v) {
#pragma unroll
    for (int o = 1; o < 64; o <<= 1) v += __shfl_xor(v, o);
    return v;
}
__device__ __forceinline__ float log_sigmoid_f(float x) { return fminf(x, 0.f) - log1pf(expf(-fabsf(x))); }
__device__ __forceinline__ float silu_f(float x) { return x / (1.0f + expf(-x)); }
__device__ __forceinline__ float sigmoid_f(float x) { return 1.0f / (1.0f + expf(-x)); }
__device__ __forceinline__ pg8::bf16x8 ldfrag(const LAS bf16* base, int stride, int r0, int k0, int lane) {
    return *(const LAS pg8::bf16x8*)(base + (r0 + (lane & 15)) * stride + k0 + 8 * (lane >> 4));
}
__device__ __forceinline__ pg8::bf16x8 pack8(const float (&v)[8]) { v4u w; w.x = pk2(v[0], v[1]); w.y = pk2(v[2], v[3]); w.z = pk2(v[4], v[5]); w.w = pk2(v[6], v[7]); return __builtin_bit_cast(pg8::bf16x8, w); }

struct Args {
    const float* x; const float* c; const int* pos; const float* w_mod; const float* b_mod; const float* norm1_w; const float* w_in; const float* gla_wa2; const float* gla_ba2; const float* hg_lb;
    const float* gla_norm_w; const float* hg_norm_w; const float* w_out; const float* norm2_w; const float* w_r; const float* b_r; const float* w_gu; const float* b_gu; const float* w_dn; const float* b_dn;
    const float* final_norm_w; float* out; unsigned char* ws; int ph_lo, ph_hi;
};

__device__ __forceinline__ void transpose_block64(const float* src, int ld, bf16* dst, LAS float* scr, int lane) {
    const int r = lane >> 4, c4 = (lane & 15) * 4;
    f32x4 v[16];
#pragma unroll
    for (int i = 0; i < 16; ++i) v[i] = *(const f32x4*)(src + (size_t)(4 * i + r) * ld + c4);
#pragma unroll
    for (int i = 0; i < 16; ++i) { LAS float* w = scr + (4 * i + r) * 65 + c4; w[0] = v[i][0]; w[1] = v[i][1]; w[2] = v[i][2]; w[3] = v[i][3]; }
    LDS_WAIT(); asm volatile("" ::: "memory");
    const int kc = lane & 7;
#pragma unroll
    for (int jj = 0; jj < 8; ++jj) { const int n = (lane >> 3) + 8 * jj; const LAS float* s = scr + (8 * kc) * 65 + n;
        v4u o; o.x = pk2(s[0 * 65], s[1 * 65]); o.y = pk2(s[2 * 65], s[3 * 65]); o.z = pk2(s[4 * 65], s[5 * 65]); o.w = pk2(s[6 * 65], s[7 * 65]);
        *(GAS v4u*)(dst + (size_t)n * D + 8 * kc) = o; }
    LDS_WAIT(); asm volatile("" ::: "memory");
}
constexpr int IT_IN = 16 * (NPROJ / 64), IT_OUT = 16 * 16, IT_GU = NE * 16 * 32, IT_DN = NE * 16 * 16, IT_LAYER = IT_IN + IT_OUT + IT_GU + IT_DN, IT_ALL = DEPTH * IT_LAYER;
__device__ __forceinline__ void p0_prologue(const Args& a, LAS unsigned char* lds, int vcu, int G, int tid, int lane, int wave) {
    unsigned char* ws = a.ws;
    bf16* WIN = (bf16*)(ws + WS_WIN); bf16* WOUT = (bf16*)(ws + WS_WOUT); bf16* WGU = (bf16*)(ws + WS_WGU); bf16* WDN = (bf16*)(ws + WS_WDN);
    LAS float* scr = (LAS float*)(lds + wave * 16640);
    const int gw = vcu * NWAVES + wave, NGW = G * NWAVES;
    for (int it = gw; it < IT_ALL; it += NGW) {
        const int l = it / IT_LAYER; int r = it - l * IT_LAYER;
        if (r < IT_IN) { const int kb = r / (NPROJ / 64), nb = r % (NPROJ / 64), n0 = 64 * nb, sc = n0 + (n0 >= SRC_GA ? 16 : 0);
            transpose_block64(a.w_in + ((size_t)l * D + 64 * kb) * DIN + sc, DIN, WIN + ((size_t)l * NPROJ + n0) * D + 64 * kb, scr, lane); continue; }
        r -= IT_IN;
        if (r < IT_OUT) { const int kb = r / 16, nb = r % 16;
            transpose_block64(a.w_out + ((size_t)l * D + 64 * kb) * D + 64 * nb, D, WOUT + ((size_t)l * D + 64 * nb) * D + 64 * kb, scr, lane); continue; }
        r -= IT_OUT;
        if (r < IT_GU) { const int e = r / 512, r2 = r % 512, kb = r2 / 32, nb = r2 % 32, cc = 64 * nb;
            const int row = (cc < 1024) ? 256 * (cc / 128) + (cc % 128) : 256 * ((cc - 1024) / 128) + 128 + ((cc - 1024) % 128);
            transpose_block64(a.w_gu + (((size_t)l * NE + e) * D + 64 * kb) * 2048 + cc, 2048, WGU + (((size_t)l * NE + e) * 2048 + row) * D + 64 * kb, scr, lane); continue; }
        r -= IT_GU;
        { const int e = r / 256, r2 = r % 256, kb = r2 / 16, nb = r2 % 16;
            transpose_block64(a.w_dn + (((size_t)l * NE + e) * FFN + 64 * kb) * D + 64 * nb, D, WDN + (((size_t)l * NE + e) * D + 64 * nb) * D + 64 * kb, scr, lane); }
    }
    __syncthreads();
    {
        LAS float* cact = (LAS float*)lds;
        LAS float* red = (LAS float*)(lds + 8192);
        for (int i = tid; i < 2 * D; i += NTHR) cact[i] = silu_f(a.c[i]);
        __syncthreads();
        float* MOD = (float*)(ws + WS_MOD);
        for (int it = vcu; it < DEPTH * 96; it += G) {
            const int l = it / 96, n0 = (it % 96) * 64;
            const float* wp = a.w_mod + ((size_t)l * D + 128 * wave) * 6144 + n0 + lane;
            float a0 = 0.f, a1 = 0.f;
#pragma unroll 8
            for (int k = 0; k < 128; ++k) { const float w = wp[(size_t)k * 6144]; a0 += cact[128 * wave + k] * w; a1 += cact[D + 128 * wave + k] * w; }
            red[(wave * 2 + 0) * 64 + lane] = a0; red[(wave * 2 + 1) * 64 + lane] = a1;
            __syncthreads();
            if (tid < 128) { const int b = tid >> 6, ln = tid & 63; float s = a.b_mod[l * 6144 + n0 + ln];
#pragma unroll
                for (int w = 0; w < 8; ++w) s += red[(w * 2 + b) * 64 + ln];
                MOD[((size_t)l * 2 + b) * 6144 + n0 + ln] = s; }
            __syncthreads();
        }
    }
    {
        float* ROPE = (float*)(ws + WS_ROPE);
        for (int i = vcu * NTHR + tid; i < MTOK * 24; i += G * NTHR) { const int t = i / 24, f = i % 24;
            const float inv = (float)pow(10000.0, -(double)f / 24.0); const float ang = (float)a.pos[t] * inv;
            ROPE[(size_t)t * 48 + f] = cosf(ang); ROPE[(size_t)t * 48 + 24 + f] = sinf(ang); }
    }
    if (vcu == 0 && tid < 256) {
        float v[4], mx = -3.0e38f; for (int l = 0; l < 4; ++l) { v[l] = a.hg_lb[l * 256 + tid]; mx = fmaxf(mx, v[l]); }
        float s = 0.f; for (int l = 0; l < 4; ++l) { v[l] = expf(v[l] - mx); s += v[l]; }
        float* LB = (float*)(ws + WS_LB); float cs = 0.f, first = 0.f;
        for (int l = 0; l < 4; ++l) { cs += v[l] / s; if (l == 0) first = cs; LB[l * 256 + tid] = cs - first; }
    }
}

__device__ __forceinline__ void moe_combine_row(f32x4 (&v)[4], int m, const bf16* Y, const int* SLOT, const float* TOPW, const float* g2, int lane) {
    const int4 sl = *(const int4*)(SLOT + (size_t)m * 4); const f32x4 tw = *(const f32x4*)(TOPW + (size_t)m * 4);
    const int s[4] = {sl.x, sl.y, sl.z, sl.w};
    f32x4 acc[4];
#pragma unroll
    for (int j = 0; j < 4; ++j) acc[j] = (f32x4){0.f, 0.f, 0.f, 0.f};
#pragma unroll
    for (int k = 0; k < 4; ++k) { const bf16* yr = Y + (size_t)s[k] * D + 4 * lane; const float w = tw[k];
#pragma unroll
        for (int j = 0; j < 4; ++j) { const uint2 p = *(const uint2*)(yr + 256 * j);
            acc[j][0] += w * __builtin_bit_cast(float, p.x << 16); acc[j][1] += w * __builtin_bit_cast(float, p.x & 0xffff0000u);
            acc[j][2] += w * __builtin_bit_cast(float, p.y << 16); acc[j][3] += w * __builtin_bit_cast(float, p.y & 0xffff0000u); } }
#pragma unroll
    for (int j = 0; j < 4; ++j) { const f32x4 g = *(const f32x4*)(g2 + 4 * lane + 256 * j); v[j] = v[j] + g * acc[j]; }
}
__device__ __forceinline__ float row_rstd(const f32x4 (&v)[4]) {
    float s = 0.f;
#pragma unroll
    for (int j = 0; j < 4; ++j) s += (v[j][0] * v[j][0] + v[j][1] * v[j][1]) + (v[j][2] * v[j][2] + v[j][3] * v[j][3]);
    return 1.0f / sqrtf(wave_sum(s) * (1.0f / D) + EPS);
}
__device__ __forceinline__ void modulate_row(f32x4 (&v)[4], float rstd, const float* nw, const float* sc, const float* sh, bf16* hrow, int lane) {
#pragma unroll
    for (int j = 0; j < 4; ++j) { const int c0 = 4 * lane + 256 * j; const f32x4 w = *(const f32x4*)(nw + c0), s1 = *(const f32x4*)(sc + c0), s0 = *(const f32x4*)(sh + c0);
        v[j] = v[j] * rstd * w * (s1 + 1.0f) + s0;
        uint2 p; p.x = pk2(v[j][0], v[j][1]); p.y = pk2(v[j][2], v[j][3]); *(uint2*)(hrow + c0) = p; }
}


constexpr int LR_SLT = 142976, LR_TWL = 144000, LR_SSR = 145024;
__device__ __forceinline__ void stage_slots(const unsigned char* ws, int row0, LAS unsigned char* lds, int tid) {
    if (tid < 64) { *(LAS v4u*)(lds + LR_SLT + 16 * tid) = *(const v4u*)((const int*)(ws + WS_SLOT) + (size_t)(row0 + tid) * 4);
                    *(LAS f32x4*)(lds + LR_TWL + 16 * tid) = *(const f32x4*)((const float*)(ws + WS_TOPW) + (size_t)(row0 + tid) * 4); }
}
template <bool SS>
__device__ __forceinline__ void flat_combine(const float* xsrc, float* xdst, int row0, const bf16* Y, const float* g2, LAS unsigned char* lds, int tid, int lane) {
    const int c4 = tid & 255, rsub = tid >> 8; const f32x4 g = *(const f32x4*)(g2 + 4 * c4);
#pragma unroll 4
    for (int it = 0; it < 32; ++it) { const int i = 2 * it + rsub; const size_t m = (size_t)(row0 + i);
        f32x4 v = *(const f32x4*)(xsrc + m * D + 4 * c4);
        const v4u sl = *(const LAS v4u*)(lds + LR_SLT + 16 * i); const f32x4 tw = *(const LAS f32x4*)(lds + LR_TWL + 16 * i);
        const uint2 p0 = *(const uint2*)(Y + (size_t)sl.x * D + 4 * c4), p1 = *(const uint2*)(Y + (size_t)sl.y * D + 4 * c4), p2 = *(const uint2*)(Y + (size_t)sl.z * D + 4 * c4), p3 = *(const uint2*)(Y + (size_t)sl.w * D + 4 * c4);
        f32x4 acc;
        acc[0] = tw[0] * __builtin_bit_cast(float, p0.x << 16) + tw[1] * __builtin_bit_cast(float, p1.x << 16) + tw[2] * __builtin_bit_cast(float, p2.x << 16) + tw[3] * __builtin_bit_cast(float, p3.x << 16);
        acc[1] = tw[0] * __builtin_bit_cast(float, p0.x & 0xffff0000u) + tw[1] * __builtin_bit_cast(float, p1.x & 0xffff0000u) + tw[2] * __builtin_bit_cast(float, p2.x & 0xffff0000u) + tw[3] * __builtin_bit_cast(float, p3.x & 0xffff0000u);
        acc[2] = tw[0] * __builtin_bit_cast(float, p0.y << 16) + tw[1] * __builtin_bit_cast(float, p1.y << 16) + tw[2] * __builtin_bit_cast(float, p2.y << 16) + tw[3] * __builtin_bit_cast(float, p3.y << 16);
        acc[3] = tw[0] * __builtin_bit_cast(float, p0.y & 0xffff0000u) + tw[1] * __builtin_bit_cast(float, p1.y & 0xffff0000u) + tw[2] * __builtin_bit_cast(float, p2.y & 0xffff0000u) + tw[3] * __builtin_bit_cast(float, p3.y & 0xffff0000u);
        v = v + g * acc;
        *(f32x4*)(xdst + m * D + 4 * c4) = v;
        if (SS) { const float sq = wave_sum((v[0] * v[0] + v[1] * v[1]) + (v[2] * v[2] + v[3] * v[3])); if (lane == 0) __hip_atomic_fetch_add((LAS float*)(lds + LR_SSR) + i, sq, __ATOMIC_RELAXED, __HIP_MEMORY_SCOPE_WORKGROUP); } }
}
__device__ __forceinline__ void flat_modulate(const float* xin, int row0, const LAS float* rstds, const float* nw, const float* scp, const float* shp, bf16* H, int tid) {
    const int c4 = tid & 255, rsub = tid >> 8; const f32x4 w = *(const f32x4*)(nw + 4 * c4), s1 = *(const f32x4*)(scp + 4 * c4), s0 = *(const f32x4*)(shp + 4 * c4); const f32x4 ws1 = w * (s1 + 1.0f);
#pragma unroll 8
    for (int it = 0; it < 32; ++it) { const int i = 2 * it + rsub; const size_t m = (size_t)(row0 + i); const f32x4 v = *(const f32x4*)(xin + m * D + 4 * c4) * rstds[i] * ws1 + s0;
        uint2 p; p.x = pk2(v[0], v[1]); p.y = pk2(v[2], v[3]); *(uint2*)(H + m * D + 4 * c4) = p; }
}

constexpr int WP = 1032;
constexpr int LR_WHI = 0, LR_PART = 132096, LR_SSX = 140288, LR_RSTD = 140544, LR_BIAS = 140800, LR_RED = 140928;
template <int NEO>
__device__ __forceinline__ void rows_mfma(const Args& a, int layer, LAS unsigned char* lds, volatile LAS unsigned* MISC, gu32* ctl, int vcu, int G, int tid, int lane, int wave) {
    constexpr bool P5 = (NEO == 32); constexpr int NET = NEO / 16;
    unsigned char* ws = a.ws; float* X = (float*)(ws + WS_X); bf16* H = (bf16*)(ws + WS_H); const float* MOD = (const float*)(ws + WS_MOD);
    LAS bf16* Whi = (LAS bf16*)(lds + LR_WHI); LAS bf16* Wlo = Whi + NEO * WP; LAS float* part = (LAS float*)(lds + LR_PART); LAS float* ssx = (LAS float*)(lds + LR_SSX);
    LAS float* rstds = (LAS float*)(lds + LR_RSTD); LAS float* biasl = (LAS float*)(lds + LR_BIAS); LAS float* red = (LAS float*)(lds + LR_RED);
    const float* nw = (P5 ? a.norm2_w : a.norm1_w) + layer * D;
    const float* Wsrc = P5 ? a.w_r + (size_t)layer * D * NE : a.w_in + (size_t)layer * D * DIN + SRC_GA; const int wld = P5 ? NE : DIN;
    if (P5) { if (tid < NE) MISC[MW_HIST + tid] = 0u; }
    for (int row0 = vcu * 64; row0 < MTOK; row0 += G * 64) {
        const int b = row0 / SEQ; const float* mp = MOD + ((size_t)layer * 2 + b) * 6144; const float* scp = mp + (P5 ? 4 : 1) * D; const float* shp = mp + (P5 ? 3 : 0) * D;
        if (!P5 && layer > 0) { stage_slots(ws, row0, lds, tid); __syncthreads(); }
        { const int e = tid % NEO, kq = tid / NEO; constexpr int NPT = NTHR / NEO;
#pragma unroll 1
            for (int it0 = 0; it0 < D / NPT; it0 += 8) { float wv[8];
#pragma unroll
                for (int u = 0; u < 8; ++u) { const int k = kq + NPT * (it0 + u); wv[u] = Wsrc[(size_t)k * wld + e] * (nw[k] * (1.0f + scp[k])); }
#pragma unroll
                for (int u = 0; u < 8; ++u) { const int k = kq + NPT * (it0 + u); const unsigned hi = f2bf(wv[u]); const float wl = wv[u] - __builtin_bit_cast(float, hi << 16); Whi[e * WP + k] = (bf16)hi; Wlo[e * WP + k] = (bf16)f2bf(wl); } }
            constexpr int KP = D / NPT; float sacc = 0.f;
#pragma unroll 8
            for (int k = kq * KP; k < kq * KP + KP; ++k) sacc += shp[k] * Wsrc[(size_t)k * wld + e];
            red[kq * NEO + e] = sacc; }
        const float* xin = X;
        if (!P5) { if (layer == 0) xin = a.x;
            else { flat_combine<false>(X, X, row0, (const bf16*)(ws + WS_Y), MOD + ((size_t)(layer - 1) * 2 + b) * 6144 + 5 * D, lds, tid, lane); asm volatile("s_waitcnt vmcnt(0)" ::: "memory"); } }
        __syncthreads();
        if (tid < NEO) { constexpr int NPT = NTHR / NEO; float sacc = P5 ? a.b_r[layer * NE + tid] : 0.f; for (int q = 0; q < NPT; ++q) sacc += red[q * NEO + tid]; biasl[tid] = sacc; }
        const int rg = wave >> 1, kh = wave & 1, r = lane & 15, g = lane >> 4;
        { const float* xr = xin + (size_t)(row0 + 16 * rg + r) * D; f32x4 acc[NET]; float ss = 0.f;
#pragma unroll
            for (int et = 0; et < NET; ++et) acc[et] = (f32x4){0.f, 0.f, 0.f, 0.f};
#pragma unroll 4
            for (int s = 16 * kh; s < 16 * kh + 16; ++s) { const int k0 = 32 * s + 8 * g; const f32x4 x0 = *(const f32x4*)(xr + k0), x1 = *(const f32x4*)(xr + k0 + 4);
                ss += (x0[0] * x0[0] + x0[1] * x0[1]) + (x0[2] * x0[2] + x0[3] * x0[3]) + (x1[0] * x1[0] + x1[1] * x1[1]) + (x1[2] * x1[2] + x1[3] * x1[3]);
                float xv[8] = {x0[0], x0[1], x0[2], x0[3], x1[0], x1[1], x1[2], x1[3]}, xl[8];
#pragma unroll
                for (int j = 0; j < 8; ++j) xl[j] = xv[j] - __builtin_bit_cast(float, f2bf(xv[j]) << 16);
                const pg8::bf16x8 ahi = pack8(xv), alo = pack8(xl);
#pragma unroll
                for (int et = 0; et < NET; ++et) { const pg8::bf16x8 whi = ldfrag(Whi, WP, 16 * et, 32 * s, lane), wlo = ldfrag(Wlo, WP, 16 * et, 32 * s, lane);
                    acc[et] = __builtin_amdgcn_mfma_f32_16x16x32_bf16(ahi, whi, acc[et], 0, 0, 0); acc[et] = __builtin_amdgcn_mfma_f32_16x16x32_bf16(alo, whi, acc[et], 0, 0, 0);
                    acc[et] = __builtin_amdgcn_mfma_f32_16x16x32_bf16(ahi, wlo, acc[et], 0, 0, 0); } }
            ss += __shfl_xor(ss, 16); ss += __shfl_xor(ss, 32);
            if (kh == 1) {
#pragma unroll
                for (int et = 0; et < NET; ++et)
#pragma unroll
                    for (int q = 0; q < 4; ++q) part[(rg * 16 + 4 * g + q) * 32 + 16 * et + r] = acc[et][q];
                if (g == 0) ssx[rg * 16 + r] = ss; }
            __syncthreads();
            if (kh == 0) { const float sst = ss + ssx[rg * 16 + r]; if (g == 0) rstds[rg * 16 + r] = 1.0f / sqrtf(sst * (1.0f / D) + EPS);
                asm volatile("s_waitcnt lgkmcnt(0)" ::: "memory");
#pragma unroll
                for (int et = 0; et < NET; ++et)
#pragma unroll
                    for (int q = 0; q < 4; ++q) { const int i = rg * 16 + 4 * g + q, e = 16 * et + r; const float v = rstds[i] * (acc[et][q] + part[i * 32 + e]) + biasl[e];
                        if (P5) part[i * 32 + e] = v; else ((float*)(ws + WS_GA))[(size_t)(row0 + i) * 16 + e] = v; }
                if (P5) { asm volatile("s_waitcnt lgkmcnt(0)" ::: "memory");
                    if (lane < 16) { const int i = rg * 16 + lane, m = row0 + i; float lv[NE];
#pragma unroll
                        for (int e = 0; e < NE; ++e) lv[e] = part[i * 32 + e];
                        float tv[4]; int te[4];
#pragma unroll
                        for (int t = 0; t < 4; ++t) { float best = -3.0e38f; int bi = 0;
#pragma unroll
                            for (int e = 0; e < NE; ++e) if (lv[e] > best) { best = lv[e]; bi = e; }
#pragma unroll
                            for (int e = 0; e < NE; ++e) if (e == bi) lv[e] = -3.0e38f;
                            tv[t] = best; te[t] = bi; }
                        const float e1 = expf(tv[1] - tv[0]), e2 = expf(tv[2] - tv[0]), e3 = expf(tv[3] - tv[0]); const float inv = 1.0f / (1.0f + e1 + e2 + e3);
                        *(int4*)((int*)(ws + WS_TOPE) + (size_t)m * 4) = make_int4(te[0], te[1], te[2], te[3]); *(f32x4*)((float*)(ws + WS_TOPW) + (size_t)m * 4) = (f32x4){inv, e1 * inv, e2 * inv, e3 * inv};
#pragma unroll
                        for (int t = 0; t < 4; ++t) __hip_atomic_fetch_add((LAS unsigned*)&MISC[MW_HIST + te[t]], 1u, __ATOMIC_RELAXED, __HIP_MEMORY_SCOPE_WORKGROUP); } } }
            __syncthreads(); }
        flat_modulate(xin, row0, rstds, nw, scp, shp, H, tid);
        __syncthreads();
    }
    if (P5) { if (tid < NE) { const unsigned hcnt = MISC[MW_HIST + tid]; if (hcnt) atomicAdd((unsigned*)(ctl + CW_CNT + layer * NE + tid), hcnt); } }
}

__device__ __forceinline__ void final_rows(const Args& a, LAS unsigned char* lds, int vcu, int G, int tid, int lane) {
    unsigned char* ws = a.ws; const float* X = (const float*)(ws + WS_X); const float* MOD = (const float*)(ws + WS_MOD); LAS float* ssr = (LAS float*)(lds + LR_SSR);
    for (int row0 = vcu * 64; row0 < MTOK; row0 += G * 64) { const int b = row0 / SEQ;
        stage_slots(ws, row0, lds, tid); if (tid < 64) ssr[tid] = 0.f;
        __syncthreads();
        flat_combine<true>(X, a.out, row0, (const bf16*)(ws + WS_Y), MOD + ((size_t)(DEPTH - 1) * 2 + b) * 6144 + 5 * D, lds, tid, lane);
        asm volatile("s_waitcnt vmcnt(0)" ::: "memory");
        __syncthreads();
        { const int c4 = tid & 255, rsub = tid >> 8; const f32x4 w = *(const f32x4*)(a.final_norm_w + 4 * c4);
#pragma unroll 8
            for (int it = 0; it < 32; ++it) { const int i = 2 * it + rsub; float* op = a.out + (size_t)(row0 + i) * D + 4 * c4; const float rstd = 1.0f / sqrtf(ssr[i] * (1.0f / D) + EPS); *(f32x4*)op = *(const f32x4*)op * rstd * w; } }
        __syncthreads();
    }
}

__device__ __noinline__ void moe_tables(gu32* ctl, int layer, volatile LAS unsigned* MISC, int tid) {
    if (tid < NE) MISC[MW_CNT + tid] = __hip_atomic_load(ctl + CW_CNT + layer * NE + tid, RLX_AGENT);
    __syncthreads();
    if (tid == 0) { unsigned p = 0;
        for (int e = 0; e < NE; ++e) { MISC[MW_PST + e] = p; const unsigned nt = (MISC[MW_CNT + e] + 255u) >> 8; for (unsigned t = 0; t < nt; ++t) MISC[MW_TILE + (p >> 8) + t] = (unsigned)e; p += nt << 8; }
        MISC[MW_PST + NE] = p; MISC[MW_NRT] = p >> 8; }
    __syncthreads();
}
__device__ __forceinline__ void p6_dispatch(const Args& a, int layer, volatile LAS unsigned* MISC, gu32* ctl, int vcu, int G, int tid, int lane, int wave) {
    unsigned char* ws = a.ws; const int* TOPE = (const int*)(ws + WS_TOPE); int* SLOT = (int*)(ws + WS_SLOT); const bf16* H = (const bf16*)(ws + WS_H); bf16* A1 = (bf16*)(ws + WS_A1);
    moe_tables(ctl, layer, MISC, tid);
    for (int t0 = vcu * 64; t0 < MTOK; t0 += G * 64) {
        if (tid < NE) MISC[MW_HIST + tid] = 0u;
        __syncthreads();
        int e = 0; unsigned r = 0;
        if (tid < 256) { e = TOPE[(size_t)t0 * 4 + tid]; r = __hip_atomic_fetch_add((LAS unsigned*)&MISC[MW_HIST + e], 1u, __ATOMIC_RELAXED, __HIP_MEMORY_SCOPE_WORKGROUP); }
        __syncthreads();
        if (tid < NE) { const unsigned h = MISC[MW_HIST + tid]; MISC[MW_BASE + tid] = h ? atomicAdd((unsigned*)(ctl + CW_FILL + layer * NE + tid), h) : 0u; }
        __syncthreads();
        if (tid < 256) { const int slot = (int)(MISC[MW_PST + e] + MISC[MW_BASE + e] + r); SLOT[(size_t)t0 * 4 + tid] = slot; MISC[MW_SLOTS + tid] = (unsigned)slot; }
        __syncthreads();
        for (int i = wave * 32; i < wave * 32 + 32; ++i) { const int slot = (int)MISC[MW_SLOTS + i]; const int t = t0 + (i >> 2);
            const v4u* src = (const v4u*)(H + (size_t)t * D); v4u* dst = (v4u*)(A1 + (size_t)slot * D);
            dst[lane] = src[lane]; dst[lane + 64] = src[lane + 64]; }
        __syncthreads();
    }
}

constexpr int BP = 72;
template <int TYPE> struct MixCfg { static constexpr int DK = (TYPE == 1) ? 64 : 48, DV = (TYPE == 1) ? 64 : 96, NC = 4 * DK, NV = 4 * DV;
    static constexpr int STOFF = (TYPE == 0) ? ST_GLA : (TYPE == 1) ? ST_HG : ST_RET, COFF = (TYPE == 0) ? 0 : 192;
    static constexpr int CQ = (TYPE == 0) ? C_GQ : (TYPE == 1) ? C_HQ : C_RQ, CK = (TYPE == 0) ? C_GK : (TYPE == 1) ? C_HF : C_RK, CV = (TYPE == 0) ? C_GV : (TYPE == 1) ? C_HI : C_RV, CG = (TYPE == 0) ? C_GG : (TYPE == 1) ? C_HG : C_RG;
    static constexpr int MIXOFF = (TYPE == 0) ? 0 : (TYPE == 1) ? 384 : 640; };
__device__ __forceinline__ float fast_logsig(float x) { x = fmaxf(x, -80.f); return -__logf(1.0f + __expf(-x)); }
__device__ __forceinline__ float ret_lg(int h) { return logf(1.0f - exp2f(-5.0f - (float)h)); }

template <int NV>
__device__ __forceinline__ void stage_vt(const bf16* pv  , LAS bf16* VT, int tid) {
    for (int idx = tid; idx < 2 * NV; idx += NTHR) { const int e = idx % NV, hf = idx / NV; const bf16* p = pv + (size_t)(32 * hf) * NPROJ + e;
#pragma unroll
        for (int q = 0; q < 4; ++q) { unsigned short b[8];
#pragma unroll
            for (int j = 0; j < 8; ++j) b[j] = p[(size_t)(8 * q + j) * NPROJ];
            v4u w; w.x = b[0] | ((unsigned)b[1] << 16); w.y = b[2] | ((unsigned)b[3] << 16); w.z = b[4] | ((unsigned)b[5] << 16); w.w = b[6] | ((unsigned)b[7] << 16);
            *(LAS v4u*)(VT + e * BP + 32 * hf + 8 * q) = w; } }
}

constexpr int LA_KT = 0, LA_VT = 36864, LA_TOT = 92160, LA_GA = 94208;
template <int TYPE>
__device__ __forceinline__ void mixa_batch(const Args& a, int layer, int unit, LAS unsigned char* lds, int tid, int lane, int wave) {
    typedef MixCfg<TYPE> C; constexpr int DK = C::DK, DV = C::DV, NC = C::NC, NV = C::NV;
    unsigned char* ws = a.ws; const bf16* PROJ = (const bf16*)(ws + WS_PROJ); float* CUM = (float*)(ws + WS_CUM); float* DVEC = (float*)(ws + WS_DVEC) + (size_t)unit * NDV;
    float* U = (float*)(ws + WS_U) + (size_t)unit * ST_TOT + C::STOFF;
    LAS bf16* KT = (LAS bf16*)(lds + LA_KT); LAS bf16* VT = (LAS bf16*)(lds + LA_VT); LAS float* TOT = (LAS float*)(lds + LA_TOT); const LAS float* GAs = (const LAS float*)(lds + LA_GA);
    const int row0 = unit * CH;
    const bool act = tid < 2 * NC; const int c = act ? tid % NC : 0, half = act ? tid / NC : 0, h = c / DK, d = c - h * DK;
    float cum[32]; float tot = 0.f;
    float w2[16], b2 = 0.f, lbv = 0.f, lg = 0.f, sg = 0.f; int f = 0, d2 = 0;
    if (act) {
        if constexpr (TYPE == 0) { b2 = a.gla_ba2[layer * 192 + c];
#pragma unroll
            for (int r = 0; r < 16; ++r) w2[r] = a.gla_wa2[(layer * 16 + r) * 192 + c]; }
        if constexpr (TYPE == 1) lbv = ((const float*)(ws + WS_LB))[layer * 256 + c];
        if constexpr (TYPE == 2) { lg = ret_lg(h); f = (d < 24) ? d : d - 24; d2 = (d < 24) ? d + 24 : d - 24; sg = (d < 24) ? -1.f : 1.f; }
#pragma unroll
        for (int i = 0; i < 32; ++i) { const int t = 32 * half + i; const bf16* pr = PROJ + (size_t)(row0 + t) * NPROJ; float g;
            if constexpr (TYPE == 0) { float pre = b2;
#pragma unroll
                for (int r = 0; r < 16; ++r) pre += GAs[t * 16 + r] * w2[r];
                g = fast_logsig(pre) * (1.0f / 16.0f); }
            else if constexpr (TYPE == 1) { const float hf = fminf(fmaxf(bf2f(pr[C_HF + c]), -80.f), 80.f); const float sgm = 1.0f / (1.0f + __expf(-hf));
                g = __logf(lbv + (1.0f - lbv) * sgm); }
            else g = lg;
            tot += g; cum[i] = tot;
            if ((i & 7) == 7) asm volatile("" ::: "memory"); }
        TOT[c * 2 + half] = tot;
    }
    stage_vt<NV>(PROJ + (size_t)row0 * NPROJ + C::CV, VT, tid);
    __syncthreads();
    if (act) { const float t0 = TOT[c * 2], t1 = TOT[c * 2 + 1]; const float off = half ? t0 : 0.f, last = t0 + t1;
#pragma unroll
        for (int q = 0; q < 4; ++q) { float kt[8];
#pragma unroll
            for (int j = 0; j < 8; ++j) { const int i = 8 * q + j; const float cm = cum[i] + off; const size_t row = (size_t)(row0 + 32 * half + i); const bf16* pr = PROJ + row * NPROJ; float k;
                if constexpr (TYPE == 0) k = bf2f(pr[C_GK + c]);
                else if constexpr (TYPE == 1) k = 1.0f - __expf(cum[i] - (i > 0 ? cum[i - 1] : 0.f));
                else { const float* rp = (const float*)(ws + WS_ROPE) + row * 48; k = bf2f(pr[C_RK + h * 48 + d]) * rp[f] + sg * bf2f(pr[C_RK + h * 48 + d2]) * rp[24 + f]; }
                if constexpr (TYPE != 2) CUM[row * NDV + C::COFF + c] = cm;
                kt[j] = k * __expf(last - cm); }
            v4u w; w.x = pk2(kt[0], kt[1]); w.y = pk2(kt[2], kt[3]); w.z = pk2(kt[4], kt[5]); w.w = pk2(kt[6], kt[7]);
            *(LAS v4u*)(KT + c * BP + 32 * half + 8 * q) = w;
            asm volatile("" ::: "memory"); }
        if (TYPE != 2 && half == 0) DVEC[C::COFF + c] = __expf(last);
    }
    __syncthreads();
    constexpr int TD = DK / 16, NT = (DV / 16) * TD;
    for (int ti = wave; ti < 4 * NT; ti += NWAVES) { const int hh = ti / NT, tr = ti - hh * NT, te = tr / TD, td = tr - te * TD; f32x4 acc = {0.f, 0.f, 0.f, 0.f};
#pragma unroll
        for (int kk = 0; kk < 2; ++kk) acc = __builtin_amdgcn_mfma_f32_16x16x32_bf16(ldfrag(VT, BP, hh * DV + te * 16, kk * 32, lane), ldfrag(KT, BP, hh * DK + td * 16, kk * 32, lane), acc, 0, 0, 0);
        float* Uh = U + hh * DK * DV;
#pragma unroll
        for (int r = 0; r < 4; ++r) Uh[(te * 16 + (lane >> 4) * 4 + r) * DK + td * 16 + (lane & 15)] = acc[r]; }
    __syncthreads();
}
__device__ __forceinline__ void p3a_summaries(const Args& a, int layer, LAS unsigned char* lds, int vcu, int G, int tid, int lane, int wave) {
    for (int unit = vcu; unit < NUNIT; unit += G) {
        { LAS float* GAs = (LAS float*)(lds + LA_GA); const float* GA = (const float*)(a.ws + WS_GA); for (int i = tid; i < CH * 16; i += NTHR) GAs[i] = GA[(size_t)unit * CH * 16 + i]; }
        __syncthreads();
        mixa_batch<0>(a, layer, unit, lds, tid, lane, wave);
        mixa_batch<1>(a, layer, unit, lds, tid, lane, wave);
        mixa_batch<2>(a, layer, unit, lds, tid, lane, wave);
    }
}

__device__ __forceinline__ void p3b_scan(const Args& a, int vcu, int G, int tid) {
    unsigned char* ws = a.ws; const float* U = (const float*)(ws + WS_U); const float* DVEC = (const float*)(ws + WS_DVEC); bf16* SP = (bf16*)(ws + WS_SP);
    for (int gid = vcu * NTHR + tid; gid < BATCH * ST_TOT; gid += G * NTHR) {
        const int b = gid / ST_TOT, el = gid - b * ST_TOT;
        int di = -1; float cdec = 0.f;
        if (el < ST_HG) { const int h = el / 4608, d = (el - h * 4608) % 48; di = h * 48 + d; }
        else if (el < ST_RET) { const int r = el - ST_HG, h = r / 4096, d = r % 64; di = 192 + h * 64 + d; }
        else { const int h = (el - ST_RET) / 4608; cdec = expf(64.0f * logf(1.0f - exp2f(-5.0f - (float)h))); }
        const float* up = U + (size_t)b * NCH * ST_TOT + el; const float* dp = DVEC + (size_t)b * NCH * NDV + (di < 0 ? 0 : di); bf16* sp = SP + (size_t)b * NCH * ST_TOT + el;
        float s = 0.f;
        for (int n0 = 0; n0 < NCH; n0 += 8) { float u[8], dc[8];
#pragma unroll
            for (int i = 0; i < 8; ++i) { u[i] = up[(size_t)(n0 + i) * ST_TOT]; dc[i] = (di < 0) ? cdec : dp[(size_t)(n0 + i) * NDV]; }
#pragma unroll
            for (int i = 0; i < 8; ++i) { sp[(size_t)(n0 + i) * ST_TOT] = (bf16)f2bf(s); s = dc[i] * s + u[i]; } }
    }
}

constexpr int LC_VT = 0, LC_ST = 55296, LC_AB = 110592;
template <int TYPE, bool ISQ>
__device__ __forceinline__ void mix_frag(const Args& a, int h, size_t row, int t, int d0, float (&x)[8], float (&cm)[8]) {
    typedef MixCfg<TYPE> C; constexpr int DK = C::DK;
    unsigned char* ws = a.ws; const bf16* pr = (const bf16*)(ws + WS_PROJ) + row * NPROJ;
    if constexpr (TYPE == 0) {
        const v4u p = *(const v4u*)(pr + (ISQ ? C_GQ : C_GK) + h * DK + d0); const unsigned pw[4] = {p.x, p.y, p.z, p.w};
        const float* cp = (const float*)(ws + WS_CUM) + row * NDV + h * DK + d0; const f32x4 c0 = *(const f32x4*)cp, c1 = *(const f32x4*)(cp + 4);
#pragma unroll
        for (int j = 0; j < 4; ++j) { x[2 * j] = __builtin_bit_cast(float, pw[j] << 16); x[2 * j + 1] = __builtin_bit_cast(float, pw[j] & 0xffff0000u); cm[j] = c0[j]; cm[4 + j] = c1[j]; }
        if (ISQ) {
#pragma unroll
            for (int j = 0; j < 8; ++j) x[j] *= 0.14433756729740643f; }
    } else if constexpr (TYPE == 1) {
        const float* cp = (const float*)(ws + WS_CUM) + row * NDV + 192 + h * DK + d0; const f32x4 c0 = *(const f32x4*)cp, c1 = *(const f32x4*)(cp + 4);
#pragma unroll
        for (int j = 0; j < 4; ++j) { cm[j] = c0[j]; cm[4 + j] = c1[j]; }
        if (ISQ) { const v4u p = *(const v4u*)(pr + C_HQ + h * DK + d0); const unsigned pw[4] = {p.x, p.y, p.z, p.w};
#pragma unroll
            for (int j = 0; j < 4; ++j) { x[2 * j] = __builtin_bit_cast(float, pw[j] << 16); x[2 * j + 1] = __builtin_bit_cast(float, pw[j] & 0xffff0000u); } }
        else { f32x4 p0 = {0.f, 0.f, 0.f, 0.f}, p1 = {0.f, 0.f, 0.f, 0.f}; if (t > 0) { p0 = *(const f32x4*)(cp - NDV); p1 = *(const f32x4*)(cp - NDV + 4); }
#pragma unroll
            for (int j = 0; j < 4; ++j) { x[j] = -expm1f(c0[j] - p0[j]); x[4 + j] = -expm1f(c1[j] - p1[j]); } }
    } else {
        const int f0 = (d0 < 24) ? d0 : d0 - 24, dp = (d0 < 24) ? d0 + 24 : d0 - 24; const float sg = (d0 < 24) ? -1.f : 1.f;
        const int cb = (ISQ ? C_RQ : C_RK) + h * DK; const v4u p = *(const v4u*)(pr + cb + d0), pp = *(const v4u*)(pr + cb + dp); const unsigned pw[4] = {p.x, p.y, p.z, p.w}, qw[4] = {pp.x, pp.y, pp.z, pp.w};
        const float* rp = (const float*)(ws + WS_ROPE) + row * 48; const f32x4 cs0 = *(const f32x4*)(rp + f0), cs1 = *(const f32x4*)(rp + f0 + 4), sn0 = *(const f32x4*)(rp + 24 + f0), sn1 = *(const f32x4*)(rp + 24 + f0 + 4);
        const float cmv = (float)(t + 1) * ret_lg(h);
#pragma unroll
        for (int j = 0; j < 4; ++j) { const float xa = __builtin_bit_cast(float, pw[j] << 16), xb = __builtin_bit_cast(float, pw[j] & 0xffff0000u), ya = __builtin_bit_cast(float, qw[j] << 16), yb = __builtin_bit_cast(float, qw[j] & 0xffff0000u);
            const float ca = (j < 2) ? cs0[2 * j] : cs1[2 * j - 4], cb2 = (j < 2) ? cs0[2 * j + 1] : cs1[2 * j - 3], sa = (j < 2) ? sn0[2 * j] : sn1[2 * j - 4], sb = (j < 2) ? sn0[2 * j + 1] : sn1[2 * j - 3];
            x[2 * j] = xa * ca + sg * ya * sa; x[2 * j + 1] = xb * cb2 + sg * yb * sb; cm[2 * j] = cmv; cm[2 * j + 1] = cmv; }
        if (ISQ) {
#pragma unroll
            for (int j = 0; j < 8; ++j) x[j] *= 0.14433756729740643f; }
    }
}

template <int TYPE>
__device__ __forceinline__ void mixc_batch(const Args& a, int layer, int unit, LAS unsigned char* lds, int tid, int lane, int wave) {
    typedef MixCfg<TYPE> C; constexpr int DK = C::DK, DV = C::DV, NV = C::NV, TE = DV / 16;
    unsigned char* ws = a.ws; const bf16* PROJ = (const bf16*)(ws + WS_PROJ); bf16* MIX = (bf16*)(ws + WS_MIX);
    LAS bf16* VT = (LAS bf16*)(lds + LC_VT); LAS bf16* ST = (LAS bf16*)(lds + LC_ST); LAS bf16* AB = (LAS bf16*)(lds + LC_AB) + wave * 16 * BP;
    const int row0 = unit * CH;
    stage_vt<NV>(PROJ + (size_t)row0 * NPROJ + C::CV, VT, tid);
    { const bf16* SPu = (const bf16*)(ws + WS_SP) + (size_t)unit * ST_TOT + C::STOFF;
        for (int idx = tid; idx < NV * 8; idx += NTHR) { const int er = idx >> 3, ch = idx & 7; v4u w = {0u, 0u, 0u, 0u}; if (ch * 8 < DK) w = *(const v4u*)(SPu + (size_t)er * DK + ch * 8); *(LAS v4u*)(ST + er * BP + ch * 8) = w; } }
    __syncthreads();
    const int h = wave >> 1, hsel = wave & 1, r = lane & 15, g = lane >> 4;
    const LAS bf16* STh = ST + h * DV * BP; const LAS bf16* VTh = VT + h * DV * BP;
    const float* CUMp = (const float*)(ws + WS_CUM);
    for (int ib = 0; ib < 2; ++ib) { const int I = ib ? 3 - hsel : hsel;
        pg8::bf16x8 qh[2], qt[2]; float refv[2][8];
#pragma unroll
        for (int s = 0; s < 2; ++s) { const int d0 = 32 * s + 8 * g; const bool valid = d0 < DK; const int d0c = valid ? d0 : 0;
            float x[8], cm[8]; mix_frag<TYPE, true>(a, h, (size_t)(row0 + 16 * I + r), 16 * I + r, d0c, x, cm);
            if constexpr (TYPE == 2) {
#pragma unroll
                for (int j = 0; j < 8; ++j) refv[s][j] = (float)(16 * I) * ret_lg(h);
            } else { if (I > 0) { const float* cp = CUMp + (size_t)(row0 + 16 * I - 1) * NDV + C::COFF + h * DK + d0c; const f32x4 c0 = *(const f32x4*)cp, c1 = *(const f32x4*)(cp + 4);
#pragma unroll
                    for (int j = 0; j < 4; ++j) { refv[s][j] = c0[j]; refv[s][4 + j] = c1[j]; } }
                else {
#pragma unroll
                    for (int j = 0; j < 8; ++j) refv[s][j] = 0.f; } }
            float xh[8], xt[8];
#pragma unroll
            for (int j = 0; j < 8; ++j) { xh[j] = valid ? x[j] * __expf(cm[j] - refv[s][j]) : 0.f; xt[j] = valid ? x[j] * __expf(cm[j]) : 0.f; }
            qh[s] = pack8(xh); qt[s] = pack8(xt); }
        for (int J = 0; J <= I; ++J) { f32x4 acc = {0.f, 0.f, 0.f, 0.f};
#pragma unroll
            for (int s = 0; s < 2; ++s) { const int d0 = 32 * s + 8 * g; const bool valid = d0 < DK; const int d0c = valid ? d0 : 0;
                float x[8], cm[8]; mix_frag<TYPE, false>(a, h, (size_t)(row0 + 16 * J + r), 16 * J + r, d0c, x, cm);
                float xk[8];
#pragma unroll
                for (int j = 0; j < 8; ++j) xk[j] = valid ? x[j] * __expf(fminf(refv[s][j] - cm[j], 80.f)) : 0.f;
                acc = __builtin_amdgcn_mfma_f32_16x16x32_bf16(qh[s], pack8(xk), acc, 0, 0, 0); }
#pragma unroll
            for (int q = 0; q < 4; ++q) { const int i = 4 * g + q; const float v = (J < I || r <= i) ? acc[q] : 0.f; AB[i * BP + 16 * J + r] = (bf16)f2bf(v); } }
        if ((I & 1) == 0) {
#pragma unroll
            for (int q = 0; q < 4; ++q) AB[(4 * g + q) * BP + 16 * (I + 1) + r] = (bf16)0; }
        asm volatile("s_waitcnt lgkmcnt(0)" ::: "memory");
        const pg8::bf16x8 ah0 = *(const LAS pg8::bf16x8*)(AB + r * BP + 8 * g), ah1 = *(const LAS pg8::bf16x8*)(AB + r * BP + 32 + 8 * g);
        f32x4 o[TE];
#pragma unroll
        for (int te = 0; te < TE; ++te) { f32x4 acc = {0.f, 0.f, 0.f, 0.f};
            acc = __builtin_amdgcn_mfma_f32_16x16x32_bf16(qt[0], ldfrag(STh, BP, te * 16, 0, lane), acc, 0, 0, 0);
            acc = __builtin_amdgcn_mfma_f32_16x16x32_bf16(qt[1], ldfrag(STh, BP, te * 16, 32, lane), acc, 0, 0, 0);
            acc = __builtin_amdgcn_mfma_f32_16x16x32_bf16(ah0, ldfrag(VTh, BP, te * 16, 0, lane), acc, 0, 0, 0);
            if (I >= 2) acc = __builtin_amdgcn_mfma_f32_16x16x32_bf16(ah1, ldfrag(VTh, BP, te * 16, 32, lane), acc, 0, 0, 0);
            o[te] = acc; }
#pragma unroll
        for (int q = 0; q < 4; ++q) { float s1 = 0.f, s2 = 0.f;
#pragma unroll
            for (int te = 0; te < TE; ++te) { s1 += o[te][q]; s2 += o[te][q] * o[te][q]; }
#pragma unroll
            for (int m = 1; m < 16; m <<= 1) { s1 += __shfl_xor(s1, m); s2 += __shfl_xor(s2, m); }
            const size_t row = (size_t)(row0 + 16 * I + 4 * g + q); const bf16* pr = PROJ + row * NPROJ + C::CG + h * DV; bf16* mo = MIX + row * D + C::MIXOFF + h * DV;
            float mean = 0.f, rstd;
            if constexpr (TYPE == 2) { mean = s1 * (1.0f / DV); rstd = 1.0f / sqrtf(fmaxf(s2 * (1.0f / DV) - mean * mean, 0.f) + EPS); }
            else rstd = 1.0f / sqrtf(s2 * (1.0f / DV) + EPS);
#pragma unroll
            for (int te = 0; te < TE; ++te) { const int e = te * 16 + r; const float gt = bf2f(pr[e]); float v;
                if constexpr (TYPE == 0) v = o[te][q] * rstd * a.gla_norm_w[layer * 384 + h * 96 + e] * (gt / (1.0f + __expf(-gt)));
                else if constexpr (TYPE == 1) v = o[te][q] * rstd * a.hg_norm_w[layer * 256 + h * 64 + e] * (1.0f / (1.0f + __expf(-gt)));
                else v = (o[te][q] - mean) * rstd * (gt / (1.0f + __expf(-gt)));
                mo[e] = (bf16)f2bf(v); } }
    }
    __syncthreads();
}
__device__ __forceinline__ void p3c_outputs(const Args& a, int layer, LAS unsigned char* lds, int vcu, int G, int tid, int lane, int wave) {
    for (int unit = vcu; unit < NUNIT; unit += G) {
        mixc_batch<0>(a, layer, unit, lds, tid, lane, wave);
        mixc_batch<1>(a, layer, unit, lds, tid, lane, wave);
        mixc_batch<2>(a, layer, unit, lds, tid, lane, wave);
    }
}

constexpr int MW_ARGS = 800;
__device__ __forceinline__ const void* ld_argp(const volatile LAS unsigned* T, int i) {
    const unsigned lo = __builtin_amdgcn_readfirstlane(T[2 * i]), hi = __builtin_amdgcn_readfirstlane(T[2 * i + 1]);
    return (const void*)(((unsigned long long)hi << 32) | lo);
}
__device__ __forceinline__ Args load_args(LAS unsigned char* lds) {
    const volatile LAS unsigned* T = (const volatile LAS unsigned*)(lds + MISC_OFF) + MW_ARGS;
    Args a;
    a.x = (const float*)ld_argp(T, 0); a.c = (const float*)ld_argp(T, 1); a.pos = (const int*)ld_argp(T, 2); a.w_mod = (const float*)ld_argp(T, 3); a.b_mod = (const float*)ld_argp(T, 4);
    a.norm1_w = (const float*)ld_argp(T, 5); a.w_in = (const float*)ld_argp(T, 6); a.gla_wa2 = (const float*)ld_argp(T, 7); a.gla_ba2 = (const float*)ld_argp(T, 8); a.hg_lb = (const float*)ld_argp(T, 9);
    a.gla_norm_w = (const float*)ld_argp(T, 10); a.hg_norm_w = (const float*)ld_argp(T, 11); a.w_out = (const float*)ld_argp(T, 12); a.norm2_w = (const float*)ld_argp(T, 13); a.w_r = (const float*)ld_argp(T, 14);
    a.b_r = (const float*)ld_argp(T, 15); a.w_gu = (const float*)ld_argp(T, 16); a.b_gu = (const float*)ld_argp(T, 17); a.w_dn = (const float*)ld_argp(T, 18); a.b_dn = (const float*)ld_argp(T, 19);
    a.final_norm_w = (const float*)ld_argp(T, 20); a.out = (float*)ld_argp(T, 21); a.ws = (unsigned char*)ld_argp(T, 22); a.ph_lo = 0; a.ph_hi = 0;
    return a;
}
#define PH_CTX() { unsigned l_ = (unsigned)(size_t)lds; asm volatile("" : "+s"(l_)); lds = (LAS unsigned char*)(size_t)l_; } const Args args = load_args(lds); volatile LAS unsigned* MISC = (volatile LAS unsigned*)(lds + MISC_OFF); int tid_ = threadIdx.x; asm volatile("" : "+v"(tid_)); const int tid = tid_, lane = tid & 63, wave = __builtin_amdgcn_readfirstlane(tid >> 6); \
    const int G = gridDim.x; const int bx = blockIdx.x; const int vcu = (G % 8 == 0) ? (bx % 8) * (G / 8) + bx / 8 : bx; unsigned char* ws = args.ws; gu32* ctl = (gu32*)(ws + WS_CTL); \
    (void)MISC; (void)lane; (void)wave; (void)vcu; (void)ctl; (void)bx; (void)tid
__device__ __forceinline__ void ph_p0(LAS unsigned char* lds) { PH_CTX(); p0_prologue(args, lds, vcu, G, tid, lane, wave); }
__device__ __forceinline__ void ph_p1(LAS unsigned char* lds, int layer_) { int layer = __builtin_amdgcn_readfirstlane(layer_); asm volatile("" : "+s"(layer)); PH_CTX(); rows_mfma<16>(args, layer, lds, MISC, ctl, vcu, G, tid, lane, wave); }
__device__ __forceinline__ void ph_p2(LAS unsigned char* lds, int layer_) { int layer = __builtin_amdgcn_readfirstlane(layer_); asm volatile("" : "+s"(layer)); PH_CTX();
    pg8::Gemm g{(const bf16*)(ws + WS_H), (const bf16*)(ws + WS_WIN) + (size_t)layer * NPROJ * D, MTOK, NPROJ, D}; pg8::StaticOrder S; S.init(MTOK, NPROJ, G, bx);
    pg8::EpiBf16Plain E{(bf16*)(ws + WS_PROJ), NPROJ};
    pg8::gemm_phase<pg8::EpiBf16Plain, pg8::StaticOrder, true, true>(lds, g, S, E); }
__device__ __forceinline__ void ph_p3a(LAS unsigned char* lds, int layer_) { int layer = __builtin_amdgcn_readfirstlane(layer_); asm volatile("" : "+s"(layer)); PH_CTX(); p3a_summaries(args, layer, lds, vcu, G, tid, lane, wave); }
__device__ __forceinline__ void ph_p3b(LAS unsigned char* lds) { PH_CTX(); p3b_scan(args, vcu, G, tid); }
__device__ __forceinline__ void ph_p3c(LAS unsigned char* lds, int layer_) { int layer = __builtin_amdgcn_readfirstlane(layer_); asm volatile("" : "+s"(layer)); PH_CTX(); p3c_outputs(args, layer, lds, vcu, G, tid, lane, wave); }
__device__ __forceinline__ void ph_p4(LAS unsigned char* lds, int layer_) { int layer = __builtin_amdgcn_readfirstlane(layer_); asm volatile("" : "+s"(layer)); PH_CTX();
    pg8::Gemm g{(const bf16*)(ws + WS_MIX), (const bf16*)(ws + WS_WOUT) + (size_t)layer * D * D, MTOK, D, D}; pg8::StaticOrder S; S.init(MTOK, D, G, bx);
    pg8::EpiResGate E{(layer == 0) ? args.x : (const float*)(ws + WS_X), (float*)(ws + WS_X), D, (const float*)(ws + WS_MOD) + (size_t)layer * 2 * 6144 + 2 * D, 6144, SEQ};
    pg8::gemm_phase<pg8::EpiResGate, pg8::StaticOrder, true, true>(lds, g, S, E); }
__device__ __forceinline__ void ph_p5(LAS unsigned char* lds, int layer_) { int layer = __builtin_amdgcn_readfirstlane(layer_); asm volatile("" : "+s"(layer)); PH_CTX(); rows_mfma<32>(args, layer, lds, MISC, ctl, vcu, G, tid, lane, wave); }
__device__ __forceinline__ void ph_p6(LAS unsigned char* lds, int layer_) { int layer = __builtin_amdgcn_readfirstlane(layer_); asm volatile("" : "+s"(layer)); PH_CTX(); p6_dispatch(args, layer, MISC, ctl, vcu, G, tid, lane, wave); }
__device__ __forceinline__ void ph_p7(LAS unsigned char* lds, int layer_) { int layer = __builtin_amdgcn_readfirstlane(layer_); asm volatile("" : "+s"(layer)); PH_CTX();
    moe_tables(ctl, layer, MISC, tid);
    const int nrt = __builtin_amdgcn_readfirstlane((int)MISC[MW_NRT]);
    pg8::Gemm g{(const bf16*)(ws + WS_A1), (const bf16*)(ws + WS_WGU) + (size_t)layer * NE * 2048 * D, nrt * 256, NE * 2048, D};
    pg8::MoeOrder S{8, G, vcu, nrt * 8, (const LAS int*)(lds + MISC_OFF + 4 * MW_TILE)};
    pg8::EpiSwiglu E{(bf16*)(ws + WS_ACT), FFN, args.b_gu + (size_t)layer * NE * 2048};
    pg8::gemm_phase<pg8::EpiSwiglu, pg8::MoeOrder, true, true>(lds, g, S, E); }
__device__ __forceinline__ void ph_p8(LAS unsigned char* lds, int layer_) { int layer = __builtin_amdgcn_readfirstlane(layer_); asm volatile("" : "+s"(layer)); PH_CTX();
    moe_tables(ctl, layer, MISC, tid);
    const int nrt = __builtin_amdgcn_readfirstlane((int)MISC[MW_NRT]);
    pg8::Gemm g{(const bf16*)(ws + WS_ACT), (const bf16*)(ws + WS_WDN) + (size_t)layer * NE * D * FFN, nrt * 256, NE * D, FFN};
    pg8::MoeOrder S{4, G, vcu, nrt * 4, (const LAS int*)(lds + MISC_OFF + 4 * MW_TILE)};
    pg8::EpiBf16Bias E{(bf16*)(ws + WS_Y), D, args.b_dn + (size_t)layer * NE * D, D};
    pg8::gemm_phase<pg8::EpiBf16Bias, pg8::MoeOrder, true, true>(lds, g, S, E); }
__device__ __forceinline__ void ph_final(LAS unsigned char* lds) { PH_CTX(); final_rows(args, lds, vcu, G, tid, lane); }

#ifndef DBL_MASK
#define DBL_MASK 0
#endif
#if DBL_MASK
#define RUN(bit, call) do { if ((DBL_MASK >> (bit)) & 1) { const unsigned long long t0_ = __builtin_amdgcn_s_memrealtime(); call; const unsigned long long t1_ = __builtin_amdgcn_s_memrealtime(); \
        while (__builtin_amdgcn_s_memrealtime() - t1_ < t1_ - t0_) __builtin_amdgcn_s_sleep(8); } else { call; } } while (0)
#else
#define RUN(bit, call) do { call; } while (0)
#endif
__global__ void __launch_bounds__(NTHR, 2) hybrid_fwd(Args args) {
    extern __shared__ __attribute__((aligned(16))) unsigned char lds_raw[];
    LAS unsigned char* lds = (LAS unsigned char*)lds_raw;
    volatile LAS unsigned* MISC = (volatile LAS unsigned*)(lds + MISC_OFF);
    const int tid = threadIdx.x;
    gu32* ctl = (gu32*)(args.ws + WS_CTL);
    for (int u = tid; u < (LDS_BYTES - MISC_OFF) / 4; u += NTHR) MISC[u] = 0u;
    __syncthreads();
    if (tid == 0) {
#define ST_ARG(i, p) do { const unsigned long long v_ = (unsigned long long)(p); MISC[MW_ARGS + 2 * (i)] = (unsigned)v_; MISC[MW_ARGS + 2 * (i) + 1] = (unsigned)(v_ >> 32); } while (0)
        ST_ARG(0, args.x); ST_ARG(1, args.c); ST_ARG(2, args.pos); ST_ARG(3, args.w_mod); ST_ARG(4, args.b_mod); ST_ARG(5, args.norm1_w); ST_ARG(6, args.w_in); ST_ARG(7, args.gla_wa2); ST_ARG(8, args.gla_ba2);
        ST_ARG(9, args.hg_lb); ST_ARG(10, args.gla_norm_w); ST_ARG(11, args.hg_norm_w); ST_ARG(12, args.w_out); ST_ARG(13, args.norm2_w); ST_ARG(14, args.w_r); ST_ARG(15, args.b_r); ST_ARG(16, args.w_gu);
        ST_ARG(17, args.b_gu); ST_ARG(18, args.w_dn); ST_ARG(19, args.b_dn); ST_ARG(20, args.final_norm_w); ST_ARG(21, args.out); ST_ARG(22, args.ws);
#undef ST_ARG
    }
    __syncthreads();
    const int lo = args.ph_lo, hi = args.ph_hi;
    const bool multi = (hi - lo) > 1;
    XcdBarrier bar; bar.bar = (unsigned*)(ctl + CW_BAR); bar.x = 0; bar.st = nullptr;
    if (multi) bar = xcd_barrier_post((unsigned*)(ctl + CW_BAR), MISC + MW_BAR);
#define IN(k) (lo <= (k) && (k) < hi)
#define SEAM(k) do { if (IN(k) && IN((k) + 1)) xcd_barrier(bar); } while (0)

    if (IN(0)) RUN(0, ph_p0(lds));
    SEAM(0);
    for (int layer = 0; layer < DEPTH; ++layer) {
        const int pb = 1 + 10 * layer;
        if (IN(pb + 0)) RUN(1, ph_p1(lds, layer));
        SEAM(pb + 0);
        if (IN(pb + 1)) RUN(2, ph_p2(lds, layer));
        SEAM(pb + 1);
        if (IN(pb + 2)) RUN(3, ph_p3a(lds, layer));
        SEAM(pb + 2);
        if (IN(pb + 3)) RUN(4, ph_p3b(lds));
        SEAM(pb + 3);
        if (IN(pb + 4)) RUN(5, ph_p3c(lds, layer));
        SEAM(pb + 4);
        if (IN(pb + 5)) RUN(6, ph_p4(lds, layer));
        SEAM(pb + 5);
        if (IN(pb + 6)) RUN(7, ph_p5(lds, layer));
        SEAM(pb + 6);
        if (IN(pb + 7)) RUN(8, ph_p6(lds, layer));
        SEAM(pb + 7);
        if (IN(pb + 8)) RUN(9, ph_p7(lds, layer));
        SEAM(pb + 8);
        if (IN(pb + 9)) RUN(10, ph_p8(lds, layer));
        SEAM(pb + 9);
    }
    if (IN(NPHASE - 1)) RUN(11, ph_final(lds));
#undef IN
#undef SEAM
}

#ifndef MK_SINGLE
#define MK_SINGLE 1
#endif
extern "C" void kernel_launch(void* const* d_in, const int* in_sizes, int n_in, void* d_out, int out_size, void* d_ws, size_t ws_size, hipStream_t stream) {
    static int grid = 0;
    if (grid == 0) {
        if (n_in != 21 || in_sizes[0] != MTOK * D || out_size != MTOK * D || ws_size < WS_END) { fprintf(stderr, "kernel_launch: unexpected problem shape (n_in %d, in0 %d, out %d, ws %zu)\n", n_in, n_in > 0 ? in_sizes[0] : -1, out_size, ws_size); grid = -1; return; }
        int dev = 0, cus = 0, per_cu = 0;
        if (hipGetDevice(&dev) != hipSuccess || hipDeviceGetAttribute(&cus, hipDeviceAttributeMultiprocessorCount, dev) != hipSuccess) { grid = -1; return; }
        if (hipFuncSetAttribute((const void*)hybrid_fwd, hipFuncAttributeMaxDynamicSharedMemorySize, LDS_BYTES) != hipSuccess) { fprintf(stderr, "kernel_launch: hipFuncSetAttribute failed\n"); grid = -1; return; }
        if (hipOccupancyMaxActiveBlocksPerMultiprocessor(&per_cu, (const void*)hybrid_fwd, NTHR, LDS_BYTES) != hipSuccess || per_cu < 1) fprintf(stderr, "kernel_launch: occupancy query says %d\n", per_cu);
        (void)hipGetLastError();
        grid = cus;
    }
    if (grid < 0) return;
    (void)hipMemsetAsync((char*)d_ws + WS_CTL, 0, CTL_ZERO_BYTES, stream);
    Args a{};
    a.x = (const float*)d_in[0]; a.c = (const float*)d_in[1]; a.pos = (const int*)d_in[2]; a.w_mod = (const float*)d_in[3]; a.b_mod = (const float*)d_in[4]; a.norm1_w = (const float*)d_in[5];
    a.w_in = (const float*)d_in[6]; a.gla_wa2 = (const float*)d_in[7]; a.gla_ba2 = (const float*)d_in[8]; a.hg_lb = (const float*)d_in[9]; a.gla_norm_w = (const float*)d_in[10]; a.hg_norm_w = (const float*)d_in[11];
    a.w_out = (const float*)d_in[12]; a.norm2_w = (const float*)d_in[13]; a.w_r = (const float*)d_in[14]; a.b_r = (const float*)d_in[15]; a.w_gu = (const float*)d_in[16]; a.b_gu = (const float*)d_in[17];
    a.w_dn = (const float*)d_in[18]; a.b_dn = (const float*)d_in[19]; a.final_norm_w = (const float*)d_in[20]; a.out = (float*)d_out; a.ws = (unsigned char*)d_ws;
#if MK_SINGLE
    a.ph_lo = 0; a.ph_hi = NPHASE;
    hipLaunchKernelGGL(hybrid_fwd, dim3(grid), dim3(NTHR), LDS_BYTES, stream, a);
#else
    for (int p = 0; p < NPHASE; ++p) { a.ph_lo = p; a.ph_hi = p + 1; hipLaunchKernelGGL(hybrid_fwd, dim3(grid), dim3(NTHR), LDS_BYTES, stream, a); }
#endif
}
```

```cpp
#include <hip/hip_runtime.h>
#include <cstdio>
#include <cstdint>
namespace pg8 {
#define PG8_LAS __attribute__((address_space(3)))
typedef unsigned short bf16_t;
typedef short bf16x8 __attribute__((ext_vector_type(8)));
typedef float f32x4 __attribute__((ext_vector_type(4)));
typedef unsigned u32x4 __attribute__((ext_vector_type(4)));
constexpr int BM = 256, BK = 64, HALF = 128, HTB = HALF * BK * 2  , STAGE_BYTES = 8 * HTB, NXCD = 8, WGM = 8;

__host__ __device__ __forceinline__ int lds_byte(int r, int c) { const int st = (r >> 4) * 2 + (c >> 5), rr = r & 15, cc = c & 31, ob = rr * 64 + cc * 2; return st * 1024 + (ob ^ (((ob >> 9) & 1) << 5)); }
__host__ __device__ __forceinline__ void stage_rc(int b, int& R, int& C) { const int st = b / 1024, sb = b % 1024, swz = sb ^ (((sb >> 9) & 1) << 5); R = (st >> 1) * 16 + swz / 64; C = (st & 1) * 32 + (swz % 64) / 2; }
__host__ __device__ __forceinline__ int perm32(int rho) { const int n = rho >> 4, i = rho & 15; return 8 * (i >> 2) + 4 * n + (i & 3); }

struct Unit { int pm, pn, e, pl; };
struct Gemm { const bf16_t* A; const bf16_t* Bt; int M, N, K; };

struct StaticOrder {
    int nM, nN, nwg, G, c;
    __host__ __device__ void init(int M, int N, int G_, int c_) { nM = M / BM; nN = N / BM; nwg = nM * nN; G = G_; c = c_; }
    __host__ __device__ bool next(int i, Unit& u) const {
        const long L = (long)i * G + c; if (L >= nwg) return false;
        int wgid = (int)L; { const int q = nwg / NXCD, r = nwg % NXCD, xcd = wgid % NXCD, off = wgid / NXCD; wgid = (xcd < r ? xcd * (q + 1) : r * (q + 1) + (xcd - r) * q) + off; }
        const int nig = WGM * nN, gid = wgid / nig, fm = gid * WGM, gsz = (nM - fm) < WGM ? (nM - fm) : WGM;
        u.pm = fm + ((wgid % nig) % gsz); u.pn = (wgid % nig) / gsz; u.e = 0; u.pl = u.pn; return true;
    }
    __device__ __forceinline__ void a_ready(const Unit&) const {}
    __device__ __forceinline__ void done(const Unit&) const {}
};

__device__ __forceinline__ unsigned cvt_pk_bf16(float lo, float hi) { unsigned r; asm volatile("v_cvt_pk_bf16_f32 %0, %1, %2" : "=v"(r) : "v"(lo), "v"(hi)); return r; }

struct EpiBf16Plain {
    static constexpr bool PERM = true, AFTER_DRAIN = false;
    bf16_t* O; int ldc;
    __device__ __forceinline__ void operator()(const f32x4 (&acc)[2][2][4][2], const Unit& u, int wr, int wc, int fr, int fq) const {
        const int row0 = u.pm * BM + wr * 64 + fr; const int col0 = u.pn * BM + wc * 32 + 8 * fq;
#pragma unroll
        for (int ai = 0; ai < 2; ++ai)
#pragma unroll
            for (int m = 0; m < 4; ++m) { bf16_t* rowp = O + (size_t)(row0 + ai * HALF + m * 16) * ldc + col0;
#pragma unroll
                for (int bj = 0; bj < 2; ++bj) { const f32x4 v0 = acc[ai][bj][m][0], v1 = acc[ai][bj][m][1];
                    u32x4 w; w.x = cvt_pk_bf16(v0[0], v0[1]); w.y = cvt_pk_bf16(v0[2], v0[3]); w.z = cvt_pk_bf16(v1[0], v1[1]); w.w = cvt_pk_bf16(v1[2], v1[3]);
                    *(u32x4*)(rowp + bj * HALF) = w; } }
    }
};
struct EpiResGate {
    static constexpr bool PERM = false, AFTER_DRAIN = false;
    const float* base; float* out; int ldc; const float* gate; int gpitch; int rows_per_batch;
    __device__ __forceinline__ void operator()(const f32x4 (&acc)[2][2][4][2], const Unit& u, int wr, int wc, int fr, int fq) const {
        const int row0 = u.pm * BM + wr * 64 + fr, col0 = u.pn * BM + wc * 32 + 4 * fq;
        const float* gp = gate + (size_t)((u.pm * BM) / rows_per_batch) * gpitch + col0;
        f32x4 gv[2][2];
#pragma unroll
        for (int bj = 0; bj < 2; ++bj)
#pragma unroll
            for (int n = 0; n < 2; ++n) gv[bj][n] = *(const f32x4*)(gp + bj * HALF + n * 16);
#pragma unroll
        for (int ai = 0; ai < 2; ++ai)
#pragma unroll
            for (int m = 0; m < 4; ++m) { const size_t off = (size_t)(row0 + ai * HALF + m * 16) * ldc + col0;
#pragma unroll
                for (int bj = 0; bj < 2; ++bj)
#pragma unroll
                    for (int n = 0; n < 2; ++n) { const f32x4 bs = *(const f32x4*)(base + off + bj * HALF + n * 16);
                        *(f32x4*)(out + off + bj * HALF + n * 16) = bs + gv[bj][n] * acc[ai][bj][m][n]; }
                asm volatile("" ::: "memory"); }
    }
};
struct EpiSwiglu {
    static constexpr bool PERM = true, AFTER_DRAIN = false;
    unsigned char* O; int ldc; const float* bias; float inv_in, out_scale;
    __device__ __forceinline__ float act1(float g, float up) const {
        g = fminf(g, 7.0f); up = fminf(fmaxf(up, -7.0f), 7.0f);
        const float s = 1.0f / (1.0f + __expf(-1.702f * g));
        return fminf(fmaxf((up + 1.0f) * g * s * out_scale, -448.f), 448.f);
    }
    __device__ __forceinline__ void operator()(const f32x4 (&acc)[2][2][4][2], const Unit& u, int wr, int wc, int fr, int fq) const {
        const int row0 = u.pm * BM + wr * 64 + fr; const int jj0 = wc * 32 + 8 * fq; const int col0 = u.pl * HALF + jj0;
        const float* bp = bias + (size_t)u.e * 2048 + col0;
        f32x4 bg[2], bu[2];
#pragma unroll
        for (int n = 0; n < 2; ++n) { bg[n] = *(const f32x4*)(bp + 4 * n); bu[n] = *(const f32x4*)(bp + 1024 + 4 * n); }
#pragma unroll
        for (int ai = 0; ai < 2; ++ai)
#pragma unroll
            for (int m = 0; m < 4; ++m) { unsigned char* rowp = O + (size_t)(row0 + ai * HALF + m * 16) * ldc + col0;
                f32x4 r[2];
#pragma unroll
                for (int n = 0; n < 2; ++n) { const f32x4 g = acc[ai][0][m][n] * inv_in + bg[n], up = acc[ai][1][m][n] * inv_in + bu[n];
#pragma unroll
                    for (int j = 0; j < 4; ++j) r[n][j] = act1(g[j], up[j]); }
                int w0 = 0, w1 = 0;
                w0 = __builtin_amdgcn_cvt_pk_fp8_f32(r[0][0], r[0][1], w0, false); w0 = __builtin_amdgcn_cvt_pk_fp8_f32(r[0][2], r[0][3], w0, true);
                w1 = __builtin_amdgcn_cvt_pk_fp8_f32(r[1][0], r[1][1], w1, false); w1 = __builtin_amdgcn_cvt_pk_fp8_f32(r[1][2], r[1][3], w1, true);
                typedef int i32x2 __attribute__((ext_vector_type(2))); *(i32x2*)rowp = (i32x2){w0, w1}; }
    }
};
struct EpiBf16Bias {
    static constexpr bool PERM = true, AFTER_DRAIN = false;
    bf16_t* O; int ldc; const float* bias; int bpitch; float inv_in;
    __device__ __forceinline__ void operator()(const f32x4 (&acc)[2][2][4][2], const Unit& u, int wr, int wc, int fr, int fq) const {
        const int row0 = u.pm * BM + wr * 64 + fr; const int col0 = u.pl * BM + wc * 32 + 8 * fq;
        const float* bp = bias + (size_t)u.e * bpitch + col0;
        f32x4 bv[2][2];
#pragma unroll
        for (int bj = 0; bj < 2; ++bj)
#pragma unroll
            for (int n = 0; n < 2; ++n) bv[bj][n] = *(const f32x4*)(bp + bj * HALF + 4 * n);
#pragma unroll
        for (int ai = 0; ai < 2; ++ai)
#pragma unroll
            for (int m = 0; m < 4; ++m) { bf16_t* rowp = O + (size_t)(row0 + ai * HALF + m * 16) * ldc + col0;
#pragma unroll
                for (int bj = 0; bj < 2; ++bj) { const f32x4 v0 = acc[ai][bj][m][0] * inv_in + bv[bj][0], v1 = acc[ai][bj][m][1] * inv_in + bv[bj][1];
                    u32x4 w; w.x = cvt_pk_bf16(v0[0], v0[1]); w.y = cvt_pk_bf16(v0[2], v0[3]); w.z = cvt_pk_bf16(v1[0], v1[1]); w.w = cvt_pk_bf16(v1[2], v1[3]);
                    *(u32x4*)(rowp + bj * HALF) = w; } }
    }
};
struct MoeOrder {
    int nN, G, c, nunits; const PG8_LAS int* tile_e;
    __device__ __forceinline__ bool next(int i, Unit& u) const {
        const int L = i * G + c; if (L >= nunits) return false;
        const int pm = L / nN, pl = L - pm * nN, e = __builtin_amdgcn_readfirstlane(tile_e[pm]);
        u.pm = pm; u.pl = pl; u.e = e; u.pn = e * nN + pl; return true;
    }
    __device__ __forceinline__ void a_ready(const Unit&) const {}
    __device__ __forceinline__ void done(const Unit&) const {}
};
typedef int v4i32_t __attribute__((ext_vector_type(4)));
typedef int v8i32_t __attribute__((ext_vector_type(8)));
template <class Epi, class Sched, bool ALIGN_EPI = false, bool SP2 = false, bool FP8 = false>
__device__ __forceinline__ void gemm_phase(PG8_LAS unsigned char* lds, const Gemm g, const Sched& S, const Epi& E, int tid_in) {
    int tid_ = tid_in; asm volatile("" : "+v"(tid_)); const int tid = tid_, wid = __builtin_amdgcn_readfirstlane(tid >> 6), lane = tid & 63, wr = wid >> 2, wc = wid & 3, fr = lane & 15, fq = lane >> 4;
    const int K = g.K, nt = K / BK;
    unsigned voffA, voffB;
    { int R, C; stage_rc(tid * 16, R, C); const int Rb = Epi::PERM ? ((R & ~31) + perm32(R & 31)) : R;
        voffA = (unsigned)(R * K + C) * 2u; voffB = (unsigned)(Rb * K + C) * 2u; }
    const size_t rstep = (size_t)64 * K * 2;
    const size_t kstep = (size_t)(BK * 2);
    const size_t hstep = (size_t)HALF * K * 2;
    const size_t tstep = 2 * hstep;
    const unsigned ldsw = (unsigned)wid * 1024u;
    const int aoff = lds_byte(wr * 64 + fr, fq * 8), boff = lds_byte(wc * 32 + fr, fq * 8);
#define PG8_SA(b, h) (((b) * 2 + (h)) * HTB)
#define PG8_SB(b, h) ((4 + (b) * 2 + (h)) * HTB)
#define PG8_STAGE(bufoff, gbase, voff) do { _Pragma("unroll") for (int _i = 0; _i < 2; ++_i) \
        __builtin_amdgcn_global_load_lds((const unsigned*)((const char*)(gbase) + _i * rstep + (voff)), (PG8_LAS unsigned*)(lds + (bufoff) + ldsw + _i * 8192), 16, 0, 0); } while (0)
#define PG8_LDA(dst, b, h) do { _Pragma("unroll") for (int m = 0; m < 4; ++m) _Pragma("unroll") for (int k = 0; k < 2; ++k) dst[m][k] = *(const PG8_LAS bf16x8*)(lds + PG8_SA(b, h) + aoff + m * 2048 + k * 1024); } while (0)
#define PG8_LDB(dst, b, h) do { _Pragma("unroll") for (int n = 0; n < 2; ++n) _Pragma("unroll") for (int k = 0; k < 2; ++k) dst[n][k] = *(const PG8_LAS bf16x8*)(lds + PG8_SB(b, h) + boff + n * 2048 + k * 1024); } while (0)
#define PG8_MMA(ai, bj, At, Bt) do { __builtin_amdgcn_s_setprio(1); _Pragma("unroll") for (int m = 0; m < 4; ++m) _Pragma("unroll") for (int n = 0; n < 2; ++n) { \
        if constexpr (FP8) { const v8i32_t a8_ = __builtin_shufflevector(__builtin_bit_cast(v4i32_t, At[m][0]), __builtin_bit_cast(v4i32_t, At[m][1]), 0, 1, 2, 3, 4, 5, 6, 7); \
            const v8i32_t b8_ = __builtin_shufflevector(__builtin_bit_cast(v4i32_t, Bt[n][0]), __builtin_bit_cast(v4i32_t, Bt[n][1]), 0, 1, 2, 3, 4, 5, 6, 7); \
            asm volatile("v_mfma_scale_f32_16x16x128_f8f6f4 %0, %1, %2, %0, %3, %3 op_sel_hi:[0,0,0]" : "+v"(acc[ai][bj][m][n]) : "v"(b8_), "v"(a8_), "v"(one8_)); } \
        else { _Pragma("unroll") for (int k = 0; k < 2; ++k) acc[ai][bj][m][n] = __builtin_amdgcn_mfma_f32_16x16x32_bf16(Bt[n][k], At[m][k], acc[ai][bj][m][n], 0, 0, 0); } } \
        __builtin_amdgcn_s_setprio(0); } while (0)
#define PG8_WAIT_V(n) asm volatile("s_waitcnt vmcnt(" #n ")" ::: "memory")
#define PG8_WAIT_L(n) asm volatile("s_waitcnt lgkmcnt(" #n ")" ::: "memory")
#define PG8_BAR __builtin_amdgcn_s_barrier()
#define PG8_SCHED __builtin_amdgcn_sched_barrier(0)
    Unit cur, nxt; int ui = 0;
    if (!S.next(0, cur)) return;
    f32x4 acc[2][2][4][2];
#pragma unroll
    for (int a = 0; a < 2; ++a)
#pragma unroll
        for (int b = 0; b < 2; ++b)
#pragma unroll
            for (int m = 0; m < 4; ++m)
#pragma unroll
                for (int n = 0; n < 2; ++n) acc[a][b][m][n] = (f32x4){0.f, 0.f, 0.f, 0.f};
    bf16x8 At[4][2], B0[2][2], B1[2][2];
    int one8_ = 0x7f7f7f7f; asm volatile("" : "+v"(one8_));
    const char* cA = (const char*)g.A + (size_t)cur.pm * tstep; const char* cB = (const char*)g.Bt + (size_t)cur.pn * tstep;
    S.a_ready(cur);
    if constexpr (SP2) {
        PG8_STAGE(PG8_SB(0, 0), cB, voffB); PG8_STAGE(PG8_SB(0, 1), cB + hstep, voffB); PG8_STAGE(PG8_SA(0, 0), cA, voffA); PG8_STAGE(PG8_SA(0, 1), cA + hstep, voffA);
        if (wr == 1) PG8_BAR;
        PG8_WAIT_V(2); PG8_BAR;
        PG8_STAGE(PG8_SB(1, 0), cB + kstep, voffB); PG8_STAGE(PG8_SA(1, 0), cA + kstep, voffA); PG8_STAGE(PG8_SB(1, 1), cB + hstep + kstep, voffB);
        PG8_WAIT_V(6); PG8_BAR;
    } else {
        PG8_STAGE(PG8_SB(0, 0), cB, voffB); PG8_STAGE(PG8_SA(0, 0), cA, voffA); PG8_STAGE(PG8_SB(0, 1), cB + hstep, voffB); PG8_STAGE(PG8_SA(0, 1), cA + hstep, voffA);
        if (wr == 1) PG8_BAR;
        PG8_WAIT_V(4); PG8_BAR;
        PG8_STAGE(PG8_SB(1, 0), cB + kstep, voffB); PG8_STAGE(PG8_SA(1, 0), cA + kstep, voffA); PG8_STAGE(PG8_SB(1, 1), cB + hstep + kstep, voffB);
        PG8_WAIT_V(6); PG8_BAR;
    }
    for (;;) {
        const bool has_next = S.next(ui + 1, nxt);
        const char* nA = has_next ? (const char*)g.A + (size_t)nxt.pm * tstep : cA; const char* nB = has_next ? (const char*)g.Bt + (size_t)nxt.pn * tstep : cB;
#pragma unroll 1
        for (int t = 0; t < nt; t += 2) {
            const bool last = (t == nt - 2);
            const char* a1 = cA + (size_t)(t + 1) * kstep;
            const char* a2 = last ? nA : cA + (size_t)(t + 2) * kstep; const char* b2 = last ? nB : cB + (size_t)(t + 2) * kstep;
            const char* a3 = a2 + kstep; const char* b3 = b2 + kstep;
            if (last && has_next) S.a_ready(nxt);
            if constexpr (SP2) {
            PG8_LDB(B0, 0, 0); PG8_LDB(B1, 0, 1); PG8_SCHED; PG8_LDA(At, 0, 0); PG8_STAGE(PG8_SA(1, 1), a1 + hstep, voffA);
            PG8_WAIT_V(8); PG8_WAIT_L(0); PG8_BAR; PG8_MMA(0, 0, At, B0); PG8_MMA(0, 1, At, B1); PG8_BAR; PG8_SCHED;
            PG8_LDA(At, 0, 1); PG8_STAGE(PG8_SB(0, 0), b2, voffB); PG8_STAGE(PG8_SB(0, 1), b2 + hstep, voffB); PG8_STAGE(PG8_SA(0, 0), a2, voffA);
            PG8_WAIT_V(8); PG8_WAIT_L(0); PG8_BAR; PG8_MMA(1, 0, At, B0); PG8_MMA(1, 1, At, B1); PG8_BAR; PG8_SCHED;
            PG8_LDB(B0, 1, 0); PG8_LDB(B1, 1, 1); PG8_SCHED; PG8_LDA(At, 1, 0); PG8_STAGE(PG8_SA(0, 1), a2 + hstep, voffA);
            PG8_WAIT_V(8); PG8_WAIT_L(0); PG8_BAR; PG8_MMA(0, 0, At, B0); PG8_MMA(0, 1, At, B1); PG8_BAR; PG8_SCHED;
            PG8_LDA(At, 1, 1); PG8_STAGE(PG8_SB(1, 0), b3, voffB); PG8_STAGE(PG8_SB(1, 1), b3 + hstep, voffB); PG8_STAGE(PG8_SA(1, 0), a3, voffA);
            PG8_WAIT_V(8); PG8_WAIT_L(0); PG8_BAR; PG8_MMA(1, 0, At, B0); PG8_MMA(1, 1, At, B1); PG8_BAR; PG8_SCHED;
            } else {
            PG8_LDB(B0, 0, 0); PG8_SCHED; PG8_LDA(At, 0, 0); PG8_STAGE(PG8_SA(1, 1), a1 + hstep, voffA);
            PG8_WAIT_L(8); PG8_BAR; PG8_WAIT_L(0); PG8_MMA(0, 0, At, B0); PG8_BAR; PG8_SCHED;
            PG8_LDB(B1, 0, 1); PG8_STAGE(PG8_SB(0, 0), b2, voffB);
            PG8_BAR; PG8_WAIT_L(0); PG8_MMA(0, 1, At, B1); PG8_BAR;
            PG8_LDA(At, 0, 1); PG8_STAGE(PG8_SA(0, 0), a2, voffA);
            PG8_BAR; PG8_WAIT_L(0); PG8_MMA(1, 0, At, B0); PG8_BAR; PG8_SCHED;
            PG8_STAGE(PG8_SB(0, 1), b2 + hstep, voffB);
            PG8_WAIT_V(6); PG8_BAR; PG8_MMA(1, 1, At, B1); PG8_BAR;
            PG8_LDB(B0, 1, 0); PG8_SCHED; PG8_LDA(At, 1, 0); PG8_STAGE(PG8_SA(0, 1), a2 + hstep, voffA);
            PG8_WAIT_L(8); PG8_BAR; PG8_WAIT_L(0); PG8_MMA(0, 0, At, B0); PG8_BAR; PG8_SCHED;
            PG8_LDB(B1, 1, 1); PG8_STAGE(PG8_SB(1, 0), b3, voffB);
            PG8_BAR; PG8_WAIT_L(0); PG8_MMA(0, 1, At, B1); PG8_BAR;
            PG8_LDA(At, 1, 1); PG8_STAGE(PG8_SA(1, 0), a3, voffA);
            PG8_BAR; PG8_WAIT_L(0); PG8_MMA(1, 0, At, B0); PG8_BAR; PG8_SCHED;
            PG8_STAGE(PG8_SB(1, 1), b3 + hstep, voffB);
            PG8_WAIT_V(6); PG8_BAR; PG8_MMA(1, 1, At, B1); PG8_BAR;
            }
        }
        if constexpr (FP8) asm volatile("s_nop 7\n\ts_nop 7" ::: "memory");
        if constexpr (ALIGN_EPI) { if (wr == 0) PG8_BAR; }
        if constexpr (!Epi::AFTER_DRAIN) { int ln_ = (int)__builtin_amdgcn_mbcnt_hi(~0u, __builtin_amdgcn_mbcnt_lo(~0u, 0u)); asm volatile("" : "+v"(ln_)); E(acc, cur, wr, wc, ln_ & 15, ln_ >> 4); S.done(cur); }
        if (!has_next) break;
#pragma unroll
        for (int a = 0; a < 2; ++a)
#pragma unroll
            for (int b = 0; b < 2; ++b)
#pragma unroll
                for (int m = 0; m < 4; ++m)
#pragma unroll
                    for (int n = 0; n < 2; ++n) acc[a][b][m][n] = (f32x4){0.f, 0.f, 0.f, 0.f};
        cur = nxt; cA = nA; cB = nB; ++ui;
        if constexpr (ALIGN_EPI) { if (wr == 1) PG8_BAR; }
    }
    PG8_WAIT_V(0);
    if constexpr (!ALIGN_EPI) { if (wr == 0) PG8_BAR; }
    PG8_BAR;
    if constexpr (Epi::AFTER_DRAIN) { E.fused(acc, cur, wr, wc, fr, fq, lds, wid, lane); S.done(cur); }
#undef PG8_SA
#undef PG8_SB
#undef PG8_STAGE
#undef PG8_LDA
#undef PG8_LDB
#undef PG8_MMA
#undef PG8_WAIT_V
#undef PG8_WAIT_L
#undef PG8_BAR
#undef PG8_SCHED
}
}

constexpr int NWAVES = 8, NTHR = 512;
constexpr int BATCH = 2, SEQ = 8192, D = 1024, DEPTH = 4, MTOK = BATCH * SEQ;
constexpr int DIN = 3344, NPROJ = 3328, SRC_GA = 1152;
constexpr int C_GQ = 0, C_GK = 192, C_GV = 384, C_GG = 768, C_HQ = 1152, C_HF = 1408, C_HI = 1664, C_HG = 1920, C_RQ = 2176, C_RK = 2368, C_RV = 2560, C_RG = 2944;
constexpr int NE = 32, FFN = 1024;
constexpr int CH = 64, NCH = SEQ / CH, NUNIT = BATCH * NCH;
constexpr int ST_GLA = 0, ST_HG = 4 * 48 * 96, ST_RET = ST_HG + 4 * 64 * 64, ST_TOT = ST_RET + 4 * 48 * 96;
constexpr int NDV = 448;
constexpr int MAXROWS = 65536 + NE * 256, MAXRT = MAXROWS / 256;
constexpr float EPS = 1e-6f;
constexpr float S8_W = 2048.f, S8_H = 64.f, S8_A = 8.f;
constexpr int NPHASE = 42;

constexpr size_t MiB = 1u << 20;
constexpr size_t WS_CTL = 0, CTL_ZERO_BYTES = 65536;
constexpr size_t WS_MOD = 1 * MiB;
constexpr size_t WS_ROPE = 2 * MiB;
constexpr size_t WS_LB = 5 * MiB;
constexpr size_t WS_WIN = 8 * MiB;
constexpr size_t WS_WOUT = 34 * MiB;
constexpr size_t WS_WGU = 42 * MiB;
constexpr size_t WS_WDN = 554 * MiB;
constexpr size_t WS_X = 810 * MiB;
constexpr size_t WS_H = 874 * MiB;
constexpr size_t WS_GA = 906 * MiB;
constexpr size_t WS_PROJ = 907 * MiB;
constexpr size_t WS_U = 1011 * MiB;
constexpr size_t WS_DVEC = 1063 * MiB;
constexpr size_t WS_SP = 1064 * MiB;
constexpr size_t WS_MIX = 1090 * MiB;
constexpr size_t WS_TOPE = 1122 * MiB;
constexpr size_t WS_TOPW = WS_TOPE + 256 * 1024;
constexpr size_t WS_SLOT = WS_TOPW + 256 * 1024;
constexpr size_t WS_A1 = 1123 * MiB;
constexpr size_t WS_ACT = 1267 * MiB;
constexpr size_t WS_Y = 1411 * MiB;
constexpr size_t WS_CUM = 1555 * MiB;
constexpr size_t WS_END = 1583 * MiB;
static_assert(WS_WIN + (size_t)DEPTH * NPROJ * D * 2 <= WS_WOUT && WS_PROJ + (size_t)MTOK * NPROJ * 2 <= WS_U && WS_U + (size_t)NUNIT * ST_TOT * 4 <= WS_DVEC && WS_SP + (size_t)NUNIT * ST_TOT * 2 <= WS_MIX && WS_A1 + (size_t)MAXROWS * D * 2 <= WS_ACT, "ws map");
constexpr int CW_TMO = 0, CW_CODE = 1, CW_BAR = 4096, CW_CNT = 8192, CW_FILL = 8192 + 256;
constexpr int RING_BYTES = 131072;
constexpr int MISC_OFF = 147456, LDS_BYTES = MISC_OFF + 4096;
constexpr int MW_BAR = 0, MW_CNT = 16, MW_PST = 48, MW_HIST = 96, MW_BASE = 128, MW_TILE = 192, MW_NRT = 480, MW_SLOTS = 512;

#define GAS __attribute__((address_space(1)))
#define LAS __attribute__((address_space(3)))
typedef unsigned v4u __attribute__((ext_vector_type(4)));
typedef float f32x4 __attribute__((ext_vector_type(4)));
typedef short bf16x8 __attribute__((ext_vector_type(8)));
typedef GAS unsigned gu32;
typedef GAS unsigned long long gu64;
#define RLX_AGENT __ATOMIC_RELAXED, __HIP_MEMORY_SCOPE_AGENT
#define LDS_WAIT() asm volatile("s_waitcnt lgkmcnt(0)" ::: "memory")
#define VM_WAIT() asm volatile("s_waitcnt vmcnt(0)" ::: "memory")
__device__ __forceinline__ unsigned long long rt() { return __builtin_amdgcn_s_memrealtime(); }
typedef unsigned short bf16;
__device__ __forceinline__ unsigned f2bf(float f) { unsigned u = __builtin_bit_cast(unsigned, f); return (u + 0x7fffu + ((u >> 16) & 1u)) >> 16; }
__device__ __forceinline__ unsigned pk2(float lo, float hi) { return f2bf(lo) | (f2bf(hi) << 16); }
__device__ __forceinline__ float bf2f(bf16 b) { return __builtin_bit_cast(float, (unsigned)b << 16); }
#define XB_TMO      128
#define XB_XCNT(j)  (256  + 64 * (j))
#define XB_XSUB(j)  (1280 + 64 * (j))
#define XB_XGEN(j)  (2304 + 64 * (j))
#define XB_TOP      3328
#define XB_TOPGEN   3392
#define XCD_BAR_WORDS 3456
#define XB_SPIN_CAP (1u << 18)

__device__ __forceinline__ unsigned xb_ld(unsigned* p)              { return __hip_atomic_load(p, __ATOMIC_RELAXED, __HIP_MEMORY_SCOPE_AGENT); }
__device__ __forceinline__ unsigned xb_add(unsigned* p, unsigned v) { return __hip_atomic_fetch_add(p, v, __ATOMIC_RELAXED, __HIP_MEMORY_SCOPE_AGENT); }
__device__ __forceinline__ unsigned xb_xcc_id() { return (unsigned)__builtin_amdgcn_s_getreg((3 << 11) | 20) & 0xFu; }
#define XB_SPIN(cond, bar) do { unsigned _sp = 0; while (cond) { __builtin_amdgcn_s_sleep(1); \
    if ((++_sp & 255u) == 0u) { if (xb_ld(&(bar)[XB_TMO])) break; if (_sp > XB_SPIN_CAP) { atomicAdd(&(bar)[XB_TMO], 1u); break; } } } } while (0)

struct XcdBarrier {
    unsigned* bar; unsigned x;
    volatile LAS unsigned* st;
};

__device__ __forceinline__ XcdBarrier xcd_barrier_post(unsigned* bar, volatile LAS unsigned* st) {
    XcdBarrier b; b.bar = bar; b.x = xb_xcc_id(); b.st = st;
    if (threadIdx.x == 0) (void)xb_add(&bar[XB_XCNT(b.x)], 1u);
    return b;
}
__device__ __forceinline__ void xcd_barrier_complete(unsigned* bar, unsigned x, unsigned& nloc, unsigned& nx) {
    const unsigned G = gridDim.x * gridDim.y * gridDim.z;
    unsigned sum, cnt, mine, sp = 0u;
    for (;;) {
        sum = 0u; cnt = 0u; mine = 0u;
#pragma unroll
        for (unsigned j = 0; j < 16; ++j) { const unsigned c = xb_ld(&bar[XB_XCNT(j)]); sum += c; cnt += (c > 0u) ? 1u : 0u; mine = (j == x) ? c : mine; }
        if (sum == G) break;
        __builtin_amdgcn_s_sleep(1);
        if ((++sp & 255u) == 0u) { if (xb_ld(&bar[XB_TMO])) break; if (sp > XB_SPIN_CAP) { atomicAdd(&bar[XB_TMO], 1u); break; } }
    }
    nloc = mine > 0u ? mine : 1u; nx = cnt > 0u ? cnt : 1u;
}

__device__ __forceinline__ void xcd_barrier(const XcdBarrier& b) {
    asm volatile("s_waitcnt vmcnt(0)" ::: "memory");
    __syncthreads();
    if (threadIdx.x == 0) {
        unsigned* bar = b.bar;
        __builtin_amdgcn_s_waitcnt(0);
        unsigned nloc = b.st[0], nx = b.st[1];
        if (nloc == 0u) { xcd_barrier_complete(bar, b.x, nloc, nx); b.st[0] = nloc; b.st[1] = nx; }
        const unsigned old = xb_add(&bar[XB_XSUB(b.x)], 1u);
        const unsigned gen = old / nloc;
        if (old + 1u == (gen + 1u) * nloc) {
            __builtin_amdgcn_fence(__ATOMIC_RELEASE, "agent");
            asm volatile("s_waitcnt vmcnt(0)" ::: "memory");
            const unsigned og = xb_add(&bar[XB_TOP], 1u);
            const unsigned tg = og / nx;
            if (og + 1u == (tg + 1u) * nx) xb_add(&bar[XB_TOPGEN], 1u);
            else XB_SPIN(xb_ld(&bar[XB_TOPGEN]) == tg, bar);
            __builtin_amdgcn_fence(__ATOMIC_ACQUIRE, "agent");
            xb_add(&bar[XB_XGEN(b.x)], 1u);
            asm volatile("s_waitcnt vmcnt(0)" ::: "memory");
        } else {
            XB_SPIN(xb_ld(&bar[XB_XGEN(b.x)]) == gen, bar);
            __builtin_amdgcn_fence(__ATOMIC_ACQUIRE, "agent");
            asm volatile("s_waitcnt vmcnt(0)" ::: "memory");
        }
    }
    __syncthreads();
}

__device__ __forceinline__ float wave_sum(float v) {
#pragma unroll
    for (int o = 1; o < 64; o <<= 1) v += __shfl_xor(v, o);
    return v;
}
__device__ __forceinline__ float log_sigmoid_f(float x) { return fminf(x, 0.f) - log1pf(expf(-fabsf(x))); }
__device__ __forceinline__ float silu_f(float x) { return x / (1.0f + expf(-x)); }
__device__ __forceinline__ float sigmoid_f(float x) { return 1.0f / (1.0f + expf(-x)); }
__device__ __forceinline__ pg8::bf16x8 ldfrag(const LAS bf16* base, int stride, int r0, int k0, int lane) {
    return *(const LAS pg8::bf16x8*)(base + (r0 + (lane & 15)) * stride + k0 + 8 * (lane >> 4));
}
__device__ __forceinline__ pg8::bf16x8 pack8(const float (&v)[8]) { v4u w; w.x = pk2(v[0], v[1]); w.y = pk2(v[2], v[3]); w.z = pk2(v[4], v[5]); w.w = pk2(v[6], v[7]); return __builtin_bit_cast(pg8::bf16x8, w); }

struct Args {
    const float* x; const float* c; const int* pos; const float* w_mod; const float* b_mod; const float* norm1_w; const float* w_in; const float* gla_wa2; const float* gla_ba2; const float* hg_lb;
    const float* gla_norm_w; const float* hg_norm_w; const float* w_out; const float* norm2_w; const float* w_r; const float* b_r; const float* w_gu; const float* b_gu; const float* w_dn; const float* b_dn;
    const float* final_norm_w; float* out; unsigned char* ws; int ph_lo, ph_hi;
};

__device__ __forceinline__ void transpose_block64(const float* src, int ld, bf16* dst, LAS float* scr, int lane) {
    const int r = lane >> 4, c4 = (lane & 15) * 4;
    f32x4 v[16];
#pragma unroll
    for (int i = 0; i < 16; ++i) v[i] = *(const f32x4*)(src + (size_t)(4 * i + r) * ld + c4);
#pragma unroll
    for (int i = 0; i < 16; ++i) { LAS float* w = scr + (4 * i + r) * 65 + c4; w[0] = v[i][0]; w[1] = v[i][1]; w[2] = v[i][2]; w[3] = v[i][3]; }
    LDS_WAIT(); asm volatile("" ::: "memory");
    const int kc = lane & 7;
#pragma unroll
    for (int jj = 0; jj < 8; ++jj) { const int n = (lane >> 3) + 8 * jj; const LAS float* s = scr + (8 * kc) * 65 + n;
        v4u o; o.x = pk2(s[0 * 65], s[1 * 65]); o.y = pk2(s[2 * 65], s[3 * 65]); o.z = pk2(s[4 * 65], s[5 * 65]); o.w = pk2(s[6 * 65], s[7 * 65]);
        *(GAS v4u*)(dst + (size_t)n * D + 8 * kc) = o; }
    LDS_WAIT(); asm volatile("" ::: "memory");
}
__device__ __forceinline__ int pk4_fp8(float a, float b, float c, float d) { int w = 0; w = __builtin_amdgcn_cvt_pk_fp8_f32(fminf(fmaxf(a, -448.f), 448.f), fminf(fmaxf(b, -448.f), 448.f), w, false);
    return __builtin_amdgcn_cvt_pk_fp8_f32(fminf(fmaxf(c, -448.f), 448.f), fminf(fmaxf(d, -448.f), 448.f), w, true); }
__device__ __forceinline__ void transpose_block64_fp8(const float* src, int ld, unsigned char* dst, LAS float* scr, int lane, float sc) {
    const int r = lane >> 4, c4 = (lane & 15) * 4;
    f32x4 v[16];
#pragma unroll
    for (int i = 0; i < 16; ++i) v[i] = *(const f32x4*)(src + (size_t)(4 * i + r) * ld + c4);
#pragma unroll
    for (int i = 0; i < 16; ++i) { LAS float* w = scr + (4 * i + r) * 65 + c4; w[0] = v[i][0] * sc; w[1] = v[i][1] * sc; w[2] = v[i][2] * sc; w[3] = v[i][3] * sc; }
    LDS_WAIT(); asm volatile("" ::: "memory");
    const int kc = lane & 3;
#pragma unroll
    for (int jj = 0; jj < 4; ++jj) { const int n = (lane >> 2) + 16 * jj; const LAS float* s = scr + (16 * kc) * 65 + n;
        v4u o; o.x = (unsigned)pk4_fp8(s[0 * 65], s[1 * 65], s[2 * 65], s[3 * 65]); o.y = (unsigned)pk4_fp8(s[4 * 65], s[5 * 65], s[6 * 65], s[7 * 65]);
        o.z = (unsigned)pk4_fp8(s[8 * 65], s[9 * 65], s[10 * 65], s[11 * 65]); o.w = (unsigned)pk4_fp8(s[12 * 65], s[13 * 65], s[14 * 65], s[15 * 65]);
        *(GAS v4u*)(dst + (size_t)n * D + 16 * kc) = o; }
    LDS_WAIT(); asm volatile("" ::: "memory");
}
constexpr int IT_IN = 16 * (NPROJ / 64), IT_OUT = 16 * 16, IT_GU = NE * 16 * 32, IT_DN = NE * 16 * 16, IT_LAYER = IT_IN + IT_OUT + IT_GU + IT_DN, IT_ALL = DEPTH * IT_LAYER;
__device__ __forceinline__ void p0_prologue(const Args& a, LAS unsigned char* lds, int vcu, int G, int tid, int lane, int wave) {
    unsigned char* ws = a.ws;
    bf16* WIN = (bf16*)(ws + WS_WIN); bf16* WOUT = (bf16*)(ws + WS_WOUT); unsigned char* WGU = ws + WS_WGU; unsigned char* WDN = ws + WS_WDN;
    LAS float* scr = (LAS float*)(lds + wave * 16640);
    const int gw = vcu * NWAVES + wave, NGW = G * NWAVES;
    for (int it = gw; it < IT_ALL; it += NGW) {
        const int l = it / IT_LAYER; int r = it - l * IT_LAYER;
        if (r < IT_IN) { const int kb = r / (NPROJ / 64), nb = r % (NPROJ / 64), n0 = 64 * nb, sc = n0 + (n0 >= SRC_GA ? 16 : 0);
            transpose_block64(a.w_in + ((size_t)l * D + 64 * kb) * DIN + sc, DIN, WIN + ((size_t)l * NPROJ + n0) * D + 64 * kb, scr, lane); continue; }
        r -= IT_IN;
        if (r < IT_OUT) { const int kb = r / 16, nb = r % 16;
            transpose_block64(a.w_out + ((size_t)l * D + 64 * kb) * D + 64 * nb, D, WOUT + ((size_t)l * D + 64 * nb) * D + 64 * kb, scr, lane); continue; }
        r -= IT_OUT;
        if (r < IT_GU) { const int e = r / 512, r2 = r % 512, kb = r2 / 32, nb = r2 % 32, cc = 64 * nb;
            const int row = (cc < 1024) ? 256 * (cc / 128) + (cc % 128) : 256 * ((cc - 1024) / 128) + 128 + ((cc - 1024) % 128);
            transpose_block64_fp8(a.w_gu + (((size_t)l * NE + e) * D + 64 * kb) * 2048 + cc, 2048, WGU + (((size_t)l * NE + e) * 2048 + row) * D + 64 * kb, scr, lane, S8_W); continue; }
        r -= IT_GU;
        { const int e = r / 256, r2 = r % 256, kb = r2 / 16, nb = r2 % 16;
            transpose_block64_fp8(a.w_dn + (((size_t)l * NE + e) * FFN + 64 * kb) * D + 64 * nb, D, WDN + (((size_t)l * NE + e) * D + 64 * nb) * D + 64 * kb, scr, lane, S8_W); }
    }
    __syncthreads();
    {
        LAS float* cact = (LAS float*)lds;
        LAS float* red = (LAS float*)(lds + 8192);
        for (int i = tid; i < 2 * D; i += NTHR) cact[i] = silu_f(a.c[i]);
        __syncthreads();
        float* MOD = (float*)(ws + WS_MOD);
        for (int it = vcu; it < DEPTH * 96; it += G) {
            const int l = it / 96, n0 = (it % 96) * 64;
            const float* wp = a.w_mod + ((size_t)l * D + 128 * wave) * 6144 + n0 + lane;
            float a0 = 0.f, a1 = 0.f;
#pragma unroll 8
            for (int k = 0; k < 128; ++k) { const float w = wp[(size_t)k * 6144]; a0 += cact[128 * wave + k] * w; a1 += cact[D + 128 * wave + k] * w; }
            red[(wave * 2 + 0) * 64 + lane] = a0; red[(wave * 2 + 1) * 64 + lane] = a1;
            __syncthreads();
            if (tid < 128) { const int b = tid >> 6, ln = tid & 63; float s = a.b_mod[l * 6144 + n0 + ln];
#pragma unroll
                for (int w = 0; w < 8; ++w) s += red[(w * 2 + b) * 64 + ln];
                MOD[((size_t)l * 2 + b) * 6144 + n0 + ln] = s; }
            __syncthreads();
        }
    }
    {
        float* ROPE = (float*)(ws + WS_ROPE);
        for (int i = vcu * NTHR + tid; i < MTOK * 24; i += G * NTHR) { const int t = i / 24, f = i % 24;
            const float inv = (float)pow(10000.0, -(double)f / 24.0); const float ang = (float)a.pos[t] * inv;
            ROPE[(size_t)t * 48 + f] = cosf(ang); ROPE[(size_t)t * 48 + 24 + f] = sinf(ang); }
    }
    if (vcu == 0 && tid < 256) {
        float v[4], mx = -3.0e38f; for (int l = 0; l < 4; ++l) { v[l] = a.hg_lb[l * 256 + tid]; mx = fmaxf(mx, v[l]); }
        float s = 0.f; for (int l = 0; l < 4; ++l) { v[l] = expf(v[l] - mx); s += v[l]; }
        float* LB = (float*)(ws + WS_LB); float cs = 0.f, first = 0.f;
        for (int l = 0; l < 4; ++l) { cs += v[l] / s; if (l == 0) first = cs; LB[l * 256 + tid] = cs - first; }
    }
}

__device__ __forceinline__ void moe_combine_row(f32x4 (&v)[4], int m, const bf16* Y, const int* SLOT, const float* TOPW, const float* g2, int lane) {
    const int4 sl = *(const int4*)(SLOT + (size_t)m * 4); const f32x4 tw = *(const f32x4*)(TOPW + (size_t)m * 4);
    const int s[4] = {sl.x, sl.y, sl.z, sl.w};
    f32x4 acc[4];
#pragma unroll
    for (int j = 0; j < 4; ++j) acc[j] = (f32x4){0.f, 0.f, 0.f, 0.f};
#pragma unroll
    for (int k = 0; k < 4; ++k) { const bf16* yr = Y + (size_t)s[k] * D + 4 * lane; const float w = tw[k];
#pragma unroll
        for (int j = 0; j < 4; ++j) { const uint2 p = *(const uint2*)(yr + 256 * j);
            acc[j][0] += w * __builtin_bit_cast(float, p.x << 16); acc[j][1] += w * __builtin_bit_cast(float, p.x & 0xffff0000u);
            acc[j][2] += w * __builtin_bit_cast(float, p.y << 16); acc[j][3] += w * __builtin_bit_cast(float, p.y & 0xffff0000u); } }
#pragma unroll
    for (int j = 0; j < 4; ++j) { const f32x4 g = *(const f32x4*)(g2 + 4 * lane + 256 * j); v[j] = v[j] + g * acc[j]; }
}
__device__ __forceinline__ float row_rstd(const f32x4 (&v)[4]) {
    float s = 0.f;
#pragma unroll
    for (int j = 0; j < 4; ++j) s += (v[j][0] * v[j][0] + v[j][1] * v[j][1]) + (v[j][2] * v[j][2] + v[j][3] * v[j][3]);
    return 1.0f / sqrtf(wave_sum(s) * (1.0f / D) + EPS);
}
__device__ __forceinline__ void modulate_row(f32x4 (&v)[4], float rstd, const float* nw, const float* sc, const float* sh, bf16* hrow, int lane) {
#pragma unroll
    for (int j = 0; j < 4; ++j) { const int c0 = 4 * lane + 256 * j; const f32x4 w = *(const f32x4*)(nw + c0), s1 = *(const f32x4*)(sc + c0), s0 = *(const f32x4*)(sh + c0);
        v[j] = v[j] * rstd * w * (s1 + 1.0f) + s0;
        uint2 p; p.x = pk2(v[j][0], v[j][1]); p.y = pk2(v[j][2], v[j][3]); *(uint2*)(hrow + c0) = p; }
}


constexpr int LR_SLT = 142976, LR_TWL = 144000, LR_SSR = 145024;
__device__ __forceinline__ void stage_slots(const unsigned char* ws, int row0, LAS unsigned char* lds, int tid) {
    if (tid < 64) { *(LAS v4u*)(lds + LR_SLT + 16 * tid) = *(const v4u*)((const int*)(ws + WS_SLOT) + (size_t)(row0 + tid) * 4);
                    *(LAS f32x4*)(lds + LR_TWL + 16 * tid) = *(const f32x4*)((const float*)(ws + WS_TOPW) + (size_t)(row0 + tid) * 4); }
}
template <bool SS>
__device__ __forceinline__ void flat_combine(const float* xsrc, float* xdst, int row0, const bf16* Y, const float* g2, LAS unsigned char* lds, int tid, int lane) {
    const int c4 = tid & 255, rsub = tid >> 8; const f32x4 g = *(const f32x4*)(g2 + 4 * c4);
#pragma unroll 4
    for (int it = 0; it < 32; ++it) { const int i = 2 * it + rsub; const size_t m = (size_t)(row0 + i);
        f32x4 v = *(const f32x4*)(xsrc + m * D + 4 * c4);
        const v4u sl = *(const LAS v4u*)(lds + LR_SLT + 16 * i); const f32x4 tw = *(const LAS f32x4*)(lds + LR_TWL + 16 * i);
        const uint2 p0 = *(const uint2*)(Y + (size_t)sl.x * D + 4 * c4), p1 = *(const uint2*)(Y + (size_t)sl.y * D + 4 * c4), p2 = *(const uint2*)(Y + (size_t)sl.z * D + 4 * c4), p3 = *(const uint2*)(Y + (size_t)sl.w * D + 4 * c4);
        f32x4 acc;
        acc[0] = tw[0] * __builtin_bit_cast(float, p0.x << 16) + tw[1] * __builtin_bit_cast(float, p1.x << 16) + tw[2] * __builtin_bit_cast(float, p2.x << 16) + tw[3] * __builtin_bit_cast(float, p3.x << 16);
        acc[1] = tw[0] * __builtin_bit_cast(float, p0.x & 0xffff0000u) + tw[1] * __builtin_bit_cast(float, p1.x & 0xffff0000u) + tw[2] * __builtin_bit_cast(float, p2.x & 0xffff0000u) + tw[3] * __builtin_bit_cast(float, p3.x & 0xffff0000u);
        acc[2] = tw[0] * __builtin_bit_cast(float, p0.y << 16) + tw[1] * __builtin_bit_cast(float, p1.y << 16) + tw[2] * __builtin_bit_cast(float, p2.y << 16) + tw[3] * __builtin_bit_cast(float, p3.y << 16);
        acc[3] = tw[0] * __builtin_bit_cast(float, p0.y & 0xffff0000u) + tw[1] * __builtin_bit_cast(float, p1.y & 0xffff0000u) + tw[2] * __builtin_bit_cast(float, p2.y & 0xffff0000u) + tw[3] * __builtin_bit_cast(float, p3.y & 0xffff0000u);
        v = v + g * acc;
        *(f32x4*)(xdst + m * D + 4 * c4) = v;
        if (SS) { const float sq = wave_sum((v[0] * v[0] + v[1] * v[1]) + (v[2] * v[2] + v[3] * v[3])); if (lane == 0) __hip_atomic_fetch_add((LAS float*)(lds + LR_SSR) + i, sq, __ATOMIC_RELAXED, __HIP_MEMORY_SCOPE_WORKGROUP); } }
}
template <bool F8>
__device__ __forceinline__ void flat_modulate(const float* xin, int row0, const LAS float* rstds, const float* nw, const float* scp, const float* shp, bf16* H, int tid) {
    const int c4 = tid & 255, rsub = tid >> 8; const f32x4 w = *(const f32x4*)(nw + 4 * c4), s1 = *(const f32x4*)(scp + 4 * c4), s0 = *(const f32x4*)(shp + 4 * c4); const f32x4 ws1 = w * (s1 + 1.0f);
#pragma unroll 8
    for (int it = 0; it < 32; ++it) { const int i = 2 * it + rsub; const size_t m = (size_t)(row0 + i); const f32x4 v = *(const f32x4*)(xin + m * D + 4 * c4) * rstds[i] * ws1 + s0;
        if (F8) *(int*)((unsigned char*)H + m * D + 4 * c4) = pk4_fp8(v[0] * S8_H, v[1] * S8_H, v[2] * S8_H, v[3] * S8_H);
        else { uint2 p; p.x = pk2(v[0], v[1]); p.y = pk2(v[2], v[3]); *(uint2*)(H + m * D + 4 * c4) = p; } }
}

constexpr int WP = 1032;
constexpr int LR_WHI = 0, LR_PART = 132096, LR_SSX = 140288, LR_RSTD = 140544, LR_BIAS = 140800, LR_RED = 140928;
template <int NEO>
__device__ __forceinline__ void rows_mfma(const Args& a, int layer, LAS unsigned char* lds, volatile LAS unsigned* MISC, gu32* ctl, int vcu, int G, int tid, int lane, int wave) {
    constexpr bool P5 = (NEO == 32); constexpr int NET = NEO / 16;
    unsigned char* ws = a.ws; float* X = (float*)(ws + WS_X); bf16* H = (bf16*)(ws + WS_H); const float* MOD = (const float*)(ws + WS_MOD);
    LAS bf16* Whi = (LAS bf16*)(lds + LR_WHI); LAS bf16* Wlo = Whi + NEO * WP; LAS float* part = (LAS float*)(lds + LR_PART); LAS float* ssx = (LAS float*)(lds + LR_SSX);
    LAS float* rstds = (LAS float*)(lds + LR_RSTD); LAS float* biasl = (LAS float*)(lds + LR_BIAS); LAS float* red = (LAS float*)(lds + LR_RED);
    const float* nw = (P5 ? a.norm2_w : a.norm1_w) + layer * D;
    const float* Wsrc = P5 ? a.w_r + (size_t)layer * D * NE : a.w_in + (size_t)layer * D * DIN + SRC_GA; const int wld = P5 ? NE : DIN;
    if (P5) { if (tid < NE) MISC[MW_HIST + tid] = 0u; }
    for (int row0 = vcu * 64; row0 < MTOK; row0 += G * 64) {
        const int b = row0 / SEQ; const float* mp = MOD + ((size_t)layer * 2 + b) * 6144; const float* scp = mp + (P5 ? 4 : 1) * D; const float* shp = mp + (P5 ? 3 : 0) * D;
        if (!P5 && layer > 0) { stage_slots(ws, row0, lds, tid); __syncthreads(); }
        { const int e = tid % NEO, kq = tid / NEO; constexpr int NPT = NTHR / NEO;
#pragma unroll 1
            for (int it0 = 0; it0 < D / NPT; it0 += 8) { float wv[8];
#pragma unroll
                for (int u = 0; u < 8; ++u) { const int k = kq + NPT * (it0 + u); wv[u] = Wsrc[(size_t)k * wld + e] * (nw[k] * (1.0f + scp[k])); }
#pragma unroll
                for (int u = 0; u < 8; ++u) { const int k = kq + NPT * (it0 + u); const unsigned hi = f2bf(wv[u]); const float wl = wv[u] - __builtin_bit_cast(float, hi << 16); Whi[e * WP + k] = (bf16)hi; Wlo[e * WP + k] = (bf16)f2bf(wl); } }
            constexpr int KP = D / NPT; float sacc = 0.f;
#pragma unroll 8
            for (int k = kq * KP; k < kq * KP + KP; ++k) sacc += shp[k] * Wsrc[(size_t)k * wld + e];
            red[kq * NEO + e] = sacc; }
        const float* xin = X;
        if (!P5) { if (layer == 0) xin = a.x;
            else { flat_combine<false>(X, X, row0, (const bf16*)(ws + WS_Y), MOD + ((size_t)(layer - 1) * 2 + b) * 6144 + 5 * D, lds, tid, lane); asm volatile("s_waitcnt vmcnt(0)" ::: "memory"); } }
        __syncthreads();
        if (tid < NEO) { constexpr int NPT = NTHR / NEO; float sacc = P5 ? a.b_r[layer * NE + tid] : 0.f; for (int q = 0; q < NPT; ++q) sacc += red[q * NEO + tid]; biasl[tid] = sacc; }
        const int rg = wave >> 1, kh = wave & 1, r = lane & 15, g = lane >> 4;
        { const float* xr = xin + (size_t)(row0 + 16 * rg + r) * D; f32x4 acc[NET]; float ss = 0.f;
#pragma unroll
            for (int et = 0; et < NET; ++et) acc[et] = (f32x4){0.f, 0.f, 0.f, 0.f};
#pragma unroll 4
            for (int s = 16 * kh; s < 16 * kh + 16; ++s) { const int k0 = 32 * s + 8 * g; const f32x4 x0 = *(const f32x4*)(xr + k0), x1 = *(const f32x4*)(xr + k0 + 4);
                ss += (x0[0] * x0[0] + x0[1] * x0[1]) + (x0[2] * x0[2] + x0[3] * x0[3]) + (x1[0] * x1[0] + x1[1] * x1[1]) + (x1[2] * x1[2] + x1[3] * x1[3]);
                float xv[8] = {x0[0], x0[1], x0[2], x0[3], x1[0], x1[1], x1[2], x1[3]}, xl[8];
#pragma unroll
                for (int j = 0; j < 8; ++j) xl[j] = xv[j] - __builtin_bit_cast(float, f2bf(xv[j]) << 16);
                const pg8::bf16x8 ahi = pack8(xv), alo = pack8(xl);
#pragma unroll
                for (int et = 0; et < NET; ++et) { const pg8::bf16x8 whi = ldfrag(Whi, WP, 16 * et, 32 * s, lane), wlo = ldfrag(Wlo, WP, 16 * et, 32 * s, lane);
                    acc[et] = __builtin_amdgcn_mfma_f32_16x16x32_bf16(ahi, whi, acc[et], 0, 0, 0); acc[et] = __builtin_amdgcn_mfma_f32_16x16x32_bf16(alo, whi, acc[et], 0, 0, 0);
                    acc[et] = __builtin_amdgcn_mfma_f32_16x16x32_bf16(ahi, wlo, acc[et], 0, 0, 0); } }
            ss += __shfl_xor(ss, 16); ss += __shfl_xor(ss, 32);
            if (kh == 1) {
#pragma unroll
                for (int et = 0; et < NET; ++et)
#pragma unroll
                    for (int q = 0; q < 4; ++q) part[(rg * 16 + 4 * g + q) * 32 + 16 * et + r] = acc[et][q];
                if (g == 0) ssx[rg * 16 + r] = ss; }
            __syncthreads();
            if (kh == 0) { const float sst = ss + ssx[rg * 16 + r]; if (g == 0) rstds[rg * 16 + r] = 1.0f / sqrtf(sst * (1.0f / D) + EPS);
                asm volatile("s_waitcnt lgkmcnt(0)" ::: "memory");
#pragma unroll
                for (int et = 0; et < NET; ++et)
#pragma unroll
                    for (int q = 0; q < 4; ++q) { const int i = rg * 16 + 4 * g + q, e = 16 * et + r; const float v = rstds[i] * (acc[et][q] + part[i * 32 + e]) + biasl[e];
                        if (P5) part[i * 32 + e] = v; else ((float*)(ws + WS_GA))[(size_t)(row0 + i) * 16 + e] = v; }
                if (P5) { asm volatile("s_waitcnt lgkmcnt(0)" ::: "memory");
                    if (lane < 16) { const int i = rg * 16 + lane, m = row0 + i; float lv[NE];
#pragma unroll
                        for (int e = 0; e < NE; ++e) lv[e] = part[i * 32 + e];
                        float tv[4]; int te[4];
#pragma unroll
                        for (int t = 0; t < 4; ++t) { float best = -3.0e38f; int bi = 0;
#pragma unroll
                            for (int e = 0; e < NE; ++e) if (lv[e] > best) { best = lv[e]; bi = e; }
#pragma unroll
                            for (int e = 0; e < NE; ++e) if (e == bi) lv[e] = -3.0e38f;
                            tv[t] = best; te[t] = bi; }
                        const float e1 = expf(tv[1] - tv[0]), e2 = expf(tv[2] - tv[0]), e3 = expf(tv[3] - tv[0]); const float inv = 1.0f / (1.0f + e1 + e2 + e3);
                        *(int4*)((int*)(ws + WS_TOPE) + (size_t)m * 4) = make_int4(te[0], te[1], te[2], te[3]); *(f32x4*)((float*)(ws + WS_TOPW) + (size_t)m * 4) = (f32x4){inv, e1 * inv, e2 * inv, e3 * inv};
#pragma unroll
                        for (int t = 0; t < 4; ++t) __hip_atomic_fetch_add((LAS unsigned*)&MISC[MW_HIST + te[t]], 1u, __ATOMIC_RELAXED, __HIP_MEMORY_SCOPE_WORKGROUP); } } }
            __syncthreads(); }
        flat_modulate<P5>(xin, row0, rstds, nw, scp, shp, H, tid);
        __syncthreads();
    }
    if (P5) { if (tid < NE) { const unsigned hcnt = MISC[MW_HIST + tid]; if (hcnt) atomicAdd((unsigned*)(ctl + CW_CNT + layer * NE + tid), hcnt); } }
}

__device__ __forceinline__ void final_rows(const Args& a, LAS unsigned char* lds, int vcu, int G, int tid, int lane) {
    unsigned char* ws = a.ws; const float* X = (const float*)(ws + WS_X); const float* MOD = (const float*)(ws + WS_MOD); LAS float* ssr = (LAS float*)(lds + LR_SSR);
    for (int row0 = vcu * 64; row0 < MTOK; row0 += G * 64) { const int b = row0 / SEQ;
        stage_slots(ws, row0, lds, tid); if (tid < 64) ssr[tid] = 0.f;
        __syncthreads();
        flat_combine<true>(X, a.out, row0, (const bf16*)(ws + WS_Y), MOD + ((size_t)(DEPTH - 1) * 2 + b) * 6144 + 5 * D, lds, tid, lane);
        asm volatile("s_waitcnt vmcnt(0)" ::: "memory");
        __syncthreads();
        { const int c4 = tid & 255, rsub = tid >> 8; const f32x4 w = *(const f32x4*)(a.final_norm_w + 4 * c4);
#pragma unroll 8
            for (int it = 0; it < 32; ++it) { const int i = 2 * it + rsub; float* op = a.out + (size_t)(row0 + i) * D + 4 * c4; const float rstd = 1.0f / sqrtf(ssr[i] * (1.0f / D) + EPS); *(f32x4*)op = *(const f32x4*)op * rstd * w; } }
        __syncthreads();
    }
}

__device__ __noinline__ void moe_tables(gu32* ctl, int layer, volatile LAS unsigned* MISC, int tid) {
    if (tid < NE) MISC[MW_CNT + tid] = __hip_atomic_load(ctl + CW_CNT + layer * NE + tid, RLX_AGENT);
    __syncthreads();
    if (tid == 0) { unsigned p = 0;
        for (int e = 0; e < NE; ++e) { MISC[MW_PST + e] = p; const unsigned nt = (MISC[MW_CNT + e] + 255u) >> 8; for (unsigned t = 0; t < nt; ++t) MISC[MW_TILE + (p >> 8) + t] = (unsigned)e; p += nt << 8; }
        MISC[MW_PST + NE] = p; MISC[MW_NRT] = p >> 8; }
    __syncthreads();
}
__device__ __forceinline__ void p6_dispatch(const Args& a, int layer, volatile LAS unsigned* MISC, gu32* ctl, int vcu, int G, int tid, int lane, int wave) {
    unsigned char* ws = a.ws; const int* TOPE = (const int*)(ws + WS_TOPE); int* SLOT = (int*)(ws + WS_SLOT); const unsigned char* H = ws + WS_H; unsigned char* A1 = ws + WS_A1;
    moe_tables(ctl, layer, MISC, tid);
    for (int t0 = vcu * 64; t0 < MTOK; t0 += G * 64) {
        if (tid < NE) MISC[MW_HIST + tid] = 0u;
        __syncthreads();
        int e = 0; unsigned r = 0;
        if (tid < 256) { e = TOPE[(size_t)t0 * 4 + tid]; r = __hip_atomic_fetch_add((LAS unsigned*)&MISC[MW_HIST + e], 1u, __ATOMIC_RELAXED, __HIP_MEMORY_SCOPE_WORKGROUP); }
        __syncthreads();
        if (tid < NE) { const unsigned h = MISC[MW_HIST + tid]; MISC[MW_BASE + tid] = h ? atomicAdd((unsigned*)(ctl + CW_FILL + layer * NE + tid), h) : 0u; }
        __syncthreads();
        if (tid < 256) { const int slot = (int)(MISC[MW_PST + e] + MISC[MW_BASE + e] + r); SLOT[(size_t)t0 * 4 + tid] = slot; MISC[MW_SLOTS + tid] = (unsigned)slot; }
        __syncthreads();
        for (int i = wave * 32; i < wave * 32 + 32; ++i) { const int slot = (int)MISC[MW_SLOTS + i]; const int t = t0 + (i >> 2);
            const v4u* src = (const v4u*)(H + (size_t)t * D); v4u* dst = (v4u*)(A1 + (size_t)slot * D);
            dst[lane] = src[lane]; }
        __syncthreads();
    }
}

constexpr int BP = 72;
template <int TYPE> struct MixCfg { static constexpr int DK = (TYPE == 1) ? 64 : 48, DV = (TYPE == 1) ? 64 : 96, NC = 4 * DK, NV = 4 * DV;
    static constexpr int STOFF = (TYPE == 0) ? ST_GLA : (TYPE == 1) ? ST_HG : ST_RET, COFF = (TYPE == 0) ? 0 : 192;
    static constexpr int CQ = (TYPE == 0) ? C_GQ : (TYPE == 1) ? C_HQ : C_RQ, CK = (TYPE == 0) ? C_GK : (TYPE == 1) ? C_HF : C_RK, CV = (TYPE == 0) ? C_GV : (TYPE == 1) ? C_HI : C_RV, CG = (TYPE == 0) ? C_GG : (TYPE == 1) ? C_HG : C_RG;
    static constexpr int MIXOFF = (TYPE == 0) ? 0 : (TYPE == 1) ? 384 : 640; };
__device__ __forceinline__ float fast_logsig(float x) { x = fmaxf(x, -80.f); return -__logf(1.0f + __expf(-x)); }
__device__ __forceinline__ float ret_lg(int h) { return logf(1.0f - exp2f(-5.0f - (float)h)); }

template <int NV>
__device__ __forceinline__ void stage_vt(const bf16* pv  , LAS bf16* VT, int tid) {
    for (int idx = tid; idx < 2 * NV; idx += NTHR) { const int e = idx % NV, hf = idx / NV; const bf16* p = pv + (size_t)(32 * hf) * NPROJ + e;
#pragma unroll
        for (int q = 0; q < 4; ++q) { unsigned short b[8];
#pragma unroll
            for (int j = 0; j < 8; ++j) b[j] = p[(size_t)(8 * q + j) * NPROJ];
            v4u w; w.x = b[0] | ((unsigned)b[1] << 16); w.y = b[2] | ((unsigned)b[3] << 16); w.z = b[4] | ((unsigned)b[5] << 16); w.w = b[6] | ((unsigned)b[7] << 16);
            *(LAS v4u*)(VT + e * BP + 32 * hf + 8 * q) = w; } }
}

constexpr int LA_KT = 0, LA_VT = 36864, LA_TOT = 92160, LA_GA = 94208;
template <int TYPE>
__device__ __forceinline__ void mixa_batch(const Args& a, int layer, int unit, LAS unsigned char* lds, int tid, int lane, int wave) {
    typedef MixCfg<TYPE> C; constexpr int DK = C::DK, DV = C::DV, NC = C::NC, NV = C::NV;
    unsigned char* ws = a.ws; const bf16* PROJ = (const bf16*)(ws + WS_PROJ); float* CUM = (float*)(ws + WS_CUM); float* DVEC = (float*)(ws + WS_DVEC) + (size_t)unit * NDV;
    float* U = (float*)(ws + WS_U) + (size_t)unit * ST_TOT + C::STOFF;
    LAS bf16* KT = (LAS bf16*)(lds + LA_KT); LAS bf16* VT = (LAS bf16*)(lds + LA_VT); LAS float* TOT = (LAS float*)(lds + LA_TOT); const LAS float* GAs = (const LAS float*)(lds + LA_GA);
    const int row0 = unit * CH;
    const bool act = tid < 2 * NC; const int c = act ? tid % NC : 0, half = act ? tid / NC : 0, h = c / DK, d = c - h * DK;
    float cum[32]; float tot = 0.f;
    float w2[16], b2 = 0.f, lbv = 0.f, lg = 0.f, sg = 0.f; int f = 0, d2 = 0;
    if (act) {
        if constexpr (TYPE == 0) { b2 = a.gla_ba2[layer * 192 + c];
#pragma unroll
            for (int r = 0; r < 16; ++r) w2[r] = a.gla_wa2[(layer * 16 + r) * 192 + c]; }
        if constexpr (TYPE == 1) lbv = ((const float*)(ws + WS_LB))[layer * 256 + c];
        if constexpr (TYPE == 2) { lg = ret_lg(h); f = (d < 24) ? d : d - 24; d2 = (d < 24) ? d + 24 : d - 24; sg = (d < 24) ? -1.f : 1.f; }
#pragma unroll
        for (int i = 0; i < 32; ++i) { const int t = 32 * half + i; const bf16* pr = PROJ + (size_t)(row0 + t) * NPROJ; float g;
            if constexpr (TYPE == 0) { float pre = b2;
#pragma unroll
                for (int r = 0; r < 16; ++r) pre += GAs[t * 16 + r] * w2[r];
                g = fast_logsig(pre) * (1.0f / 16.0f); }
            else if constexpr (TYPE == 1) { const float hf = fminf(fmaxf(bf2f(pr[C_HF + c]), -80.f), 80.f); const float sgm = 1.0f / (1.0f + __expf(-hf));
                g = __logf(lbv + (1.0f - lbv) * sgm); }
            else g = lg;
            tot += g; cum[i] = tot;
            if ((i & 7) == 7) asm volatile("" ::: "memory"); }
        TOT[c * 2 + half] = tot;
    }
    stage_vt<NV>(PROJ + (size_t)row0 * NPROJ + C::CV, VT, tid);
    __syncthreads();
    if (act) { const float t0 = TOT[c * 2], t1 = TOT[c * 2 + 1]; const float off = half ? t0 : 0.f, last = t0 + t1;
#pragma unroll
        for (int q = 0; q < 4; ++q) { float kt[8];
#pragma unroll
            for (int j = 0; j < 8; ++j) { const int i = 8 * q + j; const float cm = cum[i] + off; const size_t row = (size_t)(row0 + 32 * half + i); const bf16* pr = PROJ + row * NPROJ; float k;
                if constexpr (TYPE == 0) k = bf2f(pr[C_GK + c]);
                else if constexpr (TYPE == 1) k = 1.0f - __expf(cum[i] - (i > 0 ? cum[i - 1] : 0.f));
                else { const float* rp = (const float*)(ws + WS_ROPE) + row * 48; k = bf2f(pr[C_RK + h * 48 + d]) * rp[f] + sg * bf2f(pr[C_RK + h * 48 + d2]) * rp[24 + f]; }
                if constexpr (TYPE != 2) CUM[row * NDV + C::COFF + c] = cm;
                kt[j] = k * __expf(last - cm); }
            v4u w; w.x = pk2(kt[0], kt[1]); w.y = pk2(kt[2], kt[3]); w.z = pk2(kt[4], kt[5]); w.w = pk2(kt[6], kt[7]);
            *(LAS v4u*)(KT + c * BP + 32 * half + 8 * q) = w;
            asm volatile("" ::: "memory"); }
        if (TYPE != 2 && half == 0) DVEC[C::COFF + c] = __expf(last);
    }
    __syncthreads();
    constexpr int TD = DK / 16, NT = (DV / 16) * TD;
    for (int ti = wave; ti < 4 * NT; ti += NWAVES) { const int hh = ti / NT, tr = ti - hh * NT, te = tr / TD, td = tr - te * TD; f32x4 acc = {0.f, 0.f, 0.f, 0.f};
#pragma unroll
        for (int kk = 0; kk < 2; ++kk) acc = __builtin_amdgcn_mfma_f32_16x16x32_bf16(ldfrag(VT, BP, hh * DV + te * 16, kk * 32, lane), ldfrag(KT, BP, hh * DK + td * 16, kk * 32, lane), acc, 0, 0, 0);
        float* Uh = U + hh * DK * DV;
#pragma unroll
        for (int r = 0; r < 4; ++r) Uh[(te * 16 + (lane >> 4) * 4 + r) * DK + td * 16 + (lane & 15)] = acc[r]; }
    __syncthreads();
}
__device__ __forceinline__ void p3a_summaries(const Args& a, int layer, LAS unsigned char* lds, int vcu, int G, int tid, int lane, int wave) {
    for (int unit = vcu; unit < NUNIT; unit += G) {
        { LAS float* GAs = (LAS float*)(lds + LA_GA); const float* GA = (const float*)(a.ws + WS_GA); for (int i = tid; i < CH * 16; i += NTHR) GAs[i] = GA[(size_t)unit * CH * 16 + i]; }
        __syncthreads();
        mixa_batch<0>(a, layer, unit, lds, tid, lane, wave);
        mixa_batch<1>(a, layer, unit, lds, tid, lane, wave);
        mixa_batch<2>(a, layer, unit, lds, tid, lane, wave);
    }
}

__device__ __forceinline__ void p3b_scan(const Args& a, int vcu, int G, int tid) {
    unsigned char* ws = a.ws; const float* U = (const float*)(ws + WS_U); const float* DVEC = (const float*)(ws + WS_DVEC); bf16* SP = (bf16*)(ws + WS_SP);
    for (int gid = vcu * NTHR + tid; gid < BATCH * ST_TOT; gid += G * NTHR) {
        const int b = gid / ST_TOT, el = gid - b * ST_TOT;
        int di = -1; float cdec = 0.f;
        if (el < ST_HG) { const int h = el / 4608, d = (el - h * 4608) % 48; di = h * 48 + d; }
        else if (el < ST_RET) { const int r = el - ST_HG, h = r / 4096, d = r % 64; di = 192 + h * 64 + d; }
        else { const int h = (el - ST_RET) / 4608; cdec = expf(64.0f * logf(1.0f - exp2f(-5.0f - (float)h))); }
        const float* up = U + (size_t)b * NCH * ST_TOT + el; const float* dp = DVEC + (size_t)b * NCH * NDV + (di < 0 ? 0 : di); bf16* sp = SP + (size_t)b * NCH * ST_TOT + el;
        float s = 0.f;
        for (int n0 = 0; n0 < NCH; n0 += 8) { float u[8], dc[8];
#pragma unroll
            for (int i = 0; i < 8; ++i) { u[i] = up[(size_t)(n0 + i) * ST_TOT]; dc[i] = (di < 0) ? cdec : dp[(size_t)(n0 + i) * NDV]; }
#pragma unroll
            for (int i = 0; i < 8; ++i) { sp[(size_t)(n0 + i) * ST_TOT] = (bf16)f2bf(s); s = dc[i] * s + u[i]; } }
    }
}

constexpr int LC_VT = 0, LC_ST = 55296, LC_AB = 110592;
template <int TYPE, bool ISQ>
__device__ __forceinline__ void mix_frag(const Args& a, int h, size_t row, int t, int d0, float (&x)[8], float (&cm)[8]) {
    typedef MixCfg<TYPE> C; constexpr int DK = C::DK;
    unsigned char* ws = a.ws; const bf16* pr = (const bf16*)(ws + WS_PROJ) + row * NPROJ;
    if constexpr (TYPE == 0) {
        const v4u p = *(const v4u*)(pr + (ISQ ? C_GQ : C_GK) + h * DK + d0); const unsigned pw[4] = {p.x, p.y, p.z, p.w};
        const float* cp = (const float*)(ws + WS_CUM) + row * NDV + h * DK + d0; const f32x4 c0 = *(const f32x4*)cp, c1 = *(const f32x4*)(cp + 4);
#pragma unroll
        for (int j = 0; j < 4; ++j) { x[2 * j] = __builtin_bit_cast(float, pw[j] << 16); x[2 * j + 1] = __builtin_bit_cast(float, pw[j] & 0xffff0000u); cm[j] = c0[j]; cm[4 + j] = c1[j]; }
        if (ISQ) {
#pragma unroll
            for (int j = 0; j < 8; ++j) x[j] *= 0.14433756729740643f; }
    } else if constexpr (TYPE == 1) {
        const float* cp = (const float*)(ws + WS_CUM) + row * NDV + 192 + h * DK + d0; const f32x4 c0 = *(const f32x4*)cp, c1 = *(const f32x4*)(cp + 4);
#pragma unroll
        for (int j = 0; j < 4; ++j) { cm[j] = c0[j]; cm[4 + j] = c1[j]; }
        if (ISQ) { const v4u p = *(const v4u*)(pr + C_HQ + h * DK + d0); const unsigned pw[4] = {p.x, p.y, p.z, p.w};
#pragma unroll
            for (int j = 0; j < 4; ++j) { x[2 * j] = __builtin_bit_cast(float, pw[j] << 16); x[2 * j + 1] = __builtin_bit_cast(float, pw[j] & 0xffff0000u); } }
        else { f32x4 p0 = {0.f, 0.f, 0.f, 0.f}, p1 = {0.f, 0.f, 0.f, 0.f}; if (t > 0) { p0 = *(const f32x4*)(cp - NDV); p1 = *(const f32x4*)(cp - NDV + 4); }
#pragma unroll
            for (int j = 0; j < 4; ++j) { x[j] = -expm1f(c0[j] - p0[j]); x[4 + j] = -expm1f(c1[j] - p1[j]); } }
    } else {
        const int f0 = (d0 < 24) ? d0 : d0 - 24, dp = (d0 < 24) ? d0 + 24 : d0 - 24; const float sg = (d0 < 24) ? -1.f : 1.f;
        const int cb = (ISQ ? C_RQ : C_RK) + h * DK; const v4u p = *(const v4u*)(pr + cb + d0), pp = *(const v4u*)(pr + cb + dp); const unsigned pw[4] = {p.x, p.y, p.z, p.w}, qw[4] = {pp.x, pp.y, pp.z, pp.w};
        const float* rp = (const float*)(ws + WS_ROPE) + row * 48; const f32x4 cs0 = *(const f32x4*)(rp + f0), cs1 = *(const f32x4*)(rp + f0 + 4), sn0 = *(const f32x4*)(rp + 24 + f0), sn1 = *(const f32x4*)(rp + 24 + f0 + 4);
        const float cmv = (float)(t + 1) * ret_lg(h);
#pragma unroll
        for (int j = 0; j < 4; ++j) { const float xa = __builtin_bit_cast(float, pw[j] << 16), xb = __builtin_bit_cast(float, pw[j] & 0xffff0000u), ya = __builtin_bit_cast(float, qw[j] << 16), yb = __builtin_bit_cast(float, qw[j] & 0xffff0000u);
            const float ca = (j < 2) ? cs0[2 * j] : cs1[2 * j - 4], cb2 = (j < 2) ? cs0[2 * j + 1] : cs1[2 * j - 3], sa = (j < 2) ? sn0[2 * j] : sn1[2 * j - 4], sb = (j < 2) ? sn0[2 * j + 1] : sn1[2 * j - 3];
            x[2 * j] = xa * ca + sg * ya * sa; x[2 * j + 1] = xb * cb2 + sg * yb * sb; cm[2 * j] = cmv; cm[2 * j + 1] = cmv; }
        if (ISQ) {
#pragma unroll
            for (int j = 0; j < 8; ++j) x[j] *= 0.14433756729740643f; }
    }
}

template <int TYPE>
__device__ __forceinline__ void mixc_batch(const Args& a, int layer, int unit, LAS unsigned char* lds, int tid, int lane, int wave) {
    typedef MixCfg<TYPE> C; constexpr int DK = C::DK, DV = C::DV, NV = C::NV, TE = DV / 16;
    unsigned char* ws = a.ws; const bf16* PROJ = (const bf16*)(ws + WS_PROJ); bf16* MIX = (bf16*)(ws + WS_MIX);
    LAS bf16* VT = (LAS bf16*)(lds + LC_VT); LAS bf16* ST = (LAS bf16*)(lds + LC_ST); LAS bf16* AB = (LAS bf16*)(lds + LC_AB) + wave * 16 * BP;
    const int row0 = unit * CH;
    stage_vt<NV>(PROJ + (size_t)row0 * NPROJ + C::CV, VT, tid);
    { const bf16* SPu = (const bf16*)(ws + WS_SP) + (size_t)unit * ST_TOT + C::STOFF;
        for (int idx = tid; idx < NV * 8; idx += NTHR) { const int er = idx >> 3, ch = idx & 7; v4u w = {0u, 0u, 0u, 0u}; if (ch * 8 < DK) w = *(const v4u*)(SPu + (size_t)er * DK + ch * 8); *(LAS v4u*)(ST + er * BP + ch * 8) = w; } }
    __syncthreads();
    const int h = wave >> 1, hsel = wave & 1, r = lane & 15, g = lane >> 4;
    const LAS bf16* STh = ST + h * DV * BP; const LAS bf16* VTh = VT + h * DV * BP;
    const float* CUMp = (const float*)(ws + WS_CUM);
    for (int ib = 0; ib < 2; ++ib) { const int I = ib ? 3 - hsel : hsel;
        pg8::bf16x8 qh[2], qt[2]; float refv[2][8];
#pragma unroll
        for (int s = 0; s < 2; ++s) { const int d0 = 32 * s + 8 * g; const bool valid = d0 < DK; const int d0c = valid ? d0 : 0;
            float x[8], cm[8]; mix_frag<TYPE, true>(a, h, (size_t)(row0 + 16 * I + r), 16 * I + r, d0c, x, cm);
            if constexpr (TYPE == 2) {
#pragma unroll
                for (int j = 0; j < 8; ++j) refv[s][j] = (float)(16 * I) * ret_lg(h);
            } else { if (I > 0) { const float* cp = CUMp + (size_t)(row0 + 16 * I - 1) * NDV + C::COFF + h * DK + d0c; const f32x4 c0 = *(const f32x4*)cp, c1 = *(const f32x4*)(cp + 4);
#pragma unroll
                    for (int j = 0; j < 4; ++j) { refv[s][j] = c0[j]; refv[s][4 + j] = c1[j]; } }
                else {
#pragma unroll
                    for (int j = 0; j < 8; ++j) refv[s][j] = 0.f; } }
            float xh[8], xt[8];
#pragma unroll
            for (int j = 0; j < 8; ++j) { xh[j] = valid ? x[j] * __expf(cm[j] - refv[s][j]) : 0.f; xt[j] = valid ? x[j] * __expf(cm[j]) : 0.f; }
            qh[s] = pack8(xh); qt[s] = pack8(xt); }
        for (int J = 0; J <= I; ++J) { f32x4 acc = {0.f, 0.f, 0.f, 0.f};
#pragma unroll
            for (int s = 0; s < 2; ++s) { const int d0 = 32 * s + 8 * g; const bool valid = d0 < DK; const int d0c = valid ? d0 : 0;
                float x[8], cm[8]; mix_frag<TYPE, false>(a, h, (size_t)(row0 + 16 * J + r), 16 * J + r, d0c, x, cm);
                float xk[8];
#pragma unroll
                for (int j = 0; j < 8; ++j) xk[j] = valid ? x[j] * __expf(fminf(refv[s][j] - cm[j], 80.f)) : 0.f;
                acc = __builtin_amdgcn_mfma_f32_16x16x32_bf16(qh[s], pack8(xk), acc, 0, 0, 0); }
#pragma unroll
            for (int q = 0; q < 4; ++q) { const int i = 4 * g + q; const float v = (J < I || r <= i) ? acc[q] : 0.f; AB[i * BP + 16 * J + r] = (bf16)f2bf(v); } }
        if ((I & 1) == 0) {
#pragma unroll
            for (int q = 0; q < 4; ++q) AB[(4 * g + q) * BP + 16 * (I + 1) + r] = (bf16)0; }
        asm volatile("s_waitcnt lgkmcnt(0)" ::: "memory");
        const pg8::bf16x8 ah0 = *(const LAS pg8::bf16x8*)(AB + r * BP + 8 * g), ah1 = *(const LAS pg8::bf16x8*)(AB + r * BP + 32 + 8 * g);
        f32x4 o[TE];
#pragma unroll
        for (int te = 0; te < TE; ++te) { f32x4 acc = {0.f, 0.f, 0.f, 0.f};
            acc = __builtin_amdgcn_mfma_f32_16x16x32_bf16(qt[0], ldfrag(STh, BP, te * 16, 0, lane), acc, 0, 0, 0);
            acc = __builtin_amdgcn_mfma_f32_16x16x32_bf16(qt[1], ldfrag(STh, BP, te * 16, 32, lane), acc, 0, 0, 0);
            acc = __builtin_amdgcn_mfma_f32_16x16x32_bf16(ah0, ldfrag(VTh, BP, te * 16, 0, lane), acc, 0, 0, 0);
            if (I >= 2) acc = __builtin_amdgcn_mfma_f32_16x16x32_bf16(ah1, ldfrag(VTh, BP, te * 16, 32, lane), acc, 0, 0, 0);
            o[te] = acc; }
#pragma unroll
        for (int q = 0; q < 4; ++q) { float s1 = 0.f, s2 = 0.f;
#pragma unroll
            for (int te = 0; te < TE; ++te) { s1 += o[te][q]; s2 += o[te][q] * o[te][q]; }
#pragma unroll
            for (int m = 1; m < 16; m <<= 1) { s1 += __shfl_xor(s1, m); s2 += __shfl_xor(s2, m); }
            const size_t row = (size_t)(row0 + 16 * I + 4 * g + q); const bf16* pr = PROJ + row * NPROJ + C::CG + h * DV; bf16* mo = MIX + row * D + C::MIXOFF + h * DV;
            float mean = 0.f, rstd;
            if constexpr (TYPE == 2) { mean = s1 * (1.0f / DV); rstd = 1.0f / sqrtf(fmaxf(s2 * (1.0f / DV) - mean * mean, 0.f) + EPS); }
            else rstd = 1.0f / sqrtf(s2 * (1.0f / DV) + EPS);
#pragma unroll
            for (int te = 0; te < TE; ++te) { const int e = te * 16 + r; const float gt = bf2f(pr[e]); float v;
                if constexpr (TYPE == 0) v = o[te][q] * rstd * a.gla_norm_w[layer * 384 + h * 96 + e] * (gt / (1.0f + __expf(-gt)));
                else if constexpr (TYPE == 1) v = o[te][q] * rstd * a.hg_norm_w[layer * 256 + h * 64 + e] * (1.0f / (1.0f + __expf(-gt)));
                else v = (o[te][q] - mean) * rstd * (gt / (1.0f + __expf(-gt)));
                mo[e] = (bf16)f2bf(v); } }
    }
    __syncthreads();
}
__device__ __forceinline__ void p3c_outputs(const Args& a, int layer, LAS unsigned char* lds, int vcu, int G, int tid, int lane, int wave) {
    for (int unit = vcu; unit < NUNIT; unit += G) {
        mixc_batch<0>(a, layer, unit, lds, tid, lane, wave);
        mixc_batch<1>(a, layer, unit, lds, tid, lane, wave);
        mixc_batch<2>(a, layer, unit, lds, tid, lane, wave);
    }
}

constexpr int MW_ARGS = 800;
__device__ __forceinline__ const void* ld_argp(const volatile LAS unsigned* T, int i) {
    const unsigned lo = __builtin_amdgcn_readfirstlane(T[2 * i]), hi = __builtin_amdgcn_readfirstlane(T[2 * i + 1]);
    return (const void*)(((unsigned long long)hi << 32) | lo);
}
__device__ __forceinline__ Args load_args(LAS unsigned char* lds) {
    const volatile LAS unsigned* T = (const volatile LAS unsigned*)(lds + MISC_OFF) + MW_ARGS;
    Args a;
    a.x = (const float*)ld_argp(T, 0); a.c = (const float*)ld_argp(T, 1); a.pos = (const int*)ld_argp(T, 2); a.w_mod = (const float*)ld_argp(T, 3); a.b_mod = (const float*)ld_argp(T, 4);
    a.norm1_w = (const float*)ld_argp(T, 5); a.w_in = (const float*)ld_argp(T, 6); a.gla_wa2 = (const float*)ld_argp(T, 7); a.gla_ba2 = (const float*)ld_argp(T, 8); a.hg_lb = (const float*)ld_argp(T, 9);
    a.gla_norm_w = (const float*)ld_argp(T, 10); a.hg_norm_w = (const float*)ld_argp(T, 11); a.w_out = (const float*)ld_argp(T, 12); a.norm2_w = (const float*)ld_argp(T, 13); a.w_r = (const float*)ld_argp(T, 14);
    a.b_r = (const float*)ld_argp(T, 15); a.w_gu = (const float*)ld_argp(T, 16); a.b_gu = (const float*)ld_argp(T, 17); a.w_dn = (const float*)ld_argp(T, 18); a.b_dn = (const float*)ld_argp(T, 19);
    a.final_norm_w = (const float*)ld_argp(T, 20); a.out = (float*)ld_argp(T, 21); a.ws = (unsigned char*)ld_argp(T, 22); a.ph_lo = 0; a.ph_hi = 0;
    return a;
}
#define PH_CTX() { unsigned l_ = (unsigned)(size_t)lds; asm volatile("" : "+s"(l_)); lds = (LAS unsigned char*)(size_t)l_; } const Args args = load_args(lds); volatile LAS unsigned* MISC = (volatile LAS unsigned*)(lds + MISC_OFF); int tid_ = wv * 64 + (int)__builtin_amdgcn_mbcnt_hi(~0u, __builtin_amdgcn_mbcnt_lo(~0u, 0u)); asm volatile("" : "+v"(tid_)); const int tid = tid_, lane = tid & 63, wave = __builtin_amdgcn_readfirstlane(tid >> 6); \
    const int G = gridDim.x; const int bx = blockIdx.x; const int vcu = (G % 8 == 0) ? (bx % 8) * (G / 8) + bx / 8 : bx; unsigned char* ws = args.ws; gu32* ctl = (gu32*)(ws + WS_CTL); \
    (void)MISC; (void)lane; (void)wave; (void)vcu; (void)ctl; (void)bx; (void)tid
__device__ __forceinline__ void ph_p0(LAS unsigned char* lds, int wv) { PH_CTX(); p0_prologue(args, lds, vcu, G, tid, lane, wave); }
__device__ __forceinline__ void ph_p1(LAS unsigned char* lds, int wv, int layer_) { int layer = __builtin_amdgcn_readfirstlane(layer_); asm volatile("" : "+s"(layer)); PH_CTX(); rows_mfma<16>(args, layer, lds, MISC, ctl, vcu, G, tid, lane, wave); }
__device__ __forceinline__ void ph_p2(LAS unsigned char* lds, int wv, int layer_) { int layer = __builtin_amdgcn_readfirstlane(layer_); asm volatile("" : "+s"(layer)); PH_CTX();
    pg8::Gemm g{(const bf16*)(ws + WS_H), (const bf16*)(ws + WS_WIN) + (size_t)layer * NPROJ * D, MTOK, NPROJ, D}; pg8::StaticOrder S; S.init(MTOK, NPROJ, G, bx);
    pg8::EpiBf16Plain E{(bf16*)(ws + WS_PROJ), NPROJ};
    pg8::gemm_phase<pg8::EpiBf16Plain, pg8::StaticOrder, true, true>(lds, g, S, E, tid); }
__device__ __forceinline__ void ph_p3a(LAS unsigned char* lds, int wv, int layer_) { int layer = __builtin_amdgcn_readfirstlane(layer_); asm volatile("" : "+s"(layer)); PH_CTX(); p3a_summaries(args, layer, lds, vcu, G, tid, lane, wave); }
__device__ __forceinline__ void ph_p3b(LAS unsigned char* lds, int wv) { PH_CTX(); p3b_scan(args, vcu, G, tid); }
__device__ __forceinline__ void ph_p3c(LAS unsigned char* lds, int wv, int layer_) { int layer = __builtin_amdgcn_readfirstlane(layer_); asm volatile("" : "+s"(layer)); PH_CTX(); p3c_outputs(args, layer, lds, vcu, G, tid, lane, wave); }
__device__ __forceinline__ void ph_p4(LAS unsigned char* lds, int wv, int layer_) { int layer = __builtin_amdgcn_readfirstlane(layer_); asm volatile("" : "+s"(layer)); PH_CTX();
    pg8::Gemm g{(const bf16*)(ws + WS_MIX), (const bf16*)(ws + WS_WOUT) + (size_t)layer * D * D, MTOK, D, D}; pg8::StaticOrder S; S.init(MTOK, D, G, bx);
    pg8::EpiResGate E{(layer == 0) ? args.x : (const float*)(ws + WS_X), (float*)(ws + WS_X), D, (const float*)(ws + WS_MOD) + (size_t)layer * 2 * 6144 + 2 * D, 6144, SEQ};
    pg8::gemm_phase<pg8::EpiResGate, pg8::StaticOrder, true, true>(lds, g, S, E, tid); }
__device__ __forceinline__ void ph_p5(LAS unsigned char* lds, int wv, int layer_) { int layer = __builtin_amdgcn_readfirstlane(layer_); asm volatile("" : "+s"(layer)); PH_CTX(); rows_mfma<32>(args, layer, lds, MISC, ctl, vcu, G, tid, lane, wave); }
__device__ __forceinline__ void ph_p6(LAS unsigned char* lds, int wv, int layer_) { int layer = __builtin_amdgcn_readfirstlane(layer_); asm volatile("" : "+s"(layer)); PH_CTX(); p6_dispatch(args, layer, MISC, ctl, vcu, G, tid, lane, wave); }
__device__ __forceinline__ void ph_p7(LAS unsigned char* lds, int wv, int layer_) { int layer = __builtin_amdgcn_readfirstlane(layer_); asm volatile("" : "+s"(layer)); PH_CTX();
    moe_tables(ctl, layer, MISC, tid);
    const int nrt = __builtin_amdgcn_readfirstlane((int)MISC[MW_NRT]);
    pg8::Gemm g{(const bf16*)(ws + WS_A1), (const bf16*)(ws + WS_WGU + (size_t)layer * NE * 2048 * D), nrt * 256, NE * 2048, D / 2};
    pg8::MoeOrder S{8, G, vcu, nrt * 8, (const LAS int*)(lds + MISC_OFF + 4 * MW_TILE)};
    pg8::EpiSwiglu E{ws + WS_ACT, FFN, args.b_gu + (size_t)layer * NE * 2048, 1.0f / (S8_H * S8_W), S8_A};
    pg8::gemm_phase<pg8::EpiSwiglu, pg8::MoeOrder, true, true, true>(lds, g, S, E, tid); }
__device__ __forceinline__ void ph_p8(LAS unsigned char* lds, int wv, int layer_) { int layer = __builtin_amdgcn_readfirstlane(layer_); asm volatile("" : "+s"(layer)); PH_CTX();
    moe_tables(ctl, layer, MISC, tid);
    const int nrt = __builtin_amdgcn_readfirstlane((int)MISC[MW_NRT]);
    pg8::Gemm g{(const bf16*)(ws + WS_ACT), (const bf16*)(ws + WS_WDN + (size_t)layer * NE * D * FFN), nrt * 256, NE * D, FFN / 2};
    pg8::MoeOrder S{4, G, vcu, nrt * 4, (const LAS int*)(lds + MISC_OFF + 4 * MW_TILE)};
    pg8::EpiBf16Bias E{(bf16*)(ws + WS_Y), D, args.b_dn + (size_t)layer * NE * D, D, 1.0f / (S8_A * S8_W)};
    pg8::gemm_phase<pg8::EpiBf16Bias, pg8::MoeOrder, true, true, true>(lds, g, S, E, tid); }
__device__ __forceinline__ void ph_final(LAS unsigned char* lds, int wv) { PH_CTX(); final_rows(args, lds, vcu, G, tid, lane); }

#ifndef DBL_MASK
#define DBL_MASK 0
#endif
#if DBL_MASK
#define RUN(bit, call) do { if ((DBL_MASK >> (bit)) & 1) { const unsigned long long t0_ = __builtin_amdgcn_s_memrealtime(); call; const unsigned long long t1_ = __builtin_amdgcn_s_memrealtime(); \
        while (__builtin_amdgcn_s_memrealtime() - t1_ < t1_ - t0_) __builtin_amdgcn_s_sleep(8); } else { call; } } while (0)
#else
#define RUN(bit, call) do { call; } while (0)
#endif
__global__ void __launch_bounds__(NTHR, 2) hybrid_fwd(Args args) {
    extern __shared__ __attribute__((aligned(16))) unsigned char lds_raw[];
    LAS unsigned char* lds = (LAS unsigned char*)lds_raw;
    volatile LAS unsigned* MISC = (volatile LAS unsigned*)(lds + MISC_OFF);
    const int tid = threadIdx.x; const int wv = __builtin_amdgcn_readfirstlane(tid >> 6);
    gu32* ctl = (gu32*)(args.ws + WS_CTL);
    for (int u = tid; u < (LDS_BYTES - MISC_OFF) / 4; u += NTHR) MISC[u] = 0u;
    __syncthreads();
    if (tid == 0) {
#define ST_ARG(i, p) do { const unsigned long long v_ = (unsigned long long)(p); MISC[MW_ARGS + 2 * (i)] = (unsigned)v_; MISC[MW_ARGS + 2 * (i) + 1] = (unsigned)(v_ >> 32); } while (0)
        ST_ARG(0, args.x); ST_ARG(1, args.c); ST_ARG(2, args.pos); ST_ARG(3, args.w_mod); ST_ARG(4, args.b_mod); ST_ARG(5, args.norm1_w); ST_ARG(6, args.w_in); ST_ARG(7, args.gla_wa2); ST_ARG(8, args.gla_ba2);
        ST_ARG(9, args.hg_lb); ST_ARG(10, args.gla_norm_w); ST_ARG(11, args.hg_norm_w); ST_ARG(12, args.w_out); ST_ARG(13, args.norm2_w); ST_ARG(14, args.w_r); ST_ARG(15, args.b_r); ST_ARG(16, args.w_gu);
        ST_ARG(17, args.b_gu); ST_ARG(18, args.w_dn); ST_ARG(19, args.b_dn); ST_ARG(20, args.final_norm_w); ST_ARG(21, args.out); ST_ARG(22, args.ws);
#undef ST_ARG
    }
    __syncthreads();
    const int lo = args.ph_lo, hi = args.ph_hi;
    const bool multi = (hi - lo) > 1;
    XcdBarrier bar; bar.bar = (unsigned*)(ctl + CW_BAR); bar.x = 0; bar.st = nullptr;
    if (multi) bar = xcd_barrier_post((unsigned*)(ctl + CW_BAR), MISC + MW_BAR);
#define IN(k) (lo <= (k) && (k) < hi)
#define SEAM(k) do { if (IN(k) && IN((k) + 1)) xcd_barrier(bar); } while (0)

    if (IN(0)) RUN(0, ph_p0(lds, wv));
    SEAM(0);
    for (int layer = 0; layer < DEPTH; ++layer) {
        const int pb = 1 + 10 * layer;
        if (IN(pb + 0)) RUN(1, ph_p1(lds, wv, layer));
        SEAM(pb + 0);
        if (IN(pb + 1)) RUN(2, ph_p2(lds, wv, layer));
        SEAM(pb + 1);
        if (IN(pb + 2)) RUN(3, ph_p3a(lds, wv, layer));
        SEAM(pb + 2);
        if (IN(pb + 3)) RUN(4, ph_p3b(lds, wv));
        SEAM(pb + 3);
        if (IN(pb + 4)) RUN(5, ph_p3c(lds, wv, layer));
        SEAM(pb + 4);
        if (IN(pb + 5)) RUN(6, ph_p4(lds, wv, layer));
        SEAM(pb + 5);
        if (IN(pb + 6)) RUN(7, ph_p5(lds, wv, layer));
        SEAM(pb + 6);
        if (IN(pb + 7)) RUN(8, ph_p6(lds, wv, layer));
        SEAM(pb + 7);
        if (IN(pb + 8)) RUN(9, ph_p7(lds, wv, layer));
        SEAM(pb + 8);
        if (IN(pb + 9)) RUN(10, ph_p8(lds, wv, layer));
        SEAM(pb + 9);
    }
    if (IN(NPHASE - 1)) RUN(11, ph_final(lds, wv));
#undef IN
#undef SEAM
}

#ifndef MK_SINGLE
#define MK_SINGLE 1
#endif
extern "C" void kernel_launch(void* const* d_in, const int* in_sizes, int n_in, void* d_out, int out_size, void* d_ws, size_t ws_size, hipStream_t stream) {
    static int grid = 0;
    if (grid == 0) {
        if (n_in != 21 || in_sizes[0] != MTOK * D || out_size != MTOK * D || ws_size < WS_END) { fprintf(stderr, "kernel_launch: unexpected problem shape (n_in %d, in0 %d, out %d, ws %zu)\n", n_in, n_in > 0 ? in_sizes[0] : -1, out_size, ws_size); grid = -1; return; }
        int dev = 0, cus = 0, per_cu = 0;
        if (hipGetDevice(&dev) != hipSuccess || hipDeviceGetAttribute(&cus, hipDeviceAttributeMultiprocessorCount, dev) != hipSuccess) { grid = -1; return; }
        if (hipFuncSetAttribute((const void*)hybrid_fwd, hipFuncAttributeMaxDynamicSharedMemorySize, LDS_BYTES) != hipSuccess) { fprintf(stderr, "kernel_launch: hipFuncSetAttribute failed\n"); grid = -1; return; }
        if (hipOccupancyMaxActiveBlocksPerMultiprocessor(&per_cu, (const void*)hybrid_fwd, NTHR, LDS_BYTES) != hipSuccess || per_cu < 1) fprintf(stderr, "kernel_launch: occupancy query says %d\n", per_cu);
        (void)hipGetLastError();
        grid = cus;
    }
    if (grid < 0) return;
    (void)hipMemsetAsync((char*)d_ws + WS_CTL, 0, CTL_ZERO_BYTES, stream);
    Args a{};
    a.x = (const float*)d_in[0]; a.c = (const float*)d_in[1]; a.pos = (const int*)d_in[2]; a.w_mod = (const float*)d_in[3]; a.b_mod = (const float*)d_in[4]; a.norm1_w = (const float*)d_in[5];
    a.w_in = (const float*)d_in[6]; a.gla_wa2 = (const float*)d_in[7]; a.gla_ba2 = (const float*)d_in[8]; a.hg_lb = (const float*)d_in[9]; a.gla_norm_w = (const float*)d_in[10]; a.hg_norm_w = (const float*)d_in[11];
    a.w_out = (const float*)d_in[12]; a.norm2_w = (const float*)d_in[13]; a.w_r = (const float*)d_in[14]; a.b_r = (const float*)d_in[15]; a.w_gu = (const float*)d_in[16]; a.b_gu = (const float*)d_in[17];
    a.w_dn = (const float*)d_in[18]; a.b_dn = (const float*)d_in[19]; a.final_norm_w = (const float*)d_in[20]; a.out = (float*)d_out; a.ws = (unsigned char*)d_ws;
#if MK_SINGLE
    a.ph_lo = 0; a.ph_hi = NPHASE;
    hipLaunchKernelGGL(hybrid_fwd, dim3(grid), dim3(NTHR), LDS_BYTES, stream, a);
#else
    for (int p = 0; p < NPHASE; ++p) { a.ph_lo = p; a.ph_hi = p + 1; hipLaunchKernelGGL(hybrid_fwd, dim3(grid), dim3(NTHR), LDS_BYTES, stream, a); }
#endif
}
```

```cpp
#include <hip/hip_runtime.h>
#include <cstdio>
#include <cstdint>
namespace pg8 {
#define PG8_LAS __attribute__((address_space(3)))
typedef unsigned short bf16_t;
typedef short bf16x8 __attribute__((ext_vector_type(8)));
typedef float f32x4 __attribute__((ext_vector_type(4)));
typedef unsigned u32x4 __attribute__((ext_vector_type(4)));
constexpr int BM = 256, BK = 64, HALF = 128, HTB = HALF * BK * 2  , STAGE_BYTES = 8 * HTB, NXCD = 8, WGM = 8;

__host__ __device__ __forceinline__ int lds_byte(int r, int c) { const int st = (r >> 4) * 2 + (c >> 5), rr = r & 15, cc = c & 31, ob = rr * 64 + cc * 2; return st * 1024 + (ob ^ (((ob >> 9) & 1) << 5)); }
__host__ __device__ __forceinline__ void stage_rc(int b, int& R, int& C) { const int st = b / 1024, sb = b % 1024, swz = sb ^ (((sb >> 9) & 1) << 5); R = (st >> 1) * 16 + swz / 64; C = (st & 1) * 32 + (swz % 64) / 2; }
__host__ __device__ __forceinline__ int perm32(int rho) { const int n = rho >> 4, i = rho & 15; return 8 * (i >> 2) + 4 * n + (i & 3); }

struct Unit { int pm, pn, e, pl; };
struct Gemm { const bf16_t* A; const bf16_t* Bt; int M, N, K; };

struct StaticOrder {
    int nM, nN, nwg, G, c;
    __host__ __device__ void init(int M, int N, int G_, int c_) { nM = M / BM; nN = N / BM; nwg = nM * nN; G = G_; c = c_; }
    __host__ __device__ bool next(int i, Unit& u) const {
        const long L = (long)i * G + c; if (L >= nwg) return false;
        int wgid = (int)L; { const int q = nwg / NXCD, r = nwg % NXCD, xcd = wgid % NXCD, off = wgid / NXCD; wgid = (xcd < r ? xcd * (q + 1) : r * (q + 1) + (xcd - r) * q) + off; }
        const int nig = WGM * nN, gid = wgid / nig, fm = gid * WGM, gsz = (nM - fm) < WGM ? (nM - fm) : WGM;
        u.pm = fm + ((wgid % nig) % gsz); u.pn = (wgid % nig) / gsz; u.e = 0; u.pl = u.pn; return true;
    }
    __device__ __forceinline__ void a_ready(const Unit&) const {}
    __device__ __forceinline__ void done(const Unit&) const {}
};

__device__ __forceinline__ unsigned cvt_pk_bf16(float lo, float hi) { unsigned r; asm volatile("v_cvt_pk_bf16_f32 %0, %1, %2" : "=v"(r) : "v"(lo), "v"(hi)); return r; }

struct EpiBf16Plain {
    static constexpr bool PERM = true, AFTER_DRAIN = false;
    bf16_t* O; int ldc; float sc;
    __device__ __forceinline__ void operator()(const f32x4 (&acc)[2][2][4][2], const Unit& u, int wr, int wc, int fr, int fq) const {
        const int row0 = u.pm * BM + wr * 64 + fr; const int col0 = u.pn * BM + wc * 32 + 8 * fq;
#pragma unroll
        for (int ai = 0; ai < 2; ++ai)
#pragma unroll
            for (int m = 0; m < 4; ++m) { bf16_t* rowp = O + (size_t)(row0 + ai * HALF + m * 16) * ldc + col0;
#pragma unroll
                for (int bj = 0; bj < 2; ++bj) { const f32x4 v0 = acc[ai][bj][m][0] * sc, v1 = acc[ai][bj][m][1] * sc;
                    u32x4 w; w.x = cvt_pk_bf16(v0[0], v0[1]); w.y = cvt_pk_bf16(v0[2], v0[3]); w.z = cvt_pk_bf16(v1[0], v1[1]); w.w = cvt_pk_bf16(v1[2], v1[3]);
                    *(u32x4*)(rowp + bj * HALF) = w; } }
    }
};
struct EpiResGate {
    static constexpr bool PERM = false, AFTER_DRAIN = false;
    const float* base; float* out; int ldc; const float* gate; int gpitch; int rows_per_batch; float sc;
    __device__ __forceinline__ void operator()(const f32x4 (&acc)[2][2][4][2], const Unit& u, int wr, int wc, int fr, int fq) const {
        const int row0 = u.pm * BM + wr * 64 + fr, col0 = u.pn * BM + wc * 32 + 4 * fq;
        const float* gp = gate + (size_t)((u.pm * BM) / rows_per_batch) * gpitch + col0;
        f32x4 gv[2][2];
#pragma unroll
        for (int bj = 0; bj < 2; ++bj)
#pragma unroll
            for (int n = 0; n < 2; ++n) gv[bj][n] = *(const f32x4*)(gp + bj * HALF + n * 16) * sc;
#pragma unroll
        for (int ai = 0; ai < 2; ++ai)
#pragma unroll
            for (int m = 0; m < 4; ++m) { const size_t off = (size_t)(row0 + ai * HALF + m * 16) * ldc + col0;
#pragma unroll
                for (int bj = 0; bj < 2; ++bj)
#pragma unroll
                    for (int n = 0; n < 2; ++n) { const f32x4 bs = *(const f32x4*)(base + off + bj * HALF + n * 16);
                        *(f32x4*)(out + off + bj * HALF + n * 16) = bs + gv[bj][n] * acc[ai][bj][m][n]; }
                asm volatile("" ::: "memory"); }
    }
};
struct EpiSwiglu {
    static constexpr bool PERM = true, AFTER_DRAIN = false;
    unsigned char* O; int ldc; const float* bias; float inv_in, out_scale;
    __device__ __forceinline__ float act1(float g, float up) const {
        g = fminf(g, 7.0f); up = fminf(fmaxf(up, -7.0f), 7.0f);
        const float s = 1.0f / (1.0f + __expf(-1.702f * g));
        return fminf(fmaxf((up + 1.0f) * g * s * out_scale, -448.f), 448.f);
    }
    __device__ __forceinline__ void operator()(const f32x4 (&acc)[2][2][4][2], const Unit& u, int wr, int wc, int fr, int fq) const {
        const int row0 = u.pm * BM + wr * 64 + fr; const int jj0 = wc * 32 + 8 * fq; const int col0 = u.pl * HALF + jj0;
        const float* bp = bias + (size_t)u.e * 2048 + col0;
        f32x4 bg[2], bu[2];
#pragma unroll
        for (int n = 0; n < 2; ++n) { bg[n] = *(const f32x4*)(bp + 4 * n); bu[n] = *(const f32x4*)(bp + 1024 + 4 * n); }
#pragma unroll
        for (int ai = 0; ai < 2; ++ai)
#pragma unroll
            for (int m = 0; m < 4; ++m) { unsigned char* rowp = O + (size_t)(row0 + ai * HALF + m * 16) * ldc + col0;
                f32x4 r[2];
#pragma unroll
                for (int n = 0; n < 2; ++n) { const f32x4 g = acc[ai][0][m][n] * inv_in + bg[n], up = acc[ai][1][m][n] * inv_in + bu[n];
#pragma unroll
                    for (int j = 0; j < 4; ++j) r[n][j] = act1(g[j], up[j]); }
                int w0 = 0, w1 = 0;
                w0 = __builtin_amdgcn_cvt_pk_fp8_f32(r[0][0], r[0][1], w0, false); w0 = __builtin_amdgcn_cvt_pk_fp8_f32(r[0][2], r[0][3], w0, true);
                w1 = __builtin_amdgcn_cvt_pk_fp8_f32(r[1][0], r[1][1], w1, false); w1 = __builtin_amdgcn_cvt_pk_fp8_f32(r[1][2], r[1][3], w1, true);
                typedef int i32x2 __attribute__((ext_vector_type(2))); *(i32x2*)rowp = (i32x2){w0, w1}; }
    }
};
struct EpiBf16Bias {
    static constexpr bool PERM = true, AFTER_DRAIN = false;
    bf16_t* O; int ldc; const float* bias; int bpitch; float inv_in;
    __device__ __forceinline__ void operator()(const f32x4 (&acc)[2][2][4][2], const Unit& u, int wr, int wc, int fr, int fq) const {
        const int row0 = u.pm * BM + wr * 64 + fr; const int col0 = u.pl * BM + wc * 32 + 8 * fq;
        const float* bp = bias + (size_t)u.e * bpitch + col0;
        f32x4 bv[2][2];
#pragma unroll
        for (int bj = 0; bj < 2; ++bj)
#pragma unroll
            for (int n = 0; n < 2; ++n) bv[bj][n] = *(const f32x4*)(bp + bj * HALF + 4 * n);
#pragma unroll
        for (int ai = 0; ai < 2; ++ai)
#pragma unroll
            for (int m = 0; m < 4; ++m) { bf16_t* rowp = O + (size_t)(row0 + ai * HALF + m * 16) * ldc + col0;
#pragma unroll
                for (int bj = 0; bj < 2; ++bj) { const f32x4 v0 = acc[ai][bj][m][0] * inv_in + bv[bj][0], v1 = acc[ai][bj][m][1] * inv_in + bv[bj][1];
                    u32x4 w; w.x = cvt_pk_bf16(v0[0], v0[1]); w.y = cvt_pk_bf16(v0[2], v0[3]); w.z = cvt_pk_bf16(v1[0], v1[1]); w.w = cvt_pk_bf16(v1[2], v1[3]);
                    *(u32x4*)(rowp + bj * HALF) = w; } }
    }
};
struct MoeOrder {
    int nN, G, c, nunits; const PG8_LAS int* tile_e;
    __device__ __forceinline__ bool next(int i, Unit& u) const {
        const int L = i * G + c; if (L >= nunits) return false;
        const int pm = L / nN, pl = L - pm * nN, e = __builtin_amdgcn_readfirstlane(tile_e[pm]);
        u.pm = pm; u.pl = pl; u.e = e; u.pn = e * nN + pl; return true;
    }
    __device__ __forceinline__ void a_ready(const Unit&) const {}
    __device__ __forceinline__ void done(const Unit&) const {}
};
typedef int v4i32_t __attribute__((ext_vector_type(4)));
typedef int v8i32_t __attribute__((ext_vector_type(8)));
template <class Epi, class Sched, bool ALIGN_EPI = false, bool SP2 = false, bool FP8 = false>
__device__ __forceinline__ void gemm_phase(PG8_LAS unsigned char* lds, const Gemm g, const Sched& S, const Epi& E, int tid_in) {
    int tid_ = tid_in; asm volatile("" : "+v"(tid_)); const int tid = tid_, wid = __builtin_amdgcn_readfirstlane(tid >> 6), lane = tid & 63, wr = wid >> 2, wc = wid & 3, fr = lane & 15, fq = lane >> 4;
    const int K = g.K, nt = K / BK;
    unsigned voffA, voffB;
    { int R, C; stage_rc(tid * 16, R, C); const int Rb = Epi::PERM ? ((R & ~31) + perm32(R & 31)) : R;
        voffA = (unsigned)(R * K + C) * 2u; voffB = (unsigned)(Rb * K + C) * 2u; }
    const size_t rstep = (size_t)64 * K * 2;
    const size_t kstep = (size_t)(BK * 2);
    const size_t hstep = (size_t)HALF * K * 2;
    const size_t tstep = 2 * hstep;
    const unsigned ldsw = (unsigned)wid * 1024u;
    const int aoff = lds_byte(wr * 64 + fr, fq * 8), boff = lds_byte(wc * 32 + fr, fq * 8);
#define PG8_SA(b, h) (((b) * 2 + (h)) * HTB)
#define PG8_SB(b, h) ((4 + (b) * 2 + (h)) * HTB)
#define PG8_STAGE(bufoff, gbase, voff) do { _Pragma("unroll") for (int _i = 0; _i < 2; ++_i) \
        __builtin_amdgcn_global_load_lds((const unsigned*)((const char*)(gbase) + _i * rstep + (voff)), (PG8_LAS unsigned*)(lds + (bufoff) + ldsw + _i * 8192), 16, 0, 0); } while (0)
#define PG8_LDA(dst, b, h) do { _Pragma("unroll") for (int m = 0; m < 4; ++m) _Pragma("unroll") for (int k = 0; k < 2; ++k) dst[m][k] = *(const PG8_LAS bf16x8*)(lds + PG8_SA(b, h) + aoff + m * 2048 + k * 1024); } while (0)
#define PG8_LDB(dst, b, h) do { _Pragma("unroll") for (int n = 0; n < 2; ++n) _Pragma("unroll") for (int k = 0; k < 2; ++k) dst[n][k] = *(const PG8_LAS bf16x8*)(lds + PG8_SB(b, h) + boff + n * 2048 + k * 1024); } while (0)
#define PG8_MMA(ai, bj, At, Bt) do { __builtin_amdgcn_s_setprio(1); _Pragma("unroll") for (int m = 0; m < 4; ++m) _Pragma("unroll") for (int n = 0; n < 2; ++n) { \
        if constexpr (FP8) { const v8i32_t a8_ = __builtin_shufflevector(__builtin_bit_cast(v4i32_t, At[m][0]), __builtin_bit_cast(v4i32_t, At[m][1]), 0, 1, 2, 3, 4, 5, 6, 7); \
            const v8i32_t b8_ = __builtin_shufflevector(__builtin_bit_cast(v4i32_t, Bt[n][0]), __builtin_bit_cast(v4i32_t, Bt[n][1]), 0, 1, 2, 3, 4, 5, 6, 7); \
            asm volatile("v_mfma_scale_f32_16x16x128_f8f6f4 %0, %1, %2, %0, %3, %3 op_sel_hi:[0,0,0]" : "+v"(acc[ai][bj][m][n]) : "v"(b8_), "v"(a8_), "v"(one8_)); } \
        else { _Pragma("unroll") for (int k = 0; k < 2; ++k) acc[ai][bj][m][n] = __builtin_amdgcn_mfma_f32_16x16x32_bf16(Bt[n][k], At[m][k], acc[ai][bj][m][n], 0, 0, 0); } } \
        __builtin_amdgcn_s_setprio(0); } while (0)
#define PG8_WAIT_V(n) asm volatile("s_waitcnt vmcnt(" #n ")" ::: "memory")
#define PG8_WAIT_L(n) asm volatile("s_waitcnt lgkmcnt(" #n ")" ::: "memory")
#define PG8_BAR __builtin_amdgcn_s_barrier()
#define PG8_SCHED __builtin_amdgcn_sched_barrier(0)
    Unit cur, nxt; int ui = 0;
    if (!S.next(0, cur)) return;
    f32x4 acc[2][2][4][2];
#pragma unroll
    for (int a = 0; a < 2; ++a)
#pragma unroll
        for (int b = 0; b < 2; ++b)
#pragma unroll
            for (int m = 0; m < 4; ++m)
#pragma unroll
                for (int n = 0; n < 2; ++n) acc[a][b][m][n] = (f32x4){0.f, 0.f, 0.f, 0.f};
    bf16x8 At[4][2], B0[2][2], B1[2][2];
    int one8_ = 0x7f7f7f7f; asm volatile("" : "+v"(one8_));
    const char* cA = (const char*)g.A + (size_t)cur.pm * tstep; const char* cB = (const char*)g.Bt + (size_t)cur.pn * tstep;
    S.a_ready(cur);
    if constexpr (SP2) {
        PG8_STAGE(PG8_SB(0, 0), cB, voffB); PG8_STAGE(PG8_SB(0, 1), cB + hstep, voffB); PG8_STAGE(PG8_SA(0, 0), cA, voffA); PG8_STAGE(PG8_SA(0, 1), cA + hstep, voffA);
        if (wr == 1) PG8_BAR;
        PG8_WAIT_V(2); PG8_BAR;
        PG8_STAGE(PG8_SB(1, 0), cB + kstep, voffB); PG8_STAGE(PG8_SA(1, 0), cA + kstep, voffA); PG8_STAGE(PG8_SB(1, 1), cB + hstep + kstep, voffB);
        PG8_WAIT_V(6); PG8_BAR;
    } else {
        PG8_STAGE(PG8_SB(0, 0), cB, voffB); PG8_STAGE(PG8_SA(0, 0), cA, voffA); PG8_STAGE(PG8_SB(0, 1), cB + hstep, voffB); PG8_STAGE(PG8_SA(0, 1), cA + hstep, voffA);
        if (wr == 1) PG8_BAR;
        PG8_WAIT_V(4); PG8_BAR;
        PG8_STAGE(PG8_SB(1, 0), cB + kstep, voffB); PG8_STAGE(PG8_SA(1, 0), cA + kstep, voffA); PG8_STAGE(PG8_SB(1, 1), cB + hstep + kstep, voffB);
        PG8_WAIT_V(6); PG8_BAR;
    }
    for (;;) {
        const bool has_next = S.next(ui + 1, nxt);
        const char* nA = has_next ? (const char*)g.A + (size_t)nxt.pm * tstep : cA; const char* nB = has_next ? (const char*)g.Bt + (size_t)nxt.pn * tstep : cB;
#pragma unroll 1
        for (int t = 0; t < nt; t += 2) {
            const bool last = (t == nt - 2);
            const char* a1 = cA + (size_t)(t + 1) * kstep;
            const char* a2 = last ? nA : cA + (size_t)(t + 2) * kstep; const char* b2 = last ? nB : cB + (size_t)(t + 2) * kstep;
            const char* a3 = a2 + kstep; const char* b3 = b2 + kstep;
            if (last && has_next) S.a_ready(nxt);
            if constexpr (SP2) {
            PG8_LDB(B0, 0, 0); PG8_LDB(B1, 0, 1); PG8_SCHED; PG8_LDA(At, 0, 0); PG8_STAGE(PG8_SA(1, 1), a1 + hstep, voffA);
            PG8_WAIT_V(8); PG8_WAIT_L(0); PG8_BAR; PG8_MMA(0, 0, At, B0); PG8_MMA(0, 1, At, B1); PG8_BAR; PG8_SCHED;
            PG8_LDA(At, 0, 1); PG8_STAGE(PG8_SB(0, 0), b2, voffB); PG8_STAGE(PG8_SB(0, 1), b2 + hstep, voffB); PG8_STAGE(PG8_SA(0, 0), a2, voffA);
            PG8_WAIT_V(8); PG8_WAIT_L(0); PG8_BAR; PG8_MMA(1, 0, At, B0); PG8_MMA(1, 1, At, B1); PG8_BAR; PG8_SCHED;
            PG8_LDB(B0, 1, 0); PG8_LDB(B1, 1, 1); PG8_SCHED; PG8_LDA(At, 1, 0); PG8_STAGE(PG8_SA(0, 1), a2 + hstep, voffA);
            PG8_WAIT_V(8); PG8_WAIT_L(0); PG8_BAR; PG8_MMA(0, 0, At, B0); PG8_MMA(0, 1, At, B1); PG8_BAR; PG8_SCHED;
            PG8_LDA(At, 1, 1); PG8_STAGE(PG8_SB(1, 0), b3, voffB); PG8_STAGE(PG8_SB(1, 1), b3 + hstep, voffB); PG8_STAGE(PG8_SA(1, 0), a3, voffA);
            PG8_WAIT_V(8); PG8_WAIT_L(0); PG8_BAR; PG8_MMA(1, 0, At, B0); PG8_MMA(1, 1, At, B1); PG8_BAR; PG8_SCHED;
            } else {
            PG8_LDB(B0, 0, 0); PG8_SCHED; PG8_LDA(At, 0, 0); PG8_STAGE(PG8_SA(1, 1), a1 + hstep, voffA);
            PG8_WAIT_L(8); PG8_BAR; PG8_WAIT_L(0); PG8_MMA(0, 0, At, B0); PG8_BAR; PG8_SCHED;
            PG8_LDB(B1, 0, 1); PG8_STAGE(PG8_SB(0, 0), b2, voffB);
            PG8_BAR; PG8_WAIT_L(0); PG8_MMA(0, 1, At, B1); PG8_BAR;
            PG8_LDA(At, 0, 1); PG8_STAGE(PG8_SA(0, 0), a2, voffA);
            PG8_BAR; PG8_WAIT_L(0); PG8_MMA(1, 0, At, B0); PG8_BAR; PG8_SCHED;
            PG8_STAGE(PG8_SB(0, 1), b2 + hstep, voffB);
            PG8_WAIT_V(6); PG8_BAR; PG8_MMA(1, 1, At, B1); PG8_BAR;
            PG8_LDB(B0, 1, 0); PG8_SCHED; PG8_LDA(At, 1, 0); PG8_STAGE(PG8_SA(0, 1), a2 + hstep, voffA);
            PG8_WAIT_L(8); PG8_BAR; PG8_WAIT_L(0); PG8_MMA(0, 0, At, B0); PG8_BAR; PG8_SCHED;
            PG8_LDB(B1, 1, 1); PG8_STAGE(PG8_SB(1, 0), b3, voffB);
            PG8_BAR; PG8_WAIT_L(0); PG8_MMA(0, 1, At, B1); PG8_BAR;
            PG8_LDA(At, 1, 1); PG8_STAGE(PG8_SA(1, 0), a3, voffA);
            PG8_BAR; PG8_WAIT_L(0); PG8_MMA(1, 0, At, B0); PG8_BAR; PG8_SCHED;
            PG8_STAGE(PG8_SB(1, 1), b3 + hstep, voffB);
            PG8_WAIT_V(6); PG8_BAR; PG8_MMA(1, 1, At, B1); PG8_BAR;
            }
        }
        if constexpr (FP8) asm volatile("s_nop 7\n\ts_nop 7" ::: "memory");
        if constexpr (ALIGN_EPI) { if (wr == 0) PG8_BAR; }
        if constexpr (!Epi::AFTER_DRAIN) { int ln_ = (int)__builtin_amdgcn_mbcnt_hi(~0u, __builtin_amdgcn_mbcnt_lo(~0u, 0u)); asm volatile("" : "+v"(ln_)); E(acc, cur, wr, wc, ln_ & 15, ln_ >> 4); S.done(cur); }
        if (!has_next) break;
#pragma unroll
        for (int a = 0; a < 2; ++a)
#pragma unroll
            for (int b = 0; b < 2; ++b)
#pragma unroll
                for (int m = 0; m < 4; ++m)
#pragma unroll
                    for (int n = 0; n < 2; ++n) acc[a][b][m][n] = (f32x4){0.f, 0.f, 0.f, 0.f};
        cur = nxt; cA = nA; cB = nB; ++ui;
        if constexpr (ALIGN_EPI) { if (wr == 1) PG8_BAR; }
    }
    PG8_WAIT_V(0);
    if constexpr (!ALIGN_EPI) { if (wr == 0) PG8_BAR; }
    PG8_BAR;
    if constexpr (Epi::AFTER_DRAIN) { E.fused(acc, cur, wr, wc, fr, fq, lds, wid, lane); S.done(cur); }
#undef PG8_SA
#undef PG8_SB
#undef PG8_STAGE
#undef PG8_LDA
#undef PG8_LDB
#undef PG8_MMA
#undef PG8_WAIT_V
#undef PG8_WAIT_L
#undef PG8_BAR
#undef PG8_SCHED
}
}

constexpr int NWAVES = 8, NTHR = 512;
constexpr int BATCH = 2, SEQ = 8192, D = 1024, DEPTH = 4, MTOK = BATCH * SEQ;
constexpr int DIN = 3344, NPROJ = 3328, SRC_GA = 1152;
constexpr int C_GQ = 0, C_GK = 192, C_GV = 384, C_GG = 768, C_HQ = 1152, C_HF = 1408, C_HI = 1664, C_HG = 1920, C_RQ = 2176, C_RK = 2368, C_RV = 2560, C_RG = 2944;
constexpr int NE = 32, FFN = 1024;
constexpr int CH = 64, NCH = SEQ / CH, NUNIT = BATCH * NCH;
constexpr int ST_GLA = 0, ST_HG = 4 * 48 * 96, ST_RET = ST_HG + 4 * 64 * 64, ST_TOT = ST_RET + 4 * 48 * 96;
constexpr int NDV = 448;
constexpr int MAXROWS = 65536 + NE * 256, MAXRT = MAXROWS / 256;
constexpr float EPS = 1e-6f;
#ifndef F8_IN_V
#define F8_IN_V false
#endif
#ifndef F8_OUT_V
#define F8_OUT_V false
#endif
constexpr bool F8_IN = F8_IN_V, F8_OUT = F8_OUT_V;
constexpr float S8_M = 32.f;
constexpr float S8_W = 2048.f, S8_H = 64.f, S8_A = 8.f;
constexpr int NPHASE = 42;

constexpr size_t MiB = 1u << 20;
constexpr size_t WS_CTL = 0, CTL_ZERO_BYTES = 65536;
constexpr size_t WS_MOD = 1 * MiB;
constexpr size_t WS_ROPE = 2 * MiB;
constexpr size_t WS_LB = 5 * MiB;
constexpr size_t WS_WIN = 8 * MiB;
constexpr size_t WS_WOUT = 34 * MiB;
constexpr size_t WS_WGU = 42 * MiB;
constexpr size_t WS_WDN = 554 * MiB;
constexpr size_t WS_X = 810 * MiB;
constexpr size_t WS_H = 874 * MiB;
constexpr size_t WS_GA = 906 * MiB;
constexpr size_t WS_PROJ = 907 * MiB;
constexpr size_t WS_U = 1011 * MiB;
constexpr size_t WS_DVEC = 1063 * MiB;
constexpr size_t WS_SP = 1064 * MiB;
constexpr size_t WS_MIX = 1090 * MiB;
constexpr size_t WS_TOPE = 1122 * MiB;
constexpr size_t WS_TOPW = WS_TOPE + 256 * 1024;
constexpr size_t WS_SLOT = WS_TOPW + 256 * 1024;
constexpr size_t WS_A1 = 1123 * MiB;
constexpr size_t WS_ACT = 1267 * MiB;
constexpr size_t WS_Y = 1411 * MiB;
constexpr size_t WS_CUM = 1555 * MiB;
constexpr size_t WS_END = 1583 * MiB;
static_assert(WS_WIN + (size_t)DEPTH * NPROJ * D * 2 <= WS_WOUT && WS_PROJ + (size_t)MTOK * NPROJ * 2 <= WS_U && WS_U + (size_t)NUNIT * ST_TOT * 4 <= WS_DVEC && WS_SP + (size_t)NUNIT * ST_TOT * 2 <= WS_MIX && WS_A1 + (size_t)MAXROWS * D * 2 <= WS_ACT, "ws map");
constexpr int CW_TMO = 0, CW_CODE = 1, CW_BAR = 4096, CW_CNT = 8192, CW_FILL = 8192 + 256;
constexpr int RING_BYTES = 131072;
constexpr int MISC_OFF = 147456, LDS_BYTES = MISC_OFF + 4096;
constexpr int MW_BAR = 0, MW_CNT = 16, MW_PST = 48, MW_HIST = 96, MW_BASE = 128, MW_TILE = 192, MW_NRT = 480, MW_SLOTS = 512;

#define GAS __attribute__((address_space(1)))
#define LAS __attribute__((address_space(3)))
typedef unsigned v4u __attribute__((ext_vector_type(4)));
typedef float f32x4 __attribute__((ext_vector_type(4)));
typedef short bf16x8 __attribute__((ext_vector_type(8)));
typedef GAS unsigned gu32;
typedef GAS unsigned long long gu64;
#define RLX_AGENT __ATOMIC_RELAXED, __HIP_MEMORY_SCOPE_AGENT
#define LDS_WAIT() asm volatile("s_waitcnt lgkmcnt(0)" ::: "memory")
#define VM_WAIT() asm volatile("s_waitcnt vmcnt(0)" ::: "memory")
__device__ __forceinline__ unsigned long long rt() { return __builtin_amdgcn_s_memrealtime(); }
typedef unsigned short bf16;
__device__ __forceinline__ unsigned f2bf(float f) { unsigned u = __builtin_bit_cast(unsigned, f); return (u + 0x7fffu + ((u >> 16) & 1u)) >> 16; }
__device__ __forceinline__ unsigned pk2(float lo, float hi) { return f2bf(lo) | (f2bf(hi) << 16); }
__device__ __forceinline__ float bf2f(bf16 b) { return __builtin_bit_cast(float, (unsigned)b << 16); }
#define XB_TMO      128
#define XB_XCNT(j)  (256  + 64 * (j))
#define XB_XSUB(j)  (1280 + 64 * (j))
#define XB_XGEN(j)  (2304 + 64 * (j))
#define XB_TOP      3328
#define XB_TOPGEN   3392
#define XCD_BAR_WORDS 3456
#define XB_SPIN_CAP (1u << 18)

__device__ __forceinline__ unsigned xb_ld(unsigned* p)              { return __hip_atomic_load(p, __ATOMIC_RELAXED, __HIP_MEMORY_SCOPE_AGENT); }
__device__ __forceinline__ unsigned xb_add(unsigned* p, unsigned v) { return __hip_atomic_fetch_add(p, v, __ATOMIC_RELAXED, __HIP_MEMORY_SCOPE_AGENT); }
__device__ __forceinline__ unsigned xb_xcc_id() { return (unsigned)__builtin_amdgcn_s_getreg((3 << 11) | 20) & 0xFu; }
#define XB_SPIN(cond, bar) do { unsigned _sp = 0; while (cond) { __builtin_amdgcn_s_sleep(1); \
    if ((++_sp & 255u) == 0u) { if (xb_ld(&(bar)[XB_TMO])) break; if (_sp > XB_SPIN_CAP) { atomicAdd(&(bar)[XB_TMO], 1u); break; } } } } while (0)

struct XcdBarrier {
    unsigned* bar; unsigned x;
    volatile LAS unsigned* st;
};

__device__ __forceinline__ XcdBarrier xcd_barrier_post(unsigned* bar, volatile LAS unsigned* st) {
    XcdBarrier b; b.bar = bar; b.x = xb_xcc_id(); b.st = st;
    if (threadIdx.x == 0) (void)xb_add(&bar[XB_XCNT(b.x)], 1u);
    return b;
}
__device__ __forceinline__ void xcd_barrier_complete(unsigned* bar, unsigned x, unsigned& nloc, unsigned& nx) {
    const unsigned G = gridDim.x * gridDim.y * gridDim.z;
    unsigned sum, cnt, mine, sp = 0u;
    for (;;) {
        sum = 0u; cnt = 0u; mine = 0u;
#pragma unroll
        for (unsigned j = 0; j < 16; ++j) { const unsigned c = xb_ld(&bar[XB_XCNT(j)]); sum += c; cnt += (c > 0u) ? 1u : 0u; mine = (j == x) ? c : mine; }
        if (sum == G) break;
        __builtin_amdgcn_s_sleep(1);
        if ((++sp & 255u) == 0u) { if (xb_ld(&bar[XB_TMO])) break; if (sp > XB_SPIN_CAP) { atomicAdd(&bar[XB_TMO], 1u); break; } }
    }
    nloc = mine > 0u ? mine : 1u; nx = cnt > 0u ? cnt : 1u;
}

__device__ __forceinline__ void xcd_barrier(const XcdBarrier& b) {
    asm volatile("s_waitcnt vmcnt(0)" ::: "memory");
    __syncthreads();
    if (threadIdx.x == 0) {
        unsigned* bar = b.bar;
        __builtin_amdgcn_s_waitcnt(0);
        unsigned nloc = b.st[0], nx = b.st[1];
        if (nloc == 0u) { xcd_barrier_complete(bar, b.x, nloc, nx); b.st[0] = nloc; b.st[1] = nx; }
        const unsigned old = xb_add(&bar[XB_XSUB(b.x)], 1u);
        const unsigned gen = old / nloc;
        if (old + 1u == (gen + 1u) * nloc) {
            __builtin_amdgcn_fence(__ATOMIC_RELEASE, "agent");
            asm volatile("s_waitcnt vmcnt(0)" ::: "memory");
            const unsigned og = xb_add(&bar[XB_TOP], 1u);
            const unsigned tg = og / nx;
            if (og + 1u == (tg + 1u) * nx) xb_add(&bar[XB_TOPGEN], 1u);
            else XB_SPIN(xb_ld(&bar[XB_TOPGEN]) == tg, bar);
            __builtin_amdgcn_fence(__ATOMIC_ACQUIRE, "agent");
            xb_add(&bar[XB_XGEN(b.x)], 1u);
            asm volatile("s_waitcnt vmcnt(0)" ::: "memory");
        } else {
            XB_SPIN(xb_ld(&bar[XB_XGEN(b.x)]) == gen, bar);
            __builtin_amdgcn_fence(__ATOMIC_ACQUIRE, "agent");
            asm volatile("s_waitcnt vmcnt(0)" ::: "memory");
        }
    }
    __syncthreads();
}

__device__ __forceinline__ float wave_sum(float v) {
#pragma unroll
    for (int o = 1; o < 64; o <<= 1) v += __shfl_xor(v, o);
    return v;
}
__device__ __forceinline__ float log_sigmoid_f(float x) { return fminf(x, 0.f) - log1pf(expf(-fabsf(x))); }
__device__ __forceinline__ float silu_f(float x) { return x / (1.0f + expf(-x)); }
__device__ __forceinline__ float sigmoid_f(float x) { return 1.0f / (1.0f + expf(-x)); }
__device__ __forceinline__ pg8::bf16x8 ldfrag(const LAS bf16* base, int stride, int r0, int k0, int lane) {
    return *(const LAS pg8::bf16x8*)(base + (r0 + (lane & 15)) * stride + k0 + 8 * (lane >> 4));
}
__device__ __forceinline__ pg8::bf16x8 pack8(const float (&v)[8]) { v4u w; w.x = pk2(v[0], v[1]); w.y = pk2(v[2], v[3]); w.z = pk2(v[4], v[5]); w.w = pk2(v[6], v[7]); return __builtin_bit_cast(pg8::bf16x8, w); }

struct Args {
    const float* x; const float* c; const int* pos; const float* w_mod; const float* b_mod; const float* norm1_w; const float* w_in; const float* gla_wa2; const float* gla_ba2; const float* hg_lb;
    const float* gla_norm_w; const float* hg_norm_w; const float* w_out; const float* norm2_w; const float* w_r; const float* b_r; const float* w_gu; const float* b_gu; const float* w_dn; const float* b_dn;
    const float* final_norm_w; float* out; unsigned char* ws; int ph_lo, ph_hi;
};

__device__ __forceinline__ void transpose_block64(const float* src, int ld, bf16* dst, LAS float* scr, int lane) {
    const int r = lane >> 4, c4 = (lane & 15) * 4;
    f32x4 v[16];
#pragma unroll
    for (int i = 0; i < 16; ++i) v[i] = *(const f32x4*)(src + (size_t)(4 * i + r) * ld + c4);
#pragma unroll
    for (int i = 0; i < 16; ++i) { LAS float* w = scr + (4 * i + r) * 65 + c4; w[0] = v[i][0]; w[1] = v[i][1]; w[2] = v[i][2]; w[3] = v[i][3]; }
    LDS_WAIT(); asm volatile("" ::: "memory");
    const int kc = lane & 7;
#pragma unroll
    for (int jj = 0; jj < 8; ++jj) { const int n = (lane >> 3) + 8 * jj; const LAS float* s = scr + (8 * kc) * 65 + n;
        v4u o; o.x = pk2(s[0 * 65], s[1 * 65]); o.y = pk2(s[2 * 65], s[3 * 65]); o.z = pk2(s[4 * 65], s[5 * 65]); o.w = pk2(s[6 * 65], s[7 * 65]);
        *(GAS v4u*)(dst + (size_t)n * D + 8 * kc) = o; }
    LDS_WAIT(); asm volatile("" ::: "memory");
}
__device__ __forceinline__ int pk4_fp8(float a, float b, float c, float d) { int w = 0; w = __builtin_amdgcn_cvt_pk_fp8_f32(fminf(fmaxf(a, -448.f), 448.f), fminf(fmaxf(b, -448.f), 448.f), w, false);
    return __builtin_amdgcn_cvt_pk_fp8_f32(fminf(fmaxf(c, -448.f), 448.f), fminf(fmaxf(d, -448.f), 448.f), w, true); }
__device__ __forceinline__ void transpose_block64_fp8(const float* src, int ld, unsigned char* dst, LAS float* scr, int lane, float sc) {
    const int r = lane >> 4, c4 = (lane & 15) * 4;
    f32x4 v[16];
#pragma unroll
    for (int i = 0; i < 16; ++i) v[i] = *(const f32x4*)(src + (size_t)(4 * i + r) * ld + c4);
#pragma unroll
    for (int i = 0; i < 16; ++i) { LAS float* w = scr + (4 * i + r) * 65 + c4; w[0] = v[i][0] * sc; w[1] = v[i][1] * sc; w[2] = v[i][2] * sc; w[3] = v[i][3] * sc; }
    LDS_WAIT(); asm volatile("" ::: "memory");
    const int kc = lane & 3;
#pragma unroll
    for (int jj = 0; jj < 4; ++jj) { const int n = (lane >> 2) + 16 * jj; const LAS float* s = scr + (16 * kc) * 65 + n;
        v4u o; o.x = (unsigned)pk4_fp8(s[0 * 65], s[1 * 65], s[2 * 65], s[3 * 65]); o.y = (unsigned)pk4_fp8(s[4 * 65], s[5 * 65], s[6 * 65], s[7 * 65]);
        o.z = (unsigned)pk4_fp8(s[8 * 65], s[9 * 65], s[10 * 65], s[11 * 65]); o.w = (unsigned)pk4_fp8(s[12 * 65], s[13 * 65], s[14 * 65], s[15 * 65]);
        *(GAS v4u*)(dst + (size_t)n * D + 16 * kc) = o; }
    LDS_WAIT(); asm volatile("" ::: "memory");
}
constexpr int IT_IN = 16 * (NPROJ / 64), IT_OUT = 16 * 16, IT_GU = NE * 16 * 32, IT_DN = NE * 16 * 16, IT_LAYER = IT_IN + IT_OUT + IT_GU + IT_DN, IT_ALL = DEPTH * IT_LAYER;
__device__ __forceinline__ void p0_prologue(const Args& a, LAS unsigned char* lds, int vcu, int G, int tid, int lane, int wave) {
    unsigned char* ws = a.ws;
    bf16* WIN = (bf16*)(ws + WS_WIN); bf16* WOUT = (bf16*)(ws + WS_WOUT); unsigned char* WGU = ws + WS_WGU; unsigned char* WDN = ws + WS_WDN;
    LAS float* scr = (LAS float*)(lds + wave * 16640);
    const int gw = vcu * NWAVES + wave, NGW = G * NWAVES;
    for (int it = gw; it < IT_ALL; it += NGW) {
        const int l = it / IT_LAYER; int r = it - l * IT_LAYER;
        if (r < IT_IN) { const int kb = r / (NPROJ / 64), nb = r % (NPROJ / 64), n0 = 64 * nb, sc = n0 + (n0 >= SRC_GA ? 16 : 0);
            if (F8_IN) transpose_block64_fp8(a.w_in + ((size_t)l * D + 64 * kb) * DIN + sc, DIN, (unsigned char*)WIN + ((size_t)l * NPROJ + n0) * D + 64 * kb, scr, lane, S8_W);
            else transpose_block64(a.w_in + ((size_t)l * D + 64 * kb) * DIN + sc, DIN, WIN + ((size_t)l * NPROJ + n0) * D + 64 * kb, scr, lane); continue; }
        r -= IT_IN;
        if (r < IT_OUT) { const int kb = r / 16, nb = r % 16;
            if (F8_OUT) transpose_block64_fp8(a.w_out + ((size_t)l * D + 64 * kb) * D + 64 * nb, D, (unsigned char*)WOUT + ((size_t)l * D + 64 * nb) * D + 64 * kb, scr, lane, S8_W);
            else transpose_block64(a.w_out + ((size_t)l * D + 64 * kb) * D + 64 * nb, D, WOUT + ((size_t)l * D + 64 * nb) * D + 64 * kb, scr, lane); continue; }
        r -= IT_OUT;
        if (r < IT_GU) { const int e = r / 512, r2 = r % 512, kb = r2 / 32, nb = r2 % 32, cc = 64 * nb;
            const int row = (cc < 1024) ? 256 * (cc / 128) + (cc % 128) : 256 * ((cc - 1024) / 128) + 128 + ((cc - 1024) % 128);
            transpose_block64_fp8(a.w_gu + (((size_t)l * NE + e) * D + 64 * kb) * 2048 + cc, 2048, WGU + (((size_t)l * NE + e) * 2048 + row) * D + 64 * kb, scr, lane, S8_W); continue; }
        r -= IT_GU;
        { const int e = r / 256, r2 = r % 256, kb = r2 / 16, nb = r2 % 16;
            transpose_block64_fp8(a.w_dn + (((size_t)l * NE + e) * FFN + 64 * kb) * D + 64 * nb, D, WDN + (((size_t)l * NE + e) * D + 64 * nb) * D + 64 * kb, scr, lane, S8_W); }
    }
    __syncthreads();
    {
        LAS float* cact = (LAS float*)lds;
        LAS float* red = (LAS float*)(lds + 8192);
        for (int i = tid; i < 2 * D; i += NTHR) cact[i] = silu_f(a.c[i]);
        __syncthreads();
        float* MOD = (float*)(ws + WS_MOD);
        for (int it = vcu; it < DEPTH * 96; it += G) {
            const int l = it / 96, n0 = (it % 96) * 64;
            const float* wp = a.w_mod + ((size_t)l * D + 128 * wave) * 6144 + n0 + lane;
            float a0 = 0.f, a1 = 0.f;
#pragma unroll 8
            for (int k = 0; k < 128; ++k) { const float w = wp[(size_t)k * 6144]; a0 += cact[128 * wave + k] * w; a1 += cact[D + 128 * wave + k] * w; }
            red[(wave * 2 + 0) * 64 + lane] = a0; red[(wave * 2 + 1) * 64 + lane] = a1;
            __syncthreads();
            if (tid < 128) { const int b = tid >> 6, ln = tid & 63; float s = a.b_mod[l * 6144 + n0 + ln];
#pragma unroll
                for (int w = 0; w < 8; ++w) s += red[(w * 2 + b) * 64 + ln];
                MOD[((size_t)l * 2 + b) * 6144 + n0 + ln] = s; }
            __syncthreads();
        }
    }
    {
        float* ROPE = (float*)(ws + WS_ROPE);
        for (int i = vcu * NTHR + tid; i < MTOK * 24; i += G * NTHR) { const int t = i / 24, f = i % 24;
            const float inv = (float)pow(10000.0, -(double)f / 24.0); const float ang = (float)a.pos[t] * inv;
            ROPE[(size_t)t * 48 + f] = cosf(ang); ROPE[(size_t)t * 48 + 24 + f] = sinf(ang); }
    }
    if (vcu == 0 && tid < 256) {
        float v[4], mx = -3.0e38f; for (int l = 0; l < 4; ++l) { v[l] = a.hg_lb[l * 256 + tid]; mx = fmaxf(mx, v[l]); }
        float s = 0.f; for (int l = 0; l < 4; ++l) { v[l] = expf(v[l] - mx); s += v[l]; }
        float* LB = (float*)(ws + WS_LB); float cs = 0.f, first = 0.f;
        for (int l = 0; l < 4; ++l) { cs += v[l] / s; if (l == 0) first = cs; LB[l * 256 + tid] = cs - first; }
    }
}

__device__ __forceinline__ void moe_combine_row(f32x4 (&v)[4], int m, const bf16* Y, const int* SLOT, const float* TOPW, const float* g2, int lane) {
    const int4 sl = *(const int4*)(SLOT + (size_t)m * 4); const f32x4 tw = *(const f32x4*)(TOPW + (size_t)m * 4);
    const int s[4] = {sl.x, sl.y, sl.z, sl.w};
    f32x4 acc[4];
#pragma unroll
    for (int j = 0; j < 4; ++j) acc[j] = (f32x4){0.f, 0.f, 0.f, 0.f};
#pragma unroll
    for (int k = 0; k < 4; ++k) { const bf16* yr = Y + (size_t)s[k] * D + 4 * lane; const float w = tw[k];
#pragma unroll
        for (int j = 0; j < 4; ++j) { const uint2 p = *(const uint2*)(yr + 256 * j);
            acc[j][0] += w * __builtin_bit_cast(float, p.x << 16); acc[j][1] += w * __builtin_bit_cast(float, p.x & 0xffff0000u);
            acc[j][2] += w * __builtin_bit_cast(float, p.y << 16); acc[j][3] += w * __builtin_bit_cast(float, p.y & 0xffff0000u); } }
#pragma unroll
    for (int j = 0; j < 4; ++j) { const f32x4 g = *(const f32x4*)(g2 + 4 * lane + 256 * j); v[j] = v[j] + g * acc[j]; }
}
__device__ __forceinline__ float row_rstd(const f32x4 (&v)[4]) {
    float s = 0.f;
#pragma unroll
    for (int j = 0; j < 4; ++j) s += (v[j][0] * v[j][0] + v[j][1] * v[j][1]) + (v[j][2] * v[j][2] + v[j][3] * v[j][3]);
    return 1.0f / sqrtf(wave_sum(s) * (1.0f / D) + EPS);
}
__device__ __forceinline__ void modulate_row(f32x4 (&v)[4], float rstd, const float* nw, const float* sc, const float* sh, bf16* hrow, int lane) {
#pragma unroll
    for (int j = 0; j < 4; ++j) { const int c0 = 4 * lane + 256 * j; const f32x4 w = *(const f32x4*)(nw + c0), s1 = *(const f32x4*)(sc + c0), s0 = *(const f32x4*)(sh + c0);
        v[j] = v[j] * rstd * w * (s1 + 1.0f) + s0;
        uint2 p; p.x = pk2(v[j][0], v[j][1]); p.y = pk2(v[j][2], v[j][3]); *(uint2*)(hrow + c0) = p; }
}


constexpr int LR_SLT = 142976, LR_TWL = 144000, LR_SSR = 145024;
__device__ __forceinline__ void stage_slots(const unsigned char* ws, int row0, LAS unsigned char* lds, int tid) {
    if (tid < 64) { *(LAS v4u*)(lds + LR_SLT + 16 * tid) = *(const v4u*)((const int*)(ws + WS_SLOT) + (size_t)(row0 + tid) * 4);
                    *(LAS f32x4*)(lds + LR_TWL + 16 * tid) = *(const f32x4*)((const float*)(ws + WS_TOPW) + (size_t)(row0 + tid) * 4); }
}
template <bool SS>
__device__ __forceinline__ void flat_combine(const float* xsrc, float* xdst, int row0, const bf16* Y, const float* g2, LAS unsigned char* lds, int tid, int lane) {
    const int c4 = tid & 255, rsub = tid >> 8; const f32x4 g = *(const f32x4*)(g2 + 4 * c4);
#pragma unroll 4
    for (int it = 0; it < 32; ++it) { const int i = 2 * it + rsub; const size_t m = (size_t)(row0 + i);
        f32x4 v = *(const f32x4*)(xsrc + m * D + 4 * c4);
        const v4u sl = *(const LAS v4u*)(lds + LR_SLT + 16 * i); const f32x4 tw = *(const LAS f32x4*)(lds + LR_TWL + 16 * i);
        const uint2 p0 = *(const uint2*)(Y + (size_t)sl.x * D + 4 * c4), p1 = *(const uint2*)(Y + (size_t)sl.y * D + 4 * c4), p2 = *(const uint2*)(Y + (size_t)sl.z * D + 4 * c4), p3 = *(const uint2*)(Y + (size_t)sl.w * D + 4 * c4);
        f32x4 acc;
        acc[0] = tw[0] * __builtin_bit_cast(float, p0.x << 16) + tw[1] * __builtin_bit_cast(float, p1.x << 16) + tw[2] * __builtin_bit_cast(float, p2.x << 16) + tw[3] * __builtin_bit_cast(float, p3.x << 16);
        acc[1] = tw[0] * __builtin_bit_cast(float, p0.x & 0xffff0000u) + tw[1] * __builtin_bit_cast(float, p1.x & 0xffff0000u) + tw[2] * __builtin_bit_cast(float, p2.x & 0xffff0000u) + tw[3] * __builtin_bit_cast(float, p3.x & 0xffff0000u);
        acc[2] = tw[0] * __builtin_bit_cast(float, p0.y << 16) + tw[1] * __builtin_bit_cast(float, p1.y << 16) + tw[2] * __builtin_bit_cast(float, p2.y << 16) + tw[3] * __builtin_bit_cast(float, p3.y << 16);
        acc[3] = tw[0] * __builtin_bit_cast(float, p0.y & 0xffff0000u) + tw[1] * __builtin_bit_cast(float, p1.y & 0xffff0000u) + tw[2] * __builtin_bit_cast(float, p2.y & 0xffff0000u) + tw[3] * __builtin_bit_cast(float, p3.y & 0xffff0000u);
        v = v + g * acc;
        *(f32x4*)(xdst + m * D + 4 * c4) = v;
        if (SS) { const float sq = wave_sum((v[0] * v[0] + v[1] * v[1]) + (v[2] * v[2] + v[3] * v[3])); if (lane == 0) __hip_atomic_fetch_add((LAS float*)(lds + LR_SSR) + i, sq, __ATOMIC_RELAXED, __HIP_MEMORY_SCOPE_WORKGROUP); } }
}
template <bool F8>
__device__ __forceinline__ void flat_modulate(const float* xin, int row0, const LAS float* rstds, const float* nw, const float* scp, const float* shp, bf16* H, int tid) {
    const int c4 = tid & 255, rsub = tid >> 8; const f32x4 w = *(const f32x4*)(nw + 4 * c4), s1 = *(const f32x4*)(scp + 4 * c4), s0 = *(const f32x4*)(shp + 4 * c4); const f32x4 ws1 = w * (s1 + 1.0f);
#pragma unroll 8
    for (int it = 0; it < 32; ++it) { const int i = 2 * it + rsub; const size_t m = (size_t)(row0 + i); const f32x4 v = *(const f32x4*)(xin + m * D + 4 * c4) * rstds[i] * ws1 + s0;
        if (F8) *(int*)((unsigned char*)H + m * D + 4 * c4) = pk4_fp8(v[0] * S8_H, v[1] * S8_H, v[2] * S8_H, v[3] * S8_H);
        else { uint2 p; p.x = pk2(v[0], v[1]); p.y = pk2(v[2], v[3]); *(uint2*)(H + m * D + 4 * c4) = p; } }
}

constexpr int WP = 1032;
constexpr int LR_WHI = 0, LR_PART = 132096, LR_SSX = 140288, LR_RSTD = 140544, LR_BIAS = 140800, LR_RED = 140928;
template <int NEO>
__device__ __forceinline__ void rows_mfma(const Args& a, int layer, LAS unsigned char* lds, volatile LAS unsigned* MISC, gu32* ctl, int vcu, int G, int tid, int lane, int wave) {
    constexpr bool P5 = (NEO == 32); constexpr int NET = NEO / 16;
    unsigned char* ws = a.ws; float* X = (float*)(ws + WS_X); bf16* H = (bf16*)(ws + WS_H); const float* MOD = (const float*)(ws + WS_MOD);
    LAS bf16* Whi = (LAS bf16*)(lds + LR_WHI); LAS bf16* Wlo = Whi + NEO * WP; LAS float* part = (LAS float*)(lds + LR_PART); LAS float* ssx = (LAS float*)(lds + LR_SSX);
    LAS float* rstds = (LAS float*)(lds + LR_RSTD); LAS float* biasl = (LAS float*)(lds + LR_BIAS); LAS float* red = (LAS float*)(lds + LR_RED);
    const float* nw = (P5 ? a.norm2_w : a.norm1_w) + layer * D;
    const float* Wsrc = P5 ? a.w_r + (size_t)layer * D * NE : a.w_in + (size_t)layer * D * DIN + SRC_GA; const int wld = P5 ? NE : DIN;
    if (P5) { if (tid < NE) MISC[MW_HIST + tid] = 0u; }
    for (int row0 = vcu * 64; row0 < MTOK; row0 += G * 64) {
        const int b = row0 / SEQ; const float* mp = MOD + ((size_t)layer * 2 + b) * 6144; const float* scp = mp + (P5 ? 4 : 1) * D; const float* shp = mp + (P5 ? 3 : 0) * D;
        if (!P5 && layer > 0) { stage_slots(ws, row0, lds, tid); __syncthreads(); }
        { const int e = tid % NEO, kq = tid / NEO; constexpr int NPT = NTHR / NEO;
#pragma unroll 1
            for (int it0 = 0; it0 < D / NPT; it0 += 8) { float wv[8];
#pragma unroll
                for (int u = 0; u < 8; ++u) { const int k = kq + NPT * (it0 + u); wv[u] = Wsrc[(size_t)k * wld + e] * (nw[k] * (1.0f + scp[k])); }
#pragma unroll
                for (int u = 0; u < 8; ++u) { const int k = kq + NPT * (it0 + u); const unsigned hi = f2bf(wv[u]); const float wl = wv[u] - __builtin_bit_cast(float, hi << 16); Whi[e * WP + k] = (bf16)hi; Wlo[e * WP + k] = (bf16)f2bf(wl); } }
            constexpr int KP = D / NPT; float sacc = 0.f;
#pragma unroll 8
            for (int k = kq * KP; k < kq * KP + KP; ++k) sacc += shp[k] * Wsrc[(size_t)k * wld + e];
            red[kq * NEO + e] = sacc; }
        const float* xin = X;
        if (!P5) { if (layer == 0) xin = a.x;
            else { flat_combine<false>(X, X, row0, (const bf16*)(ws + WS_Y), MOD + ((size_t)(layer - 1) * 2 + b) * 6144 + 5 * D, lds, tid, lane); asm volatile("s_waitcnt vmcnt(0)" ::: "memory"); } }
        __syncthreads();
        if (tid < NEO) { constexpr int NPT = NTHR / NEO; float sacc = P5 ? a.b_r[layer * NE + tid] : 0.f; for (int q = 0; q < NPT; ++q) sacc += red[q * NEO + tid]; biasl[tid] = sacc; }
        const int rg = wave >> 1, kh = wave & 1, r = lane & 15, g = lane >> 4;
        { const float* xr = xin + (size_t)(row0 + 16 * rg + r) * D; f32x4 acc[NET]; float ss = 0.f;
#pragma unroll
            for (int et = 0; et < NET; ++et) acc[et] = (f32x4){0.f, 0.f, 0.f, 0.f};
#pragma unroll 4
            for (int s = 16 * kh; s < 16 * kh + 16; ++s) { const int k0 = 32 * s + 8 * g; const f32x4 x0 = *(const f32x4*)(xr + k0), x1 = *(const f32x4*)(xr + k0 + 4);
                ss += (x0[0] * x0[0] + x0[1] * x0[1]) + (x0[2] * x0[2] + x0[3] * x0[3]) + (x1[0] * x1[0] + x1[1] * x1[1]) + (x1[2] * x1[2] + x1[3] * x1[3]);
                float xv[8] = {x0[0], x0[1], x0[2], x0[3], x1[0], x1[1], x1[2], x1[3]}, xl[8];
#pragma unroll
                for (int j = 0; j < 8; ++j) xl[j] = xv[j] - __builtin_bit_cast(float, f2bf(xv[j]) << 16);
                const pg8::bf16x8 ahi = pack8(xv), alo = pack8(xl);
#pragma unroll
                for (int et = 0; et < NET; ++et) { const pg8::bf16x8 whi = ldfrag(Whi, WP, 16 * et, 32 * s, lane), wlo = ldfrag(Wlo, WP, 16 * et, 32 * s, lane);
                    acc[et] = __builtin_amdgcn_mfma_f32_16x16x32_bf16(ahi, whi, acc[et], 0, 0, 0); acc[et] = __builtin_amdgcn_mfma_f32_16x16x32_bf16(alo, whi, acc[et], 0, 0, 0);
                    acc[et] = __builtin_amdgcn_mfma_f32_16x16x32_bf16(ahi, wlo, acc[et], 0, 0, 0); } }
            ss += __shfl_xor(ss, 16); ss += __shfl_xor(ss, 32);
            if (kh == 1) {
#pragma unroll
                for (int et = 0; et < NET; ++et)
#pragma unroll
                    for (int q = 0; q < 4; ++q) part[(rg * 16 + 4 * g + q) * 32 + 16 * et + r] = acc[et][q];
                if (g == 0) ssx[rg * 16 + r] = ss; }
            __syncthreads();
            if (kh == 0) { const float sst = ss + ssx[rg * 16 + r]; if (g == 0) rstds[rg * 16 + r] = 1.0f / sqrtf(sst * (1.0f / D) + EPS);
                asm volatile("s_waitcnt lgkmcnt(0)" ::: "memory");
#pragma unroll
                for (int et = 0; et < NET; ++et)
#pragma unroll
                    for (int q = 0; q < 4; ++q) { const int i = rg * 16 + 4 * g + q, e = 16 * et + r; const float v = rstds[i] * (acc[et][q] + part[i * 32 + e]) + biasl[e];
                        if (P5) part[i * 32 + e] = v; else ((float*)(ws + WS_GA))[(size_t)(row0 + i) * 16 + e] = v; }
                if (P5) { asm volatile("s_waitcnt lgkmcnt(0)" ::: "memory");
                    if (lane < 16) { const int i = rg * 16 + lane, m = row0 + i; float lv[NE];
#pragma unroll
                        for (int e = 0; e < NE; ++e) lv[e] = part[i * 32 + e];
                        float tv[4]; int te[4];
#pragma unroll
                        for (int t = 0; t < 4; ++t) { float best = -3.0e38f; int bi = 0;
#pragma unroll
                            for (int e = 0; e < NE; ++e) if (lv[e] > best) { best = lv[e]; bi = e; }
#pragma unroll
                            for (int e = 0; e < NE; ++e) if (e == bi) lv[e] = -3.0e38f;
                            tv[t] = best; te[t] = bi; }
                        const float e1 = expf(tv[1] - tv[0]), e2 = expf(tv[2] - tv[0]), e3 = expf(tv[3] - tv[0]); const float inv = 1.0f / (1.0f + e1 + e2 + e3);
                        *(int4*)((int*)(ws + WS_TOPE) + (size_t)m * 4) = make_int4(te[0], te[1], te[2], te[3]); *(f32x4*)((float*)(ws + WS_TOPW) + (size_t)m * 4) = (f32x4){inv, e1 * inv, e2 * inv, e3 * inv};
#pragma unroll
                        for (int t = 0; t < 4; ++t) __hip_atomic_fetch_add((LAS unsigned*)&MISC[MW_HIST + te[t]], 1u, __ATOMIC_RELAXED, __HIP_MEMORY_SCOPE_WORKGROUP); } } }
            __syncthreads(); }
        flat_modulate<P5 || F8_IN>(xin, row0, rstds, nw, scp, shp, H, tid);
        __syncthreads();
    }
    if (P5) { if (tid < NE) { const unsigned hcnt = MISC[MW_HIST + tid]; if (hcnt) atomicAdd((unsigned*)(ctl + CW_CNT + layer * NE + tid), hcnt); } }
}

__device__ __forceinline__ void final_rows(const Args& a, LAS unsigned char* lds, int vcu, int G, int tid, int lane) {
    unsigned char* ws = a.ws; const float* X = (const float*)(ws + WS_X); const float* MOD = (const float*)(ws + WS_MOD); LAS float* ssr = (LAS float*)(lds + LR_SSR);
    for (int row0 = vcu * 64; row0 < MTOK; row0 += G * 64) { const int b = row0 / SEQ;
        stage_slots(ws, row0, lds, tid); if (tid < 64) ssr[tid] = 0.f;
        __syncthreads();
        flat_combine<true>(X, a.out, row0, (const bf16*)(ws + WS_Y), MOD + ((size_t)(DEPTH - 1) * 2 + b) * 6144 + 5 * D, lds, tid, lane);
        asm volatile("s_waitcnt vmcnt(0)" ::: "memory");
        __syncthreads();
        { const int c4 = tid & 255, rsub = tid >> 8; const f32x4 w = *(const f32x4*)(a.final_norm_w + 4 * c4);
#pragma unroll 8
            for (int it = 0; it < 32; ++it) { const int i = 2 * it + rsub; float* op = a.out + (size_t)(row0 + i) * D + 4 * c4; const float rstd = 1.0f / sqrtf(ssr[i] * (1.0f / D) + EPS); *(f32x4*)op = *(const f32x4*)op * rstd * w; } }
        __syncthreads();
    }
}

__device__ __noinline__ void moe_tables(gu32* ctl, int layer, volatile LAS unsigned* MISC, int tid) {
    if (tid < NE) MISC[MW_CNT + tid] = __hip_atomic_load(ctl + CW_CNT + layer * NE + tid, RLX_AGENT);
    __syncthreads();
    if (tid == 0) { unsigned p = 0;
        for (int e = 0; e < NE; ++e) { MISC[MW_PST + e] = p; const unsigned nt = (MISC[MW_CNT + e] + 255u) >> 8; for (unsigned t = 0; t < nt; ++t) MISC[MW_TILE + (p >> 8) + t] = (unsigned)e; p += nt << 8; }
        MISC[MW_PST + NE] = p; MISC[MW_NRT] = p >> 8; }
    __syncthreads();
}
__device__ __forceinline__ void p6_dispatch(const Args& a, int layer, volatile LAS unsigned* MISC, gu32* ctl, int vcu, int G, int tid, int lane, int wave) {
    unsigned char* ws = a.ws; const int* TOPE = (const int*)(ws + WS_TOPE); int* SLOT = (int*)(ws + WS_SLOT); const unsigned char* H = ws + WS_H; unsigned char* A1 = ws + WS_A1;
    moe_tables(ctl, layer, MISC, tid);
    for (int t0 = vcu * 64; t0 < MTOK; t0 += G * 64) {
        if (tid < NE) MISC[MW_HIST + tid] = 0u;
        __syncthreads();
        int e = 0; unsigned r = 0;
        if (tid < 256) { e = TOPE[(size_t)t0 * 4 + tid]; r = __hip_atomic_fetch_add((LAS unsigned*)&MISC[MW_HIST + e], 1u, __ATOMIC_RELAXED, __HIP_MEMORY_SCOPE_WORKGROUP); }
        __syncthreads();
        if (tid < NE) { const unsigned h = MISC[MW_HIST + tid]; MISC[MW_BASE + tid] = h ? atomicAdd((unsigned*)(ctl + CW_FILL + layer * NE + tid), h) : 0u; }
        __syncthreads();
        if (tid < 256) { const int slot = (int)(MISC[MW_PST + e] + MISC[MW_BASE + e] + r); SLOT[(size_t)t0 * 4 + tid] = slot; MISC[MW_SLOTS + tid] = (unsigned)slot; }
        __syncthreads();
        for (int i = wave * 32; i < wave * 32 + 32; ++i) { const int slot = (int)MISC[MW_SLOTS + i]; const int t = t0 + (i >> 2);
            const v4u* src = (const v4u*)(H + (size_t)t * D); v4u* dst = (v4u*)(A1 + (size_t)slot * D);
            dst[lane] = src[lane]; }
        __syncthreads();
    }
}

constexpr int BP = 72;
template <int TYPE> struct MixCfg { static constexpr int DK = (TYPE == 1) ? 64 : 48, DV = (TYPE == 1) ? 64 : 96, NC = 4 * DK, NV = 4 * DV;
    static constexpr int STOFF = (TYPE == 0) ? ST_GLA : (TYPE == 1) ? ST_HG : ST_RET, COFF = (TYPE == 0) ? 0 : 192;
    static constexpr int CQ = (TYPE == 0) ? C_GQ : (TYPE == 1) ? C_HQ : C_RQ, CK = (TYPE == 0) ? C_GK : (TYPE == 1) ? C_HF : C_RK, CV = (TYPE == 0) ? C_GV : (TYPE == 1) ? C_HI : C_RV, CG = (TYPE == 0) ? C_GG : (TYPE == 1) ? C_HG : C_RG;
    static constexpr int MIXOFF = (TYPE == 0) ? 0 : (TYPE == 1) ? 384 : 640; };
__device__ __forceinline__ float fast_logsig(float x) { x = fmaxf(x, -80.f); return -__logf(1.0f + __expf(-x)); }
__device__ __forceinline__ float ret_lg(int h) { return logf(1.0f - exp2f(-5.0f - (float)h)); }

template <int NV>
__device__ __forceinline__ void stage_vt(const bf16* pv  , LAS bf16* VT, int tid) {
#pragma unroll 2
    for (int idx = tid; idx < 64 * (NV / 8); idx += NTHR) { const int j = idx & 63, ch = idx >> 6; const v4u p = *(const v4u*)(pv + (size_t)j * NPROJ + 8 * ch); LAS bf16* d = VT + (8 * ch) * BP + j;
        d[0 * BP] = (bf16)(p.x & 0xffffu); d[1 * BP] = (bf16)(p.x >> 16); d[2 * BP] = (bf16)(p.y & 0xffffu); d[3 * BP] = (bf16)(p.y >> 16);
        d[4 * BP] = (bf16)(p.z & 0xffffu); d[5 * BP] = (bf16)(p.z >> 16); d[6 * BP] = (bf16)(p.w & 0xffffu); d[7 * BP] = (bf16)(p.w >> 16); }
}

constexpr int LA_KT = 0, LA_VT = 36864, LA_TOT = 92160, LA_GA = 94208;
template <int TYPE>
__device__ __forceinline__ void mixa_batch(const Args& a, int layer, int unit, LAS unsigned char* lds, int tid, int lane, int wave) {
    typedef MixCfg<TYPE> C; constexpr int DK = C::DK, DV = C::DV, NC = C::NC, NV = C::NV;
    unsigned char* ws = a.ws; const bf16* PROJ = (const bf16*)(ws + WS_PROJ); float* CUM = (float*)(ws + WS_CUM); float* DVEC = (float*)(ws + WS_DVEC) + (size_t)unit * NDV;
    float* U = (float*)(ws + WS_U) + (size_t)unit * ST_TOT + C::STOFF;
    LAS bf16* KT = (LAS bf16*)(lds + LA_KT); LAS bf16* VT = (LAS bf16*)(lds + LA_VT); LAS float* TOT = (LAS float*)(lds + LA_TOT); const LAS float* GAs = (const LAS float*)(lds + LA_GA);
    const int row0 = unit * CH;
    const bool act = tid < 2 * NC; const int c = act ? tid % NC : 0, half = act ? tid / NC : 0, h = c / DK, d = c - h * DK;
    float cum[32]; float tot = 0.f;
    float w2[16], b2 = 0.f, lbv = 0.f, lg = 0.f, sg = 0.f; int f = 0, d2 = 0;
    if (act) {
        if constexpr (TYPE == 0) { b2 = a.gla_ba2[layer * 192 + c];
#pragma unroll
            for (int r = 0; r < 16; ++r) w2[r] = a.gla_wa2[(layer * 16 + r) * 192 + c]; }
        if constexpr (TYPE == 1) lbv = ((const float*)(ws + WS_LB))[layer * 256 + c];
        if constexpr (TYPE == 2) { lg = ret_lg(h); f = (d < 24) ? d : d - 24; d2 = (d < 24) ? d + 24 : d - 24; sg = (d < 24) ? -1.f : 1.f; }
#pragma unroll
        for (int i = 0; i < 32; ++i) { const int t = 32 * half + i; const bf16* pr = PROJ + (size_t)(row0 + t) * NPROJ; float g;
            if constexpr (TYPE == 0) { float pre = b2;
#pragma unroll
                for (int r = 0; r < 16; ++r) pre += GAs[t * 16 + r] * w2[r];
                g = fast_logsig(pre) * (1.0f / 16.0f); }
            else if constexpr (TYPE == 1) { const float hf = fminf(fmaxf(bf2f(pr[C_HF + c]), -80.f), 80.f); const float sgm = 1.0f / (1.0f + __expf(-hf));
                g = __logf(lbv + (1.0f - lbv) * sgm); }
            else g = lg;
            tot += g; cum[i] = tot;
            if ((i & 7) == 7) asm volatile("" ::: "memory"); }
        TOT[c * 2 + half] = tot;
    }
    stage_vt<NV>(PROJ + (size_t)row0 * NPROJ + C::CV, VT, tid);
    __syncthreads();
    if (act) { const float t0 = TOT[c * 2], t1 = TOT[c * 2 + 1]; const float off = half ? t0 : 0.f, last = t0 + t1;
#pragma unroll
        for (int q = 0; q < 4; ++q) { float kt[8];
#pragma unroll
            for (int j = 0; j < 8; ++j) { const int i = 8 * q + j; const float cm = cum[i] + off; const size_t row = (size_t)(row0 + 32 * half + i); const bf16* pr = PROJ + row * NPROJ; float k;
                if constexpr (TYPE == 0) k = bf2f(pr[C_GK + c]);
                else if constexpr (TYPE == 1) k = 1.0f - __expf(cum[i] - (i > 0 ? cum[i - 1] : 0.f));
                else { const float* rp = (const float*)(ws + WS_ROPE) + row * 48; k = bf2f(pr[C_RK + h * 48 + d]) * rp[f] + sg * bf2f(pr[C_RK + h * 48 + d2]) * rp[24 + f]; }
                if constexpr (TYPE != 2) CUM[row * NDV + C::COFF + c] = cm;
                kt[j] = k * __expf(last - cm); }
            v4u w; w.x = pk2(kt[0], kt[1]); w.y = pk2(kt[2], kt[3]); w.z = pk2(kt[4], kt[5]); w.w = pk2(kt[6], kt[7]);
            *(LAS v4u*)(KT + c * BP + 32 * half + 8 * q) = w;
            asm volatile("" ::: "memory"); }
        if (TYPE != 2 && half == 0) DVEC[C::COFF + c] = __expf(last);
    }
    __syncthreads();
    constexpr int TD = DK / 16, NT = (DV / 16) * TD;
    for (int ti = wave; ti < 4 * NT; ti += NWAVES) { const int hh = ti / NT, tr = ti - hh * NT, te = tr / TD, td = tr - te * TD; f32x4 acc = {0.f, 0.f, 0.f, 0.f};
#pragma unroll
        for (int kk = 0; kk < 2; ++kk) acc = __builtin_amdgcn_mfma_f32_16x16x32_bf16(ldfrag(VT, BP, hh * DV + te * 16, kk * 32, lane), ldfrag(KT, BP, hh * DK + td * 16, kk * 32, lane), acc, 0, 0, 0);
        float* Uh = U + hh * DK * DV;
#pragma unroll
        for (int r = 0; r < 4; ++r) Uh[(te * 16 + (lane >> 4) * 4 + r) * DK + td * 16 + (lane & 15)] = acc[r]; }
    __syncthreads();
}
__device__ __forceinline__ void p3a_summaries(const Args& a, int layer, LAS unsigned char* lds, int vcu, int G, int tid, int lane, int wave) {
    for (int unit = vcu; unit < NUNIT; unit += G) {
        { LAS float* GAs = (LAS float*)(lds + LA_GA); const float* GA = (const float*)(a.ws + WS_GA); for (int i = tid; i < CH * 16; i += NTHR) GAs[i] = GA[(size_t)unit * CH * 16 + i]; }
        __syncthreads();
        mixa_batch<0>(a, layer, unit, lds, tid, lane, wave);
        mixa_batch<1>(a, layer, unit, lds, tid, lane, wave);
        mixa_batch<2>(a, layer, unit, lds, tid, lane, wave);
    }
}

__device__ __forceinline__ void p3b_scan(const Args& a, int vcu, int G, int tid) {
    unsigned char* ws = a.ws; const float* U = (const float*)(ws + WS_U); const float* DVEC = (const float*)(ws + WS_DVEC); bf16* SP = (bf16*)(ws + WS_SP);
    for (int gid = vcu * NTHR + tid; gid < BATCH * ST_TOT; gid += G * NTHR) {
        const int b = gid / ST_TOT, el = gid - b * ST_TOT;
        int di = -1; float cdec = 0.f;
        if (el < ST_HG) { const int h = el / 4608, d = (el - h * 4608) % 48; di = h * 48 + d; }
        else if (el < ST_RET) { const int r = el - ST_HG, h = r / 4096, d = r % 64; di = 192 + h * 64 + d; }
        else { const int h = (el - ST_RET) / 4608; cdec = expf(64.0f * logf(1.0f - exp2f(-5.0f - (float)h))); }
        const float* up = U + (size_t)b * NCH * ST_TOT + el; const float* dp = DVEC + (size_t)b * NCH * NDV + (di < 0 ? 0 : di); bf16* sp = SP + (size_t)b * NCH * ST_TOT + el;
        float s = 0.f;
        for (int n0 = 0; n0 < NCH; n0 += 8) { float u[8], dc[8];
#pragma unroll
            for (int i = 0; i < 8; ++i) { u[i] = up[(size_t)(n0 + i) * ST_TOT]; dc[i] = (di < 0) ? cdec : dp[(size_t)(n0 + i) * NDV]; }
#pragma unroll
            for (int i = 0; i < 8; ++i) { sp[(size_t)(n0 + i) * ST_TOT] = (bf16)f2bf(s); s = dc[i] * s + u[i]; } }
    }
}

constexpr int LC_VT = 0, LC_ST = 55296, LC_AB = 110592, OBP = 104;
template <int TYPE, bool ISQ>
__device__ __forceinline__ void mix_frag(const Args& a, int h, size_t row, int t, int d0, float (&x)[8], float (&cm)[8]) {
    typedef MixCfg<TYPE> C; constexpr int DK = C::DK;
    unsigned char* ws = a.ws; const bf16* pr = (const bf16*)(ws + WS_PROJ) + row * NPROJ;
    if constexpr (TYPE == 0) {
        const v4u p = *(const v4u*)(pr + (ISQ ? C_GQ : C_GK) + h * DK + d0); const unsigned pw[4] = {p.x, p.y, p.z, p.w};
        const float* cp = (const float*)(ws + WS_CUM) + row * NDV + h * DK + d0; const f32x4 c0 = *(const f32x4*)cp, c1 = *(const f32x4*)(cp + 4);
#pragma unroll
        for (int j = 0; j < 4; ++j) { x[2 * j] = __builtin_bit_cast(float, pw[j] << 16); x[2 * j + 1] = __builtin_bit_cast(float, pw[j] & 0xffff0000u); cm[j] = c0[j]; cm[4 + j] = c1[j]; }
        if (ISQ) {
#pragma unroll
            for (int j = 0; j < 8; ++j) x[j] *= 0.14433756729740643f; }
    } else if constexpr (TYPE == 1) {
        const float* cp = (const float*)(ws + WS_CUM) + row * NDV + 192 + h * DK + d0; const f32x4 c0 = *(const f32x4*)cp, c1 = *(const f32x4*)(cp + 4);
#pragma unroll
        for (int j = 0; j < 4; ++j) { cm[j] = c0[j]; cm[4 + j] = c1[j]; }
        if (ISQ) { const v4u p = *(const v4u*)(pr + C_HQ + h * DK + d0); const unsigned pw[4] = {p.x, p.y, p.z, p.w};
#pragma unroll
            for (int j = 0; j < 4; ++j) { x[2 * j] = __builtin_bit_cast(float, pw[j] << 16); x[2 * j + 1] = __builtin_bit_cast(float, pw[j] & 0xffff0000u); } }
        else { f32x4 p0 = {0.f, 0.f, 0.f, 0.f}, p1 = {0.f, 0.f, 0.f, 0.f}; if (t > 0) { p0 = *(const f32x4*)(cp - NDV); p1 = *(const f32x4*)(cp - NDV + 4); }
#pragma unroll
            for (int j = 0; j < 4; ++j) { x[j] = 1.0f - __expf(c0[j] - p0[j]); x[4 + j] = 1.0f - __expf(c1[j] - p1[j]); } }
    } else {
        const int f0 = (d0 < 24) ? d0 : d0 - 24, dp = (d0 < 24) ? d0 + 24 : d0 - 24; const float sg = (d0 < 24) ? -1.f : 1.f;
        const int cb = (ISQ ? C_RQ : C_RK) + h * DK; const v4u p = *(const v4u*)(pr + cb + d0), pp = *(const v4u*)(pr + cb + dp); const unsigned pw[4] = {p.x, p.y, p.z, p.w}, qw[4] = {pp.x, pp.y, pp.z, pp.w};
        const float* rp = (const float*)(ws + WS_ROPE) + row * 48; const f32x4 cs0 = *(const f32x4*)(rp + f0), cs1 = *(const f32x4*)(rp + f0 + 4), sn0 = *(const f32x4*)(rp + 24 + f0), sn1 = *(const f32x4*)(rp + 24 + f0 + 4);
        const float cmv = (float)(t + 1) * ret_lg(h);
#pragma unroll
        for (int j = 0; j < 4; ++j) { const float xa = __builtin_bit_cast(float, pw[j] << 16), xb = __builtin_bit_cast(float, pw[j] & 0xffff0000u), ya = __builtin_bit_cast(float, qw[j] << 16), yb = __builtin_bit_cast(float, qw[j] & 0xffff0000u);
            const float ca = (j < 2) ? cs0[2 * j] : cs1[2 * j - 4], cb2 = (j < 2) ? cs0[2 * j + 1] : cs1[2 * j - 3], sa = (j < 2) ? sn0[2 * j] : sn1[2 * j - 4], sb = (j < 2) ? sn0[2 * j + 1] : sn1[2 * j - 3];
            x[2 * j] = xa * ca + sg * ya * sa; x[2 * j + 1] = xb * cb2 + sg * yb * sb; cm[2 * j] = cmv; cm[2 * j + 1] = cmv; }
        if (ISQ) {
#pragma unroll
            for (int j = 0; j < 8; ++j) x[j] *= 0.14433756729740643f; }
    }
}

template <int TYPE>
__device__ __forceinline__ void mixc_batch(const Args& a, int layer, int unit, LAS unsigned char* lds, int tid, int lane, int wave) {
    typedef MixCfg<TYPE> C; constexpr int DK = C::DK, DV = C::DV, NV = C::NV, TE = DV / 16;
    unsigned char* ws = a.ws; const bf16* PROJ = (const bf16*)(ws + WS_PROJ); bf16* MIX = (bf16*)(ws + WS_MIX);
    LAS bf16* VT = (LAS bf16*)(lds + LC_VT); LAS bf16* ST = (LAS bf16*)(lds + LC_ST); LAS bf16* AB = (LAS bf16*)(lds + LC_AB) + wave * 16 * OBP;
    const int row0 = unit * CH;
    stage_vt<NV>(PROJ + (size_t)row0 * NPROJ + C::CV, VT, tid);
    { const bf16* SPu = (const bf16*)(ws + WS_SP) + (size_t)unit * ST_TOT + C::STOFF;
        for (int idx = tid; idx < NV * 8; idx += NTHR) { const int er = idx >> 3, ch = idx & 7; v4u w = {0u, 0u, 0u, 0u}; if (ch * 8 < DK) w = *(const v4u*)(SPu + (size_t)er * DK + ch * 8); *(LAS v4u*)(ST + er * BP + ch * 8) = w; } }
    __syncthreads();
    const int h = wave >> 1, hsel = wave & 1, r = lane & 15, g = lane >> 4;
    const LAS bf16* STh = ST + h * DV * BP; const LAS bf16* VTh = VT + h * DV * BP;
    const float* CUMp = (const float*)(ws + WS_CUM);
    for (int ib = 0; ib < 2; ++ib) { const int I = ib ? 3 - hsel : hsel;
        pg8::bf16x8 qh[2], qt[2]; float refv[2][8];
#pragma unroll
        for (int s = 0; s < 2; ++s) { const int d0 = 32 * s + 8 * g; const bool valid = d0 < DK; const int d0c = valid ? d0 : 0;
            float x[8], cm[8]; mix_frag<TYPE, true>(a, h, (size_t)(row0 + 16 * I + r), 16 * I + r, d0c, x, cm);
            if constexpr (TYPE == 2) {
#pragma unroll
                for (int j = 0; j < 8; ++j) refv[s][j] = (float)(16 * I) * ret_lg(h);
            } else { if (I > 0) { const float* cp = CUMp + (size_t)(row0 + 16 * I - 1) * NDV + C::COFF + h * DK + d0c; const f32x4 c0 = *(const f32x4*)cp, c1 = *(const f32x4*)(cp + 4);
#pragma unroll
                    for (int j = 0; j < 4; ++j) { refv[s][j] = c0[j]; refv[s][4 + j] = c1[j]; } }
                else {
#pragma unroll
                    for (int j = 0; j < 8; ++j) refv[s][j] = 0.f; } }
            float xh[8], xt[8];
#pragma unroll
            for (int j = 0; j < 8; ++j) { xh[j] = valid ? x[j] * __expf(cm[j] - refv[s][j]) : 0.f; xt[j] = valid ? x[j] * __expf(cm[j]) : 0.f; }
            qh[s] = pack8(xh); qt[s] = pack8(xt); }
        for (int J = 0; J <= I; ++J) { f32x4 acc = {0.f, 0.f, 0.f, 0.f};
#pragma unroll
            for (int s = 0; s < 2; ++s) { const int d0 = 32 * s + 8 * g; const bool valid = d0 < DK; const int d0c = valid ? d0 : 0;
                float x[8], cm[8]; mix_frag<TYPE, false>(a, h, (size_t)(row0 + 16 * J + r), 16 * J + r, d0c, x, cm);
                float xk[8];
#pragma unroll
                for (int j = 0; j < 8; ++j) xk[j] = valid ? x[j] * __expf(fminf(refv[s][j] - cm[j], 80.f)) : 0.f;
                acc = __builtin_amdgcn_mfma_f32_16x16x32_bf16(qh[s], pack8(xk), acc, 0, 0, 0); }
#pragma unroll
            for (int q = 0; q < 4; ++q) { const int i = 4 * g + q; const float v = (J < I || r <= i) ? acc[q] : 0.f; AB[i * BP + 16 * J + r] = (bf16)f2bf(v); } }
        if ((I & 1) == 0) {
#pragma unroll
            for (int q = 0; q < 4; ++q) AB[(4 * g + q) * BP + 16 * (I + 1) + r] = (bf16)0; }
        asm volatile("s_waitcnt lgkmcnt(0)" ::: "memory");
        const pg8::bf16x8 ah0 = *(const LAS pg8::bf16x8*)(AB + r * BP + 8 * g), ah1 = *(const LAS pg8::bf16x8*)(AB + r * BP + 32 + 8 * g);
        f32x4 o[TE];
#pragma unroll
        for (int te = 0; te < TE; ++te) { f32x4 acc = {0.f, 0.f, 0.f, 0.f};
            acc = __builtin_amdgcn_mfma_f32_16x16x32_bf16(qt[0], ldfrag(STh, BP, te * 16, 0, lane), acc, 0, 0, 0);
            acc = __builtin_amdgcn_mfma_f32_16x16x32_bf16(qt[1], ldfrag(STh, BP, te * 16, 32, lane), acc, 0, 0, 0);
            acc = __builtin_amdgcn_mfma_f32_16x16x32_bf16(ah0, ldfrag(VTh, BP, te * 16, 0, lane), acc, 0, 0, 0);
            if (I >= 2) acc = __builtin_amdgcn_mfma_f32_16x16x32_bf16(ah1, ldfrag(VTh, BP, te * 16, 32, lane), acc, 0, 0, 0);
            o[te] = acc; }
#pragma unroll
        for (int q = 0; q < 4; ++q) { float s1 = 0.f, s2 = 0.f;
#pragma unroll
            for (int te = 0; te < TE; ++te) { s1 += o[te][q]; s2 += o[te][q] * o[te][q]; }
#pragma unroll
            for (int m = 1; m < 16; m <<= 1) { s1 += __shfl_xor(s1, m); s2 += __shfl_xor(s2, m); }
            float mean = 0.f, rstd;
            if constexpr (TYPE == 2) { mean = s1 * (1.0f / DV); rstd = 1.0f / sqrtf(fmaxf(s2 * (1.0f / DV) - mean * mean, 0.f) + EPS); }
            else rstd = 1.0f / sqrtf(s2 * (1.0f / DV) + EPS);
#pragma unroll
            for (int te = 0; te < TE; ++te) AB[(4 * g + q) * OBP + te * 16 + r] = (bf16)f2bf((o[te][q] - mean) * rstd); }
        asm volatile("s_waitcnt lgkmcnt(0)" ::: "memory");
        constexpr int NCHK = DV / 8;
#pragma unroll
        for (int i = 0; i < (16 * NCHK) / 64; ++i) { const int cidx = lane + 64 * i, orow = cidx / NCHK, ch = cidx - orow * NCHK; const size_t row = (size_t)(row0 + 16 * I + orow);
            const v4u ov = *(const LAS v4u*)(AB + orow * OBP + 8 * ch); const v4u gv = *(const v4u*)(PROJ + row * NPROJ + C::CG + h * DV + 8 * ch);
            const unsigned ow[4] = {ov.x, ov.y, ov.z, ov.w}, gw[4] = {gv.x, gv.y, gv.z, gv.w}; float res[8];
            f32x4 w0 = {1.f, 1.f, 1.f, 1.f}, w1 = {1.f, 1.f, 1.f, 1.f};
            if constexpr (TYPE == 0) { const float* wp = a.gla_norm_w + layer * 384 + h * 96 + 8 * ch; w0 = *(const f32x4*)wp; w1 = *(const f32x4*)(wp + 4); }
            if constexpr (TYPE == 1) { const float* wp = a.hg_norm_w + layer * 256 + h * 64 + 8 * ch; w0 = *(const f32x4*)wp; w1 = *(const f32x4*)(wp + 4); }
#pragma unroll
            for (int j = 0; j < 4; ++j) { const float oa = __builtin_bit_cast(float, ow[j] << 16), ob = __builtin_bit_cast(float, ow[j] & 0xffff0000u), ga = __builtin_bit_cast(float, gw[j] << 16), gb = __builtin_bit_cast(float, gw[j] & 0xffff0000u);
                const float wa = (j < 2) ? w0[2 * j] : w1[2 * j - 4], wb = (j < 2) ? w0[2 * j + 1] : w1[2 * j - 3];
                const float sa = 1.0f / (1.0f + __expf(-ga)), sb = 1.0f / (1.0f + __expf(-gb));
                res[2 * j] = oa * wa * ((TYPE == 1) ? sa : ga * sa); res[2 * j + 1] = ob * wb * ((TYPE == 1) ? sb : gb * sb); }
            if (F8_OUT) { typedef int i32x2 __attribute__((ext_vector_type(2)));
                *(i32x2*)((unsigned char*)MIX + row * D + C::MIXOFF + h * DV + 8 * ch) = (i32x2){pk4_fp8(res[0] * S8_M, res[1] * S8_M, res[2] * S8_M, res[3] * S8_M), pk4_fp8(res[4] * S8_M, res[5] * S8_M, res[6] * S8_M, res[7] * S8_M)}; }
            else { v4u w; w.x = pk2(res[0], res[1]); w.y = pk2(res[2], res[3]); w.z = pk2(res[4], res[5]); w.w = pk2(res[6], res[7]); *(v4u*)(MIX + row * D + C::MIXOFF + h * DV + 8 * ch) = w; } }
    }
    __syncthreads();
}
__device__ __forceinline__ void p3c_outputs(const Args& a, int layer, LAS unsigned char* lds, int vcu, int G, int tid, int lane, int wave) {
    for (int unit = vcu; unit < NUNIT; unit += G) {
        mixc_batch<0>(a, layer, unit, lds, tid, lane, wave);
        mixc_batch<1>(a, layer, unit, lds, tid, lane, wave);
        mixc_batch<2>(a, layer, unit, lds, tid, lane, wave);
    }
}

constexpr int MW_ARGS = 800;
__device__ __forceinline__ const void* ld_argp(const volatile LAS unsigned* T, int i) {
    const unsigned lo = __builtin_amdgcn_readfirstlane(T[2 * i]), hi = __builtin_amdgcn_readfirstlane(T[2 * i + 1]);
    return (const void*)(((unsigned long long)hi << 32) | lo);
}
__device__ __forceinline__ Args load_args(LAS unsigned char* lds) {
    const volatile LAS unsigned* T = (const volatile LAS unsigned*)(lds + MISC_OFF) + MW_ARGS;
    Args a;
    a.x = (const float*)ld_argp(T, 0); a.c = (const float*)ld_argp(T, 1); a.pos = (const int*)ld_argp(T, 2); a.w_mod = (const float*)ld_argp(T, 3); a.b_mod = (const float*)ld_argp(T, 4);
    a.norm1_w = (const float*)ld_argp(T, 5); a.w_in = (const float*)ld_argp(T, 6); a.gla_wa2 = (const float*)ld_argp(T, 7); a.gla_ba2 = (const float*)ld_argp(T, 8); a.hg_lb = (const float*)ld_argp(T, 9);
    a.gla_norm_w = (const float*)ld_argp(T, 10); a.hg_norm_w = (const float*)ld_argp(T, 11); a.w_out = (const float*)ld_argp(T, 12); a.norm2_w = (const float*)ld_argp(T, 13); a.w_r = (const float*)ld_argp(T, 14);
    a.b_r = (const float*)ld_argp(T, 15); a.w_gu = (const float*)ld_argp(T, 16); a.b_gu = (const float*)ld_argp(T, 17); a.w_dn = (const float*)ld_argp(T, 18); a.b_dn = (const float*)ld_argp(T, 19);
    a.final_norm_w = (const float*)ld_argp(T, 20); a.out = (float*)ld_argp(T, 21); a.ws = (unsigned char*)ld_argp(T, 22); a.ph_lo = 0; a.ph_hi = 0;
    return a;
}
#define PH_CTX() { unsigned l_ = (unsigned)(size_t)lds; asm volatile("" : "+s"(l_)); lds = (LAS unsigned char*)(size_t)l_; } const Args args = load_args(lds); volatile LAS unsigned* MISC = (volatile LAS unsigned*)(lds + MISC_OFF); int tid_ = wv * 64 + (int)__builtin_amdgcn_mbcnt_hi(~0u, __builtin_amdgcn_mbcnt_lo(~0u, 0u)); asm volatile("" : "+v"(tid_)); const int tid = tid_, lane = tid & 63, wave = __builtin_amdgcn_readfirstlane(tid >> 6); \
    const int G = gridDim.x; const int bx = blockIdx.x; const int vcu = (G % 8 == 0) ? (bx % 8) * (G / 8) + bx / 8 : bx; unsigned char* ws = args.ws; gu32* ctl = (gu32*)(ws + WS_CTL); \
    (void)MISC; (void)lane; (void)wave; (void)vcu; (void)ctl; (void)bx; (void)tid
__device__ __forceinline__ void ph_p0(LAS unsigned char* lds, int wv) { PH_CTX(); p0_prologue(args, lds, vcu, G, tid, lane, wave); }
__device__ __forceinline__ void ph_p1(LAS unsigned char* lds, int wv, int layer_) { int layer = __builtin_amdgcn_readfirstlane(layer_); asm volatile("" : "+s"(layer)); PH_CTX(); rows_mfma<16>(args, layer, lds, MISC, ctl, vcu, G, tid, lane, wave); }
__device__ __forceinline__ void ph_p2(LAS unsigned char* lds, int wv, int layer_) { int layer = __builtin_amdgcn_readfirstlane(layer_); asm volatile("" : "+s"(layer)); PH_CTX();
    pg8::Gemm g{(const bf16*)(ws + WS_H), (const bf16*)(ws + WS_WIN + (size_t)layer * NPROJ * D * (F8_IN ? 1 : 2)), MTOK, NPROJ, F8_IN ? D / 2 : D}; pg8::StaticOrder S; S.init(MTOK, NPROJ, G, bx);
    pg8::EpiBf16Plain E{(bf16*)(ws + WS_PROJ), NPROJ, F8_IN ? 1.0f / (S8_H * S8_W) : 1.0f};
    pg8::gemm_phase<pg8::EpiBf16Plain, pg8::StaticOrder, true, true, F8_IN>(lds, g, S, E, tid); }
__device__ __forceinline__ void ph_p3a(LAS unsigned char* lds, int wv, int layer_) { int layer = __builtin_amdgcn_readfirstlane(layer_); asm volatile("" : "+s"(layer)); PH_CTX(); p3a_summaries(args, layer, lds, vcu, G, tid, lane, wave); }
__device__ __forceinline__ void ph_p3b(LAS unsigned char* lds, int wv) { PH_CTX(); p3b_scan(args, vcu, G, tid); }
__device__ __forceinline__ void ph_p3c(LAS unsigned char* lds, int wv, int layer_) { int layer = __builtin_amdgcn_readfirstlane(layer_); asm volatile("" : "+s"(layer)); PH_CTX(); p3c_outputs(args, layer, lds, vcu, G, tid, lane, wave); }
__device__ __forceinline__ void ph_p4(LAS unsigned char* lds, int wv, int layer_) { int layer = __builtin_amdgcn_readfirstlane(layer_); asm volatile("" : "+s"(layer)); PH_CTX();
    pg8::Gemm g{(const bf16*)(ws + WS_MIX), (const bf16*)(ws + WS_WOUT + (size_t)layer * D * D * (F8_OUT ? 1 : 2)), MTOK, D, F8_OUT ? D / 2 : D}; pg8::StaticOrder S; S.init(MTOK, D, G, bx);
    pg8::EpiResGate E{(layer == 0) ? args.x : (const float*)(ws + WS_X), (float*)(ws + WS_X), D, (const float*)(ws + WS_MOD) + (size_t)layer * 2 * 6144 + 2 * D, 6144, SEQ, F8_OUT ? 1.0f / (S8_M * S8_W) : 1.0f};
    pg8::gemm_phase<pg8::EpiResGate, pg8::StaticOrder, true, true, F8_OUT>(lds, g, S, E, tid); }
__device__ __forceinline__ void ph_p5(LAS unsigned char* lds, int wv, int layer_) { int layer = __builtin_amdgcn_readfirstlane(layer_); asm volatile("" : "+s"(layer)); PH_CTX(); rows_mfma<32>(args, layer, lds, MISC, ctl, vcu, G, tid, lane, wave); }
__device__ __forceinline__ void ph_p6(LAS unsigned char* lds, int wv, int layer_) { int layer = __builtin_amdgcn_readfirstlane(layer_); asm volatile("" : "+s"(layer)); PH_CTX(); p6_dispatch(args, layer, MISC, ctl, vcu, G, tid, lane, wave); }
__device__ __forceinline__ void ph_p7(LAS unsigned char* lds, int wv, int layer_) { int layer = __builtin_amdgcn_readfirstlane(layer_); asm volatile("" : "+s"(layer)); PH_CTX();
    moe_tables(ctl, layer, MISC, tid);
    const int nrt = __builtin_amdgcn_readfirstlane((int)MISC[MW_NRT]);
    pg8::Gemm g{(const bf16*)(ws + WS_A1), (const bf16*)(ws + WS_WGU + (size_t)layer * NE * 2048 * D), nrt * 256, NE * 2048, D / 2};
    pg8::MoeOrder S{8, G, vcu, nrt * 8, (const LAS int*)(lds + MISC_OFF + 4 * MW_TILE)};
    pg8::EpiSwiglu E{ws + WS_ACT, FFN, args.b_gu + (size_t)layer * NE * 2048, 1.0f / (S8_H * S8_W), S8_A};
    pg8::gemm_phase<pg8::EpiSwiglu, pg8::MoeOrder, true, true, true>(lds, g, S, E, tid); }
__device__ __forceinline__ void ph_p8(LAS unsigned char* lds, int wv, int layer_) { int layer = __builtin_amdgcn_readfirstlane(layer_); asm volatile("" : "+s"(layer)); PH_CTX();
    moe_tables(ctl, layer, MISC, tid);
    const int nrt = __builtin_amdgcn_readfirstlane((int)MISC[MW_NRT]);
    pg8::Gemm g{(const bf16*)(ws + WS_ACT), (const bf16*)(ws + WS_WDN + (size_t)layer * NE * D * FFN), nrt * 256, NE * D, FFN / 2};
    pg8::MoeOrder S{4, G, vcu, nrt * 4, (const LAS int*)(lds + MISC_OFF + 4 * MW_TILE)};
    pg8::EpiBf16Bias E{(bf16*)(ws + WS_Y), D, args.b_dn + (size_t)layer * NE * D, D, 1.0f / (S8_A * S8_W)};
    pg8::gemm_phase<pg8::EpiBf16Bias, pg8::MoeOrder, true, true, true>(lds, g, S, E, tid); }
__device__ __forceinline__ void ph_final(LAS unsigned char* lds, int wv) { PH_CTX(); final_rows(args, lds, vcu, G, tid, lane); }

#ifndef DBL_MASK
#define DBL_MASK 0
#endif
#if DBL_MASK
#define RUN(bit, call) do { if ((DBL_MASK >> (bit)) & 1) { const unsigned long long t0_ = __builtin_amdgcn_s_memrealtime(); call; const unsigned long long t1_ = __builtin_amdgcn_s_memrealtime(); \
        while (__builtin_amdgcn_s_memrealtime() - t1_ < t1_ - t0_) __builtin_amdgcn_s_sleep(8); } else { call; } } while (0)
#else
#define RUN(bit, call) do { call; } while (0)
#endif
__global__ void __launch_bounds__(NTHR, 2) hybrid_fwd(Args args) {
    extern __shared__ __attribute__((aligned(16))) unsigned char lds_raw[];
    LAS unsigned char* lds = (LAS unsigned char*)lds_raw;
    volatile LAS unsigned* MISC = (volatile LAS unsigned*)(lds + MISC_OFF);
    const int tid = threadIdx.x; const int wv = __builtin_amdgcn_readfirstlane(tid >> 6);
    gu32* ctl = (gu32*)(args.ws + WS_CTL);
    for (int u = tid; u < (LDS_BYTES - MISC_OFF) / 4; u += NTHR) MISC[u] = 0u;
    __syncthreads();
    if (tid == 0) {
#define ST_ARG(i, p) do { const unsigned long long v_ = (unsigned long long)(p); MISC[MW_ARGS + 2 * (i)] = (unsigned)v_; MISC[MW_ARGS + 2 * (i) + 1] = (unsigned)(v_ >> 32); } while (0)
        ST_ARG(0, args.x); ST_ARG(1, args.c); ST_ARG(2, args.pos); ST_ARG(3, args.w_mod); ST_ARG(4, args.b_mod); ST_ARG(5, args.norm1_w); ST_ARG(6, args.w_in); ST_ARG(7, args.gla_wa2); ST_ARG(8, args.gla_ba2);
        ST_ARG(9, args.hg_lb); ST_ARG(10, args.gla_norm_w); ST_ARG(11, args.hg_norm_w); ST_ARG(12, args.w_out); ST_ARG(13, args.norm2_w); ST_ARG(14, args.w_r); ST_ARG(15, args.b_r); ST_ARG(16, args.w_gu);
        ST_ARG(17, args.b_gu); ST_ARG(18, args.w_dn); ST_ARG(19, args.b_dn); ST_ARG(20, args.final_norm_w); ST_ARG(21, args.out); ST_ARG(22, args.ws);
#undef ST_ARG
    }
    __syncthreads();
    const int lo = args.ph_lo, hi = args.ph_hi;
    const bool multi = (hi - lo) > 1;
    XcdBarrier bar; bar.bar = (unsigned*)(ctl + CW_BAR); bar.x = 0; bar.st = nullptr;
    if (multi) bar = xcd_barrier_post((unsigned*)(ctl + CW_BAR), MISC + MW_BAR);
#define IN(k) (lo <= (k) && (k) < hi)
#define SEAM(k) do { if (IN(k) && IN((k) + 1)) xcd_barrier(bar); } while (0)

    if (IN(0)) RUN(0, ph_p0(lds, wv));
    SEAM(0);
    for (int layer = 0; layer < DEPTH; ++layer) {
        const int pb = 1 + 10 * layer;
        if (IN(pb + 0)) RUN(1, ph_p1(lds, wv, layer));
        SEAM(pb + 0);
        if (IN(pb + 1)) RUN(2, ph_p2(lds, wv, layer));
        SEAM(pb + 1);
        if (IN(pb + 2)) RUN(3, ph_p3a(lds, wv, layer));
        SEAM(pb + 2);
        if (IN(pb + 3)) RUN(4, ph_p3b(lds, wv));
        SEAM(pb + 3);
        if (IN(pb + 4)) RUN(5, ph_p3c(lds, wv, layer));
        SEAM(pb + 4);
        if (IN(pb + 5)) RUN(6, ph_p4(lds, wv, layer));
        SEAM(pb + 5);
        if (IN(pb + 6)) RUN(7, ph_p5(lds, wv, layer));
        SEAM(pb + 6);
        if (IN(pb + 7)) RUN(8, ph_p6(lds, wv, layer));
        SEAM(pb + 7);
        if (IN(pb + 8)) RUN(9, ph_p7(lds, wv, layer));
        SEAM(pb + 8);
        if (IN(pb + 9)) RUN(10, ph_p8(lds, wv, layer));
        SEAM(pb + 9);
    }
    if (IN(NPHASE - 1)) RUN(11, ph_final(lds, wv));
#undef IN
#undef SEAM
}

#ifndef MK_SINGLE
#define MK_SINGLE 1
#endif
extern "C" void kernel_launch(void* const* d_in, const int* in_sizes, int n_in, void* d_out, int out_size, void* d_ws, size_t ws_size, hipStream_t stream) {
    static int grid = 0;
    if (grid == 0) {
        if (n_in != 21 || in_sizes[0] != MTOK * D || out_size != MTOK * D || ws_size < WS_END) { fprintf(stderr, "kernel_launch: unexpected problem shape (n_in %d, in0 %d, out %d, ws %zu)\n", n_in, n_in > 0 ? in_sizes[0] : -1, out_size, ws_size); grid = -1; return; }
        int dev = 0, cus = 0, per_cu = 0;
        if (hipGetDevice(&dev) != hipSuccess || hipDeviceGetAttribute(&cus, hipDeviceAttributeMultiprocessorCount, dev) != hipSuccess) { grid = -1; return; }
        if (hipFuncSetAttribute((const void*)hybrid_fwd, hipFuncAttributeMaxDynamicSharedMemorySize, LDS_BYTES) != hipSuccess) { fprintf(stderr, "kernel_launch: hipFuncSetAttribute failed\n"); grid = -1; return; }
        if (hipOccupancyMaxActiveBlocksPerMultiprocessor(&per_cu, (const void*)hybrid_fwd, NTHR, LDS_BYTES) != hipSuccess || per_cu < 1) fprintf(stderr, "kernel_launch: occupancy query says %d\n", per_cu);
        (void)hipGetLastError();
        grid = cus;
    }
    if (grid < 0) return;
    (void)hipMemsetAsync((char*)d_ws + WS_CTL, 0, CTL_ZERO_BYTES, stream);
    Args a{};
    a.x = (const float*)d_in[0]; a.c = (const float*)d_in[1]; a.pos = (const int*)d_in[2]; a.w_mod = (const float*)d_in[3]; a.b_mod = (const float*)d_in[4]; a.norm1_w = (const float*)d_in[5];
    a.w_in = (const float*)d_in[6]; a.gla_wa2 = (const float*)d_in[7]; a.gla_ba2 = (const float*)d_in[8]; a.hg_lb = (const float*)d_in[9]; a.gla_norm_w = (const float*)d_in[10]; a.hg_norm_w = (const float*)d_in[11];
    a.w_out = (const float*)d_in[12]; a.norm2_w = (const float*)d_in[13]; a.w_r = (const float*)d_in[14]; a.b_r = (const float*)d_in[15]; a.w_gu = (const float*)d_in[16]; a.b_gu = (const float*)d_in[17];
    a.w_dn = (const float*)d_in[18]; a.b_dn = (const float*)d_in[19]; a.final_norm_w = (const float*)d_in[20]; a.out = (float*)d_out; a.ws = (unsigned char*)d_ws;
#if MK_SINGLE
    a.ph_lo = 0; a.ph_hi = NPHASE;
    hipLaunchKernelGGL(hybrid_fwd, dim3(grid), dim3(NTHR), LDS_BYTES, stream, a);
#else
    for (int p = 0; p < NPHASE; ++p) { a.ph_lo = p; a.ph_hi = p + 1; hipLaunchKernelGGL(hybrid_fwd, dim3(grid), dim3(NTHR), LDS_BYTES, stream, a); }
#endif
}
```

```cpp
#include <hip/hip_runtime.h>
#include <cstdio>
#include <cstdint>
namespace pg8 {
#define PG8_LAS __attribute__((address_space(3)))
typedef unsigned short bf16_t;
typedef short bf16x8 __attribute__((ext_vector_type(8)));
typedef float f32x4 __attribute__((ext_vector_type(4)));
typedef unsigned u32x4 __attribute__((ext_vector_type(4)));
constexpr int BM = 256, BK = 64, HALF = 128, HTB = HALF * BK * 2  , STAGE_BYTES = 8 * HTB, NXCD = 8, WGM = 8;

__host__ __device__ __forceinline__ int lds_byte(int r, int c) { const int st = (r >> 4) * 2 + (c >> 5), rr = r & 15, cc = c & 31, ob = rr * 64 + cc * 2; return st * 1024 + (ob ^ (((ob >> 9) & 1) << 5)); }
__host__ __device__ __forceinline__ void stage_rc(int b, int& R, int& C) { const int st = b / 1024, sb = b % 1024, swz = sb ^ (((sb >> 9) & 1) << 5); R = (st >> 1) * 16 + swz / 64; C = (st & 1) * 32 + (swz % 64) / 2; }
__host__ __device__ __forceinline__ int perm32(int rho) { const int n = rho >> 4, i = rho & 15; return 8 * (i >> 2) + 4 * n + (i & 3); }

struct Unit { int pm, pn, e, pl; };
struct Gemm { const bf16_t* A; const bf16_t* Bt; int M, N, K; };

struct StaticOrder {
    int nM, nN, nwg, G, c;
    __host__ __device__ void init(int M, int N, int G_, int c_) { nM = M / BM; nN = N / BM; nwg = nM * nN; G = G_; c = c_; }
    __host__ __device__ bool next(int i, Unit& u) const {
        const long L = (long)i * G + c; if (L >= nwg) return false;
        int wgid = (int)L; { const int q = nwg / NXCD, r = nwg % NXCD, xcd = wgid % NXCD, off = wgid / NXCD; wgid = (xcd < r ? xcd * (q + 1) : r * (q + 1) + (xcd - r) * q) + off; }
        const int nig = WGM * nN, gid = wgid / nig, fm = gid * WGM, gsz = (nM - fm) < WGM ? (nM - fm) : WGM;
        u.pm = fm + ((wgid % nig) % gsz); u.pn = (wgid % nig) / gsz; u.e = 0; u.pl = u.pn; return true;
    }
    __device__ __forceinline__ void a_ready(const Unit&) const {}
    __device__ __forceinline__ void done(const Unit&) const {}
};

__device__ __forceinline__ unsigned cvt_pk_bf16(float lo, float hi) { unsigned r; asm volatile("v_cvt_pk_bf16_f32 %0, %1, %2" : "=v"(r) : "v"(lo), "v"(hi)); return r; }

struct EpiBf16Plain {
    static constexpr bool PERM = true, AFTER_DRAIN = false;
    bf16_t* O; int ldc; float sc;
    __device__ __forceinline__ void operator()(const f32x4 (&acc)[2][2][4][2], const Unit& u, int wr, int wc, int fr, int fq) const {
        const int row0 = u.pm * BM + wr * 64 + fr; const int col0 = u.pn * BM + wc * 32 + 8 * fq;
#pragma unroll
        for (int ai = 0; ai < 2; ++ai)
#pragma unroll
            for (int m = 0; m < 4; ++m) { bf16_t* rowp = O + (size_t)(row0 + ai * HALF + m * 16) * ldc + col0;
#pragma unroll
                for (int bj = 0; bj < 2; ++bj) { const f32x4 v0 = acc[ai][bj][m][0] * sc, v1 = acc[ai][bj][m][1] * sc;
                    u32x4 w; w.x = cvt_pk_bf16(v0[0], v0[1]); w.y = cvt_pk_bf16(v0[2], v0[3]); w.z = cvt_pk_bf16(v1[0], v1[1]); w.w = cvt_pk_bf16(v1[2], v1[3]);
                    *(u32x4*)(rowp + bj * HALF) = w; } }
    }
};
struct EpiResGate {
    static constexpr bool PERM = false, AFTER_DRAIN = false;
    const float* base; float* out; int ldc; const float* gate; int gpitch; int rows_per_batch; float sc;
    __device__ __forceinline__ void operator()(const f32x4 (&acc)[2][2][4][2], const Unit& u, int wr, int wc, int fr, int fq) const {
        const int row0 = u.pm * BM + wr * 64 + fr, col0 = u.pn * BM + wc * 32 + 4 * fq;
        const float* gp = gate + (size_t)((u.pm * BM) / rows_per_batch) * gpitch + col0;
        f32x4 gv[2][2];
#pragma unroll
        for (int bj = 0; bj < 2; ++bj)
#pragma unroll
            for (int n = 0; n < 2; ++n) gv[bj][n] = *(const f32x4*)(gp + bj * HALF + n * 16) * sc;
#pragma unroll
        for (int ai = 0; ai < 2; ++ai)
#pragma unroll
            for (int m = 0; m < 4; ++m) { const size_t off = (size_t)(row0 + ai * HALF + m * 16) * ldc + col0;
#pragma unroll
                for (int bj = 0; bj < 2; ++bj)
#pragma unroll
                    for (int n = 0; n < 2; ++n) { const f32x4 bs = *(const f32x4*)(base + off + bj * HALF + n * 16);
                        *(f32x4*)(out + off + bj * HALF + n * 16) = bs + gv[bj][n] * acc[ai][bj][m][n]; }
                asm volatile("" ::: "memory"); }
    }
};
struct EpiSwiglu {
    static constexpr bool PERM = true, AFTER_DRAIN = false;
    unsigned char* O; int ldc; const float* bias; float inv_in, out_scale;
    __device__ __forceinline__ float act1(float g, float up) const {
        g = fminf(g, 7.0f); up = fminf(fmaxf(up, -7.0f), 7.0f);
        const float s = 1.0f / (1.0f + __expf(-1.702f * g));
        return fminf(fmaxf((up + 1.0f) * g * s * out_scale, -448.f), 448.f);
    }
    __device__ __forceinline__ void operator()(const f32x4 (&acc)[2][2][4][2], const Unit& u, int wr, int wc, int fr, int fq) const {
        const int row0 = u.pm * BM + wr * 64 + fr; const int jj0 = wc * 32 + 8 * fq; const int col0 = u.pl * HALF + jj0;
        const float* bp = bias + (size_t)u.e * 2048 + col0;
        f32x4 bg[2], bu[2];
#pragma unroll
        for (int n = 0; n < 2; ++n) { bg[n] = *(const f32x4*)(bp + 4 * n); bu[n] = *(const f32x4*)(bp + 1024 + 4 * n); }
#pragma unroll
        for (int ai = 0; ai < 2; ++ai)
#pragma unroll
            for (int m = 0; m < 4; ++m) { unsigned char* rowp = O + (size_t)(row0 + ai * HALF + m * 16) * ldc + col0;
                f32x4 r[2];
#pragma unroll
                for (int n = 0; n < 2; ++n) { const f32x4 g = acc[ai][0][m][n] * inv_in + bg[n], up = acc[ai][1][m][n] * inv_in + bu[n];
#pragma unroll
                    for (int j = 0; j < 4; ++j) r[n][j] = act1(g[j], up[j]); }
                int w0 = 0, w1 = 0;
                w0 = __builtin_amdgcn_cvt_pk_fp8_f32(r[0][0], r[0][1], w0, false); w0 = __builtin_amdgcn_cvt_pk_fp8_f32(r[0][2], r[0][3], w0, true);
                w1 = __builtin_amdgcn_cvt_pk_fp8_f32(r[1][0], r[1][1], w1, false); w1 = __builtin_amdgcn_cvt_pk_fp8_f32(r[1][2], r[1][3], w1, true);
                typedef int i32x2 __attribute__((ext_vector_type(2))); *(i32x2*)rowp = (i32x2){w0, w1}; }
    }
};
struct EpiBf16Bias {
    static constexpr bool PERM = true, AFTER_DRAIN = false;
    bf16_t* O; int ldc; const float* bias; int bpitch; float inv_in;
    __device__ __forceinline__ void operator()(const f32x4 (&acc)[2][2][4][2], const Unit& u, int wr, int wc, int fr, int fq) const {
        const int row0 = u.pm * BM + wr * 64 + fr; const int col0 = u.pl * BM + wc * 32 + 8 * fq;
        const float* bp = bias + (size_t)u.e * bpitch + col0;
        f32x4 bv[2][2];
#pragma unroll
        for (int bj = 0; bj < 2; ++bj)
#pragma unroll
            for (int n = 0; n < 2; ++n) bv[bj][n] = *(const f32x4*)(bp + bj * HALF + 4 * n);
#pragma unroll
        for (int ai = 0; ai < 2; ++ai)
#pragma unroll
            for (int m = 0; m < 4; ++m) { bf16_t* rowp = O + (size_t)(row0 + ai * HALF + m * 16) * ldc + col0;
#pragma unroll
                for (int bj = 0; bj < 2; ++bj) { const f32x4 v0 = acc[ai][bj][m][0] * inv_in + bv[bj][0], v1 = acc[ai][bj][m][1] * inv_in + bv[bj][1];
                    u32x4 w; w.x = cvt_pk_bf16(v0[0], v0[1]); w.y = cvt_pk_bf16(v0[2], v0[3]); w.z = cvt_pk_bf16(v1[0], v1[1]); w.w = cvt_pk_bf16(v1[2], v1[3]);
                    *(u32x4*)(rowp + bj * HALF) = w; } }
    }
};
struct MoeOrder {
    int nN, G, c, nunits; const PG8_LAS int* tile_pm;
    __device__ __forceinline__ bool next(int i, Unit& u) const {
        const int L = i * G + c; if (L >= nunits) return false;
        const int idx = L / nN, pl = L - idx * nN, pm = __builtin_amdgcn_readfirstlane(tile_pm[idx]), e = pm >> 6;
        u.pm = pm; u.pl = pl; u.e = e; u.pn = e * nN + pl; return true;
    }
    __device__ __forceinline__ void a_ready(const Unit&) const {}
    __device__ __forceinline__ void done(const Unit&) const {}
};
typedef int v4i32_t __attribute__((ext_vector_type(4)));
typedef int v8i32_t __attribute__((ext_vector_type(8)));
template <class Epi, class Sched, bool ALIGN_EPI = false, bool SP2 = false, bool FP8 = false>
__device__ __forceinline__ void gemm_phase(PG8_LAS unsigned char* lds, const Gemm g, const Sched& S, const Epi& E, int tid_in) {
    int tid_ = tid_in; asm volatile("" : "+v"(tid_)); const int tid = tid_, wid = __builtin_amdgcn_readfirstlane(tid >> 6), lane = tid & 63, wr = wid >> 2, wc = wid & 3, fr = lane & 15, fq = lane >> 4;
    const int K = g.K, nt = K / BK;
    unsigned voffA, voffB;
    { int R, C; stage_rc(tid * 16, R, C); const int Rb = Epi::PERM ? ((R & ~31) + perm32(R & 31)) : R;
        voffA = (unsigned)(R * K + C) * 2u; voffB = (unsigned)(Rb * K + C) * 2u; }
    const size_t rstep = (size_t)64 * K * 2;
    const size_t kstep = (size_t)(BK * 2);
    const size_t hstep = (size_t)HALF * K * 2;
    const size_t tstep = 2 * hstep;
    const unsigned ldsw = (unsigned)wid * 1024u;
    const int aoff = lds_byte(wr * 64 + fr, fq * 8), boff = lds_byte(wc * 32 + fr, fq * 8);
#define PG8_SA(b, h) (((b) * 2 + (h)) * HTB)
#define PG8_SB(b, h) ((4 + (b) * 2 + (h)) * HTB)
#define PG8_STAGE(bufoff, gbase, voff) do { _Pragma("unroll") for (int _i = 0; _i < 2; ++_i) \
        __builtin_amdgcn_global_load_lds((const unsigned*)((const char*)(gbase) + _i * rstep + (voff)), (PG8_LAS unsigned*)(lds + (bufoff) + ldsw + _i * 8192), 16, 0, 0); } while (0)
#define PG8_LDA(dst, b, h) do { _Pragma("unroll") for (int m = 0; m < 4; ++m) _Pragma("unroll") for (int k = 0; k < 2; ++k) dst[m][k] = *(const PG8_LAS bf16x8*)(lds + PG8_SA(b, h) + aoff + m * 2048 + k * 1024); } while (0)
#define PG8_LDB(dst, b, h) do { _Pragma("unroll") for (int n = 0; n < 2; ++n) _Pragma("unroll") for (int k = 0; k < 2; ++k) dst[n][k] = *(const PG8_LAS bf16x8*)(lds + PG8_SB(b, h) + boff + n * 2048 + k * 1024); } while (0)
#define PG8_MMA(ai, bj, At, Bt) do { __builtin_amdgcn_s_setprio(1); _Pragma("unroll") for (int m = 0; m < 4; ++m) _Pragma("unroll") for (int n = 0; n < 2; ++n) { \
        if constexpr (FP8) { const v8i32_t a8_ = __builtin_shufflevector(__builtin_bit_cast(v4i32_t, At[m][0]), __builtin_bit_cast(v4i32_t, At[m][1]), 0, 1, 2, 3, 4, 5, 6, 7); \
            const v8i32_t b8_ = __builtin_shufflevector(__builtin_bit_cast(v4i32_t, Bt[n][0]), __builtin_bit_cast(v4i32_t, Bt[n][1]), 0, 1, 2, 3, 4, 5, 6, 7); \
            asm volatile("v_mfma_scale_f32_16x16x128_f8f6f4 %0, %1, %2, %0, %3, %3 op_sel_hi:[0,0,0]" : "+v"(acc[ai][bj][m][n]) : "v"(b8_), "v"(a8_), "v"(one8_)); } \
        else { _Pragma("unroll") for (int k = 0; k < 2; ++k) acc[ai][bj][m][n] = __builtin_amdgcn_mfma_f32_16x16x32_bf16(Bt[n][k], At[m][k], acc[ai][bj][m][n], 0, 0, 0); } } \
        __builtin_amdgcn_s_setprio(0); } while (0)
#define PG8_WAIT_V(n) asm volatile("s_waitcnt vmcnt(" #n ")" ::: "memory")
#define PG8_WAIT_L(n) asm volatile("s_waitcnt lgkmcnt(" #n ")" ::: "memory")
#define PG8_BAR __builtin_amdgcn_s_barrier()
#define PG8_SCHED __builtin_amdgcn_sched_barrier(0)
    Unit cur, nxt; int ui = 0;
    if (!S.next(0, cur)) return;
    f32x4 acc[2][2][4][2];
#pragma unroll
    for (int a = 0; a < 2; ++a)
#pragma unroll
        for (int b = 0; b < 2; ++b)
#pragma unroll
            for (int m = 0; m < 4; ++m)
#pragma unroll
                for (int n = 0; n < 2; ++n) acc[a][b][m][n] = (f32x4){0.f, 0.f, 0.f, 0.f};
    bf16x8 At[4][2], B0[2][2], B1[2][2];
    int one8_ = 0x7f7f7f7f; asm volatile("" : "+v"(one8_));
    const char* cA = (const char*)g.A + (size_t)cur.pm * tstep; const char* cB = (const char*)g.Bt + (size_t)cur.pn * tstep;
    S.a_ready(cur);
    if constexpr (SP2) {
        PG8_STAGE(PG8_SB(0, 0), cB, voffB); PG8_STAGE(PG8_SB(0, 1), cB + hstep, voffB); PG8_STAGE(PG8_SA(0, 0), cA, voffA); PG8_STAGE(PG8_SA(0, 1), cA + hstep, voffA);
        if (wr == 1) PG8_BAR;
        PG8_WAIT_V(2); PG8_BAR;
        PG8_STAGE(PG8_SB(1, 0), cB + kstep, voffB); PG8_STAGE(PG8_SA(1, 0), cA + kstep, voffA); PG8_STAGE(PG8_SB(1, 1), cB + hstep + kstep, voffB);
        PG8_WAIT_V(6); PG8_BAR;
    } else {
        PG8_STAGE(PG8_SB(0, 0), cB, voffB); PG8_STAGE(PG8_SA(0, 0), cA, voffA); PG8_STAGE(PG8_SB(0, 1), cB + hstep, voffB); PG8_STAGE(PG8_SA(0, 1), cA + hstep, voffA);
        if (wr == 1) PG8_BAR;
        PG8_WAIT_V(4); PG8_BAR;
        PG8_STAGE(PG8_SB(1, 0), cB + kstep, voffB); PG8_STAGE(PG8_SA(1, 0), cA + kstep, voffA); PG8_STAGE(PG8_SB(1, 1), cB + hstep + kstep, voffB);
        PG8_WAIT_V(6); PG8_BAR;
    }
    for (;;) {
        const bool has_next = S.next(ui + 1, nxt);
        const char* nA = has_next ? (const char*)g.A + (size_t)nxt.pm * tstep : cA; const char* nB = has_next ? (const char*)g.Bt + (size_t)nxt.pn * tstep : cB;
#pragma unroll 1
        for (int t = 0; t < nt; t += 2) {
            const bool last = (t == nt - 2);
            const char* a1 = cA + (size_t)(t + 1) * kstep;
            const char* a2 = last ? nA : cA + (size_t)(t + 2) * kstep; const char* b2 = last ? nB : cB + (size_t)(t + 2) * kstep;
            const char* a3 = a2 + kstep; const char* b3 = b2 + kstep;
            if (last && has_next) S.a_ready(nxt);
            if constexpr (SP2) {
            PG8_LDB(B0, 0, 0); PG8_LDB(B1, 0, 1); PG8_SCHED; PG8_LDA(At, 0, 0); PG8_STAGE(PG8_SA(1, 1), a1 + hstep, voffA);
            PG8_WAIT_V(8); PG8_WAIT_L(0); PG8_BAR; PG8_MMA(0, 0, At, B0); PG8_MMA(0, 1, At, B1); PG8_BAR; PG8_SCHED;
            PG8_LDA(At, 0, 1); PG8_STAGE(PG8_SB(0, 0), b2, voffB); PG8_STAGE(PG8_SB(0, 1), b2 + hstep, voffB); PG8_STAGE(PG8_SA(0, 0), a2, voffA);
            PG8_WAIT_V(8); PG8_WAIT_L(0); PG8_BAR; PG8_MMA(1, 0, At, B0); PG8_MMA(1, 1, At, B1); PG8_BAR; PG8_SCHED;
            PG8_LDB(B0, 1, 0); PG8_LDB(B1, 1, 1); PG8_SCHED; PG8_LDA(At, 1, 0); PG8_STAGE(PG8_SA(0, 1), a2 + hstep, voffA);
            PG8_WAIT_V(8); PG8_WAIT_L(0); PG8_BAR; PG8_MMA(0, 0, At, B0); PG8_MMA(0, 1, At, B1); PG8_BAR; PG8_SCHED;
            PG8_LDA(At, 1, 1); PG8_STAGE(PG8_SB(1, 0), b3, voffB); PG8_STAGE(PG8_SB(1, 1), b3 + hstep, voffB); PG8_STAGE(PG8_SA(1, 0), a3, voffA);
            PG8_WAIT_V(8); PG8_WAIT_L(0); PG8_BAR; PG8_MMA(1, 0, At, B0); PG8_MMA(1, 1, At, B1); PG8_BAR; PG8_SCHED;
            } else {
            PG8_LDB(B0, 0, 0); PG8_SCHED; PG8_LDA(At, 0, 0); PG8_STAGE(PG8_SA(1, 1), a1 + hstep, voffA);
            PG8_WAIT_L(8); PG8_BAR; PG8_WAIT_L(0); PG8_MMA(0, 0, At, B0); PG8_BAR; PG8_SCHED;
            PG8_LDB(B1, 0, 1); PG8_STAGE(PG8_SB(0, 0), b2, voffB);
            PG8_BAR; PG8_WAIT_L(0); PG8_MMA(0, 1, At, B1); PG8_BAR;
            PG8_LDA(At, 0, 1); PG8_STAGE(PG8_SA(0, 0), a2, voffA);
            PG8_BAR; PG8_WAIT_L(0); PG8_MMA(1, 0, At, B0); PG8_BAR; PG8_SCHED;
            PG8_STAGE(PG8_SB(0, 1), b2 + hstep, voffB);
            PG8_WAIT_V(6); PG8_BAR; PG8_MMA(1, 1, At, B1); PG8_BAR;
            PG8_LDB(B0, 1, 0); PG8_SCHED; PG8_LDA(At, 1, 0); PG8_STAGE(PG8_SA(0, 1), a2 + hstep, voffA);
            PG8_WAIT_L(8); PG8_BAR; PG8_WAIT_L(0); PG8_MMA(0, 0, At, B0); PG8_BAR; PG8_SCHED;
            PG8_LDB(B1, 1, 1); PG8_STAGE(PG8_SB(1, 0), b3, voffB);
            PG8_BAR; PG8_WAIT_L(0); PG8_MMA(0, 1, At, B1); PG8_BAR;
            PG8_LDA(At, 1, 1); PG8_STAGE(PG8_SA(1, 0), a3, voffA);
            PG8_BAR; PG8_WAIT_L(0); PG8_MMA(1, 0, At, B0); PG8_BAR; PG8_SCHED;
            PG8_STAGE(PG8_SB(1, 1), b3 + hstep, voffB);
            PG8_WAIT_V(6); PG8_BAR; PG8_MMA(1, 1, At, B1); PG8_BAR;
            }
        }
        if constexpr (FP8) asm volatile("s_nop 7\n\ts_nop 7" ::: "memory");
        if constexpr (ALIGN_EPI) { if (wr == 0) PG8_BAR; }
        if constexpr (!Epi::AFTER_DRAIN) { int ln_ = (int)__builtin_amdgcn_mbcnt_hi(~0u, __builtin_amdgcn_mbcnt_lo(~0u, 0u)); asm volatile("" : "+v"(ln_)); E(acc, cur, wr, wc, ln_ & 15, ln_ >> 4); S.done(cur); }
        if (!has_next) break;
#pragma unroll
        for (int a = 0; a < 2; ++a)
#pragma unroll
            for (int b = 0; b < 2; ++b)
#pragma unroll
                for (int m = 0; m < 4; ++m)
#pragma unroll
                    for (int n = 0; n < 2; ++n) acc[a][b][m][n] = (f32x4){0.f, 0.f, 0.f, 0.f};
        cur = nxt; cA = nA; cB = nB; ++ui;
        if constexpr (ALIGN_EPI) { if (wr == 1) PG8_BAR; }
    }
    PG8_WAIT_V(0);
    if constexpr (!ALIGN_EPI) { if (wr == 0) PG8_BAR; }
    PG8_BAR;
    if constexpr (Epi::AFTER_DRAIN) { E.fused(acc, cur, wr, wc, fr, fq, lds, wid, lane); S.done(cur); }
#undef PG8_SA
#undef PG8_SB
#undef PG8_STAGE
#undef PG8_LDA
#undef PG8_LDB
#undef PG8_MMA
#undef PG8_WAIT_V
#undef PG8_WAIT_L
#undef PG8_BAR
#undef PG8_SCHED
}
}

constexpr int NWAVES = 8, NTHR = 512;
constexpr int BATCH = 2, SEQ = 8192, D = 1024, DEPTH = 4, MTOK = BATCH * SEQ;
constexpr int DIN = 3344, NPROJ = 3328, SRC_GA = 1152;
constexpr int C_GQ = 0, C_GK = 192, C_GV = 384, C_GG = 768, C_HQ = 1152, C_HF = 1408, C_HI = 1664, C_HG = 1920, C_RQ = 2176, C_RK = 2368, C_RV = 2560, C_RG = 2944;
constexpr int NE = 32, FFN = 1024;
constexpr int CH = 64, NCH = SEQ / CH, NUNIT = BATCH * NCH;
constexpr int ST_GLA = 0, ST_HG = 4 * 48 * 96, ST_RET = ST_HG + 4 * 64 * 64, ST_TOT = ST_RET + 4 * 48 * 96;
constexpr int NDV = 448;
constexpr int MAXROWS = 65536 + NE * 256, MAXRT = MAXROWS / 256;
constexpr float EPS = 1e-6f;
#ifndef F8_IN_V
#define F8_IN_V false
#endif
#ifndef F8_OUT_V
#define F8_OUT_V false
#endif
constexpr bool F8_IN = F8_IN_V, F8_OUT = F8_OUT_V;
constexpr float S8_M = 32.f;
constexpr float S8_W = 2048.f, S8_H = 64.f, S8_A = 8.f;
constexpr int NPHASE = 38;
constexpr int ECAP = 16384, ECAP_SH = 14;

constexpr size_t MiB = 1u << 20;
constexpr size_t WS_CTL = 0, CTL_ZERO_BYTES = 65536;
constexpr size_t WS_MOD = 1 * MiB;
constexpr size_t WS_ROPE = 2 * MiB;
constexpr size_t WS_LB = 5 * MiB;
constexpr size_t WS_WIN = 8 * MiB;
constexpr size_t WS_WOUT = 34 * MiB;
constexpr size_t WS_WGU = 42 * MiB;
constexpr size_t WS_WDN = 554 * MiB;
constexpr size_t WS_X = 810 * MiB;
constexpr size_t WS_H = 874 * MiB;
constexpr size_t WS_GA = 906 * MiB;
constexpr size_t WS_PROJ = 907 * MiB;
constexpr size_t WS_U = 1011 * MiB;
constexpr size_t WS_DVEC = 1063 * MiB;
constexpr size_t WS_SP = 1064 * MiB;
constexpr size_t WS_MIX = 1090 * MiB;
constexpr size_t WS_TOPE = 1122 * MiB;
constexpr size_t WS_TOPW = WS_TOPE + 256 * 1024;
constexpr size_t WS_SLOT = WS_TOPW + 256 * 1024;
constexpr size_t WS_A1 = 1123 * MiB;
constexpr size_t WS_ACT = 1635 * MiB;
constexpr size_t WS_Y = 2147 * MiB;
constexpr size_t WS_CUM = 3171 * MiB;
constexpr size_t WS_END = 3199 * MiB;
static_assert(WS_WIN + (size_t)DEPTH * NPROJ * D * 2 <= WS_WOUT && WS_PROJ + (size_t)MTOK * NPROJ * 2 <= WS_U && WS_U + (size_t)NUNIT * ST_TOT * 4 <= WS_DVEC && WS_SP + (size_t)NUNIT * ST_TOT * 2 <= WS_MIX && WS_A1 + (size_t)NE * ECAP * D <= WS_ACT && WS_ACT + (size_t)NE * ECAP * D <= WS_Y && WS_Y + (size_t)NE * ECAP * D * 2 <= WS_CUM, "ws map");
constexpr int CW_TMO = 0, CW_CODE = 1, CW_BAR = 4096, CW_CNT = 8192, CW_FILL = 8192 + 256;
constexpr int RING_BYTES = 131072;
constexpr int MISC_OFF = 147456, LDS_BYTES = MISC_OFF + 4096;
constexpr int MW_BAR = 0, MW_CNT = 16, MW_PST = 48, MW_HIST = 96, MW_BASE = 128, MW_TILE = 192, MW_NRT = 480, MW_SLOTS = 512;

#define GAS __attribute__((address_space(1)))
#define LAS __attribute__((address_space(3)))
typedef unsigned v4u __attribute__((ext_vector_type(4)));
typedef float f32x4 __attribute__((ext_vector_type(4)));
typedef short bf16x8 __attribute__((ext_vector_type(8)));
typedef GAS unsigned gu32;
typedef GAS unsigned long long gu64;
#define RLX_AGENT __ATOMIC_RELAXED, __HIP_MEMORY_SCOPE_AGENT
#define LDS_WAIT() asm volatile("s_waitcnt lgkmcnt(0)" ::: "memory")
#define VM_WAIT() asm volatile("s_waitcnt vmcnt(0)" ::: "memory")
__device__ __forceinline__ unsigned long long rt() { return __builtin_amdgcn_s_memrealtime(); }
typedef unsigned short bf16;
__device__ __forceinline__ unsigned f2bf(float f) { unsigned u = __builtin_bit_cast(unsigned, f); return (u + 0x7fffu + ((u >> 16) & 1u)) >> 16; }
__device__ __forceinline__ unsigned pk2(float lo, float hi) { return f2bf(lo) | (f2bf(hi) << 16); }
__device__ __forceinline__ float bf2f(bf16 b) { return __builtin_bit_cast(float, (unsigned)b << 16); }
#define XB_TMO      128
#define XB_XCNT(j)  (256  + 64 * (j))
#define XB_XSUB(j)  (1280 + 64 * (j))
#define XB_XGEN(j)  (2304 + 64 * (j))
#define XB_TOP      3328
#define XB_TOPGEN   3392
#define XCD_BAR_WORDS 3456
#define XB_SPIN_CAP (1u << 18)

__device__ __forceinline__ unsigned xb_ld(unsigned* p)              { return __hip_atomic_load(p, __ATOMIC_RELAXED, __HIP_MEMORY_SCOPE_AGENT); }
__device__ __forceinline__ unsigned xb_add(unsigned* p, unsigned v) { return __hip_atomic_fetch_add(p, v, __ATOMIC_RELAXED, __HIP_MEMORY_SCOPE_AGENT); }
__device__ __forceinline__ unsigned xb_xcc_id() { return (unsigned)__builtin_amdgcn_s_getreg((3 << 11) | 20) & 0xFu; }
#define XB_SPIN(cond, bar) do { unsigned _sp = 0; while (cond) { __builtin_amdgcn_s_sleep(1); \
    if ((++_sp & 255u) == 0u) { if (xb_ld(&(bar)[XB_TMO])) break; if (_sp > XB_SPIN_CAP) { atomicAdd(&(bar)[XB_TMO], 1u); break; } } } } while (0)

struct XcdBarrier {
    unsigned* bar; unsigned x;
    volatile LAS unsigned* st;
};

__device__ __forceinline__ XcdBarrier xcd_barrier_post(unsigned* bar, volatile LAS unsigned* st) {
    XcdBarrier b; b.bar = bar; b.x = xb_xcc_id(); b.st = st;
    if (threadIdx.x == 0) (void)xb_add(&bar[XB_XCNT(b.x)], 1u);
    return b;
}
__device__ __forceinline__ void xcd_barrier_complete(unsigned* bar, unsigned x, unsigned& nloc, unsigned& nx) {
    const unsigned G = gridDim.x * gridDim.y * gridDim.z;
    unsigned sum, cnt, mine, sp = 0u;
    for (;;) {
        sum = 0u; cnt = 0u; mine = 0u;
#pragma unroll
        for (unsigned j = 0; j < 16; ++j) { const unsigned c = xb_ld(&bar[XB_XCNT(j)]); sum += c; cnt += (c > 0u) ? 1u : 0u; mine = (j == x) ? c : mine; }
        if (sum == G) break;
        __builtin_amdgcn_s_sleep(1);
        if ((++sp & 255u) == 0u) { if (xb_ld(&bar[XB_TMO])) break; if (sp > XB_SPIN_CAP) { atomicAdd(&bar[XB_TMO], 1u); break; } }
    }
    nloc = mine > 0u ? mine : 1u; nx = cnt > 0u ? cnt : 1u;
}

__device__ __forceinline__ void xcd_barrier(const XcdBarrier& b) {
    asm volatile("s_waitcnt vmcnt(0)" ::: "memory");
    __syncthreads();
    if (threadIdx.x == 0) {
        unsigned* bar = b.bar;
        __builtin_amdgcn_s_waitcnt(0);
        unsigned nloc = b.st[0], nx = b.st[1];
        if (nloc == 0u) { xcd_barrier_complete(bar, b.x, nloc, nx); b.st[0] = nloc; b.st[1] = nx; }
        const unsigned old = xb_add(&bar[XB_XSUB(b.x)], 1u);
        const unsigned gen = old / nloc;
        if (old + 1u == (gen + 1u) * nloc) {
            __builtin_amdgcn_fence(__ATOMIC_RELEASE, "agent");
            asm volatile("s_waitcnt vmcnt(0)" ::: "memory");
            const unsigned og = xb_add(&bar[XB_TOP], 1u);
            const unsigned tg = og / nx;
            if (og + 1u == (tg + 1u) * nx) xb_add(&bar[XB_TOPGEN], 1u);
            else XB_SPIN(xb_ld(&bar[XB_TOPGEN]) == tg, bar);
            __builtin_amdgcn_fence(__ATOMIC_ACQUIRE, "agent");
            xb_add(&bar[XB_XGEN(b.x)], 1u);
            asm volatile("s_waitcnt vmcnt(0)" ::: "memory");
        } else {
            XB_SPIN(xb_ld(&bar[XB_XGEN(b.x)]) == gen, bar);
            __builtin_amdgcn_fence(__ATOMIC_ACQUIRE, "agent");
            asm volatile("s_waitcnt vmcnt(0)" ::: "memory");
        }
    }
    __syncthreads();
}

__device__ __forceinline__ float wave_sum(float v) {
#pragma unroll
    for (int o = 1; o < 64; o <<= 1) v += __shfl_xor(v, o);
    return v;
}
__device__ __forceinline__ float log_sigmoid_f(float x) { return fminf(x, 0.f) - log1pf(expf(-fabsf(x))); }
__device__ __forceinline__ float silu_f(float x) { return x / (1.0f + expf(-x)); }
__device__ __forceinline__ float sigmoid_f(float x) { return 1.0f / (1.0f + expf(-x)); }
__device__ __forceinline__ pg8::bf16x8 ldfrag(const LAS bf16* base, int stride, int r0, int k0, int lane) {
    return *(const LAS pg8::bf16x8*)(base + (r0 + (lane & 15)) * stride + k0 + 8 * (lane >> 4));
}
__device__ __forceinline__ pg8::bf16x8 pack8(const float (&v)[8]) { v4u w; w.x = pk2(v[0], v[1]); w.y = pk2(v[2], v[3]); w.z = pk2(v[4], v[5]); w.w = pk2(v[6], v[7]); return __builtin_bit_cast(pg8::bf16x8, w); }

struct Args {
    const float* x; const float* c; const int* pos; const float* w_mod; const float* b_mod; const float* norm1_w; const float* w_in; const float* gla_wa2; const float* gla_ba2; const float* hg_lb;
    const float* gla_norm_w; const float* hg_norm_w; const float* w_out; const float* norm2_w; const float* w_r; const float* b_r; const float* w_gu; const float* b_gu; const float* w_dn; const float* b_dn;
    const float* final_norm_w; float* out; unsigned char* ws; int ph_lo, ph_hi;
};

__device__ __forceinline__ void transpose_block64(const float* src, int ld, bf16* dst, LAS float* scr, int lane) {
    const int r = lane >> 4, c4 = (lane & 15) * 4;
    f32x4 v[16];
#pragma unroll
    for (int i = 0; i < 16; ++i) v[i] = *(const f32x4*)(src + (size_t)(4 * i + r) * ld + c4);
#pragma unroll
    for (int i = 0; i < 16; ++i) { LAS float* w = scr + (4 * i + r) * 65 + c4; w[0] = v[i][0]; w[1] = v[i][1]; w[2] = v[i][2]; w[3] = v[i][3]; }
    LDS_WAIT(); asm volatile("" ::: "memory");
    const int kc = lane & 7;
#pragma unroll
    for (int jj = 0; jj < 8; ++jj) { const int n = (lane >> 3) + 8 * jj; const LAS float* s = scr + (8 * kc) * 65 + n;
        v4u o; o.x = pk2(s[0 * 65], s[1 * 65]); o.y = pk2(s[2 * 65], s[3 * 65]); o.z = pk2(s[4 * 65], s[5 * 65]); o.w = pk2(s[6 * 65], s[7 * 65]);
        *(GAS v4u*)(dst + (size_t)n * D + 8 * kc) = o; }
    LDS_WAIT(); asm volatile("" ::: "memory");
}
__device__ __forceinline__ int pk4_fp8(float a, float b, float c, float d) { int w = 0; w = __builtin_amdgcn_cvt_pk_fp8_f32(fminf(fmaxf(a, -448.f), 448.f), fminf(fmaxf(b, -448.f), 448.f), w, false);
    return __builtin_amdgcn_cvt_pk_fp8_f32(fminf(fmaxf(c, -448.f), 448.f), fminf(fmaxf(d, -448.f), 448.f), w, true); }
__device__ __forceinline__ void transpose_block64_fp8(const float* src, int ld, unsigned char* dst, LAS float* scr, int lane, float sc) {
    const int r = lane >> 4, c4 = (lane & 15) * 4;
    f32x4 v[16];
#pragma unroll
    for (int i = 0; i < 16; ++i) v[i] = *(const f32x4*)(src + (size_t)(4 * i + r) * ld + c4);
#pragma unroll
    for (int i = 0; i < 16; ++i) { LAS float* w = scr + (4 * i + r) * 65 + c4; w[0] = v[i][0] * sc; w[1] = v[i][1] * sc; w[2] = v[i][2] * sc; w[3] = v[i][3] * sc; }
    LDS_WAIT(); asm volatile("" ::: "memory");
    const int kc = lane & 3;
#pragma unroll
    for (int jj = 0; jj < 4; ++jj) { const int n = (lane >> 2) + 16 * jj; const LAS float* s = scr + (16 * kc) * 65 + n;
        v4u o; o.x = (unsigned)pk4_fp8(s[0 * 65], s[1 * 65], s[2 * 65], s[3 * 65]); o.y = (unsigned)pk4_fp8(s[4 * 65], s[5 * 65], s[6 * 65], s[7 * 65]);
        o.z = (unsigned)pk4_fp8(s[8 * 65], s[9 * 65], s[10 * 65], s[11 * 65]); o.w = (unsigned)pk4_fp8(s[12 * 65], s[13 * 65], s[14 * 65], s[15 * 65]);
        *(GAS v4u*)(dst + (size_t)n * D + 16 * kc) = o; }
    LDS_WAIT(); asm volatile("" ::: "memory");
}
constexpr int IT_IN = 16 * (NPROJ / 64), IT_OUT = 16 * 16, IT_GU = NE * 16 * 32, IT_DN = NE * 16 * 16, IT_LAYER = IT_IN + IT_OUT + IT_GU + IT_DN, IT_ALL = DEPTH * IT_LAYER;
__device__ __forceinline__ void p0_prologue(const Args& a, LAS unsigned char* lds, int vcu, int G, int tid, int lane, int wave) {
    unsigned char* ws = a.ws;
    bf16* WIN = (bf16*)(ws + WS_WIN); bf16* WOUT = (bf16*)(ws + WS_WOUT); unsigned char* WGU = ws + WS_WGU; unsigned char* WDN = ws + WS_WDN;
    LAS float* scr = (LAS float*)(lds + wave * 16640);
    const int gw = vcu * NWAVES + wave, NGW = G * NWAVES;
    for (int it = gw; it < IT_ALL; it += NGW) {
        const int l = it / IT_LAYER; int r = it - l * IT_LAYER;
        if (r < IT_IN) { const int kb = r / (NPROJ / 64), nb = r % (NPROJ / 64), n0 = 64 * nb, sc = n0 + (n0 >= SRC_GA ? 16 : 0);
            if (F8_IN) transpose_block64_fp8(a.w_in + ((size_t)l * D + 64 * kb) * DIN + sc, DIN, (unsigned char*)WIN + ((size_t)l * NPROJ + n0) * D + 64 * kb, scr, lane, S8_W);
            else transpose_block64(a.w_in + ((size_t)l * D + 64 * kb) * DIN + sc, DIN, WIN + ((size_t)l * NPROJ + n0) * D + 64 * kb, scr, lane); continue; }
        r -= IT_IN;
        if (r < IT_OUT) { const int kb = r / 16, nb = r % 16;
            if (F8_OUT) transpose_block64_fp8(a.w_out + ((size_t)l * D + 64 * kb) * D + 64 * nb, D, (unsigned char*)WOUT + ((size_t)l * D + 64 * nb) * D + 64 * kb, scr, lane, S8_W);
            else transpose_block64(a.w_out + ((size_t)l * D + 64 * kb) * D + 64 * nb, D, WOUT + ((size_t)l * D + 64 * nb) * D + 64 * kb, scr, lane); continue; }
        r -= IT_OUT;
        if (r < IT_GU) { const int e = r / 512, r2 = r % 512, kb = r2 / 32, nb = r2 % 32, cc = 64 * nb;
            const int row = (cc < 1024) ? 256 * (cc / 128) + (cc % 128) : 256 * ((cc - 1024) / 128) + 128 + ((cc - 1024) % 128);
            transpose_block64_fp8(a.w_gu + (((size_t)l * NE + e) * D + 64 * kb) * 2048 + cc, 2048, WGU + (((size_t)l * NE + e) * 2048 + row) * D + 64 * kb, scr, lane, S8_W); continue; }
        r -= IT_GU;
        { const int e = r / 256, r2 = r % 256, kb = r2 / 16, nb = r2 % 16;
            transpose_block64_fp8(a.w_dn + (((size_t)l * NE + e) * FFN + 64 * kb) * D + 64 * nb, D, WDN + (((size_t)l * NE + e) * D + 64 * nb) * D + 64 * kb, scr, lane, S8_W); }
    }
    __syncthreads();
    {
        LAS float* cact = (LAS float*)lds;
        LAS float* red = (LAS float*)(lds + 8192);
        for (int i = tid; i < 2 * D; i += NTHR) cact[i] = silu_f(a.c[i]);
        __syncthreads();
        float* MOD = (float*)(ws + WS_MOD);
        for (int it = vcu; it < DEPTH * 96; it += G) {
            const int l = it / 96, n0 = (it % 96) * 64;
            const float* wp = a.w_mod + ((size_t)l * D + 128 * wave) * 6144 + n0 + lane;
            float a0 = 0.f, a1 = 0.f;
#pragma unroll 8
            for (int k = 0; k < 128; ++k) { const float w = wp[(size_t)k * 6144]; a0 += cact[128 * wave + k] * w; a1 += cact[D + 128 * wave + k] * w; }
            red[(wave * 2 + 0) * 64 + lane] = a0; red[(wave * 2 + 1) * 64 + lane] = a1;
            __syncthreads();
            if (tid < 128) { const int b = tid >> 6, ln = tid & 63; float s = a.b_mod[l * 6144 + n0 + ln];
#pragma unroll
                for (int w = 0; w < 8; ++w) s += red[(w * 2 + b) * 64 + ln];
                MOD[((size_t)l * 2 + b) * 6144 + n0 + ln] = s; }
            __syncthreads();
        }
    }
    {
        float* ROPE = (float*)(ws + WS_ROPE);
        for (int i = vcu * NTHR + tid; i < MTOK * 24; i += G * NTHR) { const int t = i / 24, f = i % 24;
            const float inv = (float)pow(10000.0, -(double)f / 24.0); const float ang = (float)a.pos[t] * inv;
            ROPE[(size_t)t * 48 + f] = cosf(ang); ROPE[(size_t)t * 48 + 24 + f] = sinf(ang); }
    }
    if (vcu == 0 && tid < 256) {
        float v[4], mx = -3.0e38f; for (int l = 0; l < 4; ++l) { v[l] = a.hg_lb[l * 256 + tid]; mx = fmaxf(mx, v[l]); }
        float s = 0.f; for (int l = 0; l < 4; ++l) { v[l] = expf(v[l] - mx); s += v[l]; }
        float* LB = (float*)(ws + WS_LB); float cs = 0.f, first = 0.f;
        for (int l = 0; l < 4; ++l) { cs += v[l] / s; if (l == 0) first = cs; LB[l * 256 + tid] = cs - first; }
    }
}

__device__ __forceinline__ void moe_combine_row(f32x4 (&v)[4], int m, const bf16* Y, const int* SLOT, const float* TOPW, const float* g2, int lane) {
    const int4 sl = *(const int4*)(SLOT + (size_t)m * 4); const f32x4 tw = *(const f32x4*)(TOPW + (size_t)m * 4);
    const int s[4] = {sl.x, sl.y, sl.z, sl.w};
    f32x4 acc[4];
#pragma unroll
    for (int j = 0; j < 4; ++j) acc[j] = (f32x4){0.f, 0.f, 0.f, 0.f};
#pragma unroll
    for (int k = 0; k < 4; ++k) { const bf16* yr = Y + (size_t)s[k] * D + 4 * lane; const float w = tw[k];
#pragma unroll
        for (int j = 0; j < 4; ++j) { const uint2 p = *(const uint2*)(yr + 256 * j);
            acc[j][0] += w * __builtin_bit_cast(float, p.x << 16); acc[j][1] += w * __builtin_bit_cast(float, p.x & 0xffff0000u);
            acc[j][2] += w * __builtin_bit_cast(float, p.y << 16); acc[j][3] += w * __builtin_bit_cast(float, p.y & 0xffff0000u); } }
#pragma unroll
    for (int j = 0; j < 4; ++j) { const f32x4 g = *(const f32x4*)(g2 + 4 * lane + 256 * j); v[j] = v[j] + g * acc[j]; }
}
__device__ __forceinline__ float row_rstd(const f32x4 (&v)[4]) {
    float s = 0.f;
#pragma unroll
    for (int j = 0; j < 4; ++j) s += (v[j][0] * v[j][0] + v[j][1] * v[j][1]) + (v[j][2] * v[j][2] + v[j][3] * v[j][3]);
    return 1.0f / sqrtf(wave_sum(s) * (1.0f / D) + EPS);
}
__device__ __forceinline__ void modulate_row(f32x4 (&v)[4], float rstd, const float* nw, const float* sc, const float* sh, bf16* hrow, int lane) {
#pragma unroll
    for (int j = 0; j < 4; ++j) { const int c0 = 4 * lane + 256 * j; const f32x4 w = *(const f32x4*)(nw + c0), s1 = *(const f32x4*)(sc + c0), s0 = *(const f32x4*)(sh + c0);
        v[j] = v[j] * rstd * w * (s1 + 1.0f) + s0;
        uint2 p; p.x = pk2(v[j][0], v[j][1]); p.y = pk2(v[j][2], v[j][3]); *(uint2*)(hrow + c0) = p; }
}


constexpr int LR_SLT = 142976, LR_TWL = 144000, LR_SSR = 145024;
__device__ __forceinline__ void stage_slots(const unsigned char* ws, int row0, LAS unsigned char* lds, int tid) {
    if (tid < 64) { *(LAS v4u*)(lds + LR_SLT + 16 * tid) = *(const v4u*)((const int*)(ws + WS_SLOT) + (size_t)(row0 + tid) * 4);
                    *(LAS f32x4*)(lds + LR_TWL + 16 * tid) = *(const f32x4*)((const float*)(ws + WS_TOPW) + (size_t)(row0 + tid) * 4); }
}
template <bool SS>
__device__ __forceinline__ void flat_combine(const float* xsrc, float* xdst, int row0, const bf16* Y, const float* g2, LAS unsigned char* lds, int tid, int lane) {
    const int c4 = tid & 255, rsub = tid >> 8; const f32x4 g = *(const f32x4*)(g2 + 4 * c4);
#pragma unroll 4
    for (int it = 0; it < 32; ++it) { const int i = 2 * it + rsub; const size_t m = (size_t)(row0 + i);
        f32x4 v = *(const f32x4*)(xsrc + m * D + 4 * c4);
        const v4u sl = *(const LAS v4u*)(lds + LR_SLT + 16 * i); const f32x4 tw = *(const LAS f32x4*)(lds + LR_TWL + 16 * i);
        const uint2 p0 = *(const uint2*)(Y + (size_t)sl.x * D + 4 * c4), p1 = *(const uint2*)(Y + (size_t)sl.y * D + 4 * c4), p2 = *(const uint2*)(Y + (size_t)sl.z * D + 4 * c4), p3 = *(const uint2*)(Y + (size_t)sl.w * D + 4 * c4);
        f32x4 acc;
        acc[0] = tw[0] * __builtin_bit_cast(float, p0.x << 16) + tw[1] * __builtin_bit_cast(float, p1.x << 16) + tw[2] * __builtin_bit_cast(float, p2.x << 16) + tw[3] * __builtin_bit_cast(float, p3.x << 16);
        acc[1] = tw[0] * __builtin_bit_cast(float, p0.x & 0xffff0000u) + tw[1] * __builtin_bit_cast(float, p1.x & 0xffff0000u) + tw[2] * __builtin_bit_cast(float, p2.x & 0xffff0000u) + tw[3] * __builtin_bit_cast(float, p3.x & 0xffff0000u);
        acc[2] = tw[0] * __builtin_bit_cast(float, p0.y << 16) + tw[1] * __builtin_bit_cast(float, p1.y << 16) + tw[2] * __builtin_bit_cast(float, p2.y << 16) + tw[3] * __builtin_bit_cast(float, p3.y << 16);
        acc[3] = tw[0] * __builtin_bit_cast(float, p0.y & 0xffff0000u) + tw[1] * __builtin_bit_cast(float, p1.y & 0xffff0000u) + tw[2] * __builtin_bit_cast(float, p2.y & 0xffff0000u) + tw[3] * __builtin_bit_cast(float, p3.y & 0xffff0000u);
        v = v + g * acc;
        *(f32x4*)(xdst + m * D + 4 * c4) = v;
        if (SS) { const float sq = wave_sum((v[0] * v[0] + v[1] * v[1]) + (v[2] * v[2] + v[3] * v[3])); if (lane == 0) __hip_atomic_fetch_add((LAS float*)(lds + LR_SSR) + i, sq, __ATOMIC_RELAXED, __HIP_MEMORY_SCOPE_WORKGROUP); } }
}
template <bool F8>
__device__ __forceinline__ void flat_modulate(const float* xin, int row0, const LAS float* rstds, const float* nw, const float* scp, const float* shp, bf16* H, int tid) {
    const int c4 = tid & 255, rsub = tid >> 8; const f32x4 w = *(const f32x4*)(nw + 4 * c4), s1 = *(const f32x4*)(scp + 4 * c4), s0 = *(const f32x4*)(shp + 4 * c4); const f32x4 ws1 = w * (s1 + 1.0f);
#pragma unroll 8
    for (int it = 0; it < 32; ++it) { const int i = 2 * it + rsub; const size_t m = (size_t)(row0 + i); const f32x4 v = *(const f32x4*)(xin + m * D + 4 * c4) * rstds[i] * ws1 + s0;
        if (F8) *(int*)((unsigned char*)H + m * D + 4 * c4) = pk4_fp8(v[0] * S8_H, v[1] * S8_H, v[2] * S8_H, v[3] * S8_H);
        else { uint2 p; p.x = pk2(v[0], v[1]); p.y = pk2(v[2], v[3]); *(uint2*)(H + m * D + 4 * c4) = p; } }
}

constexpr int WP = 1032;
constexpr int LR_WHI = 0, LR_PART = 132096, LR_SSX = 140288, LR_RSTD = 140544, LR_BIAS = 140800, LR_RED = 140928;
template <int NEO>
__device__ __forceinline__ void rows_mfma(const Args& a, int layer, LAS unsigned char* lds, volatile LAS unsigned* MISC, gu32* ctl, int vcu, int G, int tid, int lane, int wave) {
    constexpr bool P5 = (NEO == 32); constexpr int NET = NEO / 16;
    unsigned char* ws = a.ws; float* X = (float*)(ws + WS_X); bf16* H = (bf16*)(ws + WS_H); const float* MOD = (const float*)(ws + WS_MOD);
    LAS bf16* Whi = (LAS bf16*)(lds + LR_WHI); LAS bf16* Wlo = Whi + NEO * WP; LAS float* part = (LAS float*)(lds + LR_PART); LAS float* ssx = (LAS float*)(lds + LR_SSX);
    LAS float* rstds = (LAS float*)(lds + LR_RSTD); LAS float* biasl = (LAS float*)(lds + LR_BIAS); LAS float* red = (LAS float*)(lds + LR_RED);
    const float* nw = (P5 ? a.norm2_w : a.norm1_w) + layer * D;
    const float* Wsrc = P5 ? a.w_r + (size_t)layer * D * NE : a.w_in + (size_t)layer * D * DIN + SRC_GA; const int wld = P5 ? NE : DIN;
    if (P5) { if (tid < NE) MISC[MW_HIST + tid] = 0u; }
    for (int row0 = vcu * 64; row0 < MTOK; row0 += G * 64) {
        const int b = row0 / SEQ; const float* mp = MOD + ((size_t)layer * 2 + b) * 6144; const float* scp = mp + (P5 ? 4 : 1) * D; const float* shp = mp + (P5 ? 3 : 0) * D;
        if (!P5 && layer > 0) { stage_slots(ws, row0, lds, tid); __syncthreads(); }
        { const int e = tid % NEO, kq = tid / NEO; constexpr int NPT = NTHR / NEO;
#pragma unroll 1
            for (int it0 = 0; it0 < D / NPT; it0 += 8) { float wv[8];
#pragma unroll
                for (int u = 0; u < 8; ++u) { const int k = kq + NPT * (it0 + u); wv[u] = Wsrc[(size_t)k * wld + e] * (nw[k] * (1.0f + scp[k])); }
#pragma unroll
                for (int u = 0; u < 8; ++u) { const int k = kq + NPT * (it0 + u); const unsigned hi = f2bf(wv[u]); const float wl = wv[u] - __builtin_bit_cast(float, hi << 16); Whi[e * WP + k] = (bf16)hi; Wlo[e * WP + k] = (bf16)f2bf(wl); } }
            constexpr int KP = D / NPT; float sacc = 0.f;
#pragma unroll 8
            for (int k = kq * KP; k < kq * KP + KP; ++k) sacc += shp[k] * Wsrc[(size_t)k * wld + e];
            red[kq * NEO + e] = sacc; }
        const float* xin = X;
        if (!P5) { if (layer == 0) xin = a.x;
            else { flat_combine<false>(X, X, row0, (const bf16*)(ws + WS_Y), MOD + ((size_t)(layer - 1) * 2 + b) * 6144 + 5 * D, lds, tid, lane); asm volatile("s_waitcnt vmcnt(0)" ::: "memory"); } }
        __syncthreads();
        if (tid < NEO) { constexpr int NPT = NTHR / NEO; float sacc = P5 ? a.b_r[layer * NE + tid] : 0.f; for (int q = 0; q < NPT; ++q) sacc += red[q * NEO + tid]; biasl[tid] = sacc; }
        const int rg = wave >> 1, kh = wave & 1, r = lane & 15, g = lane >> 4;
        { const float* xr = xin + (size_t)(row0 + 16 * rg + r) * D; f32x4 acc[NET]; float ss = 0.f;
#pragma unroll
            for (int et = 0; et < NET; ++et) acc[et] = (f32x4){0.f, 0.f, 0.f, 0.f};
#pragma unroll 4
            for (int s = 16 * kh; s < 16 * kh + 16; ++s) { const int k0 = 32 * s + 8 * g; const f32x4 x0 = *(const f32x4*)(xr + k0), x1 = *(const f32x4*)(xr + k0 + 4);
                ss += (x0[0] * x0[0] + x0[1] * x0[1]) + (x0[2] * x0[2] + x0[3] * x0[3]) + (x1[0] * x1[0] + x1[1] * x1[1]) + (x1[2] * x1[2] + x1[3] * x1[3]);
                float xv[8] = {x0[0], x0[1], x0[2], x0[3], x1[0], x1[1], x1[2], x1[3]}, xl[8];
#pragma unroll
                for (int j = 0; j < 8; ++j) xl[j] = xv[j] - __builtin_bit_cast(float, f2bf(xv[j]) << 16);
                const pg8::bf16x8 ahi = pack8(xv), alo = pack8(xl);
#pragma unroll
                for (int et = 0; et < NET; ++et) { const pg8::bf16x8 whi = ldfrag(Whi, WP, 16 * et, 32 * s, lane), wlo = ldfrag(Wlo, WP, 16 * et, 32 * s, lane);
                    acc[et] = __builtin_amdgcn_mfma_f32_16x16x32_bf16(ahi, whi, acc[et], 0, 0, 0); acc[et] = __builtin_amdgcn_mfma_f32_16x16x32_bf16(alo, whi, acc[et], 0, 0, 0);
                    acc[et] = __builtin_amdgcn_mfma_f32_16x16x32_bf16(ahi, wlo, acc[et], 0, 0, 0); } }
            ss += __shfl_xor(ss, 16); ss += __shfl_xor(ss, 32);
            if (kh == 1) {
#pragma unroll
                for (int et = 0; et < NET; ++et)
#pragma unroll
                    for (int q = 0; q < 4; ++q) part[(rg * 16 + 4 * g + q) * 32 + 16 * et + r] = acc[et][q];
                if (g == 0) ssx[rg * 16 + r] = ss; }
            __syncthreads();
            if (kh == 0) { const float sst = ss + ssx[rg * 16 + r]; if (g == 0) rstds[rg * 16 + r] = 1.0f / sqrtf(sst * (1.0f / D) + EPS);
                asm volatile("s_waitcnt lgkmcnt(0)" ::: "memory");
#pragma unroll
                for (int et = 0; et < NET; ++et)
#pragma unroll
                    for (int q = 0; q < 4; ++q) { const int i = rg * 16 + 4 * g + q, e = 16 * et + r; const float v = rstds[i] * (acc[et][q] + part[i * 32 + e]) + biasl[e];
                        if (P5) part[i * 32 + e] = v; else ((float*)(ws + WS_GA))[(size_t)(row0 + i) * 16 + e] = v; }
                if (P5) { asm volatile("s_waitcnt lgkmcnt(0)" ::: "memory");
                    if (lane < 16) { const int i = rg * 16 + lane, m = row0 + i; float lv[NE];
#pragma unroll
                        for (int e = 0; e < NE; ++e) lv[e] = part[i * 32 + e];
                        float tv[4]; int te[4];
#pragma unroll
                        for (int t = 0; t < 4; ++t) { float best = -3.0e38f; int bi = 0;
#pragma unroll
                            for (int e = 0; e < NE; ++e) if (lv[e] > best) { best = lv[e]; bi = e; }
#pragma unroll
                            for (int e = 0; e < NE; ++e) if (e == bi) lv[e] = -3.0e38f;
                            tv[t] = best; te[t] = bi; }
                        const float e1 = expf(tv[1] - tv[0]), e2 = expf(tv[2] - tv[0]), e3 = expf(tv[3] - tv[0]); const float inv = 1.0f / (1.0f + e1 + e2 + e3);
                        *(f32x4*)((float*)(ws + WS_TOPW) + (size_t)m * 4) = (f32x4){inv, e1 * inv, e2 * inv, e3 * inv};
#pragma unroll
                        for (int t = 0; t < 4; ++t) { const unsigned rk = __hip_atomic_fetch_add((LAS unsigned*)&MISC[MW_HIST + te[t]], 1u, __ATOMIC_RELAXED, __HIP_MEMORY_SCOPE_WORKGROUP);
                            ((LAS unsigned*)(lds + LR_SLT))[i * 4 + t] = ((unsigned)te[t] << 16) | rk; } } } }
            __syncthreads(); }
        if (P5) { if (tid < NE) { const unsigned hcnt = MISC[MW_HIST + tid]; MISC[MW_BASE + tid] = hcnt ? atomicAdd((unsigned*)(ctl + CW_CNT + layer * NE + tid), hcnt) : 0u; }
            __syncthreads();
            if (tid < 256) { LAS unsigned* sl = (LAS unsigned*)(lds + LR_SLT) + tid; const unsigned v = *sl, e = v >> 16; const unsigned slot = (e << ECAP_SH) + MISC[MW_BASE + e] + (v & 0xffffu);
                *sl = slot; ((int*)(ws + WS_SLOT))[(size_t)row0 * 4 + tid] = (int)slot; }
            if (tid < NE) MISC[MW_HIST + tid] = 0u;
            __syncthreads(); }
        if (P5) { const int c4 = tid & 255, rsub = tid >> 8; const f32x4 w = *(const f32x4*)(nw + 4 * c4), s1 = *(const f32x4*)(scp + 4 * c4), s0 = *(const f32x4*)(shp + 4 * c4); const f32x4 ws1 = w * (s1 + 1.0f);
            unsigned char* A1 = ws + WS_A1;
#pragma unroll 8
            for (int it = 0; it < 32; ++it) { const int i = 2 * it + rsub; const f32x4 v = *(const f32x4*)(xin + (size_t)(row0 + i) * D + 4 * c4) * rstds[i] * ws1 + s0;
                const int pw = pk4_fp8(v[0] * S8_H, v[1] * S8_H, v[2] * S8_H, v[3] * S8_H); const v4u sl = *(const LAS v4u*)(lds + LR_SLT + 16 * i);
                *(int*)(A1 + (size_t)sl.x * D + 4 * c4) = pw; *(int*)(A1 + (size_t)sl.y * D + 4 * c4) = pw; *(int*)(A1 + (size_t)sl.z * D + 4 * c4) = pw; *(int*)(A1 + (size_t)sl.w * D + 4 * c4) = pw; } }
        else flat_modulate<F8_IN>(xin, row0, rstds, nw, scp, shp, H, tid);
        __syncthreads();
    }
}

__device__ __forceinline__ void final_rows(const Args& a, LAS unsigned char* lds, int vcu, int G, int tid, int lane) {
    unsigned char* ws = a.ws; const float* X = (const float*)(ws + WS_X); const float* MOD = (const float*)(ws + WS_MOD); LAS float* ssr = (LAS float*)(lds + LR_SSR);
    for (int row0 = vcu * 64; row0 < MTOK; row0 += G * 64) { const int b = row0 / SEQ;
        stage_slots(ws, row0, lds, tid); if (tid < 64) ssr[tid] = 0.f;
        __syncthreads();
        flat_combine<true>(X, a.out, row0, (const bf16*)(ws + WS_Y), MOD + ((size_t)(DEPTH - 1) * 2 + b) * 6144 + 5 * D, lds, tid, lane);
        asm volatile("s_waitcnt vmcnt(0)" ::: "memory");
        __syncthreads();
        { const int c4 = tid & 255, rsub = tid >> 8; const f32x4 w = *(const f32x4*)(a.final_norm_w + 4 * c4);
#pragma unroll 8
            for (int it = 0; it < 32; ++it) { const int i = 2 * it + rsub; float* op = a.out + (size_t)(row0 + i) * D + 4 * c4; const float rstd = 1.0f / sqrtf(ssr[i] * (1.0f / D) + EPS); *(f32x4*)op = *(const f32x4*)op * rstd * w; } }
        __syncthreads();
    }
}

__device__ __noinline__ void moe_tables(gu32* ctl, int layer, volatile LAS unsigned* MISC, int tid) {
    if (tid < NE) MISC[MW_CNT + tid] = __hip_atomic_load(ctl + CW_CNT + layer * NE + tid, RLX_AGENT);
    __syncthreads();
    if (tid == 0) { unsigned n = 0;
        for (int e = 0; e < NE; ++e) { const unsigned nt = (MISC[MW_CNT + e] + 255u) >> 8; for (unsigned t = 0; t < nt; ++t) MISC[MW_TILE + n + t] = (unsigned)(e * 64) + t; n += nt; }
        MISC[MW_NRT] = n; }
    __syncthreads();
}

constexpr int BP = 72;
template <int TYPE> struct MixCfg { static constexpr int DK = (TYPE == 1) ? 64 : 48, DV = (TYPE == 1) ? 64 : 96, NC = 4 * DK, NV = 4 * DV;
    static constexpr int STOFF = (TYPE == 0) ? ST_GLA : (TYPE == 1) ? ST_HG : ST_RET, COFF = (TYPE == 0) ? 0 : 192;
    static constexpr int CQ = (TYPE == 0) ? C_GQ : (TYPE == 1) ? C_HQ : C_RQ, CK = (TYPE == 0) ? C_GK : (TYPE == 1) ? C_HF : C_RK, CV = (TYPE == 0) ? C_GV : (TYPE == 1) ? C_HI : C_RV, CG = (TYPE == 0) ? C_GG : (TYPE == 1) ? C_HG : C_RG;
    static constexpr int MIXOFF = (TYPE == 0) ? 0 : (TYPE == 1) ? 384 : 640; };
__device__ __forceinline__ float fast_logsig(float x) { x = fmaxf(x, -80.f); return -__logf(1.0f + __expf(-x)); }
__device__ __forceinline__ float ret_lg(int h) { return logf(1.0f - exp2f(-5.0f - (float)h)); }

template <int NV>
__device__ __forceinline__ void stage_vt(const bf16* pv  , LAS bf16* VT, int tid) {
#pragma unroll 2
    for (int idx = tid; idx < 64 * (NV / 8); idx += NTHR) { const int j = idx & 63, ch = idx >> 6; const v4u p = *(const v4u*)(pv + (size_t)j * NPROJ + 8 * ch); LAS bf16* d = VT + (8 * ch) * BP + j;
        d[0 * BP] = (bf16)(p.x & 0xffffu); d[1 * BP] = (bf16)(p.x >> 16); d[2 * BP] = (bf16)(p.y & 0xffffu); d[3 * BP] = (bf16)(p.y >> 16);
        d[4 * BP] = (bf16)(p.z & 0xffffu); d[5 * BP] = (bf16)(p.z >> 16); d[6 * BP] = (bf16)(p.w & 0xffffu); d[7 * BP] = (bf16)(p.w >> 16); }
}

constexpr int LA_KT = 0, LA_VT = 36864, LA_TOT = 92160, LA_GA = 94208;
template <int TYPE>
__device__ __forceinline__ void mixa_batch(const Args& a, int layer, int unit, LAS unsigned char* lds, int tid, int lane, int wave) {
    typedef MixCfg<TYPE> C; constexpr int DK = C::DK, DV = C::DV, NC = C::NC, NV = C::NV;
    unsigned char* ws = a.ws; const bf16* PROJ = (const bf16*)(ws + WS_PROJ); float* CUM = (float*)(ws + WS_CUM); float* DVEC = (float*)(ws + WS_DVEC) + (size_t)unit * NDV;
    float* U = (float*)(ws + WS_U) + (size_t)unit * ST_TOT + C::STOFF;
    LAS bf16* KT = (LAS bf16*)(lds + LA_KT); LAS bf16* VT = (LAS bf16*)(lds + LA_VT); LAS float* TOT = (LAS float*)(lds + LA_TOT); const LAS float* GAs = (const LAS float*)(lds + LA_GA);
    const int row0 = unit * CH;
    const bool act = tid < 2 * NC; const int c = act ? tid % NC : 0, half = act ? tid / NC : 0, h = c / DK, d = c - h * DK;
    float cum[32]; float tot = 0.f;
    float w2[16], b2 = 0.f, lbv = 0.f, lg = 0.f, sg = 0.f; int f = 0, d2 = 0;
    if (act) {
        if constexpr (TYPE == 0) { b2 = a.gla_ba2[layer * 192 + c];
#pragma unroll
            for (int r = 0; r < 16; ++r) w2[r] = a.gla_wa2[(layer * 16 + r) * 192 + c]; }
        if constexpr (TYPE == 1) lbv = ((const float*)(ws + WS_LB))[layer * 256 + c];
        if constexpr (TYPE == 2) { lg = ret_lg(h); f = (d < 24) ? d : d - 24; d2 = (d < 24) ? d + 24 : d - 24; sg = (d < 24) ? -1.f : 1.f; }
#pragma unroll
        for (int i = 0; i < 32; ++i) { const int t = 32 * half + i; const bf16* pr = PROJ + (size_t)(row0 + t) * NPROJ; float g;
            if constexpr (TYPE == 0) { float pre = b2;
#pragma unroll
                for (int r = 0; r < 16; ++r) pre += GAs[t * 16 + r] * w2[r];
                g = fast_logsig(pre) * (1.0f / 16.0f); }
            else if constexpr (TYPE == 1) { const float hf = fminf(fmaxf(bf2f(pr[C_HF + c]), -80.f), 80.f); const float sgm = 1.0f / (1.0f + __expf(-hf));
                g = __logf(lbv + (1.0f - lbv) * sgm); }
            else g = lg;
            tot += g; cum[i] = tot;
            if ((i & 7) == 7) asm volatile("" ::: "memory"); }
        TOT[c * 2 + half] = tot;
    }
    stage_vt<NV>(PROJ + (size_t)row0 * NPROJ + C::CV, VT, tid);
    __syncthreads();
    if (act) { const float t0 = TOT[c * 2], t1 = TOT[c * 2 + 1]; const float off = half ? t0 : 0.f, last = t0 + t1;
#pragma unroll
        for (int q = 0; q < 4; ++q) { float kt[8];
#pragma unroll
            for (int j = 0; j < 8; ++j) { const int i = 8 * q + j; const float cm = cum[i] + off; const size_t row = (size_t)(row0 + 32 * half + i); const bf16* pr = PROJ + row * NPROJ; float k;
                if constexpr (TYPE == 0) k = bf2f(pr[C_GK + c]);
                else if constexpr (TYPE == 1) k = 1.0f - __expf(cum[i] - (i > 0 ? cum[i - 1] : 0.f));
                else { const float* rp = (const float*)(ws + WS_ROPE) + row * 48; k = bf2f(pr[C_RK + h * 48 + d]) * rp[f] + sg * bf2f(pr[C_RK + h * 48 + d2]) * rp[24 + f]; }
                if constexpr (TYPE != 2) CUM[row * NDV + C::COFF + c] = cm;
                kt[j] = k * __expf(last - cm); }
            v4u w; w.x = pk2(kt[0], kt[1]); w.y = pk2(kt[2], kt[3]); w.z = pk2(kt[4], kt[5]); w.w = pk2(kt[6], kt[7]);
            *(LAS v4u*)(KT + c * BP + 32 * half + 8 * q) = w;
            asm volatile("" ::: "memory"); }
        if (TYPE != 2 && half == 0) DVEC[C::COFF + c] = __expf(last);
    }
    __syncthreads();
    constexpr int TD = DK / 16, NT = (DV / 16) * TD;
    for (int ti = wave; ti < 4 * NT; ti += NWAVES) { const int hh = ti / NT, tr = ti - hh * NT, te = tr / TD, td = tr - te * TD; f32x4 acc = {0.f, 0.f, 0.f, 0.f};
#pragma unroll
        for (int kk = 0; kk < 2; ++kk) acc = __builtin_amdgcn_mfma_f32_16x16x32_bf16(ldfrag(VT, BP, hh * DV + te * 16, kk * 32, lane), ldfrag(KT, BP, hh * DK + td * 16, kk * 32, lane), acc, 0, 0, 0);
        float* Uh = U + hh * DK * DV;
#pragma unroll
        for (int r = 0; r < 4; ++r) Uh[(te * 16 + (lane >> 4) * 4 + r) * DK + td * 16 + (lane & 15)] = acc[r]; }
    __syncthreads();
}
__device__ __forceinline__ void p3a_summaries(const Args& a, int layer, LAS unsigned char* lds, int vcu, int G, int tid, int lane, int wave) {
    for (int unit = vcu; unit < NUNIT; unit += G) {
        { LAS float* GAs = (LAS float*)(lds + LA_GA); const float* GA = (const float*)(a.ws + WS_GA); for (int i = tid; i < CH * 16; i += NTHR) GAs[i] = GA[(size_t)unit * CH * 16 + i]; }
        __syncthreads();
        mixa_batch<0>(a, layer, unit, lds, tid, lane, wave);
        mixa_batch<1>(a, layer, unit, lds, tid, lane, wave);
        mixa_batch<2>(a, layer, unit, lds, tid, lane, wave);
    }
}

__device__ __forceinline__ void p3b_scan(const Args& a, int vcu, int G, int tid) {
    unsigned char* ws = a.ws; const float* U = (const float*)(ws + WS_U); const float* DVEC = (const float*)(ws + WS_DVEC); bf16* SP = (bf16*)(ws + WS_SP);
    for (int gid = vcu * NTHR + tid; gid < BATCH * ST_TOT; gid += G * NTHR) {
        const int b = gid / ST_TOT, el = gid - b * ST_TOT;
        int di = -1; float cdec = 0.f;
        if (el < ST_HG) { const int h = el / 4608, d = (el - h * 4608) % 48; di = h * 48 + d; }
        else if (el < ST_RET) { const int r = el - ST_HG, h = r / 4096, d = r % 64; di = 192 + h * 64 + d; }
        else { const int h = (el - ST_RET) / 4608; cdec = expf(64.0f * logf(1.0f - exp2f(-5.0f - (float)h))); }
        const float* up = U + (size_t)b * NCH * ST_TOT + el; const float* dp = DVEC + (size_t)b * NCH * NDV + (di < 0 ? 0 : di); bf16* sp = SP + (size_t)b * NCH * ST_TOT + el;
        float s = 0.f;
        for (int n0 = 0; n0 < NCH; n0 += 8) { float u[8], dc[8];
#pragma unroll
            for (int i = 0; i < 8; ++i) { u[i] = up[(size_t)(n0 + i) * ST_TOT]; dc[i] = (di < 0) ? cdec : dp[(size_t)(n0 + i) * NDV]; }
#pragma unroll
            for (int i = 0; i < 8; ++i) { sp[(size_t)(n0 + i) * ST_TOT] = (bf16)f2bf(s); s = dc[i] * s + u[i]; } }
    }
}

constexpr int LC_VT = 0, LC_ST = 55296, LC_AB = 110592, OBP = 104;
template <int TYPE, bool ISQ>
__device__ __forceinline__ void mix_frag(const Args& a, int h, size_t row, int t, int d0, float (&x)[8], float (&cm)[8]) {
    typedef MixCfg<TYPE> C; constexpr int DK = C::DK;
    unsigned char* ws = a.ws; const bf16* pr = (const bf16*)(ws + WS_PROJ) + row * NPROJ;
    if constexpr (TYPE == 0) {
        const v4u p = *(const v4u*)(pr + (ISQ ? C_GQ : C_GK) + h * DK + d0); const unsigned pw[4] = {p.x, p.y, p.z, p.w};
        const float* cp = (const float*)(ws + WS_CUM) + row * NDV + h * DK + d0; const f32x4 c0 = *(const f32x4*)cp, c1 = *(const f32x4*)(cp + 4);
#pragma unroll
        for (int j = 0; j < 4; ++j) { x[2 * j] = __builtin_bit_cast(float, pw[j] << 16); x[2 * j + 1] = __builtin_bit_cast(float, pw[j] & 0xffff0000u); cm[j] = c0[j]; cm[4 + j] = c1[j]; }
        if (ISQ) {
#pragma unroll
            for (int j = 0; j < 8; ++j) x[j] *= 0.14433756729740643f; }
    } else if constexpr (TYPE == 1) {
        const float* cp = (const float*)(ws + WS_CUM) + row * NDV + 192 + h * DK + d0; const f32x4 c0 = *(const f32x4*)cp, c1 = *(const f32x4*)(cp + 4);
#pragma unroll
        for (int j = 0; j < 4; ++j) { cm[j] = c0[j]; cm[4 + j] = c1[j]; }
        if (ISQ) { const v4u p = *(const v4u*)(pr + C_HQ + h * DK + d0); const unsigned pw[4] = {p.x, p.y, p.z, p.w};
#pragma unroll
            for (int j = 0; j < 4; ++j) { x[2 * j] = __builtin_bit_cast(float, pw[j] << 16); x[2 * j + 1] = __builtin_bit_cast(float, pw[j] & 0xffff0000u); } }
        else { f32x4 p0 = {0.f, 0.f, 0.f, 0.f}, p1 = {0.f, 0.f, 0.f, 0.f}; if (t > 0) { p0 = *(const f32x4*)(cp - NDV); p1 = *(const f32x4*)(cp - NDV + 4); }
#pragma unroll
            for (int j = 0; j < 4; ++j) { x[j] = 1.0f - __expf(c0[j] - p0[j]); x[4 + j] = 1.0f - __expf(c1[j] - p1[j]); } }
    } else {
        const int f0 = (d0 < 24) ? d0 : d0 - 24, dp = (d0 < 24) ? d0 + 24 : d0 - 24; const float sg = (d0 < 24) ? -1.f : 1.f;
        const int cb = (ISQ ? C_RQ : C_RK) + h * DK; const v4u p = *(const v4u*)(pr + cb + d0), pp = *(const v4u*)(pr + cb + dp); const unsigned pw[4] = {p.x, p.y, p.z, p.w}, qw[4] = {pp.x, pp.y, pp.z, pp.w};
        const float* rp = (const float*)(ws + WS_ROPE) + row * 48; const f32x4 cs0 = *(const f32x4*)(rp + f0), cs1 = *(const f32x4*)(rp + f0 + 4), sn0 = *(const f32x4*)(rp + 24 + f0), sn1 = *(const f32x4*)(rp + 24 + f0 + 4);
        const float cmv = (float)(t + 1) * ret_lg(h);
#pragma unroll
        for (int j = 0; j < 4; ++j) { const float xa = __builtin_bit_cast(float, pw[j] << 16), xb = __builtin_bit_cast(float, pw[j] & 0xffff0000u), ya = __builtin_bit_cast(float, qw[j] << 16), yb = __builtin_bit_cast(float, qw[j] & 0xffff0000u);
            const float ca = (j < 2) ? cs0[2 * j] : cs1[2 * j - 4], cb2 = (j < 2) ? cs0[2 * j + 1] : cs1[2 * j - 3], sa = (j < 2) ? sn0[2 * j] : sn1[2 * j - 4], sb = (j < 2) ? sn0[2 * j + 1] : sn1[2 * j - 3];
            x[2 * j] = xa * ca + sg * ya * sa; x[2 * j + 1] = xb * cb2 + sg * yb * sb; cm[2 * j] = cmv; cm[2 * j + 1] = cmv; }
        if (ISQ) {
#pragma unroll
            for (int j = 0; j < 8; ++j) x[j] *= 0.14433756729740643f; }
    }
}

template <int TYPE>
__device__ __forceinline__ void mixc_batch(const Args& a, int layer, int unit, LAS unsigned char* lds, int tid, int lane, int wave) {
    typedef MixCfg<TYPE> C; constexpr int DK = C::DK, DV = C::DV, NV = C::NV, TE = DV / 16;
    unsigned char* ws = a.ws; const bf16* PROJ = (const bf16*)(ws + WS_PROJ); bf16* MIX = (bf16*)(ws + WS_MIX);
    LAS bf16* VT = (LAS bf16*)(lds + LC_VT); LAS bf16* ST = (LAS bf16*)(lds + LC_ST); LAS bf16* AB = (LAS bf16*)(lds + LC_AB) + wave * 16 * OBP;
    const int row0 = unit * CH;
    stage_vt<NV>(PROJ + (size_t)row0 * NPROJ + C::CV, VT, tid);
    { const bf16* SPu = (const bf16*)(ws + WS_SP) + (size_t)unit * ST_TOT + C::STOFF;
        for (int idx = tid; idx < NV * 8; idx += NTHR) { const int er = idx >> 3, ch = idx & 7; v4u w = {0u, 0u, 0u, 0u}; if (ch * 8 < DK) w = *(const v4u*)(SPu + (size_t)er * DK + ch * 8); *(LAS v4u*)(ST + er * BP + ch * 8) = w; } }
    __syncthreads();
    const int h = wave >> 1, hsel = wave & 1, r = lane & 15, g = lane >> 4;
    const LAS bf16* STh = ST + h * DV * BP; const LAS bf16* VTh = VT + h * DV * BP;
    const float* CUMp = (const float*)(ws + WS_CUM);
    for (int ib = 0; ib < 2; ++ib) { const int I = ib ? 3 - hsel : hsel;
        pg8::bf16x8 qh[2], qt[2]; float refv[2][8];
#pragma unroll
        for (int s = 0; s < 2; ++s) { const int d0 = 32 * s + 8 * g; const bool valid = d0 < DK; const int d0c = valid ? d0 : 0;
            float x[8], cm[8]; mix_frag<TYPE, true>(a, h, (size_t)(row0 + 16 * I + r), 16 * I + r, d0c, x, cm);
            if constexpr (TYPE == 2) {
#pragma unroll
                for (int j = 0; j < 8; ++j) refv[s][j] = (float)(16 * I) * ret_lg(h);
            } else { if (I > 0) { const float* cp = CUMp + (size_t)(row0 + 16 * I - 1) * NDV + C::COFF + h * DK + d0c; const f32x4 c0 = *(const f32x4*)cp, c1 = *(const f32x4*)(cp + 4);
#pragma unroll
                    for (int j = 0; j < 4; ++j) { refv[s][j] = c0[j]; refv[s][4 + j] = c1[j]; } }
                else {
#pragma unroll
                    for (int j = 0; j < 8; ++j) refv[s][j] = 0.f; } }
            float xh[8], xt[8];
#pragma unroll
            for (int j = 0; j < 8; ++j) { xh[j] = valid ? x[j] * __expf(cm[j] - refv[s][j]) : 0.f; xt[j] = valid ? x[j] * __expf(cm[j]) : 0.f; }
            qh[s] = pack8(xh); qt[s] = pack8(xt); }
        for (int J = 0; J <= I; ++J) { f32x4 acc = {0.f, 0.f, 0.f, 0.f};
#pragma unroll
            for (int s = 0; s < 2; ++s) { const int d0 = 32 * s + 8 * g; const bool valid = d0 < DK; const int d0c = valid ? d0 : 0;
                float x[8], cm[8]; mix_frag<TYPE, false>(a, h, (size_t)(row0 + 16 * J + r), 16 * J + r, d0c, x, cm);
                float xk[8];
#pragma unroll
                for (int j = 0; j < 8; ++j) xk[j] = valid ? x[j] * __expf(fminf(refv[s][j] - cm[j], 80.f)) : 0.f;
                acc = __builtin_amdgcn_mfma_f32_16x16x32_bf16(qh[s], pack8(xk), acc, 0, 0, 0); }
#pragma unroll
            for (int q = 0; q < 4; ++q) { const int i = 4 * g + q; const float v = (J < I || r <= i) ? acc[q] : 0.f; AB[i * BP + 16 * J + r] = (bf16)f2bf(v); } }
        if ((I & 1) == 0) {
#pragma unroll
            for (int q = 0; q < 4; ++q) AB[(4 * g + q) * BP + 16 * (I + 1) + r] = (bf16)0; }
        asm volatile("s_waitcnt lgkmcnt(0)" ::: "memory");
        const pg8::bf16x8 ah0 = *(const LAS pg8::bf16x8*)(AB + r * BP + 8 * g), ah1 = *(const LAS pg8::bf16x8*)(AB + r * BP + 32 + 8 * g);
        f32x4 o[TE];
#pragma unroll
        for (int te = 0; te < TE; ++te) { f32x4 acc = {0.f, 0.f, 0.f, 0.f};
            acc = __builtin_amdgcn_mfma_f32_16x16x32_bf16(qt[0], ldfrag(STh, BP, te * 16, 0, lane), acc, 0, 0, 0);
            acc = __builtin_amdgcn_mfma_f32_16x16x32_bf16(qt[1], ldfrag(STh, BP, te * 16, 32, lane), acc, 0, 0, 0);
            acc = __builtin_amdgcn_mfma_f32_16x16x32_bf16(ah0, ldfrag(VTh, BP, te * 16, 0, lane), acc, 0, 0, 0);
            if (I >= 2) acc = __builtin_amdgcn_mfma_f32_16x16x32_bf16(ah1, ldfrag(VTh, BP, te * 16, 32, lane), acc, 0, 0, 0);
            o[te] = acc; }
#pragma unroll
        for (int q = 0; q < 4; ++q) { float s1 = 0.f, s2 = 0.f;
#pragma unroll
            for (int te = 0; te < TE; ++te) { s1 += o[te][q]; s2 += o[te][q] * o[te][q]; }
#pragma unroll
            for (int m = 1; m < 16; m <<= 1) { s1 += __shfl_xor(s1, m); s2 += __shfl_xor(s2, m); }
            float mean = 0.f, rstd;
            if constexpr (TYPE == 2) { mean = s1 * (1.0f / DV); rstd = 1.0f / sqrtf(fmaxf(s2 * (1.0f / DV) - mean * mean, 0.f) + EPS); }
            else rstd = 1.0f / sqrtf(s2 * (1.0f / DV) + EPS);
#pragma unroll
            for (int te = 0; te < TE; ++te) AB[(4 * g + q) * OBP + te * 16 + r] = (bf16)f2bf((o[te][q] - mean) * rstd); }
        asm volatile("s_waitcnt lgkmcnt(0)" ::: "memory");
        constexpr int NCHK = DV / 8;
#pragma unroll
        for (int i = 0; i < (16 * NCHK) / 64; ++i) { const int cidx = lane + 64 * i, orow = cidx / NCHK, ch = cidx - orow * NCHK; const size_t row = (size_t)(row0 + 16 * I + orow);
            const v4u ov = *(const LAS v4u*)(AB + orow * OBP + 8 * ch); const v4u gv = *(const v4u*)(PROJ + row * NPROJ + C::CG + h * DV + 8 * ch);
            const unsigned ow[4] = {ov.x, ov.y, ov.z, ov.w}, gw[4] = {gv.x, gv.y, gv.z, gv.w}; float res[8];
            f32x4 w0 = {1.f, 1.f, 1.f, 1.f}, w1 = {1.f, 1.f, 1.f, 1.f};
            if constexpr (TYPE == 0) { const float* wp = a.gla_norm_w + layer * 384 + h * 96 + 8 * ch; w0 = *(const f32x4*)wp; w1 = *(const f32x4*)(wp + 4); }
            if constexpr (TYPE == 1) { const float* wp = a.hg_norm_w + layer * 256 + h * 64 + 8 * ch; w0 = *(const f32x4*)wp; w1 = *(const f32x4*)(wp + 4); }
#pragma unroll
            for (int j = 0; j < 4; ++j) { const float oa = __builtin_bit_cast(float, ow[j] << 16), ob = __builtin_bit_cast(float, ow[j] & 0xffff0000u), ga = __builtin_bit_cast(float, gw[j] << 16), gb = __builtin_bit_cast(float, gw[j] & 0xffff0000u);
                const float wa = (j < 2) ? w0[2 * j] : w1[2 * j - 4], wb = (j < 2) ? w0[2 * j + 1] : w1[2 * j - 3];
                const float sa = 1.0f / (1.0f + __expf(-ga)), sb = 1.0f / (1.0f + __expf(-gb));
                res[2 * j] = oa * wa * ((TYPE == 1) ? sa : ga * sa); res[2 * j + 1] = ob * wb * ((TYPE == 1) ? sb : gb * sb); }
            if (F8_OUT) { typedef int i32x2 __attribute__((ext_vector_type(2)));
                *(i32x2*)((unsigned char*)MIX + row * D + C::MIXOFF + h * DV + 8 * ch) = (i32x2){pk4_fp8(res[0] * S8_M, res[1] * S8_M, res[2] * S8_M, res[3] * S8_M), pk4_fp8(res[4] * S8_M, res[5] * S8_M, res[6] * S8_M, res[7] * S8_M)}; }
            else { v4u w; w.x = pk2(res[0], res[1]); w.y = pk2(res[2], res[3]); w.z = pk2(res[4], res[5]); w.w = pk2(res[6], res[7]); *(v4u*)(MIX + row * D + C::MIXOFF + h * DV + 8 * ch) = w; } }
    }
    __syncthreads();
}
__device__ __forceinline__ void p3c_outputs(const Args& a, int layer, LAS unsigned char* lds, int vcu, int G, int tid, int lane, int wave) {
    for (int unit = vcu; unit < NUNIT; unit += G) {
        mixc_batch<0>(a, layer, unit, lds, tid, lane, wave);
        mixc_batch<1>(a, layer, unit, lds, tid, lane, wave);
        mixc_batch<2>(a, layer, unit, lds, tid, lane, wave);
    }
}


constexpr int MW_ARGS = 800;
__device__ __forceinline__ const void* ld_argp(const volatile LAS unsigned* T, int i) {
    const unsigned lo = __builtin_amdgcn_readfirstlane(T[2 * i]), hi = __builtin_amdgcn_readfirstlane(T[2 * i + 1]);
    return (const void*)(((unsigned long long)hi << 32) | lo);
}
__device__ __forceinline__ Args load_args(LAS unsigned char* lds) {
    const volatile LAS unsigned* T = (const volatile LAS unsigned*)(lds + MISC_OFF) + MW_ARGS;
    Args a;
    a.x = (const float*)ld_argp(T, 0); a.c = (const float*)ld_argp(T, 1); a.pos = (const int*)ld_argp(T, 2); a.w_mod = (const float*)ld_argp(T, 3); a.b_mod = (const float*)ld_argp(T, 4);
    a.norm1_w = (const float*)ld_argp(T, 5); a.w_in = (const float*)ld_argp(T, 6); a.gla_wa2 = (const float*)ld_argp(T, 7); a.gla_ba2 = (const float*)ld_argp(T, 8); a.hg_lb = (const float*)ld_argp(T, 9);
    a.gla_norm_w = (const float*)ld_argp(T, 10); a.hg_norm_w = (const float*)ld_argp(T, 11); a.w_out = (const float*)ld_argp(T, 12); a.norm2_w = (const float*)ld_argp(T, 13); a.w_r = (const float*)ld_argp(T, 14);
    a.b_r = (const float*)ld_argp(T, 15); a.w_gu = (const float*)ld_argp(T, 16); a.b_gu = (const float*)ld_argp(T, 17); a.w_dn = (const float*)ld_argp(T, 18); a.b_dn = (const float*)ld_argp(T, 19);
    a.final_norm_w = (const float*)ld_argp(T, 20); a.out = (float*)ld_argp(T, 21); a.ws = (unsigned char*)ld_argp(T, 22); a.ph_lo = 0; a.ph_hi = 0;
    return a;
}
#define PH_CTX() { unsigned l_ = (unsigned)(size_t)lds; asm volatile("" : "+s"(l_)); lds = (LAS unsigned char*)(size_t)l_; } const Args args = load_args(lds); volatile LAS unsigned* MISC = (volatile LAS unsigned*)(lds + MISC_OFF); int tid_ = wv * 64 + (int)__builtin_amdgcn_mbcnt_hi(~0u, __builtin_amdgcn_mbcnt_lo(~0u, 0u)); asm volatile("" : "+v"(tid_)); const int tid = tid_, lane = tid & 63, wave = __builtin_amdgcn_readfirstlane(tid >> 6); \
    const int G = gridDim.x; const int bx = blockIdx.x; const int vcu = (G % 8 == 0) ? (bx % 8) * (G / 8) + bx / 8 : bx; unsigned char* ws = args.ws; gu32* ctl = (gu32*)(ws + WS_CTL); \
    (void)MISC; (void)lane; (void)wave; (void)vcu; (void)ctl; (void)bx; (void)tid
__device__ __forceinline__ void ph_p0(LAS unsigned char* lds, int wv) { PH_CTX(); p0_prologue(args, lds, vcu, G, tid, lane, wave); }
__device__ __forceinline__ void ph_p1(LAS unsigned char* lds, int wv, int layer_) { int layer = __builtin_amdgcn_readfirstlane(layer_); asm volatile("" : "+s"(layer)); PH_CTX(); rows_mfma<16>(args, layer, lds, MISC, ctl, vcu, G, tid, lane, wave); }
__device__ __forceinline__ void ph_p2(LAS unsigned char* lds, int wv, int layer_) { int layer = __builtin_amdgcn_readfirstlane(layer_); asm volatile("" : "+s"(layer)); PH_CTX();
    pg8::Gemm g{(const bf16*)(ws + WS_H), (const bf16*)(ws + WS_WIN + (size_t)layer * NPROJ * D * (F8_IN ? 1 : 2)), MTOK, NPROJ, F8_IN ? D / 2 : D}; pg8::StaticOrder S; S.init(MTOK, NPROJ, G, bx);
    pg8::EpiBf16Plain E{(bf16*)(ws + WS_PROJ), NPROJ, F8_IN ? 1.0f / (S8_H * S8_W) : 1.0f};
    pg8::gemm_phase<pg8::EpiBf16Plain, pg8::StaticOrder, true, true, F8_IN>(lds, g, S, E, tid); }
__device__ __forceinline__ void ph_p3a(LAS unsigned char* lds, int wv, int layer_) { int layer = __builtin_amdgcn_readfirstlane(layer_); asm volatile("" : "+s"(layer)); PH_CTX(); p3a_summaries(args, layer, lds, vcu, G, tid, lane, wave); }
__device__ __forceinline__ void ph_p3b(LAS unsigned char* lds, int wv) { PH_CTX(); p3b_scan(args, vcu, G, tid); }
__device__ __forceinline__ void ph_p3c(LAS unsigned char* lds, int wv, int layer_) { int layer = __builtin_amdgcn_readfirstlane(layer_); asm volatile("" : "+s"(layer)); PH_CTX(); p3c_outputs(args, layer, lds, vcu, G, tid, lane, wave); }
__device__ __forceinline__ void ph_p4(LAS unsigned char* lds, int wv, int layer_) { int layer = __builtin_amdgcn_readfirstlane(layer_); asm volatile("" : "+s"(layer)); PH_CTX();
    pg8::Gemm g{(const bf16*)(ws + WS_MIX), (const bf16*)(ws + WS_WOUT + (size_t)layer * D * D * (F8_OUT ? 1 : 2)), MTOK, D, F8_OUT ? D / 2 : D}; pg8::StaticOrder S; S.init(MTOK, D, G, bx);
    pg8::EpiResGate E{(layer == 0) ? args.x : (const float*)(ws + WS_X), (float*)(ws + WS_X), D, (const float*)(ws + WS_MOD) + (size_t)layer * 2 * 6144 + 2 * D, 6144, SEQ, F8_OUT ? 1.0f / (S8_M * S8_W) : 1.0f};
    pg8::gemm_phase<pg8::EpiResGate, pg8::StaticOrder, true, true, F8_OUT>(lds, g, S, E, tid); }
__device__ __forceinline__ void ph_p5(LAS unsigned char* lds, int wv, int layer_) { int layer = __builtin_amdgcn_readfirstlane(layer_); asm volatile("" : "+s"(layer)); PH_CTX(); rows_mfma<32>(args, layer, lds, MISC, ctl, vcu, G, tid, lane, wave); }
__device__ __forceinline__ void ph_p7(LAS unsigned char* lds, int wv, int layer_) { int layer = __builtin_amdgcn_readfirstlane(layer_); asm volatile("" : "+s"(layer)); PH_CTX();
    moe_tables(ctl, layer, MISC, tid);
    const int nrt = __builtin_amdgcn_readfirstlane((int)MISC[MW_NRT]);
    pg8::Gemm g{(const bf16*)(ws + WS_A1), (const bf16*)(ws + WS_WGU + (size_t)layer * NE * 2048 * D), nrt * 256, NE * 2048, D / 2};
    pg8::MoeOrder S{8, G, vcu, nrt * 8, (const LAS int*)(lds + MISC_OFF + 4 * MW_TILE)};
    pg8::EpiSwiglu E{ws + WS_ACT, FFN, args.b_gu + (size_t)layer * NE * 2048, 1.0f / (S8_H * S8_W), S8_A};
    pg8::gemm_phase<pg8::EpiSwiglu, pg8::MoeOrder, true, true, true>(lds, g, S, E, tid); }
__device__ __forceinline__ void ph_p8(LAS unsigned char* lds, int wv, int layer_) { int layer = __builtin_amdgcn_readfirstlane(layer_); asm volatile("" : "+s"(layer)); PH_CTX();
    moe_tables(ctl, layer, MISC, tid);
    const int nrt = __builtin_amdgcn_readfirstlane((int)MISC[MW_NRT]);
    pg8::Gemm g{(const bf16*)(ws + WS_ACT), (const bf16*)(ws + WS_WDN + (size_t)layer * NE * D * FFN), nrt * 256, NE * D, FFN / 2};
    pg8::MoeOrder S{4, G, vcu, nrt * 4, (const LAS int*)(lds + MISC_OFF + 4 * MW_TILE)};
    pg8::EpiBf16Bias E{(bf16*)(ws + WS_Y), D, args.b_dn + (size_t)layer * NE * D, D, 1.0f / (S8_A * S8_W)};
    pg8::gemm_phase<pg8::EpiBf16Bias, pg8::MoeOrder, true, true, true>(lds, g, S, E, tid); }
__device__ __forceinline__ void ph_final(LAS unsigned char* lds, int wv) { PH_CTX(); final_rows(args, lds, vcu, G, tid, lane); }

#ifndef DBL_MASK
#define DBL_MASK 0
#endif
#if DBL_MASK
#define RUN(bit, call) do { if ((DBL_MASK >> (bit)) & 1) { const unsigned long long t0_ = __builtin_amdgcn_s_memrealtime(); call; const unsigned long long t1_ = __builtin_amdgcn_s_memrealtime(); \
        while (__builtin_amdgcn_s_memrealtime() - t1_ < t1_ - t0_) __builtin_amdgcn_s_sleep(8); } else { call; } } while (0)
#else
#define RUN(bit, call) do { call; } while (0)
#endif
__global__ void __launch_bounds__(NTHR, 2) hybrid_fwd(Args args) {
    extern __shared__ __attribute__((aligned(16))) unsigned char lds_raw[];
    LAS unsigned char* lds = (LAS unsigned char*)lds_raw;
    volatile LAS unsigned* MISC = (volatile LAS unsigned*)(lds + MISC_OFF);
    const int tid = threadIdx.x; const int wv = __builtin_amdgcn_readfirstlane(tid >> 6);
    gu32* ctl = (gu32*)(args.ws + WS_CTL);
    for (int u = tid; u < (LDS_BYTES - MISC_OFF) / 4; u += NTHR) MISC[u] = 0u;
    __syncthreads();
    if (tid == 0) {
#define ST_ARG(i, p) do { const unsigned long long v_ = (unsigned long long)(p); MISC[MW_ARGS + 2 * (i)] = (unsigned)v_; MISC[MW_ARGS + 2 * (i) + 1] = (unsigned)(v_ >> 32); } while (0)
        ST_ARG(0, args.x); ST_ARG(1, args.c); ST_ARG(2, args.pos); ST_ARG(3, args.w_mod); ST_ARG(4, args.b_mod); ST_ARG(5, args.norm1_w); ST_ARG(6, args.w_in); ST_ARG(7, args.gla_wa2); ST_ARG(8, args.gla_ba2);
        ST_ARG(9, args.hg_lb); ST_ARG(10, args.gla_norm_w); ST_ARG(11, args.hg_norm_w); ST_ARG(12, args.w_out); ST_ARG(13, args.norm2_w); ST_ARG(14, args.w_r); ST_ARG(15, args.b_r); ST_ARG(16, args.w_gu);
        ST_ARG(17, args.b_gu); ST_ARG(18, args.w_dn); ST_ARG(19, args.b_dn); ST_ARG(20, args.final_norm_w); ST_ARG(21, args.out); ST_ARG(22, args.ws);
#undef ST_ARG
    }
    __syncthreads();
    const int lo = args.ph_lo, hi = args.ph_hi;
    const bool multi = (hi - lo) > 1;
    XcdBarrier bar; bar.bar = (unsigned*)(ctl + CW_BAR); bar.x = 0; bar.st = nullptr;
    if (multi) bar = xcd_barrier_post((unsigned*)(ctl + CW_BAR), MISC + MW_BAR);
#define IN(k) (lo <= (k) && (k) < hi)
#define SEAM(k) do { if (IN(k) && IN((k) + 1)) xcd_barrier(bar); } while (0)

    if (IN(0)) RUN(0, ph_p0(lds, wv));
    SEAM(0);
    for (int layer = 0; layer < DEPTH; ++layer) {
        const int pb = 1 + 9 * layer;
        if (IN(pb + 0)) RUN(1, ph_p1(lds, wv, layer));
        SEAM(pb + 0);
        if (IN(pb + 1)) RUN(2, ph_p2(lds, wv, layer));
        SEAM(pb + 1);
        if (IN(pb + 2)) RUN(3, ph_p3a(lds, wv, layer));
        SEAM(pb + 2);
        if (IN(pb + 3)) RUN(4, ph_p3b(lds, wv));
        SEAM(pb + 3);
        if (IN(pb + 4)) RUN(5, ph_p3c(lds, wv, layer));
        SEAM(pb + 4);
        if (IN(pb + 5)) RUN(6, ph_p4(lds, wv, layer));
        SEAM(pb + 5);
        if (IN(pb + 6)) RUN(7, ph_p5(lds, wv, layer));
        SEAM(pb + 6);
        if (IN(pb + 7)) RUN(9, ph_p7(lds, wv, layer));
        SEAM(pb + 7);
        if (IN(pb + 8)) RUN(10, ph_p8(lds, wv, layer));
        SEAM(pb + 8);
    }
    if (IN(NPHASE - 1)) RUN(11, ph_final(lds, wv));
#undef IN
#undef SEAM
}

#ifndef MK_SINGLE
#define MK_SINGLE 1
#endif
extern "C" void kernel_launch(void* const* d_in, const int* in_sizes, int n_in, void* d_out, int out_size, void* d_ws, size_t ws_size, hipStream_t stream) {
    static int grid = 0;
    if (grid == 0) {
        if (n_in != 21 || in_sizes[0] != MTOK * D || out_size != MTOK * D || ws_size < WS_END) { fprintf(stderr, "kernel_launch: unexpected problem shape (n_in %d, in0 %d, out %d, ws %zu)\n", n_in, n_in > 0 ? in_sizes[0] : -1, out_size, ws_size); grid = -1; return; }
        int dev = 0, cus = 0, per_cu = 0;
        if (hipGetDevice(&dev) != hipSuccess || hipDeviceGetAttribute(&cus, hipDeviceAttributeMultiprocessorCount, dev) != hipSuccess) { grid = -1; return; }
        if (hipFuncSetAttribute((const void*)hybrid_fwd, hipFuncAttributeMaxDynamicSharedMemorySize, LDS_BYTES) != hipSuccess) { fprintf(stderr, "kernel_launch: hipFuncSetAttribute failed\n"); grid = -1; return; }
        if (hipOccupancyMaxActiveBlocksPerMultiprocessor(&per_cu, (const void*)hybrid_fwd, NTHR, LDS_BYTES) != hipSuccess || per_cu < 1) fprintf(stderr, "kernel_launch: occupancy query says %d\n", per_cu);
        (void)hipGetLastError();
        grid = cus;
    }
    if (grid < 0) return;
    (void)hipMemsetAsync((char*)d_ws + WS_CTL, 0, CTL_ZERO_BYTES, stream);
    Args a{};
    a.x = (const float*)d_in[0]; a.c = (const float*)d_in[1]; a.pos = (const int*)d_in[2]; a.w_mod = (const float*)d_in[3]; a.b_mod = (const float*)d_in[4]; a.norm1_w = (const float*)d_in[5];
    a.w_in = (const float*)d_in[6]; a.gla_wa2 = (const float*)d_in[7]; a.gla_ba2 = (const float*)d_in[8]; a.hg_lb = (const float*)d_in[9]; a.gla_norm_w = (const float*)d_in[10]; a.hg_norm_w = (const float*)d_in[11];
    a.w_out = (const float*)d_in[12]; a.norm2_w = (const float*)d_in[13]; a.w_r = (const float*)d_in[14]; a.b_r = (const float*)d_in[15]; a.w_gu = (const float*)d_in[16]; a.b_gu = (const float*)d_in[17];
    a.w_dn = (const float*)d_in[18]; a.b_dn = (const float*)d_in[19]; a.final_norm_w = (const float*)d_in[20]; a.out = (float*)d_out; a.ws = (unsigned char*)d_ws;
#if MK_SINGLE
    a.ph_lo = 0; a.ph_hi = NPHASE;
    hipLaunchKernelGGL(hybrid_fwd, dim3(grid), dim3(NTHR), LDS_BYTES, stream, a);
#else
    for (int p = 0; p < NPHASE; ++p) { a.ph_lo = p; a.ph_hi = p + 1; hipLaunchKernelGGL(hybrid_fwd, dim3(grid), dim3(NTHR), LDS_BYTES, stream, a); }
#endif
}
```

```cpp
#include <hip/hip_runtime.h>
#include <cstdio>
#include <cstdint>
namespace pg8 {
#define PG8_LAS __attribute__((address_space(3)))
typedef unsigned short bf16_t;
typedef short bf16x8 __attribute__((ext_vector_type(8)));
typedef float f32x4 __attribute__((ext_vector_type(4)));
typedef unsigned u32x4 __attribute__((ext_vector_type(4)));
constexpr int BM = 256, BK = 64, HALF = 128, HTB = HALF * BK * 2  , STAGE_BYTES = 8 * HTB, NXCD = 8, WGM = 8;

__host__ __device__ __forceinline__ int lds_byte(int r, int c) { const int st = (r >> 4) * 2 + (c >> 5), rr = r & 15, cc = c & 31, ob = rr * 64 + cc * 2; return st * 1024 + (ob ^ (((ob >> 9) & 1) << 5)); }
__host__ __device__ __forceinline__ void stage_rc(int b, int& R, int& C) { const int st = b / 1024, sb = b % 1024, swz = sb ^ (((sb >> 9) & 1) << 5); R = (st >> 1) * 16 + swz / 64; C = (st & 1) * 32 + (swz % 64) / 2; }
__host__ __device__ __forceinline__ int perm32(int rho) { const int n = rho >> 4, i = rho & 15; return 8 * (i >> 2) + 4 * n + (i & 3); }

struct Unit { int pm, pn, e, pl; };
struct Gemm { const bf16_t* A; const bf16_t* Bt; int M, N, K; };

struct StaticOrder {
    int nM, nN, nwg, G, c;
    __host__ __device__ void init(int M, int N, int G_, int c_) { nM = M / BM; nN = N / BM; nwg = nM * nN; G = G_; c = c_; }
    __host__ __device__ bool next(int i, Unit& u) const {
        const long L = (long)i * G + c; if (L >= nwg) return false;
        int wgid = (int)L; { const int q = nwg / NXCD, r = nwg % NXCD, xcd = wgid % NXCD, off = wgid / NXCD; wgid = (xcd < r ? xcd * (q + 1) : r * (q + 1) + (xcd - r) * q) + off; }
        const int nig = WGM * nN, gid = wgid / nig, fm = gid * WGM, gsz = (nM - fm) < WGM ? (nM - fm) : WGM;
        u.pm = fm + ((wgid % nig) % gsz); u.pn = (wgid % nig) / gsz; u.e = 0; u.pl = u.pn; return true;
    }
    __device__ __forceinline__ void a_ready(const Unit&) const {}
    __device__ __forceinline__ void done(const Unit&) const {}
};

__device__ __forceinline__ unsigned cvt_pk_bf16(float lo, float hi) { unsigned r; asm volatile("v_cvt_pk_bf16_f32 %0, %1, %2" : "=v"(r) : "v"(lo), "v"(hi)); return r; }

struct EpiBf16Plain {
    static constexpr bool PERM = true, AFTER_DRAIN = false;
    bf16_t* O; int ldc; float sc;
    __device__ __forceinline__ void operator()(const f32x4 (&acc)[2][2][4][2], const Unit& u, int wr, int wc, int fr, int fq) const {
        const int row0 = u.pm * BM + wr * 64 + fr; const int col0 = u.pn * BM + wc * 32 + 8 * fq;
#pragma unroll
        for (int ai = 0; ai < 2; ++ai)
#pragma unroll
            for (int m = 0; m < 4; ++m) { bf16_t* rowp = O + (size_t)(row0 + ai * HALF + m * 16) * ldc + col0;
#pragma unroll
                for (int bj = 0; bj < 2; ++bj) { const f32x4 v0 = acc[ai][bj][m][0] * sc, v1 = acc[ai][bj][m][1] * sc;
                    u32x4 w; w.x = cvt_pk_bf16(v0[0], v0[1]); w.y = cvt_pk_bf16(v0[2], v0[3]); w.z = cvt_pk_bf16(v1[0], v1[1]); w.w = cvt_pk_bf16(v1[2], v1[3]);
                    *(u32x4*)(rowp + bj * HALF) = w; } }
    }
};
struct EpiResGate {
    static constexpr bool PERM = false, AFTER_DRAIN = false;
    const float* base; float* out; int ldc; const float* gate; int gpitch; int rows_per_batch; float sc;
    __device__ __forceinline__ void operator()(const f32x4 (&acc)[2][2][4][2], const Unit& u, int wr, int wc, int fr, int fq) const {
        const int row0 = u.pm * BM + wr * 64 + fr, col0 = u.pn * BM + wc * 32 + 4 * fq;
        const float* gp = gate + (size_t)((u.pm * BM) / rows_per_batch) * gpitch + col0;
        f32x4 gv[2][2];
#pragma unroll
        for (int bj = 0; bj < 2; ++bj)
#pragma unroll
            for (int n = 0; n < 2; ++n) gv[bj][n] = *(const f32x4*)(gp + bj * HALF + n * 16) * sc;
#pragma unroll
        for (int ai = 0; ai < 2; ++ai)
#pragma unroll
            for (int m = 0; m < 4; ++m) { const size_t off = (size_t)(row0 + ai * HALF + m * 16) * ldc + col0;
#pragma unroll
                for (int bj = 0; bj < 2; ++bj)
#pragma unroll
                    for (int n = 0; n < 2; ++n) { const f32x4 bs = *(const f32x4*)(base + off + bj * HALF + n * 16);
                        *(f32x4*)(out + off + bj * HALF + n * 16) = bs + gv[bj][n] * acc[ai][bj][m][n]; }
                asm volatile("" ::: "memory"); }
    }
};
struct EpiSwiglu {
    static constexpr bool PERM = true, AFTER_DRAIN = false;
    unsigned char* O; int ldc; const float* bias; float inv_in, out_scale;
    __device__ __forceinline__ float act1(float g, float up) const {
        g = fminf(g, 7.0f); up = fminf(fmaxf(up, -7.0f), 7.0f);
        const float s = 1.0f / (1.0f + __expf(-1.702f * g));
        return fminf(fmaxf((up + 1.0f) * g * s * out_scale, -448.f), 448.f);
    }
    __device__ __forceinline__ void operator()(const f32x4 (&acc)[2][2][4][2], const Unit& u, int wr, int wc, int fr, int fq) const {
        const int row0 = u.pm * BM + wr * 64 + fr; const int jj0 = wc * 32 + 8 * fq; const int col0 = u.pl * HALF + jj0;
        const float* bp = bias + (size_t)u.e * 2048 + col0;
        f32x4 bg[2], bu[2];
#pragma unroll
        for (int n = 0; n < 2; ++n) { bg[n] = *(const f32x4*)(bp + 4 * n); bu[n] = *(const f32x4*)(bp + 1024 + 4 * n); }
#pragma unroll
        for (int ai = 0; ai < 2; ++ai)
#pragma unroll
            for (int m = 0; m < 4; ++m) { unsigned char* rowp = O + (size_t)(row0 + ai * HALF + m * 16) * ldc + col0;
                f32x4 r[2];
#pragma unroll
                for (int n = 0; n < 2; ++n) { const f32x4 g = acc[ai][0][m][n] * inv_in + bg[n], up = acc[ai][1][m][n] * inv_in + bu[n];
#pragma unroll
                    for (int j = 0; j < 4; ++j) r[n][j] = act1(g[j], up[j]); }
                int w0 = 0, w1 = 0;
                w0 = __builtin_amdgcn_cvt_pk_fp8_f32(r[0][0], r[0][1], w0, false); w0 = __builtin_amdgcn_cvt_pk_fp8_f32(r[0][2], r[0][3], w0, true);
                w1 = __builtin_amdgcn_cvt_pk_fp8_f32(r[1][0], r[1][1], w1, false); w1 = __builtin_amdgcn_cvt_pk_fp8_f32(r[1][2], r[1][3], w1, true);
                typedef int i32x2 __attribute__((ext_vector_type(2))); *(i32x2*)rowp = (i32x2){w0, w1}; }
    }
};
struct EpiBf16Bias {
    static constexpr bool PERM = true, AFTER_DRAIN = false;
    bf16_t* O; int ldc; const float* bias; int bpitch; float inv_in;
    __device__ __forceinline__ void operator()(const f32x4 (&acc)[2][2][4][2], const Unit& u, int wr, int wc, int fr, int fq) const {
        const int row0 = u.pm * BM + wr * 64 + fr; const int col0 = u.pl * BM + wc * 32 + 8 * fq;
        const float* bp = bias + (size_t)u.e * bpitch + col0;
        f32x4 bv[2][2];
#pragma unroll
        for (int bj = 0; bj < 2; ++bj)
#pragma unroll
            for (int n = 0; n < 2; ++n) bv[bj][n] = *(const f32x4*)(bp + bj * HALF + 4 * n);
#pragma unroll
        for (int ai = 0; ai < 2; ++ai)
#pragma unroll
            for (int m = 0; m < 4; ++m) { bf16_t* rowp = O + (size_t)(row0 + ai * HALF + m * 16) * ldc + col0;
#pragma unroll
                for (int bj = 0; bj < 2; ++bj) { const f32x4 v0 = acc[ai][bj][m][0] * inv_in + bv[bj][0], v1 = acc[ai][bj][m][1] * inv_in + bv[bj][1];
                    u32x4 w; w.x = cvt_pk_bf16(v0[0], v0[1]); w.y = cvt_pk_bf16(v0[2], v0[3]); w.z = cvt_pk_bf16(v1[0], v1[1]); w.w = cvt_pk_bf16(v1[2], v1[3]);
                    *(u32x4*)(rowp + bj * HALF) = w; } }
    }
};
struct EpiFp8Bias {
    static constexpr bool PERM = true, AFTER_DRAIN = false;
    unsigned char* O; int ldc; const float* bias; int bpitch; float inv_in, out_scale;
    __device__ __forceinline__ int pk4(f32x4 v) const { int w = 0; w = __builtin_amdgcn_cvt_pk_fp8_f32(fminf(fmaxf(v[0], -448.f), 448.f), fminf(fmaxf(v[1], -448.f), 448.f), w, false);
        return __builtin_amdgcn_cvt_pk_fp8_f32(fminf(fmaxf(v[2], -448.f), 448.f), fminf(fmaxf(v[3], -448.f), 448.f), w, true); }
    __device__ __forceinline__ void operator()(const f32x4 (&acc)[2][2][4][2], const Unit& u, int wr, int wc, int fr, int fq) const {
        const int row0 = u.pm * BM + wr * 64 + fr; const int col0 = u.pl * BM + wc * 32 + 8 * fq;
        const float* bp = bias + (size_t)u.e * bpitch + col0;
        f32x4 bv[2][2];
#pragma unroll
        for (int bj = 0; bj < 2; ++bj)
#pragma unroll
            for (int n = 0; n < 2; ++n) bv[bj][n] = *(const f32x4*)(bp + bj * HALF + 4 * n);
#pragma unroll
        for (int ai = 0; ai < 2; ++ai)
#pragma unroll
            for (int m = 0; m < 4; ++m) { unsigned char* rowp = O + (size_t)(row0 + ai * HALF + m * 16) * ldc + col0;
#pragma unroll
                for (int bj = 0; bj < 2; ++bj) { const f32x4 v0 = (acc[ai][bj][m][0] * inv_in + bv[bj][0]) * out_scale, v1 = (acc[ai][bj][m][1] * inv_in + bv[bj][1]) * out_scale;
                    typedef int i32x2 __attribute__((ext_vector_type(2))); *(i32x2*)(rowp + bj * HALF) = (i32x2){pk4(v0), pk4(v1)}; } }
    }
};
struct MoeOrder {
    int nN, G, c, nunits; const PG8_LAS int* tile_pm;
    __device__ __forceinline__ bool next(int i, Unit& u) const {
        const int L = i * G + c; if (L >= nunits) return false;
        const int idx = L / nN, pl = L - idx * nN, pm = __builtin_amdgcn_readfirstlane(tile_pm[idx]), e = pm >> 6;
        u.pm = pm; u.pl = pl; u.e = e; u.pn = e * nN + pl; return true;
    }
    __device__ __forceinline__ void a_ready(const Unit&) const {}
    __device__ __forceinline__ void done(const Unit&) const {}
};
typedef int v4i32_t __attribute__((ext_vector_type(4)));
typedef int v8i32_t __attribute__((ext_vector_type(8)));
template <class Epi, class Sched, bool ALIGN_EPI = false, bool SP2 = false, bool FP8 = false>
__device__ __forceinline__ void gemm_phase(PG8_LAS unsigned char* lds, const Gemm g, const Sched& S, const Epi& E, int tid_in) {
    int tid_ = tid_in; asm volatile("" : "+v"(tid_)); const int tid = tid_, wid = __builtin_amdgcn_readfirstlane(tid >> 6), lane = tid & 63, wr = wid >> 2, wc = wid & 3, fr = lane & 15, fq = lane >> 4;
    const int K = g.K, nt = K / BK;
    unsigned voffA, voffB;
    { int R, C; stage_rc(tid * 16, R, C); const int Rb = Epi::PERM ? ((R & ~31) + perm32(R & 31)) : R;
        voffA = (unsigned)(R * K + C) * 2u; voffB = (unsigned)(Rb * K + C) * 2u; }
    const size_t rstep = (size_t)64 * K * 2;
    const size_t kstep = (size_t)(BK * 2);
    const size_t hstep = (size_t)HALF * K * 2;
    const size_t tstep = 2 * hstep;
    const unsigned ldsw = (unsigned)wid * 1024u;
    const int aoff = lds_byte(wr * 64 + fr, fq * 8), boff = lds_byte(wc * 32 + fr, fq * 8);
#define PG8_SA(b, h) (((b) * 2 + (h)) * HTB)
#define PG8_SB(b, h) ((4 + (b) * 2 + (h)) * HTB)
#define PG8_STAGE(bufoff, gbase, voff) do { _Pragma("unroll") for (int _i = 0; _i < 2; ++_i) \
        __builtin_amdgcn_global_load_lds((const unsigned*)((const char*)(gbase) + _i * rstep + (voff)), (PG8_LAS unsigned*)(lds + (bufoff) + ldsw + _i * 8192), 16, 0, 0); } while (0)
#define PG8_LDA(dst, b, h) do { _Pragma("unroll") for (int m = 0; m < 4; ++m) _Pragma("unroll") for (int k = 0; k < 2; ++k) dst[m][k] = *(const PG8_LAS bf16x8*)(lds + PG8_SA(b, h) + aoff + m * 2048 + k * 1024); } while (0)
#define PG8_LDB(dst, b, h) do { _Pragma("unroll") for (int n = 0; n < 2; ++n) _Pragma("unroll") for (int k = 0; k < 2; ++k) dst[n][k] = *(const PG8_LAS bf16x8*)(lds + PG8_SB(b, h) + boff + n * 2048 + k * 1024); } while (0)
#define PG8_MMA(ai, bj, At, Bt) do { __builtin_amdgcn_s_setprio(1); _Pragma("unroll") for (int m = 0; m < 4; ++m) _Pragma("unroll") for (int n = 0; n < 2; ++n) { \
        if constexpr (FP8) { const v8i32_t a8_ = __builtin_shufflevector(__builtin_bit_cast(v4i32_t, At[m][0]), __builtin_bit_cast(v4i32_t, At[m][1]), 0, 1, 2, 3, 4, 5, 6, 7); \
            const v8i32_t b8_ = __builtin_shufflevector(__builtin_bit_cast(v4i32_t, Bt[n][0]), __builtin_bit_cast(v4i32_t, Bt[n][1]), 0, 1, 2, 3, 4, 5, 6, 7); \
            asm volatile("v_mfma_scale_f32_16x16x128_f8f6f4 %0, %1, %2, %0, %3, %3 op_sel_hi:[0,0,0]" : "+v"(acc[ai][bj][m][n]) : "v"(b8_), "v"(a8_), "v"(one8_)); } \
        else { _Pragma("unroll") for (int k = 0; k < 2; ++k) acc[ai][bj][m][n] = __builtin_amdgcn_mfma_f32_16x16x32_bf16(Bt[n][k], At[m][k], acc[ai][bj][m][n], 0, 0, 0); } } \
        __builtin_amdgcn_s_setprio(0); } while (0)
#define PG8_WAIT_V(n) asm volatile("s_waitcnt vmcnt(" #n ")" ::: "memory")
#define PG8_WAIT_L(n) asm volatile("s_waitcnt lgkmcnt(" #n ")" ::: "memory")
#define PG8_BAR __builtin_amdgcn_s_barrier()
#define PG8_SCHED __builtin_amdgcn_sched_barrier(0)
    Unit cur, nxt; int ui = 0;
    if (!S.next(0, cur)) return;
    f32x4 acc[2][2][4][2];
#pragma unroll
    for (int a = 0; a < 2; ++a)
#pragma unroll
        for (int b = 0; b < 2; ++b)
#pragma unroll
            for (int m = 0; m < 4; ++m)
#pragma unroll
                for (int n = 0; n < 2; ++n) acc[a][b][m][n] = (f32x4){0.f, 0.f, 0.f, 0.f};
    bf16x8 At[4][2], B0[2][2], B1[2][2];
    int one8_ = 0x7f7f7f7f; asm volatile("" : "+v"(one8_));
    const char* cA = (const char*)g.A + (size_t)cur.pm * tstep; const char* cB = (const char*)g.Bt + (size_t)cur.pn * tstep;
    S.a_ready(cur);
    if constexpr (SP2) {
        PG8_STAGE(PG8_SB(0, 0), cB, voffB); PG8_STAGE(PG8_SB(0, 1), cB + hstep, voffB); PG8_STAGE(PG8_SA(0, 0), cA, voffA); PG8_STAGE(PG8_SA(0, 1), cA + hstep, voffA);
        if (wr == 1) PG8_BAR;
        PG8_WAIT_V(2); PG8_BAR;
        PG8_STAGE(PG8_SB(1, 0), cB + kstep, voffB); PG8_STAGE(PG8_SA(1, 0), cA + kstep, voffA); PG8_STAGE(PG8_SB(1, 1), cB + hstep + kstep, voffB);
        PG8_WAIT_V(6); PG8_BAR;
    } else {
        PG8_STAGE(PG8_SB(0, 0), cB, voffB); PG8_STAGE(PG8_SA(0, 0), cA, voffA); PG8_STAGE(PG8_SB(0, 1), cB + hstep, voffB); PG8_STAGE(PG8_SA(0, 1), cA + hstep, voffA);
        if (wr == 1) PG8_BAR;
        PG8_WAIT_V(4); PG8_BAR;
        PG8_STAGE(PG8_SB(1, 0), cB + kstep, voffB); PG8_STAGE(PG8_SA(1, 0), cA + kstep, voffA); PG8_STAGE(PG8_SB(1, 1), cB + hstep + kstep, voffB);
        PG8_WAIT_V(6); PG8_BAR;
    }
    for (;;) {
        const bool has_next = S.next(ui + 1, nxt);
        const char* nA = has_next ? (const char*)g.A + (size_t)nxt.pm * tstep : cA; const char* nB = has_next ? (const char*)g.Bt + (size_t)nxt.pn * tstep : cB;
#pragma unroll 1
        for (int t = 0; t < nt; t += 2) {
            const bool last = (t == nt - 2);
            const char* a1 = cA + (size_t)(t + 1) * kstep;
            const char* a2 = last ? nA : cA + (size_t)(t + 2) * kstep; const char* b2 = last ? nB : cB + (size_t)(t + 2) * kstep;
            const char* a3 = a2 + kstep; const char* b3 = b2 + kstep;
            if (last && has_next) S.a_ready(nxt);
            if constexpr (SP2) {
            PG8_LDB(B0, 0, 0); PG8_LDB(B1, 0, 1); PG8_SCHED; PG8_LDA(At, 0, 0); PG8_STAGE(PG8_SA(1, 1), a1 + hstep, voffA);
            PG8_WAIT_V(8); PG8_WAIT_L(0); PG8_BAR; PG8_MMA(0, 0, At, B0); PG8_MMA(0, 1, At, B1); PG8_BAR; PG8_SCHED;
            PG8_LDA(At, 0, 1); PG8_STAGE(PG8_SB(0, 0), b2, voffB); PG8_STAGE(PG8_SB(0, 1), b2 + hstep, voffB); PG8_STAGE(PG8_SA(0, 0), a2, voffA);
            PG8_WAIT_V(8); PG8_WAIT_L(0); PG8_BAR; PG8_MMA(1, 0, At, B0); PG8_MMA(1, 1, At, B1); PG8_BAR; PG8_SCHED;
            PG8_LDB(B0, 1, 0); PG8_LDB(B1, 1, 1); PG8_SCHED; PG8_LDA(At, 1, 0); PG8_STAGE(PG8_SA(0, 1), a2 + hstep, voffA);
            PG8_WAIT_V(8); PG8_WAIT_L(0); PG8_BAR; PG8_MMA(0, 0, At, B0); PG8_MMA(0, 1, At, B1); PG8_BAR; PG8_SCHED;
            PG8_LDA(At, 1, 1); PG8_STAGE(PG8_SB(1, 0), b3, voffB); PG8_STAGE(PG8_SB(1, 1), b3 + hstep, voffB); PG8_STAGE(PG8_SA(1, 0), a3, voffA);
            PG8_WAIT_V(8); PG8_WAIT_L(0); PG8_BAR; PG8_MMA(1, 0, At, B0); PG8_MMA(1, 1, At, B1); PG8_BAR; PG8_SCHED;
            } else {
            PG8_LDB(B0, 0, 0); PG8_SCHED; PG8_LDA(At, 0, 0); PG8_STAGE(PG8_SA(1, 1), a1 + hstep, voffA);
            PG8_WAIT_L(8); PG8_BAR; PG8_WAIT_L(0); PG8_MMA(0, 0, At, B0); PG8_BAR; PG8_SCHED;
            PG8_LDB(B1, 0, 1); PG8_STAGE(PG8_SB(0, 0), b2, voffB);
            PG8_BAR; PG8_WAIT_L(0); PG8_MMA(0, 1, At, B1); PG8_BAR;
            PG8_LDA(At, 0, 1); PG8_STAGE(PG8_SA(0, 0), a2, voffA);
            PG8_BAR; PG8_WAIT_L(0); PG8_MMA(1, 0, At, B0); PG8_BAR; PG8_SCHED;
            PG8_STAGE(PG8_SB(0, 1), b2 + hstep, voffB);
            PG8_WAIT_V(6); PG8_BAR; PG8_MMA(1, 1, At, B1); PG8_BAR;
            PG8_LDB(B0, 1, 0); PG8_SCHED; PG8_LDA(At, 1, 0); PG8_STAGE(PG8_SA(0, 1), a2 + hstep, voffA);
            PG8_WAIT_L(8); PG8_BAR; PG8_WAIT_L(0); PG8_MMA(0, 0, At, B0); PG8_BAR; PG8_SCHED;
            PG8_LDB(B1, 1, 1); PG8_STAGE(PG8_SB(1, 0), b3, voffB);
            PG8_BAR; PG8_WAIT_L(0); PG8_MMA(0, 1, At, B1); PG8_BAR;
            PG8_LDA(At, 1, 1); PG8_STAGE(PG8_SA(1, 0), a3, voffA);
            PG8_BAR; PG8_WAIT_L(0); PG8_MMA(1, 0, At, B0); PG8_BAR; PG8_SCHED;
            PG8_STAGE(PG8_SB(1, 1), b3 + hstep, voffB);
            PG8_WAIT_V(6); PG8_BAR; PG8_MMA(1, 1, At, B1); PG8_BAR;
            }
        }
        if constexpr (FP8) asm volatile("s_nop 7\n\ts_nop 7" ::: "memory");
        if constexpr (ALIGN_EPI) { if (wr == 0) PG8_BAR; }
        if constexpr (!Epi::AFTER_DRAIN) { int ln_ = (int)__builtin_amdgcn_mbcnt_hi(~0u, __builtin_amdgcn_mbcnt_lo(~0u, 0u)); asm volatile("" : "+v"(ln_)); E(acc, cur, wr, wc, ln_ & 15, ln_ >> 4); S.done(cur); }
        if (!has_next) break;
#pragma unroll
        for (int a = 0; a < 2; ++a)
#pragma unroll
            for (int b = 0; b < 2; ++b)
#pragma unroll
                for (int m = 0; m < 4; ++m)
#pragma unroll
                    for (int n = 0; n < 2; ++n) acc[a][b][m][n] = (f32x4){0.f, 0.f, 0.f, 0.f};
        cur = nxt; cA = nA; cB = nB; ++ui;
        if constexpr (ALIGN_EPI) { if (wr == 1) PG8_BAR; }
    }
    PG8_WAIT_V(0);
    if constexpr (!ALIGN_EPI) { if (wr == 0) PG8_BAR; }
    PG8_BAR;
    if constexpr (Epi::AFTER_DRAIN) { E.fused(acc, cur, wr, wc, fr, fq, lds, wid, lane); S.done(cur); }
#undef PG8_SA
#undef PG8_SB
#undef PG8_STAGE
#undef PG8_LDA
#undef PG8_LDB
#undef PG8_MMA
#undef PG8_WAIT_V
#undef PG8_WAIT_L
#undef PG8_BAR
#undef PG8_SCHED
}
}

constexpr int NWAVES = 8, NTHR = 512;
constexpr int BATCH = 2, SEQ = 8192, D = 1024, DEPTH = 4, MTOK = BATCH * SEQ;
constexpr int DIN = 3344, NPROJ = 3328, SRC_GA = 1152;
constexpr int C_GQ = 0, C_GK = 192, C_GV = 384, C_GG = 768, C_HQ = 1152, C_HF = 1408, C_HI = 1664, C_HG = 1920, C_RQ = 2176, C_RK = 2368, C_RV = 2560, C_RG = 2944;
constexpr int NE = 32, FFN = 1024;
constexpr int CH = 64, NCH = SEQ / CH, NUNIT = BATCH * NCH;
constexpr int ST_GLA = 0, ST_HG = 4 * 48 * 96, ST_RET = ST_HG + 4 * 64 * 64, ST_TOT = ST_RET + 4 * 48 * 96;
constexpr int NDV = 448;
constexpr int MAXROWS = 65536 + NE * 256, MAXRT = MAXROWS / 256;
constexpr float EPS = 1e-6f;
#ifndef F8_IN_V
#define F8_IN_V false
#endif
#ifndef F8_OUT_V
#define F8_OUT_V false
#endif
constexpr bool F8_IN = F8_IN_V, F8_OUT = F8_OUT_V;
#ifndef Y8_V
#define Y8_V true
#endif
constexpr bool Y8 = Y8_V;
constexpr float S8_Y = 16.f;
constexpr float S8_M = 32.f;
constexpr float S8_W = 2048.f, S8_H = 64.f, S8_A = 8.f;
constexpr int NPHASE = 38;
constexpr int ECAP = 16384, ECAP_SH = 14;

constexpr size_t MiB = 1u << 20;
constexpr size_t WS_CTL = 0, CTL_ZERO_BYTES = 65536;
constexpr size_t WS_MOD = 1 * MiB;
constexpr size_t WS_ROPE = 2 * MiB;
constexpr size_t WS_LB = 5 * MiB;
constexpr size_t WS_WIN = 8 * MiB;
constexpr size_t WS_WOUT = 34 * MiB;
constexpr size_t WS_WGU = 42 * MiB;
constexpr size_t WS_WDN = 554 * MiB;
constexpr size_t WS_X = 810 * MiB;
constexpr size_t WS_H = 874 * MiB;
constexpr size_t WS_GA = 906 * MiB;
constexpr size_t WS_PROJ = 907 * MiB;
constexpr size_t WS_U = 1011 * MiB;
constexpr size_t WS_DVEC = 1063 * MiB;
constexpr size_t WS_SP = 1064 * MiB;
constexpr size_t WS_MIX = 1090 * MiB;
constexpr size_t WS_TOPE = 1122 * MiB;
constexpr size_t WS_TOPW = WS_TOPE + 256 * 1024;
constexpr size_t WS_SLOT = WS_TOPW + 256 * 1024;
constexpr size_t WS_A1 = 1123 * MiB;
constexpr size_t WS_ACT = 1635 * MiB;
constexpr size_t WS_Y = 2147 * MiB;
constexpr size_t WS_CUM = 3171 * MiB;
constexpr size_t WS_END = 3199 * MiB;
static_assert(WS_WIN + (size_t)DEPTH * NPROJ * D * 2 <= WS_WOUT && WS_PROJ + (size_t)MTOK * NPROJ * 2 <= WS_U && WS_U + (size_t)NUNIT * ST_TOT * 4 <= WS_DVEC && WS_SP + (size_t)NUNIT * ST_TOT * 2 <= WS_MIX && WS_A1 + (size_t)NE * ECAP * D <= WS_ACT && WS_ACT + (size_t)NE * ECAP * D <= WS_Y && WS_Y + (size_t)NE * ECAP * D * 2 <= WS_CUM, "ws map");
constexpr int CW_TMO = 0, CW_CODE = 1, CW_BAR = 4096, CW_CNT = 8192, CW_FILL = 8192 + 256;
constexpr int RING_BYTES = 131072;
constexpr int MISC_OFF = 147456, LDS_BYTES = MISC_OFF + 4096;
constexpr int MW_BAR = 0, MW_CNT = 16, MW_PST = 48, MW_HIST = 96, MW_BASE = 128, MW_TILE = 192, MW_NRT = 480, MW_SLOTS = 512;

#define GAS __attribute__((address_space(1)))
#define LAS __attribute__((address_space(3)))
typedef unsigned v4u __attribute__((ext_vector_type(4)));
typedef float f32x4 __attribute__((ext_vector_type(4)));
typedef short bf16x8 __attribute__((ext_vector_type(8)));
typedef GAS unsigned gu32;
typedef GAS unsigned long long gu64;
#define RLX_AGENT __ATOMIC_RELAXED, __HIP_MEMORY_SCOPE_AGENT
#define LDS_WAIT() asm volatile("s_waitcnt lgkmcnt(0)" ::: "memory")
#define VM_WAIT() asm volatile("s_waitcnt vmcnt(0)" ::: "memory")
__device__ __forceinline__ unsigned long long rt() { return __builtin_amdgcn_s_memrealtime(); }
typedef unsigned short bf16;
__device__ __forceinline__ unsigned f2bf(float f) { unsigned u = __builtin_bit_cast(unsigned, f); return (u + 0x7fffu + ((u >> 16) & 1u)) >> 16; }
__device__ __forceinline__ unsigned pk2(float lo, float hi) { return f2bf(lo) | (f2bf(hi) << 16); }
__device__ __forceinline__ float bf2f(bf16 b) { return __builtin_bit_cast(float, (unsigned)b << 16); }
#define XB_TMO      128
#define XB_XCNT(j)  (256  + 64 * (j))
#define XB_XSUB(j)  (1280 + 64 * (j))
#define XB_XGEN(j)  (2304 + 64 * (j))
#define XB_TOP      3328
#define XB_TOPGEN   3392
#define XCD_BAR_WORDS 3456
#define XB_SPIN_CAP (1u << 18)

__device__ __forceinline__ unsigned xb_ld(unsigned* p)              { return __hip_atomic_load(p, __ATOMIC_RELAXED, __HIP_MEMORY_SCOPE_AGENT); }
__device__ __forceinline__ unsigned xb_add(unsigned* p, unsigned v) { return __hip_atomic_fetch_add(p, v, __ATOMIC_RELAXED, __HIP_MEMORY_SCOPE_AGENT); }
__device__ __forceinline__ unsigned xb_xcc_id() { return (unsigned)__builtin_amdgcn_s_getreg((3 << 11) | 20) & 0xFu; }
#define XB_SPIN(cond, bar) do { unsigned _sp = 0; while (cond) { __builtin_amdgcn_s_sleep(1); \
    if ((++_sp & 255u) == 0u) { if (xb_ld(&(bar)[XB_TMO])) break; if (_sp > XB_SPIN_CAP) { atomicAdd(&(bar)[XB_TMO], 1u); break; } } } } while (0)

struct XcdBarrier {
    unsigned* bar; unsigned x;
    volatile LAS unsigned* st;
};

__device__ __forceinline__ XcdBarrier xcd_barrier_post(unsigned* bar, volatile LAS unsigned* st) {
    XcdBarrier b; b.bar = bar; b.x = xb_xcc_id(); b.st = st;
    if (threadIdx.x == 0) (void)xb_add(&bar[XB_XCNT(b.x)], 1u);
    return b;
}
__device__ __forceinline__ void xcd_barrier_complete(unsigned* bar, unsigned x, unsigned& nloc, unsigned& nx) {
    const unsigned G = gridDim.x * gridDim.y * gridDim.z;
    unsigned sum, cnt, mine, sp = 0u;
    for (;;) {
        sum = 0u; cnt = 0u; mine = 0u;
#pragma unroll
        for (unsigned j = 0; j < 16; ++j) { const unsigned c = xb_ld(&bar[XB_XCNT(j)]); sum += c; cnt += (c > 0u) ? 1u : 0u; mine = (j == x) ? c : mine; }
        if (sum == G) break;
        __builtin_amdgcn_s_sleep(1);
        if ((++sp & 255u) == 0u) { if (xb_ld(&bar[XB_TMO])) break; if (sp > XB_SPIN_CAP) { atomicAdd(&bar[XB_TMO], 1u); break; } }
    }
    nloc = mine > 0u ? mine : 1u; nx = cnt > 0u ? cnt : 1u;
}

__device__ __forceinline__ void xcd_barrier(const XcdBarrier& b) {
    asm volatile("s_waitcnt vmcnt(0)" ::: "memory");
    __syncthreads();
    if (threadIdx.x == 0) {
        unsigned* bar = b.bar;
        __builtin_amdgcn_s_waitcnt(0);
        unsigned nloc = b.st[0], nx = b.st[1];
        if (nloc == 0u) { xcd_barrier_complete(bar, b.x, nloc, nx); b.st[0] = nloc; b.st[1] = nx; }
        const unsigned old = xb_add(&bar[XB_XSUB(b.x)], 1u);
        const unsigned gen = old / nloc;
        if (old + 1u == (gen + 1u) * nloc) {
            __builtin_amdgcn_fence(__ATOMIC_RELEASE, "agent");
            asm volatile("s_waitcnt vmcnt(0)" ::: "memory");
            const unsigned og = xb_add(&bar[XB_TOP], 1u);
            const unsigned tg = og / nx;
            if (og + 1u == (tg + 1u) * nx) xb_add(&bar[XB_TOPGEN], 1u);
            else XB_SPIN(xb_ld(&bar[XB_TOPGEN]) == tg, bar);
            __builtin_amdgcn_fence(__ATOMIC_ACQUIRE, "agent");
            xb_add(&bar[XB_XGEN(b.x)], 1u);
            asm volatile("s_waitcnt vmcnt(0)" ::: "memory");
        } else {
            XB_SPIN(xb_ld(&bar[XB_XGEN(b.x)]) == gen, bar);
            __builtin_amdgcn_fence(__ATOMIC_ACQUIRE, "agent");
            asm volatile("s_waitcnt vmcnt(0)" ::: "memory");
        }
    }
    __syncthreads();
}

__device__ __forceinline__ float wave_sum(float v) {
#pragma unroll
    for (int o = 1; o < 64; o <<= 1) v += __shfl_xor(v, o);
    return v;
}
__device__ __forceinline__ float log_sigmoid_f(float x) { return fminf(x, 0.f) - log1pf(expf(-fabsf(x))); }
__device__ __forceinline__ float silu_f(float x) { return x / (1.0f + expf(-x)); }
__device__ __forceinline__ float sigmoid_f(float x) { return 1.0f / (1.0f + expf(-x)); }
__device__ __forceinline__ pg8::bf16x8 ldfrag(const LAS bf16* base, int stride, int r0, int k0, int lane) {
    return *(const LAS pg8::bf16x8*)(base + (r0 + (lane & 15)) * stride + k0 + 8 * (lane >> 4));
}
__device__ __forceinline__ pg8::bf16x8 pack8(const float (&v)[8]) { v4u w; w.x = pk2(v[0], v[1]); w.y = pk2(v[2], v[3]); w.z = pk2(v[4], v[5]); w.w = pk2(v[6], v[7]); return __builtin_bit_cast(pg8::bf16x8, w); }

struct Args {
    const float* x; const float* c; const int* pos; const float* w_mod; const float* b_mod; const float* norm1_w; const float* w_in; const float* gla_wa2; const float* gla_ba2; const float* hg_lb;
    const float* gla_norm_w; const float* hg_norm_w; const float* w_out; const float* norm2_w; const float* w_r; const float* b_r; const float* w_gu; const float* b_gu; const float* w_dn; const float* b_dn;
    const float* final_norm_w; float* out; unsigned char* ws; int ph_lo, ph_hi;
};

__device__ __forceinline__ void transpose_block64(const float* src, int ld, bf16* dst, LAS float* scr, int lane) {
    const int r = lane >> 4, c4 = (lane & 15) * 4;
    f32x4 v[16];
#pragma unroll
    for (int i = 0; i < 16; ++i) v[i] = __builtin_nontemporal_load((const f32x4*)(src + (size_t)(4 * i + r) * ld + c4));
#pragma unroll
    for (int i = 0; i < 16; ++i) { LAS float* w = scr + (4 * i + r) * 65 + c4; w[0] = v[i][0]; w[1] = v[i][1]; w[2] = v[i][2]; w[3] = v[i][3]; }
    LDS_WAIT(); asm volatile("" ::: "memory");
    const int kc = lane & 7;
#pragma unroll
    for (int jj = 0; jj < 8; ++jj) { const int n = (lane >> 3) + 8 * jj; const LAS float* s = scr + (8 * kc) * 65 + n;
        v4u o; o.x = pk2(s[0 * 65], s[1 * 65]); o.y = pk2(s[2 * 65], s[3 * 65]); o.z = pk2(s[4 * 65], s[5 * 65]); o.w = pk2(s[6 * 65], s[7 * 65]);
        *(GAS v4u*)(dst + (size_t)n * D + 8 * kc) = o; }
    LDS_WAIT(); asm volatile("" ::: "memory");
}
__device__ __forceinline__ int pk4_fp8(float a, float b, float c, float d) { int w = 0; w = __builtin_amdgcn_cvt_pk_fp8_f32(fminf(fmaxf(a, -448.f), 448.f), fminf(fmaxf(b, -448.f), 448.f), w, false);
    return __builtin_amdgcn_cvt_pk_fp8_f32(fminf(fmaxf(c, -448.f), 448.f), fminf(fmaxf(d, -448.f), 448.f), w, true); }
__device__ __forceinline__ void transpose_block64_fp8(const float* src, int ld, unsigned char* dst, LAS float* scr, int lane, float sc) {
    const int r = lane >> 4, c4 = (lane & 15) * 4;
    f32x4 v[16];
#pragma unroll
    for (int i = 0; i < 16; ++i) v[i] = __builtin_nontemporal_load((const f32x4*)(src + (size_t)(4 * i + r) * ld + c4));
#pragma unroll
    for (int i = 0; i < 16; ++i) { LAS float* w = scr + (4 * i + r) * 65 + c4; w[0] = v[i][0] * sc; w[1] = v[i][1] * sc; w[2] = v[i][2] * sc; w[3] = v[i][3] * sc; }
    LDS_WAIT(); asm volatile("" ::: "memory");
    const int kc = lane & 3;
#pragma unroll
    for (int jj = 0; jj < 4; ++jj) { const int n = (lane >> 2) + 16 * jj; const LAS float* s = scr + (16 * kc) * 65 + n;
        v4u o; o.x = (unsigned)pk4_fp8(s[0 * 65], s[1 * 65], s[2 * 65], s[3 * 65]); o.y = (unsigned)pk4_fp8(s[4 * 65], s[5 * 65], s[6 * 65], s[7 * 65]);
        o.z = (unsigned)pk4_fp8(s[8 * 65], s[9 * 65], s[10 * 65], s[11 * 65]); o.w = (unsigned)pk4_fp8(s[12 * 65], s[13 * 65], s[14 * 65], s[15 * 65]);
        *(GAS v4u*)(dst + (size_t)n * D + 16 * kc) = o; }
    LDS_WAIT(); asm volatile("" ::: "memory");
}
constexpr int IT_IN = 16 * (NPROJ / 64), IT_OUT = 16 * 16, IT_GU = NE * 16 * 32, IT_DN = NE * 16 * 16, IT_LAYER = IT_IN + IT_OUT + IT_GU + IT_DN, IT_ALL = DEPTH * IT_LAYER;
__device__ __forceinline__ void p0_prologue(const Args& a, LAS unsigned char* lds, int vcu, int G, int tid, int lane, int wave) {
    unsigned char* ws = a.ws;
    bf16* WIN = (bf16*)(ws + WS_WIN); bf16* WOUT = (bf16*)(ws + WS_WOUT); unsigned char* WGU = ws + WS_WGU; unsigned char* WDN = ws + WS_WDN;
    LAS float* scr = (LAS float*)(lds + wave * 16640);
    const int gw = vcu * NWAVES + wave, NGW = G * NWAVES;
    for (int it = gw; it < IT_ALL; it += NGW) {
        const int l = it / IT_LAYER; int r = it - l * IT_LAYER;
        if (r < IT_IN) { const int kb = r / (NPROJ / 64), nb = r % (NPROJ / 64), n0 = 64 * nb, sc = n0 + (n0 >= SRC_GA ? 16 : 0);
            if (F8_IN) transpose_block64_fp8(a.w_in + ((size_t)l * D + 64 * kb) * DIN + sc, DIN, (unsigned char*)WIN + ((size_t)l * NPROJ + n0) * D + 64 * kb, scr, lane, S8_W);
            else transpose_block64(a.w_in + ((size_t)l * D + 64 * kb) * DIN + sc, DIN, WIN + ((size_t)l * NPROJ + n0) * D + 64 * kb, scr, lane); continue; }
        r -= IT_IN;
        if (r < IT_OUT) { const int kb = r / 16, nb = r % 16;
            if (F8_OUT) transpose_block64_fp8(a.w_out + ((size_t)l * D + 64 * kb) * D + 64 * nb, D, (unsigned char*)WOUT + ((size_t)l * D + 64 * nb) * D + 64 * kb, scr, lane, S8_W);
            else transpose_block64(a.w_out + ((size_t)l * D + 64 * kb) * D + 64 * nb, D, WOUT + ((size_t)l * D + 64 * nb) * D + 64 * kb, scr, lane); continue; }
        r -= IT_OUT;
        if (r < IT_GU) { const int e = r / 512, r2 = r % 512, kb = r2 / 32, nb = r2 % 32, cc = 64 * nb;
            const int row = (cc < 1024) ? 256 * (cc / 128) + (cc % 128) : 256 * ((cc - 1024) / 128) + 128 + ((cc - 1024) % 128);
            transpose_block64_fp8(a.w_gu + (((size_t)l * NE + e) * D + 64 * kb) * 2048 + cc, 2048, WGU + (((size_t)l * NE + e) * 2048 + row) * D + 64 * kb, scr, lane, S8_W); continue; }
        r -= IT_GU;
        { const int e = r / 256, r2 = r % 256, kb = r2 / 16, nb = r2 % 16;
            transpose_block64_fp8(a.w_dn + (((size_t)l * NE + e) * FFN + 64 * kb) * D + 64 * nb, D, WDN + (((size_t)l * NE + e) * D + 64 * nb) * D + 64 * kb, scr, lane, S8_W); }
    }
    __syncthreads();
    {
        LAS float* cact = (LAS float*)lds;
        LAS float* red = (LAS float*)(lds + 8192);
        for (int i = tid; i < 2 * D; i += NTHR) cact[i] = silu_f(a.c[i]);
        __syncthreads();
        float* MOD = (float*)(ws + WS_MOD);
        for (int it = vcu; it < DEPTH * 96; it += G) {
            const int l = it / 96, n0 = (it % 96) * 64;
            const float* wp = a.w_mod + ((size_t)l * D + 128 * wave) * 6144 + n0 + lane;
            float a0 = 0.f, a1 = 0.f;
#pragma unroll 32
            for (int k = 0; k < 128; ++k) { const float w = __builtin_nontemporal_load(wp + (size_t)k * 6144); a0 += cact[128 * wave + k] * w; a1 += cact[D + 128 * wave + k] * w; }
            red[(wave * 2 + 0) * 64 + lane] = a0; red[(wave * 2 + 1) * 64 + lane] = a1;
            __syncthreads();
            if (tid < 128) { const int b = tid >> 6, ln = tid & 63; float s = a.b_mod[l * 6144 + n0 + ln];
#pragma unroll
                for (int w = 0; w < 8; ++w) s += red[(w * 2 + b) * 64 + ln];
                MOD[((size_t)l * 2 + b) * 6144 + n0 + ln] = s; }
            __syncthreads();
        }
    }
    {
        float* ROPE = (float*)(ws + WS_ROPE);
        for (int i = vcu * NTHR + tid; i < MTOK * 24; i += G * NTHR) { const int t = i / 24, f = i % 24;
            const float inv = (float)pow(10000.0, -(double)f / 24.0); const float ang = (float)a.pos[t] * inv;
            ROPE[(size_t)t * 48 + f] = cosf(ang); ROPE[(size_t)t * 48 + 24 + f] = sinf(ang); }
    }
    if (vcu == 0 && tid < 256) {
        float v[4], mx = -3.0e38f; for (int l = 0; l < 4; ++l) { v[l] = a.hg_lb[l * 256 + tid]; mx = fmaxf(mx, v[l]); }
        float s = 0.f; for (int l = 0; l < 4; ++l) { v[l] = expf(v[l] - mx); s += v[l]; }
        float* LB = (float*)(ws + WS_LB); float cs = 0.f, first = 0.f;
        for (int l = 0; l < 4; ++l) { cs += v[l] / s; if (l == 0) first = cs; LB[l * 256 + tid] = cs - first; }
    }
}

__device__ __forceinline__ void moe_combine_row(f32x4 (&v)[4], int m, const bf16* Y, const int* SLOT, const float* TOPW, const float* g2, int lane) {
    const int4 sl = *(const int4*)(SLOT + (size_t)m * 4); const f32x4 tw = *(const f32x4*)(TOPW + (size_t)m * 4);
    const int s[4] = {sl.x, sl.y, sl.z, sl.w};
    f32x4 acc[4];
#pragma unroll
    for (int j = 0; j < 4; ++j) acc[j] = (f32x4){0.f, 0.f, 0.f, 0.f};
#pragma unroll
    for (int k = 0; k < 4; ++k) { const bf16* yr = Y + (size_t)s[k] * D + 4 * lane; const float w = tw[k];
#pragma unroll
        for (int j = 0; j < 4; ++j) { const uint2 p = *(const uint2*)(yr + 256 * j);
            acc[j][0] += w * __builtin_bit_cast(float, p.x << 16); acc[j][1] += w * __builtin_bit_cast(float, p.x & 0xffff0000u);
            acc[j][2] += w * __builtin_bit_cast(float, p.y << 16); acc[j][3] += w * __builtin_bit_cast(float, p.y & 0xffff0000u); } }
#pragma unroll
    for (int j = 0; j < 4; ++j) { const f32x4 g = *(const f32x4*)(g2 + 4 * lane + 256 * j); v[j] = v[j] + g * acc[j]; }
}
__device__ __forceinline__ float row_rstd(const f32x4 (&v)[4]) {
    float s = 0.f;
#pragma unroll
    for (int j = 0; j < 4; ++j) s += (v[j][0] * v[j][0] + v[j][1] * v[j][1]) + (v[j][2] * v[j][2] + v[j][3] * v[j][3]);
    return 1.0f / sqrtf(wave_sum(s) * (1.0f / D) + EPS);
}
__device__ __forceinline__ void modulate_row(f32x4 (&v)[4], float rstd, const float* nw, const float* sc, const float* sh, bf16* hrow, int lane) {
#pragma unroll
    for (int j = 0; j < 4; ++j) { const int c0 = 4 * lane + 256 * j; const f32x4 w = *(const f32x4*)(nw + c0), s1 = *(const f32x4*)(sc + c0), s0 = *(const f32x4*)(sh + c0);
        v[j] = v[j] * rstd * w * (s1 + 1.0f) + s0;
        uint2 p; p.x = pk2(v[j][0], v[j][1]); p.y = pk2(v[j][2], v[j][3]); *(uint2*)(hrow + c0) = p; }
}


constexpr int LR_SLT = 142976, LR_TWL = 144000, LR_SSR = 145024;
__device__ __forceinline__ void stage_slots(const unsigned char* ws, int row0, LAS unsigned char* lds, int tid) {
    if (tid < 64) { *(LAS v4u*)(lds + LR_SLT + 16 * tid) = *(const v4u*)((const int*)(ws + WS_SLOT) + (size_t)(row0 + tid) * 4);
                    *(LAS f32x4*)(lds + LR_TWL + 16 * tid) = *(const f32x4*)((const float*)(ws + WS_TOPW) + (size_t)(row0 + tid) * 4); }
}
template <bool SS>
__device__ __forceinline__ void flat_combine(const float* xsrc, float* xdst, int row0, const bf16* Y, const float* g2, LAS unsigned char* lds, int tid, int lane) {
    const int c4 = tid & 255, rsub = tid >> 8; const f32x4 g = *(const f32x4*)(g2 + 4 * c4);
#pragma unroll 4
    for (int it = 0; it < 32; ++it) { const int i = 2 * it + rsub; const size_t m = (size_t)(row0 + i);
        f32x4 v = *(const f32x4*)(xsrc + m * D + 4 * c4);
        const v4u sl = *(const LAS v4u*)(lds + LR_SLT + 16 * i); const f32x4 tw = *(const LAS f32x4*)(lds + LR_TWL + 16 * i);
        f32x4 acc;
        if (Y8) { const unsigned char* Yb = (const unsigned char*)Y; typedef float f32x2v __attribute__((ext_vector_type(2)));
            const int q0 = *(const int*)(Yb + (size_t)sl.x * D + 4 * c4), q1 = *(const int*)(Yb + (size_t)sl.y * D + 4 * c4), q2 = *(const int*)(Yb + (size_t)sl.z * D + 4 * c4), q3 = *(const int*)(Yb + (size_t)sl.w * D + 4 * c4);
            const f32x2v a0 = __builtin_amdgcn_cvt_pk_f32_fp8(q0, false), b0 = __builtin_amdgcn_cvt_pk_f32_fp8(q0, true), a1 = __builtin_amdgcn_cvt_pk_f32_fp8(q1, false), b1 = __builtin_amdgcn_cvt_pk_f32_fp8(q1, true);
            const f32x2v a2 = __builtin_amdgcn_cvt_pk_f32_fp8(q2, false), b2 = __builtin_amdgcn_cvt_pk_f32_fp8(q2, true), a3 = __builtin_amdgcn_cvt_pk_f32_fp8(q3, false), b3 = __builtin_amdgcn_cvt_pk_f32_fp8(q3, true);
            const f32x4 tws = tw * (1.0f / S8_Y);
            acc[0] = tws[0] * a0[0] + tws[1] * a1[0] + tws[2] * a2[0] + tws[3] * a3[0]; acc[1] = tws[0] * a0[1] + tws[1] * a1[1] + tws[2] * a2[1] + tws[3] * a3[1];
            acc[2] = tws[0] * b0[0] + tws[1] * b1[0] + tws[2] * b2[0] + tws[3] * b3[0]; acc[3] = tws[0] * b0[1] + tws[1] * b1[1] + tws[2] * b2[1] + tws[3] * b3[1]; }
        else {
        const uint2 p0 = *(const uint2*)(Y + (size_t)sl.x * D + 4 * c4), p1 = *(const uint2*)(Y + (size_t)sl.y * D + 4 * c4), p2 = *(const uint2*)(Y + (size_t)sl.z * D + 4 * c4), p3 = *(const uint2*)(Y + (size_t)sl.w * D + 4 * c4);
        acc[0] = tw[0] * __builtin_bit_cast(float, p0.x << 16) + tw[1] * __builtin_bit_cast(float, p1.x << 16) + tw[2] * __builtin_bit_cast(float, p2.x << 16) + tw[3] * __builtin_bit_cast(float, p3.x << 16);
        acc[1] = tw[0] * __builtin_bit_cast(float, p0.x & 0xffff0000u) + tw[1] * __builtin_bit_cast(float, p1.x & 0xffff0000u) + tw[2] * __builtin_bit_cast(float, p2.x & 0xffff0000u) + tw[3] * __builtin_bit_cast(float, p3.x & 0xffff0000u);
        acc[2] = tw[0] * __builtin_bit_cast(float, p0.y << 16) + tw[1] * __builtin_bit_cast(float, p1.y << 16) + tw[2] * __builtin_bit_cast(float, p2.y << 16) + tw[3] * __builtin_bit_cast(float, p3.y << 16);
        acc[3] = tw[0] * __builtin_bit_cast(float, p0.y & 0xffff0000u) + tw[1] * __builtin_bit_cast(float, p1.y & 0xffff0000u) + tw[2] * __builtin_bit_cast(float, p2.y & 0xffff0000u) + tw[3] * __builtin_bit_cast(float, p3.y & 0xffff0000u); }
        v = v + g * acc;
        *(f32x4*)(xdst + m * D + 4 * c4) = v;
        if (SS) { const float sq = wave_sum((v[0] * v[0] + v[1] * v[1]) + (v[2] * v[2] + v[3] * v[3])); if (lane == 0) __hip_atomic_fetch_add((LAS float*)(lds + LR_SSR) + i, sq, __ATOMIC_RELAXED, __HIP_MEMORY_SCOPE_WORKGROUP); } }
}
template <bool F8>
__device__ __forceinline__ void flat_modulate(const float* xin, int row0, const LAS float* rstds, const float* nw, const float* scp, const float* shp, bf16* H, int tid) {
    const int c4 = tid & 255, rsub = tid >> 8; const f32x4 w = *(const f32x4*)(nw + 4 * c4), s1 = *(const f32x4*)(scp + 4 * c4), s0 = *(const f32x4*)(shp + 4 * c4); const f32x4 ws1 = w * (s1 + 1.0f);
#pragma unroll 8
    for (int it = 0; it < 32; ++it) { const int i = 2 * it + rsub; const size_t m = (size_t)(row0 + i); const f32x4 v = *(const f32x4*)(xin + m * D + 4 * c4) * rstds[i] * ws1 + s0;
        if (F8) *(int*)((unsigned char*)H + m * D + 4 * c4) = pk4_fp8(v[0] * S8_H, v[1] * S8_H, v[2] * S8_H, v[3] * S8_H);
        else { uint2 p; p.x = pk2(v[0], v[1]); p.y = pk2(v[2], v[3]); *(uint2*)(H + m * D + 4 * c4) = p; } }
}

constexpr int WP = 1032;
constexpr int LR_WHI = 0, LR_PART = 132096, LR_SSX = 140288, LR_RSTD = 140544, LR_BIAS = 140800, LR_RED = 140928;
template <int NEO>
__device__ __forceinline__ void rows_mfma(const Args& a, int layer, LAS unsigned char* lds, volatile LAS unsigned* MISC, gu32* ctl, int vcu, int G, int tid, int lane, int wave) {
    constexpr bool P5 = (NEO == 32); constexpr int NET = NEO / 16;
    unsigned char* ws = a.ws; float* X = (float*)(ws + WS_X); bf16* H = (bf16*)(ws + WS_H); const float* MOD = (const float*)(ws + WS_MOD);
    LAS bf16* Whi = (LAS bf16*)(lds + LR_WHI); LAS bf16* Wlo = Whi + NEO * WP; LAS float* part = (LAS float*)(lds + LR_PART); LAS float* ssx = (LAS float*)(lds + LR_SSX);
    LAS float* rstds = (LAS float*)(lds + LR_RSTD); LAS float* biasl = (LAS float*)(lds + LR_BIAS); LAS float* red = (LAS float*)(lds + LR_RED);
    const float* nw = (P5 ? a.norm2_w : a.norm1_w) + layer * D;
    const float* Wsrc = P5 ? a.w_r + (size_t)layer * D * NE : a.w_in + (size_t)layer * D * DIN + SRC_GA; const int wld = P5 ? NE : DIN;
    if (P5) { if (tid < NE) MISC[MW_HIST + tid] = 0u; }
    for (int row0 = vcu * 64; row0 < MTOK; row0 += G * 64) {
        const int b = row0 / SEQ; const float* mp = MOD + ((size_t)layer * 2 + b) * 6144; const float* scp = mp + (P5 ? 4 : 1) * D; const float* shp = mp + (P5 ? 3 : 0) * D;
        if (!P5 && layer > 0) { stage_slots(ws, row0, lds, tid); __syncthreads(); }
        { const int e = tid % NEO, kq = tid / NEO; constexpr int NPT = NTHR / NEO;
#pragma unroll 1
            for (int it0 = 0; it0 < D / NPT; it0 += 8) { float wv[8];
#pragma unroll
                for (int u = 0; u < 8; ++u) { const int k = kq + NPT * (it0 + u); wv[u] = Wsrc[(size_t)k * wld + e] * (nw[k] * (1.0f + scp[k])); }
#pragma unroll
                for (int u = 0; u < 8; ++u) { const int k = kq + NPT * (it0 + u); const unsigned hi = f2bf(wv[u]); const float wl = wv[u] - __builtin_bit_cast(float, hi << 16); Whi[e * WP + k] = (bf16)hi; Wlo[e * WP + k] = (bf16)f2bf(wl); } }
            constexpr int KP = D / NPT; float sacc = 0.f;
#pragma unroll 8
            for (int k = kq * KP; k < kq * KP + KP; ++k) sacc += shp[k] * Wsrc[(size_t)k * wld + e];
            red[kq * NEO + e] = sacc; }
        const float* xin = X;
        if (!P5) { if (layer == 0) xin = a.x;
            else { flat_combine<false>(X, X, row0, (const bf16*)(ws + WS_Y), MOD + ((size_t)(layer - 1) * 2 + b) * 6144 + 5 * D, lds, tid, lane); asm volatile("s_waitcnt vmcnt(0)" ::: "memory"); } }
        __syncthreads();
        if (tid < NEO) { constexpr int NPT = NTHR / NEO; float sacc = P5 ? a.b_r[layer * NE + tid] : 0.f; for (int q = 0; q < NPT; ++q) sacc += red[q * NEO + tid]; biasl[tid] = sacc; }
        const int rg = wave >> 1, kh = wave & 1, r = lane & 15, g = lane >> 4;
        { const float* xr = xin + (size_t)(row0 + 16 * rg + r) * D; f32x4 acc[NET]; float ss = 0.f;
#pragma unroll
            for (int et = 0; et < NET; ++et) acc[et] = (f32x4){0.f, 0.f, 0.f, 0.f};
#pragma unroll 4
            for (int s = 16 * kh; s < 16 * kh + 16; ++s) { const int k0 = 32 * s + 8 * g; const f32x4 x0 = *(const f32x4*)(xr + k0), x1 = *(const f32x4*)(xr + k0 + 4);
                ss += (x0[0] * x0[0] + x0[1] * x0[1]) + (x0[2] * x0[2] + x0[3] * x0[3]) + (x1[0] * x1[0] + x1[1] * x1[1]) + (x1[2] * x1[2] + x1[3] * x1[3]);
                float xv[8] = {x0[0], x0[1], x0[2], x0[3], x1[0], x1[1], x1[2], x1[3]}, xl[8];
#pragma unroll
                for (int j = 0; j < 8; ++j) xl[j] = xv[j] - __builtin_bit_cast(float, f2bf(xv[j]) << 16);
                const pg8::bf16x8 ahi = pack8(xv), alo = pack8(xl);
#pragma unroll
                for (int et = 0; et < NET; ++et) { const pg8::bf16x8 whi = ldfrag(Whi, WP, 16 * et, 32 * s, lane), wlo = ldfrag(Wlo, WP, 16 * et, 32 * s, lane);
                    acc[et] = __builtin_amdgcn_mfma_f32_16x16x32_bf16(ahi, whi, acc[et], 0, 0, 0); acc[et] = __builtin_amdgcn_mfma_f32_16x16x32_bf16(alo, whi, acc[et], 0, 0, 0);
                    acc[et] = __builtin_amdgcn_mfma_f32_16x16x32_bf16(ahi, wlo, acc[et], 0, 0, 0); } }
            ss += __shfl_xor(ss, 16); ss += __shfl_xor(ss, 32);
            if (kh == 1) {
#pragma unroll
                for (int et = 0; et < NET; ++et)
#pragma unroll
                    for (int q = 0; q < 4; ++q) part[(rg * 16 + 4 * g + q) * 32 + 16 * et + r] = acc[et][q];
                if (g == 0) ssx[rg * 16 + r] = ss; }
            __syncthreads();
            if (kh == 0) { const float sst = ss + ssx[rg * 16 + r]; if (g == 0) rstds[rg * 16 + r] = 1.0f / sqrtf(sst * (1.0f / D) + EPS);
                asm volatile("s_waitcnt lgkmcnt(0)" ::: "memory");
#pragma unroll
                for (int et = 0; et < NET; ++et)
#pragma unroll
                    for (int q = 0; q < 4; ++q) { const int i = rg * 16 + 4 * g + q, e = 16 * et + r; const float v = rstds[i] * (acc[et][q] + part[i * 32 + e]) + biasl[e];
                        if (P5) part[i * 32 + e] = v; else ((float*)(ws + WS_GA))[(size_t)(row0 + i) * 16 + e] = v; }
                if (P5) { asm volatile("s_waitcnt lgkmcnt(0)" ::: "memory");
                    if (lane < 16) { const int i = rg * 16 + lane, m = row0 + i; float lv[NE];
#pragma unroll
                        for (int e = 0; e < NE; ++e) lv[e] = part[i * 32 + e];
                        float tv[4]; int te[4];
#pragma unroll
                        for (int t = 0; t < 4; ++t) { float best = -3.0e38f; int bi = 0;
#pragma unroll
                            for (int e = 0; e < NE; ++e) if (lv[e] > best) { best = lv[e]; bi = e; }
#pragma unroll
                            for (int e = 0; e < NE; ++e) if (e == bi) lv[e] = -3.0e38f;
                            tv[t] = best; te[t] = bi; }
                        const float e1 = expf(tv[1] - tv[0]), e2 = expf(tv[2] - tv[0]), e3 = expf(tv[3] - tv[0]); const float inv = 1.0f / (1.0f + e1 + e2 + e3);
                        *(f32x4*)((float*)(ws + WS_TOPW) + (size_t)m * 4) = (f32x4){inv, e1 * inv, e2 * inv, e3 * inv};
#pragma unroll
                        for (int t = 0; t < 4; ++t) { const unsigned rk = __hip_atomic_fetch_add((LAS unsigned*)&MISC[MW_HIST + te[t]], 1u, __ATOMIC_RELAXED, __HIP_MEMORY_SCOPE_WORKGROUP);
                            ((LAS unsigned*)(lds + LR_SLT))[i * 4 + t] = ((unsigned)te[t] << 16) | rk; } } } }
            __syncthreads(); }
        if (P5) { if (tid < NE) { const unsigned hcnt = MISC[MW_HIST + tid]; MISC[MW_BASE + tid] = hcnt ? atomicAdd((unsigned*)(ctl + CW_CNT + layer * NE + tid), hcnt) : 0u; }
            __syncthreads();
            if (tid < 256) { LAS unsigned* sl = (LAS unsigned*)(lds + LR_SLT) + tid; const unsigned v = *sl, e = v >> 16; const unsigned slot = (e << ECAP_SH) + MISC[MW_BASE + e] + (v & 0xffffu);
                *sl = slot; ((int*)(ws + WS_SLOT))[(size_t)row0 * 4 + tid] = (int)slot; }
            if (tid < NE) MISC[MW_HIST + tid] = 0u;
            __syncthreads(); }
        if (P5) { const int c4 = tid & 255, rsub = tid >> 8; const f32x4 w = *(const f32x4*)(nw + 4 * c4), s1 = *(const f32x4*)(scp + 4 * c4), s0 = *(const f32x4*)(shp + 4 * c4); const f32x4 ws1 = w * (s1 + 1.0f);
            unsigned char* A1 = ws + WS_A1;
#pragma unroll 8
            for (int it = 0; it < 32; ++it) { const int i = 2 * it + rsub; const f32x4 v = *(const f32x4*)(xin + (size_t)(row0 + i) * D + 4 * c4) * rstds[i] * ws1 + s0;
                const int pw = pk4_fp8(v[0] * S8_H, v[1] * S8_H, v[2] * S8_H, v[3] * S8_H); const v4u sl = *(const LAS v4u*)(lds + LR_SLT + 16 * i);
                *(int*)(A1 + (size_t)sl.x * D + 4 * c4) = pw; *(int*)(A1 + (size_t)sl.y * D + 4 * c4) = pw; *(int*)(A1 + (size_t)sl.z * D + 4 * c4) = pw; *(int*)(A1 + (size_t)sl.w * D + 4 * c4) = pw; } }
        else flat_modulate<F8_IN>(xin, row0, rstds, nw, scp, shp, H, tid);
        __syncthreads();
    }
}

__device__ __forceinline__ void final_rows(const Args& a, LAS unsigned char* lds, int vcu, int G, int tid, int lane) {
    unsigned char* ws = a.ws; const float* X = (const float*)(ws + WS_X); const float* MOD = (const float*)(ws + WS_MOD); LAS float* ssr = (LAS float*)(lds + LR_SSR);
    for (int row0 = vcu * 64; row0 < MTOK; row0 += G * 64) { const int b = row0 / SEQ;
        stage_slots(ws, row0, lds, tid); if (tid < 64) ssr[tid] = 0.f;
        __syncthreads();
        flat_combine<true>(X, a.out, row0, (const bf16*)(ws + WS_Y), MOD + ((size_t)(DEPTH - 1) * 2 + b) * 6144 + 5 * D, lds, tid, lane);
        asm volatile("s_waitcnt vmcnt(0)" ::: "memory");
        __syncthreads();
        { const int c4 = tid & 255, rsub = tid >> 8; const f32x4 w = *(const f32x4*)(a.final_norm_w + 4 * c4);
#pragma unroll 8
            for (int it = 0; it < 32; ++it) { const int i = 2 * it + rsub; float* op = a.out + (size_t)(row0 + i) * D + 4 * c4; const float rstd = 1.0f / sqrtf(ssr[i] * (1.0f / D) + EPS); *(f32x4*)op = *(const f32x4*)op * rstd * w; } }
        __syncthreads();
    }
}

__device__ __noinline__ void moe_tables(gu32* ctl, int layer, volatile LAS unsigned* MISC, int tid) {
    if (tid < NE) MISC[MW_CNT + tid] = __hip_atomic_load(ctl + CW_CNT + layer * NE + tid, RLX_AGENT);
    __syncthreads();
    if (tid == 0) { unsigned n = 0;
        for (int e = 0; e < NE; ++e) { const unsigned nt = (MISC[MW_CNT + e] + 255u) >> 8; for (unsigned t = 0; t < nt; ++t) MISC[MW_TILE + n + t] = (unsigned)(e * 64) + t; n += nt; }
        MISC[MW_NRT] = n; }
    __syncthreads();
}

constexpr int BP = 72;
template <int TYPE> struct MixCfg { static constexpr int DK = (TYPE == 1) ? 64 : 48, DV = (TYPE == 1) ? 64 : 96, NC = 4 * DK, NV = 4 * DV;
    static constexpr int STOFF = (TYPE == 0) ? ST_GLA : (TYPE == 1) ? ST_HG : ST_RET, COFF = (TYPE == 0) ? 0 : 192;
    static constexpr int CQ = (TYPE == 0) ? C_GQ : (TYPE == 1) ? C_HQ : C_RQ, CK = (TYPE == 0) ? C_GK : (TYPE == 1) ? C_HF : C_RK, CV = (TYPE == 0) ? C_GV : (TYPE == 1) ? C_HI : C_RV, CG = (TYPE == 0) ? C_GG : (TYPE == 1) ? C_HG : C_RG;
    static constexpr int MIXOFF = (TYPE == 0) ? 0 : (TYPE == 1) ? 384 : 640; };
__device__ __forceinline__ float fast_logsig(float x) { x = fmaxf(x, -80.f); return -__logf(1.0f + __expf(-x)); }
__device__ __forceinline__ float ret_lg(int h) { return logf(1.0f - exp2f(-5.0f - (float)h)); }

template <int NV>
__device__ __forceinline__ void stage_vt(const bf16* pv  , LAS bf16* VT, int tid) {
#pragma unroll 2
    for (int idx = tid; idx < 64 * (NV / 8); idx += NTHR) { const int j = idx & 63, ch = idx >> 6; const v4u p = *(const v4u*)(pv + (size_t)j * NPROJ + 8 * ch); LAS bf16* d = VT + (8 * ch) * BP + j;
        d[0 * BP] = (bf16)(p.x & 0xffffu); d[1 * BP] = (bf16)(p.x >> 16); d[2 * BP] = (bf16)(p.y & 0xffffu); d[3 * BP] = (bf16)(p.y >> 16);
        d[4 * BP] = (bf16)(p.z & 0xffffu); d[5 * BP] = (bf16)(p.z >> 16); d[6 * BP] = (bf16)(p.w & 0xffffu); d[7 * BP] = (bf16)(p.w >> 16); }
}

constexpr int LA_KT = 0, LA_VT = 36864, LA_TOT = 92160, LA_GA = 94208;
template <int TYPE>
__device__ __forceinline__ void mixa_batch(const Args& a, int layer, int unit, LAS unsigned char* lds, int tid, int lane, int wave) {
    typedef MixCfg<TYPE> C; constexpr int DK = C::DK, DV = C::DV, NC = C::NC, NV = C::NV;
    unsigned char* ws = a.ws; const bf16* PROJ = (const bf16*)(ws + WS_PROJ); float* CUM = (float*)(ws + WS_CUM); float* DVEC = (float*)(ws + WS_DVEC) + (size_t)unit * NDV;
    float* U = (float*)(ws + WS_U) + (size_t)unit * ST_TOT + C::STOFF;
    LAS bf16* KT = (LAS bf16*)(lds + LA_KT); LAS bf16* VT = (LAS bf16*)(lds + LA_VT); LAS float* TOT = (LAS float*)(lds + LA_TOT); const LAS float* GAs = (const LAS float*)(lds + LA_GA);
    const int row0 = unit * CH;
    const bool act = tid < 2 * NC; const int c = act ? tid % NC : 0, half = act ? tid / NC : 0, h = c / DK, d = c - h * DK;
    float cum[32]; float tot = 0.f;
    float w2[16], b2 = 0.f, lbv = 0.f, lg = 0.f, sg = 0.f; int f = 0, d2 = 0;
    if (act) {
        if constexpr (TYPE == 0) { b2 = a.gla_ba2[layer * 192 + c];
#pragma unroll
            for (int r = 0; r < 16; ++r) w2[r] = a.gla_wa2[(layer * 16 + r) * 192 + c]; }
        if constexpr (TYPE == 1) lbv = ((const float*)(ws + WS_LB))[layer * 256 + c];
        if constexpr (TYPE == 2) { lg = ret_lg(h); f = (d < 24) ? d : d - 24; d2 = (d < 24) ? d + 24 : d - 24; sg = (d < 24) ? -1.f : 1.f; }
        bf16 hraw[32];
        if constexpr (TYPE == 1) {
#pragma unroll
            for (int i = 0; i < 32; ++i) hraw[i] = PROJ[(size_t)(row0 + 32 * half + i) * NPROJ + C_HF + c]; }
#pragma unroll
        for (int i = 0; i < 32; ++i) { const int t = 32 * half + i; float g;
            if constexpr (TYPE == 0) { float pre = b2;
#pragma unroll
                for (int r = 0; r < 16; ++r) pre += GAs[t * 16 + r] * w2[r];
                g = fast_logsig(pre) * (1.0f / 16.0f); }
            else if constexpr (TYPE == 1) { const float hf = fminf(fmaxf(bf2f(hraw[i]), -80.f), 80.f); const float sgm = 1.0f / (1.0f + __expf(-hf));
                g = __logf(lbv + (1.0f - lbv) * sgm); }
            else g = lg;
            tot += g; cum[i] = tot;
            if ((i & 7) == 7) asm volatile("" ::: "memory"); }
        TOT[c * 2 + half] = tot;
    }
    stage_vt<NV>(PROJ + (size_t)row0 * NPROJ + C::CV, VT, tid);
    __syncthreads();
    if (act) { const float t0 = TOT[c * 2], t1 = TOT[c * 2 + 1]; const float off = half ? t0 : 0.f, last = t0 + t1;
#pragma unroll
        for (int hq = 0; hq < 2; ++hq) {
            bf16 ka[16], kb[16]; float cs[16], sn[16];
            if constexpr (TYPE != 1) {
#pragma unroll
                for (int i = 0; i < 16; ++i) { const size_t row = (size_t)(row0 + 32 * half + 16 * hq + i); const bf16* pr = PROJ + row * NPROJ;
                    if constexpr (TYPE == 0) ka[i] = pr[C_GK + c];
                    else { const float* rp = (const float*)(ws + WS_ROPE) + row * 48; ka[i] = pr[C_RK + h * 48 + d]; kb[i] = pr[C_RK + h * 48 + d2]; cs[i] = rp[f]; sn[i] = rp[24 + f]; } } }
#pragma unroll
            for (int q2 = 0; q2 < 2; ++q2) { float kt[8];
#pragma unroll
                for (int j = 0; j < 8; ++j) { const int ii = 8 * q2 + j, i = 16 * hq + ii; const float cm = cum[i] + off; const size_t row = (size_t)(row0 + 32 * half + i); float k;
                    if constexpr (TYPE == 0) k = bf2f(ka[ii]);
                    else if constexpr (TYPE == 1) k = 1.0f - __expf(cum[i] - (i > 0 ? cum[i - 1] : 0.f));
                    else k = bf2f(ka[ii]) * cs[ii] + sg * bf2f(kb[ii]) * sn[ii];
                    if constexpr (TYPE != 2) CUM[row * NDV + C::COFF + c] = cm;
                    kt[j] = k * __expf(last - cm); }
                v4u w; w.x = pk2(kt[0], kt[1]); w.y = pk2(kt[2], kt[3]); w.z = pk2(kt[4], kt[5]); w.w = pk2(kt[6], kt[7]);
                *(LAS v4u*)(KT + c * BP + 32 * half + 16 * hq + 8 * q2) = w; } }
        if (TYPE != 2 && half == 0) DVEC[C::COFF + c] = __expf(last);
    }
    __syncthreads();
    constexpr int TD = DK / 16, NT = (DV / 16) * TD;
    for (int ti = wave; ti < 4 * NT; ti += NWAVES) { const int hh = ti / NT, tr = ti - hh * NT, te = tr / TD, td = tr - te * TD; f32x4 acc = {0.f, 0.f, 0.f, 0.f};
#pragma unroll
        for (int kk = 0; kk < 2; ++kk) acc = __builtin_amdgcn_mfma_f32_16x16x32_bf16(ldfrag(VT, BP, hh * DV + te * 16, kk * 32, lane), ldfrag(KT, BP, hh * DK + td * 16, kk * 32, lane), acc, 0, 0, 0);
        float* Uh = U + hh * DK * DV;
#pragma unroll
        for (int r = 0; r < 4; ++r) Uh[(te * 16 + (lane >> 4) * 4 + r) * DK + td * 16 + (lane & 15)] = acc[r]; }
    __syncthreads();
}
__device__ __forceinline__ void p3a_summaries(const Args& a, int layer, LAS unsigned char* lds, int vcu, int G, int tid, int lane, int wave) {
    for (int unit = vcu; unit < NUNIT; unit += G) {
        { LAS float* GAs = (LAS float*)(lds + LA_GA); const float* GA = (const float*)(a.ws + WS_GA); for (int i = tid; i < CH * 16; i += NTHR) GAs[i] = GA[(size_t)unit * CH * 16 + i]; }
        __syncthreads();
        mixa_batch<0>(a, layer, unit, lds, tid, lane, wave);
        mixa_batch<1>(a, layer, unit, lds, tid, lane, wave);
        mixa_batch<2>(a, layer, unit, lds, tid, lane, wave);
    }
}

__device__ __forceinline__ void p3b_scan(const Args& a, int vcu, int G, int tid) {
    unsigned char* ws = a.ws; const float* U = (const float*)(ws + WS_U); const float* DVEC = (const float*)(ws + WS_DVEC); bf16* SP = (bf16*)(ws + WS_SP);
    for (int gid = vcu * NTHR + tid; gid < BATCH * ST_TOT; gid += G * NTHR) {
        const int b = gid / ST_TOT, el = gid - b * ST_TOT;
        int di = -1; float cdec = 0.f;
        if (el < ST_HG) { const int h = el / 4608, d = (el - h * 4608) % 48; di = h * 48 + d; }
        else if (el < ST_RET) { const int r = el - ST_HG, h = r / 4096, d = r % 64; di = 192 + h * 64 + d; }
        else { const int h = (el - ST_RET) / 4608; cdec = expf(64.0f * logf(1.0f - exp2f(-5.0f - (float)h))); }
        const float* up = U + (size_t)b * NCH * ST_TOT + el; const float* dp = DVEC + (size_t)b * NCH * NDV + (di < 0 ? 0 : di); bf16* sp = SP + (size_t)b * NCH * ST_TOT + el;
        float s = 0.f;
        for (int n0 = 0; n0 < NCH; n0 += 8) { float u[8], dc[8];
#pragma unroll
            for (int i = 0; i < 8; ++i) { u[i] = up[(size_t)(n0 + i) * ST_TOT]; dc[i] = (di < 0) ? cdec : dp[(size_t)(n0 + i) * NDV]; }
#pragma unroll
            for (int i = 0; i < 8; ++i) { sp[(size_t)(n0 + i) * ST_TOT] = (bf16)f2bf(s); s = dc[i] * s + u[i]; } }
    }
}

constexpr int LC_VT = 0, LC_ST = 55296, LC_AB = 110592, OBP = 104;
template <int TYPE, bool ISQ>
__device__ __forceinline__ void mix_frag(const Args& a, int h, size_t row, int t, int d0, float (&x)[8], float (&cm)[8]) {
    typedef MixCfg<TYPE> C; constexpr int DK = C::DK;
    unsigned char* ws = a.ws; const bf16* pr = (const bf16*)(ws + WS_PROJ) + row * NPROJ;
    if constexpr (TYPE == 0) {
        const v4u p = *(const v4u*)(pr + (ISQ ? C_GQ : C_GK) + h * DK + d0); const unsigned pw[4] = {p.x, p.y, p.z, p.w};
        const float* cp = (const float*)(ws + WS_CUM) + row * NDV + h * DK + d0; const f32x4 c0 = *(const f32x4*)cp, c1 = *(const f32x4*)(cp + 4);
#pragma unroll
        for (int j = 0; j < 4; ++j) { x[2 * j] = __builtin_bit_cast(float, pw[j] << 16); x[2 * j + 1] = __builtin_bit_cast(float, pw[j] & 0xffff0000u); cm[j] = c0[j]; cm[4 + j] = c1[j]; }
        if (ISQ) {
#pragma unroll
            for (int j = 0; j < 8; ++j) x[j] *= 0.14433756729740643f; }
    } else if constexpr (TYPE == 1) {
        const float* cp = (const float*)(ws + WS_CUM) + row * NDV + 192 + h * DK + d0; const f32x4 c0 = *(const f32x4*)cp, c1 = *(const f32x4*)(cp + 4);
#pragma unroll
        for (int j = 0; j < 4; ++j) { cm[j] = c0[j]; cm[4 + j] = c1[j]; }
        if (ISQ) { const v4u p = *(const v4u*)(pr + C_HQ + h * DK + d0); const unsigned pw[4] = {p.x, p.y, p.z, p.w};
#pragma unroll
            for (int j = 0; j < 4; ++j) { x[2 * j] = __builtin_bit_cast(float, pw[j] << 16); x[2 * j + 1] = __builtin_bit_cast(float, pw[j] & 0xffff0000u); } }
        else { f32x4 p0 = {0.f, 0.f, 0.f, 0.f}, p1 = {0.f, 0.f, 0.f, 0.f}; if (t > 0) { p0 = *(const f32x4*)(cp - NDV); p1 = *(const f32x4*)(cp - NDV + 4); }
#pragma unroll
            for (int j = 0; j < 4; ++j) { x[j] = 1.0f - __expf(c0[j] - p0[j]); x[4 + j] = 1.0f - __expf(c1[j] - p1[j]); } }
    } else {
        const int f0 = (d0 < 24) ? d0 : d0 - 24, dp = (d0 < 24) ? d0 + 24 : d0 - 24; const float sg = (d0 < 24) ? -1.f : 1.f;
        const int cb = (ISQ ? C_RQ : C_RK) + h * DK; const v4u p = *(const v4u*)(pr + cb + d0), pp = *(const v4u*)(pr + cb + dp); const unsigned pw[4] = {p.x, p.y, p.z, p.w}, qw[4] = {pp.x, pp.y, pp.z, pp.w};
        const float* rp = (const float*)(ws + WS_ROPE) + row * 48; const f32x4 cs0 = *(const f32x4*)(rp + f0), cs1 = *(const f32x4*)(rp + f0 + 4), sn0 = *(const f32x4*)(rp + 24 + f0), sn1 = *(const f32x4*)(rp + 24 + f0 + 4);
        const float cmv = (float)(t + 1) * ret_lg(h);
#pragma unroll
        for (int j = 0; j < 4; ++j) { const float xa = __builtin_bit_cast(float, pw[j] << 16), xb = __builtin_bit_cast(float, pw[j] & 0xffff0000u), ya = __builtin_bit_cast(float, qw[j] << 16), yb = __builtin_bit_cast(float, qw[j] & 0xffff0000u);
            const float ca = (j < 2) ? cs0[2 * j] : cs1[2 * j - 4], cb2 = (j < 2) ? cs0[2 * j + 1] : cs1[2 * j - 3], sa = (j < 2) ? sn0[2 * j] : sn1[2 * j - 4], sb = (j < 2) ? sn0[2 * j + 1] : sn1[2 * j - 3];
            x[2 * j] = xa * ca + sg * ya * sa; x[2 * j + 1] = xb * cb2 + sg * yb * sb; cm[2 * j] = cmv; cm[2 * j + 1] = cmv; }
        if (ISQ) {
#pragma unroll
            for (int j = 0; j < 8; ++j) x[j] *= 0.14433756729740643f; }
    }
}

template <int TYPE>
__device__ __forceinline__ void mixc_batch(const Args& a, int layer, int unit, LAS unsigned char* lds, int tid, int lane, int wave) {
    typedef MixCfg<TYPE> C; constexpr int DK = C::DK, DV = C::DV, NV = C::NV, TE = DV / 16;
    unsigned char* ws = a.ws; const bf16* PROJ = (const bf16*)(ws + WS_PROJ); bf16* MIX = (bf16*)(ws + WS_MIX);
    LAS bf16* VT = (LAS bf16*)(lds + LC_VT); LAS bf16* ST = (LAS bf16*)(lds + LC_ST); LAS bf16* AB = (LAS bf16*)(lds + LC_AB) + wave * 16 * OBP;
    const int row0 = unit * CH;
    stage_vt<NV>(PROJ + (size_t)row0 * NPROJ + C::CV, VT, tid);
    { const bf16* SPu = (const bf16*)(ws + WS_SP) + (size_t)unit * ST_TOT + C::STOFF;
        for (int idx = tid; idx < NV * 8; idx += NTHR) { const int er = idx >> 3, ch = idx & 7; v4u w = {0u, 0u, 0u, 0u}; if (ch * 8 < DK) w = *(const v4u*)(SPu + (size_t)er * DK + ch * 8); *(LAS v4u*)(ST + er * BP + ch * 8) = w; } }
    __syncthreads();
    const int h = wave >> 1, hsel = wave & 1, r = lane & 15, g = lane >> 4;
    const LAS bf16* STh = ST + h * DV * BP; const LAS bf16* VTh = VT + h * DV * BP;
    const float* CUMp = (const float*)(ws + WS_CUM);
    for (int ib = 0; ib < 2; ++ib) { const int I = ib ? 3 - hsel : hsel;
        pg8::bf16x8 qh[2], qt[2]; float refv[2][8];
#pragma unroll
        for (int s = 0; s < 2; ++s) { const int d0 = 32 * s + 8 * g; const bool valid = d0 < DK; const int d0c = valid ? d0 : 0;
            float x[8], cm[8]; mix_frag<TYPE, true>(a, h, (size_t)(row0 + 16 * I + r), 16 * I + r, d0c, x, cm);
            if constexpr (TYPE == 2) {
#pragma unroll
                for (int j = 0; j < 8; ++j) refv[s][j] = (float)(16 * I) * ret_lg(h);
            } else { if (I > 0) { const float* cp = CUMp + (size_t)(row0 + 16 * I - 1) * NDV + C::COFF + h * DK + d0c; const f32x4 c0 = *(const f32x4*)cp, c1 = *(const f32x4*)(cp + 4);
#pragma unroll
                    for (int j = 0; j < 4; ++j) { refv[s][j] = c0[j]; refv[s][4 + j] = c1[j]; } }
                else {
#pragma unroll
                    for (int j = 0; j < 8; ++j) refv[s][j] = 0.f; } }
            float xh[8], xt[8];
#pragma unroll
            for (int j = 0; j < 8; ++j) { xh[j] = valid ? x[j] * __expf(cm[j] - refv[s][j]) : 0.f; xt[j] = valid ? x[j] * __expf(cm[j]) : 0.f; }
            qh[s] = pack8(xh); qt[s] = pack8(xt); }
        for (int J = 0; J <= I; ++J) { f32x4 acc = {0.f, 0.f, 0.f, 0.f};
#pragma unroll
            for (int s = 0; s < 2; ++s) { const int d0 = 32 * s + 8 * g; const bool valid = d0 < DK; const int d0c = valid ? d0 : 0;
                float x[8], cm[8]; mix_frag<TYPE, false>(a, h, (size_t)(row0 + 16 * J + r), 16 * J + r, d0c, x, cm);
                float xk[8];
#pragma unroll
                for (int j = 0; j < 8; ++j) xk[j] = valid ? x[j] * __expf(fminf(refv[s][j] - cm[j], 80.f)) : 0.f;
                acc = __builtin_amdgcn_mfma_f32_16x16x32_bf16(qh[s], pack8(xk), acc, 0, 0, 0); }
#pragma unroll
            for (int q = 0; q < 4; ++q) { const int i = 4 * g + q; const float v = (J < I || r <= i) ? acc[q] : 0.f; AB[i * BP + 16 * J + r] = (bf16)f2bf(v); } }
        if ((I & 1) == 0) {
#pragma unroll
            for (int q = 0; q < 4; ++q) AB[(4 * g + q) * BP + 16 * (I + 1) + r] = (bf16)0; }
        asm volatile("s_waitcnt lgkmcnt(0)" ::: "memory");
        const pg8::bf16x8 ah0 = *(const LAS pg8::bf16x8*)(AB + r * BP + 8 * g), ah1 = *(const LAS pg8::bf16x8*)(AB + r * BP + 32 + 8 * g);
        f32x4 o[TE];
#pragma unroll
        for (int te = 0; te < TE; ++te) { f32x4 acc = {0.f, 0.f, 0.f, 0.f};
            acc = __builtin_amdgcn_mfma_f32_16x16x32_bf16(qt[0], ldfrag(STh, BP, te * 16, 0, lane), acc, 0, 0, 0);
            acc = __builtin_amdgcn_mfma_f32_16x16x32_bf16(qt[1], ldfrag(STh, BP, te * 16, 32, lane), acc, 0, 0, 0);
            acc = __builtin_amdgcn_mfma_f32_16x16x32_bf16(ah0, ldfrag(VTh, BP, te * 16, 0, lane), acc, 0, 0, 0);
            if (I >= 2) acc = __builtin_amdgcn_mfma_f32_16x16x32_bf16(ah1, ldfrag(VTh, BP, te * 16, 32, lane), acc, 0, 0, 0);
            o[te] = acc; }
#pragma unroll
        for (int q = 0; q < 4; ++q) { float s1 = 0.f, s2 = 0.f;
#pragma unroll
            for (int te = 0; te < TE; ++te) { s1 += o[te][q]; s2 += o[te][q] * o[te][q]; }
#pragma unroll
            for (int m = 1; m < 16; m <<= 1) { s1 += __shfl_xor(s1, m); s2 += __shfl_xor(s2, m); }
            float mean = 0.f, rstd;
            if constexpr (TYPE == 2) { mean = s1 * (1.0f / DV); rstd = 1.0f / sqrtf(fmaxf(s2 * (1.0f / DV) - mean * mean, 0.f) + EPS); }
            else rstd = 1.0f / sqrtf(s2 * (1.0f / DV) + EPS);
#pragma unroll
            for (int te = 0; te < TE; ++te) AB[(4 * g + q) * OBP + te * 16 + r] = (bf16)f2bf((o[te][q] - mean) * rstd); }
        asm volatile("s_waitcnt lgkmcnt(0)" ::: "memory");
        constexpr int NCHK = DV / 8;
#pragma unroll
        for (int i = 0; i < (16 * NCHK) / 64; ++i) { const int cidx = lane + 64 * i, orow = cidx / NCHK, ch = cidx - orow * NCHK; const size_t row = (size_t)(row0 + 16 * I + orow);
            const v4u ov = *(const LAS v4u*)(AB + orow * OBP + 8 * ch); const v4u gv = *(const v4u*)(PROJ + row * NPROJ + C::CG + h * DV + 8 * ch);
            const unsigned ow[4] = {ov.x, ov.y, ov.z, ov.w}, gw[4] = {gv.x, gv.y, gv.z, gv.w}; float res[8];
            f32x4 w0 = {1.f, 1.f, 1.f, 1.f}, w1 = {1.f, 1.f, 1.f, 1.f};
            if constexpr (TYPE == 0) { const float* wp = a.gla_norm_w + layer * 384 + h * 96 + 8 * ch; w0 = *(const f32x4*)wp; w1 = *(const f32x4*)(wp + 4); }
            if constexpr (TYPE == 1) { const float* wp = a.hg_norm_w + layer * 256 + h * 64 + 8 * ch; w0 = *(const f32x4*)wp; w1 = *(const f32x4*)(wp + 4); }
#pragma unroll
            for (int j = 0; j < 4; ++j) { const float oa = __builtin_bit_cast(float, ow[j] << 16), ob = __builtin_bit_cast(float, ow[j] & 0xffff0000u), ga = __builtin_bit_cast(float, gw[j] << 16), gb = __builtin_bit_cast(float, gw[j] & 0xffff0000u);
                const float wa = (j < 2) ? w0[2 * j] : w1[2 * j - 4], wb = (j < 2) ? w0[2 * j + 1] : w1[2 * j - 3];
                const float sa = 1.0f / (1.0f + __expf(-ga)), sb = 1.0f / (1.0f + __expf(-gb));
                res[2 * j] = oa * wa * ((TYPE == 1) ? sa : ga * sa); res[2 * j + 1] = ob * wb * ((TYPE == 1) ? sb : gb * sb); }
            if (F8_OUT) { typedef int i32x2 __attribute__((ext_vector_type(2)));
                *(i32x2*)((unsigned char*)MIX + row * D + C::MIXOFF + h * DV + 8 * ch) = (i32x2){pk4_fp8(res[0] * S8_M, res[1] * S8_M, res[2] * S8_M, res[3] * S8_M), pk4_fp8(res[4] * S8_M, res[5] * S8_M, res[6] * S8_M, res[7] * S8_M)}; }
            else { v4u w; w.x = pk2(res[0], res[1]); w.y = pk2(res[2], res[3]); w.z = pk2(res[4], res[5]); w.w = pk2(res[6], res[7]); *(v4u*)(MIX + row * D + C::MIXOFF + h * DV + 8 * ch) = w; } }
    }
    __syncthreads();
}
__device__ __forceinline__ void p3c_outputs(const Args& a, int layer, LAS unsigned char* lds, int vcu, int G, int tid, int lane, int wave) {
    for (int unit = vcu; unit < NUNIT; unit += G) {
        mixc_batch<0>(a, layer, unit, lds, tid, lane, wave);
        mixc_batch<1>(a, layer, unit, lds, tid, lane, wave);
        mixc_batch<2>(a, layer, unit, lds, tid, lane, wave);
    }
}


constexpr int MW_ARGS = 800;
__device__ __forceinline__ const void* ld_argp(const volatile LAS unsigned* T, int i) {
    const unsigned lo = __builtin_amdgcn_readfirstlane(T[2 * i]), hi = __builtin_amdgcn_readfirstlane(T[2 * i + 1]);
    return (const void*)(((unsigned long long)hi << 32) | lo);
}
__device__ __forceinline__ Args load_args(LAS unsigned char* lds) {
    const volatile LAS unsigned* T = (const volatile LAS unsigned*)(lds + MISC_OFF) + MW_ARGS;
    Args a;
    a.x = (const float*)ld_argp(T, 0); a.c = (const float*)ld_argp(T, 1); a.pos = (const int*)ld_argp(T, 2); a.w_mod = (const float*)ld_argp(T, 3); a.b_mod = (const float*)ld_argp(T, 4);
    a.norm1_w = (const float*)ld_argp(T, 5); a.w_in = (const float*)ld_argp(T, 6); a.gla_wa2 = (const float*)ld_argp(T, 7); a.gla_ba2 = (const float*)ld_argp(T, 8); a.hg_lb = (const float*)ld_argp(T, 9);
    a.gla_norm_w = (const float*)ld_argp(T, 10); a.hg_norm_w = (const float*)ld_argp(T, 11); a.w_out = (const float*)ld_argp(T, 12); a.norm2_w = (const float*)ld_argp(T, 13); a.w_r = (const float*)ld_argp(T, 14);
    a.b_r = (const float*)ld_argp(T, 15); a.w_gu = (const float*)ld_argp(T, 16); a.b_gu = (const float*)ld_argp(T, 17); a.w_dn = (const float*)ld_argp(T, 18); a.b_dn = (const float*)ld_argp(T, 19);
    a.final_norm_w = (const float*)ld_argp(T, 20); a.out = (float*)ld_argp(T, 21); a.ws = (unsigned char*)ld_argp(T, 22); a.ph_lo = 0; a.ph_hi = 0;
    return a;
}
#define PH_CTX() { unsigned l_ = (unsigned)(size_t)lds; asm volatile("" : "+s"(l_)); lds = (LAS unsigned char*)(size_t)l_; } const Args args = load_args(lds); volatile LAS unsigned* MISC = (volatile LAS unsigned*)(lds + MISC_OFF); int tid_ = wv * 64 + (int)__builtin_amdgcn_mbcnt_hi(~0u, __builtin_amdgcn_mbcnt_lo(~0u, 0u)); asm volatile("" : "+v"(tid_)); const int tid = tid_, lane = tid & 63, wave = __builtin_amdgcn_readfirstlane(tid >> 6); \
    const int G = gridDim.x; const int bx = blockIdx.x; const int vcu = (G % 8 == 0) ? (bx % 8) * (G / 8) + bx / 8 : bx; unsigned char* ws = args.ws; gu32* ctl = (gu32*)(ws + WS_CTL); \
    (void)MISC; (void)lane; (void)wave; (void)vcu; (void)ctl; (void)bx; (void)tid
__device__ __forceinline__ void ph_p0(LAS unsigned char* lds, int wv) { PH_CTX(); p0_prologue(args, lds, vcu, G, tid, lane, wave); }
__device__ __forceinline__ void ph_p1(LAS unsigned char* lds, int wv, int layer_) { int layer = __builtin_amdgcn_readfirstlane(layer_); asm volatile("" : "+s"(layer)); PH_CTX(); rows_mfma<16>(args, layer, lds, MISC, ctl, vcu, G, tid, lane, wave); }
__device__ __forceinline__ void ph_p2(LAS unsigned char* lds, int wv, int layer_) { int layer = __builtin_amdgcn_readfirstlane(layer_); asm volatile("" : "+s"(layer)); PH_CTX();
    pg8::Gemm g{(const bf16*)(ws + WS_H), (const bf16*)(ws + WS_WIN + (size_t)layer * NPROJ * D * (F8_IN ? 1 : 2)), MTOK, NPROJ, F8_IN ? D / 2 : D}; pg8::StaticOrder S; S.init(MTOK, NPROJ, G, bx);
    pg8::EpiBf16Plain E{(bf16*)(ws + WS_PROJ), NPROJ, F8_IN ? 1.0f / (S8_H * S8_W) : 1.0f};
    pg8::gemm_phase<pg8::EpiBf16Plain, pg8::StaticOrder, true, true, F8_IN>(lds, g, S, E, tid); }
__device__ __forceinline__ void ph_p3a(LAS unsigned char* lds, int wv, int layer_) { int layer = __builtin_amdgcn_readfirstlane(layer_); asm volatile("" : "+s"(layer)); PH_CTX(); p3a_summaries(args, layer, lds, vcu, G, tid, lane, wave); }
__device__ __forceinline__ void ph_p3b(LAS unsigned char* lds, int wv) { PH_CTX(); p3b_scan(args, vcu, G, tid); }
__device__ __forceinline__ void ph_p3c(LAS unsigned char* lds, int wv, int layer_) { int layer = __builtin_amdgcn_readfirstlane(layer_); asm volatile("" : "+s"(layer)); PH_CTX(); p3c_outputs(args, layer, lds, vcu, G, tid, lane, wave); }
__device__ __forceinline__ void ph_p4(LAS unsigned char* lds, int wv, int layer_) { int layer = __builtin_amdgcn_readfirstlane(layer_); asm volatile("" : "+s"(layer)); PH_CTX();
    pg8::Gemm g{(const bf16*)(ws + WS_MIX), (const bf16*)(ws + WS_WOUT + (size_t)layer * D * D * (F8_OUT ? 1 : 2)), MTOK, D, F8_OUT ? D / 2 : D}; pg8::StaticOrder S; S.init(MTOK, D, G, bx);
    pg8::EpiResGate E{(layer == 0) ? args.x : (const float*)(ws + WS_X), (float*)(ws + WS_X), D, (const float*)(ws + WS_MOD) + (size_t)layer * 2 * 6144 + 2 * D, 6144, SEQ, F8_OUT ? 1.0f / (S8_M * S8_W) : 1.0f};
    pg8::gemm_phase<pg8::EpiResGate, pg8::StaticOrder, true, true, F8_OUT>(lds, g, S, E, tid); }
__device__ __forceinline__ void ph_p5(LAS unsigned char* lds, int wv, int layer_) { int layer = __builtin_amdgcn_readfirstlane(layer_); asm volatile("" : "+s"(layer)); PH_CTX(); rows_mfma<32>(args, layer, lds, MISC, ctl, vcu, G, tid, lane, wave); }
__device__ __forceinline__ void ph_p7(LAS unsigned char* lds, int wv, int layer_) { int layer = __builtin_amdgcn_readfirstlane(layer_); asm volatile("" : "+s"(layer)); PH_CTX();
    moe_tables(ctl, layer, MISC, tid);
    const int nrt = __builtin_amdgcn_readfirstlane((int)MISC[MW_NRT]);
    pg8::Gemm g{(const bf16*)(ws + WS_A1), (const bf16*)(ws + WS_WGU + (size_t)layer * NE * 2048 * D), nrt * 256, NE * 2048, D / 2};
    pg8::MoeOrder S{8, G, vcu, nrt * 8, (const LAS int*)(lds + MISC_OFF + 4 * MW_TILE)};
    pg8::EpiSwiglu E{ws + WS_ACT, FFN, args.b_gu + (size_t)layer * NE * 2048, 1.0f / (S8_H * S8_W), S8_A};
    pg8::gemm_phase<pg8::EpiSwiglu, pg8::MoeOrder, true, true, true>(lds, g, S, E, tid); }
__device__ __forceinline__ void ph_p8(LAS unsigned char* lds, int wv, int layer_) { int layer = __builtin_amdgcn_readfirstlane(layer_); asm volatile("" : "+s"(layer)); PH_CTX();
    moe_tables(ctl, layer, MISC, tid);
    const int nrt = __builtin_amdgcn_readfirstlane((int)MISC[MW_NRT]);
    pg8::Gemm g{(const bf16*)(ws + WS_ACT), (const bf16*)(ws + WS_WDN + (size_t)layer * NE * D * FFN), nrt * 256, NE * D, FFN / 2};
    pg8::MoeOrder S{4, G, vcu, nrt * 4, (const LAS int*)(lds + MISC_OFF + 4 * MW_TILE)};
    if constexpr (Y8) { pg8::EpiFp8Bias E{ws + WS_Y, D, args.b_dn + (size_t)layer * NE * D, D, 1.0f / (S8_A * S8_W), S8_Y};
        pg8::gemm_phase<pg8::EpiFp8Bias, pg8::MoeOrder, true, true, true>(lds, g, S, E, tid); }
    else { pg8::EpiBf16Bias E{(bf16*)(ws + WS_Y), D, args.b_dn + (size_t)layer * NE * D, D, 1.0f / (S8_A * S8_W)};
        pg8::gemm_phase<pg8::EpiBf16Bias, pg8::MoeOrder, true, true, true>(lds, g, S, E, tid); } }
__device__ __forceinline__ void ph_final(LAS unsigned char* lds, int wv) { PH_CTX(); final_rows(args, lds, vcu, G, tid, lane); }

#ifndef DBL_MASK
#define DBL_MASK 0
#endif
#if DBL_MASK
#define RUN(bit, call) do { if ((DBL_MASK >> (bit)) & 1) { const unsigned long long t0_ = __builtin_amdgcn_s_memrealtime(); call; const unsigned long long t1_ = __builtin_amdgcn_s_memrealtime(); \
        while (__builtin_amdgcn_s_memrealtime() - t1_ < t1_ - t0_) __builtin_amdgcn_s_sleep(8); } else { call; } } while (0)
#else
#define RUN(bit, call) do { call; } while (0)
#endif
__global__ void __launch_bounds__(NTHR, 2) hybrid_fwd(Args args) {
    extern __shared__ __attribute__((aligned(16))) unsigned char lds_raw[];
    LAS unsigned char* lds = (LAS unsigned char*)lds_raw;
    volatile LAS unsigned* MISC = (volatile LAS unsigned*)(lds + MISC_OFF);
    const int tid = threadIdx.x; const int wv = __builtin_amdgcn_readfirstlane(tid >> 6);
    gu32* ctl = (gu32*)(args.ws + WS_CTL);
    for (int u = tid; u < (LDS_BYTES - MISC_OFF) / 4; u += NTHR) MISC[u] = 0u;
    __syncthreads();
    if (tid == 0) {
#define ST_ARG(i, p) do { const unsigned long long v_ = (unsigned long long)(p); MISC[MW_ARGS + 2 * (i)] = (unsigned)v_; MISC[MW_ARGS + 2 * (i) + 1] = (unsigned)(v_ >> 32); } while (0)
        ST_ARG(0, args.x); ST_ARG(1, args.c); ST_ARG(2, args.pos); ST_ARG(3, args.w_mod); ST_ARG(4, args.b_mod); ST_ARG(5, args.norm1_w); ST_ARG(6, args.w_in); ST_ARG(7, args.gla_wa2); ST_ARG(8, args.gla_ba2);
        ST_ARG(9, args.hg_lb); ST_ARG(10, args.gla_norm_w); ST_ARG(11, args.hg_norm_w); ST_ARG(12, args.w_out); ST_ARG(13, args.norm2_w); ST_ARG(14, args.w_r); ST_ARG(15, args.b_r); ST_ARG(16, args.w_gu);
        ST_ARG(17, args.b_gu); ST_ARG(18, args.w_dn); ST_ARG(19, args.b_dn); ST_ARG(20, args.final_norm_w); ST_ARG(21, args.out); ST_ARG(22, args.ws);
#undef ST_ARG
    }
    __syncthreads();
    const int lo = args.ph_lo, hi = args.ph_hi;
    const bool multi = (hi - lo) > 1;
    XcdBarrier bar; bar.bar = (unsigned*)(ctl + CW_BAR); bar.x = 0; bar.st = nullptr;
    if (multi) bar = xcd_barrier_post((unsigned*)(ctl + CW_BAR), MISC + MW_BAR);
#define IN(k) (lo <= (k) && (k) < hi)
#define SEAM(k) do { if (IN(k) && IN((k) + 1)) xcd_barrier(bar); } while (0)

    if (IN(0)) RUN(0, ph_p0(lds, wv));
    SEAM(0);
    for (int layer = 0; layer < DEPTH; ++layer) {
        const int pb = 1 + 9 * layer;
        if (IN(pb + 0)) RUN(1, ph_p1(lds, wv, layer));
        SEAM(pb + 0);
        if (IN(pb + 1)) RUN(2, ph_p2(lds, wv, layer));
        SEAM(pb + 1);
        if (IN(pb + 2)) RUN(3, ph_p3a(lds, wv, layer));
        SEAM(pb + 2);
        if (IN(pb + 3)) RUN(4, ph_p3b(lds, wv));
        SEAM(pb + 3);
        if (IN(pb + 4)) RUN(5, ph_p3c(lds, wv, layer));
        SEAM(pb + 4);
        if (IN(pb + 5)) RUN(6, ph_p4(lds, wv, layer));
        SEAM(pb + 5);
        if (IN(pb + 6)) RUN(7, ph_p5(lds, wv, layer));
        SEAM(pb + 6);
        if (IN(pb + 7)) RUN(9, ph_p7(lds, wv, layer));
        SEAM(pb + 7);
        if (IN(pb + 8)) RUN(10, ph_p8(lds, wv, layer));
        SEAM(pb + 8);
    }
    if (IN(NPHASE - 1)) RUN(11, ph_final(lds, wv));
#undef IN
#undef SEAM
}

#ifndef MK_SINGLE
#define MK_SINGLE 1
#endif
extern "C" void kernel_launch(void* const* d_in, const int* in_sizes, int n_in, void* d_out, int out_size, void* d_ws, size_t ws_size, hipStream_t stream) {
    static int grid = 0;
    if (grid == 0) {
        if (n_in != 21 || in_sizes[0] != MTOK * D || out_size != MTOK * D || ws_size < WS_END) { fprintf(stderr, "kernel_launch: unexpected problem shape (n_in %d, in0 %d, out %d, ws %zu)\n", n_in, n_in > 0 ? in_sizes[0] : -1, out_size, ws_size); grid = -1; return; }
        int dev = 0, cus = 0, per_cu = 0;
        if (hipGetDevice(&dev) != hipSuccess || hipDeviceGetAttribute(&cus, hipDeviceAttributeMultiprocessorCount, dev) != hipSuccess) { grid = -1; return; }
        if (hipFuncSetAttribute((const void*)hybrid_fwd, hipFuncAttributeMaxDynamicSharedMemorySize, LDS_BYTES) != hipSuccess) { fprintf(stderr, "kernel_launch: hipFuncSetAttribute failed\n"); grid = -1; return; }
        if (hipOccupancyMaxActiveBlocksPerMultiprocessor(&per_cu, (const void*)hybrid_fwd, NTHR, LDS_BYTES) != hipSuccess || per_cu < 1) fprintf(stderr, "kernel_launch: occupancy query says %d\n", per_cu);
        (void)hipGetLastError();
        grid = cus;
    }
    if (grid < 0) return;
    (void)hipMemsetAsync((char*)d_ws + WS_CTL, 0, CTL_ZERO_BYTES, stream);
    Args a{};
    a.x = (const float*)d_in[0]; a.c = (const float*)d_in[1]; a.pos = (const int*)d_in[2]; a.w_mod = (const float*)d_in[3]; a.b_mod = (const float*)d_in[4]; a.norm1_w = (const float*)d_in[5];
    a.w_in = (const float*)d_in[6]; a.gla_wa2 = (const float*)d_in[7]; a.gla_ba2 = (const float*)d_in[8]; a.hg_lb = (const float*)d_in[9]; a.gla_norm_w = (const float*)d_in[10]; a.hg_norm_w = (const float*)d_in[11];
    a.w_out = (const float*)d_in[12]; a.norm2_w = (const float*)d_in[13]; a.w_r = (const float*)d_in[14]; a.b_r = (const float*)d_in[15]; a.w_gu = (const float*)d_in[16]; a.b_gu = (const float*)d_in[17];
    a.w_dn = (const float*)d_in[18]; a.b_dn = (const float*)d_in[19]; a.final_norm_w = (const float*)d_in[20]; a.out = (float*)d_out; a.ws = (unsigned char*)d_ws;
#if MK_SINGLE
    a.ph_lo = 0; a.ph_hi = NPHASE;
    hipLaunchKernelGGL(hybrid_fwd, dim3(grid), dim3(NTHR), LDS_BYTES, stream, a);
#else
    for (int p = 0; p < NPHASE; ++p) { a.ph_lo = p; a.ph_hi = p + 1; hipLaunchKernelGGL(hybrid_fwd, dim3(grid), dim3(NTHR), LDS_BYTES, stream, a); }
#endif
}
```

```cpp
#include <hip/hip_runtime.h>
#include <cstdio>
#include <cstdint>
namespace pg8 {
#define PG8_LAS __attribute__((address_space(3)))
typedef unsigned short bf16_t;
typedef short bf16x8 __attribute__((ext_vector_type(8)));
typedef float f32x4 __attribute__((ext_vector_type(4)));
typedef unsigned u32x4 __attribute__((ext_vector_type(4)));
constexpr int BM = 256, BK = 64, HALF = 128, HTB = HALF * BK * 2  , STAGE_BYTES = 8 * HTB, NXCD = 8, WGM = 8;

__host__ __device__ __forceinline__ int lds_byte(int r, int c) { const int st = (r >> 4) * 2 + (c >> 5), rr = r & 15, cc = c & 31, ob = rr * 64 + cc * 2; return st * 1024 + (ob ^ (((ob >> 9) & 1) << 5)); }
__host__ __device__ __forceinline__ void stage_rc(int b, int& R, int& C) { const int st = b / 1024, sb = b % 1024, swz = sb ^ (((sb >> 9) & 1) << 5); R = (st >> 1) * 16 + swz / 64; C = (st & 1) * 32 + (swz % 64) / 2; }
__host__ __device__ __forceinline__ int perm32(int rho) { const int n = rho >> 4, i = rho & 15; return 8 * (i >> 2) + 4 * n + (i & 3); }

struct Unit { int pm, pn, e, pl; };
struct Gemm { const bf16_t* A; const bf16_t* Bt; int M, N, K; };

struct StaticOrder {
    int nM, nN, nwg, G, c;
    __host__ __device__ void init(int M, int N, int G_, int c_) { nM = M / BM; nN = N / BM; nwg = nM * nN; G = G_; c = c_; }
    __host__ __device__ bool next(int i, Unit& u) const {
        const long L = (long)i * G + c; if (L >= nwg) return false;
        int wgid = (int)L; { const int q = nwg / NXCD, r = nwg % NXCD, xcd = wgid % NXCD, off = wgid / NXCD; wgid = (xcd < r ? xcd * (q + 1) : r * (q + 1) + (xcd - r) * q) + off; }
        const int nig = WGM * nN, gid = wgid / nig, fm = gid * WGM, gsz = (nM - fm) < WGM ? (nM - fm) : WGM;
        u.pm = fm + ((wgid % nig) % gsz); u.pn = (wgid % nig) / gsz; u.e = 0; u.pl = u.pn; return true;
    }
    __device__ __forceinline__ void a_ready(const Unit&) const {}
    __device__ __forceinline__ void done(const Unit&) const {}
};

__device__ __forceinline__ unsigned cvt_pk_bf16(float lo, float hi) { unsigned r; asm volatile("v_cvt_pk_bf16_f32 %0, %1, %2" : "=v"(r) : "v"(lo), "v"(hi)); return r; }

struct EpiBf16Plain {
    static constexpr bool PERM = true, AFTER_DRAIN = false;
    bf16_t* O; int ldc; float sc;
    __device__ __forceinline__ void operator()(const f32x4 (&acc)[2][2][4][2], const Unit& u, int wr, int wc, int fr, int fq) const {
        const int row0 = u.pm * BM + wr * 64 + fr; const int col0 = u.pn * BM + wc * 32 + 8 * fq;
#pragma unroll
        for (int ai = 0; ai < 2; ++ai)
#pragma unroll
            for (int m = 0; m < 4; ++m) { bf16_t* rowp = O + (size_t)(row0 + ai * HALF + m * 16) * ldc + col0;
#pragma unroll
                for (int bj = 0; bj < 2; ++bj) { const f32x4 v0 = acc[ai][bj][m][0] * sc, v1 = acc[ai][bj][m][1] * sc;
                    u32x4 w; w.x = cvt_pk_bf16(v0[0], v0[1]); w.y = cvt_pk_bf16(v0[2], v0[3]); w.z = cvt_pk_bf16(v1[0], v1[1]); w.w = cvt_pk_bf16(v1[2], v1[3]);
                    *(u32x4*)(rowp + bj * HALF) = w; } }
    }
};
struct EpiResGate {
    static constexpr bool PERM = false, AFTER_DRAIN = false;
    const float* base; float* out; int ldc; const float* gate; int gpitch; int rows_per_batch; float sc;
    __device__ __forceinline__ void operator()(const f32x4 (&acc)[2][2][4][2], const Unit& u, int wr, int wc, int fr, int fq) const {
        const int row0 = u.pm * BM + wr * 64 + fr, col0 = u.pn * BM + wc * 32 + 4 * fq;
        const float* gp = gate + (size_t)((u.pm * BM) / rows_per_batch) * gpitch + col0;
        f32x4 gv[2][2];
#pragma unroll
        for (int bj = 0; bj < 2; ++bj)
#pragma unroll
            for (int n = 0; n < 2; ++n) gv[bj][n] = *(const f32x4*)(gp + bj * HALF + n * 16) * sc;
#pragma unroll
        for (int ai = 0; ai < 2; ++ai)
#pragma unroll
            for (int m = 0; m < 4; ++m) { const size_t off = (size_t)(row0 + ai * HALF + m * 16) * ldc + col0;
#pragma unroll
                for (int bj = 0; bj < 2; ++bj)
#pragma unroll
                    for (int n = 0; n < 2; ++n) { const f32x4 bs = *(const f32x4*)(base + off + bj * HALF + n * 16);
                        *(f32x4*)(out + off + bj * HALF + n * 16) = bs + gv[bj][n] * acc[ai][bj][m][n]; }
                asm volatile("" ::: "memory"); }
    }
};
struct EpiSwiglu {
    static constexpr bool PERM = true, AFTER_DRAIN = false;
    unsigned char* O; int ldc; const float* bias; float inv_in, out_scale;
    __device__ __forceinline__ float act1(float g, float up) const {
        g = fminf(g, 7.0f); up = fminf(fmaxf(up, -7.0f), 7.0f);
        const float s = 1.0f / (1.0f + __expf(-1.702f * g));
        return fminf(fmaxf((up + 1.0f) * g * s * out_scale, -448.f), 448.f);
    }
    __device__ __forceinline__ void operator()(const f32x4 (&acc)[2][2][4][2], const Unit& u, int wr, int wc, int fr, int fq) const {
        const int row0 = u.pm * BM + wr * 64 + fr; const int jj0 = wc * 32 + 8 * fq; const int col0 = u.pl * HALF + jj0;
        const float* bp = bias + (size_t)u.e * 2048 + col0;
        f32x4 bg[2], bu[2];
#pragma unroll
        for (int n = 0; n < 2; ++n) { bg[n] = *(const f32x4*)(bp + 4 * n); bu[n] = *(const f32x4*)(bp + 1024 + 4 * n); }
#pragma unroll
        for (int ai = 0; ai < 2; ++ai)
#pragma unroll
            for (int m = 0; m < 4; ++m) { unsigned char* rowp = O + (size_t)(row0 + ai * HALF + m * 16) * ldc + col0;
                f32x4 r[2];
#pragma unroll
                for (int n = 0; n < 2; ++n) { const f32x4 g = acc[ai][0][m][n] * inv_in + bg[n], up = acc[ai][1][m][n] * inv_in + bu[n];
#pragma unroll
                    for (int j = 0; j < 4; ++j) r[n][j] = act1(g[j], up[j]); }
                int w0 = 0, w1 = 0;
                w0 = __builtin_amdgcn_cvt_pk_fp8_f32(r[0][0], r[0][1], w0, false); w0 = __builtin_amdgcn_cvt_pk_fp8_f32(r[0][2], r[0][3], w0, true);
                w1 = __builtin_amdgcn_cvt_pk_fp8_f32(r[1][0], r[1][1], w1, false); w1 = __builtin_amdgcn_cvt_pk_fp8_f32(r[1][2], r[1][3], w1, true);
                typedef int i32x2 __attribute__((ext_vector_type(2))); *(i32x2*)rowp = (i32x2){w0, w1}; }
    }
};
struct EpiBf16Bias {
    static constexpr bool PERM = true, AFTER_DRAIN = false;
    bf16_t* O; int ldc; const float* bias; int bpitch; float inv_in;
    __device__ __forceinline__ void operator()(const f32x4 (&acc)[2][2][4][2], const Unit& u, int wr, int wc, int fr, int fq) const {
        const int row0 = u.pm * BM + wr * 64 + fr; const int col0 = u.pl * BM + wc * 32 + 8 * fq;
        const float* bp = bias + (size_t)u.e * bpitch + col0;
        f32x4 bv[2][2];
#pragma unroll
        for (int bj = 0; bj < 2; ++bj)
#pragma unroll
            for (int n = 0; n < 2; ++n) bv[bj][n] = *(const f32x4*)(bp + bj * HALF + 4 * n);
#pragma unroll
        for (int ai = 0; ai < 2; ++ai)
#pragma unroll
            for (int m = 0; m < 4; ++m) { bf16_t* rowp = O + (size_t)(row0 + ai * HALF + m * 16) * ldc + col0;
#pragma unroll
                for (int bj = 0; bj < 2; ++bj) { const f32x4 v0 = acc[ai][bj][m][0] * inv_in + bv[bj][0], v1 = acc[ai][bj][m][1] * inv_in + bv[bj][1];
                    u32x4 w; w.x = cvt_pk_bf16(v0[0], v0[1]); w.y = cvt_pk_bf16(v0[2], v0[3]); w.z = cvt_pk_bf16(v1[0], v1[1]); w.w = cvt_pk_bf16(v1[2], v1[3]);
                    *(u32x4*)(rowp + bj * HALF) = w; } }
    }
};
struct EpiFp8Bias {
    static constexpr bool PERM = true, AFTER_DRAIN = false;
    unsigned char* O; int ldc; const float* bias; int bpitch; float inv_in, out_scale;
    __device__ __forceinline__ int pk4(f32x4 v) const { int w = 0; w = __builtin_amdgcn_cvt_pk_fp8_f32(fminf(fmaxf(v[0], -448.f), 448.f), fminf(fmaxf(v[1], -448.f), 448.f), w, false);
        return __builtin_amdgcn_cvt_pk_fp8_f32(fminf(fmaxf(v[2], -448.f), 448.f), fminf(fmaxf(v[3], -448.f), 448.f), w, true); }
    __device__ __forceinline__ void operator()(const f32x4 (&acc)[2][2][4][2], const Unit& u, int wr, int wc, int fr, int fq) const {
        const int row0 = u.pm * BM + wr * 64 + fr; const int col0 = u.pl * BM + wc * 32 + 8 * fq;
        const float* bp = bias + (size_t)u.e * bpitch + col0;
        f32x4 bv[2][2];
#pragma unroll
        for (int bj = 0; bj < 2; ++bj)
#pragma unroll
            for (int n = 0; n < 2; ++n) bv[bj][n] = *(const f32x4*)(bp + bj * HALF + 4 * n);
#pragma unroll
        for (int ai = 0; ai < 2; ++ai)
#pragma unroll
            for (int m = 0; m < 4; ++m) { unsigned char* rowp = O + (size_t)(row0 + ai * HALF + m * 16) * ldc + col0;
#pragma unroll
                for (int bj = 0; bj < 2; ++bj) { const f32x4 v0 = (acc[ai][bj][m][0] * inv_in + bv[bj][0]) * out_scale, v1 = (acc[ai][bj][m][1] * inv_in + bv[bj][1]) * out_scale;
                    typedef int i32x2 __attribute__((ext_vector_type(2))); *(i32x2*)(rowp + bj * HALF) = (i32x2){pk4(v0), pk4(v1)}; } }
    }
};
struct MoeOrder {
    int nN, G, c, nunits; const PG8_LAS int* tile_pm;
    __device__ __forceinline__ bool next(int i, Unit& u) const {
        const int L = i * G + c; if (L >= nunits) return false;
        const int idx = L / nN, pl = L - idx * nN, pm = __builtin_amdgcn_readfirstlane(tile_pm[idx]), e = pm >> 6;
        u.pm = pm; u.pl = pl; u.e = e; u.pn = e * nN + pl; return true;
    }
    __device__ __forceinline__ void a_ready(const Unit&) const {}
    __device__ __forceinline__ void done(const Unit&) const {}
};
typedef int v4i32_t __attribute__((ext_vector_type(4)));
typedef int v8i32_t __attribute__((ext_vector_type(8)));
template <class Epi, class Sched, bool ALIGN_EPI = false, bool SP2 = false, bool FP8 = false>
__device__ __forceinline__ void gemm_phase(PG8_LAS unsigned char* lds, const Gemm g, const Sched& S, const Epi& E, int tid_in) {
    int tid_ = tid_in; asm volatile("" : "+v"(tid_)); const int tid = tid_, wid = __builtin_amdgcn_readfirstlane(tid >> 6), lane = tid & 63, wr = wid >> 2, wc = wid & 3, fr = lane & 15, fq = lane >> 4;
    const int K = g.K, nt = K / BK;
    unsigned voffA, voffB;
    { int R, C; stage_rc(tid * 16, R, C); const int Rb = Epi::PERM ? ((R & ~31) + perm32(R & 31)) : R;
        voffA = (unsigned)(R * K + C) * 2u; voffB = (unsigned)(Rb * K + C) * 2u; }
    const size_t rstep = (size_t)64 * K * 2;
    const size_t kstep = (size_t)(BK * 2);
    const size_t hstep = (size_t)HALF * K * 2;
    const size_t tstep = 2 * hstep;
    const unsigned ldsw = (unsigned)wid * 1024u;
    const int aoff = lds_byte(wr * 64 + fr, fq * 8), boff = lds_byte(wc * 32 + fr, fq * 8);
#define PG8_SA(b, h) (((b) * 2 + (h)) * HTB)
#define PG8_SB(b, h) ((4 + (b) * 2 + (h)) * HTB)
#define PG8_STAGE(bufoff, gbase, voff) do { _Pragma("unroll") for (int _i = 0; _i < 2; ++_i) \
        __builtin_amdgcn_global_load_lds((const unsigned*)((const char*)(gbase) + _i * rstep + (voff)), (PG8_LAS unsigned*)(lds + (bufoff) + ldsw + _i * 8192), 16, 0, 0); } while (0)
#define PG8_LDA(dst, b, h) do { _Pragma("unroll") for (int m = 0; m < 4; ++m) _Pragma("unroll") for (int k = 0; k < 2; ++k) dst[m][k] = *(const PG8_LAS bf16x8*)(lds + PG8_SA(b, h) + aoff + m * 2048 + k * 1024); } while (0)
#define PG8_LDB(dst, b, h) do { _Pragma("unroll") for (int n = 0; n < 2; ++n) _Pragma("unroll") for (int k = 0; k < 2; ++k) dst[n][k] = *(const PG8_LAS bf16x8*)(lds + PG8_SB(b, h) + boff + n * 2048 + k * 1024); } while (0)
#define PG8_MMA(ai, bj, At, Bt) do { __builtin_amdgcn_s_setprio(1); _Pragma("unroll") for (int m = 0; m < 4; ++m) _Pragma("unroll") for (int n = 0; n < 2; ++n) { \
        if constexpr (FP8) { const v8i32_t a8_ = __builtin_shufflevector(__builtin_bit_cast(v4i32_t, At[m][0]), __builtin_bit_cast(v4i32_t, At[m][1]), 0, 1, 2, 3, 4, 5, 6, 7); \
            const v8i32_t b8_ = __builtin_shufflevector(__builtin_bit_cast(v4i32_t, Bt[n][0]), __builtin_bit_cast(v4i32_t, Bt[n][1]), 0, 1, 2, 3, 4, 5, 6, 7); \
            asm volatile("v_mfma_scale_f32_16x16x128_f8f6f4 %0, %1, %2, %0, %3, %3 op_sel_hi:[0,0,0]" : "+v"(acc[ai][bj][m][n]) : "v"(b8_), "v"(a8_), "v"(one8_)); } \
        else { _Pragma("unroll") for (int k = 0; k < 2; ++k) acc[ai][bj][m][n] = __builtin_amdgcn_mfma_f32_16x16x32_bf16(Bt[n][k], At[m][k], acc[ai][bj][m][n], 0, 0, 0); } } \
        __builtin_amdgcn_s_setprio(0); } while (0)
#define PG8_WAIT_V(n) asm volatile("s_waitcnt vmcnt(" #n ")" ::: "memory")
#define PG8_WAIT_L(n) asm volatile("s_waitcnt lgkmcnt(" #n ")" ::: "memory")
#define PG8_BAR __builtin_amdgcn_s_barrier()
#define PG8_SCHED __builtin_amdgcn_sched_barrier(0)
    Unit cur, nxt; int ui = 0;
    if (!S.next(0, cur)) return;
    f32x4 acc[2][2][4][2];
#pragma unroll
    for (int a = 0; a < 2; ++a)
#pragma unroll
        for (int b = 0; b < 2; ++b)
#pragma unroll
            for (int m = 0; m < 4; ++m)
#pragma unroll
                for (int n = 0; n < 2; ++n) acc[a][b][m][n] = (f32x4){0.f, 0.f, 0.f, 0.f};
    bf16x8 At[4][2], B0[2][2], B1[2][2];
    int one8_ = 0x7f7f7f7f; asm volatile("" : "+v"(one8_));
    const char* cA = (const char*)g.A + (size_t)cur.pm * tstep; const char* cB = (const char*)g.Bt + (size_t)cur.pn * tstep;
    S.a_ready(cur);
    if constexpr (SP2) {
        PG8_STAGE(PG8_SB(0, 0), cB, voffB); PG8_STAGE(PG8_SB(0, 1), cB + hstep, voffB); PG8_STAGE(PG8_SA(0, 0), cA, voffA); PG8_STAGE(PG8_SA(0, 1), cA + hstep, voffA);
        if (wr == 1) PG8_BAR;
        PG8_WAIT_V(2); PG8_BAR;
        PG8_STAGE(PG8_SB(1, 0), cB + kstep, voffB); PG8_STAGE(PG8_SA(1, 0), cA + kstep, voffA); PG8_STAGE(PG8_SB(1, 1), cB + hstep + kstep, voffB);
        PG8_WAIT_V(6); PG8_BAR;
    } else {
        PG8_STAGE(PG8_SB(0, 0), cB, voffB); PG8_STAGE(PG8_SA(0, 0), cA, voffA); PG8_STAGE(PG8_SB(0, 1), cB + hstep, voffB); PG8_STAGE(PG8_SA(0, 1), cA + hstep, voffA);
        if (wr == 1) PG8_BAR;
        PG8_WAIT_V(4); PG8_BAR;
        PG8_STAGE(PG8_SB(1, 0), cB + kstep, voffB); PG8_STAGE(PG8_SA(1, 0), cA + kstep, voffA); PG8_STAGE(PG8_SB(1, 1), cB + hstep + kstep, voffB);
        PG8_WAIT_V(6); PG8_BAR;
    }
    for (;;) {
        const bool has_next = S.next(ui + 1, nxt);
        const char* nA = has_next ? (const char*)g.A + (size_t)nxt.pm * tstep : cA; const char* nB = has_next ? (const char*)g.Bt + (size_t)nxt.pn * tstep : cB;
#pragma unroll 1
        for (int t = 0; t < nt; t += 2) {
            const bool last = (t == nt - 2);
            const char* a1 = cA + (size_t)(t + 1) * kstep;
            const char* a2 = last ? nA : cA + (size_t)(t + 2) * kstep; const char* b2 = last ? nB : cB + (size_t)(t + 2) * kstep;
            const char* a3 = a2 + kstep; const char* b3 = b2 + kstep;
            if (last && has_next) S.a_ready(nxt);
            if constexpr (SP2) {
            PG8_LDB(B0, 0, 0); PG8_LDB(B1, 0, 1); PG8_SCHED; PG8_LDA(At, 0, 0); PG8_STAGE(PG8_SA(1, 1), a1 + hstep, voffA);
            PG8_WAIT_V(8); PG8_WAIT_L(0); PG8_BAR; PG8_MMA(0, 0, At, B0); PG8_MMA(0, 1, At, B1); PG8_BAR; PG8_SCHED;
            PG8_LDA(At, 0, 1); PG8_STAGE(PG8_SB(0, 0), b2, voffB); PG8_STAGE(PG8_SB(0, 1), b2 + hstep, voffB); PG8_STAGE(PG8_SA(0, 0), a2, voffA);
            PG8_WAIT_V(8); PG8_WAIT_L(0); PG8_BAR; PG8_MMA(1, 0, At, B0); PG8_MMA(1, 1, At, B1); PG8_BAR; PG8_SCHED;
            PG8_LDB(B0, 1, 0); PG8_LDB(B1, 1, 1); PG8_SCHED; PG8_LDA(At, 1, 0); PG8_STAGE(PG8_SA(0, 1), a2 + hstep, voffA);
            PG8_WAIT_V(8); PG8_WAIT_L(0); PG8_BAR; PG8_MMA(0, 0, At, B0); PG8_MMA(0, 1, At, B1); PG8_BAR; PG8_SCHED;
            PG8_LDA(At, 1, 1); PG8_STAGE(PG8_SB(1, 0), b3, voffB); PG8_STAGE(PG8_SB(1, 1), b3 + hstep, voffB); PG8_STAGE(PG8_SA(1, 0), a3, voffA);
            PG8_WAIT_V(8); PG8_WAIT_L(0); PG8_BAR; PG8_MMA(1, 0, At, B0); PG8_MMA(1, 1, At, B1); PG8_BAR; PG8_SCHED;
            } else {
            PG8_LDB(B0, 0, 0); PG8_SCHED; PG8_LDA(At, 0, 0); PG8_STAGE(PG8_SA(1, 1), a1 + hstep, voffA);
            PG8_WAIT_L(8); PG8_BAR; PG8_WAIT_L(0); PG8_MMA(0, 0, At, B0); PG8_BAR; PG8_SCHED;
            PG8_LDB(B1, 0, 1); PG8_STAGE(PG8_SB(0, 0), b2, voffB);
            PG8_BAR; PG8_WAIT_L(0); PG8_MMA(0, 1, At, B1); PG8_BAR;
            PG8_LDA(At, 0, 1); PG8_STAGE(PG8_SA(0, 0), a2, voffA);
            PG8_BAR; PG8_WAIT_L(0); PG8_MMA(1, 0, At, B0); PG8_BAR; PG8_SCHED;
            PG8_STAGE(PG8_SB(0, 1), b2 + hstep, voffB);
            PG8_WAIT_V(6); PG8_BAR; PG8_MMA(1, 1, At, B1); PG8_BAR;
            PG8_LDB(B0, 1, 0); PG8_SCHED; PG8_LDA(At, 1, 0); PG8_STAGE(PG8_SA(0, 1), a2 + hstep, voffA);
            PG8_WAIT_L(8); PG8_BAR; PG8_WAIT_L(0); PG8_MMA(0, 0, At, B0); PG8_BAR; PG8_SCHED;
            PG8_LDB(B1, 1, 1); PG8_STAGE(PG8_SB(1, 0), b3, voffB);
            PG8_BAR; PG8_WAIT_L(0); PG8_MMA(0, 1, At, B1); PG8_BAR;
            PG8_LDA(At, 1, 1); PG8_STAGE(PG8_SA(1, 0), a3, voffA);
            PG8_BAR; PG8_WAIT_L(0); PG8_MMA(1, 0, At, B0); PG8_BAR; PG8_SCHED;
            PG8_STAGE(PG8_SB(1, 1), b3 + hstep, voffB);
            PG8_WAIT_V(6); PG8_BAR; PG8_MMA(1, 1, At, B1); PG8_BAR;
            }
        }
        if constexpr (FP8) asm volatile("s_nop 7\n\ts_nop 7" ::: "memory");
        if constexpr (ALIGN_EPI) { if (wr == 0) PG8_BAR; }
        if constexpr (!Epi::AFTER_DRAIN) { int ln_ = (int)__builtin_amdgcn_mbcnt_hi(~0u, __builtin_amdgcn_mbcnt_lo(~0u, 0u)); asm volatile("" : "+v"(ln_)); E(acc, cur, wr, wc, ln_ & 15, ln_ >> 4); S.done(cur); }
        if (!has_next) break;
#pragma unroll
        for (int a = 0; a < 2; ++a)
#pragma unroll
            for (int b = 0; b < 2; ++b)
#pragma unroll
                for (int m = 0; m < 4; ++m)
#pragma unroll
                    for (int n = 0; n < 2; ++n) acc[a][b][m][n] = (f32x4){0.f, 0.f, 0.f, 0.f};
        cur = nxt; cA = nA; cB = nB; ++ui;
        if constexpr (ALIGN_EPI) { if (wr == 1) PG8_BAR; }
    }
    PG8_WAIT_V(0);
    if constexpr (!ALIGN_EPI) { if (wr == 0) PG8_BAR; }
    PG8_BAR;
    if constexpr (Epi::AFTER_DRAIN) { E.fused(acc, cur, wr, wc, fr, fq, lds, wid, lane); S.done(cur); }
#undef PG8_SA
#undef PG8_SB
#undef PG8_STAGE
#undef PG8_LDA
#undef PG8_LDB
#undef PG8_MMA
#undef PG8_WAIT_V
#undef PG8_WAIT_L
#undef PG8_BAR
#undef PG8_SCHED
}
}

constexpr int NWAVES = 8, NTHR = 512;
constexpr int BATCH = 2, SEQ = 8192, D = 1024, DEPTH = 4, MTOK = BATCH * SEQ;
constexpr int DIN = 3344, NPROJ = 3328, SRC_GA = 1152;
constexpr int C_GQ = 0, C_GK = 192, C_GV = 384, C_GG = 768, C_HQ = 1152, C_HF = 1408, C_HI = 1664, C_HG = 1920, C_RQ = 2176, C_RK = 2368, C_RV = 2560, C_RG = 2944;
constexpr int NE = 32, FFN = 1024;
constexpr int CH = 64, NCH = SEQ / CH, NUNIT = BATCH * NCH;
constexpr int ST_GLA = 0, ST_HG = 4 * 48 * 96, ST_RET = ST_HG + 4 * 64 * 64, ST_TOT = ST_RET + 4 * 48 * 96;
constexpr int NDV = 448;
constexpr int MAXROWS = 65536 + NE * 256, MAXRT = MAXROWS / 256;
constexpr float EPS = 1e-6f;
#ifndef F8_IN_V
#define F8_IN_V false
#endif
#ifndef F8_OUT_V
#define F8_OUT_V false
#endif
constexpr bool F8_IN = F8_IN_V, F8_OUT = F8_OUT_V;
#ifndef Y8_V
#define Y8_V true
#endif
constexpr bool Y8 = Y8_V;
constexpr float S8_Y = 16.f;
constexpr float S8_M = 32.f;
constexpr float S8_W = 2048.f, S8_H = 64.f, S8_A = 8.f;
constexpr int NPHASE = 38;
constexpr int ECAP = 16384, ECAP_SH = 14;

constexpr size_t MiB = 1u << 20;
constexpr size_t WS_CTL = 0, CTL_ZERO_BYTES = 65536;
constexpr size_t WS_MOD = 1 * MiB;
constexpr size_t WS_ROPE = 2 * MiB;
constexpr size_t WS_LB = 5 * MiB;
constexpr size_t WS_WIN = 8 * MiB;
constexpr size_t WS_WOUT = 34 * MiB;
constexpr size_t WS_WGU = 42 * MiB;
constexpr size_t WS_WDN = 554 * MiB;
constexpr size_t WS_X = 810 * MiB;
constexpr size_t WS_H = 874 * MiB;
constexpr size_t WS_GA = 906 * MiB;
constexpr size_t WS_PROJ = 907 * MiB;
constexpr size_t WS_U = 1011 * MiB;
constexpr size_t WS_DVEC = 1063 * MiB;
constexpr size_t WS_SP = 1064 * MiB;
constexpr size_t WS_MIX = 1090 * MiB;
constexpr size_t WS_TOPE = 1122 * MiB;
constexpr size_t WS_TOPW = WS_TOPE + 256 * 1024;
constexpr size_t WS_SLOT = WS_TOPW + 256 * 1024;
constexpr size_t WS_A1 = 1123 * MiB;
constexpr size_t WS_ACT = 1635 * MiB;
constexpr size_t WS_Y = 2147 * MiB;
constexpr size_t WS_CUM = 3171 * MiB;
constexpr size_t WS_END = 3199 * MiB;
static_assert(WS_WIN + (size_t)DEPTH * NPROJ * D * 2 <= WS_WOUT && WS_PROJ + (size_t)MTOK * NPROJ * 2 <= WS_U && WS_U + (size_t)NUNIT * ST_TOT * 4 <= WS_DVEC && WS_SP + (size_t)NUNIT * ST_TOT * 2 <= WS_MIX && WS_A1 + (size_t)NE * ECAP * D <= WS_ACT && WS_ACT + (size_t)NE * ECAP * D <= WS_Y && WS_Y + (size_t)NE * ECAP * D * 2 <= WS_CUM, "ws map");
constexpr int CW_TMO = 0, CW_CODE = 1, CW_BAR = 4096, CW_CNT = 8192, CW_FILL = 8192 + 256;
constexpr int RING_BYTES = 131072;
constexpr int MISC_OFF = 147456, LDS_BYTES = MISC_OFF + 4096;
constexpr int MW_BAR = 0, MW_CNT = 16, MW_PST = 48, MW_HIST = 96, MW_BASE = 128, MW_TILE = 192, MW_NRT = 480, MW_SLOTS = 512;

#define GAS __attribute__((address_space(1)))
#define LAS __attribute__((address_space(3)))
typedef unsigned v4u __attribute__((ext_vector_type(4)));
typedef float f32x4 __attribute__((ext_vector_type(4)));
typedef short bf16x8 __attribute__((ext_vector_type(8)));
typedef GAS unsigned gu32;
typedef GAS unsigned long long gu64;
#define RLX_AGENT __ATOMIC_RELAXED, __HIP_MEMORY_SCOPE_AGENT
#define LDS_WAIT() asm volatile("s_waitcnt lgkmcnt(0)" ::: "memory")
#define VM_WAIT() asm volatile("s_waitcnt vmcnt(0)" ::: "memory")
__device__ __forceinline__ unsigned long long rt() { return __builtin_amdgcn_s_memrealtime(); }
typedef unsigned short bf16;
__device__ __forceinline__ unsigned f2bf(float f) { unsigned u = __builtin_bit_cast(unsigned, f); return (u + 0x7fffu + ((u >> 16) & 1u)) >> 16; }
__device__ __forceinline__ unsigned pk2(float lo, float hi) { return f2bf(lo) | (f2bf(hi) << 16); }
__device__ __forceinline__ float bf2f(bf16 b) { return __builtin_bit_cast(float, (unsigned)b << 16); }
#define XB_TMO      128
#define XB_XCNT(j)  (256  + 64 * (j))
#define XB_XSUB(j)  (1280 + 64 * (j))
#define XB_XGEN(j)  (2304 + 64 * (j))
#define XB_TOP      3328
#define XB_TOPGEN   3392
#define XCD_BAR_WORDS 3456
#define XB_SPIN_CAP (1u << 18)

__device__ __forceinline__ unsigned xb_ld(unsigned* p)              { return __hip_atomic_load(p, __ATOMIC_RELAXED, __HIP_MEMORY_SCOPE_AGENT); }
__device__ __forceinline__ unsigned xb_add(unsigned* p, unsigned v) { return __hip_atomic_fetch_add(p, v, __ATOMIC_RELAXED, __HIP_MEMORY_SCOPE_AGENT); }
__device__ __forceinline__ unsigned xb_xcc_id() { return (unsigned)__builtin_amdgcn_s_getreg((3 << 11) | 20) & 0xFu; }
#define XB_SPIN(cond, bar) do { unsigned _sp = 0; while (cond) { __builtin_amdgcn_s_sleep(1); \
    if ((++_sp & 255u) == 0u) { if (xb_ld(&(bar)[XB_TMO])) break; if (_sp > XB_SPIN_CAP) { atomicAdd(&(bar)[XB_TMO], 1u); break; } } } } while (0)

struct XcdBarrier {
    unsigned* bar; unsigned x;
    volatile LAS unsigned* st;
};

__device__ __forceinline__ XcdBarrier xcd_barrier_post(unsigned* bar, volatile LAS unsigned* st) {
    XcdBarrier b; b.bar = bar; b.x = xb_xcc_id(); b.st = st;
    if (threadIdx.x == 0) (void)xb_add(&bar[XB_XCNT(b.x)], 1u);
    return b;
}
__device__ __forceinline__ void xcd_barrier_complete(unsigned* bar, unsigned x, unsigned& nloc, unsigned& nx) {
    const unsigned G = gridDim.x * gridDim.y * gridDim.z;
    unsigned sum, cnt, mine, sp = 0u;
    for (;;) {
        sum = 0u; cnt = 0u; mine = 0u;
#pragma unroll
        for (unsigned j = 0; j < 16; ++j) { const unsigned c = xb_ld(&bar[XB_XCNT(j)]); sum += c; cnt += (c > 0u) ? 1u : 0u; mine = (j == x) ? c : mine; }
        if (sum == G) break;
        __builtin_amdgcn_s_sleep(1);
        if ((++sp & 255u) == 0u) { if (xb_ld(&bar[XB_TMO])) break; if (sp > XB_SPIN_CAP) { atomicAdd(&bar[XB_TMO], 1u); break; } }
    }
    nloc = mine > 0u ? mine : 1u; nx = cnt > 0u ? cnt : 1u;
}

__device__ __forceinline__ void xcd_barrier(const XcdBarrier& b) {
    asm volatile("s_waitcnt vmcnt(0)" ::: "memory");
    __syncthreads();
    if (threadIdx.x == 0) {
        unsigned* bar = b.bar;
        __builtin_amdgcn_s_waitcnt(0);
        unsigned nloc = b.st[0], nx = b.st[1];
        if (nloc == 0u) { xcd_barrier_complete(bar, b.x, nloc, nx); b.st[0] = nloc; b.st[1] = nx; }
        const unsigned old = xb_add(&bar[XB_XSUB(b.x)], 1u);
        const unsigned gen = old / nloc;
        if (old + 1u == (gen + 1u) * nloc) {
            __builtin_amdgcn_fence(__ATOMIC_RELEASE, "agent");
            asm volatile("s_waitcnt vmcnt(0)" ::: "memory");
            const unsigned og = xb_add(&bar[XB_TOP], 1u);
            const unsigned tg = og / nx;
            if (og + 1u == (tg + 1u) * nx) xb_add(&bar[XB_TOPGEN], 1u);
            else XB_SPIN(xb_ld(&bar[XB_TOPGEN]) == tg, bar);
            __builtin_amdgcn_fence(__ATOMIC_ACQUIRE, "agent");
            xb_add(&bar[XB_XGEN(b.x)], 1u);
            asm volatile("s_waitcnt vmcnt(0)" ::: "memory");
        } else {
            XB_SPIN(xb_ld(&bar[XB_XGEN(b.x)]) == gen, bar);
            __builtin_amdgcn_fence(__ATOMIC_ACQUIRE, "agent");
            asm volatile("s_waitcnt vmcnt(0)" ::: "memory");
        }
    }
    __syncthreads();
}

__device__ __forceinline__ float wave_sum(float v) {
#pragma unroll
    for (int o = 1; o < 64; o <<= 1) v += __shfl_xor(v, o);
    return v;
}
__device__ __forceinline__ float log_sigmoid_f(float x) { return fminf(x, 0.f) - log1pf(expf(-fabsf(x))); }
__device__ __forceinline__ float silu_f(float x) { return x / (1.0f + expf(-x)); }
__device__ __forceinline__ float sigmoid_f(float x) { return 1.0f / (1.0f + expf(-x)); }
__device__ __forceinline__ pg8::bf16x8 ldfrag(const LAS bf16* base, int stride, int r0, int k0, int lane) {
    return *(const LAS pg8::bf16x8*)(base + (r0 + (lane & 15)) * stride + k0 + 8 * (lane >> 4));
}
__device__ __forceinline__ pg8::bf16x8 pack8(const float (&v)[8]) { v4u w; w.x = pk2(v[0], v[1]); w.y = pk2(v[2], v[3]); w.z = pk2(v[4], v[5]); w.w = pk2(v[6], v[7]); return __builtin_bit_cast(pg8::bf16x8, w); }

struct Args {
    const float* x; const float* c; const int* pos; const float* w_mod; const float* b_mod; const float* norm1_w; const float* w_in; const float* gla_wa2; const float* gla_ba2; const float* hg_lb;
    const float* gla_norm_w; const float* hg_norm_w; const float* w_out; const float* norm2_w; const float* w_r; const float* b_r; const float* w_gu; const float* b_gu; const float* w_dn; const float* b_dn;
    const float* final_norm_w; float* out; unsigned char* ws; int ph_lo, ph_hi;
};

__device__ __forceinline__ void transpose_block64(const float* src, int ld, bf16* dst, LAS float* scr, int lane) {
    const int r = lane >> 4, c4 = (lane & 15) * 4;
    f32x4 v[16];
#pragma unroll
    for (int i = 0; i < 16; ++i) v[i] = __builtin_nontemporal_load((const f32x4*)(src + (size_t)(4 * i + r) * ld + c4));
#pragma unroll
    for (int i = 0; i < 16; ++i) { LAS float* w = scr + (4 * i + r) * 65 + c4; w[0] = v[i][0]; w[1] = v[i][1]; w[2] = v[i][2]; w[3] = v[i][3]; }
    LDS_WAIT(); asm volatile("" ::: "memory");
    const int kc = lane & 7;
#pragma unroll
    for (int jj = 0; jj < 8; ++jj) { const int n = (lane >> 3) + 8 * jj; const LAS float* s = scr + (8 * kc) * 65 + n;
        v4u o; o.x = pk2(s[0 * 65], s[1 * 65]); o.y = pk2(s[2 * 65], s[3 * 65]); o.z = pk2(s[4 * 65], s[5 * 65]); o.w = pk2(s[6 * 65], s[7 * 65]);
        *(GAS v4u*)(dst + (size_t)n * D + 8 * kc) = o; }
    LDS_WAIT(); asm volatile("" ::: "memory");
}
__device__ __forceinline__ int pk4_fp8(float a, float b, float c, float d) { int w = 0; w = __builtin_amdgcn_cvt_pk_fp8_f32(fminf(fmaxf(a, -448.f), 448.f), fminf(fmaxf(b, -448.f), 448.f), w, false);
    return __builtin_amdgcn_cvt_pk_fp8_f32(fminf(fmaxf(c, -448.f), 448.f), fminf(fmaxf(d, -448.f), 448.f), w, true); }
__device__ __forceinline__ void transpose_block64_fp8(const float* src, int ld, unsigned char* dst, LAS float* scr, int lane, float sc) {
    const int r = lane >> 4, c4 = (lane & 15) * 4;
    f32x4 v[16];
#pragma unroll
    for (int i = 0; i < 16; ++i) v[i] = __builtin_nontemporal_load((const f32x4*)(src + (size_t)(4 * i + r) * ld + c4));
#pragma unroll
    for (int i = 0; i < 16; ++i) { LAS float* w = scr + (4 * i + r) * 65 + c4; w[0] = v[i][0] * sc; w[1] = v[i][1] * sc; w[2] = v[i][2] * sc; w[3] = v[i][3] * sc; }
    LDS_WAIT(); asm volatile("" ::: "memory");
    const int kc = lane & 3;
#pragma unroll
    for (int jj = 0; jj < 4; ++jj) { const int n = (lane >> 2) + 16 * jj; const LAS float* s = scr + (16 * kc) * 65 + n;
        v4u o; o.x = (unsigned)pk4_fp8(s[0 * 65], s[1 * 65], s[2 * 65], s[3 * 65]); o.y = (unsigned)pk4_fp8(s[4 * 65], s[5 * 65], s[6 * 65], s[7 * 65]);
        o.z = (unsigned)pk4_fp8(s[8 * 65], s[9 * 65], s[10 * 65], s[11 * 65]); o.w = (unsigned)pk4_fp8(s[12 * 65], s[13 * 65], s[14 * 65], s[15 * 65]);
        *(GAS v4u*)(dst + (size_t)n * D + 16 * kc) = o; }
    LDS_WAIT(); asm volatile("" ::: "memory");
}
constexpr int IT_IN = 16 * (NPROJ / 64), IT_OUT = 16 * 16, IT_GU = NE * 16 * 32, IT_DN = NE * 16 * 16, IT_LAYER = IT_IN + IT_OUT + IT_GU + IT_DN, IT_ALL = DEPTH * IT_LAYER;
__device__ __forceinline__ void convert_item(const Args& a, int l, int r, LAS float* scr, int lane) {
    unsigned char* ws = a.ws;
    bf16* WIN = (bf16*)(ws + WS_WIN); bf16* WOUT = (bf16*)(ws + WS_WOUT); unsigned char* WGU = ws + WS_WGU; unsigned char* WDN = ws + WS_WDN;
    if (r < IT_IN) { const int kb = r / (NPROJ / 64), nb = r % (NPROJ / 64), n0 = 64 * nb, sc = n0 + (n0 >= SRC_GA ? 16 : 0);
        if (F8_IN) transpose_block64_fp8(a.w_in + ((size_t)l * D + 64 * kb) * DIN + sc, DIN, (unsigned char*)WIN + ((size_t)l * NPROJ + n0) * D + 64 * kb, scr, lane, S8_W);
        else transpose_block64(a.w_in + ((size_t)l * D + 64 * kb) * DIN + sc, DIN, WIN + ((size_t)l * NPROJ + n0) * D + 64 * kb, scr, lane); return; }
    r -= IT_IN;
    if (r < IT_OUT) { const int kb = r / 16, nb = r % 16;
        if (F8_OUT) transpose_block64_fp8(a.w_out + ((size_t)l * D + 64 * kb) * D + 64 * nb, D, (unsigned char*)WOUT + ((size_t)l * D + 64 * nb) * D + 64 * kb, scr, lane, S8_W);
        else transpose_block64(a.w_out + ((size_t)l * D + 64 * kb) * D + 64 * nb, D, WOUT + ((size_t)l * D + 64 * nb) * D + 64 * kb, scr, lane); return; }
    r -= IT_OUT;
    if (r < IT_GU) { const int e = r / 512, r2 = r % 512, kb = r2 / 32, nb = r2 % 32, cc = 64 * nb;
        const int row = (cc < 1024) ? 256 * (cc / 128) + (cc % 128) : 256 * ((cc - 1024) / 128) + 128 + ((cc - 1024) % 128);
        transpose_block64_fp8(a.w_gu + (((size_t)l * NE + e) * D + 64 * kb) * 2048 + cc, 2048, WGU + (((size_t)l * NE + e) * 2048 + row) * D + 64 * kb, scr, lane, S8_W); return; }
    r -= IT_GU;
    { const int e = r / 256, r2 = r % 256, kb = r2 / 16, nb = r2 % 16;
        transpose_block64_fp8(a.w_dn + (((size_t)l * NE + e) * FFN + 64 * kb) * D + 64 * nb, D, WDN + (((size_t)l * NE + e) * D + 64 * nb) * D + 64 * kb, scr, lane, S8_W); }
}
constexpr int CB2 = 5, CB7 = 3, CB8 = 3;
__device__ __forceinline__ int conv_t2(int G) { return (G == 256) ? 192 * NWAVES * CB2 : 0; }
__device__ __forceinline__ int conv_idle(int nunits, int G) { const int rem = nunits % G; return rem ? G - rem : 0; }
__device__ __forceinline__ void convert_range(const Args& a, int l, int first, int count, LAS unsigned char* lds, int lane, int wave) {
    LAS float* scr = (LAS float*)(lds + wave * 16640);
    for (int k = 0; k < count; ++k) { const int it = first + k; if (it < IT_LAYER) convert_item(a, l, it, scr, lane); }
}
__device__ __forceinline__ void p0_prologue(const Args& a, LAS unsigned char* lds, int vcu, int G, int tid, int lane, int wave) {
    unsigned char* ws = a.ws;
    LAS float* scr = (LAS float*)(lds + wave * 16640);
    const int gw = vcu * NWAVES + wave, NGW = G * NWAVES;
    for (int it = gw; it < IT_LAYER; it += NGW) convert_item(a, 0, it, scr, lane);
    __syncthreads();
    {
        LAS float* cact = (LAS float*)lds;
        LAS float* red = (LAS float*)(lds + 8192);
        for (int i = tid; i < 2 * D; i += NTHR) cact[i] = silu_f(a.c[i]);
        __syncthreads();
        float* MOD = (float*)(ws + WS_MOD);
        for (int it = vcu; it < DEPTH * 96; it += G) {
            const int l = it / 96, n0 = (it % 96) * 64;
            const float* wp = a.w_mod + ((size_t)l * D + 128 * wave) * 6144 + n0 + lane;
            float a0 = 0.f, a1 = 0.f;
#pragma unroll 32
            for (int k = 0; k < 128; ++k) { const float w = __builtin_nontemporal_load(wp + (size_t)k * 6144); a0 += cact[128 * wave + k] * w; a1 += cact[D + 128 * wave + k] * w; }
            red[(wave * 2 + 0) * 64 + lane] = a0; red[(wave * 2 + 1) * 64 + lane] = a1;
            __syncthreads();
            if (tid < 128) { const int b = tid >> 6, ln = tid & 63; float s = a.b_mod[l * 6144 + n0 + ln];
#pragma unroll
                for (int w = 0; w < 8; ++w) s += red[(w * 2 + b) * 64 + ln];
                MOD[((size_t)l * 2 + b) * 6144 + n0 + ln] = s; }
            __syncthreads();
        }
    }
    {
        float* ROPE = (float*)(ws + WS_ROPE);
        for (int i = vcu * NTHR + tid; i < MTOK * 24; i += G * NTHR) { const int t = i / 24, f = i % 24;
            const float inv = (float)pow(10000.0, -(double)f / 24.0); const float ang = (float)a.pos[t] * inv;
            ROPE[(size_t)t * 48 + f] = cosf(ang); ROPE[(size_t)t * 48 + 24 + f] = sinf(ang); }
    }
    if (vcu == 0 && tid < 256) {
        float v[4], mx = -3.0e38f; for (int l = 0; l < 4; ++l) { v[l] = a.hg_lb[l * 256 + tid]; mx = fmaxf(mx, v[l]); }
        float s = 0.f; for (int l = 0; l < 4; ++l) { v[l] = expf(v[l] - mx); s += v[l]; }
        float* LB = (float*)(ws + WS_LB); float cs = 0.f, first = 0.f;
        for (int l = 0; l < 4; ++l) { cs += v[l] / s; if (l == 0) first = cs; LB[l * 256 + tid] = cs - first; }
    }
}

__device__ __forceinline__ void moe_combine_row(f32x4 (&v)[4], int m, const bf16* Y, const int* SLOT, const float* TOPW, const float* g2, int lane) {
    const int4 sl = *(const int4*)(SLOT + (size_t)m * 4); const f32x4 tw = *(const f32x4*)(TOPW + (size_t)m * 4);
    const int s[4] = {sl.x, sl.y, sl.z, sl.w};
    f32x4 acc[4];
#pragma unroll
    for (int j = 0; j < 4; ++j) acc[j] = (f32x4){0.f, 0.f, 0.f, 0.f};
#pragma unroll
    for (int k = 0; k < 4; ++k) { const bf16* yr = Y + (size_t)s[k] * D + 4 * lane; const float w = tw[k];
#pragma unroll
        for (int j = 0; j < 4; ++j) { const uint2 p = *(const uint2*)(yr + 256 * j);
            acc[j][0] += w * __builtin_bit_cast(float, p.x << 16); acc[j][1] += w * __builtin_bit_cast(float, p.x & 0xffff0000u);
            acc[j][2] += w * __builtin_bit_cast(float, p.y << 16); acc[j][3] += w * __builtin_bit_cast(float, p.y & 0xffff0000u); } }
#pragma unroll
    for (int j = 0; j < 4; ++j) { const f32x4 g = *(const f32x4*)(g2 + 4 * lane + 256 * j); v[j] = v[j] + g * acc[j]; }
}
__device__ __forceinline__ float row_rstd(const f32x4 (&v)[4]) {
    float s = 0.f;
#pragma unroll
    for (int j = 0; j < 4; ++j) s += (v[j][0] * v[j][0] + v[j][1] * v[j][1]) + (v[j][2] * v[j][2] + v[j][3] * v[j][3]);
    return 1.0f / sqrtf(wave_sum(s) * (1.0f / D) + EPS);
}
__device__ __forceinline__ void modulate_row(f32x4 (&v)[4], float rstd, const float* nw, const float* sc, const float* sh, bf16* hrow, int lane) {
#pragma unroll
    for (int j = 0; j < 4; ++j) { const int c0 = 4 * lane + 256 * j; const f32x4 w = *(const f32x4*)(nw + c0), s1 = *(const f32x4*)(sc + c0), s0 = *(const f32x4*)(sh + c0);
        v[j] = v[j] * rstd * w * (s1 + 1.0f) + s0;
        uint2 p; p.x = pk2(v[j][0], v[j][1]); p.y = pk2(v[j][2], v[j][3]); *(uint2*)(hrow + c0) = p; }
}


constexpr int LR_SLT = 142976, LR_TWL = 144000, LR_SSR = 145024;
__device__ __forceinline__ void stage_slots(const unsigned char* ws, int row0, LAS unsigned char* lds, int tid) {
    if (tid < 64) { *(LAS v4u*)(lds + LR_SLT + 16 * tid) = *(const v4u*)((const int*)(ws + WS_SLOT) + (size_t)(row0 + tid) * 4);
                    *(LAS f32x4*)(lds + LR_TWL + 16 * tid) = *(const f32x4*)((const float*)(ws + WS_TOPW) + (size_t)(row0 + tid) * 4); }
}
template <bool SS>
__device__ __forceinline__ void flat_combine(const float* xsrc, float* xdst, int row0, const bf16* Y, const float* g2, LAS unsigned char* lds, int tid, int lane) {
    const int c4 = tid & 255, rsub = tid >> 8; const f32x4 g = *(const f32x4*)(g2 + 4 * c4);
#pragma unroll 4
    for (int it = 0; it < 32; ++it) { const int i = 2 * it + rsub; const size_t m = (size_t)(row0 + i);
        f32x4 v = *(const f32x4*)(xsrc + m * D + 4 * c4);
        const v4u sl = *(const LAS v4u*)(lds + LR_SLT + 16 * i); const f32x4 tw = *(const LAS f32x4*)(lds + LR_TWL + 16 * i);
        f32x4 acc;
        if (Y8) { const unsigned char* Yb = (const unsigned char*)Y; typedef float f32x2v __attribute__((ext_vector_type(2)));
            const int q0 = *(const int*)(Yb + (size_t)sl.x * D + 4 * c4), q1 = *(const int*)(Yb + (size_t)sl.y * D + 4 * c4), q2 = *(const int*)(Yb + (size_t)sl.z * D + 4 * c4), q3 = *(const int*)(Yb + (size_t)sl.w * D + 4 * c4);
            const f32x2v a0 = __builtin_amdgcn_cvt_pk_f32_fp8(q0, false), b0 = __builtin_amdgcn_cvt_pk_f32_fp8(q0, true), a1 = __builtin_amdgcn_cvt_pk_f32_fp8(q1, false), b1 = __builtin_amdgcn_cvt_pk_f32_fp8(q1, true);
            const f32x2v a2 = __builtin_amdgcn_cvt_pk_f32_fp8(q2, false), b2 = __builtin_amdgcn_cvt_pk_f32_fp8(q2, true), a3 = __builtin_amdgcn_cvt_pk_f32_fp8(q3, false), b3 = __builtin_amdgcn_cvt_pk_f32_fp8(q3, true);
            const f32x4 tws = tw * (1.0f / S8_Y);
            acc[0] = tws[0] * a0[0] + tws[1] * a1[0] + tws[2] * a2[0] + tws[3] * a3[0]; acc[1] = tws[0] * a0[1] + tws[1] * a1[1] + tws[2] * a2[1] + tws[3] * a3[1];
            acc[2] = tws[0] * b0[0] + tws[1] * b1[0] + tws[2] * b2[0] + tws[3] * b3[0]; acc[3] = tws[0] * b0[1] + tws[1] * b1[1] + tws[2] * b2[1] + tws[3] * b3[1]; }
        else {
        const uint2 p0 = *(const uint2*)(Y + (size_t)sl.x * D + 4 * c4), p1 = *(const uint2*)(Y + (size_t)sl.y * D + 4 * c4), p2 = *(const uint2*)(Y + (size_t)sl.z * D + 4 * c4), p3 = *(const uint2*)(Y + (size_t)sl.w * D + 4 * c4);
        acc[0] = tw[0] * __builtin_bit_cast(float, p0.x << 16) + tw[1] * __builtin_bit_cast(float, p1.x << 16) + tw[2] * __builtin_bit_cast(float, p2.x << 16) + tw[3] * __builtin_bit_cast(float, p3.x << 16);
        acc[1] = tw[0] * __builtin_bit_cast(float, p0.x & 0xffff0000u) + tw[1] * __builtin_bit_cast(float, p1.x & 0xffff0000u) + tw[2] * __builtin_bit_cast(float, p2.x & 0xffff0000u) + tw[3] * __builtin_bit_cast(float, p3.x & 0xffff0000u);
        acc[2] = tw[0] * __builtin_bit_cast(float, p0.y << 16) + tw[1] * __builtin_bit_cast(float, p1.y << 16) + tw[2] * __builtin_bit_cast(float, p2.y << 16) + tw[3] * __builtin_bit_cast(float, p3.y << 16);
        acc[3] = tw[0] * __builtin_bit_cast(float, p0.y & 0xffff0000u) + tw[1] * __builtin_bit_cast(float, p1.y & 0xffff0000u) + tw[2] * __builtin_bit_cast(float, p2.y & 0xffff0000u) + tw[3] * __builtin_bit_cast(float, p3.y & 0xffff0000u); }
        v = v + g * acc;
        *(f32x4*)(xdst + m * D + 4 * c4) = v;
        if (SS) { const float sq = wave_sum((v[0] * v[0] + v[1] * v[1]) + (v[2] * v[2] + v[3] * v[3])); if (lane == 0) __hip_atomic_fetch_add((LAS float*)(lds + LR_SSR) + i, sq, __ATOMIC_RELAXED, __HIP_MEMORY_SCOPE_WORKGROUP); } }
}
template <bool F8>
__device__ __forceinline__ void flat_modulate(const float* xin, int row0, const LAS float* rstds, const float* nw, const float* scp, const float* shp, bf16* H, int tid) {
    const int c4 = tid & 255, rsub = tid >> 8; const f32x4 w = *(const f32x4*)(nw + 4 * c4), s1 = *(const f32x4*)(scp + 4 * c4), s0 = *(const f32x4*)(shp + 4 * c4); const f32x4 ws1 = w * (s1 + 1.0f);
#pragma unroll 8
    for (int it = 0; it < 32; ++it) { const int i = 2 * it + rsub; const size_t m = (size_t)(row0 + i); const f32x4 v = *(const f32x4*)(xin + m * D + 4 * c4) * rstds[i] * ws1 + s0;
        if (F8) *(int*)((unsigned char*)H + m * D + 4 * c4) = pk4_fp8(v[0] * S8_H, v[1] * S8_H, v[2] * S8_H, v[3] * S8_H);
        else { uint2 p; p.x = pk2(v[0], v[1]); p.y = pk2(v[2], v[3]); *(uint2*)(H + m * D + 4 * c4) = p; } }
}

constexpr int WP = 1032;
constexpr int LR_WHI = 0, LR_PART = 132096, LR_SSX = 140288, LR_RSTD = 140544, LR_BIAS = 140800, LR_RED = 140928;
template <int NEO>
__device__ __forceinline__ void rows_mfma(const Args& a, int layer, LAS unsigned char* lds, volatile LAS unsigned* MISC, gu32* ctl, int vcu, int G, int tid, int lane, int wave) {
    constexpr bool P5 = (NEO == 32); constexpr int NET = NEO / 16;
    unsigned char* ws = a.ws; float* X = (float*)(ws + WS_X); bf16* H = (bf16*)(ws + WS_H); const float* MOD = (const float*)(ws + WS_MOD);
    LAS bf16* Whi = (LAS bf16*)(lds + LR_WHI); LAS bf16* Wlo = Whi + NEO * WP; LAS float* part = (LAS float*)(lds + LR_PART); LAS float* ssx = (LAS float*)(lds + LR_SSX);
    LAS float* rstds = (LAS float*)(lds + LR_RSTD); LAS float* biasl = (LAS float*)(lds + LR_BIAS); LAS float* red = (LAS float*)(lds + LR_RED);
    const float* nw = (P5 ? a.norm2_w : a.norm1_w) + layer * D;
    const float* Wsrc = P5 ? a.w_r + (size_t)layer * D * NE : a.w_in + (size_t)layer * D * DIN + SRC_GA; const int wld = P5 ? NE : DIN;
    if (P5) { if (tid < NE) MISC[MW_HIST + tid] = 0u; }
    for (int row0 = vcu * 64; row0 < MTOK; row0 += G * 64) {
        const int b = row0 / SEQ; const float* mp = MOD + ((size_t)layer * 2 + b) * 6144; const float* scp = mp + (P5 ? 4 : 1) * D; const float* shp = mp + (P5 ? 3 : 0) * D;
        if (!P5 && layer > 0) { stage_slots(ws, row0, lds, tid); __syncthreads(); }
        { const int e = tid % NEO, kq = tid / NEO; constexpr int NPT = NTHR / NEO;
#pragma unroll 1
            for (int it0 = 0; it0 < D / NPT; it0 += 8) { float wv[8];
#pragma unroll
                for (int u = 0; u < 8; ++u) { const int k = kq + NPT * (it0 + u); wv[u] = Wsrc[(size_t)k * wld + e] * (nw[k] * (1.0f + scp[k])); }
#pragma unroll
                for (int u = 0; u < 8; ++u) { const int k = kq + NPT * (it0 + u); const unsigned hi = f2bf(wv[u]); const float wl = wv[u] - __builtin_bit_cast(float, hi << 16); Whi[e * WP + k] = (bf16)hi; Wlo[e * WP + k] = (bf16)f2bf(wl); } }
            constexpr int KP = D / NPT; float sacc = 0.f;
#pragma unroll 8
            for (int k = kq * KP; k < kq * KP + KP; ++k) sacc += shp[k] * Wsrc[(size_t)k * wld + e];
            red[kq * NEO + e] = sacc; }
        const float* xin = X;
        if (!P5) { if (layer == 0) xin = a.x;
            else { flat_combine<false>(X, X, row0, (const bf16*)(ws + WS_Y), MOD + ((size_t)(layer - 1) * 2 + b) * 6144 + 5 * D, lds, tid, lane); asm volatile("s_waitcnt vmcnt(0)" ::: "memory"); } }
        __syncthreads();
        if (tid < NEO) { constexpr int NPT = NTHR / NEO; float sacc = P5 ? a.b_r[layer * NE + tid] : 0.f; for (int q = 0; q < NPT; ++q) sacc += red[q * NEO + tid]; biasl[tid] = sacc; }
        const int rg = wave >> 1, kh = wave & 1, r = lane & 15, g = lane >> 4;
        { const float* xr = xin + (size_t)(row0 + 16 * rg + r) * D; f32x4 acc[NET]; float ss = 0.f;
#pragma unroll
            for (int et = 0; et < NET; ++et) acc[et] = (f32x4){0.f, 0.f, 0.f, 0.f};
#pragma unroll 4
            for (int s = 16 * kh; s < 16 * kh + 16; ++s) { const int k0 = 32 * s + 8 * g; const f32x4 x0 = *(const f32x4*)(xr + k0), x1 = *(const f32x4*)(xr + k0 + 4);
                ss += (x0[0] * x0[0] + x0[1] * x0[1]) + (x0[2] * x0[2] + x0[3] * x0[3]) + (x1[0] * x1[0] + x1[1] * x1[1]) + (x1[2] * x1[2] + x1[3] * x1[3]);
                float xv[8] = {x0[0], x0[1], x0[2], x0[3], x1[0], x1[1], x1[2], x1[3]}, xl[8];
#pragma unroll
                for (int j = 0; j < 8; ++j) xl[j] = xv[j] - __builtin_bit_cast(float, f2bf(xv[j]) << 16);
                const pg8::bf16x8 ahi = pack8(xv), alo = pack8(xl);
#pragma unroll
                for (int et = 0; et < NET; ++et) { const pg8::bf16x8 whi = ldfrag(Whi, WP, 16 * et, 32 * s, lane), wlo = ldfrag(Wlo, WP, 16 * et, 32 * s, lane);
                    acc[et] = __builtin_amdgcn_mfma_f32_16x16x32_bf16(ahi, whi, acc[et], 0, 0, 0); acc[et] = __builtin_amdgcn_mfma_f32_16x16x32_bf16(alo, whi, acc[et], 0, 0, 0);
                    acc[et] = __builtin_amdgcn_mfma_f32_16x16x32_bf16(ahi, wlo, acc[et], 0, 0, 0); } }
            ss += __shfl_xor(ss, 16); ss += __shfl_xor(ss, 32);
            if (kh == 1) {
#pragma unroll
                for (int et = 0; et < NET; ++et)
#pragma unroll
                    for (int q = 0; q < 4; ++q) part[(rg * 16 + 4 * g + q) * 32 + 16 * et + r] = acc[et][q];
                if (g == 0) ssx[rg * 16 + r] = ss; }
            __syncthreads();
            if (kh == 0) { const float sst = ss + ssx[rg * 16 + r]; if (g == 0) rstds[rg * 16 + r] = 1.0f / sqrtf(sst * (1.0f / D) + EPS);
                asm volatile("s_waitcnt lgkmcnt(0)" ::: "memory");
#pragma unroll
                for (int et = 0; et < NET; ++et)
#pragma unroll
                    for (int q = 0; q < 4; ++q) { const int i = rg * 16 + 4 * g + q, e = 16 * et + r; const float v = rstds[i] * (acc[et][q] + part[i * 32 + e]) + biasl[e];
                        if (P5) part[i * 32 + e] = v; else ((float*)(ws + WS_GA))[(size_t)(row0 + i) * 16 + e] = v; }
                if (P5) { asm volatile("s_waitcnt lgkmcnt(0)" ::: "memory");
                    if (lane < 16) { const int i = rg * 16 + lane, m = row0 + i; float lv[NE];
#pragma unroll
                        for (int e = 0; e < NE; ++e) lv[e] = part[i * 32 + e];
                        float tv[4]; int te[4];
#pragma unroll
                        for (int t = 0; t < 4; ++t) { float best = -3.0e38f; int bi = 0;
#pragma unroll
                            for (int e = 0; e < NE; ++e) if (lv[e] > best) { best = lv[e]; bi = e; }
#pragma unroll
                            for (int e = 0; e < NE; ++e) if (e == bi) lv[e] = -3.0e38f;
                            tv[t] = best; te[t] = bi; }
                        const float e1 = expf(tv[1] - tv[0]), e2 = expf(tv[2] - tv[0]), e3 = expf(tv[3] - tv[0]); const float inv = 1.0f / (1.0f + e1 + e2 + e3);
                        *(f32x4*)((float*)(ws + WS_TOPW) + (size_t)m * 4) = (f32x4){inv, e1 * inv, e2 * inv, e3 * inv};
#pragma unroll
                        for (int t = 0; t < 4; ++t) { const unsigned rk = __hip_atomic_fetch_add((LAS unsigned*)&MISC[MW_HIST + te[t]], 1u, __ATOMIC_RELAXED, __HIP_MEMORY_SCOPE_WORKGROUP);
                            ((LAS unsigned*)(lds + LR_SLT))[i * 4 + t] = ((unsigned)te[t] << 16) | rk; } } } }
            __syncthreads(); }
        if (P5) { if (tid < NE) { const unsigned hcnt = MISC[MW_HIST + tid]; MISC[MW_BASE + tid] = hcnt ? atomicAdd((unsigned*)(ctl + CW_CNT + layer * NE + tid), hcnt) : 0u; }
            __syncthreads();
            if (tid < 256) { LAS unsigned* sl = (LAS unsigned*)(lds + LR_SLT) + tid; const unsigned v = *sl, e = v >> 16; const unsigned slot = (e << ECAP_SH) + MISC[MW_BASE + e] + (v & 0xffffu);
                *sl = slot; ((int*)(ws + WS_SLOT))[(size_t)row0 * 4 + tid] = (int)slot; }
            if (tid < NE) MISC[MW_HIST + tid] = 0u;
            __syncthreads(); }
        if (P5) { const int c4 = tid & 255, rsub = tid >> 8; const f32x4 w = *(const f32x4*)(nw + 4 * c4), s1 = *(const f32x4*)(scp + 4 * c4), s0 = *(const f32x4*)(shp + 4 * c4); const f32x4 ws1 = w * (s1 + 1.0f);
            unsigned char* A1 = ws + WS_A1;
#pragma unroll 8
            for (int it = 0; it < 32; ++it) { const int i = 2 * it + rsub; const f32x4 v = *(const f32x4*)(xin + (size_t)(row0 + i) * D + 4 * c4) * rstds[i] * ws1 + s0;
                const int pw = pk4_fp8(v[0] * S8_H, v[1] * S8_H, v[2] * S8_H, v[3] * S8_H); const v4u sl = *(const LAS v4u*)(lds + LR_SLT + 16 * i);
                *(int*)(A1 + (size_t)sl.x * D + 4 * c4) = pw; *(int*)(A1 + (size_t)sl.y * D + 4 * c4) = pw; *(int*)(A1 + (size_t)sl.z * D + 4 * c4) = pw; *(int*)(A1 + (size_t)sl.w * D + 4 * c4) = pw; } }
        else flat_modulate<F8_IN>(xin, row0, rstds, nw, scp, shp, H, tid);
        __syncthreads();
    }
}

__device__ __forceinline__ void final_rows(const Args& a, LAS unsigned char* lds, int vcu, int G, int tid, int lane) {
    unsigned char* ws = a.ws; const float* X = (const float*)(ws + WS_X); const float* MOD = (const float*)(ws + WS_MOD); LAS float* ssr = (LAS float*)(lds + LR_SSR);
    for (int row0 = vcu * 64; row0 < MTOK; row0 += G * 64) { const int b = row0 / SEQ;
        stage_slots(ws, row0, lds, tid); if (tid < 64) ssr[tid] = 0.f;
        __syncthreads();
        flat_combine<true>(X, a.out, row0, (const bf16*)(ws + WS_Y), MOD + ((size_t)(DEPTH - 1) * 2 + b) * 6144 + 5 * D, lds, tid, lane);
        asm volatile("s_waitcnt vmcnt(0)" ::: "memory");
        __syncthreads();
        { const int c4 = tid & 255, rsub = tid >> 8; const f32x4 w = *(const f32x4*)(a.final_norm_w + 4 * c4);
#pragma unroll 8
            for (int it = 0; it < 32; ++it) { const int i = 2 * it + rsub; float* op = a.out + (size_t)(row0 + i) * D + 4 * c4; const float rstd = 1.0f / sqrtf(ssr[i] * (1.0f / D) + EPS); *(f32x4*)op = *(const f32x4*)op * rstd * w; } }
        __syncthreads();
    }
}

__device__ __noinline__ void moe_tables(gu32* ctl, int layer, volatile LAS unsigned* MISC, int tid) {
    if (tid < NE) MISC[MW_CNT + tid] = __hip_atomic_load(ctl + CW_CNT + layer * NE + tid, RLX_AGENT);
    __syncthreads();
    if (tid == 0) { unsigned n = 0;
        for (int e = 0; e < NE; ++e) { const unsigned nt = (MISC[MW_CNT + e] + 255u) >> 8; for (unsigned t = 0; t < nt; ++t) MISC[MW_TILE + n + t] = (unsigned)(e * 64) + t; n += nt; }
        MISC[MW_NRT] = n; }
    __syncthreads();
}

constexpr int BP = 72;
template <int TYPE> struct MixCfg { static constexpr int DK = (TYPE == 1) ? 64 : 48, DV = (TYPE == 1) ? 64 : 96, NC = 4 * DK, NV = 4 * DV;
    static constexpr int STOFF = (TYPE == 0) ? ST_GLA : (TYPE == 1) ? ST_HG : ST_RET, COFF = (TYPE == 0) ? 0 : 192;
    static constexpr int CQ = (TYPE == 0) ? C_GQ : (TYPE == 1) ? C_HQ : C_RQ, CK = (TYPE == 0) ? C_GK : (TYPE == 1) ? C_HF : C_RK, CV = (TYPE == 0) ? C_GV : (TYPE == 1) ? C_HI : C_RV, CG = (TYPE == 0) ? C_GG : (TYPE == 1) ? C_HG : C_RG;
    static constexpr int MIXOFF = (TYPE == 0) ? 0 : (TYPE == 1) ? 384 : 640; };
__device__ __forceinline__ float fast_logsig(float x) { x = fmaxf(x, -80.f); return -__logf(1.0f + __expf(-x)); }
__device__ __forceinline__ float ret_lg(int h) { return logf(1.0f - exp2f(-5.0f - (float)h)); }

template <int NV>
__device__ __forceinline__ void stage_vt(const bf16* pv  , LAS bf16* VT, int tid) {
#pragma unroll 2
    for (int idx = tid; idx < 64 * (NV / 8); idx += NTHR) { const int j = idx & 63, ch = idx >> 6; const v4u p = *(const v4u*)(pv + (size_t)j * NPROJ + 8 * ch); LAS bf16* d = VT + (8 * ch) * BP + j;
        d[0 * BP] = (bf16)(p.x & 0xffffu); d[1 * BP] = (bf16)(p.x >> 16); d[2 * BP] = (bf16)(p.y & 0xffffu); d[3 * BP] = (bf16)(p.y >> 16);
        d[4 * BP] = (bf16)(p.z & 0xffffu); d[5 * BP] = (bf16)(p.z >> 16); d[6 * BP] = (bf16)(p.w & 0xffffu); d[7 * BP] = (bf16)(p.w >> 16); }
}

constexpr int LA_KT = 0, LA_VT = 36864, LA_TOT = 92160, LA_GA = 94208;
template <int TYPE>
__device__ __forceinline__ void mixa_batch(const Args& a, int layer, int unit, LAS unsigned char* lds, int tid, int lane, int wave) {
    typedef MixCfg<TYPE> C; constexpr int DK = C::DK, DV = C::DV, NC = C::NC, NV = C::NV;
    unsigned char* ws = a.ws; const bf16* PROJ = (const bf16*)(ws + WS_PROJ); float* CUM = (float*)(ws + WS_CUM); float* DVEC = (float*)(ws + WS_DVEC) + (size_t)unit * NDV;
    float* U = (float*)(ws + WS_U) + (size_t)unit * ST_TOT + C::STOFF;
    LAS bf16* KT = (LAS bf16*)(lds + LA_KT); LAS bf16* VT = (LAS bf16*)(lds + LA_VT); LAS float* TOT = (LAS float*)(lds + LA_TOT); const LAS float* GAs = (const LAS float*)(lds + LA_GA);
    const int row0 = unit * CH;
    const bool act = tid < 2 * NC; const int c = act ? tid % NC : 0, half = act ? tid / NC : 0, h = c / DK, d = c - h * DK;
    float cum[32]; float tot = 0.f;
    float w2[16], b2 = 0.f, lbv = 0.f, lg = 0.f, sg = 0.f; int f = 0, d2 = 0;
    if (act) {
        if constexpr (TYPE == 0) { b2 = a.gla_ba2[layer * 192 + c];
#pragma unroll
            for (int r = 0; r < 16; ++r) w2[r] = a.gla_wa2[(layer * 16 + r) * 192 + c]; }
        if constexpr (TYPE == 1) lbv = ((const float*)(ws + WS_LB))[layer * 256 + c];
        if constexpr (TYPE == 2) { lg = ret_lg(h); f = (d < 24) ? d : d - 24; d2 = (d < 24) ? d + 24 : d - 24; sg = (d < 24) ? -1.f : 1.f; }
        bf16 hraw[32];
        if constexpr (TYPE == 1) {
#pragma unroll
            for (int i = 0; i < 32; ++i) hraw[i] = PROJ[(size_t)(row0 + 32 * half + i) * NPROJ + C_HF + c]; }
#pragma unroll
        for (int i = 0; i < 32; ++i) { const int t = 32 * half + i; float g;
            if constexpr (TYPE == 0) { float pre = b2;
#pragma unroll
                for (int r = 0; r < 16; ++r) pre += GAs[t * 16 + r] * w2[r];
                g = fast_logsig(pre) * (1.0f / 16.0f); }
            else if constexpr (TYPE == 1) { const float hf = fminf(fmaxf(bf2f(hraw[i]), -80.f), 80.f); const float sgm = 1.0f / (1.0f + __expf(-hf));
                g = __logf(lbv + (1.0f - lbv) * sgm); }
            else g = lg;
            tot += g; cum[i] = tot;
            if ((i & 7) == 7) asm volatile("" ::: "memory"); }
        TOT[c * 2 + half] = tot;
    }
    stage_vt<NV>(PROJ + (size_t)row0 * NPROJ + C::CV, VT, tid);
    __syncthreads();
    if (act) { const float t0 = TOT[c * 2], t1 = TOT[c * 2 + 1]; const float off = half ? t0 : 0.f, last = t0 + t1;
#pragma unroll
        for (int hq = 0; hq < 2; ++hq) {
            bf16 ka[16], kb[16]; float cs[16], sn[16];
            if constexpr (TYPE != 1) {
#pragma unroll
                for (int i = 0; i < 16; ++i) { const size_t row = (size_t)(row0 + 32 * half + 16 * hq + i); const bf16* pr = PROJ + row * NPROJ;
                    if constexpr (TYPE == 0) ka[i] = pr[C_GK + c];
                    else { const float* rp = (const float*)(ws + WS_ROPE) + row * 48; ka[i] = pr[C_RK + h * 48 + d]; kb[i] = pr[C_RK + h * 48 + d2]; cs[i] = rp[f]; sn[i] = rp[24 + f]; } } }
#pragma unroll
            for (int q2 = 0; q2 < 2; ++q2) { float kt[8];
#pragma unroll
                for (int j = 0; j < 8; ++j) { const int ii = 8 * q2 + j, i = 16 * hq + ii; const float cm = cum[i] + off; const size_t row = (size_t)(row0 + 32 * half + i); float k;
                    if constexpr (TYPE == 0) k = bf2f(ka[ii]);
                    else if constexpr (TYPE == 1) k = 1.0f - __expf(cum[i] - (i > 0 ? cum[i - 1] : 0.f));
                    else k = bf2f(ka[ii]) * cs[ii] + sg * bf2f(kb[ii]) * sn[ii];
                    if constexpr (TYPE != 2) CUM[row * NDV + C::COFF + c] = cm;
                    kt[j] = k * __expf(last - cm); }
                v4u w; w.x = pk2(kt[0], kt[1]); w.y = pk2(kt[2], kt[3]); w.z = pk2(kt[4], kt[5]); w.w = pk2(kt[6], kt[7]);
                *(LAS v4u*)(KT + c * BP + 32 * half + 16 * hq + 8 * q2) = w; } }
        if (TYPE != 2 && half == 0) DVEC[C::COFF + c] = __expf(last);
    }
    __syncthreads();
    constexpr int TD = DK / 16, NT = (DV / 16) * TD;
    for (int ti = wave; ti < 4 * NT; ti += NWAVES) { const int hh = ti / NT, tr = ti - hh * NT, te = tr / TD, td = tr - te * TD; f32x4 acc = {0.f, 0.f, 0.f, 0.f};
#pragma unroll
        for (int kk = 0; kk < 2; ++kk) acc = __builtin_amdgcn_mfma_f32_16x16x32_bf16(ldfrag(VT, BP, hh * DV + te * 16, kk * 32, lane), ldfrag(KT, BP, hh * DK + td * 16, kk * 32, lane), acc, 0, 0, 0);
        float* Uh = U + hh * DK * DV;
#pragma unroll
        for (int r = 0; r < 4; ++r) Uh[(te * 16 + (lane >> 4) * 4 + r) * DK + td * 16 + (lane & 15)] = acc[r]; }
    __syncthreads();
}
__device__ __forceinline__ void p3a_summaries(const Args& a, int layer, LAS unsigned char* lds, int vcu, int G, int tid, int lane, int wave) {
    for (int unit = vcu; unit < NUNIT; unit += G) {
        { LAS float* GAs = (LAS float*)(lds + LA_GA); const float* GA = (const float*)(a.ws + WS_GA); for (int i = tid; i < CH * 16; i += NTHR) GAs[i] = GA[(size_t)unit * CH * 16 + i]; }
        __syncthreads();
        mixa_batch<0>(a, layer, unit, lds, tid, lane, wave);
        mixa_batch<1>(a, layer, unit, lds, tid, lane, wave);
        mixa_batch<2>(a, layer, unit, lds, tid, lane, wave);
    }
}

__device__ __forceinline__ void p3b_scan(const Args& a, int vcu, int G, int tid) {
    unsigned char* ws = a.ws; const float* U = (const float*)(ws + WS_U); const float* DVEC = (const float*)(ws + WS_DVEC); bf16* SP = (bf16*)(ws + WS_SP);
    for (int gid = vcu * NTHR + tid; gid < BATCH * ST_TOT; gid += G * NTHR) {
        const int b = gid / ST_TOT, el = gid - b * ST_TOT;
        int di = -1; float cdec = 0.f;
        if (el < ST_HG) { const int h = el / 4608, d = (el - h * 4608) % 48; di = h * 48 + d; }
        else if (el < ST_RET) { const int r = el - ST_HG, h = r / 4096, d = r % 64; di = 192 + h * 64 + d; }
        else { const int h = (el - ST_RET) / 4608; cdec = expf(64.0f * logf(1.0f - exp2f(-5.0f - (float)h))); }
        const float* up = U + (size_t)b * NCH * ST_TOT + el; const float* dp = DVEC + (size_t)b * NCH * NDV + (di < 0 ? 0 : di); bf16* sp = SP + (size_t)b * NCH * ST_TOT + el;
        float s = 0.f;
        for (int n0 = 0; n0 < NCH; n0 += 8) { float u[8], dc[8];
#pragma unroll
            for (int i = 0; i < 8; ++i) { u[i] = up[(size_t)(n0 + i) * ST_TOT]; dc[i] = (di < 0) ? cdec : dp[(size_t)(n0 + i) * NDV]; }
#pragma unroll
            for (int i = 0; i < 8; ++i) { sp[(size_t)(n0 + i) * ST_TOT] = (bf16)f2bf(s); s = dc[i] * s + u[i]; } }
    }
}

constexpr int LC_VT = 0, LC_ST = 55296, LC_AB = 110592, OBP = 104;
template <int TYPE, bool ISQ>
__device__ __forceinline__ void mix_frag(const Args& a, int h, size_t row, int t, int d0, float (&x)[8], float (&cm)[8]) {
    typedef MixCfg<TYPE> C; constexpr int DK = C::DK;
    unsigned char* ws = a.ws; const bf16* pr = (const bf16*)(ws + WS_PROJ) + row * NPROJ;
    if constexpr (TYPE == 0) {
        const v4u p = *(const v4u*)(pr + (ISQ ? C_GQ : C_GK) + h * DK + d0); const unsigned pw[4] = {p.x, p.y, p.z, p.w};
        const float* cp = (const float*)(ws + WS_CUM) + row * NDV + h * DK + d0; const f32x4 c0 = *(const f32x4*)cp, c1 = *(const f32x4*)(cp + 4);
#pragma unroll
        for (int j = 0; j < 4; ++j) { x[2 * j] = __builtin_bit_cast(float, pw[j] << 16); x[2 * j + 1] = __builtin_bit_cast(float, pw[j] & 0xffff0000u); cm[j] = c0[j]; cm[4 + j] = c1[j]; }
        if (ISQ) {
#pragma unroll
            for (int j = 0; j < 8; ++j) x[j] *= 0.14433756729740643f; }
    } else if constexpr (TYPE == 1) {
        const float* cp = (const float*)(ws + WS_CUM) + row * NDV + 192 + h * DK + d0; const f32x4 c0 = *(const f32x4*)cp, c1 = *(const f32x4*)(cp + 4);
#pragma unroll
        for (int j = 0; j < 4; ++j) { cm[j] = c0[j]; cm[4 + j] = c1[j]; }
        if (ISQ) { const v4u p = *(const v4u*)(pr + C_HQ + h * DK + d0); const unsigned pw[4] = {p.x, p.y, p.z, p.w};
#pragma unroll
            for (int j = 0; j < 4; ++j) { x[2 * j] = __builtin_bit_cast(float, pw[j] << 16); x[2 * j + 1] = __builtin_bit_cast(float, pw[j] & 0xffff0000u); } }
        else { f32x4 p0 = {0.f, 0.f, 0.f, 0.f}, p1 = {0.f, 0.f, 0.f, 0.f}; if (t > 0) { p0 = *(const f32x4*)(cp - NDV); p1 = *(const f32x4*)(cp - NDV + 4); }
#pragma unroll
            for (int j = 0; j < 4; ++j) { x[j] = 1.0f - __expf(c0[j] - p0[j]); x[4 + j] = 1.0f - __expf(c1[j] - p1[j]); } }
    } else {
        const int f0 = (d0 < 24) ? d0 : d0 - 24, dp = (d0 < 24) ? d0 + 24 : d0 - 24; const float sg = (d0 < 24) ? -1.f : 1.f;
        const int cb = (ISQ ? C_RQ : C_RK) + h * DK; const v4u p = *(const v4u*)(pr + cb + d0), pp = *(const v4u*)(pr + cb + dp); const unsigned pw[4] = {p.x, p.y, p.z, p.w}, qw[4] = {pp.x, pp.y, pp.z, pp.w};
        const float* rp = (const float*)(ws + WS_ROPE) + row * 48; const f32x4 cs0 = *(const f32x4*)(rp + f0), cs1 = *(const f32x4*)(rp + f0 + 4), sn0 = *(const f32x4*)(rp + 24 + f0), sn1 = *(const f32x4*)(rp + 24 + f0 + 4);
        const float cmv = (float)(t + 1) * ret_lg(h);
#pragma unroll
        for (int j = 0; j < 4; ++j) { const float xa = __builtin_bit_cast(float, pw[j] << 16), xb = __builtin_bit_cast(float, pw[j] & 0xffff0000u), ya = __builtin_bit_cast(float, qw[j] << 16), yb = __builtin_bit_cast(float, qw[j] & 0xffff0000u);
            const float ca = (j < 2) ? cs0[2 * j] : cs1[2 * j - 4], cb2 = (j < 2) ? cs0[2 * j + 1] : cs1[2 * j - 3], sa = (j < 2) ? sn0[2 * j] : sn1[2 * j - 4], sb = (j < 2) ? sn0[2 * j + 1] : sn1[2 * j - 3];
            x[2 * j] = xa * ca + sg * ya * sa; x[2 * j + 1] = xb * cb2 + sg * yb * sb; cm[2 * j] = cmv; cm[2 * j + 1] = cmv; }
        if (ISQ) {
#pragma unroll
            for (int j = 0; j < 8; ++j) x[j] *= 0.14433756729740643f; }
    }
}

template <int TYPE>
__device__ __forceinline__ void mixc_batch(const Args& a, int layer, int unit, LAS unsigned char* lds, int tid, int lane, int wave) {
    typedef MixCfg<TYPE> C; constexpr int DK = C::DK, DV = C::DV, NV = C::NV, TE = DV / 16;
    unsigned char* ws = a.ws; const bf16* PROJ = (const bf16*)(ws + WS_PROJ); bf16* MIX = (bf16*)(ws + WS_MIX);
    LAS bf16* VT = (LAS bf16*)(lds + LC_VT); LAS bf16* ST = (LAS bf16*)(lds + LC_ST); LAS bf16* AB = (LAS bf16*)(lds + LC_AB) + wave * 16 * OBP;
    const int row0 = unit * CH;
    stage_vt<NV>(PROJ + (size_t)row0 * NPROJ + C::CV, VT, tid);
    { const bf16* SPu = (const bf16*)(ws + WS_SP) + (size_t)unit * ST_TOT + C::STOFF;
        for (int idx = tid; idx < NV * 8; idx += NTHR) { const int er = idx >> 3, ch = idx & 7; v4u w = {0u, 0u, 0u, 0u}; if (ch * 8 < DK) w = *(const v4u*)(SPu + (size_t)er * DK + ch * 8); *(LAS v4u*)(ST + er * BP + ch * 8) = w; } }
    __syncthreads();
    const int h = wave >> 1, hsel = wave & 1, r = lane & 15, g = lane >> 4;
    const LAS bf16* STh = ST + h * DV * BP; const LAS bf16* VTh = VT + h * DV * BP;
    const float* CUMp = (const float*)(ws + WS_CUM);
    for (int ib = 0; ib < 2; ++ib) { const int I = ib ? 3 - hsel : hsel;
        pg8::bf16x8 qh[2], qt[2]; float refv[2][8];
#pragma unroll
        for (int s = 0; s < 2; ++s) { const int d0 = 32 * s + 8 * g; const bool valid = d0 < DK; const int d0c = valid ? d0 : 0;
            float x[8], cm[8]; mix_frag<TYPE, true>(a, h, (size_t)(row0 + 16 * I + r), 16 * I + r, d0c, x, cm);
            if constexpr (TYPE == 2) {
#pragma unroll
                for (int j = 0; j < 8; ++j) refv[s][j] = (float)(16 * I) * ret_lg(h);
            } else { if (I > 0) { const float* cp = CUMp + (size_t)(row0 + 16 * I - 1) * NDV + C::COFF + h * DK + d0c; const f32x4 c0 = *(const f32x4*)cp, c1 = *(const f32x4*)(cp + 4);
#pragma unroll
                    for (int j = 0; j < 4; ++j) { refv[s][j] = c0[j]; refv[s][4 + j] = c1[j]; } }
                else {
#pragma unroll
                    for (int j = 0; j < 8; ++j) refv[s][j] = 0.f; } }
            float xh[8], xt[8];
#pragma unroll
            for (int j = 0; j < 8; ++j) { xh[j] = valid ? x[j] * __expf(cm[j] - refv[s][j]) : 0.f; xt[j] = valid ? x[j] * __expf(cm[j]) : 0.f; }
            qh[s] = pack8(xh); qt[s] = pack8(xt); }
        for (int J = 0; J <= I; ++J) { f32x4 acc = {0.f, 0.f, 0.f, 0.f};
#pragma unroll
            for (int s = 0; s < 2; ++s) { const int d0 = 32 * s + 8 * g; const bool valid = d0 < DK; const int d0c = valid ? d0 : 0;
                float x[8], cm[8]; mix_frag<TYPE, false>(a, h, (size_t)(row0 + 16 * J + r), 16 * J + r, d0c, x, cm);
                float xk[8];
#pragma unroll
                for (int j = 0; j < 8; ++j) xk[j] = valid ? x[j] * __expf(fminf(refv[s][j] - cm[j], 80.f)) : 0.f;
                acc = __builtin_amdgcn_mfma_f32_16x16x32_bf16(qh[s], pack8(xk), acc, 0, 0, 0); }
#pragma unroll
            for (int q = 0; q < 4; ++q) { const int i = 4 * g + q; const float v = (J < I || r <= i) ? acc[q] : 0.f; AB[i * BP + 16 * J + r] = (bf16)f2bf(v); } }
        if ((I & 1) == 0) {
#pragma unroll
            for (int q = 0; q < 4; ++q) AB[(4 * g + q) * BP + 16 * (I + 1) + r] = (bf16)0; }
        asm volatile("s_waitcnt lgkmcnt(0)" ::: "memory");
        const pg8::bf16x8 ah0 = *(const LAS pg8::bf16x8*)(AB + r * BP + 8 * g), ah1 = *(const LAS pg8::bf16x8*)(AB + r * BP + 32 + 8 * g);
        f32x4 o[TE];
#pragma unroll
        for (int te = 0; te < TE; ++te) { f32x4 acc = {0.f, 0.f, 0.f, 0.f};
            acc = __builtin_amdgcn_mfma_f32_16x16x32_bf16(qt[0], ldfrag(STh, BP, te * 16, 0, lane), acc, 0, 0, 0);
            acc = __builtin_amdgcn_mfma_f32_16x16x32_bf16(qt[1], ldfrag(STh, BP, te * 16, 32, lane), acc, 0, 0, 0);
            acc = __builtin_amdgcn_mfma_f32_16x16x32_bf16(ah0, ldfrag(VTh, BP, te * 16, 0, lane), acc, 0, 0, 0);
            if (I >= 2) acc = __builtin_amdgcn_mfma_f32_16x16x32_bf16(ah1, ldfrag(VTh, BP, te * 16, 32, lane), acc, 0, 0, 0);
            o[te] = acc; }
#pragma unroll
        for (int q = 0; q < 4; ++q) { float s1 = 0.f, s2 = 0.f;
#pragma unroll
            for (int te = 0; te < TE; ++te) { s1 += o[te][q]; s2 += o[te][q] * o[te][q]; }
#pragma unroll
            for (int m = 1; m < 16; m <<= 1) { s1 += __shfl_xor(s1, m); s2 += __shfl_xor(s2, m); }
            float mean = 0.f, rstd;
            if constexpr (TYPE == 2) { mean = s1 * (1.0f / DV); rstd = 1.0f / sqrtf(fmaxf(s2 * (1.0f / DV) - mean * mean, 0.f) + EPS); }
            else rstd = 1.0f / sqrtf(s2 * (1.0f / DV) + EPS);
#pragma unroll
            for (int te = 0; te < TE; ++te) AB[(4 * g + q) * OBP + te * 16 + r] = (bf16)f2bf((o[te][q] - mean) * rstd); }
        asm volatile("s_waitcnt lgkmcnt(0)" ::: "memory");
        constexpr int NCHK = DV / 8;
#pragma unroll
        for (int i = 0; i < (16 * NCHK) / 64; ++i) { const int cidx = lane + 64 * i, orow = cidx / NCHK, ch = cidx - orow * NCHK; const size_t row = (size_t)(row0 + 16 * I + orow);
            const v4u ov = *(const LAS v4u*)(AB + orow * OBP + 8 * ch); const v4u gv = *(const v4u*)(PROJ + row * NPROJ + C::CG + h * DV + 8 * ch);
            const unsigned ow[4] = {ov.x, ov.y, ov.z, ov.w}, gw[4] = {gv.x, gv.y, gv.z, gv.w}; float res[8];
            f32x4 w0 = {1.f, 1.f, 1.f, 1.f}, w1 = {1.f, 1.f, 1.f, 1.f};
            if constexpr (TYPE == 0) { const float* wp = a.gla_norm_w + layer * 384 + h * 96 + 8 * ch; w0 = *(const f32x4*)wp; w1 = *(const f32x4*)(wp + 4); }
            if constexpr (TYPE == 1) { const float* wp = a.hg_norm_w + layer * 256 + h * 64 + 8 * ch; w0 = *(const f32x4*)wp; w1 = *(const f32x4*)(wp + 4); }
#pragma unroll
            for (int j = 0; j < 4; ++j) { const float oa = __builtin_bit_cast(float, ow[j] << 16), ob = __builtin_bit_cast(float, ow[j] & 0xffff0000u), ga = __builtin_bit_cast(float, gw[j] << 16), gb = __builtin_bit_cast(float, gw[j] & 0xffff0000u);
                const float wa = (j < 2) ? w0[2 * j] : w1[2 * j - 4], wb = (j < 2) ? w0[2 * j + 1] : w1[2 * j - 3];
                const float sa = 1.0f / (1.0f + __expf(-ga)), sb = 1.0f / (1.0f + __expf(-gb));
                res[2 * j] = oa * wa * ((TYPE == 1) ? sa : ga * sa); res[2 * j + 1] = ob * wb * ((TYPE == 1) ? sb : gb * sb); }
            if (F8_OUT) { typedef int i32x2 __attribute__((ext_vector_type(2)));
                *(i32x2*)((unsigned char*)MIX + row * D + C::MIXOFF + h * DV + 8 * ch) = (i32x2){pk4_fp8(res[0] * S8_M, res[1] * S8_M, res[2] * S8_M, res[3] * S8_M), pk4_fp8(res[4] * S8_M, res[5] * S8_M, res[6] * S8_M, res[7] * S8_M)}; }
            else { v4u w; w.x = pk2(res[0], res[1]); w.y = pk2(res[2], res[3]); w.z = pk2(res[4], res[5]); w.w = pk2(res[6], res[7]); *(v4u*)(MIX + row * D + C::MIXOFF + h * DV + 8 * ch) = w; } }
    }
    __syncthreads();
}
__device__ __forceinline__ void p3c_outputs(const Args& a, int layer, LAS unsigned char* lds, int vcu, int G, int tid, int lane, int wave) {
    for (int unit = vcu; unit < NUNIT; unit += G) {
        mixc_batch<0>(a, layer, unit, lds, tid, lane, wave);
        mixc_batch<1>(a, layer, unit, lds, tid, lane, wave);
        mixc_batch<2>(a, layer, unit, lds, tid, lane, wave);
    }
}


constexpr int MW_ARGS = 800;
__device__ __forceinline__ const void* ld_argp(const volatile LAS unsigned* T, int i) {
    const unsigned lo = __builtin_amdgcn_readfirstlane(T[2 * i]), hi = __builtin_amdgcn_readfirstlane(T[2 * i + 1]);
    return (const void*)(((unsigned long long)hi << 32) | lo);
}
__device__ __forceinline__ Args load_args(LAS unsigned char* lds) {
    const volatile LAS unsigned* T = (const volatile LAS unsigned*)(lds + MISC_OFF) + MW_ARGS;
    Args a;
    a.x = (const float*)ld_argp(T, 0); a.c = (const float*)ld_argp(T, 1); a.pos = (const int*)ld_argp(T, 2); a.w_mod = (const float*)ld_argp(T, 3); a.b_mod = (const float*)ld_argp(T, 4);
    a.norm1_w = (const float*)ld_argp(T, 5); a.w_in = (const float*)ld_argp(T, 6); a.gla_wa2 = (const float*)ld_argp(T, 7); a.gla_ba2 = (const float*)ld_argp(T, 8); a.hg_lb = (const float*)ld_argp(T, 9);
    a.gla_norm_w = (const float*)ld_argp(T, 10); a.hg_norm_w = (const float*)ld_argp(T, 11); a.w_out = (const float*)ld_argp(T, 12); a.norm2_w = (const float*)ld_argp(T, 13); a.w_r = (const float*)ld_argp(T, 14);
    a.b_r = (const float*)ld_argp(T, 15); a.w_gu = (const float*)ld_argp(T, 16); a.b_gu = (const float*)ld_argp(T, 17); a.w_dn = (const float*)ld_argp(T, 18); a.b_dn = (const float*)ld_argp(T, 19);
    a.final_norm_w = (const float*)ld_argp(T, 20); a.out = (float*)ld_argp(T, 21); a.ws = (unsigned char*)ld_argp(T, 22); a.ph_lo = 0; a.ph_hi = 0;
    return a;
}
#define PH_CTX() { unsigned l_ = (unsigned)(size_t)lds; asm volatile("" : "+s"(l_)); lds = (LAS unsigned char*)(size_t)l_; } const Args args = load_args(lds); volatile LAS unsigned* MISC = (volatile LAS unsigned*)(lds + MISC_OFF); int tid_ = wv * 64 + (int)__builtin_amdgcn_mbcnt_hi(~0u, __builtin_amdgcn_mbcnt_lo(~0u, 0u)); asm volatile("" : "+v"(tid_)); const int tid = tid_, lane = tid & 63, wave = __builtin_amdgcn_readfirstlane(tid >> 6); \
    const int G = gridDim.x; const int bx = blockIdx.x; const int vcu = (G % 8 == 0) ? (bx % 8) * (G / 8) + bx / 8 : bx; unsigned char* ws = args.ws; gu32* ctl = (gu32*)(ws + WS_CTL); \
    (void)MISC; (void)lane; (void)wave; (void)vcu; (void)ctl; (void)bx; (void)tid
__device__ __forceinline__ void ph_p0(LAS unsigned char* lds, int wv) { PH_CTX(); p0_prologue(args, lds, vcu, G, tid, lane, wave); }
__device__ __forceinline__ void ph_p1(LAS unsigned char* lds, int wv, int layer_) { int layer = __builtin_amdgcn_readfirstlane(layer_); asm volatile("" : "+s"(layer)); PH_CTX();
    if (layer > 0) { moe_tables(ctl, layer - 1, MISC, tid); const int nrt = __builtin_amdgcn_readfirstlane((int)MISC[MW_NRT]);
        const int done = conv_t2(G) + conv_idle(nrt * 8, G) * NWAVES * CB7 + conv_idle(nrt * 4, G) * NWAVES * CB8; LAS float* scr = (LAS float*)(lds + wave * 16640);
        for (int it = done + vcu * NWAVES + wave; it < IT_LAYER; it += G * NWAVES) convert_item(args, layer, it, scr, lane);
        __syncthreads(); }
    rows_mfma<16>(args, layer, lds, MISC, ctl, vcu, G, tid, lane, wave); }
__device__ __forceinline__ void ph_p2(LAS unsigned char* lds, int wv, int layer_) { int layer = __builtin_amdgcn_readfirstlane(layer_); asm volatile("" : "+s"(layer)); PH_CTX();
    pg8::Gemm g{(const bf16*)(ws + WS_H), (const bf16*)(ws + WS_WIN + (size_t)layer * NPROJ * D * (F8_IN ? 1 : 2)), MTOK, NPROJ, F8_IN ? D / 2 : D}; pg8::StaticOrder S; S.init(MTOK, NPROJ, G, bx);
    pg8::EpiBf16Plain E{(bf16*)(ws + WS_PROJ), NPROJ, F8_IN ? 1.0f / (S8_H * S8_W) : 1.0f};
    pg8::gemm_phase<pg8::EpiBf16Plain, pg8::StaticOrder, true, true, F8_IN>(lds, g, S, E, tid);
    if (layer + 1 < DEPTH && G == 256 && bx >= 64) convert_range(args, layer + 1, ((bx - 64) * NWAVES + wave) * CB2, CB2, lds, lane, wave); }
__device__ __forceinline__ void ph_p3a(LAS unsigned char* lds, int wv, int layer_) { int layer = __builtin_amdgcn_readfirstlane(layer_); asm volatile("" : "+s"(layer)); PH_CTX(); p3a_summaries(args, layer, lds, vcu, G, tid, lane, wave); }
__device__ __forceinline__ void ph_p3b(LAS unsigned char* lds, int wv) { PH_CTX(); p3b_scan(args, vcu, G, tid); }
__device__ __forceinline__ void ph_p3c(LAS unsigned char* lds, int wv, int layer_) { int layer = __builtin_amdgcn_readfirstlane(layer_); asm volatile("" : "+s"(layer)); PH_CTX(); p3c_outputs(args, layer, lds, vcu, G, tid, lane, wave); }
__device__ __forceinline__ void ph_p4(LAS unsigned char* lds, int wv, int layer_) { int layer = __builtin_amdgcn_readfirstlane(layer_); asm volatile("" : "+s"(layer)); PH_CTX();
    pg8::Gemm g{(const bf16*)(ws + WS_MIX), (const bf16*)(ws + WS_WOUT + (size_t)layer * D * D * (F8_OUT ? 1 : 2)), MTOK, D, F8_OUT ? D / 2 : D}; pg8::StaticOrder S; S.init(MTOK, D, G, bx);
    pg8::EpiResGate E{(layer == 0) ? args.x : (const float*)(ws + WS_X), (float*)(ws + WS_X), D, (const float*)(ws + WS_MOD) + (size_t)layer * 2 * 6144 + 2 * D, 6144, SEQ, F8_OUT ? 1.0f / (S8_M * S8_W) : 1.0f};
    pg8::gemm_phase<pg8::EpiResGate, pg8::StaticOrder, true, true, F8_OUT>(lds, g, S, E, tid); }
__device__ __forceinline__ void ph_p5(LAS unsigned char* lds, int wv, int layer_) { int layer = __builtin_amdgcn_readfirstlane(layer_); asm volatile("" : "+s"(layer)); PH_CTX(); rows_mfma<32>(args, layer, lds, MISC, ctl, vcu, G, tid, lane, wave); }
__device__ __forceinline__ void ph_p7(LAS unsigned char* lds, int wv, int layer_) { int layer = __builtin_amdgcn_readfirstlane(layer_); asm volatile("" : "+s"(layer)); PH_CTX();
    moe_tables(ctl, layer, MISC, tid);
    const int nrt = __builtin_amdgcn_readfirstlane((int)MISC[MW_NRT]);
    pg8::Gemm g{(const bf16*)(ws + WS_A1), (const bf16*)(ws + WS_WGU + (size_t)layer * NE * 2048 * D), nrt * 256, NE * 2048, D / 2};
    pg8::MoeOrder S{8, G, vcu, nrt * 8, (const LAS int*)(lds + MISC_OFF + 4 * MW_TILE)};
    pg8::EpiSwiglu E{ws + WS_ACT, FFN, args.b_gu + (size_t)layer * NE * 2048, 1.0f / (S8_H * S8_W), S8_A};
    pg8::gemm_phase<pg8::EpiSwiglu, pg8::MoeOrder, true, true, true>(lds, g, S, E, tid);
    { const int rem = (nrt * 8) % G; if (layer + 1 < DEPTH && rem != 0 && vcu >= rem) convert_range(args, layer + 1, conv_t2(G) + ((vcu - rem) * NWAVES + wave) * CB7, CB7, lds, lane, wave); } }
__device__ __forceinline__ void ph_p8(LAS unsigned char* lds, int wv, int layer_) { int layer = __builtin_amdgcn_readfirstlane(layer_); asm volatile("" : "+s"(layer)); PH_CTX();
    moe_tables(ctl, layer, MISC, tid);
    const int nrt = __builtin_amdgcn_readfirstlane((int)MISC[MW_NRT]);
    pg8::Gemm g{(const bf16*)(ws + WS_ACT), (const bf16*)(ws + WS_WDN + (size_t)layer * NE * D * FFN), nrt * 256, NE * D, FFN / 2};
    pg8::MoeOrder S{4, G, vcu, nrt * 4, (const LAS int*)(lds + MISC_OFF + 4 * MW_TILE)};
    if constexpr (Y8) { pg8::EpiFp8Bias E{ws + WS_Y, D, args.b_dn + (size_t)layer * NE * D, D, 1.0f / (S8_A * S8_W), S8_Y};
        pg8::gemm_phase<pg8::EpiFp8Bias, pg8::MoeOrder, true, true, true>(lds, g, S, E, tid); }
    else { pg8::EpiBf16Bias E{(bf16*)(ws + WS_Y), D, args.b_dn + (size_t)layer * NE * D, D, 1.0f / (S8_A * S8_W)};
        pg8::gemm_phase<pg8::EpiBf16Bias, pg8::MoeOrder, true, true, true>(lds, g, S, E, tid); }
    { const int rem = (nrt * 4) % G; if (layer + 1 < DEPTH && rem != 0 && vcu >= rem) convert_range(args, layer + 1, conv_t2(G) + conv_idle(nrt * 8, G) * NWAVES * CB7 + ((vcu - rem) * NWAVES + wave) * CB8, CB8, lds, lane, wave); } }
__device__ __forceinline__ void ph_final(LAS unsigned char* lds, int wv) { PH_CTX(); final_rows(args, lds, vcu, G, tid, lane); }

#ifndef DBL_MASK
#define DBL_MASK 0
#endif
#if DBL_MASK
#define RUN(bit, call) do { if ((DBL_MASK >> (bit)) & 1) { const unsigned long long t0_ = __builtin_amdgcn_s_memrealtime(); call; const unsigned long long t1_ = __builtin_amdgcn_s_memrealtime(); \
        while (__builtin_amdgcn_s_memrealtime() - t1_ < t1_ - t0_) __builtin_amdgcn_s_sleep(8); } else { call; } } while (0)
#else
#define RUN(bit, call) do { call; } while (0)
#endif
__global__ void __launch_bounds__(NTHR, 2) hybrid_fwd(Args args) {
    extern __shared__ __attribute__((aligned(16))) unsigned char lds_raw[];
    LAS unsigned char* lds = (LAS unsigned char*)lds_raw;
    volatile LAS unsigned* MISC = (volatile LAS unsigned*)(lds + MISC_OFF);
    const int tid = threadIdx.x; const int wv = __builtin_amdgcn_readfirstlane(tid >> 6);
    gu32* ctl = (gu32*)(args.ws + WS_CTL);
    for (int u = tid; u < (LDS_BYTES - MISC_OFF) / 4; u += NTHR) MISC[u] = 0u;
    __syncthreads();
    if (tid == 0) {
#define ST_ARG(i, p) do { const unsigned long long v_ = (unsigned long long)(p); MISC[MW_ARGS + 2 * (i)] = (unsigned)v_; MISC[MW_ARGS + 2 * (i) + 1] = (unsigned)(v_ >> 32); } while (0)
        ST_ARG(0, args.x); ST_ARG(1, args.c); ST_ARG(2, args.pos); ST_ARG(3, args.w_mod); ST_ARG(4, args.b_mod); ST_ARG(5, args.norm1_w); ST_ARG(6, args.w_in); ST_ARG(7, args.gla_wa2); ST_ARG(8, args.gla_ba2);
        ST_ARG(9, args.hg_lb); ST_ARG(10, args.gla_norm_w); ST_ARG(11, args.hg_norm_w); ST_ARG(12, args.w_out); ST_ARG(13, args.norm2_w); ST_ARG(14, args.w_r); ST_ARG(15, args.b_r); ST_ARG(16, args.w_gu);
        ST_ARG(17, args.b_gu); ST_ARG(18, args.w_dn); ST_ARG(19, args.b_dn); ST_ARG(20, args.final_norm_w); ST_ARG(21, args.out); ST_ARG(22, args.ws);
#undef ST_ARG
    }
    __syncthreads();
    const int lo = args.ph_lo, hi = args.ph_hi;
    const bool multi = (hi - lo) > 1;
    XcdBarrier bar; bar.bar = (unsigned*)(ctl + CW_BAR); bar.x = 0; bar.st = nullptr;
    if (multi) bar = xcd_barrier_post((unsigned*)(ctl + CW_BAR), MISC + MW_BAR);
#define IN(k) (lo <= (k) && (k) < hi)
#define SEAM(k) do { if (IN(k) && IN((k) + 1)) xcd_barrier(bar); } while (0)

    if (IN(0)) RUN(0, ph_p0(lds, wv));
    SEAM(0);
    for (int layer = 0; layer < DEPTH; ++layer) {
        const int pb = 1 + 9 * layer;
        if (IN(pb + 0)) RUN(1, ph_p1(lds, wv, layer));
        SEAM(pb + 0);
        if (IN(pb + 1)) RUN(2, ph_p2(lds, wv, layer));
        SEAM(pb + 1);
        if (IN(pb + 2)) RUN(3, ph_p3a(lds, wv, layer));
        SEAM(pb + 2);
        if (IN(pb + 3)) RUN(4, ph_p3b(lds, wv));
        SEAM(pb + 3);
        if (IN(pb + 4)) RUN(5, ph_p3c(lds, wv, layer));
        SEAM(pb + 4);
        if (IN(pb + 5)) RUN(6, ph_p4(lds, wv, layer));
        SEAM(pb + 5);
        if (IN(pb + 6)) RUN(7, ph_p5(lds, wv, layer));
        SEAM(pb + 6);
        if (IN(pb + 7)) RUN(9, ph_p7(lds, wv, layer));
        SEAM(pb + 7);
        if (IN(pb + 8)) RUN(10, ph_p8(lds, wv, layer));
        SEAM(pb + 8);
    }
    if (IN(NPHASE - 1)) RUN(11, ph_final(lds, wv));
#undef IN
#undef SEAM
}

#ifndef MK_SINGLE
#define MK_SINGLE 1
#endif
extern "C" void kernel_launch(void* const* d_in, const int* in_sizes, int n_in, void* d_out, int out_size, void* d_ws, size_t ws_size, hipStream_t stream) {
    static int grid = 0;
    if (grid == 0) {
        if (n_in != 21 || in_sizes[0] != MTOK * D || out_size != MTOK * D || ws_size < WS_END) { fprintf(stderr, "kernel_launch: unexpected problem shape (n_in %d, in0 %d, out %d, ws %zu)\n", n_in, n_in > 0 ? in_sizes[0] : -1, out_size, ws_size); grid = -1; return; }
        int dev = 0, cus = 0, per_cu = 0;
        if (hipGetDevice(&dev) != hipSuccess || hipDeviceGetAttribute(&cus, hipDeviceAttributeMultiprocessorCount, dev) != hipSuccess) { grid = -1; return; }
        if (hipFuncSetAttribute((const void*)hybrid_fwd, hipFuncAttributeMaxDynamicSharedMemorySize, LDS_BYTES) != hipSuccess) { fprintf(stderr, "kernel_launch: hipFuncSetAttribute failed\n"); grid = -1; return; }
        if (hipOccupancyMaxActiveBlocksPerMultiprocessor(&per_cu, (const void*)hybrid_fwd, NTHR, LDS_BYTES) != hipSuccess || per_cu < 1) fprintf(stderr, "kernel_launch: occupancy query says %d\n", per_cu);
        (void)hipGetLastError();
        grid = cus;
    }
    if (grid < 0) return;
    (void)hipMemsetAsync((char*)d_ws + WS_CTL, 0, CTL_ZERO_BYTES, stream);
    Args a{};
    a.x = (const float*)d_in[0]; a.c = (const float*)d_in[1]; a.pos = (const int*)d_in[2]; a.w_mod = (const float*)d_in[3]; a.b_mod = (const float*)d_in[4]; a.norm1_w = (const float*)d_in[5];
    a.w_in = (const float*)d_in[6]; a.gla_wa2 = (const float*)d_in[7]; a.gla_ba2 = (const float*)d_in[8]; a.hg_lb = (const float*)d_in[9]; a.gla_norm_w = (const float*)d_in[10]; a.hg_norm_w = (const float*)d_in[11];
    a.w_out = (const float*)d_in[12]; a.norm2_w = (const float*)d_in[13]; a.w_r = (const float*)d_in[14]; a.b_r = (const float*)d_in[15]; a.w_gu = (const float*)d_in[16]; a.b_gu = (const float*)d_in[17];
    a.w_dn = (const float*)d_in[18]; a.b_dn = (const float*)d_in[19]; a.final_norm_w = (const float*)d_in[20]; a.out = (float*)d_out; a.ws = (unsigned char*)d_ws;
#if MK_SINGLE
    a.ph_lo = 0; a.ph_hi = NPHASE;
    hipLaunchKernelGGL(hybrid_fwd, dim3(grid), dim3(NTHR), LDS_BYTES, stream, a);
#else
    for (int p = 0; p < NPHASE; ++p) { a.ph_lo = p; a.ph_hi = p + 1; hipLaunchKernelGGL(hybrid_fwd, dim3(grid), dim3(NTHR), LDS_BYTES, stream, a); }
#endif
}
```

```cpp
#include <hip/hip_runtime.h>
#include <cstdio>
#include <cstdint>
namespace pg8 {
#define PG8_LAS __attribute__((address_space(3)))
typedef unsigned short bf16_t;
typedef short bf16x8 __attribute__((ext_vector_type(8)));
typedef float f32x4 __attribute__((ext_vector_type(4)));
typedef unsigned u32x4 __attribute__((ext_vector_type(4)));
constexpr int BM = 256, BK = 64, HALF = 128, HTB = HALF * BK * 2  , STAGE_BYTES = 8 * HTB, NXCD = 8, WGM = 8;

__host__ __device__ __forceinline__ int lds_byte(int r, int c) { const int st = (r >> 4) * 2 + (c >> 5), rr = r & 15, cc = c & 31, ob = rr * 64 + cc * 2; return st * 1024 + (ob ^ (((ob >> 9) & 1) << 5)); }
__host__ __device__ __forceinline__ void stage_rc(int b, int& R, int& C) { const int st = b / 1024, sb = b % 1024, swz = sb ^ (((sb >> 9) & 1) << 5); R = (st >> 1) * 16 + swz / 64; C = (st & 1) * 32 + (swz % 64) / 2; }
__host__ __device__ __forceinline__ int perm32(int rho) { const int n = rho >> 4, i = rho & 15; return 8 * (i >> 2) + 4 * n + (i & 3); }

struct Unit { int pm, pn, e, pl; };
struct Gemm { const bf16_t* A; const bf16_t* Bt; int M, N, K; };

struct StaticOrder {
    int nM, nN, nwg, G, c;
    __host__ __device__ void init(int M, int N, int G_, int c_) { nM = M / BM; nN = N / BM; nwg = nM * nN; G = G_; c = c_; }
    __host__ __device__ bool next(int i, Unit& u) const {
        const long L = (long)i * G + c; if (L >= nwg) return false;
        int wgid = (int)L; { const int q = nwg / NXCD, r = nwg % NXCD, xcd = wgid % NXCD, off = wgid / NXCD; wgid = (xcd < r ? xcd * (q + 1) : r * (q + 1) + (xcd - r) * q) + off; }
        const int nig = WGM * nN, gid = wgid / nig, fm = gid * WGM, gsz = (nM - fm) < WGM ? (nM - fm) : WGM;
        u.pm = fm + ((wgid % nig) % gsz); u.pn = (wgid % nig) / gsz; u.e = 0; u.pl = u.pn; return true;
    }
    __device__ __forceinline__ void a_ready(const Unit&) const {}
    __device__ __forceinline__ void done(const Unit&) const {}
};

__device__ __forceinline__ unsigned cvt_pk_bf16(float lo, float hi) { unsigned r; asm volatile("v_cvt_pk_bf16_f32 %0, %1, %2" : "=v"(r) : "v"(lo), "v"(hi)); return r; }

struct EpiBf16Plain {
    static constexpr bool PERM = true, AFTER_DRAIN = false;
    bf16_t* O; int ldc; float sc;
    __device__ __forceinline__ void operator()(const f32x4 (&acc)[2][2][4][2], const Unit& u, int wr, int wc, int fr, int fq) const {
        const int row0 = u.pm * BM + wr * 64 + fr; const int col0 = u.pn * BM + wc * 32 + 8 * fq;
#pragma unroll
        for (int ai = 0; ai < 2; ++ai)
#pragma unroll
            for (int m = 0; m < 4; ++m) { bf16_t* rowp = O + (size_t)(row0 + ai * HALF + m * 16) * ldc + col0;
#pragma unroll
                for (int bj = 0; bj < 2; ++bj) { const f32x4 v0 = acc[ai][bj][m][0] * sc, v1 = acc[ai][bj][m][1] * sc;
                    u32x4 w; w.x = cvt_pk_bf16(v0[0], v0[1]); w.y = cvt_pk_bf16(v0[2], v0[3]); w.z = cvt_pk_bf16(v1[0], v1[1]); w.w = cvt_pk_bf16(v1[2], v1[3]);
                    *(u32x4*)(rowp + bj * HALF) = w; } }
    }
};
struct EpiResGate {
    static constexpr bool PERM = false, AFTER_DRAIN = false;
    const float* base; float* out; int ldc; const float* gate; int gpitch; int rows_per_batch; float sc;
    __device__ __forceinline__ void operator()(const f32x4 (&acc)[2][2][4][2], const Unit& u, int wr, int wc, int fr, int fq) const {
        const int row0 = u.pm * BM + wr * 64 + fr, col0 = u.pn * BM + wc * 32 + 4 * fq;
        const float* gp = gate + (size_t)((u.pm * BM) / rows_per_batch) * gpitch + col0;
        f32x4 gv[2][2];
#pragma unroll
        for (int bj = 0; bj < 2; ++bj)
#pragma unroll
            for (int n = 0; n < 2; ++n) gv[bj][n] = *(const f32x4*)(gp + bj * HALF + n * 16) * sc;
#pragma unroll
        for (int ai = 0; ai < 2; ++ai)
#pragma unroll
            for (int m = 0; m < 4; ++m) { const size_t off = (size_t)(row0 + ai * HALF + m * 16) * ldc + col0;
#pragma unroll
                for (int bj = 0; bj < 2; ++bj)
#pragma unroll
                    for (int n = 0; n < 2; ++n) { const f32x4 bs = *(const f32x4*)(base + off + bj * HALF + n * 16);
                        *(f32x4*)(out + off + bj * HALF + n * 16) = bs + gv[bj][n] * acc[ai][bj][m][n]; }
                asm volatile("" ::: "memory"); }
    }
};
struct EpiSwiglu {
    static constexpr bool PERM = true, AFTER_DRAIN = false;
    unsigned char* O; int ldc; const float* bias; float inv_in, out_scale;
    __device__ __forceinline__ float act1(float g, float up) const {
        g = fminf(g, 7.0f); up = fminf(fmaxf(up, -7.0f), 7.0f);
        const float s = 1.0f / (1.0f + __expf(-1.702f * g));
        return fminf(fmaxf((up + 1.0f) * g * s * out_scale, -448.f), 448.f);
    }
    __device__ __forceinline__ void operator()(const f32x4 (&acc)[2][2][4][2], const Unit& u, int wr, int wc, int fr, int fq) const {
        const int row0 = u.pm * BM + wr * 64 + fr; const int jj0 = wc * 32 + 8 * fq; const int col0 = u.pl * HALF + jj0;
        const float* bp = bias + (size_t)u.e * 2048 + col0;
        f32x4 bg[2], bu[2];
#pragma unroll
        for (int n = 0; n < 2; ++n) { bg[n] = *(const f32x4*)(bp + 4 * n); bu[n] = *(const f32x4*)(bp + 1024 + 4 * n); }
#pragma unroll
        for (int ai = 0; ai < 2; ++ai)
#pragma unroll
            for (int m = 0; m < 4; ++m) { unsigned char* rowp = O + (size_t)(row0 + ai * HALF + m * 16) * ldc + col0;
                f32x4 r[2];
#pragma unroll
                for (int n = 0; n < 2; ++n) { const f32x4 g = acc[ai][0][m][n] * inv_in + bg[n], up = acc[ai][1][m][n] * inv_in + bu[n];
#pragma unroll
                    for (int j = 0; j < 4; ++j) r[n][j] = act1(g[j], up[j]); }
                int w0 = 0, w1 = 0;
                w0 = __builtin_amdgcn_cvt_pk_fp8_f32(r[0][0], r[0][1], w0, false); w0 = __builtin_amdgcn_cvt_pk_fp8_f32(r[0][2], r[0][3], w0, true);
                w1 = __builtin_amdgcn_cvt_pk_fp8_f32(r[1][0], r[1][1], w1, false); w1 = __builtin_amdgcn_cvt_pk_fp8_f32(r[1][2], r[1][3], w1, true);
                typedef int i32x2 __attribute__((ext_vector_type(2))); *(i32x2*)rowp = (i32x2){w0, w1}; }
    }
};
struct EpiBf16Bias {
    static constexpr bool PERM = true, AFTER_DRAIN = false;
    bf16_t* O; int ldc; const float* bias; int bpitch; float inv_in;
    __device__ __forceinline__ void operator()(const f32x4 (&acc)[2][2][4][2], const Unit& u, int wr, int wc, int fr, int fq) const {
        const int row0 = u.pm * BM + wr * 64 + fr; const int col0 = u.pl * BM + wc * 32 + 8 * fq;
        const float* bp = bias + (size_t)u.e * bpitch + col0;
        f32x4 bv[2][2];
#pragma unroll
        for (int bj = 0; bj < 2; ++bj)
#pragma unroll
            for (int n = 0; n < 2; ++n) bv[bj][n] = *(const f32x4*)(bp + bj * HALF + 4 * n);
#pragma unroll
        for (int ai = 0; ai < 2; ++ai)
#pragma unroll
            for (int m = 0; m < 4; ++m) { bf16_t* rowp = O + (size_t)(row0 + ai * HALF + m * 16) * ldc + col0;
#pragma unroll
                for (int bj = 0; bj < 2; ++bj) { const f32x4 v0 = acc[ai][bj][m][0] * inv_in + bv[bj][0], v1 = acc[ai][bj][m][1] * inv_in + bv[bj][1];
                    u32x4 w; w.x = cvt_pk_bf16(v0[0], v0[1]); w.y = cvt_pk_bf16(v0[2], v0[3]); w.z = cvt_pk_bf16(v1[0], v1[1]); w.w = cvt_pk_bf16(v1[2], v1[3]);
                    *(u32x4*)(rowp + bj * HALF) = w; } }
    }
};
struct EpiFp8Bias {
    static constexpr bool PERM = true, AFTER_DRAIN = false;
    unsigned char* O; int ldc; const float* bias; int bpitch; float inv_in, out_scale;
    __device__ __forceinline__ int pk4(f32x4 v) const { int w = 0; w = __builtin_amdgcn_cvt_pk_fp8_f32(fminf(fmaxf(v[0], -448.f), 448.f), fminf(fmaxf(v[1], -448.f), 448.f), w, false);
        return __builtin_amdgcn_cvt_pk_fp8_f32(fminf(fmaxf(v[2], -448.f), 448.f), fminf(fmaxf(v[3], -448.f), 448.f), w, true); }
    __device__ __forceinline__ void operator()(const f32x4 (&acc)[2][2][4][2], const Unit& u, int wr, int wc, int fr, int fq) const {
        const int row0 = u.pm * BM + wr * 64 + fr; const int col0 = u.pl * BM + wc * 32 + 8 * fq;
        const float* bp = bias + (size_t)u.e * bpitch + col0;
        f32x4 bv[2][2];
#pragma unroll
        for (int bj = 0; bj < 2; ++bj)
#pragma unroll
            for (int n = 0; n < 2; ++n) bv[bj][n] = *(const f32x4*)(bp + bj * HALF + 4 * n);
#pragma unroll
        for (int ai = 0; ai < 2; ++ai)
#pragma unroll
            for (int m = 0; m < 4; ++m) { unsigned char* rowp = O + (size_t)(row0 + ai * HALF + m * 16) * ldc + col0;
#pragma unroll
                for (int bj = 0; bj < 2; ++bj) { const f32x4 v0 = (acc[ai][bj][m][0] * inv_in + bv[bj][0]) * out_scale, v1 = (acc[ai][bj][m][1] * inv_in + bv[bj][1]) * out_scale;
                    typedef int i32x2 __attribute__((ext_vector_type(2))); *(i32x2*)(rowp + bj * HALF) = (i32x2){pk4(v0), pk4(v1)}; } }
    }
};
struct MoeOrder {
    int nN, G, c, nunits; const PG8_LAS int* tile_pm;
    __device__ __forceinline__ bool next(int i, Unit& u) const {
        const int L = i * G + c; if (L >= nunits) return false;
        const int idx = L / nN, pl = L - idx * nN, pm = __builtin_amdgcn_readfirstlane(tile_pm[idx]), e = pm >> 6;
        u.pm = pm; u.pl = pl; u.e = e; u.pn = e * nN + pl; return true;
    }
    __device__ __forceinline__ void a_ready(const Unit&) const {}
    __device__ __forceinline__ void done(const Unit&) const {}
};
typedef int v4i32_t __attribute__((ext_vector_type(4)));
typedef int v8i32_t __attribute__((ext_vector_type(8)));
template <class Epi, class Sched, bool ALIGN_EPI = false, bool SP2 = false, bool FP8 = false>
__device__ __forceinline__ void gemm_phase(PG8_LAS unsigned char* lds, const Gemm g, const Sched& S, const Epi& E, int tid_in) {
    int tid_ = tid_in; asm volatile("" : "+v"(tid_)); const int tid = tid_, wid = __builtin_amdgcn_readfirstlane(tid >> 6), lane = tid & 63, wr = wid >> 2, wc = wid & 3, fr = lane & 15, fq = lane >> 4;
    const int K = g.K, nt = K / BK;
    unsigned voffA, voffB;
    { int R, C; stage_rc(tid * 16, R, C); const int Rb = Epi::PERM ? ((R & ~31) + perm32(R & 31)) : R;
        voffA = (unsigned)(R * K + C) * 2u; voffB = (unsigned)(Rb * K + C) * 2u; }
    const size_t rstep = (size_t)64 * K * 2;
    const size_t kstep = (size_t)(BK * 2);
    const size_t hstep = (size_t)HALF * K * 2;
    const size_t tstep = 2 * hstep;
    const unsigned ldsw = (unsigned)wid * 1024u;
    const int aoff = lds_byte(wr * 64 + fr, fq * 8), boff = lds_byte(wc * 32 + fr, fq * 8);
#define PG8_SA(b, h) (((b) * 2 + (h)) * HTB)
#define PG8_SB(b, h) ((4 + (b) * 2 + (h)) * HTB)
#define PG8_STAGE(bufoff, gbase, voff) do { _Pragma("unroll") for (int _i = 0; _i < 2; ++_i) \
        __builtin_amdgcn_global_load_lds((const unsigned*)((const char*)(gbase) + _i * rstep + (voff)), (PG8_LAS unsigned*)(lds + (bufoff) + ldsw + _i * 8192), 16, 0, 0); } while (0)
#define PG8_LDA(dst, b, h) do { _Pragma("unroll") for (int m = 0; m < 4; ++m) _Pragma("unroll") for (int k = 0; k < 2; ++k) dst[m][k] = *(const PG8_LAS bf16x8*)(lds + PG8_SA(b, h) + aoff + m * 2048 + k * 1024); } while (0)
#define PG8_LDB(dst, b, h) do { _Pragma("unroll") for (int n = 0; n < 2; ++n) _Pragma("unroll") for (int k = 0; k < 2; ++k) dst[n][k] = *(const PG8_LAS bf16x8*)(lds + PG8_SB(b, h) + boff + n * 2048 + k * 1024); } while (0)
#define PG8_MMA(ai, bj, At, Bt) do { __builtin_amdgcn_s_setprio(1); _Pragma("unroll") for (int m = 0; m < 4; ++m) _Pragma("unroll") for (int n = 0; n < 2; ++n) { \
        if constexpr (FP8) { const v8i32_t a8_ = __builtin_shufflevector(__builtin_bit_cast(v4i32_t, At[m][0]), __builtin_bit_cast(v4i32_t, At[m][1]), 0, 1, 2, 3, 4, 5, 6, 7); \
            const v8i32_t b8_ = __builtin_shufflevector(__builtin_bit_cast(v4i32_t, Bt[n][0]), __builtin_bit_cast(v4i32_t, Bt[n][1]), 0, 1, 2, 3, 4, 5, 6, 7); \
            asm volatile("v_mfma_scale_f32_16x16x128_f8f6f4 %0, %1, %2, %0, %3, %3 op_sel_hi:[0,0,0]" : "+v"(acc[ai][bj][m][n]) : "v"(b8_), "v"(a8_), "v"(one8_)); } \
        else { _Pragma("unroll") for (int k = 0; k < 2; ++k) acc[ai][bj][m][n] = __builtin_amdgcn_mfma_f32_16x16x32_bf16(Bt[n][k], At[m][k], acc[ai][bj][m][n], 0, 0, 0); } } \
        __builtin_amdgcn_s_setprio(0); } while (0)
#define PG8_WAIT_V(n) asm volatile("s_waitcnt vmcnt(" #n ")" ::: "memory")
#define PG8_WAIT_L(n) asm volatile("s_waitcnt lgkmcnt(" #n ")" ::: "memory")
#define PG8_BAR __builtin_amdgcn_s_barrier()
#define PG8_SCHED __builtin_amdgcn_sched_barrier(0)
    Unit cur, nxt; int ui = 0;
    if (!S.next(0, cur)) return;
    f32x4 acc[2][2][4][2];
#pragma unroll
    for (int a = 0; a < 2; ++a)
#pragma unroll
        for (int b = 0; b < 2; ++b)
#pragma unroll
            for (int m = 0; m < 4; ++m)
#pragma unroll
                for (int n = 0; n < 2; ++n) acc[a][b][m][n] = (f32x4){0.f, 0.f, 0.f, 0.f};
    bf16x8 At[4][2], B0[2][2], B1[2][2];
    int one8_ = 0x7f7f7f7f; asm volatile("" : "+v"(one8_));
    const char* cA = (const char*)g.A + (size_t)cur.pm * tstep; const char* cB = (const char*)g.Bt + (size_t)cur.pn * tstep;
    S.a_ready(cur);
    if constexpr (SP2) {
        PG8_STAGE(PG8_SB(0, 0), cB, voffB); PG8_STAGE(PG8_SB(0, 1), cB + hstep, voffB); PG8_STAGE(PG8_SA(0, 0), cA, voffA); PG8_STAGE(PG8_SA(0, 1), cA + hstep, voffA);
        if (wr == 1) PG8_BAR;
        PG8_WAIT_V(2); PG8_BAR;
        PG8_STAGE(PG8_SB(1, 0), cB + kstep, voffB); PG8_STAGE(PG8_SA(1, 0), cA + kstep, voffA); PG8_STAGE(PG8_SB(1, 1), cB + hstep + kstep, voffB);
        PG8_WAIT_V(6); PG8_BAR;
    } else {
        PG8_STAGE(PG8_SB(0, 0), cB, voffB); PG8_STAGE(PG8_SA(0, 0), cA, voffA); PG8_STAGE(PG8_SB(0, 1), cB + hstep, voffB); PG8_STAGE(PG8_SA(0, 1), cA + hstep, voffA);
        if (wr == 1) PG8_BAR;
        PG8_WAIT_V(4); PG8_BAR;
        PG8_STAGE(PG8_SB(1, 0), cB + kstep, voffB); PG8_STAGE(PG8_SA(1, 0), cA + kstep, voffA); PG8_STAGE(PG8_SB(1, 1), cB + hstep + kstep, voffB);
        PG8_WAIT_V(6); PG8_BAR;
    }
    for (;;) {
        const bool has_next = S.next(ui + 1, nxt);
        const char* nA = has_next ? (const char*)g.A + (size_t)nxt.pm * tstep : cA; const char* nB = has_next ? (const char*)g.Bt + (size_t)nxt.pn * tstep : cB;
#pragma unroll 1
        for (int t = 0; t < nt; t += 2) {
            const bool last = (t == nt - 2);
            const char* a1 = cA + (size_t)(t + 1) * kstep;
            const char* a2 = last ? nA : cA + (size_t)(t + 2) * kstep; const char* b2 = last ? nB : cB + (size_t)(t + 2) * kstep;
            const char* a3 = a2 + kstep; const char* b3 = b2 + kstep;
            if (last && has_next) S.a_ready(nxt);
            if constexpr (SP2) {
            PG8_LDB(B0, 0, 0); PG8_LDB(B1, 0, 1); PG8_SCHED; PG8_LDA(At, 0, 0); PG8_STAGE(PG8_SA(1, 1), a1 + hstep, voffA);
            PG8_WAIT_V(8); PG8_WAIT_L(0); PG8_BAR; PG8_MMA(0, 0, At, B0); PG8_MMA(0, 1, At, B1); PG8_BAR; PG8_SCHED;
            PG8_LDA(At, 0, 1); PG8_STAGE(PG8_SB(0, 0), b2, voffB); PG8_STAGE(PG8_SB(0, 1), b2 + hstep, voffB); PG8_STAGE(PG8_SA(0, 0), a2, voffA);
            PG8_WAIT_V(8); PG8_WAIT_L(0); PG8_BAR; PG8_MMA(1, 0, At, B0); PG8_MMA(1, 1, At, B1); PG8_BAR; PG8_SCHED;
            PG8_LDB(B0, 1, 0); PG8_LDB(B1, 1, 1); PG8_SCHED; PG8_LDA(At, 1, 0); PG8_STAGE(PG8_SA(0, 1), a2 + hstep, voffA);
            PG8_WAIT_V(8); PG8_WAIT_L(0); PG8_BAR; PG8_MMA(0, 0, At, B0); PG8_MMA(0, 1, At, B1); PG8_BAR; PG8_SCHED;
            PG8_LDA(At, 1, 1); PG8_STAGE(PG8_SB(1, 0), b3, voffB); PG8_STAGE(PG8_SB(1, 1), b3 + hstep, voffB); PG8_STAGE(PG8_SA(1, 0), a3, voffA);
            PG8_WAIT_V(8); PG8_WAIT_L(0); PG8_BAR; PG8_MMA(1, 0, At, B0); PG8_MMA(1, 1, At, B1); PG8_BAR; PG8_SCHED;
            } else {
            PG8_LDB(B0, 0, 0); PG8_SCHED; PG8_LDA(At, 0, 0); PG8_STAGE(PG8_SA(1, 1), a1 + hstep, voffA);
            PG8_WAIT_L(8); PG8_BAR; PG8_WAIT_L(0); PG8_MMA(0, 0, At, B0); PG8_BAR; PG8_SCHED;
            PG8_LDB(B1, 0, 1); PG8_STAGE(PG8_SB(0, 0), b2, voffB);
            PG8_BAR; PG8_WAIT_L(0); PG8_MMA(0, 1, At, B1); PG8_BAR;
            PG8_LDA(At, 0, 1); PG8_STAGE(PG8_SA(0, 0), a2, voffA);
            PG8_BAR; PG8_WAIT_L(0); PG8_MMA(1, 0, At, B0); PG8_BAR; PG8_SCHED;
            PG8_STAGE(PG8_SB(0, 1), b2 + hstep, voffB);
            PG8_WAIT_V(6); PG8_BAR; PG8_MMA(1, 1, At, B1); PG8_BAR;
            PG8_LDB(B0, 1, 0); PG8_SCHED; PG8_LDA(At, 1, 0); PG8_STAGE(PG8_SA(0, 1), a2 + hstep, voffA);
            PG8_WAIT_L(8); PG8_BAR; PG8_WAIT_L(0); PG8_MMA(0, 0, At, B0); PG8_BAR; PG8_SCHED;
            PG8_LDB(B1, 1, 1); PG8_STAGE(PG8_SB(1, 0), b3, voffB);
            PG8_BAR; PG8_WAIT_L(0); PG8_MMA(0, 1, At, B1); PG8_BAR;
            PG8_LDA(At, 1, 1); PG8_STAGE(PG8_SA(1, 0), a3, voffA);
            PG8_BAR; PG8_WAIT_L(0); PG8_MMA(1, 0, At, B0); PG8_BAR; PG8_SCHED;
            PG8_STAGE(PG8_SB(1, 1), b3 + hstep, voffB);
            PG8_WAIT_V(6); PG8_BAR; PG8_MMA(1, 1, At, B1); PG8_BAR;
            }
        }
        if constexpr (FP8) asm volatile("s_nop 7\n\ts_nop 7" ::: "memory");
        if constexpr (ALIGN_EPI) { if (wr == 0) PG8_BAR; }
        if constexpr (!Epi::AFTER_DRAIN) { int ln_ = (int)__builtin_amdgcn_mbcnt_hi(~0u, __builtin_amdgcn_mbcnt_lo(~0u, 0u)); asm volatile("" : "+v"(ln_)); E(acc, cur, wr, wc, ln_ & 15, ln_ >> 4); S.done(cur); }
        if (!has_next) break;
#pragma unroll
        for (int a = 0; a < 2; ++a)
#pragma unroll
            for (int b = 0; b < 2; ++b)
#pragma unroll
                for (int m = 0; m < 4; ++m)
#pragma unroll
                    for (int n = 0; n < 2; ++n) acc[a][b][m][n] = (f32x4){0.f, 0.f, 0.f, 0.f};
        cur = nxt; cA = nA; cB = nB; ++ui;
        if constexpr (ALIGN_EPI) { if (wr == 1) PG8_BAR; }
    }
    PG8_WAIT_V(0);
    if constexpr (!ALIGN_EPI) { if (wr == 0) PG8_BAR; }
    PG8_BAR;
    if constexpr (Epi::AFTER_DRAIN) { E.fused(acc, cur, wr, wc, fr, fq, lds, wid, lane); S.done(cur); }
#undef PG8_SA
#undef PG8_SB
#undef PG8_STAGE
#undef PG8_LDA
#undef PG8_LDB
#undef PG8_MMA
#undef PG8_WAIT_V
#undef PG8_WAIT_L
#undef PG8_BAR
#undef PG8_SCHED
}
}

constexpr int NWAVES = 8, NTHR = 512;
constexpr int BATCH = 2, SEQ = 8192, D = 1024, DEPTH = 4, MTOK = BATCH * SEQ;
constexpr int DIN = 3344, NPROJ = 3328, SRC_GA = 1152;
constexpr int C_GQ = 0, C_GK = 192, C_GV = 384, C_GG = 768, C_HQ = 1152, C_HF = 1408, C_HI = 1664, C_HG = 1920, C_RQ = 2176, C_RK = 2368, C_RV = 2560, C_RG = 2944;
constexpr int NE = 32, FFN = 1024;
constexpr int CH = 64, NCH = SEQ / CH, NUNIT = BATCH * NCH;
constexpr int ST_GLA = 0, ST_HG = 4 * 48 * 96, ST_RET = ST_HG + 4 * 64 * 64, ST_TOT = ST_RET + 4 * 48 * 96;
constexpr int NDV = 448;
constexpr int MAXROWS = 65536 + NE * 256, MAXRT = MAXROWS / 256;
constexpr float EPS = 1e-6f;
#ifndef F8_IN_V
#define F8_IN_V false
#endif
#ifndef F8_OUT_V
#define F8_OUT_V false
#endif
constexpr bool F8_IN = F8_IN_V, F8_OUT = F8_OUT_V;
#ifndef Y8_V
#define Y8_V true
#endif
constexpr bool Y8 = Y8_V;
constexpr float S8_Y = 16.f;
constexpr float S8_M = 32.f;
constexpr float S8_W = 2048.f, S8_H = 64.f, S8_A = 8.f;
constexpr int NPHASE = 38;
constexpr int ECAP = 16384, ECAP_SH = 14;

constexpr size_t MiB = 1u << 20;
constexpr size_t WS_CTL = 0, CTL_ZERO_BYTES = 65536;
constexpr size_t WS_MOD = 1 * MiB;
constexpr size_t WS_ROPE = 2 * MiB;
constexpr size_t WS_LB = 5 * MiB;
constexpr size_t WS_WIN = 8 * MiB;
constexpr size_t WS_WOUT = 34 * MiB;
constexpr size_t WS_WGU = 42 * MiB;
constexpr size_t WS_WDN = 554 * MiB;
constexpr size_t WS_X = 810 * MiB;
constexpr size_t WS_H = 874 * MiB;
constexpr size_t WS_GA = 906 * MiB;
constexpr size_t WS_PROJ = 907 * MiB;
constexpr size_t WS_U = 1011 * MiB;
constexpr size_t WS_DVEC = 1063 * MiB;
constexpr size_t WS_SP = 1064 * MiB;
constexpr size_t WS_MIX = 1090 * MiB;
constexpr size_t WS_TOPE = 1122 * MiB;
constexpr size_t WS_TOPW = WS_TOPE + 256 * 1024;
constexpr size_t WS_SLOT = WS_TOPW + 256 * 1024;
constexpr size_t WS_A1 = 1123 * MiB;
constexpr size_t WS_ACT = 1635 * MiB;
constexpr size_t WS_Y = 2147 * MiB;
constexpr size_t WS_CUM = 3171 * MiB;
constexpr size_t WS_END = 3199 * MiB;
static_assert(WS_WIN + (size_t)DEPTH * NPROJ * D * 2 <= WS_WOUT && WS_PROJ + (size_t)MTOK * NPROJ * 2 <= WS_U && WS_U + (size_t)NUNIT * ST_TOT * 4 <= WS_DVEC && WS_SP + (size_t)NUNIT * ST_TOT * 2 <= WS_MIX && WS_A1 + (size_t)NE * ECAP * D <= WS_ACT && WS_ACT + (size_t)NE * ECAP * D <= WS_Y && WS_Y + (size_t)NE * ECAP * D * 2 <= WS_CUM, "ws map");
constexpr int CW_TMO = 0, CW_CODE = 1, CW_BAR = 4096, CW_CNT = 8192, CW_FILL = 8192 + 256;
constexpr int RING_BYTES = 131072;
constexpr int MISC_OFF = 147456, LDS_BYTES = MISC_OFF + 4096;
constexpr int MW_BAR = 0, MW_CNT = 16, MW_PST = 48, MW_HIST = 96, MW_BASE = 128, MW_TILE = 192, MW_NRT = 480, MW_SLOTS = 512;

#define GAS __attribute__((address_space(1)))
#define LAS __attribute__((address_space(3)))
typedef unsigned v4u __attribute__((ext_vector_type(4)));
typedef float f32x4 __attribute__((ext_vector_type(4)));
typedef short bf16x8 __attribute__((ext_vector_type(8)));
typedef GAS unsigned gu32;
typedef GAS unsigned long long gu64;
#define RLX_AGENT __ATOMIC_RELAXED, __HIP_MEMORY_SCOPE_AGENT
#define LDS_WAIT() asm volatile("s_waitcnt lgkmcnt(0)" ::: "memory")
#define VM_WAIT() asm volatile("s_waitcnt vmcnt(0)" ::: "memory")
__device__ __forceinline__ unsigned long long rt() { return __builtin_amdgcn_s_memrealtime(); }
typedef unsigned short bf16;
__device__ __forceinline__ unsigned f2bf(float f) { unsigned u = __builtin_bit_cast(unsigned, f); return (u + 0x7fffu + ((u >> 16) & 1u)) >> 16; }
__device__ __forceinline__ unsigned pk2(float lo, float hi) { return f2bf(lo) | (f2bf(hi) << 16); }
__device__ __forceinline__ float bf2f(bf16 b) { return __builtin_bit_cast(float, (unsigned)b << 16); }
#define XB_TMO      128
#define XB_XCNT(j)  (256  + 64 * (j))
#define XB_XSUB(j)  (1280 + 64 * (j))
#define XB_XGEN(j)  (2304 + 64 * (j))
#define XB_TOP      3328
#define XB_TOPGEN   3392
#define XCD_BAR_WORDS 3456
#define XB_SPIN_CAP (1u << 18)

__device__ __forceinline__ unsigned xb_ld(unsigned* p)              { return __hip_atomic_load(p, __ATOMIC_RELAXED, __HIP_MEMORY_SCOPE_AGENT); }
__device__ __forceinline__ unsigned xb_add(unsigned* p, unsigned v) { return __hip_atomic_fetch_add(p, v, __ATOMIC_RELAXED, __HIP_MEMORY_SCOPE_AGENT); }
__device__ __forceinline__ unsigned xb_xcc_id() { return (unsigned)__builtin_amdgcn_s_getreg((3 << 11) | 20) & 0xFu; }
#define XB_SPIN(cond, bar) do { unsigned _sp = 0; while (cond) { __builtin_amdgcn_s_sleep(1); \
    if ((++_sp & 255u) == 0u) { if (xb_ld(&(bar)[XB_TMO])) break; if (_sp > XB_SPIN_CAP) { atomicAdd(&(bar)[XB_TMO], 1u); break; } } } } while (0)

struct XcdBarrier {
    unsigned* bar; unsigned x;
    volatile LAS unsigned* st;
};

__device__ __forceinline__ XcdBarrier xcd_barrier_post(unsigned* bar, volatile LAS unsigned* st) {
    XcdBarrier b; b.bar = bar; b.x = xb_xcc_id(); b.st = st;
    if (threadIdx.x == 0) (void)xb_add(&bar[XB_XCNT(b.x)], 1u);
    return b;
}
__device__ __forceinline__ void xcd_barrier_complete(unsigned* bar, unsigned x, unsigned& nloc, unsigned& nx) {
    const unsigned G = gridDim.x * gridDim.y * gridDim.z;
    unsigned sum, cnt, mine, sp = 0u;
    for (;;) {
        sum = 0u; cnt = 0u; mine = 0u;
#pragma unroll
        for (unsigned j = 0; j < 16; ++j) { const unsigned c = xb_ld(&bar[XB_XCNT(j)]); sum += c; cnt += (c > 0u) ? 1u : 0u; mine = (j == x) ? c : mine; }
        if (sum == G) break;
        __builtin_amdgcn_s_sleep(1);
        if ((++sp & 255u) == 0u) { if (xb_ld(&bar[XB_TMO])) break; if (sp > XB_SPIN_CAP) { atomicAdd(&bar[XB_TMO], 1u); break; } }
    }
    nloc = mine > 0u ? mine : 1u; nx = cnt > 0u ? cnt : 1u;
}

__device__ __forceinline__ void xcd_barrier(const XcdBarrier& b) {
    asm volatile("s_waitcnt vmcnt(0)" ::: "memory");
    __syncthreads();
    if (threadIdx.x == 0) {
        unsigned* bar = b.bar;
        __builtin_amdgcn_s_waitcnt(0);
        unsigned nloc = b.st[0], nx = b.st[1];
        if (nloc == 0u) { xcd_barrier_complete(bar, b.x, nloc, nx); b.st[0] = nloc; b.st[1] = nx; }
        const unsigned old = xb_add(&bar[XB_XSUB(b.x)], 1u);
        const unsigned gen = old / nloc;
        if (old + 1u == (gen + 1u) * nloc) {
            __builtin_amdgcn_fence(__ATOMIC_RELEASE, "agent");
            asm volatile("s_waitcnt vmcnt(0)" ::: "memory");
            const unsigned og = xb_add(&bar[XB_TOP], 1u);
            const unsigned tg = og / nx;
            if (og + 1u == (tg + 1u) * nx) xb_add(&bar[XB_TOPGEN], 1u);
            else XB_SPIN(xb_ld(&bar[XB_TOPGEN]) == tg, bar);
            __builtin_amdgcn_fence(__ATOMIC_ACQUIRE, "agent");
            xb_add(&bar[XB_XGEN(b.x)], 1u);
            asm volatile("s_waitcnt vmcnt(0)" ::: "memory");
        } else {
            XB_SPIN(xb_ld(&bar[XB_XGEN(b.x)]) == gen, bar);
            __builtin_amdgcn_fence(__ATOMIC_ACQUIRE, "agent");
            asm volatile("s_waitcnt vmcnt(0)" ::: "memory");
        }
    }
    __syncthreads();
}

__device__ __forceinline__ float wave_sum(float v) {
#pragma unroll
    for (int o = 1; o < 64; o <<= 1) v += __shfl_xor(v, o);
    return v;
}
__device__ __forceinline__ float log_sigmoid_f(float x) { return fminf(x, 0.f) - log1pf(expf(-fabsf(x))); }
__device__ __forceinline__ float silu_f(float x) { return x / (1.0f + expf(-x)); }
__device__ __forceinline__ float sigmoid_f(float x) { return 1.0f / (1.0f + expf(-x)); }
__device__ __forceinline__ pg8::bf16x8 ldfrag(const LAS bf16* base, int stride, int r0, int k0, int lane) {
    return *(const LAS pg8::bf16x8*)(base + (r0 + (lane & 15)) * stride + k0 + 8 * (lane >> 4));
}
__device__ __forceinline__ pg8::bf16x8 pack8(const float (&v)[8]) { v4u w; w.x = pk2(v[0], v[1]); w.y = pk2(v[2], v[3]); w.z = pk2(v[4], v[5]); w.w = pk2(v[6], v[7]); return __builtin_bit_cast(pg8::bf16x8, w); }

struct Args {
    const float* x; const float* c; const int* pos; const float* w_mod; const float* b_mod; const float* norm1_w; const float* w_in; const float* gla_wa2; const float* gla_ba2; const float* hg_lb;
    const float* gla_norm_w; const float* hg_norm_w; const float* w_out; const float* norm2_w; const float* w_r; const float* b_r; const float* w_gu; const float* b_gu; const float* w_dn; const float* b_dn;
    const float* final_norm_w; float* out; unsigned char* ws; int ph_lo, ph_hi;
};

__device__ __forceinline__ void transpose_block64(const float* src, int ld, bf16* dst, LAS float* scr, int lane) {
    const int r = lane >> 4, c4 = (lane & 15) * 4;
    f32x4 v[16];
#pragma unroll
    for (int i = 0; i < 16; ++i) v[i] = __builtin_nontemporal_load((const f32x4*)(src + (size_t)(4 * i + r) * ld + c4));
#pragma unroll
    for (int i = 0; i < 16; ++i) { LAS float* w = scr + (4 * i + r) * 65 + c4; w[0] = v[i][0]; w[1] = v[i][1]; w[2] = v[i][2]; w[3] = v[i][3]; }
    LDS_WAIT(); asm volatile("" ::: "memory");
    const int kc = lane & 7;
#pragma unroll
    for (int jj = 0; jj < 8; ++jj) { const int n = (lane >> 3) + 8 * jj; const LAS float* s = scr + (8 * kc) * 65 + n;
        v4u o; o.x = pk2(s[0 * 65], s[1 * 65]); o.y = pk2(s[2 * 65], s[3 * 65]); o.z = pk2(s[4 * 65], s[5 * 65]); o.w = pk2(s[6 * 65], s[7 * 65]);
        *(GAS v4u*)(dst + (size_t)n * D + 8 * kc) = o; }
    LDS_WAIT(); asm volatile("" ::: "memory");
}
__device__ __forceinline__ int pk4_fp8(float a, float b, float c, float d) { int w = 0; w = __builtin_amdgcn_cvt_pk_fp8_f32(fminf(fmaxf(a, -448.f), 448.f), fminf(fmaxf(b, -448.f), 448.f), w, false);
    return __builtin_amdgcn_cvt_pk_fp8_f32(fminf(fmaxf(c, -448.f), 448.f), fminf(fmaxf(d, -448.f), 448.f), w, true); }
__device__ __forceinline__ void transpose_block64_fp8(const float* src, int ld, unsigned char* dst, LAS float* scr, int lane, float sc) {
    const int r = lane >> 4, c4 = (lane & 15) * 4;
    f32x4 v[16];
#pragma unroll
    for (int i = 0; i < 16; ++i) v[i] = __builtin_nontemporal_load((const f32x4*)(src + (size_t)(4 * i + r) * ld + c4));
#pragma unroll
    for (int i = 0; i < 16; ++i) { LAS float* w = scr + (4 * i + r) * 65 + c4; w[0] = v[i][0] * sc; w[1] = v[i][1] * sc; w[2] = v[i][2] * sc; w[3] = v[i][3] * sc; }
    LDS_WAIT(); asm volatile("" ::: "memory");
    const int kc = lane & 3;
#pragma unroll
    for (int jj = 0; jj < 4; ++jj) { const int n = (lane >> 2) + 16 * jj; const LAS float* s = scr + (16 * kc) * 65 + n;
        v4u o; o.x = (unsigned)pk4_fp8(s[0 * 65], s[1 * 65], s[2 * 65], s[3 * 65]); o.y = (unsigned)pk4_fp8(s[4 * 65], s[5 * 65], s[6 * 65], s[7 * 65]);
        o.z = (unsigned)pk4_fp8(s[8 * 65], s[9 * 65], s[10 * 65], s[11 * 65]); o.w = (unsigned)pk4_fp8(s[12 * 65], s[13 * 65], s[14 * 65], s[15 * 65]);
        *(GAS v4u*)(dst + (size_t)n * D + 16 * kc) = o; }
    LDS_WAIT(); asm volatile("" ::: "memory");
}
constexpr int IT_IN = 16 * (NPROJ / 64), IT_OUT = 16 * 16, IT_GU = NE * 16 * 32, IT_DN = NE * 16 * 16, IT_LAYER = IT_IN + IT_OUT + IT_GU + IT_DN, IT_ALL = DEPTH * IT_LAYER;
__device__ __forceinline__ void convert_item(const Args& a, int l, int r, LAS float* scr, int lane) {
    unsigned char* ws = a.ws;
    bf16* WIN = (bf16*)(ws + WS_WIN); bf16* WOUT = (bf16*)(ws + WS_WOUT); unsigned char* WGU = ws + WS_WGU; unsigned char* WDN = ws + WS_WDN;
    if (r < IT_IN) { const int kb = r / (NPROJ / 64), nb = r % (NPROJ / 64), n0 = 64 * nb, sc = n0 + (n0 >= SRC_GA ? 16 : 0);
        if (F8_IN) transpose_block64_fp8(a.w_in + ((size_t)l * D + 64 * kb) * DIN + sc, DIN, (unsigned char*)WIN + ((size_t)l * NPROJ + n0) * D + 64 * kb, scr, lane, S8_W);
        else transpose_block64(a.w_in + ((size_t)l * D + 64 * kb) * DIN + sc, DIN, WIN + ((size_t)l * NPROJ + n0) * D + 64 * kb, scr, lane); return; }
    r -= IT_IN;
    if (r < IT_OUT) { const int kb = r / 16, nb = r % 16;
        if (F8_OUT) transpose_block64_fp8(a.w_out + ((size_t)l * D + 64 * kb) * D + 64 * nb, D, (unsigned char*)WOUT + ((size_t)l * D + 64 * nb) * D + 64 * kb, scr, lane, S8_W);
        else transpose_block64(a.w_out + ((size_t)l * D + 64 * kb) * D + 64 * nb, D, WOUT + ((size_t)l * D + 64 * nb) * D + 64 * kb, scr, lane); return; }
    r -= IT_OUT;
    if (r < IT_GU) { const int e = r / 512, r2 = r % 512, kb = r2 / 32, nb = r2 % 32, cc = 64 * nb;
        const int row = (cc < 1024) ? 256 * (cc / 128) + (cc % 128) : 256 * ((cc - 1024) / 128) + 128 + ((cc - 1024) % 128);
        transpose_block64_fp8(a.w_gu + (((size_t)l * NE + e) * D + 64 * kb) * 2048 + cc, 2048, WGU + (((size_t)l * NE + e) * 2048 + row) * D + 64 * kb, scr, lane, S8_W); return; }
    r -= IT_GU;
    { const int e = r / 256, r2 = r % 256, kb = r2 / 16, nb = r2 % 16;
        transpose_block64_fp8(a.w_dn + (((size_t)l * NE + e) * FFN + 64 * kb) * D + 64 * nb, D, WDN + (((size_t)l * NE + e) * D + 64 * nb) * D + 64 * kb, scr, lane, S8_W); }
}
constexpr int CB2 = 4, CB7 = 2, CB8 = 2;
__device__ __forceinline__ int conv_t2(int G) { return (G == 256) ? 192 * NWAVES * CB2 : 0; }
__device__ __forceinline__ int conv_idle(int nunits, int G) { const int rem = nunits % G; return rem ? G - rem : 0; }
__device__ __forceinline__ void convert_range(const Args& a, int l, int first, int count, LAS unsigned char* lds, int lane, int wave) {
    LAS float* scr = (LAS float*)(lds + wave * 16640);
    for (int k = 0; k < count; ++k) { const int it = first + k; if (it < IT_LAYER) convert_item(a, l, it, scr, lane); }
}
__device__ __forceinline__ void p0_prologue(const Args& a, LAS unsigned char* lds, int vcu, int G, int tid, int lane, int wave) {
    unsigned char* ws = a.ws;
    LAS float* scr = (LAS float*)(lds + wave * 16640);
    const int gw = vcu * NWAVES + wave, NGW = G * NWAVES;
    for (int it = gw; it < IT_LAYER; it += NGW) convert_item(a, 0, it, scr, lane);
    __syncthreads();
    {
        LAS float* cact = (LAS float*)lds;
        LAS float* red = (LAS float*)(lds + 8192);
        for (int i = tid; i < 2 * D; i += NTHR) cact[i] = silu_f(a.c[i]);
        __syncthreads();
        float* MOD = (float*)(ws + WS_MOD);
        for (int it = vcu; it < DEPTH * 96; it += G) {
            const int l = it / 96, n0 = (it % 96) * 64;
            const float* wp = a.w_mod + ((size_t)l * D + 128 * wave) * 6144 + n0 + lane;
            float a0 = 0.f, a1 = 0.f;
#pragma unroll 32
            for (int k = 0; k < 128; ++k) { const float w = __builtin_nontemporal_load(wp + (size_t)k * 6144); a0 += cact[128 * wave + k] * w; a1 += cact[D + 128 * wave + k] * w; }
            red[(wave * 2 + 0) * 64 + lane] = a0; red[(wave * 2 + 1) * 64 + lane] = a1;
            __syncthreads();
            if (tid < 128) { const int b = tid >> 6, ln = tid & 63; float s = a.b_mod[l * 6144 + n0 + ln];
#pragma unroll
                for (int w = 0; w < 8; ++w) s += red[(w * 2 + b) * 64 + ln];
                MOD[((size_t)l * 2 + b) * 6144 + n0 + ln] = s; }
            __syncthreads();
        }
    }
    {
        float* ROPE = (float*)(ws + WS_ROPE);
        for (int i = vcu * NTHR + tid; i < MTOK * 24; i += G * NTHR) { const int t = i / 24, f = i % 24;
            const float inv = (float)pow(10000.0, -(double)f / 24.0); const float ang = (float)a.pos[t] * inv;
            ROPE[(size_t)t * 48 + f] = cosf(ang); ROPE[(size_t)t * 48 + 24 + f] = sinf(ang); }
    }
    if (vcu == 0 && tid < 256) {
        float v[4], mx = -3.0e38f; for (int l = 0; l < 4; ++l) { v[l] = a.hg_lb[l * 256 + tid]; mx = fmaxf(mx, v[l]); }
        float s = 0.f; for (int l = 0; l < 4; ++l) { v[l] = expf(v[l] - mx); s += v[l]; }
        float* LB = (float*)(ws + WS_LB); float cs = 0.f, first = 0.f;
        for (int l = 0; l < 4; ++l) { cs += v[l] / s; if (l == 0) first = cs; LB[l * 256 + tid] = cs - first; }
    }
}

__device__ __forceinline__ void moe_combine_row(f32x4 (&v)[4], int m, const bf16* Y, const int* SLOT, const float* TOPW, const float* g2, int lane) {
    const int4 sl = *(const int4*)(SLOT + (size_t)m * 4); const f32x4 tw = *(const f32x4*)(TOPW + (size_t)m * 4);
    const int s[4] = {sl.x, sl.y, sl.z, sl.w};
    f32x4 acc[4];
#pragma unroll
    for (int j = 0; j < 4; ++j) acc[j] = (f32x4){0.f, 0.f, 0.f, 0.f};
#pragma unroll
    for (int k = 0; k < 4; ++k) { const bf16* yr = Y + (size_t)s[k] * D + 4 * lane; const float w = tw[k];
#pragma unroll
        for (int j = 0; j < 4; ++j) { const uint2 p = *(const uint2*)(yr + 256 * j);
            acc[j][0] += w * __builtin_bit_cast(float, p.x << 16); acc[j][1] += w * __builtin_bit_cast(float, p.x & 0xffff0000u);
            acc[j][2] += w * __builtin_bit_cast(float, p.y << 16); acc[j][3] += w * __builtin_bit_cast(float, p.y & 0xffff0000u); } }
#pragma unroll
    for (int j = 0; j < 4; ++j) { const f32x4 g = *(const f32x4*)(g2 + 4 * lane + 256 * j); v[j] = v[j] + g * acc[j]; }
}
__device__ __forceinline__ float row_rstd(const f32x4 (&v)[4]) {
    float s = 0.f;
#pragma unroll
    for (int j = 0; j < 4; ++j) s += (v[j][0] * v[j][0] + v[j][1] * v[j][1]) + (v[j][2] * v[j][2] + v[j][3] * v[j][3]);
    return 1.0f / sqrtf(wave_sum(s) * (1.0f / D) + EPS);
}
__device__ __forceinline__ void modulate_row(f32x4 (&v)[4], float rstd, const float* nw, const float* sc, const float* sh, bf16* hrow, int lane) {
#pragma unroll
    for (int j = 0; j < 4; ++j) { const int c0 = 4 * lane + 256 * j; const f32x4 w = *(const f32x4*)(nw + c0), s1 = *(const f32x4*)(sc + c0), s0 = *(const f32x4*)(sh + c0);
        v[j] = v[j] * rstd * w * (s1 + 1.0f) + s0;
        uint2 p; p.x = pk2(v[j][0], v[j][1]); p.y = pk2(v[j][2], v[j][3]); *(uint2*)(hrow + c0) = p; }
}


constexpr int LR_SLT = 142976, LR_TWL = 144000, LR_SSR = 145024;
__device__ __forceinline__ void stage_slots(const unsigned char* ws, int row0, LAS unsigned char* lds, int tid) {
    if (tid < 64) { *(LAS v4u*)(lds + LR_SLT + 16 * tid) = *(const v4u*)((const int*)(ws + WS_SLOT) + (size_t)(row0 + tid) * 4);
                    *(LAS f32x4*)(lds + LR_TWL + 16 * tid) = *(const f32x4*)((const float*)(ws + WS_TOPW) + (size_t)(row0 + tid) * 4); }
}
template <bool SS>
__device__ __forceinline__ void flat_combine(const float* xsrc, float* xdst, int row0, const bf16* Y, const float* g2, LAS unsigned char* lds, int tid, int lane) {
    const int c4 = tid & 255, rsub = tid >> 8; const f32x4 g = *(const f32x4*)(g2 + 4 * c4);
#pragma unroll 4
    for (int it = 0; it < 32; ++it) { const int i = 2 * it + rsub; const size_t m = (size_t)(row0 + i);
        f32x4 v = *(const f32x4*)(xsrc + m * D + 4 * c4);
        const v4u sl = *(const LAS v4u*)(lds + LR_SLT + 16 * i); const f32x4 tw = *(const LAS f32x4*)(lds + LR_TWL + 16 * i);
        f32x4 acc;
        if (Y8) { const unsigned char* Yb = (const unsigned char*)Y; typedef float f32x2v __attribute__((ext_vector_type(2)));
            const int q0 = *(const int*)(Yb + (size_t)sl.x * D + 4 * c4), q1 = *(const int*)(Yb + (size_t)sl.y * D + 4 * c4), q2 = *(const int*)(Yb + (size_t)sl.z * D + 4 * c4), q3 = *(const int*)(Yb + (size_t)sl.w * D + 4 * c4);
            const f32x2v a0 = __builtin_amdgcn_cvt_pk_f32_fp8(q0, false), b0 = __builtin_amdgcn_cvt_pk_f32_fp8(q0, true), a1 = __builtin_amdgcn_cvt_pk_f32_fp8(q1, false), b1 = __builtin_amdgcn_cvt_pk_f32_fp8(q1, true);
            const f32x2v a2 = __builtin_amdgcn_cvt_pk_f32_fp8(q2, false), b2 = __builtin_amdgcn_cvt_pk_f32_fp8(q2, true), a3 = __builtin_amdgcn_cvt_pk_f32_fp8(q3, false), b3 = __builtin_amdgcn_cvt_pk_f32_fp8(q3, true);
            const f32x4 tws = tw * (1.0f / S8_Y);
            acc[0] = tws[0] * a0[0] + tws[1] * a1[0] + tws[2] * a2[0] + tws[3] * a3[0]; acc[1] = tws[0] * a0[1] + tws[1] * a1[1] + tws[2] * a2[1] + tws[3] * a3[1];
            acc[2] = tws[0] * b0[0] + tws[1] * b1[0] + tws[2] * b2[0] + tws[3] * b3[0]; acc[3] = tws[0] * b0[1] + tws[1] * b1[1] + tws[2] * b2[1] + tws[3] * b3[1]; }
        else {
        const uint2 p0 = *(const uint2*)(Y + (size_t)sl.x * D + 4 * c4), p1 = *(const uint2*)(Y + (size_t)sl.y * D + 4 * c4), p2 = *(const uint2*)(Y + (size_t)sl.z * D + 4 * c4), p3 = *(const uint2*)(Y + (size_t)sl.w * D + 4 * c4);
        acc[0] = tw[0] * __builtin_bit_cast(float, p0.x << 16) + tw[1] * __builtin_bit_cast(float, p1.x << 16) + tw[2] * __builtin_bit_cast(float, p2.x << 16) + tw[3] * __builtin_bit_cast(float, p3.x << 16);
        acc[1] = tw[0] * __builtin_bit_cast(float, p0.x & 0xffff0000u) + tw[1] * __builtin_bit_cast(float, p1.x & 0xffff0000u) + tw[2] * __builtin_bit_cast(float, p2.x & 0xffff0000u) + tw[3] * __builtin_bit_cast(float, p3.x & 0xffff0000u);
        acc[2] = tw[0] * __builtin_bit_cast(float, p0.y << 16) + tw[1] * __builtin_bit_cast(float, p1.y << 16) + tw[2] * __builtin_bit_cast(float, p2.y << 16) + tw[3] * __builtin_bit_cast(float, p3.y << 16);
        acc[3] = tw[0] * __builtin_bit_cast(float, p0.y & 0xffff0000u) + tw[1] * __builtin_bit_cast(float, p1.y & 0xffff0000u) + tw[2] * __builtin_bit_cast(float, p2.y & 0xffff0000u) + tw[3] * __builtin_bit_cast(float, p3.y & 0xffff0000u); }
        v = v + g * acc;
        *(f32x4*)(xdst + m * D + 4 * c4) = v;
        if (SS) { const float sq = wave_sum((v[0] * v[0] + v[1] * v[1]) + (v[2] * v[2] + v[3] * v[3])); if (lane == 0) __hip_atomic_fetch_add((LAS float*)(lds + LR_SSR) + i, sq, __ATOMIC_RELAXED, __HIP_MEMORY_SCOPE_WORKGROUP); } }
}
template <bool F8>
__device__ __forceinline__ void flat_modulate(const float* xin, int row0, const LAS float* rstds, const float* nw, const float* scp, const float* shp, bf16* H, int tid) {
    const int c4 = tid & 255, rsub = tid >> 8; const f32x4 w = *(const f32x4*)(nw + 4 * c4), s1 = *(const f32x4*)(scp + 4 * c4), s0 = *(const f32x4*)(shp + 4 * c4); const f32x4 ws1 = w * (s1 + 1.0f);
#pragma unroll 8
    for (int it = 0; it < 32; ++it) { const int i = 2 * it + rsub; const size_t m = (size_t)(row0 + i); const f32x4 v = *(const f32x4*)(xin + m * D + 4 * c4) * rstds[i] * ws1 + s0;
        if (F8) *(int*)((unsigned char*)H + m * D + 4 * c4) = pk4_fp8(v[0] * S8_H, v[1] * S8_H, v[2] * S8_H, v[3] * S8_H);
        else { uint2 p; p.x = pk2(v[0], v[1]); p.y = pk2(v[2], v[3]); *(uint2*)(H + m * D + 4 * c4) = p; } }
}

constexpr int WP = 1032;
constexpr int LR_WHI = 0, LR_PART = 132096, LR_SSX = 140288, LR_RSTD = 140544, LR_BIAS = 140800, LR_RED = 140928;
template <int NEO>
__device__ __forceinline__ void rows_mfma(const Args& a, int layer, LAS unsigned char* lds, volatile LAS unsigned* MISC, gu32* ctl, int vcu, int G, int tid, int lane, int wave) {
    constexpr bool P5 = (NEO == 32); constexpr int NET = NEO / 16;
    unsigned char* ws = a.ws; float* X = (float*)(ws + WS_X); bf16* H = (bf16*)(ws + WS_H); const float* MOD = (const float*)(ws + WS_MOD);
    LAS bf16* Whi = (LAS bf16*)(lds + LR_WHI); LAS bf16* Wlo = Whi + NEO * WP; LAS float* part = (LAS float*)(lds + LR_PART); LAS float* ssx = (LAS float*)(lds + LR_SSX);
    LAS float* rstds = (LAS float*)(lds + LR_RSTD); LAS float* biasl = (LAS float*)(lds + LR_BIAS); LAS float* red = (LAS float*)(lds + LR_RED);
    const float* nw = (P5 ? a.norm2_w : a.norm1_w) + layer * D;
    const float* Wsrc = P5 ? a.w_r + (size_t)layer * D * NE : a.w_in + (size_t)layer * D * DIN + SRC_GA; const int wld = P5 ? NE : DIN;
    if (P5) { if (tid < NE) MISC[MW_HIST + tid] = 0u; }
    for (int row0 = vcu * 64; row0 < MTOK; row0 += G * 64) {
        const int b = row0 / SEQ; const float* mp = MOD + ((size_t)layer * 2 + b) * 6144; const float* scp = mp + (P5 ? 4 : 1) * D; const float* shp = mp + (P5 ? 3 : 0) * D;
        if (!P5 && layer > 0) { stage_slots(ws, row0, lds, tid); __syncthreads(); }
        { const int e = tid % NEO, kq = tid / NEO; constexpr int NPT = NTHR / NEO;
#pragma unroll 1
            for (int it0 = 0; it0 < D / NPT; it0 += 8) { float wv[8];
#pragma unroll
                for (int u = 0; u < 8; ++u) { const int k = kq + NPT * (it0 + u); wv[u] = Wsrc[(size_t)k * wld + e] * (nw[k] * (1.0f + scp[k])); }
#pragma unroll
                for (int u = 0; u < 8; ++u) { const int k = kq + NPT * (it0 + u); const unsigned hi = f2bf(wv[u]); const float wl = wv[u] - __builtin_bit_cast(float, hi << 16); Whi[e * WP + k] = (bf16)hi; Wlo[e * WP + k] = (bf16)f2bf(wl); } }
            constexpr int KP = D / NPT; float sacc = 0.f;
#pragma unroll 8
            for (int k = kq * KP; k < kq * KP + KP; ++k) sacc += shp[k] * Wsrc[(size_t)k * wld + e];
            red[kq * NEO + e] = sacc; }
        const float* xin = X;
        if (!P5) { if (layer == 0) xin = a.x;
            else { flat_combine<false>(X, X, row0, (const bf16*)(ws + WS_Y), MOD + ((size_t)(layer - 1) * 2 + b) * 6144 + 5 * D, lds, tid, lane); asm volatile("s_waitcnt vmcnt(0)" ::: "memory"); } }
        __syncthreads();
        if (tid < NEO) { constexpr int NPT = NTHR / NEO; float sacc = P5 ? a.b_r[layer * NE + tid] : 0.f; for (int q = 0; q < NPT; ++q) sacc += red[q * NEO + tid]; biasl[tid] = sacc; }
        const int rg = wave >> 1, kh = wave & 1, r = lane & 15, g = lane >> 4;
        { const float* xr = xin + (size_t)(row0 + 16 * rg + r) * D; f32x4 acc[NET]; float ss = 0.f;
#pragma unroll
            for (int et = 0; et < NET; ++et) acc[et] = (f32x4){0.f, 0.f, 0.f, 0.f};
#pragma unroll 4
            for (int s = 16 * kh; s < 16 * kh + 16; ++s) { const int k0 = 32 * s + 8 * g; const f32x4 x0 = *(const f32x4*)(xr + k0), x1 = *(const f32x4*)(xr + k0 + 4);
                ss += (x0[0] * x0[0] + x0[1] * x0[1]) + (x0[2] * x0[2] + x0[3] * x0[3]) + (x1[0] * x1[0] + x1[1] * x1[1]) + (x1[2] * x1[2] + x1[3] * x1[3]);
                float xv[8] = {x0[0], x0[1], x0[2], x0[3], x1[0], x1[1], x1[2], x1[3]}, xl[8];
#pragma unroll
                for (int j = 0; j < 8; ++j) xl[j] = xv[j] - __builtin_bit_cast(float, f2bf(xv[j]) << 16);
                const pg8::bf16x8 ahi = pack8(xv), alo = pack8(xl);
#pragma unroll
                for (int et = 0; et < NET; ++et) { const pg8::bf16x8 whi = ldfrag(Whi, WP, 16 * et, 32 * s, lane), wlo = ldfrag(Wlo, WP, 16 * et, 32 * s, lane);
                    acc[et] = __builtin_amdgcn_mfma_f32_16x16x32_bf16(ahi, whi, acc[et], 0, 0, 0); acc[et] = __builtin_amdgcn_mfma_f32_16x16x32_bf16(alo, whi, acc[et], 0, 0, 0);
                    acc[et] = __builtin_amdgcn_mfma_f32_16x16x32_bf16(ahi, wlo, acc[et], 0, 0, 0); } }
            ss += __shfl_xor(ss, 16); ss += __shfl_xor(ss, 32);
            if (kh == 1) {
#pragma unroll
                for (int et = 0; et < NET; ++et)
#pragma unroll
                    for (int q = 0; q < 4; ++q) part[(rg * 16 + 4 * g + q) * 32 + 16 * et + r] = acc[et][q];
                if (g == 0) ssx[rg * 16 + r] = ss; }
            __syncthreads();
            if (kh == 0) { const float sst = ss + ssx[rg * 16 + r]; if (g == 0) rstds[rg * 16 + r] = 1.0f / sqrtf(sst * (1.0f / D) + EPS);
                asm volatile("s_waitcnt lgkmcnt(0)" ::: "memory");
#pragma unroll
                for (int et = 0; et < NET; ++et)
#pragma unroll
                    for (int q = 0; q < 4; ++q) { const int i = rg * 16 + 4 * g + q, e = 16 * et + r; const float v = rstds[i] * (acc[et][q] + part[i * 32 + e]) + biasl[e];
                        if (P5) part[i * 32 + e] = v; else ((float*)(ws + WS_GA))[(size_t)(row0 + i) * 16 + e] = v; }
                if (P5) { asm volatile("s_waitcnt lgkmcnt(0)" ::: "memory");
                    if (lane < 16) { const int i = rg * 16 + lane, m = row0 + i; float lv[NE];
#pragma unroll
                        for (int e = 0; e < NE; ++e) lv[e] = part[i * 32 + e];
                        float tv[4]; int te[4];
#pragma unroll
                        for (int t = 0; t < 4; ++t) { float best = -3.0e38f; int bi = 0;
#pragma unroll
                            for (int e = 0; e < NE; ++e) if (lv[e] > best) { best = lv[e]; bi = e; }
#pragma unroll
                            for (int e = 0; e < NE; ++e) if (e == bi) lv[e] = -3.0e38f;
                            tv[t] = best; te[t] = bi; }
                        const float e1 = expf(tv[1] - tv[0]), e2 = expf(tv[2] - tv[0]), e3 = expf(tv[3] - tv[0]); const float inv = 1.0f / (1.0f + e1 + e2 + e3);
                        *(f32x4*)((float*)(ws + WS_TOPW) + (size_t)m * 4) = (f32x4){inv, e1 * inv, e2 * inv, e3 * inv};
#pragma unroll
                        for (int t = 0; t < 4; ++t) { const unsigned rk = __hip_atomic_fetch_add((LAS unsigned*)&MISC[MW_HIST + te[t]], 1u, __ATOMIC_RELAXED, __HIP_MEMORY_SCOPE_WORKGROUP);
                            ((LAS unsigned*)(lds + LR_SLT))[i * 4 + t] = ((unsigned)te[t] << 16) | rk; } } } }
            __syncthreads(); }
        if (P5) { if (tid < NE) { const unsigned hcnt = MISC[MW_HIST + tid]; MISC[MW_BASE + tid] = hcnt ? atomicAdd((unsigned*)(ctl + CW_CNT + layer * NE + tid), hcnt) : 0u; }
            __syncthreads();
            if (tid < 256) { LAS unsigned* sl = (LAS unsigned*)(lds + LR_SLT) + tid; const unsigned v = *sl, e = v >> 16; const unsigned slot = (e << ECAP_SH) + MISC[MW_BASE + e] + (v & 0xffffu);
                *sl = slot; ((int*)(ws + WS_SLOT))[(size_t)row0 * 4 + tid] = (int)slot; }
            if (tid < NE) MISC[MW_HIST + tid] = 0u;
            __syncthreads(); }
        if (P5) { const int c4 = tid & 255, rsub = tid >> 8; const f32x4 w = *(const f32x4*)(nw + 4 * c4), s1 = *(const f32x4*)(scp + 4 * c4), s0 = *(const f32x4*)(shp + 4 * c4); const f32x4 ws1 = w * (s1 + 1.0f);
            unsigned char* A1 = ws + WS_A1;
#pragma unroll 8
            for (int it = 0; it < 32; ++it) { const int i = 2 * it + rsub; const f32x4 v = *(const f32x4*)(xin + (size_t)(row0 + i) * D + 4 * c4) * rstds[i] * ws1 + s0;
                const int pw = pk4_fp8(v[0] * S8_H, v[1] * S8_H, v[2] * S8_H, v[3] * S8_H); const v4u sl = *(const LAS v4u*)(lds + LR_SLT + 16 * i);
                *(int*)(A1 + (size_t)sl.x * D + 4 * c4) = pw; *(int*)(A1 + (size_t)sl.y * D + 4 * c4) = pw; *(int*)(A1 + (size_t)sl.z * D + 4 * c4) = pw; *(int*)(A1 + (size_t)sl.w * D + 4 * c4) = pw; } }
        else flat_modulate<F8_IN>(xin, row0, rstds, nw, scp, shp, H, tid);
        __syncthreads();
    }
}

__device__ __forceinline__ void final_rows(const Args& a, LAS unsigned char* lds, int vcu, int G, int tid, int lane) {
    unsigned char* ws = a.ws; const float* X = (const float*)(ws + WS_X); const float* MOD = (const float*)(ws + WS_MOD); LAS float* ssr = (LAS float*)(lds + LR_SSR);
    for (int row0 = vcu * 64; row0 < MTOK; row0 += G * 64) { const int b = row0 / SEQ;
        stage_slots(ws, row0, lds, tid); if (tid < 64) ssr[tid] = 0.f;
        __syncthreads();
        flat_combine<true>(X, a.out, row0, (const bf16*)(ws + WS_Y), MOD + ((size_t)(DEPTH - 1) * 2 + b) * 6144 + 5 * D, lds, tid, lane);
        asm volatile("s_waitcnt vmcnt(0)" ::: "memory");
        __syncthreads();
        { const int c4 = tid & 255, rsub = tid >> 8; const f32x4 w = *(const f32x4*)(a.final_norm_w + 4 * c4);
#pragma unroll 8
            for (int it = 0; it < 32; ++it) { const int i = 2 * it + rsub; float* op = a.out + (size_t)(row0 + i) * D + 4 * c4; const float rstd = 1.0f / sqrtf(ssr[i] * (1.0f / D) + EPS); *(f32x4*)op = *(const f32x4*)op * rstd * w; } }
        __syncthreads();
    }
}

__device__ __noinline__ void moe_tables(gu32* ctl, int layer, volatile LAS unsigned* MISC, int tid) {
    if (tid < NE) MISC[MW_CNT + tid] = __hip_atomic_load(ctl + CW_CNT + layer * NE + tid, RLX_AGENT);
    __syncthreads();
    if (tid == 0) { unsigned n = 0;
        for (int e = 0; e < NE; ++e) { const unsigned nt = (MISC[MW_CNT + e] + 255u) >> 8; for (unsigned t = 0; t < nt; ++t) MISC[MW_TILE + n + t] = (unsigned)(e * 64) + t; n += nt; }
        MISC[MW_NRT] = n; }
    __syncthreads();
}

constexpr int BP = 72;
template <int TYPE> struct MixCfg { static constexpr int DK = (TYPE == 1) ? 64 : 48, DV = (TYPE == 1) ? 64 : 96, NC = 4 * DK, NV = 4 * DV;
    static constexpr int STOFF = (TYPE == 0) ? ST_GLA : (TYPE == 1) ? ST_HG : ST_RET, COFF = (TYPE == 0) ? 0 : 192;
    static constexpr int CQ = (TYPE == 0) ? C_GQ : (TYPE == 1) ? C_HQ : C_RQ, CK = (TYPE == 0) ? C_GK : (TYPE == 1) ? C_HF : C_RK, CV = (TYPE == 0) ? C_GV : (TYPE == 1) ? C_HI : C_RV, CG = (TYPE == 0) ? C_GG : (TYPE == 1) ? C_HG : C_RG;
    static constexpr int MIXOFF = (TYPE == 0) ? 0 : (TYPE == 1) ? 384 : 640; };
__device__ __forceinline__ float fast_logsig(float x) { x = fmaxf(x, -80.f); return -__logf(1.0f + __expf(-x)); }
__device__ __forceinline__ float ret_lg(int h) { return logf(1.0f - exp2f(-5.0f - (float)h)); }

template <int NV>
__device__ __forceinline__ void stage_vt(const bf16* pv  , LAS bf16* VT, int tid) {
#pragma unroll 2
    for (int idx = tid; idx < 64 * (NV / 8); idx += NTHR) { const int j = idx & 63, ch = idx >> 6; const v4u p = *(const v4u*)(pv + (size_t)j * NPROJ + 8 * ch); LAS bf16* d = VT + (8 * ch) * BP + j;
        d[0 * BP] = (bf16)(p.x & 0xffffu); d[1 * BP] = (bf16)(p.x >> 16); d[2 * BP] = (bf16)(p.y & 0xffffu); d[3 * BP] = (bf16)(p.y >> 16);
        d[4 * BP] = (bf16)(p.z & 0xffffu); d[5 * BP] = (bf16)(p.z >> 16); d[6 * BP] = (bf16)(p.w & 0xffffu); d[7 * BP] = (bf16)(p.w >> 16); }
}

constexpr int LA_KT = 0, LA_VT = 36864, LA_TOT = 92160, LA_GA = 94208;
template <int TYPE>
__device__ __forceinline__ void mixa_batch(const Args& a, int layer, int unit, LAS unsigned char* lds, int tid, int lane, int wave) {
    typedef MixCfg<TYPE> C; constexpr int DK = C::DK, DV = C::DV, NC = C::NC, NV = C::NV;
    unsigned char* ws = a.ws; const bf16* PROJ = (const bf16*)(ws + WS_PROJ); float* CUM = (float*)(ws + WS_CUM); float* DVEC = (float*)(ws + WS_DVEC) + (size_t)unit * NDV;
    float* U = (float*)(ws + WS_U) + (size_t)unit * ST_TOT + C::STOFF;
    LAS bf16* KT = (LAS bf16*)(lds + LA_KT); LAS bf16* VT = (LAS bf16*)(lds + LA_VT); LAS float* TOT = (LAS float*)(lds + LA_TOT); const LAS float* GAs = (const LAS float*)(lds + LA_GA);
    const int row0 = unit * CH;
    const bool act = tid < 2 * NC; const int c = act ? tid % NC : 0, half = act ? tid / NC : 0, h = c / DK, d = c - h * DK;
    float cum[32]; float tot = 0.f;
    float w2[16], b2 = 0.f, lbv = 0.f, lg = 0.f, sg = 0.f; int f = 0, d2 = 0;
    if (act) {
        if constexpr (TYPE == 0) { b2 = a.gla_ba2[layer * 192 + c];
#pragma unroll
            for (int r = 0; r < 16; ++r) w2[r] = a.gla_wa2[(layer * 16 + r) * 192 + c]; }
        if constexpr (TYPE == 1) lbv = ((const float*)(ws + WS_LB))[layer * 256 + c];
        if constexpr (TYPE == 2) { lg = ret_lg(h); f = (d < 24) ? d : d - 24; d2 = (d < 24) ? d + 24 : d - 24; sg = (d < 24) ? -1.f : 1.f; }
        bf16 hraw[32];
        if constexpr (TYPE == 1) {
#pragma unroll
            for (int i = 0; i < 32; ++i) hraw[i] = PROJ[(size_t)(row0 + 32 * half + i) * NPROJ + C_HF + c]; }
#pragma unroll
        for (int i = 0; i < 32; ++i) { const int t = 32 * half + i; float g;
            if constexpr (TYPE == 0) { float pre = b2;
#pragma unroll
                for (int r = 0; r < 16; ++r) pre += GAs[t * 16 + r] * w2[r];
                g = fast_logsig(pre) * (1.0f / 16.0f); }
            else if constexpr (TYPE == 1) { const float hf = fminf(fmaxf(bf2f(hraw[i]), -80.f), 80.f); const float sgm = 1.0f / (1.0f + __expf(-hf));
                g = __logf(lbv + (1.0f - lbv) * sgm); }
            else g = lg;
            tot += g; cum[i] = tot;
            if ((i & 7) == 7) asm volatile("" ::: "memory"); }
        TOT[c * 2 + half] = tot;
    }
    stage_vt<NV>(PROJ + (size_t)row0 * NPROJ + C::CV, VT, tid);
    __syncthreads();
    if (act) { const float t0 = TOT[c * 2], t1 = TOT[c * 2 + 1]; const float off = half ? t0 : 0.f, last = t0 + t1;
#pragma unroll
        for (int hq = 0; hq < 2; ++hq) {
            bf16 ka[16], kb[16]; float cs[16], sn[16];
            if constexpr (TYPE != 1) {
#pragma unroll
                for (int i = 0; i < 16; ++i) { const size_t row = (size_t)(row0 + 32 * half + 16 * hq + i); const bf16* pr = PROJ + row * NPROJ;
                    if constexpr (TYPE == 0) ka[i] = pr[C_GK + c];
                    else { const float* rp = (const float*)(ws + WS_ROPE) + row * 48; ka[i] = pr[C_RK + h * 48 + d]; kb[i] = pr[C_RK + h * 48 + d2]; cs[i] = rp[f]; sn[i] = rp[24 + f]; } } }
#pragma unroll
            for (int q2 = 0; q2 < 2; ++q2) { float kt[8];
#pragma unroll
                for (int j = 0; j < 8; ++j) { const int ii = 8 * q2 + j, i = 16 * hq + ii; const float cm = cum[i] + off; const size_t row = (size_t)(row0 + 32 * half + i); float k;
                    if constexpr (TYPE == 0) k = bf2f(ka[ii]);
                    else if constexpr (TYPE == 1) k = 1.0f - __expf(cum[i] - (i > 0 ? cum[i - 1] : 0.f));
                    else k = bf2f(ka[ii]) * cs[ii] + sg * bf2f(kb[ii]) * sn[ii];
                    if constexpr (TYPE != 2) CUM[row * NDV + C::COFF + c] = cm;
                    kt[j] = k * __expf(last - cm); }
                v4u w; w.x = pk2(kt[0], kt[1]); w.y = pk2(kt[2], kt[3]); w.z = pk2(kt[4], kt[5]); w.w = pk2(kt[6], kt[7]);
                *(LAS v4u*)(KT + c * BP + 32 * half + 16 * hq + 8 * q2) = w; } }
        if (TYPE != 2 && half == 0) DVEC[C::COFF + c] = __expf(last);
    }
    __syncthreads();
    constexpr int TD = DK / 16, NT = (DV / 16) * TD;
    for (int ti = wave; ti < 4 * NT; ti += NWAVES) { const int hh = ti / NT, tr = ti - hh * NT, te = tr / TD, td = tr - te * TD; f32x4 acc = {0.f, 0.f, 0.f, 0.f};
#pragma unroll
        for (int kk = 0; kk < 2; ++kk) acc = __builtin_amdgcn_mfma_f32_16x16x32_bf16(ldfrag(VT, BP, hh * DV + te * 16, kk * 32, lane), ldfrag(KT, BP, hh * DK + td * 16, kk * 32, lane), acc, 0, 0, 0);
        float* Uh = U + hh * DK * DV;
#pragma unroll
        for (int r = 0; r < 4; ++r) Uh[(te * 16 + (lane >> 4) * 4 + r) * DK + td * 16 + (lane & 15)] = acc[r]; }
    __syncthreads();
}
__device__ __forceinline__ void p3a_summaries(const Args& a, int layer, LAS unsigned char* lds, int vcu, int G, int tid, int lane, int wave) {
    for (int unit = vcu; unit < NUNIT; unit += G) {
        { LAS float* GAs = (LAS float*)(lds + LA_GA); const float* GA = (const float*)(a.ws + WS_GA); for (int i = tid; i < CH * 16; i += NTHR) GAs[i] = GA[(size_t)unit * CH * 16 + i]; }
        __syncthreads();
        mixa_batch<0>(a, layer, unit, lds, tid, lane, wave);
        mixa_batch<1>(a, layer, unit, lds, tid, lane, wave);
        mixa_batch<2>(a, layer, unit, lds, tid, lane, wave);
    }
}

__device__ __forceinline__ void p3b_scan(const Args& a, int vcu, int G, int tid) {
    unsigned char* ws = a.ws; const float* U = (const float*)(ws + WS_U); const float* DVEC = (const float*)(ws + WS_DVEC); bf16* SP = (bf16*)(ws + WS_SP);
    for (int gid = vcu * NTHR + tid; gid < BATCH * ST_TOT; gid += G * NTHR) {
        const int b = gid / ST_TOT, el = gid - b * ST_TOT;
        int di = -1; float cdec = 0.f;
        if (el < ST_HG) { const int h = el / 4608, d = (el - h * 4608) % 48; di = h * 48 + d; }
        else if (el < ST_RET) { const int r = el - ST_HG, h = r / 4096, d = r % 64; di = 192 + h * 64 + d; }
        else { const int h = (el - ST_RET) / 4608; cdec = expf(64.0f * logf(1.0f - exp2f(-5.0f - (float)h))); }
        const float* up = U + (size_t)b * NCH * ST_TOT + el; const float* dp = DVEC + (size_t)b * NCH * NDV + (di < 0 ? 0 : di); bf16* sp = SP + (size_t)b * NCH * ST_TOT + el;
        float s = 0.f;
        for (int n0 = 0; n0 < NCH; n0 += 8) { float u[8], dc[8];
#pragma unroll
            for (int i = 0; i < 8; ++i) { u[i] = up[(size_t)(n0 + i) * ST_TOT]; dc[i] = (di < 0) ? cdec : dp[(size_t)(n0 + i) * NDV]; }
#pragma unroll
            for (int i = 0; i < 8; ++i) { sp[(size_t)(n0 + i) * ST_TOT] = (bf16)f2bf(s); s = dc[i] * s + u[i]; } }
    }
}

constexpr int LC_VT = 0, LC_ST = 55296, LC_AB = 110592, OBP = 104;
template <int TYPE, bool ISQ>
__device__ __forceinline__ void mix_frag(const Args& a, int h, size_t row, int t, int d0, float (&x)[8], float (&cm)[8]) {
    typedef MixCfg<TYPE> C; constexpr int DK = C::DK;
    unsigned char* ws = a.ws; const bf16* pr = (const bf16*)(ws + WS_PROJ) + row * NPROJ;
    if constexpr (TYPE == 0) {
        const v4u p = *(const v4u*)(pr + (ISQ ? C_GQ : C_GK) + h * DK + d0); const unsigned pw[4] = {p.x, p.y, p.z, p.w};
        const float* cp = (const float*)(ws + WS_CUM) + row * NDV + h * DK + d0; const f32x4 c0 = *(const f32x4*)cp, c1 = *(const f32x4*)(cp + 4);
#pragma unroll
        for (int j = 0; j < 4; ++j) { x[2 * j] = __builtin_bit_cast(float, pw[j] << 16); x[2 * j + 1] = __builtin_bit_cast(float, pw[j] & 0xffff0000u); cm[j] = c0[j]; cm[4 + j] = c1[j]; }
        if (ISQ) {
#pragma unroll
            for (int j = 0; j < 8; ++j) x[j] *= 0.14433756729740643f; }
    } else if constexpr (TYPE == 1) {
        const float* cp = (const float*)(ws + WS_CUM) + row * NDV + 192 + h * DK + d0; const f32x4 c0 = *(const f32x4*)cp, c1 = *(const f32x4*)(cp + 4);
#pragma unroll
        for (int j = 0; j < 4; ++j) { cm[j] = c0[j]; cm[4 + j] = c1[j]; }
        if (ISQ) { const v4u p = *(const v4u*)(pr + C_HQ + h * DK + d0); const unsigned pw[4] = {p.x, p.y, p.z, p.w};
#pragma unroll
            for (int j = 0; j < 4; ++j) { x[2 * j] = __builtin_bit_cast(float, pw[j] << 16); x[2 * j + 1] = __builtin_bit_cast(float, pw[j] & 0xffff0000u); } }
        else { f32x4 p0 = {0.f, 0.f, 0.f, 0.f}, p1 = {0.f, 0.f, 0.f, 0.f}; if (t > 0) { p0 = *(const f32x4*)(cp - NDV); p1 = *(const f32x4*)(cp - NDV + 4); }
#pragma unroll
            for (int j = 0; j < 4; ++j) { x[j] = 1.0f - __expf(c0[j] - p0[j]); x[4 + j] = 1.0f - __expf(c1[j] - p1[j]); } }
    } else {
        const int f0 = (d0 < 24) ? d0 : d0 - 24, dp = (d0 < 24) ? d0 + 24 : d0 - 24; const float sg = (d0 < 24) ? -1.f : 1.f;
        const int cb = (ISQ ? C_RQ : C_RK) + h * DK; const v4u p = *(const v4u*)(pr + cb + d0), pp = *(const v4u*)(pr + cb + dp); const unsigned pw[4] = {p.x, p.y, p.z, p.w}, qw[4] = {pp.x, pp.y, pp.z, pp.w};
        const float* rp = (const float*)(ws + WS_ROPE) + row * 48; const f32x4 cs0 = *(const f32x4*)(rp + f0), cs1 = *(const f32x4*)(rp + f0 + 4), sn0 = *(const f32x4*)(rp + 24 + f0), sn1 = *(const f32x4*)(rp + 24 + f0 + 4);
        const float cmv = (float)(t + 1) * ret_lg(h);
#pragma unroll
        for (int j = 0; j < 4; ++j) { const float xa = __builtin_bit_cast(float, pw[j] << 16), xb = __builtin_bit_cast(float, pw[j] & 0xffff0000u), ya = __builtin_bit_cast(float, qw[j] << 16), yb = __builtin_bit_cast(float, qw[j] & 0xffff0000u);
            const float ca = (j < 2) ? cs0[2 * j] : cs1[2 * j - 4], cb2 = (j < 2) ? cs0[2 * j + 1] : cs1[2 * j - 3], sa = (j < 2) ? sn0[2 * j] : sn1[2 * j - 4], sb = (j < 2) ? sn0[2 * j + 1] : sn1[2 * j - 3];
            x[2 * j] = xa * ca + sg * ya * sa; x[2 * j + 1] = xb * cb2 + sg * yb * sb; cm[2 * j] = cmv; cm[2 * j + 1] = cmv; }
        if (ISQ) {
#pragma unroll
            for (int j = 0; j < 8; ++j) x[j] *= 0.14433756729740643f; }
    }
}

template <int TYPE>
__device__ __forceinline__ void mixc_batch(const Args& a, int layer, int unit, LAS unsigned char* lds, int tid, int lane, int wave) {
    typedef MixCfg<TYPE> C; constexpr int DK = C::DK, DV = C::DV, NV = C::NV, TE = DV / 16;
    unsigned char* ws = a.ws; const bf16* PROJ = (const bf16*)(ws + WS_PROJ); bf16* MIX = (bf16*)(ws + WS_MIX);
    LAS bf16* VT = (LAS bf16*)(lds + LC_VT); LAS bf16* ST = (LAS bf16*)(lds + LC_ST); LAS bf16* AB = (LAS bf16*)(lds + LC_AB) + wave * 16 * OBP;
    const int row0 = unit * CH;
    stage_vt<NV>(PROJ + (size_t)row0 * NPROJ + C::CV, VT, tid);
    { const bf16* SPu = (const bf16*)(ws + WS_SP) + (size_t)unit * ST_TOT + C::STOFF;
        for (int idx = tid; idx < NV * 8; idx += NTHR) { const int er = idx >> 3, ch = idx & 7; v4u w = {0u, 0u, 0u, 0u}; if (ch * 8 < DK) w = *(const v4u*)(SPu + (size_t)er * DK + ch * 8); *(LAS v4u*)(ST + er * BP + ch * 8) = w; } }
    __syncthreads();
    const int h = wave >> 1, hsel = wave & 1, r = lane & 15, g = lane >> 4;
    const LAS bf16* STh = ST + h * DV * BP; const LAS bf16* VTh = VT + h * DV * BP;
    const float* CUMp = (const float*)(ws + WS_CUM);
    for (int ib = 0; ib < 2; ++ib) { const int I = ib ? 3 - hsel : hsel;
        pg8::bf16x8 qh[2], qt[2]; float refv[2][8];
#pragma unroll
        for (int s = 0; s < 2; ++s) { const int d0 = 32 * s + 8 * g; const bool valid = d0 < DK; const int d0c = valid ? d0 : 0;
            float x[8], cm[8]; mix_frag<TYPE, true>(a, h, (size_t)(row0 + 16 * I + r), 16 * I + r, d0c, x, cm);
            if constexpr (TYPE == 2) {
#pragma unroll
                for (int j = 0; j < 8; ++j) refv[s][j] = (float)(16 * I) * ret_lg(h);
            } else { if (I > 0) { const float* cp = CUMp + (size_t)(row0 + 16 * I - 1) * NDV + C::COFF + h * DK + d0c; const f32x4 c0 = *(const f32x4*)cp, c1 = *(const f32x4*)(cp + 4);
#pragma unroll
                    for (int j = 0; j < 4; ++j) { refv[s][j] = c0[j]; refv[s][4 + j] = c1[j]; } }
                else {
#pragma unroll
                    for (int j = 0; j < 8; ++j) refv[s][j] = 0.f; } }
            float xh[8], xt[8];
#pragma unroll
            for (int j = 0; j < 8; ++j) { xh[j] = valid ? x[j] * __expf(cm[j] - refv[s][j]) : 0.f; xt[j] = valid ? x[j] * __expf(cm[j]) : 0.f; }
            qh[s] = pack8(xh); qt[s] = pack8(xt); }
        for (int J = 0; J <= I; ++J) { f32x4 acc = {0.f, 0.f, 0.f, 0.f};
#pragma unroll
            for (int s = 0; s < 2; ++s) { const int d0 = 32 * s + 8 * g; const bool valid = d0 < DK; const int d0c = valid ? d0 : 0;
                float x[8], cm[8]; mix_frag<TYPE, false>(a, h, (size_t)(row0 + 16 * J + r), 16 * J + r, d0c, x, cm);
                float xk[8];
#pragma unroll
                for (int j = 0; j < 8; ++j) xk[j] = valid ? x[j] * __expf(fminf(refv[s][j] - cm[j], 80.f)) : 0.f;
                acc = __builtin_amdgcn_mfma_f32_16x16x32_bf16(qh[s], pack8(xk), acc, 0, 0, 0); }
#pragma unroll
            for (int q = 0; q < 4; ++q) { const int i = 4 * g + q; const float v = (J < I || r <= i) ? acc[q] : 0.f; AB[i * BP + 16 * J + r] = (bf16)f2bf(v); } }
        if ((I & 1) == 0) {
#pragma unroll
            for (int q = 0; q < 4; ++q) AB[(4 * g + q) * BP + 16 * (I + 1) + r] = (bf16)0; }
        asm volatile("s_waitcnt lgkmcnt(0)" ::: "memory");
        const pg8::bf16x8 ah0 = *(const LAS pg8::bf16x8*)(AB + r * BP + 8 * g), ah1 = *(const LAS pg8::bf16x8*)(AB + r * BP + 32 + 8 * g);
        f32x4 o[TE];
#pragma unroll
        for (int te = 0; te < TE; ++te) { f32x4 acc = {0.f, 0.f, 0.f, 0.f};
            acc = __builtin_amdgcn_mfma_f32_16x16x32_bf16(qt[0], ldfrag(STh, BP, te * 16, 0, lane), acc, 0, 0, 0);
            acc = __builtin_amdgcn_mfma_f32_16x16x32_bf16(qt[1], ldfrag(STh, BP, te * 16, 32, lane), acc, 0, 0, 0);
            acc = __builtin_amdgcn_mfma_f32_16x16x32_bf16(ah0, ldfrag(VTh, BP, te * 16, 0, lane), acc, 0, 0, 0);
            if (I >= 2) acc = __builtin_amdgcn_mfma_f32_16x16x32_bf16(ah1, ldfrag(VTh, BP, te * 16, 32, lane), acc, 0, 0, 0);
            o[te] = acc; }
#pragma unroll
        for (int q = 0; q < 4; ++q) { float s1 = 0.f, s2 = 0.f;
#pragma unroll
            for (int te = 0; te < TE; ++te) { s1 += o[te][q]; s2 += o[te][q] * o[te][q]; }
#pragma unroll
            for (int m = 1; m < 16; m <<= 1) { s1 += __shfl_xor(s1, m); s2 += __shfl_xor(s2, m); }
            float mean = 0.f, rstd;
            if constexpr (TYPE == 2) { mean = s1 * (1.0f / DV); rstd = 1.0f / sqrtf(fmaxf(s2 * (1.0f / DV) - mean * mean, 0.f) + EPS); }
            else rstd = 1.0f / sqrtf(s2 * (1.0f / DV) + EPS);
#pragma unroll
            for (int te = 0; te < TE; ++te) AB[(4 * g + q) * OBP + te * 16 + r] = (bf16)f2bf((o[te][q] - mean) * rstd); }
        asm volatile("s_waitcnt lgkmcnt(0)" ::: "memory");
        constexpr int NCHK = DV / 8;
#pragma unroll
        for (int i = 0; i < (16 * NCHK) / 64; ++i) { const int cidx = lane + 64 * i, orow = cidx / NCHK, ch = cidx - orow * NCHK; const size_t row = (size_t)(row0 + 16 * I + orow);
            const v4u ov = *(const LAS v4u*)(AB + orow * OBP + 8 * ch); const v4u gv = *(const v4u*)(PROJ + row * NPROJ + C::CG + h * DV + 8 * ch);
            const unsigned ow[4] = {ov.x, ov.y, ov.z, ov.w}, gw[4] = {gv.x, gv.y, gv.z, gv.w}; float res[8];
            f32x4 w0 = {1.f, 1.f, 1.f, 1.f}, w1 = {1.f, 1.f, 1.f, 1.f};
            if constexpr (TYPE == 0) { const float* wp = a.gla_norm_w + layer * 384 + h * 96 + 8 * ch; w0 = *(const f32x4*)wp; w1 = *(const f32x4*)(wp + 4); }
            if constexpr (TYPE == 1) { const float* wp = a.hg_norm_w + layer * 256 + h * 64 + 8 * ch; w0 = *(const f32x4*)wp; w1 = *(const f32x4*)(wp + 4); }
#pragma unroll
            for (int j = 0; j < 4; ++j) { const float oa = __builtin_bit_cast(float, ow[j] << 16), ob = __builtin_bit_cast(float, ow[j] & 0xffff0000u), ga = __builtin_bit_cast(float, gw[j] << 16), gb = __builtin_bit_cast(float, gw[j] & 0xffff0000u);
                const float wa = (j < 2) ? w0[2 * j] : w1[2 * j - 4], wb = (j < 2) ? w0[2 * j + 1] : w1[2 * j - 3];
                const float sa = 1.0f / (1.0f + __expf(-ga)), sb = 1.0f / (1.0f + __expf(-gb));
                res[2 * j] = oa * wa * ((TYPE == 1) ? sa : ga * sa); res[2 * j + 1] = ob * wb * ((TYPE == 1) ? sb : gb * sb); }
            if (F8_OUT) { typedef int i32x2 __attribute__((ext_vector_type(2)));
                *(i32x2*)((unsigned char*)MIX + row * D + C::MIXOFF + h * DV + 8 * ch) = (i32x2){pk4_fp8(res[0] * S8_M, res[1] * S8_M, res[2] * S8_M, res[3] * S8_M), pk4_fp8(res[4] * S8_M, res[5] * S8_M, res[6] * S8_M, res[7] * S8_M)}; }
            else { v4u w; w.x = pk2(res[0], res[1]); w.y = pk2(res[2], res[3]); w.z = pk2(res[4], res[5]); w.w = pk2(res[6], res[7]); *(v4u*)(MIX + row * D + C::MIXOFF + h * DV + 8 * ch) = w; } }
    }
    __syncthreads();
}
__device__ __forceinline__ void p3c_outputs(const Args& a, int layer, LAS unsigned char* lds, int vcu, int G, int tid, int lane, int wave) {
    for (int unit = vcu; unit < NUNIT; unit += G) {
        mixc_batch<0>(a, layer, unit, lds, tid, lane, wave);
        mixc_batch<1>(a, layer, unit, lds, tid, lane, wave);
        mixc_batch<2>(a, layer, unit, lds, tid, lane, wave);
    }
}


constexpr int MW_ARGS = 800;
__device__ __forceinline__ const void* ld_argp(const volatile LAS unsigned* T, int i) {
    const unsigned lo = __builtin_amdgcn_readfirstlane(T[2 * i]), hi = __builtin_amdgcn_readfirstlane(T[2 * i + 1]);
    return (const void*)(((unsigned long long)hi << 32) | lo);
}
__device__ __forceinline__ Args load_args(LAS unsigned char* lds) {
    const volatile LAS unsigned* T = (const volatile LAS unsigned*)(lds + MISC_OFF) + MW_ARGS;
    Args a;
    a.x = (const float*)ld_argp(T, 0); a.c = (const float*)ld_argp(T, 1); a.pos = (const int*)ld_argp(T, 2); a.w_mod = (const float*)ld_argp(T, 3); a.b_mod = (const float*)ld_argp(T, 4);
    a.norm1_w = (const float*)ld_argp(T, 5); a.w_in = (const float*)ld_argp(T, 6); a.gla_wa2 = (const float*)ld_argp(T, 7); a.gla_ba2 = (const float*)ld_argp(T, 8); a.hg_lb = (const float*)ld_argp(T, 9);
    a.gla_norm_w = (const float*)ld_argp(T, 10); a.hg_norm_w = (const float*)ld_argp(T, 11); a.w_out = (const float*)ld_argp(T, 12); a.norm2_w = (const float*)ld_argp(T, 13); a.w_r = (const float*)ld_argp(T, 14);
    a.b_r = (const float*)ld_argp(T, 15); a.w_gu = (const float*)ld_argp(T, 16); a.b_gu = (const float*)ld_argp(T, 17); a.w_dn = (const float*)ld_argp(T, 18); a.b_dn = (const float*)ld_argp(T, 19);
    a.final_norm_w = (const float*)ld_argp(T, 20); a.out = (float*)ld_argp(T, 21); a.ws = (unsigned char*)ld_argp(T, 22); a.ph_lo = 0; a.ph_hi = 0;
    return a;
}
#define PH_CTX() { unsigned l_ = (unsigned)(size_t)lds; asm volatile("" : "+s"(l_)); lds = (LAS unsigned char*)(size_t)l_; } const Args args = load_args(lds); volatile LAS unsigned* MISC = (volatile LAS unsigned*)(lds + MISC_OFF); int tid_ = wv * 64 + (int)__builtin_amdgcn_mbcnt_hi(~0u, __builtin_amdgcn_mbcnt_lo(~0u, 0u)); asm volatile("" : "+v"(tid_)); const int tid = tid_, lane = tid & 63, wave = __builtin_amdgcn_readfirstlane(tid >> 6); \
    const int G = gridDim.x; const int bx = blockIdx.x; const int vcu = (G % 8 == 0) ? (bx % 8) * (G / 8) + bx / 8 : bx; unsigned char* ws = args.ws; gu32* ctl = (gu32*)(ws + WS_CTL); \
    (void)MISC; (void)lane; (void)wave; (void)vcu; (void)ctl; (void)bx; (void)tid
__device__ __forceinline__ void ph_p0(LAS unsigned char* lds, int wv) { PH_CTX(); p0_prologue(args, lds, vcu, G, tid, lane, wave); }
__device__ __forceinline__ void ph_p1(LAS unsigned char* lds, int wv, int layer_) { int layer = __builtin_amdgcn_readfirstlane(layer_); asm volatile("" : "+s"(layer)); PH_CTX();
    if (layer > 0) { moe_tables(ctl, layer - 1, MISC, tid); const int nrt = __builtin_amdgcn_readfirstlane((int)MISC[MW_NRT]);
        const int done = conv_t2(G) + conv_idle(nrt * 8, G) * NWAVES * CB7 + conv_idle(nrt * 4, G) * NWAVES * CB8; LAS float* scr = (LAS float*)(lds + wave * 16640);
        for (int it = done + vcu * NWAVES + wave; it < IT_LAYER; it += G * NWAVES) convert_item(args, layer, it, scr, lane);
        __syncthreads(); }
    rows_mfma<16>(args, layer, lds, MISC, ctl, vcu, G, tid, lane, wave); }
__device__ __forceinline__ void ph_p2(LAS unsigned char* lds, int wv, int layer_) { int layer = __builtin_amdgcn_readfirstlane(layer_); asm volatile("" : "+s"(layer)); PH_CTX();
    pg8::Gemm g{(const bf16*)(ws + WS_H), (const bf16*)(ws + WS_WIN + (size_t)layer * NPROJ * D * (F8_IN ? 1 : 2)), MTOK, NPROJ, F8_IN ? D / 2 : D}; pg8::StaticOrder S; S.init(MTOK, NPROJ, G, bx);
    pg8::EpiBf16Plain E{(bf16*)(ws + WS_PROJ), NPROJ, F8_IN ? 1.0f / (S8_H * S8_W) : 1.0f};
    pg8::gemm_phase<pg8::EpiBf16Plain, pg8::StaticOrder, true, true, F8_IN>(lds, g, S, E, tid);
    if (layer + 1 < DEPTH && G == 256 && bx >= 64) convert_range(args, layer + 1, ((bx - 64) * NWAVES + wave) * CB2, CB2, lds, lane, wave); }
__device__ __forceinline__ void ph_p3a(LAS unsigned char* lds, int wv, int layer_) { int layer = __builtin_amdgcn_readfirstlane(layer_); asm volatile("" : "+s"(layer)); PH_CTX(); p3a_summaries(args, layer, lds, vcu, G, tid, lane, wave); }
__device__ __forceinline__ void ph_p3b(LAS unsigned char* lds, int wv) { PH_CTX(); p3b_scan(args, vcu, G, tid); }
__device__ __forceinline__ void ph_p3c(LAS unsigned char* lds, int wv, int layer_) { int layer = __builtin_amdgcn_readfirstlane(layer_); asm volatile("" : "+s"(layer)); PH_CTX(); p3c_outputs(args, layer, lds, vcu, G, tid, lane, wave); }
__device__ __forceinline__ void ph_p4(LAS unsigned char* lds, int wv, int layer_) { int layer = __builtin_amdgcn_readfirstlane(layer_); asm volatile("" : "+s"(layer)); PH_CTX();
    pg8::Gemm g{(const bf16*)(ws + WS_MIX), (const bf16*)(ws + WS_WOUT + (size_t)layer * D * D * (F8_OUT ? 1 : 2)), MTOK, D, F8_OUT ? D / 2 : D}; pg8::StaticOrder S; S.init(MTOK, D, G, bx);
    pg8::EpiResGate E{(layer == 0) ? args.x : (const float*)(ws + WS_X), (float*)(ws + WS_X), D, (const float*)(ws + WS_MOD) + (size_t)layer * 2 * 6144 + 2 * D, 6144, SEQ, F8_OUT ? 1.0f / (S8_M * S8_W) : 1.0f};
    pg8::gemm_phase<pg8::EpiResGate, pg8::StaticOrder, true, true, F8_OUT>(lds, g, S, E, tid); }
__device__ __forceinline__ void ph_p5(LAS unsigned char* lds, int wv, int layer_) { int layer = __builtin_amdgcn_readfirstlane(layer_); asm volatile("" : "+s"(layer)); PH_CTX(); rows_mfma<32>(args, layer, lds, MISC, ctl, vcu, G, tid, lane, wave); }
__device__ __forceinline__ void ph_p7(LAS unsigned char* lds, int wv, int layer_) { int layer = __builtin_amdgcn_readfirstlane(layer_); asm volatile("" : "+s"(layer)); PH_CTX();
    moe_tables(ctl, layer, MISC, tid);
    const int nrt = __builtin_amdgcn_readfirstlane((int)MISC[MW_NRT]);
    pg8::Gemm g{(const bf16*)(ws + WS_A1), (const bf16*)(ws + WS_WGU + (size_t)layer * NE * 2048 * D), nrt * 256, NE * 2048, D / 2};
    pg8::MoeOrder S{8, G, vcu, nrt * 8, (const LAS int*)(lds + MISC_OFF + 4 * MW_TILE)};
    pg8::EpiSwiglu E{ws + WS_ACT, FFN, args.b_gu + (size_t)layer * NE * 2048, 1.0f / (S8_H * S8_W), S8_A};
    pg8::gemm_phase<pg8::EpiSwiglu, pg8::MoeOrder, true, true, true>(lds, g, S, E, tid);
    { const int rem = (nrt * 8) % G; if (layer + 1 < DEPTH && rem != 0 && vcu >= rem) convert_range(args, layer + 1, conv_t2(G) + ((vcu - rem) * NWAVES + wave) * CB7, CB7, lds, lane, wave); } }
__device__ __forceinline__ void ph_p8(LAS unsigned char* lds, int wv, int layer_) { int layer = __builtin_amdgcn_readfirstlane(layer_); asm volatile("" : "+s"(layer)); PH_CTX();
    moe_tables(ctl, layer, MISC, tid);
    const int nrt = __builtin_amdgcn_readfirstlane((int)MISC[MW_NRT]);
    pg8::Gemm g{(const bf16*)(ws + WS_ACT), (const bf16*)(ws + WS_WDN + (size_t)layer * NE * D * FFN), nrt * 256, NE * D, FFN / 2};
    pg8::MoeOrder S{4, G, vcu, nrt * 4, (const LAS int*)(lds + MISC_OFF + 4 * MW_TILE)};
    if constexpr (Y8) { pg8::EpiFp8Bias E{ws + WS_Y, D, args.b_dn + (size_t)layer * NE * D, D, 1.0f / (S8_A * S8_W), S8_Y};
        pg8::gemm_phase<pg8::EpiFp8Bias, pg8::MoeOrder, true, true, true>(lds, g, S, E, tid); }
    else { pg8::EpiBf16Bias E{(bf16*)(ws + WS_Y), D, args.b_dn + (size_t)layer * NE * D, D, 1.0f / (S8_A * S8_W)};
        pg8::gemm_phase<pg8::EpiBf16Bias, pg8::MoeOrder, true, true, true>(lds, g, S, E, tid); }
    { const int rem = (nrt * 4) % G; if (layer + 1 < DEPTH && rem != 0 && vcu >= rem) convert_range(args, layer + 1, conv_t2(G) + conv_idle(nrt * 8, G) * NWAVES * CB7 + ((vcu - rem) * NWAVES + wave) * CB8, CB8, lds, lane, wave); } }
__device__ __forceinline__ void ph_final(LAS unsigned char* lds, int wv) { PH_CTX(); final_rows(args, lds, vcu, G, tid, lane); }

#ifndef DBL_MASK
#define DBL_MASK 0
#endif
#if DBL_MASK
#define RUN(bit, call) do { if ((DBL_MASK >> (bit)) & 1) { const unsigned long long t0_ = __builtin_amdgcn_s_memrealtime(); call; const unsigned long long t1_ = __builtin_amdgcn_s_memrealtime(); \
        while (__builtin_amdgcn_s_memrealtime() - t1_ < t1_ - t0_) __builtin_amdgcn_s_sleep(8); } else { call; } } while (0)
#else
#define RUN(bit, call) do { call; } while (0)
#endif
__global__ void __launch_bounds__(NTHR, 2) hybrid_fwd(Args args) {
    extern __shared__ __attribute__((aligned(16))) unsigned char lds_raw[];
    LAS unsigned char* lds = (LAS unsigned char*)lds_raw;
    volatile LAS unsigned* MISC = (volatile LAS unsigned*)(lds + MISC_OFF);
    const int tid = threadIdx.x; const int wv = __builtin_amdgcn_readfirstlane(tid >> 6);
    gu32* ctl = (gu32*)(args.ws + WS_CTL);
    for (int u = tid; u < (LDS_BYTES - MISC_OFF) / 4; u += NTHR) MISC[u] = 0u;
    __syncthreads();
    if (tid == 0) {
#define ST_ARG(i, p) do { const unsigned long long v_ = (unsigned long long)(p); MISC[MW_ARGS + 2 * (i)] = (unsigned)v_; MISC[MW_ARGS + 2 * (i) + 1] = (unsigned)(v_ >> 32); } while (0)
        ST_ARG(0, args.x); ST_ARG(1, args.c); ST_ARG(2, args.pos); ST_ARG(3, args.w_mod); ST_ARG(4, args.b_mod); ST_ARG(5, args.norm1_w); ST_ARG(6, args.w_in); ST_ARG(7, args.gla_wa2); ST_ARG(8, args.gla_ba2);
        ST_ARG(9, args.hg_lb); ST_ARG(10, args.gla_norm_w); ST_ARG(11, args.hg_norm_w); ST_ARG(12, args.w_out); ST_ARG(13, args.norm2_w); ST_ARG(14, args.w_r); ST_ARG(15, args.b_r); ST_ARG(16, args.w_gu);
        ST_ARG(17, args.b_gu); ST_ARG(18, args.w_dn); ST_ARG(19, args.b_dn); ST_ARG(20, args.final_norm_w); ST_ARG(21, args.out); ST_ARG(22, args.ws);
#undef ST_ARG
    }
    __syncthreads();
    const int lo = args.ph_lo, hi = args.ph_hi;
    const bool multi = (hi - lo) > 1;
    XcdBarrier bar; bar.bar = (unsigned*)(ctl + CW_BAR); bar.x = 0; bar.st = nullptr;
    if (multi) bar = xcd_barrier_post((unsigned*)(ctl + CW_BAR), MISC + MW_BAR);
#define IN(k) (lo <= (k) && (k) < hi)
#define SEAM(k) do { if (IN(k) && IN((k) + 1)) xcd_barrier(bar); } while (0)

    if (IN(0)) RUN(0, ph_p0(lds, wv));
    SEAM(0);
    for (int layer = 0; layer < DEPTH; ++layer) {
        const int pb = 1 + 9 * layer;
        if (IN(pb + 0)) RUN(1, ph_p1(lds, wv, layer));
        SEAM(pb + 0);
        if (IN(pb + 1)) RUN(2, ph_p2(lds, wv, layer));
        SEAM(pb + 1);
        if (IN(pb + 2)) RUN(3, ph_p3a(lds, wv, layer));
        SEAM(pb + 2);
        if (IN(pb + 3)) RUN(4, ph_p3b(lds, wv));
        SEAM(pb + 3);
        if (IN(pb + 4)) RUN(5, ph_p3c(lds, wv, layer));
        SEAM(pb + 4);
        if (IN(pb + 5)) RUN(6, ph_p4(lds, wv, layer));
        SEAM(pb + 5);
        if (IN(pb + 6)) RUN(7, ph_p5(lds, wv, layer));
        SEAM(pb + 6);
        if (IN(pb + 7)) RUN(9, ph_p7(lds, wv, layer));
        SEAM(pb + 7);
        if (IN(pb + 8)) RUN(10, ph_p8(lds, wv, layer));
        SEAM(pb + 8);
    }
    if (IN(NPHASE - 1)) RUN(11, ph_final(lds, wv));
#undef IN
#undef SEAM
}

#ifndef MK_SINGLE
#define MK_SINGLE 1
#endif
extern "C" void kernel_launch(void* const* d_in, const int* in_sizes, int n_in, void* d_out, int out_size, void* d_ws, size_t ws_size, hipStream_t stream) {
    static int grid = 0;
    if (grid == 0) {
        if (n_in != 21 || in_sizes[0] != MTOK * D || out_size != MTOK * D || ws_size < WS_END) { fprintf(stderr, "kernel_launch: unexpected problem shape (n_in %d, in0 %d, out %d, ws %zu)\n", n_in, n_in > 0 ? in_sizes[0] : -1, out_size, ws_size); grid = -1; return; }
        int dev = 0, cus = 0, per_cu = 0;
        if (hipGetDevice(&dev) != hipSuccess || hipDeviceGetAttribute(&cus, hipDeviceAttributeMultiprocessorCount, dev) != hipSuccess) { grid = -1; return; }
        if (hipFuncSetAttribute((const void*)hybrid_fwd, hipFuncAttributeMaxDynamicSharedMemorySize, LDS_BYTES) != hipSuccess) { fprintf(stderr, "kernel_launch: hipFuncSetAttribute failed\n"); grid = -1; return; }
        if (hipOccupancyMaxActiveBlocksPerMultiprocessor(&per_cu, (const void*)hybrid_fwd, NTHR, LDS_BYTES) != hipSuccess || per_cu < 1) fprintf(stderr, "kernel_launch: occupancy query says %d\n", per_cu);
        (void)hipGetLastError();
        grid = cus;
    }
    if (grid < 0) return;
    (void)hipMemsetAsync((char*)d_ws + WS_CTL, 0, CTL_ZERO_BYTES, stream);
    Args a{};
    a.x = (const float*)d_in[0]; a.c = (const float*)d_in[1]; a.pos = (const int*)d_in[2]; a.w_mod = (const float*)d_in[3]; a.b_mod = (const float*)d_in[4]; a.norm1_w = (const float*)d_in[5];
    a.w_in = (const float*)d_in[6]; a.gla_wa2 = (const float*)d_in[7]; a.gla_ba2 = (const float*)d_in[8]; a.hg_lb = (const float*)d_in[9]; a.gla_norm_w = (const float*)d_in[10]; a.hg_norm_w = (const float*)d_in[11];
    a.w_out = (const float*)d_in[12]; a.norm2_w = (const float*)d_in[13]; a.w_r = (const float*)d_in[14]; a.b_r = (const float*)d_in[15]; a.w_gu = (const float*)d_in[16]; a.b_gu = (const float*)d_in[17];
    a.w_dn = (const float*)d_in[18]; a.b_dn = (const float*)d_in[19]; a.final_norm_w = (const float*)d_in[20]; a.out = (float*)d_out; a.ws = (unsigned char*)d_ws;
#if MK_SINGLE
    a.ph_lo = 0; a.ph_hi = NPHASE;
    hipLaunchKernelGGL(hybrid_fwd, dim3(grid), dim3(NTHR), LDS_BYTES, stream, a);
#else
    for (int p = 0; p < NPHASE; ++p) { a.ph_lo = p; a.ph_hi = p + 1; hipLaunchKernelGGL(hybrid_fwd, dim3(grid), dim3(NTHR), LDS_BYTES, stream, a); }
#endif
}
```

```cpp
#include <hip/hip_runtime.h>
#include <cstdio>
#include <cstdint>
namespace pg8 {
#define PG8_LAS __attribute__((address_space(3)))
typedef unsigned short bf16_t;
typedef short bf16x8 __attribute__((ext_vector_type(8)));
typedef float f32x4 __attribute__((ext_vector_type(4)));
typedef unsigned u32x4 __attribute__((ext_vector_type(4)));
constexpr int BM = 256, BK = 64, HALF = 128, HTB = HALF * BK * 2  , STAGE_BYTES = 8 * HTB, NXCD = 8, WGM = 8;

__host__ __device__ __forceinline__ int lds_byte(int r, int c) { const int st = (r >> 4) * 2 + (c >> 5), rr = r & 15, cc = c & 31, ob = rr * 64 + cc * 2; return st * 1024 + (ob ^ (((ob >> 9) & 1) << 5)); }
__host__ __device__ __forceinline__ void stage_rc(int b, int& R, int& C) { const int st = b / 1024, sb = b % 1024, swz = sb ^ (((sb >> 9) & 1) << 5); R = (st >> 1) * 16 + swz / 64; C = (st & 1) * 32 + (swz % 64) / 2; }
__host__ __device__ __forceinline__ int perm32(int rho) { const int n = rho >> 4, i = rho & 15; return 8 * (i >> 2) + 4 * n + (i & 3); }

struct Unit { int pm, pn, e, pl; };
struct Gemm { const bf16_t* A; const bf16_t* Bt; int M, N, K; };

struct StaticOrder {
    int nM, nN, nwg, G, c;
    __host__ __device__ void init(int M, int N, int G_, int c_) { nM = M / BM; nN = N / BM; nwg = nM * nN; G = G_; c = c_; }
    __host__ __device__ bool next(int i, Unit& u) const {
        const long L = (long)i * G + c; if (L >= nwg) return false;
        int wgid = (int)L; { const int q = nwg / NXCD, r = nwg % NXCD, xcd = wgid % NXCD, off = wgid / NXCD; wgid = (xcd < r ? xcd * (q + 1) : r * (q + 1) + (xcd - r) * q) + off; }
        const int nig = WGM * nN, gid = wgid / nig, fm = gid * WGM, gsz = (nM - fm) < WGM ? (nM - fm) : WGM;
        u.pm = fm + ((wgid % nig) % gsz); u.pn = (wgid % nig) / gsz; u.e = 0; u.pl = u.pn; return true;
    }
    __device__ __forceinline__ void a_ready(const Unit&) const {}
    __device__ __forceinline__ void done(const Unit&) const {}
};

__device__ __forceinline__ unsigned cvt_pk_bf16(float lo, float hi) { unsigned r; asm volatile("v_cvt_pk_bf16_f32 %0, %1, %2" : "=v"(r) : "v"(lo), "v"(hi)); return r; }

struct EpiBf16Plain {
    static constexpr bool PERM = true, AFTER_DRAIN = false;
    bf16_t* O; int ldc; float sc;
    __device__ __forceinline__ void operator()(const f32x4 (&acc)[2][2][4][2], const Unit& u, int wr, int wc, int fr, int fq) const {
        const int row0 = u.pm * BM + wr * 64 + fr; const int col0 = u.pn * BM + wc * 32 + 8 * fq;
#pragma unroll
        for (int ai = 0; ai < 2; ++ai)
#pragma unroll
            for (int m = 0; m < 4; ++m) { bf16_t* rowp = O + (size_t)(row0 + ai * HALF + m * 16) * ldc + col0;
#pragma unroll
                for (int bj = 0; bj < 2; ++bj) { const f32x4 v0 = acc[ai][bj][m][0] * sc, v1 = acc[ai][bj][m][1] * sc;
                    u32x4 w; w.x = cvt_pk_bf16(v0[0], v0[1]); w.y = cvt_pk_bf16(v0[2], v0[3]); w.z = cvt_pk_bf16(v1[0], v1[1]); w.w = cvt_pk_bf16(v1[2], v1[3]);
                    *(u32x4*)(rowp + bj * HALF) = w; } }
    }
};
struct EpiResGate {
    static constexpr bool PERM = true, AFTER_DRAIN = false;
    const bf16_t* base; bf16_t* out; int ldc; const float* gate; int gpitch; int rows_per_batch; float sc;
    __device__ __forceinline__ void operator()(const f32x4 (&acc)[2][2][4][2], const Unit& u, int wr, int wc, int fr, int fq) const {
        const int row0 = u.pm * BM + wr * 64 + fr, col0 = u.pn * BM + wc * 32 + 8 * fq;
        const float* gp = gate + (size_t)((u.pm * BM) / rows_per_batch) * gpitch + col0;
        f32x4 gv[2][2];
#pragma unroll
        for (int bj = 0; bj < 2; ++bj)
#pragma unroll
            for (int n = 0; n < 2; ++n) gv[bj][n] = *(const f32x4*)(gp + bj * HALF + 4 * n) * sc;
#pragma unroll
        for (int ai = 0; ai < 2; ++ai)
#pragma unroll
            for (int m = 0; m < 4; ++m) { const size_t off = (size_t)(row0 + ai * HALF + m * 16) * ldc + col0;
#pragma unroll
                for (int bj = 0; bj < 2; ++bj) { const u32x4 bs = *(const u32x4*)(base + off + bj * HALF); const unsigned bw[4] = {bs.x, bs.y, bs.z, bs.w}; float r[8];
#pragma unroll
                    for (int j = 0; j < 4; ++j) { const f32x4& a4 = acc[ai][bj][m][j >> 1]; const f32x4& g4 = gv[bj][j >> 1];
                        r[2 * j] = __builtin_bit_cast(float, bw[j] << 16) + g4[2 * (j & 1)] * a4[2 * (j & 1)]; r[2 * j + 1] = __builtin_bit_cast(float, bw[j] & 0xffff0000u) + g4[2 * (j & 1) + 1] * a4[2 * (j & 1) + 1]; }
                    u32x4 w; w.x = cvt_pk_bf16(r[0], r[1]); w.y = cvt_pk_bf16(r[2], r[3]); w.z = cvt_pk_bf16(r[4], r[5]); w.w = cvt_pk_bf16(r[6], r[7]);
                    *(u32x4*)(out + off + bj * HALF) = w; }
                asm volatile("" ::: "memory"); }
    }
};
struct EpiSwiglu {
    static constexpr bool PERM = true, AFTER_DRAIN = false;
    unsigned char* O; int ldc; const float* bias; float inv_in, out_scale;
    __device__ __forceinline__ float act1(float g, float up) const {
        g = fminf(g, 7.0f); up = fminf(fmaxf(up, -7.0f), 7.0f);
        const float s = 1.0f / (1.0f + __expf(-1.702f * g));
        return fminf(fmaxf((up + 1.0f) * g * s * out_scale, -448.f), 448.f);
    }
    __device__ __forceinline__ void operator()(const f32x4 (&acc)[2][2][4][2], const Unit& u, int wr, int wc, int fr, int fq) const {
        const int row0 = u.pm * BM + wr * 64 + fr; const int jj0 = wc * 32 + 8 * fq; const int col0 = u.pl * HALF + jj0;
        const float* bp = bias + (size_t)u.e * 2048 + col0;
        f32x4 bg[2], bu[2];
#pragma unroll
        for (int n = 0; n < 2; ++n) { bg[n] = *(const f32x4*)(bp + 4 * n); bu[n] = *(const f32x4*)(bp + 1024 + 4 * n); }
#pragma unroll
        for (int ai = 0; ai < 2; ++ai)
#pragma unroll
            for (int m = 0; m < 4; ++m) { unsigned char* rowp = O + (size_t)(row0 + ai * HALF + m * 16) * ldc + col0;
                f32x4 r[2];
#pragma unroll
                for (int n = 0; n < 2; ++n) { const f32x4 g = acc[ai][0][m][n] * inv_in + bg[n], up = acc[ai][1][m][n] * inv_in + bu[n];
#pragma unroll
                    for (int j = 0; j < 4; ++j) r[n][j] = act1(g[j], up[j]); }
                int w0 = 0, w1 = 0;
                w0 = __builtin_amdgcn_cvt_pk_fp8_f32(r[0][0], r[0][1], w0, false); w0 = __builtin_amdgcn_cvt_pk_fp8_f32(r[0][2], r[0][3], w0, true);
                w1 = __builtin_amdgcn_cvt_pk_fp8_f32(r[1][0], r[1][1], w1, false); w1 = __builtin_amdgcn_cvt_pk_fp8_f32(r[1][2], r[1][3], w1, true);
                typedef int i32x2 __attribute__((ext_vector_type(2))); *(i32x2*)rowp = (i32x2){w0, w1}; }
    }
};
struct EpiBf16Bias {
    static constexpr bool PERM = true, AFTER_DRAIN = false;
    bf16_t* O; int ldc; const float* bias; int bpitch; float inv_in;
    __device__ __forceinline__ void operator()(const f32x4 (&acc)[2][2][4][2], const Unit& u, int wr, int wc, int fr, int fq) const {
        const int row0 = u.pm * BM + wr * 64 + fr; const int col0 = u.pl * BM + wc * 32 + 8 * fq;
        const float* bp = bias + (size_t)u.e * bpitch + col0;
        f32x4 bv[2][2];
#pragma unroll
        for (int bj = 0; bj < 2; ++bj)
#pragma unroll
            for (int n = 0; n < 2; ++n) bv[bj][n] = *(const f32x4*)(bp + bj * HALF + 4 * n);
#pragma unroll
        for (int ai = 0; ai < 2; ++ai)
#pragma unroll
            for (int m = 0; m < 4; ++m) { bf16_t* rowp = O + (size_t)(row0 + ai * HALF + m * 16) * ldc + col0;
#pragma unroll
                for (int bj = 0; bj < 2; ++bj) { const f32x4 v0 = acc[ai][bj][m][0] * inv_in + bv[bj][0], v1 = acc[ai][bj][m][1] * inv_in + bv[bj][1];
                    u32x4 w; w.x = cvt_pk_bf16(v0[0], v0[1]); w.y = cvt_pk_bf16(v0[2], v0[3]); w.z = cvt_pk_bf16(v1[0], v1[1]); w.w = cvt_pk_bf16(v1[2], v1[3]);
                    *(u32x4*)(rowp + bj * HALF) = w; } }
    }
};
struct EpiFp8Bias {
    static constexpr bool PERM = true, AFTER_DRAIN = false;
    unsigned char* O; int ldc; const float* bias; int bpitch; float inv_in, out_scale;
    __device__ __forceinline__ int pk4(f32x4 v) const { int w = 0; w = __builtin_amdgcn_cvt_pk_fp8_f32(fminf(fmaxf(v[0], -448.f), 448.f), fminf(fmaxf(v[1], -448.f), 448.f), w, false);
        return __builtin_amdgcn_cvt_pk_fp8_f32(fminf(fmaxf(v[2], -448.f), 448.f), fminf(fmaxf(v[3], -448.f), 448.f), w, true); }
    __device__ __forceinline__ void operator()(const f32x4 (&acc)[2][2][4][2], const Unit& u, int wr, int wc, int fr, int fq) const {
        const int row0 = u.pm * BM + wr * 64 + fr; const int col0 = u.pl * BM + wc * 32 + 8 * fq;
        const float* bp = bias + (size_t)u.e * bpitch + col0;
        f32x4 bv[2][2];
#pragma unroll
        for (int bj = 0; bj < 2; ++bj)
#pragma unroll
            for (int n = 0; n < 2; ++n) bv[bj][n] = *(const f32x4*)(bp + bj * HALF + 4 * n);
#pragma unroll
        for (int ai = 0; ai < 2; ++ai)
#pragma unroll
            for (int m = 0; m < 4; ++m) { unsigned char* rowp = O + (size_t)(row0 + ai * HALF + m * 16) * ldc + col0;
#pragma unroll
                for (int bj = 0; bj < 2; ++bj) { const f32x4 v0 = (acc[ai][bj][m][0] * inv_in + bv[bj][0]) * out_scale, v1 = (acc[ai][bj][m][1] * inv_in + bv[bj][1]) * out_scale;
                    typedef int i32x2 __attribute__((ext_vector_type(2))); *(i32x2*)(rowp + bj * HALF) = (i32x2){pk4(v0), pk4(v1)}; } }
    }
};
struct MoeOrder {
    int nN, G, c, nunits; const PG8_LAS int* tile_pm;
    __device__ __forceinline__ bool next(int i, Unit& u) const {
        const int L = i * G + c; if (L >= nunits) return false;
        const int idx = L / nN, pl = L - idx * nN, pm = __builtin_amdgcn_readfirstlane(tile_pm[idx]), e = pm >> 6;
        u.pm = pm; u.pl = pl; u.e = e; u.pn = e * nN + pl; return true;
    }
    __device__ __forceinline__ void a_ready(const Unit&) const {}
    __device__ __forceinline__ void done(const Unit&) const {}
};
typedef int v4i32_t __attribute__((ext_vector_type(4)));
typedef int v8i32_t __attribute__((ext_vector_type(8)));
template <class Epi, class Sched, bool ALIGN_EPI = false, bool SP2 = false, bool FP8 = false>
__device__ __forceinline__ void gemm_phase(PG8_LAS unsigned char* lds, const Gemm g, const Sched& S, const Epi& E, int tid_in) {
    int tid_ = tid_in; asm volatile("" : "+v"(tid_)); const int tid = tid_, wid = __builtin_amdgcn_readfirstlane(tid >> 6), lane = tid & 63, wr = wid >> 2, wc = wid & 3, fr = lane & 15, fq = lane >> 4;
    const int K = g.K, nt = K / BK;
    unsigned voffA, voffB;
    { int R, C; stage_rc(tid * 16, R, C); const int Rb = Epi::PERM ? ((R & ~31) + perm32(R & 31)) : R;
        voffA = (unsigned)(R * K + C) * 2u; voffB = (unsigned)(Rb * K + C) * 2u; }
    const size_t rstep = (size_t)64 * K * 2;
    const size_t kstep = (size_t)(BK * 2);
    const size_t hstep = (size_t)HALF * K * 2;
    const size_t tstep = 2 * hstep;
    const unsigned ldsw = (unsigned)wid * 1024u;
    const int aoff = lds_byte(wr * 64 + fr, fq * 8), boff = lds_byte(wc * 32 + fr, fq * 8);
#define PG8_SA(b, h) (((b) * 2 + (h)) * HTB)
#define PG8_SB(b, h) ((4 + (b) * 2 + (h)) * HTB)
#define PG8_STAGE(bufoff, gbase, voff) do { _Pragma("unroll") for (int _i = 0; _i < 2; ++_i) \
        __builtin_amdgcn_global_load_lds((const unsigned*)((const char*)(gbase) + _i * rstep + (voff)), (PG8_LAS unsigned*)(lds + (bufoff) + ldsw + _i * 8192), 16, 0, 0); } while (0)
#define PG8_LDA(dst, b, h) do { _Pragma("unroll") for (int m = 0; m < 4; ++m) _Pragma("unroll") for (int k = 0; k < 2; ++k) dst[m][k] = *(const PG8_LAS bf16x8*)(lds + PG8_SA(b, h) + aoff + m * 2048 + k * 1024); } while (0)
#define PG8_LDB(dst, b, h) do { _Pragma("unroll") for (int n = 0; n < 2; ++n) _Pragma("unroll") for (int k = 0; k < 2; ++k) dst[n][k] = *(const PG8_LAS bf16x8*)(lds + PG8_SB(b, h) + boff + n * 2048 + k * 1024); } while (0)
#define PG8_MMA(ai, bj, At, Bt) do { __builtin_amdgcn_s_setprio(1); _Pragma("unroll") for (int m = 0; m < 4; ++m) _Pragma("unroll") for (int n = 0; n < 2; ++n) { \
        if constexpr (FP8) { const v8i32_t a8_ = __builtin_shufflevector(__builtin_bit_cast(v4i32_t, At[m][0]), __builtin_bit_cast(v4i32_t, At[m][1]), 0, 1, 2, 3, 4, 5, 6, 7); \
            const v8i32_t b8_ = __builtin_shufflevector(__builtin_bit_cast(v4i32_t, Bt[n][0]), __builtin_bit_cast(v4i32_t, Bt[n][1]), 0, 1, 2, 3, 4, 5, 6, 7); \
            asm volatile("v_mfma_scale_f32_16x16x128_f8f6f4 %0, %1, %2, %0, %3, %3 op_sel_hi:[0,0,0]" : "+v"(acc[ai][bj][m][n]) : "v"(b8_), "v"(a8_), "v"(one8_)); } \
        else { _Pragma("unroll") for (int k = 0; k < 2; ++k) acc[ai][bj][m][n] = __builtin_amdgcn_mfma_f32_16x16x32_bf16(Bt[n][k], At[m][k], acc[ai][bj][m][n], 0, 0, 0); } } \
        __builtin_amdgcn_s_setprio(0); } while (0)
#define PG8_WAIT_V(n) asm volatile("s_waitcnt vmcnt(" #n ")" ::: "memory")
#define PG8_WAIT_L(n) asm volatile("s_waitcnt lgkmcnt(" #n ")" ::: "memory")
#define PG8_BAR __builtin_amdgcn_s_barrier()
#define PG8_SCHED __builtin_amdgcn_sched_barrier(0)
    Unit cur, nxt; int ui = 0;
    if (!S.next(0, cur)) return;
    f32x4 acc[2][2][4][2];
#pragma unroll
    for (int a = 0; a < 2; ++a)
#pragma unroll
        for (int b = 0; b < 2; ++b)
#pragma unroll
            for (int m = 0; m < 4; ++m)
#pragma unroll
                for (int n = 0; n < 2; ++n) acc[a][b][m][n] = (f32x4){0.f, 0.f, 0.f, 0.f};
    bf16x8 At[4][2], B0[2][2], B1[2][2];
    int one8_ = 0x7f7f7f7f; asm volatile("" : "+v"(one8_));
    const char* cA = (const char*)g.A + (size_t)cur.pm * tstep; const char* cB = (const char*)g.Bt + (size_t)cur.pn * tstep;
    S.a_ready(cur);
    if constexpr (SP2) {
        PG8_STAGE(PG8_SB(0, 0), cB, voffB); PG8_STAGE(PG8_SB(0, 1), cB + hstep, voffB); PG8_STAGE(PG8_SA(0, 0), cA, voffA); PG8_STAGE(PG8_SA(0, 1), cA + hstep, voffA);
        if (wr == 1) PG8_BAR;
        PG8_WAIT_V(2); PG8_BAR;
        PG8_STAGE(PG8_SB(1, 0), cB + kstep, voffB); PG8_STAGE(PG8_SA(1, 0), cA + kstep, voffA); PG8_STAGE(PG8_SB(1, 1), cB + hstep + kstep, voffB);
        PG8_WAIT_V(6); PG8_BAR;
    } else {
        PG8_STAGE(PG8_SB(0, 0), cB, voffB); PG8_STAGE(PG8_SA(0, 0), cA, voffA); PG8_STAGE(PG8_SB(0, 1), cB + hstep, voffB); PG8_STAGE(PG8_SA(0, 1), cA + hstep, voffA);
        if (wr == 1) PG8_BAR;
        PG8_WAIT_V(4); PG8_BAR;
        PG8_STAGE(PG8_SB(1, 0), cB + kstep, voffB); PG8_STAGE(PG8_SA(1, 0), cA + kstep, voffA); PG8_STAGE(PG8_SB(1, 1), cB + hstep + kstep, voffB);
        PG8_WAIT_V(6); PG8_BAR;
    }
    for (;;) {
        const bool has_next = S.next(ui + 1, nxt);
        const char* nA = has_next ? (const char*)g.A + (size_t)nxt.pm * tstep : cA; const char* nB = has_next ? (const char*)g.Bt + (size_t)nxt.pn * tstep : cB;
#pragma unroll 1
        for (int t = 0; t < nt; t += 2) {
            const bool last = (t == nt - 2);
            const char* a1 = cA + (size_t)(t + 1) * kstep;
            const char* a2 = last ? nA : cA + (size_t)(t + 2) * kstep; const char* b2 = last ? nB : cB + (size_t)(t + 2) * kstep;
            const char* a3 = a2 + kstep; const char* b3 = b2 + kstep;
            if (last && has_next) S.a_ready(nxt);
            if constexpr (SP2) {
            PG8_LDB(B0, 0, 0); PG8_LDB(B1, 0, 1); PG8_SCHED; PG8_LDA(At, 0, 0); PG8_STAGE(PG8_SA(1, 1), a1 + hstep, voffA);
            PG8_WAIT_V(8); PG8_WAIT_L(0); PG8_BAR; PG8_MMA(0, 0, At, B0); PG8_MMA(0, 1, At, B1); PG8_BAR; PG8_SCHED;
            PG8_LDA(At, 0, 1); PG8_STAGE(PG8_SB(0, 0), b2, voffB); PG8_STAGE(PG8_SB(0, 1), b2 + hstep, voffB); PG8_STAGE(PG8_SA(0, 0), a2, voffA);
            PG8_WAIT_V(8); PG8_WAIT_L(0); PG8_BAR; PG8_MMA(1, 0, At, B0); PG8_MMA(1, 1, At, B1); PG8_BAR; PG8_SCHED;
            PG8_LDB(B0, 1, 0); PG8_LDB(B1, 1, 1); PG8_SCHED; PG8_LDA(At, 1, 0); PG8_STAGE(PG8_SA(0, 1), a2 + hstep, voffA);
            PG8_WAIT_V(8); PG8_WAIT_L(0); PG8_BAR; PG8_MMA(0, 0, At, B0); PG8_MMA(0, 1, At, B1); PG8_BAR; PG8_SCHED;
            PG8_LDA(At, 1, 1); PG8_STAGE(PG8_SB(1, 0), b3, voffB); PG8_STAGE(PG8_SB(1, 1), b3 + hstep, voffB); PG8_STAGE(PG8_SA(1, 0), a3, voffA);
            PG8_WAIT_V(8); PG8_WAIT_L(0); PG8_BAR; PG8_MMA(1, 0, At, B0); PG8_MMA(1, 1, At, B1); PG8_BAR; PG8_SCHED;
            } else {
            PG8_LDB(B0, 0, 0); PG8_SCHED; PG8_LDA(At, 0, 0); PG8_STAGE(PG8_SA(1, 1), a1 + hstep, voffA);
            PG8_WAIT_L(8); PG8_BAR; PG8_WAIT_L(0); PG8_MMA(0, 0, At, B0); PG8_BAR; PG8_SCHED;
            PG8_LDB(B1, 0, 1); PG8_STAGE(PG8_SB(0, 0), b2, voffB);
            PG8_BAR; PG8_WAIT_L(0); PG8_MMA(0, 1, At, B1); PG8_BAR;
            PG8_LDA(At, 0, 1); PG8_STAGE(PG8_SA(0, 0), a2, voffA);
            PG8_BAR; PG8_WAIT_L(0); PG8_MMA(1, 0, At, B0); PG8_BAR; PG8_SCHED;
            PG8_STAGE(PG8_SB(0, 1), b2 + hstep, voffB);
            PG8_WAIT_V(6); PG8_BAR; PG8_MMA(1, 1, At, B1); PG8_BAR;
            PG8_LDB(B0, 1, 0); PG8_SCHED; PG8_LDA(At, 1, 0); PG8_STAGE(PG8_SA(0, 1), a2 + hstep, voffA);
            PG8_WAIT_L(8); PG8_BAR; PG8_WAIT_L(0); PG8_MMA(0, 0, At, B0); PG8_BAR; PG8_SCHED;
            PG8_LDB(B1, 1, 1); PG8_STAGE(PG8_SB(1, 0), b3, voffB);
            PG8_BAR; PG8_WAIT_L(0); PG8_MMA(0, 1, At, B1); PG8_BAR;
            PG8_LDA(At, 1, 1); PG8_STAGE(PG8_SA(1, 0), a3, voffA);
            PG8_BAR; PG8_WAIT_L(0); PG8_MMA(1, 0, At, B0); PG8_BAR; PG8_SCHED;
            PG8_STAGE(PG8_SB(1, 1), b3 + hstep, voffB);
            PG8_WAIT_V(6); PG8_BAR; PG8_MMA(1, 1, At, B1); PG8_BAR;
            }
        }
        if constexpr (FP8) asm volatile("s_nop 7\n\ts_nop 7" ::: "memory");
        if constexpr (ALIGN_EPI) { if (wr == 0) PG8_BAR; }
        if constexpr (!Epi::AFTER_DRAIN) { int ln_ = (int)__builtin_amdgcn_mbcnt_hi(~0u, __builtin_amdgcn_mbcnt_lo(~0u, 0u)); asm volatile("" : "+v"(ln_)); E(acc, cur, wr, wc, ln_ & 15, ln_ >> 4); S.done(cur); }
        if (!has_next) break;
#pragma unroll
        for (int a = 0; a < 2; ++a)
#pragma unroll
            for (int b = 0; b < 2; ++b)
#pragma unroll
                for (int m = 0; m < 4; ++m)
#pragma unroll
                    for (int n = 0; n < 2; ++n) acc[a][b][m][n] = (f32x4){0.f, 0.f, 0.f, 0.f};
        cur = nxt; cA = nA; cB = nB; ++ui;
        if constexpr (ALIGN_EPI) { if (wr == 1) PG8_BAR; }
    }
    PG8_WAIT_V(0);
    if constexpr (!ALIGN_EPI) { if (wr == 0) PG8_BAR; }
    PG8_BAR;
    if constexpr (Epi::AFTER_DRAIN) { E.fused(acc, cur, wr, wc, fr, fq, lds, wid, lane); S.done(cur); }
#undef PG8_SA
#undef PG8_SB
#undef PG8_STAGE
#undef PG8_LDA
#undef PG8_LDB
#undef PG8_MMA
#undef PG8_WAIT_V
#undef PG8_WAIT_L
#undef PG8_BAR
#undef PG8_SCHED
}
}

constexpr int NWAVES = 8, NTHR = 512;
constexpr int BATCH = 2, SEQ = 8192, D = 1024, DEPTH = 4, MTOK = BATCH * SEQ;
constexpr int DIN = 3344, NPROJ = 3328, SRC_GA = 1152;
constexpr int C_GQ = 0, C_GK = 192, C_GV = 384, C_GG = 768, C_HQ = 1152, C_HF = 1408, C_HI = 1664, C_HG = 1920, C_RQ = 2176, C_RK = 2368, C_RV = 2560, C_RG = 2944;
constexpr int NE = 32, FFN = 1024;
constexpr int CH = 64, NCH = SEQ / CH, NUNIT = BATCH * NCH;
constexpr int ST_GLA = 0, ST_HG = 4 * 48 * 96, ST_RET = ST_HG + 4 * 64 * 64, ST_TOT = ST_RET + 4 * 48 * 96;
constexpr int NDV = 448;
constexpr int MAXROWS = 65536 + NE * 256, MAXRT = MAXROWS / 256;
constexpr float EPS = 1e-6f;
#ifndef F8_IN_V
#define F8_IN_V false
#endif
#ifndef F8_OUT_V
#define F8_OUT_V false
#endif
constexpr bool F8_IN = F8_IN_V, F8_OUT = F8_OUT_V;
#ifndef Y8_V
#define Y8_V true
#endif
constexpr bool Y8 = Y8_V;
constexpr float S8_Y = 16.f;
constexpr float S8_M = 32.f;
constexpr float S8_W = 2048.f, S8_H = 64.f, S8_A = 8.f;
constexpr int NPHASE = 38;
constexpr int ECAP = 16384, ECAP_SH = 14;

constexpr size_t MiB = 1u << 20;
constexpr size_t WS_CTL = 0, CTL_ZERO_BYTES = 65536;
constexpr size_t WS_MOD = 1 * MiB;
constexpr size_t WS_ROPE = 2 * MiB;
constexpr size_t WS_LB = 5 * MiB;
constexpr size_t WS_WIN = 8 * MiB;
constexpr size_t WS_WOUT = 34 * MiB;
constexpr size_t WS_WGU = 42 * MiB;
constexpr size_t WS_WDN = 554 * MiB;
constexpr size_t WS_X = 810 * MiB;
constexpr size_t WS_H = 874 * MiB;
constexpr size_t WS_GA = 906 * MiB;
constexpr size_t WS_PROJ = 907 * MiB;
constexpr size_t WS_U = 1011 * MiB;
constexpr size_t WS_DVEC = 1063 * MiB;
constexpr size_t WS_SP = 1064 * MiB;
constexpr size_t WS_MIX = 1090 * MiB;
constexpr size_t WS_TOPE = 1122 * MiB;
constexpr size_t WS_TOPW = WS_TOPE + 256 * 1024;
constexpr size_t WS_SLOT = WS_TOPW + 256 * 1024;
constexpr size_t WS_A1 = 1123 * MiB;
constexpr size_t WS_ACT = 1635 * MiB;
constexpr size_t WS_Y = 2147 * MiB;
constexpr size_t WS_CUM = 3171 * MiB;
constexpr size_t WS_END = 3199 * MiB;
static_assert(WS_WIN + (size_t)DEPTH * NPROJ * D * 2 <= WS_WOUT && WS_PROJ + (size_t)MTOK * NPROJ * 2 <= WS_U && WS_U + (size_t)NUNIT * ST_TOT * 4 <= WS_DVEC && WS_SP + (size_t)NUNIT * ST_TOT * 2 <= WS_MIX && WS_A1 + (size_t)NE * ECAP * D <= WS_ACT && WS_ACT + (size_t)NE * ECAP * D <= WS_Y && WS_Y + (size_t)NE * ECAP * D * 2 <= WS_CUM, "ws map");
constexpr int CW_TMO = 0, CW_CODE = 1, CW_BAR = 4096, CW_CNT = 8192, CW_FILL = 8192 + 256;
constexpr int RING_BYTES = 131072;
constexpr int MISC_OFF = 147456, LDS_BYTES = MISC_OFF + 4096;
constexpr int MW_BAR = 0, MW_CNT = 16, MW_PST = 48, MW_HIST = 96, MW_BASE = 128, MW_TILE = 192, MW_NRT = 480, MW_SLOTS = 512;

#define GAS __attribute__((address_space(1)))
#define LAS __attribute__((address_space(3)))
typedef unsigned v4u __attribute__((ext_vector_type(4)));
typedef float f32x4 __attribute__((ext_vector_type(4)));
typedef short bf16x8 __attribute__((ext_vector_type(8)));
typedef GAS unsigned gu32;
typedef GAS unsigned long long gu64;
#define RLX_AGENT __ATOMIC_RELAXED, __HIP_MEMORY_SCOPE_AGENT
#define LDS_WAIT() asm volatile("s_waitcnt lgkmcnt(0)" ::: "memory")
#define VM_WAIT() asm volatile("s_waitcnt vmcnt(0)" ::: "memory")
__device__ __forceinline__ unsigned long long rt() { return __builtin_amdgcn_s_memrealtime(); }
typedef unsigned short bf16;
__device__ __forceinline__ unsigned f2bf(float f) { unsigned u = __builtin_bit_cast(unsigned, f); return (u + 0x7fffu + ((u >> 16) & 1u)) >> 16; }
__device__ __forceinline__ unsigned pk2(float lo, float hi) { return f2bf(lo) | (f2bf(hi) << 16); }
__device__ __forceinline__ float bf2f(bf16 b) { return __builtin_bit_cast(float, (unsigned)b << 16); }
#define XB_TMO      128
#define XB_XCNT(j)  (256  + 64 * (j))
#define XB_XSUB(j)  (1280 + 64 * (j))
#define XB_XGEN(j)  (2304 + 64 * (j))
#define XB_TOP      3328
#define XB_TOPGEN   3392
#define XCD_BAR_WORDS 3456
#define XB_SPIN_CAP (1u << 18)

__device__ __forceinline__ unsigned xb_ld(unsigned* p)              { return __hip_atomic_load(p, __ATOMIC_RELAXED, __HIP_MEMORY_SCOPE_AGENT); }
__device__ __forceinline__ unsigned xb_add(unsigned* p, unsigned v) { return __hip_atomic_fetch_add(p, v, __ATOMIC_RELAXED, __HIP_MEMORY_SCOPE_AGENT); }
__device__ __forceinline__ unsigned xb_xcc_id() { return (unsigned)__builtin_amdgcn_s_getreg((3 << 11) | 20) & 0xFu; }
#define XB_SPIN(cond, bar) do { unsigned _sp = 0; while (cond) { __builtin_amdgcn_s_sleep(1); \
    if ((++_sp & 255u) == 0u) { if (xb_ld(&(bar)[XB_TMO])) break; if (_sp > XB_SPIN_CAP) { atomicAdd(&(bar)[XB_TMO], 1u); break; } } } } while (0)

struct XcdBarrier {
    unsigned* bar; unsigned x;
    volatile LAS unsigned* st;
};

__device__ __forceinline__ XcdBarrier xcd_barrier_post(unsigned* bar, volatile LAS unsigned* st) {
    XcdBarrier b; b.bar = bar; b.x = xb_xcc_id(); b.st = st;
    if (threadIdx.x == 0) (void)xb_add(&bar[XB_XCNT(b.x)], 1u);
    return b;
}
__device__ __forceinline__ void xcd_barrier_complete(unsigned* bar, unsigned x, unsigned& nloc, unsigned& nx) {
    const unsigned G = gridDim.x * gridDim.y * gridDim.z;
    unsigned sum, cnt, mine, sp = 0u;
    for (;;) {
        sum = 0u; cnt = 0u; mine = 0u;
#pragma unroll
        for (unsigned j = 0; j < 16; ++j) { const unsigned c = xb_ld(&bar[XB_XCNT(j)]); sum += c; cnt += (c > 0u) ? 1u : 0u; mine = (j == x) ? c : mine; }
        if (sum == G) break;
        __builtin_amdgcn_s_sleep(1);
        if ((++sp & 255u) == 0u) { if (xb_ld(&bar[XB_TMO])) break; if (sp > XB_SPIN_CAP) { atomicAdd(&bar[XB_TMO], 1u); break; } }
    }
    nloc = mine > 0u ? mine : 1u; nx = cnt > 0u ? cnt : 1u;
}

__device__ __forceinline__ void xcd_barrier(const XcdBarrier& b) {
    asm volatile("s_waitcnt vmcnt(0)" ::: "memory");
    __syncthreads();
    if (threadIdx.x == 0) {
        unsigned* bar = b.bar;
        __builtin_amdgcn_s_waitcnt(0);
        unsigned nloc = b.st[0], nx = b.st[1];
        if (nloc == 0u) { xcd_barrier_complete(bar, b.x, nloc, nx); b.st[0] = nloc; b.st[1] = nx; }
        const unsigned old = xb_add(&bar[XB_XSUB(b.x)], 1u);
        const unsigned gen = old / nloc;
        if (old + 1u == (gen + 1u) * nloc) {
            __builtin_amdgcn_fence(__ATOMIC_RELEASE, "agent");
            asm volatile("s_waitcnt vmcnt(0)" ::: "memory");
            const unsigned og = xb_add(&bar[XB_TOP], 1u);
            const unsigned tg = og / nx;
            if (og + 1u == (tg + 1u) * nx) xb_add(&bar[XB_TOPGEN], 1u);
            else XB_SPIN(xb_ld(&bar[XB_TOPGEN]) == tg, bar);
            __builtin_amdgcn_fence(__ATOMIC_ACQUIRE, "agent");
            xb_add(&bar[XB_XGEN(b.x)], 1u);
            asm volatile("s_waitcnt vmcnt(0)" ::: "memory");
        } else {
            XB_SPIN(xb_ld(&bar[XB_XGEN(b.x)]) == gen, bar);
            __builtin_amdgcn_fence(__ATOMIC_ACQUIRE, "agent");
            asm volatile("s_waitcnt vmcnt(0)" ::: "memory");
        }
    }
    __syncthreads();
}

__device__ __forceinline__ float wave_sum(float v) {
#pragma unroll
    for (int o = 1; o < 64; o <<= 1) v += __shfl_xor(v, o);
    return v;
}
__device__ __forceinline__ float log_sigmoid_f(float x) { return fminf(x, 0.f) - log1pf(expf(-fabsf(x))); }
__device__ __forceinline__ float silu_f(float x) { return x / (1.0f + expf(-x)); }
__device__ __forceinline__ float sigmoid_f(float x) { return 1.0f / (1.0f + expf(-x)); }
__device__ __forceinline__ pg8::bf16x8 ldfrag(const LAS bf16* base, int stride, int r0, int k0, int lane) {
    return *(const LAS pg8::bf16x8*)(base + (r0 + (lane & 15)) * stride + k0 + 8 * (lane >> 4));
}
__device__ __forceinline__ pg8::bf16x8 pack8(const float (&v)[8]) { v4u w; w.x = pk2(v[0], v[1]); w.y = pk2(v[2], v[3]); w.z = pk2(v[4], v[5]); w.w = pk2(v[6], v[7]); return __builtin_bit_cast(pg8::bf16x8, w); }

struct Args {
    const float* x; const float* c; const int* pos; const float* w_mod; const float* b_mod; const float* norm1_w; const float* w_in; const float* gla_wa2; const float* gla_ba2; const float* hg_lb;
    const float* gla_norm_w; const float* hg_norm_w; const float* w_out; const float* norm2_w; const float* w_r; const float* b_r; const float* w_gu; const float* b_gu; const float* w_dn; const float* b_dn;
    const float* final_norm_w; float* out; unsigned char* ws; int ph_lo, ph_hi;
};

__device__ __forceinline__ void transpose_block64(const float* src, int ld, bf16* dst, LAS float* scr, int lane) {
    const int r = lane >> 4, c4 = (lane & 15) * 4;
    f32x4 v[16];
#pragma unroll
    for (int i = 0; i < 16; ++i) v[i] = __builtin_nontemporal_load((const f32x4*)(src + (size_t)(4 * i + r) * ld + c4));
#pragma unroll
    for (int i = 0; i < 16; ++i) { LAS float* w = scr + (4 * i + r) * 65 + c4; w[0] = v[i][0]; w[1] = v[i][1]; w[2] = v[i][2]; w[3] = v[i][3]; }
    LDS_WAIT(); asm volatile("" ::: "memory");
    const int kc = lane & 7;
#pragma unroll
    for (int jj = 0; jj < 8; ++jj) { const int n = (lane >> 3) + 8 * jj; const LAS float* s = scr + (8 * kc) * 65 + n;
        v4u o; o.x = pk2(s[0 * 65], s[1 * 65]); o.y = pk2(s[2 * 65], s[3 * 65]); o.z = pk2(s[4 * 65], s[5 * 65]); o.w = pk2(s[6 * 65], s[7 * 65]);
        *(GAS v4u*)(dst + (size_t)n * D + 8 * kc) = o; }
    LDS_WAIT(); asm volatile("" ::: "memory");
}
__device__ __forceinline__ int pk4_fp8(float a, float b, float c, float d) { int w = 0; w = __builtin_amdgcn_cvt_pk_fp8_f32(fminf(fmaxf(a, -448.f), 448.f), fminf(fmaxf(b, -448.f), 448.f), w, false);
    return __builtin_amdgcn_cvt_pk_fp8_f32(fminf(fmaxf(c, -448.f), 448.f), fminf(fmaxf(d, -448.f), 448.f), w, true); }
__device__ __forceinline__ void transpose_block64_fp8(const float* src, int ld, unsigned char* dst, LAS float* scr, int lane, float sc) {
    const int r = lane >> 4, c4 = (lane & 15) * 4;
    f32x4 v[16];
#pragma unroll
    for (int i = 0; i < 16; ++i) v[i] = __builtin_nontemporal_load((const f32x4*)(src + (size_t)(4 * i + r) * ld + c4));
#pragma unroll
    for (int i = 0; i < 16; ++i) { LAS float* w = scr + (4 * i + r) * 65 + c4; w[0] = v[i][0] * sc; w[1] = v[i][1] * sc; w[2] = v[i][2] * sc; w[3] = v[i][3] * sc; }
    LDS_WAIT(); asm volatile("" ::: "memory");
    const int kc = lane & 3;
#pragma unroll
    for (int jj = 0; jj < 4; ++jj) { const int n = (lane >> 2) + 16 * jj; const LAS float* s = scr + (16 * kc) * 65 + n;
        v4u o; o.x = (unsigned)pk4_fp8(s[0 * 65], s[1 * 65], s[2 * 65], s[3 * 65]); o.y = (unsigned)pk4_fp8(s[4 * 65], s[5 * 65], s[6 * 65], s[7 * 65]);
        o.z = (unsigned)pk4_fp8(s[8 * 65], s[9 * 65], s[10 * 65], s[11 * 65]); o.w = (unsigned)pk4_fp8(s[12 * 65], s[13 * 65], s[14 * 65], s[15 * 65]);
        *(GAS v4u*)(dst + (size_t)n * D + 16 * kc) = o; }
    LDS_WAIT(); asm volatile("" ::: "memory");
}
constexpr int IT_IN = 16 * (NPROJ / 64), IT_OUT = 16 * 16, IT_GU = NE * 16 * 32, IT_DN = NE * 16 * 16, IT_LAYER = IT_IN + IT_OUT + IT_GU + IT_DN, IT_ALL = DEPTH * IT_LAYER;
__device__ __forceinline__ void convert_item(const Args& a, int l, int r, LAS float* scr, int lane) {
    unsigned char* ws = a.ws;
    bf16* WIN = (bf16*)(ws + WS_WIN); bf16* WOUT = (bf16*)(ws + WS_WOUT); unsigned char* WGU = ws + WS_WGU; unsigned char* WDN = ws + WS_WDN;
    if (r < IT_IN) { const int kb = r / (NPROJ / 64), nb = r % (NPROJ / 64), n0 = 64 * nb, sc = n0 + (n0 >= SRC_GA ? 16 : 0);
        if (F8_IN) transpose_block64_fp8(a.w_in + ((size_t)l * D + 64 * kb) * DIN + sc, DIN, (unsigned char*)WIN + ((size_t)l * NPROJ + n0) * D + 64 * kb, scr, lane, S8_W);
        else transpose_block64(a.w_in + ((size_t)l * D + 64 * kb) * DIN + sc, DIN, WIN + ((size_t)l * NPROJ + n0) * D + 64 * kb, scr, lane); return; }
    r -= IT_IN;
    if (r < IT_OUT) { const int kb = r / 16, nb = r % 16;
        if (F8_OUT) transpose_block64_fp8(a.w_out + ((size_t)l * D + 64 * kb) * D + 64 * nb, D, (unsigned char*)WOUT + ((size_t)l * D + 64 * nb) * D + 64 * kb, scr, lane, S8_W);
        else transpose_block64(a.w_out + ((size_t)l * D + 64 * kb) * D + 64 * nb, D, WOUT + ((size_t)l * D + 64 * nb) * D + 64 * kb, scr, lane); return; }
    r -= IT_OUT;
    if (r < IT_GU) { const int e = r / 512, r2 = r % 512, kb = r2 / 32, nb = r2 % 32, cc = 64 * nb;
        const int row = (cc < 1024) ? 256 * (cc / 128) + (cc % 128) : 256 * ((cc - 1024) / 128) + 128 + ((cc - 1024) % 128);
        transpose_block64_fp8(a.w_gu + (((size_t)l * NE + e) * D + 64 * kb) * 2048 + cc, 2048, WGU + (((size_t)l * NE + e) * 2048 + row) * D + 64 * kb, scr, lane, S8_W); return; }
    r -= IT_GU;
    { const int e = r / 256, r2 = r % 256, kb = r2 / 16, nb = r2 % 16;
        transpose_block64_fp8(a.w_dn + (((size_t)l * NE + e) * FFN + 64 * kb) * D + 64 * nb, D, WDN + (((size_t)l * NE + e) * D + 64 * nb) * D + 64 * kb, scr, lane, S8_W); }
}
constexpr int CB2 = 4, CB7 = 2, CB8 = 2;
__device__ __forceinline__ int conv_t2(int G) { return (G == 256) ? 192 * NWAVES * CB2 : 0; }
__device__ __forceinline__ int conv_idle(int nunits, int G) { const int rem = nunits % G; return rem ? G - rem : 0; }
__device__ __forceinline__ void convert_range(const Args& a, int l, int first, int count, LAS unsigned char* lds, int lane, int wave) {
    LAS float* scr = (LAS float*)(lds + wave * 16640);
    for (int k = 0; k < count; ++k) { const int it = first + k; if (it < IT_LAYER) convert_item(a, l, it, scr, lane); }
}
__device__ __forceinline__ void p0_prologue(const Args& a, LAS unsigned char* lds, int vcu, int G, int tid, int lane, int wave) {
    unsigned char* ws = a.ws;
    LAS float* scr = (LAS float*)(lds + wave * 16640);
    const int gw = vcu * NWAVES + wave, NGW = G * NWAVES;
    for (int it = gw; it < IT_LAYER; it += NGW) convert_item(a, 0, it, scr, lane);
    __syncthreads();
    {
        LAS float* cact = (LAS float*)lds;
        LAS float* red = (LAS float*)(lds + 8192);
        for (int i = tid; i < 2 * D; i += NTHR) cact[i] = silu_f(a.c[i]);
        __syncthreads();
        float* MOD = (float*)(ws + WS_MOD);
        for (int it = vcu; it < DEPTH * 96; it += G) {
            const int l = it / 96, n0 = (it % 96) * 64;
            const float* wp = a.w_mod + ((size_t)l * D + 128 * wave) * 6144 + n0 + lane;
            float a0 = 0.f, a1 = 0.f;
#pragma unroll 32
            for (int k = 0; k < 128; ++k) { const float w = __builtin_nontemporal_load(wp + (size_t)k * 6144); a0 += cact[128 * wave + k] * w; a1 += cact[D + 128 * wave + k] * w; }
            red[(wave * 2 + 0) * 64 + lane] = a0; red[(wave * 2 + 1) * 64 + lane] = a1;
            __syncthreads();
            if (tid < 128) { const int b = tid >> 6, ln = tid & 63; float s = a.b_mod[l * 6144 + n0 + ln];
#pragma unroll
                for (int w = 0; w < 8; ++w) s += red[(w * 2 + b) * 64 + ln];
                MOD[((size_t)l * 2 + b) * 6144 + n0 + ln] = s; }
            __syncthreads();
        }
    }
    { const f32x4* xs = (const f32x4*)a.x; uint2* xd = (uint2*)(ws + WS_X);
        for (int i = vcu * NTHR + tid; i < MTOK * D / 4; i += G * NTHR) { const f32x4 v = xs[i]; uint2 p; p.x = pk2(v[0], v[1]); p.y = pk2(v[2], v[3]); xd[i] = p; } }
    {
        float* ROPE = (float*)(ws + WS_ROPE);
        for (int i = vcu * NTHR + tid; i < MTOK * 24; i += G * NTHR) { const int t = i / 24, f = i % 24;
            const float inv = (float)pow(10000.0, -(double)f / 24.0); const float ang = (float)a.pos[t] * inv;
            ROPE[(size_t)t * 48 + f] = cosf(ang); ROPE[(size_t)t * 48 + 24 + f] = sinf(ang); }
    }
    if (vcu == 0 && tid < 256) {
        float v[4], mx = -3.0e38f; for (int l = 0; l < 4; ++l) { v[l] = a.hg_lb[l * 256 + tid]; mx = fmaxf(mx, v[l]); }
        float s = 0.f; for (int l = 0; l < 4; ++l) { v[l] = expf(v[l] - mx); s += v[l]; }
        float* LB = (float*)(ws + WS_LB); float cs = 0.f, first = 0.f;
        for (int l = 0; l < 4; ++l) { cs += v[l] / s; if (l == 0) first = cs; LB[l * 256 + tid] = cs - first; }
    }
}

__device__ __forceinline__ void moe_combine_row(f32x4 (&v)[4], int m, const bf16* Y, const int* SLOT, const float* TOPW, const float* g2, int lane) {
    const int4 sl = *(const int4*)(SLOT + (size_t)m * 4); const f32x4 tw = *(const f32x4*)(TOPW + (size_t)m * 4);
    const int s[4] = {sl.x, sl.y, sl.z, sl.w};
    f32x4 acc[4];
#pragma unroll
    for (int j = 0; j < 4; ++j) acc[j] = (f32x4){0.f, 0.f, 0.f, 0.f};
#pragma unroll
    for (int k = 0; k < 4; ++k) { const bf16* yr = Y + (size_t)s[k] * D + 4 * lane; const float w = tw[k];
#pragma unroll
        for (int j = 0; j < 4; ++j) { const uint2 p = *(const uint2*)(yr + 256 * j);
            acc[j][0] += w * __builtin_bit_cast(float, p.x << 16); acc[j][1] += w * __builtin_bit_cast(float, p.x & 0xffff0000u);
            acc[j][2] += w * __builtin_bit_cast(float, p.y << 16); acc[j][3] += w * __builtin_bit_cast(float, p.y & 0xffff0000u); } }
#pragma unroll
    for (int j = 0; j < 4; ++j) { const f32x4 g = *(const f32x4*)(g2 + 4 * lane + 256 * j); v[j] = v[j] + g * acc[j]; }
}
__device__ __forceinline__ float row_rstd(const f32x4 (&v)[4]) {
    float s = 0.f;
#pragma unroll
    for (int j = 0; j < 4; ++j) s += (v[j][0] * v[j][0] + v[j][1] * v[j][1]) + (v[j][2] * v[j][2] + v[j][3] * v[j][3]);
    return 1.0f / sqrtf(wave_sum(s) * (1.0f / D) + EPS);
}
__device__ __forceinline__ void modulate_row(f32x4 (&v)[4], float rstd, const float* nw, const float* sc, const float* sh, bf16* hrow, int lane) {
#pragma unroll
    for (int j = 0; j < 4; ++j) { const int c0 = 4 * lane + 256 * j; const f32x4 w = *(const f32x4*)(nw + c0), s1 = *(const f32x4*)(sc + c0), s0 = *(const f32x4*)(sh + c0);
        v[j] = v[j] * rstd * w * (s1 + 1.0f) + s0;
        uint2 p; p.x = pk2(v[j][0], v[j][1]); p.y = pk2(v[j][2], v[j][3]); *(uint2*)(hrow + c0) = p; }
}


constexpr int LR_SLT = 142976, LR_TWL = 144000, LR_SSR = 145024;
__device__ __forceinline__ void stage_slots(const unsigned char* ws, int row0, LAS unsigned char* lds, int tid) {
    if (tid < 64) { *(LAS v4u*)(lds + LR_SLT + 16 * tid) = *(const v4u*)((const int*)(ws + WS_SLOT) + (size_t)(row0 + tid) * 4);
                    *(LAS f32x4*)(lds + LR_TWL + 16 * tid) = *(const f32x4*)((const float*)(ws + WS_TOPW) + (size_t)(row0 + tid) * 4); }
}
template <bool SS, bool OUTF32>
__device__ __forceinline__ void flat_combine(const bf16* xsrc, void* xdst, int row0, const bf16* Y, const float* g2, LAS unsigned char* lds, int tid, int lane) {
    const int c4 = tid & 255, rsub = tid >> 8; const f32x4 g = *(const f32x4*)(g2 + 4 * c4);
#pragma unroll 4
    for (int it = 0; it < 32; ++it) { const int i = 2 * it + rsub; const size_t m = (size_t)(row0 + i);
        f32x4 v; { const uint2 xp = *(const uint2*)(xsrc + m * D + 4 * c4); v[0] = __builtin_bit_cast(float, xp.x << 16); v[1] = __builtin_bit_cast(float, xp.x & 0xffff0000u); v[2] = __builtin_bit_cast(float, xp.y << 16); v[3] = __builtin_bit_cast(float, xp.y & 0xffff0000u); }
        const v4u sl = *(const LAS v4u*)(lds + LR_SLT + 16 * i); const f32x4 tw = *(const LAS f32x4*)(lds + LR_TWL + 16 * i);
        f32x4 acc;
        if (Y8) { const unsigned char* Yb = (const unsigned char*)Y; typedef float f32x2v __attribute__((ext_vector_type(2)));
            const int q0 = *(const int*)(Yb + (size_t)sl.x * D + 4 * c4), q1 = *(const int*)(Yb + (size_t)sl.y * D + 4 * c4), q2 = *(const int*)(Yb + (size_t)sl.z * D + 4 * c4), q3 = *(const int*)(Yb + (size_t)sl.w * D + 4 * c4);
            const f32x2v a0 = __builtin_amdgcn_cvt_pk_f32_fp8(q0, false), b0 = __builtin_amdgcn_cvt_pk_f32_fp8(q0, true), a1 = __builtin_amdgcn_cvt_pk_f32_fp8(q1, false), b1 = __builtin_amdgcn_cvt_pk_f32_fp8(q1, true);
            const f32x2v a2 = __builtin_amdgcn_cvt_pk_f32_fp8(q2, false), b2 = __builtin_amdgcn_cvt_pk_f32_fp8(q2, true), a3 = __builtin_amdgcn_cvt_pk_f32_fp8(q3, false), b3 = __builtin_amdgcn_cvt_pk_f32_fp8(q3, true);
            const f32x4 tws = tw * (1.0f / S8_Y);
            acc[0] = tws[0] * a0[0] + tws[1] * a1[0] + tws[2] * a2[0] + tws[3] * a3[0]; acc[1] = tws[0] * a0[1] + tws[1] * a1[1] + tws[2] * a2[1] + tws[3] * a3[1];
            acc[2] = tws[0] * b0[0] + tws[1] * b1[0] + tws[2] * b2[0] + tws[3] * b3[0]; acc[3] = tws[0] * b0[1] + tws[1] * b1[1] + tws[2] * b2[1] + tws[3] * b3[1]; }
        else {
        const uint2 p0 = *(const uint2*)(Y + (size_t)sl.x * D + 4 * c4), p1 = *(const uint2*)(Y + (size_t)sl.y * D + 4 * c4), p2 = *(const uint2*)(Y + (size_t)sl.z * D + 4 * c4), p3 = *(const uint2*)(Y + (size_t)sl.w * D + 4 * c4);
        acc[0] = tw[0] * __builtin_bit_cast(float, p0.x << 16) + tw[1] * __builtin_bit_cast(float, p1.x << 16) + tw[2] * __builtin_bit_cast(float, p2.x << 16) + tw[3] * __builtin_bit_cast(float, p3.x << 16);
        acc[1] = tw[0] * __builtin_bit_cast(float, p0.x & 0xffff0000u) + tw[1] * __builtin_bit_cast(float, p1.x & 0xffff0000u) + tw[2] * __builtin_bit_cast(float, p2.x & 0xffff0000u) + tw[3] * __builtin_bit_cast(float, p3.x & 0xffff0000u);
        acc[2] = tw[0] * __builtin_bit_cast(float, p0.y << 16) + tw[1] * __builtin_bit_cast(float, p1.y << 16) + tw[2] * __builtin_bit_cast(float, p2.y << 16) + tw[3] * __builtin_bit_cast(float, p3.y << 16);
        acc[3] = tw[0] * __builtin_bit_cast(float, p0.y & 0xffff0000u) + tw[1] * __builtin_bit_cast(float, p1.y & 0xffff0000u) + tw[2] * __builtin_bit_cast(float, p2.y & 0xffff0000u) + tw[3] * __builtin_bit_cast(float, p3.y & 0xffff0000u); }
        v = v + g * acc;
        if (OUTF32) *(f32x4*)((float*)xdst + m * D + 4 * c4) = v;
        else { uint2 xo; xo.x = pk2(v[0], v[1]); xo.y = pk2(v[2], v[3]); *(uint2*)((bf16*)xdst + m * D + 4 * c4) = xo; }
        if (SS) { const float sq = wave_sum((v[0] * v[0] + v[1] * v[1]) + (v[2] * v[2] + v[3] * v[3])); if (lane == 0) __hip_atomic_fetch_add((LAS float*)(lds + LR_SSR) + i, sq, __ATOMIC_RELAXED, __HIP_MEMORY_SCOPE_WORKGROUP); } }
}
template <bool F8>
__device__ __forceinline__ void flat_modulate(const bf16* xin, int row0, const LAS float* rstds, const float* nw, const float* scp, const float* shp, bf16* H, int tid) {
    const int c4 = tid & 255, rsub = tid >> 8; const f32x4 w = *(const f32x4*)(nw + 4 * c4), s1 = *(const f32x4*)(scp + 4 * c4), s0 = *(const f32x4*)(shp + 4 * c4); const f32x4 ws1 = w * (s1 + 1.0f);
#pragma unroll 8
    for (int it = 0; it < 32; ++it) { const int i = 2 * it + rsub; const size_t m = (size_t)(row0 + i); const uint2 xp = *(const uint2*)(xin + m * D + 4 * c4);
        const f32x4 v = (f32x4){__builtin_bit_cast(float, xp.x << 16), __builtin_bit_cast(float, xp.x & 0xffff0000u), __builtin_bit_cast(float, xp.y << 16), __builtin_bit_cast(float, xp.y & 0xffff0000u)} * rstds[i] * ws1 + s0;
        if (F8) *(int*)((unsigned char*)H + m * D + 4 * c4) = pk4_fp8(v[0] * S8_H, v[1] * S8_H, v[2] * S8_H, v[3] * S8_H);
        else { uint2 p; p.x = pk2(v[0], v[1]); p.y = pk2(v[2], v[3]); *(uint2*)(H + m * D + 4 * c4) = p; } }
}

constexpr int WP = 1032;
constexpr int LR_WHI = 0, LR_PART = 132096, LR_SSX = 140288, LR_RSTD = 140544, LR_BIAS = 140800, LR_RED = 140928;
template <int NEO>
__device__ __forceinline__ void rows_mfma(const Args& a, int layer, LAS unsigned char* lds, volatile LAS unsigned* MISC, gu32* ctl, int vcu, int G, int tid, int lane, int wave) {
    constexpr bool P5 = (NEO == 32); constexpr int NET = NEO / 16;
    unsigned char* ws = a.ws; bf16* X = (bf16*)(ws + WS_X); bf16* H = (bf16*)(ws + WS_H); const float* MOD = (const float*)(ws + WS_MOD);
    LAS bf16* Whi = (LAS bf16*)(lds + LR_WHI); LAS bf16* Wlo = Whi + NEO * WP; LAS float* part = (LAS float*)(lds + LR_PART); LAS float* ssx = (LAS float*)(lds + LR_SSX);
    LAS float* rstds = (LAS float*)(lds + LR_RSTD); LAS float* biasl = (LAS float*)(lds + LR_BIAS); LAS float* red = (LAS float*)(lds + LR_RED);
    const float* nw = (P5 ? a.norm2_w : a.norm1_w) + layer * D;
    const float* Wsrc = P5 ? a.w_r + (size_t)layer * D * NE : a.w_in + (size_t)layer * D * DIN + SRC_GA; const int wld = P5 ? NE : DIN;
    if (P5) { if (tid < NE) MISC[MW_HIST + tid] = 0u; }
    for (int row0 = vcu * 64; row0 < MTOK; row0 += G * 64) {
        const int b = row0 / SEQ; const float* mp = MOD + ((size_t)layer * 2 + b) * 6144; const float* scp = mp + (P5 ? 4 : 1) * D; const float* shp = mp + (P5 ? 3 : 0) * D;
        if (!P5 && layer > 0) { stage_slots(ws, row0, lds, tid); __syncthreads(); }
        { const int e = tid % NEO, kq = tid / NEO; constexpr int NPT = NTHR / NEO;
#pragma unroll 1
            for (int it0 = 0; it0 < D / NPT; it0 += 8) { float wv[8];
#pragma unroll
                for (int u = 0; u < 8; ++u) { const int k = kq + NPT * (it0 + u); wv[u] = Wsrc[(size_t)k * wld + e] * (nw[k] * (1.0f + scp[k])); }
#pragma unroll
                for (int u = 0; u < 8; ++u) { const int k = kq + NPT * (it0 + u); const unsigned hi = f2bf(wv[u]); const float wl = wv[u] - __builtin_bit_cast(float, hi << 16); Whi[e * WP + k] = (bf16)hi; Wlo[e * WP + k] = (bf16)f2bf(wl); } }
            constexpr int KP = D / NPT; float sacc = 0.f;
#pragma unroll 8
            for (int k = kq * KP; k < kq * KP + KP; ++k) sacc += shp[k] * Wsrc[(size_t)k * wld + e];
            red[kq * NEO + e] = sacc; }
        const bf16* xin = X;
        if (!P5 && layer > 0) { flat_combine<false, false>(X, X, row0, (const bf16*)(ws + WS_Y), MOD + ((size_t)(layer - 1) * 2 + b) * 6144 + 5 * D, lds, tid, lane); asm volatile("s_waitcnt vmcnt(0)" ::: "memory"); }
        __syncthreads();
        if (tid < NEO) { constexpr int NPT = NTHR / NEO; float sacc = P5 ? a.b_r[layer * NE + tid] : 0.f; for (int q = 0; q < NPT; ++q) sacc += red[q * NEO + tid]; biasl[tid] = sacc; }
        const int rg = wave >> 1, kh = wave & 1, r = lane & 15, g = lane >> 4;
        { const bf16* xr = xin + (size_t)(row0 + 16 * rg + r) * D; f32x4 acc[NET]; float ss = 0.f;
#pragma unroll
            for (int et = 0; et < NET; ++et) acc[et] = (f32x4){0.f, 0.f, 0.f, 0.f};
#pragma unroll 4
            for (int s = 16 * kh; s < 16 * kh + 16; ++s) { const int k0 = 32 * s + 8 * g; const v4u xp = *(const v4u*)(xr + k0); const unsigned xw[4] = {xp.x, xp.y, xp.z, xp.w};
#pragma unroll
                for (int j = 0; j < 4; ++j) { const float xa = __builtin_bit_cast(float, xw[j] << 16), xb = __builtin_bit_cast(float, xw[j] & 0xffff0000u); ss += xa * xa + xb * xb; }
                const pg8::bf16x8 ahi = __builtin_bit_cast(pg8::bf16x8, xp);
#pragma unroll
                for (int et = 0; et < NET; ++et) { const pg8::bf16x8 whi = ldfrag(Whi, WP, 16 * et, 32 * s, lane), wlo = ldfrag(Wlo, WP, 16 * et, 32 * s, lane);
                    acc[et] = __builtin_amdgcn_mfma_f32_16x16x32_bf16(ahi, whi, acc[et], 0, 0, 0); acc[et] = __builtin_amdgcn_mfma_f32_16x16x32_bf16(ahi, wlo, acc[et], 0, 0, 0); } }
            ss += __shfl_xor(ss, 16); ss += __shfl_xor(ss, 32);
            if (kh == 1) {
#pragma unroll
                for (int et = 0; et < NET; ++et)
#pragma unroll
                    for (int q = 0; q < 4; ++q) part[(rg * 16 + 4 * g + q) * 32 + 16 * et + r] = acc[et][q];
                if (g == 0) ssx[rg * 16 + r] = ss; }
            __syncthreads();
            if (kh == 0) { const float sst = ss + ssx[rg * 16 + r]; if (g == 0) rstds[rg * 16 + r] = 1.0f / sqrtf(sst * (1.0f / D) + EPS);
                asm volatile("s_waitcnt lgkmcnt(0)" ::: "memory");
#pragma unroll
                for (int et = 0; et < NET; ++et)
#pragma unroll
                    for (int q = 0; q < 4; ++q) { const int i = rg * 16 + 4 * g + q, e = 16 * et + r; const float v = rstds[i] * (acc[et][q] + part[i * 32 + e]) + biasl[e];
                        if (P5) part[i * 32 + e] = v; else ((float*)(ws + WS_GA))[(size_t)(row0 + i) * 16 + e] = v; }
                if (P5) { asm volatile("s_waitcnt lgkmcnt(0)" ::: "memory");
                    if (lane < 16) { const int i = rg * 16 + lane, m = row0 + i; float lv[NE];
#pragma unroll
                        for (int e = 0; e < NE; ++e) lv[e] = part[i * 32 + e];
                        float tv[4]; int te[4];
#pragma unroll
                        for (int t = 0; t < 4; ++t) { float best = -3.0e38f; int bi = 0;
#pragma unroll
                            for (int e = 0; e < NE; ++e) if (lv[e] > best) { best = lv[e]; bi = e; }
#pragma unroll
                            for (int e = 0; e < NE; ++e) if (e == bi) lv[e] = -3.0e38f;
                            tv[t] = best; te[t] = bi; }
                        const float e1 = expf(tv[1] - tv[0]), e2 = expf(tv[2] - tv[0]), e3 = expf(tv[3] - tv[0]); const float inv = 1.0f / (1.0f + e1 + e2 + e3);
                        *(f32x4*)((float*)(ws + WS_TOPW) + (size_t)m * 4) = (f32x4){inv, e1 * inv, e2 * inv, e3 * inv};
#pragma unroll
                        for (int t = 0; t < 4; ++t) { const unsigned rk = __hip_atomic_fetch_add((LAS unsigned*)&MISC[MW_HIST + te[t]], 1u, __ATOMIC_RELAXED, __HIP_MEMORY_SCOPE_WORKGROUP);
                            ((LAS unsigned*)(lds + LR_SLT))[i * 4 + t] = ((unsigned)te[t] << 16) | rk; } } } }
            __syncthreads(); }
        if (P5) { if (tid < NE) { const unsigned hcnt = MISC[MW_HIST + tid]; MISC[MW_BASE + tid] = hcnt ? atomicAdd((unsigned*)(ctl + CW_CNT + layer * NE + tid), hcnt) : 0u; }
            __syncthreads();
            if (tid < 256) { LAS unsigned* sl = (LAS unsigned*)(lds + LR_SLT) + tid; const unsigned v = *sl, e = v >> 16; const unsigned slot = (e << ECAP_SH) + MISC[MW_BASE + e] + (v & 0xffffu);
                *sl = slot; ((int*)(ws + WS_SLOT))[(size_t)row0 * 4 + tid] = (int)slot; }
            if (tid < NE) MISC[MW_HIST + tid] = 0u;
            __syncthreads(); }
        if (P5) { const int c4 = tid & 255, rsub = tid >> 8; const f32x4 w = *(const f32x4*)(nw + 4 * c4), s1 = *(const f32x4*)(scp + 4 * c4), s0 = *(const f32x4*)(shp + 4 * c4); const f32x4 ws1 = w * (s1 + 1.0f);
            unsigned char* A1 = ws + WS_A1;
#pragma unroll 8
            for (int it = 0; it < 32; ++it) { const int i = 2 * it + rsub; const uint2 xp = *(const uint2*)(xin + (size_t)(row0 + i) * D + 4 * c4);
                const f32x4 v = (f32x4){__builtin_bit_cast(float, xp.x << 16), __builtin_bit_cast(float, xp.x & 0xffff0000u), __builtin_bit_cast(float, xp.y << 16), __builtin_bit_cast(float, xp.y & 0xffff0000u)} * rstds[i] * ws1 + s0;
                const int pw = pk4_fp8(v[0] * S8_H, v[1] * S8_H, v[2] * S8_H, v[3] * S8_H); const v4u sl = *(const LAS v4u*)(lds + LR_SLT + 16 * i);
                *(int*)(A1 + (size_t)sl.x * D + 4 * c4) = pw; *(int*)(A1 + (size_t)sl.y * D + 4 * c4) = pw; *(int*)(A1 + (size_t)sl.z * D + 4 * c4) = pw; *(int*)(A1 + (size_t)sl.w * D + 4 * c4) = pw; } }
        else flat_modulate<F8_IN>(xin, row0, rstds, nw, scp, shp, H, tid);
        __syncthreads();
    }
}

__device__ __forceinline__ void final_rows(const Args& a, LAS unsigned char* lds, int vcu, int G, int tid, int lane) {
    unsigned char* ws = a.ws; const bf16* X = (const bf16*)(ws + WS_X); const float* MOD = (const float*)(ws + WS_MOD); LAS float* ssr = (LAS float*)(lds + LR_SSR);
    for (int row0 = vcu * 64; row0 < MTOK; row0 += G * 64) { const int b = row0 / SEQ;
        stage_slots(ws, row0, lds, tid); if (tid < 64) ssr[tid] = 0.f;
        __syncthreads();
        flat_combine<true, true>(X, a.out, row0, (const bf16*)(ws + WS_Y), MOD + ((size_t)(DEPTH - 1) * 2 + b) * 6144 + 5 * D, lds, tid, lane);
        asm volatile("s_waitcnt vmcnt(0)" ::: "memory");
        __syncthreads();
        { const int c4 = tid & 255, rsub = tid >> 8; const f32x4 w = *(const f32x4*)(a.final_norm_w + 4 * c4);
#pragma unroll 8
            for (int it = 0; it < 32; ++it) { const int i = 2 * it + rsub; float* op = a.out + (size_t)(row0 + i) * D + 4 * c4; const float rstd = 1.0f / sqrtf(ssr[i] * (1.0f / D) + EPS); *(f32x4*)op = *(const f32x4*)op * rstd * w; } }
        __syncthreads();
    }
}

__device__ __noinline__ void moe_tables(gu32* ctl, int layer, volatile LAS unsigned* MISC, int tid) {
    if (tid < NE) MISC[MW_CNT + tid] = __hip_atomic_load(ctl + CW_CNT + layer * NE + tid, RLX_AGENT);
    __syncthreads();
    if (tid == 0) { unsigned n = 0;
        for (int e = 0; e < NE; ++e) { const unsigned nt = (MISC[MW_CNT + e] + 255u) >> 8; for (unsigned t = 0; t < nt; ++t) MISC[MW_TILE + n + t] = (unsigned)(e * 64) + t; n += nt; }
        MISC[MW_NRT] = n; }
    __syncthreads();
}

constexpr int BP = 72;
template <int TYPE> struct MixCfg { static constexpr int DK = (TYPE == 1) ? 64 : 48, DV = (TYPE == 1) ? 64 : 96, NC = 4 * DK, NV = 4 * DV;
    static constexpr int STOFF = (TYPE == 0) ? ST_GLA : (TYPE == 1) ? ST_HG : ST_RET, COFF = (TYPE == 0) ? 0 : 192;
    static constexpr int CQ = (TYPE == 0) ? C_GQ : (TYPE == 1) ? C_HQ : C_RQ, CK = (TYPE == 0) ? C_GK : (TYPE == 1) ? C_HF : C_RK, CV = (TYPE == 0) ? C_GV : (TYPE == 1) ? C_HI : C_RV, CG = (TYPE == 0) ? C_GG : (TYPE == 1) ? C_HG : C_RG;
    static constexpr int MIXOFF = (TYPE == 0) ? 0 : (TYPE == 1) ? 384 : 640; };
__device__ __forceinline__ float fast_logsig(float x) { x = fmaxf(x, -80.f); return -__logf(1.0f + __expf(-x)); }
__device__ __forceinline__ float ret_lg(int h) { return logf(1.0f - exp2f(-5.0f - (float)h)); }

template <int NV>
__device__ __forceinline__ void stage_vt(const bf16* pv  , LAS bf16* VT, int tid) {
#pragma unroll 2
    for (int idx = tid; idx < 64 * (NV / 8); idx += NTHR) { const int j = idx & 63, ch = idx >> 6; const v4u p = *(const v4u*)(pv + (size_t)j * NPROJ + 8 * ch); LAS bf16* d = VT + (8 * ch) * BP + j;
        d[0 * BP] = (bf16)(p.x & 0xffffu); d[1 * BP] = (bf16)(p.x >> 16); d[2 * BP] = (bf16)(p.y & 0xffffu); d[3 * BP] = (bf16)(p.y >> 16);
        d[4 * BP] = (bf16)(p.z & 0xffffu); d[5 * BP] = (bf16)(p.z >> 16); d[6 * BP] = (bf16)(p.w & 0xffffu); d[7 * BP] = (bf16)(p.w >> 16); }
}

constexpr int LA_KT = 0, LA_VT = 36864, LA_TOT = 92160, LA_GA = 94208;
template <int TYPE>
__device__ __forceinline__ void mixa_batch(const Args& a, int layer, int unit, LAS unsigned char* lds, int tid, int lane, int wave) {
    typedef MixCfg<TYPE> C; constexpr int DK = C::DK, DV = C::DV, NC = C::NC, NV = C::NV;
    unsigned char* ws = a.ws; const bf16* PROJ = (const bf16*)(ws + WS_PROJ); float* CUM = (float*)(ws + WS_CUM); float* DVEC = (float*)(ws + WS_DVEC) + (size_t)unit * NDV;
    float* U = (float*)(ws + WS_U) + (size_t)unit * ST_TOT + C::STOFF;
    LAS bf16* KT = (LAS bf16*)(lds + LA_KT); LAS bf16* VT = (LAS bf16*)(lds + LA_VT); LAS float* TOT = (LAS float*)(lds + LA_TOT); const LAS float* GAs = (const LAS float*)(lds + LA_GA);
    const int row0 = unit * CH;
    const bool act = tid < 2 * NC; const int c = act ? tid % NC : 0, half = act ? tid / NC : 0, h = c / DK, d = c - h * DK;
    float cum[32]; float tot = 0.f;
    float w2[16], b2 = 0.f, lbv = 0.f, lg = 0.f, sg = 0.f; int f = 0, d2 = 0;
    if (act) {
        if constexpr (TYPE == 0) { b2 = a.gla_ba2[layer * 192 + c];
#pragma unroll
            for (int r = 0; r < 16; ++r) w2[r] = a.gla_wa2[(layer * 16 + r) * 192 + c]; }
        if constexpr (TYPE == 1) lbv = ((const float*)(ws + WS_LB))[layer * 256 + c];
        if constexpr (TYPE == 2) { lg = ret_lg(h); f = (d < 24) ? d : d - 24; d2 = (d < 24) ? d + 24 : d - 24; sg = (d < 24) ? -1.f : 1.f; }
        bf16 hraw[32];
        if constexpr (TYPE == 1) {
#pragma unroll
            for (int i = 0; i < 32; ++i) hraw[i] = PROJ[(size_t)(row0 + 32 * half + i) * NPROJ + C_HF + c]; }
#pragma unroll
        for (int i = 0; i < 32; ++i) { const int t = 32 * half + i; float g;
            if constexpr (TYPE == 0) { float pre = b2;
#pragma unroll
                for (int r = 0; r < 16; ++r) pre += GAs[t * 16 + r] * w2[r];
                g = fast_logsig(pre) * (1.0f / 16.0f); }
            else if constexpr (TYPE == 1) { const float hf = fminf(fmaxf(bf2f(hraw[i]), -80.f), 80.f); const float sgm = 1.0f / (1.0f + __expf(-hf));
                g = __logf(lbv + (1.0f - lbv) * sgm); }
            else g = lg;
            tot += g; cum[i] = tot;
            if ((i & 7) == 7) asm volatile("" ::: "memory"); }
        TOT[c * 2 + half] = tot;
    }
    stage_vt<NV>(PROJ + (size_t)row0 * NPROJ + C::CV, VT, tid);
    __syncthreads();
    if (act) { const float t0 = TOT[c * 2], t1 = TOT[c * 2 + 1]; const float off = half ? t0 : 0.f, last = t0 + t1;
#pragma unroll
        for (int hq = 0; hq < 2; ++hq) {
            bf16 ka[16], kb[16]; float cs[16], sn[16];
            if constexpr (TYPE != 1) {
#pragma unroll
                for (int i = 0; i < 16; ++i) { const size_t row = (size_t)(row0 + 32 * half + 16 * hq + i); const bf16* pr = PROJ + row * NPROJ;
                    if constexpr (TYPE == 0) ka[i] = pr[C_GK + c];
                    else { const float* rp = (const float*)(ws + WS_ROPE) + row * 48; ka[i] = pr[C_RK + h * 48 + d]; kb[i] = pr[C_RK + h * 48 + d2]; cs[i] = rp[f]; sn[i] = rp[24 + f]; } } }
#pragma unroll
            for (int q2 = 0; q2 < 2; ++q2) { float kt[8];
#pragma unroll
                for (int j = 0; j < 8; ++j) { const int ii = 8 * q2 + j, i = 16 * hq + ii; const float cm = cum[i] + off; const size_t row = (size_t)(row0 + 32 * half + i); float k;
                    if constexpr (TYPE == 0) k = bf2f(ka[ii]);
                    else if constexpr (TYPE == 1) k = 1.0f - __expf(cum[i] - (i > 0 ? cum[i - 1] : 0.f));
                    else k = bf2f(ka[ii]) * cs[ii] + sg * bf2f(kb[ii]) * sn[ii];
                    if constexpr (TYPE != 2) CUM[row * NDV + C::COFF + c] = cm;
                    kt[j] = k * __expf(last - cm); }
                v4u w; w.x = pk2(kt[0], kt[1]); w.y = pk2(kt[2], kt[3]); w.z = pk2(kt[4], kt[5]); w.w = pk2(kt[6], kt[7]);
                *(LAS v4u*)(KT + c * BP + 32 * half + 16 * hq + 8 * q2) = w; } }
        if (TYPE != 2 && half == 0) DVEC[C::COFF + c] = __expf(last);
    }
    __syncthreads();
    constexpr int TD = DK / 16, NT = (DV / 16) * TD;
    for (int ti = wave; ti < 4 * NT; ti += NWAVES) { const int hh = ti / NT, tr = ti - hh * NT, te = tr / TD, td = tr - te * TD; f32x4 acc = {0.f, 0.f, 0.f, 0.f};
#pragma unroll
        for (int kk = 0; kk < 2; ++kk) acc = __builtin_amdgcn_mfma_f32_16x16x32_bf16(ldfrag(VT, BP, hh * DV + te * 16, kk * 32, lane), ldfrag(KT, BP, hh * DK + td * 16, kk * 32, lane), acc, 0, 0, 0);
        float* Uh = U + hh * DK * DV;
#pragma unroll
        for (int r = 0; r < 4; ++r) Uh[(te * 16 + (lane >> 4) * 4 + r) * DK + td * 16 + (lane & 15)] = acc[r]; }
    __syncthreads();
}
__device__ __forceinline__ void p3a_summaries(const Args& a, int layer, LAS unsigned char* lds, int vcu, int G, int tid, int lane, int wave) {
    for (int unit = vcu; unit < NUNIT; unit += G) {
        { LAS float* GAs = (LAS float*)(lds + LA_GA); const float* GA = (const float*)(a.ws + WS_GA); for (int i = tid; i < CH * 16; i += NTHR) GAs[i] = GA[(size_t)unit * CH * 16 + i]; }
        __syncthreads();
        mixa_batch<0>(a, layer, unit, lds, tid, lane, wave);
        mixa_batch<1>(a, layer, unit, lds, tid, lane, wave);
        mixa_batch<2>(a, layer, unit, lds, tid, lane, wave);
    }
}

__device__ __forceinline__ void p3b_scan(const Args& a, int vcu, int G, int tid) {
    unsigned char* ws = a.ws; const float* U = (const float*)(ws + WS_U); const float* DVEC = (const float*)(ws + WS_DVEC); bf16* SP = (bf16*)(ws + WS_SP);
    for (int gid = vcu * NTHR + tid; gid < BATCH * ST_TOT; gid += G * NTHR) {
        const int b = gid / ST_TOT, el = gid - b * ST_TOT;
        int di = -1; float cdec = 0.f;
        if (el < ST_HG) { const int h = el / 4608, d = (el - h * 4608) % 48; di = h * 48 + d; }
        else if (el < ST_RET) { const int r = el - ST_HG, h = r / 4096, d = r % 64; di = 192 + h * 64 + d; }
        else { const int h = (el - ST_RET) / 4608; cdec = expf(64.0f * logf(1.0f - exp2f(-5.0f - (float)h))); }
        const float* up = U + (size_t)b * NCH * ST_TOT + el; const float* dp = DVEC + (size_t)b * NCH * NDV + (di < 0 ? 0 : di); bf16* sp = SP + (size_t)b * NCH * ST_TOT + el;
        float s = 0.f;
        for (int n0 = 0; n0 < NCH; n0 += 8) { float u[8], dc[8];
#pragma unroll
            for (int i = 0; i < 8; ++i) { u[i] = up[(size_t)(n0 + i) * ST_TOT]; dc[i] = (di < 0) ? cdec : dp[(size_t)(n0 + i) * NDV]; }
#pragma unroll
            for (int i = 0; i < 8; ++i) { sp[(size_t)(n0 + i) * ST_TOT] = (bf16)f2bf(s); s = dc[i] * s + u[i]; } }
    }
}

constexpr int LC_VT = 0, LC_ST = 55296, LC_AB = 110592, OBP = 104;
template <int TYPE, bool ISQ>
__device__ __forceinline__ void mix_frag(const Args& a, int h, size_t row, int t, int d0, float (&x)[8], float (&cm)[8]) {
    typedef MixCfg<TYPE> C; constexpr int DK = C::DK;
    unsigned char* ws = a.ws; const bf16* pr = (const bf16*)(ws + WS_PROJ) + row * NPROJ;
    if constexpr (TYPE == 0) {
        const v4u p = *(const v4u*)(pr + (ISQ ? C_GQ : C_GK) + h * DK + d0); const unsigned pw[4] = {p.x, p.y, p.z, p.w};
        const float* cp = (const float*)(ws + WS_CUM) + row * NDV + h * DK + d0; const f32x4 c0 = *(const f32x4*)cp, c1 = *(const f32x4*)(cp + 4);
#pragma unroll
        for (int j = 0; j < 4; ++j) { x[2 * j] = __builtin_bit_cast(float, pw[j] << 16); x[2 * j + 1] = __builtin_bit_cast(float, pw[j] & 0xffff0000u); cm[j] = c0[j]; cm[4 + j] = c1[j]; }
        if (ISQ) {
#pragma unroll
            for (int j = 0; j < 8; ++j) x[j] *= 0.14433756729740643f; }
    } else if constexpr (TYPE == 1) {
        const float* cp = (const float*)(ws + WS_CUM) + row * NDV + 192 + h * DK + d0; const f32x4 c0 = *(const f32x4*)cp, c1 = *(const f32x4*)(cp + 4);
#pragma unroll
        for (int j = 0; j < 4; ++j) { cm[j] = c0[j]; cm[4 + j] = c1[j]; }
        if (ISQ) { const v4u p = *(const v4u*)(pr + C_HQ + h * DK + d0); const unsigned pw[4] = {p.x, p.y, p.z, p.w};
#pragma unroll
            for (int j = 0; j < 4; ++j) { x[2 * j] = __builtin_bit_cast(float, pw[j] << 16); x[2 * j + 1] = __builtin_bit_cast(float, pw[j] & 0xffff0000u); } }
        else { f32x4 p0 = {0.f, 0.f, 0.f, 0.f}, p1 = {0.f, 0.f, 0.f, 0.f}; if (t > 0) { p0 = *(const f32x4*)(cp - NDV); p1 = *(const f32x4*)(cp - NDV + 4); }
#pragma unroll
            for (int j = 0; j < 4; ++j) { x[j] = 1.0f - __expf(c0[j] - p0[j]); x[4 + j] = 1.0f - __expf(c1[j] - p1[j]); } }
    } else {
        const int f0 = (d0 < 24) ? d0 : d0 - 24, dp = (d0 < 24) ? d0 + 24 : d0 - 24; const float sg = (d0 < 24) ? -1.f : 1.f;
        const int cb = (ISQ ? C_RQ : C_RK) + h * DK; const v4u p = *(const v4u*)(pr + cb + d0), pp = *(const v4u*)(pr + cb + dp); const unsigned pw[4] = {p.x, p.y, p.z, p.w}, qw[4] = {pp.x, pp.y, pp.z, pp.w};
        const float* rp = (const float*)(ws + WS_ROPE) + row * 48; const f32x4 cs0 = *(const f32x4*)(rp + f0), cs1 = *(const f32x4*)(rp + f0 + 4), sn0 = *(const f32x4*)(rp + 24 + f0), sn1 = *(const f32x4*)(rp + 24 + f0 + 4);
        const float cmv = (float)(t + 1) * ret_lg(h);
#pragma unroll
        for (int j = 0; j < 4; ++j) { const float xa = __builtin_bit_cast(float, pw[j] << 16), xb = __builtin_bit_cast(float, pw[j] & 0xffff0000u), ya = __builtin_bit_cast(float, qw[j] << 16), yb = __builtin_bit_cast(float, qw[j] & 0xffff0000u);
            const float ca = (j < 2) ? cs0[2 * j] : cs1[2 * j - 4], cb2 = (j < 2) ? cs0[2 * j + 1] : cs1[2 * j - 3], sa = (j < 2) ? sn0[2 * j] : sn1[2 * j - 4], sb = (j < 2) ? sn0[2 * j + 1] : sn1[2 * j - 3];
            x[2 * j] = xa * ca + sg * ya * sa; x[2 * j + 1] = xb * cb2 + sg * yb * sb; cm[2 * j] = cmv; cm[2 * j + 1] = cmv; }
        if (ISQ) {
#pragma unroll
            for (int j = 0; j < 8; ++j) x[j] *= 0.14433756729740643f; }
    }
}

template <int TYPE>
__device__ __forceinline__ void mixc_batch(const Args& a, int layer, int unit, LAS unsigned char* lds, int tid, int lane, int wave) {
    typedef MixCfg<TYPE> C; constexpr int DK = C::DK, DV = C::DV, NV = C::NV, TE = DV / 16;
    unsigned char* ws = a.ws; const bf16* PROJ = (const bf16*)(ws + WS_PROJ); bf16* MIX = (bf16*)(ws + WS_MIX);
    LAS bf16* VT = (LAS bf16*)(lds + LC_VT); LAS bf16* ST = (LAS bf16*)(lds + LC_ST); LAS bf16* AB = (LAS bf16*)(lds + LC_AB) + wave * 16 * OBP;
    const int row0 = unit * CH;
    stage_vt<NV>(PROJ + (size_t)row0 * NPROJ + C::CV, VT, tid);
    { const bf16* SPu = (const bf16*)(ws + WS_SP) + (size_t)unit * ST_TOT + C::STOFF;
        for (int idx = tid; idx < NV * 8; idx += NTHR) { const int er = idx >> 3, ch = idx & 7; v4u w = {0u, 0u, 0u, 0u}; if (ch * 8 < DK) w = *(const v4u*)(SPu + (size_t)er * DK + ch * 8); *(LAS v4u*)(ST + er * BP + ch * 8) = w; } }
    __syncthreads();
    const int h = wave >> 1, hsel = wave & 1, r = lane & 15, g = lane >> 4;
    const LAS bf16* STh = ST + h * DV * BP; const LAS bf16* VTh = VT + h * DV * BP;
    const float* CUMp = (const float*)(ws + WS_CUM);
    for (int ib = 0; ib < 2; ++ib) { const int I = ib ? 3 - hsel : hsel;
        pg8::bf16x8 qh[2], qt[2]; float refv[2][8];
#pragma unroll
        for (int s = 0; s < 2; ++s) { const int d0 = 32 * s + 8 * g; const bool valid = d0 < DK; const int d0c = valid ? d0 : 0;
            float x[8], cm[8]; mix_frag<TYPE, true>(a, h, (size_t)(row0 + 16 * I + r), 16 * I + r, d0c, x, cm);
            if constexpr (TYPE == 2) {
#pragma unroll
                for (int j = 0; j < 8; ++j) refv[s][j] = (float)(16 * I) * ret_lg(h);
            } else { if (I > 0) { const float* cp = CUMp + (size_t)(row0 + 16 * I - 1) * NDV + C::COFF + h * DK + d0c; const f32x4 c0 = *(const f32x4*)cp, c1 = *(const f32x4*)(cp + 4);
#pragma unroll
                    for (int j = 0; j < 4; ++j) { refv[s][j] = c0[j]; refv[s][4 + j] = c1[j]; } }
                else {
#pragma unroll
                    for (int j = 0; j < 8; ++j) refv[s][j] = 0.f; } }
            float xh[8], xt[8];
#pragma unroll
            for (int j = 0; j < 8; ++j) { xh[j] = valid ? x[j] * __expf(cm[j] - refv[s][j]) : 0.f; xt[j] = valid ? x[j] * __expf(cm[j]) : 0.f; }
            qh[s] = pack8(xh); qt[s] = pack8(xt); }
        for (int J = 0; J <= I; ++J) { f32x4 acc = {0.f, 0.f, 0.f, 0.f};
#pragma unroll
            for (int s = 0; s < 2; ++s) { const int d0 = 32 * s + 8 * g; const bool valid = d0 < DK; const int d0c = valid ? d0 : 0;
                float x[8], cm[8]; mix_frag<TYPE, false>(a, h, (size_t)(row0 + 16 * J + r), 16 * J + r, d0c, x, cm);
                float xk[8];
#pragma unroll
                for (int j = 0; j < 8; ++j) xk[j] = valid ? x[j] * __expf(fminf(refv[s][j] - cm[j], 80.f)) : 0.f;
                acc = __builtin_amdgcn_mfma_f32_16x16x32_bf16(qh[s], pack8(xk), acc, 0, 0, 0); }
#pragma unroll
            for (int q = 0; q < 4; ++q) { const int i = 4 * g + q; const float v = (J < I || r <= i) ? acc[q] : 0.f; AB[i * BP + 16 * J + r] = (bf16)f2bf(v); } }
        if ((I & 1) == 0) {
#pragma unroll
            for (int q = 0; q < 4; ++q) AB[(4 * g + q) * BP + 16 * (I + 1) + r] = (bf16)0; }
        asm volatile("s_waitcnt lgkmcnt(0)" ::: "memory");
        const pg8::bf16x8 ah0 = *(const LAS pg8::bf16x8*)(AB + r * BP + 8 * g), ah1 = *(const LAS pg8::bf16x8*)(AB + r * BP + 32 + 8 * g);
        f32x4 o[TE];
#pragma unroll
        for (int te = 0; te < TE; ++te) { f32x4 acc = {0.f, 0.f, 0.f, 0.f};
            acc = __builtin_amdgcn_mfma_f32_16x16x32_bf16(qt[0], ldfrag(STh, BP, te * 16, 0, lane), acc, 0, 0, 0);
            acc = __builtin_amdgcn_mfma_f32_16x16x32_bf16(qt[1], ldfrag(STh, BP, te * 16, 32, lane), acc, 0, 0, 0);
            acc = __builtin_amdgcn_mfma_f32_16x16x32_bf16(ah0, ldfrag(VTh, BP, te * 16, 0, lane), acc, 0, 0, 0);
            if (I >= 2) acc = __builtin_amdgcn_mfma_f32_16x16x32_bf16(ah1, ldfrag(VTh, BP, te * 16, 32, lane), acc, 0, 0, 0);
            o[te] = acc; }
#pragma unroll
        for (int q = 0; q < 4; ++q) { float s1 = 0.f, s2 = 0.f;
#pragma unroll
            for (int te = 0; te < TE; ++te) { s1 += o[te][q]; s2 += o[te][q] * o[te][q]; }
#pragma unroll
            for (int m = 1; m < 16; m <<= 1) { s1 += __shfl_xor(s1, m); s2 += __shfl_xor(s2, m); }
            float mean = 0.f, rstd;
            if constexpr (TYPE == 2) { mean = s1 * (1.0f / DV); rstd = 1.0f / sqrtf(fmaxf(s2 * (1.0f / DV) - mean * mean, 0.f) + EPS); }
            else rstd = 1.0f / sqrtf(s2 * (1.0f / DV) + EPS);
#pragma unroll
            for (int te = 0; te < TE; ++te) AB[(4 * g + q) * OBP + te * 16 + r] = (bf16)f2bf((o[te][q] - mean) * rstd); }
        asm volatile("s_waitcnt lgkmcnt(0)" ::: "memory");
        constexpr int NCHK = DV / 8;
#pragma unroll
        for (int i = 0; i < (16 * NCHK) / 64; ++i) { const int cidx = lane + 64 * i, orow = cidx / NCHK, ch = cidx - orow * NCHK; const size_t row = (size_t)(row0 + 16 * I + orow);
            const v4u ov = *(const LAS v4u*)(AB + orow * OBP + 8 * ch); const v4u gv = *(const v4u*)(PROJ + row * NPROJ + C::CG + h * DV + 8 * ch);
            const unsigned ow[4] = {ov.x, ov.y, ov.z, ov.w}, gw[4] = {gv.x, gv.y, gv.z, gv.w}; float res[8];
            f32x4 w0 = {1.f, 1.f, 1.f, 1.f}, w1 = {1.f, 1.f, 1.f, 1.f};
            if constexpr (TYPE == 0) { const float* wp = a.gla_norm_w + layer * 384 + h * 96 + 8 * ch; w0 = *(const f32x4*)wp; w1 = *(const f32x4*)(wp + 4); }
            if constexpr (TYPE == 1) { const float* wp = a.hg_norm_w + layer * 256 + h * 64 + 8 * ch; w0 = *(const f32x4*)wp; w1 = *(const f32x4*)(wp + 4); }
#pragma unroll
            for (int j = 0; j < 4; ++j) { const float oa = __builtin_bit_cast(float, ow[j] << 16), ob = __builtin_bit_cast(float, ow[j] & 0xffff0000u), ga = __builtin_bit_cast(float, gw[j] << 16), gb = __builtin_bit_cast(float, gw[j] & 0xffff0000u);
                const float wa = (j < 2) ? w0[2 * j] : w1[2 * j - 4], wb = (j < 2) ? w0[2 * j + 1] : w1[2 * j - 3];
                const float sa = 1.0f / (1.0f + __expf(-ga)), sb = 1.0f / (1.0f + __expf(-gb));
                res[2 * j] = oa * wa * ((TYPE == 1) ? sa : ga * sa); res[2 * j + 1] = ob * wb * ((TYPE == 1) ? sb : gb * sb); }
            if (F8_OUT) { typedef int i32x2 __attribute__((ext_vector_type(2)));
                *(i32x2*)((unsigned char*)MIX + row * D + C::MIXOFF + h * DV + 8 * ch) = (i32x2){pk4_fp8(res[0] * S8_M, res[1] * S8_M, res[2] * S8_M, res[3] * S8_M), pk4_fp8(res[4] * S8_M, res[5] * S8_M, res[6] * S8_M, res[7] * S8_M)}; }
            else { v4u w; w.x = pk2(res[0], res[1]); w.y = pk2(res[2], res[3]); w.z = pk2(res[4], res[5]); w.w = pk2(res[6], res[7]); *(v4u*)(MIX + row * D + C::MIXOFF + h * DV + 8 * ch) = w; } }
    }
    __syncthreads();
}
__device__ __forceinline__ void p3c_outputs(const Args& a, int layer, LAS unsigned char* lds, int vcu, int G, int tid, int lane, int wave) {
    for (int unit = vcu; unit < NUNIT; unit += G) {
        mixc_batch<0>(a, layer, unit, lds, tid, lane, wave);
        mixc_batch<1>(a, layer, unit, lds, tid, lane, wave);
        mixc_batch<2>(a, layer, unit, lds, tid, lane, wave);
    }
}


constexpr int MW_ARGS = 800;
__device__ __forceinline__ const void* ld_argp(const volatile LAS unsigned* T, int i) {
    const unsigned lo = __builtin_amdgcn_readfirstlane(T[2 * i]), hi = __builtin_amdgcn_readfirstlane(T[2 * i + 1]);
    return (const void*)(((unsigned long long)hi << 32) | lo);
}
__device__ __forceinline__ Args load_args(LAS unsigned char* lds) {
    const volatile LAS unsigned* T = (const volatile LAS unsigned*)(lds + MISC_OFF) + MW_ARGS;
    Args a;
    a.x = (const float*)ld_argp(T, 0); a.c = (const float*)ld_argp(T, 1); a.pos = (const int*)ld_argp(T, 2); a.w_mod = (const float*)ld_argp(T, 3); a.b_mod = (const float*)ld_argp(T, 4);
    a.norm1_w = (const float*)ld_argp(T, 5); a.w_in = (const float*)ld_argp(T, 6); a.gla_wa2 = (const float*)ld_argp(T, 7); a.gla_ba2 = (const float*)ld_argp(T, 8); a.hg_lb = (const float*)ld_argp(T, 9);
    a.gla_norm_w = (const float*)ld_argp(T, 10); a.hg_norm_w = (const float*)ld_argp(T, 11); a.w_out = (const float*)ld_argp(T, 12); a.norm2_w = (const float*)ld_argp(T, 13); a.w_r = (const float*)ld_argp(T, 14);
    a.b_r = (const float*)ld_argp(T, 15); a.w_gu = (const float*)ld_argp(T, 16); a.b_gu = (const float*)ld_argp(T, 17); a.w_dn = (const float*)ld_argp(T, 18); a.b_dn = (const float*)ld_argp(T, 19);
    a.final_norm_w = (const float*)ld_argp(T, 20); a.out = (float*)ld_argp(T, 21); a.ws = (unsigned char*)ld_argp(T, 22); a.ph_lo = 0; a.ph_hi = 0;
    return a;
}
#define PH_CTX() { unsigned l_ = (unsigned)(size_t)lds; asm volatile("" : "+s"(l_)); lds = (LAS unsigned char*)(size_t)l_; } const Args args = load_args(lds); volatile LAS unsigned* MISC = (volatile LAS unsigned*)(lds + MISC_OFF); int tid_ = wv * 64 + (int)__builtin_amdgcn_mbcnt_hi(~0u, __builtin_amdgcn_mbcnt_lo(~0u, 0u)); asm volatile("" : "+v"(tid_)); const int tid = tid_, lane = tid & 63, wave = __builtin_amdgcn_readfirstlane(tid >> 6); \
    const int G = gridDim.x; const int bx = blockIdx.x; const int vcu = (G % 8 == 0) ? (bx % 8) * (G / 8) + bx / 8 : bx; unsigned char* ws = args.ws; gu32* ctl = (gu32*)(ws + WS_CTL); \
    (void)MISC; (void)lane; (void)wave; (void)vcu; (void)ctl; (void)bx; (void)tid
__device__ __forceinline__ void ph_p0(LAS unsigned char* lds, int wv) { PH_CTX(); p0_prologue(args, lds, vcu, G, tid, lane, wave); }
__device__ __forceinline__ void ph_p1(LAS unsigned char* lds, int wv, int layer_) { int layer = __builtin_amdgcn_readfirstlane(layer_); asm volatile("" : "+s"(layer)); PH_CTX();
    if (layer > 0) { moe_tables(ctl, layer - 1, MISC, tid); const int nrt = __builtin_amdgcn_readfirstlane((int)MISC[MW_NRT]);
        const int done = conv_t2(G) + conv_idle(nrt * 8, G) * NWAVES * CB7 + conv_idle(nrt * 4, G) * NWAVES * CB8; LAS float* scr = (LAS float*)(lds + wave * 16640);
        for (int it = done + vcu * NWAVES + wave; it < IT_LAYER; it += G * NWAVES) convert_item(args, layer, it, scr, lane);
        __syncthreads(); }
    rows_mfma<16>(args, layer, lds, MISC, ctl, vcu, G, tid, lane, wave); }
__device__ __forceinline__ void ph_p2(LAS unsigned char* lds, int wv, int layer_) { int layer = __builtin_amdgcn_readfirstlane(layer_); asm volatile("" : "+s"(layer)); PH_CTX();
    pg8::Gemm g{(const bf16*)(ws + WS_H), (const bf16*)(ws + WS_WIN + (size_t)layer * NPROJ * D * (F8_IN ? 1 : 2)), MTOK, NPROJ, F8_IN ? D / 2 : D}; pg8::StaticOrder S; S.init(MTOK, NPROJ, G, bx);
    pg8::EpiBf16Plain E{(bf16*)(ws + WS_PROJ), NPROJ, F8_IN ? 1.0f / (S8_H * S8_W) : 1.0f};
    pg8::gemm_phase<pg8::EpiBf16Plain, pg8::StaticOrder, true, true, F8_IN>(lds, g, S, E, tid);
    if (layer + 1 < DEPTH && G == 256 && bx >= 64) convert_range(args, layer + 1, ((bx - 64) * NWAVES + wave) * CB2, CB2, lds, lane, wave); }
__device__ __forceinline__ void ph_p3a(LAS unsigned char* lds, int wv, int layer_) { int layer = __builtin_amdgcn_readfirstlane(layer_); asm volatile("" : "+s"(layer)); PH_CTX(); p3a_summaries(args, layer, lds, vcu, G, tid, lane, wave); }
__device__ __forceinline__ void ph_p3b(LAS unsigned char* lds, int wv) { PH_CTX(); p3b_scan(args, vcu, G, tid); }
__device__ __forceinline__ void ph_p3c(LAS unsigned char* lds, int wv, int layer_) { int layer = __builtin_amdgcn_readfirstlane(layer_); asm volatile("" : "+s"(layer)); PH_CTX(); p3c_outputs(args, layer, lds, vcu, G, tid, lane, wave); }
__device__ __forceinline__ void ph_p4(LAS unsigned char* lds, int wv, int layer_) { int layer = __builtin_amdgcn_readfirstlane(layer_); asm volatile("" : "+s"(layer)); PH_CTX();
    pg8::Gemm g{(const bf16*)(ws + WS_MIX), (const bf16*)(ws + WS_WOUT + (size_t)layer * D * D * (F8_OUT ? 1 : 2)), MTOK, D, F8_OUT ? D / 2 : D}; pg8::StaticOrder S; S.init(MTOK, D, G, bx);
    pg8::EpiResGate E{(const bf16*)(ws + WS_X), (bf16*)(ws + WS_X), D, (const float*)(ws + WS_MOD) + (size_t)layer * 2 * 6144 + 2 * D, 6144, SEQ, F8_OUT ? 1.0f / (S8_M * S8_W) : 1.0f};
    pg8::gemm_phase<pg8::EpiResGate, pg8::StaticOrder, true, true, F8_OUT>(lds, g, S, E, tid); }
__device__ __forceinline__ void ph_p5(LAS unsigned char* lds, int wv, int layer_) { int layer = __builtin_amdgcn_readfirstlane(layer_); asm volatile("" : "+s"(layer)); PH_CTX(); rows_mfma<32>(args, layer, lds, MISC, ctl, vcu, G, tid, lane, wave); }
__device__ __forceinline__ void ph_p7(LAS unsigned char* lds, int wv, int layer_) { int layer = __builtin_amdgcn_readfirstlane(layer_); asm volatile("" : "+s"(layer)); PH_CTX();
    moe_tables(ctl, layer, MISC, tid);
    const int nrt = __builtin_amdgcn_readfirstlane((int)MISC[MW_NRT]);
    pg8::Gemm g{(const bf16*)(ws + WS_A1), (const bf16*)(ws + WS_WGU + (size_t)layer * NE * 2048 * D), nrt * 256, NE * 2048, D / 2};
    pg8::MoeOrder S{8, G, vcu, nrt * 8, (const LAS int*)(lds + MISC_OFF + 4 * MW_TILE)};
    pg8::EpiSwiglu E{ws + WS_ACT, FFN, args.b_gu + (size_t)layer * NE * 2048, 1.0f / (S8_H * S8_W), S8_A};
    pg8::gemm_phase<pg8::EpiSwiglu, pg8::MoeOrder, true, true, true>(lds, g, S, E, tid);
    { const int rem = (nrt * 8) % G; if (layer + 1 < DEPTH && rem != 0 && vcu >= rem) convert_range(args, layer + 1, conv_t2(G) + ((vcu - rem) * NWAVES + wave) * CB7, CB7, lds, lane, wave); } }
__device__ __forceinline__ void ph_p8(LAS unsigned char* lds, int wv, int layer_) { int layer = __builtin_amdgcn_readfirstlane(layer_); asm volatile("" : "+s"(layer)); PH_CTX();
    moe_tables(ctl, layer, MISC, tid);
    const int nrt = __builtin_amdgcn_readfirstlane((int)MISC[MW_NRT]);
    pg8::Gemm g{(const bf16*)(ws + WS_ACT), (const bf16*)(ws + WS_WDN + (size_t)layer * NE * D * FFN), nrt * 256, NE * D, FFN / 2};
    pg8::MoeOrder S{4, G, vcu, nrt * 4, (const LAS int*)(lds + MISC_OFF + 4 * MW_TILE)};
    if constexpr (Y8) { pg8::EpiFp8Bias E{ws + WS_Y, D, args.b_dn + (size_t)layer * NE * D, D, 1.0f / (S8_A * S8_W), S8_Y};
        pg8::gemm_phase<pg8::EpiFp8Bias, pg8::MoeOrder, true, true, true>(lds, g, S, E, tid); }
    else { pg8::EpiBf16Bias E{(bf16*)(ws + WS_Y), D, args.b_dn + (size_t)layer * NE * D, D, 1.0f / (S8_A * S8_W)};
        pg8::gemm_phase<pg8::EpiBf16Bias, pg8::MoeOrder, true, true, true>(lds, g, S, E, tid); }
    { const int rem = (nrt * 4) % G; if (layer + 1 < DEPTH && rem != 0 && vcu >= rem) convert_range(args, layer + 1, conv_t2(G) + conv_idle(nrt * 8, G) * NWAVES * CB7 + ((vcu - rem) * NWAVES + wave) * CB8, CB8, lds, lane, wave); } }
__device__ __forceinline__ void ph_final(LAS unsigned char* lds, int wv) { PH_CTX(); final_rows(args, lds, vcu, G, tid, lane); }

#ifndef DBL_MASK
#define DBL_MASK 0
#endif
#if DBL_MASK
#define RUN(bit, call) do { if ((DBL_MASK >> (bit)) & 1) { const unsigned long long t0_ = __builtin_amdgcn_s_memrealtime(); call; const unsigned long long t1_ = __builtin_amdgcn_s_memrealtime(); \
        while (__builtin_amdgcn_s_memrealtime() - t1_ < t1_ - t0_) __builtin_amdgcn_s_sleep(8); } else { call; } } while (0)
#else
#define RUN(bit, call) do { call; } while (0)
#endif
__global__ void __launch_bounds__(NTHR, 2) hybrid_fwd(Args args) {
    extern __shared__ __attribute__((aligned(16))) unsigned char lds_raw[];
    LAS unsigned char* lds = (LAS unsigned char*)lds_raw;
    volatile LAS unsigned* MISC = (volatile LAS unsigned*)(lds + MISC_OFF);
    const int tid = threadIdx.x; const int wv = __builtin_amdgcn_readfirstlane(tid >> 6);
    gu32* ctl = (gu32*)(args.ws + WS_CTL);
    for (int u = tid; u < (LDS_BYTES - MISC_OFF) / 4; u += NTHR) MISC[u] = 0u;
    __syncthreads();
    if (tid == 0) {
#define ST_ARG(i, p) do { const unsigned long long v_ = (unsigned long long)(p); MISC[MW_ARGS + 2 * (i)] = (unsigned)v_; MISC[MW_ARGS + 2 * (i) + 1] = (unsigned)(v_ >> 32); } while (0)
        ST_ARG(0, args.x); ST_ARG(1, args.c); ST_ARG(2, args.pos); ST_ARG(3, args.w_mod); ST_ARG(4, args.b_mod); ST_ARG(5, args.norm1_w); ST_ARG(6, args.w_in); ST_ARG(7, args.gla_wa2); ST_ARG(8, args.gla_ba2);
        ST_ARG(9, args.hg_lb); ST_ARG(10, args.gla_norm_w); ST_ARG(11, args.hg_norm_w); ST_ARG(12, args.w_out); ST_ARG(13, args.norm2_w); ST_ARG(14, args.w_r); ST_ARG(15, args.b_r); ST_ARG(16, args.w_gu);
        ST_ARG(17, args.b_gu); ST_ARG(18, args.w_dn); ST_ARG(19, args.b_dn); ST_ARG(20, args.final_norm_w); ST_ARG(21, args.out); ST_ARG(22, args.ws);
#undef ST_ARG
    }
    __syncthreads();
    const int lo = args.ph_lo, hi = args.ph_hi;
    const bool multi = (hi - lo) > 1;
    XcdBarrier bar; bar.bar = (unsigned*)(ctl + CW_BAR); bar.x = 0; bar.st = nullptr;
    if (multi) bar = xcd_barrier_post((unsigned*)(ctl + CW_BAR), MISC + MW_BAR);
#define IN(k) (lo <= (k) && (k) < hi)
#define SEAM(k) do { if (IN(k) && IN((k) + 1)) xcd_barrier(bar); } while (0)

    if (IN(0)) RUN(0, ph_p0(lds, wv));
    SEAM(0);
    for (int layer = 0; layer < DEPTH; ++layer) {
        const int pb = 1 + 9 * layer;
        if (IN(pb + 0)) RUN(1, ph_p1(lds, wv, layer));
        SEAM(pb + 0);
        if (IN(pb + 1)) RUN(2, ph_p2(lds, wv, layer));
        SEAM(pb + 1);
        if (IN(pb + 2)) RUN(3, ph_p3a(lds, wv, layer));
        SEAM(pb + 2);
        if (IN(pb + 3)) RUN(4, ph_p3b(lds, wv));
        SEAM(pb + 3);
        if (IN(pb + 4)) RUN(5, ph_p3c(lds, wv, layer));
        SEAM(pb + 4);
        if (IN(pb + 5)) RUN(6, ph_p4(lds, wv, layer));
        SEAM(pb + 5);
        if (IN(pb + 6)) RUN(7, ph_p5(lds, wv, layer));
        SEAM(pb + 6);
        if (IN(pb + 7)) RUN(9, ph_p7(lds, wv, layer));
        SEAM(pb + 7);
        if (IN(pb + 8)) RUN(10, ph_p8(lds, wv, layer));
        SEAM(pb + 8);
    }
    if (IN(NPHASE - 1)) RUN(11, ph_final(lds, wv));
#undef IN
#undef SEAM
}

#ifndef MK_SINGLE
#define MK_SINGLE 1
#endif
extern "C" void kernel_launch(void* const* d_in, const int* in_sizes, int n_in, void* d_out, int out_size, void* d_ws, size_t ws_size, hipStream_t stream) {
    static int grid = 0;
    if (grid == 0) {
        if (n_in != 21 || in_sizes[0] != MTOK * D || out_size != MTOK * D || ws_size < WS_END) { fprintf(stderr, "kernel_launch: unexpected problem shape (n_in %d, in0 %d, out %d, ws %zu)\n", n_in, n_in > 0 ? in_sizes[0] : -1, out_size, ws_size); grid = -1; return; }
        int dev = 0, cus = 0, per_cu = 0;
        if (hipGetDevice(&dev) != hipSuccess || hipDeviceGetAttribute(&cus, hipDeviceAttributeMultiprocessorCount, dev) != hipSuccess) { grid = -1; return; }
        if (hipFuncSetAttribute((const void*)hybrid_fwd, hipFuncAttributeMaxDynamicSharedMemorySize, LDS_BYTES) != hipSuccess) { fprintf(stderr, "kernel_launch: hipFuncSetAttribute failed\n"); grid = -1; return; }
        if (hipOccupancyMaxActiveBlocksPerMultiprocessor(&per_cu, (const void*)hybrid_fwd, NTHR, LDS_BYTES) != hipSuccess || per_cu < 1) fprintf(stderr, "kernel_launch: occupancy query says %d\n", per_cu);
        (void)hipGetLastError();
        grid = cus;
    }
    if (grid < 0) return;
    (void)hipMemsetAsync((char*)d_ws + WS_CTL, 0, CTL_ZERO_BYTES, stream);
    Args a{};
    a.x = (const float*)d_in[0]; a.c = (const float*)d_in[1]; a.pos = (const int*)d_in[2]; a.w_mod = (const float*)d_in[3]; a.b_mod = (const float*)d_in[4]; a.norm1_w = (const float*)d_in[5];
    a.w_in = (const float*)d_in[6]; a.gla_wa2 = (const float*)d_in[7]; a.gla_ba2 = (const float*)d_in[8]; a.hg_lb = (const float*)d_in[9]; a.gla_norm_w = (const float*)d_in[10]; a.hg_norm_w = (const float*)d_in[11];
    a.w_out = (const float*)d_in[12]; a.norm2_w = (const float*)d_in[13]; a.w_r = (const float*)d_in[14]; a.b_r = (const float*)d_in[15]; a.w_gu = (const float*)d_in[16]; a.b_gu = (const float*)d_in[17];
    a.w_dn = (const float*)d_in[18]; a.b_dn = (const float*)d_in[19]; a.final_norm_w = (const float*)d_in[20]; a.out = (float*)d_out; a.ws = (unsigned char*)d_ws;
#if MK_SINGLE
    a.ph_lo = 0; a.ph_hi = NPHASE;
    hipLaunchKernelGGL(hybrid_fwd, dim3(grid), dim3(NTHR), LDS_BYTES, stream, a);
#else
    for (int p = 0; p < NPHASE; ++p) { a.ph_lo = p; a.ph_hi = p + 1; hipLaunchKernelGGL(hybrid_fwd, dim3(grid), dim3(NTHR), LDS_BYTES, stream, a); }
#endif
}
```

```cpp
#include <hip/hip_runtime.h>
#include <cstdio>
#include <cstdint>
namespace pg8 {
#define PG8_LAS __attribute__((address_space(3)))
typedef unsigned short bf16_t;
typedef short bf16x8 __attribute__((ext_vector_type(8)));
typedef float f32x4 __attribute__((ext_vector_type(4)));
typedef unsigned u32x4 __attribute__((ext_vector_type(4)));
constexpr int BM = 256, BK = 64, HALF = 128, HTB = HALF * BK * 2  , STAGE_BYTES = 8 * HTB, NXCD = 8, WGM = 8;

__host__ __device__ __forceinline__ int lds_byte(int r, int c) { const int st = (r >> 4) * 2 + (c >> 5), rr = r & 15, cc = c & 31, ob = rr * 64 + cc * 2; return st * 1024 + (ob ^ (((ob >> 9) & 1) << 5)); }
__host__ __device__ __forceinline__ void stage_rc(int b, int& R, int& C) { const int st = b / 1024, sb = b % 1024, swz = sb ^ (((sb >> 9) & 1) << 5); R = (st >> 1) * 16 + swz / 64; C = (st & 1) * 32 + (swz % 64) / 2; }
__host__ __device__ __forceinline__ int perm32(int rho) { const int n = rho >> 4, i = rho & 15; return 8 * (i >> 2) + 4 * n + (i & 3); }

struct Unit { int pm, pn, e, pl; };
struct Gemm { const bf16_t* A; const bf16_t* Bt; int M, N, K; };

struct StaticOrder {
    int nM, nN, nwg, G, c;
    __host__ __device__ void init(int M, int N, int G_, int c_) { nM = M / BM; nN = N / BM; nwg = nM * nN; G = G_; c = c_; }
    __host__ __device__ bool next(int i, Unit& u) const {
        const long L = (long)i * G + c; if (L >= nwg) return false;
        int wgid = (int)L; { const int q = nwg / NXCD, r = nwg % NXCD, xcd = wgid % NXCD, off = wgid / NXCD; wgid = (xcd < r ? xcd * (q + 1) : r * (q + 1) + (xcd - r) * q) + off; }
        const int nig = WGM * nN, gid = wgid / nig, fm = gid * WGM, gsz = (nM - fm) < WGM ? (nM - fm) : WGM;
        u.pm = fm + ((wgid % nig) % gsz); u.pn = (wgid % nig) / gsz; u.e = 0; u.pl = u.pn; return true;
    }
    __device__ __forceinline__ void a_ready(const Unit&) const {}
    __device__ __forceinline__ void done(const Unit&) const {}
};

__device__ __forceinline__ unsigned cvt_pk_bf16(float lo, float hi) { unsigned r; asm volatile("v_cvt_pk_bf16_f32 %0, %1, %2" : "=v"(r) : "v"(lo), "v"(hi)); return r; }

struct EpiBf16Plain {
    static constexpr bool PERM = true, AFTER_DRAIN = false;
    bf16_t* O; int ldc; float sc;
    __device__ __forceinline__ void operator()(const f32x4 (&acc)[2][2][4][2], const Unit& u, int wr, int wc, int fr, int fq) const {
        const int row0 = u.pm * BM + wr * 64 + fr; const int col0 = u.pn * BM + wc * 32 + 8 * fq;
#pragma unroll
        for (int ai = 0; ai < 2; ++ai)
#pragma unroll
            for (int m = 0; m < 4; ++m) { bf16_t* rowp = O + (size_t)(row0 + ai * HALF + m * 16) * ldc + col0;
#pragma unroll
                for (int bj = 0; bj < 2; ++bj) { const f32x4 v0 = acc[ai][bj][m][0] * sc, v1 = acc[ai][bj][m][1] * sc;
                    u32x4 w; w.x = cvt_pk_bf16(v0[0], v0[1]); w.y = cvt_pk_bf16(v0[2], v0[3]); w.z = cvt_pk_bf16(v1[0], v1[1]); w.w = cvt_pk_bf16(v1[2], v1[3]);
                    *(u32x4*)(rowp + bj * HALF) = w; } }
    }
};
struct EpiResGate {
    static constexpr bool PERM = true, AFTER_DRAIN = false;
    const bf16_t* base; bf16_t* out; int ldc; const float* gate; int gpitch; int rows_per_batch; float sc;
    __device__ __forceinline__ void operator()(const f32x4 (&acc)[2][2][4][2], const Unit& u, int wr, int wc, int fr, int fq) const {
        const int row0 = u.pm * BM + wr * 64 + fr, col0 = u.pn * BM + wc * 32 + 8 * fq;
        const float* gp = gate + (size_t)((u.pm * BM) / rows_per_batch) * gpitch + col0;
        f32x4 gv[2][2];
#pragma unroll
        for (int bj = 0; bj < 2; ++bj)
#pragma unroll
            for (int n = 0; n < 2; ++n) gv[bj][n] = *(const f32x4*)(gp + bj * HALF + 4 * n) * sc;
#pragma unroll
        for (int ai = 0; ai < 2; ++ai)
#pragma unroll
            for (int m = 0; m < 4; ++m) { const size_t off = (size_t)(row0 + ai * HALF + m * 16) * ldc + col0;
#pragma unroll
                for (int bj = 0; bj < 2; ++bj) { const u32x4 bs = *(const u32x4*)(base + off + bj * HALF); const unsigned bw[4] = {bs.x, bs.y, bs.z, bs.w}; float r[8];
#pragma unroll
                    for (int j = 0; j < 4; ++j) { const f32x4& a4 = acc[ai][bj][m][j >> 1]; const f32x4& g4 = gv[bj][j >> 1];
                        r[2 * j] = __builtin_bit_cast(float, bw[j] << 16) + g4[2 * (j & 1)] * a4[2 * (j & 1)]; r[2 * j + 1] = __builtin_bit_cast(float, bw[j] & 0xffff0000u) + g4[2 * (j & 1) + 1] * a4[2 * (j & 1) + 1]; }
                    u32x4 w; w.x = cvt_pk_bf16(r[0], r[1]); w.y = cvt_pk_bf16(r[2], r[3]); w.z = cvt_pk_bf16(r[4], r[5]); w.w = cvt_pk_bf16(r[6], r[7]);
                    *(u32x4*)(out + off + bj * HALF) = w; }
                asm volatile("" ::: "memory"); }
    }
};
struct EpiSwiglu {
    static constexpr bool PERM = true, AFTER_DRAIN = false;
    unsigned char* O; int ldc; const float* bias; float inv_in, out_scale;
    __device__ __forceinline__ float act1(float g, float up) const {
        g = fminf(g, 7.0f); up = fminf(fmaxf(up, -7.0f), 7.0f);
        const float s = 1.0f / (1.0f + __expf(-1.702f * g));
        return fminf(fmaxf((up + 1.0f) * g * s * out_scale, -448.f), 448.f);
    }
    __device__ __forceinline__ void operator()(const f32x4 (&acc)[2][2][4][2], const Unit& u, int wr, int wc, int fr, int fq) const {
        const int row0 = u.pm * BM + wr * 64 + fr; const int jj0 = wc * 32 + 8 * fq; const int col0 = u.pl * HALF + jj0;
        const float* bp = bias + (size_t)u.e * 2048 + col0;
        f32x4 bg[2], bu[2];
#pragma unroll
        for (int n = 0; n < 2; ++n) { bg[n] = *(const f32x4*)(bp + 4 * n); bu[n] = *(const f32x4*)(bp + 1024 + 4 * n); }
#pragma unroll
        for (int ai = 0; ai < 2; ++ai)
#pragma unroll
            for (int m = 0; m < 4; ++m) { unsigned char* rowp = O + (size_t)(row0 + ai * HALF + m * 16) * ldc + col0;
                f32x4 r[2];
#pragma unroll
                for (int n = 0; n < 2; ++n) { const f32x4 g = acc[ai][0][m][n] * inv_in + bg[n], up = acc[ai][1][m][n] * inv_in + bu[n];
#pragma unroll
                    for (int j = 0; j < 4; ++j) r[n][j] = act1(g[j], up[j]); }
                int w0 = 0, w1 = 0;
                w0 = __builtin_amdgcn_cvt_pk_fp8_f32(r[0][0], r[0][1], w0, false); w0 = __builtin_amdgcn_cvt_pk_fp8_f32(r[0][2], r[0][3], w0, true);
                w1 = __builtin_amdgcn_cvt_pk_fp8_f32(r[1][0], r[1][1], w1, false); w1 = __builtin_amdgcn_cvt_pk_fp8_f32(r[1][2], r[1][3], w1, true);
                typedef int i32x2 __attribute__((ext_vector_type(2))); *(i32x2*)rowp = (i32x2){w0, w1}; }
    }
};
struct EpiBf16Bias {
    static constexpr bool PERM = true, AFTER_DRAIN = false;
    bf16_t* O; int ldc; const float* bias; int bpitch; float inv_in;
    __device__ __forceinline__ void operator()(const f32x4 (&acc)[2][2][4][2], const Unit& u, int wr, int wc, int fr, int fq) const {
        const int row0 = u.pm * BM + wr * 64 + fr; const int col0 = u.pl * BM + wc * 32 + 8 * fq;
        const float* bp = bias + (size_t)u.e * bpitch + col0;
        f32x4 bv[2][2];
#pragma unroll
        for (int bj = 0; bj < 2; ++bj)
#pragma unroll
            for (int n = 0; n < 2; ++n) bv[bj][n] = *(const f32x4*)(bp + bj * HALF + 4 * n);
#pragma unroll
        for (int ai = 0; ai < 2; ++ai)
#pragma unroll
            for (int m = 0; m < 4; ++m) { bf16_t* rowp = O + (size_t)(row0 + ai * HALF + m * 16) * ldc + col0;
#pragma unroll
                for (int bj = 0; bj < 2; ++bj) { const f32x4 v0 = acc[ai][bj][m][0] * inv_in + bv[bj][0], v1 = acc[ai][bj][m][1] * inv_in + bv[bj][1];
                    u32x4 w; w.x = cvt_pk_bf16(v0[0], v0[1]); w.y = cvt_pk_bf16(v0[2], v0[3]); w.z = cvt_pk_bf16(v1[0], v1[1]); w.w = cvt_pk_bf16(v1[2], v1[3]);
                    *(u32x4*)(rowp + bj * HALF) = w; } }
    }
};
struct EpiFp8Bias {
    static constexpr bool PERM = true, AFTER_DRAIN = false;
    unsigned char* O; int ldc; const float* bias; int bpitch; float inv_in, out_scale;
    __device__ __forceinline__ int pk4(f32x4 v) const { int w = 0; w = __builtin_amdgcn_cvt_pk_fp8_f32(fminf(fmaxf(v[0], -448.f), 448.f), fminf(fmaxf(v[1], -448.f), 448.f), w, false);
        return __builtin_amdgcn_cvt_pk_fp8_f32(fminf(fmaxf(v[2], -448.f), 448.f), fminf(fmaxf(v[3], -448.f), 448.f), w, true); }
    __device__ __forceinline__ void operator()(const f32x4 (&acc)[2][2][4][2], const Unit& u, int wr, int wc, int fr, int fq) const {
        const int row0 = u.pm * BM + wr * 64 + fr; const int col0 = u.pl * BM + wc * 32 + 8 * fq;
        const float* bp = bias + (size_t)u.e * bpitch + col0;
        f32x4 bv[2][2];
#pragma unroll
        for (int bj = 0; bj < 2; ++bj)
#pragma unroll
            for (int n = 0; n < 2; ++n) bv[bj][n] = *(const f32x4*)(bp + bj * HALF + 4 * n);
#pragma unroll
        for (int ai = 0; ai < 2; ++ai)
#pragma unroll
            for (int m = 0; m < 4; ++m) { unsigned char* rowp = O + (size_t)(row0 + ai * HALF + m * 16) * ldc + col0;
#pragma unroll
                for (int bj = 0; bj < 2; ++bj) { const f32x4 v0 = (acc[ai][bj][m][0] * inv_in + bv[bj][0]) * out_scale, v1 = (acc[ai][bj][m][1] * inv_in + bv[bj][1]) * out_scale;
                    typedef int i32x2 __attribute__((ext_vector_type(2))); *(i32x2*)(rowp + bj * HALF) = (i32x2){pk4(v0), pk4(v1)}; } }
    }
};
struct MoeOrder {
    int nN, G, c, nunits; const PG8_LAS int* tile_pm;
    __device__ __forceinline__ bool next(int i, Unit& u) const {
        const int L = i * G + c; if (L >= nunits) return false;
        const int idx = L / nN, pl = L - idx * nN, pm = __builtin_amdgcn_readfirstlane(tile_pm[idx]), e = pm >> 6;
        u.pm = pm; u.pl = pl; u.e = e; u.pn = e * nN + pl; return true;
    }
    __device__ __forceinline__ void a_ready(const Unit&) const {}
    __device__ __forceinline__ void done(const Unit&) const {}
};
typedef int v4i32_t __attribute__((ext_vector_type(4)));
typedef int v8i32_t __attribute__((ext_vector_type(8)));
template <class Epi, class Sched, bool ALIGN_EPI = false, bool SP2 = false, bool FP8 = false>
__device__ __forceinline__ void gemm_phase(PG8_LAS unsigned char* lds, const Gemm g, const Sched& S, const Epi& E, int tid_in) {
    int tid_ = tid_in; asm volatile("" : "+v"(tid_)); const int tid = tid_, wid = __builtin_amdgcn_readfirstlane(tid >> 6), lane = tid & 63, wr = wid >> 2, wc = wid & 3, fr = lane & 15, fq = lane >> 4;
    const int K = g.K, nt = K / BK;
    unsigned voffA, voffB;
    { int R, C; stage_rc(tid * 16, R, C); const int Rb = Epi::PERM ? ((R & ~31) + perm32(R & 31)) : R;
        voffA = (unsigned)(R * K + C) * 2u; voffB = (unsigned)(Rb * K + C) * 2u; }
    const size_t rstep = (size_t)64 * K * 2;
    const size_t kstep = (size_t)(BK * 2);
    const size_t hstep = (size_t)HALF * K * 2;
    const size_t tstep = 2 * hstep;
    const unsigned ldsw = (unsigned)wid * 1024u;
    const int aoff = lds_byte(wr * 64 + fr, fq * 8), boff = lds_byte(wc * 32 + fr, fq * 8);
#define PG8_SA(b, h) (((b) * 2 + (h)) * HTB)
#define PG8_SB(b, h) ((4 + (b) * 2 + (h)) * HTB)
#define PG8_STAGE(bufoff, gbase, voff) do { _Pragma("unroll") for (int _i = 0; _i < 2; ++_i) \
        __builtin_amdgcn_global_load_lds((const unsigned*)((const char*)(gbase) + _i * rstep + (voff)), (PG8_LAS unsigned*)(lds + (bufoff) + ldsw + _i * 8192), 16, 0, 0); } while (0)
#define PG8_LDA(dst, b, h) do { _Pragma("unroll") for (int m = 0; m < 4; ++m) _Pragma("unroll") for (int k = 0; k < 2; ++k) dst[m][k] = *(const PG8_LAS bf16x8*)(lds + PG8_SA(b, h) + aoff + m * 2048 + k * 1024); } while (0)
#define PG8_LDB(dst, b, h) do { _Pragma("unroll") for (int n = 0; n < 2; ++n) _Pragma("unroll") for (int k = 0; k < 2; ++k) dst[n][k] = *(const PG8_LAS bf16x8*)(lds + PG8_SB(b, h) + boff + n * 2048 + k * 1024); } while (0)
#define PG8_MMA(ai, bj, At, Bt) do { __builtin_amdgcn_s_setprio(1); _Pragma("unroll") for (int m = 0; m < 4; ++m) _Pragma("unroll") for (int n = 0; n < 2; ++n) { \
        if constexpr (FP8) { const v8i32_t a8_ = __builtin_shufflevector(__builtin_bit_cast(v4i32_t, At[m][0]), __builtin_bit_cast(v4i32_t, At[m][1]), 0, 1, 2, 3, 4, 5, 6, 7); \
            const v8i32_t b8_ = __builtin_shufflevector(__builtin_bit_cast(v4i32_t, Bt[n][0]), __builtin_bit_cast(v4i32_t, Bt[n][1]), 0, 1, 2, 3, 4, 5, 6, 7); \
            asm volatile("v_mfma_scale_f32_16x16x128_f8f6f4 %0, %1, %2, %0, %3, %3 op_sel_hi:[0,0,0]" : "+v"(acc[ai][bj][m][n]) : "v"(b8_), "v"(a8_), "v"(one8_)); } \
        else { _Pragma("unroll") for (int k = 0; k < 2; ++k) acc[ai][bj][m][n] = __builtin_amdgcn_mfma_f32_16x16x32_bf16(Bt[n][k], At[m][k], acc[ai][bj][m][n], 0, 0, 0); } } \
        __builtin_amdgcn_s_setprio(0); } while (0)
#define PG8_WAIT_V(n) asm volatile("s_waitcnt vmcnt(" #n ")" ::: "memory")
#define PG8_WAIT_L(n) asm volatile("s_waitcnt lgkmcnt(" #n ")" ::: "memory")
#define PG8_BAR __builtin_amdgcn_s_barrier()
#define PG8_SCHED __builtin_amdgcn_sched_barrier(0)
    Unit cur, nxt; int ui = 0;
    if (!S.next(0, cur)) return;
    f32x4 acc[2][2][4][2];
#pragma unroll
    for (int a = 0; a < 2; ++a)
#pragma unroll
        for (int b = 0; b < 2; ++b)
#pragma unroll
            for (int m = 0; m < 4; ++m)
#pragma unroll
                for (int n = 0; n < 2; ++n) acc[a][b][m][n] = (f32x4){0.f, 0.f, 0.f, 0.f};
    bf16x8 At[4][2], B0[2][2], B1[2][2];
    int one8_ = 0x7f7f7f7f; asm volatile("" : "+v"(one8_));
    const char* cA = (const char*)g.A + (size_t)cur.pm * tstep; const char* cB = (const char*)g.Bt + (size_t)cur.pn * tstep;
    S.a_ready(cur);
    if constexpr (SP2) {
        PG8_STAGE(PG8_SB(0, 0), cB, voffB); PG8_STAGE(PG8_SB(0, 1), cB + hstep, voffB); PG8_STAGE(PG8_SA(0, 0), cA, voffA); PG8_STAGE(PG8_SA(0, 1), cA + hstep, voffA);
        if (wr == 1) PG8_BAR;
        PG8_WAIT_V(2); PG8_BAR;
        PG8_STAGE(PG8_SB(1, 0), cB + kstep, voffB); PG8_STAGE(PG8_SA(1, 0), cA + kstep, voffA); PG8_STAGE(PG8_SB(1, 1), cB + hstep + kstep, voffB);
        PG8_WAIT_V(6); PG8_BAR;
    } else {
        PG8_STAGE(PG8_SB(0, 0), cB, voffB); PG8_STAGE(PG8_SA(0, 0), cA, voffA); PG8_STAGE(PG8_SB(0, 1), cB + hstep, voffB); PG8_STAGE(PG8_SA(0, 1), cA + hstep, voffA);
        if (wr == 1) PG8_BAR;
        PG8_WAIT_V(4); PG8_BAR;
        PG8_STAGE(PG8_SB(1, 0), cB + kstep, voffB); PG8_STAGE(PG8_SA(1, 0), cA + kstep, voffA); PG8_STAGE(PG8_SB(1, 1), cB + hstep + kstep, voffB);
        PG8_WAIT_V(6); PG8_BAR;
    }
    for (;;) {
        const bool has_next = S.next(ui + 1, nxt);
        const char* nA = has_next ? (const char*)g.A + (size_t)nxt.pm * tstep : cA; const char* nB = has_next ? (const char*)g.Bt + (size_t)nxt.pn * tstep : cB;
#pragma unroll 1
        for (int t = 0; t < nt; t += 2) {
            const bool last = (t == nt - 2);
            const char* a1 = cA + (size_t)(t + 1) * kstep;
            const char* a2 = last ? nA : cA + (size_t)(t + 2) * kstep; const char* b2 = last ? nB : cB + (size_t)(t + 2) * kstep;
            const char* a3 = a2 + kstep; const char* b3 = b2 + kstep;
            if (last && has_next) S.a_ready(nxt);
            if constexpr (SP2) {
            PG8_LDB(B0, 0, 0); PG8_LDB(B1, 0, 1); PG8_SCHED; PG8_LDA(At, 0, 0); PG8_STAGE(PG8_SA(1, 1), a1 + hstep, voffA);
            PG8_WAIT_V(8); PG8_WAIT_L(0); PG8_BAR; PG8_MMA(0, 0, At, B0); PG8_MMA(0, 1, At, B1); PG8_BAR; PG8_SCHED;
            PG8_LDA(At, 0, 1); PG8_STAGE(PG8_SB(0, 0), b2, voffB); PG8_STAGE(PG8_SB(0, 1), b2 + hstep, voffB); PG8_STAGE(PG8_SA(0, 0), a2, voffA);
            PG8_WAIT_V(8); PG8_WAIT_L(0); PG8_BAR; PG8_MMA(1, 0, At, B0); PG8_MMA(1, 1, At, B1); PG8_BAR; PG8_SCHED;
            PG8_LDB(B0, 1, 0); PG8_LDB(B1, 1, 1); PG8_SCHED; PG8_LDA(At, 1, 0); PG8_STAGE(PG8_SA(0, 1), a2 + hstep, voffA);
            PG8_WAIT_V(8); PG8_WAIT_L(0); PG8_BAR; PG8_MMA(0, 0, At, B0); PG8_MMA(0, 1, At, B1); PG8_BAR; PG8_SCHED;
            PG8_LDA(At, 1, 1); PG8_STAGE(PG8_SB(1, 0), b3, voffB); PG8_STAGE(PG8_SB(1, 1), b3 + hstep, voffB); PG8_STAGE(PG8_SA(1, 0), a3, voffA);
            PG8_WAIT_V(8); PG8_WAIT_L(0); PG8_BAR; PG8_MMA(1, 0, At, B0); PG8_MMA(1, 1, At, B1); PG8_BAR; PG8_SCHED;
            } else {
            PG8_LDB(B0, 0, 0); PG8_SCHED; PG8_LDA(At, 0, 0); PG8_STAGE(PG8_SA(1, 1), a1 + hstep, voffA);
            PG8_WAIT_L(8); PG8_BAR; PG8_WAIT_L(0); PG8_MMA(0, 0, At, B0); PG8_BAR; PG8_SCHED;
            PG8_LDB(B1, 0, 1); PG8_STAGE(PG8_SB(0, 0), b2, voffB);
            PG8_BAR; PG8_WAIT_L(0); PG8_MMA(0, 1, At, B1); PG8_BAR;
            PG8_LDA(At, 0, 1); PG8_STAGE(PG8_SA(0, 0), a2, voffA);
            PG8_BAR; PG8_WAIT_L(0); PG8_MMA(1, 0, At, B0); PG8_BAR; PG8_SCHED;
            PG8_STAGE(PG8_SB(0, 1), b2 + hstep, voffB);
            PG8_WAIT_V(6); PG8_BAR; PG8_MMA(1, 1, At, B1); PG8_BAR;
            PG8_LDB(B0, 1, 0); PG8_SCHED; PG8_LDA(At, 1, 0); PG8_STAGE(PG8_SA(0, 1), a2 + hstep, voffA);
            PG8_WAIT_L(8); PG8_BAR; PG8_WAIT_L(0); PG8_MMA(0, 0, At, B0); PG8_BAR; PG8_SCHED;
            PG8_LDB(B1, 1, 1); PG8_STAGE(PG8_SB(1, 0), b3, voffB);
            PG8_BAR; PG8_WAIT_L(0); PG8_MMA(0, 1, At, B1); PG8_BAR;
            PG8_LDA(At, 1, 1); PG8_STAGE(PG8_SA(1, 0), a3, voffA);
            PG8_BAR; PG8_WAIT_L(0); PG8_MMA(1, 0, At, B0); PG8_BAR; PG8_SCHED;
            PG8_STAGE(PG8_SB(1, 1), b3 + hstep, voffB);
            PG8_WAIT_V(6); PG8_BAR; PG8_MMA(1, 1, At, B1); PG8_BAR;
            }
        }
        if constexpr (FP8) asm volatile("s_nop 7\n\ts_nop 7" ::: "memory");
        if constexpr (ALIGN_EPI) { if (wr == 0) PG8_BAR; }
        if constexpr (!Epi::AFTER_DRAIN) { int ln_ = (int)__builtin_amdgcn_mbcnt_hi(~0u, __builtin_amdgcn_mbcnt_lo(~0u, 0u)); asm volatile("" : "+v"(ln_)); E(acc, cur, wr, wc, ln_ & 15, ln_ >> 4); S.done(cur); }
        if (!has_next) break;
#pragma unroll
        for (int a = 0; a < 2; ++a)
#pragma unroll
            for (int b = 0; b < 2; ++b)
#pragma unroll
                for (int m = 0; m < 4; ++m)
#pragma unroll
                    for (int n = 0; n < 2; ++n) acc[a][b][m][n] = (f32x4){0.f, 0.f, 0.f, 0.f};
        cur = nxt; cA = nA; cB = nB; ++ui;
        if constexpr (ALIGN_EPI) { if (wr == 1) PG8_BAR; }
    }
    PG8_WAIT_V(0);
    if constexpr (!ALIGN_EPI) { if (wr == 0) PG8_BAR; }
    PG8_BAR;
    if constexpr (Epi::AFTER_DRAIN) { E.fused(acc, cur, wr, wc, fr, fq, lds, wid, lane); S.done(cur); }
#undef PG8_SA
#undef PG8_SB
#undef PG8_STAGE
#undef PG8_LDA
#undef PG8_LDB
#undef PG8_MMA
#undef PG8_WAIT_V
#undef PG8_WAIT_L
#undef PG8_BAR
#undef PG8_SCHED
}
}

constexpr int NWAVES = 8, NTHR = 512;
constexpr int BATCH = 2, SEQ = 8192, D = 1024, DEPTH = 4, MTOK = BATCH * SEQ;
constexpr int DIN = 3344, NPROJ = 3328, SRC_GA = 1152;
constexpr int C_GQ = 0, C_GK = 192, C_GV = 384, C_GG = 768, C_HQ = 1152, C_HF = 1408, C_HI = 1664, C_HG = 1920, C_RQ = 2176, C_RK = 2368, C_RV = 2560, C_RG = 2944;
constexpr int NE = 32, FFN = 1024;
constexpr int CH = 64, NCH = SEQ / CH, NUNIT = BATCH * NCH;
constexpr int ST_GLA = 0, ST_HG = 4 * 48 * 96, ST_RET = ST_HG + 4 * 64 * 64, ST_TOT = ST_RET + 4 * 48 * 96;
constexpr int NDV = 448, NKT = 640;
constexpr int MAXROWS = 65536 + NE * 256, MAXRT = MAXROWS / 256;
constexpr float EPS = 1e-6f;
#ifndef F8_IN_V
#define F8_IN_V false
#endif
#ifndef F8_OUT_V
#define F8_OUT_V false
#endif
constexpr bool F8_IN = F8_IN_V, F8_OUT = F8_OUT_V;
#ifndef Y8_V
#define Y8_V true
#endif
constexpr bool Y8 = Y8_V;
constexpr float S8_Y = 16.f;
constexpr float S8_M = 32.f;
constexpr float S8_W = 2048.f, S8_H = 64.f, S8_A = 8.f;
constexpr int NPHASE = 38;
constexpr int ECAP = 16384, ECAP_SH = 14;

constexpr size_t MiB = 1u << 20;
constexpr size_t WS_CTL = 0, CTL_ZERO_BYTES = 65536;
constexpr size_t WS_MOD = 1 * MiB;
constexpr size_t WS_ROPE = 2 * MiB;
constexpr size_t WS_LB = 5 * MiB;
constexpr size_t WS_WIN = 8 * MiB;
constexpr size_t WS_WOUT = 34 * MiB;
constexpr size_t WS_WGU = 42 * MiB;
constexpr size_t WS_WDN = 554 * MiB;
constexpr size_t WS_X = 810 * MiB;
constexpr size_t WS_H = 874 * MiB;
constexpr size_t WS_GA = 906 * MiB;
constexpr size_t WS_PROJ = 907 * MiB;
constexpr size_t WS_U = 1011 * MiB;
constexpr size_t WS_DVEC = 1063 * MiB;
constexpr size_t WS_SP = 1064 * MiB;
constexpr size_t WS_MIX = 1090 * MiB;
constexpr size_t WS_TOPE = 1122 * MiB;
constexpr size_t WS_TOPW = WS_TOPE + 256 * 1024;
constexpr size_t WS_SLOT = WS_TOPW + 256 * 1024;
constexpr size_t WS_A1 = 1123 * MiB;
constexpr size_t WS_ACT = 1635 * MiB;
constexpr size_t WS_Y = 2147 * MiB;
constexpr size_t WS_CUM = 3171 * MiB;
constexpr size_t WS_KT = 3199 * MiB;
constexpr size_t WS_END = 3239 * MiB;
static_assert(WS_WIN + (size_t)DEPTH * NPROJ * D * 2 <= WS_WOUT && WS_PROJ + (size_t)MTOK * NPROJ * 2 <= WS_U && WS_U + (size_t)NUNIT * ST_TOT * 4 <= WS_DVEC && WS_SP + (size_t)NUNIT * ST_TOT * 2 <= WS_MIX && WS_A1 + (size_t)NE * ECAP * D <= WS_ACT && WS_ACT + (size_t)NE * ECAP * D <= WS_Y && WS_Y + (size_t)NE * ECAP * D * 2 <= WS_CUM, "ws map");
constexpr int CW_TMO = 0, CW_CODE = 1, CW_BAR = 4096, CW_CNT = 8192, CW_FILL = 8192 + 256;
constexpr int RING_BYTES = 131072;
constexpr int MISC_OFF = 147456, LDS_BYTES = MISC_OFF + 4096;
constexpr int MW_BAR = 0, MW_CNT = 16, MW_PST = 48, MW_HIST = 96, MW_BASE = 128, MW_TILE = 192, MW_NRT = 480, MW_SLOTS = 512;

#define GAS __attribute__((address_space(1)))
#define LAS __attribute__((address_space(3)))
typedef unsigned v4u __attribute__((ext_vector_type(4)));
typedef float f32x4 __attribute__((ext_vector_type(4)));
typedef short bf16x8 __attribute__((ext_vector_type(8)));
typedef GAS unsigned gu32;
typedef GAS unsigned long long gu64;
#define RLX_AGENT __ATOMIC_RELAXED, __HIP_MEMORY_SCOPE_AGENT
#define LDS_WAIT() asm volatile("s_waitcnt lgkmcnt(0)" ::: "memory")
#define VM_WAIT() asm volatile("s_waitcnt vmcnt(0)" ::: "memory")
__device__ __forceinline__ unsigned long long rt() { return __builtin_amdgcn_s_memrealtime(); }
typedef unsigned short bf16;
__device__ __forceinline__ unsigned f2bf(float f) { unsigned u = __builtin_bit_cast(unsigned, f); return (u + 0x7fffu + ((u >> 16) & 1u)) >> 16; }
__device__ __forceinline__ unsigned pk2(float lo, float hi) { return f2bf(lo) | (f2bf(hi) << 16); }
__device__ __forceinline__ float bf2f(bf16 b) { return __builtin_bit_cast(float, (unsigned)b << 16); }
#define XB_TMO      128
#define XB_XCNT(j)  (256  + 64 * (j))
#define XB_XSUB(j)  (1280 + 64 * (j))
#define XB_XGEN(j)  (2304 + 64 * (j))
#define XB_TOP      3328
#define XB_TOPGEN   3392
#define XCD_BAR_WORDS 3456
#define XB_SPIN_CAP (1u << 18)

__device__ __forceinline__ unsigned xb_ld(unsigned* p)              { return __hip_atomic_load(p, __ATOMIC_RELAXED, __HIP_MEMORY_SCOPE_AGENT); }
__device__ __forceinline__ unsigned xb_add(unsigned* p, unsigned v) { return __hip_atomic_fetch_add(p, v, __ATOMIC_RELAXED, __HIP_MEMORY_SCOPE_AGENT); }
__device__ __forceinline__ unsigned xb_xcc_id() { return (unsigned)__builtin_amdgcn_s_getreg((3 << 11) | 20) & 0xFu; }
#define XB_SPIN(cond, bar) do { unsigned _sp = 0; while (cond) { __builtin_amdgcn_s_sleep(1); \
    if ((++_sp & 255u) == 0u) { if (xb_ld(&(bar)[XB_TMO])) break; if (_sp > XB_SPIN_CAP) { atomicAdd(&(bar)[XB_TMO], 1u); break; } } } } while (0)

struct XcdBarrier {
    unsigned* bar; unsigned x;
    volatile LAS unsigned* st;
};

__device__ __forceinline__ XcdBarrier xcd_barrier_post(unsigned* bar, volatile LAS unsigned* st) {
    XcdBarrier b; b.bar = bar; b.x = xb_xcc_id(); b.st = st;
    if (threadIdx.x == 0) (void)xb_add(&bar[XB_XCNT(b.x)], 1u);
    return b;
}
__device__ __forceinline__ void xcd_barrier_complete(unsigned* bar, unsigned x, unsigned& nloc, unsigned& nx) {
    const unsigned G = gridDim.x * gridDim.y * gridDim.z;
    unsigned sum, cnt, mine, sp = 0u;
    for (;;) {
        sum = 0u; cnt = 0u; mine = 0u;
#pragma unroll
        for (unsigned j = 0; j < 16; ++j) { const unsigned c = xb_ld(&bar[XB_XCNT(j)]); sum += c; cnt += (c > 0u) ? 1u : 0u; mine = (j == x) ? c : mine; }
        if (sum == G) break;
        __builtin_amdgcn_s_sleep(1);
        if ((++sp & 255u) == 0u) { if (xb_ld(&bar[XB_TMO])) break; if (sp > XB_SPIN_CAP) { atomicAdd(&bar[XB_TMO], 1u); break; } }
    }
    nloc = mine > 0u ? mine : 1u; nx = cnt > 0u ? cnt : 1u;
}

__device__ __forceinline__ void xcd_barrier(const XcdBarrier& b) {
    asm volatile("s_waitcnt vmcnt(0)" ::: "memory");
    __syncthreads();
    if (threadIdx.x == 0) {
        unsigned* bar = b.bar;
        __builtin_amdgcn_s_waitcnt(0);
        unsigned nloc = b.st[0], nx = b.st[1];
        if (nloc == 0u) { xcd_barrier_complete(bar, b.x, nloc, nx); b.st[0] = nloc; b.st[1] = nx; }
        const unsigned old = xb_add(&bar[XB_XSUB(b.x)], 1u);
        const unsigned gen = old / nloc;
        if (old + 1u == (gen + 1u) * nloc) {
            __builtin_amdgcn_fence(__ATOMIC_RELEASE, "agent");
            asm volatile("s_waitcnt vmcnt(0)" ::: "memory");
            const unsigned og = xb_add(&bar[XB_TOP], 1u);
            const unsigned tg = og / nx;
            if (og + 1u == (tg + 1u) * nx) xb_add(&bar[XB_TOPGEN], 1u);
            else XB_SPIN(xb_ld(&bar[XB_TOPGEN]) == tg, bar);
            __builtin_amdgcn_fence(__ATOMIC_ACQUIRE, "agent");
            xb_add(&bar[XB_XGEN(b.x)], 1u);
            asm volatile("s_waitcnt vmcnt(0)" ::: "memory");
        } else {
            XB_SPIN(xb_ld(&bar[XB_XGEN(b.x)]) == gen, bar);
            __builtin_amdgcn_fence(__ATOMIC_ACQUIRE, "agent");
            asm volatile("s_waitcnt vmcnt(0)" ::: "memory");
        }
    }
    __syncthreads();
}

__device__ __forceinline__ float wave_sum(float v) {
#pragma unroll
    for (int o = 1; o < 64; o <<= 1) v += __shfl_xor(v, o);
    return v;
}
__device__ __forceinline__ float log_sigmoid_f(float x) { return fminf(x, 0.f) - log1pf(expf(-fabsf(x))); }
__device__ __forceinline__ float silu_f(float x) { return x / (1.0f + expf(-x)); }
__device__ __forceinline__ float sigmoid_f(float x) { return 1.0f / (1.0f + expf(-x)); }
__device__ __forceinline__ pg8::bf16x8 ldfrag(const LAS bf16* base, int stride, int r0, int k0, int lane) {
    return *(const LAS pg8::bf16x8*)(base + (r0 + (lane & 15)) * stride + k0 + 8 * (lane >> 4));
}
__device__ __forceinline__ pg8::bf16x8 pack8(const float (&v)[8]) { v4u w; w.x = pk2(v[0], v[1]); w.y = pk2(v[2], v[3]); w.z = pk2(v[4], v[5]); w.w = pk2(v[6], v[7]); return __builtin_bit_cast(pg8::bf16x8, w); }

struct Args {
    const float* x; const float* c; const int* pos; const float* w_mod; const float* b_mod; const float* norm1_w; const float* w_in; const float* gla_wa2; const float* gla_ba2; const float* hg_lb;
    const float* gla_norm_w; const float* hg_norm_w; const float* w_out; const float* norm2_w; const float* w_r; const float* b_r; const float* w_gu; const float* b_gu; const float* w_dn; const float* b_dn;
    const float* final_norm_w; float* out; unsigned char* ws; int ph_lo, ph_hi;
};

__device__ __forceinline__ void transpose_block64(const float* src, int ld, bf16* dst, LAS float* scr, int lane) {
    const int r = lane >> 4, c4 = (lane & 15) * 4;
    f32x4 v[16];
#pragma unroll
    for (int i = 0; i < 16; ++i) v[i] = __builtin_nontemporal_load((const f32x4*)(src + (size_t)(4 * i + r) * ld + c4));
#pragma unroll
    for (int i = 0; i < 16; ++i) { LAS float* w = scr + (4 * i + r) * 65 + c4; w[0] = v[i][0]; w[1] = v[i][1]; w[2] = v[i][2]; w[3] = v[i][3]; }
    LDS_WAIT(); asm volatile("" ::: "memory");
    const int kc = lane & 7;
#pragma unroll
    for (int jj = 0; jj < 8; ++jj) { const int n = (lane >> 3) + 8 * jj; const LAS float* s = scr + (8 * kc) * 65 + n;
        v4u o; o.x = pk2(s[0 * 65], s[1 * 65]); o.y = pk2(s[2 * 65], s[3 * 65]); o.z = pk2(s[4 * 65], s[5 * 65]); o.w = pk2(s[6 * 65], s[7 * 65]);
        *(GAS v4u*)(dst + (size_t)n * D + 8 * kc) = o; }
    LDS_WAIT(); asm volatile("" ::: "memory");
}
__device__ __forceinline__ int pk4_fp8(float a, float b, float c, float d) { int w = 0; w = __builtin_amdgcn_cvt_pk_fp8_f32(fminf(fmaxf(a, -448.f), 448.f), fminf(fmaxf(b, -448.f), 448.f), w, false);
    return __builtin_amdgcn_cvt_pk_fp8_f32(fminf(fmaxf(c, -448.f), 448.f), fminf(fmaxf(d, -448.f), 448.f), w, true); }
__device__ __forceinline__ void transpose_block64_fp8(const float* src, int ld, unsigned char* dst, LAS float* scr, int lane, float sc) {
    const int r = lane >> 4, c4 = (lane & 15) * 4;
    f32x4 v[16];
#pragma unroll
    for (int i = 0; i < 16; ++i) v[i] = __builtin_nontemporal_load((const f32x4*)(src + (size_t)(4 * i + r) * ld + c4));
#pragma unroll
    for (int i = 0; i < 16; ++i) { LAS float* w = scr + (4 * i + r) * 65 + c4; w[0] = v[i][0] * sc; w[1] = v[i][1] * sc; w[2] = v[i][2] * sc; w[3] = v[i][3] * sc; }
    LDS_WAIT(); asm volatile("" ::: "memory");
    const int kc = lane & 3;
#pragma unroll
    for (int jj = 0; jj < 4; ++jj) { const int n = (lane >> 2) + 16 * jj; const LAS float* s = scr + (16 * kc) * 65 + n;
        v4u o; o.x = (unsigned)pk4_fp8(s[0 * 65], s[1 * 65], s[2 * 65], s[3 * 65]); o.y = (unsigned)pk4_fp8(s[4 * 65], s[5 * 65], s[6 * 65], s[7 * 65]);
        o.z = (unsigned)pk4_fp8(s[8 * 65], s[9 * 65], s[10 * 65], s[11 * 65]); o.w = (unsigned)pk4_fp8(s[12 * 65], s[13 * 65], s[14 * 65], s[15 * 65]);
        *(GAS v4u*)(dst + (size_t)n * D + 16 * kc) = o; }
    LDS_WAIT(); asm volatile("" ::: "memory");
}
constexpr int IT_IN = 16 * (NPROJ / 64), IT_OUT = 16 * 16, IT_GU = NE * 16 * 32, IT_DN = NE * 16 * 16, IT_LAYER = IT_IN + IT_OUT + IT_GU + IT_DN, IT_ALL = DEPTH * IT_LAYER;
__device__ __forceinline__ void convert_item(const Args& a, int l, int r, LAS float* scr, int lane) {
    unsigned char* ws = a.ws;
    bf16* WIN = (bf16*)(ws + WS_WIN); bf16* WOUT = (bf16*)(ws + WS_WOUT); unsigned char* WGU = ws + WS_WGU; unsigned char* WDN = ws + WS_WDN;
    if (r < IT_IN) { const int kb = r / (NPROJ / 64), nb = r % (NPROJ / 64), n0 = 64 * nb, sc = n0 + (n0 >= SRC_GA ? 16 : 0);
        if (F8_IN) transpose_block64_fp8(a.w_in + ((size_t)l * D + 64 * kb) * DIN + sc, DIN, (unsigned char*)WIN + ((size_t)l * NPROJ + n0) * D + 64 * kb, scr, lane, S8_W);
        else transpose_block64(a.w_in + ((size_t)l * D + 64 * kb) * DIN + sc, DIN, WIN + ((size_t)l * NPROJ + n0) * D + 64 * kb, scr, lane); return; }
    r -= IT_IN;
    if (r < IT_OUT) { const int kb = r / 16, nb = r % 16;
        if (F8_OUT) transpose_block64_fp8(a.w_out + ((size_t)l * D + 64 * kb) * D + 64 * nb, D, (unsigned char*)WOUT + ((size_t)l * D + 64 * nb) * D + 64 * kb, scr, lane, S8_W);
        else transpose_block64(a.w_out + ((size_t)l * D + 64 * kb) * D + 64 * nb, D, WOUT + ((size_t)l * D + 64 * nb) * D + 64 * kb, scr, lane); return; }
    r -= IT_OUT;
    if (r < IT_GU) { const int e = r / 512, r2 = r % 512, kb = r2 / 32, nb = r2 % 32, cc = 64 * nb;
        const int row = (cc < 1024) ? 256 * (cc / 128) + (cc % 128) : 256 * ((cc - 1024) / 128) + 128 + ((cc - 1024) % 128);
        transpose_block64_fp8(a.w_gu + (((size_t)l * NE + e) * D + 64 * kb) * 2048 + cc, 2048, WGU + (((size_t)l * NE + e) * 2048 + row) * D + 64 * kb, scr, lane, S8_W); return; }
    r -= IT_GU;
    { const int e = r / 256, r2 = r % 256, kb = r2 / 16, nb = r2 % 16;
        transpose_block64_fp8(a.w_dn + (((size_t)l * NE + e) * FFN + 64 * kb) * D + 64 * nb, D, WDN + (((size_t)l * NE + e) * D + 64 * nb) * D + 64 * kb, scr, lane, S8_W); }
}
constexpr int CB2 = 4, CB7 = 2, CB8 = 2;
__device__ __forceinline__ int conv_t2(int G) { return (G == 256) ? 192 * NWAVES * CB2 : 0; }
__device__ __forceinline__ int conv_idle(int nunits, int G) { const int rem = nunits % G; return rem ? G - rem : 0; }
__device__ __forceinline__ void convert_range(const Args& a, int l, int first, int count, LAS unsigned char* lds, int lane, int wave) {
    LAS float* scr = (LAS float*)(lds + wave * 16640);
    for (int k = 0; k < count; ++k) { const int it = first + k; if (it < IT_LAYER) convert_item(a, l, it, scr, lane); }
}
__device__ __forceinline__ void p0_prologue(const Args& a, LAS unsigned char* lds, int vcu, int G, int tid, int lane, int wave) {
    unsigned char* ws = a.ws;
    LAS float* scr = (LAS float*)(lds + wave * 16640);
    const int gw = vcu * NWAVES + wave, NGW = G * NWAVES;
    for (int it = gw; it < IT_LAYER; it += NGW) convert_item(a, 0, it, scr, lane);
    __syncthreads();
    {
        LAS float* cact = (LAS float*)lds;
        LAS float* red = (LAS float*)(lds + 8192);
        for (int i = tid; i < 2 * D; i += NTHR) cact[i] = silu_f(a.c[i]);
        __syncthreads();
        float* MOD = (float*)(ws + WS_MOD);
        for (int it = vcu; it < DEPTH * 96; it += G) {
            const int l = it / 96, n0 = (it % 96) * 64;
            const float* wp = a.w_mod + ((size_t)l * D + 128 * wave) * 6144 + n0 + lane;
            float a0 = 0.f, a1 = 0.f;
#pragma unroll 32
            for (int k = 0; k < 128; ++k) { const float w = __builtin_nontemporal_load(wp + (size_t)k * 6144); a0 += cact[128 * wave + k] * w; a1 += cact[D + 128 * wave + k] * w; }
            red[(wave * 2 + 0) * 64 + lane] = a0; red[(wave * 2 + 1) * 64 + lane] = a1;
            __syncthreads();
            if (tid < 128) { const int b = tid >> 6, ln = tid & 63; float s = a.b_mod[l * 6144 + n0 + ln];
#pragma unroll
                for (int w = 0; w < 8; ++w) s += red[(w * 2 + b) * 64 + ln];
                MOD[((size_t)l * 2 + b) * 6144 + n0 + ln] = s; }
            __syncthreads();
        }
    }
    { const f32x4* xs = (const f32x4*)a.x; uint2* xd = (uint2*)(ws + WS_X);
        for (int i = vcu * NTHR + tid; i < MTOK * D / 4; i += G * NTHR) { const f32x4 v = xs[i]; uint2 p; p.x = pk2(v[0], v[1]); p.y = pk2(v[2], v[3]); xd[i] = p; } }
    {
        float* ROPE = (float*)(ws + WS_ROPE);
        for (int i = vcu * NTHR + tid; i < MTOK * 24; i += G * NTHR) { const int t = i / 24, f = i % 24;
            const float inv = (float)pow(10000.0, -(double)f / 24.0); const float ang = (float)a.pos[t] * inv;
            ROPE[(size_t)t * 48 + f] = cosf(ang); ROPE[(size_t)t * 48 + 24 + f] = sinf(ang); }
    }
    if (vcu == 0 && tid < 256) {
        float v[4], mx = -3.0e38f; for (int l = 0; l < 4; ++l) { v[l] = a.hg_lb[l * 256 + tid]; mx = fmaxf(mx, v[l]); }
        float s = 0.f; for (int l = 0; l < 4; ++l) { v[l] = expf(v[l] - mx); s += v[l]; }
        float* LB = (float*)(ws + WS_LB); float cs = 0.f, first = 0.f;
        for (int l = 0; l < 4; ++l) { cs += v[l] / s; if (l == 0) first = cs; LB[l * 256 + tid] = cs - first; }
    }
}

__device__ __forceinline__ void moe_combine_row(f32x4 (&v)[4], int m, const bf16* Y, const int* SLOT, const float* TOPW, const float* g2, int lane) {
    const int4 sl = *(const int4*)(SLOT + (size_t)m * 4); const f32x4 tw = *(const f32x4*)(TOPW + (size_t)m * 4);
    const int s[4] = {sl.x, sl.y, sl.z, sl.w};
    f32x4 acc[4];
#pragma unroll
    for (int j = 0; j < 4; ++j) acc[j] = (f32x4){0.f, 0.f, 0.f, 0.f};
#pragma unroll
    for (int k = 0; k < 4; ++k) { const bf16* yr = Y + (size_t)s[k] * D + 4 * lane; const float w = tw[k];
#pragma unroll
        for (int j = 0; j < 4; ++j) { const uint2 p = *(const uint2*)(yr + 256 * j);
            acc[j][0] += w * __builtin_bit_cast(float, p.x << 16); acc[j][1] += w * __builtin_bit_cast(float, p.x & 0xffff0000u);
            acc[j][2] += w * __builtin_bit_cast(float, p.y << 16); acc[j][3] += w * __builtin_bit_cast(float, p.y & 0xffff0000u); } }
#pragma unroll
    for (int j = 0; j < 4; ++j) { const f32x4 g = *(const f32x4*)(g2 + 4 * lane + 256 * j); v[j] = v[j] + g * acc[j]; }
}
__device__ __forceinline__ float row_rstd(const f32x4 (&v)[4]) {
    float s = 0.f;
#pragma unroll
    for (int j = 0; j < 4; ++j) s += (v[j][0] * v[j][0] + v[j][1] * v[j][1]) + (v[j][2] * v[j][2] + v[j][3] * v[j][3]);
    return 1.0f / sqrtf(wave_sum(s) * (1.0f / D) + EPS);
}
__device__ __forceinline__ void modulate_row(f32x4 (&v)[4], float rstd, const float* nw, const float* sc, const float* sh, bf16* hrow, int lane) {
#pragma unroll
    for (int j = 0; j < 4; ++j) { const int c0 = 4 * lane + 256 * j; const f32x4 w = *(const f32x4*)(nw + c0), s1 = *(const f32x4*)(sc + c0), s0 = *(const f32x4*)(sh + c0);
        v[j] = v[j] * rstd * w * (s1 + 1.0f) + s0;
        uint2 p; p.x = pk2(v[j][0], v[j][1]); p.y = pk2(v[j][2], v[j][3]); *(uint2*)(hrow + c0) = p; }
}


constexpr int LR_SLT = 142976, LR_TWL = 144000, LR_SSR = 145024;
__device__ __forceinline__ void stage_slots(const unsigned char* ws, int row0, LAS unsigned char* lds, int tid) {
    if (tid < 64) { *(LAS v4u*)(lds + LR_SLT + 16 * tid) = *(const v4u*)((const int*)(ws + WS_SLOT) + (size_t)(row0 + tid) * 4);
                    *(LAS f32x4*)(lds + LR_TWL + 16 * tid) = *(const f32x4*)((const float*)(ws + WS_TOPW) + (size_t)(row0 + tid) * 4); }
}
template <bool SS, bool OUTF32>
__device__ __forceinline__ void flat_combine(const bf16* xsrc, void* xdst, int row0, const bf16* Y, const float* g2, LAS unsigned char* lds, int tid, int lane) {
    const int c4 = tid & 255, rsub = tid >> 8; const f32x4 g = *(const f32x4*)(g2 + 4 * c4);
#pragma unroll 4
    for (int it = 0; it < 32; ++it) { const int i = 2 * it + rsub; const size_t m = (size_t)(row0 + i);
        f32x4 v; { const uint2 xp = *(const uint2*)(xsrc + m * D + 4 * c4); v[0] = __builtin_bit_cast(float, xp.x << 16); v[1] = __builtin_bit_cast(float, xp.x & 0xffff0000u); v[2] = __builtin_bit_cast(float, xp.y << 16); v[3] = __builtin_bit_cast(float, xp.y & 0xffff0000u); }
        const v4u sl = *(const LAS v4u*)(lds + LR_SLT + 16 * i); const f32x4 tw = *(const LAS f32x4*)(lds + LR_TWL + 16 * i);
        f32x4 acc;
        if (Y8) { const unsigned char* Yb = (const unsigned char*)Y; typedef float f32x2v __attribute__((ext_vector_type(2)));
            const int q0 = *(const int*)(Yb + (size_t)sl.x * D + 4 * c4), q1 = *(const int*)(Yb + (size_t)sl.y * D + 4 * c4), q2 = *(const int*)(Yb + (size_t)sl.z * D + 4 * c4), q3 = *(const int*)(Yb + (size_t)sl.w * D + 4 * c4);
            const f32x2v a0 = __builtin_amdgcn_cvt_pk_f32_fp8(q0, false), b0 = __builtin_amdgcn_cvt_pk_f32_fp8(q0, true), a1 = __builtin_amdgcn_cvt_pk_f32_fp8(q1, false), b1 = __builtin_amdgcn_cvt_pk_f32_fp8(q1, true);
            const f32x2v a2 = __builtin_amdgcn_cvt_pk_f32_fp8(q2, false), b2 = __builtin_amdgcn_cvt_pk_f32_fp8(q2, true), a3 = __builtin_amdgcn_cvt_pk_f32_fp8(q3, false), b3 = __builtin_amdgcn_cvt_pk_f32_fp8(q3, true);
            const f32x4 tws = tw * (1.0f / S8_Y);
            acc[0] = tws[0] * a0[0] + tws[1] * a1[0] + tws[2] * a2[0] + tws[3] * a3[0]; acc[1] = tws[0] * a0[1] + tws[1] * a1[1] + tws[2] * a2[1] + tws[3] * a3[1];
            acc[2] = tws[0] * b0[0] + tws[1] * b1[0] + tws[2] * b2[0] + tws[3] * b3[0]; acc[3] = tws[0] * b0[1] + tws[1] * b1[1] + tws[2] * b2[1] + tws[3] * b3[1]; }
        else {
        const uint2 p0 = *(const uint2*)(Y + (size_t)sl.x * D + 4 * c4), p1 = *(const uint2*)(Y + (size_t)sl.y * D + 4 * c4), p2 = *(const uint2*)(Y + (size_t)sl.z * D + 4 * c4), p3 = *(const uint2*)(Y + (size_t)sl.w * D + 4 * c4);
        acc[0] = tw[0] * __builtin_bit_cast(float, p0.x << 16) + tw[1] * __builtin_bit_cast(float, p1.x << 16) + tw[2] * __builtin_bit_cast(float, p2.x << 16) + tw[3] * __builtin_bit_cast(float, p3.x << 16);
        acc[1] = tw[0] * __builtin_bit_cast(float, p0.x & 0xffff0000u) + tw[1] * __builtin_bit_cast(float, p1.x & 0xffff0000u) + tw[2] * __builtin_bit_cast(float, p2.x & 0xffff0000u) + tw[3] * __builtin_bit_cast(float, p3.x & 0xffff0000u);
        acc[2] = tw[0] * __builtin_bit_cast(float, p0.y << 16) + tw[1] * __builtin_bit_cast(float, p1.y << 16) + tw[2] * __builtin_bit_cast(float, p2.y << 16) + tw[3] * __builtin_bit_cast(float, p3.y << 16);
        acc[3] = tw[0] * __builtin_bit_cast(float, p0.y & 0xffff0000u) + tw[1] * __builtin_bit_cast(float, p1.y & 0xffff0000u) + tw[2] * __builtin_bit_cast(float, p2.y & 0xffff0000u) + tw[3] * __builtin_bit_cast(float, p3.y & 0xffff0000u); }
        v = v + g * acc;
        if (OUTF32) *(f32x4*)((float*)xdst + m * D + 4 * c4) = v;
        else { uint2 xo; xo.x = pk2(v[0], v[1]); xo.y = pk2(v[2], v[3]); *(uint2*)((bf16*)xdst + m * D + 4 * c4) = xo; }
        if (SS) { const float sq = wave_sum((v[0] * v[0] + v[1] * v[1]) + (v[2] * v[2] + v[3] * v[3])); if (lane == 0) __hip_atomic_fetch_add((LAS float*)(lds + LR_SSR) + i, sq, __ATOMIC_RELAXED, __HIP_MEMORY_SCOPE_WORKGROUP); } }
}
template <bool F8>
__device__ __forceinline__ void flat_modulate(const bf16* xin, int row0, const LAS float* rstds, const float* nw, const float* scp, const float* shp, bf16* H, int tid) {
    const int c4 = tid & 255, rsub = tid >> 8; const f32x4 w = *(const f32x4*)(nw + 4 * c4), s1 = *(const f32x4*)(scp + 4 * c4), s0 = *(const f32x4*)(shp + 4 * c4); const f32x4 ws1 = w * (s1 + 1.0f);
#pragma unroll 8
    for (int it = 0; it < 32; ++it) { const int i = 2 * it + rsub; const size_t m = (size_t)(row0 + i); const uint2 xp = *(const uint2*)(xin + m * D + 4 * c4);
        const f32x4 v = (f32x4){__builtin_bit_cast(float, xp.x << 16), __builtin_bit_cast(float, xp.x & 0xffff0000u), __builtin_bit_cast(float, xp.y << 16), __builtin_bit_cast(float, xp.y & 0xffff0000u)} * rstds[i] * ws1 + s0;
        if (F8) *(int*)((unsigned char*)H + m * D + 4 * c4) = pk4_fp8(v[0] * S8_H, v[1] * S8_H, v[2] * S8_H, v[3] * S8_H);
        else { uint2 p; p.x = pk2(v[0], v[1]); p.y = pk2(v[2], v[3]); *(uint2*)(H + m * D + 4 * c4) = p; } }
}

constexpr int WP = 1032;
constexpr int LR_WHI = 0, LR_PART = 132096, LR_SSX = 140288, LR_RSTD = 140544, LR_BIAS = 140800, LR_RED = 140928;
template <int NEO>
__device__ __forceinline__ void rows_mfma(const Args& a, int layer, LAS unsigned char* lds, volatile LAS unsigned* MISC, gu32* ctl, int vcu, int G, int tid, int lane, int wave) {
    constexpr bool P5 = (NEO == 32); constexpr int NET = NEO / 16;
    unsigned char* ws = a.ws; bf16* X = (bf16*)(ws + WS_X); bf16* H = (bf16*)(ws + WS_H); const float* MOD = (const float*)(ws + WS_MOD);
    LAS bf16* Whi = (LAS bf16*)(lds + LR_WHI); LAS bf16* Wlo = Whi + NEO * WP; LAS float* part = (LAS float*)(lds + LR_PART); LAS float* ssx = (LAS float*)(lds + LR_SSX);
    LAS float* rstds = (LAS float*)(lds + LR_RSTD); LAS float* biasl = (LAS float*)(lds + LR_BIAS); LAS float* red = (LAS float*)(lds + LR_RED);
    const float* nw = (P5 ? a.norm2_w : a.norm1_w) + layer * D;
    const float* Wsrc = P5 ? a.w_r + (size_t)layer * D * NE : a.w_in + (size_t)layer * D * DIN + SRC_GA; const int wld = P5 ? NE : DIN;
    if (P5) { if (tid < NE) MISC[MW_HIST + tid] = 0u; }
    for (int row0 = vcu * 64; row0 < MTOK; row0 += G * 64) {
        const int b = row0 / SEQ; const float* mp = MOD + ((size_t)layer * 2 + b) * 6144; const float* scp = mp + (P5 ? 4 : 1) * D; const float* shp = mp + (P5 ? 3 : 0) * D;
        if (!P5 && layer > 0) { stage_slots(ws, row0, lds, tid); __syncthreads(); }
        { const int e = tid % NEO, kq = tid / NEO; constexpr int NPT = NTHR / NEO;
#pragma unroll 1
            for (int it0 = 0; it0 < D / NPT; it0 += 8) { float wv[8];
#pragma unroll
                for (int u = 0; u < 8; ++u) { const int k = kq + NPT * (it0 + u); wv[u] = Wsrc[(size_t)k * wld + e] * (nw[k] * (1.0f + scp[k])); }
#pragma unroll
                for (int u = 0; u < 8; ++u) { const int k = kq + NPT * (it0 + u); const unsigned hi = f2bf(wv[u]); const float wl = wv[u] - __builtin_bit_cast(float, hi << 16); Whi[e * WP + k] = (bf16)hi; Wlo[e * WP + k] = (bf16)f2bf(wl); } }
            constexpr int KP = D / NPT; float sacc = 0.f;
#pragma unroll 8
            for (int k = kq * KP; k < kq * KP + KP; ++k) sacc += shp[k] * Wsrc[(size_t)k * wld + e];
            red[kq * NEO + e] = sacc; }
        const bf16* xin = X;
        if (!P5 && layer > 0) { flat_combine<false, false>(X, X, row0, (const bf16*)(ws + WS_Y), MOD + ((size_t)(layer - 1) * 2 + b) * 6144 + 5 * D, lds, tid, lane); asm volatile("s_waitcnt vmcnt(0)" ::: "memory"); }
        __syncthreads();
        if (tid < NEO) { constexpr int NPT = NTHR / NEO; float sacc = P5 ? a.b_r[layer * NE + tid] : 0.f; for (int q = 0; q < NPT; ++q) sacc += red[q * NEO + tid]; biasl[tid] = sacc; }
        const int rg = wave >> 1, kh = wave & 1, r = lane & 15, g = lane >> 4;
        { const bf16* xr = xin + (size_t)(row0 + 16 * rg + r) * D; f32x4 acc[NET]; float ss = 0.f;
#pragma unroll
            for (int et = 0; et < NET; ++et) acc[et] = (f32x4){0.f, 0.f, 0.f, 0.f};
#pragma unroll 4
            for (int s = 16 * kh; s < 16 * kh + 16; ++s) { const int k0 = 32 * s + 8 * g; const v4u xp = *(const v4u*)(xr + k0); const unsigned xw[4] = {xp.x, xp.y, xp.z, xp.w};
#pragma unroll
                for (int j = 0; j < 4; ++j) { const float xa = __builtin_bit_cast(float, xw[j] << 16), xb = __builtin_bit_cast(float, xw[j] & 0xffff0000u); ss += xa * xa + xb * xb; }
                const pg8::bf16x8 ahi = __builtin_bit_cast(pg8::bf16x8, xp);
#pragma unroll
                for (int et = 0; et < NET; ++et) { const pg8::bf16x8 whi = ldfrag(Whi, WP, 16 * et, 32 * s, lane), wlo = ldfrag(Wlo, WP, 16 * et, 32 * s, lane);
                    acc[et] = __builtin_amdgcn_mfma_f32_16x16x32_bf16(ahi, whi, acc[et], 0, 0, 0); acc[et] = __builtin_amdgcn_mfma_f32_16x16x32_bf16(ahi, wlo, acc[et], 0, 0, 0); } }
            ss += __shfl_xor(ss, 16); ss += __shfl_xor(ss, 32);
            if (kh == 1) {
#pragma unroll
                for (int et = 0; et < NET; ++et)
#pragma unroll
                    for (int q = 0; q < 4; ++q) part[(rg * 16 + 4 * g + q) * 32 + 16 * et + r] = acc[et][q];
                if (g == 0) ssx[rg * 16 + r] = ss; }
            __syncthreads();
            if (kh == 0) { const float sst = ss + ssx[rg * 16 + r]; if (g == 0) rstds[rg * 16 + r] = 1.0f / sqrtf(sst * (1.0f / D) + EPS);
                asm volatile("s_waitcnt lgkmcnt(0)" ::: "memory");
#pragma unroll
                for (int et = 0; et < NET; ++et)
#pragma unroll
                    for (int q = 0; q < 4; ++q) { const int i = rg * 16 + 4 * g + q, e = 16 * et + r; const float v = rstds[i] * (acc[et][q] + part[i * 32 + e]) + biasl[e];
                        if (P5) part[i * 32 + e] = v; else ((float*)(ws + WS_GA))[(size_t)(row0 + i) * 16 + e] = v; }
                if (P5) { asm volatile("s_waitcnt lgkmcnt(0)" ::: "memory");
                    if (lane < 16) { const int i = rg * 16 + lane, m = row0 + i; float lv[NE];
#pragma unroll
                        for (int e = 0; e < NE; ++e) lv[e] = part[i * 32 + e];
                        float tv[4]; int te[4];
#pragma unroll
                        for (int t = 0; t < 4; ++t) { float best = -3.0e38f; int bi = 0;
#pragma unroll
                            for (int e = 0; e < NE; ++e) if (lv[e] > best) { best = lv[e]; bi = e; }
#pragma unroll
                            for (int e = 0; e < NE; ++e) if (e == bi) lv[e] = -3.0e38f;
                            tv[t] = best; te[t] = bi; }
                        const float e1 = expf(tv[1] - tv[0]), e2 = expf(tv[2] - tv[0]), e3 = expf(tv[3] - tv[0]); const float inv = 1.0f / (1.0f + e1 + e2 + e3);
                        *(f32x4*)((float*)(ws + WS_TOPW) + (size_t)m * 4) = (f32x4){inv, e1 * inv, e2 * inv, e3 * inv};
#pragma unroll
                        for (int t = 0; t < 4; ++t) { const unsigned rk = __hip_atomic_fetch_add((LAS unsigned*)&MISC[MW_HIST + te[t]], 1u, __ATOMIC_RELAXED, __HIP_MEMORY_SCOPE_WORKGROUP);
                            ((LAS unsigned*)(lds + LR_SLT))[i * 4 + t] = ((unsigned)te[t] << 16) | rk; } } } }
            __syncthreads(); }
        if (P5) { if (tid < NE) { const unsigned hcnt = MISC[MW_HIST + tid]; MISC[MW_BASE + tid] = hcnt ? atomicAdd((unsigned*)(ctl + CW_CNT + layer * NE + tid), hcnt) : 0u; }
            __syncthreads();
            if (tid < 256) { LAS unsigned* sl = (LAS unsigned*)(lds + LR_SLT) + tid; const unsigned v = *sl, e = v >> 16; const unsigned slot = (e << ECAP_SH) + MISC[MW_BASE + e] + (v & 0xffffu);
                *sl = slot; ((int*)(ws + WS_SLOT))[(size_t)row0 * 4 + tid] = (int)slot; }
            if (tid < NE) MISC[MW_HIST + tid] = 0u;
            __syncthreads(); }
        if (P5) { const int c4 = tid & 255, rsub = tid >> 8; const f32x4 w = *(const f32x4*)(nw + 4 * c4), s1 = *(const f32x4*)(scp + 4 * c4), s0 = *(const f32x4*)(shp + 4 * c4); const f32x4 ws1 = w * (s1 + 1.0f);
            unsigned char* A1 = ws + WS_A1;
#pragma unroll 8
            for (int it = 0; it < 32; ++it) { const int i = 2 * it + rsub; const uint2 xp = *(const uint2*)(xin + (size_t)(row0 + i) * D + 4 * c4);
                const f32x4 v = (f32x4){__builtin_bit_cast(float, xp.x << 16), __builtin_bit_cast(float, xp.x & 0xffff0000u), __builtin_bit_cast(float, xp.y << 16), __builtin_bit_cast(float, xp.y & 0xffff0000u)} * rstds[i] * ws1 + s0;
                const int pw = pk4_fp8(v[0] * S8_H, v[1] * S8_H, v[2] * S8_H, v[3] * S8_H); const v4u sl = *(const LAS v4u*)(lds + LR_SLT + 16 * i);
                *(int*)(A1 + (size_t)sl.x * D + 4 * c4) = pw; *(int*)(A1 + (size_t)sl.y * D + 4 * c4) = pw; *(int*)(A1 + (size_t)sl.z * D + 4 * c4) = pw; *(int*)(A1 + (size_t)sl.w * D + 4 * c4) = pw; } }
        else flat_modulate<F8_IN>(xin, row0, rstds, nw, scp, shp, H, tid);
        __syncthreads();
    }
}

__device__ __forceinline__ void final_rows(const Args& a, LAS unsigned char* lds, int vcu, int G, int tid, int lane) {
    unsigned char* ws = a.ws; const bf16* X = (const bf16*)(ws + WS_X); const float* MOD = (const float*)(ws + WS_MOD); LAS float* ssr = (LAS float*)(lds + LR_SSR);
    for (int row0 = vcu * 64; row0 < MTOK; row0 += G * 64) { const int b = row0 / SEQ;
        stage_slots(ws, row0, lds, tid); if (tid < 64) ssr[tid] = 0.f;
        __syncthreads();
        flat_combine<true, true>(X, a.out, row0, (const bf16*)(ws + WS_Y), MOD + ((size_t)(DEPTH - 1) * 2 + b) * 6144 + 5 * D, lds, tid, lane);
        asm volatile("s_waitcnt vmcnt(0)" ::: "memory");
        __syncthreads();
        { const int c4 = tid & 255, rsub = tid >> 8; const f32x4 w = *(const f32x4*)(a.final_norm_w + 4 * c4);
#pragma unroll 8
            for (int it = 0; it < 32; ++it) { const int i = 2 * it + rsub; float* op = a.out + (size_t)(row0 + i) * D + 4 * c4; const float rstd = 1.0f / sqrtf(ssr[i] * (1.0f / D) + EPS); *(f32x4*)op = *(const f32x4*)op * rstd * w; } }
        __syncthreads();
    }
}

__device__ __noinline__ void moe_tables(gu32* ctl, int layer, volatile LAS unsigned* MISC, int tid) {
    if (tid < NE) MISC[MW_CNT + tid] = __hip_atomic_load(ctl + CW_CNT + layer * NE + tid, RLX_AGENT);
    __syncthreads();
    if (tid == 0) { unsigned n = 0;
        for (int e = 0; e < NE; ++e) { const unsigned nt = (MISC[MW_CNT + e] + 255u) >> 8; for (unsigned t = 0; t < nt; ++t) MISC[MW_TILE + n + t] = (unsigned)(e * 64) + t; n += nt; }
        MISC[MW_NRT] = n; }
    __syncthreads();
}

constexpr int BP = 72;
template <int TYPE> struct MixCfg { static constexpr int DK = (TYPE == 1) ? 64 : 48, DV = (TYPE == 1) ? 64 : 96, NC = 4 * DK, NV = 4 * DV;
    static constexpr int STOFF = (TYPE == 0) ? ST_GLA : (TYPE == 1) ? ST_HG : ST_RET, COFF = (TYPE == 0) ? 0 : 192;
    static constexpr int CQ = (TYPE == 0) ? C_GQ : (TYPE == 1) ? C_HQ : C_RQ, CK = (TYPE == 0) ? C_GK : (TYPE == 1) ? C_HF : C_RK, CV = (TYPE == 0) ? C_GV : (TYPE == 1) ? C_HI : C_RV, CG = (TYPE == 0) ? C_GG : (TYPE == 1) ? C_HG : C_RG;
    static constexpr int MIXOFF = (TYPE == 0) ? 0 : (TYPE == 1) ? 384 : 640, KOFF = (TYPE == 0) ? 0 : (TYPE == 1) ? 192 : 448; };
__device__ __forceinline__ float fast_logsig(float x) { x = fmaxf(x, -80.f); return -__logf(1.0f + __expf(-x)); }
__device__ __forceinline__ float ret_lg(int h) { return logf(1.0f - exp2f(-5.0f - (float)h)); }

template <int NV>
__device__ __forceinline__ void stage_vt(const bf16* pv  , LAS bf16* VT, int tid) {
    constexpr int NIT = (64 * (NV / 8)) / NTHR; static_assert((64 * (NV / 8)) % NTHR == 0, "stage_vt");
    v4u p[NIT];
#pragma unroll
    for (int it = 0; it < NIT; ++it) { const int idx = tid + NTHR * it, j = idx & 63, ch = idx >> 6; p[it] = *(const v4u*)(pv + (size_t)j * NPROJ + 8 * ch); }
#pragma unroll
    for (int it = 0; it < NIT; ++it) { const int idx = tid + NTHR * it, j = idx & 63, ch = idx >> 6; LAS bf16* d = VT + (8 * ch) * BP + j;
        d[0 * BP] = (bf16)(p[it].x & 0xffffu); d[1 * BP] = (bf16)(p[it].x >> 16); d[2 * BP] = (bf16)(p[it].y & 0xffffu); d[3 * BP] = (bf16)(p[it].y >> 16);
        d[4 * BP] = (bf16)(p[it].z & 0xffffu); d[5 * BP] = (bf16)(p[it].z >> 16); d[6 * BP] = (bf16)(p[it].w & 0xffffu); d[7 * BP] = (bf16)(p[it].w >> 16); }
}

constexpr int LA_KT = 0, LA_VT = 36864, LA_TOT = 92160, LA_GA = 94208, LA_KTT = 98304, KTP = 264;
template <int TYPE>
__device__ __forceinline__ void mixa_batch(const Args& a, int layer, int unit, LAS unsigned char* lds, int tid, int lane, int wave) {
    asm volatile("" : "+v"(tid), "+v"(lane));
    typedef MixCfg<TYPE> C; constexpr int DK = C::DK, DV = C::DV, NC = C::NC, NV = C::NV;
    unsigned char* ws = a.ws; const bf16* PROJ = (const bf16*)(ws + WS_PROJ); float* CUM = (float*)(ws + WS_CUM); float* DVEC = (float*)(ws + WS_DVEC) + (size_t)unit * NDV;
    bf16* U = (bf16*)(ws + WS_U) + (size_t)unit * ST_TOT + C::STOFF;
    LAS bf16* KT = (LAS bf16*)(lds + LA_KT); LAS bf16* VT = (LAS bf16*)(lds + LA_VT); LAS float* TOT = (LAS float*)(lds + LA_TOT); const LAS float* GAs = (const LAS float*)(lds + LA_GA);
    const int row0 = unit * CH;
    stage_vt<NV>(PROJ + (size_t)row0 * NPROJ + C::CV, VT, tid);
    const bool act = tid < 2 * NC; const int c = act ? tid % NC : 0, half = act ? tid / NC : 0, h = c / DK, d = c - h * DK;
    float cum[32]; float tot = 0.f;
    float w2[16], b2 = 0.f, lbv = 0.f, lg = 0.f, sg = 0.f; int f = 0, d2 = 0;
    if (act) {
        if constexpr (TYPE == 0) { b2 = a.gla_ba2[layer * 192 + c];
#pragma unroll
            for (int r = 0; r < 16; ++r) w2[r] = a.gla_wa2[(layer * 16 + r) * 192 + c]; }
        if constexpr (TYPE == 1) lbv = ((const float*)(ws + WS_LB))[layer * 256 + c];
        if constexpr (TYPE == 2) { lg = ret_lg(h); f = (d < 24) ? d : d - 24; d2 = (d < 24) ? d + 24 : d - 24; sg = (d < 24) ? -1.f : 1.f; }
#pragma unroll
        for (int gq = 0; gq < 2; ++gq) {
            bf16 hraw[16];
            if constexpr (TYPE == 1) {
#pragma unroll
                for (int i = 0; i < 16; ++i) hraw[i] = PROJ[(size_t)(row0 + 32 * half + 16 * gq + i) * NPROJ + C_HF + c]; }
#pragma unroll
            for (int ii = 0; ii < 16; ++ii) { const int i = 16 * gq + ii, t = 32 * half + i; float g;
                if constexpr (TYPE == 0) { float pre = b2;
#pragma unroll
                    for (int r = 0; r < 16; ++r) pre += GAs[t * 16 + r] * w2[r];
                    g = fast_logsig(pre) * (1.0f / 16.0f); }
                else if constexpr (TYPE == 1) { const float hf = fminf(fmaxf(bf2f(hraw[ii]), -80.f), 80.f); const float sgm = 1.0f / (1.0f + __expf(-hf));
                    g = __logf(lbv + (1.0f - lbv) * sgm); }
                else g = lg;
                tot += g; cum[i] = tot;
                if constexpr (TYPE == 0) { if ((ii & 3) == 3) asm volatile("" ::: "memory"); } } }
        TOT[c * 2 + half] = tot;
    }
    __syncthreads();
    if (act) { const float t0 = TOT[c * 2], t1 = TOT[c * 2 + 1]; const float off = half ? t0 : 0.f, last = t0 + t1;
#pragma unroll
        for (int hq = 0; hq < 4; ++hq) {
            bf16 ka[8], kb[8]; float cs[8], sn[8];
            if constexpr (TYPE != 1) {
#pragma unroll
                for (int i = 0; i < 8; ++i) { const size_t row = (size_t)(row0 + 32 * half + 8 * hq + i); const bf16* pr = PROJ + row * NPROJ;
                    if constexpr (TYPE == 0) ka[i] = pr[C_GK + c];
                    else { const float* rp = (const float*)(ws + WS_ROPE) + row * 48; ka[i] = pr[C_RK + h * 48 + d]; kb[i] = pr[C_RK + h * 48 + d2]; cs[i] = rp[f]; sn[i] = rp[24 + f]; } } }
            float kt[8];
#pragma unroll
            for (int j = 0; j < 8; ++j) { const int i = 8 * hq + j; const float cm = cum[i] + off; const size_t row = (size_t)(row0 + 32 * half + i); float k;
                if constexpr (TYPE == 0) k = bf2f(ka[j]);
                else if constexpr (TYPE == 1) k = 1.0f - __expf(cum[i] - (i > 0 ? cum[i - 1] : 0.f));
                else k = bf2f(ka[j]) * cs[j] + sg * bf2f(kb[j]) * sn[j];
                if constexpr (TYPE != 2) CUM[row * NDV + C::COFF + c] = cm;
                { const float eb = cum[(i < 16) ? 15 : 31] + off;
                  ((LAS bf16*)(lds + LA_KTT))[(32 * half + i) * KTP + c] = (bf16)f2bf(k * __expf(eb - cm)); }
                kt[j] = k * __expf(last - cm); }
            v4u w; w.x = pk2(kt[0], kt[1]); w.y = pk2(kt[2], kt[3]); w.z = pk2(kt[4], kt[5]); w.w = pk2(kt[6], kt[7]);
            *(LAS v4u*)(KT + c * BP + 32 * half + 8 * hq) = w; }
        if (TYPE != 2 && half == 0) DVEC[C::COFF + c] = __expf(last);
    }
    __syncthreads();
    { constexpr int CPR = NC / 8;
#pragma unroll
        for (int it = 0; it < (64 * CPR) / NTHR; ++it) { const int idx = tid + NTHR * it, t = idx / CPR, ch = idx - t * CPR;
            *(v4u*)((bf16*)(ws + WS_KT) + (size_t)(row0 + t) * NKT + C::KOFF + 8 * ch) = *(const LAS v4u*)((const LAS bf16*)(lds + LA_KTT) + t * KTP + 8 * ch); } }
    constexpr int TD = DK / 16, NT = (DV / 16) * TD;
    for (int ti = wave; ti < 4 * NT; ti += NWAVES) { const int hh = ti / NT, tr = ti - hh * NT, te = tr / TD, td = tr - te * TD; f32x4 acc = {0.f, 0.f, 0.f, 0.f};
#pragma unroll
        for (int kk = 0; kk < 2; ++kk) acc = __builtin_amdgcn_mfma_f32_16x16x32_bf16(ldfrag(VT, BP, hh * DV + te * 16, kk * 32, lane), ldfrag(KT, BP, hh * DK + td * 16, kk * 32, lane), acc, 0, 0, 0);
        bf16* Uh = U + hh * DK * DV;
#pragma unroll
        for (int r = 0; r < 4; ++r) Uh[(te * 16 + (lane >> 4) * 4 + r) * DK + td * 16 + (lane & 15)] = (bf16)f2bf(acc[r]); }
    __syncthreads();
}
__device__ __forceinline__ void p3a_summaries(const Args& a, int layer, LAS unsigned char* lds, int vcu, int G, int tid, int lane, int wave) {
    for (int unit = vcu; unit < NUNIT; unit += G) {
        { LAS float* GAs = (LAS float*)(lds + LA_GA); const float* GA = (const float*)(a.ws + WS_GA); for (int i = tid; i < CH * 16; i += NTHR) GAs[i] = GA[(size_t)unit * CH * 16 + i]; }
        __syncthreads();
        mixa_batch<0>(a, layer, unit, lds, tid, lane, wave);
        mixa_batch<1>(a, layer, unit, lds, tid, lane, wave);
        mixa_batch<2>(a, layer, unit, lds, tid, lane, wave);
    }
}

__device__ __forceinline__ void p3b_scan(const Args& a, int vcu, int G, int tid) {
    unsigned char* ws = a.ws; const bf16* U = (const bf16*)(ws + WS_U); const float* DVEC = (const float*)(ws + WS_DVEC); bf16* SP = (bf16*)(ws + WS_SP);
    for (int gid = vcu * NTHR + tid; gid < BATCH * ST_TOT; gid += G * NTHR) {
        const int b = gid / ST_TOT, el = gid - b * ST_TOT;
        int di = -1; float cdec = 0.f;
        if (el < ST_HG) { const int h = el / 4608, d = (el - h * 4608) % 48; di = h * 48 + d; }
        else if (el < ST_RET) { const int r = el - ST_HG, h = r / 4096, d = r % 64; di = 192 + h * 64 + d; }
        else { const int h = (el - ST_RET) / 4608; cdec = expf(64.0f * logf(1.0f - exp2f(-5.0f - (float)h))); }
        const bf16* up = U + (size_t)b * NCH * ST_TOT + el; const float* dp = DVEC + (size_t)b * NCH * NDV + (di < 0 ? 0 : di); bf16* sp = SP + (size_t)b * NCH * ST_TOT + el;
        float s = 0.f;
#pragma unroll 1
        for (int n0 = 0; n0 < NCH; n0 += 32) { float u[32], dc[32];
#pragma unroll
            for (int i = 0; i < 32; ++i) { u[i] = bf2f(up[(size_t)(n0 + i) * ST_TOT]); dc[i] = (di < 0) ? cdec : dp[(size_t)(n0 + i) * NDV]; }
#pragma unroll
            for (int i = 0; i < 32; ++i) { sp[(size_t)(n0 + i) * ST_TOT] = (bf16)f2bf(s); s = dc[i] * s + u[i]; } }
    }
}

#ifndef SUB_MASK
#define SUB_MASK 0
#endif
#define SUBSTRETCH(bit, t0_) do { if ((SUB_MASK >> (bit)) & 1) { const unsigned long long t1_ = __builtin_amdgcn_s_memrealtime(); while (__builtin_amdgcn_s_memrealtime() - t1_ < t1_ - (t0_)) __builtin_amdgcn_s_sleep(8); } } while (0)
constexpr int LC_VT = 0, LC_ST = 55296, LC_AB = 110592, OBP = 104, LC_EC = 137216;
template <int TYPE, bool ISQ>
__device__ __forceinline__ void mix_frag(const Args& a, int h, size_t row, int t, int d0, float (&x)[8], float (&cm)[8]) {
    typedef MixCfg<TYPE> C; constexpr int DK = C::DK;
    unsigned char* ws = a.ws; const bf16* pr = (const bf16*)(ws + WS_PROJ) + row * NPROJ;
    if constexpr (TYPE == 0) {
        const v4u p = *(const v4u*)(pr + (ISQ ? C_GQ : C_GK) + h * DK + d0); const unsigned pw[4] = {p.x, p.y, p.z, p.w};
        const float* cp = (const float*)(ws + WS_CUM) + row * NDV + h * DK + d0; const f32x4 c0 = *(const f32x4*)cp, c1 = *(const f32x4*)(cp + 4);
#pragma unroll
        for (int j = 0; j < 4; ++j) { x[2 * j] = __builtin_bit_cast(float, pw[j] << 16); x[2 * j + 1] = __builtin_bit_cast(float, pw[j] & 0xffff0000u); cm[j] = c0[j]; cm[4 + j] = c1[j]; }
        if (ISQ) {
#pragma unroll
            for (int j = 0; j < 8; ++j) x[j] *= 0.14433756729740643f; }
    } else if constexpr (TYPE == 1) {
        const float* cp = (const float*)(ws + WS_CUM) + row * NDV + 192 + h * DK + d0; const f32x4 c0 = *(const f32x4*)cp, c1 = *(const f32x4*)(cp + 4);
#pragma unroll
        for (int j = 0; j < 4; ++j) { cm[j] = c0[j]; cm[4 + j] = c1[j]; }
        if (ISQ) { const v4u p = *(const v4u*)(pr + C_HQ + h * DK + d0); const unsigned pw[4] = {p.x, p.y, p.z, p.w};
#pragma unroll
            for (int j = 0; j < 4; ++j) { x[2 * j] = __builtin_bit_cast(float, pw[j] << 16); x[2 * j + 1] = __builtin_bit_cast(float, pw[j] & 0xffff0000u); } }
        else { f32x4 p0 = {0.f, 0.f, 0.f, 0.f}, p1 = {0.f, 0.f, 0.f, 0.f}; if (t > 0) { p0 = *(const f32x4*)(cp - NDV); p1 = *(const f32x4*)(cp - NDV + 4); }
#pragma unroll
            for (int j = 0; j < 4; ++j) { x[j] = 1.0f - __expf(c0[j] - p0[j]); x[4 + j] = 1.0f - __expf(c1[j] - p1[j]); } }
    } else {
        const int f0 = (d0 < 24) ? d0 : d0 - 24, dp = (d0 < 24) ? d0 + 24 : d0 - 24; const float sg = (d0 < 24) ? -1.f : 1.f;
        const int cb = (ISQ ? C_RQ : C_RK) + h * DK; const v4u p = *(const v4u*)(pr + cb + d0), pp = *(const v4u*)(pr + cb + dp); const unsigned pw[4] = {p.x, p.y, p.z, p.w}, qw[4] = {pp.x, pp.y, pp.z, pp.w};
        const float* rp = (const float*)(ws + WS_ROPE) + row * 48; const f32x4 cs0 = *(const f32x4*)(rp + f0), cs1 = *(const f32x4*)(rp + f0 + 4), sn0 = *(const f32x4*)(rp + 24 + f0), sn1 = *(const f32x4*)(rp + 24 + f0 + 4);
        const float cmv = (float)(t + 1) * ret_lg(h);
#pragma unroll
        for (int j = 0; j < 4; ++j) { const float xa = __builtin_bit_cast(float, pw[j] << 16), xb = __builtin_bit_cast(float, pw[j] & 0xffff0000u), ya = __builtin_bit_cast(float, qw[j] << 16), yb = __builtin_bit_cast(float, qw[j] & 0xffff0000u);
            const float ca = (j < 2) ? cs0[2 * j] : cs1[2 * j - 4], cb2 = (j < 2) ? cs0[2 * j + 1] : cs1[2 * j - 3], sa = (j < 2) ? sn0[2 * j] : sn1[2 * j - 4], sb = (j < 2) ? sn0[2 * j + 1] : sn1[2 * j - 3];
            x[2 * j] = xa * ca + sg * ya * sa; x[2 * j + 1] = xb * cb2 + sg * yb * sb; cm[2 * j] = cmv; cm[2 * j + 1] = cmv; }
        if (ISQ) {
#pragma unroll
            for (int j = 0; j < 8; ++j) x[j] *= 0.14433756729740643f; }
    }
}

template <int TYPE>
__device__ __forceinline__ void mixc_batch(const Args& a, int layer, int unit, LAS unsigned char* lds, int tid, int lane, int wave) {
    asm volatile("" : "+v"(tid), "+v"(lane));
    typedef MixCfg<TYPE> C; constexpr int DK = C::DK, DV = C::DV, NV = C::NV, TE = DV / 16;
    unsigned char* ws = a.ws; const bf16* PROJ = (const bf16*)(ws + WS_PROJ); bf16* MIX = (bf16*)(ws + WS_MIX);
    LAS bf16* VT = (LAS bf16*)(lds + LC_VT); LAS bf16* ST = (LAS bf16*)(lds + LC_ST); LAS bf16* AB = (LAS bf16*)(lds + LC_AB) + wave * 16 * OBP;
    const int row0 = unit * CH;
    const unsigned long long ts0_ = SUB_MASK ? __builtin_amdgcn_s_memrealtime() : 0ull;
    stage_vt<NV>(PROJ + (size_t)row0 * NPROJ + C::CV, VT, tid);
    SUBSTRETCH(3, ts0_);
    const unsigned long long ts3_ = SUB_MASK ? __builtin_amdgcn_s_memrealtime() : 0ull;
    { const bf16* SPu = (const bf16*)(ws + WS_SP) + (size_t)unit * ST_TOT + C::STOFF;
        constexpr int NIS = (NV * 8) / NTHR; static_assert((NV * 8) % NTHR == 0, "ST staging"); v4u sw[NIS];
#pragma unroll
        for (int it = 0; it < NIS; ++it) { const int idx = tid + NTHR * it, er = idx >> 3, ch = idx & 7; sw[it] = (v4u){0u, 0u, 0u, 0u}; if (ch * 8 < DK) sw[it] = *(const v4u*)(SPu + (size_t)er * DK + ch * 8); }
#pragma unroll
        for (int it = 0; it < NIS; ++it) { const int idx = tid + NTHR * it, er = idx >> 3, ch = idx & 7; *(LAS v4u*)(ST + er * BP + ch * 8) = sw[it]; } }
    SUBSTRETCH(4, ts3_);
    SUBSTRETCH(0, ts0_);
    if constexpr (TYPE != 2) { LAS float* EC = (LAS float*)(lds + LC_EC);
        for (int idx = tid; idx < 4 * C::NC; idx += NTHR) { const int jb = idx / C::NC, cc = idx - jb * C::NC; EC[jb * 256 + cc] = ((const float*)(ws + WS_CUM))[(size_t)(row0 + 16 * jb + 15) * NDV + C::COFF + cc]; } }
    __syncthreads();
    const unsigned long long ts1_ = SUB_MASK ? __builtin_amdgcn_s_memrealtime() : 0ull;
    const int h = wave >> 1, hsel = wave & 1, r = lane & 15, g = lane >> 4;
    const LAS bf16* STh = ST + h * DV * BP; const LAS bf16* VTh = VT + h * DV * BP;
    const float* CUMp = (const float*)(ws + WS_CUM);
    constexpr int NCHK = DV / 8, NOC = (16 * NCHK) / 64;
#pragma unroll 1
    for (int ib = 0; ib < 2; ++ib) { const int I = ib ? 3 - hsel : hsel;
        pg8::bf16x8 qh[2], qt[2]; float refv[2][8], qhf[2][8];
#pragma unroll
        for (int s = 0; s < 2; ++s) { const int d0 = 32 * s + 8 * g; const bool valid = d0 < DK; const int d0c = valid ? d0 : 0;
            float x[8], cm[8]; mix_frag<TYPE, true>(a, h, (size_t)(row0 + 16 * I + r), 16 * I + r, d0c, x, cm);
            if constexpr (TYPE == 2) {
#pragma unroll
                for (int j = 0; j < 8; ++j) refv[s][j] = (float)(16 * I) * ret_lg(h);
            } else { if (I > 0) { const float* cp = CUMp + (size_t)(row0 + 16 * I - 1) * NDV + C::COFF + h * DK + d0c; const f32x4 c0 = *(const f32x4*)cp, c1 = *(const f32x4*)(cp + 4);
#pragma unroll
                    for (int j = 0; j < 4; ++j) { refv[s][j] = c0[j]; refv[s][4 + j] = c1[j]; } }
                else {
#pragma unroll
                    for (int j = 0; j < 8; ++j) refv[s][j] = 0.f; } }
            float xt[8];
#pragma unroll
            for (int j = 0; j < 8; ++j) { qhf[s][j] = valid ? x[j] * __expf(cm[j] - refv[s][j]) : 0.f; xt[j] = valid ? x[j] * __expf(cm[j]) : 0.f; }
            qh[s] = pack8(qhf[s]); qt[s] = pack8(xt); }
        v4u kf[4][2];
#pragma unroll
        for (int J = 0; J < 4; ++J) { const int Jc = (J < I) ? J : I; const size_t rowJ = (size_t)(row0 + 16 * Jc + r);
#pragma unroll
            for (int s = 0; s < 2; ++s) { const int d0 = 32 * s + 8 * g; const int d0c = (d0 < DK) ? d0 : 0;
                kf[J][s] = *(const v4u*)((const bf16*)(ws + WS_KT) + rowJ * NKT + C::KOFF + h * DK + d0c); } }
#pragma unroll
        for (int J = 0; J < 4; ++J) { if (J <= I) { f32x4 acc = {0.f, 0.f, 0.f, 0.f};
#pragma unroll
            for (int s = 0; s < 2; ++s) { pg8::bf16x8 qop;
                { float xq[8], ej[8]; const int d0 = 32 * s + 8 * g; const int d0c = (d0 < DK) ? d0 : 0;
                    if constexpr (TYPE == 2) {
#pragma unroll
                        for (int j = 0; j < 8; ++j) ej[j] = (float)(16 * (J + 1)) * ret_lg(h); }
                    else { const LAS float* ep = (const LAS float*)(lds + LC_EC) + J * 256 + h * DK + d0c; const f32x4 e0 = *(const LAS f32x4*)ep, e1 = *(const LAS f32x4*)(ep + 4);
#pragma unroll
                        for (int j = 0; j < 4; ++j) { ej[j] = e0[j]; ej[4 + j] = e1[j]; } }
#pragma unroll
                    for (int j = 0; j < 8; ++j) xq[j] = qhf[s][j] * __expf(fminf(refv[s][j] - ej[j], 80.f));
                    qop = pack8(xq); }
                acc = __builtin_amdgcn_mfma_f32_16x16x32_bf16(qop, __builtin_bit_cast(pg8::bf16x8, kf[J][s]), acc, 0, 0, 0); }
#pragma unroll
            for (int q = 0; q < 4; ++q) { const int i = 4 * g + q; const float v = (J < I || r <= i) ? acc[q] : 0.f; AB[i * BP + 16 * J + r] = (bf16)f2bf(v); } } }
        if ((I & 1) == 0) {
#pragma unroll
            for (int q = 0; q < 4; ++q) AB[(4 * g + q) * BP + 16 * (I + 1) + r] = (bf16)0; }
        asm volatile("s_waitcnt lgkmcnt(0)" ::: "memory");
        const pg8::bf16x8 ah0 = *(const LAS pg8::bf16x8*)(AB + r * BP + 8 * g), ah1 = *(const LAS pg8::bf16x8*)(AB + r * BP + 32 + 8 * g);
        f32x4 o[TE];
#pragma unroll
        for (int te = 0; te < TE; ++te) { f32x4 acc = {0.f, 0.f, 0.f, 0.f};
            acc = __builtin_amdgcn_mfma_f32_16x16x32_bf16(qt[0], ldfrag(STh, BP, te * 16, 0, lane), acc, 0, 0, 0);
            acc = __builtin_amdgcn_mfma_f32_16x16x32_bf16(qt[1], ldfrag(STh, BP, te * 16, 32, lane), acc, 0, 0, 0);
            acc = __builtin_amdgcn_mfma_f32_16x16x32_bf16(ah0, ldfrag(VTh, BP, te * 16, 0, lane), acc, 0, 0, 0);
            if (I >= 2) acc = __builtin_amdgcn_mfma_f32_16x16x32_bf16(ah1, ldfrag(VTh, BP, te * 16, 32, lane), acc, 0, 0, 0);
            o[te] = acc; }
        const unsigned long long ts2_ = SUB_MASK ? __builtin_amdgcn_s_memrealtime() : 0ull;
#pragma unroll
        for (int q = 0; q < 4; ++q) { float s1 = 0.f, s2 = 0.f;
#pragma unroll
            for (int te = 0; te < TE; ++te) { s1 += o[te][q]; s2 += o[te][q] * o[te][q]; }
#pragma unroll
            for (int m = 1; m < 16; m <<= 1) { s1 += __shfl_xor(s1, m); s2 += __shfl_xor(s2, m); }
            float mean = 0.f, rstd;
            if constexpr (TYPE == 2) { mean = s1 * (1.0f / DV); rstd = 1.0f / sqrtf(fmaxf(s2 * (1.0f / DV) - mean * mean, 0.f) + EPS); }
            else rstd = 1.0f / sqrtf(s2 * (1.0f / DV) + EPS);
#pragma unroll
            for (int te = 0; te < TE; ++te) AB[(4 * g + q) * OBP + te * 16 + r] = (bf16)f2bf((o[te][q] - mean) * rstd); }
        asm volatile("s_waitcnt lgkmcnt(0)" ::: "memory");
#pragma unroll 1
        for (int i = 0; i < NOC; ++i) { const int cidx = lane + 64 * i, orow = cidx / NCHK, ch = cidx - orow * NCHK; const size_t row = (size_t)(row0 + 16 * I + orow);
            const v4u ov = *(const LAS v4u*)(AB + orow * OBP + 8 * ch); const v4u gv = *(const v4u*)(PROJ + row * NPROJ + C::CG + h * DV + 8 * ch);
            const unsigned ow[4] = {ov.x, ov.y, ov.z, ov.w}, gw[4] = {gv.x, gv.y, gv.z, gv.w}; float res[8];
            f32x4 w0 = {1.f, 1.f, 1.f, 1.f}, w1 = {1.f, 1.f, 1.f, 1.f};
            if constexpr (TYPE == 0) { const float* wp = a.gla_norm_w + layer * 384 + h * 96 + 8 * ch; w0 = *(const f32x4*)wp; w1 = *(const f32x4*)(wp + 4); }
            if constexpr (TYPE == 1) { const float* wp = a.hg_norm_w + layer * 256 + h * 64 + 8 * ch; w0 = *(const f32x4*)wp; w1 = *(const f32x4*)(wp + 4); }
#pragma unroll
            for (int j = 0; j < 4; ++j) { const float oa = __builtin_bit_cast(float, ow[j] << 16), ob = __builtin_bit_cast(float, ow[j] & 0xffff0000u), ga = __builtin_bit_cast(float, gw[j] << 16), gb = __builtin_bit_cast(float, gw[j] & 0xffff0000u);
                const float wa = (j < 2) ? w0[2 * j] : w1[2 * j - 4], wb = (j < 2) ? w0[2 * j + 1] : w1[2 * j - 3];
                const float sa = 1.0f / (1.0f + __expf(-ga)), sb = 1.0f / (1.0f + __expf(-gb));
                res[2 * j] = oa * wa * ((TYPE == 1) ? sa : ga * sa); res[2 * j + 1] = ob * wb * ((TYPE == 1) ? sb : gb * sb); }
            if (F8_OUT) { typedef int i32x2 __attribute__((ext_vector_type(2)));
                *(i32x2*)((unsigned char*)MIX + row * D + C::MIXOFF + h * DV + 8 * ch) = (i32x2){pk4_fp8(res[0] * S8_M, res[1] * S8_M, res[2] * S8_M, res[3] * S8_M), pk4_fp8(res[4] * S8_M, res[5] * S8_M, res[6] * S8_M, res[7] * S8_M)}; }
            else { v4u w; w.x = pk2(res[0], res[1]); w.y = pk2(res[2], res[3]); w.z = pk2(res[4], res[5]); w.w = pk2(res[6], res[7]); *(v4u*)(MIX + row * D + C::MIXOFF + h * DV + 8 * ch) = w; } }
        SUBSTRETCH(2, ts2_);
    }
    SUBSTRETCH(1, ts1_);
    __syncthreads();
}
__device__ __forceinline__ void p3c_outputs(const Args& a, int layer, LAS unsigned char* lds, int vcu, int G, int tid, int lane, int wave) {
    for (int unit = vcu; unit < NUNIT; unit += G) {
        mixc_batch<0>(a, layer, unit, lds, tid, lane, wave);
        mixc_batch<1>(a, layer, unit, lds, tid, lane, wave);
        mixc_batch<2>(a, layer, unit, lds, tid, lane, wave);
    }
}


constexpr int MW_ARGS = 800;
__device__ __forceinline__ const void* ld_argp(const volatile LAS unsigned* T, int i) {
    const unsigned lo = __builtin_amdgcn_readfirstlane(T[2 * i]), hi = __builtin_amdgcn_readfirstlane(T[2 * i + 1]);
    return (const void*)(((unsigned long long)hi << 32) | lo);
}
__device__ __forceinline__ Args load_args(LAS unsigned char* lds) {
    const volatile LAS unsigned* T = (const volatile LAS unsigned*)(lds + MISC_OFF) + MW_ARGS;
    Args a;
    a.x = (const float*)ld_argp(T, 0); a.c = (const float*)ld_argp(T, 1); a.pos = (const int*)ld_argp(T, 2); a.w_mod = (const float*)ld_argp(T, 3); a.b_mod = (const float*)ld_argp(T, 4);
    a.norm1_w = (const float*)ld_argp(T, 5); a.w_in = (const float*)ld_argp(T, 6); a.gla_wa2 = (const float*)ld_argp(T, 7); a.gla_ba2 = (const float*)ld_argp(T, 8); a.hg_lb = (const float*)ld_argp(T, 9);
    a.gla_norm_w = (const float*)ld_argp(T, 10); a.hg_norm_w = (const float*)ld_argp(T, 11); a.w_out = (const float*)ld_argp(T, 12); a.norm2_w = (const float*)ld_argp(T, 13); a.w_r = (const float*)ld_argp(T, 14);
    a.b_r = (const float*)ld_argp(T, 15); a.w_gu = (const float*)ld_argp(T, 16); a.b_gu = (const float*)ld_argp(T, 17); a.w_dn = (const float*)ld_argp(T, 18); a.b_dn = (const float*)ld_argp(T, 19);
    a.final_norm_w = (const float*)ld_argp(T, 20); a.out = (float*)ld_argp(T, 21); a.ws = (unsigned char*)ld_argp(T, 22); a.ph_lo = 0; a.ph_hi = 0;
    return a;
}
#define PH_CTX() { unsigned l_ = (unsigned)(size_t)lds; asm volatile("" : "+s"(l_)); lds = (LAS unsigned char*)(size_t)l_; } const Args args = load_args(lds); volatile LAS unsigned* MISC = (volatile LAS unsigned*)(lds + MISC_OFF); int tid_ = wv * 64 + (int)__builtin_amdgcn_mbcnt_hi(~0u, __builtin_amdgcn_mbcnt_lo(~0u, 0u)); asm volatile("" : "+v"(tid_)); const int tid = tid_, lane = tid & 63, wave = __builtin_amdgcn_readfirstlane(tid >> 6); \
    const int G = gridDim.x; const int bx = blockIdx.x; const int vcu = (G % 8 == 0) ? (bx % 8) * (G / 8) + bx / 8 : bx; unsigned char* ws = args.ws; gu32* ctl = (gu32*)(ws + WS_CTL); \
    (void)MISC; (void)lane; (void)wave; (void)vcu; (void)ctl; (void)bx; (void)tid
__device__ __forceinline__ void ph_p0(LAS unsigned char* lds, int wv) { PH_CTX(); p0_prologue(args, lds, vcu, G, tid, lane, wave); }
__device__ __forceinline__ void ph_p1(LAS unsigned char* lds, int wv, int layer_) { int layer = __builtin_amdgcn_readfirstlane(layer_); asm volatile("" : "+s"(layer)); PH_CTX();
    if (layer > 0) { moe_tables(ctl, layer - 1, MISC, tid); const int nrt = __builtin_amdgcn_readfirstlane((int)MISC[MW_NRT]);
        const int done = conv_t2(G) + conv_idle(nrt * 8, G) * NWAVES * CB7 + conv_idle(nrt * 4, G) * NWAVES * CB8; LAS float* scr = (LAS float*)(lds + wave * 16640);
        for (int it = done + vcu * NWAVES + wave; it < IT_LAYER; it += G * NWAVES) convert_item(args, layer, it, scr, lane);
        __syncthreads(); }
    rows_mfma<16>(args, layer, lds, MISC, ctl, vcu, G, tid, lane, wave); }
__device__ __forceinline__ void ph_p2(LAS unsigned char* lds, int wv, int layer_) { int layer = __builtin_amdgcn_readfirstlane(layer_); asm volatile("" : "+s"(layer)); PH_CTX();
    pg8::Gemm g{(const bf16*)(ws + WS_H), (const bf16*)(ws + WS_WIN + (size_t)layer * NPROJ * D * (F8_IN ? 1 : 2)), MTOK, NPROJ, F8_IN ? D / 2 : D}; pg8::StaticOrder S; S.init(MTOK, NPROJ, G, bx);
    pg8::EpiBf16Plain E{(bf16*)(ws + WS_PROJ), NPROJ, F8_IN ? 1.0f / (S8_H * S8_W) : 1.0f};
    pg8::gemm_phase<pg8::EpiBf16Plain, pg8::StaticOrder, true, true, F8_IN>(lds, g, S, E, tid);
    if (layer + 1 < DEPTH && G == 256 && bx >= 64) convert_range(args, layer + 1, ((bx - 64) * NWAVES + wave) * CB2, CB2, lds, lane, wave); }
__device__ __forceinline__ void ph_p3a(LAS unsigned char* lds, int wv, int layer_) { int layer = __builtin_amdgcn_readfirstlane(layer_); asm volatile("" : "+s"(layer)); PH_CTX(); p3a_summaries(args, layer, lds, vcu, G, tid, lane, wave); }
__device__ __forceinline__ void ph_p3b(LAS unsigned char* lds, int wv) { PH_CTX(); p3b_scan(args, vcu, G, tid); }
__device__ __forceinline__ void ph_p3c(LAS unsigned char* lds, int wv, int layer_) { int layer = __builtin_amdgcn_readfirstlane(layer_); asm volatile("" : "+s"(layer)); PH_CTX(); p3c_outputs(args, layer, lds, vcu, G, tid, lane, wave); }
__device__ __forceinline__ void ph_p4(LAS unsigned char* lds, int wv, int layer_) { int layer = __builtin_amdgcn_readfirstlane(layer_); asm volatile("" : "+s"(layer)); PH_CTX();
    pg8::Gemm g{(const bf16*)(ws + WS_MIX), (const bf16*)(ws + WS_WOUT + (size_t)layer * D * D * (F8_OUT ? 1 : 2)), MTOK, D, F8_OUT ? D / 2 : D}; pg8::StaticOrder S; S.init(MTOK, D, G, bx);
    pg8::EpiResGate E{(const bf16*)(ws + WS_X), (bf16*)(ws + WS_X), D, (const float*)(ws + WS_MOD) + (size_t)layer * 2 * 6144 + 2 * D, 6144, SEQ, F8_OUT ? 1.0f / (S8_M * S8_W) : 1.0f};
    pg8::gemm_phase<pg8::EpiResGate, pg8::StaticOrder, true, true, F8_OUT>(lds, g, S, E, tid); }
__device__ __forceinline__ void ph_p5(LAS unsigned char* lds, int wv, int layer_) { int layer = __builtin_amdgcn_readfirstlane(layer_); asm volatile("" : "+s"(layer)); PH_CTX(); rows_mfma<32>(args, layer, lds, MISC, ctl, vcu, G, tid, lane, wave); }
__device__ __forceinline__ void ph_p7(LAS unsigned char* lds, int wv, int layer_) { int layer = __builtin_amdgcn_readfirstlane(layer_); asm volatile("" : "+s"(layer)); PH_CTX();
    moe_tables(ctl, layer, MISC, tid);
    const int nrt = __builtin_amdgcn_readfirstlane((int)MISC[MW_NRT]);
    pg8::Gemm g{(const bf16*)(ws + WS_A1), (const bf16*)(ws + WS_WGU + (size_t)layer * NE * 2048 * D), nrt * 256, NE * 2048, D / 2};
    pg8::MoeOrder S{8, G, vcu, nrt * 8, (const LAS int*)(lds + MISC_OFF + 4 * MW_TILE)};
    pg8::EpiSwiglu E{ws + WS_ACT, FFN, args.b_gu + (size_t)layer * NE * 2048, 1.0f / (S8_H * S8_W), S8_A};
    pg8::gemm_phase<pg8::EpiSwiglu, pg8::MoeOrder, true, true, true>(lds, g, S, E, tid);
    { const int rem = (nrt * 8) % G; if (layer + 1 < DEPTH && rem != 0 && vcu >= rem) convert_range(args, layer + 1, conv_t2(G) + ((vcu - rem) * NWAVES + wave) * CB7, CB7, lds, lane, wave); } }
__device__ __forceinline__ void ph_p8(LAS unsigned char* lds, int wv, int layer_) { int layer = __builtin_amdgcn_readfirstlane(layer_); asm volatile("" : "+s"(layer)); PH_CTX();
    moe_tables(ctl, layer, MISC, tid);
    const int nrt = __builtin_amdgcn_readfirstlane((int)MISC[MW_NRT]);
    pg8::Gemm g{(const bf16*)(ws + WS_ACT), (const bf16*)(ws + WS_WDN + (size_t)layer * NE * D * FFN), nrt * 256, NE * D, FFN / 2};
    pg8::MoeOrder S{4, G, vcu, nrt * 4, (const LAS int*)(lds + MISC_OFF + 4 * MW_TILE)};
    if constexpr (Y8) { pg8::EpiFp8Bias E{ws + WS_Y, D, args.b_dn + (size_t)layer * NE * D, D, 1.0f / (S8_A * S8_W), S8_Y};
        pg8::gemm_phase<pg8::EpiFp8Bias, pg8::MoeOrder, true, true, true>(lds, g, S, E, tid); }
    else { pg8::EpiBf16Bias E{(bf16*)(ws + WS_Y), D, args.b_dn + (size_t)layer * NE * D, D, 1.0f / (S8_A * S8_W)};
        pg8::gemm_phase<pg8::EpiBf16Bias, pg8::MoeOrder, true, true, true>(lds, g, S, E, tid); }
    { const int rem = (nrt * 4) % G; if (layer + 1 < DEPTH && rem != 0 && vcu >= rem) convert_range(args, layer + 1, conv_t2(G) + conv_idle(nrt * 8, G) * NWAVES * CB7 + ((vcu - rem) * NWAVES + wave) * CB8, CB8, lds, lane, wave); } }
__device__ __forceinline__ void ph_final(LAS unsigned char* lds, int wv) { PH_CTX(); final_rows(args, lds, vcu, G, tid, lane); }

#ifndef DBL_MASK
#define DBL_MASK 0
#endif
#if DBL_MASK
#define RUN(bit, call) do { if ((DBL_MASK >> (bit)) & 1) { const unsigned long long t0_ = __builtin_amdgcn_s_memrealtime(); call; const unsigned long long t1_ = __builtin_amdgcn_s_memrealtime(); \
        while (__builtin_amdgcn_s_memrealtime() - t1_ < t1_ - t0_) __builtin_amdgcn_s_sleep(8); } else { call; } } while (0)
#else
#define RUN(bit, call) do { call; } while (0)
#endif
__global__ void __launch_bounds__(NTHR, 2) hybrid_fwd(Args args) {
    extern __shared__ __attribute__((aligned(16))) unsigned char lds_raw[];
    LAS unsigned char* lds = (LAS unsigned char*)lds_raw;
    volatile LAS unsigned* MISC = (volatile LAS unsigned*)(lds + MISC_OFF);
    const int tid = threadIdx.x; const int wv = __builtin_amdgcn_readfirstlane(tid >> 6);
    gu32* ctl = (gu32*)(args.ws + WS_CTL);
    for (int u = tid; u < (LDS_BYTES - MISC_OFF) / 4; u += NTHR) MISC[u] = 0u;
    __syncthreads();
    if (tid == 0) {
#define ST_ARG(i, p) do { const unsigned long long v_ = (unsigned long long)(p); MISC[MW_ARGS + 2 * (i)] = (unsigned)v_; MISC[MW_ARGS + 2 * (i) + 1] = (unsigned)(v_ >> 32); } while (0)
        ST_ARG(0, args.x); ST_ARG(1, args.c); ST_ARG(2, args.pos); ST_ARG(3, args.w_mod); ST_ARG(4, args.b_mod); ST_ARG(5, args.norm1_w); ST_ARG(6, args.w_in); ST_ARG(7, args.gla_wa2); ST_ARG(8, args.gla_ba2);
        ST_ARG(9, args.hg_lb); ST_ARG(10, args.gla_norm_w); ST_ARG(11, args.hg_norm_w); ST_ARG(12, args.w_out); ST_ARG(13, args.norm2_w); ST_ARG(14, args.w_r); ST_ARG(15, args.b_r); ST_ARG(16, args.w_gu);
        ST_ARG(17, args.b_gu); ST_ARG(18, args.w_dn); ST_ARG(19, args.b_dn); ST_ARG(20, args.final_norm_w); ST_ARG(21, args.out); ST_ARG(22, args.ws);
#undef ST_ARG
    }
    __syncthreads();
    const int lo = args.ph_lo, hi = args.ph_hi;
    const bool multi = (hi - lo) > 1;
    XcdBarrier bar; bar.bar = (unsigned*)(ctl + CW_BAR); bar.x = 0; bar.st = nullptr;
    if (multi) bar = xcd_barrier_post((unsigned*)(ctl + CW_BAR), MISC + MW_BAR);
#define IN(k) (lo <= (k) && (k) < hi)
#define SEAM(k) do { if (IN(k) && IN((k) + 1)) xcd_barrier(bar); } while (0)

    if (IN(0)) RUN(0, ph_p0(lds, wv));
    SEAM(0);
    for (int layer = 0; layer < DEPTH; ++layer) {
        const int pb = 1 + 9 * layer;
        if (IN(pb + 0)) RUN(1, ph_p1(lds, wv, layer));
        SEAM(pb + 0);
        if (IN(pb + 1)) RUN(2, ph_p2(lds, wv, layer));
        SEAM(pb + 1);
        if (IN(pb + 2)) RUN(3, ph_p3a(lds, wv, layer));
        SEAM(pb + 2);
        if (IN(pb + 3)) RUN(4, ph_p3b(lds, wv));
        SEAM(pb + 3);
        if (IN(pb + 4)) RUN(5, ph_p3c(lds, wv, layer));
        SEAM(pb + 4);
        if (IN(pb + 5)) RUN(6, ph_p4(lds, wv, layer));
        SEAM(pb + 5);
        if (IN(pb + 6)) RUN(7, ph_p5(lds, wv, layer));
        SEAM(pb + 6);
        if (IN(pb + 7)) RUN(9, ph_p7(lds, wv, layer));
        SEAM(pb + 7);
        if (IN(pb + 8)) RUN(10, ph_p8(lds, wv, layer));
        SEAM(pb + 8);
    }
    if (IN(NPHASE - 1)) RUN(11, ph_final(lds, wv));
#undef IN
#undef SEAM
}

#ifndef MK_SINGLE
#define MK_SINGLE 1
#endif
extern "C" void kernel_launch(void* const* d_in, const int* in_sizes, int n_in, void* d_out, int out_size, void* d_ws, size_t ws_size, hipStream_t stream) {
    static int grid = 0;
    if (grid == 0) {
        if (n_in != 21 || in_sizes[0] != MTOK * D || out_size != MTOK * D || ws_size < WS_END) { fprintf(stderr, "kernel_launch: unexpected problem shape (n_in %d, in0 %d, out %d, ws %zu)\n", n_in, n_in > 0 ? in_sizes[0] : -1, out_size, ws_size); grid = -1; return; }
        int dev = 0, cus = 0, per_cu = 0;
        if (hipGetDevice(&dev) != hipSuccess || hipDeviceGetAttribute(&cus, hipDeviceAttributeMultiprocessorCount, dev) != hipSuccess) { grid = -1; return; }
        if (hipFuncSetAttribute((const void*)hybrid_fwd, hipFuncAttributeMaxDynamicSharedMemorySize, LDS_BYTES) != hipSuccess) { fprintf(stderr, "kernel_launch: hipFuncSetAttribute failed\n"); grid = -1; return; }
        if (hipOccupancyMaxActiveBlocksPerMultiprocessor(&per_cu, (const void*)hybrid_fwd, NTHR, LDS_BYTES) != hipSuccess || per_cu < 1) fprintf(stderr, "kernel_launch: occupancy query says %d\n", per_cu);
        (void)hipGetLastError();
        grid = cus;
    }
    if (grid < 0) return;
    (void)hipMemsetAsync((char*)d_ws + WS_CTL, 0, CTL_ZERO_BYTES, stream);
    Args a{};
    a.x = (const float*)d_in[0]; a.c = (const float*)d_in[1]; a.pos = (const int*)d_in[2]; a.w_mod = (const float*)d_in[3]; a.b_mod = (const float*)d_in[4]; a.norm1_w = (const float*)d_in[5];
    a.w_in = (const float*)d_in[6]; a.gla_wa2 = (const float*)d_in[7]; a.gla_ba2 = (const float*)d_in[8]; a.hg_lb = (const float*)d_in[9]; a.gla_norm_w = (const float*)d_in[10]; a.hg_norm_w = (const float*)d_in[11];
    a.w_out = (const float*)d_in[12]; a.norm2_w = (const float*)d_in[13]; a.w_r = (const float*)d_in[14]; a.b_r = (const float*)d_in[15]; a.w_gu = (const float*)d_in[16]; a.b_gu = (const float*)d_in[17];
    a.w_dn = (const float*)d_in[18]; a.b_dn = (const float*)d_in[19]; a.final_norm_w = (const float*)d_in[20]; a.out = (float*)d_out; a.ws = (unsigned char*)d_ws;
#if MK_SINGLE
    a.ph_lo = 0; a.ph_hi = NPHASE;
    hipLaunchKernelGGL(hybrid_fwd, dim3(grid), dim3(NTHR), LDS_BYTES, stream, a);
#else
    for (int p = 0; p < NPHASE; ++p) { a.ph_lo = p; a.ph_hi = p + 1; hipLaunchKernelGGL(hybrid_fwd, dim3(grid), dim3(NTHR), LDS_BYTES, stream, a); }
#endif
}
```

```cpp
#include <hip/hip_runtime.h>
#include <cstdio>
#include <cstdint>
namespace pg8 {
#define PG8_LAS __attribute__((address_space(3)))
typedef unsigned short bf16_t;
typedef short bf16x8 __attribute__((ext_vector_type(8)));
typedef float f32x4 __attribute__((ext_vector_type(4)));
typedef unsigned u32x4 __attribute__((ext_vector_type(4)));
constexpr int BM = 256, BK = 64, HALF = 128, HTB = HALF * BK * 2  , STAGE_BYTES = 8 * HTB, NXCD = 8, WGM = 8;

__host__ __device__ __forceinline__ int lds_byte(int r, int c) { const int st = (r >> 4) * 2 + (c >> 5), rr = r & 15, cc = c & 31, ob = rr * 64 + cc * 2; return st * 1024 + (ob ^ (((ob >> 9) & 1) << 5)); }
__host__ __device__ __forceinline__ void stage_rc(int b, int& R, int& C) { const int st = b / 1024, sb = b % 1024, swz = sb ^ (((sb >> 9) & 1) << 5); R = (st >> 1) * 16 + swz / 64; C = (st & 1) * 32 + (swz % 64) / 2; }
__host__ __device__ __forceinline__ int perm32(int rho) { const int n = rho >> 4, i = rho & 15; return 8 * (i >> 2) + 4 * n + (i & 3); }

struct Unit { int pm, pn, e, pl; };
struct Gemm { const bf16_t* A; const bf16_t* Bt; int M, N, K; };

struct StaticOrder {
    int nM, nN, nwg, G, c;
    __host__ __device__ void init(int M, int N, int G_, int c_) { nM = M / BM; nN = N / BM; nwg = nM * nN; G = G_; c = c_; }
    __host__ __device__ bool next(int i, Unit& u) const {
        const long L = (long)i * G + c; if (L >= nwg) return false;
        int wgid = (int)L; { const int q = nwg / NXCD, r = nwg % NXCD, xcd = wgid % NXCD, off = wgid / NXCD; wgid = (xcd < r ? xcd * (q + 1) : r * (q + 1) + (xcd - r) * q) + off; }
        const int nig = WGM * nN, gid = wgid / nig, fm = gid * WGM, gsz = (nM - fm) < WGM ? (nM - fm) : WGM;
        u.pm = fm + ((wgid % nig) % gsz); u.pn = (wgid % nig) / gsz; u.e = 0; u.pl = u.pn; return true;
    }
    __device__ __forceinline__ void a_ready(const Unit&) const {}
    __device__ __forceinline__ void done(const Unit&) const {}
};

__device__ __forceinline__ unsigned cvt_pk_bf16(float lo, float hi) { unsigned r; asm volatile("v_cvt_pk_bf16_f32 %0, %1, %2" : "=v"(r) : "v"(lo), "v"(hi)); return r; }

struct EpiBf16Plain {
    static constexpr bool PERM = true, AFTER_DRAIN = false;
    bf16_t* O; int ldc; float sc;
    __device__ __forceinline__ void operator()(const f32x4 (&acc)[2][2][4][2], const Unit& u, int wr, int wc, int fr, int fq) const {
        const int row0 = u.pm * BM + wr * 64 + fr; const int col0 = u.pn * BM + wc * 32 + 8 * fq;
#pragma unroll
        for (int ai = 0; ai < 2; ++ai)
#pragma unroll
            for (int m = 0; m < 4; ++m) { bf16_t* rowp = O + (size_t)(row0 + ai * HALF + m * 16) * ldc + col0;
#pragma unroll
                for (int bj = 0; bj < 2; ++bj) { const f32x4 v0 = acc[ai][bj][m][0] * sc, v1 = acc[ai][bj][m][1] * sc;
                    u32x4 w; w.x = cvt_pk_bf16(v0[0], v0[1]); w.y = cvt_pk_bf16(v0[2], v0[3]); w.z = cvt_pk_bf16(v1[0], v1[1]); w.w = cvt_pk_bf16(v1[2], v1[3]);
                    *(u32x4*)(rowp + bj * HALF) = w; } }
    }
};
struct EpiResGate {
    static constexpr bool PERM = true, AFTER_DRAIN = false;
    const bf16_t* base; bf16_t* out; int ldc; const float* gate; int gpitch; int rows_per_batch; float sc;
    __device__ __forceinline__ void operator()(const f32x4 (&acc)[2][2][4][2], const Unit& u, int wr, int wc, int fr, int fq) const {
        const int row0 = u.pm * BM + wr * 64 + fr, col0 = u.pn * BM + wc * 32 + 8 * fq;
        const float* gp = gate + (size_t)((u.pm * BM) / rows_per_batch) * gpitch + col0;
        f32x4 gv[2][2];
#pragma unroll
        for (int bj = 0; bj < 2; ++bj)
#pragma unroll
            for (int n = 0; n < 2; ++n) gv[bj][n] = *(const f32x4*)(gp + bj * HALF + 4 * n) * sc;
#pragma unroll
        for (int ai = 0; ai < 2; ++ai)
#pragma unroll
            for (int m = 0; m < 4; ++m) { const size_t off = (size_t)(row0 + ai * HALF + m * 16) * ldc + col0;
#pragma unroll
                for (int bj = 0; bj < 2; ++bj) { const u32x4 bs = *(const u32x4*)(base + off + bj * HALF); const unsigned bw[4] = {bs.x, bs.y, bs.z, bs.w}; float r[8];
#pragma unroll
                    for (int j = 0; j < 4; ++j) { const f32x4& a4 = acc[ai][bj][m][j >> 1]; const f32x4& g4 = gv[bj][j >> 1];
                        r[2 * j] = __builtin_bit_cast(float, bw[j] << 16) + g4[2 * (j & 1)] * a4[2 * (j & 1)]; r[2 * j + 1] = __builtin_bit_cast(float, bw[j] & 0xffff0000u) + g4[2 * (j & 1) + 1] * a4[2 * (j & 1) + 1]; }
                    u32x4 w; w.x = cvt_pk_bf16(r[0], r[1]); w.y = cvt_pk_bf16(r[2], r[3]); w.z = cvt_pk_bf16(r[4], r[5]); w.w = cvt_pk_bf16(r[6], r[7]);
                    *(u32x4*)(out + off + bj * HALF) = w; }
                asm volatile("" ::: "memory"); }
    }
};
struct EpiSwiglu {
    static constexpr bool PERM = true, AFTER_DRAIN = false;
    unsigned char* O; int ldc; const float* bias; float inv_in, out_scale;
    __device__ __forceinline__ float act1(float g, float up) const {
        g = fminf(g, 7.0f); up = fminf(fmaxf(up, -7.0f), 7.0f);
        const float s = 1.0f / (1.0f + __expf(-1.702f * g));
        return fminf(fmaxf((up + 1.0f) * g * s * out_scale, -448.f), 448.f);
    }
    __device__ __forceinline__ void operator()(const f32x4 (&acc)[2][2][4][2], const Unit& u, int wr, int wc, int fr, int fq) const {
        const int row0 = u.pm * BM + wr * 64 + fr; const int jj0 = wc * 32 + 8 * fq; const int col0 = u.pl * HALF + jj0;
        const float* bp = bias + (size_t)u.e * 2048 + col0;
        f32x4 bg[2], bu[2];
#pragma unroll
        for (int n = 0; n < 2; ++n) { bg[n] = *(const f32x4*)(bp + 4 * n); bu[n] = *(const f32x4*)(bp + 1024 + 4 * n); }
#pragma unroll
        for (int ai = 0; ai < 2; ++ai)
#pragma unroll
            for (int m = 0; m < 4; ++m) { unsigned char* rowp = O + (size_t)(row0 + ai * HALF + m * 16) * ldc + col0;
                f32x4 r[2];
#pragma unroll
                for (int n = 0; n < 2; ++n) { const f32x4 g = acc[ai][0][m][n] * inv_in + bg[n], up = acc[ai][1][m][n] * inv_in + bu[n];
#pragma unroll
                    for (int j = 0; j < 4; ++j) r[n][j] = act1(g[j], up[j]); }
                int w0 = 0, w1 = 0;
                w0 = __builtin_amdgcn_cvt_pk_fp8_f32(r[0][0], r[0][1], w0, false); w0 = __builtin_amdgcn_cvt_pk_fp8_f32(r[0][2], r[0][3], w0, true);
                w1 = __builtin_amdgcn_cvt_pk_fp8_f32(r[1][0], r[1][1], w1, false); w1 = __builtin_amdgcn_cvt_pk_fp8_f32(r[1][2], r[1][3], w1, true);
                typedef int i32x2 __attribute__((ext_vector_type(2))); *(i32x2*)rowp = (i32x2){w0, w1}; }
    }
};
struct EpiBf16Bias {
    static constexpr bool PERM = true, AFTER_DRAIN = false;
    bf16_t* O; int ldc; const float* bias; int bpitch; float inv_in;
    __device__ __forceinline__ void operator()(const f32x4 (&acc)[2][2][4][2], const Unit& u, int wr, int wc, int fr, int fq) const {
        const int row0 = u.pm * BM + wr * 64 + fr; const int col0 = u.pl * BM + wc * 32 + 8 * fq;
        const float* bp = bias + (size_t)u.e * bpitch + col0;
        f32x4 bv[2][2];
#pragma unroll
        for (int bj = 0; bj < 2; ++bj)
#pragma unroll
            for (int n = 0; n < 2; ++n) bv[bj][n] = *(const f32x4*)(bp + bj * HALF + 4 * n);
#pragma unroll
        for (int ai = 0; ai < 2; ++ai)
#pragma unroll
            for (int m = 0; m < 4; ++m) { bf16_t* rowp = O + (size_t)(row0 + ai * HALF + m * 16) * ldc + col0;
#pragma unroll
                for (int bj = 0; bj < 2; ++bj) { const f32x4 v0 = acc[ai][bj][m][0] * inv_in + bv[bj][0], v1 = acc[ai][bj][m][1] * inv_in + bv[bj][1];
                    u32x4 w; w.x = cvt_pk_bf16(v0[0], v0[1]); w.y = cvt_pk_bf16(v0[2], v0[3]); w.z = cvt_pk_bf16(v1[0], v1[1]); w.w = cvt_pk_bf16(v1[2], v1[3]);
                    *(u32x4*)(rowp + bj * HALF) = w; } }
    }
};
struct EpiFp8Bias {
    static constexpr bool PERM = true, AFTER_DRAIN = false;
    unsigned char* O; int ldc; const float* bias; int bpitch; float inv_in, out_scale;
    __device__ __forceinline__ int pk4(f32x4 v) const { int w = 0; w = __builtin_amdgcn_cvt_pk_fp8_f32(fminf(fmaxf(v[0], -448.f), 448.f), fminf(fmaxf(v[1], -448.f), 448.f), w, false);
        return __builtin_amdgcn_cvt_pk_fp8_f32(fminf(fmaxf(v[2], -448.f), 448.f), fminf(fmaxf(v[3], -448.f), 448.f), w, true); }
    __device__ __forceinline__ void operator()(const f32x4 (&acc)[2][2][4][2], const Unit& u, int wr, int wc, int fr, int fq) const {
        const int row0 = u.pm * BM + wr * 64 + fr; const int col0 = u.pl * BM + wc * 32 + 8 * fq;
        const float* bp = bias + (size_t)u.e * bpitch + col0;
        f32x4 bv[2][2];
#pragma unroll
        for (int bj = 0; bj < 2; ++bj)
#pragma unroll
            for (int n = 0; n < 2; ++n) bv[bj][n] = *(const f32x4*)(bp + bj * HALF + 4 * n);
#pragma unroll
        for (int ai = 0; ai < 2; ++ai)
#pragma unroll
            for (int m = 0; m < 4; ++m) { unsigned char* rowp = O + (size_t)(row0 + ai * HALF + m * 16) * ldc + col0;
#pragma unroll
                for (int bj = 0; bj < 2; ++bj) { const f32x4 v0 = (acc[ai][bj][m][0] * inv_in + bv[bj][0]) * out_scale, v1 = (acc[ai][bj][m][1] * inv_in + bv[bj][1]) * out_scale;
                    typedef int i32x2 __attribute__((ext_vector_type(2))); *(i32x2*)(rowp + bj * HALF) = (i32x2){pk4(v0), pk4(v1)}; } }
    }
};
struct MoeOrder {
    int nN, G, c, nunits; const PG8_LAS int* tile_pm;
    __device__ __forceinline__ bool next(int i, Unit& u) const {
        const int L = i * G + c; if (L >= nunits) return false;
        const int idx = L / nN, pl = L - idx * nN, pm = __builtin_amdgcn_readfirstlane(tile_pm[idx]), e = pm >> 6;
        u.pm = pm; u.pl = pl; u.e = e; u.pn = e * nN + pl; return true;
    }
    __device__ __forceinline__ void a_ready(const Unit&) const {}
    __device__ __forceinline__ void done(const Unit&) const {}
};
typedef int v4i32_t __attribute__((ext_vector_type(4)));
typedef int v8i32_t __attribute__((ext_vector_type(8)));
template <class Epi, class Sched, bool ALIGN_EPI = false, bool SP2 = false, bool FP8 = false>
__device__ __forceinline__ void gemm_phase(PG8_LAS unsigned char* lds, const Gemm g, const Sched& S, const Epi& E, int tid_in) {
    int tid_ = tid_in; asm volatile("" : "+v"(tid_)); const int tid = tid_, wid = __builtin_amdgcn_readfirstlane(tid >> 6), lane = tid & 63, wr = wid >> 2, wc = wid & 3, fr = lane & 15, fq = lane >> 4;
    const int K = g.K, nt = K / BK;
    unsigned voffA, voffB;
    { int R, C; stage_rc(tid * 16, R, C); const int Rb = Epi::PERM ? ((R & ~31) + perm32(R & 31)) : R;
        voffA = (unsigned)(R * K + C) * 2u; voffB = (unsigned)(Rb * K + C) * 2u; }
    const size_t rstep = (size_t)64 * K * 2;
    const size_t kstep = (size_t)(BK * 2);
    const size_t hstep = (size_t)HALF * K * 2;
    const size_t tstep = 2 * hstep;
    const unsigned ldsw = (unsigned)wid * 1024u;
    const int aoff = lds_byte(wr * 64 + fr, fq * 8), boff = lds_byte(wc * 32 + fr, fq * 8);
#define PG8_SA(b, h) (((b) * 2 + (h)) * HTB)
#define PG8_SB(b, h) ((4 + (b) * 2 + (h)) * HTB)
#define PG8_STAGE(bufoff, gbase, voff) do { _Pragma("unroll") for (int _i = 0; _i < 2; ++_i) \
        __builtin_amdgcn_global_load_lds((const unsigned*)((const char*)(gbase) + _i * rstep + (voff)), (PG8_LAS unsigned*)(lds + (bufoff) + ldsw + _i * 8192), 16, 0, 0); } while (0)
#define PG8_LDA(dst, b, h) do { _Pragma("unroll") for (int m = 0; m < 4; ++m) _Pragma("unroll") for (int k = 0; k < 2; ++k) dst[m][k] = *(const PG8_LAS bf16x8*)(lds + PG8_SA(b, h) + aoff + m * 2048 + k * 1024); } while (0)
#define PG8_LDB(dst, b, h) do { _Pragma("unroll") for (int n = 0; n < 2; ++n) _Pragma("unroll") for (int k = 0; k < 2; ++k) dst[n][k] = *(const PG8_LAS bf16x8*)(lds + PG8_SB(b, h) + boff + n * 2048 + k * 1024); } while (0)
#define PG8_MMA(ai, bj, At, Bt) do { __builtin_amdgcn_s_setprio(1); _Pragma("unroll") for (int m = 0; m < 4; ++m) _Pragma("unroll") for (int n = 0; n < 2; ++n) { \
        if constexpr (FP8) { const v8i32_t a8_ = __builtin_shufflevector(__builtin_bit_cast(v4i32_t, At[m][0]), __builtin_bit_cast(v4i32_t, At[m][1]), 0, 1, 2, 3, 4, 5, 6, 7); \
            const v8i32_t b8_ = __builtin_shufflevector(__builtin_bit_cast(v4i32_t, Bt[n][0]), __builtin_bit_cast(v4i32_t, Bt[n][1]), 0, 1, 2, 3, 4, 5, 6, 7); \
            asm volatile("v_mfma_scale_f32_16x16x128_f8f6f4 %0, %1, %2, %0, %3, %3 op_sel_hi:[0,0,0]" : "+v"(acc[ai][bj][m][n]) : "v"(b8_), "v"(a8_), "v"(one8_)); } \
        else { _Pragma("unroll") for (int k = 0; k < 2; ++k) acc[ai][bj][m][n] = __builtin_amdgcn_mfma_f32_16x16x32_bf16(Bt[n][k], At[m][k], acc[ai][bj][m][n], 0, 0, 0); } } \
        __builtin_amdgcn_s_setprio(0); } while (0)
#define PG8_WAIT_V(n) asm volatile("s_waitcnt vmcnt(" #n ")" ::: "memory")
#define PG8_WAIT_L(n) asm volatile("s_waitcnt lgkmcnt(" #n ")" ::: "memory")
#define PG8_BAR __builtin_amdgcn_s_barrier()
#define PG8_SCHED __builtin_amdgcn_sched_barrier(0)
    Unit cur, nxt; int ui = 0;
    if (!S.next(0, cur)) return;
    f32x4 acc[2][2][4][2];
#pragma unroll
    for (int a = 0; a < 2; ++a)
#pragma unroll
        for (int b = 0; b < 2; ++b)
#pragma unroll
            for (int m = 0; m < 4; ++m)
#pragma unroll
                for (int n = 0; n < 2; ++n) acc[a][b][m][n] = (f32x4){0.f, 0.f, 0.f, 0.f};
    bf16x8 At[4][2], B0[2][2], B1[2][2];
    int one8_ = 0x7f7f7f7f; asm volatile("" : "+v"(one8_));
    const char* cA = (const char*)g.A + (size_t)cur.pm * tstep; const char* cB = (const char*)g.Bt + (size_t)cur.pn * tstep;
    S.a_ready(cur);
    if constexpr (SP2) {
        PG8_STAGE(PG8_SB(0, 0), cB, voffB); PG8_STAGE(PG8_SB(0, 1), cB + hstep, voffB); PG8_STAGE(PG8_SA(0, 0), cA, voffA); PG8_STAGE(PG8_SA(0, 1), cA + hstep, voffA);
        if (wr == 1) PG8_BAR;
        PG8_WAIT_V(2); PG8_BAR;
        PG8_STAGE(PG8_SB(1, 0), cB + kstep, voffB); PG8_STAGE(PG8_SA(1, 0), cA + kstep, voffA); PG8_STAGE(PG8_SB(1, 1), cB + hstep + kstep, voffB);
        PG8_WAIT_V(6); PG8_BAR;
    } else {
        PG8_STAGE(PG8_SB(0, 0), cB, voffB); PG8_STAGE(PG8_SA(0, 0), cA, voffA); PG8_STAGE(PG8_SB(0, 1), cB + hstep, voffB); PG8_STAGE(PG8_SA(0, 1), cA + hstep, voffA);
        if (wr == 1) PG8_BAR;
        PG8_WAIT_V(4); PG8_BAR;
        PG8_STAGE(PG8_SB(1, 0), cB + kstep, voffB); PG8_STAGE(PG8_SA(1, 0), cA + kstep, voffA); PG8_STAGE(PG8_SB(1, 1), cB + hstep + kstep, voffB);
        PG8_WAIT_V(6); PG8_BAR;
    }
    for (;;) {
        const bool has_next = S.next(ui + 1, nxt);
        const char* nA = has_next ? (const char*)g.A + (size_t)nxt.pm * tstep : cA; const char* nB = has_next ? (const char*)g.Bt + (size_t)nxt.pn * tstep : cB;
#pragma unroll 1
        for (int t = 0; t < nt; t += 2) {
            const bool last = (t == nt - 2);
            const char* a1 = cA + (size_t)(t + 1) * kstep;
            const char* a2 = last ? nA : cA + (size_t)(t + 2) * kstep; const char* b2 = last ? nB : cB + (size_t)(t + 2) * kstep;
            const char* a3 = a2 + kstep; const char* b3 = b2 + kstep;
            if (last && has_next) S.a_ready(nxt);
            if constexpr (SP2) {
            PG8_LDB(B0, 0, 0); PG8_LDB(B1, 0, 1); PG8_SCHED; PG8_LDA(At, 0, 0); PG8_STAGE(PG8_SA(1, 1), a1 + hstep, voffA);
            PG8_WAIT_V(8); PG8_WAIT_L(0); PG8_BAR; PG8_MMA(0, 0, At, B0); PG8_MMA(0, 1, At, B1); PG8_BAR; PG8_SCHED;
            PG8_LDA(At, 0, 1); PG8_STAGE(PG8_SB(0, 0), b2, voffB); PG8_STAGE(PG8_SB(0, 1), b2 + hstep, voffB); PG8_STAGE(PG8_SA(0, 0), a2, voffA);
            PG8_WAIT_V(8); PG8_WAIT_L(0); PG8_BAR; PG8_MMA(1, 0, At, B0); PG8_MMA(1, 1, At, B1); PG8_BAR; PG8_SCHED;
            PG8_LDB(B0, 1, 0); PG8_LDB(B1, 1, 1); PG8_SCHED; PG8_LDA(At, 1, 0); PG8_STAGE(PG8_SA(0, 1), a2 + hstep, voffA);
            PG8_WAIT_V(8); PG8_WAIT_L(0); PG8_BAR; PG8_MMA(0, 0, At, B0); PG8_MMA(0, 1, At, B1); PG8_BAR; PG8_SCHED;
            PG8_LDA(At, 1, 1); PG8_STAGE(PG8_SB(1, 0), b3, voffB); PG8_STAGE(PG8_SB(1, 1), b3 + hstep, voffB); PG8_STAGE(PG8_SA(1, 0), a3, voffA);
            PG8_WAIT_V(8); PG8_WAIT_L(0); PG8_BAR; PG8_MMA(1, 0, At, B0); PG8_MMA(1, 1, At, B1); PG8_BAR; PG8_SCHED;
            } else {
            PG8_LDB(B0, 0, 0); PG8_SCHED; PG8_LDA(At, 0, 0); PG8_STAGE(PG8_SA(1, 1), a1 + hstep, voffA);
            PG8_WAIT_L(8); PG8_BAR; PG8_WAIT_L(0); PG8_MMA(0, 0, At, B0); PG8_BAR; PG8_SCHED;
            PG8_LDB(B1, 0, 1); PG8_STAGE(PG8_SB(0, 0), b2, voffB);
            PG8_BAR; PG8_WAIT_L(0); PG8_MMA(0, 1, At, B1); PG8_BAR;
            PG8_LDA(At, 0, 1); PG8_STAGE(PG8_SA(0, 0), a2, voffA);
            PG8_BAR; PG8_WAIT_L(0); PG8_MMA(1, 0, At, B0); PG8_BAR; PG8_SCHED;
            PG8_STAGE(PG8_SB(0, 1), b2 + hstep, voffB);
            PG8_WAIT_V(6); PG8_BAR; PG8_MMA(1, 1, At, B1); PG8_BAR;
            PG8_LDB(B0, 1, 0); PG8_SCHED; PG8_LDA(At, 1, 0); PG8_STAGE(PG8_SA(0, 1), a2 + hstep, voffA);
            PG8_WAIT_L(8); PG8_BAR; PG8_WAIT_L(0); PG8_MMA(0, 0, At, B0); PG8_BAR; PG8_SCHED;
            PG8_LDB(B1, 1, 1); PG8_STAGE(PG8_SB(1, 0), b3, voffB);
            PG8_BAR; PG8_WAIT_L(0); PG8_MMA(0, 1, At, B1); PG8_BAR;
            PG8_LDA(At, 1, 1); PG8_STAGE(PG8_SA(1, 0), a3, voffA);
            PG8_BAR; PG8_WAIT_L(0); PG8_MMA(1, 0, At, B0); PG8_BAR; PG8_SCHED;
            PG8_STAGE(PG8_SB(1, 1), b3 + hstep, voffB);
            PG8_WAIT_V(6); PG8_BAR; PG8_MMA(1, 1, At, B1); PG8_BAR;
            }
        }
        if constexpr (FP8) asm volatile("s_nop 7\n\ts_nop 7" ::: "memory");
        if constexpr (ALIGN_EPI) { if (wr == 0) PG8_BAR; }
        if constexpr (!Epi::AFTER_DRAIN) { int ln_ = (int)__builtin_amdgcn_mbcnt_hi(~0u, __builtin_amdgcn_mbcnt_lo(~0u, 0u)); asm volatile("" : "+v"(ln_)); E(acc, cur, wr, wc, ln_ & 15, ln_ >> 4); S.done(cur); }
        if (!has_next) break;
#pragma unroll
        for (int a = 0; a < 2; ++a)
#pragma unroll
            for (int b = 0; b < 2; ++b)
#pragma unroll
                for (int m = 0; m < 4; ++m)
#pragma unroll
                    for (int n = 0; n < 2; ++n) acc[a][b][m][n] = (f32x4){0.f, 0.f, 0.f, 0.f};
        cur = nxt; cA = nA; cB = nB; ++ui;
        if constexpr (ALIGN_EPI) { if (wr == 1) PG8_BAR; }
    }
    PG8_WAIT_V(0);
    if constexpr (!ALIGN_EPI) { if (wr == 0) PG8_BAR; }
    PG8_BAR;
    if constexpr (Epi::AFTER_DRAIN) { E.fused(acc, cur, wr, wc, fr, fq, lds, wid, lane); S.done(cur); }
#undef PG8_SA
#undef PG8_SB
#undef PG8_STAGE
#undef PG8_LDA
#undef PG8_LDB
#undef PG8_MMA
#undef PG8_WAIT_V
#undef PG8_WAIT_L
#undef PG8_BAR
#undef PG8_SCHED
}
}

constexpr int NWAVES = 8, NTHR = 512;
constexpr int BATCH = 2, SEQ = 8192, D = 1024, DEPTH = 4, MTOK = BATCH * SEQ;
constexpr int DIN = 3344, NPROJ = 3328, SRC_GA = 1152;
constexpr int C_GQ = 0, C_GK = 192, C_GV = 384, C_GG = 768, C_HQ = 1152, C_HF = 1408, C_HI = 1664, C_HG = 1920, C_RQ = 2176, C_RK = 2368, C_RV = 2560, C_RG = 2944;
constexpr int NE = 32, FFN = 1024;
constexpr int CH = 64, NCH = SEQ / CH, NUNIT = BATCH * NCH;
constexpr int ST_GLA = 0, ST_HG = 4 * 48 * 96, ST_RET = ST_HG + 4 * 64 * 64, ST_TOT = ST_RET + 4 * 48 * 96;
constexpr int NDV = 448, NKT = 640;
constexpr int MAXROWS = 65536 + NE * 256, MAXRT = MAXROWS / 256;
constexpr float EPS = 1e-6f;
#ifndef F8_IN_V
#define F8_IN_V false
#endif
#ifndef F8_OUT_V
#define F8_OUT_V false
#endif
constexpr bool F8_IN = F8_IN_V, F8_OUT = F8_OUT_V;
#ifndef Y8_V
#define Y8_V true
#endif
constexpr bool Y8 = Y8_V;
constexpr float S8_Y = 16.f;
constexpr float S8_M = 32.f;
constexpr float S8_W = 2048.f, S8_H = 64.f, S8_A = 8.f;
constexpr int NPHASE = 38;
constexpr int ECAP = 16384, ECAP_SH = 14;

constexpr size_t MiB = 1u << 20;
constexpr size_t WS_CTL = 0, CTL_ZERO_BYTES = 65536;
constexpr size_t WS_MOD = 1 * MiB;
constexpr size_t WS_ROPE = 2 * MiB;
constexpr size_t WS_LB = 5 * MiB;
constexpr size_t WS_WIN = 8 * MiB;
constexpr size_t WS_WOUT = 34 * MiB;
constexpr size_t WS_WGU = 42 * MiB;
constexpr size_t WS_WDN = 554 * MiB;
constexpr size_t WS_X = 810 * MiB;
constexpr size_t WS_H = 874 * MiB;
constexpr size_t WS_GA = 906 * MiB;
constexpr size_t WS_PROJ = 907 * MiB;
constexpr size_t WS_U = 1011 * MiB;
constexpr size_t WS_DVEC = 1063 * MiB;
constexpr size_t WS_SP = 1064 * MiB;
constexpr size_t WS_MIX = 1090 * MiB;
constexpr size_t WS_TOPE = 1122 * MiB;
constexpr size_t WS_TOPW = WS_TOPE + 256 * 1024;
constexpr size_t WS_SLOT = WS_TOPW + 256 * 1024;
constexpr size_t WS_A1 = 1123 * MiB;
constexpr size_t WS_ACT = 1635 * MiB;
constexpr size_t WS_Y = 2147 * MiB;
constexpr size_t WS_CUM = 3171 * MiB;
constexpr size_t WS_KT = 3199 * MiB;
constexpr size_t WS_END = 3239 * MiB;
static_assert(WS_WIN + (size_t)DEPTH * NPROJ * D * 2 <= WS_WOUT && WS_PROJ + (size_t)MTOK * NPROJ * 2 <= WS_U && WS_U + (size_t)NUNIT * ST_TOT * 4 <= WS_DVEC && WS_SP + (size_t)NUNIT * ST_TOT * 2 <= WS_MIX && WS_A1 + (size_t)NE * ECAP * D <= WS_ACT && WS_ACT + (size_t)NE * ECAP * D <= WS_Y && WS_Y + (size_t)NE * ECAP * D * 2 <= WS_CUM, "ws map");
constexpr int CW_TMO = 0, CW_CODE = 1, CW_BAR = 4096, CW_CNT = 8192, CW_FILL = 8192 + 256;
constexpr int RING_BYTES = 131072;
constexpr int MISC_OFF = 147456, LDS_BYTES = MISC_OFF + 4096;
constexpr int MW_BAR = 0, MW_CNT = 16, MW_PST = 48, MW_HIST = 96, MW_BASE = 128, MW_TILE = 192, MW_NRT = 480, MW_SLOTS = 512;

#define GAS __attribute__((address_space(1)))
#define LAS __attribute__((address_space(3)))
typedef unsigned v4u __attribute__((ext_vector_type(4)));
typedef float f32x4 __attribute__((ext_vector_type(4)));
typedef short bf16x8 __attribute__((ext_vector_type(8)));
typedef GAS unsigned gu32;
typedef GAS unsigned long long gu64;
#define RLX_AGENT __ATOMIC_RELAXED, __HIP_MEMORY_SCOPE_AGENT
#define LDS_WAIT() asm volatile("s_waitcnt lgkmcnt(0)" ::: "memory")
#define VM_WAIT() asm volatile("s_waitcnt vmcnt(0)" ::: "memory")
__device__ __forceinline__ unsigned long long rt() { return __builtin_amdgcn_s_memrealtime(); }
typedef unsigned short bf16;
__device__ __forceinline__ unsigned f2bf(float f) { unsigned u = __builtin_bit_cast(unsigned, f); return (u + 0x7fffu + ((u >> 16) & 1u)) >> 16; }
__device__ __forceinline__ unsigned pk2(float lo, float hi) { return f2bf(lo) | (f2bf(hi) << 16); }
__device__ __forceinline__ float bf2f(bf16 b) { return __builtin_bit_cast(float, (unsigned)b << 16); }
#define XB_TMO      128
#define XB_XCNT(j)  (256  + 64 * (j))
#define XB_XSUB(j)  (1280 + 64 * (j))
#define XB_XGEN(j)  (2304 + 64 * (j))
#define XB_TOP      3328
#define XB_TOPGEN   3392
#define XCD_BAR_WORDS 3456
#define XB_SPIN_CAP (1u << 18)

__device__ __forceinline__ unsigned xb_ld(unsigned* p)              { return __hip_atomic_load(p, __ATOMIC_RELAXED, __HIP_MEMORY_SCOPE_AGENT); }
__device__ __forceinline__ unsigned xb_add(unsigned* p, unsigned v) { return __hip_atomic_fetch_add(p, v, __ATOMIC_RELAXED, __HIP_MEMORY_SCOPE_AGENT); }
__device__ __forceinline__ unsigned xb_xcc_id() { return (unsigned)__builtin_amdgcn_s_getreg((3 << 11) | 20) & 0xFu; }
#define XB_SPIN(cond, bar) do { unsigned _sp = 0; while (cond) { __builtin_amdgcn_s_sleep(1); \
    if ((++_sp & 255u) == 0u) { if (xb_ld(&(bar)[XB_TMO])) break; if (_sp > XB_SPIN_CAP) { atomicAdd(&(bar)[XB_TMO], 1u); break; } } } } while (0)

struct XcdBarrier {
    unsigned* bar; unsigned x;
    volatile LAS unsigned* st;
};

__device__ __forceinline__ XcdBarrier xcd_barrier_post(unsigned* bar, volatile LAS unsigned* st) {
    XcdBarrier b; b.bar = bar; b.x = xb_xcc_id(); b.st = st;
    if (threadIdx.x == 0) (void)xb_add(&bar[XB_XCNT(b.x)], 1u);
    return b;
}
__device__ __forceinline__ void xcd_barrier_complete(unsigned* bar, unsigned x, unsigned& nloc, unsigned& nx) {
    const unsigned G = gridDim.x * gridDim.y * gridDim.z;
    unsigned sum, cnt, mine, sp = 0u;
    for (;;) {
        sum = 0u; cnt = 0u; mine = 0u;
#pragma unroll
        for (unsigned j = 0; j < 16; ++j) { const unsigned c = xb_ld(&bar[XB_XCNT(j)]); sum += c; cnt += (c > 0u) ? 1u : 0u; mine = (j == x) ? c : mine; }
        if (sum == G) break;
        __builtin_amdgcn_s_sleep(1);
        if ((++sp & 255u) == 0u) { if (xb_ld(&bar[XB_TMO])) break; if (sp > XB_SPIN_CAP) { atomicAdd(&bar[XB_TMO], 1u); break; } }
    }
    nloc = mine > 0u ? mine : 1u; nx = cnt > 0u ? cnt : 1u;
}

__device__ __forceinline__ void xcd_barrier(const XcdBarrier& b) {
    asm volatile("s_waitcnt vmcnt(0)" ::: "memory");
    __syncthreads();
    if (threadIdx.x == 0) {
        unsigned* bar = b.bar;
        __builtin_amdgcn_s_waitcnt(0);
        unsigned nloc = b.st[0], nx = b.st[1];
        if (nloc == 0u) { xcd_barrier_complete(bar, b.x, nloc, nx); b.st[0] = nloc; b.st[1] = nx; }
        const unsigned old = xb_add(&bar[XB_XSUB(b.x)], 1u);
        const unsigned gen = old / nloc;
        if (old + 1u == (gen + 1u) * nloc) {
            __builtin_amdgcn_fence(__ATOMIC_RELEASE, "agent");
            asm volatile("s_waitcnt vmcnt(0)" ::: "memory");
            const unsigned og = xb_add(&bar[XB_TOP], 1u);
            const unsigned tg = og / nx;
            if (og + 1u == (tg + 1u) * nx) xb_add(&bar[XB_TOPGEN], 1u);
            else XB_SPIN(xb_ld(&bar[XB_TOPGEN]) == tg, bar);
            __builtin_amdgcn_fence(__ATOMIC_ACQUIRE, "agent");
            xb_add(&bar[XB_XGEN(b.x)], 1u);
            asm volatile("s_waitcnt vmcnt(0)" ::: "memory");
        } else {
            XB_SPIN(xb_ld(&bar[XB_XGEN(b.x)]) == gen, bar);
            __builtin_amdgcn_fence(__ATOMIC_ACQUIRE, "agent");
            asm volatile("s_waitcnt vmcnt(0)" ::: "memory");
        }
    }
    __syncthreads();
}

__device__ __forceinline__ float wave_sum(float v) {
#pragma unroll
    for (int o = 1; o < 64; o <<= 1) v += __shfl_xor(v, o);
    return v;
}
__device__ __forceinline__ float log_sigmoid_f(float x) { return fminf(x, 0.f) - log1pf(expf(-fabsf(x))); }
__device__ __forceinline__ float silu_f(float x) { return x / (1.0f + expf(-x)); }
__device__ __forceinline__ float sigmoid_f(float x) { return 1.0f / (1.0f + expf(-x)); }
__device__ __forceinline__ pg8::bf16x8 ldfrag(const LAS bf16* base, int stride, int r0, int k0, int lane) {
    return *(const LAS pg8::bf16x8*)(base + (r0 + (lane & 15)) * stride + k0 + 8 * (lane >> 4));
}
__device__ __forceinline__ pg8::bf16x8 pack8(const float (&v)[8]) { v4u w; w.x = pk2(v[0], v[1]); w.y = pk2(v[2], v[3]); w.z = pk2(v[4], v[5]); w.w = pk2(v[6], v[7]); return __builtin_bit_cast(pg8::bf16x8, w); }

struct Args {
    const float* x; const float* c; const int* pos; const float* w_mod; const float* b_mod; const float* norm1_w; const float* w_in; const float* gla_wa2; const float* gla_ba2; const float* hg_lb;
    const float* gla_norm_w; const float* hg_norm_w; const float* w_out; const float* norm2_w; const float* w_r; const float* b_r; const float* w_gu; const float* b_gu; const float* w_dn; const float* b_dn;
    const float* final_norm_w; float* out; unsigned char* ws; int ph_lo, ph_hi;
};

__device__ __forceinline__ void transpose_block64(const float* src, int ld, bf16* dst, LAS float* scr, int lane) {
    const int r = lane >> 4, c4 = (lane & 15) * 4;
    f32x4 v[16];
#pragma unroll
    for (int i = 0; i < 16; ++i) v[i] = __builtin_nontemporal_load((const f32x4*)(src + (size_t)(4 * i + r) * ld + c4));
#pragma unroll
    for (int i = 0; i < 16; ++i) { LAS float* w = scr + (4 * i + r) * 65 + c4; w[0] = v[i][0]; w[1] = v[i][1]; w[2] = v[i][2]; w[3] = v[i][3]; }
    LDS_WAIT(); asm volatile("" ::: "memory");
    const int kc = lane & 7;
#pragma unroll
    for (int jj = 0; jj < 8; ++jj) { const int n = (lane >> 3) + 8 * jj; const LAS float* s = scr + (8 * kc) * 65 + n;
        v4u o; o.x = pk2(s[0 * 65], s[1 * 65]); o.y = pk2(s[2 * 65], s[3 * 65]); o.z = pk2(s[4 * 65], s[5 * 65]); o.w = pk2(s[6 * 65], s[7 * 65]);
        *(GAS v4u*)(dst + (size_t)n * D + 8 * kc) = o; }
    LDS_WAIT(); asm volatile("" ::: "memory");
}
__device__ __forceinline__ int pk4_fp8(float a, float b, float c, float d) { int w = 0; w = __builtin_amdgcn_cvt_pk_fp8_f32(fminf(fmaxf(a, -448.f), 448.f), fminf(fmaxf(b, -448.f), 448.f), w, false);
    return __builtin_amdgcn_cvt_pk_fp8_f32(fminf(fmaxf(c, -448.f), 448.f), fminf(fmaxf(d, -448.f), 448.f), w, true); }
__device__ __forceinline__ void transpose_block64_fp8(const float* src, int ld, unsigned char* dst, LAS float* scr, int lane, float sc) {
    const int r = lane >> 4, c4 = (lane & 15) * 4;
    f32x4 v[16];
#pragma unroll
    for (int i = 0; i < 16; ++i) v[i] = __builtin_nontemporal_load((const f32x4*)(src + (size_t)(4 * i + r) * ld + c4));
#pragma unroll
    for (int i = 0; i < 16; ++i) { LAS float* w = scr + (4 * i + r) * 65 + c4; w[0] = v[i][0] * sc; w[1] = v[i][1] * sc; w[2] = v[i][2] * sc; w[3] = v[i][3] * sc; }
    LDS_WAIT(); asm volatile("" ::: "memory");
    const int kc = lane & 3;
#pragma unroll
    for (int jj = 0; jj < 4; ++jj) { const int n = (lane >> 2) + 16 * jj; const LAS float* s = scr + (16 * kc) * 65 + n;
        v4u o; o.x = (unsigned)pk4_fp8(s[0 * 65], s[1 * 65], s[2 * 65], s[3 * 65]); o.y = (unsigned)pk4_fp8(s[4 * 65], s[5 * 65], s[6 * 65], s[7 * 65]);
        o.z = (unsigned)pk4_fp8(s[8 * 65], s[9 * 65], s[10 * 65], s[11 * 65]); o.w = (unsigned)pk4_fp8(s[12 * 65], s[13 * 65], s[14 * 65], s[15 * 65]);
        *(GAS v4u*)(dst + (size_t)n * D + 16 * kc) = o; }
    LDS_WAIT(); asm volatile("" ::: "memory");
}
constexpr int IT_IN = 16 * (NPROJ / 64), IT_OUT = 16 * 16, IT_GU = NE * 16 * 32, IT_DN = NE * 16 * 16, IT_LAYER = IT_IN + IT_OUT + IT_GU + IT_DN, IT_ALL = DEPTH * IT_LAYER;
__device__ __forceinline__ void convert_item(const Args& a, int l, int r, LAS float* scr, int lane) {
    unsigned char* ws = a.ws;
    bf16* WIN = (bf16*)(ws + WS_WIN); bf16* WOUT = (bf16*)(ws + WS_WOUT); unsigned char* WGU = ws + WS_WGU; unsigned char* WDN = ws + WS_WDN;
    if (r < IT_IN) { const int kb = r / (NPROJ / 64), nb = r % (NPROJ / 64), n0 = 64 * nb, sc = n0 + (n0 >= SRC_GA ? 16 : 0);
        if (F8_IN) transpose_block64_fp8(a.w_in + ((size_t)l * D + 64 * kb) * DIN + sc, DIN, (unsigned char*)WIN + ((size_t)l * NPROJ + n0) * D + 64 * kb, scr, lane, S8_W);
        else transpose_block64(a.w_in + ((size_t)l * D + 64 * kb) * DIN + sc, DIN, WIN + ((size_t)l * NPROJ + n0) * D + 64 * kb, scr, lane); return; }
    r -= IT_IN;
    if (r < IT_OUT) { const int kb = r / 16, nb = r % 16;
        if (F8_OUT) transpose_block64_fp8(a.w_out + ((size_t)l * D + 64 * kb) * D + 64 * nb, D, (unsigned char*)WOUT + ((size_t)l * D + 64 * nb) * D + 64 * kb, scr, lane, S8_W);
        else transpose_block64(a.w_out + ((size_t)l * D + 64 * kb) * D + 64 * nb, D, WOUT + ((size_t)l * D + 64 * nb) * D + 64 * kb, scr, lane); return; }
    r -= IT_OUT;
    if (r < IT_GU) { const int e = r / 512, r2 = r % 512, kb = r2 / 32, nb = r2 % 32, cc = 64 * nb;
        const int row = (cc < 1024) ? 256 * (cc / 128) + (cc % 128) : 256 * ((cc - 1024) / 128) + 128 + ((cc - 1024) % 128);
        transpose_block64_fp8(a.w_gu + (((size_t)l * NE + e) * D + 64 * kb) * 2048 + cc, 2048, WGU + (((size_t)l * NE + e) * 2048 + row) * D + 64 * kb, scr, lane, S8_W); return; }
    r -= IT_GU;
    { const int e = r / 256, r2 = r % 256, kb = r2 / 16, nb = r2 % 16;
        transpose_block64_fp8(a.w_dn + (((size_t)l * NE + e) * FFN + 64 * kb) * D + 64 * nb, D, WDN + (((size_t)l * NE + e) * D + 64 * nb) * D + 64 * kb, scr, lane, S8_W); }
}
constexpr int CB2 = 4, CB7 = 2, CB8 = 2;
__device__ __forceinline__ int conv_t2(int G) { return (G == 256) ? 192 * NWAVES * CB2 : 0; }
__device__ __forceinline__ int conv_idle(int nunits, int G) { const int rem = nunits % G; return rem ? G - rem : 0; }
__device__ __forceinline__ void convert_range(const Args& a, int l, int first, int count, LAS unsigned char* lds, int lane, int wave) {
    LAS float* scr = (LAS float*)(lds + wave * 16640);
    for (int k = 0; k < count; ++k) { const int it = first + k; if (it < IT_LAYER) convert_item(a, l, it, scr, lane); }
}
__device__ __forceinline__ void p0_prologue(const Args& a, LAS unsigned char* lds, int vcu, int G, int tid, int lane, int wave) {
    unsigned char* ws = a.ws;
    LAS float* scr = (LAS float*)(lds + wave * 16640);
    const int gw = vcu * NWAVES + wave, NGW = G * NWAVES;
    for (int it = gw; it < IT_LAYER; it += NGW) convert_item(a, 0, it, scr, lane);
    __syncthreads();
    {
        LAS float* cact = (LAS float*)lds;
        LAS float* red = (LAS float*)(lds + 8192);
        for (int i = tid; i < 2 * D; i += NTHR) cact[i] = silu_f(a.c[i]);
        __syncthreads();
        float* MOD = (float*)(ws + WS_MOD);
        for (int it = vcu; it < DEPTH * 96; it += G) {
            const int l = it / 96, n0 = (it % 96) * 64;
            const float* wp = a.w_mod + ((size_t)l * D + 128 * wave) * 6144 + n0 + lane;
            float a0 = 0.f, a1 = 0.f;
#pragma unroll 32
            for (int k = 0; k < 128; ++k) { const float w = __builtin_nontemporal_load(wp + (size_t)k * 6144); a0 += cact[128 * wave + k] * w; a1 += cact[D + 128 * wave + k] * w; }
            red[(wave * 2 + 0) * 64 + lane] = a0; red[(wave * 2 + 1) * 64 + lane] = a1;
            __syncthreads();
            if (tid < 128) { const int b = tid >> 6, ln = tid & 63; float s = a.b_mod[l * 6144 + n0 + ln];
#pragma unroll
                for (int w = 0; w < 8; ++w) s += red[(w * 2 + b) * 64 + ln];
                MOD[((size_t)l * 2 + b) * 6144 + n0 + ln] = s; }
            __syncthreads();
        }
    }
    { const f32x4* xs = (const f32x4*)a.x; uint2* xd = (uint2*)(ws + WS_X);
        for (int i = vcu * NTHR + tid; i < MTOK * D / 4; i += G * NTHR) { const f32x4 v = xs[i]; uint2 p; p.x = pk2(v[0], v[1]); p.y = pk2(v[2], v[3]); xd[i] = p; } }
    {
        float* ROPE = (float*)(ws + WS_ROPE);
        for (int i = vcu * NTHR + tid; i < MTOK * 24; i += G * NTHR) { const int t = i / 24, f = i % 24;
            const float inv = (float)pow(10000.0, -(double)f / 24.0); const float ang = (float)a.pos[t] * inv;
            ROPE[(size_t)t * 48 + f] = cosf(ang); ROPE[(size_t)t * 48 + 24 + f] = sinf(ang); }
    }
    if (vcu == 0 && tid < 256) {
        float v[4], mx = -3.0e38f; for (int l = 0; l < 4; ++l) { v[l] = a.hg_lb[l * 256 + tid]; mx = fmaxf(mx, v[l]); }
        float s = 0.f; for (int l = 0; l < 4; ++l) { v[l] = expf(v[l] - mx); s += v[l]; }
        float* LB = (float*)(ws + WS_LB); float cs = 0.f, first = 0.f;
        for (int l = 0; l < 4; ++l) { cs += v[l] / s; if (l == 0) first = cs; LB[l * 256 + tid] = cs - first; }
    }
}

__device__ __forceinline__ void moe_combine_row(f32x4 (&v)[4], int m, const bf16* Y, const int* SLOT, const float* TOPW, const float* g2, int lane) {
    const int4 sl = *(const int4*)(SLOT + (size_t)m * 4); const f32x4 tw = *(const f32x4*)(TOPW + (size_t)m * 4);
    const int s[4] = {sl.x, sl.y, sl.z, sl.w};
    f32x4 acc[4];
#pragma unroll
    for (int j = 0; j < 4; ++j) acc[j] = (f32x4){0.f, 0.f, 0.f, 0.f};
#pragma unroll
    for (int k = 0; k < 4; ++k) { const bf16* yr = Y + (size_t)s[k] * D + 4 * lane; const float w = tw[k];
#pragma unroll
        for (int j = 0; j < 4; ++j) { const uint2 p = *(const uint2*)(yr + 256 * j);
            acc[j][0] += w * __builtin_bit_cast(float, p.x << 16); acc[j][1] += w * __builtin_bit_cast(float, p.x & 0xffff0000u);
            acc[j][2] += w * __builtin_bit_cast(float, p.y << 16); acc[j][3] += w * __builtin_bit_cast(float, p.y & 0xffff0000u); } }
#pragma unroll
    for (int j = 0; j < 4; ++j) { const f32x4 g = *(const f32x4*)(g2 + 4 * lane + 256 * j); v[j] = v[j] + g * acc[j]; }
}
__device__ __forceinline__ float row_rstd(const f32x4 (&v)[4]) {
    float s = 0.f;
#pragma unroll
    for (int j = 0; j < 4; ++j) s += (v[j][0] * v[j][0] + v[j][1] * v[j][1]) + (v[j][2] * v[j][2] + v[j][3] * v[j][3]);
    return 1.0f / sqrtf(wave_sum(s) * (1.0f / D) + EPS);
}
__device__ __forceinline__ void modulate_row(f32x4 (&v)[4], float rstd, const float* nw, const float* sc, const float* sh, bf16* hrow, int lane) {
#pragma unroll
    for (int j = 0; j < 4; ++j) { const int c0 = 4 * lane + 256 * j; const f32x4 w = *(const f32x4*)(nw + c0), s1 = *(const f32x4*)(sc + c0), s0 = *(const f32x4*)(sh + c0);
        v[j] = v[j] * rstd * w * (s1 + 1.0f) + s0;
        uint2 p; p.x = pk2(v[j][0], v[j][1]); p.y = pk2(v[j][2], v[j][3]); *(uint2*)(hrow + c0) = p; }
}


constexpr int LR_SLT = 142976, LR_TWL = 144000, LR_SSR = 145024;
__device__ __forceinline__ void stage_slots(const unsigned char* ws, int row0, LAS unsigned char* lds, int tid) {
    if (tid < 64) { *(LAS v4u*)(lds + LR_SLT + 16 * tid) = *(const v4u*)((const int*)(ws + WS_SLOT) + (size_t)(row0 + tid) * 4);
                    *(LAS f32x4*)(lds + LR_TWL + 16 * tid) = *(const f32x4*)((const float*)(ws + WS_TOPW) + (size_t)(row0 + tid) * 4); }
}
template <bool SS, bool OUTF32>
__device__ __forceinline__ void flat_combine(const bf16* xsrc, void* xdst, int row0, const bf16* Y, const float* g2, LAS unsigned char* lds, int tid, int lane) {
    const int c4 = tid & 255, rsub = tid >> 8; const f32x4 g = *(const f32x4*)(g2 + 4 * c4);
#pragma unroll 8
    for (int it = 0; it < 32; ++it) { const int i = 2 * it + rsub; const size_t m = (size_t)(row0 + i);
        f32x4 v; { const uint2 xp = *(const uint2*)(xsrc + m * D + 4 * c4); v[0] = __builtin_bit_cast(float, xp.x << 16); v[1] = __builtin_bit_cast(float, xp.x & 0xffff0000u); v[2] = __builtin_bit_cast(float, xp.y << 16); v[3] = __builtin_bit_cast(float, xp.y & 0xffff0000u); }
        const v4u sl = *(const LAS v4u*)(lds + LR_SLT + 16 * i); const f32x4 tw = *(const LAS f32x4*)(lds + LR_TWL + 16 * i);
        f32x4 acc;
        if (Y8) { const unsigned char* Yb = (const unsigned char*)Y; typedef float f32x2v __attribute__((ext_vector_type(2)));
            const int q0 = *(const int*)(Yb + (size_t)sl.x * D + 4 * c4), q1 = *(const int*)(Yb + (size_t)sl.y * D + 4 * c4), q2 = *(const int*)(Yb + (size_t)sl.z * D + 4 * c4), q3 = *(const int*)(Yb + (size_t)sl.w * D + 4 * c4);
            const f32x2v a0 = __builtin_amdgcn_cvt_pk_f32_fp8(q0, false), b0 = __builtin_amdgcn_cvt_pk_f32_fp8(q0, true), a1 = __builtin_amdgcn_cvt_pk_f32_fp8(q1, false), b1 = __builtin_amdgcn_cvt_pk_f32_fp8(q1, true);
            const f32x2v a2 = __builtin_amdgcn_cvt_pk_f32_fp8(q2, false), b2 = __builtin_amdgcn_cvt_pk_f32_fp8(q2, true), a3 = __builtin_amdgcn_cvt_pk_f32_fp8(q3, false), b3 = __builtin_amdgcn_cvt_pk_f32_fp8(q3, true);
            const f32x4 tws = tw * (1.0f / S8_Y);
            acc[0] = tws[0] * a0[0] + tws[1] * a1[0] + tws[2] * a2[0] + tws[3] * a3[0]; acc[1] = tws[0] * a0[1] + tws[1] * a1[1] + tws[2] * a2[1] + tws[3] * a3[1];
            acc[2] = tws[0] * b0[0] + tws[1] * b1[0] + tws[2] * b2[0] + tws[3] * b3[0]; acc[3] = tws[0] * b0[1] + tws[1] * b1[1] + tws[2] * b2[1] + tws[3] * b3[1]; }
        else {
        const uint2 p0 = *(const uint2*)(Y + (size_t)sl.x * D + 4 * c4), p1 = *(const uint2*)(Y + (size_t)sl.y * D + 4 * c4), p2 = *(const uint2*)(Y + (size_t)sl.z * D + 4 * c4), p3 = *(const uint2*)(Y + (size_t)sl.w * D + 4 * c4);
        acc[0] = tw[0] * __builtin_bit_cast(float, p0.x << 16) + tw[1] * __builtin_bit_cast(float, p1.x << 16) + tw[2] * __builtin_bit_cast(float, p2.x << 16) + tw[3] * __builtin_bit_cast(float, p3.x << 16);
        acc[1] = tw[0] * __builtin_bit_cast(float, p0.x & 0xffff0000u) + tw[1] * __builtin_bit_cast(float, p1.x & 0xffff0000u) + tw[2] * __builtin_bit_cast(float, p2.x & 0xffff0000u) + tw[3] * __builtin_bit_cast(float, p3.x & 0xffff0000u);
        acc[2] = tw[0] * __builtin_bit_cast(float, p0.y << 16) + tw[1] * __builtin_bit_cast(float, p1.y << 16) + tw[2] * __builtin_bit_cast(float, p2.y << 16) + tw[3] * __builtin_bit_cast(float, p3.y << 16);
        acc[3] = tw[0] * __builtin_bit_cast(float, p0.y & 0xffff0000u) + tw[1] * __builtin_bit_cast(float, p1.y & 0xffff0000u) + tw[2] * __builtin_bit_cast(float, p2.y & 0xffff0000u) + tw[3] * __builtin_bit_cast(float, p3.y & 0xffff0000u); }
        v = v + g * acc;
        if (OUTF32) *(f32x4*)((float*)xdst + m * D + 4 * c4) = v;
        else { uint2 xo; xo.x = pk2(v[0], v[1]); xo.y = pk2(v[2], v[3]); *(uint2*)((bf16*)xdst + m * D + 4 * c4) = xo; }
        if (SS) { const float sq = wave_sum((v[0] * v[0] + v[1] * v[1]) + (v[2] * v[2] + v[3] * v[3])); if (lane == 0) __hip_atomic_fetch_add((LAS float*)(lds + LR_SSR) + i, sq, __ATOMIC_RELAXED, __HIP_MEMORY_SCOPE_WORKGROUP); } }
}
template <bool F8>
__device__ __forceinline__ void flat_modulate(const bf16* xin, int row0, const LAS float* rstds, const float* nw, const float* scp, const float* shp, bf16* H, int tid) {
    const int c4 = tid & 255, rsub = tid >> 8; const f32x4 w = *(const f32x4*)(nw + 4 * c4), s1 = *(const f32x4*)(scp + 4 * c4), s0 = *(const f32x4*)(shp + 4 * c4); const f32x4 ws1 = w * (s1 + 1.0f);
#pragma unroll 8
    for (int it = 0; it < 32; ++it) { const int i = 2 * it + rsub; const size_t m = (size_t)(row0 + i); const uint2 xp = *(const uint2*)(xin + m * D + 4 * c4);
        const f32x4 v = (f32x4){__builtin_bit_cast(float, xp.x << 16), __builtin_bit_cast(float, xp.x & 0xffff0000u), __builtin_bit_cast(float, xp.y << 16), __builtin_bit_cast(float, xp.y & 0xffff0000u)} * rstds[i] * ws1 + s0;
        if (F8) *(int*)((unsigned char*)H + m * D + 4 * c4) = pk4_fp8(v[0] * S8_H, v[1] * S8_H, v[2] * S8_H, v[3] * S8_H);
        else { uint2 p; p.x = pk2(v[0], v[1]); p.y = pk2(v[2], v[3]); *(uint2*)(H + m * D + 4 * c4) = p; } }
}

constexpr int WP = 1032;
constexpr int LR_WHI = 0, LR_PART = 132096, LR_SSX = 140288, LR_RSTD = 140544, LR_BIAS = 140800, LR_RED = 140928;
template <int NEO>
__device__ __forceinline__ void rows_mfma(const Args& a, int layer, LAS unsigned char* lds, volatile LAS unsigned* MISC, gu32* ctl, int vcu, int G, int tid, int lane, int wave) {
    constexpr bool P5 = (NEO == 32); constexpr int NET = NEO / 16;
    unsigned char* ws = a.ws; bf16* X = (bf16*)(ws + WS_X); bf16* H = (bf16*)(ws + WS_H); const float* MOD = (const float*)(ws + WS_MOD);
    LAS bf16* Whi = (LAS bf16*)(lds + LR_WHI); LAS bf16* Wlo = Whi + NEO * WP; LAS float* part = (LAS float*)(lds + LR_PART); LAS float* ssx = (LAS float*)(lds + LR_SSX);
    LAS float* rstds = (LAS float*)(lds + LR_RSTD); LAS float* biasl = (LAS float*)(lds + LR_BIAS); LAS float* red = (LAS float*)(lds + LR_RED);
    const float* nw = (P5 ? a.norm2_w : a.norm1_w) + layer * D;
    const float* Wsrc = P5 ? a.w_r + (size_t)layer * D * NE : a.w_in + (size_t)layer * D * DIN + SRC_GA; const int wld = P5 ? NE : DIN;
    if (P5) { if (tid < NE) MISC[MW_HIST + tid] = 0u; }
    for (int row0 = vcu * 64; row0 < MTOK; row0 += G * 64) {
        const int b = row0 / SEQ; const float* mp = MOD + ((size_t)layer * 2 + b) * 6144; const float* scp = mp + (P5 ? 4 : 1) * D; const float* shp = mp + (P5 ? 3 : 0) * D;
        if (!P5 && layer > 0) { stage_slots(ws, row0, lds, tid); __syncthreads(); }
        { const int e = tid % NEO, kq = tid / NEO; constexpr int NPT = NTHR / NEO;
#pragma unroll 1
            for (int it0 = 0; it0 < D / NPT; it0 += 8) { float wv[8];
#pragma unroll
                for (int u = 0; u < 8; ++u) { const int k = kq + NPT * (it0 + u); wv[u] = Wsrc[(size_t)k * wld + e] * (nw[k] * (1.0f + scp[k])); }
#pragma unroll
                for (int u = 0; u < 8; ++u) { const int k = kq + NPT * (it0 + u); const unsigned hi = f2bf(wv[u]); const float wl = wv[u] - __builtin_bit_cast(float, hi << 16); Whi[e * WP + k] = (bf16)hi; Wlo[e * WP + k] = (bf16)f2bf(wl); } }
            constexpr int KP = D / NPT; float sacc = 0.f;
#pragma unroll 8
            for (int k = kq * KP; k < kq * KP + KP; ++k) sacc += shp[k] * Wsrc[(size_t)k * wld + e];
            red[kq * NEO + e] = sacc; }
        const bf16* xin = X;
        if (!P5 && layer > 0) { flat_combine<false, false>(X, X, row0, (const bf16*)(ws + WS_Y), MOD + ((size_t)(layer - 1) * 2 + b) * 6144 + 5 * D, lds, tid, lane); asm volatile("s_waitcnt vmcnt(0)" ::: "memory"); }
        __syncthreads();
        if (tid < NEO) { constexpr int NPT = NTHR / NEO; float sacc = P5 ? a.b_r[layer * NE + tid] : 0.f; for (int q = 0; q < NPT; ++q) sacc += red[q * NEO + tid]; biasl[tid] = sacc; }
        const int rg = wave >> 1, kh = wave & 1, r = lane & 15, g = lane >> 4;
        { const bf16* xr = xin + (size_t)(row0 + 16 * rg + r) * D; f32x4 acc[NET]; float ss = 0.f;
#pragma unroll
            for (int et = 0; et < NET; ++et) acc[et] = (f32x4){0.f, 0.f, 0.f, 0.f};
#pragma unroll 4
            for (int s = 16 * kh; s < 16 * kh + 16; ++s) { const int k0 = 32 * s + 8 * g; const v4u xp = *(const v4u*)(xr + k0); const unsigned xw[4] = {xp.x, xp.y, xp.z, xp.w};
#pragma unroll
                for (int j = 0; j < 4; ++j) { const float xa = __builtin_bit_cast(float, xw[j] << 16), xb = __builtin_bit_cast(float, xw[j] & 0xffff0000u); ss += xa * xa + xb * xb; }
                const pg8::bf16x8 ahi = __builtin_bit_cast(pg8::bf16x8, xp);
#pragma unroll
                for (int et = 0; et < NET; ++et) { const pg8::bf16x8 whi = ldfrag(Whi, WP, 16 * et, 32 * s, lane), wlo = ldfrag(Wlo, WP, 16 * et, 32 * s, lane);
                    acc[et] = __builtin_amdgcn_mfma_f32_16x16x32_bf16(ahi, whi, acc[et], 0, 0, 0); acc[et] = __builtin_amdgcn_mfma_f32_16x16x32_bf16(ahi, wlo, acc[et], 0, 0, 0); } }
            ss += __shfl_xor(ss, 16); ss += __shfl_xor(ss, 32);
            if (kh == 1) {
#pragma unroll
                for (int et = 0; et < NET; ++et)
#pragma unroll
                    for (int q = 0; q < 4; ++q) part[(rg * 16 + 4 * g + q) * 32 + 16 * et + r] = acc[et][q];
                if (g == 0) ssx[rg * 16 + r] = ss; }
            __syncthreads();
            if (kh == 0) { const float sst = ss + ssx[rg * 16 + r]; if (g == 0) rstds[rg * 16 + r] = 1.0f / sqrtf(sst * (1.0f / D) + EPS);
                asm volatile("s_waitcnt lgkmcnt(0)" ::: "memory");
#pragma unroll
                for (int et = 0; et < NET; ++et)
#pragma unroll
                    for (int q = 0; q < 4; ++q) { const int i = rg * 16 + 4 * g + q, e = 16 * et + r; const float v = rstds[i] * (acc[et][q] + part[i * 32 + e]) + biasl[e];
                        if (P5) part[i * 32 + e] = v; else ((float*)(ws + WS_GA))[(size_t)(row0 + i) * 16 + e] = v; }
                if (P5) { asm volatile("s_waitcnt lgkmcnt(0)" ::: "memory");
                    if (lane < 16) { const int i = rg * 16 + lane, m = row0 + i; float lv[NE];
#pragma unroll
                        for (int e = 0; e < NE; ++e) lv[e] = part[i * 32 + e];
                        float tv[4]; int te[4];
#pragma unroll
                        for (int t = 0; t < 4; ++t) { float best = -3.0e38f; int bi = 0;
#pragma unroll
                            for (int e = 0; e < NE; ++e) if (lv[e] > best) { best = lv[e]; bi = e; }
#pragma unroll
                            for (int e = 0; e < NE; ++e) if (e == bi) lv[e] = -3.0e38f;
                            tv[t] = best; te[t] = bi; }
                        const float e1 = expf(tv[1] - tv[0]), e2 = expf(tv[2] - tv[0]), e3 = expf(tv[3] - tv[0]); const float inv = 1.0f / (1.0f + e1 + e2 + e3);
                        *(f32x4*)((float*)(ws + WS_TOPW) + (size_t)m * 4) = (f32x4){inv, e1 * inv, e2 * inv, e3 * inv};
#pragma unroll
                        for (int t = 0; t < 4; ++t) { const unsigned rk = __hip_atomic_fetch_add((LAS unsigned*)&MISC[MW_HIST + te[t]], 1u, __ATOMIC_RELAXED, __HIP_MEMORY_SCOPE_WORKGROUP);
                            ((LAS unsigned*)(lds + LR_SLT))[i * 4 + t] = ((unsigned)te[t] << 16) | rk; } } } }
            __syncthreads(); }
        if (P5) { if (tid < NE) { const unsigned hcnt = MISC[MW_HIST + tid]; MISC[MW_BASE + tid] = hcnt ? atomicAdd((unsigned*)(ctl + CW_CNT + layer * NE + tid), hcnt) : 0u; }
            __syncthreads();
            if (tid < 256) { LAS unsigned* sl = (LAS unsigned*)(lds + LR_SLT) + tid; const unsigned v = *sl, e = v >> 16; const unsigned slot = (e << ECAP_SH) + MISC[MW_BASE + e] + (v & 0xffffu);
                *sl = slot; ((int*)(ws + WS_SLOT))[(size_t)row0 * 4 + tid] = (int)slot; }
            if (tid < NE) MISC[MW_HIST + tid] = 0u;
            __syncthreads(); }
        if (P5) { const int c4 = tid & 255, rsub = tid >> 8; const f32x4 w = *(const f32x4*)(nw + 4 * c4), s1 = *(const f32x4*)(scp + 4 * c4), s0 = *(const f32x4*)(shp + 4 * c4); const f32x4 ws1 = w * (s1 + 1.0f);
            unsigned char* A1 = ws + WS_A1;
#pragma unroll 8
            for (int it = 0; it < 32; ++it) { const int i = 2 * it + rsub; const uint2 xp = *(const uint2*)(xin + (size_t)(row0 + i) * D + 4 * c4);
                const f32x4 v = (f32x4){__builtin_bit_cast(float, xp.x << 16), __builtin_bit_cast(float, xp.x & 0xffff0000u), __builtin_bit_cast(float, xp.y << 16), __builtin_bit_cast(float, xp.y & 0xffff0000u)} * rstds[i] * ws1 + s0;
                const int pw = pk4_fp8(v[0] * S8_H, v[1] * S8_H, v[2] * S8_H, v[3] * S8_H); const v4u sl = *(const LAS v4u*)(lds + LR_SLT + 16 * i);
                *(int*)(A1 + (size_t)sl.x * D + 4 * c4) = pw; *(int*)(A1 + (size_t)sl.y * D + 4 * c4) = pw; *(int*)(A1 + (size_t)sl.z * D + 4 * c4) = pw; *(int*)(A1 + (size_t)sl.w * D + 4 * c4) = pw; } }
        else flat_modulate<F8_IN>(xin, row0, rstds, nw, scp, shp, H, tid);
        __syncthreads();
    }
}

__device__ __forceinline__ void final_rows(const Args& a, LAS unsigned char* lds, int vcu, int G, int tid, int lane) {
    unsigned char* ws = a.ws; const bf16* X = (const bf16*)(ws + WS_X); const float* MOD = (const float*)(ws + WS_MOD); LAS float* ssr = (LAS float*)(lds + LR_SSR);
    for (int row0 = vcu * 64; row0 < MTOK; row0 += G * 64) { const int b = row0 / SEQ;
        stage_slots(ws, row0, lds, tid); if (tid < 64) ssr[tid] = 0.f;
        __syncthreads();
        flat_combine<true, true>(X, a.out, row0, (const bf16*)(ws + WS_Y), MOD + ((size_t)(DEPTH - 1) * 2 + b) * 6144 + 5 * D, lds, tid, lane);
        asm volatile("s_waitcnt vmcnt(0)" ::: "memory");
        __syncthreads();
        { const int c4 = tid & 255, rsub = tid >> 8; const f32x4 w = *(const f32x4*)(a.final_norm_w + 4 * c4);
#pragma unroll 8
            for (int it = 0; it < 32; ++it) { const int i = 2 * it + rsub; float* op = a.out + (size_t)(row0 + i) * D + 4 * c4; const float rstd = 1.0f / sqrtf(ssr[i] * (1.0f / D) + EPS); *(f32x4*)op = *(const f32x4*)op * rstd * w; } }
        __syncthreads();
    }
}

__device__ __noinline__ void moe_tables(gu32* ctl, int layer, volatile LAS unsigned* MISC, int tid) {
    if (tid < NE) MISC[MW_CNT + tid] = __hip_atomic_load(ctl + CW_CNT + layer * NE + tid, RLX_AGENT);
    __syncthreads();
    if (tid == 0) { unsigned n = 0;
        for (int e = 0; e < NE; ++e) { const unsigned nt = (MISC[MW_CNT + e] + 255u) >> 8; for (unsigned t = 0; t < nt; ++t) MISC[MW_TILE + n + t] = (unsigned)(e * 64) + t; n += nt; }
        MISC[MW_NRT] = n; }
    __syncthreads();
}

constexpr int BP = 72;
template <int TYPE> struct MixCfg { static constexpr int DK = (TYPE == 1) ? 64 : 48, DV = (TYPE == 1) ? 64 : 96, NC = 4 * DK, NV = 4 * DV;
    static constexpr int STOFF = (TYPE == 0) ? ST_GLA : (TYPE == 1) ? ST_HG : ST_RET, COFF = (TYPE == 0) ? 0 : 192;
    static constexpr int CQ = (TYPE == 0) ? C_GQ : (TYPE == 1) ? C_HQ : C_RQ, CK = (TYPE == 0) ? C_GK : (TYPE == 1) ? C_HF : C_RK, CV = (TYPE == 0) ? C_GV : (TYPE == 1) ? C_HI : C_RV, CG = (TYPE == 0) ? C_GG : (TYPE == 1) ? C_HG : C_RG;
    static constexpr int MIXOFF = (TYPE == 0) ? 0 : (TYPE == 1) ? 384 : 640, KOFF = (TYPE == 0) ? 0 : (TYPE == 1) ? 192 : 448; };
__device__ __forceinline__ float fast_logsig(float x) { x = fmaxf(x, -80.f); return -__logf(1.0f + __expf(-x)); }
__device__ __forceinline__ float ret_lg(int h) { return logf(1.0f - exp2f(-5.0f - (float)h)); }

template <int NV>
__device__ __forceinline__ void stage_vt(const bf16* pv  , LAS bf16* VT, int tid) {
    constexpr int NIT = (64 * (NV / 8)) / NTHR; static_assert((64 * (NV / 8)) % NTHR == 0, "stage_vt");
    v4u p[NIT];
#pragma unroll
    for (int it = 0; it < NIT; ++it) { const int idx = tid + NTHR * it, j = idx & 63, ch = idx >> 6; p[it] = *(const v4u*)(pv + (size_t)j * NPROJ + 8 * ch); }
#pragma unroll
    for (int it = 0; it < NIT; ++it) { const int idx = tid + NTHR * it, j = idx & 63, ch = idx >> 6; LAS bf16* d = VT + (8 * ch) * BP + j;
        d[0 * BP] = (bf16)(p[it].x & 0xffffu); d[1 * BP] = (bf16)(p[it].x >> 16); d[2 * BP] = (bf16)(p[it].y & 0xffffu); d[3 * BP] = (bf16)(p[it].y >> 16);
        d[4 * BP] = (bf16)(p[it].z & 0xffffu); d[5 * BP] = (bf16)(p[it].z >> 16); d[6 * BP] = (bf16)(p[it].w & 0xffffu); d[7 * BP] = (bf16)(p[it].w >> 16); }
}

constexpr int LA_KT = 0, LA_VT = 36864, LA_TOT = 92160, LA_GA = 94208, LA_KTT = 98304, KTP = 264;
template <int TYPE>
__device__ __forceinline__ void mixa_batch(const Args& a, int layer, int unit, LAS unsigned char* lds, int tid, int lane, int wave) {
    asm volatile("" : "+v"(tid), "+v"(lane));
    typedef MixCfg<TYPE> C; constexpr int DK = C::DK, DV = C::DV, NC = C::NC, NV = C::NV;
    unsigned char* ws = a.ws; const bf16* PROJ = (const bf16*)(ws + WS_PROJ); float* CUM = (float*)(ws + WS_CUM); float* DVEC = (float*)(ws + WS_DVEC) + (size_t)unit * NDV;
    bf16* U = (bf16*)(ws + WS_U) + (size_t)unit * ST_TOT + C::STOFF;
    LAS bf16* KT = (LAS bf16*)(lds + LA_KT); LAS bf16* VT = (LAS bf16*)(lds + LA_VT); LAS float* TOT = (LAS float*)(lds + LA_TOT); const LAS float* GAs = (const LAS float*)(lds + LA_GA);
    const int row0 = unit * CH;
    stage_vt<NV>(PROJ + (size_t)row0 * NPROJ + C::CV, VT, tid);
    const bool act = tid < 2 * NC; const int c = act ? tid % NC : 0, half = act ? tid / NC : 0, h = c / DK, d = c - h * DK;
    float cum[32]; float tot = 0.f;
    float w2[16], b2 = 0.f, lbv = 0.f, lg = 0.f, sg = 0.f; int f = 0, d2 = 0;
    if (act) {
        if constexpr (TYPE == 0) { b2 = a.gla_ba2[layer * 192 + c];
#pragma unroll
            for (int r = 0; r < 16; ++r) w2[r] = a.gla_wa2[(layer * 16 + r) * 192 + c]; }
        if constexpr (TYPE == 1) lbv = ((const float*)(ws + WS_LB))[layer * 256 + c];
        if constexpr (TYPE == 2) { lg = ret_lg(h); f = (d < 24) ? d : d - 24; d2 = (d < 24) ? d + 24 : d - 24; sg = (d < 24) ? -1.f : 1.f; }
#pragma unroll
        for (int gq = 0; gq < 2; ++gq) {
            bf16 hraw[16];
            if constexpr (TYPE == 1) {
#pragma unroll
                for (int i = 0; i < 16; ++i) hraw[i] = PROJ[(size_t)(row0 + 32 * half + 16 * gq + i) * NPROJ + C_HF + c]; }
#pragma unroll
            for (int ii = 0; ii < 16; ++ii) { const int i = 16 * gq + ii, t = 32 * half + i; float g;
                if constexpr (TYPE == 0) { float pre = b2;
#pragma unroll
                    for (int r = 0; r < 16; ++r) pre += GAs[t * 16 + r] * w2[r];
                    g = fast_logsig(pre) * (1.0f / 16.0f); }
                else if constexpr (TYPE == 1) { const float hf = fminf(fmaxf(bf2f(hraw[ii]), -80.f), 80.f); const float sgm = 1.0f / (1.0f + __expf(-hf));
                    g = __logf(lbv + (1.0f - lbv) * sgm); }
                else g = lg;
                tot += g; cum[i] = tot;
                if constexpr (TYPE == 0) { if ((ii & 3) == 3) asm volatile("" ::: "memory"); } } }
        TOT[c * 2 + half] = tot;
    }
    __syncthreads();
    if (act) { const float t0 = TOT[c * 2], t1 = TOT[c * 2 + 1]; const float off = half ? t0 : 0.f, last = t0 + t1;
#pragma unroll
        for (int hq = 0; hq < 4; ++hq) {
            bf16 ka[8], kb[8]; float cs[8], sn[8];
            if constexpr (TYPE != 1) {
#pragma unroll
                for (int i = 0; i < 8; ++i) { const size_t row = (size_t)(row0 + 32 * half + 8 * hq + i); const bf16* pr = PROJ + row * NPROJ;
                    if constexpr (TYPE == 0) ka[i] = pr[C_GK + c];
                    else { const float* rp = (const float*)(ws + WS_ROPE) + row * 48; ka[i] = pr[C_RK + h * 48 + d]; kb[i] = pr[C_RK + h * 48 + d2]; cs[i] = rp[f]; sn[i] = rp[24 + f]; } } }
            float kt[8];
#pragma unroll
            for (int j = 0; j < 8; ++j) { const int i = 8 * hq + j; const float cm = cum[i] + off; const size_t row = (size_t)(row0 + 32 * half + i); float k;
                if constexpr (TYPE == 0) k = bf2f(ka[j]);
                else if constexpr (TYPE == 1) k = 1.0f - __expf(cum[i] - (i > 0 ? cum[i - 1] : 0.f));
                else k = bf2f(ka[j]) * cs[j] + sg * bf2f(kb[j]) * sn[j];
                if constexpr (TYPE != 2) CUM[row * NDV + C::COFF + c] = cm;
                { const float eb = cum[(i < 16) ? 15 : 31] + off;
                  ((LAS bf16*)(lds + LA_KTT))[(32 * half + i) * KTP + c] = (bf16)f2bf(k * __expf(eb - cm)); }
                kt[j] = k * __expf(last - cm); }
            v4u w; w.x = pk2(kt[0], kt[1]); w.y = pk2(kt[2], kt[3]); w.z = pk2(kt[4], kt[5]); w.w = pk2(kt[6], kt[7]);
            *(LAS v4u*)(KT + c * BP + 32 * half + 8 * hq) = w; }
        if (TYPE != 2 && half == 0) DVEC[C::COFF + c] = __expf(last);
    }
    __syncthreads();
    { constexpr int CPR = NC / 8;
#pragma unroll
        for (int it = 0; it < (64 * CPR) / NTHR; ++it) { const int idx = tid + NTHR * it, t = idx / CPR, ch = idx - t * CPR;
            *(v4u*)((bf16*)(ws + WS_KT) + (size_t)(row0 + t) * NKT + C::KOFF + 8 * ch) = *(const LAS v4u*)((const LAS bf16*)(lds + LA_KTT) + t * KTP + 8 * ch); } }
    constexpr int TD = DK / 16, NT = (DV / 16) * TD;
    for (int ti = wave; ti < 4 * NT; ti += NWAVES) { const int hh = ti / NT, tr = ti - hh * NT, te = tr / TD, td = tr - te * TD; f32x4 acc = {0.f, 0.f, 0.f, 0.f};
#pragma unroll
        for (int kk = 0; kk < 2; ++kk) acc = __builtin_amdgcn_mfma_f32_16x16x32_bf16(ldfrag(VT, BP, hh * DV + te * 16, kk * 32, lane), ldfrag(KT, BP, hh * DK + td * 16, kk * 32, lane), acc, 0, 0, 0);
        bf16* Uh = U + hh * DK * DV;
#pragma unroll
        for (int r = 0; r < 4; ++r) Uh[(te * 16 + (lane >> 4) * 4 + r) * DK + td * 16 + (lane & 15)] = (bf16)f2bf(acc[r]); }
    __syncthreads();
}
__device__ __forceinline__ void p3a_summaries(const Args& a, int layer, LAS unsigned char* lds, int vcu, int G, int tid, int lane, int wave) {
    for (int unit = vcu; unit < NUNIT; unit += G) {
        { LAS float* GAs = (LAS float*)(lds + LA_GA); const float* GA = (const float*)(a.ws + WS_GA); for (int i = tid; i < CH * 16; i += NTHR) GAs[i] = GA[(size_t)unit * CH * 16 + i]; }
        __syncthreads();
        mixa_batch<0>(a, layer, unit, lds, tid, lane, wave);
        mixa_batch<1>(a, layer, unit, lds, tid, lane, wave);
        mixa_batch<2>(a, layer, unit, lds, tid, lane, wave);
    }
}

__device__ __forceinline__ void p3b_scan(const Args& a, int vcu, int G, int tid) {
    unsigned char* ws = a.ws; const bf16* U = (const bf16*)(ws + WS_U); const float* DVEC = (const float*)(ws + WS_DVEC); bf16* SP = (bf16*)(ws + WS_SP);
    for (int gid = vcu * NTHR + tid; gid < BATCH * ST_TOT; gid += G * NTHR) {
        const int b = gid / ST_TOT, el = gid - b * ST_TOT;
        int di = -1; float cdec = 0.f;
        if (el < ST_HG) { const int h = el / 4608, d = (el - h * 4608) % 48; di = h * 48 + d; }
        else if (el < ST_RET) { const int r = el - ST_HG, h = r / 4096, d = r % 64; di = 192 + h * 64 + d; }
        else { const int h = (el - ST_RET) / 4608; cdec = expf(64.0f * logf(1.0f - exp2f(-5.0f - (float)h))); }
        const bf16* up = U + (size_t)b * NCH * ST_TOT + el; const float* dp = DVEC + (size_t)b * NCH * NDV + (di < 0 ? 0 : di); bf16* sp = SP + (size_t)b * NCH * ST_TOT + el;
        float s = 0.f;
#pragma unroll 1
        for (int n0 = 0; n0 < NCH; n0 += 32) { float u[32], dc[32];
#pragma unroll
            for (int i = 0; i < 32; ++i) { u[i] = bf2f(up[(size_t)(n0 + i) * ST_TOT]); dc[i] = (di < 0) ? cdec : dp[(size_t)(n0 + i) * NDV]; }
#pragma unroll
            for (int i = 0; i < 32; ++i) { sp[(size_t)(n0 + i) * ST_TOT] = (bf16)f2bf(s); s = dc[i] * s + u[i]; } }
    }
}

#ifndef SUB_MASK
#define SUB_MASK 0
#endif
#define SUBSTRETCH(bit, t0_) do { if ((SUB_MASK >> (bit)) & 1) { const unsigned long long t1_ = __builtin_amdgcn_s_memrealtime(); while (__builtin_amdgcn_s_memrealtime() - t1_ < t1_ - (t0_)) __builtin_amdgcn_s_sleep(8); } } while (0)
constexpr int LC_VT = 0, LC_ST = 55296, LC_AB = 110592, OBP = 104, LC_EC = 137216;
template <int TYPE, bool ISQ>
__device__ __forceinline__ void mix_frag(const Args& a, int h, size_t row, int t, int d0, float (&x)[8], float (&cm)[8]) {
    typedef MixCfg<TYPE> C; constexpr int DK = C::DK;
    unsigned char* ws = a.ws; const bf16* pr = (const bf16*)(ws + WS_PROJ) + row * NPROJ;
    if constexpr (TYPE == 0) {
        const v4u p = *(const v4u*)(pr + (ISQ ? C_GQ : C_GK) + h * DK + d0); const unsigned pw[4] = {p.x, p.y, p.z, p.w};
        const float* cp = (const float*)(ws + WS_CUM) + row * NDV + h * DK + d0; const f32x4 c0 = *(const f32x4*)cp, c1 = *(const f32x4*)(cp + 4);
#pragma unroll
        for (int j = 0; j < 4; ++j) { x[2 * j] = __builtin_bit_cast(float, pw[j] << 16); x[2 * j + 1] = __builtin_bit_cast(float, pw[j] & 0xffff0000u); cm[j] = c0[j]; cm[4 + j] = c1[j]; }
        if (ISQ) {
#pragma unroll
            for (int j = 0; j < 8; ++j) x[j] *= 0.14433756729740643f; }
    } else if constexpr (TYPE == 1) {
        const float* cp = (const float*)(ws + WS_CUM) + row * NDV + 192 + h * DK + d0; const f32x4 c0 = *(const f32x4*)cp, c1 = *(const f32x4*)(cp + 4);
#pragma unroll
        for (int j = 0; j < 4; ++j) { cm[j] = c0[j]; cm[4 + j] = c1[j]; }
        if (ISQ) { const v4u p = *(const v4u*)(pr + C_HQ + h * DK + d0); const unsigned pw[4] = {p.x, p.y, p.z, p.w};
#pragma unroll
            for (int j = 0; j < 4; ++j) { x[2 * j] = __builtin_bit_cast(float, pw[j] << 16); x[2 * j + 1] = __builtin_bit_cast(float, pw[j] & 0xffff0000u); } }
        else { f32x4 p0 = {0.f, 0.f, 0.f, 0.f}, p1 = {0.f, 0.f, 0.f, 0.f}; if (t > 0) { p0 = *(const f32x4*)(cp - NDV); p1 = *(const f32x4*)(cp - NDV + 4); }
#pragma unroll
            for (int j = 0; j < 4; ++j) { x[j] = 1.0f - __expf(c0[j] - p0[j]); x[4 + j] = 1.0f - __expf(c1[j] - p1[j]); } }
    } else {
        const int f0 = (d0 < 24) ? d0 : d0 - 24, dp = (d0 < 24) ? d0 + 24 : d0 - 24; const float sg = (d0 < 24) ? -1.f : 1.f;
        const int cb = (ISQ ? C_RQ : C_RK) + h * DK; const v4u p = *(const v4u*)(pr + cb + d0), pp = *(const v4u*)(pr + cb + dp); const unsigned pw[4] = {p.x, p.y, p.z, p.w}, qw[4] = {pp.x, pp.y, pp.z, pp.w};
        const float* rp = (const float*)(ws + WS_ROPE) + row * 48; const f32x4 cs0 = *(const f32x4*)(rp + f0), cs1 = *(const f32x4*)(rp + f0 + 4), sn0 = *(const f32x4*)(rp + 24 + f0), sn1 = *(const f32x4*)(rp + 24 + f0 + 4);
        const float cmv = (float)(t + 1) * ret_lg(h);
#pragma unroll
        for (int j = 0; j < 4; ++j) { const float xa = __builtin_bit_cast(float, pw[j] << 16), xb = __builtin_bit_cast(float, pw[j] & 0xffff0000u), ya = __builtin_bit_cast(float, qw[j] << 16), yb = __builtin_bit_cast(float, qw[j] & 0xffff0000u);
            const float ca = (j < 2) ? cs0[2 * j] : cs1[2 * j - 4], cb2 = (j < 2) ? cs0[2 * j + 1] : cs1[2 * j - 3], sa = (j < 2) ? sn0[2 * j] : sn1[2 * j - 4], sb = (j < 2) ? sn0[2 * j + 1] : sn1[2 * j - 3];
            x[2 * j] = xa * ca + sg * ya * sa; x[2 * j + 1] = xb * cb2 + sg * yb * sb; cm[2 * j] = cmv; cm[2 * j + 1] = cmv; }
        if (ISQ) {
#pragma unroll
            for (int j = 0; j < 8; ++j) x[j] *= 0.14433756729740643f; }
    }
}

template <int TYPE>
__device__ __forceinline__ void mixc_batch(const Args& a, int layer, int unit, LAS unsigned char* lds, int tid, int lane, int wave) {
    asm volatile("" : "+v"(tid), "+v"(lane));
    typedef MixCfg<TYPE> C; constexpr int DK = C::DK, DV = C::DV, NV = C::NV, TE = DV / 16;
    unsigned char* ws = a.ws; const bf16* PROJ = (const bf16*)(ws + WS_PROJ); bf16* MIX = (bf16*)(ws + WS_MIX);
    LAS bf16* VT = (LAS bf16*)(lds + LC_VT); LAS bf16* ST = (LAS bf16*)(lds + LC_ST); LAS bf16* AB = (LAS bf16*)(lds + LC_AB) + wave * 16 * OBP;
    const int row0 = unit * CH;
    const unsigned long long ts0_ = SUB_MASK ? __builtin_amdgcn_s_memrealtime() : 0ull;
    stage_vt<NV>(PROJ + (size_t)row0 * NPROJ + C::CV, VT, tid);
    SUBSTRETCH(3, ts0_);
    const unsigned long long ts3_ = SUB_MASK ? __builtin_amdgcn_s_memrealtime() : 0ull;
    { const bf16* SPu = (const bf16*)(ws + WS_SP) + (size_t)unit * ST_TOT + C::STOFF;
        constexpr int NIS = (NV * 8) / NTHR; static_assert((NV * 8) % NTHR == 0, "ST staging"); v4u sw[NIS];
#pragma unroll
        for (int it = 0; it < NIS; ++it) { const int idx = tid + NTHR * it, er = idx >> 3, ch = idx & 7; sw[it] = (v4u){0u, 0u, 0u, 0u}; if (ch * 8 < DK) sw[it] = *(const v4u*)(SPu + (size_t)er * DK + ch * 8); }
#pragma unroll
        for (int it = 0; it < NIS; ++it) { const int idx = tid + NTHR * it, er = idx >> 3, ch = idx & 7; *(LAS v4u*)(ST + er * BP + ch * 8) = sw[it]; } }
    SUBSTRETCH(4, ts3_);
    SUBSTRETCH(0, ts0_);
    if constexpr (TYPE != 2) { LAS float* EC = (LAS float*)(lds + LC_EC);
        for (int idx = tid; idx < 4 * C::NC; idx += NTHR) { const int jb = idx / C::NC, cc = idx - jb * C::NC; EC[jb * 256 + cc] = ((const float*)(ws + WS_CUM))[(size_t)(row0 + 16 * jb + 15) * NDV + C::COFF + cc]; } }
    __syncthreads();
    const unsigned long long ts1_ = SUB_MASK ? __builtin_amdgcn_s_memrealtime() : 0ull;
    const int h = wave >> 1, hsel = wave & 1, r = lane & 15, g = lane >> 4;
    const LAS bf16* STh = ST + h * DV * BP; const LAS bf16* VTh = VT + h * DV * BP;
    const float* CUMp = (const float*)(ws + WS_CUM);
    constexpr int NCHK = DV / 8, NOC = (16 * NCHK) / 64;
#pragma unroll 1
    for (int ib = 0; ib < 2; ++ib) { const int I = ib ? 3 - hsel : hsel;
        pg8::bf16x8 qh[2], qt[2]; float refv[2][8], qhf[2][8];
#pragma unroll
        for (int s = 0; s < 2; ++s) { const int d0 = 32 * s + 8 * g; const bool valid = d0 < DK; const int d0c = valid ? d0 : 0;
            float x[8], cm[8]; mix_frag<TYPE, true>(a, h, (size_t)(row0 + 16 * I + r), 16 * I + r, d0c, x, cm);
            if constexpr (TYPE == 2) {
#pragma unroll
                for (int j = 0; j < 8; ++j) refv[s][j] = (float)(16 * I) * ret_lg(h);
            } else { if (I > 0) { const LAS float* cp = (const LAS float*)(lds + LC_EC) + (I - 1) * 256 + h * DK + d0c; const f32x4 c0 = *(const LAS f32x4*)cp, c1 = *(const LAS f32x4*)(cp + 4);
#pragma unroll
                    for (int j = 0; j < 4; ++j) { refv[s][j] = c0[j]; refv[s][4 + j] = c1[j]; } }
                else {
#pragma unroll
                    for (int j = 0; j < 8; ++j) refv[s][j] = 0.f; } }
            float xt[8];
#pragma unroll
            for (int j = 0; j < 8; ++j) { qhf[s][j] = valid ? x[j] * __expf(cm[j] - refv[s][j]) : 0.f; xt[j] = valid ? x[j] * __expf(cm[j]) : 0.f; }
            qh[s] = pack8(qhf[s]); qt[s] = pack8(xt); }
        v4u kf[4][2];
#pragma unroll
        for (int J = 0; J < 4; ++J) { const int Jc = (J < I) ? J : I; const size_t rowJ = (size_t)(row0 + 16 * Jc + r);
#pragma unroll
            for (int s = 0; s < 2; ++s) { const int d0 = 32 * s + 8 * g; const int d0c = (d0 < DK) ? d0 : 0;
                kf[J][s] = *(const v4u*)((const bf16*)(ws + WS_KT) + rowJ * NKT + C::KOFF + h * DK + d0c); } }
#pragma unroll
        for (int J = 0; J < 4; ++J) { if (J <= I) { f32x4 acc = {0.f, 0.f, 0.f, 0.f};
#pragma unroll
            for (int s = 0; s < 2; ++s) { pg8::bf16x8 qop;
                { float xq[8], ej[8]; const int d0 = 32 * s + 8 * g; const int d0c = (d0 < DK) ? d0 : 0;
                    if constexpr (TYPE == 2) {
#pragma unroll
                        for (int j = 0; j < 8; ++j) ej[j] = (float)(16 * (J + 1)) * ret_lg(h); }
                    else { const LAS float* ep = (const LAS float*)(lds + LC_EC) + J * 256 + h * DK + d0c; const f32x4 e0 = *(const LAS f32x4*)ep, e1 = *(const LAS f32x4*)(ep + 4);
#pragma unroll
                        for (int j = 0; j < 4; ++j) { ej[j] = e0[j]; ej[4 + j] = e1[j]; } }
#pragma unroll
                    for (int j = 0; j < 8; ++j) xq[j] = qhf[s][j] * __expf(fminf(refv[s][j] - ej[j], 80.f));
                    qop = pack8(xq); }
                acc = __builtin_amdgcn_mfma_f32_16x16x32_bf16(qop, __builtin_bit_cast(pg8::bf16x8, kf[J][s]), acc, 0, 0, 0); }
#pragma unroll
            for (int q = 0; q < 4; ++q) { const int i = 4 * g + q; const float v = (J < I || r <= i) ? acc[q] : 0.f; AB[i * BP + 16 * J + r] = (bf16)f2bf(v); } } }
        if ((I & 1) == 0) {
#pragma unroll
            for (int q = 0; q < 4; ++q) AB[(4 * g + q) * BP + 16 * (I + 1) + r] = (bf16)0; }
        asm volatile("s_waitcnt lgkmcnt(0)" ::: "memory");
        const pg8::bf16x8 ah0 = *(const LAS pg8::bf16x8*)(AB + r * BP + 8 * g), ah1 = *(const LAS pg8::bf16x8*)(AB + r * BP + 32 + 8 * g);
        f32x4 o[TE];
#pragma unroll
        for (int te = 0; te < TE; ++te) { f32x4 acc = {0.f, 0.f, 0.f, 0.f};
            acc = __builtin_amdgcn_mfma_f32_16x16x32_bf16(qt[0], ldfrag(STh, BP, te * 16, 0, lane), acc, 0, 0, 0);
            acc = __builtin_amdgcn_mfma_f32_16x16x32_bf16(qt[1], ldfrag(STh, BP, te * 16, 32, lane), acc, 0, 0, 0);
            acc = __builtin_amdgcn_mfma_f32_16x16x32_bf16(ah0, ldfrag(VTh, BP, te * 16, 0, lane), acc, 0, 0, 0);
            if (I >= 2) acc = __builtin_amdgcn_mfma_f32_16x16x32_bf16(ah1, ldfrag(VTh, BP, te * 16, 32, lane), acc, 0, 0, 0);
            o[te] = acc; }
        const unsigned long long ts2_ = SUB_MASK ? __builtin_amdgcn_s_memrealtime() : 0ull;
#pragma unroll
        for (int q = 0; q < 4; ++q) { float s1 = 0.f, s2 = 0.f;
#pragma unroll
            for (int te = 0; te < TE; ++te) { s1 += o[te][q]; s2 += o[te][q] * o[te][q]; }
#pragma unroll
            for (int m = 1; m < 16; m <<= 1) { s1 += __shfl_xor(s1, m); s2 += __shfl_xor(s2, m); }
            float mean = 0.f, rstd;
            if constexpr (TYPE == 2) { mean = s1 * (1.0f / DV); rstd = 1.0f / sqrtf(fmaxf(s2 * (1.0f / DV) - mean * mean, 0.f) + EPS); }
            else rstd = 1.0f / sqrtf(s2 * (1.0f / DV) + EPS);
#pragma unroll
            for (int te = 0; te < TE; ++te) AB[(4 * g + q) * OBP + te * 16 + r] = (bf16)f2bf((o[te][q] - mean) * rstd); }
        asm volatile("s_waitcnt lgkmcnt(0)" ::: "memory");
#pragma unroll 1
        for (int i = 0; i < NOC; ++i) { const int cidx = lane + 64 * i, orow = cidx / NCHK, ch = cidx - orow * NCHK; const size_t row = (size_t)(row0 + 16 * I + orow);
            const v4u ov = *(const LAS v4u*)(AB + orow * OBP + 8 * ch); const v4u gv = *(const v4u*)(PROJ + row * NPROJ + C::CG + h * DV + 8 * ch);
            const unsigned ow[4] = {ov.x, ov.y, ov.z, ov.w}, gw[4] = {gv.x, gv.y, gv.z, gv.w}; float res[8];
            f32x4 w0 = {1.f, 1.f, 1.f, 1.f}, w1 = {1.f, 1.f, 1.f, 1.f};
            if constexpr (TYPE == 0) { const float* wp = a.gla_norm_w + layer * 384 + h * 96 + 8 * ch; w0 = *(const f32x4*)wp; w1 = *(const f32x4*)(wp + 4); }
            if constexpr (TYPE == 1) { const float* wp = a.hg_norm_w + layer * 256 + h * 64 + 8 * ch; w0 = *(const f32x4*)wp; w1 = *(const f32x4*)(wp + 4); }
#pragma unroll
            for (int j = 0; j < 4; ++j) { const float oa = __builtin_bit_cast(float, ow[j] << 16), ob = __builtin_bit_cast(float, ow[j] & 0xffff0000u), ga = __builtin_bit_cast(float, gw[j] << 16), gb = __builtin_bit_cast(float, gw[j] & 0xffff0000u);
                const float wa = (j < 2) ? w0[2 * j] : w1[2 * j - 4], wb = (j < 2) ? w0[2 * j + 1] : w1[2 * j - 3];
                const float sa = 1.0f / (1.0f + __expf(-ga)), sb = 1.0f / (1.0f + __expf(-gb));
                res[2 * j] = oa * wa * ((TYPE == 1) ? sa : ga * sa); res[2 * j + 1] = ob * wb * ((TYPE == 1) ? sb : gb * sb); }
            if (F8_OUT) { typedef int i32x2 __attribute__((ext_vector_type(2)));
                *(i32x2*)((unsigned char*)MIX + row * D + C::MIXOFF + h * DV + 8 * ch) = (i32x2){pk4_fp8(res[0] * S8_M, res[1] * S8_M, res[2] * S8_M, res[3] * S8_M), pk4_fp8(res[4] * S8_M, res[5] * S8_M, res[6] * S8_M, res[7] * S8_M)}; }
            else { v4u w; w.x = pk2(res[0], res[1]); w.y = pk2(res[2], res[3]); w.z = pk2(res[4], res[5]); w.w = pk2(res[6], res[7]); *(v4u*)(MIX + row * D + C::MIXOFF + h * DV + 8 * ch) = w; } }
        SUBSTRETCH(2, ts2_);
    }
    SUBSTRETCH(1, ts1_);
    __syncthreads();
}
__device__ __forceinline__ void p3c_outputs(const Args& a, int layer, LAS unsigned char* lds, int vcu, int G, int tid, int lane, int wave) {
    for (int unit = vcu; unit < NUNIT; unit += G) {
        mixc_batch<0>(a, layer, unit, lds, tid, lane, wave);
        mixc_batch<1>(a, layer, unit, lds, tid, lane, wave);
        mixc_batch<2>(a, layer, unit, lds, tid, lane, wave);
    }
}


constexpr int MW_ARGS = 800;
__device__ __forceinline__ const void* ld_argp(const volatile LAS unsigned* T, int i) {
    const unsigned lo = __builtin_amdgcn_readfirstlane(T[2 * i]), hi = __builtin_amdgcn_readfirstlane(T[2 * i + 1]);
    return (const void*)(((unsigned long long)hi << 32) | lo);
}
__device__ __forceinline__ Args load_args(LAS unsigned char* lds) {
    const volatile LAS unsigned* T = (const volatile LAS unsigned*)(lds + MISC_OFF) + MW_ARGS;
    Args a;
    a.x = (const float*)ld_argp(T, 0); a.c = (const float*)ld_argp(T, 1); a.pos = (const int*)ld_argp(T, 2); a.w_mod = (const float*)ld_argp(T, 3); a.b_mod = (const float*)ld_argp(T, 4);
    a.norm1_w = (const float*)ld_argp(T, 5); a.w_in = (const float*)ld_argp(T, 6); a.gla_wa2 = (const float*)ld_argp(T, 7); a.gla_ba2 = (const float*)ld_argp(T, 8); a.hg_lb = (const float*)ld_argp(T, 9);
    a.gla_norm_w = (const float*)ld_argp(T, 10); a.hg_norm_w = (const float*)ld_argp(T, 11); a.w_out = (const float*)ld_argp(T, 12); a.norm2_w = (const float*)ld_argp(T, 13); a.w_r = (const float*)ld_argp(T, 14);
    a.b_r = (const float*)ld_argp(T, 15); a.w_gu = (const float*)ld_argp(T, 16); a.b_gu = (const float*)ld_argp(T, 17); a.w_dn = (const float*)ld_argp(T, 18); a.b_dn = (const float*)ld_argp(T, 19);
    a.final_norm_w = (const float*)ld_argp(T, 20); a.out = (float*)ld_argp(T, 21); a.ws = (unsigned char*)ld_argp(T, 22); a.ph_lo = 0; a.ph_hi = 0;
    return a;
}
#define PH_CTX() { unsigned l_ = (unsigned)(size_t)lds; asm volatile("" : "+s"(l_)); lds = (LAS unsigned char*)(size_t)l_; } const Args args = load_args(lds); volatile LAS unsigned* MISC = (volatile LAS unsigned*)(lds + MISC_OFF); int tid_ = wv * 64 + (int)__builtin_amdgcn_mbcnt_hi(~0u, __builtin_amdgcn_mbcnt_lo(~0u, 0u)); asm volatile("" : "+v"(tid_)); const int tid = tid_, lane = tid & 63, wave = __builtin_amdgcn_readfirstlane(tid >> 6); \
    const int G = gridDim.x; const int bx = blockIdx.x; const int vcu = (G % 8 == 0) ? (bx % 8) * (G / 8) + bx / 8 : bx; unsigned char* ws = args.ws; gu32* ctl = (gu32*)(ws + WS_CTL); \
    (void)MISC; (void)lane; (void)wave; (void)vcu; (void)ctl; (void)bx; (void)tid
__device__ __forceinline__ void ph_p0(LAS unsigned char* lds, int wv) { PH_CTX(); p0_prologue(args, lds, vcu, G, tid, lane, wave); }
__device__ __forceinline__ void ph_p1(LAS unsigned char* lds, int wv, int layer_) { int layer = __builtin_amdgcn_readfirstlane(layer_); asm volatile("" : "+s"(layer)); PH_CTX();
    if (layer > 0) { moe_tables(ctl, layer - 1, MISC, tid); const int nrt = __builtin_amdgcn_readfirstlane((int)MISC[MW_NRT]);
        const int done = conv_t2(G) + conv_idle(nrt * 8, G) * NWAVES * CB7 + conv_idle(nrt * 4, G) * NWAVES * CB8; LAS float* scr = (LAS float*)(lds + wave * 16640);
        for (int it = done + vcu * NWAVES + wave; it < IT_LAYER; it += G * NWAVES) convert_item(args, layer, it, scr, lane);
        __syncthreads(); }
    rows_mfma<16>(args, layer, lds, MISC, ctl, vcu, G, tid, lane, wave); }
__device__ __forceinline__ void ph_p2(LAS unsigned char* lds, int wv, int layer_) { int layer = __builtin_amdgcn_readfirstlane(layer_); asm volatile("" : "+s"(layer)); PH_CTX();
    pg8::Gemm g{(const bf16*)(ws + WS_H), (const bf16*)(ws + WS_WIN + (size_t)layer * NPROJ * D * (F8_IN ? 1 : 2)), MTOK, NPROJ, F8_IN ? D / 2 : D}; pg8::StaticOrder S; S.init(MTOK, NPROJ, G, bx);
    pg8::EpiBf16Plain E{(bf16*)(ws + WS_PROJ), NPROJ, F8_IN ? 1.0f / (S8_H * S8_W) : 1.0f};
    pg8::gemm_phase<pg8::EpiBf16Plain, pg8::StaticOrder, true, true, F8_IN>(lds, g, S, E, tid);
    if (layer + 1 < DEPTH && G == 256 && bx >= 64) convert_range(args, layer + 1, ((bx - 64) * NWAVES + wave) * CB2, CB2, lds, lane, wave); }
__device__ __forceinline__ void ph_p3a(LAS unsigned char* lds, int wv, int layer_) { int layer = __builtin_amdgcn_readfirstlane(layer_); asm volatile("" : "+s"(layer)); PH_CTX(); p3a_summaries(args, layer, lds, vcu, G, tid, lane, wave); }
__device__ __forceinline__ void ph_p3b(LAS unsigned char* lds, int wv) { PH_CTX(); p3b_scan(args, vcu, G, tid); }
__device__ __forceinline__ void ph_p3c(LAS unsigned char* lds, int wv, int layer_) { int layer = __builtin_amdgcn_readfirstlane(layer_); asm volatile("" : "+s"(layer)); PH_CTX(); p3c_outputs(args, layer, lds, vcu, G, tid, lane, wave); }
__device__ __forceinline__ void ph_p4(LAS unsigned char* lds, int wv, int layer_) { int layer = __builtin_amdgcn_readfirstlane(layer_); asm volatile("" : "+s"(layer)); PH_CTX();
    pg8::Gemm g{(const bf16*)(ws + WS_MIX), (const bf16*)(ws + WS_WOUT + (size_t)layer * D * D * (F8_OUT ? 1 : 2)), MTOK, D, F8_OUT ? D / 2 : D}; pg8::StaticOrder S; S.init(MTOK, D, G, bx);
    pg8::EpiResGate E{(const bf16*)(ws + WS_X), (bf16*)(ws + WS_X), D, (const float*)(ws + WS_MOD) + (size_t)layer * 2 * 6144 + 2 * D, 6144, SEQ, F8_OUT ? 1.0f / (S8_M * S8_W) : 1.0f};
    pg8::gemm_phase<pg8::EpiResGate, pg8::StaticOrder, true, true, F8_OUT>(lds, g, S, E, tid); }
__device__ __forceinline__ void ph_p5(LAS unsigned char* lds, int wv, int layer_) { int layer = __builtin_amdgcn_readfirstlane(layer_); asm volatile("" : "+s"(layer)); PH_CTX(); rows_mfma<32>(args, layer, lds, MISC, ctl, vcu, G, tid, lane, wave); }
__device__ __forceinline__ void ph_p7(LAS unsigned char* lds, int wv, int layer_) { int layer = __builtin_amdgcn_readfirstlane(layer_); asm volatile("" : "+s"(layer)); PH_CTX();
    moe_tables(ctl, layer, MISC, tid);
    const int nrt = __builtin_amdgcn_readfirstlane((int)MISC[MW_NRT]);
    pg8::Gemm g{(const bf16*)(ws + WS_A1), (const bf16*)(ws + WS_WGU + (size_t)layer * NE * 2048 * D), nrt * 256, NE * 2048, D / 2};
    pg8::MoeOrder S{8, G, vcu, nrt * 8, (const LAS int*)(lds + MISC_OFF + 4 * MW_TILE)};
    pg8::EpiSwiglu E{ws + WS_ACT, FFN, args.b_gu + (size_t)layer * NE * 2048, 1.0f / (S8_H * S8_W), S8_A};
    pg8::gemm_phase<pg8::EpiSwiglu, pg8::MoeOrder, true, true, true>(lds, g, S, E, tid);
    { const int rem = (nrt * 8) % G; if (layer + 1 < DEPTH && rem != 0 && vcu >= rem) convert_range(args, layer + 1, conv_t2(G) + ((vcu - rem) * NWAVES + wave) * CB7, CB7, lds, lane, wave); } }
__device__ __forceinline__ void ph_p8(LAS unsigned char* lds, int wv, int layer_) { int layer = __builtin_amdgcn_readfirstlane(layer_); asm volatile("" : "+s"(layer)); PH_CTX();
    moe_tables(ctl, layer, MISC, tid);
    const int nrt = __builtin_amdgcn_readfirstlane((int)MISC[MW_NRT]);
    pg8::Gemm g{(const bf16*)(ws + WS_ACT), (const bf16*)(ws + WS_WDN + (size_t)layer * NE * D * FFN), nrt * 256, NE * D, FFN / 2};
    pg8::MoeOrder S{4, G, vcu, nrt * 4, (const LAS int*)(lds + MISC_OFF + 4 * MW_TILE)};
    if constexpr (Y8) { pg8::EpiFp8Bias E{ws + WS_Y, D, args.b_dn + (size_t)layer * NE * D, D, 1.0f / (S8_A * S8_W), S8_Y};
        pg8::gemm_phase<pg8::EpiFp8Bias, pg8::MoeOrder, true, true, true>(lds, g, S, E, tid); }
    else { pg8::EpiBf16Bias E{(bf16*)(ws + WS_Y), D, args.b_dn + (size_t)layer * NE * D, D, 1.0f / (S8_A * S8_W)};
        pg8::gemm_phase<pg8::EpiBf16Bias, pg8::MoeOrder, true, true, true>(lds, g, S, E, tid); }
    { const int rem = (nrt * 4) % G; if (layer + 1 < DEPTH && rem != 0 && vcu >= rem) convert_range(args, layer + 1, conv_t2(G) + conv_idle(nrt * 8, G) * NWAVES * CB7 + ((vcu - rem) * NWAVES + wave) * CB8, CB8, lds, lane, wave); } }
__device__ __forceinline__ void ph_final(LAS unsigned char* lds, int wv) { PH_CTX(); final_rows(args, lds, vcu, G, tid, lane); }

#ifndef DBL_MASK
#define DBL_MASK 0
#endif
#if DBL_MASK
#define RUN(bit, call) do { if ((DBL_MASK >> (bit)) & 1) { const unsigned long long t0_ = __builtin_amdgcn_s_memrealtime(); call; const unsigned long long t1_ = __builtin_amdgcn_s_memrealtime(); \
        while (__builtin_amdgcn_s_memrealtime() - t1_ < t1_ - t0_) __builtin_amdgcn_s_sleep(8); } else { call; } } while (0)
#else
#define RUN(bit, call) do { call; } while (0)
#endif
__global__ void __launch_bounds__(NTHR, 2) hybrid_fwd(Args args) {
    extern __shared__ __attribute__((aligned(16))) unsigned char lds_raw[];
    LAS unsigned char* lds = (LAS unsigned char*)lds_raw;
    volatile LAS unsigned* MISC = (volatile LAS unsigned*)(lds + MISC_OFF);
    const int tid = threadIdx.x; const int wv = __builtin_amdgcn_readfirstlane(tid >> 6);
    gu32* ctl = (gu32*)(args.ws + WS_CTL);
    for (int u = tid; u < (LDS_BYTES - MISC_OFF) / 4; u += NTHR) MISC[u] = 0u;
    __syncthreads();
    if (tid == 0) {
#define ST_ARG(i, p) do { const unsigned long long v_ = (unsigned long long)(p); MISC[MW_ARGS + 2 * (i)] = (unsigned)v_; MISC[MW_ARGS + 2 * (i) + 1] = (unsigned)(v_ >> 32); } while (0)
        ST_ARG(0, args.x); ST_ARG(1, args.c); ST_ARG(2, args.pos); ST_ARG(3, args.w_mod); ST_ARG(4, args.b_mod); ST_ARG(5, args.norm1_w); ST_ARG(6, args.w_in); ST_ARG(7, args.gla_wa2); ST_ARG(8, args.gla_ba2);
        ST_ARG(9, args.hg_lb); ST_ARG(10, args.gla_norm_w); ST_ARG(11, args.hg_norm_w); ST_ARG(12, args.w_out); ST_ARG(13, args.norm2_w); ST_ARG(14, args.w_r); ST_ARG(15, args.b_r); ST_ARG(16, args.w_gu);
        ST_ARG(17, args.b_gu); ST_ARG(18, args.w_dn); ST_ARG(19, args.b_dn); ST_ARG(20, args.final_norm_w); ST_ARG(21, args.out); ST_ARG(22, args.ws);
#undef ST_ARG
    }
    __syncthreads();
    const int lo = args.ph_lo, hi = args.ph_hi;
    const bool multi = (hi - lo) > 1;
    XcdBarrier bar; bar.bar = (unsigned*)(ctl + CW_BAR); bar.x = 0; bar.st = nullptr;
    if (multi) bar = xcd_barrier_post((unsigned*)(ctl + CW_BAR), MISC + MW_BAR);
#define IN(k) (lo <= (k) && (k) < hi)
#define SEAM(k) do { if (IN(k) && IN((k) + 1)) xcd_barrier(bar); } while (0)

    if (IN(0)) RUN(0, ph_p0(lds, wv));
    SEAM(0);
    for (int layer = 0; layer < DEPTH; ++layer) {
        const int pb = 1 + 9 * layer;
        if (IN(pb + 0)) RUN(1, ph_p1(lds, wv, layer));
        SEAM(pb + 0);
        if (IN(pb + 1)) RUN(2, ph_p2(lds, wv, layer));
        SEAM(pb + 1);
        if (IN(pb + 2)) RUN(3, ph_p3a(lds, wv, layer));
        SEAM(pb + 2);
        if (IN(pb + 3)) RUN(4, ph_p3b(lds, wv));
        SEAM(pb + 3);
        if (IN(pb + 4)) RUN(5, ph_p3c(lds, wv, layer));
        SEAM(pb + 4);
        if (IN(pb + 5)) RUN(6, ph_p4(lds, wv, layer));
        SEAM(pb + 5);
        if (IN(pb + 6)) RUN(7, ph_p5(lds, wv, layer));
        SEAM(pb + 6);
        if (IN(pb + 7)) RUN(9, ph_p7(lds, wv, layer));
        SEAM(pb + 7);
        if (IN(pb + 8)) RUN(10, ph_p8(lds, wv, layer));
        SEAM(pb + 8);
    }
    if (IN(NPHASE - 1)) RUN(11, ph_final(lds, wv));
#undef IN
#undef SEAM
}

#ifndef MK_SINGLE
#define MK_SINGLE 1
#endif
extern "C" void kernel_launch(void* const* d_in, const int* in_sizes, int n_in, void* d_out, int out_size, void* d_ws, size_t ws_size, hipStream_t stream) {
    static int grid = 0;
    if (grid == 0) {
        if (n_in != 21 || in_sizes[0] != MTOK * D || out_size != MTOK * D || ws_size < WS_END) { fprintf(stderr, "kernel_launch: unexpected problem shape (n_in %d, in0 %d, out %d, ws %zu)\n", n_in, n_in > 0 ? in_sizes[0] : -1, out_size, ws_size); grid = -1; return; }
        int dev = 0, cus = 0, per_cu = 0;
        if (hipGetDevice(&dev) != hipSuccess || hipDeviceGetAttribute(&cus, hipDeviceAttributeMultiprocessorCount, dev) != hipSuccess) { grid = -1; return; }
        if (hipFuncSetAttribute((const void*)hybrid_fwd, hipFuncAttributeMaxDynamicSharedMemorySize, LDS_BYTES) != hipSuccess) { fprintf(stderr, "kernel_launch: hipFuncSetAttribute failed\n"); grid = -1; return; }
        if (hipOccupancyMaxActiveBlocksPerMultiprocessor(&per_cu, (const void*)hybrid_fwd, NTHR, LDS_BYTES) != hipSuccess || per_cu < 1) fprintf(stderr, "kernel_launch: occupancy query says %d\n", per_cu);
        (void)hipGetLastError();
        grid = cus;
    }
    if (grid < 0) return;
    (void)hipMemsetAsync((char*)d_ws + WS_CTL, 0, CTL_ZERO_BYTES, stream);
    Args a{};
    a.x = (const float*)d_in[0]; a.c = (const float*)d_in[1]; a.pos = (const int*)d_in[2]; a.w_mod = (const float*)d_in[3]; a.b_mod = (const float*)d_in[4]; a.norm1_w = (const float*)d_in[5];
    a.w_in = (const float*)d_in[6]; a.gla_wa2 = (const float*)d_in[7]; a.gla_ba2 = (const float*)d_in[8]; a.hg_lb = (const float*)d_in[9]; a.gla_norm_w = (const float*)d_in[10]; a.hg_norm_w = (const float*)d_in[11];
    a.w_out = (const float*)d_in[12]; a.norm2_w = (const float*)d_in[13]; a.w_r = (const float*)d_in[14]; a.b_r = (const float*)d_in[15]; a.w_gu = (const float*)d_in[16]; a.b_gu = (const float*)d_in[17];
    a.w_dn = (const float*)d_in[18]; a.b_dn = (const float*)d_in[19]; a.final_norm_w = (const float*)d_in[20]; a.out = (float*)d_out; a.ws = (unsigned char*)d_ws;
#if MK_SINGLE
    a.ph_lo = 0; a.ph_hi = NPHASE;
    hipLaunchKernelGGL(hybrid_fwd, dim3(grid), dim3(NTHR), LDS_BYTES, stream, a);
#else
    for (int p = 0; p < NPHASE; ++p) { a.ph_lo = p; a.ph_hi = p + 1; hipLaunchKernelGGL(hybrid_fwd, dim3(grid), dim3(NTHR), LDS_BYTES, stream, a); }
#endif
}
```

```cpp
#include <hip/hip_runtime.h>
#include <cstdio>
#include <cstdint>
namespace pg8 {
#define PG8_LAS __attribute__((address_space(3)))
typedef unsigned short bf16_t;
typedef short bf16x8 __attribute__((ext_vector_type(8)));
typedef float f32x4 __attribute__((ext_vector_type(4)));
typedef unsigned u32x4 __attribute__((ext_vector_type(4)));
constexpr int BM = 256, BK = 64, HALF = 128, HTB = HALF * BK * 2  , STAGE_BYTES = 8 * HTB, NXCD = 8, WGM = 8;

__host__ __device__ __forceinline__ int lds_byte(int r, int c) { const int st = (r >> 4) * 2 + (c >> 5), rr = r & 15, cc = c & 31, ob = rr * 64 + cc * 2; return st * 1024 + (ob ^ (((ob >> 9) & 1) << 5)); }
__host__ __device__ __forceinline__ void stage_rc(int b, int& R, int& C) { const int st = b / 1024, sb = b % 1024, swz = sb ^ (((sb >> 9) & 1) << 5); R = (st >> 1) * 16 + swz / 64; C = (st & 1) * 32 + (swz % 64) / 2; }
__host__ __device__ __forceinline__ int perm32(int rho) { const int n = rho >> 4, i = rho & 15; return 8 * (i >> 2) + 4 * n + (i & 3); }

struct Unit { int pm, pn, e, pl; };
struct Gemm { const bf16_t* A; const bf16_t* Bt; int M, N, K; };

struct StaticOrder {
    int nM, nN, nwg, G, c;
    __host__ __device__ void init(int M, int N, int G_, int c_) { nM = M / BM; nN = N / BM; nwg = nM * nN; G = G_; c = c_; }
    __host__ __device__ bool next(int i, Unit& u) const {
        const long L = (long)i * G + c; if (L >= nwg) return false;
        int wgid = (int)L; { const int q = nwg / NXCD, r = nwg % NXCD, xcd = wgid % NXCD, off = wgid / NXCD; wgid = (xcd < r ? xcd * (q + 1) : r * (q + 1) + (xcd - r) * q) + off; }
        const int nig = WGM * nN, gid = wgid / nig, fm = gid * WGM, gsz = (nM - fm) < WGM ? (nM - fm) : WGM;
        u.pm = fm + ((wgid % nig) % gsz); u.pn = (wgid % nig) / gsz; u.e = 0; u.pl = u.pn; return true;
    }
    __device__ __forceinline__ void a_ready(const Unit&) const {}
    __device__ __forceinline__ void done(const Unit&) const {}
};

__device__ __forceinline__ unsigned cvt_pk_bf16(float lo, float hi) { unsigned r; asm volatile("v_cvt_pk_bf16_f32 %0, %1, %2" : "=v"(r) : "v"(lo), "v"(hi)); return r; }

#define PG8_GAS __attribute__((address_space(1)))
struct NoPre {};
struct EpiBf16Plain {
    static constexpr bool PERM = true, AFTER_DRAIN = false; static constexpr int NST = 0; typedef NoPre Pre;
    __device__ __forceinline__ Pre prefetch(const Unit&, int, int) const { return Pre{}; }
    bf16_t* O; int ldc; float sc;
    __device__ __forceinline__ void operator()(const f32x4 (&acc)[2][2][4][2], const Unit& u, int wr, int wc, int fr, int fq, const Pre&) const {
        const int row0 = u.pm * BM + wr * 64 + fr; const int col0 = u.pn * BM + wc * 32 + 8 * fq;
#pragma unroll
        for (int ai = 0; ai < 2; ++ai)
#pragma unroll
            for (int m = 0; m < 4; ++m) { bf16_t* rowp = O + (size_t)(row0 + ai * HALF + m * 16) * ldc + col0;
#pragma unroll
                for (int bj = 0; bj < 2; ++bj) { const f32x4 v0 = acc[ai][bj][m][0] * sc, v1 = acc[ai][bj][m][1] * sc;
                    u32x4 w; w.x = cvt_pk_bf16(v0[0], v0[1]); w.y = cvt_pk_bf16(v0[2], v0[3]); w.z = cvt_pk_bf16(v1[0], v1[1]); w.w = cvt_pk_bf16(v1[2], v1[3]);
                    *(PG8_GAS u32x4*)(rowp + bj * HALF) = w; } }
    }
};
struct EpiResGate {
    static constexpr bool PERM = true, AFTER_DRAIN = false; static constexpr int NST = 0; typedef NoPre Pre;
    __device__ __forceinline__ Pre prefetch(const Unit&, int, int) const { return Pre{}; }
    const bf16_t* base; bf16_t* out; int ldc; const float* gate; int gpitch; int rows_per_batch; float sc;
    __device__ __forceinline__ void operator()(const f32x4 (&acc)[2][2][4][2], const Unit& u, int wr, int wc, int fr, int fq, const Pre&) const {
        const int row0 = u.pm * BM + wr * 64 + fr, col0 = u.pn * BM + wc * 32 + 8 * fq;
        const float* gp = gate + (size_t)((u.pm * BM) / rows_per_batch) * gpitch + col0;
        f32x4 gv[2][2];
#pragma unroll
        for (int bj = 0; bj < 2; ++bj)
#pragma unroll
            for (int n = 0; n < 2; ++n) gv[bj][n] = *(const PG8_GAS f32x4*)(gp + bj * HALF + 4 * n) * sc;
#pragma unroll
        for (int ai = 0; ai < 2; ++ai)
#pragma unroll
            for (int m = 0; m < 4; ++m) { const size_t off = (size_t)(row0 + ai * HALF + m * 16) * ldc + col0;
#pragma unroll
                for (int bj = 0; bj < 2; ++bj) { const u32x4 bs = *(const PG8_GAS u32x4*)(base + off + bj * HALF); const unsigned bw[4] = {bs.x, bs.y, bs.z, bs.w}; float r[8];
#pragma unroll
                    for (int j = 0; j < 4; ++j) { const f32x4& a4 = acc[ai][bj][m][j >> 1]; const f32x4& g4 = gv[bj][j >> 1];
                        r[2 * j] = __builtin_bit_cast(float, bw[j] << 16) + g4[2 * (j & 1)] * a4[2 * (j & 1)]; r[2 * j + 1] = __builtin_bit_cast(float, bw[j] & 0xffff0000u) + g4[2 * (j & 1) + 1] * a4[2 * (j & 1) + 1]; }
                    u32x4 w; w.x = cvt_pk_bf16(r[0], r[1]); w.y = cvt_pk_bf16(r[2], r[3]); w.z = cvt_pk_bf16(r[4], r[5]); w.w = cvt_pk_bf16(r[6], r[7]);
                    *(PG8_GAS u32x4*)(out + off + bj * HALF) = w; }
                asm volatile("" ::: "memory"); }
    }
};
struct EpiSwiglu {
    static constexpr bool PERM = true, AFTER_DRAIN = false; static constexpr int NST = 0; struct Pre { f32x4 bg[2], bu[2]; };
    __device__ __forceinline__ Pre prefetch(const Unit& u, int wc, int fq) const { typedef const __attribute__((address_space(1))) f32x4 gf4;
        const float* bp = bias + (size_t)u.e * 2048 + u.pl * HALF + wc * 32 + 8 * fq; Pre p; p.bg[0] = *(gf4*)bp; p.bg[1] = *(gf4*)(bp + 4); p.bu[0] = *(gf4*)(bp + 1024); p.bu[1] = *(gf4*)(bp + 1028); return p; }
    unsigned char* O; int ldc; const float* bias; float inv_in, out_scale;
    __device__ __forceinline__ float act1(float g, float up) const {
        g = fminf(g, 7.0f); up = fminf(fmaxf(up, -7.0f), 7.0f);
        const float s = 1.0f / (1.0f + __expf(-1.702f * g));
        return fminf(fmaxf((up + 1.0f) * g * s * out_scale, -448.f), 448.f);
    }
    __device__ __forceinline__ void operator()(const f32x4 (&acc)[2][2][4][2], const Unit& u, int wr, int wc, int fr, int fq, const Pre& pre) const {
        const int row0 = u.pm * BM + wr * 64 + fr; const int jj0 = wc * 32 + 8 * fq; const int col0 = u.pl * HALF + jj0;
        const f32x4 bg[2] = {pre.bg[0], pre.bg[1]}, bu[2] = {pre.bu[0], pre.bu[1]};
#pragma unroll
        for (int ai = 0; ai < 2; ++ai)
#pragma unroll
            for (int m = 0; m < 4; ++m) { unsigned char* rowp = O + (size_t)(row0 + ai * HALF + m * 16) * ldc + col0;
                f32x4 r[2];
#pragma unroll
                for (int n = 0; n < 2; ++n) { const f32x4 g = acc[ai][0][m][n] * inv_in + bg[n], up = acc[ai][1][m][n] * inv_in + bu[n];
#pragma unroll
                    for (int j = 0; j < 4; ++j) r[n][j] = act1(g[j], up[j]); }
                int w0 = 0, w1 = 0;
                w0 = __builtin_amdgcn_cvt_pk_fp8_f32(r[0][0], r[0][1], w0, false); w0 = __builtin_amdgcn_cvt_pk_fp8_f32(r[0][2], r[0][3], w0, true);
                w1 = __builtin_amdgcn_cvt_pk_fp8_f32(r[1][0], r[1][1], w1, false); w1 = __builtin_amdgcn_cvt_pk_fp8_f32(r[1][2], r[1][3], w1, true);
                typedef int i32x2 __attribute__((ext_vector_type(2))); *(PG8_GAS i32x2*)rowp = (i32x2){w0, w1}; }
    }
};
struct EpiBf16Bias {
    static constexpr bool PERM = true, AFTER_DRAIN = false; static constexpr int NST = 0; typedef NoPre Pre;
    __device__ __forceinline__ Pre prefetch(const Unit&, int, int) const { return Pre{}; }
    bf16_t* O; int ldc; const float* bias; int bpitch; float inv_in;
    __device__ __forceinline__ void operator()(const f32x4 (&acc)[2][2][4][2], const Unit& u, int wr, int wc, int fr, int fq, const Pre&) const {
        const int row0 = u.pm * BM + wr * 64 + fr; const int col0 = u.pl * BM + wc * 32 + 8 * fq;
        const float* bp = bias + (size_t)u.e * bpitch + col0;
        f32x4 bv[2][2];
#pragma unroll
        for (int bj = 0; bj < 2; ++bj)
#pragma unroll
            for (int n = 0; n < 2; ++n) bv[bj][n] = *(const PG8_GAS f32x4*)(bp + bj * HALF + 4 * n);
#pragma unroll
        for (int ai = 0; ai < 2; ++ai)
#pragma unroll
            for (int m = 0; m < 4; ++m) { bf16_t* rowp = O + (size_t)(row0 + ai * HALF + m * 16) * ldc + col0;
#pragma unroll
                for (int bj = 0; bj < 2; ++bj) { const f32x4 v0 = acc[ai][bj][m][0] * inv_in + bv[bj][0], v1 = acc[ai][bj][m][1] * inv_in + bv[bj][1];
                    u32x4 w; w.x = cvt_pk_bf16(v0[0], v0[1]); w.y = cvt_pk_bf16(v0[2], v0[3]); w.z = cvt_pk_bf16(v1[0], v1[1]); w.w = cvt_pk_bf16(v1[2], v1[3]);
                    *(PG8_GAS u32x4*)(rowp + bj * HALF) = w; } }
    }
};
struct EpiFp8Bias {
    static constexpr bool PERM = true, AFTER_DRAIN = false; static constexpr int NST = 0; struct Pre { f32x4 bv[2][2]; };
    __device__ __forceinline__ Pre prefetch(const Unit& u, int wc, int fq) const { typedef const __attribute__((address_space(1))) f32x4 gf4;
        const float* bp = bias + (size_t)u.e * bpitch + u.pl * BM + wc * 32 + 8 * fq; Pre p; p.bv[0][0] = *(gf4*)bp; p.bv[0][1] = *(gf4*)(bp + 4); p.bv[1][0] = *(gf4*)(bp + HALF); p.bv[1][1] = *(gf4*)(bp + HALF + 4); return p; }
    unsigned char* O; int ldc; const float* bias; int bpitch; float inv_in, out_scale;
    __device__ __forceinline__ int pk4(f32x4 v) const { int w = 0; w = __builtin_amdgcn_cvt_pk_fp8_f32(fminf(fmaxf(v[0], -448.f), 448.f), fminf(fmaxf(v[1], -448.f), 448.f), w, false);
        return __builtin_amdgcn_cvt_pk_fp8_f32(fminf(fmaxf(v[2], -448.f), 448.f), fminf(fmaxf(v[3], -448.f), 448.f), w, true); }
    __device__ __forceinline__ void operator()(const f32x4 (&acc)[2][2][4][2], const Unit& u, int wr, int wc, int fr, int fq, const Pre& pre) const {
        const int row0 = u.pm * BM + wr * 64 + fr; const int col0 = u.pl * BM + wc * 32 + 8 * fq;
        const f32x4 bv[2][2] = {{pre.bv[0][0], pre.bv[0][1]}, {pre.bv[1][0], pre.bv[1][1]}};
#pragma unroll
        for (int ai = 0; ai < 2; ++ai)
#pragma unroll
            for (int m = 0; m < 4; ++m) { unsigned char* rowp = O + (size_t)(row0 + ai * HALF + m * 16) * ldc + col0;
#pragma unroll
                for (int bj = 0; bj < 2; ++bj) { const f32x4 v0 = (acc[ai][bj][m][0] * inv_in + bv[bj][0]) * out_scale, v1 = (acc[ai][bj][m][1] * inv_in + bv[bj][1]) * out_scale;
                    typedef int i32x2 __attribute__((ext_vector_type(2))); *(PG8_GAS i32x2*)(rowp + bj * HALF) = (i32x2){pk4(v0), pk4(v1)}; } }
    }
};
struct MoeOrder {
    int nN, G, c, nunits; const PG8_LAS int* tile_pm;
    __device__ __forceinline__ bool next(int i, Unit& u) const {
        const int L = i * G + c; if (L >= nunits) return false;
        const int idx = L / nN, pl = L - idx * nN, pm = __builtin_amdgcn_readfirstlane(tile_pm[idx]), e = pm >> 6;
        u.pm = pm; u.pl = pl; u.e = e; u.pn = e * nN + pl; return true;
    }
    __device__ __forceinline__ void a_ready(const Unit&) const {}
    __device__ __forceinline__ void done(const Unit&) const {}
};
typedef int v4i32_t __attribute__((ext_vector_type(4)));
typedef int v8i32_t __attribute__((ext_vector_type(8)));
template <class Epi, class Sched, bool ALIGN_EPI = false, bool SP2 = false, bool FP8 = false>
__device__ __forceinline__ void gemm_phase(PG8_LAS unsigned char* lds, const Gemm g, const Sched& S, const Epi& E, int tid_in) {
    int tid_ = tid_in; asm volatile("" : "+v"(tid_)); const int tid = tid_, wid = __builtin_amdgcn_readfirstlane(tid >> 6), lane = tid & 63, wr = wid >> 2, wc = wid & 3, fr = lane & 15, fq = lane >> 4;
    const int K = g.K, nt = K / BK;
    unsigned voffA, voffB;
    { int R, C; stage_rc(tid * 16, R, C); const int Rb = Epi::PERM ? ((R & ~31) + perm32(R & 31)) : R;
        voffA = (unsigned)(R * K + C) * 2u; voffB = (unsigned)(Rb * K + C) * 2u; }
    const size_t rstep = (size_t)64 * K * 2;
    const size_t kstep = (size_t)(BK * 2);
    const size_t hstep = (size_t)HALF * K * 2;
    const size_t tstep = 2 * hstep;
    const unsigned ldsw = (unsigned)wid * 1024u;
    const int aoff = lds_byte(wr * 64 + fr, fq * 8), boff = lds_byte(wc * 32 + fr, fq * 8);
#define PG8_SA(b, h) (((b) * 2 + (h)) * HTB)
#define PG8_SB(b, h) ((4 + (b) * 2 + (h)) * HTB)
#define PG8_STAGE(bufoff, gbase, voff) do { _Pragma("unroll") for (int _i = 0; _i < 2; ++_i) \
        __builtin_amdgcn_global_load_lds((const unsigned*)((const char*)(gbase) + _i * rstep + (voff)), (PG8_LAS unsigned*)(lds + (bufoff) + ldsw + _i * 8192), 16, 0, 0); } while (0)
#define PG8_LDA(dst, b, h) do { _Pragma("unroll") for (int m = 0; m < 4; ++m) _Pragma("unroll") for (int k = 0; k < 2; ++k) dst[m][k] = *(const PG8_LAS bf16x8*)(lds + PG8_SA(b, h) + aoff + m * 2048 + k * 1024); } while (0)
#define PG8_LDB(dst, b, h) do { _Pragma("unroll") for (int n = 0; n < 2; ++n) _Pragma("unroll") for (int k = 0; k < 2; ++k) dst[n][k] = *(const PG8_LAS bf16x8*)(lds + PG8_SB(b, h) + boff + n * 2048 + k * 1024); } while (0)
#define PG8_MMA(ai, bj, At, Bt) do { __builtin_amdgcn_s_setprio(1); _Pragma("unroll") for (int m = 0; m < 4; ++m) _Pragma("unroll") for (int n = 0; n < 2; ++n) { \
        if constexpr (FP8) { const v8i32_t a8_ = __builtin_shufflevector(__builtin_bit_cast(v4i32_t, At[m][0]), __builtin_bit_cast(v4i32_t, At[m][1]), 0, 1, 2, 3, 4, 5, 6, 7); \
            const v8i32_t b8_ = __builtin_shufflevector(__builtin_bit_cast(v4i32_t, Bt[n][0]), __builtin_bit_cast(v4i32_t, Bt[n][1]), 0, 1, 2, 3, 4, 5, 6, 7); \
            asm volatile("v_mfma_scale_f32_16x16x128_f8f6f4 %0, %1, %2, %0, %3, %3 op_sel_hi:[0,0,0]" : "+v"(acc[ai][bj][m][n]) : "v"(b8_), "v"(a8_), "v"(one8_)); } \
        else { _Pragma("unroll") for (int k = 0; k < 2; ++k) acc[ai][bj][m][n] = __builtin_amdgcn_mfma_f32_16x16x32_bf16(Bt[n][k], At[m][k], acc[ai][bj][m][n], 0, 0, 0); } } \
        __builtin_amdgcn_s_setprio(0); } while (0)
#define PG8_WAIT_V(n) asm volatile("s_waitcnt vmcnt(" #n ")" ::: "memory")
#define PG8_WAIT_L(n) asm volatile("s_waitcnt lgkmcnt(" #n ")" ::: "memory")
#define PG8_WAIT_V8R(relax) do { if (relax) { if constexpr (Epi::NST == 8) PG8_WAIT_V(16); else if constexpr (Epi::NST == 16) PG8_WAIT_V(24); else PG8_WAIT_V(8); } else PG8_WAIT_V(8); } while (0)
#define PG8_BAR __builtin_amdgcn_s_barrier()
#define PG8_SCHED __builtin_amdgcn_sched_barrier(0)
    Unit cur, nxt; int ui = 0;
    if (!S.next(0, cur)) return;
    f32x4 acc[2][2][4][2];
#pragma unroll
    for (int a = 0; a < 2; ++a)
#pragma unroll
        for (int b = 0; b < 2; ++b)
#pragma unroll
            for (int m = 0; m < 4; ++m)
#pragma unroll
                for (int n = 0; n < 2; ++n) acc[a][b][m][n] = (f32x4){0.f, 0.f, 0.f, 0.f};
    bf16x8 At[4][2], B0[2][2], B1[2][2];
    int one8_ = 0x7f7f7f7f; asm volatile("" : "+v"(one8_));
    const char* cA = (const char*)g.A + (size_t)cur.pm * tstep; const char* cB = (const char*)g.Bt + (size_t)cur.pn * tstep;
    S.a_ready(cur);
    if constexpr (SP2) {
        PG8_STAGE(PG8_SB(0, 0), cB, voffB); PG8_STAGE(PG8_SB(0, 1), cB + hstep, voffB); PG8_STAGE(PG8_SA(0, 0), cA, voffA); PG8_STAGE(PG8_SA(0, 1), cA + hstep, voffA);
        if (wr == 1) PG8_BAR;
        PG8_WAIT_V(2); PG8_BAR;
        PG8_STAGE(PG8_SB(1, 0), cB + kstep, voffB); PG8_STAGE(PG8_SA(1, 0), cA + kstep, voffA); PG8_STAGE(PG8_SB(1, 1), cB + hstep + kstep, voffB);
        PG8_WAIT_V(6); PG8_BAR;
    } else {
        PG8_STAGE(PG8_SB(0, 0), cB, voffB); PG8_STAGE(PG8_SA(0, 0), cA, voffA); PG8_STAGE(PG8_SB(0, 1), cB + hstep, voffB); PG8_STAGE(PG8_SA(0, 1), cA + hstep, voffA);
        if (wr == 1) PG8_BAR;
        PG8_WAIT_V(4); PG8_BAR;
        PG8_STAGE(PG8_SB(1, 0), cB + kstep, voffB); PG8_STAGE(PG8_SA(1, 0), cA + kstep, voffA); PG8_STAGE(PG8_SB(1, 1), cB + hstep + kstep, voffB);
        PG8_WAIT_V(6); PG8_BAR;
    }
    for (;;) {
        const bool has_next = S.next(ui + 1, nxt);
        typename Epi::Pre pre_; { int lp_ = (int)__builtin_amdgcn_mbcnt_hi(~0u, __builtin_amdgcn_mbcnt_lo(~0u, 0u)); asm volatile("" : "+v"(lp_)); pre_ = E.prefetch(cur, wc, lp_ >> 4); }
        const char* nA = has_next ? (const char*)g.A + (size_t)nxt.pm * tstep : cA; const char* nB = has_next ? (const char*)g.Bt + (size_t)nxt.pn * tstep : cB;
#pragma unroll 1
        for (int t = 0; t < nt; t += 2) {
            const bool last = (t == nt - 2);
            const char* a1 = cA + (size_t)(t + 1) * kstep;
            const char* a2 = last ? nA : cA + (size_t)(t + 2) * kstep; const char* b2 = last ? nB : cB + (size_t)(t + 2) * kstep;
            const char* a3 = a2 + kstep; const char* b3 = b2 + kstep;
            if (last && has_next) S.a_ready(nxt);
            const bool relax = (Epi::NST > 0) && (ui > 0) && (t == 0);
            if constexpr (SP2) {
            PG8_LDB(B0, 0, 0); PG8_LDB(B1, 0, 1); PG8_SCHED; PG8_LDA(At, 0, 0); PG8_STAGE(PG8_SA(1, 1), a1 + hstep, voffA);
            PG8_WAIT_V8R(relax); PG8_WAIT_L(0); PG8_BAR; PG8_MMA(0, 0, At, B0); PG8_MMA(0, 1, At, B1); PG8_BAR; PG8_SCHED;
            PG8_LDA(At, 0, 1); PG8_STAGE(PG8_SB(0, 0), b2, voffB); PG8_STAGE(PG8_SB(0, 1), b2 + hstep, voffB); PG8_STAGE(PG8_SA(0, 0), a2, voffA);
            PG8_WAIT_V8R(relax); PG8_WAIT_L(0); PG8_BAR; PG8_MMA(1, 0, At, B0); PG8_MMA(1, 1, At, B1); PG8_BAR; PG8_SCHED;
            PG8_LDB(B0, 1, 0); PG8_LDB(B1, 1, 1); PG8_SCHED; PG8_LDA(At, 1, 0); PG8_STAGE(PG8_SA(0, 1), a2 + hstep, voffA);
            PG8_WAIT_V(8); PG8_WAIT_L(0); PG8_BAR; PG8_MMA(0, 0, At, B0); PG8_MMA(0, 1, At, B1); PG8_BAR; PG8_SCHED;
            PG8_LDA(At, 1, 1); PG8_STAGE(PG8_SB(1, 0), b3, voffB); PG8_STAGE(PG8_SB(1, 1), b3 + hstep, voffB); PG8_STAGE(PG8_SA(1, 0), a3, voffA);
            PG8_WAIT_V(8); PG8_WAIT_L(0); PG8_BAR; PG8_MMA(1, 0, At, B0); PG8_MMA(1, 1, At, B1); PG8_BAR; PG8_SCHED;
            } else {
            PG8_LDB(B0, 0, 0); PG8_SCHED; PG8_LDA(At, 0, 0); PG8_STAGE(PG8_SA(1, 1), a1 + hstep, voffA);
            PG8_WAIT_L(8); PG8_BAR; PG8_WAIT_L(0); PG8_MMA(0, 0, At, B0); PG8_BAR; PG8_SCHED;
            PG8_LDB(B1, 0, 1); PG8_STAGE(PG8_SB(0, 0), b2, voffB);
            PG8_BAR; PG8_WAIT_L(0); PG8_MMA(0, 1, At, B1); PG8_BAR;
            PG8_LDA(At, 0, 1); PG8_STAGE(PG8_SA(0, 0), a2, voffA);
            PG8_BAR; PG8_WAIT_L(0); PG8_MMA(1, 0, At, B0); PG8_BAR; PG8_SCHED;
            PG8_STAGE(PG8_SB(0, 1), b2 + hstep, voffB);
            PG8_WAIT_V(6); PG8_BAR; PG8_MMA(1, 1, At, B1); PG8_BAR;
            PG8_LDB(B0, 1, 0); PG8_SCHED; PG8_LDA(At, 1, 0); PG8_STAGE(PG8_SA(0, 1), a2 + hstep, voffA);
            PG8_WAIT_L(8); PG8_BAR; PG8_WAIT_L(0); PG8_MMA(0, 0, At, B0); PG8_BAR; PG8_SCHED;
            PG8_LDB(B1, 1, 1); PG8_STAGE(PG8_SB(1, 0), b3, voffB);
            PG8_BAR; PG8_WAIT_L(0); PG8_MMA(0, 1, At, B1); PG8_BAR;
            PG8_LDA(At, 1, 1); PG8_STAGE(PG8_SA(1, 0), a3, voffA);
            PG8_BAR; PG8_WAIT_L(0); PG8_MMA(1, 0, At, B0); PG8_BAR; PG8_SCHED;
            PG8_STAGE(PG8_SB(1, 1), b3 + hstep, voffB);
            PG8_WAIT_V(6); PG8_BAR; PG8_MMA(1, 1, At, B1); PG8_BAR;
            }
        }
        if constexpr (FP8) asm volatile("s_nop 7\n\ts_nop 7" ::: "memory");
        if constexpr (ALIGN_EPI) { if (wr == 0) PG8_BAR; }
        if constexpr (!Epi::AFTER_DRAIN) { int ln_ = (int)__builtin_amdgcn_mbcnt_hi(~0u, __builtin_amdgcn_mbcnt_lo(~0u, 0u)); asm volatile("" : "+v"(ln_)); E(acc, cur, wr, wc, ln_ & 15, ln_ >> 4, pre_); S.done(cur); }
        if (!has_next) break;
#pragma unroll
        for (int a = 0; a < 2; ++a)
#pragma unroll
            for (int b = 0; b < 2; ++b)
#pragma unroll
                for (int m = 0; m < 4; ++m)
#pragma unroll
                    for (int n = 0; n < 2; ++n) acc[a][b][m][n] = (f32x4){0.f, 0.f, 0.f, 0.f};
        cur = nxt; cA = nA; cB = nB; ++ui;
        if constexpr (ALIGN_EPI) { if (wr == 1) PG8_BAR; }
    }
    PG8_WAIT_V(0);
    if constexpr (!ALIGN_EPI) { if (wr == 0) PG8_BAR; }
    PG8_BAR;
    if constexpr (Epi::AFTER_DRAIN) { E.fused(acc, cur, wr, wc, fr, fq, lds, wid, lane); S.done(cur); }
#undef PG8_SA
#undef PG8_SB
#undef PG8_STAGE
#undef PG8_LDA
#undef PG8_LDB
#undef PG8_MMA
#undef PG8_WAIT_V
#undef PG8_WAIT_L
#undef PG8_BAR
#undef PG8_SCHED
}
}

constexpr int NWAVES = 8, NTHR = 512;
constexpr int BATCH = 2, SEQ = 8192, D = 1024, DEPTH = 4, MTOK = BATCH * SEQ;
constexpr int DIN = 3344, NPROJ = 3328, SRC_GA = 1152;
constexpr int C_GQ = 0, C_GK = 192, C_GV = 384, C_GG = 768, C_HQ = 1152, C_HF = 1408, C_HI = 1664, C_HG = 1920, C_RQ = 2176, C_RK = 2368, C_RV = 2560, C_RG = 2944;
constexpr int NE = 32, FFN = 1024;
constexpr int CH = 64, NCH = SEQ / CH, NUNIT = BATCH * NCH;
constexpr int ST_GLA = 0, ST_HG = 4 * 48 * 96, ST_RET = ST_HG + 4 * 64 * 64, ST_TOT = ST_RET + 4 * 48 * 96;
constexpr int NDV = 448, NKT = 640;
constexpr int MAXROWS = 65536 + NE * 256, MAXRT = MAXROWS / 256;
constexpr float EPS = 1e-6f;
#ifndef F8_IN_V
#define F8_IN_V false
#endif
#ifndef F8_OUT_V
#define F8_OUT_V false
#endif
constexpr bool F8_IN = F8_IN_V, F8_OUT = F8_OUT_V;
#ifndef Y8_V
#define Y8_V true
#endif
constexpr bool Y8 = Y8_V;
constexpr float S8_Y = 16.f;
constexpr float S8_M = 32.f;
constexpr float S8_W = 2048.f, S8_H = 64.f, S8_A = 8.f;
constexpr int NPHASE = 38;
constexpr int ECAP = 16384, ECAP_SH = 14;

constexpr size_t MiB = 1u << 20;
constexpr size_t WS_CTL = 0, CTL_ZERO_BYTES = 65536;
constexpr size_t WS_MOD = 1 * MiB;
constexpr size_t WS_ROPE = 2 * MiB;
constexpr size_t WS_LB = 5 * MiB;
constexpr size_t WS_WIN = 8 * MiB;
constexpr size_t WS_WOUT = 34 * MiB;
constexpr size_t WS_WGU = 42 * MiB;
constexpr size_t WS_WDN = 554 * MiB;
constexpr size_t WS_X = 810 * MiB;
constexpr size_t WS_H = 874 * MiB;
constexpr size_t WS_GA = 906 * MiB;
constexpr size_t WS_PROJ = 907 * MiB;
constexpr size_t WS_U = 1011 * MiB;
constexpr size_t WS_DVEC = 1063 * MiB;
constexpr size_t WS_SP = 1064 * MiB;
constexpr size_t WS_MIX = 1090 * MiB;
constexpr size_t WS_TOPE = 1122 * MiB;
constexpr size_t WS_TOPW = WS_TOPE + 256 * 1024;
constexpr size_t WS_SLOT = WS_TOPW + 256 * 1024;
constexpr size_t WS_A1 = 1123 * MiB;
constexpr size_t WS_ACT = 1635 * MiB;
constexpr size_t WS_Y = 2147 * MiB;
constexpr size_t WS_CUM = 3171 * MiB;
constexpr size_t WS_KT = 3199 * MiB;
constexpr size_t WS_END = 3239 * MiB;
static_assert(WS_WIN + (size_t)DEPTH * NPROJ * D * 2 <= WS_WOUT && WS_PROJ + (size_t)MTOK * NPROJ * 2 <= WS_U && WS_U + (size_t)NUNIT * ST_TOT * 4 <= WS_DVEC && WS_SP + (size_t)NUNIT * ST_TOT * 2 <= WS_MIX && WS_A1 + (size_t)NE * ECAP * D <= WS_ACT && WS_ACT + (size_t)NE * ECAP * D <= WS_Y && WS_Y + (size_t)NE * ECAP * D * 2 <= WS_CUM, "ws map");
constexpr int CW_TMO = 0, CW_CODE = 1, CW_BAR = 4096, CW_CNT = 8192, CW_FILL = 8192 + 256;
constexpr int RING_BYTES = 131072;
constexpr int MISC_OFF = 147456, LDS_BYTES = MISC_OFF + 4096;
constexpr int MW_BAR = 0, MW_CNT = 16, MW_PST = 48, MW_HIST = 96, MW_BASE = 128, MW_TILE = 192, MW_NRT = 480, MW_SLOTS = 512;

#define GAS __attribute__((address_space(1)))
#define LAS __attribute__((address_space(3)))
typedef unsigned v4u __attribute__((ext_vector_type(4)));
typedef float f32x4 __attribute__((ext_vector_type(4)));
typedef short bf16x8 __attribute__((ext_vector_type(8)));
typedef GAS unsigned gu32;
typedef GAS unsigned long long gu64;
#define RLX_AGENT __ATOMIC_RELAXED, __HIP_MEMORY_SCOPE_AGENT
#define LDS_WAIT() asm volatile("s_waitcnt lgkmcnt(0)" ::: "memory")
#define VM_WAIT() asm volatile("s_waitcnt vmcnt(0)" ::: "memory")
__device__ __forceinline__ unsigned long long rt() { return __builtin_amdgcn_s_memrealtime(); }
typedef unsigned short bf16;
__device__ __forceinline__ unsigned f2bf(float f) { unsigned u = __builtin_bit_cast(unsigned, f); return (u + 0x7fffu + ((u >> 16) & 1u)) >> 16; }
__device__ __forceinline__ unsigned pk2(float lo, float hi) { return f2bf(lo) | (f2bf(hi) << 16); }
__device__ __forceinline__ float bf2f(bf16 b) { return __builtin_bit_cast(float, (unsigned)b << 16); }
#define XB_TMO      128
#define XB_XCNT(j)  (256  + 64 * (j))
#define XB_XSUB(j)  (1280 + 64 * (j))
#define XB_XGEN(j)  (2304 + 64 * (j))
#define XB_TOP      3328
#define XB_TOPGEN   3392
#define XCD_BAR_WORDS 3456
#define XB_SPIN_CAP (1u << 18)

__device__ __forceinline__ unsigned xb_ld(unsigned* p)              { return __hip_atomic_load(p, __ATOMIC_RELAXED, __HIP_MEMORY_SCOPE_AGENT); }
__device__ __forceinline__ unsigned xb_add(unsigned* p, unsigned v) { return __hip_atomic_fetch_add(p, v, __ATOMIC_RELAXED, __HIP_MEMORY_SCOPE_AGENT); }
__device__ __forceinline__ unsigned xb_xcc_id() { return (unsigned)__builtin_amdgcn_s_getreg((3 << 11) | 20) & 0xFu; }
#define XB_SPIN(cond, bar) do { unsigned _sp = 0; while (cond) { __builtin_amdgcn_s_sleep(1); \
    if ((++_sp & 255u) == 0u) { if (xb_ld(&(bar)[XB_TMO])) break; if (_sp > XB_SPIN_CAP) { atomicAdd(&(bar)[XB_TMO], 1u); break; } } } } while (0)

struct XcdBarrier {
    unsigned* bar; unsigned x;
    volatile LAS unsigned* st;
};

__device__ __forceinline__ XcdBarrier xcd_barrier_post(unsigned* bar, volatile LAS unsigned* st) {
    XcdBarrier b; b.bar = bar; b.x = xb_xcc_id(); b.st = st;
    if (threadIdx.x == 0) (void)xb_add(&bar[XB_XCNT(b.x)], 1u);
    return b;
}
__device__ __forceinline__ void xcd_barrier_complete(unsigned* bar, unsigned x, unsigned& nloc, unsigned& nx) {
    const unsigned G = gridDim.x * gridDim.y * gridDim.z;
    unsigned sum, cnt, mine, sp = 0u;
    for (;;) {
        sum = 0u; cnt = 0u; mine = 0u;
#pragma unroll
        for (unsigned j = 0; j < 16; ++j) { const unsigned c = xb_ld(&bar[XB_XCNT(j)]); sum += c; cnt += (c > 0u) ? 1u : 0u; mine = (j == x) ? c : mine; }
        if (sum == G) break;
        __builtin_amdgcn_s_sleep(1);
        if ((++sp & 255u) == 0u) { if (xb_ld(&bar[XB_TMO])) break; if (sp > XB_SPIN_CAP) { atomicAdd(&bar[XB_TMO], 1u); break; } }
    }
    nloc = mine > 0u ? mine : 1u; nx = cnt > 0u ? cnt : 1u;
}

__device__ __forceinline__ void xcd_barrier(const XcdBarrier& b) {
    asm volatile("s_waitcnt vmcnt(0)" ::: "memory");
    __syncthreads();
    if (threadIdx.x == 0) {
        unsigned* bar = b.bar;
        __builtin_amdgcn_s_waitcnt(0);
        unsigned nloc = b.st[0], nx = b.st[1];
        if (nloc == 0u) { xcd_barrier_complete(bar, b.x, nloc, nx); b.st[0] = nloc; b.st[1] = nx; }
        const unsigned old = xb_add(&bar[XB_XSUB(b.x)], 1u);
        const unsigned gen = old / nloc;
        if (old + 1u == (gen + 1u) * nloc) {
            __builtin_amdgcn_fence(__ATOMIC_RELEASE, "agent");
            asm volatile("s_waitcnt vmcnt(0)" ::: "memory");
            const unsigned og = xb_add(&bar[XB_TOP], 1u);
            const unsigned tg = og / nx;
            if (og + 1u == (tg + 1u) * nx) xb_add(&bar[XB_TOPGEN], 1u);
            else XB_SPIN(xb_ld(&bar[XB_TOPGEN]) == tg, bar);
            __builtin_amdgcn_fence(__ATOMIC_ACQUIRE, "agent");
            xb_add(&bar[XB_XGEN(b.x)], 1u);
            asm volatile("s_waitcnt vmcnt(0)" ::: "memory");
        } else {
            XB_SPIN(xb_ld(&bar[XB_XGEN(b.x)]) == gen, bar);
            __builtin_amdgcn_fence(__ATOMIC_ACQUIRE, "agent");
            asm volatile("s_waitcnt vmcnt(0)" ::: "memory");
        }
    }
    __syncthreads();
}

__device__ __forceinline__ float wave_sum(float v) {
#pragma unroll
    for (int o = 1; o < 64; o <<= 1) v += __shfl_xor(v, o);
    return v;
}
__device__ __forceinline__ float log_sigmoid_f(float x) { return fminf(x, 0.f) - log1pf(expf(-fabsf(x))); }
__device__ __forceinline__ float silu_f(float x) { return x / (1.0f + expf(-x)); }
__device__ __forceinline__ float sigmoid_f(float x) { return 1.0f / (1.0f + expf(-x)); }
__device__ __forceinline__ pg8::bf16x8 ldfrag(const LAS bf16* base, int stride, int r0, int k0, int lane) {
    return *(const LAS pg8::bf16x8*)(base + (r0 + (lane & 15)) * stride + k0 + 8 * (lane >> 4));
}
__device__ __forceinline__ pg8::bf16x8 pack8(const float (&v)[8]) { v4u w; w.x = pk2(v[0], v[1]); w.y = pk2(v[2], v[3]); w.z = pk2(v[4], v[5]); w.w = pk2(v[6], v[7]); return __builtin_bit_cast(pg8::bf16x8, w); }

struct Args {
    const float* x; const float* c; const int* pos; const float* w_mod; const float* b_mod; const float* norm1_w; const float* w_in; const float* gla_wa2; const float* gla_ba2; const float* hg_lb;
    const float* gla_norm_w; const float* hg_norm_w; const float* w_out; const float* norm2_w; const float* w_r; const float* b_r; const float* w_gu; const float* b_gu; const float* w_dn; const float* b_dn;
    const float* final_norm_w; float* out; unsigned char* ws; int ph_lo, ph_hi;
};

__device__ __forceinline__ void transpose_block64(const float* src, int ld, bf16* dst, LAS float* scr, int lane) {
    const int r = lane >> 4, c4 = (lane & 15) * 4;
    f32x4 v[16];
#pragma unroll
    for (int i = 0; i < 16; ++i) v[i] = __builtin_nontemporal_load((const f32x4*)(src + (size_t)(4 * i + r) * ld + c4));
#pragma unroll
    for (int i = 0; i < 16; ++i) { LAS float* w = scr + (4 * i + r) * 65 + c4; w[0] = v[i][0]; w[1] = v[i][1]; w[2] = v[i][2]; w[3] = v[i][3]; }
    LDS_WAIT(); asm volatile("" ::: "memory");
    const int kc = lane & 7;
#pragma unroll
    for (int jj = 0; jj < 8; ++jj) { const int n = (lane >> 3) + 8 * jj; const LAS float* s = scr + (8 * kc) * 65 + n;
        v4u o; o.x = pk2(s[0 * 65], s[1 * 65]); o.y = pk2(s[2 * 65], s[3 * 65]); o.z = pk2(s[4 * 65], s[5 * 65]); o.w = pk2(s[6 * 65], s[7 * 65]);
        *(GAS v4u*)(dst + (size_t)n * D + 8 * kc) = o; }
    LDS_WAIT(); asm volatile("" ::: "memory");
}
__device__ __forceinline__ int pk4_fp8(float a, float b, float c, float d) { int w = 0; w = __builtin_amdgcn_cvt_pk_fp8_f32(fminf(fmaxf(a, -448.f), 448.f), fminf(fmaxf(b, -448.f), 448.f), w, false);
    return __builtin_amdgcn_cvt_pk_fp8_f32(fminf(fmaxf(c, -448.f), 448.f), fminf(fmaxf(d, -448.f), 448.f), w, true); }
__device__ __forceinline__ void transpose_block64_fp8(const float* src, int ld, unsigned char* dst, LAS float* scr, int lane, float sc) {
    const int r = lane >> 4, c4 = (lane & 15) * 4;
    f32x4 v[16];
#pragma unroll
    for (int i = 0; i < 16; ++i) v[i] = __builtin_nontemporal_load((const f32x4*)(src + (size_t)(4 * i + r) * ld + c4));
#pragma unroll
    for (int i = 0; i < 16; ++i) { LAS float* w = scr + (4 * i + r) * 65 + c4; w[0] = v[i][0] * sc; w[1] = v[i][1] * sc; w[2] = v[i][2] * sc; w[3] = v[i][3] * sc; }
    LDS_WAIT(); asm volatile("" ::: "memory");
    const int kc = lane & 3;
#pragma unroll
    for (int jj = 0; jj < 4; ++jj) { const int n = (lane >> 2) + 16 * jj; const LAS float* s = scr + (16 * kc) * 65 + n;
        v4u o; o.x = (unsigned)pk4_fp8(s[0 * 65], s[1 * 65], s[2 * 65], s[3 * 65]); o.y = (unsigned)pk4_fp8(s[4 * 65], s[5 * 65], s[6 * 65], s[7 * 65]);
        o.z = (unsigned)pk4_fp8(s[8 * 65], s[9 * 65], s[10 * 65], s[11 * 65]); o.w = (unsigned)pk4_fp8(s[12 * 65], s[13 * 65], s[14 * 65], s[15 * 65]);
        *(GAS v4u*)(dst + (size_t)n * D + 16 * kc) = o; }
    LDS_WAIT(); asm volatile("" ::: "memory");
}
constexpr int IT_IN = 16 * (NPROJ / 64), IT_OUT = 16 * 16, IT_GU = NE * 16 * 32, IT_DN = NE * 16 * 16, IT_LAYER = IT_IN + IT_OUT + IT_GU + IT_DN, IT_ALL = DEPTH * IT_LAYER;
__device__ __forceinline__ void convert_item(const Args& a, int l, int r, LAS float* scr, int lane) {
    unsigned char* ws = a.ws;
    bf16* WIN = (bf16*)(ws + WS_WIN); bf16* WOUT = (bf16*)(ws + WS_WOUT); unsigned char* WGU = ws + WS_WGU; unsigned char* WDN = ws + WS_WDN;
    if (r < IT_IN) { const int kb = r / (NPROJ / 64), nb = r % (NPROJ / 64), n0 = 64 * nb, sc = n0 + (n0 >= SRC_GA ? 16 : 0);
        if (F8_IN) transpose_block64_fp8(a.w_in + ((size_t)l * D + 64 * kb) * DIN + sc, DIN, (unsigned char*)WIN + ((size_t)l * NPROJ + n0) * D + 64 * kb, scr, lane, S8_W);
        else transpose_block64(a.w_in + ((size_t)l * D + 64 * kb) * DIN + sc, DIN, WIN + ((size_t)l * NPROJ + n0) * D + 64 * kb, scr, lane); return; }
    r -= IT_IN;
    if (r < IT_OUT) { const int kb = r / 16, nb = r % 16;
        if (F8_OUT) transpose_block64_fp8(a.w_out + ((size_t)l * D + 64 * kb) * D + 64 * nb, D, (unsigned char*)WOUT + ((size_t)l * D + 64 * nb) * D + 64 * kb, scr, lane, S8_W);
        else transpose_block64(a.w_out + ((size_t)l * D + 64 * kb) * D + 64 * nb, D, WOUT + ((size_t)l * D + 64 * nb) * D + 64 * kb, scr, lane); return; }
    r -= IT_OUT;
    if (r < IT_GU) { const int e = r / 512, r2 = r % 512, kb = r2 / 32, nb = r2 % 32, cc = 64 * nb;
        const int row = (cc < 1024) ? 256 * (cc / 128) + (cc % 128) : 256 * ((cc - 1024) / 128) + 128 + ((cc - 1024) % 128);
        transpose_block64_fp8(a.w_gu + (((size_t)l * NE + e) * D + 64 * kb) * 2048 + cc, 2048, WGU + (((size_t)l * NE + e) * 2048 + row) * D + 64 * kb, scr, lane, S8_W); return; }
    r -= IT_GU;
    { const int e = r / 256, r2 = r % 256, kb = r2 / 16, nb = r2 % 16;
        transpose_block64_fp8(a.w_dn + (((size_t)l * NE + e) * FFN + 64 * kb) * D + 64 * nb, D, WDN + (((size_t)l * NE + e) * D + 64 * nb) * D + 64 * kb, scr, lane, S8_W); }
}
constexpr int CB2 = 4, CB7 = 2, CB8 = 2;
__device__ __forceinline__ int conv_t2(int G) { return (G == 256) ? 192 * NWAVES * CB2 : 0; }
__device__ __forceinline__ int conv_idle(int nunits, int G) { const int rem = nunits % G; return rem ? G - rem : 0; }
__device__ __forceinline__ void convert_range(const Args& a, int l, int first, int count, LAS unsigned char* lds, int lane, int wave) {
    LAS float* scr = (LAS float*)(lds + wave * 16640);
    for (int k = 0; k < count; ++k) { const int it = first + k; if (it < IT_LAYER) convert_item(a, l, it, scr, lane); }
}
__device__ __forceinline__ void p0_prologue(const Args& a, LAS unsigned char* lds, int vcu, int G, int tid, int lane, int wave) {
    unsigned char* ws = a.ws;
    LAS float* scr = (LAS float*)(lds + wave * 16640);
    const int gw = vcu * NWAVES + wave, NGW = G * NWAVES;
    for (int it = gw; it < IT_LAYER; it += NGW) convert_item(a, 0, it, scr, lane);
    __syncthreads();
    {
        LAS float* cact = (LAS float*)lds;
        LAS float* red = (LAS float*)(lds + 8192);
        for (int i = tid; i < 2 * D; i += NTHR) cact[i] = silu_f(a.c[i]);
        __syncthreads();
        float* MOD = (float*)(ws + WS_MOD);
        for (int it = vcu; it < DEPTH * 96; it += G) {
            const int l = it / 96, n0 = (it % 96) * 64;
            const float* wp = a.w_mod + ((size_t)l * D + 128 * wave) * 6144 + n0 + lane;
            float a0 = 0.f, a1 = 0.f;
#pragma unroll 32
            for (int k = 0; k < 128; ++k) { const float w = __builtin_nontemporal_load(wp + (size_t)k * 6144); a0 += cact[128 * wave + k] * w; a1 += cact[D + 128 * wave + k] * w; }
            red[(wave * 2 + 0) * 64 + lane] = a0; red[(wave * 2 + 1) * 64 + lane] = a1;
            __syncthreads();
            if (tid < 128) { const int b = tid >> 6, ln = tid & 63; float s = a.b_mod[l * 6144 + n0 + ln];
#pragma unroll
                for (int w = 0; w < 8; ++w) s += red[(w * 2 + b) * 64 + ln];
                MOD[((size_t)l * 2 + b) * 6144 + n0 + ln] = s; }
            __syncthreads();
        }
    }
    { const f32x4* xs = (const f32x4*)a.x; uint2* xd = (uint2*)(ws + WS_X);
        for (int i = vcu * NTHR + tid; i < MTOK * D / 4; i += G * NTHR) { const f32x4 v = xs[i]; uint2 p; p.x = pk2(v[0], v[1]); p.y = pk2(v[2], v[3]); xd[i] = p; } }
    {
        float* ROPE = (float*)(ws + WS_ROPE);
        for (int i = vcu * NTHR + tid; i < MTOK * 24; i += G * NTHR) { const int t = i / 24, f = i % 24;
            const float inv = (float)pow(10000.0, -(double)f / 24.0); const float ang = (float)a.pos[t] * inv;
            ROPE[(size_t)t * 48 + f] = cosf(ang); ROPE[(size_t)t * 48 + 24 + f] = sinf(ang); }
    }
    if (vcu == 0 && tid < 256) {
        float v[4], mx = -3.0e38f; for (int l = 0; l < 4; ++l) { v[l] = a.hg_lb[l * 256 + tid]; mx = fmaxf(mx, v[l]); }
        float s = 0.f; for (int l = 0; l < 4; ++l) { v[l] = expf(v[l] - mx); s += v[l]; }
        float* LB = (float*)(ws + WS_LB); float cs = 0.f, first = 0.f;
        for (int l = 0; l < 4; ++l) { cs += v[l] / s; if (l == 0) first = cs; LB[l * 256 + tid] = cs - first; }
    }
}

__device__ __forceinline__ void moe_combine_row(f32x4 (&v)[4], int m, const bf16* Y, const int* SLOT, const float* TOPW, const float* g2, int lane) {
    const int4 sl = *(const int4*)(SLOT + (size_t)m * 4); const f32x4 tw = *(const f32x4*)(TOPW + (size_t)m * 4);
    const int s[4] = {sl.x, sl.y, sl.z, sl.w};
    f32x4 acc[4];
#pragma unroll
    for (int j = 0; j < 4; ++j) acc[j] = (f32x4){0.f, 0.f, 0.f, 0.f};
#pragma unroll
    for (int k = 0; k < 4; ++k) { const bf16* yr = Y + (size_t)s[k] * D + 4 * lane; const float w = tw[k];
#pragma unroll
        for (int j = 0; j < 4; ++j) { const uint2 p = *(const uint2*)(yr + 256 * j);
            acc[j][0] += w * __builtin_bit_cast(float, p.x << 16); acc[j][1] += w * __builtin_bit_cast(float, p.x & 0xffff0000u);
            acc[j][2] += w * __builtin_bit_cast(float, p.y << 16); acc[j][3] += w * __builtin_bit_cast(float, p.y & 0xffff0000u); } }
#pragma unroll
    for (int j = 0; j < 4; ++j) { const f32x4 g = *(const f32x4*)(g2 + 4 * lane + 256 * j); v[j] = v[j] + g * acc[j]; }
}
__device__ __forceinline__ float row_rstd(const f32x4 (&v)[4]) {
    float s = 0.f;
#pragma unroll
    for (int j = 0; j < 4; ++j) s += (v[j][0] * v[j][0] + v[j][1] * v[j][1]) + (v[j][2] * v[j][2] + v[j][3] * v[j][3]);
    return 1.0f / sqrtf(wave_sum(s) * (1.0f / D) + EPS);
}
__device__ __forceinline__ void modulate_row(f32x4 (&v)[4], float rstd, const float* nw, const float* sc, const float* sh, bf16* hrow, int lane) {
#pragma unroll
    for (int j = 0; j < 4; ++j) { const int c0 = 4 * lane + 256 * j; const f32x4 w = *(const f32x4*)(nw + c0), s1 = *(const f32x4*)(sc + c0), s0 = *(const f32x4*)(sh + c0);
        v[j] = v[j] * rstd * w * (s1 + 1.0f) + s0;
        uint2 p; p.x = pk2(v[j][0], v[j][1]); p.y = pk2(v[j][2], v[j][3]); *(uint2*)(hrow + c0) = p; }
}


constexpr int LR_SLT = 142976, LR_TWL = 144000, LR_SSR = 145024;
__device__ __forceinline__ void stage_slots(const unsigned char* ws, int row0, LAS unsigned char* lds, int tid) {
    if (tid < 64) { *(LAS v4u*)(lds + LR_SLT + 16 * tid) = *(const v4u*)((const int*)(ws + WS_SLOT) + (size_t)(row0 + tid) * 4);
                    *(LAS f32x4*)(lds + LR_TWL + 16 * tid) = *(const f32x4*)((const float*)(ws + WS_TOPW) + (size_t)(row0 + tid) * 4); }
}
template <bool SS, bool OUTF32>
__device__ __forceinline__ void flat_combine(const bf16* xsrc, void* xdst, int row0, const bf16* Y, const float* g2, LAS unsigned char* lds, int tid, int lane) {
    const int c4 = tid & 255, rsub = tid >> 8; const f32x4 g = *(const f32x4*)(g2 + 4 * c4);
#pragma unroll 8
    for (int it = 0; it < 32; ++it) { const int i = 2 * it + rsub; const size_t m = (size_t)(row0 + i);
        f32x4 v; { const uint2 xp = *(const uint2*)(xsrc + m * D + 4 * c4); v[0] = __builtin_bit_cast(float, xp.x << 16); v[1] = __builtin_bit_cast(float, xp.x & 0xffff0000u); v[2] = __builtin_bit_cast(float, xp.y << 16); v[3] = __builtin_bit_cast(float, xp.y & 0xffff0000u); }
        const v4u sl = *(const LAS v4u*)(lds + LR_SLT + 16 * i); const f32x4 tw = *(const LAS f32x4*)(lds + LR_TWL + 16 * i);
        f32x4 acc;
        if (Y8) { const unsigned char* Yb = (const unsigned char*)Y; typedef float f32x2v __attribute__((ext_vector_type(2)));
            const int q0 = *(const int*)(Yb + (size_t)sl.x * D + 4 * c4), q1 = *(const int*)(Yb + (size_t)sl.y * D + 4 * c4), q2 = *(const int*)(Yb + (size_t)sl.z * D + 4 * c4), q3 = *(const int*)(Yb + (size_t)sl.w * D + 4 * c4);
            const f32x2v a0 = __builtin_amdgcn_cvt_pk_f32_fp8(q0, false), b0 = __builtin_amdgcn_cvt_pk_f32_fp8(q0, true), a1 = __builtin_amdgcn_cvt_pk_f32_fp8(q1, false), b1 = __builtin_amdgcn_cvt_pk_f32_fp8(q1, true);
            const f32x2v a2 = __builtin_amdgcn_cvt_pk_f32_fp8(q2, false), b2 = __builtin_amdgcn_cvt_pk_f32_fp8(q2, true), a3 = __builtin_amdgcn_cvt_pk_f32_fp8(q3, false), b3 = __builtin_amdgcn_cvt_pk_f32_fp8(q3, true);
            const f32x4 tws = tw * (1.0f / S8_Y);
            acc[0] = tws[0] * a0[0] + tws[1] * a1[0] + tws[2] * a2[0] + tws[3] * a3[0]; acc[1] = tws[0] * a0[1] + tws[1] * a1[1] + tws[2] * a2[1] + tws[3] * a3[1];
            acc[2] = tws[0] * b0[0] + tws[1] * b1[0] + tws[2] * b2[0] + tws[3] * b3[0]; acc[3] = tws[0] * b0[1] + tws[1] * b1[1] + tws[2] * b2[1] + tws[3] * b3[1]; }
        else {
        const uint2 p0 = *(const uint2*)(Y + (size_t)sl.x * D + 4 * c4), p1 = *(const uint2*)(Y + (size_t)sl.y * D + 4 * c4), p2 = *(const uint2*)(Y + (size_t)sl.z * D + 4 * c4), p3 = *(const uint2*)(Y + (size_t)sl.w * D + 4 * c4);
        acc[0] = tw[0] * __builtin_bit_cast(float, p0.x << 16) + tw[1] * __builtin_bit_cast(float, p1.x << 16) + tw[2] * __builtin_bit_cast(float, p2.x << 16) + tw[3] * __builtin_bit_cast(float, p3.x << 16);
        acc[1] = tw[0] * __builtin_bit_cast(float, p0.x & 0xffff0000u) + tw[1] * __builtin_bit_cast(float, p1.x & 0xffff0000u) + tw[2] * __builtin_bit_cast(float, p2.x & 0xffff0000u) + tw[3] * __builtin_bit_cast(float, p3.x & 0xffff0000u);
        acc[2] = tw[0] * __builtin_bit_cast(float, p0.y << 16) + tw[1] * __builtin_bit_cast(float, p1.y << 16) + tw[2] * __builtin_bit_cast(float, p2.y << 16) + tw[3] * __builtin_bit_cast(float, p3.y << 16);
        acc[3] = tw[0] * __builtin_bit_cast(float, p0.y & 0xffff0000u) + tw[1] * __builtin_bit_cast(float, p1.y & 0xffff0000u) + tw[2] * __builtin_bit_cast(float, p2.y & 0xffff0000u) + tw[3] * __builtin_bit_cast(float, p3.y & 0xffff0000u); }
        v = v + g * acc;
        if (OUTF32) *(f32x4*)((float*)xdst + m * D + 4 * c4) = v;
        else { uint2 xo; xo.x = pk2(v[0], v[1]); xo.y = pk2(v[2], v[3]); *(uint2*)((bf16*)xdst + m * D + 4 * c4) = xo; }
        if (SS) { const float sq = wave_sum((v[0] * v[0] + v[1] * v[1]) + (v[2] * v[2] + v[3] * v[3])); if (lane == 0) __hip_atomic_fetch_add((LAS float*)(lds + LR_SSR) + i, sq, __ATOMIC_RELAXED, __HIP_MEMORY_SCOPE_WORKGROUP); } }
}
template <bool F8>
__device__ __forceinline__ void flat_modulate(const bf16* xin, int row0, const LAS float* rstds, const float* nw, const float* scp, const float* shp, bf16* H, int tid) {
    const int c4 = tid & 255, rsub = tid >> 8; const f32x4 w = *(const f32x4*)(nw + 4 * c4), s1 = *(const f32x4*)(scp + 4 * c4), s0 = *(const f32x4*)(shp + 4 * c4); const f32x4 ws1 = w * (s1 + 1.0f);
#pragma unroll 8
    for (int it = 0; it < 32; ++it) { const int i = 2 * it + rsub; const size_t m = (size_t)(row0 + i); const uint2 xp = *(const uint2*)(xin + m * D + 4 * c4);
        const f32x4 v = (f32x4){__builtin_bit_cast(float, xp.x << 16), __builtin_bit_cast(float, xp.x & 0xffff0000u), __builtin_bit_cast(float, xp.y << 16), __builtin_bit_cast(float, xp.y & 0xffff0000u)} * rstds[i] * ws1 + s0;
        if (F8) *(int*)((unsigned char*)H + m * D + 4 * c4) = pk4_fp8(v[0] * S8_H, v[1] * S8_H, v[2] * S8_H, v[3] * S8_H);
        else { uint2 p; p.x = pk2(v[0], v[1]); p.y = pk2(v[2], v[3]); *(uint2*)(H + m * D + 4 * c4) = p; } }
}

constexpr int WP = 1032;
constexpr int LR_WHI = 0, LR_PART = 132096, LR_SSX = 140288, LR_RSTD = 140544, LR_BIAS = 140800, LR_RED = 140928;
template <int NEO>
__device__ __forceinline__ void rows_mfma(const Args& a, int layer, LAS unsigned char* lds, volatile LAS unsigned* MISC, gu32* ctl, int vcu, int G, int tid, int lane, int wave) {
    constexpr bool P5 = (NEO == 32); constexpr int NET = NEO / 16;
    unsigned char* ws = a.ws; bf16* X = (bf16*)(ws + WS_X); bf16* H = (bf16*)(ws + WS_H); const float* MOD = (const float*)(ws + WS_MOD);
    LAS bf16* Whi = (LAS bf16*)(lds + LR_WHI); LAS bf16* Wlo = Whi + NEO * WP; LAS float* part = (LAS float*)(lds + LR_PART); LAS float* ssx = (LAS float*)(lds + LR_SSX);
    LAS float* rstds = (LAS float*)(lds + LR_RSTD); LAS float* biasl = (LAS float*)(lds + LR_BIAS); LAS float* red = (LAS float*)(lds + LR_RED);
    const float* nw = (P5 ? a.norm2_w : a.norm1_w) + layer * D;
    const float* Wsrc = P5 ? a.w_r + (size_t)layer * D * NE : a.w_in + (size_t)layer * D * DIN + SRC_GA; const int wld = P5 ? NE : DIN;
    if (P5) { if (tid < NE) MISC[MW_HIST + tid] = 0u; }
    for (int row0 = vcu * 64; row0 < MTOK; row0 += G * 64) {
        const int b = row0 / SEQ; const float* mp = MOD + ((size_t)layer * 2 + b) * 6144; const float* scp = mp + (P5 ? 4 : 1) * D; const float* shp = mp + (P5 ? 3 : 0) * D;
        if (!P5 && layer > 0) { stage_slots(ws, row0, lds, tid); __syncthreads(); }
        { const int e = tid % NEO, kq = tid / NEO; constexpr int NPT = NTHR / NEO;
#pragma unroll 1
            for (int it0 = 0; it0 < D / NPT; it0 += 8) { float wv[8];
#pragma unroll
                for (int u = 0; u < 8; ++u) { const int k = kq + NPT * (it0 + u); wv[u] = Wsrc[(size_t)k * wld + e] * (nw[k] * (1.0f + scp[k])); }
#pragma unroll
                for (int u = 0; u < 8; ++u) { const int k = kq + NPT * (it0 + u); const unsigned hi = f2bf(wv[u]); const float wl = wv[u] - __builtin_bit_cast(float, hi << 16); Whi[e * WP + k] = (bf16)hi; Wlo[e * WP + k] = (bf16)f2bf(wl); } }
            constexpr int KP = D / NPT; float sacc = 0.f;
#pragma unroll 8
            for (int k = kq * KP; k < kq * KP + KP; ++k) sacc += shp[k] * Wsrc[(size_t)k * wld + e];
            red[kq * NEO + e] = sacc; }
        const bf16* xin = X;
        if (!P5 && layer > 0) { flat_combine<false, false>(X, X, row0, (const bf16*)(ws + WS_Y), MOD + ((size_t)(layer - 1) * 2 + b) * 6144 + 5 * D, lds, tid, lane); asm volatile("s_waitcnt vmcnt(0)" ::: "memory"); }
        __syncthreads();
        if (tid < NEO) { constexpr int NPT = NTHR / NEO; float sacc = P5 ? a.b_r[layer * NE + tid] : 0.f; for (int q = 0; q < NPT; ++q) sacc += red[q * NEO + tid]; biasl[tid] = sacc; }
        const int rg = wave >> 1, kh = wave & 1, r = lane & 15, g = lane >> 4;
        { const bf16* xr = xin + (size_t)(row0 + 16 * rg + r) * D; f32x4 acc[NET]; float ss = 0.f;
#pragma unroll
            for (int et = 0; et < NET; ++et) acc[et] = (f32x4){0.f, 0.f, 0.f, 0.f};
#pragma unroll 4
            for (int s = 16 * kh; s < 16 * kh + 16; ++s) { const int k0 = 32 * s + 8 * g; const v4u xp = *(const v4u*)(xr + k0); const unsigned xw[4] = {xp.x, xp.y, xp.z, xp.w};
#pragma unroll
                for (int j = 0; j < 4; ++j) { const float xa = __builtin_bit_cast(float, xw[j] << 16), xb = __builtin_bit_cast(float, xw[j] & 0xffff0000u); ss += xa * xa + xb * xb; }
                const pg8::bf16x8 ahi = __builtin_bit_cast(pg8::bf16x8, xp);
#pragma unroll
                for (int et = 0; et < NET; ++et) { const pg8::bf16x8 whi = ldfrag(Whi, WP, 16 * et, 32 * s, lane), wlo = ldfrag(Wlo, WP, 16 * et, 32 * s, lane);
                    acc[et] = __builtin_amdgcn_mfma_f32_16x16x32_bf16(ahi, whi, acc[et], 0, 0, 0); acc[et] = __builtin_amdgcn_mfma_f32_16x16x32_bf16(ahi, wlo, acc[et], 0, 0, 0); } }
            ss += __shfl_xor(ss, 16); ss += __shfl_xor(ss, 32);
            if (kh == 1) {
#pragma unroll
                for (int et = 0; et < NET; ++et)
#pragma unroll
                    for (int q = 0; q < 4; ++q) part[(rg * 16 + 4 * g + q) * 32 + 16 * et + r] = acc[et][q];
                if (g == 0) ssx[rg * 16 + r] = ss; }
            __syncthreads();
            if (kh == 0) { const float sst = ss + ssx[rg * 16 + r]; if (g == 0) rstds[rg * 16 + r] = 1.0f / sqrtf(sst * (1.0f / D) + EPS);
                asm volatile("s_waitcnt lgkmcnt(0)" ::: "memory");
#pragma unroll
                for (int et = 0; et < NET; ++et)
#pragma unroll
                    for (int q = 0; q < 4; ++q) { const int i = rg * 16 + 4 * g + q, e = 16 * et + r; const float v = rstds[i] * (acc[et][q] + part[i * 32 + e]) + biasl[e];
                        if (P5) part[i * 32 + e] = v; else ((float*)(ws + WS_GA))[(size_t)(row0 + i) * 16 + e] = v; }
                if (P5) { asm volatile("s_waitcnt lgkmcnt(0)" ::: "memory");
                    if (lane < 16) { const int i = rg * 16 + lane, m = row0 + i; float lv[NE];
#pragma unroll
                        for (int e = 0; e < NE; ++e) lv[e] = part[i * 32 + e];
                        float tv[4]; int te[4];
#pragma unroll
                        for (int t = 0; t < 4; ++t) { float best = -3.0e38f; int bi = 0;
#pragma unroll
                            for (int e = 0; e < NE; ++e) if (lv[e] > best) { best = lv[e]; bi = e; }
#pragma unroll
                            for (int e = 0; e < NE; ++e) if (e == bi) lv[e] = -3.0e38f;
                            tv[t] = best; te[t] = bi; }
                        const float e1 = expf(tv[1] - tv[0]), e2 = expf(tv[2] - tv[0]), e3 = expf(tv[3] - tv[0]); const float inv = 1.0f / (1.0f + e1 + e2 + e3);
                        *(f32x4*)((float*)(ws + WS_TOPW) + (size_t)m * 4) = (f32x4){inv, e1 * inv, e2 * inv, e3 * inv};
#pragma unroll
                        for (int t = 0; t < 4; ++t) { const unsigned rk = __hip_atomic_fetch_add((LAS unsigned*)&MISC[MW_HIST + te[t]], 1u, __ATOMIC_RELAXED, __HIP_MEMORY_SCOPE_WORKGROUP);
                            ((LAS unsigned*)(lds + LR_SLT))[i * 4 + t] = ((unsigned)te[t] << 16) | rk; } } } }
            __syncthreads(); }
        if (P5) { if (tid < NE) { const unsigned hcnt = MISC[MW_HIST + tid]; MISC[MW_BASE + tid] = hcnt ? atomicAdd((unsigned*)(ctl + CW_CNT + layer * NE + tid), hcnt) : 0u; }
            __syncthreads();
            if (tid < 256) { LAS unsigned* sl = (LAS unsigned*)(lds + LR_SLT) + tid; const unsigned v = *sl, e = v >> 16; const unsigned slot = (e << ECAP_SH) + MISC[MW_BASE + e] + (v & 0xffffu);
                *sl = slot; ((int*)(ws + WS_SLOT))[(size_t)row0 * 4 + tid] = (int)slot; }
            if (tid < NE) MISC[MW_HIST + tid] = 0u;
            __syncthreads(); }
        if (P5) { const int c4 = tid & 255, rsub = tid >> 8; const f32x4 w = *(const f32x4*)(nw + 4 * c4), s1 = *(const f32x4*)(scp + 4 * c4), s0 = *(const f32x4*)(shp + 4 * c4); const f32x4 ws1 = w * (s1 + 1.0f);
            unsigned char* A1 = ws + WS_A1;
#pragma unroll 8
            for (int it = 0; it < 32; ++it) { const int i = 2 * it + rsub; const uint2 xp = *(const uint2*)(xin + (size_t)(row0 + i) * D + 4 * c4);
                const f32x4 v = (f32x4){__builtin_bit_cast(float, xp.x << 16), __builtin_bit_cast(float, xp.x & 0xffff0000u), __builtin_bit_cast(float, xp.y << 16), __builtin_bit_cast(float, xp.y & 0xffff0000u)} * rstds[i] * ws1 + s0;
                const int pw = pk4_fp8(v[0] * S8_H, v[1] * S8_H, v[2] * S8_H, v[3] * S8_H); const v4u sl = *(const LAS v4u*)(lds + LR_SLT + 16 * i);
                *(int*)(A1 + (size_t)sl.x * D + 4 * c4) = pw; *(int*)(A1 + (size_t)sl.y * D + 4 * c4) = pw; *(int*)(A1 + (size_t)sl.z * D + 4 * c4) = pw; *(int*)(A1 + (size_t)sl.w * D + 4 * c4) = pw; } }
        else flat_modulate<F8_IN>(xin, row0, rstds, nw, scp, shp, H, tid);
        __syncthreads();
    }
}

__device__ __forceinline__ void final_rows(const Args& a, LAS unsigned char* lds, int vcu, int G, int tid, int lane) {
    unsigned char* ws = a.ws; const bf16* X = (const bf16*)(ws + WS_X); const float* MOD = (const float*)(ws + WS_MOD); LAS float* ssr = (LAS float*)(lds + LR_SSR);
    for (int row0 = vcu * 64; row0 < MTOK; row0 += G * 64) { const int b = row0 / SEQ;
        stage_slots(ws, row0, lds, tid); if (tid < 64) ssr[tid] = 0.f;
        __syncthreads();
        flat_combine<true, true>(X, a.out, row0, (const bf16*)(ws + WS_Y), MOD + ((size_t)(DEPTH - 1) * 2 + b) * 6144 + 5 * D, lds, tid, lane);
        asm volatile("s_waitcnt vmcnt(0)" ::: "memory");
        __syncthreads();
        { const int c4 = tid & 255, rsub = tid >> 8; const f32x4 w = *(const f32x4*)(a.final_norm_w + 4 * c4);
#pragma unroll 8
            for (int it = 0; it < 32; ++it) { const int i = 2 * it + rsub; float* op = a.out + (size_t)(row0 + i) * D + 4 * c4; const float rstd = 1.0f / sqrtf(ssr[i] * (1.0f / D) + EPS); *(f32x4*)op = *(const f32x4*)op * rstd * w; } }
        __syncthreads();
    }
}

__device__ __noinline__ void moe_tables(gu32* ctl, int layer, volatile LAS unsigned* MISC, int tid) {
    if (tid < NE) MISC[MW_CNT + tid] = __hip_atomic_load(ctl + CW_CNT + layer * NE + tid, RLX_AGENT);
    __syncthreads();
    if (tid == 0) { unsigned n = 0;
        for (int e = 0; e < NE; ++e) { const unsigned nt = (MISC[MW_CNT + e] + 255u) >> 8; for (unsigned t = 0; t < nt; ++t) MISC[MW_TILE + n + t] = (unsigned)(e * 64) + t; n += nt; }
        MISC[MW_NRT] = n; }
    __syncthreads();
}

constexpr int BP = 72;
template <int TYPE> struct MixCfg { static constexpr int DK = (TYPE == 1) ? 64 : 48, DV = (TYPE == 1) ? 64 : 96, NC = 4 * DK, NV = 4 * DV;
    static constexpr int STOFF = (TYPE == 0) ? ST_GLA : (TYPE == 1) ? ST_HG : ST_RET, COFF = (TYPE == 0) ? 0 : 192;
    static constexpr int CQ = (TYPE == 0) ? C_GQ : (TYPE == 1) ? C_HQ : C_RQ, CK = (TYPE == 0) ? C_GK : (TYPE == 1) ? C_HF : C_RK, CV = (TYPE == 0) ? C_GV : (TYPE == 1) ? C_HI : C_RV, CG = (TYPE == 0) ? C_GG : (TYPE == 1) ? C_HG : C_RG;
    static constexpr int MIXOFF = (TYPE == 0) ? 0 : (TYPE == 1) ? 384 : 640, KOFF = (TYPE == 0) ? 0 : (TYPE == 1) ? 192 : 448; };
__device__ __forceinline__ float fast_logsig(float x) { x = fmaxf(x, -80.f); return -__logf(1.0f + __expf(-x)); }
__device__ __forceinline__ float ret_lg(int h) { return logf(1.0f - exp2f(-5.0f - (float)h)); }

template <int NV>
__device__ __forceinline__ void stage_vt(const bf16* pv  , LAS bf16* VT, int tid) {
    constexpr int NIT = (64 * (NV / 8)) / NTHR; static_assert((64 * (NV / 8)) % NTHR == 0, "stage_vt");
    v4u p[NIT];
#pragma unroll
    for (int it = 0; it < NIT; ++it) { const int idx = tid + NTHR * it, j = idx & 63, ch = idx >> 6; p[it] = *(const v4u*)(pv + (size_t)j * NPROJ + 8 * ch); }
#pragma unroll
    for (int it = 0; it < NIT; ++it) { const int idx = tid + NTHR * it, j = idx & 63, ch = idx >> 6; LAS bf16* d = VT + (8 * ch) * BP + j;
        d[0 * BP] = (bf16)(p[it].x & 0xffffu); d[1 * BP] = (bf16)(p[it].x >> 16); d[2 * BP] = (bf16)(p[it].y & 0xffffu); d[3 * BP] = (bf16)(p[it].y >> 16);
        d[4 * BP] = (bf16)(p[it].z & 0xffffu); d[5 * BP] = (bf16)(p[it].z >> 16); d[6 * BP] = (bf16)(p[it].w & 0xffffu); d[7 * BP] = (bf16)(p[it].w >> 16); }
}

constexpr int LA_KT = 0, LA_VT = 36864, LA_TOT = 92160, LA_GA = 94208, LA_KTT = 98304, KTP = 264;
template <int TYPE>
__device__ __forceinline__ void mixa_batch(const Args& a, int layer, int unit, LAS unsigned char* lds, int tid, int lane, int wave) {
    asm volatile("" : "+v"(tid), "+v"(lane));
    typedef MixCfg<TYPE> C; constexpr int DK = C::DK, DV = C::DV, NC = C::NC, NV = C::NV;
    unsigned char* ws = a.ws; const bf16* PROJ = (const bf16*)(ws + WS_PROJ); bf16* F1 = (bf16*)(ws + WS_CUM); float* ECG = (float*)(ws + WS_CUM + 16 * MiB) + (size_t)unit * 4 * NDV; float* DVEC = (float*)(ws + WS_DVEC) + (size_t)unit * NDV;
    bf16* U = (bf16*)(ws + WS_U) + (size_t)unit * ST_TOT + C::STOFF;
    LAS bf16* KT = (LAS bf16*)(lds + LA_KT); LAS bf16* VT = (LAS bf16*)(lds + LA_VT); LAS float* TOT = (LAS float*)(lds + LA_TOT); const LAS float* GAs = (const LAS float*)(lds + LA_GA);
    const int row0 = unit * CH;
    stage_vt<NV>(PROJ + (size_t)row0 * NPROJ + C::CV, VT, tid);
    const bool act = tid < 2 * NC; const int c = act ? tid % NC : 0, half = act ? tid / NC : 0, h = c / DK, d = c - h * DK;
    float cum[32]; float tot = 0.f;
    float w2[16], b2 = 0.f, lbv = 0.f, lg = 0.f, sg = 0.f; int f = 0, d2 = 0;
    if (act) {
        if constexpr (TYPE == 0) { b2 = a.gla_ba2[layer * 192 + c];
#pragma unroll
            for (int r = 0; r < 16; ++r) w2[r] = a.gla_wa2[(layer * 16 + r) * 192 + c]; }
        if constexpr (TYPE == 1) lbv = ((const float*)(ws + WS_LB))[layer * 256 + c];
        if constexpr (TYPE == 2) { lg = ret_lg(h); f = (d < 24) ? d : d - 24; d2 = (d < 24) ? d + 24 : d - 24; sg = (d < 24) ? -1.f : 1.f; }
#pragma unroll
        for (int gq = 0; gq < 2; ++gq) {
            bf16 hraw[16];
            if constexpr (TYPE == 1) {
#pragma unroll
                for (int i = 0; i < 16; ++i) hraw[i] = PROJ[(size_t)(row0 + 32 * half + 16 * gq + i) * NPROJ + C_HF + c]; }
#pragma unroll
            for (int ii = 0; ii < 16; ++ii) { const int i = 16 * gq + ii, t = 32 * half + i; float g;
                if constexpr (TYPE == 0) { float pre = b2;
#pragma unroll
                    for (int r = 0; r < 16; ++r) pre += GAs[t * 16 + r] * w2[r];
                    g = fast_logsig(pre) * (1.0f / 16.0f); }
                else if constexpr (TYPE == 1) { const float hf = fminf(fmaxf(bf2f(hraw[ii]), -80.f), 80.f); const float sgm = 1.0f / (1.0f + __expf(-hf));
                    g = __logf(lbv + (1.0f - lbv) * sgm); }
                else g = lg;
                tot += g; cum[i] = tot;
                if constexpr (TYPE == 0) { if ((ii & 3) == 3) asm volatile("" ::: "memory"); } } }
        TOT[c * 2 + half] = tot;
    }
    __syncthreads();
    if (act) { const float t0 = TOT[c * 2], t1 = TOT[c * 2 + 1]; const float off = half ? t0 : 0.f, last = t0 + t1;
#pragma unroll
        for (int hq = 0; hq < 4; ++hq) {
            bf16 ka[8], kb[8]; float cs[8], sn[8];
            if constexpr (TYPE != 1) {
#pragma unroll
                for (int i = 0; i < 8; ++i) { const size_t row = (size_t)(row0 + 32 * half + 8 * hq + i); const bf16* pr = PROJ + row * NPROJ;
                    if constexpr (TYPE == 0) ka[i] = pr[C_GK + c];
                    else { const float* rp = (const float*)(ws + WS_ROPE) + row * 48; ka[i] = pr[C_RK + h * 48 + d]; kb[i] = pr[C_RK + h * 48 + d2]; cs[i] = rp[f]; sn[i] = rp[24 + f]; } } }
            float kt[8];
#pragma unroll
            for (int j = 0; j < 8; ++j) { const int i = 8 * hq + j; const float cm = cum[i] + off; const size_t row = (size_t)(row0 + 32 * half + i); float k;
                if constexpr (TYPE == 0) k = bf2f(ka[j]);
                else if constexpr (TYPE == 1) k = 1.0f - __expf(cum[i] - (i > 0 ? cum[i - 1] : 0.f));
                else k = bf2f(ka[j]) * cs[j] + sg * bf2f(kb[j]) * sn[j];
                if constexpr (TYPE != 2) F1[row * NDV + C::COFF + c] = (bf16)f2bf(__expf(cm - ((i < 16) ? off : cum[15] + off)));
                { const float eb = cum[(i < 16) ? 15 : 31] + off;
                  ((LAS bf16*)(lds + LA_KTT))[(32 * half + i) * KTP + c] = (bf16)f2bf(k * __expf(eb - cm)); }
                kt[j] = k * __expf(last - cm); }
            v4u w; w.x = pk2(kt[0], kt[1]); w.y = pk2(kt[2], kt[3]); w.z = pk2(kt[4], kt[5]); w.w = pk2(kt[6], kt[7]);
            *(LAS v4u*)(KT + c * BP + 32 * half + 8 * hq) = w; }
        if (TYPE != 2) { ECG[(2 * half + 0) * NDV + C::COFF + c] = cum[15] + off; ECG[(2 * half + 1) * NDV + C::COFF + c] = cum[31] + off; }
        if (TYPE != 2 && half == 0) DVEC[C::COFF + c] = __expf(last);
    }
    __syncthreads();
    { constexpr int CPR = NC / 8;
#pragma unroll
        for (int it = 0; it < (64 * CPR) / NTHR; ++it) { const int idx = tid + NTHR * it, t = idx / CPR, ch = idx - t * CPR;
            *(v4u*)((bf16*)(ws + WS_KT) + (size_t)(row0 + t) * NKT + C::KOFF + 8 * ch) = *(const LAS v4u*)((const LAS bf16*)(lds + LA_KTT) + t * KTP + 8 * ch); } }
    constexpr int TD = DK / 16, NT = (DV / 16) * TD;
    for (int ti = wave; ti < 4 * NT; ti += NWAVES) { const int hh = ti / NT, tr = ti - hh * NT, te = tr / TD, td = tr - te * TD; f32x4 acc = {0.f, 0.f, 0.f, 0.f};
#pragma unroll
        for (int kk = 0; kk < 2; ++kk) acc = __builtin_amdgcn_mfma_f32_16x16x32_bf16(ldfrag(VT, BP, hh * DV + te * 16, kk * 32, lane), ldfrag(KT, BP, hh * DK + td * 16, kk * 32, lane), acc, 0, 0, 0);
        bf16* Uh = U + hh * DK * DV;
#pragma unroll
        for (int r = 0; r < 4; ++r) Uh[(te * 16 + (lane >> 4) * 4 + r) * DK + td * 16 + (lane & 15)] = (bf16)f2bf(acc[r]); }
    __syncthreads();
}
__device__ __forceinline__ void p3a_summaries(const Args& a, int layer, LAS unsigned char* lds, int vcu, int G, int tid, int lane, int wave) {
    for (int unit = vcu; unit < NUNIT; unit += G) {
        { LAS float* GAs = (LAS float*)(lds + LA_GA); const float* GA = (const float*)(a.ws + WS_GA); for (int i = tid; i < CH * 16; i += NTHR) GAs[i] = GA[(size_t)unit * CH * 16 + i]; }
        __syncthreads();
        mixa_batch<0>(a, layer, unit, lds, tid, lane, wave);
        mixa_batch<1>(a, layer, unit, lds, tid, lane, wave);
        mixa_batch<2>(a, layer, unit, lds, tid, lane, wave);
    }
}

__device__ __forceinline__ void p3b_scan(const Args& a, int vcu, int G, int tid) {
    unsigned char* ws = a.ws; const bf16* U = (const bf16*)(ws + WS_U); const float* DVEC = (const float*)(ws + WS_DVEC); bf16* SP = (bf16*)(ws + WS_SP);
    for (int gid = vcu * NTHR + tid; gid < BATCH * ST_TOT; gid += G * NTHR) {
        const int b = gid / ST_TOT, el = gid - b * ST_TOT;
        int di = -1; float cdec = 0.f;
        if (el < ST_HG) { const int h = el / 4608, d = (el - h * 4608) % 48; di = h * 48 + d; }
        else if (el < ST_RET) { const int r = el - ST_HG, h = r / 4096, d = r % 64; di = 192 + h * 64 + d; }
        else { const int h = (el - ST_RET) / 4608; cdec = expf(64.0f * logf(1.0f - exp2f(-5.0f - (float)h))); }
        const bf16* up = U + (size_t)b * NCH * ST_TOT + el; const float* dp = DVEC + (size_t)b * NCH * NDV + (di < 0 ? 0 : di); bf16* sp = SP + (size_t)b * NCH * ST_TOT + el;
        float s = 0.f;
#pragma unroll 1
        for (int n0 = 0; n0 < NCH; n0 += 32) { float u[32], dc[32];
#pragma unroll
            for (int i = 0; i < 32; ++i) { u[i] = bf2f(up[(size_t)(n0 + i) * ST_TOT]); dc[i] = (di < 0) ? cdec : dp[(size_t)(n0 + i) * NDV]; }
#pragma unroll
            for (int i = 0; i < 32; ++i) { sp[(size_t)(n0 + i) * ST_TOT] = (bf16)f2bf(s); s = dc[i] * s + u[i]; } }
    }
}

#ifndef SUB_MASK
#define SUB_MASK 0
#endif
#define SUBSTRETCH(bit, t0_) do { if ((SUB_MASK >> (bit)) & 1) { const unsigned long long t1_ = __builtin_amdgcn_s_memrealtime(); while (__builtin_amdgcn_s_memrealtime() - t1_ < t1_ - (t0_)) __builtin_amdgcn_s_sleep(8); } } while (0)
constexpr int LC_VT = 0, LC_ST = 55296, LC_AB = 110592, OBP = 104, LC_EC = 137216;
template <int TYPE, bool ISQ>
__device__ __forceinline__ void mix_frag(const Args& a, int h, size_t row, int t, int d0, float (&x)[8], float (&cm)[8]) {
    typedef MixCfg<TYPE> C; constexpr int DK = C::DK; static_assert(ISQ, "query path only");
    unsigned char* ws = a.ws; const bf16* pr = (const bf16*)(ws + WS_PROJ) + row * NPROJ;
    if constexpr (TYPE != 2) {
        const v4u p = *(const v4u*)(pr + C::CQ + h * DK + d0); const unsigned pw[4] = {p.x, p.y, p.z, p.w};
        const v4u f = *(const v4u*)((const bf16*)(ws + WS_CUM) + row * NDV + C::COFF + h * DK + d0); const unsigned fw[4] = {f.x, f.y, f.z, f.w};
#pragma unroll
        for (int j = 0; j < 4; ++j) { x[2 * j] = __builtin_bit_cast(float, pw[j] << 16); x[2 * j + 1] = __builtin_bit_cast(float, pw[j] & 0xffff0000u); cm[2 * j] = __builtin_bit_cast(float, fw[j] << 16); cm[2 * j + 1] = __builtin_bit_cast(float, fw[j] & 0xffff0000u); }
        if constexpr (TYPE == 0) {
#pragma unroll
            for (int j = 0; j < 8; ++j) x[j] *= 0.14433756729740643f; }
    } else {
        const int f0 = (d0 < 24) ? d0 : d0 - 24, dp = (d0 < 24) ? d0 + 24 : d0 - 24; const float sg = (d0 < 24) ? -1.f : 1.f;
        const int cb = C_RQ + h * DK; const v4u p = *(const v4u*)(pr + cb + d0), pp = *(const v4u*)(pr + cb + dp); const unsigned pw[4] = {p.x, p.y, p.z, p.w}, qw[4] = {pp.x, pp.y, pp.z, pp.w};
        const float* rp = (const float*)(ws + WS_ROPE) + row * 48; const f32x4 cs0 = *(const f32x4*)(rp + f0), cs1 = *(const f32x4*)(rp + f0 + 4), sn0 = *(const f32x4*)(rp + 24 + f0), sn1 = *(const f32x4*)(rp + 24 + f0 + 4);
        const float cmv = (float)(t + 1) * ret_lg(h);
#pragma unroll
        for (int j = 0; j < 4; ++j) { const float xa = __builtin_bit_cast(float, pw[j] << 16), xb = __builtin_bit_cast(float, pw[j] & 0xffff0000u), ya = __builtin_bit_cast(float, qw[j] << 16), yb = __builtin_bit_cast(float, qw[j] & 0xffff0000u);
            const float ca = (j < 2) ? cs0[2 * j] : cs1[2 * j - 4], cb2 = (j < 2) ? cs0[2 * j + 1] : cs1[2 * j - 3], sa = (j < 2) ? sn0[2 * j] : sn1[2 * j - 4], sb = (j < 2) ? sn0[2 * j + 1] : sn1[2 * j - 3];
            x[2 * j] = (xa * ca + sg * ya * sa) * 0.14433756729740643f; x[2 * j + 1] = (xb * cb2 + sg * yb * sb) * 0.14433756729740643f; cm[2 * j] = cmv; cm[2 * j + 1] = cmv; }
    }
}

template <int TYPE>
__device__ __forceinline__ void mixc_batch(const Args& a, int layer, int unit, LAS unsigned char* lds, int tid, int lane, int wave) {
    asm volatile("" : "+v"(tid), "+v"(lane));
    typedef MixCfg<TYPE> C; constexpr int DK = C::DK, DV = C::DV, NV = C::NV, TE = DV / 16;
    unsigned char* ws = a.ws; const bf16* PROJ = (const bf16*)(ws + WS_PROJ); bf16* MIX = (bf16*)(ws + WS_MIX);
    LAS bf16* VT = (LAS bf16*)(lds + LC_VT); LAS bf16* ST = (LAS bf16*)(lds + LC_ST); LAS bf16* AB = (LAS bf16*)(lds + LC_AB) + wave * 16 * OBP;
    const int row0 = unit * CH;
    const unsigned long long ts0_ = SUB_MASK ? __builtin_amdgcn_s_memrealtime() : 0ull;
    stage_vt<NV>(PROJ + (size_t)row0 * NPROJ + C::CV, VT, tid);
    SUBSTRETCH(3, ts0_);
    const unsigned long long ts3_ = SUB_MASK ? __builtin_amdgcn_s_memrealtime() : 0ull;
    { const bf16* SPu = (const bf16*)(ws + WS_SP) + (size_t)unit * ST_TOT + C::STOFF;
        constexpr int NIS = (NV * 8) / NTHR; static_assert((NV * 8) % NTHR == 0, "ST staging"); v4u sw[NIS];
#pragma unroll
        for (int it = 0; it < NIS; ++it) { const int idx = tid + NTHR * it, er = idx >> 3, ch = idx & 7; sw[it] = (v4u){0u, 0u, 0u, 0u}; if (ch * 8 < DK) sw[it] = *(const v4u*)(SPu + (size_t)er * DK + ch * 8); }
#pragma unroll
        for (int it = 0; it < NIS; ++it) { const int idx = tid + NTHR * it, er = idx >> 3, ch = idx & 7; *(LAS v4u*)(ST + er * BP + ch * 8) = sw[it]; } }
    SUBSTRETCH(4, ts3_);
    SUBSTRETCH(0, ts0_);
    if constexpr (TYPE != 2) { LAS float* EC = (LAS float*)(lds + LC_EC);
        for (int idx = tid; idx < 4 * C::NC; idx += NTHR) { const int jb = idx / C::NC, cc = idx - jb * C::NC; EC[jb * 256 + cc] = ((const float*)(ws + WS_CUM + 16 * MiB))[((size_t)unit * 4 + jb) * NDV + C::COFF + cc]; } }
    __syncthreads();
    const unsigned long long ts1_ = SUB_MASK ? __builtin_amdgcn_s_memrealtime() : 0ull;
    const int h = wave >> 1, hsel = wave & 1, r = lane & 15, g = lane >> 4;
    const LAS bf16* STh = ST + h * DV * BP; const LAS bf16* VTh = VT + h * DV * BP;
    constexpr int NCHK = DV / 8, NOC = (16 * NCHK) / 64;
#pragma unroll 1
    for (int ib = 0; ib < 2; ++ib) { const int I = ib ? 3 - hsel : hsel;
        pg8::bf16x8 qh[2], qt[2]; float refv[2][8], qhf[2][8];
#pragma unroll
        for (int s = 0; s < 2; ++s) { const int d0 = 32 * s + 8 * g; const bool valid = d0 < DK; const int d0c = valid ? d0 : 0;
            float x[8], cm[8]; mix_frag<TYPE, true>(a, h, (size_t)(row0 + 16 * I + r), 16 * I + r, d0c, x, cm);
            if constexpr (TYPE == 2) {
#pragma unroll
                for (int j = 0; j < 8; ++j) refv[s][j] = (float)(16 * I) * ret_lg(h);
            } else { if (I > 0) { const LAS float* cp = (const LAS float*)(lds + LC_EC) + (I - 1) * 256 + h * DK + d0c; const f32x4 c0 = *(const LAS f32x4*)cp, c1 = *(const LAS f32x4*)(cp + 4);
#pragma unroll
                    for (int j = 0; j < 4; ++j) { refv[s][j] = c0[j]; refv[s][4 + j] = c1[j]; } }
                else {
#pragma unroll
                    for (int j = 0; j < 8; ++j) refv[s][j] = 0.f; } }
            float xt[8];
#pragma unroll
            for (int j = 0; j < 8; ++j) { if constexpr (TYPE == 2) { qhf[s][j] = valid ? x[j] * __expf(cm[j] - refv[s][j]) : 0.f; xt[j] = valid ? x[j] * __expf(cm[j]) : 0.f; }
                else { qhf[s][j] = valid ? x[j] * cm[j] : 0.f; xt[j] = qhf[s][j] * __expf(refv[s][j]); } }
            qh[s] = pack8(qhf[s]); qt[s] = pack8(xt); }
        v4u kf[4][2];
#pragma unroll
        for (int J = 0; J < 4; ++J) { const int Jc = (J < I) ? J : I; const size_t rowJ = (size_t)(row0 + 16 * Jc + r);
#pragma unroll
            for (int s = 0; s < 2; ++s) { const int d0 = 32 * s + 8 * g; const int d0c = (d0 < DK) ? d0 : 0;
                kf[J][s] = *(const v4u*)((const bf16*)(ws + WS_KT) + rowJ * NKT + C::KOFF + h * DK + d0c); } }
#pragma unroll
        for (int J = 0; J < 4; ++J) { if (J <= I) { f32x4 acc = {0.f, 0.f, 0.f, 0.f};
#pragma unroll
            for (int s = 0; s < 2; ++s) { pg8::bf16x8 qop;
                { float xq[8], ej[8]; const int d0 = 32 * s + 8 * g; const int d0c = (d0 < DK) ? d0 : 0;
                    if constexpr (TYPE == 2) {
#pragma unroll
                        for (int j = 0; j < 8; ++j) ej[j] = (float)(16 * (J + 1)) * ret_lg(h); }
                    else { const LAS float* ep = (const LAS float*)(lds + LC_EC) + J * 256 + h * DK + d0c; const f32x4 e0 = *(const LAS f32x4*)ep, e1 = *(const LAS f32x4*)(ep + 4);
#pragma unroll
                        for (int j = 0; j < 4; ++j) { ej[j] = e0[j]; ej[4 + j] = e1[j]; } }
#pragma unroll
                    for (int j = 0; j < 8; ++j) xq[j] = qhf[s][j] * __expf(fminf(refv[s][j] - ej[j], 80.f));
                    qop = pack8(xq); }
                acc = __builtin_amdgcn_mfma_f32_16x16x32_bf16(qop, __builtin_bit_cast(pg8::bf16x8, kf[J][s]), acc, 0, 0, 0); }
#pragma unroll
            for (int q = 0; q < 4; ++q) { const int i = 4 * g + q; const float v = (J < I || r <= i) ? acc[q] : 0.f; AB[i * BP + 16 * J + r] = (bf16)f2bf(v); } } }
        if ((I & 1) == 0) {
#pragma unroll
            for (int q = 0; q < 4; ++q) AB[(4 * g + q) * BP + 16 * (I + 1) + r] = (bf16)0; }
        asm volatile("s_waitcnt lgkmcnt(0)" ::: "memory");
        const pg8::bf16x8 ah0 = *(const LAS pg8::bf16x8*)(AB + r * BP + 8 * g), ah1 = *(const LAS pg8::bf16x8*)(AB + r * BP + 32 + 8 * g);
        f32x4 o[TE];
#pragma unroll
        for (int te = 0; te < TE; ++te) { f32x4 acc = {0.f, 0.f, 0.f, 0.f};
            acc = __builtin_amdgcn_mfma_f32_16x16x32_bf16(qt[0], ldfrag(STh, BP, te * 16, 0, lane), acc, 0, 0, 0);
            acc = __builtin_amdgcn_mfma_f32_16x16x32_bf16(qt[1], ldfrag(STh, BP, te * 16, 32, lane), acc, 0, 0, 0);
            acc = __builtin_amdgcn_mfma_f32_16x16x32_bf16(ah0, ldfrag(VTh, BP, te * 16, 0, lane), acc, 0, 0, 0);
            if (I >= 2) acc = __builtin_amdgcn_mfma_f32_16x16x32_bf16(ah1, ldfrag(VTh, BP, te * 16, 32, lane), acc, 0, 0, 0);
            o[te] = acc; }
        const unsigned long long ts2_ = SUB_MASK ? __builtin_amdgcn_s_memrealtime() : 0ull;
#pragma unroll
        for (int q = 0; q < 4; ++q) { float s1 = 0.f, s2 = 0.f;
#pragma unroll
            for (int te = 0; te < TE; ++te) { s1 += o[te][q]; s2 += o[te][q] * o[te][q]; }
#pragma unroll
            for (int m = 1; m < 16; m <<= 1) { s1 += __shfl_xor(s1, m); s2 += __shfl_xor(s2, m); }
            float mean = 0.f, rstd;
            if constexpr (TYPE == 2) { mean = s1 * (1.0f / DV); rstd = 1.0f / sqrtf(fmaxf(s2 * (1.0f / DV) - mean * mean, 0.f) + EPS); }
            else rstd = 1.0f / sqrtf(s2 * (1.0f / DV) + EPS);
#pragma unroll
            for (int te = 0; te < TE; ++te) AB[(4 * g + q) * OBP + te * 16 + r] = (bf16)f2bf((o[te][q] - mean) * rstd); }
        asm volatile("s_waitcnt lgkmcnt(0)" ::: "memory");
#pragma unroll 1
        for (int i = 0; i < NOC; ++i) { const int cidx = lane + 64 * i, orow = cidx / NCHK, ch = cidx - orow * NCHK; const size_t row = (size_t)(row0 + 16 * I + orow);
            const v4u ov = *(const LAS v4u*)(AB + orow * OBP + 8 * ch); const v4u gv = *(const v4u*)(PROJ + row * NPROJ + C::CG + h * DV + 8 * ch);
            const unsigned ow[4] = {ov.x, ov.y, ov.z, ov.w}, gw[4] = {gv.x, gv.y, gv.z, gv.w}; float res[8];
            f32x4 w0 = {1.f, 1.f, 1.f, 1.f}, w1 = {1.f, 1.f, 1.f, 1.f};
            if constexpr (TYPE == 0) { const float* wp = a.gla_norm_w + layer * 384 + h * 96 + 8 * ch; w0 = *(const f32x4*)wp; w1 = *(const f32x4*)(wp + 4); }
            if constexpr (TYPE == 1) { const float* wp = a.hg_norm_w + layer * 256 + h * 64 + 8 * ch; w0 = *(const f32x4*)wp; w1 = *(const f32x4*)(wp + 4); }
#pragma unroll
            for (int j = 0; j < 4; ++j) { const float oa = __builtin_bit_cast(float, ow[j] << 16), ob = __builtin_bit_cast(float, ow[j] & 0xffff0000u), ga = __builtin_bit_cast(float, gw[j] << 16), gb = __builtin_bit_cast(float, gw[j] & 0xffff0000u);
                const float wa = (j < 2) ? w0[2 * j] : w1[2 * j - 4], wb = (j < 2) ? w0[2 * j + 1] : w1[2 * j - 3];
                const float sa = 1.0f / (1.0f + __expf(-ga)), sb = 1.0f / (1.0f + __expf(-gb));
                res[2 * j] = oa * wa * ((TYPE == 1) ? sa : ga * sa); res[2 * j + 1] = ob * wb * ((TYPE == 1) ? sb : gb * sb); }
            if (F8_OUT) { typedef int i32x2 __attribute__((ext_vector_type(2)));
                *(i32x2*)((unsigned char*)MIX + row * D + C::MIXOFF + h * DV + 8 * ch) = (i32x2){pk4_fp8(res[0] * S8_M, res[1] * S8_M, res[2] * S8_M, res[3] * S8_M), pk4_fp8(res[4] * S8_M, res[5] * S8_M, res[6] * S8_M, res[7] * S8_M)}; }
            else { v4u w; w.x = pk2(res[0], res[1]); w.y = pk2(res[2], res[3]); w.z = pk2(res[4], res[5]); w.w = pk2(res[6], res[7]); *(v4u*)(MIX + row * D + C::MIXOFF + h * DV + 8 * ch) = w; } }
        SUBSTRETCH(2, ts2_);
    }
    SUBSTRETCH(1, ts1_);
    __syncthreads();
}
__device__ __forceinline__ void p3c_outputs(const Args& a, int layer, LAS unsigned char* lds, int vcu, int G, int tid, int lane, int wave) {
    for (int unit = vcu; unit < NUNIT; unit += G) {
        mixc_batch<0>(a, layer, unit, lds, tid, lane, wave);
        mixc_batch<1>(a, layer, unit, lds, tid, lane, wave);
        mixc_batch<2>(a, layer, unit, lds, tid, lane, wave);
    }
}


constexpr int MW_ARGS = 800;
__device__ __forceinline__ const void* ld_argp(const volatile LAS unsigned* T, int i) {
    const unsigned lo = __builtin_amdgcn_readfirstlane(T[2 * i]), hi = __builtin_amdgcn_readfirstlane(T[2 * i + 1]);
    return (const void*)(((unsigned long long)hi << 32) | lo);
}
__device__ __forceinline__ Args load_args(LAS unsigned char* lds) {
    const volatile LAS unsigned* T = (const volatile LAS unsigned*)(lds + MISC_OFF) + MW_ARGS;
    Args a;
    a.x = (const float*)ld_argp(T, 0); a.c = (const float*)ld_argp(T, 1); a.pos = (const int*)ld_argp(T, 2); a.w_mod = (const float*)ld_argp(T, 3); a.b_mod = (const float*)ld_argp(T, 4);
    a.norm1_w = (const float*)ld_argp(T, 5); a.w_in = (const float*)ld_argp(T, 6); a.gla_wa2 = (const float*)ld_argp(T, 7); a.gla_ba2 = (const float*)ld_argp(T, 8); a.hg_lb = (const float*)ld_argp(T, 9);
    a.gla_norm_w = (const float*)ld_argp(T, 10); a.hg_norm_w = (const float*)ld_argp(T, 11); a.w_out = (const float*)ld_argp(T, 12); a.norm2_w = (const float*)ld_argp(T, 13); a.w_r = (const float*)ld_argp(T, 14);
    a.b_r = (const float*)ld_argp(T, 15); a.w_gu = (const float*)ld_argp(T, 16); a.b_gu = (const float*)ld_argp(T, 17); a.w_dn = (const float*)ld_argp(T, 18); a.b_dn = (const float*)ld_argp(T, 19);
    a.final_norm_w = (const float*)ld_argp(T, 20); a.out = (float*)ld_argp(T, 21); a.ws = (unsigned char*)ld_argp(T, 22); a.ph_lo = 0; a.ph_hi = 0;
    return a;
}
#define PH_CTX() { unsigned l_ = (unsigned)(size_t)lds; asm volatile("" : "+s"(l_)); lds = (LAS unsigned char*)(size_t)l_; } const Args args = load_args(lds); volatile LAS unsigned* MISC = (volatile LAS unsigned*)(lds + MISC_OFF); int tid_ = wv * 64 + (int)__builtin_amdgcn_mbcnt_hi(~0u, __builtin_amdgcn_mbcnt_lo(~0u, 0u)); asm volatile("" : "+v"(tid_)); const int tid = tid_, lane = tid & 63, wave = __builtin_amdgcn_readfirstlane(tid >> 6); \
    const int G = gridDim.x; const int bx = blockIdx.x; const int vcu = (G % 8 == 0) ? (bx % 8) * (G / 8) + bx / 8 : bx; unsigned char* ws = args.ws; gu32* ctl = (gu32*)(ws + WS_CTL); \
    (void)MISC; (void)lane; (void)wave; (void)vcu; (void)ctl; (void)bx; (void)tid
__device__ __forceinline__ void ph_p0(LAS unsigned char* lds, int wv) { PH_CTX(); p0_prologue(args, lds, vcu, G, tid, lane, wave); }
__device__ __forceinline__ void ph_p1(LAS unsigned char* lds, int wv, int layer_) { int layer = __builtin_amdgcn_readfirstlane(layer_); asm volatile("" : "+s"(layer)); PH_CTX();
    if (layer > 0) { moe_tables(ctl, layer - 1, MISC, tid); const int nrt = __builtin_amdgcn_readfirstlane((int)MISC[MW_NRT]);
        const int done = conv_t2(G) + conv_idle(nrt * 8, G) * NWAVES * CB7 + conv_idle(nrt * 4, G) * NWAVES * CB8; LAS float* scr = (LAS float*)(lds + wave * 16640);
        for (int it = done + vcu * NWAVES + wave; it < IT_LAYER; it += G * NWAVES) convert_item(args, layer, it, scr, lane);
        __syncthreads(); }
    rows_mfma<16>(args, layer, lds, MISC, ctl, vcu, G, tid, lane, wave); }
__device__ __forceinline__ void ph_p2(LAS unsigned char* lds, int wv, int layer_) { int layer = __builtin_amdgcn_readfirstlane(layer_); asm volatile("" : "+s"(layer)); PH_CTX();
    pg8::Gemm g{(const bf16*)(ws + WS_H), (const bf16*)(ws + WS_WIN + (size_t)layer * NPROJ * D * (F8_IN ? 1 : 2)), MTOK, NPROJ, F8_IN ? D / 2 : D}; pg8::StaticOrder S; S.init(MTOK, NPROJ, G, bx);
    pg8::EpiBf16Plain E{(bf16*)(ws + WS_PROJ), NPROJ, F8_IN ? 1.0f / (S8_H * S8_W) : 1.0f};
    pg8::gemm_phase<pg8::EpiBf16Plain, pg8::StaticOrder, true, true, F8_IN>(lds, g, S, E, tid);
    if (layer + 1 < DEPTH && G == 256 && bx >= 64) convert_range(args, layer + 1, ((bx - 64) * NWAVES + wave) * CB2, CB2, lds, lane, wave); }
__device__ __forceinline__ void ph_p3a(LAS unsigned char* lds, int wv, int layer_) { int layer = __builtin_amdgcn_readfirstlane(layer_); asm volatile("" : "+s"(layer)); PH_CTX(); p3a_summaries(args, layer, lds, vcu, G, tid, lane, wave); }
__device__ __forceinline__ void ph_p3b(LAS unsigned char* lds, int wv) { PH_CTX(); p3b_scan(args, vcu, G, tid); }
__device__ __forceinline__ void ph_p3c(LAS unsigned char* lds, int wv, int layer_) { int layer = __builtin_amdgcn_readfirstlane(layer_); asm volatile("" : "+s"(layer)); PH_CTX(); p3c_outputs(args, layer, lds, vcu, G, tid, lane, wave); }
__device__ __forceinline__ void ph_p4(LAS unsigned char* lds, int wv, int layer_) { int layer = __builtin_amdgcn_readfirstlane(layer_); asm volatile("" : "+s"(layer)); PH_CTX();
    pg8::Gemm g{(const bf16*)(ws + WS_MIX), (const bf16*)(ws + WS_WOUT + (size_t)layer * D * D * (F8_OUT ? 1 : 2)), MTOK, D, F8_OUT ? D / 2 : D}; pg8::StaticOrder S; S.init(MTOK, D, G, bx);
    pg8::EpiResGate E{(const bf16*)(ws + WS_X), (bf16*)(ws + WS_X), D, (const float*)(ws + WS_MOD) + (size_t)layer * 2 * 6144 + 2 * D, 6144, SEQ, F8_OUT ? 1.0f / (S8_M * S8_W) : 1.0f};
    pg8::gemm_phase<pg8::EpiResGate, pg8::StaticOrder, true, true, F8_OUT>(lds, g, S, E, tid); }
__device__ __forceinline__ void ph_p5(LAS unsigned char* lds, int wv, int layer_) { int layer = __builtin_amdgcn_readfirstlane(layer_); asm volatile("" : "+s"(layer)); PH_CTX(); rows_mfma<32>(args, layer, lds, MISC, ctl, vcu, G, tid, lane, wave); }
__device__ __forceinline__ void ph_p7(LAS unsigned char* lds, int wv, int layer_) { int layer = __builtin_amdgcn_readfirstlane(layer_); asm volatile("" : "+s"(layer)); PH_CTX();
    moe_tables(ctl, layer, MISC, tid);
    const int nrt = __builtin_amdgcn_readfirstlane((int)MISC[MW_NRT]);
    pg8::Gemm g{(const bf16*)(ws + WS_A1), (const bf16*)(ws + WS_WGU + (size_t)layer * NE * 2048 * D), nrt * 256, NE * 2048, D / 2};
    pg8::MoeOrder S{8, G, vcu, nrt * 8, (const LAS int*)(lds + MISC_OFF + 4 * MW_TILE)};
    pg8::EpiSwiglu E{ws + WS_ACT, FFN, args.b_gu + (size_t)layer * NE * 2048, 1.0f / (S8_H * S8_W), S8_A};
    pg8::gemm_phase<pg8::EpiSwiglu, pg8::MoeOrder, true, true, true>(lds, g, S, E, tid);
    { const int rem = (nrt * 8) % G; if (layer + 1 < DEPTH && rem != 0 && vcu >= rem) convert_range(args, layer + 1, conv_t2(G) + ((vcu - rem) * NWAVES + wave) * CB7, CB7, lds, lane, wave); } }
__device__ __forceinline__ void ph_p8(LAS unsigned char* lds, int wv, int layer_) { int layer = __builtin_amdgcn_readfirstlane(layer_); asm volatile("" : "+s"(layer)); PH_CTX();
    moe_tables(ctl, layer, MISC, tid);
    const int nrt = __builtin_amdgcn_readfirstlane((int)MISC[MW_NRT]);
    pg8::Gemm g{(const bf16*)(ws + WS_ACT), (const bf16*)(ws + WS_WDN + (size_t)layer * NE * D * FFN), nrt * 256, NE * D, FFN / 2};
    pg8::MoeOrder S{4, G, vcu, nrt * 4, (const LAS int*)(lds + MISC_OFF + 4 * MW_TILE)};
    if constexpr (Y8) { pg8::EpiFp8Bias E{ws + WS_Y, D, args.b_dn + (size_t)layer * NE * D, D, 1.0f / (S8_A * S8_W), S8_Y};
        pg8::gemm_phase<pg8::EpiFp8Bias, pg8::MoeOrder, true, true, true>(lds, g, S, E, tid); }
    else { pg8::EpiBf16Bias E{(bf16*)(ws + WS_Y), D, args.b_dn + (size_t)layer * NE * D, D, 1.0f / (S8_A * S8_W)};
        pg8::gemm_phase<pg8::EpiBf16Bias, pg8::MoeOrder, true, true, true>(lds, g, S, E, tid); }
    { const int rem = (nrt * 4) % G; if (layer + 1 < DEPTH && rem != 0 && vcu >= rem) convert_range(args, layer + 1, conv_t2(G) + conv_idle(nrt * 8, G) * NWAVES * CB7 + ((vcu - rem) * NWAVES + wave) * CB8, CB8, lds, lane, wave); } }
__device__ __forceinline__ void ph_final(LAS unsigned char* lds, int wv) { PH_CTX(); final_rows(args, lds, vcu, G, tid, lane); }

#ifndef DBL_MASK
#define DBL_MASK 0
#endif
#if DBL_MASK
#define RUN(bit, call) do { if ((DBL_MASK >> (bit)) & 1) { const unsigned long long t0_ = __builtin_amdgcn_s_memrealtime(); call; const unsigned long long t1_ = __builtin_amdgcn_s_memrealtime(); \
        while (__builtin_amdgcn_s_memrealtime() - t1_ < t1_ - t0_) __builtin_amdgcn_s_sleep(8); } else { call; } } while (0)
#else
#define RUN(bit, call) do { call; } while (0)
#endif
__global__ void __launch_bounds__(NTHR, 2) hybrid_fwd(Args args) {
    extern __shared__ __attribute__((aligned(16))) unsigned char lds_raw[];
    LAS unsigned char* lds = (LAS unsigned char*)lds_raw;
    volatile LAS unsigned* MISC = (volatile LAS unsigned*)(lds + MISC_OFF);
    const int tid = threadIdx.x; const int wv = __builtin_amdgcn_readfirstlane(tid >> 6);
    gu32* ctl = (gu32*)(args.ws + WS_CTL);
    for (int u = tid; u < (LDS_BYTES - MISC_OFF) / 4; u += NTHR) MISC[u] = 0u;
    __syncthreads();
    if (tid == 0) {
#define ST_ARG(i, p) do { const unsigned long long v_ = (unsigned long long)(p); MISC[MW_ARGS + 2 * (i)] = (unsigned)v_; MISC[MW_ARGS + 2 * (i) + 1] = (unsigned)(v_ >> 32); } while (0)
        ST_ARG(0, args.x); ST_ARG(1, args.c); ST_ARG(2, args.pos); ST_ARG(3, args.w_mod); ST_ARG(4, args.b_mod); ST_ARG(5, args.norm1_w); ST_ARG(6, args.w_in); ST_ARG(7, args.gla_wa2); ST_ARG(8, args.gla_ba2);
        ST_ARG(9, args.hg_lb); ST_ARG(10, args.gla_norm_w); ST_ARG(11, args.hg_norm_w); ST_ARG(12, args.w_out); ST_ARG(13, args.norm2_w); ST_ARG(14, args.w_r); ST_ARG(15, args.b_r); ST_ARG(16, args.w_gu);
        ST_ARG(17, args.b_gu); ST_ARG(18, args.w_dn); ST_ARG(19, args.b_dn); ST_ARG(20, args.final_norm_w); ST_ARG(21, args.out); ST_ARG(22, args.ws);
#undef ST_ARG
    }
    __syncthreads();
    const int lo = args.ph_lo, hi = args.ph_hi;
    const bool multi = (hi - lo) > 1;
    XcdBarrier bar; bar.bar = (unsigned*)(ctl + CW_BAR); bar.x = 0; bar.st = nullptr;
    if (multi) bar = xcd_barrier_post((unsigned*)(ctl + CW_BAR), MISC + MW_BAR);
#define IN(k) (lo <= (k) && (k) < hi)
#define SEAM(k) do { if (IN(k) && IN((k) + 1)) xcd_barrier(bar); } while (0)

    if (IN(0)) RUN(0, ph_p0(lds, wv));
    SEAM(0);
    for (int layer = 0; layer < DEPTH; ++layer) {
        const int pb = 1 + 9 * layer;
        if (IN(pb + 0)) RUN(1, ph_p1(lds, wv, layer));
        SEAM(pb + 0);
        if (IN(pb + 1)) RUN(2, ph_p2(lds, wv, layer));
        SEAM(pb + 1);
        if (IN(pb + 2)) RUN(3, ph_p3a(lds, wv, layer));
        SEAM(pb + 2);
        if (IN(pb + 3)) RUN(4, ph_p3b(lds, wv));
        SEAM(pb + 3);
        if (IN(pb + 4)) RUN(5, ph_p3c(lds, wv, layer));
        SEAM(pb + 4);
        if (IN(pb + 5)) RUN(6, ph_p4(lds, wv, layer));
        SEAM(pb + 5);
        if (IN(pb + 6)) RUN(7, ph_p5(lds, wv, layer));
        SEAM(pb + 6);
        if (IN(pb + 7)) RUN(9, ph_p7(lds, wv, layer));
        SEAM(pb + 7);
        if (IN(pb + 8)) RUN(10, ph_p8(lds, wv, layer));
        SEAM(pb + 8);
    }
    if (IN(NPHASE - 1)) RUN(11, ph_final(lds, wv));
#undef IN
#undef SEAM
}

#ifndef MK_SINGLE
#define MK_SINGLE 1
#endif
extern "C" void kernel_launch(void* const* d_in, const int* in_sizes, int n_in, void* d_out, int out_size, void* d_ws, size_t ws_size, hipStream_t stream) {
    static int grid = 0;
    if (grid == 0) {
        if (n_in != 21 || in_sizes[0] != MTOK * D || out_size != MTOK * D || ws_size < WS_END) { fprintf(stderr, "kernel_launch: unexpected problem shape (n_in %d, in0 %d, out %d, ws %zu)\n", n_in, n_in > 0 ? in_sizes[0] : -1, out_size, ws_size); grid = -1; return; }
        int dev = 0, cus = 0, per_cu = 0;
        if (hipGetDevice(&dev) != hipSuccess || hipDeviceGetAttribute(&cus, hipDeviceAttributeMultiprocessorCount, dev) != hipSuccess) { grid = -1; return; }
        if (hipFuncSetAttribute((const void*)hybrid_fwd, hipFuncAttributeMaxDynamicSharedMemorySize, LDS_BYTES) != hipSuccess) { fprintf(stderr, "kernel_launch: hipFuncSetAttribute failed\n"); grid = -1; return; }
        if (hipOccupancyMaxActiveBlocksPerMultiprocessor(&per_cu, (const void*)hybrid_fwd, NTHR, LDS_BYTES) != hipSuccess || per_cu < 1) fprintf(stderr, "kernel_launch: occupancy query says %d\n", per_cu);
        (void)hipGetLastError();
        grid = cus;
    }
    if (grid < 0) return;
    (void)hipMemsetAsync((char*)d_ws + WS_CTL, 0, CTL_ZERO_BYTES, stream);
    Args a{};
    a.x = (const float*)d_in[0]; a.c = (const float*)d_in[1]; a.pos = (const int*)d_in[2]; a.w_mod = (const float*)d_in[3]; a.b_mod = (const float*)d_in[4]; a.norm1_w = (const float*)d_in[5];
    a.w_in = (const float*)d_in[6]; a.gla_wa2 = (const float*)d_in[7]; a.gla_ba2 = (const float*)d_in[8]; a.hg_lb = (const float*)d_in[9]; a.gla_norm_w = (const float*)d_in[10]; a.hg_norm_w = (const float*)d_in[11];
    a.w_out = (const float*)d_in[12]; a.norm2_w = (const float*)d_in[13]; a.w_r = (const float*)d_in[14]; a.b_r = (const float*)d_in[15]; a.w_gu = (const float*)d_in[16]; a.b_gu = (const float*)d_in[17];
    a.w_dn = (const float*)d_in[18]; a.b_dn = (const float*)d_in[19]; a.final_norm_w = (const float*)d_in[20]; a.out = (float*)d_out; a.ws = (unsigned char*)d_ws;
#if MK_SINGLE
    a.ph_lo = 0; a.ph_hi = NPHASE;
    hipLaunchKernelGGL(hybrid_fwd, dim3(grid), dim3(NTHR), LDS_BYTES, stream, a);
#else
    for (int p = 0; p < NPHASE; ++p) { a.ph_lo = p; a.ph_hi = p + 1; hipLaunchKernelGGL(hybrid_fwd, dim3(grid), dim3(NTHR), LDS_BYTES, stream, a); }
#endif
}
```

```cpp
#include <hip/hip_runtime.h>
#include <cstdio>
#include <cstdint>
namespace pg8 {
#define PG8_LAS __attribute__((address_space(3)))
typedef unsigned short bf16_t;
typedef short bf16x8 __attribute__((ext_vector_type(8)));
typedef float f32x4 __attribute__((ext_vector_type(4)));
typedef unsigned u32x4 __attribute__((ext_vector_type(4)));
constexpr int BM = 256, BK = 64, HALF = 128, HTB = HALF * BK * 2  , STAGE_BYTES = 8 * HTB, NXCD = 8, WGM = 8;

__host__ __device__ __forceinline__ int lds_byte(int r, int c) { const int st = (r >> 4) * 2 + (c >> 5), rr = r & 15, cc = c & 31, ob = rr * 64 + cc * 2; return st * 1024 + (ob ^ (((ob >> 9) & 1) << 5)); }
__host__ __device__ __forceinline__ void stage_rc(int b, int& R, int& C) { const int st = b / 1024, sb = b % 1024, swz = sb ^ (((sb >> 9) & 1) << 5); R = (st >> 1) * 16 + swz / 64; C = (st & 1) * 32 + (swz % 64) / 2; }
__host__ __device__ __forceinline__ int perm32(int rho) { const int n = rho >> 4, i = rho & 15; return 8 * (i >> 2) + 4 * n + (i & 3); }

struct Unit { int pm, pn, e, pl; };
struct Gemm { const bf16_t* A; const bf16_t* Bt; int M, N, K; };

struct StaticOrder {
    int nM, nN, nwg, G, c;
    __host__ __device__ void init(int M, int N, int G_, int c_) { nM = M / BM; nN = N / BM; nwg = nM * nN; G = G_; c = c_; }
    __host__ __device__ bool next(int i, Unit& u) const {
        const long L = (long)i * G + c; if (L >= nwg) return false;
        int wgid = (int)L; { const int q = nwg / NXCD, r = nwg % NXCD, xcd = wgid % NXCD, off = wgid / NXCD; wgid = (xcd < r ? xcd * (q + 1) : r * (q + 1) + (xcd - r) * q) + off; }
        const int nig = WGM * nN, gid = wgid / nig, fm = gid * WGM, gsz = (nM - fm) < WGM ? (nM - fm) : WGM;
        u.pm = fm + ((wgid % nig) % gsz); u.pn = (wgid % nig) / gsz; u.e = 0; u.pl = u.pn; return true;
    }
    __device__ __forceinline__ void a_ready(const Unit&) const {}
    __device__ __forceinline__ void done(const Unit&) const {}
};

__device__ __forceinline__ unsigned cvt_pk_bf16(float lo, float hi) { unsigned r; asm volatile("v_cvt_pk_bf16_f32 %0, %1, %2" : "=v"(r) : "v"(lo), "v"(hi)); return r; }

#define PG8_GAS __attribute__((address_space(1)))
struct NoPre {};
struct EpiBf16Plain {
    static constexpr bool PERM = true, AFTER_DRAIN = false; static constexpr int NST = 0; typedef NoPre Pre;
    __device__ __forceinline__ Pre prefetch(const Unit&, int, int) const { return Pre{}; }
    bf16_t* O; int ldc; float sc;
    __device__ __forceinline__ void operator()(const f32x4 (&acc)[2][2][4][2], const Unit& u, int wr, int wc, int fr, int fq, const Pre&) const {
        const int row0 = u.pm * BM + wr * 64 + fr; const int col0 = u.pn * BM + wc * 32 + 8 * fq;
#pragma unroll
        for (int ai = 0; ai < 2; ++ai)
#pragma unroll
            for (int m = 0; m < 4; ++m) { bf16_t* rowp = O + (size_t)(row0 + ai * HALF + m * 16) * ldc + col0;
#pragma unroll
                for (int bj = 0; bj < 2; ++bj) { const f32x4 v0 = acc[ai][bj][m][0] * sc, v1 = acc[ai][bj][m][1] * sc;
                    u32x4 w; w.x = cvt_pk_bf16(v0[0], v0[1]); w.y = cvt_pk_bf16(v0[2], v0[3]); w.z = cvt_pk_bf16(v1[0], v1[1]); w.w = cvt_pk_bf16(v1[2], v1[3]);
                    *(PG8_GAS u32x4*)(rowp + bj * HALF) = w; } }
    }
};
struct EpiResGate {
    static constexpr bool PERM = true, AFTER_DRAIN = false; static constexpr int NST = 0; typedef NoPre Pre;
    __device__ __forceinline__ Pre prefetch(const Unit&, int, int) const { return Pre{}; }
    const bf16_t* base; bf16_t* out; int ldc; const float* gate; int gpitch; int rows_per_batch; float sc;
    __device__ __forceinline__ void operator()(const f32x4 (&acc)[2][2][4][2], const Unit& u, int wr, int wc, int fr, int fq, const Pre&) const {
        const int row0 = u.pm * BM + wr * 64 + fr, col0 = u.pn * BM + wc * 32 + 8 * fq;
        const float* gp = gate + (size_t)((u.pm * BM) / rows_per_batch) * gpitch + col0;
        f32x4 gv[2][2];
#pragma unroll
        for (int bj = 0; bj < 2; ++bj)
#pragma unroll
            for (int n = 0; n < 2; ++n) gv[bj][n] = *(const PG8_GAS f32x4*)(gp + bj * HALF + 4 * n) * sc;
#pragma unroll
        for (int ai = 0; ai < 2; ++ai)
#pragma unroll
            for (int m = 0; m < 4; ++m) { const size_t off = (size_t)(row0 + ai * HALF + m * 16) * ldc + col0;
#pragma unroll
                for (int bj = 0; bj < 2; ++bj) { const u32x4 bs = *(const PG8_GAS u32x4*)(base + off + bj * HALF); const unsigned bw[4] = {bs.x, bs.y, bs.z, bs.w}; float r[8];
#pragma unroll
                    for (int j = 0; j < 4; ++j) { const f32x4& a4 = acc[ai][bj][m][j >> 1]; const f32x4& g4 = gv[bj][j >> 1];
                        r[2 * j] = __builtin_bit_cast(float, bw[j] << 16) + g4[2 * (j & 1)] * a4[2 * (j & 1)]; r[2 * j + 1] = __builtin_bit_cast(float, bw[j] & 0xffff0000u) + g4[2 * (j & 1) + 1] * a4[2 * (j & 1) + 1]; }
                    u32x4 w; w.x = cvt_pk_bf16(r[0], r[1]); w.y = cvt_pk_bf16(r[2], r[3]); w.z = cvt_pk_bf16(r[4], r[5]); w.w = cvt_pk_bf16(r[6], r[7]);
                    *(PG8_GAS u32x4*)(out + off + bj * HALF) = w; }
                asm volatile("" ::: "memory"); }
    }
};
struct EpiSwiglu {
    static constexpr bool PERM = true, AFTER_DRAIN = false; static constexpr int NST = 0; struct Pre { f32x4 bg[2], bu[2]; };
    __device__ __forceinline__ Pre prefetch(const Unit& u, int wc, int fq) const { typedef const __attribute__((address_space(1))) f32x4 gf4;
        const float* bp = bias + (size_t)u.e * 2048 + u.pl * HALF + wc * 32 + 8 * fq; Pre p; p.bg[0] = *(gf4*)bp; p.bg[1] = *(gf4*)(bp + 4); p.bu[0] = *(gf4*)(bp + 1024); p.bu[1] = *(gf4*)(bp + 1028); return p; }
    unsigned char* O; int ldc; const float* bias; float inv_in, out_scale;
    __device__ __forceinline__ float act1(float g, float up) const {
        g = fminf(g, 7.0f); up = fminf(fmaxf(up, -7.0f), 7.0f);
        const float s = __builtin_amdgcn_rcpf(1.0f + __builtin_amdgcn_exp2f(-1.702f * 1.4426950408889634f * g));
        return (up + 1.0f) * g * s * out_scale;
    }
    __device__ __forceinline__ void operator()(const f32x4 (&acc)[2][2][4][2], const Unit& u, int wr, int wc, int fr, int fq, const Pre& pre) const {
        const int row0 = u.pm * BM + wr * 64 + fr; const int jj0 = wc * 32 + 8 * fq; const int col0 = u.pl * HALF + jj0;
        const f32x4 bg[2] = {pre.bg[0], pre.bg[1]}, bu[2] = {pre.bu[0], pre.bu[1]};
#pragma unroll
        for (int ai = 0; ai < 2; ++ai)
#pragma unroll
            for (int m = 0; m < 4; ++m) { unsigned char* rowp = O + (size_t)(row0 + ai * HALF + m * 16) * ldc + col0;
                f32x4 r[2];
#pragma unroll
                for (int n = 0; n < 2; ++n) { const f32x4 g = acc[ai][0][m][n] * inv_in + bg[n], up = acc[ai][1][m][n] * inv_in + bu[n];
#pragma unroll
                    for (int j = 0; j < 4; ++j) r[n][j] = act1(g[j], up[j]); }
                int w0 = 0, w1 = 0;
                w0 = __builtin_amdgcn_cvt_pk_fp8_f32(r[0][0], r[0][1], w0, false); w0 = __builtin_amdgcn_cvt_pk_fp8_f32(r[0][2], r[0][3], w0, true);
                w1 = __builtin_amdgcn_cvt_pk_fp8_f32(r[1][0], r[1][1], w1, false); w1 = __builtin_amdgcn_cvt_pk_fp8_f32(r[1][2], r[1][3], w1, true);
                typedef int i32x2 __attribute__((ext_vector_type(2))); *(PG8_GAS i32x2*)rowp = (i32x2){w0, w1}; }
    }
};
struct EpiBf16Bias {
    static constexpr bool PERM = true, AFTER_DRAIN = false; static constexpr int NST = 0; typedef NoPre Pre;
    __device__ __forceinline__ Pre prefetch(const Unit&, int, int) const { return Pre{}; }
    bf16_t* O; int ldc; const float* bias; int bpitch; float inv_in;
    __device__ __forceinline__ void operator()(const f32x4 (&acc)[2][2][4][2], const Unit& u, int wr, int wc, int fr, int fq, const Pre&) const {
        const int row0 = u.pm * BM + wr * 64 + fr; const int col0 = u.pl * BM + wc * 32 + 8 * fq;
        const float* bp = bias + (size_t)u.e * bpitch + col0;
        f32x4 bv[2][2];
#pragma unroll
        for (int bj = 0; bj < 2; ++bj)
#pragma unroll
            for (int n = 0; n < 2; ++n) bv[bj][n] = *(const PG8_GAS f32x4*)(bp + bj * HALF + 4 * n);
#pragma unroll
        for (int ai = 0; ai < 2; ++ai)
#pragma unroll
            for (int m = 0; m < 4; ++m) { bf16_t* rowp = O + (size_t)(row0 + ai * HALF + m * 16) * ldc + col0;
#pragma unroll
                for (int bj = 0; bj < 2; ++bj) { const f32x4 v0 = acc[ai][bj][m][0] * inv_in + bv[bj][0], v1 = acc[ai][bj][m][1] * inv_in + bv[bj][1];
                    u32x4 w; w.x = cvt_pk_bf16(v0[0], v0[1]); w.y = cvt_pk_bf16(v0[2], v0[3]); w.z = cvt_pk_bf16(v1[0], v1[1]); w.w = cvt_pk_bf16(v1[2], v1[3]);
                    *(PG8_GAS u32x4*)(rowp + bj * HALF) = w; } }
    }
};
struct EpiFp8Bias {
    static constexpr bool PERM = true, AFTER_DRAIN = false; static constexpr int NST = 0; struct Pre { f32x4 bv[2][2]; };
    __device__ __forceinline__ Pre prefetch(const Unit& u, int wc, int fq) const { typedef const __attribute__((address_space(1))) f32x4 gf4;
        const float* bp = bias + (size_t)u.e * bpitch + u.pl * BM + wc * 32 + 8 * fq; Pre p; p.bv[0][0] = *(gf4*)bp; p.bv[0][1] = *(gf4*)(bp + 4); p.bv[1][0] = *(gf4*)(bp + HALF); p.bv[1][1] = *(gf4*)(bp + HALF + 4); return p; }
    unsigned char* O; int ldc; const float* bias; int bpitch; float inv_in, out_scale;
    __device__ __forceinline__ int pk4(f32x4 v) const { int w = 0; w = __builtin_amdgcn_cvt_pk_fp8_f32(__builtin_amdgcn_fmed3f(v[0], -448.f, 448.f), __builtin_amdgcn_fmed3f(v[1], -448.f, 448.f), w, false);
        return __builtin_amdgcn_cvt_pk_fp8_f32(__builtin_amdgcn_fmed3f(v[2], -448.f, 448.f), __builtin_amdgcn_fmed3f(v[3], -448.f, 448.f), w, true); }
    __device__ __forceinline__ void operator()(const f32x4 (&acc)[2][2][4][2], const Unit& u, int wr, int wc, int fr, int fq, const Pre& pre) const {
        const int row0 = u.pm * BM + wr * 64 + fr; const int col0 = u.pl * BM + wc * 32 + 8 * fq;
        const f32x4 bv[2][2] = {{pre.bv[0][0], pre.bv[0][1]}, {pre.bv[1][0], pre.bv[1][1]}};
#pragma unroll
        for (int ai = 0; ai < 2; ++ai)
#pragma unroll
            for (int m = 0; m < 4; ++m) { unsigned char* rowp = O + (size_t)(row0 + ai * HALF + m * 16) * ldc + col0;
#pragma unroll
                for (int bj = 0; bj < 2; ++bj) { const f32x4 v0 = (acc[ai][bj][m][0] * inv_in + bv[bj][0]) * out_scale, v1 = (acc[ai][bj][m][1] * inv_in + bv[bj][1]) * out_scale;
                    typedef int i32x2 __attribute__((ext_vector_type(2))); *(PG8_GAS i32x2*)(rowp + bj * HALF) = (i32x2){pk4(v0), pk4(v1)}; } }
    }
};
struct MoeOrder {
    int nN, G, c, nunits; const PG8_LAS int* tile_pm;
    __device__ __forceinline__ bool next(int i, Unit& u) const {
        const int L = i * G + c; if (L >= nunits) return false;
        const int idx = L / nN, pl = L - idx * nN, pm = __builtin_amdgcn_readfirstlane(tile_pm[idx]), e = pm >> 6;
        u.pm = pm; u.pl = pl; u.e = e; u.pn = e * nN + pl; return true;
    }
    __device__ __forceinline__ void a_ready(const Unit&) const {}
    __device__ __forceinline__ void done(const Unit&) const {}
};
typedef int v4i32_t __attribute__((ext_vector_type(4)));
typedef int v8i32_t __attribute__((ext_vector_type(8)));
template <class Epi, class Sched, bool ALIGN_EPI = false, bool SP2 = false, bool FP8 = false>
__device__ __forceinline__ void gemm_phase(PG8_LAS unsigned char* lds, const Gemm g, const Sched& S, const Epi& E, int tid_in) {
    int tid_ = tid_in; asm volatile("" : "+v"(tid_)); const int tid = tid_, wid = __builtin_amdgcn_readfirstlane(tid >> 6), lane = tid & 63, wr = wid >> 2, wc = wid & 3, fr = lane & 15, fq = lane >> 4;
    const int K = g.K, nt = K / BK;
    unsigned voffA, voffB;
    { int R, C; stage_rc(tid * 16, R, C); const int Rb = Epi::PERM ? ((R & ~31) + perm32(R & 31)) : R;
        voffA = (unsigned)(R * K + C) * 2u; voffB = (unsigned)(Rb * K + C) * 2u; }
    const size_t rstep = (size_t)64 * K * 2;
    const size_t kstep = (size_t)(BK * 2);
    const size_t hstep = (size_t)HALF * K * 2;
    const size_t tstep = 2 * hstep;
    const unsigned ldsw = (unsigned)wid * 1024u;
    const int aoff = lds_byte(wr * 64 + fr, fq * 8), boff = lds_byte(wc * 32 + fr, fq * 8);
#define PG8_SA(b, h) (((b) * 2 + (h)) * HTB)
#define PG8_SB(b, h) ((4 + (b) * 2 + (h)) * HTB)
#define PG8_STAGE(bufoff, gbase, voff) do { _Pragma("unroll") for (int _i = 0; _i < 2; ++_i) \
        __builtin_amdgcn_global_load_lds((const unsigned*)((const char*)(gbase) + _i * rstep + (voff)), (PG8_LAS unsigned*)(lds + (bufoff) + ldsw + _i * 8192), 16, 0, 0); } while (0)
#define PG8_LDA(dst, b, h) do { _Pragma("unroll") for (int m = 0; m < 4; ++m) _Pragma("unroll") for (int k = 0; k < 2; ++k) dst[m][k] = *(const PG8_LAS bf16x8*)(lds + PG8_SA(b, h) + aoff + m * 2048 + k * 1024); } while (0)
#define PG8_LDB(dst, b, h) do { _Pragma("unroll") for (int n = 0; n < 2; ++n) _Pragma("unroll") for (int k = 0; k < 2; ++k) dst[n][k] = *(const PG8_LAS bf16x8*)(lds + PG8_SB(b, h) + boff + n * 2048 + k * 1024); } while (0)
#define PG8_MMA(ai, bj, At, Bt) do { __builtin_amdgcn_s_setprio(1); _Pragma("unroll") for (int m = 0; m < 4; ++m) _Pragma("unroll") for (int n = 0; n < 2; ++n) { \
        if constexpr (FP8) { const v8i32_t a8_ = __builtin_shufflevector(__builtin_bit_cast(v4i32_t, At[m][0]), __builtin_bit_cast(v4i32_t, At[m][1]), 0, 1, 2, 3, 4, 5, 6, 7); \
            const v8i32_t b8_ = __builtin_shufflevector(__builtin_bit_cast(v4i32_t, Bt[n][0]), __builtin_bit_cast(v4i32_t, Bt[n][1]), 0, 1, 2, 3, 4, 5, 6, 7); \
            asm volatile("v_mfma_scale_f32_16x16x128_f8f6f4 %0, %1, %2, %0, %3, %3 op_sel_hi:[0,0,0]" : "+v"(acc[ai][bj][m][n]) : "v"(b8_), "v"(a8_), "v"(one8_)); } \
        else { _Pragma("unroll") for (int k = 0; k < 2; ++k) acc[ai][bj][m][n] = __builtin_amdgcn_mfma_f32_16x16x32_bf16(Bt[n][k], At[m][k], acc[ai][bj][m][n], 0, 0, 0); } } \
        __builtin_amdgcn_s_setprio(0); } while (0)
#define PG8_WAIT_V(n) asm volatile("s_waitcnt vmcnt(" #n ")" ::: "memory")
#define PG8_WAIT_L(n) asm volatile("s_waitcnt lgkmcnt(" #n ")" ::: "memory")
#define PG8_WAIT_V8R(relax) do { if (relax) { if constexpr (Epi::NST == 8) PG8_WAIT_V(16); else if constexpr (Epi::NST == 16) PG8_WAIT_V(24); else PG8_WAIT_V(8); } else PG8_WAIT_V(8); } while (0)
#define PG8_BAR __builtin_amdgcn_s_barrier()
#define PG8_SCHED __builtin_amdgcn_sched_barrier(0)
    Unit cur, nxt; int ui = 0;
    if (!S.next(0, cur)) return;
    f32x4 acc[2][2][4][2];
#pragma unroll
    for (int a = 0; a < 2; ++a)
#pragma unroll
        for (int b = 0; b < 2; ++b)
#pragma unroll
            for (int m = 0; m < 4; ++m)
#pragma unroll
                for (int n = 0; n < 2; ++n) acc[a][b][m][n] = (f32x4){0.f, 0.f, 0.f, 0.f};
    bf16x8 At[4][2], B0[2][2], B1[2][2];
    int one8_ = 0x7f7f7f7f; asm volatile("" : "+v"(one8_));
    const char* cA = (const char*)g.A + (size_t)cur.pm * tstep; const char* cB = (const char*)g.Bt + (size_t)cur.pn * tstep;
    S.a_ready(cur);
    if constexpr (SP2) {
        PG8_STAGE(PG8_SB(0, 0), cB, voffB); PG8_STAGE(PG8_SB(0, 1), cB + hstep, voffB); PG8_STAGE(PG8_SA(0, 0), cA, voffA); PG8_STAGE(PG8_SA(0, 1), cA + hstep, voffA);
        if (wr == 1) PG8_BAR;
        PG8_WAIT_V(2); PG8_BAR;
        PG8_STAGE(PG8_SB(1, 0), cB + kstep, voffB); PG8_STAGE(PG8_SA(1, 0), cA + kstep, voffA); PG8_STAGE(PG8_SB(1, 1), cB + hstep + kstep, voffB);
        PG8_WAIT_V(6); PG8_BAR;
    } else {
        PG8_STAGE(PG8_SB(0, 0), cB, voffB); PG8_STAGE(PG8_SA(0, 0), cA, voffA); PG8_STAGE(PG8_SB(0, 1), cB + hstep, voffB); PG8_STAGE(PG8_SA(0, 1), cA + hstep, voffA);
        if (wr == 1) PG8_BAR;
        PG8_WAIT_V(4); PG8_BAR;
        PG8_STAGE(PG8_SB(1, 0), cB + kstep, voffB); PG8_STAGE(PG8_SA(1, 0), cA + kstep, voffA); PG8_STAGE(PG8_SB(1, 1), cB + hstep + kstep, voffB);
        PG8_WAIT_V(6); PG8_BAR;
    }
    for (;;) {
        const bool has_next = S.next(ui + 1, nxt);
        typename Epi::Pre pre_; { int lp_ = (int)__builtin_amdgcn_mbcnt_hi(~0u, __builtin_amdgcn_mbcnt_lo(~0u, 0u)); asm volatile("" : "+v"(lp_)); pre_ = E.prefetch(cur, wc, lp_ >> 4); }
        const char* nA = has_next ? (const char*)g.A + (size_t)nxt.pm * tstep : cA; const char* nB = has_next ? (const char*)g.Bt + (size_t)nxt.pn * tstep : cB;
#pragma unroll 1
        for (int t = 0; t < nt; t += 2) {
            const bool last = (t == nt - 2);
            const char* a1 = cA + (size_t)(t + 1) * kstep;
            const char* a2 = last ? nA : cA + (size_t)(t + 2) * kstep; const char* b2 = last ? nB : cB + (size_t)(t + 2) * kstep;
            const char* a3 = a2 + kstep; const char* b3 = b2 + kstep;
            if (last && has_next) S.a_ready(nxt);
            const bool relax = (Epi::NST > 0) && (ui > 0) && (t == 0);
            if constexpr (SP2) {
            PG8_LDB(B0, 0, 0); PG8_LDB(B1, 0, 1); PG8_SCHED; PG8_LDA(At, 0, 0); PG8_STAGE(PG8_SA(1, 1), a1 + hstep, voffA);
            PG8_WAIT_V8R(relax); PG8_WAIT_L(0); PG8_BAR; PG8_MMA(0, 0, At, B0); PG8_MMA(0, 1, At, B1); PG8_BAR; PG8_SCHED;
            PG8_LDA(At, 0, 1); PG8_STAGE(PG8_SB(0, 0), b2, voffB); PG8_STAGE(PG8_SB(0, 1), b2 + hstep, voffB); PG8_STAGE(PG8_SA(0, 0), a2, voffA);
            PG8_WAIT_V8R(relax); PG8_WAIT_L(0); PG8_BAR; PG8_MMA(1, 0, At, B0); PG8_MMA(1, 1, At, B1); PG8_BAR; PG8_SCHED;
            PG8_LDB(B0, 1, 0); PG8_LDB(B1, 1, 1); PG8_SCHED; PG8_LDA(At, 1, 0); PG8_STAGE(PG8_SA(0, 1), a2 + hstep, voffA);
            PG8_WAIT_V(8); PG8_WAIT_L(0); PG8_BAR; PG8_MMA(0, 0, At, B0); PG8_MMA(0, 1, At, B1); PG8_BAR; PG8_SCHED;
            PG8_LDA(At, 1, 1); PG8_STAGE(PG8_SB(1, 0), b3, voffB); PG8_STAGE(PG8_SB(1, 1), b3 + hstep, voffB); PG8_STAGE(PG8_SA(1, 0), a3, voffA);
            PG8_WAIT_V(8); PG8_WAIT_L(0); PG8_BAR; PG8_MMA(1, 0, At, B0); PG8_MMA(1, 1, At, B1); PG8_BAR; PG8_SCHED;
            } else {
            PG8_LDB(B0, 0, 0); PG8_SCHED; PG8_LDA(At, 0, 0); PG8_STAGE(PG8_SA(1, 1), a1 + hstep, voffA);
            PG8_WAIT_L(8); PG8_BAR; PG8_WAIT_L(0); PG8_MMA(0, 0, At, B0); PG8_BAR; PG8_SCHED;
            PG8_LDB(B1, 0, 1); PG8_STAGE(PG8_SB(0, 0), b2, voffB);
            PG8_BAR; PG8_WAIT_L(0); PG8_MMA(0, 1, At, B1); PG8_BAR;
            PG8_LDA(At, 0, 1); PG8_STAGE(PG8_SA(0, 0), a2, voffA);
            PG8_BAR; PG8_WAIT_L(0); PG8_MMA(1, 0, At, B0); PG8_BAR; PG8_SCHED;
            PG8_STAGE(PG8_SB(0, 1), b2 + hstep, voffB);
            PG8_WAIT_V(6); PG8_BAR; PG8_MMA(1, 1, At, B1); PG8_BAR;
            PG8_LDB(B0, 1, 0); PG8_SCHED; PG8_LDA(At, 1, 0); PG8_STAGE(PG8_SA(0, 1), a2 + hstep, voffA);
            PG8_WAIT_L(8); PG8_BAR; PG8_WAIT_L(0); PG8_MMA(0, 0, At, B0); PG8_BAR; PG8_SCHED;
            PG8_LDB(B1, 1, 1); PG8_STAGE(PG8_SB(1, 0), b3, voffB);
            PG8_BAR; PG8_WAIT_L(0); PG8_MMA(0, 1, At, B1); PG8_BAR;
            PG8_LDA(At, 1, 1); PG8_STAGE(PG8_SA(1, 0), a3, voffA);
            PG8_BAR; PG8_WAIT_L(0); PG8_MMA(1, 0, At, B0); PG8_BAR; PG8_SCHED;
            PG8_STAGE(PG8_SB(1, 1), b3 + hstep, voffB);
            PG8_WAIT_V(6); PG8_BAR; PG8_MMA(1, 1, At, B1); PG8_BAR;
            }
        }
        if constexpr (FP8) asm volatile("s_nop 7\n\ts_nop 7" ::: "memory");
        if constexpr (ALIGN_EPI) { if (wr == 0) PG8_BAR; }
        if constexpr (!Epi::AFTER_DRAIN) { int ln_ = (int)__builtin_amdgcn_mbcnt_hi(~0u, __builtin_amdgcn_mbcnt_lo(~0u, 0u)); asm volatile("" : "+v"(ln_)); E(acc, cur, wr, wc, ln_ & 15, ln_ >> 4, pre_); S.done(cur); }
        if (!has_next) break;
#pragma unroll
        for (int a = 0; a < 2; ++a)
#pragma unroll
            for (int b = 0; b < 2; ++b)
#pragma unroll
                for (int m = 0; m < 4; ++m)
#pragma unroll
                    for (int n = 0; n < 2; ++n) acc[a][b][m][n] = (f32x4){0.f, 0.f, 0.f, 0.f};
        cur = nxt; cA = nA; cB = nB; ++ui;
        if constexpr (ALIGN_EPI) { if (wr == 1) PG8_BAR; }
    }
    PG8_WAIT_V(0);
    if constexpr (!ALIGN_EPI) { if (wr == 0) PG8_BAR; }
    PG8_BAR;
    if constexpr (Epi::AFTER_DRAIN) { E.fused(acc, cur, wr, wc, fr, fq, lds, wid, lane); S.done(cur); }
#undef PG8_SA
#undef PG8_SB
#undef PG8_STAGE
#undef PG8_LDA
#undef PG8_LDB
#undef PG8_MMA
#undef PG8_WAIT_V
#undef PG8_WAIT_L
#undef PG8_BAR
#undef PG8_SCHED
}
}

constexpr int NWAVES = 8, NTHR = 512;
constexpr int BATCH = 2, SEQ = 8192, D = 1024, DEPTH = 4, MTOK = BATCH * SEQ;
constexpr int DIN = 3344, NPROJ = 3328, SRC_GA = 1152;
constexpr int C_GQ = 0, C_GK = 192, C_GV = 384, C_GG = 768, C_HQ = 1152, C_HF = 1408, C_HI = 1664, C_HG = 1920, C_RQ = 2176, C_RK = 2368, C_RV = 2560, C_RG = 2944;
constexpr int NE = 32, FFN = 1024;
constexpr int CH = 64, NCH = SEQ / CH, NUNIT = BATCH * NCH;
constexpr int ST_GLA = 0, ST_HG = 4 * 48 * 96, ST_RET = ST_HG + 4 * 64 * 64, ST_TOT = ST_RET + 4 * 48 * 96;
constexpr int NDV = 448, NKT = 640;
constexpr int MAXROWS = 65536 + NE * 256, MAXRT = MAXROWS / 256;
constexpr float EPS = 1e-6f;
#ifndef F8_IN_V
#define F8_IN_V false
#endif
#ifndef F8_OUT_V
#define F8_OUT_V false
#endif
constexpr bool F8_IN = F8_IN_V, F8_OUT = F8_OUT_V;
#ifndef Y8_V
#define Y8_V true
#endif
constexpr bool Y8 = Y8_V;
constexpr float S8_Y = 16.f;
constexpr float S8_M = 32.f;
constexpr float S8_W = 2048.f, S8_H = 64.f, S8_A = 8.f;
constexpr int NPHASE = 38;
constexpr int ECAP = 16384, ECAP_SH = 14;

constexpr size_t MiB = 1u << 20;
constexpr size_t WS_CTL = 0, CTL_ZERO_BYTES = 65536;
constexpr size_t WS_MOD = 1 * MiB;
constexpr size_t WS_ROPE = 2 * MiB;
constexpr size_t WS_LB = 5 * MiB;
constexpr size_t WS_WIN = 8 * MiB;
constexpr size_t WS_WOUT = 34 * MiB;
constexpr size_t WS_WGU = 42 * MiB;
constexpr size_t WS_WDN = 554 * MiB;
constexpr size_t WS_X = 810 * MiB;
constexpr size_t WS_H = 874 * MiB;
constexpr size_t WS_GA = 906 * MiB;
constexpr size_t WS_PROJ = 907 * MiB;
constexpr size_t WS_U = 1011 * MiB;
constexpr size_t WS_DVEC = 1063 * MiB;
constexpr size_t WS_SP = 1064 * MiB;
constexpr size_t WS_MIX = 1090 * MiB;
constexpr size_t WS_TOPE = 1122 * MiB;
constexpr size_t WS_TOPW = WS_TOPE + 256 * 1024;
constexpr size_t WS_SLOT = WS_TOPW + 256 * 1024;
constexpr size_t WS_A1 = 1123 * MiB;
constexpr size_t WS_ACT = 1635 * MiB;
constexpr size_t WS_Y = 2147 * MiB;
constexpr size_t WS_CUM = 3171 * MiB;
constexpr size_t WS_KT = 3199 * MiB;
constexpr size_t WS_END = 3239 * MiB;
static_assert(WS_WIN + (size_t)DEPTH * NPROJ * D * 2 <= WS_WOUT && WS_PROJ + (size_t)MTOK * NPROJ * 2 <= WS_U && WS_U + (size_t)NUNIT * ST_TOT * 4 <= WS_DVEC && WS_SP + (size_t)NUNIT * ST_TOT * 2 <= WS_MIX && WS_A1 + (size_t)NE * ECAP * D <= WS_ACT && WS_ACT + (size_t)NE * ECAP * D <= WS_Y && WS_Y + (size_t)NE * ECAP * D * 2 <= WS_CUM, "ws map");
constexpr int CW_TMO = 0, CW_CODE = 1, CW_BAR = 4096, CW_CNT = 8192, CW_FILL = 8192 + 256;
constexpr int RING_BYTES = 131072;
constexpr int MISC_OFF = 147456, LDS_BYTES = MISC_OFF + 4096;
constexpr int MW_BAR = 0, MW_CNT = 16, MW_PST = 48, MW_HIST = 96, MW_BASE = 128, MW_TILE = 192, MW_NRT = 480, MW_SLOTS = 512;

#define GAS __attribute__((address_space(1)))
#define LAS __attribute__((address_space(3)))
typedef unsigned v4u __attribute__((ext_vector_type(4)));
typedef float f32x4 __attribute__((ext_vector_type(4)));
typedef short bf16x8 __attribute__((ext_vector_type(8)));
typedef GAS unsigned gu32;
typedef GAS unsigned long long gu64;
#define RLX_AGENT __ATOMIC_RELAXED, __HIP_MEMORY_SCOPE_AGENT
#define LDS_WAIT() asm volatile("s_waitcnt lgkmcnt(0)" ::: "memory")
#define VM_WAIT() asm volatile("s_waitcnt vmcnt(0)" ::: "memory")
__device__ __forceinline__ unsigned long long rt() { return __builtin_amdgcn_s_memrealtime(); }
typedef unsigned short bf16;
typedef float f32x2_t __attribute__((ext_vector_type(2))); typedef __bf16 bf16x2_t __attribute__((ext_vector_type(2)));
__device__ __forceinline__ unsigned pk2(float lo, float hi) { const f32x2_t v = {lo, hi}; return __builtin_bit_cast(unsigned, __builtin_convertvector(v, bf16x2_t)); }
__device__ __forceinline__ unsigned f2bf(float f) { return pk2(f, 0.f) & 0xffffu; }
__device__ __forceinline__ float bf2f(bf16 b) { return __builtin_bit_cast(float, (unsigned)b << 16); }
#define XB_TMO      128
#define XB_XCNT(j)  (256  + 64 * (j))
#define XB_XSUB(j)  (1280 + 64 * (j))
#define XB_XGEN(j)  (2304 + 64 * (j))
#define XB_TOP      3328
#define XB_TOPGEN   3392
#define XCD_BAR_WORDS 3456
#define XB_SPIN_CAP (1u << 18)

__device__ __forceinline__ unsigned xb_ld(unsigned* p)              { return __hip_atomic_load(p, __ATOMIC_RELAXED, __HIP_MEMORY_SCOPE_AGENT); }
__device__ __forceinline__ unsigned xb_add(unsigned* p, unsigned v) { return __hip_atomic_fetch_add(p, v, __ATOMIC_RELAXED, __HIP_MEMORY_SCOPE_AGENT); }
__device__ __forceinline__ unsigned xb_xcc_id() { return (unsigned)__builtin_amdgcn_s_getreg((3 << 11) | 20) & 0xFu; }
#define XB_SPIN(cond, bar) do { unsigned _sp = 0; while (cond) { __builtin_amdgcn_s_sleep(1); \
    if ((++_sp & 255u) == 0u) { if (xb_ld(&(bar)[XB_TMO])) break; if (_sp > XB_SPIN_CAP) { atomicAdd(&(bar)[XB_TMO], 1u); break; } } } } while (0)

struct XcdBarrier {
    unsigned* bar; unsigned x;
    volatile LAS unsigned* st;
};

__device__ __forceinline__ XcdBarrier xcd_barrier_post(unsigned* bar, volatile LAS unsigned* st) {
    XcdBarrier b; b.bar = bar; b.x = xb_xcc_id(); b.st = st;
    if (threadIdx.x == 0) (void)xb_add(&bar[XB_XCNT(b.x)], 1u);
    return b;
}
__device__ __forceinline__ void xcd_barrier_complete(unsigned* bar, unsigned x, unsigned& nloc, unsigned& nx) {
    const unsigned G = gridDim.x * gridDim.y * gridDim.z;
    unsigned sum, cnt, mine, sp = 0u;
    for (;;) {
        sum = 0u; cnt = 0u; mine = 0u;
#pragma unroll
        for (unsigned j = 0; j < 16; ++j) { const unsigned c = xb_ld(&bar[XB_XCNT(j)]); sum += c; cnt += (c > 0u) ? 1u : 0u; mine = (j == x) ? c : mine; }
        if (sum == G) break;
        __builtin_amdgcn_s_sleep(1);
        if ((++sp & 255u) == 0u) { if (xb_ld(&bar[XB_TMO])) break; if (sp > XB_SPIN_CAP) { atomicAdd(&bar[XB_TMO], 1u); break; } }
    }
    nloc = mine > 0u ? mine : 1u; nx = cnt > 0u ? cnt : 1u;
}

__device__ __forceinline__ void xcd_barrier(const XcdBarrier& b) {
    asm volatile("s_waitcnt vmcnt(0)" ::: "memory");
    __syncthreads();
    if (threadIdx.x == 0) {
        unsigned* bar = b.bar;
        __builtin_amdgcn_s_waitcnt(0);
        unsigned nloc = b.st[0], nx = b.st[1];
        if (nloc == 0u) { xcd_barrier_complete(bar, b.x, nloc, nx); b.st[0] = nloc; b.st[1] = nx; }
        const unsigned old = xb_add(&bar[XB_XSUB(b.x)], 1u);
        const unsigned gen = old / nloc;
        if (old + 1u == (gen + 1u) * nloc) {
            __builtin_amdgcn_fence(__ATOMIC_RELEASE, "agent");
            asm volatile("s_waitcnt vmcnt(0)" ::: "memory");
            const unsigned og = xb_add(&bar[XB_TOP], 1u);
            const unsigned tg = og / nx;
            if (og + 1u == (tg + 1u) * nx) xb_add(&bar[XB_TOPGEN], 1u);
            else XB_SPIN(xb_ld(&bar[XB_TOPGEN]) == tg, bar);
            __builtin_amdgcn_fence(__ATOMIC_ACQUIRE, "agent");
            xb_add(&bar[XB_XGEN(b.x)], 1u);
            asm volatile("s_waitcnt vmcnt(0)" ::: "memory");
        } else {
            XB_SPIN(xb_ld(&bar[XB_XGEN(b.x)]) == gen, bar);
            __builtin_amdgcn_fence(__ATOMIC_ACQUIRE, "agent");
            asm volatile("s_waitcnt vmcnt(0)" ::: "memory");
        }
    }
    __syncthreads();
}

__device__ __forceinline__ float wave_sum(float v) {
#pragma unroll
    for (int o = 1; o < 64; o <<= 1) v += __shfl_xor(v, o);
    return v;
}
__device__ __forceinline__ float log_sigmoid_f(float x) { return fminf(x, 0.f) - log1pf(expf(-fabsf(x))); }
__device__ __forceinline__ float silu_f(float x) { return x / (1.0f + expf(-x)); }
__device__ __forceinline__ float sigmoid_f(float x) { return 1.0f / (1.0f + expf(-x)); }
__device__ __forceinline__ pg8::bf16x8 ldfrag(const LAS bf16* base, int stride, int r0, int k0, int lane) {
    return *(const LAS pg8::bf16x8*)(base + (r0 + (lane & 15)) * stride + k0 + 8 * (lane >> 4));
}
__device__ __forceinline__ pg8::bf16x8 pack8(const float (&v)[8]) { v4u w; w.x = pk2(v[0], v[1]); w.y = pk2(v[2], v[3]); w.z = pk2(v[4], v[5]); w.w = pk2(v[6], v[7]); return __builtin_bit_cast(pg8::bf16x8, w); }

struct Args {
    const float* x; const float* c; const int* pos; const float* w_mod; const float* b_mod; const float* norm1_w; const float* w_in; const float* gla_wa2; const float* gla_ba2; const float* hg_lb;
    const float* gla_norm_w; const float* hg_norm_w; const float* w_out; const float* norm2_w; const float* w_r; const float* b_r; const float* w_gu; const float* b_gu; const float* w_dn; const float* b_dn;
    const float* final_norm_w; float* out; unsigned char* ws; int ph_lo, ph_hi;
};

__device__ __forceinline__ void transpose_block64(const float* src, int ld, bf16* dst, LAS float* scr, int lane) {
    const int r = lane >> 4, c4 = (lane & 15) * 4;
    f32x4 v[16];
#pragma unroll
    for (int i = 0; i < 16; ++i) v[i] = __builtin_nontemporal_load((const f32x4*)(src + (size_t)(4 * i + r) * ld + c4));
#pragma unroll
    for (int i = 0; i < 16; ++i) { LAS float* w = scr + (4 * i + r) * 65 + c4; w[0] = v[i][0]; w[1] = v[i][1]; w[2] = v[i][2]; w[3] = v[i][3]; }
    LDS_WAIT(); asm volatile("" ::: "memory");
    const int kc = lane & 7;
#pragma unroll
    for (int jj = 0; jj < 8; ++jj) { const int n = (lane >> 3) + 8 * jj; const LAS float* s = scr + (8 * kc) * 65 + n;
        v4u o; o.x = pk2(s[0 * 65], s[1 * 65]); o.y = pk2(s[2 * 65], s[3 * 65]); o.z = pk2(s[4 * 65], s[5 * 65]); o.w = pk2(s[6 * 65], s[7 * 65]);
        *(GAS v4u*)(dst + (size_t)n * D + 8 * kc) = o; }
    LDS_WAIT(); asm volatile("" ::: "memory");
}
__device__ __forceinline__ float clamp448(float x) { return __builtin_amdgcn_fmed3f(x, -448.f, 448.f); }
__device__ __forceinline__ int pk4_fp8(float a, float b, float c, float d) { int w = 0; w = __builtin_amdgcn_cvt_pk_fp8_f32(clamp448(a), clamp448(b), w, false);
    return __builtin_amdgcn_cvt_pk_fp8_f32(clamp448(c), clamp448(d), w, true); }
__device__ __forceinline__ void transpose_block64_fp8(const float* src, int ld, unsigned char* dst, LAS float* scr, int lane, float sc) {
    const int r = lane >> 4, c4 = (lane & 15) * 4;
    f32x4 v[16];
#pragma unroll
    for (int i = 0; i < 16; ++i) v[i] = __builtin_nontemporal_load((const f32x4*)(src + (size_t)(4 * i + r) * ld + c4));
#pragma unroll
    for (int i = 0; i < 16; ++i) { LAS float* w = scr + (4 * i + r) * 65 + c4; w[0] = v[i][0] * sc; w[1] = v[i][1] * sc; w[2] = v[i][2] * sc; w[3] = v[i][3] * sc; }
    LDS_WAIT(); asm volatile("" ::: "memory");
    const int kc = lane & 3;
#pragma unroll
    for (int jj = 0; jj < 4; ++jj) { const int n = (lane >> 2) + 16 * jj; const LAS float* s = scr + (16 * kc) * 65 + n;
        v4u o; o.x = (unsigned)pk4_fp8(s[0 * 65], s[1 * 65], s[2 * 65], s[3 * 65]); o.y = (unsigned)pk4_fp8(s[4 * 65], s[5 * 65], s[6 * 65], s[7 * 65]);
        o.z = (unsigned)pk4_fp8(s[8 * 65], s[9 * 65], s[10 * 65], s[11 * 65]); o.w = (unsigned)pk4_fp8(s[12 * 65], s[13 * 65], s[14 * 65], s[15 * 65]);
        *(GAS v4u*)(dst + (size_t)n * D + 16 * kc) = o; }
    LDS_WAIT(); asm volatile("" ::: "memory");
}
constexpr int IT_IN = 16 * (NPROJ / 64), IT_OUT = 16 * 16, IT_GU = NE * 16 * 32, IT_DN = NE * 16 * 16, IT_LAYER = IT_IN + IT_OUT + IT_GU + IT_DN, IT_ALL = DEPTH * IT_LAYER;
__device__ __forceinline__ void convert_item(const Args& a, int l, int r, LAS float* scr, int lane) {
    unsigned char* ws = a.ws;
    bf16* WIN = (bf16*)(ws + WS_WIN); bf16* WOUT = (bf16*)(ws + WS_WOUT); unsigned char* WGU = ws + WS_WGU; unsigned char* WDN = ws + WS_WDN;
    if (r < IT_IN) { const int kb = r / (NPROJ / 64), nb = r % (NPROJ / 64), n0 = 64 * nb, sc = n0 + (n0 >= SRC_GA ? 16 : 0);
        if (F8_IN) transpose_block64_fp8(a.w_in + ((size_t)l * D + 64 * kb) * DIN + sc, DIN, (unsigned char*)WIN + ((size_t)l * NPROJ + n0) * D + 64 * kb, scr, lane, S8_W);
        else transpose_block64(a.w_in + ((size_t)l * D + 64 * kb) * DIN + sc, DIN, WIN + ((size_t)l * NPROJ + n0) * D + 64 * kb, scr, lane); return; }
    r -= IT_IN;
    if (r < IT_OUT) { const int kb = r / 16, nb = r % 16;
        if (F8_OUT) transpose_block64_fp8(a.w_out + ((size_t)l * D + 64 * kb) * D + 64 * nb, D, (unsigned char*)WOUT + ((size_t)l * D + 64 * nb) * D + 64 * kb, scr, lane, S8_W);
        else transpose_block64(a.w_out + ((size_t)l * D + 64 * kb) * D + 64 * nb, D, WOUT + ((size_t)l * D + 64 * nb) * D + 64 * kb, scr, lane); return; }
    r -= IT_OUT;
    if (r < IT_GU) { const int e = r / 512, r2 = r % 512, kb = r2 / 32, nb = r2 % 32, cc = 64 * nb;
        const int row = (cc < 1024) ? 256 * (cc / 128) + (cc % 128) : 256 * ((cc - 1024) / 128) + 128 + ((cc - 1024) % 128);
        transpose_block64_fp8(a.w_gu + (((size_t)l * NE + e) * D + 64 * kb) * 2048 + cc, 2048, WGU + (((size_t)l * NE + e) * 2048 + row) * D + 64 * kb, scr, lane, S8_W); return; }
    r -= IT_GU;
    { const int e = r / 256, r2 = r % 256, kb = r2 / 16, nb = r2 % 16;
        transpose_block64_fp8(a.w_dn + (((size_t)l * NE + e) * FFN + 64 * kb) * D + 64 * nb, D, WDN + (((size_t)l * NE + e) * D + 64 * nb) * D + 64 * kb, scr, lane, S8_W); }
}
constexpr int CB2 = 4, CB7 = 2, CB8 = 2;
__device__ __forceinline__ int conv_t2(int G) { return (G == 256) ? 192 * NWAVES * CB2 : 0; }
__device__ __forceinline__ int conv_idle(int nunits, int G) { const int rem = nunits % G; return rem ? G - rem : 0; }
__device__ __forceinline__ void convert_range(const Args& a, int l, int first, int count, LAS unsigned char* lds, int lane, int wave) {
    LAS float* scr = (LAS float*)(lds + wave * 16640);
    for (int k = 0; k < count; ++k) { const int it = first + k; if (it < IT_LAYER) convert_item(a, l, it, scr, lane); }
}
__device__ __forceinline__ void p0_prologue(const Args& a, LAS unsigned char* lds, int vcu, int G, int tid, int lane, int wave) {
    unsigned char* ws = a.ws;
    LAS float* scr = (LAS float*)(lds + wave * 16640);
    const int gw = vcu * NWAVES + wave, NGW = G * NWAVES;
    for (int it = gw; it < IT_LAYER; it += NGW) convert_item(a, 0, it, scr, lane);
    __syncthreads();
    {
        LAS float* cact = (LAS float*)lds;
        LAS float* red = (LAS float*)(lds + 8192);
        for (int i = tid; i < 2 * D; i += NTHR) cact[i] = silu_f(a.c[i]);
        __syncthreads();
        float* MOD = (float*)(ws + WS_MOD);
        for (int it = vcu; it < DEPTH * 96; it += G) {
            const int l = it / 96, n0 = (it % 96) * 64;
            const float* wp = a.w_mod + ((size_t)l * D + 128 * wave) * 6144 + n0 + lane;
            float a0 = 0.f, a1 = 0.f;
#pragma unroll 32
            for (int k = 0; k < 128; ++k) { const float w = __builtin_nontemporal_load(wp + (size_t)k * 6144); a0 += cact[128 * wave + k] * w; a1 += cact[D + 128 * wave + k] * w; }
            red[(wave * 2 + 0) * 64 + lane] = a0; red[(wave * 2 + 1) * 64 + lane] = a1;
            __syncthreads();
            if (tid < 128) { const int b = tid >> 6, ln = tid & 63; float s = a.b_mod[l * 6144 + n0 + ln];
#pragma unroll
                for (int w = 0; w < 8; ++w) s += red[(w * 2 + b) * 64 + ln];
                MOD[((size_t)l * 2 + b) * 6144 + n0 + ln] = s; }
            __syncthreads();
        }
    }
    { const f32x4* xs = (const f32x4*)a.x; uint2* xd = (uint2*)(ws + WS_X);
        for (int i = vcu * NTHR + tid; i < MTOK * D / 4; i += G * NTHR) { const f32x4 v = xs[i]; uint2 p; p.x = pk2(v[0], v[1]); p.y = pk2(v[2], v[3]); xd[i] = p; } }
    {
        float* ROPE = (float*)(ws + WS_ROPE);
        for (int i = vcu * NTHR + tid; i < MTOK * 24; i += G * NTHR) { const int t = i / 24, f = i % 24;
            const float inv = (float)pow(10000.0, -(double)f / 24.0); const float ang = (float)a.pos[t] * inv;
            ROPE[(size_t)t * 48 + f] = cosf(ang); ROPE[(size_t)t * 48 + 24 + f] = sinf(ang); }
    }
    if (vcu == 0 && tid < 256) {
        float v[4], mx = -3.0e38f; for (int l = 0; l < 4; ++l) { v[l] = a.hg_lb[l * 256 + tid]; mx = fmaxf(mx, v[l]); }
        float s = 0.f; for (int l = 0; l < 4; ++l) { v[l] = expf(v[l] - mx); s += v[l]; }
        float* LB = (float*)(ws + WS_LB); float cs = 0.f, first = 0.f;
        for (int l = 0; l < 4; ++l) { cs += v[l] / s; if (l == 0) first = cs; LB[l * 256 + tid] = cs - first; }
    }
}

__device__ __forceinline__ void moe_combine_row(f32x4 (&v)[4], int m, const bf16* Y, const int* SLOT, const float* TOPW, const float* g2, int lane) {
    const int4 sl = *(const int4*)(SLOT + (size_t)m * 4); const f32x4 tw = *(const f32x4*)(TOPW + (size_t)m * 4);
    const int s[4] = {sl.x, sl.y, sl.z, sl.w};
    f32x4 acc[4];
#pragma unroll
    for (int j = 0; j < 4; ++j) acc[j] = (f32x4){0.f, 0.f, 0.f, 0.f};
#pragma unroll
    for (int k = 0; k < 4; ++k) { const bf16* yr = Y + (size_t)s[k] * D + 4 * lane; const float w = tw[k];
#pragma unroll
        for (int j = 0; j < 4; ++j) { const uint2 p = *(const uint2*)(yr + 256 * j);
            acc[j][0] += w * __builtin_bit_cast(float, p.x << 16); acc[j][1] += w * __builtin_bit_cast(float, p.x & 0xffff0000u);
            acc[j][2] += w * __builtin_bit_cast(float, p.y << 16); acc[j][3] += w * __builtin_bit_cast(float, p.y & 0xffff0000u); } }
#pragma unroll
    for (int j = 0; j < 4; ++j) { const f32x4 g = *(const f32x4*)(g2 + 4 * lane + 256 * j); v[j] = v[j] + g * acc[j]; }
}
__device__ __forceinline__ float row_rstd(const f32x4 (&v)[4]) {
    float s = 0.f;
#pragma unroll
    for (int j = 0; j < 4; ++j) s += (v[j][0] * v[j][0] + v[j][1] * v[j][1]) + (v[j][2] * v[j][2] + v[j][3] * v[j][3]);
    return 1.0f / sqrtf(wave_sum(s) * (1.0f / D) + EPS);
}
__device__ __forceinline__ void modulate_row(f32x4 (&v)[4], float rstd, const float* nw, const float* sc, const float* sh, bf16* hrow, int lane) {
#pragma unroll
    for (int j = 0; j < 4; ++j) { const int c0 = 4 * lane + 256 * j; const f32x4 w = *(const f32x4*)(nw + c0), s1 = *(const f32x4*)(sc + c0), s0 = *(const f32x4*)(sh + c0);
        v[j] = v[j] * rstd * w * (s1 + 1.0f) + s0;
        uint2 p; p.x = pk2(v[j][0], v[j][1]); p.y = pk2(v[j][2], v[j][3]); *(uint2*)(hrow + c0) = p; }
}


constexpr int LR_SLT = 142976, LR_TWL = 144000, LR_SSR = 145024;
__device__ __forceinline__ void stage_slots(const unsigned char* ws, int row0, LAS unsigned char* lds, int tid) {
    if (tid < 64) { *(LAS v4u*)(lds + LR_SLT + 16 * tid) = *(const v4u*)((const int*)(ws + WS_SLOT) + (size_t)(row0 + tid) * 4);
                    *(LAS f32x4*)(lds + LR_TWL + 16 * tid) = *(const f32x4*)((const float*)(ws + WS_TOPW) + (size_t)(row0 + tid) * 4); }
}
template <bool SS, bool OUTF32>
__device__ __forceinline__ void flat_combine(const bf16* xsrc, void* xdst, int row0, const bf16* Y, const float* g2, LAS unsigned char* lds, int tid, int lane) {
    const int c4 = tid & 255, rsub = tid >> 8; const f32x4 g = *(const f32x4*)(g2 + 4 * c4);
#pragma unroll 8
    for (int it = 0; it < 32; ++it) { const int i = 2 * it + rsub; const size_t m = (size_t)(row0 + i);
        f32x4 v; { const uint2 xp = *(const uint2*)(xsrc + m * D + 4 * c4); v[0] = __builtin_bit_cast(float, xp.x << 16); v[1] = __builtin_bit_cast(float, xp.x & 0xffff0000u); v[2] = __builtin_bit_cast(float, xp.y << 16); v[3] = __builtin_bit_cast(float, xp.y & 0xffff0000u); }
        const v4u sl = *(const LAS v4u*)(lds + LR_SLT + 16 * i); const f32x4 tw = *(const LAS f32x4*)(lds + LR_TWL + 16 * i);
        f32x4 acc;
        if (Y8) { const unsigned char* Yb = (const unsigned char*)Y; typedef float f32x2v __attribute__((ext_vector_type(2)));
            const int q0 = *(const int*)(Yb + (size_t)sl.x * D + 4 * c4), q1 = *(const int*)(Yb + (size_t)sl.y * D + 4 * c4), q2 = *(const int*)(Yb + (size_t)sl.z * D + 4 * c4), q3 = *(const int*)(Yb + (size_t)sl.w * D + 4 * c4);
            const f32x2v a0 = __builtin_amdgcn_cvt_pk_f32_fp8(q0, false), b0 = __builtin_amdgcn_cvt_pk_f32_fp8(q0, true), a1 = __builtin_amdgcn_cvt_pk_f32_fp8(q1, false), b1 = __builtin_amdgcn_cvt_pk_f32_fp8(q1, true);
            const f32x2v a2 = __builtin_amdgcn_cvt_pk_f32_fp8(q2, false), b2 = __builtin_amdgcn_cvt_pk_f32_fp8(q2, true), a3 = __builtin_amdgcn_cvt_pk_f32_fp8(q3, false), b3 = __builtin_amdgcn_cvt_pk_f32_fp8(q3, true);
            const f32x4 tws = tw * (1.0f / S8_Y);
            acc[0] = tws[0] * a0[0] + tws[1] * a1[0] + tws[2] * a2[0] + tws[3] * a3[0]; acc[1] = tws[0] * a0[1] + tws[1] * a1[1] + tws[2] * a2[1] + tws[3] * a3[1];
            acc[2] = tws[0] * b0[0] + tws[1] * b1[0] + tws[2] * b2[0] + tws[3] * b3[0]; acc[3] = tws[0] * b0[1] + tws[1] * b1[1] + tws[2] * b2[1] + tws[3] * b3[1]; }
        else {
        const uint2 p0 = *(const uint2*)(Y + (size_t)sl.x * D + 4 * c4), p1 = *(const uint2*)(Y + (size_t)sl.y * D + 4 * c4), p2 = *(const uint2*)(Y + (size_t)sl.z * D + 4 * c4), p3 = *(const uint2*)(Y + (size_t)sl.w * D + 4 * c4);
        acc[0] = tw[0] * __builtin_bit_cast(float, p0.x << 16) + tw[1] * __builtin_bit_cast(float, p1.x << 16) + tw[2] * __builtin_bit_cast(float, p2.x << 16) + tw[3] * __builtin_bit_cast(float, p3.x << 16);
        acc[1] = tw[0] * __builtin_bit_cast(float, p0.x & 0xffff0000u) + tw[1] * __builtin_bit_cast(float, p1.x & 0xffff0000u) + tw[2] * __builtin_bit_cast(float, p2.x & 0xffff0000u) + tw[3] * __builtin_bit_cast(float, p3.x & 0xffff0000u);
        acc[2] = tw[0] * __builtin_bit_cast(float, p0.y << 16) + tw[1] * __builtin_bit_cast(float, p1.y << 16) + tw[2] * __builtin_bit_cast(float, p2.y << 16) + tw[3] * __builtin_bit_cast(float, p3.y << 16);
        acc[3] = tw[0] * __builtin_bit_cast(float, p0.y & 0xffff0000u) + tw[1] * __builtin_bit_cast(float, p1.y & 0xffff0000u) + tw[2] * __builtin_bit_cast(float, p2.y & 0xffff0000u) + tw[3] * __builtin_bit_cast(float, p3.y & 0xffff0000u); }
        v = v + g * acc;
        if (OUTF32) *(GAS f32x4*)((float*)xdst + m * D + 4 * c4) = v;
        else { typedef unsigned u32x2v __attribute__((ext_vector_type(2))); *(GAS u32x2v*)((bf16*)xdst + m * D + 4 * c4) = (u32x2v){pk2(v[0], v[1]), pk2(v[2], v[3])}; }
        if (SS) { const float sq = wave_sum((v[0] * v[0] + v[1] * v[1]) + (v[2] * v[2] + v[3] * v[3])); if (lane == 0) __hip_atomic_fetch_add((LAS float*)(lds + LR_SSR) + i, sq, __ATOMIC_RELAXED, __HIP_MEMORY_SCOPE_WORKGROUP); } }
}
template <bool F8>
__device__ __forceinline__ void flat_modulate(const bf16* xin, int row0, const LAS float* rstds, const float* nw, const float* scp, const float* shp, bf16* H, int tid) {
    const int c4 = tid & 255, rsub = tid >> 8; const f32x4 w = *(const f32x4*)(nw + 4 * c4), s1 = *(const f32x4*)(scp + 4 * c4), s0 = *(const f32x4*)(shp + 4 * c4); const f32x4 ws1 = w * (s1 + 1.0f);
#pragma unroll 8
    for (int it = 0; it < 32; ++it) { const int i = 2 * it + rsub; const size_t m = (size_t)(row0 + i); const uint2 xp = *(const uint2*)(xin + m * D + 4 * c4);
        const f32x4 v = (f32x4){__builtin_bit_cast(float, xp.x << 16), __builtin_bit_cast(float, xp.x & 0xffff0000u), __builtin_bit_cast(float, xp.y << 16), __builtin_bit_cast(float, xp.y & 0xffff0000u)} * rstds[i] * ws1 + s0;
        if (F8) *(GAS int*)((unsigned char*)H + m * D + 4 * c4) = pk4_fp8(v[0] * S8_H, v[1] * S8_H, v[2] * S8_H, v[3] * S8_H);
        else { typedef unsigned u32x2v __attribute__((ext_vector_type(2))); *(GAS u32x2v*)(H + m * D + 4 * c4) = (u32x2v){pk2(v[0], v[1]), pk2(v[2], v[3])}; } }
}

constexpr int WP = 1032;
constexpr int LR_WHI = 0, LR_PART = 132096, LR_SSX = 140288, LR_RSTD = 140544, LR_BIAS = 140800, LR_RED = 140928;
template <int NEO>
__device__ __forceinline__ void rows_mfma(const Args& a, int layer, LAS unsigned char* lds, volatile LAS unsigned* MISC, gu32* ctl, int vcu, int G, int tid, int lane, int wave) {
    constexpr bool P5 = (NEO == 32); constexpr int NET = NEO / 16;
    unsigned char* ws = a.ws; bf16* X = (bf16*)(ws + WS_X); bf16* H = (bf16*)(ws + WS_H); const float* MOD = (const float*)(ws + WS_MOD);
    LAS bf16* Whi = (LAS bf16*)(lds + LR_WHI); LAS bf16* Wlo = Whi + NEO * WP; LAS float* part = (LAS float*)(lds + LR_PART); LAS float* ssx = (LAS float*)(lds + LR_SSX);
    LAS float* rstds = (LAS float*)(lds + LR_RSTD); LAS float* biasl = (LAS float*)(lds + LR_BIAS); LAS float* red = (LAS float*)(lds + LR_RED);
    const float* nw = (P5 ? a.norm2_w : a.norm1_w) + layer * D;
    const float* Wsrc = P5 ? a.w_r + (size_t)layer * D * NE : a.w_in + (size_t)layer * D * DIN + SRC_GA; const int wld = P5 ? NE : DIN;
    if (P5) { if (tid < NE) MISC[MW_HIST + tid] = 0u; }
    for (int row0 = vcu * 64; row0 < MTOK; row0 += G * 64) {
        const int b = row0 / SEQ; const float* mp = MOD + ((size_t)layer * 2 + b) * 6144; const float* scp = mp + (P5 ? 4 : 1) * D; const float* shp = mp + (P5 ? 3 : 0) * D;
        if (!P5 && layer > 0) { stage_slots(ws, row0, lds, tid); __syncthreads(); }
        { const int e = tid % NEO, kq = tid / NEO; constexpr int NPT = NTHR / NEO;
#pragma unroll 1
            for (int it0 = 0; it0 < D / NPT; it0 += 8) { float wv[8];
#pragma unroll
                for (int u = 0; u < 8; ++u) { const int k = kq + NPT * (it0 + u); wv[u] = Wsrc[(size_t)k * wld + e] * (nw[k] * (1.0f + scp[k])); }
#pragma unroll
                for (int u = 0; u < 8; ++u) { const int k = kq + NPT * (it0 + u); const unsigned hi = f2bf(wv[u]); const float wl = wv[u] - __builtin_bit_cast(float, hi << 16); Whi[e * WP + k] = (bf16)hi; Wlo[e * WP + k] = (bf16)f2bf(wl); } }
            constexpr int KP = D / NPT; float sacc = 0.f;
#pragma unroll 8
            for (int k = kq * KP; k < kq * KP + KP; ++k) sacc += shp[k] * Wsrc[(size_t)k * wld + e];
            red[kq * NEO + e] = sacc; }
        const bf16* xin = X;
        if (!P5 && layer > 0) { flat_combine<false, false>(X, X, row0, (const bf16*)(ws + WS_Y), MOD + ((size_t)(layer - 1) * 2 + b) * 6144 + 5 * D, lds, tid, lane); asm volatile("s_waitcnt vmcnt(0)" ::: "memory"); }
        __syncthreads();
        if (tid < NEO) { constexpr int NPT = NTHR / NEO; float sacc = P5 ? a.b_r[layer * NE + tid] : 0.f; for (int q = 0; q < NPT; ++q) sacc += red[q * NEO + tid]; biasl[tid] = sacc; }
        const int rg = wave >> 1, kh = wave & 1, r = lane & 15, g = lane >> 4;
        { const bf16* xr = xin + (size_t)(row0 + 16 * rg + r) * D; f32x4 acc[NET]; float ss = 0.f;
#pragma unroll
            for (int et = 0; et < NET; ++et) acc[et] = (f32x4){0.f, 0.f, 0.f, 0.f};
#pragma unroll 4
            for (int s = 16 * kh; s < 16 * kh + 16; ++s) { const int k0 = 32 * s + 8 * g; const v4u xp = *(const v4u*)(xr + k0); const unsigned xw[4] = {xp.x, xp.y, xp.z, xp.w};
#pragma unroll
                for (int j = 0; j < 4; ++j) { const float xa = __builtin_bit_cast(float, xw[j] << 16), xb = __builtin_bit_cast(float, xw[j] & 0xffff0000u); ss += xa * xa + xb * xb; }
                const pg8::bf16x8 ahi = __builtin_bit_cast(pg8::bf16x8, xp);
#pragma unroll
                for (int et = 0; et < NET; ++et) { const pg8::bf16x8 whi = ldfrag(Whi, WP, 16 * et, 32 * s, lane), wlo = ldfrag(Wlo, WP, 16 * et, 32 * s, lane);
                    acc[et] = __builtin_amdgcn_mfma_f32_16x16x32_bf16(ahi, whi, acc[et], 0, 0, 0); acc[et] = __builtin_amdgcn_mfma_f32_16x16x32_bf16(ahi, wlo, acc[et], 0, 0, 0); } }
            ss += __shfl_xor(ss, 16); ss += __shfl_xor(ss, 32);
            if (kh == 1) {
#pragma unroll
                for (int et = 0; et < NET; ++et)
#pragma unroll
                    for (int q = 0; q < 4; ++q) part[(rg * 16 + 4 * g + q) * 32 + 16 * et + r] = acc[et][q];
                if (g == 0) ssx[rg * 16 + r] = ss; }
            __syncthreads();
            if (kh == 0) { const float sst = ss + ssx[rg * 16 + r]; if (g == 0) rstds[rg * 16 + r] = 1.0f / sqrtf(sst * (1.0f / D) + EPS);
                asm volatile("s_waitcnt lgkmcnt(0)" ::: "memory");
#pragma unroll
                for (int et = 0; et < NET; ++et)
#pragma unroll
                    for (int q = 0; q < 4; ++q) { const int i = rg * 16 + 4 * g + q, e = 16 * et + r; const float v = rstds[i] * (acc[et][q] + part[i * 32 + e]) + biasl[e];
                        if (P5) part[i * 32 + e] = v; else ((float*)(ws + WS_GA))[(size_t)(row0 + i) * 16 + e] = v; }
                if (P5) { asm volatile("s_waitcnt lgkmcnt(0)" ::: "memory");
                    if (lane < 16) { const int i = rg * 16 + lane, m = row0 + i; float lv[NE];
#pragma unroll
                        for (int e = 0; e < NE; ++e) lv[e] = part[i * 32 + e];
                        float tv[4]; int te[4];
#pragma unroll
                        for (int t = 0; t < 4; ++t) { float best = -3.0e38f; int bi = 0;
#pragma unroll
                            for (int e = 0; e < NE; ++e) if (lv[e] > best) { best = lv[e]; bi = e; }
#pragma unroll
                            for (int e = 0; e < NE; ++e) if (e == bi) lv[e] = -3.0e38f;
                            tv[t] = best; te[t] = bi; }
                        const float e1 = expf(tv[1] - tv[0]), e2 = expf(tv[2] - tv[0]), e3 = expf(tv[3] - tv[0]); const float inv = 1.0f / (1.0f + e1 + e2 + e3);
                        *(f32x4*)((float*)(ws + WS_TOPW) + (size_t)m * 4) = (f32x4){inv, e1 * inv, e2 * inv, e3 * inv};
#pragma unroll
                        for (int t = 0; t < 4; ++t) { const unsigned rk = __hip_atomic_fetch_add((LAS unsigned*)&MISC[MW_HIST + te[t]], 1u, __ATOMIC_RELAXED, __HIP_MEMORY_SCOPE_WORKGROUP);
                            ((LAS unsigned*)(lds + LR_SLT))[i * 4 + t] = ((unsigned)te[t] << 16) | rk; } } } }
            __syncthreads(); }
        if (P5) { if (tid < NE) { const unsigned hcnt = MISC[MW_HIST + tid]; MISC[MW_BASE + tid] = hcnt ? atomicAdd((unsigned*)(ctl + CW_CNT + layer * NE + tid), hcnt) : 0u; }
            __syncthreads();
            if (tid < 256) { LAS unsigned* sl = (LAS unsigned*)(lds + LR_SLT) + tid; const unsigned v = *sl, e = v >> 16; const unsigned slot = (e << ECAP_SH) + MISC[MW_BASE + e] + (v & 0xffffu);
                *sl = slot; ((int*)(ws + WS_SLOT))[(size_t)row0 * 4 + tid] = (int)slot; }
            if (tid < NE) MISC[MW_HIST + tid] = 0u;
            __syncthreads(); }
        if (P5) { const int c4 = tid & 255, rsub = tid >> 8; const f32x4 w = *(const f32x4*)(nw + 4 * c4), s1 = *(const f32x4*)(scp + 4 * c4), s0 = *(const f32x4*)(shp + 4 * c4); const f32x4 ws1 = w * (s1 + 1.0f);
            unsigned char* A1 = ws + WS_A1;
#pragma unroll 8
            for (int it = 0; it < 32; ++it) { const int i = 2 * it + rsub; const uint2 xp = *(const uint2*)(xin + (size_t)(row0 + i) * D + 4 * c4);
                const f32x4 v = (f32x4){__builtin_bit_cast(float, xp.x << 16), __builtin_bit_cast(float, xp.x & 0xffff0000u), __builtin_bit_cast(float, xp.y << 16), __builtin_bit_cast(float, xp.y & 0xffff0000u)} * rstds[i] * ws1 + s0;
                const int pw = pk4_fp8(v[0] * S8_H, v[1] * S8_H, v[2] * S8_H, v[3] * S8_H); const v4u sl = *(const LAS v4u*)(lds + LR_SLT + 16 * i);
                *(GAS int*)(A1 + (size_t)sl.x * D + 4 * c4) = pw; *(GAS int*)(A1 + (size_t)sl.y * D + 4 * c4) = pw; *(GAS int*)(A1 + (size_t)sl.z * D + 4 * c4) = pw; *(GAS int*)(A1 + (size_t)sl.w * D + 4 * c4) = pw; } }
        else flat_modulate<F8_IN>(xin, row0, rstds, nw, scp, shp, H, tid);
        __syncthreads();
    }
}

__device__ __forceinline__ void final_rows(const Args& a, LAS unsigned char* lds, int vcu, int G, int tid, int lane) {
    unsigned char* ws = a.ws; const bf16* X = (const bf16*)(ws + WS_X); const float* MOD = (const float*)(ws + WS_MOD); LAS float* ssr = (LAS float*)(lds + LR_SSR);
    for (int row0 = vcu * 64; row0 < MTOK; row0 += G * 64) { const int b = row0 / SEQ;
        stage_slots(ws, row0, lds, tid); if (tid < 64) ssr[tid] = 0.f;
        __syncthreads();
        flat_combine<true, true>(X, a.out, row0, (const bf16*)(ws + WS_Y), MOD + ((size_t)(DEPTH - 1) * 2 + b) * 6144 + 5 * D, lds, tid, lane);
        asm volatile("s_waitcnt vmcnt(0)" ::: "memory");
        __syncthreads();
        { const int c4 = tid & 255, rsub = tid >> 8; const f32x4 w = *(const f32x4*)(a.final_norm_w + 4 * c4);
#pragma unroll 8
            for (int it = 0; it < 32; ++it) { const int i = 2 * it + rsub; float* op = a.out + (size_t)(row0 + i) * D + 4 * c4; const float rstd = 1.0f / sqrtf(ssr[i] * (1.0f / D) + EPS); *(GAS f32x4*)op = *(const GAS f32x4*)op * rstd * w; } }
        __syncthreads();
    }
}

__device__ __noinline__ void moe_tables(gu32* ctl, int layer, volatile LAS unsigned* MISC, int tid) {
    if (tid < NE) MISC[MW_CNT + tid] = __hip_atomic_load(ctl + CW_CNT + layer * NE + tid, RLX_AGENT);
    __syncthreads();
    if (tid == 0) { unsigned n = 0;
        for (int e = 0; e < NE; ++e) { const unsigned nt = (MISC[MW_CNT + e] + 255u) >> 8; for (unsigned t = 0; t < nt; ++t) MISC[MW_TILE + n + t] = (unsigned)(e * 64) + t; n += nt; }
        MISC[MW_NRT] = n; }
    __syncthreads();
}

constexpr int BP = 72;
template <int TYPE> struct MixCfg { static constexpr int DK = (TYPE == 1) ? 64 : 48, DV = (TYPE == 1) ? 64 : 96, NC = 4 * DK, NV = 4 * DV;
    static constexpr int STOFF = (TYPE == 0) ? ST_GLA : (TYPE == 1) ? ST_HG : ST_RET, COFF = (TYPE == 0) ? 0 : 192;
    static constexpr int CQ = (TYPE == 0) ? C_GQ : (TYPE == 1) ? C_HQ : C_RQ, CK = (TYPE == 0) ? C_GK : (TYPE == 1) ? C_HF : C_RK, CV = (TYPE == 0) ? C_GV : (TYPE == 1) ? C_HI : C_RV, CG = (TYPE == 0) ? C_GG : (TYPE == 1) ? C_HG : C_RG;
    static constexpr int MIXOFF = (TYPE == 0) ? 0 : (TYPE == 1) ? 384 : 640, KOFF = (TYPE == 0) ? 0 : (TYPE == 1) ? 192 : 448; };
__device__ __forceinline__ float fast_logsig(float x) { x = fmaxf(x, -80.f); return -__logf(1.0f + __expf(-x)); }
__device__ __forceinline__ float ret_lg(int h) { return logf(1.0f - exp2f(-5.0f - (float)h)); }

template <int NV>
__device__ __forceinline__ void stage_vt(const bf16* pv  , LAS bf16* VT, int tid) {
    constexpr int NIT = (64 * (NV / 8)) / NTHR; static_assert((64 * (NV / 8)) % NTHR == 0, "stage_vt");
    v4u p[NIT];
#pragma unroll
    for (int it = 0; it < NIT; ++it) { const int idx = tid + NTHR * it, j = idx & 63, ch = idx >> 6; p[it] = *(const v4u*)(pv + (size_t)j * NPROJ + 8 * ch); }
#pragma unroll
    for (int it = 0; it < NIT; ++it) { const int idx = tid + NTHR * it, j = idx & 63, ch = idx >> 6; LAS bf16* d = VT + (8 * ch) * BP + j;
        d[0 * BP] = (bf16)(p[it].x & 0xffffu); d[1 * BP] = (bf16)(p[it].x >> 16); d[2 * BP] = (bf16)(p[it].y & 0xffffu); d[3 * BP] = (bf16)(p[it].y >> 16);
        d[4 * BP] = (bf16)(p[it].z & 0xffffu); d[5 * BP] = (bf16)(p[it].z >> 16); d[6 * BP] = (bf16)(p[it].w & 0xffffu); d[7 * BP] = (bf16)(p[it].w >> 16); }
}

constexpr int LA_KT = 0, LA_VT = 36864, LA_TOT = 92160, LA_GA = 94208, LA_KTT = 98304, KTP = 264;
template <int TYPE>
__device__ __forceinline__ void mixa_batch(const Args& a, int layer, int unit, LAS unsigned char* lds, int tid, int lane, int wave) {
    asm volatile("" : "+v"(tid), "+v"(lane));
    typedef MixCfg<TYPE> C; constexpr int DK = C::DK, DV = C::DV, NC = C::NC, NV = C::NV;
    unsigned char* ws = a.ws; const bf16* PROJ = (const bf16*)(ws + WS_PROJ); bf16* F1 = (bf16*)(ws + WS_CUM); float* ECG = (float*)(ws + WS_CUM + 16 * MiB) + (size_t)unit * 4 * NDV; float* DVEC = (float*)(ws + WS_DVEC) + (size_t)unit * NDV;
    bf16* U = (bf16*)(ws + WS_U) + (size_t)unit * ST_TOT + C::STOFF;
    LAS bf16* KT = (LAS bf16*)(lds + LA_KT); LAS bf16* VT = (LAS bf16*)(lds + LA_VT); LAS float* TOT = (LAS float*)(lds + LA_TOT); const LAS float* GAs = (const LAS float*)(lds + LA_GA);
    const int row0 = unit * CH;
    stage_vt<NV>(PROJ + (size_t)row0 * NPROJ + C::CV, VT, tid);
    const bool act = tid < 2 * NC; const int c = act ? tid % NC : 0, half = act ? tid / NC : 0, h = c / DK, d = c - h * DK;
    float cum[32]; float tot = 0.f;
    float w2[16], b2 = 0.f, lbv = 0.f, lg = 0.f, sg = 0.f; int f = 0, d2 = 0;
    if (act) {
        if constexpr (TYPE == 0) { b2 = a.gla_ba2[layer * 192 + c];
#pragma unroll
            for (int r = 0; r < 16; ++r) w2[r] = a.gla_wa2[(layer * 16 + r) * 192 + c]; }
        if constexpr (TYPE == 1) lbv = ((const float*)(ws + WS_LB))[layer * 256 + c];
        if constexpr (TYPE == 2) { lg = ret_lg(h); f = (d < 24) ? d : d - 24; d2 = (d < 24) ? d + 24 : d - 24; sg = (d < 24) ? -1.f : 1.f; }
#pragma unroll
        for (int gq = 0; gq < 2; ++gq) {
            bf16 hraw[16];
            if constexpr (TYPE == 1) {
#pragma unroll
                for (int i = 0; i < 16; ++i) hraw[i] = PROJ[(size_t)(row0 + 32 * half + 16 * gq + i) * NPROJ + C_HF + c]; }
#pragma unroll
            for (int ii = 0; ii < 16; ++ii) { const int i = 16 * gq + ii, t = 32 * half + i; float g;
                if constexpr (TYPE == 0) { float pre = b2;
#pragma unroll
                    for (int r = 0; r < 16; ++r) pre += GAs[t * 16 + r] * w2[r];
                    g = fast_logsig(pre) * (1.0f / 16.0f); }
                else if constexpr (TYPE == 1) { const float hf = fminf(fmaxf(bf2f(hraw[ii]), -80.f), 80.f); const float sgm = __builtin_amdgcn_rcpf(1.0f + __expf(-hf));
                    g = __logf(lbv + (1.0f - lbv) * sgm); }
                else g = lg;
                tot += g; cum[i] = tot;
                if constexpr (TYPE == 0) { if ((ii & 3) == 3) asm volatile("" ::: "memory"); } } }
        TOT[c * 2 + half] = tot;
    }
    __syncthreads();
    if (act) { const float t0 = TOT[c * 2], t1 = TOT[c * 2 + 1]; const float off = half ? t0 : 0.f, last = t0 + t1;
#pragma unroll
        for (int hq = 0; hq < 4; ++hq) {
            bf16 ka[8], kb[8]; float cs[8], sn[8];
            if constexpr (TYPE != 1) {
#pragma unroll
                for (int i = 0; i < 8; ++i) { const size_t row = (size_t)(row0 + 32 * half + 8 * hq + i); const bf16* pr = PROJ + row * NPROJ;
                    if constexpr (TYPE == 0) ka[i] = pr[C_GK + c];
                    else { const float* rp = (const float*)(ws + WS_ROPE) + row * 48; ka[i] = pr[C_RK + h * 48 + d]; kb[i] = pr[C_RK + h * 48 + d2]; cs[i] = rp[f]; sn[i] = rp[24 + f]; } } }
            float kt[8];
#pragma unroll
            for (int j = 0; j < 8; ++j) { const int i = 8 * hq + j; const float cm = cum[i] + off; const size_t row = (size_t)(row0 + 32 * half + i); float k;
                if constexpr (TYPE == 0) k = bf2f(ka[j]);
                else if constexpr (TYPE == 1) k = 1.0f - __expf(cum[i] - (i > 0 ? cum[i - 1] : 0.f));
                else k = bf2f(ka[j]) * cs[j] + sg * bf2f(kb[j]) * sn[j];
                if constexpr (TYPE != 2) *(GAS bf16*)(F1 + row * NDV + C::COFF + c) = (bf16)f2bf(__expf(cm - ((i < 16) ? off : cum[15] + off)));
                { const float eb = cum[(i < 16) ? 15 : 31] + off;
                  ((LAS bf16*)(lds + LA_KTT))[(32 * half + i) * KTP + c] = (bf16)f2bf(k * __expf(eb - cm)); }
                kt[j] = k * __expf(last - cm); }
            v4u w; w.x = pk2(kt[0], kt[1]); w.y = pk2(kt[2], kt[3]); w.z = pk2(kt[4], kt[5]); w.w = pk2(kt[6], kt[7]);
            *(LAS v4u*)(KT + c * BP + 32 * half + 8 * hq) = w; }
        if (TYPE != 2) { *(GAS float*)(ECG + (2 * half + 0) * NDV + C::COFF + c) = cum[15] + off; *(GAS float*)(ECG + (2 * half + 1) * NDV + C::COFF + c) = cum[31] + off; }
        if (TYPE != 2 && half == 0) *(GAS float*)(DVEC + C::COFF + c) = __expf(last);
    }
    __syncthreads();
    { constexpr int CPR = NC / 8;
#pragma unroll
        for (int it = 0; it < (64 * CPR) / NTHR; ++it) { const int idx = tid + NTHR * it, t = idx / CPR, ch = idx - t * CPR;
            *(GAS v4u*)((bf16*)(ws + WS_KT) + (size_t)(row0 + t) * NKT + C::KOFF + 8 * ch) = *(const LAS v4u*)((const LAS bf16*)(lds + LA_KTT) + t * KTP + 8 * ch); } }
    constexpr int TD = DK / 16, NT = (DV / 16) * TD;
    for (int ti = wave; ti < 4 * NT; ti += NWAVES) { const int hh = ti / NT, tr = ti - hh * NT, te = tr / TD, td = tr - te * TD; f32x4 acc = {0.f, 0.f, 0.f, 0.f};
#pragma unroll
        for (int kk = 0; kk < 2; ++kk) acc = __builtin_amdgcn_mfma_f32_16x16x32_bf16(ldfrag(VT, BP, hh * DV + te * 16, kk * 32, lane), ldfrag(KT, BP, hh * DK + td * 16, kk * 32, lane), acc, 0, 0, 0);
        bf16* Uh = U + hh * DK * DV;
#pragma unroll
        for (int r = 0; r < 4; ++r) *(GAS bf16*)(Uh + (te * 16 + (lane >> 4) * 4 + r) * DK + td * 16 + (lane & 15)) = (bf16)f2bf(acc[r]); }
    __syncthreads();
}
__device__ __forceinline__ void p3a_summaries(const Args& a, int layer, LAS unsigned char* lds, int vcu, int G, int tid, int lane, int wave) {
    for (int unit = vcu; unit < NUNIT; unit += G) {
        { LAS float* GAs = (LAS float*)(lds + LA_GA); const float* GA = (const float*)(a.ws + WS_GA); for (int i = tid; i < CH * 16; i += NTHR) GAs[i] = GA[(size_t)unit * CH * 16 + i]; }
        __syncthreads();
        mixa_batch<0>(a, layer, unit, lds, tid, lane, wave);
        mixa_batch<1>(a, layer, unit, lds, tid, lane, wave);
        mixa_batch<2>(a, layer, unit, lds, tid, lane, wave);
    }
}

__device__ __forceinline__ void p3b_scan(const Args& a, int vcu, int G, int tid) {
    unsigned char* ws = a.ws; const bf16* U = (const bf16*)(ws + WS_U); const float* DVEC = (const float*)(ws + WS_DVEC); bf16* SP = (bf16*)(ws + WS_SP);
    for (int gid = vcu * NTHR + tid; gid < BATCH * ST_TOT; gid += G * NTHR) {
        const int b = gid / ST_TOT, el = gid - b * ST_TOT;
        int di = -1; float cdec = 0.f;
        if (el < ST_HG) { const int h = el / 4608, d = (el - h * 4608) % 48; di = h * 48 + d; }
        else if (el < ST_RET) { const int r = el - ST_HG, h = r / 4096, d = r % 64; di = 192 + h * 64 + d; }
        else { const int h = (el - ST_RET) / 4608; cdec = expf(64.0f * logf(1.0f - exp2f(-5.0f - (float)h))); }
        const bf16* up = U + (size_t)b * NCH * ST_TOT + el; const float* dp = DVEC + (size_t)b * NCH * NDV + (di < 0 ? 0 : di); bf16* sp = SP + (size_t)b * NCH * ST_TOT + el;
        float s = 0.f;
#pragma unroll 1
        for (int n0 = 0; n0 < NCH; n0 += 32) { float u[32], dc[32];
#pragma unroll
            for (int i = 0; i < 32; ++i) { u[i] = bf2f(up[(size_t)(n0 + i) * ST_TOT]); dc[i] = (di < 0) ? cdec : dp[(size_t)(n0 + i) * NDV]; }
#pragma unroll
            for (int i = 0; i < 32; ++i) { *(GAS bf16*)(sp + (size_t)(n0 + i) * ST_TOT) = (bf16)f2bf(s); s = dc[i] * s + u[i]; } }
    }
}

#ifndef SUB_MASK
#define SUB_MASK 0
#endif
#define SUBSTRETCH(bit, t0_) do { if ((SUB_MASK >> (bit)) & 1) { const unsigned long long t1_ = __builtin_amdgcn_s_memrealtime(); while (__builtin_amdgcn_s_memrealtime() - t1_ < t1_ - (t0_)) __builtin_amdgcn_s_sleep(8); } } while (0)
constexpr int LC_VT = 0, LC_ST = 55296, LC_AB = 110592, OBP = 104, LC_EC = 137216;
template <int TYPE, bool ISQ>
__device__ __forceinline__ void mix_frag(const Args& a, int h, size_t row, int t, int d0, float (&x)[8], float (&cm)[8]) {
    typedef MixCfg<TYPE> C; constexpr int DK = C::DK; static_assert(ISQ, "query path only");
    unsigned char* ws = a.ws; const bf16* pr = (const bf16*)(ws + WS_PROJ) + row * NPROJ;
    if constexpr (TYPE != 2) {
        const v4u p = *(const v4u*)(pr + C::CQ + h * DK + d0); const unsigned pw[4] = {p.x, p.y, p.z, p.w};
        const v4u f = *(const v4u*)((const bf16*)(ws + WS_CUM) + row * NDV + C::COFF + h * DK + d0); const unsigned fw[4] = {f.x, f.y, f.z, f.w};
#pragma unroll
        for (int j = 0; j < 4; ++j) { x[2 * j] = __builtin_bit_cast(float, pw[j] << 16); x[2 * j + 1] = __builtin_bit_cast(float, pw[j] & 0xffff0000u); cm[2 * j] = __builtin_bit_cast(float, fw[j] << 16); cm[2 * j + 1] = __builtin_bit_cast(float, fw[j] & 0xffff0000u); }
        if constexpr (TYPE == 0) {
#pragma unroll
            for (int j = 0; j < 8; ++j) x[j] *= 0.14433756729740643f; }
    } else {
        const int f0 = (d0 < 24) ? d0 : d0 - 24, dp = (d0 < 24) ? d0 + 24 : d0 - 24; const float sg = (d0 < 24) ? -1.f : 1.f;
        const int cb = C_RQ + h * DK; const v4u p = *(const v4u*)(pr + cb + d0), pp = *(const v4u*)(pr + cb + dp); const unsigned pw[4] = {p.x, p.y, p.z, p.w}, qw[4] = {pp.x, pp.y, pp.z, pp.w};
        const float* rp = (const float*)(ws + WS_ROPE) + row * 48; const f32x4 cs0 = *(const f32x4*)(rp + f0), cs1 = *(const f32x4*)(rp + f0 + 4), sn0 = *(const f32x4*)(rp + 24 + f0), sn1 = *(const f32x4*)(rp + 24 + f0 + 4);
        const float cmv = (float)(t + 1) * ret_lg(h);
#pragma unroll
        for (int j = 0; j < 4; ++j) { const float xa = __builtin_bit_cast(float, pw[j] << 16), xb = __builtin_bit_cast(float, pw[j] & 0xffff0000u), ya = __builtin_bit_cast(float, qw[j] << 16), yb = __builtin_bit_cast(float, qw[j] & 0xffff0000u);
            const float ca = (j < 2) ? cs0[2 * j] : cs1[2 * j - 4], cb2 = (j < 2) ? cs0[2 * j + 1] : cs1[2 * j - 3], sa = (j < 2) ? sn0[2 * j] : sn1[2 * j - 4], sb = (j < 2) ? sn0[2 * j + 1] : sn1[2 * j - 3];
            x[2 * j] = (xa * ca + sg * ya * sa) * 0.14433756729740643f; x[2 * j + 1] = (xb * cb2 + sg * yb * sb) * 0.14433756729740643f; cm[2 * j] = cmv; cm[2 * j + 1] = cmv; }
    }
}

template <int TYPE>
__device__ __forceinline__ void mixc_batch(const Args& a, int layer, int unit, LAS unsigned char* lds, int tid, int lane, int wave) {
    asm volatile("" : "+v"(tid), "+v"(lane));
    typedef MixCfg<TYPE> C; constexpr int DK = C::DK, DV = C::DV, NV = C::NV, TE = DV / 16;
    unsigned char* ws = a.ws; const bf16* PROJ = (const bf16*)(ws + WS_PROJ); bf16* MIX = (bf16*)(ws + WS_MIX);
    LAS bf16* VT = (LAS bf16*)(lds + LC_VT); LAS bf16* ST = (LAS bf16*)(lds + LC_ST); LAS bf16* AB = (LAS bf16*)(lds + LC_AB) + wave * 16 * OBP;
    const int row0 = unit * CH;
    const unsigned long long ts0_ = SUB_MASK ? __builtin_amdgcn_s_memrealtime() : 0ull;
    stage_vt<NV>(PROJ + (size_t)row0 * NPROJ + C::CV, VT, tid);
    SUBSTRETCH(3, ts0_);
    const unsigned long long ts3_ = SUB_MASK ? __builtin_amdgcn_s_memrealtime() : 0ull;
    { const bf16* SPu = (const bf16*)(ws + WS_SP) + (size_t)unit * ST_TOT + C::STOFF;
        constexpr int NIS = (NV * 8) / NTHR; static_assert((NV * 8) % NTHR == 0, "ST staging"); v4u sw[NIS];
#pragma unroll
        for (int it = 0; it < NIS; ++it) { const int idx = tid + NTHR * it, er = idx >> 3, ch = idx & 7; sw[it] = (v4u){0u, 0u, 0u, 0u}; if (ch * 8 < DK) sw[it] = *(const v4u*)(SPu + (size_t)er * DK + ch * 8); }
#pragma unroll
        for (int it = 0; it < NIS; ++it) { const int idx = tid + NTHR * it, er = idx >> 3, ch = idx & 7; *(LAS v4u*)(ST + er * BP + ch * 8) = sw[it]; } }
    SUBSTRETCH(4, ts3_);
    SUBSTRETCH(0, ts0_);
    if constexpr (TYPE != 2) { LAS float* EC = (LAS float*)(lds + LC_EC);
        for (int idx = tid; idx < 4 * C::NC; idx += NTHR) { const int jb = idx / C::NC, cc = idx - jb * C::NC; EC[jb * 256 + cc] = ((const float*)(ws + WS_CUM + 16 * MiB))[((size_t)unit * 4 + jb) * NDV + C::COFF + cc]; } }
    __syncthreads();
    const unsigned long long ts1_ = SUB_MASK ? __builtin_amdgcn_s_memrealtime() : 0ull;
    const int h = wave >> 1, hsel = wave & 1, r = lane & 15, g = lane >> 4;
    const LAS bf16* STh = ST + h * DV * BP; const LAS bf16* VTh = VT + h * DV * BP;
    constexpr int NCHK = DV / 8, NOC = (16 * NCHK) / 64;
#pragma unroll 1
    for (int ib = 0; ib < 2; ++ib) { const int I = ib ? 3 - hsel : hsel;
        pg8::bf16x8 qh[2], qt[2]; float refv[2][8], qhf[2][8];
#pragma unroll
        for (int s = 0; s < 2; ++s) { const int d0 = 32 * s + 8 * g; const bool valid = d0 < DK; const int d0c = valid ? d0 : 0;
            float x[8], cm[8]; mix_frag<TYPE, true>(a, h, (size_t)(row0 + 16 * I + r), 16 * I + r, d0c, x, cm);
            if constexpr (TYPE == 2) {
#pragma unroll
                for (int j = 0; j < 8; ++j) refv[s][j] = (float)(16 * I) * ret_lg(h);
            } else { if (I > 0) { const LAS float* cp = (const LAS float*)(lds + LC_EC) + (I - 1) * 256 + h * DK + d0c; const f32x4 c0 = *(const LAS f32x4*)cp, c1 = *(const LAS f32x4*)(cp + 4);
#pragma unroll
                    for (int j = 0; j < 4; ++j) { refv[s][j] = c0[j]; refv[s][4 + j] = c1[j]; } }
                else {
#pragma unroll
                    for (int j = 0; j < 8; ++j) refv[s][j] = 0.f; } }
            float xt[8];
#pragma unroll
            for (int j = 0; j < 8; ++j) { if constexpr (TYPE == 2) { qhf[s][j] = valid ? x[j] * __expf(cm[j] - refv[s][j]) : 0.f; xt[j] = valid ? x[j] * __expf(cm[j]) : 0.f; }
                else { qhf[s][j] = valid ? x[j] * cm[j] : 0.f; xt[j] = qhf[s][j] * __expf(refv[s][j]); } }
            qh[s] = pack8(qhf[s]); qt[s] = pack8(xt); }
        v4u kf[4][2];
#pragma unroll
        for (int J = 0; J < 4; ++J) { const int Jc = (J < I) ? J : I; const size_t rowJ = (size_t)(row0 + 16 * Jc + r);
#pragma unroll
            for (int s = 0; s < 2; ++s) { const int d0 = 32 * s + 8 * g; const int d0c = (d0 < DK) ? d0 : 0;
                kf[J][s] = *(const v4u*)((const bf16*)(ws + WS_KT) + rowJ * NKT + C::KOFF + h * DK + d0c); } }
#pragma unroll
        for (int J = 0; J < 4; ++J) { if (J <= I) { f32x4 acc = {0.f, 0.f, 0.f, 0.f};
#pragma unroll
            for (int s = 0; s < 2; ++s) { pg8::bf16x8 qop;
                { float xq[8], ej[8]; const int d0 = 32 * s + 8 * g; const int d0c = (d0 < DK) ? d0 : 0;
                    if constexpr (TYPE == 2) {
#pragma unroll
                        for (int j = 0; j < 8; ++j) ej[j] = (float)(16 * (J + 1)) * ret_lg(h); }
                    else { const LAS float* ep = (const LAS float*)(lds + LC_EC) + J * 256 + h * DK + d0c; const f32x4 e0 = *(const LAS f32x4*)ep, e1 = *(const LAS f32x4*)(ep + 4);
#pragma unroll
                        for (int j = 0; j < 4; ++j) { ej[j] = e0[j]; ej[4 + j] = e1[j]; } }
#pragma unroll
                    for (int j = 0; j < 8; ++j) xq[j] = qhf[s][j] * __expf(fminf(refv[s][j] - ej[j], 80.f));
                    qop = pack8(xq); }
                acc = __builtin_amdgcn_mfma_f32_16x16x32_bf16(qop, __builtin_bit_cast(pg8::bf16x8, kf[J][s]), acc, 0, 0, 0); }
#pragma unroll
            for (int q = 0; q < 4; ++q) { const int i = 4 * g + q; const float v = (J < I || r <= i) ? acc[q] : 0.f; AB[i * BP + 16 * J + r] = (bf16)f2bf(v); } } }
        if ((I & 1) == 0) {
#pragma unroll
            for (int q = 0; q < 4; ++q) AB[(4 * g + q) * BP + 16 * (I + 1) + r] = (bf16)0; }
        asm volatile("s_waitcnt lgkmcnt(0)" ::: "memory");
        const pg8::bf16x8 ah0 = *(const LAS pg8::bf16x8*)(AB + r * BP + 8 * g), ah1 = *(const LAS pg8::bf16x8*)(AB + r * BP + 32 + 8 * g);
        f32x4 o[TE];
#pragma unroll
        for (int te = 0; te < TE; ++te) { f32x4 acc = {0.f, 0.f, 0.f, 0.f};
            acc = __builtin_amdgcn_mfma_f32_16x16x32_bf16(qt[0], ldfrag(STh, BP, te * 16, 0, lane), acc, 0, 0, 0);
            acc = __builtin_amdgcn_mfma_f32_16x16x32_bf16(qt[1], ldfrag(STh, BP, te * 16, 32, lane), acc, 0, 0, 0);
            acc = __builtin_amdgcn_mfma_f32_16x16x32_bf16(ah0, ldfrag(VTh, BP, te * 16, 0, lane), acc, 0, 0, 0);
            if (I >= 2) acc = __builtin_amdgcn_mfma_f32_16x16x32_bf16(ah1, ldfrag(VTh, BP, te * 16, 32, lane), acc, 0, 0, 0);
            o[te] = acc; }
        const unsigned long long ts2_ = SUB_MASK ? __builtin_amdgcn_s_memrealtime() : 0ull;
#pragma unroll
        for (int q = 0; q < 4; ++q) { float s1 = 0.f, s2 = 0.f;
#pragma unroll
            for (int te = 0; te < TE; ++te) { s1 += o[te][q]; s2 += o[te][q] * o[te][q]; }
#pragma unroll
            for (int m = 1; m < 16; m <<= 1) { s1 += __shfl_xor(s1, m); s2 += __shfl_xor(s2, m); }
            float mean = 0.f, rstd;
            if constexpr (TYPE == 2) { mean = s1 * (1.0f / DV); rstd = __builtin_amdgcn_rsqf(fmaxf(s2 * (1.0f / DV) - mean * mean, 0.f) + EPS); }
            else rstd = __builtin_amdgcn_rsqf(s2 * (1.0f / DV) + EPS);
#pragma unroll
            for (int te = 0; te < TE; ++te) AB[(4 * g + q) * OBP + te * 16 + r] = (bf16)f2bf((o[te][q] - mean) * rstd); }
        asm volatile("s_waitcnt lgkmcnt(0)" ::: "memory");
#pragma unroll 1
        for (int i = 0; i < NOC; ++i) { const int cidx = lane + 64 * i, orow = cidx / NCHK, ch = cidx - orow * NCHK; const size_t row = (size_t)(row0 + 16 * I + orow);
            const v4u ov = *(const LAS v4u*)(AB + orow * OBP + 8 * ch); const v4u gv = *(const v4u*)(PROJ + row * NPROJ + C::CG + h * DV + 8 * ch);
            const unsigned ow[4] = {ov.x, ov.y, ov.z, ov.w}, gw[4] = {gv.x, gv.y, gv.z, gv.w}; float res[8];
            f32x4 w0 = {1.f, 1.f, 1.f, 1.f}, w1 = {1.f, 1.f, 1.f, 1.f};
            if constexpr (TYPE == 0) { const float* wp = a.gla_norm_w + layer * 384 + h * 96 + 8 * ch; w0 = *(const f32x4*)wp; w1 = *(const f32x4*)(wp + 4); }
            if constexpr (TYPE == 1) { const float* wp = a.hg_norm_w + layer * 256 + h * 64 + 8 * ch; w0 = *(const f32x4*)wp; w1 = *(const f32x4*)(wp + 4); }
#pragma unroll
            for (int j = 0; j < 4; ++j) { const float oa = __builtin_bit_cast(float, ow[j] << 16), ob = __builtin_bit_cast(float, ow[j] & 0xffff0000u), ga = __builtin_bit_cast(float, gw[j] << 16), gb = __builtin_bit_cast(float, gw[j] & 0xffff0000u);
                const float wa = (j < 2) ? w0[2 * j] : w1[2 * j - 4], wb = (j < 2) ? w0[2 * j + 1] : w1[2 * j - 3];
                const float sa = __builtin_amdgcn_rcpf(1.0f + __expf(-ga)), sb = __builtin_amdgcn_rcpf(1.0f + __expf(-gb));
                res[2 * j] = oa * wa * ((TYPE == 1) ? sa : ga * sa); res[2 * j + 1] = ob * wb * ((TYPE == 1) ? sb : gb * sb); }
            if (F8_OUT) { typedef int i32x2 __attribute__((ext_vector_type(2)));
                *(GAS i32x2*)((unsigned char*)MIX + row * D + C::MIXOFF + h * DV + 8 * ch) = (i32x2){pk4_fp8(res[0] * S8_M, res[1] * S8_M, res[2] * S8_M, res[3] * S8_M), pk4_fp8(res[4] * S8_M, res[5] * S8_M, res[6] * S8_M, res[7] * S8_M)}; }
            else { v4u w; w.x = pk2(res[0], res[1]); w.y = pk2(res[2], res[3]); w.z = pk2(res[4], res[5]); w.w = pk2(res[6], res[7]); *(GAS v4u*)(MIX + row * D + C::MIXOFF + h * DV + 8 * ch) = w; } }
        SUBSTRETCH(2, ts2_);
    }
    SUBSTRETCH(1, ts1_);
    __syncthreads();
}
__device__ __forceinline__ void p3c_outputs(const Args& a, int layer, LAS unsigned char* lds, int vcu, int G, int tid, int lane, int wave) {
    for (int unit = vcu; unit < NUNIT; unit += G) {
        mixc_batch<0>(a, layer, unit, lds, tid, lane, wave);
        mixc_batch<1>(a, layer, unit, lds, tid, lane, wave);
        mixc_batch<2>(a, layer, unit, lds, tid, lane, wave);
    }
}


constexpr int MW_ARGS = 800;
__device__ __forceinline__ const void* ld_argp(const volatile LAS unsigned* T, int i) {
    const unsigned lo = __builtin_amdgcn_readfirstlane(T[2 * i]), hi = __builtin_amdgcn_readfirstlane(T[2 * i + 1]);
    return (const void*)(((unsigned long long)hi << 32) | lo);
}
__device__ __forceinline__ Args load_args(LAS unsigned char* lds) {
    const volatile LAS unsigned* T = (const volatile LAS unsigned*)(lds + MISC_OFF) + MW_ARGS;
    Args a;
    a.x = (const float*)ld_argp(T, 0); a.c = (const float*)ld_argp(T, 1); a.pos = (const int*)ld_argp(T, 2); a.w_mod = (const float*)ld_argp(T, 3); a.b_mod = (const float*)ld_argp(T, 4);
    a.norm1_w = (const float*)ld_argp(T, 5); a.w_in = (const float*)ld_argp(T, 6); a.gla_wa2 = (const float*)ld_argp(T, 7); a.gla_ba2 = (const float*)ld_argp(T, 8); a.hg_lb = (const float*)ld_argp(T, 9);
    a.gla_norm_w = (const float*)ld_argp(T, 10); a.hg_norm_w = (const float*)ld_argp(T, 11); a.w_out = (const float*)ld_argp(T, 12); a.norm2_w = (const float*)ld_argp(T, 13); a.w_r = (const float*)ld_argp(T, 14);
    a.b_r = (const float*)ld_argp(T, 15); a.w_gu = (const float*)ld_argp(T, 16); a.b_gu = (const float*)ld_argp(T, 17); a.w_dn = (const float*)ld_argp(T, 18); a.b_dn = (const float*)ld_argp(T, 19);
    a.final_norm_w = (const float*)ld_argp(T, 20); a.out = (float*)ld_argp(T, 21); a.ws = (unsigned char*)ld_argp(T, 22); a.ph_lo = 0; a.ph_hi = 0;
    return a;
}
#define PH_CTX() { unsigned l_ = (unsigned)(size_t)lds; asm volatile("" : "+s"(l_)); lds = (LAS unsigned char*)(size_t)l_; } const Args args = load_args(lds); volatile LAS unsigned* MISC = (volatile LAS unsigned*)(lds + MISC_OFF); int tid_ = wv * 64 + (int)__builtin_amdgcn_mbcnt_hi(~0u, __builtin_amdgcn_mbcnt_lo(~0u, 0u)); asm volatile("" : "+v"(tid_)); const int tid = tid_, lane = tid & 63, wave = __builtin_amdgcn_readfirstlane(tid >> 6); \
    const int G = gridDim.x; const int bx = blockIdx.x; const int vcu = (G % 8 == 0) ? (bx % 8) * (G / 8) + bx / 8 : bx; unsigned char* ws = args.ws; gu32* ctl = (gu32*)(ws + WS_CTL); \
    (void)MISC; (void)lane; (void)wave; (void)vcu; (void)ctl; (void)bx; (void)tid
__device__ __forceinline__ void ph_p0(LAS unsigned char* lds, int wv) { PH_CTX(); p0_prologue(args, lds, vcu, G, tid, lane, wave); }
__device__ __forceinline__ void ph_p1(LAS unsigned char* lds, int wv, int layer_) { int layer = __builtin_amdgcn_readfirstlane(layer_); asm volatile("" : "+s"(layer)); PH_CTX();
    if (layer > 0) { moe_tables(ctl, layer - 1, MISC, tid); const int nrt = __builtin_amdgcn_readfirstlane((int)MISC[MW_NRT]);
        const int done = conv_t2(G) + conv_idle(nrt * 8, G) * NWAVES * CB7 + conv_idle(nrt * 4, G) * NWAVES * CB8; LAS float* scr = (LAS float*)(lds + wave * 16640);
        for (int it = done + vcu * NWAVES + wave; it < IT_LAYER; it += G * NWAVES) convert_item(args, layer, it, scr, lane);
        __syncthreads(); }
    rows_mfma<16>(args, layer, lds, MISC, ctl, vcu, G, tid, lane, wave); }
__device__ __forceinline__ void ph_p2(LAS unsigned char* lds, int wv, int layer_) { int layer = __builtin_amdgcn_readfirstlane(layer_); asm volatile("" : "+s"(layer)); PH_CTX();
    pg8::Gemm g{(const bf16*)(ws + WS_H), (const bf16*)(ws + WS_WIN + (size_t)layer * NPROJ * D * (F8_IN ? 1 : 2)), MTOK, NPROJ, F8_IN ? D / 2 : D}; pg8::StaticOrder S; S.init(MTOK, NPROJ, G, bx);
    pg8::EpiBf16Plain E{(bf16*)(ws + WS_PROJ), NPROJ, F8_IN ? 1.0f / (S8_H * S8_W) : 1.0f};
    pg8::gemm_phase<pg8::EpiBf16Plain, pg8::StaticOrder, true, true, F8_IN>(lds, g, S, E, tid);
    if (layer + 1 < DEPTH && G == 256 && bx >= 64) convert_range(args, layer + 1, ((bx - 64) * NWAVES + wave) * CB2, CB2, lds, lane, wave); }
__device__ __forceinline__ void ph_p3a(LAS unsigned char* lds, int wv, int layer_) { int layer = __builtin_amdgcn_readfirstlane(layer_); asm volatile("" : "+s"(layer)); PH_CTX(); p3a_summaries(args, layer, lds, vcu, G, tid, lane, wave); }
__device__ __forceinline__ void ph_p3b(LAS unsigned char* lds, int wv) { PH_CTX(); p3b_scan(args, vcu, G, tid); }
__device__ __forceinline__ void ph_p3c(LAS unsigned char* lds, int wv, int layer_) { int layer = __builtin_amdgcn_readfirstlane(layer_); asm volatile("" : "+s"(layer)); PH_CTX(); p3c_outputs(args, layer, lds, vcu, G, tid, lane, wave); }
__device__ __forceinline__ void ph_p4(LAS unsigned char* lds, int wv, int layer_) { int layer = __builtin_amdgcn_readfirstlane(layer_); asm volatile("" : "+s"(layer)); PH_CTX();
    pg8::Gemm g{(const bf16*)(ws + WS_MIX), (const bf16*)(ws + WS_WOUT + (size_t)layer * D * D * (F8_OUT ? 1 : 2)), MTOK, D, F8_OUT ? D / 2 : D}; pg8::StaticOrder S; S.init(MTOK, D, G, bx);
    pg8::EpiResGate E{(const bf16*)(ws + WS_X), (bf16*)(ws + WS_X), D, (const float*)(ws + WS_MOD) + (size_t)layer * 2 * 6144 + 2 * D, 6144, SEQ, F8_OUT ? 1.0f / (S8_M * S8_W) : 1.0f};
    pg8::gemm_phase<pg8::EpiResGate, pg8::StaticOrder, true, true, F8_OUT>(lds, g, S, E, tid); }
__device__ __forceinline__ void ph_p5(LAS unsigned char* lds, int wv, int layer_) { int layer = __builtin_amdgcn_readfirstlane(layer_); asm volatile("" : "+s"(layer)); PH_CTX(); rows_mfma<32>(args, layer, lds, MISC, ctl, vcu, G, tid, lane, wave); }
__device__ __forceinline__ void ph_p7(LAS unsigned char* lds, int wv, int layer_) { int layer = __builtin_amdgcn_readfirstlane(layer_); asm volatile("" : "+s"(layer)); PH_CTX();
    moe_tables(ctl, layer, MISC, tid);
    const int nrt = __builtin_amdgcn_readfirstlane((int)MISC[MW_NRT]);
    pg8::Gemm g{(const bf16*)(ws + WS_A1), (const bf16*)(ws + WS_WGU + (size_t)layer * NE * 2048 * D), nrt * 256, NE * 2048, D / 2};
    pg8::MoeOrder S{8, G, vcu, nrt * 8, (const LAS int*)(lds + MISC_OFF + 4 * MW_TILE)};
    pg8::EpiSwiglu E{ws + WS_ACT, FFN, args.b_gu + (size_t)layer * NE * 2048, 1.0f / (S8_H * S8_W), S8_A};
    pg8::gemm_phase<pg8::EpiSwiglu, pg8::MoeOrder, true, true, true>(lds, g, S, E, tid);
    { const int rem = (nrt * 8) % G; if (layer + 1 < DEPTH && rem != 0 && vcu >= rem) convert_range(args, layer + 1, conv_t2(G) + ((vcu - rem) * NWAVES + wave) * CB7, CB7, lds, lane, wave); } }
__device__ __forceinline__ void ph_p8(LAS unsigned char* lds, int wv, int layer_) { int layer = __builtin_amdgcn_readfirstlane(layer_); asm volatile("" : "+s"(layer)); PH_CTX();
    moe_tables(ctl, layer, MISC, tid);
    const int nrt = __builtin_amdgcn_readfirstlane((int)MISC[MW_NRT]);
    pg8::Gemm g{(const bf16*)(ws + WS_ACT), (const bf16*)(ws + WS_WDN + (size_t)layer * NE * D * FFN), nrt * 256, NE * D, FFN / 2};
    pg8::MoeOrder S{4, G, vcu, nrt * 4, (const LAS int*)(lds + MISC_OFF + 4 * MW_TILE)};
    if constexpr (Y8) { pg8::EpiFp8Bias E{ws + WS_Y, D, args.b_dn + (size_t)layer * NE * D, D, 1.0f / (S8_A * S8_W), S8_Y};
        pg8::gemm_phase<pg8::EpiFp8Bias, pg8::MoeOrder, true, true, true>(lds, g, S, E, tid); }
    else { pg8::EpiBf16Bias E{(bf16*)(ws + WS_Y), D, args.b_dn + (size_t)layer * NE * D, D, 1.0f / (S8_A * S8_W)};
        pg8::gemm_phase<pg8::EpiBf16Bias, pg8::MoeOrder, true, true, true>(lds, g, S, E, tid); }
    { const int rem = (nrt * 4) % G; if (layer + 1 < DEPTH && rem != 0 && vcu >= rem) convert_range(args, layer + 1, conv_t2(G) + conv_idle(nrt * 8, G) * NWAVES * CB7 + ((vcu - rem) * NWAVES + wave) * CB8, CB8, lds, lane, wave); } }
__device__ __forceinline__ void ph_final(LAS unsigned char* lds, int wv) { PH_CTX(); final_rows(args, lds, vcu, G, tid, lane); }

#ifndef DBL_MASK
#define DBL_MASK 0
#endif
#if DBL_MASK
#define RUN(bit, call) do { if ((DBL_MASK >> (bit)) & 1) { const unsigned long long t0_ = __builtin_amdgcn_s_memrealtime(); call; const unsigned long long t1_ = __builtin_amdgcn_s_memrealtime(); \
        while (__builtin_amdgcn_s_memrealtime() - t1_ < t1_ - t0_) __builtin_amdgcn_s_sleep(8); } else { call; } } while (0)
#else
#define RUN(bit, call) do { call; } while (0)
#endif
__global__ void __launch_bounds__(NTHR, 2) hybrid_fwd(Args args) {
    extern __shared__ __attribute__((aligned(16))) unsigned char lds_raw[];
    LAS unsigned char* lds = (LAS unsigned char*)lds_raw;
    volatile LAS unsigned* MISC = (volatile LAS unsigned*)(lds + MISC_OFF);
    const int tid = threadIdx.x; const int wv = __builtin_amdgcn_readfirstlane(tid >> 6);
    gu32* ctl = (gu32*)(args.ws + WS_CTL);
    for (int u = tid; u < (LDS_BYTES - MISC_OFF) / 4; u += NTHR) MISC[u] = 0u;
    __syncthreads();
    if (tid == 0) {
#define ST_ARG(i, p) do { const unsigned long long v_ = (unsigned long long)(p); MISC[MW_ARGS + 2 * (i)] = (unsigned)v_; MISC[MW_ARGS + 2 * (i) + 1] = (unsigned)(v_ >> 32); } while (0)
        ST_ARG(0, args.x); ST_ARG(1, args.c); ST_ARG(2, args.pos); ST_ARG(3, args.w_mod); ST_ARG(4, args.b_mod); ST_ARG(5, args.norm1_w); ST_ARG(6, args.w_in); ST_ARG(7, args.gla_wa2); ST_ARG(8, args.gla_ba2);
        ST_ARG(9, args.hg_lb); ST_ARG(10, args.gla_norm_w); ST_ARG(11, args.hg_norm_w); ST_ARG(12, args.w_out); ST_ARG(13, args.norm2_w); ST_ARG(14, args.w_r); ST_ARG(15, args.b_r); ST_ARG(16, args.w_gu);
        ST_ARG(17, args.b_gu); ST_ARG(18, args.w_dn); ST_ARG(19, args.b_dn); ST_ARG(20, args.final_norm_w); ST_ARG(21, args.out); ST_ARG(22, args.ws);
#undef ST_ARG
    }
    __syncthreads();
    const int lo = args.ph_lo, hi = args.ph_hi;
    const bool multi = (hi - lo) > 1;
    XcdBarrier bar; bar.bar = (unsigned*)(ctl + CW_BAR); bar.x = 0; bar.st = nullptr;
    if (multi) bar = xcd_barrier_post((unsigned*)(ctl + CW_BAR), MISC + MW_BAR);
#define IN(k) (lo <= (k) && (k) < hi)
#define SEAM(k) do { if (IN(k) && IN((k) + 1)) xcd_barrier(bar); } while (0)

    if (IN(0)) RUN(0, ph_p0(lds, wv));
    SEAM(0);
    for (int layer = 0; layer < DEPTH; ++layer) {
        const int pb = 1 + 9 * layer;
        if (IN(pb + 0)) RUN(1, ph_p1(lds, wv, layer));
        SEAM(pb + 0);
        if (IN(pb + 1)) RUN(2, ph_p2(lds, wv, layer));
        SEAM(pb + 1);
        if (IN(pb + 2)) RUN(3, ph_p3a(lds, wv, layer));
        SEAM(pb + 2);
        if (IN(pb + 3)) RUN(4, ph_p3b(lds, wv));
        SEAM(pb + 3);
        if (IN(pb + 4)) RUN(5, ph_p3c(lds, wv, layer));
        SEAM(pb + 4);
        if (IN(pb + 5)) RUN(6, ph_p4(lds, wv, layer));
        SEAM(pb + 5);
        if (IN(pb + 6)) RUN(7, ph_p5(lds, wv, layer));
        SEAM(pb + 6);
        if (IN(pb + 7)) RUN(9, ph_p7(lds, wv, layer));
        SEAM(pb + 7);
        if (IN(pb + 8)) RUN(10, ph_p8(lds, wv, layer));
        SEAM(pb + 8);
    }
    if (IN(NPHASE - 1)) RUN(11, ph_final(lds, wv));
#undef IN
#undef SEAM
}

#ifndef MK_SINGLE
#define MK_SINGLE 1
#endif
extern "C" void kernel_launch(void* const* d_in, const int* in_sizes, int n_in, void* d_out, int out_size, void* d_ws, size_t ws_size, hipStream_t stream) {
    static int grid = 0;
    if (grid == 0) {
        if (n_in != 21 || in_sizes[0] != MTOK * D || out_size != MTOK * D || ws_size < WS_END) { fprintf(stderr, "kernel_launch: unexpected problem shape (n_in %d, in0 %d, out %d, ws %zu)\n", n_in, n_in > 0 ? in_sizes[0] : -1, out_size, ws_size); grid = -1; return; }
        int dev = 0, cus = 0, per_cu = 0;
        if (hipGetDevice(&dev) != hipSuccess || hipDeviceGetAttribute(&cus, hipDeviceAttributeMultiprocessorCount, dev) != hipSuccess) { grid = -1; return; }
        if (hipFuncSetAttribute((const void*)hybrid_fwd, hipFuncAttributeMaxDynamicSharedMemorySize, LDS_BYTES) != hipSuccess) { fprintf(stderr, "kernel_launch: hipFuncSetAttribute failed\n"); grid = -1; return; }
        if (hipOccupancyMaxActiveBlocksPerMultiprocessor(&per_cu, (const void*)hybrid_fwd, NTHR, LDS_BYTES) != hipSuccess || per_cu < 1) fprintf(stderr, "kernel_launch: occupancy query says %d\n", per_cu);
        (void)hipGetLastError();
        grid = cus;
    }
    if (grid < 0) return;
    (void)hipMemsetAsync((char*)d_ws + WS_CTL, 0, CTL_ZERO_BYTES, stream);
    Args a{};
    a.x = (const float*)d_in[0]; a.c = (const float*)d_in[1]; a.pos = (const int*)d_in[2]; a.w_mod = (const float*)d_in[3]; a.b_mod = (const float*)d_in[4]; a.norm1_w = (const float*)d_in[5];
    a.w_in = (const float*)d_in[6]; a.gla_wa2 = (const float*)d_in[7]; a.gla_ba2 = (const float*)d_in[8]; a.hg_lb = (const float*)d_in[9]; a.gla_norm_w = (const float*)d_in[10]; a.hg_norm_w = (const float*)d_in[11];
    a.w_out = (const float*)d_in[12]; a.norm2_w = (const float*)d_in[13]; a.w_r = (const float*)d_in[14]; a.b_r = (const float*)d_in[15]; a.w_gu = (const float*)d_in[16]; a.b_gu = (const float*)d_in[17];
    a.w_dn = (const float*)d_in[18]; a.b_dn = (const float*)d_in[19]; a.final_norm_w = (const float*)d_in[20]; a.out = (float*)d_out; a.ws = (unsigned char*)d_ws;
#if MK_SINGLE
    a.ph_lo = 0; a.ph_hi = NPHASE;
    hipLaunchKernelGGL(hybrid_fwd, dim3(grid), dim3(NTHR), LDS_BYTES, stream, a);
#else
    for (int p = 0; p < NPHASE; ++p) { a.ph_lo = p; a.ph_hi = p + 1; hipLaunchKernelGGL(hybrid_fwd, dim3(grid), dim3(NTHR), LDS_BYTES, stream, a); }
#endif
}
```

```cpp
#include <hip/hip_runtime.h>
#include <cstdio>
#include <cstdint>
namespace pg8 {
#define PG8_LAS __attribute__((address_space(3)))
typedef unsigned short bf16_t;
typedef short bf16x8 __attribute__((ext_vector_type(8)));
typedef float f32x4 __attribute__((ext_vector_type(4)));
typedef unsigned u32x4 __attribute__((ext_vector_type(4)));
constexpr int BM = 256, BK = 64, HALF = 128, HTB = HALF * BK * 2  , STAGE_BYTES = 8 * HTB, NXCD = 8, WGM = 8;

__host__ __device__ __forceinline__ int lds_byte(int r, int c) { const int st = (r >> 4) * 2 + (c >> 5), rr = r & 15, cc = c & 31, ob = rr * 64 + cc * 2; return st * 1024 + (ob ^ (((ob >> 9) & 1) << 5)); }
__host__ __device__ __forceinline__ void stage_rc(int b, int& R, int& C) { const int st = b / 1024, sb = b % 1024, swz = sb ^ (((sb >> 9) & 1) << 5); R = (st >> 1) * 16 + swz / 64; C = (st & 1) * 32 + (swz % 64) / 2; }
__host__ __device__ __forceinline__ int perm32(int rho) { const int n = rho >> 4, i = rho & 15; return 8 * (i >> 2) + 4 * n + (i & 3); }

struct Unit { int pm, pn, e, pl; };
struct Gemm { const bf16_t* A; const bf16_t* Bt; int M, N, K; };

struct StaticOrder {
    int nM, nN, nwg, G, c;
    __host__ __device__ void init(int M, int N, int G_, int c_) { nM = M / BM; nN = N / BM; nwg = nM * nN; G = G_; c = c_; }
    __host__ __device__ bool next(int i, Unit& u) const {
        const long L = (long)i * G + c; if (L >= nwg) return false;
        int wgid = (int)L; { const int q = nwg / NXCD, r = nwg % NXCD, xcd = wgid % NXCD, off = wgid / NXCD; wgid = (xcd < r ? xcd * (q + 1) : r * (q + 1) + (xcd - r) * q) + off; }
        const int nig = WGM * nN, gid = wgid / nig, fm = gid * WGM, gsz = (nM - fm) < WGM ? (nM - fm) : WGM;
        u.pm = fm + ((wgid % nig) % gsz); u.pn = (wgid % nig) / gsz; u.e = 0; u.pl = u.pn; return true;
    }
    __device__ __forceinline__ void a_ready(const Unit&) const {}
    __device__ __forceinline__ void done(const Unit&) const {}
};

__device__ __forceinline__ unsigned cvt_pk_bf16(float lo, float hi) { unsigned r; asm volatile("v_cvt_pk_bf16_f32 %0, %1, %2" : "=v"(r) : "v"(lo), "v"(hi)); return r; }

#define PG8_GAS __attribute__((address_space(1)))
struct NoPre {};
struct EpiBf16Plain {
    static constexpr bool PERM = true, AFTER_DRAIN = false; static constexpr int NST = 0; typedef NoPre Pre;
    __device__ __forceinline__ Pre prefetch(const Unit&, int, int) const { return Pre{}; }
    bf16_t* O; int ldc; float sc;
    __device__ __forceinline__ void operator()(const f32x4 (&acc)[2][2][4][2], const Unit& u, int wr, int wc, int fr, int fq, const Pre&) const {
        const int row0 = u.pm * BM + wr * 64 + fr; const int col0 = u.pn * BM + wc * 32 + 8 * fq;
#pragma unroll
        for (int ai = 0; ai < 2; ++ai)
#pragma unroll
            for (int m = 0; m < 4; ++m) { bf16_t* rowp = O + (size_t)(row0 + ai * HALF + m * 16) * ldc + col0;
#pragma unroll
                for (int bj = 0; bj < 2; ++bj) { const f32x4 v0 = acc[ai][bj][m][0] * sc, v1 = acc[ai][bj][m][1] * sc;
                    u32x4 w; w.x = cvt_pk_bf16(v0[0], v0[1]); w.y = cvt_pk_bf16(v0[2], v0[3]); w.z = cvt_pk_bf16(v1[0], v1[1]); w.w = cvt_pk_bf16(v1[2], v1[3]);
                    *(PG8_GAS u32x4*)(rowp + bj * HALF) = w; } }
    }
};
struct EpiResGate {
    static constexpr bool PERM = true, AFTER_DRAIN = false; static constexpr int NST = 0; typedef NoPre Pre;
    __device__ __forceinline__ Pre prefetch(const Unit&, int, int) const { return Pre{}; }
    const bf16_t* base; bf16_t* out; int ldc; const float* gate; int gpitch; int rows_per_batch; float sc;
    __device__ __forceinline__ void operator()(const f32x4 (&acc)[2][2][4][2], const Unit& u, int wr, int wc, int fr, int fq, const Pre&) const {
        const int row0 = u.pm * BM + wr * 64 + fr, col0 = u.pn * BM + wc * 32 + 8 * fq;
        const float* gp = gate + (size_t)((u.pm * BM) / rows_per_batch) * gpitch + col0;
        f32x4 gv[2][2];
#pragma unroll
        for (int bj = 0; bj < 2; ++bj)
#pragma unroll
            for (int n = 0; n < 2; ++n) gv[bj][n] = *(const PG8_GAS f32x4*)(gp + bj * HALF + 4 * n) * sc;
#pragma unroll
        for (int ai = 0; ai < 2; ++ai)
#pragma unroll
            for (int m = 0; m < 4; ++m) { const size_t off = (size_t)(row0 + ai * HALF + m * 16) * ldc + col0;
#pragma unroll
                for (int bj = 0; bj < 2; ++bj) { const u32x4 bs = *(const PG8_GAS u32x4*)(base + off + bj * HALF); const unsigned bw[4] = {bs.x, bs.y, bs.z, bs.w}; float r[8];
#pragma unroll
                    for (int j = 0; j < 4; ++j) { const f32x4& a4 = acc[ai][bj][m][j >> 1]; const f32x4& g4 = gv[bj][j >> 1];
                        r[2 * j] = __builtin_bit_cast(float, bw[j] << 16) + g4[2 * (j & 1)] * a4[2 * (j & 1)]; r[2 * j + 1] = __builtin_bit_cast(float, bw[j] & 0xffff0000u) + g4[2 * (j & 1) + 1] * a4[2 * (j & 1) + 1]; }
                    u32x4 w; w.x = cvt_pk_bf16(r[0], r[1]); w.y = cvt_pk_bf16(r[2], r[3]); w.z = cvt_pk_bf16(r[4], r[5]); w.w = cvt_pk_bf16(r[6], r[7]);
                    *(PG8_GAS u32x4*)(out + off + bj * HALF) = w; }
                asm volatile("" ::: "memory"); }
    }
};
struct EpiSwiglu {
    static constexpr bool PERM = true, AFTER_DRAIN = false; static constexpr int NST = 0; struct Pre { f32x4 bg[2], bu[2]; };
    __device__ __forceinline__ Pre prefetch(const Unit& u, int wc, int fq) const { typedef const __attribute__((address_space(1))) f32x4 gf4;
        const float* bp = bias + (size_t)u.e * 2048 + u.pl * HALF + wc * 32 + 8 * fq; Pre p; p.bg[0] = *(gf4*)bp; p.bg[1] = *(gf4*)(bp + 4); p.bu[0] = *(gf4*)(bp + 1024); p.bu[1] = *(gf4*)(bp + 1028); return p; }
    unsigned char* O; int ldc; const float* bias; float inv_in, out_scale;
    __device__ __forceinline__ float act1(float g, float up) const {
        g = fminf(g, 7.0f); up = fminf(fmaxf(up, -7.0f), 7.0f);
        const float s = __builtin_amdgcn_rcpf(1.0f + __builtin_amdgcn_exp2f(-1.702f * 1.4426950408889634f * g));
        return (up + 1.0f) * g * s * out_scale;
    }
    __device__ __forceinline__ void operator()(const f32x4 (&acc)[2][2][4][2], const Unit& u, int wr, int wc, int fr, int fq, const Pre& pre) const {
        const int row0 = u.pm * BM + wr * 64 + fr; const int jj0 = wc * 32 + 8 * fq; const int col0 = u.pl * HALF + jj0;
        const f32x4 bg[2] = {pre.bg[0], pre.bg[1]}, bu[2] = {pre.bu[0], pre.bu[1]};
#pragma unroll
        for (int ai = 0; ai < 2; ++ai)
#pragma unroll
            for (int m = 0; m < 4; ++m) { unsigned char* rowp = O + (size_t)(row0 + ai * HALF + m * 16) * ldc + col0;
                f32x4 r[2];
#pragma unroll
                for (int n = 0; n < 2; ++n) { const f32x4 g = acc[ai][0][m][n] * inv_in + bg[n], up = acc[ai][1][m][n] * inv_in + bu[n];
#pragma unroll
                    for (int j = 0; j < 4; ++j) r[n][j] = act1(g[j], up[j]); }
                int w0 = 0, w1 = 0;
                w0 = __builtin_amdgcn_cvt_pk_fp8_f32(r[0][0], r[0][1], w0, false); w0 = __builtin_amdgcn_cvt_pk_fp8_f32(r[0][2], r[0][3], w0, true);
                w1 = __builtin_amdgcn_cvt_pk_fp8_f32(r[1][0], r[1][1], w1, false); w1 = __builtin_amdgcn_cvt_pk_fp8_f32(r[1][2], r[1][3], w1, true);
                typedef int i32x2 __attribute__((ext_vector_type(2))); *(PG8_GAS i32x2*)rowp = (i32x2){w0, w1}; }
    }
};
struct EpiBf16Bias {
    static constexpr bool PERM = true, AFTER_DRAIN = false; static constexpr int NST = 0; typedef NoPre Pre;
    __device__ __forceinline__ Pre prefetch(const Unit&, int, int) const { return Pre{}; }
    bf16_t* O; int ldc; const float* bias; int bpitch; float inv_in;
    __device__ __forceinline__ void operator()(const f32x4 (&acc)[2][2][4][2], const Unit& u, int wr, int wc, int fr, int fq, const Pre&) const {
        const int row0 = u.pm * BM + wr * 64 + fr; const int col0 = u.pl * BM + wc * 32 + 8 * fq;
        const float* bp = bias + (size_t)u.e * bpitch + col0;
        f32x4 bv[2][2];
#pragma unroll
        for (int bj = 0; bj < 2; ++bj)
#pragma unroll
            for (int n = 0; n < 2; ++n) bv[bj][n] = *(const PG8_GAS f32x4*)(bp + bj * HALF + 4 * n);
#pragma unroll
        for (int ai = 0; ai < 2; ++ai)
#pragma unroll
            for (int m = 0; m < 4; ++m) { bf16_t* rowp = O + (size_t)(row0 + ai * HALF + m * 16) * ldc + col0;
#pragma unroll
                for (int bj = 0; bj < 2; ++bj) { const f32x4 v0 = acc[ai][bj][m][0] * inv_in + bv[bj][0], v1 = acc[ai][bj][m][1] * inv_in + bv[bj][1];
                    u32x4 w; w.x = cvt_pk_bf16(v0[0], v0[1]); w.y = cvt_pk_bf16(v0[2], v0[3]); w.z = cvt_pk_bf16(v1[0], v1[1]); w.w = cvt_pk_bf16(v1[2], v1[3]);
                    *(PG8_GAS u32x4*)(rowp + bj * HALF) = w; } }
    }
};
struct EpiFp8Bias {
    static constexpr bool PERM = true, AFTER_DRAIN = false; static constexpr int NST = 0; struct Pre { f32x4 bv[2][2]; };
    __device__ __forceinline__ Pre prefetch(const Unit& u, int wc, int fq) const { typedef const __attribute__((address_space(1))) f32x4 gf4;
        const float* bp = bias + (size_t)u.e * bpitch + u.pl * BM + wc * 32 + 8 * fq; Pre p; p.bv[0][0] = *(gf4*)bp; p.bv[0][1] = *(gf4*)(bp + 4); p.bv[1][0] = *(gf4*)(bp + HALF); p.bv[1][1] = *(gf4*)(bp + HALF + 4); return p; }
    unsigned char* O; int ldc; const float* bias; int bpitch; float inv_in, out_scale;
    __device__ __forceinline__ int pk4(f32x4 v) const { int w = 0; w = __builtin_amdgcn_cvt_pk_fp8_f32(__builtin_amdgcn_fmed3f(v[0], -448.f, 448.f), __builtin_amdgcn_fmed3f(v[1], -448.f, 448.f), w, false);
        return __builtin_amdgcn_cvt_pk_fp8_f32(__builtin_amdgcn_fmed3f(v[2], -448.f, 448.f), __builtin_amdgcn_fmed3f(v[3], -448.f, 448.f), w, true); }
    __device__ __forceinline__ void operator()(const f32x4 (&acc)[2][2][4][2], const Unit& u, int wr, int wc, int fr, int fq, const Pre& pre) const {
        const int row0 = u.pm * BM + wr * 64 + fr; const int col0 = u.pl * BM + wc * 32 + 8 * fq;
        const f32x4 bv[2][2] = {{pre.bv[0][0], pre.bv[0][1]}, {pre.bv[1][0], pre.bv[1][1]}};
#pragma unroll
        for (int ai = 0; ai < 2; ++ai)
#pragma unroll
            for (int m = 0; m < 4; ++m) { unsigned char* rowp = O + (size_t)(row0 + ai * HALF + m * 16) * ldc + col0;
#pragma unroll
                for (int bj = 0; bj < 2; ++bj) { const f32x4 v0 = (acc[ai][bj][m][0] * inv_in + bv[bj][0]) * out_scale, v1 = (acc[ai][bj][m][1] * inv_in + bv[bj][1]) * out_scale;
                    typedef int i32x2 __attribute__((ext_vector_type(2))); *(PG8_GAS i32x2*)(rowp + bj * HALF) = (i32x2){pk4(v0), pk4(v1)}; } }
    }
};
struct MoeOrder {
    int nN, G, c, nunits; const PG8_LAS int* tile_pm;
    __device__ __forceinline__ bool next(int i, Unit& u) const {
        const int L = i * G + c; if (L >= nunits) return false;
        const int idx = L / nN, pl = L - idx * nN, pm = __builtin_amdgcn_readfirstlane(tile_pm[idx]), e = pm >> 6;
        u.pm = pm; u.pl = pl; u.e = e; u.pn = e * nN + pl; return true;
    }
    __device__ __forceinline__ void a_ready(const Unit&) const {}
    __device__ __forceinline__ void done(const Unit&) const {}
};
typedef int v4i32_t __attribute__((ext_vector_type(4)));
typedef int v8i32_t __attribute__((ext_vector_type(8)));
template <class Epi, class Sched, bool ALIGN_EPI = false, bool SP2 = false, bool FP8 = false>
__device__ __forceinline__ void gemm_phase(PG8_LAS unsigned char* lds, const Gemm g, const Sched& S, const Epi& E, int tid_in) {
    int tid_ = tid_in; asm volatile("" : "+v"(tid_)); const int tid = tid_, wid = __builtin_amdgcn_readfirstlane(tid >> 6), lane = tid & 63, wr = wid >> 2, wc = wid & 3, fr = lane & 15, fq = lane >> 4;
    const int K = g.K, nt = K / BK;
    unsigned voffA, voffB;
    { int R, C; stage_rc(tid * 16, R, C); const int Rb = Epi::PERM ? ((R & ~31) + perm32(R & 31)) : R;
        voffA = (unsigned)(R * K + C) * 2u; voffB = (unsigned)(Rb * K + C) * 2u; }
    const size_t rstep = (size_t)64 * K * 2;
    const size_t kstep = (size_t)(BK * 2);
    const size_t hstep = (size_t)HALF * K * 2;
    const size_t tstep = 2 * hstep;
    const unsigned ldsw = (unsigned)wid * 1024u;
    const int aoff = lds_byte(wr * 64 + fr, fq * 8), boff = lds_byte(wc * 32 + fr, fq * 8);
#define PG8_SA(b, h) (((b) * 2 + (h)) * HTB)
#define PG8_SB(b, h) ((4 + (b) * 2 + (h)) * HTB)
#define PG8_STAGE(bufoff, gbase, voff) do { _Pragma("unroll") for (int _i = 0; _i < 2; ++_i) \
        __builtin_amdgcn_global_load_lds((const unsigned*)((const char*)(gbase) + _i * rstep + (voff)), (PG8_LAS unsigned*)(lds + (bufoff) + ldsw + _i * 8192), 16, 0, 0); } while (0)
#define PG8_LDA(dst, b, h) do { _Pragma("unroll") for (int m = 0; m < 4; ++m) _Pragma("unroll") for (int k = 0; k < 2; ++k) dst[m][k] = *(const PG8_LAS bf16x8*)(lds + PG8_SA(b, h) + aoff + m * 2048 + k * 1024); } while (0)
#define PG8_LDB(dst, b, h) do { _Pragma("unroll") for (int n = 0; n < 2; ++n) _Pragma("unroll") for (int k = 0; k < 2; ++k) dst[n][k] = *(const PG8_LAS bf16x8*)(lds + PG8_SB(b, h) + boff + n * 2048 + k * 1024); } while (0)
#define PG8_MMA(ai, bj, At, Bt) do { __builtin_amdgcn_s_setprio(1); _Pragma("unroll") for (int m = 0; m < 4; ++m) _Pragma("unroll") for (int n = 0; n < 2; ++n) { \
        if constexpr (FP8) { const v8i32_t a8_ = __builtin_shufflevector(__builtin_bit_cast(v4i32_t, At[m][0]), __builtin_bit_cast(v4i32_t, At[m][1]), 0, 1, 2, 3, 4, 5, 6, 7); \
            const v8i32_t b8_ = __builtin_shufflevector(__builtin_bit_cast(v4i32_t, Bt[n][0]), __builtin_bit_cast(v4i32_t, Bt[n][1]), 0, 1, 2, 3, 4, 5, 6, 7); \
            asm volatile("v_mfma_scale_f32_16x16x128_f8f6f4 %0, %1, %2, %0, %3, %3 op_sel_hi:[0,0,0]" : "+v"(acc[ai][bj][m][n]) : "v"(b8_), "v"(a8_), "v"(one8_)); } \
        else { _Pragma("unroll") for (int k = 0; k < 2; ++k) acc[ai][bj][m][n] = __builtin_amdgcn_mfma_f32_16x16x32_bf16(Bt[n][k], At[m][k], acc[ai][bj][m][n], 0, 0, 0); } } \
        __builtin_amdgcn_s_setprio(0); } while (0)
#define PG8_WAIT_V(n) asm volatile("s_waitcnt vmcnt(" #n ")" ::: "memory")
#define PG8_WAIT_L(n) asm volatile("s_waitcnt lgkmcnt(" #n ")" ::: "memory")
#define PG8_WAIT_V8R(relax) do { if (relax) { if constexpr (Epi::NST == 8) PG8_WAIT_V(16); else if constexpr (Epi::NST == 16) PG8_WAIT_V(24); else PG8_WAIT_V(8); } else PG8_WAIT_V(8); } while (0)
#define PG8_BAR __builtin_amdgcn_s_barrier()
#define PG8_SCHED __builtin_amdgcn_sched_barrier(0)
    Unit cur, nxt; int ui = 0;
    if (!S.next(0, cur)) return;
    f32x4 acc[2][2][4][2];
#pragma unroll
    for (int a = 0; a < 2; ++a)
#pragma unroll
        for (int b = 0; b < 2; ++b)
#pragma unroll
            for (int m = 0; m < 4; ++m)
#pragma unroll
                for (int n = 0; n < 2; ++n) acc[a][b][m][n] = (f32x4){0.f, 0.f, 0.f, 0.f};
    bf16x8 At[4][2], B0[2][2], B1[2][2];
    int one8_ = 0x7f7f7f7f; asm volatile("" : "+v"(one8_));
    const char* cA = (const char*)g.A + (size_t)cur.pm * tstep; const char* cB = (const char*)g.Bt + (size_t)cur.pn * tstep;
    S.a_ready(cur);
    if constexpr (SP2) {
        PG8_STAGE(PG8_SB(0, 0), cB, voffB); PG8_STAGE(PG8_SB(0, 1), cB + hstep, voffB); PG8_STAGE(PG8_SA(0, 0), cA, voffA); PG8_STAGE(PG8_SA(0, 1), cA + hstep, voffA);
        if (wr == 1) PG8_BAR;
        PG8_WAIT_V(2); PG8_BAR;
        PG8_STAGE(PG8_SB(1, 0), cB + kstep, voffB); PG8_STAGE(PG8_SA(1, 0), cA + kstep, voffA); PG8_STAGE(PG8_SB(1, 1), cB + hstep + kstep, voffB);
        PG8_WAIT_V(6); PG8_BAR;
    } else {
        PG8_STAGE(PG8_SB(0, 0), cB, voffB); PG8_STAGE(PG8_SA(0, 0), cA, voffA); PG8_STAGE(PG8_SB(0, 1), cB + hstep, voffB); PG8_STAGE(PG8_SA(0, 1), cA + hstep, voffA);
        if (wr == 1) PG8_BAR;
        PG8_WAIT_V(4); PG8_BAR;
        PG8_STAGE(PG8_SB(1, 0), cB + kstep, voffB); PG8_STAGE(PG8_SA(1, 0), cA + kstep, voffA); PG8_STAGE(PG8_SB(1, 1), cB + hstep + kstep, voffB);
        PG8_WAIT_V(6); PG8_BAR;
    }
    for (;;) {
        const bool has_next = S.next(ui + 1, nxt);
        typename Epi::Pre pre_; { int lp_ = (int)__builtin_amdgcn_mbcnt_hi(~0u, __builtin_amdgcn_mbcnt_lo(~0u, 0u)); asm volatile("" : "+v"(lp_)); pre_ = E.prefetch(cur, wc, lp_ >> 4); }
        const char* nA = has_next ? (const char*)g.A + (size_t)nxt.pm * tstep : cA; const char* nB = has_next ? (const char*)g.Bt + (size_t)nxt.pn * tstep : cB;
#pragma unroll 1
        for (int t = 0; t < nt; t += 2) {
            const bool last = (t == nt - 2);
            const char* a1 = cA + (size_t)(t + 1) * kstep;
            const char* a2 = last ? nA : cA + (size_t)(t + 2) * kstep; const char* b2 = last ? nB : cB + (size_t)(t + 2) * kstep;
            const char* a3 = a2 + kstep; const char* b3 = b2 + kstep;
            if (last && has_next) S.a_ready(nxt);
            const bool relax = (Epi::NST > 0) && (ui > 0) && (t == 0);
            if constexpr (SP2) {
            PG8_LDB(B0, 0, 0); PG8_LDB(B1, 0, 1); PG8_SCHED; PG8_LDA(At, 0, 0); PG8_STAGE(PG8_SA(1, 1), a1 + hstep, voffA);
            PG8_WAIT_V8R(relax); PG8_WAIT_L(0); PG8_BAR; PG8_MMA(0, 0, At, B0); PG8_MMA(0, 1, At, B1); PG8_BAR; PG8_SCHED;
            PG8_LDA(At, 0, 1); PG8_STAGE(PG8_SB(0, 0), b2, voffB); PG8_STAGE(PG8_SB(0, 1), b2 + hstep, voffB); PG8_STAGE(PG8_SA(0, 0), a2, voffA);
            PG8_WAIT_V8R(relax); PG8_WAIT_L(0); PG8_BAR; PG8_MMA(1, 0, At, B0); PG8_MMA(1, 1, At, B1); PG8_BAR; PG8_SCHED;
            PG8_LDB(B0, 1, 0); PG8_LDB(B1, 1, 1); PG8_SCHED; PG8_LDA(At, 1, 0); PG8_STAGE(PG8_SA(0, 1), a2 + hstep, voffA);
            PG8_WAIT_V(8); PG8_WAIT_L(0); PG8_BAR; PG8_MMA(0, 0, At, B0); PG8_MMA(0, 1, At, B1); PG8_BAR; PG8_SCHED;
            PG8_LDA(At, 1, 1); PG8_STAGE(PG8_SB(1, 0), b3, voffB); PG8_STAGE(PG8_SB(1, 1), b3 + hstep, voffB); PG8_STAGE(PG8_SA(1, 0), a3, voffA);
            PG8_WAIT_V(8); PG8_WAIT_L(0); PG8_BAR; PG8_MMA(1, 0, At, B0); PG8_MMA(1, 1, At, B1); PG8_BAR; PG8_SCHED;
            } else {
            PG8_LDB(B0, 0, 0); PG8_SCHED; PG8_LDA(At, 0, 0); PG8_STAGE(PG8_SA(1, 1), a1 + hstep, voffA);
            PG8_WAIT_L(8); PG8_BAR; PG8_WAIT_L(0); PG8_MMA(0, 0, At, B0); PG8_BAR; PG8_SCHED;
            PG8_LDB(B1, 0, 1); PG8_STAGE(PG8_SB(0, 0), b2, voffB);
            PG8_BAR; PG8_WAIT_L(0); PG8_MMA(0, 1, At, B1); PG8_BAR;
            PG8_LDA(At, 0, 1); PG8_STAGE(PG8_SA(0, 0), a2, voffA);
            PG8_BAR; PG8_WAIT_L(0); PG8_MMA(1, 0, At, B0); PG8_BAR; PG8_SCHED;
            PG8_STAGE(PG8_SB(0, 1), b2 + hstep, voffB);
            PG8_WAIT_V(6); PG8_BAR; PG8_MMA(1, 1, At, B1); PG8_BAR;
            PG8_LDB(B0, 1, 0); PG8_SCHED; PG8_LDA(At, 1, 0); PG8_STAGE(PG8_SA(0, 1), a2 + hstep, voffA);
            PG8_WAIT_L(8); PG8_BAR; PG8_WAIT_L(0); PG8_MMA(0, 0, At, B0); PG8_BAR; PG8_SCHED;
            PG8_LDB(B1, 1, 1); PG8_STAGE(PG8_SB(1, 0), b3, voffB);
            PG8_BAR; PG8_WAIT_L(0); PG8_MMA(0, 1, At, B1); PG8_BAR;
            PG8_LDA(At, 1, 1); PG8_STAGE(PG8_SA(1, 0), a3, voffA);
            PG8_BAR; PG8_WAIT_L(0); PG8_MMA(1, 0, At, B0); PG8_BAR; PG8_SCHED;
            PG8_STAGE(PG8_SB(1, 1), b3 + hstep, voffB);
            PG8_WAIT_V(6); PG8_BAR; PG8_MMA(1, 1, At, B1); PG8_BAR;
            }
        }
        if constexpr (FP8) asm volatile("s_nop 7\n\ts_nop 7" ::: "memory");
        if constexpr (ALIGN_EPI) { if (wr == 0) PG8_BAR; }
        if constexpr (!Epi::AFTER_DRAIN) { int ln_ = (int)__builtin_amdgcn_mbcnt_hi(~0u, __builtin_amdgcn_mbcnt_lo(~0u, 0u)); asm volatile("" : "+v"(ln_)); E(acc, cur, wr, wc, ln_ & 15, ln_ >> 4, pre_); S.done(cur); }
        if (!has_next) break;
#pragma unroll
        for (int a = 0; a < 2; ++a)
#pragma unroll
            for (int b = 0; b < 2; ++b)
#pragma unroll
                for (int m = 0; m < 4; ++m)
#pragma unroll
                    for (int n = 0; n < 2; ++n) acc[a][b][m][n] = (f32x4){0.f, 0.f, 0.f, 0.f};
        cur = nxt; cA = nA; cB = nB; ++ui;
        if constexpr (ALIGN_EPI) { if (wr == 1) PG8_BAR; }
    }
    PG8_WAIT_V(0);
    if constexpr (!ALIGN_EPI) { if (wr == 0) PG8_BAR; }
    PG8_BAR;
    if constexpr (Epi::AFTER_DRAIN) { E.fused(acc, cur, wr, wc, fr, fq, lds, wid, lane); S.done(cur); }
#undef PG8_SA
#undef PG8_SB
#undef PG8_STAGE
#undef PG8_LDA
#undef PG8_LDB
#undef PG8_MMA
#undef PG8_WAIT_V
#undef PG8_WAIT_L
#undef PG8_BAR
#undef PG8_SCHED
}
}

constexpr int NWAVES = 8, NTHR = 512;
constexpr int BATCH = 2, SEQ = 8192, D = 1024, DEPTH = 4, MTOK = BATCH * SEQ;
constexpr int DIN = 3344, NPROJ = 3328, SRC_GA = 1152;
constexpr int C_GQ = 0, C_GK = 192, C_GV = 384, C_GG = 768, C_HQ = 1152, C_HF = 1408, C_HI = 1664, C_HG = 1920, C_RQ = 2176, C_RK = 2368, C_RV = 2560, C_RG = 2944;
constexpr int NE = 32, FFN = 1024;
constexpr int CH = 64, NCH = SEQ / CH, NUNIT = BATCH * NCH;
constexpr int ST_GLA = 0, ST_HG = 4 * 48 * 96, ST_RET = ST_HG + 4 * 64 * 64, ST_TOT = ST_RET + 4 * 48 * 96;
constexpr int NDV = 448, NKT = 640;
constexpr int MAXROWS = 65536 + NE * 256, MAXRT = MAXROWS / 256;
constexpr float EPS = 1e-6f;
#ifndef F8_IN_V
#define F8_IN_V false
#endif
#ifndef F8_OUT_V
#define F8_OUT_V false
#endif
constexpr bool F8_IN = F8_IN_V, F8_OUT = F8_OUT_V;
#ifndef Y8_V
#define Y8_V true
#endif
constexpr bool Y8 = Y8_V;
constexpr float S8_Y = 16.f;
constexpr float S8_M = 32.f;
constexpr float S8_W = 2048.f, S8_H = 64.f, S8_A = 8.f;
constexpr int NPHASE = 38;
constexpr int ECAP = 16384, ECAP_SH = 14;

constexpr size_t MiB = 1u << 20;
constexpr size_t WS_CTL = 0, CTL_ZERO_BYTES = 65536;
constexpr size_t WS_MOD = 1 * MiB;
constexpr size_t WS_ROPE = 2 * MiB;
constexpr size_t WS_LB = 5 * MiB;
constexpr size_t WS_WIN = 8 * MiB;
constexpr size_t WS_WOUT = 34 * MiB;
constexpr size_t WS_WGU = 42 * MiB;
constexpr size_t WS_WDN = 554 * MiB;
constexpr size_t WS_X = 810 * MiB;
constexpr size_t WS_H = 874 * MiB;
constexpr size_t WS_GA = 906 * MiB;
constexpr size_t WS_PROJ = 907 * MiB;
constexpr size_t WS_U = 1011 * MiB;
constexpr size_t WS_DVEC = 1063 * MiB;
constexpr size_t WS_SP = 1064 * MiB;
constexpr size_t WS_MIX = 1090 * MiB;
constexpr size_t WS_TOPE = 1122 * MiB;
constexpr size_t WS_TOPW = WS_TOPE + 256 * 1024;
constexpr size_t WS_SLOT = WS_TOPW + 256 * 1024;
constexpr size_t WS_A1 = 1123 * MiB;
constexpr size_t WS_ACT = 1635 * MiB;
constexpr size_t WS_Y = 2147 * MiB;
constexpr size_t WS_CUM = 3171 * MiB;
constexpr size_t WS_KT = 3199 * MiB;
constexpr size_t WS_END = 3239 * MiB;
static_assert(WS_WIN + (size_t)DEPTH * NPROJ * D * 2 <= WS_WOUT && WS_PROJ + (size_t)MTOK * NPROJ * 2 <= WS_U && WS_U + (size_t)NUNIT * ST_TOT * 4 <= WS_DVEC && WS_SP + (size_t)NUNIT * ST_TOT * 2 <= WS_MIX && WS_A1 + (size_t)NE * ECAP * D <= WS_ACT && WS_ACT + (size_t)NE * ECAP * D <= WS_Y && WS_Y + (size_t)NE * ECAP * D * 2 <= WS_CUM, "ws map");
constexpr int CW_TMO = 0, CW_CODE = 1, CW_BAR = 4096, CW_CNT = 8192, CW_FILL = 8192 + 256;
constexpr int RING_BYTES = 131072;
constexpr int MISC_OFF = 147456, LDS_BYTES = MISC_OFF + 4096;
constexpr int MW_BAR = 0, MW_CNT = 16, MW_PST = 48, MW_HIST = 96, MW_BASE = 128, MW_TILE = 192, MW_NRT = 480, MW_SLOTS = 512;

#define GAS __attribute__((address_space(1)))
#define LAS __attribute__((address_space(3)))
typedef unsigned v4u __attribute__((ext_vector_type(4)));
typedef float f32x4 __attribute__((ext_vector_type(4)));
typedef short bf16x8 __attribute__((ext_vector_type(8)));
typedef GAS unsigned gu32;
typedef GAS unsigned long long gu64;
#define RLX_AGENT __ATOMIC_RELAXED, __HIP_MEMORY_SCOPE_AGENT
#define LDS_WAIT() asm volatile("s_waitcnt lgkmcnt(0)" ::: "memory")
#define VM_WAIT() asm volatile("s_waitcnt vmcnt(0)" ::: "memory")
__device__ __forceinline__ unsigned long long rt() { return __builtin_amdgcn_s_memrealtime(); }
typedef unsigned short bf16;
typedef float f32x2_t __attribute__((ext_vector_type(2))); typedef __bf16 bf16x2_t __attribute__((ext_vector_type(2)));
__device__ __forceinline__ unsigned pk2(float lo, float hi) { const f32x2_t v = {lo, hi}; return __builtin_bit_cast(unsigned, __builtin_convertvector(v, bf16x2_t)); }
__device__ __forceinline__ unsigned f2bf(float f) { return pk2(f, 0.f) & 0xffffu; }
__device__ __forceinline__ float bf2f(bf16 b) { return __builtin_bit_cast(float, (unsigned)b << 16); }
#define XB_TMO      128
#define XB_XCNT(j)  (256  + 64 * (j))
#define XB_XSUB(j)  (1280 + 64 * (j))
#define XB_XGEN(j)  (2304 + 64 * (j))
#define XB_TOP      3328
#define XB_TOPGEN   3392
#define XCD_BAR_WORDS 3456
#define XB_SPIN_CAP (1u << 18)

__device__ __forceinline__ unsigned xb_ld(unsigned* p)              { return __hip_atomic_load(p, __ATOMIC_RELAXED, __HIP_MEMORY_SCOPE_AGENT); }
__device__ __forceinline__ unsigned xb_add(unsigned* p, unsigned v) { return __hip_atomic_fetch_add(p, v, __ATOMIC_RELAXED, __HIP_MEMORY_SCOPE_AGENT); }
__device__ __forceinline__ unsigned xb_xcc_id() { return (unsigned)__builtin_amdgcn_s_getreg((3 << 11) | 20) & 0xFu; }
#define XB_SPIN(cond, bar) do { unsigned _sp = 0; while (cond) { __builtin_amdgcn_s_sleep(1); \
    if ((++_sp & 255u) == 0u) { if (xb_ld(&(bar)[XB_TMO])) break; if (_sp > XB_SPIN_CAP) { atomicAdd(&(bar)[XB_TMO], 1u); break; } } } } while (0)

struct XcdBarrier {
    unsigned* bar; unsigned x;
    volatile LAS unsigned* st;
};

__device__ __forceinline__ XcdBarrier xcd_barrier_post(unsigned* bar, volatile LAS unsigned* st) {
    XcdBarrier b; b.bar = bar; b.x = xb_xcc_id(); b.st = st;
    if (threadIdx.x == 0) (void)xb_add(&bar[XB_XCNT(b.x)], 1u);
    return b;
}
__device__ __forceinline__ void xcd_barrier_complete(unsigned* bar, unsigned x, unsigned& nloc, unsigned& nx) {
    const unsigned G = gridDim.x * gridDim.y * gridDim.z;
    unsigned sum, cnt, mine, sp = 0u;
    for (;;) {
        sum = 0u; cnt = 0u; mine = 0u;
#pragma unroll
        for (unsigned j = 0; j < 16; ++j) { const unsigned c = xb_ld(&bar[XB_XCNT(j)]); sum += c; cnt += (c > 0u) ? 1u : 0u; mine = (j == x) ? c : mine; }
        if (sum == G) break;
        __builtin_amdgcn_s_sleep(1);
        if ((++sp & 255u) == 0u) { if (xb_ld(&bar[XB_TMO])) break; if (sp > XB_SPIN_CAP) { atomicAdd(&bar[XB_TMO], 1u); break; } }
    }
    nloc = mine > 0u ? mine : 1u; nx = cnt > 0u ? cnt : 1u;
}

__device__ __forceinline__ void xcd_barrier(const XcdBarrier& b) {
    asm volatile("s_waitcnt vmcnt(0)" ::: "memory");
    __syncthreads();
    if (threadIdx.x == 0) {
        unsigned* bar = b.bar;
        __builtin_amdgcn_s_waitcnt(0);
        unsigned nloc = b.st[0], nx = b.st[1];
        if (nloc == 0u) { xcd_barrier_complete(bar, b.x, nloc, nx); b.st[0] = nloc; b.st[1] = nx; }
        const unsigned old = xb_add(&bar[XB_XSUB(b.x)], 1u);
        const unsigned gen = old / nloc;
        if (old + 1u == (gen + 1u) * nloc) {
            __builtin_amdgcn_fence(__ATOMIC_RELEASE, "agent");
            asm volatile("s_waitcnt vmcnt(0)" ::: "memory");
            const unsigned og = xb_add(&bar[XB_TOP], 1u);
            const unsigned tg = og / nx;
            if (og + 1u == (tg + 1u) * nx) xb_add(&bar[XB_TOPGEN], 1u);
            else XB_SPIN(xb_ld(&bar[XB_TOPGEN]) == tg, bar);
            __builtin_amdgcn_fence(__ATOMIC_ACQUIRE, "agent");
            xb_add(&bar[XB_XGEN(b.x)], 1u);
            asm volatile("s_waitcnt vmcnt(0)" ::: "memory");
        } else {
            XB_SPIN(xb_ld(&bar[XB_XGEN(b.x)]) == gen, bar);
            __builtin_amdgcn_fence(__ATOMIC_ACQUIRE, "agent");
            asm volatile("s_waitcnt vmcnt(0)" ::: "memory");
        }
    }
    __syncthreads();
}

__device__ __forceinline__ float wave_sum(float v) {
#pragma unroll
    for (int o = 1; o < 64; o <<= 1) v += __shfl_xor(v, o);
    return v;
}
__device__ __forceinline__ float log_sigmoid_f(float x) { return fminf(x, 0.f) - log1pf(expf(-fabsf(x))); }
__device__ __forceinline__ float silu_f(float x) { return x / (1.0f + expf(-x)); }
__device__ __forceinline__ float sigmoid_f(float x) { return 1.0f / (1.0f + expf(-x)); }
__device__ __forceinline__ pg8::bf16x8 ldfrag(const LAS bf16* base, int stride, int r0, int k0, int lane) {
    return *(const LAS pg8::bf16x8*)(base + (r0 + (lane & 15)) * stride + k0 + 8 * (lane >> 4));
}
__device__ __forceinline__ pg8::bf16x8 pack8(const float (&v)[8]) { v4u w; w.x = pk2(v[0], v[1]); w.y = pk2(v[2], v[3]); w.z = pk2(v[4], v[5]); w.w = pk2(v[6], v[7]); return __builtin_bit_cast(pg8::bf16x8, w); }

struct Args {
    const float* x; const float* c; const int* pos; const float* w_mod; const float* b_mod; const float* norm1_w; const float* w_in; const float* gla_wa2; const float* gla_ba2; const float* hg_lb;
    const float* gla_norm_w; const float* hg_norm_w; const float* w_out; const float* norm2_w; const float* w_r; const float* b_r; const float* w_gu; const float* b_gu; const float* w_dn; const float* b_dn;
    const float* final_norm_w; float* out; unsigned char* ws; int ph_lo, ph_hi;
};

__device__ __forceinline__ void transpose_block64(const float* src, int ld, bf16* dst, LAS float* scr, int lane) {
    const int r = lane >> 4, c4 = (lane & 15) * 4;
    f32x4 v[16];
#pragma unroll
    for (int i = 0; i < 16; ++i) v[i] = __builtin_nontemporal_load((const f32x4*)(src + (size_t)(4 * i + r) * ld + c4));
#pragma unroll
    for (int i = 0; i < 16; ++i) { LAS float* w = scr + (4 * i + r) * 65 + c4; w[0] = v[i][0]; w[1] = v[i][1]; w[2] = v[i][2]; w[3] = v[i][3]; }
    LDS_WAIT(); asm volatile("" ::: "memory");
    const int kc = lane & 7;
#pragma unroll
    for (int jj = 0; jj < 8; ++jj) { const int n = (lane >> 3) + 8 * jj; const LAS float* s = scr + (8 * kc) * 65 + n;
        v4u o; o.x = pk2(s[0 * 65], s[1 * 65]); o.y = pk2(s[2 * 65], s[3 * 65]); o.z = pk2(s[4 * 65], s[5 * 65]); o.w = pk2(s[6 * 65], s[7 * 65]);
        *(GAS v4u*)(dst + (size_t)n * D + 8 * kc) = o; }
    LDS_WAIT(); asm volatile("" ::: "memory");
}
__device__ __forceinline__ float clamp448(float x) { return __builtin_amdgcn_fmed3f(x, -448.f, 448.f); }
__device__ __forceinline__ int pk4_fp8(float a, float b, float c, float d) { int w = 0; w = __builtin_amdgcn_cvt_pk_fp8_f32(clamp448(a), clamp448(b), w, false);
    return __builtin_amdgcn_cvt_pk_fp8_f32(clamp448(c), clamp448(d), w, true); }
__device__ __forceinline__ void transpose_block64_fp8(const float* src, int ld, unsigned char* dst, LAS float* scr, int lane, float sc) {
    const int r = lane >> 4, c4 = (lane & 15) * 4;
    f32x4 v[16];
#pragma unroll
    for (int i = 0; i < 16; ++i) v[i] = __builtin_nontemporal_load((const f32x4*)(src + (size_t)(4 * i + r) * ld + c4));
#pragma unroll
    for (int i = 0; i < 16; ++i) { LAS float* w = scr + (4 * i + r) * 65 + c4; w[0] = v[i][0] * sc; w[1] = v[i][1] * sc; w[2] = v[i][2] * sc; w[3] = v[i][3] * sc; }
    LDS_WAIT(); asm volatile("" ::: "memory");
    const int kc = lane & 3;
#pragma unroll
    for (int jj = 0; jj < 4; ++jj) { const int n = (lane >> 2) + 16 * jj; const LAS float* s = scr + (16 * kc) * 65 + n;
        v4u o; o.x = (unsigned)pk4_fp8(s[0 * 65], s[1 * 65], s[2 * 65], s[3 * 65]); o.y = (unsigned)pk4_fp8(s[4 * 65], s[5 * 65], s[6 * 65], s[7 * 65]);
        o.z = (unsigned)pk4_fp8(s[8 * 65], s[9 * 65], s[10 * 65], s[11 * 65]); o.w = (unsigned)pk4_fp8(s[12 * 65], s[13 * 65], s[14 * 65], s[15 * 65]);
        *(GAS v4u*)(dst + (size_t)n * D + 16 * kc) = o; }
    LDS_WAIT(); asm volatile("" ::: "memory");
}
constexpr int IT_IN = 16 * (NPROJ / 64), IT_OUT = 16 * 16, IT_GU = NE * 16 * 32, IT_DN = NE * 16 * 16, IT_LAYER = IT_IN + IT_OUT + IT_GU + IT_DN, IT_ALL = DEPTH * IT_LAYER;
__device__ __forceinline__ void convert_item(const Args& a, int l, int r, LAS float* scr, int lane) {
    unsigned char* ws = a.ws;
    bf16* WIN = (bf16*)(ws + WS_WIN); bf16* WOUT = (bf16*)(ws + WS_WOUT); unsigned char* WGU = ws + WS_WGU; unsigned char* WDN = ws + WS_WDN;
    if (r < IT_IN) { const int kb = r / (NPROJ / 64), nb = r % (NPROJ / 64), n0 = 64 * nb, sc = n0 + (n0 >= SRC_GA ? 16 : 0);
        if (F8_IN) transpose_block64_fp8(a.w_in + ((size_t)l * D + 64 * kb) * DIN + sc, DIN, (unsigned char*)WIN + ((size_t)l * NPROJ + n0) * D + 64 * kb, scr, lane, S8_W);
        else transpose_block64(a.w_in + ((size_t)l * D + 64 * kb) * DIN + sc, DIN, WIN + ((size_t)l * NPROJ + n0) * D + 64 * kb, scr, lane); return; }
    r -= IT_IN;
    if (r < IT_OUT) { const int kb = r / 16, nb = r % 16;
        if (F8_OUT) transpose_block64_fp8(a.w_out + ((size_t)l * D + 64 * kb) * D + 64 * nb, D, (unsigned char*)WOUT + ((size_t)l * D + 64 * nb) * D + 64 * kb, scr, lane, S8_W);
        else transpose_block64(a.w_out + ((size_t)l * D + 64 * kb) * D + 64 * nb, D, WOUT + ((size_t)l * D + 64 * nb) * D + 64 * kb, scr, lane); return; }
    r -= IT_OUT;
    if (r < IT_GU) { const int e = r / 512, r2 = r % 512, kb = r2 / 32, nb = r2 % 32, cc = 64 * nb;
        const int row = (cc < 1024) ? 256 * (cc / 128) + (cc % 128) : 256 * ((cc - 1024) / 128) + 128 + ((cc - 1024) % 128);
        transpose_block64_fp8(a.w_gu + (((size_t)l * NE + e) * D + 64 * kb) * 2048 + cc, 2048, WGU + (((size_t)l * NE + e) * 2048 + row) * D + 64 * kb, scr, lane, S8_W); return; }
    r -= IT_GU;
    { const int e = r / 256, r2 = r % 256, kb = r2 / 16, nb = r2 % 16;
        transpose_block64_fp8(a.w_dn + (((size_t)l * NE + e) * FFN + 64 * kb) * D + 64 * nb, D, WDN + (((size_t)l * NE + e) * D + 64 * nb) * D + 64 * kb, scr, lane, S8_W); }
}
constexpr int CB2 = 4, CB7 = 2, CB8 = 2;
__device__ __forceinline__ int conv_t2(int G) { return (G == 256) ? 192 * NWAVES * CB2 : 0; }
__device__ __forceinline__ int conv_idle(int nunits, int G) { const int rem = nunits % G; return rem ? G - rem : 0; }
__device__ __forceinline__ void convert_range(const Args& a, int l, int first, int count, LAS unsigned char* lds, int lane, int wave) {
    LAS float* scr = (LAS float*)(lds + wave * 16640);
    for (int k = 0; k < count; ++k) { const int it = first + k; if (it < IT_LAYER) convert_item(a, l, it, scr, lane); }
}
__device__ __forceinline__ void p0_prologue(const Args& a, LAS unsigned char* lds, int vcu, int G, int tid, int lane, int wave) {
    unsigned char* ws = a.ws;
    LAS float* scr = (LAS float*)(lds + wave * 16640);
    const int gw = vcu * NWAVES + wave, NGW = G * NWAVES;
    for (int it = gw; it < IT_LAYER; it += NGW) convert_item(a, 0, it, scr, lane);
    __syncthreads();
    {
        LAS float* cact = (LAS float*)lds;
        LAS float* red = (LAS float*)(lds + 8192);
        for (int i = tid; i < 2 * D; i += NTHR) cact[i] = silu_f(a.c[i]);
        __syncthreads();
        float* MOD = (float*)(ws + WS_MOD);
        for (int it = vcu; it < DEPTH * 96; it += G) {
            const int l = it / 96, n0 = (it % 96) * 64;
            const float* wp = a.w_mod + ((size_t)l * D + 128 * wave) * 6144 + n0 + lane;
            float a0 = 0.f, a1 = 0.f;
#pragma unroll 32
            for (int k = 0; k < 128; ++k) { const float w = __builtin_nontemporal_load(wp + (size_t)k * 6144); a0 += cact[128 * wave + k] * w; a1 += cact[D + 128 * wave + k] * w; }
            red[(wave * 2 + 0) * 64 + lane] = a0; red[(wave * 2 + 1) * 64 + lane] = a1;
            __syncthreads();
            if (tid < 128) { const int b = tid >> 6, ln = tid & 63; float s = a.b_mod[l * 6144 + n0 + ln];
#pragma unroll
                for (int w = 0; w < 8; ++w) s += red[(w * 2 + b) * 64 + ln];
                MOD[((size_t)l * 2 + b) * 6144 + n0 + ln] = s; }
            __syncthreads();
        }
    }
    { const f32x4* xs = (const f32x4*)a.x; uint2* xd = (uint2*)(ws + WS_X);
        for (int i = vcu * NTHR + tid; i < MTOK * D / 4; i += G * NTHR) { const f32x4 v = xs[i]; uint2 p; p.x = pk2(v[0], v[1]); p.y = pk2(v[2], v[3]); xd[i] = p; } }
    {
        float* ROPE = (float*)(ws + WS_ROPE);
        for (int i = vcu * NTHR + tid; i < MTOK * 24; i += G * NTHR) { const int t = i / 24, f = i % 24;
            const float inv = (float)pow(10000.0, -(double)f / 24.0); const float ang = (float)a.pos[t] * inv;
            ROPE[(size_t)t * 48 + f] = cosf(ang); ROPE[(size_t)t * 48 + 24 + f] = sinf(ang); }
    }
    if (vcu == 0 && tid < 256) {
        float v[4], mx = -3.0e38f; for (int l = 0; l < 4; ++l) { v[l] = a.hg_lb[l * 256 + tid]; mx = fmaxf(mx, v[l]); }
        float s = 0.f; for (int l = 0; l < 4; ++l) { v[l] = expf(v[l] - mx); s += v[l]; }
        float* LB = (float*)(ws + WS_LB); float cs = 0.f, first = 0.f;
        for (int l = 0; l < 4; ++l) { cs += v[l] / s; if (l == 0) first = cs; LB[l * 256 + tid] = cs - first; }
    }
}

__device__ __forceinline__ void moe_combine_row(f32x4 (&v)[4], int m, const bf16* Y, const int* SLOT, const float* TOPW, const float* g2, int lane) {
    const int4 sl = *(const int4*)(SLOT + (size_t)m * 4); const f32x4 tw = *(const f32x4*)(TOPW + (size_t)m * 4);
    const int s[4] = {sl.x, sl.y, sl.z, sl.w};
    f32x4 acc[4];
#pragma unroll
    for (int j = 0; j < 4; ++j) acc[j] = (f32x4){0.f, 0.f, 0.f, 0.f};
#pragma unroll
    for (int k = 0; k < 4; ++k) { const bf16* yr = Y + (size_t)s[k] * D + 4 * lane; const float w = tw[k];
#pragma unroll
        for (int j = 0; j < 4; ++j) { const uint2 p = *(const uint2*)(yr + 256 * j);
            acc[j][0] += w * __builtin_bit_cast(float, p.x << 16); acc[j][1] += w * __builtin_bit_cast(float, p.x & 0xffff0000u);
            acc[j][2] += w * __builtin_bit_cast(float, p.y << 16); acc[j][3] += w * __builtin_bit_cast(float, p.y & 0xffff0000u); } }
#pragma unroll
    for (int j = 0; j < 4; ++j) { const f32x4 g = *(const f32x4*)(g2 + 4 * lane + 256 * j); v[j] = v[j] + g * acc[j]; }
}
__device__ __forceinline__ float row_rstd(const f32x4 (&v)[4]) {
    float s = 0.f;
#pragma unroll
    for (int j = 0; j < 4; ++j) s += (v[j][0] * v[j][0] + v[j][1] * v[j][1]) + (v[j][2] * v[j][2] + v[j][3] * v[j][3]);
    return 1.0f / sqrtf(wave_sum(s) * (1.0f / D) + EPS);
}
__device__ __forceinline__ void modulate_row(f32x4 (&v)[4], float rstd, const float* nw, const float* sc, const float* sh, bf16* hrow, int lane) {
#pragma unroll
    for (int j = 0; j < 4; ++j) { const int c0 = 4 * lane + 256 * j; const f32x4 w = *(const f32x4*)(nw + c0), s1 = *(const f32x4*)(sc + c0), s0 = *(const f32x4*)(sh + c0);
        v[j] = v[j] * rstd * w * (s1 + 1.0f) + s0;
        uint2 p; p.x = pk2(v[j][0], v[j][1]); p.y = pk2(v[j][2], v[j][3]); *(uint2*)(hrow + c0) = p; }
}


constexpr int LR_SLT = 142976, LR_TWL = 144000, LR_SSR = 145024;
__device__ __forceinline__ void stage_slots(const unsigned char* ws, int row0, LAS unsigned char* lds, int tid) {
    if (tid < 64) { *(LAS v4u*)(lds + LR_SLT + 16 * tid) = *(const v4u*)((const int*)(ws + WS_SLOT) + (size_t)(row0 + tid) * 4);
                    *(LAS f32x4*)(lds + LR_TWL + 16 * tid) = *(const f32x4*)((const float*)(ws + WS_TOPW) + (size_t)(row0 + tid) * 4); }
}
template <bool SS, bool OUTF32>
__device__ __forceinline__ void flat_combine(const bf16* xsrc, void* xdst, int row0, const bf16* Y, const float* g2, LAS unsigned char* lds, int tid, int lane) {
    static_assert(Y8, "expert outputs are stored as fp8");
    typedef float f32x2v __attribute__((ext_vector_type(2)));
    const int c16 = tid & 63, rsub = tid >> 6; const unsigned char* Yb = (const unsigned char*)Y;
    f32x4 g[4];
#pragma unroll
    for (int q = 0; q < 4; ++q) g[q] = *(const f32x4*)(g2 + 16 * c16 + 4 * q);
#pragma unroll 2
    for (int it = 0; it < 8; ++it) { const int i = 8 * it + rsub; const size_t m = (size_t)(row0 + i);
        const v4u x0 = *(const v4u*)(xsrc + m * D + 16 * c16), x1 = *(const v4u*)(xsrc + m * D + 16 * c16 + 8);
        const v4u sl = *(const LAS v4u*)(lds + LR_SLT + 16 * i); const f32x4 tws = *(const LAS f32x4*)(lds + LR_TWL + 16 * i) * (1.0f / S8_Y);
        const v4u y0 = *(const v4u*)(Yb + (size_t)sl.x * D + 16 * c16), y1 = *(const v4u*)(Yb + (size_t)sl.y * D + 16 * c16), y2 = *(const v4u*)(Yb + (size_t)sl.z * D + 16 * c16), y3 = *(const v4u*)(Yb + (size_t)sl.w * D + 16 * c16);
        const unsigned xw[8] = {x0.x, x0.y, x0.z, x0.w, x1.x, x1.y, x1.z, x1.w}, w0[4] = {y0.x, y0.y, y0.z, y0.w}, w1[4] = {y1.x, y1.y, y1.z, y1.w}, w2[4] = {y2.x, y2.y, y2.z, y2.w}, w3[4] = {y3.x, y3.y, y3.z, y3.w};
        float v[16]; float sq = 0.f;
#pragma unroll
        for (int q = 0; q < 4; ++q) {
            const f32x2v a0 = __builtin_amdgcn_cvt_pk_f32_fp8((int)w0[q], false), b0 = __builtin_amdgcn_cvt_pk_f32_fp8((int)w0[q], true), a1 = __builtin_amdgcn_cvt_pk_f32_fp8((int)w1[q], false), b1 = __builtin_amdgcn_cvt_pk_f32_fp8((int)w1[q], true);
            const f32x2v a2 = __builtin_amdgcn_cvt_pk_f32_fp8((int)w2[q], false), b2 = __builtin_amdgcn_cvt_pk_f32_fp8((int)w2[q], true), a3 = __builtin_amdgcn_cvt_pk_f32_fp8((int)w3[q], false), b3 = __builtin_amdgcn_cvt_pk_f32_fp8((int)w3[q], true);
            const float e0 = tws[0] * a0[0] + tws[1] * a1[0] + tws[2] * a2[0] + tws[3] * a3[0], e1 = tws[0] * a0[1] + tws[1] * a1[1] + tws[2] * a2[1] + tws[3] * a3[1];
            const float e2 = tws[0] * b0[0] + tws[1] * b1[0] + tws[2] * b2[0] + tws[3] * b3[0], e3 = tws[0] * b0[1] + tws[1] * b1[1] + tws[2] * b2[1] + tws[3] * b3[1];
            v[4 * q + 0] = __builtin_bit_cast(float, xw[2 * q] << 16) + g[q][0] * e0; v[4 * q + 1] = __builtin_bit_cast(float, xw[2 * q] & 0xffff0000u) + g[q][1] * e1;
            v[4 * q + 2] = __builtin_bit_cast(float, xw[2 * q + 1] << 16) + g[q][2] * e2; v[4 * q + 3] = __builtin_bit_cast(float, xw[2 * q + 1] & 0xffff0000u) + g[q][3] * e3;
            sq += (v[4 * q] * v[4 * q] + v[4 * q + 1] * v[4 * q + 1]) + (v[4 * q + 2] * v[4 * q + 2] + v[4 * q + 3] * v[4 * q + 3]); }
        if (OUTF32) {
#pragma unroll
            for (int q = 0; q < 4; ++q) *(GAS f32x4*)((float*)xdst + m * D + 16 * c16 + 4 * q) = (f32x4){v[4 * q], v[4 * q + 1], v[4 * q + 2], v[4 * q + 3]}; }
        else { v4u o0, o1; o0.x = pk2(v[0], v[1]); o0.y = pk2(v[2], v[3]); o0.z = pk2(v[4], v[5]); o0.w = pk2(v[6], v[7]); o1.x = pk2(v[8], v[9]); o1.y = pk2(v[10], v[11]); o1.z = pk2(v[12], v[13]); o1.w = pk2(v[14], v[15]);
            *(GAS v4u*)((bf16*)xdst + m * D + 16 * c16) = o0; *(GAS v4u*)((bf16*)xdst + m * D + 16 * c16 + 8) = o1; }
        if (SS) { const float sqs = wave_sum(sq); if (lane == 0) __hip_atomic_fetch_add((LAS float*)(lds + LR_SSR) + i, sqs, __ATOMIC_RELAXED, __HIP_MEMORY_SCOPE_WORKGROUP); } }
}
template <bool F8, bool SLOTS>
__device__ __forceinline__ void flat_modulate(const bf16* xin, int row0, const LAS float* rstds, const float* nw, const float* scp, const float* shp, bf16* H, unsigned char* A1, LAS unsigned char* lds, int tid) {
    const int c16 = tid & 63, rsub = tid >> 6; f32x4 ws1[4], s0[4];
#pragma unroll
    for (int q = 0; q < 4; ++q) { const int c0 = 16 * c16 + 4 * q; ws1[q] = *(const f32x4*)(nw + c0) * (*(const f32x4*)(scp + c0) + 1.0f); s0[q] = *(const f32x4*)(shp + c0); }
#pragma unroll 2
    for (int it = 0; it < 8; ++it) { const int i = 8 * it + rsub; const size_t m = (size_t)(row0 + i); const float rs = rstds[i];
        const v4u x0 = *(const v4u*)(xin + m * D + 16 * c16), x1 = *(const v4u*)(xin + m * D + 16 * c16 + 8); const unsigned xw[8] = {x0.x, x0.y, x0.z, x0.w, x1.x, x1.y, x1.z, x1.w};
        f32x4 v[4];
#pragma unroll
        for (int q = 0; q < 4; ++q) v[q] = (f32x4){__builtin_bit_cast(float, xw[2 * q] << 16), __builtin_bit_cast(float, xw[2 * q] & 0xffff0000u), __builtin_bit_cast(float, xw[2 * q + 1] << 16), __builtin_bit_cast(float, xw[2 * q + 1] & 0xffff0000u)} * rs * ws1[q] + s0[q];
        if (F8) { v4u o; o.x = (unsigned)pk4_fp8(v[0][0] * S8_H, v[0][1] * S8_H, v[0][2] * S8_H, v[0][3] * S8_H); o.y = (unsigned)pk4_fp8(v[1][0] * S8_H, v[1][1] * S8_H, v[1][2] * S8_H, v[1][3] * S8_H);
            o.z = (unsigned)pk4_fp8(v[2][0] * S8_H, v[2][1] * S8_H, v[2][2] * S8_H, v[2][3] * S8_H); o.w = (unsigned)pk4_fp8(v[3][0] * S8_H, v[3][1] * S8_H, v[3][2] * S8_H, v[3][3] * S8_H);
            if (SLOTS) { const v4u sl = *(const LAS v4u*)(lds + LR_SLT + 16 * i);
                *(GAS v4u*)(A1 + (size_t)sl.x * D + 16 * c16) = o; *(GAS v4u*)(A1 + (size_t)sl.y * D + 16 * c16) = o; *(GAS v4u*)(A1 + (size_t)sl.z * D + 16 * c16) = o; *(GAS v4u*)(A1 + (size_t)sl.w * D + 16 * c16) = o; }
            else *(GAS v4u*)((unsigned char*)H + m * D + 16 * c16) = o; }
        else { v4u o0, o1; o0.x = pk2(v[0][0], v[0][1]); o0.y = pk2(v[0][2], v[0][3]); o0.z = pk2(v[1][0], v[1][1]); o0.w = pk2(v[1][2], v[1][3]); o1.x = pk2(v[2][0], v[2][1]); o1.y = pk2(v[2][2], v[2][3]); o1.z = pk2(v[3][0], v[3][1]); o1.w = pk2(v[3][2], v[3][3]);
            *(GAS v4u*)(H + m * D + 16 * c16) = o0; *(GAS v4u*)(H + m * D + 16 * c16 + 8) = o1; } }
}

constexpr int WP = 1032;
constexpr int LR_WHI = 0, LR_PART = 132096, LR_SSX = 140288, LR_RSTD = 140544, LR_BIAS = 140800, LR_RED = 140928;
template <int NEO>
__device__ __forceinline__ void rows_mfma(const Args& a, int layer, LAS unsigned char* lds, volatile LAS unsigned* MISC, gu32* ctl, int vcu, int G, int tid, int lane, int wave) {
    constexpr bool P5 = (NEO == 32); constexpr int NET = NEO / 16;
    unsigned char* ws = a.ws; bf16* X = (bf16*)(ws + WS_X); bf16* H = (bf16*)(ws + WS_H); const float* MOD = (const float*)(ws + WS_MOD);
    LAS bf16* Whi = (LAS bf16*)(lds + LR_WHI); LAS bf16* Wlo = Whi + NEO * WP; LAS float* part = (LAS float*)(lds + LR_PART); LAS float* ssx = (LAS float*)(lds + LR_SSX);
    LAS float* rstds = (LAS float*)(lds + LR_RSTD); LAS float* biasl = (LAS float*)(lds + LR_BIAS); LAS float* red = (LAS float*)(lds + LR_RED);
    const float* nw = (P5 ? a.norm2_w : a.norm1_w) + layer * D;
    const float* Wsrc = P5 ? a.w_r + (size_t)layer * D * NE : a.w_in + (size_t)layer * D * DIN + SRC_GA; const int wld = P5 ? NE : DIN;
    if (P5) { if (tid < NE) MISC[MW_HIST + tid] = 0u; }
    for (int row0 = vcu * 64; row0 < MTOK; row0 += G * 64) {
        const int b = row0 / SEQ; const float* mp = MOD + ((size_t)layer * 2 + b) * 6144; const float* scp = mp + (P5 ? 4 : 1) * D; const float* shp = mp + (P5 ? 3 : 0) * D;
        if (!P5 && layer > 0) { stage_slots(ws, row0, lds, tid); __syncthreads(); }
        { const int e = tid % NEO, kq = tid / NEO; constexpr int NPT = NTHR / NEO;
#pragma unroll 1
            for (int it0 = 0; it0 < D / NPT; it0 += 8) { float wv[8];
#pragma unroll
                for (int u = 0; u < 8; ++u) { const int k = kq + NPT * (it0 + u); wv[u] = Wsrc[(size_t)k * wld + e] * (nw[k] * (1.0f + scp[k])); }
#pragma unroll
                for (int u = 0; u < 8; ++u) { const int k = kq + NPT * (it0 + u); const unsigned hi = f2bf(wv[u]); const float wl = wv[u] - __builtin_bit_cast(float, hi << 16); Whi[e * WP + k] = (bf16)hi; Wlo[e * WP + k] = (bf16)f2bf(wl); } }
            constexpr int KP = D / NPT; float sacc = 0.f;
#pragma unroll 8
            for (int k = kq * KP; k < kq * KP + KP; ++k) sacc += shp[k] * Wsrc[(size_t)k * wld + e];
            red[kq * NEO + e] = sacc; }
        const bf16* xin = X;
        if (!P5 && layer > 0) { flat_combine<false, false>(X, X, row0, (const bf16*)(ws + WS_Y), MOD + ((size_t)(layer - 1) * 2 + b) * 6144 + 5 * D, lds, tid, lane); asm volatile("s_waitcnt vmcnt(0)" ::: "memory"); }
        __syncthreads();
        if (tid < NEO) { constexpr int NPT = NTHR / NEO; float sacc = P5 ? a.b_r[layer * NE + tid] : 0.f; for (int q = 0; q < NPT; ++q) sacc += red[q * NEO + tid]; biasl[tid] = sacc; }
        const int rg = wave >> 1, kh = wave & 1, r = lane & 15, g = lane >> 4;
        { const bf16* xr = xin + (size_t)(row0 + 16 * rg + r) * D; f32x4 acc[NET]; float ss = 0.f;
#pragma unroll
            for (int et = 0; et < NET; ++et) acc[et] = (f32x4){0.f, 0.f, 0.f, 0.f};
#pragma unroll 4
            for (int s = 16 * kh; s < 16 * kh + 16; ++s) { const int k0 = 32 * s + 8 * g; const v4u xp = *(const v4u*)(xr + k0); const unsigned xw[4] = {xp.x, xp.y, xp.z, xp.w};
#pragma unroll
                for (int j = 0; j < 4; ++j) { const float xa = __builtin_bit_cast(float, xw[j] << 16), xb = __builtin_bit_cast(float, xw[j] & 0xffff0000u); ss += xa * xa + xb * xb; }
                const pg8::bf16x8 ahi = __builtin_bit_cast(pg8::bf16x8, xp);
#pragma unroll
                for (int et = 0; et < NET; ++et) { const pg8::bf16x8 whi = ldfrag(Whi, WP, 16 * et, 32 * s, lane), wlo = ldfrag(Wlo, WP, 16 * et, 32 * s, lane);
                    acc[et] = __builtin_amdgcn_mfma_f32_16x16x32_bf16(ahi, whi, acc[et], 0, 0, 0); acc[et] = __builtin_amdgcn_mfma_f32_16x16x32_bf16(ahi, wlo, acc[et], 0, 0, 0); } }
            ss += __shfl_xor(ss, 16); ss += __shfl_xor(ss, 32);
            if (kh == 1) {
#pragma unroll
                for (int et = 0; et < NET; ++et)
#pragma unroll
                    for (int q = 0; q < 4; ++q) part[(rg * 16 + 4 * g + q) * 32 + 16 * et + r] = acc[et][q];
                if (g == 0) ssx[rg * 16 + r] = ss; }
            __syncthreads();
            if (kh == 0) { const float sst = ss + ssx[rg * 16 + r]; if (g == 0) rstds[rg * 16 + r] = 1.0f / sqrtf(sst * (1.0f / D) + EPS);
                asm volatile("s_waitcnt lgkmcnt(0)" ::: "memory");
#pragma unroll
                for (int et = 0; et < NET; ++et)
#pragma unroll
                    for (int q = 0; q < 4; ++q) { const int i = rg * 16 + 4 * g + q, e = 16 * et + r; const float v = rstds[i] * (acc[et][q] + part[i * 32 + e]) + biasl[e];
                        if (P5) part[i * 32 + e] = v; else ((float*)(ws + WS_GA))[(size_t)(row0 + i) * 16 + e] = v; }
                if (P5) { asm volatile("s_waitcnt lgkmcnt(0)" ::: "memory");
                    if (lane < 16) { const int i = rg * 16 + lane, m = row0 + i; float lv[NE];
#pragma unroll
                        for (int e = 0; e < NE; ++e) lv[e] = part[i * 32 + e];
                        float tv[4]; int te[4];
#pragma unroll
                        for (int t = 0; t < 4; ++t) { float best = -3.0e38f; int bi = 0;
#pragma unroll
                            for (int e = 0; e < NE; ++e) if (lv[e] > best) { best = lv[e]; bi = e; }
#pragma unroll
                            for (int e = 0; e < NE; ++e) if (e == bi) lv[e] = -3.0e38f;
                            tv[t] = best; te[t] = bi; }
                        const float e1 = expf(tv[1] - tv[0]), e2 = expf(tv[2] - tv[0]), e3 = expf(tv[3] - tv[0]); const float inv = 1.0f / (1.0f + e1 + e2 + e3);
                        *(f32x4*)((float*)(ws + WS_TOPW) + (size_t)m * 4) = (f32x4){inv, e1 * inv, e2 * inv, e3 * inv};
#pragma unroll
                        for (int t = 0; t < 4; ++t) { const unsigned rk = __hip_atomic_fetch_add((LAS unsigned*)&MISC[MW_HIST + te[t]], 1u, __ATOMIC_RELAXED, __HIP_MEMORY_SCOPE_WORKGROUP);
                            ((LAS unsigned*)(lds + LR_SLT))[i * 4 + t] = ((unsigned)te[t] << 16) | rk; } } } }
            __syncthreads(); }
        if (P5) { if (tid < NE) { const unsigned hcnt = MISC[MW_HIST + tid]; MISC[MW_BASE + tid] = hcnt ? atomicAdd((unsigned*)(ctl + CW_CNT + layer * NE + tid), hcnt) : 0u; }
            __syncthreads();
            if (tid < 256) { LAS unsigned* sl = (LAS unsigned*)(lds + LR_SLT) + tid; const unsigned v = *sl, e = v >> 16; const unsigned slot = (e << ECAP_SH) + MISC[MW_BASE + e] + (v & 0xffffu);
                *sl = slot; ((int*)(ws + WS_SLOT))[(size_t)row0 * 4 + tid] = (int)slot; }
            if (tid < NE) MISC[MW_HIST + tid] = 0u;
            __syncthreads(); }
        if (P5) flat_modulate<true, true>(xin, row0, rstds, nw, scp, shp, H, ws + WS_A1, lds, tid);
        else flat_modulate<F8_IN, false>(xin, row0, rstds, nw, scp, shp, H, ws + WS_A1, lds, tid);
        __syncthreads();
    }
}

__device__ __forceinline__ void final_rows(const Args& a, LAS unsigned char* lds, int vcu, int G, int tid, int lane) {
    unsigned char* ws = a.ws; const bf16* X = (const bf16*)(ws + WS_X); const float* MOD = (const float*)(ws + WS_MOD); LAS float* ssr = (LAS float*)(lds + LR_SSR);
    for (int row0 = vcu * 64; row0 < MTOK; row0 += G * 64) { const int b = row0 / SEQ;
        stage_slots(ws, row0, lds, tid); if (tid < 64) ssr[tid] = 0.f;
        __syncthreads();
        flat_combine<true, true>(X, a.out, row0, (const bf16*)(ws + WS_Y), MOD + ((size_t)(DEPTH - 1) * 2 + b) * 6144 + 5 * D, lds, tid, lane);
        asm volatile("s_waitcnt vmcnt(0)" ::: "memory");
        __syncthreads();
        { const int c4 = tid & 255, rsub = tid >> 8; const f32x4 w = *(const f32x4*)(a.final_norm_w + 4 * c4);
#pragma unroll 8
            for (int it = 0; it < 32; ++it) { const int i = 2 * it + rsub; float* op = a.out + (size_t)(row0 + i) * D + 4 * c4; const float rstd = 1.0f / sqrtf(ssr[i] * (1.0f / D) + EPS); *(GAS f32x4*)op = *(const GAS f32x4*)op * rstd * w; } }
        __syncthreads();
    }
}

__device__ __noinline__ void moe_tables(gu32* ctl, int layer, volatile LAS unsigned* MISC, int tid) {
    if (tid < NE) MISC[MW_CNT + tid] = __hip_atomic_load(ctl + CW_CNT + layer * NE + tid, RLX_AGENT);
    __syncthreads();
    if (tid == 0) { unsigned n = 0;
        for (int e = 0; e < NE; ++e) { const unsigned nt = (MISC[MW_CNT + e] + 255u) >> 8; for (unsigned t = 0; t < nt; ++t) MISC[MW_TILE + n + t] = (unsigned)(e * 64) + t; n += nt; }
        MISC[MW_NRT] = n; }
    __syncthreads();
}

constexpr int BP = 72;
template <int TYPE> struct MixCfg { static constexpr int DK = (TYPE == 1) ? 64 : 48, DV = (TYPE == 1) ? 64 : 96, NC = 4 * DK, NV = 4 * DV;
    static constexpr int STOFF = (TYPE == 0) ? ST_GLA : (TYPE == 1) ? ST_HG : ST_RET, COFF = (TYPE == 0) ? 0 : 192;
    static constexpr int CQ = (TYPE == 0) ? C_GQ : (TYPE == 1) ? C_HQ : C_RQ, CK = (TYPE == 0) ? C_GK : (TYPE == 1) ? C_HF : C_RK, CV = (TYPE == 0) ? C_GV : (TYPE == 1) ? C_HI : C_RV, CG = (TYPE == 0) ? C_GG : (TYPE == 1) ? C_HG : C_RG;
    static constexpr int MIXOFF = (TYPE == 0) ? 0 : (TYPE == 1) ? 384 : 640, KOFF = (TYPE == 0) ? 0 : (TYPE == 1) ? 192 : 448; };
__device__ __forceinline__ float fast_logsig(float x) { x = fmaxf(x, -80.f); return -__logf(1.0f + __expf(-x)); }
__device__ __forceinline__ float ret_lg(int h) { return logf(1.0f - exp2f(-5.0f - (float)h)); }

template <int NV>
__device__ __forceinline__ void stage_vt(const bf16* pv  , LAS bf16* VT, int tid) {
    constexpr int NIT = (64 * (NV / 8)) / NTHR; static_assert((64 * (NV / 8)) % NTHR == 0, "stage_vt");
    v4u p[NIT];
#pragma unroll
    for (int it = 0; it < NIT; ++it) { const int idx = tid + NTHR * it, j = idx & 63, ch = idx >> 6; p[it] = *(const v4u*)(pv + (size_t)j * NPROJ + 8 * ch); }
#pragma unroll
    for (int it = 0; it < NIT; ++it) { const int idx = tid + NTHR * it, j = idx & 63, ch = idx >> 6; LAS bf16* d = VT + (8 * ch) * BP + j;
        d[0 * BP] = (bf16)(p[it].x & 0xffffu); d[1 * BP] = (bf16)(p[it].x >> 16); d[2 * BP] = (bf16)(p[it].y & 0xffffu); d[3 * BP] = (bf16)(p[it].y >> 16);
        d[4 * BP] = (bf16)(p[it].z & 0xffffu); d[5 * BP] = (bf16)(p[it].z >> 16); d[6 * BP] = (bf16)(p[it].w & 0xffffu); d[7 * BP] = (bf16)(p[it].w >> 16); }
}

constexpr int LA_KT = 0, LA_VT = 36864, LA_TOT = 92160, LA_GA = 94208, LA_KTT = 98304, KTP = 264;
template <int TYPE>
__device__ __forceinline__ void mixa_batch(const Args& a, int layer, int unit, LAS unsigned char* lds, int tid, int lane, int wave) {
    asm volatile("" : "+v"(tid), "+v"(lane));
    typedef MixCfg<TYPE> C; constexpr int DK = C::DK, DV = C::DV, NC = C::NC, NV = C::NV;
    unsigned char* ws = a.ws; const bf16* PROJ = (const bf16*)(ws + WS_PROJ); bf16* F1 = (bf16*)(ws + WS_CUM); float* ECG = (float*)(ws + WS_CUM + 16 * MiB) + (size_t)unit * 4 * NDV; float* DVEC = (float*)(ws + WS_DVEC) + (size_t)unit * NDV;
    bf16* U = (bf16*)(ws + WS_U) + (size_t)unit * ST_TOT + C::STOFF;
    LAS bf16* KT = (LAS bf16*)(lds + LA_KT); LAS bf16* VT = (LAS bf16*)(lds + LA_VT); LAS float* TOT = (LAS float*)(lds + LA_TOT); const LAS float* GAs = (const LAS float*)(lds + LA_GA);
    const int row0 = unit * CH;
    stage_vt<NV>(PROJ + (size_t)row0 * NPROJ + C::CV, VT, tid);
    const bool act = tid < 2 * NC; const int c = act ? tid % NC : 0, half = act ? tid / NC : 0, h = c / DK, d = c - h * DK;
    float cum[32]; float tot = 0.f;
    float w2[16], b2 = 0.f, lbv = 0.f, lg = 0.f, sg = 0.f; int f = 0, d2 = 0;
    if (act) {
        if constexpr (TYPE == 0) { b2 = a.gla_ba2[layer * 192 + c];
#pragma unroll
            for (int r = 0; r < 16; ++r) w2[r] = a.gla_wa2[(layer * 16 + r) * 192 + c]; }
        if constexpr (TYPE == 1) lbv = ((const float*)(ws + WS_LB))[layer * 256 + c];
        if constexpr (TYPE == 2) { lg = ret_lg(h); f = (d < 24) ? d : d - 24; d2 = (d < 24) ? d + 24 : d - 24; sg = (d < 24) ? -1.f : 1.f; }
#pragma unroll
        for (int gq = 0; gq < 2; ++gq) {
            bf16 hraw[16];
            if constexpr (TYPE == 1) {
#pragma unroll
                for (int i = 0; i < 16; ++i) hraw[i] = PROJ[(size_t)(row0 + 32 * half + 16 * gq + i) * NPROJ + C_HF + c]; }
#pragma unroll
            for (int ii = 0; ii < 16; ++ii) { const int i = 16 * gq + ii, t = 32 * half + i; float g;
                if constexpr (TYPE == 0) { float pre = b2;
#pragma unroll
                    for (int r = 0; r < 16; ++r) pre += GAs[t * 16 + r] * w2[r];
                    g = fast_logsig(pre) * (1.0f / 16.0f); }
                else if constexpr (TYPE == 1) { const float hf = fminf(fmaxf(bf2f(hraw[ii]), -80.f), 80.f); const float sgm = __builtin_amdgcn_rcpf(1.0f + __expf(-hf));
                    g = __logf(lbv + (1.0f - lbv) * sgm); }
                else g = lg;
                tot += g; cum[i] = tot;
                if constexpr (TYPE == 0) { if ((ii & 3) == 3) asm volatile("" ::: "memory"); } } }
        TOT[c * 2 + half] = tot;
    }
    __syncthreads();
    if (act) { const float t0 = TOT[c * 2], t1 = TOT[c * 2 + 1]; const float off = half ? t0 : 0.f, last = t0 + t1;
#pragma unroll
        for (int hq = 0; hq < 4; ++hq) {
            bf16 ka[8], kb[8]; float cs[8], sn[8];
            if constexpr (TYPE != 1) {
#pragma unroll
                for (int i = 0; i < 8; ++i) { const size_t row = (size_t)(row0 + 32 * half + 8 * hq + i); const bf16* pr = PROJ + row * NPROJ;
                    if constexpr (TYPE == 0) ka[i] = pr[C_GK + c];
                    else { const float* rp = (const float*)(ws + WS_ROPE) + row * 48; ka[i] = pr[C_RK + h * 48 + d]; kb[i] = pr[C_RK + h * 48 + d2]; cs[i] = rp[f]; sn[i] = rp[24 + f]; } } }
            float kt[8];
#pragma unroll
            for (int j = 0; j < 8; ++j) { const int i = 8 * hq + j; const float cm = cum[i] + off; const size_t row = (size_t)(row0 + 32 * half + i); float k;
                if constexpr (TYPE == 0) k = bf2f(ka[j]);
                else if constexpr (TYPE == 1) k = 1.0f - __expf(cum[i] - (i > 0 ? cum[i - 1] : 0.f));
                else k = bf2f(ka[j]) * cs[j] + sg * bf2f(kb[j]) * sn[j];
                if constexpr (TYPE != 2) *(GAS bf16*)(F1 + row * NDV + C::COFF + c) = (bf16)f2bf(__expf(cm - ((i < 16) ? off : cum[15] + off)));
                { const float eb = cum[(i < 16) ? 15 : 31] + off;
                  ((LAS bf16*)(lds + LA_KTT))[(32 * half + i) * KTP + c] = (bf16)f2bf(k * __expf(eb - cm)); }
                kt[j] = k * __expf(last - cm); }
            v4u w; w.x = pk2(kt[0], kt[1]); w.y = pk2(kt[2], kt[3]); w.z = pk2(kt[4], kt[5]); w.w = pk2(kt[6], kt[7]);
            *(LAS v4u*)(KT + c * BP + 32 * half + 8 * hq) = w; }
        if (TYPE != 2) { *(GAS float*)(ECG + (2 * half + 0) * NDV + C::COFF + c) = cum[15] + off; *(GAS float*)(ECG + (2 * half + 1) * NDV + C::COFF + c) = cum[31] + off; }
        if (TYPE != 2 && half == 0) *(GAS float*)(DVEC + C::COFF + c) = __expf(last);
    }
    __syncthreads();
    { constexpr int CPR = NC / 8;
#pragma unroll
        for (int it = 0; it < (64 * CPR) / NTHR; ++it) { const int idx = tid + NTHR * it, t = idx / CPR, ch = idx - t * CPR;
            *(GAS v4u*)((bf16*)(ws + WS_KT) + (size_t)(row0 + t) * NKT + C::KOFF + 8 * ch) = *(const LAS v4u*)((const LAS bf16*)(lds + LA_KTT) + t * KTP + 8 * ch); } }
    constexpr int TD = DK / 16, NT = (DV / 16) * TD;
    for (int ti = wave; ti < 4 * NT; ti += NWAVES) { const int hh = ti / NT, tr = ti - hh * NT, te = tr / TD, td = tr - te * TD; f32x4 acc = {0.f, 0.f, 0.f, 0.f};
#pragma unroll
        for (int kk = 0; kk < 2; ++kk) acc = __builtin_amdgcn_mfma_f32_16x16x32_bf16(ldfrag(VT, BP, hh * DV + te * 16, kk * 32, lane), ldfrag(KT, BP, hh * DK + td * 16, kk * 32, lane), acc, 0, 0, 0);
        bf16* Uh = U + hh * DK * DV;
#pragma unroll
        for (int r = 0; r < 4; ++r) *(GAS bf16*)(Uh + (te * 16 + (lane >> 4) * 4 + r) * DK + td * 16 + (lane & 15)) = (bf16)f2bf(acc[r]); }
    __syncthreads();
}
__device__ __forceinline__ void p3a_summaries(const Args& a, int layer, LAS unsigned char* lds, int vcu, int G, int tid, int lane, int wave) {
    for (int unit = vcu; unit < NUNIT; unit += G) {
        { LAS float* GAs = (LAS float*)(lds + LA_GA); const float* GA = (const float*)(a.ws + WS_GA); for (int i = tid; i < CH * 16; i += NTHR) GAs[i] = GA[(size_t)unit * CH * 16 + i]; }
        __syncthreads();
        mixa_batch<0>(a, layer, unit, lds, tid, lane, wave);
        mixa_batch<1>(a, layer, unit, lds, tid, lane, wave);
        mixa_batch<2>(a, layer, unit, lds, tid, lane, wave);
    }
}

__device__ __forceinline__ void p3b_scan(const Args& a, int vcu, int G, int tid) {
    unsigned char* ws = a.ws; const bf16* U = (const bf16*)(ws + WS_U); const float* DVEC = (const float*)(ws + WS_DVEC); bf16* SP = (bf16*)(ws + WS_SP);
    for (int gid = vcu * NTHR + tid; gid < BATCH * ST_TOT; gid += G * NTHR) {
        const int b = gid / ST_TOT, el = gid - b * ST_TOT;
        int di = -1; float cdec = 0.f;
        if (el < ST_HG) { const int h = el / 4608, d = (el - h * 4608) % 48; di = h * 48 + d; }
        else if (el < ST_RET) { const int r = el - ST_HG, h = r / 4096, d = r % 64; di = 192 + h * 64 + d; }
        else { const int h = (el - ST_RET) / 4608; cdec = expf(64.0f * logf(1.0f - exp2f(-5.0f - (float)h))); }
        const bf16* up = U + (size_t)b * NCH * ST_TOT + el; const float* dp = DVEC + (size_t)b * NCH * NDV + (di < 0 ? 0 : di); bf16* sp = SP + (size_t)b * NCH * ST_TOT + el;
        float s = 0.f;
#pragma unroll 1
        for (int n0 = 0; n0 < NCH; n0 += 32) { float u[32], dc[32];
#pragma unroll
            for (int i = 0; i < 32; ++i) { u[i] = bf2f(up[(size_t)(n0 + i) * ST_TOT]); dc[i] = (di < 0) ? cdec : dp[(size_t)(n0 + i) * NDV]; }
#pragma unroll
            for (int i = 0; i < 32; ++i) { *(GAS bf16*)(sp + (size_t)(n0 + i) * ST_TOT) = (bf16)f2bf(s); s = dc[i] * s + u[i]; } }
    }
}

#ifndef SUB_MASK
#define SUB_MASK 0
#endif
#define SUBSTRETCH(bit, t0_) do { if ((SUB_MASK >> (bit)) & 1) { const unsigned long long t1_ = __builtin_amdgcn_s_memrealtime(); while (__builtin_amdgcn_s_memrealtime() - t1_ < t1_ - (t0_)) __builtin_amdgcn_s_sleep(8); } } while (0)
constexpr int LC_VT = 0, LC_ST = 55296, LC_AB = 110592, OBP = 104, LC_EC = 137216;
template <int TYPE, bool ISQ>
__device__ __forceinline__ void mix_frag(const Args& a, int h, size_t row, int t, int d0, float (&x)[8], float (&cm)[8]) {
    typedef MixCfg<TYPE> C; constexpr int DK = C::DK; static_assert(ISQ, "query path only");
    unsigned char* ws = a.ws; const bf16* pr = (const bf16*)(ws + WS_PROJ) + row * NPROJ;
    if constexpr (TYPE != 2) {
        const v4u p = *(const v4u*)(pr + C::CQ + h * DK + d0); const unsigned pw[4] = {p.x, p.y, p.z, p.w};
        const v4u f = *(const v4u*)((const bf16*)(ws + WS_CUM) + row * NDV + C::COFF + h * DK + d0); const unsigned fw[4] = {f.x, f.y, f.z, f.w};
#pragma unroll
        for (int j = 0; j < 4; ++j) { x[2 * j] = __builtin_bit_cast(float, pw[j] << 16); x[2 * j + 1] = __builtin_bit_cast(float, pw[j] & 0xffff0000u); cm[2 * j] = __builtin_bit_cast(float, fw[j] << 16); cm[2 * j + 1] = __builtin_bit_cast(float, fw[j] & 0xffff0000u); }
        if constexpr (TYPE == 0) {
#pragma unroll
            for (int j = 0; j < 8; ++j) x[j] *= 0.14433756729740643f; }
    } else {
        const int f0 = (d0 < 24) ? d0 : d0 - 24, dp = (d0 < 24) ? d0 + 24 : d0 - 24; const float sg = (d0 < 24) ? -1.f : 1.f;
        const int cb = C_RQ + h * DK; const v4u p = *(const v4u*)(pr + cb + d0), pp = *(const v4u*)(pr + cb + dp); const unsigned pw[4] = {p.x, p.y, p.z, p.w}, qw[4] = {pp.x, pp.y, pp.z, pp.w};
        const float* rp = (const float*)(ws + WS_ROPE) + row * 48; const f32x4 cs0 = *(const f32x4*)(rp + f0), cs1 = *(const f32x4*)(rp + f0 + 4), sn0 = *(const f32x4*)(rp + 24 + f0), sn1 = *(const f32x4*)(rp + 24 + f0 + 4);
        const float cmv = (float)(t + 1) * ret_lg(h);
#pragma unroll
        for (int j = 0; j < 4; ++j) { const float xa = __builtin_bit_cast(float, pw[j] << 16), xb = __builtin_bit_cast(float, pw[j] & 0xffff0000u), ya = __builtin_bit_cast(float, qw[j] << 16), yb = __builtin_bit_cast(float, qw[j] & 0xffff0000u);
            const float ca = (j < 2) ? cs0[2 * j] : cs1[2 * j - 4], cb2 = (j < 2) ? cs0[2 * j + 1] : cs1[2 * j - 3], sa = (j < 2) ? sn0[2 * j] : sn1[2 * j - 4], sb = (j < 2) ? sn0[2 * j + 1] : sn1[2 * j - 3];
            x[2 * j] = (xa * ca + sg * ya * sa) * 0.14433756729740643f; x[2 * j + 1] = (xb * cb2 + sg * yb * sb) * 0.14433756729740643f; cm[2 * j] = cmv; cm[2 * j + 1] = cmv; }
    }
}

template <int TYPE>
__device__ __forceinline__ void mixc_batch(const Args& a, int layer, int unit, LAS unsigned char* lds, int tid, int lane, int wave) {
    asm volatile("" : "+v"(tid), "+v"(lane));
    typedef MixCfg<TYPE> C; constexpr int DK = C::DK, DV = C::DV, NV = C::NV, TE = DV / 16;
    unsigned char* ws = a.ws; const bf16* PROJ = (const bf16*)(ws + WS_PROJ); bf16* MIX = (bf16*)(ws + WS_MIX);
    LAS bf16* VT = (LAS bf16*)(lds + LC_VT); LAS bf16* ST = (LAS bf16*)(lds + LC_ST); LAS bf16* AB = (LAS bf16*)(lds + LC_AB) + wave * 16 * OBP;
    const int row0 = unit * CH;
    const unsigned long long ts0_ = SUB_MASK ? __builtin_amdgcn_s_memrealtime() : 0ull;
    stage_vt<NV>(PROJ + (size_t)row0 * NPROJ + C::CV, VT, tid);
    SUBSTRETCH(3, ts0_);
    const unsigned long long ts3_ = SUB_MASK ? __builtin_amdgcn_s_memrealtime() : 0ull;
    { const bf16* SPu = (const bf16*)(ws + WS_SP) + (size_t)unit * ST_TOT + C::STOFF;
        constexpr int NIS = (NV * 8) / NTHR; static_assert((NV * 8) % NTHR == 0, "ST staging"); v4u sw[NIS];
#pragma unroll
        for (int it = 0; it < NIS; ++it) { const int idx = tid + NTHR * it, er = idx >> 3, ch = idx & 7; sw[it] = (v4u){0u, 0u, 0u, 0u}; if (ch * 8 < DK) sw[it] = *(const v4u*)(SPu + (size_t)er * DK + ch * 8); }
#pragma unroll
        for (int it = 0; it < NIS; ++it) { const int idx = tid + NTHR * it, er = idx >> 3, ch = idx & 7; *(LAS v4u*)(ST + er * BP + ch * 8) = sw[it]; } }
    SUBSTRETCH(4, ts3_);
    SUBSTRETCH(0, ts0_);
    if constexpr (TYPE != 2) { LAS float* EC = (LAS float*)(lds + LC_EC);
        for (int idx = tid; idx < 4 * C::NC; idx += NTHR) { const int jb = idx / C::NC, cc = idx - jb * C::NC; EC[jb * 256 + cc] = ((const float*)(ws + WS_CUM + 16 * MiB))[((size_t)unit * 4 + jb) * NDV + C::COFF + cc]; } }
    __syncthreads();
    const unsigned long long ts1_ = SUB_MASK ? __builtin_amdgcn_s_memrealtime() : 0ull;
    const int h = wave >> 1, hsel = wave & 1, r = lane & 15, g = lane >> 4;
    const LAS bf16* STh = ST + h * DV * BP; const LAS bf16* VTh = VT + h * DV * BP;
    constexpr int NCHK = DV / 8, NOC = (16 * NCHK) / 64;
#pragma unroll 1
    for (int ib = 0; ib < 2; ++ib) { const int I = ib ? 3 - hsel : hsel;
        pg8::bf16x8 qh[2], qt[2]; float refv[2][8], qhf[2][8];
#pragma unroll
        for (int s = 0; s < 2; ++s) { const int d0 = 32 * s + 8 * g; const bool valid = d0 < DK; const int d0c = valid ? d0 : 0;
            float x[8], cm[8]; mix_frag<TYPE, true>(a, h, (size_t)(row0 + 16 * I + r), 16 * I + r, d0c, x, cm);
            if constexpr (TYPE == 2) {
#pragma unroll
                for (int j = 0; j < 8; ++j) refv[s][j] = (float)(16 * I) * ret_lg(h);
            } else { if (I > 0) { const LAS float* cp = (const LAS float*)(lds + LC_EC) + (I - 1) * 256 + h * DK + d0c; const f32x4 c0 = *(const LAS f32x4*)cp, c1 = *(const LAS f32x4*)(cp + 4);
#pragma unroll
                    for (int j = 0; j < 4; ++j) { refv[s][j] = c0[j]; refv[s][4 + j] = c1[j]; } }
                else {
#pragma unroll
                    for (int j = 0; j < 8; ++j) refv[s][j] = 0.f; } }
            float xt[8];
#pragma unroll
            for (int j = 0; j < 8; ++j) { if constexpr (TYPE == 2) { qhf[s][j] = valid ? x[j] * __expf(cm[j] - refv[s][j]) : 0.f; xt[j] = valid ? x[j] * __expf(cm[j]) : 0.f; }
                else { qhf[s][j] = valid ? x[j] * cm[j] : 0.f; xt[j] = qhf[s][j] * __expf(refv[s][j]); } }
            qh[s] = pack8(qhf[s]); qt[s] = pack8(xt); }
        v4u kf[4][2];
#pragma unroll
        for (int J = 0; J < 4; ++J) { const int Jc = (J < I) ? J : I; const size_t rowJ = (size_t)(row0 + 16 * Jc + r);
#pragma unroll
            for (int s = 0; s < 2; ++s) { const int d0 = 32 * s + 8 * g; const int d0c = (d0 < DK) ? d0 : 0;
                kf[J][s] = *(const v4u*)((const bf16*)(ws + WS_KT) + rowJ * NKT + C::KOFF + h * DK + d0c); } }
#pragma unroll
        for (int J = 0; J < 4; ++J) { if (J <= I) { f32x4 acc = {0.f, 0.f, 0.f, 0.f};
#pragma unroll
            for (int s = 0; s < 2; ++s) { pg8::bf16x8 qop;
                { float xq[8], ej[8]; const int d0 = 32 * s + 8 * g; const int d0c = (d0 < DK) ? d0 : 0;
                    if constexpr (TYPE == 2) {
#pragma unroll
                        for (int j = 0; j < 8; ++j) ej[j] = (float)(16 * (J + 1)) * ret_lg(h); }
                    else { const LAS float* ep = (const LAS float*)(lds + LC_EC) + J * 256 + h * DK + d0c; const f32x4 e0 = *(const LAS f32x4*)ep, e1 = *(const LAS f32x4*)(ep + 4);
#pragma unroll
                        for (int j = 0; j < 4; ++j) { ej[j] = e0[j]; ej[4 + j] = e1[j]; } }
#pragma unroll
                    for (int j = 0; j < 8; ++j) xq[j] = qhf[s][j] * __expf(fminf(refv[s][j] - ej[j], 80.f));
                    qop = pack8(xq); }
                acc = __builtin_amdgcn_mfma_f32_16x16x32_bf16(qop, __builtin_bit_cast(pg8::bf16x8, kf[J][s]), acc, 0, 0, 0); }
#pragma unroll
            for (int q = 0; q < 4; ++q) { const int i = 4 * g + q; const float v = (J < I || r <= i) ? acc[q] : 0.f; AB[i * BP + 16 * J + r] = (bf16)f2bf(v); } } }
        if ((I & 1) == 0) {
#pragma unroll
            for (int q = 0; q < 4; ++q) AB[(4 * g + q) * BP + 16 * (I + 1) + r] = (bf16)0; }
        asm volatile("s_waitcnt lgkmcnt(0)" ::: "memory");
        const pg8::bf16x8 ah0 = *(const LAS pg8::bf16x8*)(AB + r * BP + 8 * g), ah1 = *(const LAS pg8::bf16x8*)(AB + r * BP + 32 + 8 * g);
        f32x4 o[TE];
#pragma unroll
        for (int te = 0; te < TE; ++te) { f32x4 acc = {0.f, 0.f, 0.f, 0.f};
            acc = __builtin_amdgcn_mfma_f32_16x16x32_bf16(qt[0], ldfrag(STh, BP, te * 16, 0, lane), acc, 0, 0, 0);
            acc = __builtin_amdgcn_mfma_f32_16x16x32_bf16(qt[1], ldfrag(STh, BP, te * 16, 32, lane), acc, 0, 0, 0);
            acc = __builtin_amdgcn_mfma_f32_16x16x32_bf16(ah0, ldfrag(VTh, BP, te * 16, 0, lane), acc, 0, 0, 0);
            if (I >= 2) acc = __builtin_amdgcn_mfma_f32_16x16x32_bf16(ah1, ldfrag(VTh, BP, te * 16, 32, lane), acc, 0, 0, 0);
            o[te] = acc; }
        const unsigned long long ts2_ = SUB_MASK ? __builtin_amdgcn_s_memrealtime() : 0ull;
#pragma unroll
        for (int q = 0; q < 4; ++q) { float s1 = 0.f, s2 = 0.f;
#pragma unroll
            for (int te = 0; te < TE; ++te) { s1 += o[te][q]; s2 += o[te][q] * o[te][q]; }
#pragma unroll
            for (int m = 1; m < 16; m <<= 1) { s1 += __shfl_xor(s1, m); s2 += __shfl_xor(s2, m); }
            float mean = 0.f, rstd;
            if constexpr (TYPE == 2) { mean = s1 * (1.0f / DV); rstd = __builtin_amdgcn_rsqf(fmaxf(s2 * (1.0f / DV) - mean * mean, 0.f) + EPS); }
            else rstd = __builtin_amdgcn_rsqf(s2 * (1.0f / DV) + EPS);
#pragma unroll
            for (int te = 0; te < TE; ++te) AB[(4 * g + q) * OBP + te * 16 + r] = (bf16)f2bf((o[te][q] - mean) * rstd); }
        asm volatile("s_waitcnt lgkmcnt(0)" ::: "memory");
#pragma unroll 1
        for (int i = 0; i < NOC; ++i) { const int cidx = lane + 64 * i, orow = cidx / NCHK, ch = cidx - orow * NCHK; const size_t row = (size_t)(row0 + 16 * I + orow);
            const v4u ov = *(const LAS v4u*)(AB + orow * OBP + 8 * ch); const v4u gv = *(const v4u*)(PROJ + row * NPROJ + C::CG + h * DV + 8 * ch);
            const unsigned ow[4] = {ov.x, ov.y, ov.z, ov.w}, gw[4] = {gv.x, gv.y, gv.z, gv.w}; float res[8];
            f32x4 w0 = {1.f, 1.f, 1.f, 1.f}, w1 = {1.f, 1.f, 1.f, 1.f};
            if constexpr (TYPE == 0) { const float* wp = a.gla_norm_w + layer * 384 + h * 96 + 8 * ch; w0 = *(const f32x4*)wp; w1 = *(const f32x4*)(wp + 4); }
            if constexpr (TYPE == 1) { const float* wp = a.hg_norm_w + layer * 256 + h * 64 + 8 * ch; w0 = *(const f32x4*)wp; w1 = *(const f32x4*)(wp + 4); }
#pragma unroll
            for (int j = 0; j < 4; ++j) { const float oa = __builtin_bit_cast(float, ow[j] << 16), ob = __builtin_bit_cast(float, ow[j] & 0xffff0000u), ga = __builtin_bit_cast(float, gw[j] << 16), gb = __builtin_bit_cast(float, gw[j] & 0xffff0000u);
                const float wa = (j < 2) ? w0[2 * j] : w1[2 * j - 4], wb = (j < 2) ? w0[2 * j + 1] : w1[2 * j - 3];
                const float sa = __builtin_amdgcn_rcpf(1.0f + __expf(-ga)), sb = __builtin_amdgcn_rcpf(1.0f + __expf(-gb));
                res[2 * j] = oa * wa * ((TYPE == 1) ? sa : ga * sa); res[2 * j + 1] = ob * wb * ((TYPE == 1) ? sb : gb * sb); }
            if (F8_OUT) { typedef int i32x2 __attribute__((ext_vector_type(2)));
                *(GAS i32x2*)((unsigned char*)MIX + row * D + C::MIXOFF + h * DV + 8 * ch) = (i32x2){pk4_fp8(res[0] * S8_M, res[1] * S8_M, res[2] * S8_M, res[3] * S8_M), pk4_fp8(res[4] * S8_M, res[5] * S8_M, res[6] * S8_M, res[7] * S8_M)}; }
            else { v4u w; w.x = pk2(res[0], res[1]); w.y = pk2(res[2], res[3]); w.z = pk2(res[4], res[5]); w.w = pk2(res[6], res[7]); *(GAS v4u*)(MIX + row * D + C::MIXOFF + h * DV + 8 * ch) = w; } }
        SUBSTRETCH(2, ts2_);
    }
    SUBSTRETCH(1, ts1_);
    __syncthreads();
}
__device__ __forceinline__ void p3c_outputs(const Args& a, int layer, LAS unsigned char* lds, int vcu, int G, int tid, int lane, int wave) {
    for (int unit = vcu; unit < NUNIT; unit += G) {
        mixc_batch<0>(a, layer, unit, lds, tid, lane, wave);
        mixc_batch<1>(a, layer, unit, lds, tid, lane, wave);
        mixc_batch<2>(a, layer, unit, lds, tid, lane, wave);
    }
}


constexpr int MW_ARGS = 800;
__device__ __forceinline__ const void* ld_argp(const volatile LAS unsigned* T, int i) {
    const unsigned lo = __builtin_amdgcn_readfirstlane(T[2 * i]), hi = __builtin_amdgcn_readfirstlane(T[2 * i + 1]);
    return (const void*)(((unsigned long long)hi << 32) | lo);
}
__device__ __forceinline__ Args load_args(LAS unsigned char* lds) {
    const volatile LAS unsigned* T = (const volatile LAS unsigned*)(lds + MISC_OFF) + MW_ARGS;
    Args a;
    a.x = (const float*)ld_argp(T, 0); a.c = (const float*)ld_argp(T, 1); a.pos = (const int*)ld_argp(T, 2); a.w_mod = (const float*)ld_argp(T, 3); a.b_mod = (const float*)ld_argp(T, 4);
    a.norm1_w = (const float*)ld_argp(T, 5); a.w_in = (const float*)ld_argp(T, 6); a.gla_wa2 = (const float*)ld_argp(T, 7); a.gla_ba2 = (const float*)ld_argp(T, 8); a.hg_lb = (const float*)ld_argp(T, 9);
    a.gla_norm_w = (const float*)ld_argp(T, 10); a.hg_norm_w = (const float*)ld_argp(T, 11); a.w_out = (const float*)ld_argp(T, 12); a.norm2_w = (const float*)ld_argp(T, 13); a.w_r = (const float*)ld_argp(T, 14);
    a.b_r = (const float*)ld_argp(T, 15); a.w_gu = (const float*)ld_argp(T, 16); a.b_gu = (const float*)ld_argp(T, 17); a.w_dn = (const float*)ld_argp(T, 18); a.b_dn = (const float*)ld_argp(T, 19);
    a.final_norm_w = (const float*)ld_argp(T, 20); a.out = (float*)ld_argp(T, 21); a.ws = (unsigned char*)ld_argp(T, 22); a.ph_lo = 0; a.ph_hi = 0;
    return a;
}
#define PH_CTX() { unsigned l_ = (unsigned)(size_t)lds; asm volatile("" : "+s"(l_)); lds = (LAS unsigned char*)(size_t)l_; } const Args args = load_args(lds); volatile LAS unsigned* MISC = (volatile LAS unsigned*)(lds + MISC_OFF); int tid_ = wv * 64 + (int)__builtin_amdgcn_mbcnt_hi(~0u, __builtin_amdgcn_mbcnt_lo(~0u, 0u)); asm volatile("" : "+v"(tid_)); const int tid = tid_, lane = tid & 63, wave = __builtin_amdgcn_readfirstlane(tid >> 6); \
    const int G = gridDim.x; const int bx = blockIdx.x; const int vcu = (G % 8 == 0) ? (bx % 8) * (G / 8) + bx / 8 : bx; unsigned char* ws = args.ws; gu32* ctl = (gu32*)(ws + WS_CTL); \
    (void)MISC; (void)lane; (void)wave; (void)vcu; (void)ctl; (void)bx; (void)tid
__device__ __forceinline__ void ph_p0(LAS unsigned char* lds, int wv) { PH_CTX(); p0_prologue(args, lds, vcu, G, tid, lane, wave); }
__device__ __forceinline__ void ph_p1(LAS unsigned char* lds, int wv, int layer_) { int layer = __builtin_amdgcn_readfirstlane(layer_); asm volatile("" : "+s"(layer)); PH_CTX();
    if (layer > 0) { moe_tables(ctl, layer - 1, MISC, tid); const int nrt = __builtin_amdgcn_readfirstlane((int)MISC[MW_NRT]);
        const int done = conv_t2(G) + conv_idle(nrt * 8, G) * NWAVES * CB7 + conv_idle(nrt * 4, G) * NWAVES * CB8; LAS float* scr = (LAS float*)(lds + wave * 16640);
        for (int it = done + vcu * NWAVES + wave; it < IT_LAYER; it += G * NWAVES) convert_item(args, layer, it, scr, lane);
        __syncthreads(); }
    rows_mfma<16>(args, layer, lds, MISC, ctl, vcu, G, tid, lane, wave); }
__device__ __forceinline__ void ph_p2(LAS unsigned char* lds, int wv, int layer_) { int layer = __builtin_amdgcn_readfirstlane(layer_); asm volatile("" : "+s"(layer)); PH_CTX();
    pg8::Gemm g{(const bf16*)(ws + WS_H), (const bf16*)(ws + WS_WIN + (size_t)layer * NPROJ * D * (F8_IN ? 1 : 2)), MTOK, NPROJ, F8_IN ? D / 2 : D}; pg8::StaticOrder S; S.init(MTOK, NPROJ, G, bx);
    pg8::EpiBf16Plain E{(bf16*)(ws + WS_PROJ), NPROJ, F8_IN ? 1.0f / (S8_H * S8_W) : 1.0f};
    pg8::gemm_phase<pg8::EpiBf16Plain, pg8::StaticOrder, true, true, F8_IN>(lds, g, S, E, tid);
    if (layer + 1 < DEPTH && G == 256 && bx >= 64) convert_range(args, layer + 1, ((bx - 64) * NWAVES + wave) * CB2, CB2, lds, lane, wave); }
__device__ __forceinline__ void ph_p3a(LAS unsigned char* lds, int wv, int layer_) { int layer = __builtin_amdgcn_readfirstlane(layer_); asm volatile("" : "+s"(layer)); PH_CTX(); p3a_summaries(args, layer, lds, vcu, G, tid, lane, wave); }
__device__ __forceinline__ void ph_p3b(LAS unsigned char* lds, int wv) { PH_CTX(); p3b_scan(args, vcu, G, tid); }
__device__ __forceinline__ void ph_p3c(LAS unsigned char* lds, int wv, int layer_) { int layer = __builtin_amdgcn_readfirstlane(layer_); asm volatile("" : "+s"(layer)); PH_CTX(); p3c_outputs(args, layer, lds, vcu, G, tid, lane, wave); }
__device__ __forceinline__ void ph_p4(LAS unsigned char* lds, int wv, int layer_) { int layer = __builtin_amdgcn_readfirstlane(layer_); asm volatile("" : "+s"(layer)); PH_CTX();
    pg8::Gemm g{(const bf16*)(ws + WS_MIX), (const bf16*)(ws + WS_WOUT + (size_t)layer * D * D * (F8_OUT ? 1 : 2)), MTOK, D, F8_OUT ? D / 2 : D}; pg8::StaticOrder S; S.init(MTOK, D, G, bx);
    pg8::EpiResGate E{(const bf16*)(ws + WS_X), (bf16*)(ws + WS_X), D, (const float*)(ws + WS_MOD) + (size_t)layer * 2 * 6144 + 2 * D, 6144, SEQ, F8_OUT ? 1.0f / (S8_M * S8_W) : 1.0f};
    pg8::gemm_phase<pg8::EpiResGate, pg8::StaticOrder, true, true, F8_OUT>(lds, g, S, E, tid); }
__device__ __forceinline__ void ph_p5(LAS unsigned char* lds, int wv, int layer_) { int layer = __builtin_amdgcn_readfirstlane(layer_); asm volatile("" : "+s"(layer)); PH_CTX(); rows_mfma<32>(args, layer, lds, MISC, ctl, vcu, G, tid, lane, wave); }
__device__ __forceinline__ void ph_p7(LAS unsigned char* lds, int wv, int layer_) { int layer = __builtin_amdgcn_readfirstlane(layer_); asm volatile("" : "+s"(layer)); PH_CTX();
    moe_tables(ctl, layer, MISC, tid);
    const int nrt = __builtin_amdgcn_readfirstlane((int)MISC[MW_NRT]);
    pg8::Gemm g{(const bf16*)(ws + WS_A1), (const bf16*)(ws + WS_WGU + (size_t)layer * NE * 2048 * D), nrt * 256, NE * 2048, D / 2};
    pg8::MoeOrder S{8, G, vcu, nrt * 8, (const LAS int*)(lds + MISC_OFF + 4 * MW_TILE)};
    pg8::EpiSwiglu E{ws + WS_ACT, FFN, args.b_gu + (size_t)layer * NE * 2048, 1.0f / (S8_H * S8_W), S8_A};
    pg8::gemm_phase<pg8::EpiSwiglu, pg8::MoeOrder, true, true, true>(lds, g, S, E, tid);
    { const int rem = (nrt * 8) % G; if (layer + 1 < DEPTH && rem != 0 && vcu >= rem) convert_range(args, layer + 1, conv_t2(G) + ((vcu - rem) * NWAVES + wave) * CB7, CB7, lds, lane, wave); } }
__device__ __forceinline__ void ph_p8(LAS unsigned char* lds, int wv, int layer_) { int layer = __builtin_amdgcn_readfirstlane(layer_); asm volatile("" : "+s"(layer)); PH_CTX();
    moe_tables(ctl, layer, MISC, tid);
    const int nrt = __builtin_amdgcn_readfirstlane((int)MISC[MW_NRT]);
    pg8::Gemm g{(const bf16*)(ws + WS_ACT), (const bf16*)(ws + WS_WDN + (size_t)layer * NE * D * FFN), nrt * 256, NE * D, FFN / 2};
    pg8::MoeOrder S{4, G, vcu, nrt * 4, (const LAS int*)(lds + MISC_OFF + 4 * MW_TILE)};
    if constexpr (Y8) { pg8::EpiFp8Bias E{ws + WS_Y, D, args.b_dn + (size_t)layer * NE * D, D, 1.0f / (S8_A * S8_W), S8_Y};
        pg8::gemm_phase<pg8::EpiFp8Bias, pg8::MoeOrder, true, true, true>(lds, g, S, E, tid); }
    else { pg8::EpiBf16Bias E{(bf16*)(ws + WS_Y), D, args.b_dn + (size_t)layer * NE * D, D, 1.0f / (S8_A * S8_W)};
        pg8::gemm_phase<pg8::EpiBf16Bias, pg8::MoeOrder, true, true, true>(lds, g, S, E, tid); }
    { const int rem = (nrt * 4) % G; if (layer + 1 < DEPTH && rem != 0 && vcu >= rem) convert_range(args, layer + 1, conv_t2(G) + conv_idle(nrt * 8, G) * NWAVES * CB7 + ((vcu - rem) * NWAVES + wave) * CB8, CB8, lds, lane, wave); } }
__device__ __forceinline__ void ph_final(LAS unsigned char* lds, int wv) { PH_CTX(); final_rows(args, lds, vcu, G, tid, lane); }

#ifndef DBL_MASK
#define DBL_MASK 0
#endif
#if DBL_MASK
#define RUN(bit, call) do { if ((DBL_MASK >> (bit)) & 1) { const unsigned long long t0_ = __builtin_amdgcn_s_memrealtime(); call; const unsigned long long t1_ = __builtin_amdgcn_s_memrealtime(); \
        while (__builtin_amdgcn_s_memrealtime() - t1_ < t1_ - t0_) __builtin_amdgcn_s_sleep(8); } else { call; } } while (0)
#else
#define RUN(bit, call) do { call; } while (0)
#endif
__global__ void __launch_bounds__(NTHR, 2) hybrid_fwd(Args args) {
    extern __shared__ __attribute__((aligned(16))) unsigned char lds_raw[];
    LAS unsigned char* lds = (LAS unsigned char*)lds_raw;
    volatile LAS unsigned* MISC = (volatile LAS unsigned*)(lds + MISC_OFF);
    const int tid = threadIdx.x; const int wv = __builtin_amdgcn_readfirstlane(tid >> 6);
    gu32* ctl = (gu32*)(args.ws + WS_CTL);
    for (int u = tid; u < (LDS_BYTES - MISC_OFF) / 4; u += NTHR) MISC[u] = 0u;
    __syncthreads();
    if (tid == 0) {
#define ST_ARG(i, p) do { const unsigned long long v_ = (unsigned long long)(p); MISC[MW_ARGS + 2 * (i)] = (unsigned)v_; MISC[MW_ARGS + 2 * (i) + 1] = (unsigned)(v_ >> 32); } while (0)
        ST_ARG(0, args.x); ST_ARG(1, args.c); ST_ARG(2, args.pos); ST_ARG(3, args.w_mod); ST_ARG(4, args.b_mod); ST_ARG(5, args.norm1_w); ST_ARG(6, args.w_in); ST_ARG(7, args.gla_wa2); ST_ARG(8, args.gla_ba2);
        ST_ARG(9, args.hg_lb); ST_ARG(10, args.gla_norm_w); ST_ARG(11, args.hg_norm_w); ST_ARG(12, args.w_out); ST_ARG(13, args.norm2_w); ST_ARG(14, args.w_r); ST_ARG(15, args.b_r); ST_ARG(16, args.w_gu);
        ST_ARG(17, args.b_gu); ST_ARG(18, args.w_dn); ST_ARG(19, args.b_dn); ST_ARG(20, args.final_norm_w); ST_ARG(21, args.out); ST_ARG(22, args.ws);
#undef ST_ARG
    }
    __syncthreads();
    const int lo = args.ph_lo, hi = args.ph_hi;
    const bool multi = (hi - lo) > 1;
    XcdBarrier bar; bar.bar = (unsigned*)(ctl + CW_BAR); bar.x = 0; bar.st = nullptr;
    if (multi) bar = xcd_barrier_post((unsigned*)(ctl + CW_BAR), MISC + MW_BAR);
#define IN(k) (lo <= (k) && (k) < hi)
#define SEAM(k) do { if (IN(k) && IN((k) + 1)) xcd_barrier(bar); } while (0)

    if (IN(0)) RUN(0, ph_p0(lds, wv));
    SEAM(0);
    for (int layer = 0; layer < DEPTH; ++layer) {
        const int pb = 1 + 9 * layer;
        if (IN(pb + 0)) RUN(1, ph_p1(lds, wv, layer));
        SEAM(pb + 0);
        if (IN(pb + 1)) RUN(2, ph_p2(lds, wv, layer));
        SEAM(pb + 1);
        if (IN(pb + 2)) RUN(3, ph_p3a(lds, wv, layer));
        SEAM(pb + 2);
        if (IN(pb + 3)) RUN(4, ph_p3b(lds, wv));
        SEAM(pb + 3);
        if (IN(pb + 4)) RUN(5, ph_p3c(lds, wv, layer));
        SEAM(pb + 4);
        if (IN(pb + 5)) RUN(6, ph_p4(lds, wv, layer));
        SEAM(pb + 5);
        if (IN(pb + 6)) RUN(7, ph_p5(lds, wv, layer));
        SEAM(pb + 6);
        if (IN(pb + 7)) RUN(9, ph_p7(lds, wv, layer));
        SEAM(pb + 7);
        if (IN(pb + 8)) RUN(10, ph_p8(lds, wv, layer));
        SEAM(pb + 8);
    }
    if (IN(NPHASE - 1)) RUN(11, ph_final(lds, wv));
#undef IN
#undef SEAM
}

#ifndef MK_SINGLE
#define MK_SINGLE 1
#endif
extern "C" void kernel_launch(void* const* d_in, const int* in_sizes, int n_in, void* d_out, int out_size, void* d_ws, size_t ws_size, hipStream_t stream) {
    static int grid = 0;
    if (grid == 0) {
        if (n_in != 21 || in_sizes[0] != MTOK * D || out_size != MTOK * D || ws_size < WS_END) { fprintf(stderr, "kernel_launch: unexpected problem shape (n_in %d, in0 %d, out %d, ws %zu)\n", n_in, n_in > 0 ? in_sizes[0] : -1, out_size, ws_size); grid = -1; return; }
        int dev = 0, cus = 0, per_cu = 0;
        if (hipGetDevice(&dev) != hipSuccess || hipDeviceGetAttribute(&cus, hipDeviceAttributeMultiprocessorCount, dev) != hipSuccess) { grid = -1; return; }
        if (hipFuncSetAttribute((const void*)hybrid_fwd, hipFuncAttributeMaxDynamicSharedMemorySize, LDS_BYTES) != hipSuccess) { fprintf(stderr, "kernel_launch: hipFuncSetAttribute failed\n"); grid = -1; return; }
        if (hipOccupancyMaxActiveBlocksPerMultiprocessor(&per_cu, (const void*)hybrid_fwd, NTHR, LDS_BYTES) != hipSuccess || per_cu < 1) fprintf(stderr, "kernel_launch: occupancy query says %d\n", per_cu);
        (void)hipGetLastError();
        grid = cus;
    }
    if (grid < 0) return;
    (void)hipMemsetAsync((char*)d_ws + WS_CTL, 0, CTL_ZERO_BYTES, stream);
    Args a{};
    a.x = (const float*)d_in[0]; a.c = (const float*)d_in[1]; a.pos = (const int*)d_in[2]; a.w_mod = (const float*)d_in[3]; a.b_mod = (const float*)d_in[4]; a.norm1_w = (const float*)d_in[5];
    a.w_in = (const float*)d_in[6]; a.gla_wa2 = (const float*)d_in[7]; a.gla_ba2 = (const float*)d_in[8]; a.hg_lb = (const float*)d_in[9]; a.gla_norm_w = (const float*)d_in[10]; a.hg_norm_w = (const float*)d_in[11];
    a.w_out = (const float*)d_in[12]; a.norm2_w = (const float*)d_in[13]; a.w_r = (const float*)d_in[14]; a.b_r = (const float*)d_in[15]; a.w_gu = (const float*)d_in[16]; a.b_gu = (const float*)d_in[17];
    a.w_dn = (const float*)d_in[18]; a.b_dn = (const float*)d_in[19]; a.final_norm_w = (const float*)d_in[20]; a.out = (float*)d_out; a.ws = (unsigned char*)d_ws;
#if MK_SINGLE
    a.ph_lo = 0; a.ph_hi = NPHASE;
    hipLaunchKernelGGL(hybrid_fwd, dim3(grid), dim3(NTHR), LDS_BYTES, stream, a);
#else
    for (int p = 0; p < NPHASE; ++p) { a.ph_lo = p; a.ph_hi = p + 1; hipLaunchKernelGGL(hybrid_fwd, dim3(grid), dim3(NTHR), LDS_BYTES, stream, a); }
#endif
}
```

```cpp
#include <hip/hip_runtime.h>
#include <cstdio>
#include <cstdint>
namespace pg8 {
#define PG8_LAS __attribute__((address_space(3)))
typedef unsigned short bf16_t;
typedef short bf16x8 __attribute__((ext_vector_type(8)));
typedef float f32x4 __attribute__((ext_vector_type(4)));
typedef unsigned u32x4 __attribute__((ext_vector_type(4)));
constexpr int BM = 256, BK = 64, HALF = 128, HTB = HALF * BK * 2  , STAGE_BYTES = 8 * HTB, NXCD = 8, WGM = 8;

__host__ __device__ __forceinline__ int lds_byte(int r, int c) { const int st = (r >> 4) * 2 + (c >> 5), rr = r & 15, cc = c & 31, ob = rr * 64 + cc * 2; return st * 1024 + (ob ^ (((ob >> 9) & 1) << 5)); }
__host__ __device__ __forceinline__ void stage_rc(int b, int& R, int& C) { const int st = b / 1024, sb = b % 1024, swz = sb ^ (((sb >> 9) & 1) << 5); R = (st >> 1) * 16 + swz / 64; C = (st & 1) * 32 + (swz % 64) / 2; }
__host__ __device__ __forceinline__ int perm32(int rho) { const int n = rho >> 4, i = rho & 15; return 8 * (i >> 2) + 4 * n + (i & 3); }

struct Unit { int pm, pn, e, pl; };
struct Gemm { const bf16_t* A; const bf16_t* Bt; int M, N, K; };

struct StaticOrder {
    int nM, nN, nwg, G, c;
    __host__ __device__ void init(int M, int N, int G_, int c_) { nM = M / BM; nN = N / BM; nwg = nM * nN; G = G_; c = c_; }
    __host__ __device__ bool next(int i, Unit& u) const {
        const long L = (long)i * G + c; if (L >= nwg) return false;
        int wgid = (int)L; { const int q = nwg / NXCD, r = nwg % NXCD, xcd = wgid % NXCD, off = wgid / NXCD; wgid = (xcd < r ? xcd * (q + 1) : r * (q + 1) + (xcd - r) * q) + off; }
        const int nig = WGM * nN, gid = wgid / nig, fm = gid * WGM, gsz = (nM - fm) < WGM ? (nM - fm) : WGM;
        u.pm = fm + ((wgid % nig) % gsz); u.pn = (wgid % nig) / gsz; u.e = 0; u.pl = u.pn; return true;
    }
    __device__ __forceinline__ void a_ready(const Unit&) const {}
    __device__ __forceinline__ void done(const Unit&) const {}
};

__device__ __forceinline__ unsigned cvt_pk_bf16(float lo, float hi) { unsigned r; asm volatile("v_cvt_pk_bf16_f32 %0, %1, %2" : "=v"(r) : "v"(lo), "v"(hi)); return r; }

#define PG8_GAS __attribute__((address_space(1)))
struct NoPre {};
struct EpiBf16Plain {
    static constexpr bool PERM = true, AFTER_DRAIN = false; static constexpr int NST = 0; typedef NoPre Pre;
    __device__ __forceinline__ Pre prefetch(const Unit&, int, int) const { return Pre{}; }
    bf16_t* O; int ldc; float sc;
    __device__ __forceinline__ void operator()(const f32x4 (&acc)[2][2][4][2], const Unit& u, int wr, int wc, int fr, int fq, const Pre&) const {
        const int row0 = u.pm * BM + wr * 64 + fr; const int col0 = u.pn * BM + wc * 32 + 8 * fq;
#pragma unroll
        for (int ai = 0; ai < 2; ++ai)
#pragma unroll
            for (int m = 0; m < 4; ++m) { bf16_t* rowp = O + (size_t)(row0 + ai * HALF + m * 16) * ldc + col0;
#pragma unroll
                for (int bj = 0; bj < 2; ++bj) { const f32x4 v0 = acc[ai][bj][m][0] * sc, v1 = acc[ai][bj][m][1] * sc;
                    u32x4 w; w.x = cvt_pk_bf16(v0[0], v0[1]); w.y = cvt_pk_bf16(v0[2], v0[3]); w.z = cvt_pk_bf16(v1[0], v1[1]); w.w = cvt_pk_bf16(v1[2], v1[3]);
                    *(PG8_GAS u32x4*)(rowp + bj * HALF) = w; } }
    }
};
struct EpiResGate {
    static constexpr bool PERM = true, AFTER_DRAIN = false; static constexpr int NST = 0; typedef NoPre Pre;
    __device__ __forceinline__ Pre prefetch(const Unit&, int, int) const { return Pre{}; }
    const bf16_t* base; bf16_t* out; int ldc; const float* gate; int gpitch; int rows_per_batch; float sc;
    __device__ __forceinline__ void operator()(const f32x4 (&acc)[2][2][4][2], const Unit& u, int wr, int wc, int fr, int fq, const Pre&) const {
        const int row0 = u.pm * BM + wr * 64 + fr, col0 = u.pn * BM + wc * 32 + 8 * fq;
        const float* gp = gate + (size_t)((u.pm * BM) / rows_per_batch) * gpitch + col0;
        f32x4 gv[2][2];
#pragma unroll
        for (int bj = 0; bj < 2; ++bj)
#pragma unroll
            for (int n = 0; n < 2; ++n) gv[bj][n] = *(const PG8_GAS f32x4*)(gp + bj * HALF + 4 * n) * sc;
#pragma unroll
        for (int ai = 0; ai < 2; ++ai)
#pragma unroll
            for (int m = 0; m < 4; ++m) { const size_t off = (size_t)(row0 + ai * HALF + m * 16) * ldc + col0;
#pragma unroll
                for (int bj = 0; bj < 2; ++bj) { const u32x4 bs = *(const PG8_GAS u32x4*)(base + off + bj * HALF); const unsigned bw[4] = {bs.x, bs.y, bs.z, bs.w}; float r[8];
#pragma unroll
                    for (int j = 0; j < 4; ++j) { const f32x4& a4 = acc[ai][bj][m][j >> 1]; const f32x4& g4 = gv[bj][j >> 1];
                        r[2 * j] = __builtin_bit_cast(float, bw[j] << 16) + g4[2 * (j & 1)] * a4[2 * (j & 1)]; r[2 * j + 1] = __builtin_bit_cast(float, bw[j] & 0xffff0000u) + g4[2 * (j & 1) + 1] * a4[2 * (j & 1) + 1]; }
                    u32x4 w; w.x = cvt_pk_bf16(r[0], r[1]); w.y = cvt_pk_bf16(r[2], r[3]); w.z = cvt_pk_bf16(r[4], r[5]); w.w = cvt_pk_bf16(r[6], r[7]);
                    *(PG8_GAS u32x4*)(out + off + bj * HALF) = w; }
                asm volatile("" ::: "memory"); }
    }
};
struct EpiSwiglu {
    static constexpr bool PERM = true, AFTER_DRAIN = false; static constexpr int NST = 0; struct Pre { f32x4 bg[2], bu[2]; };
    __device__ __forceinline__ Pre prefetch(const Unit& u, int wc, int fq) const { typedef const __attribute__((address_space(1))) f32x4 gf4;
        const float* bp = bias + (size_t)u.e * 2048 + u.pl * HALF + wc * 32 + 8 * fq; Pre p; p.bg[0] = *(gf4*)bp; p.bg[1] = *(gf4*)(bp + 4); p.bu[0] = *(gf4*)(bp + 1024); p.bu[1] = *(gf4*)(bp + 1028); return p; }
    unsigned char* O; int ldc; const float* bias; float inv_in, out_scale;
    __device__ __forceinline__ float act1(float g, float up) const {
        g = fminf(g, 7.0f); up = fminf(fmaxf(up, -7.0f), 7.0f);
        const float s = __builtin_amdgcn_rcpf(1.0f + __builtin_amdgcn_exp2f(-1.702f * 1.4426950408889634f * g));
        return (up + 1.0f) * g * s * out_scale;
    }
    __device__ __forceinline__ void operator()(const f32x4 (&acc)[2][2][4][2], const Unit& u, int wr, int wc, int fr, int fq, const Pre& pre) const {
        const int row0 = u.pm * BM + wr * 64 + fr; const int jj0 = wc * 32 + 8 * fq; const int col0 = u.pl * HALF + jj0;
        const f32x4 bg[2] = {pre.bg[0], pre.bg[1]}, bu[2] = {pre.bu[0], pre.bu[1]};
#pragma unroll
        for (int ai = 0; ai < 2; ++ai)
#pragma unroll
            for (int m = 0; m < 4; ++m) { unsigned char* rowp = O + (size_t)(row0 + ai * HALF + m * 16) * ldc + col0;
                f32x4 r[2];
#pragma unroll
                for (int n = 0; n < 2; ++n) { const f32x4 g = acc[ai][0][m][n] * inv_in + bg[n], up = acc[ai][1][m][n] * inv_in + bu[n];
#pragma unroll
                    for (int j = 0; j < 4; ++j) r[n][j] = act1(g[j], up[j]); }
                int w0 = 0, w1 = 0;
                w0 = __builtin_amdgcn_cvt_pk_fp8_f32(r[0][0], r[0][1], w0, false); w0 = __builtin_amdgcn_cvt_pk_fp8_f32(r[0][2], r[0][3], w0, true);
                w1 = __builtin_amdgcn_cvt_pk_fp8_f32(r[1][0], r[1][1], w1, false); w1 = __builtin_amdgcn_cvt_pk_fp8_f32(r[1][2], r[1][3], w1, true);
                typedef int i32x2 __attribute__((ext_vector_type(2))); *(PG8_GAS i32x2*)rowp = (i32x2){w0, w1}; }
    }
};
struct EpiBf16Bias {
    static constexpr bool PERM = true, AFTER_DRAIN = false; static constexpr int NST = 0; typedef NoPre Pre;
    __device__ __forceinline__ Pre prefetch(const Unit&, int, int) const { return Pre{}; }
    bf16_t* O; int ldc; const float* bias; int bpitch; float inv_in;
    __device__ __forceinline__ void operator()(const f32x4 (&acc)[2][2][4][2], const Unit& u, int wr, int wc, int fr, int fq, const Pre&) const {
        const int row0 = u.pm * BM + wr * 64 + fr; const int col0 = u.pl * BM + wc * 32 + 8 * fq;
        const float* bp = bias + (size_t)u.e * bpitch + col0;
        f32x4 bv[2][2];
#pragma unroll
        for (int bj = 0; bj < 2; ++bj)
#pragma unroll
            for (int n = 0; n < 2; ++n) bv[bj][n] = *(const PG8_GAS f32x4*)(bp + bj * HALF + 4 * n);
#pragma unroll
        for (int ai = 0; ai < 2; ++ai)
#pragma unroll
            for (int m = 0; m < 4; ++m) { bf16_t* rowp = O + (size_t)(row0 + ai * HALF + m * 16) * ldc + col0;
#pragma unroll
                for (int bj = 0; bj < 2; ++bj) { const f32x4 v0 = acc[ai][bj][m][0] * inv_in + bv[bj][0], v1 = acc[ai][bj][m][1] * inv_in + bv[bj][1];
                    u32x4 w; w.x = cvt_pk_bf16(v0[0], v0[1]); w.y = cvt_pk_bf16(v0[2], v0[3]); w.z = cvt_pk_bf16(v1[0], v1[1]); w.w = cvt_pk_bf16(v1[2], v1[3]);
                    *(PG8_GAS u32x4*)(rowp + bj * HALF) = w; } }
    }
};
struct EpiFp8Bias {
    static constexpr bool PERM = true, AFTER_DRAIN = false; static constexpr int NST = 0; struct Pre { f32x4 bv[2][2]; };
    __device__ __forceinline__ Pre prefetch(const Unit& u, int wc, int fq) const { typedef const __attribute__((address_space(1))) f32x4 gf4;
        const float* bp = bias + (size_t)u.e * bpitch + u.pl * BM + wc * 32 + 8 * fq; Pre p; p.bv[0][0] = *(gf4*)bp; p.bv[0][1] = *(gf4*)(bp + 4); p.bv[1][0] = *(gf4*)(bp + HALF); p.bv[1][1] = *(gf4*)(bp + HALF + 4); return p; }
    unsigned char* O; int ldc; const float* bias; int bpitch; float inv_in, out_scale;
    __device__ __forceinline__ int pk4(f32x4 v) const { int w = 0; w = __builtin_amdgcn_cvt_pk_fp8_f32(__builtin_amdgcn_fmed3f(v[0], -448.f, 448.f), __builtin_amdgcn_fmed3f(v[1], -448.f, 448.f), w, false);
        return __builtin_amdgcn_cvt_pk_fp8_f32(__builtin_amdgcn_fmed3f(v[2], -448.f, 448.f), __builtin_amdgcn_fmed3f(v[3], -448.f, 448.f), w, true); }
    __device__ __forceinline__ void operator()(const f32x4 (&acc)[2][2][4][2], const Unit& u, int wr, int wc, int fr, int fq, const Pre& pre) const {
        const int row0 = u.pm * BM + wr * 64 + fr; const int col0 = u.pl * BM + wc * 32 + 8 * fq;
        const f32x4 bv[2][2] = {{pre.bv[0][0], pre.bv[0][1]}, {pre.bv[1][0], pre.bv[1][1]}};
#pragma unroll
        for (int ai = 0; ai < 2; ++ai)
#pragma unroll
            for (int m = 0; m < 4; ++m) { unsigned char* rowp = O + (size_t)(row0 + ai * HALF + m * 16) * ldc + col0;
#pragma unroll
                for (int bj = 0; bj < 2; ++bj) { const f32x4 v0 = (acc[ai][bj][m][0] * inv_in + bv[bj][0]) * out_scale, v1 = (acc[ai][bj][m][1] * inv_in + bv[bj][1]) * out_scale;
                    typedef int i32x2 __attribute__((ext_vector_type(2))); *(PG8_GAS i32x2*)(rowp + bj * HALF) = (i32x2){pk4(v0), pk4(v1)}; } }
    }
};
struct MoeOrder {
    int nN, G, c, nunits; const PG8_LAS int* tile_pm;
    __device__ __forceinline__ bool next(int i, Unit& u) const {
        const int L = i * G + c; if (L >= nunits) return false;
        const int idx = L / nN, pl = L - idx * nN, pm = __builtin_amdgcn_readfirstlane(tile_pm[idx]), e = pm >> 6;
        u.pm = pm; u.pl = pl; u.e = e; u.pn = e * nN + pl; return true;
    }
    __device__ __forceinline__ void a_ready(const Unit&) const {}
    __device__ __forceinline__ void done(const Unit&) const {}
};
typedef int v4i32_t __attribute__((ext_vector_type(4)));
typedef int v8i32_t __attribute__((ext_vector_type(8)));
template <class Epi, class Sched, bool ALIGN_EPI = false, bool SP2 = false, bool FP8 = false>
__device__ __forceinline__ void gemm_phase(PG8_LAS unsigned char* lds, const Gemm g, const Sched& S, const Epi& E, int tid_in) {
    int tid_ = tid_in; asm volatile("" : "+v"(tid_)); const int tid = tid_, wid = __builtin_amdgcn_readfirstlane(tid >> 6), lane = tid & 63, wr = wid >> 2, wc = wid & 3, fr = lane & 15, fq = lane >> 4;
    const int K = g.K, nt = K / BK;
    unsigned voffA, voffB;
    { int R, C; stage_rc(tid * 16, R, C); const int Rb = Epi::PERM ? ((R & ~31) + perm32(R & 31)) : R;
        voffA = (unsigned)(R * K + C) * 2u; voffB = (unsigned)(Rb * K + C) * 2u; }
    const size_t rstep = (size_t)64 * K * 2;
    const size_t kstep = (size_t)(BK * 2);
    const size_t hstep = (size_t)HALF * K * 2;
    const size_t tstep = 2 * hstep;
    const unsigned ldsw = (unsigned)wid * 1024u;
    const int aoff = lds_byte(wr * 64 + fr, fq * 8), boff = lds_byte(wc * 32 + fr, fq * 8);
#define PG8_SA(b, h) (((b) * 2 + (h)) * HTB)
#define PG8_SB(b, h) ((4 + (b) * 2 + (h)) * HTB)
#define PG8_STAGE(bufoff, gbase, voff) do { _Pragma("unroll") for (int _i = 0; _i < 2; ++_i) \
        __builtin_amdgcn_global_load_lds((const unsigned*)((const char*)(gbase) + _i * rstep + (voff)), (PG8_LAS unsigned*)(lds + (bufoff) + ldsw + _i * 8192), 16, 0, 0); } while (0)
#define PG8_LDA(dst, b, h) do { _Pragma("unroll") for (int m = 0; m < 4; ++m) _Pragma("unroll") for (int k = 0; k < 2; ++k) dst[m][k] = *(const PG8_LAS bf16x8*)(lds + PG8_SA(b, h) + aoff + m * 2048 + k * 1024); } while (0)
#define PG8_LDB(dst, b, h) do { _Pragma("unroll") for (int n = 0; n < 2; ++n) _Pragma("unroll") for (int k = 0; k < 2; ++k) dst[n][k] = *(const PG8_LAS bf16x8*)(lds + PG8_SB(b, h) + boff + n * 2048 + k * 1024); } while (0)
#define PG8_MMA(ai, bj, At, Bt) do { __builtin_amdgcn_s_setprio(1); _Pragma("unroll") for (int m = 0; m < 4; ++m) _Pragma("unroll") for (int n = 0; n < 2; ++n) { \
        if constexpr (FP8) { const v8i32_t a8_ = __builtin_shufflevector(__builtin_bit_cast(v4i32_t, At[m][0]), __builtin_bit_cast(v4i32_t, At[m][1]), 0, 1, 2, 3, 4, 5, 6, 7); \
            const v8i32_t b8_ = __builtin_shufflevector(__builtin_bit_cast(v4i32_t, Bt[n][0]), __builtin_bit_cast(v4i32_t, Bt[n][1]), 0, 1, 2, 3, 4, 5, 6, 7); \
            asm volatile("v_mfma_scale_f32_16x16x128_f8f6f4 %0, %1, %2, %0, %3, %3 op_sel_hi:[0,0,0]" : "+v"(acc[ai][bj][m][n]) : "v"(b8_), "v"(a8_), "v"(one8_)); } \
        else { _Pragma("unroll") for (int k = 0; k < 2; ++k) acc[ai][bj][m][n] = __builtin_amdgcn_mfma_f32_16x16x32_bf16(Bt[n][k], At[m][k], acc[ai][bj][m][n], 0, 0, 0); } } \
        __builtin_amdgcn_s_setprio(0); } while (0)
#define PG8_WAIT_V(n) asm volatile("s_waitcnt vmcnt(" #n ")" ::: "memory")
#define PG8_WAIT_L(n) asm volatile("s_waitcnt lgkmcnt(" #n ")" ::: "memory")
#define PG8_WAIT_V8R(relax) do { if (relax) { if constexpr (Epi::NST == 8) PG8_WAIT_V(16); else if constexpr (Epi::NST == 16) PG8_WAIT_V(24); else PG8_WAIT_V(8); } else PG8_WAIT_V(8); } while (0)
#define PG8_BAR __builtin_amdgcn_s_barrier()
#define PG8_SCHED __builtin_amdgcn_sched_barrier(0)
    Unit cur, nxt; int ui = 0;
    if (!S.next(0, cur)) return;
    f32x4 acc[2][2][4][2];
#pragma unroll
    for (int a = 0; a < 2; ++a)
#pragma unroll
        for (int b = 0; b < 2; ++b)
#pragma unroll
            for (int m = 0; m < 4; ++m)
#pragma unroll
                for (int n = 0; n < 2; ++n) acc[a][b][m][n] = (f32x4){0.f, 0.f, 0.f, 0.f};
    bf16x8 At[4][2], B0[2][2], B1[2][2];
    int one8_ = 0x7f7f7f7f; asm volatile("" : "+v"(one8_));
    const char* cA = (const char*)g.A + (size_t)cur.pm * tstep; const char* cB = (const char*)g.Bt + (size_t)cur.pn * tstep;
    S.a_ready(cur);
    if constexpr (SP2) {
        PG8_STAGE(PG8_SB(0, 0), cB, voffB); PG8_STAGE(PG8_SB(0, 1), cB + hstep, voffB); PG8_STAGE(PG8_SA(0, 0), cA, voffA); PG8_STAGE(PG8_SA(0, 1), cA + hstep, voffA);
        if (wr == 1) PG8_BAR;
        PG8_WAIT_V(2); PG8_BAR;
        PG8_STAGE(PG8_SB(1, 0), cB + kstep, voffB); PG8_STAGE(PG8_SA(1, 0), cA + kstep, voffA); PG8_STAGE(PG8_SB(1, 1), cB + hstep + kstep, voffB);
        PG8_WAIT_V(6); PG8_BAR;
    } else {
        PG8_STAGE(PG8_SB(0, 0), cB, voffB); PG8_STAGE(PG8_SA(0, 0), cA, voffA); PG8_STAGE(PG8_SB(0, 1), cB + hstep, voffB); PG8_STAGE(PG8_SA(0, 1), cA + hstep, voffA);
        if (wr == 1) PG8_BAR;
        PG8_WAIT_V(4); PG8_BAR;
        PG8_STAGE(PG8_SB(1, 0), cB + kstep, voffB); PG8_STAGE(PG8_SA(1, 0), cA + kstep, voffA); PG8_STAGE(PG8_SB(1, 1), cB + hstep + kstep, voffB);
        PG8_WAIT_V(6); PG8_BAR;
    }
    for (;;) {
        const bool has_next = S.next(ui + 1, nxt);
        typename Epi::Pre pre_; { int lp_ = (int)__builtin_amdgcn_mbcnt_hi(~0u, __builtin_amdgcn_mbcnt_lo(~0u, 0u)); asm volatile("" : "+v"(lp_)); pre_ = E.prefetch(cur, wc, lp_ >> 4); }
        const char* nA = has_next ? (const char*)g.A + (size_t)nxt.pm * tstep : cA; const char* nB = has_next ? (const char*)g.Bt + (size_t)nxt.pn * tstep : cB;
#pragma unroll 1
        for (int t = 0; t < nt; t += 2) {
            const bool last = (t == nt - 2);
            const char* a1 = cA + (size_t)(t + 1) * kstep;
            const char* a2 = last ? nA : cA + (size_t)(t + 2) * kstep; const char* b2 = last ? nB : cB + (size_t)(t + 2) * kstep;
            const char* a3 = a2 + kstep; const char* b3 = b2 + kstep;
            if (last && has_next) S.a_ready(nxt);
            const bool relax = (Epi::NST > 0) && (ui > 0) && (t == 0);
            if constexpr (SP2) {
            PG8_LDB(B0, 0, 0); PG8_LDB(B1, 0, 1); PG8_SCHED; PG8_LDA(At, 0, 0); PG8_STAGE(PG8_SA(1, 1), a1 + hstep, voffA);
            PG8_WAIT_V8R(relax); PG8_WAIT_L(0); PG8_BAR; PG8_MMA(0, 0, At, B0); PG8_MMA(0, 1, At, B1); PG8_BAR; PG8_SCHED;
            PG8_LDA(At, 0, 1); PG8_STAGE(PG8_SB(0, 0), b2, voffB); PG8_STAGE(PG8_SB(0, 1), b2 + hstep, voffB); PG8_STAGE(PG8_SA(0, 0), a2, voffA);
            PG8_WAIT_V8R(relax); PG8_WAIT_L(0); PG8_BAR; PG8_MMA(1, 0, At, B0); PG8_MMA(1, 1, At, B1); PG8_BAR; PG8_SCHED;
            PG8_LDB(B0, 1, 0); PG8_LDB(B1, 1, 1); PG8_SCHED; PG8_LDA(At, 1, 0); PG8_STAGE(PG8_SA(0, 1), a2 + hstep, voffA);
            PG8_WAIT_V(8); PG8_WAIT_L(0); PG8_BAR; PG8_MMA(0, 0, At, B0); PG8_MMA(0, 1, At, B1); PG8_BAR; PG8_SCHED;
            PG8_LDA(At, 1, 1); PG8_STAGE(PG8_SB(1, 0), b3, voffB); PG8_STAGE(PG8_SB(1, 1), b3 + hstep, voffB); PG8_STAGE(PG8_SA(1, 0), a3, voffA);
            PG8_WAIT_V(8); PG8_WAIT_L(0); PG8_BAR; PG8_MMA(1, 0, At, B0); PG8_MMA(1, 1, At, B1); PG8_BAR; PG8_SCHED;
            } else {
            PG8_LDB(B0, 0, 0); PG8_SCHED; PG8_LDA(At, 0, 0); PG8_STAGE(PG8_SA(1, 1), a1 + hstep, voffA);
            PG8_WAIT_L(8); PG8_BAR; PG8_WAIT_L(0); PG8_MMA(0, 0, At, B0); PG8_BAR; PG8_SCHED;
            PG8_LDB(B1, 0, 1); PG8_STAGE(PG8_SB(0, 0), b2, voffB);
            PG8_BAR; PG8_WAIT_L(0); PG8_MMA(0, 1, At, B1); PG8_BAR;
            PG8_LDA(At, 0, 1); PG8_STAGE(PG8_SA(0, 0), a2, voffA);
            PG8_BAR; PG8_WAIT_L(0); PG8_MMA(1, 0, At, B0); PG8_BAR; PG8_SCHED;
            PG8_STAGE(PG8_SB(0, 1), b2 + hstep, voffB);
            PG8_WAIT_V(6); PG8_BAR; PG8_MMA(1, 1, At, B1); PG8_BAR;
            PG8_LDB(B0, 1, 0); PG8_SCHED; PG8_LDA(At, 1, 0); PG8_STAGE(PG8_SA(0, 1), a2 + hstep, voffA);
            PG8_WAIT_L(8); PG8_BAR; PG8_WAIT_L(0); PG8_MMA(0, 0, At, B0); PG8_BAR; PG8_SCHED;
            PG8_LDB(B1, 1, 1); PG8_STAGE(PG8_SB(1, 0), b3, voffB);
            PG8_BAR; PG8_WAIT_L(0); PG8_MMA(0, 1, At, B1); PG8_BAR;
            PG8_LDA(At, 1, 1); PG8_STAGE(PG8_SA(1, 0), a3, voffA);
            PG8_BAR; PG8_WAIT_L(0); PG8_MMA(1, 0, At, B0); PG8_BAR; PG8_SCHED;
            PG8_STAGE(PG8_SB(1, 1), b3 + hstep, voffB);
            PG8_WAIT_V(6); PG8_BAR; PG8_MMA(1, 1, At, B1); PG8_BAR;
            }
        }
        if constexpr (FP8) asm volatile("s_nop 7\n\ts_nop 7" ::: "memory");
        if constexpr (ALIGN_EPI) { if (wr == 0) PG8_BAR; }
        if constexpr (!Epi::AFTER_DRAIN) { int ln_ = (int)__builtin_amdgcn_mbcnt_hi(~0u, __builtin_amdgcn_mbcnt_lo(~0u, 0u)); asm volatile("" : "+v"(ln_)); E(acc, cur, wr, wc, ln_ & 15, ln_ >> 4, pre_); S.done(cur); }
        if (!has_next) break;
#pragma unroll
        for (int a = 0; a < 2; ++a)
#pragma unroll
            for (int b = 0; b < 2; ++b)
#pragma unroll
                for (int m = 0; m < 4; ++m)
#pragma unroll
                    for (int n = 0; n < 2; ++n) acc[a][b][m][n] = (f32x4){0.f, 0.f, 0.f, 0.f};
        cur = nxt; cA = nA; cB = nB; ++ui;
        if constexpr (ALIGN_EPI) { if (wr == 1) PG8_BAR; }
    }
    PG8_WAIT_V(0);
    if constexpr (!ALIGN_EPI) { if (wr == 0) PG8_BAR; }
    PG8_BAR;
    if constexpr (Epi::AFTER_DRAIN) { E.fused(acc, cur, wr, wc, fr, fq, lds, wid, lane); S.done(cur); }
#undef PG8_SA
#undef PG8_SB
#undef PG8_STAGE
#undef PG8_LDA
#undef PG8_LDB
#undef PG8_MMA
#undef PG8_WAIT_V
#undef PG8_WAIT_L
#undef PG8_BAR
#undef PG8_SCHED
}
}

constexpr int NWAVES = 8, NTHR = 512;
constexpr int BATCH = 2, SEQ = 8192, D = 1024, DEPTH = 4, MTOK = BATCH * SEQ;
constexpr int DIN = 3344, NPROJ = 3328, SRC_GA = 1152;
constexpr int C_GQ = 0, C_GK = 192, C_GV = 384, C_GG = 768, C_HQ = 1152, C_HF = 1408, C_HI = 1664, C_HG = 1920, C_RQ = 2176, C_RK = 2368, C_RV = 2560, C_RG = 2944;
constexpr int NE = 32, FFN = 1024;
constexpr int CH = 64, NCH = SEQ / CH, NUNIT = BATCH * NCH;
constexpr int ST_GLA = 0, ST_HG = 4 * 48 * 96, ST_RET = ST_HG + 4 * 64 * 64, ST_TOT = ST_RET + 4 * 48 * 96;
constexpr int NDV = 448, NKT = 640;
constexpr int MAXROWS = 65536 + NE * 256, MAXRT = MAXROWS / 256;
constexpr float EPS = 1e-6f;
#ifndef F8_IN_V
#define F8_IN_V false
#endif
#ifndef F8_OUT_V
#define F8_OUT_V false
#endif
constexpr bool F8_IN = F8_IN_V, F8_OUT = F8_OUT_V;
#ifndef Y8_V
#define Y8_V true
#endif
constexpr bool Y8 = Y8_V;
constexpr float S8_Y = 16.f;
constexpr float S8_M = 32.f;
constexpr float S8_W = 2048.f, S8_H = 64.f, S8_A = 8.f;
constexpr int NPHASE = 38;
constexpr int ECAP = 16384, ECAP_SH = 14;

constexpr size_t MiB = 1u << 20;
constexpr size_t WS_CTL = 0, CTL_ZERO_BYTES = 65536;
constexpr size_t WS_MOD = 1 * MiB;
constexpr size_t WS_ROPE = 2 * MiB;
constexpr size_t WS_LB = 5 * MiB;
constexpr size_t WS_WIN = 8 * MiB;
constexpr size_t WS_WOUT = 34 * MiB;
constexpr size_t WS_WGU = 42 * MiB;
constexpr size_t WS_WDN = 554 * MiB;
constexpr size_t WS_X = 810 * MiB;
constexpr size_t WS_H = 874 * MiB;
constexpr size_t WS_GA = 906 * MiB;
constexpr size_t WS_PROJ = 907 * MiB;
constexpr size_t WS_U = 1011 * MiB;
constexpr size_t WS_DVEC = 1063 * MiB;
constexpr size_t WS_SP = 1064 * MiB;
constexpr size_t WS_MIX = 1090 * MiB;
constexpr size_t WS_TOPE = 1122 * MiB;
constexpr size_t WS_TOPW = WS_TOPE + 256 * 1024;
constexpr size_t WS_SLOT = WS_TOPW + 256 * 1024;
constexpr size_t WS_A1 = 1123 * MiB;
constexpr size_t WS_ACT = 1635 * MiB;
constexpr size_t WS_Y = 2147 * MiB;
constexpr size_t WS_CUM = 3171 * MiB;
constexpr size_t WS_KT = 3199 * MiB;
constexpr size_t WS_END = 3239 * MiB;
static_assert(WS_WIN + (size_t)DEPTH * NPROJ * D * 2 <= WS_WOUT && WS_PROJ + (size_t)MTOK * NPROJ * 2 <= WS_U && WS_U + (size_t)NUNIT * ST_TOT * 4 <= WS_DVEC && WS_SP + (size_t)NUNIT * ST_TOT * 2 <= WS_MIX && WS_A1 + (size_t)NE * ECAP * D <= WS_ACT && WS_ACT + (size_t)NE * ECAP * D <= WS_Y && WS_Y + (size_t)NE * ECAP * D * 2 <= WS_CUM, "ws map");
constexpr int CW_TMO = 0, CW_CODE = 1, CW_BAR = 4096, CW_CNT = 8192, CW_FILL = 8192 + 256;
constexpr int RING_BYTES = 131072;
constexpr int MISC_OFF = 147456, LDS_BYTES = MISC_OFF + 4096;
constexpr int MW_BAR = 0, MW_CNT = 16, MW_PST = 48, MW_HIST = 96, MW_BASE = 128, MW_TILE = 192, MW_NRT = 480, MW_SLOTS = 512;

#define GAS __attribute__((address_space(1)))
#define LAS __attribute__((address_space(3)))
typedef unsigned v4u __attribute__((ext_vector_type(4)));
typedef float f32x4 __attribute__((ext_vector_type(4)));
typedef short bf16x8 __attribute__((ext_vector_type(8)));
typedef GAS unsigned gu32;
typedef GAS unsigned long long gu64;
#define RLX_AGENT __ATOMIC_RELAXED, __HIP_MEMORY_SCOPE_AGENT
#define LDS_WAIT() asm volatile("s_waitcnt lgkmcnt(0)" ::: "memory")
#define VM_WAIT() asm volatile("s_waitcnt vmcnt(0)" ::: "memory")
__device__ __forceinline__ unsigned long long rt() { return __builtin_amdgcn_s_memrealtime(); }
typedef unsigned short bf16;
typedef float f32x2_t __attribute__((ext_vector_type(2))); typedef __bf16 bf16x2_t __attribute__((ext_vector_type(2)));
__device__ __forceinline__ unsigned pk2(float lo, float hi) { const f32x2_t v = {lo, hi}; return __builtin_bit_cast(unsigned, __builtin_convertvector(v, bf16x2_t)); }
__device__ __forceinline__ unsigned f2bf(float f) { return pk2(f, 0.f) & 0xffffu; }
__device__ __forceinline__ float bf2f(bf16 b) { return __builtin_bit_cast(float, (unsigned)b << 16); }
#define XB_TMO      128
#define XB_XCNT(j)  (256  + 64 * (j))
#define XB_XSUB(j)  (1280 + 64 * (j))
#define XB_XGEN(j)  (2304 + 64 * (j))
#define XB_TOP      3328
#define XB_TOPGEN   3392
#define XCD_BAR_WORDS 3456
#define XB_SPIN_CAP (1u << 18)

__device__ __forceinline__ unsigned xb_ld(unsigned* p)              { return __hip_atomic_load(p, __ATOMIC_RELAXED, __HIP_MEMORY_SCOPE_AGENT); }
__device__ __forceinline__ unsigned xb_add(unsigned* p, unsigned v) { return __hip_atomic_fetch_add(p, v, __ATOMIC_RELAXED, __HIP_MEMORY_SCOPE_AGENT); }
__device__ __forceinline__ unsigned xb_xcc_id() { return (unsigned)__builtin_amdgcn_s_getreg((3 << 11) | 20) & 0xFu; }
#define XB_SPIN(cond, bar) do { unsigned _sp = 0; while (cond) { __builtin_amdgcn_s_sleep(1); \
    if ((++_sp & 255u) == 0u) { if (xb_ld(&(bar)[XB_TMO])) break; if (_sp > XB_SPIN_CAP) { atomicAdd(&(bar)[XB_TMO], 1u); break; } } } } while (0)

struct XcdBarrier {
    unsigned* bar; unsigned x;
    volatile LAS unsigned* st;
};

__device__ __forceinline__ XcdBarrier xcd_barrier_post(unsigned* bar, volatile LAS unsigned* st) {
    XcdBarrier b; b.bar = bar; b.x = xb_xcc_id(); b.st = st;
    if (threadIdx.x == 0) (void)xb_add(&bar[XB_XCNT(b.x)], 1u);
    return b;
}
__device__ __forceinline__ void xcd_barrier_complete(unsigned* bar, unsigned x, unsigned& nloc, unsigned& nx) {
    const unsigned G = gridDim.x * gridDim.y * gridDim.z;
    unsigned sum, cnt, mine, sp = 0u;
    for (;;) {
        sum = 0u; cnt = 0u; mine = 0u;
#pragma unroll
        for (unsigned j = 0; j < 16; ++j) { const unsigned c = xb_ld(&bar[XB_XCNT(j)]); sum += c; cnt += (c > 0u) ? 1u : 0u; mine = (j == x) ? c : mine; }
        if (sum == G) break;
        __builtin_amdgcn_s_sleep(1);
        if ((++sp & 255u) == 0u) { if (xb_ld(&bar[XB_TMO])) break; if (sp > XB_SPIN_CAP) { atomicAdd(&bar[XB_TMO], 1u); break; } }
    }
    nloc = mine > 0u ? mine : 1u; nx = cnt > 0u ? cnt : 1u;
}

__device__ __forceinline__ void xcd_barrier(const XcdBarrier& b) {
    asm volatile("s_waitcnt vmcnt(0)" ::: "memory");
    __syncthreads();
    if (threadIdx.x == 0) {
        unsigned* bar = b.bar;
        __builtin_amdgcn_s_waitcnt(0);
        unsigned nloc = b.st[0], nx = b.st[1];
        if (nloc == 0u) { xcd_barrier_complete(bar, b.x, nloc, nx); b.st[0] = nloc; b.st[1] = nx; }
        const unsigned old = xb_add(&bar[XB_XSUB(b.x)], 1u);
        const unsigned gen = old / nloc;
        if (old + 1u == (gen + 1u) * nloc) {
            __builtin_amdgcn_fence(__ATOMIC_RELEASE, "agent");
            asm volatile("s_waitcnt vmcnt(0)" ::: "memory");
            const unsigned og = xb_add(&bar[XB_TOP], 1u);
            const unsigned tg = og / nx;
            if (og + 1u == (tg + 1u) * nx) xb_add(&bar[XB_TOPGEN], 1u);
            else XB_SPIN(xb_ld(&bar[XB_TOPGEN]) == tg, bar);
            __builtin_amdgcn_fence(__ATOMIC_ACQUIRE, "agent");
            xb_add(&bar[XB_XGEN(b.x)], 1u);
            asm volatile("s_waitcnt vmcnt(0)" ::: "memory");
        } else {
            XB_SPIN(xb_ld(&bar[XB_XGEN(b.x)]) == gen, bar);
            __builtin_amdgcn_fence(__ATOMIC_ACQUIRE, "agent");
            asm volatile("s_waitcnt vmcnt(0)" ::: "memory");
        }
    }
    __syncthreads();
}

__device__ __forceinline__ float wave_sum(float v) {
#pragma unroll
    for (int o = 1; o < 64; o <<= 1) v += __shfl_xor(v, o);
    return v;
}
__device__ __forceinline__ float log_sigmoid_f(float x) { return fminf(x, 0.f) - log1pf(expf(-fabsf(x))); }
__device__ __forceinline__ float silu_f(float x) { return x / (1.0f + expf(-x)); }
__device__ __forceinline__ float sigmoid_f(float x) { return 1.0f / (1.0f + expf(-x)); }
__device__ __forceinline__ pg8::bf16x8 ldfrag(const LAS bf16* base, int stride, int r0, int k0, int lane) {
    return *(const LAS pg8::bf16x8*)(base + (r0 + (lane & 15)) * stride + k0 + 8 * (lane >> 4));
}
__device__ __forceinline__ pg8::bf16x8 pack8(const float (&v)[8]) { v4u w; w.x = pk2(v[0], v[1]); w.y = pk2(v[2], v[3]); w.z = pk2(v[4], v[5]); w.w = pk2(v[6], v[7]); return __builtin_bit_cast(pg8::bf16x8, w); }

struct Args {
    const float* x; const float* c; const int* pos; const float* w_mod; const float* b_mod; const float* norm1_w; const float* w_in; const float* gla_wa2; const float* gla_ba2; const float* hg_lb;
    const float* gla_norm_w; const float* hg_norm_w; const float* w_out; const float* norm2_w; const float* w_r; const float* b_r; const float* w_gu; const float* b_gu; const float* w_dn; const float* b_dn;
    const float* final_norm_w; float* out; unsigned char* ws; int ph_lo, ph_hi;
};

__device__ __forceinline__ void transpose_block64(const float* src, int ld, bf16* dst, LAS float* scr, int lane) {
    const int r = lane >> 4, c4 = (lane & 15) * 4;
    f32x4 v[16];
#pragma unroll
    for (int i = 0; i < 16; ++i) v[i] = __builtin_nontemporal_load((const f32x4*)(src + (size_t)(4 * i + r) * ld + c4));
#pragma unroll
    for (int i = 0; i < 16; ++i) { LAS float* w = scr + (4 * i + r) * 65 + c4; w[0] = v[i][0]; w[1] = v[i][1]; w[2] = v[i][2]; w[3] = v[i][3]; }
    LDS_WAIT(); asm volatile("" ::: "memory");
    const int kc = lane & 7;
#pragma unroll
    for (int jj = 0; jj < 8; ++jj) { const int n = (lane >> 3) + 8 * jj; const LAS float* s = scr + (8 * kc) * 65 + n;
        v4u o; o.x = pk2(s[0 * 65], s[1 * 65]); o.y = pk2(s[2 * 65], s[3 * 65]); o.z = pk2(s[4 * 65], s[5 * 65]); o.w = pk2(s[6 * 65], s[7 * 65]);
        *(GAS v4u*)(dst + (size_t)n * D + 8 * kc) = o; }
    LDS_WAIT(); asm volatile("" ::: "memory");
}
__device__ __forceinline__ float clamp448(float x) { return __builtin_amdgcn_fmed3f(x, -448.f, 448.f); }
__device__ __forceinline__ int pk4_fp8(float a, float b, float c, float d) { int w = 0; w = __builtin_amdgcn_cvt_pk_fp8_f32(clamp448(a), clamp448(b), w, false);
    return __builtin_amdgcn_cvt_pk_fp8_f32(clamp448(c), clamp448(d), w, true); }
__device__ __forceinline__ void transpose_block64_fp8(const float* src, int ld, unsigned char* dst, LAS float* scr, int lane, float sc) {
    const int r = lane >> 4, c4 = (lane & 15) * 4;
    f32x4 v[16];
#pragma unroll
    for (int i = 0; i < 16; ++i) v[i] = __builtin_nontemporal_load((const f32x4*)(src + (size_t)(4 * i + r) * ld + c4));
#pragma unroll
    for (int i = 0; i < 16; ++i) { LAS float* w = scr + (4 * i + r) * 65 + c4; w[0] = v[i][0] * sc; w[1] = v[i][1] * sc; w[2] = v[i][2] * sc; w[3] = v[i][3] * sc; }
    LDS_WAIT(); asm volatile("" ::: "memory");
    const int kc = lane & 3;
#pragma unroll
    for (int jj = 0; jj < 4; ++jj) { const int n = (lane >> 2) + 16 * jj; const LAS float* s = scr + (16 * kc) * 65 + n;
        v4u o; o.x = (unsigned)pk4_fp8(s[0 * 65], s[1 * 65], s[2 * 65], s[3 * 65]); o.y = (unsigned)pk4_fp8(s[4 * 65], s[5 * 65], s[6 * 65], s[7 * 65]);
        o.z = (unsigned)pk4_fp8(s[8 * 65], s[9 * 65], s[10 * 65], s[11 * 65]); o.w = (unsigned)pk4_fp8(s[12 * 65], s[13 * 65], s[14 * 65], s[15 * 65]);
        *(GAS v4u*)(dst + (size_t)n * D + 16 * kc) = o; }
    LDS_WAIT(); asm volatile("" ::: "memory");
}
constexpr int IT_IN = 16 * (NPROJ / 64), IT_OUT = 16 * 16, IT_GU = NE * 16 * 32, IT_DN = NE * 16 * 16, IT_LAYER = IT_IN + IT_OUT + IT_GU + IT_DN, IT_ALL = DEPTH * IT_LAYER;
__device__ __forceinline__ void convert_item(const Args& a, int l, int r, LAS float* scr, int lane) {
    unsigned char* ws = a.ws;
    bf16* WIN = (bf16*)(ws + WS_WIN); bf16* WOUT = (bf16*)(ws + WS_WOUT); unsigned char* WGU = ws + WS_WGU; unsigned char* WDN = ws + WS_WDN;
    if (r < IT_IN) { const int kb = r / (NPROJ / 64), nb = r % (NPROJ / 64), n0 = 64 * nb, sc = n0 + (n0 >= SRC_GA ? 16 : 0);
        if (F8_IN) transpose_block64_fp8(a.w_in + ((size_t)l * D + 64 * kb) * DIN + sc, DIN, (unsigned char*)WIN + ((size_t)l * NPROJ + n0) * D + 64 * kb, scr, lane, S8_W);
        else transpose_block64(a.w_in + ((size_t)l * D + 64 * kb) * DIN + sc, DIN, WIN + ((size_t)l * NPROJ + n0) * D + 64 * kb, scr, lane); return; }
    r -= IT_IN;
    if (r < IT_OUT) { const int kb = r / 16, nb = r % 16;
        if (F8_OUT) transpose_block64_fp8(a.w_out + ((size_t)l * D + 64 * kb) * D + 64 * nb, D, (unsigned char*)WOUT + ((size_t)l * D + 64 * nb) * D + 64 * kb, scr, lane, S8_W);
        else transpose_block64(a.w_out + ((size_t)l * D + 64 * kb) * D + 64 * nb, D, WOUT + ((size_t)l * D + 64 * nb) * D + 64 * kb, scr, lane); return; }
    r -= IT_OUT;
    if (r < IT_GU) { const int e = r / 512, r2 = r % 512, kb = r2 / 32, nb = r2 % 32, cc = 64 * nb;
        const int row = (cc < 1024) ? 256 * (cc / 128) + (cc % 128) : 256 * ((cc - 1024) / 128) + 128 + ((cc - 1024) % 128);
        transpose_block64_fp8(a.w_gu + (((size_t)l * NE + e) * D + 64 * kb) * 2048 + cc, 2048, WGU + (((size_t)l * NE + e) * 2048 + row) * D + 64 * kb, scr, lane, S8_W); return; }
    r -= IT_GU;
    { const int e = r / 256, r2 = r % 256, kb = r2 / 16, nb = r2 % 16;
        transpose_block64_fp8(a.w_dn + (((size_t)l * NE + e) * FFN + 64 * kb) * D + 64 * nb, D, WDN + (((size_t)l * NE + e) * D + 64 * nb) * D + 64 * kb, scr, lane, S8_W); }
}
constexpr int CB2 = 4, CB7 = 2, CB8 = 2;
__device__ __forceinline__ int conv_t2(int G) { return (G == 256) ? 192 * NWAVES * CB2 : 0; }
__device__ __forceinline__ int conv_idle(int nunits, int G) { const int rem = nunits % G; return rem ? G - rem : 0; }
__device__ __forceinline__ void convert_range(const Args& a, int l, int first, int count, LAS unsigned char* lds, int lane, int wave) {
    LAS float* scr = (LAS float*)(lds + wave * 16640);
    for (int k = 0; k < count; ++k) { const int it = first + k; if (it < IT_LAYER) convert_item(a, l, it, scr, lane); }
}
__device__ __forceinline__ void p0_prologue(const Args& a, LAS unsigned char* lds, int vcu, int G, int tid, int lane, int wave) {
    unsigned char* ws = a.ws;
    LAS float* scr = (LAS float*)(lds + wave * 16640);
    const int gw = vcu * NWAVES + wave, NGW = G * NWAVES;
    for (int it = gw; it < IT_LAYER; it += NGW) convert_item(a, 0, it, scr, lane);
    __syncthreads();
    {
        LAS float* cact = (LAS float*)lds;
        LAS float* red = (LAS float*)(lds + 8192);
        for (int i = tid; i < 2 * D; i += NTHR) cact[i] = silu_f(a.c[i]);
        __syncthreads();
        float* MOD = (float*)(ws + WS_MOD);
        for (int it = vcu; it < DEPTH * 96; it += G) {
            const int l = it / 96, n0 = (it % 96) * 64;
            const float* wp = a.w_mod + ((size_t)l * D + 128 * wave) * 6144 + n0 + lane;
            float a0 = 0.f, a1 = 0.f;
#pragma unroll 32
            for (int k = 0; k < 128; ++k) { const float w = __builtin_nontemporal_load(wp + (size_t)k * 6144); a0 += cact[128 * wave + k] * w; a1 += cact[D + 128 * wave + k] * w; }
            red[(wave * 2 + 0) * 64 + lane] = a0; red[(wave * 2 + 1) * 64 + lane] = a1;
            __syncthreads();
            if (tid < 128) { const int b = tid >> 6, ln = tid & 63; float s = a.b_mod[l * 6144 + n0 + ln];
#pragma unroll
                for (int w = 0; w < 8; ++w) s += red[(w * 2 + b) * 64 + ln];
                MOD[((size_t)l * 2 + b) * 6144 + n0 + ln] = s; }
            __syncthreads();
        }
    }
    { const f32x4* xs = (const f32x4*)a.x; uint2* xd = (uint2*)(ws + WS_X);
        for (int i = vcu * NTHR + tid; i < MTOK * D / 4; i += G * NTHR) { const f32x4 v = xs[i]; uint2 p; p.x = pk2(v[0], v[1]); p.y = pk2(v[2], v[3]); xd[i] = p; } }
    {
        float* ROPE = (float*)(ws + WS_ROPE);
        for (int i = vcu * NTHR + tid; i < MTOK * 24; i += G * NTHR) { const int t = i / 24, f = i % 24;
            const float inv = (float)pow(10000.0, -(double)f / 24.0); const float ang = (float)a.pos[t] * inv;
            ROPE[(size_t)t * 48 + f] = cosf(ang); ROPE[(size_t)t * 48 + 24 + f] = sinf(ang); }
    }
    if (vcu == 0 && tid < 256) {
        float v[4], mx = -3.0e38f; for (int l = 0; l < 4; ++l) { v[l] = a.hg_lb[l * 256 + tid]; mx = fmaxf(mx, v[l]); }
        float s = 0.f; for (int l = 0; l < 4; ++l) { v[l] = expf(v[l] - mx); s += v[l]; }
        float* LB = (float*)(ws + WS_LB); float cs = 0.f, first = 0.f;
        for (int l = 0; l < 4; ++l) { cs += v[l] / s; if (l == 0) first = cs; LB[l * 256 + tid] = cs - first; }
    }
}

__device__ __forceinline__ void moe_combine_row(f32x4 (&v)[4], int m, const bf16* Y, const int* SLOT, const float* TOPW, const float* g2, int lane) {
    const int4 sl = *(const int4*)(SLOT + (size_t)m * 4); const f32x4 tw = *(const f32x4*)(TOPW + (size_t)m * 4);
    const int s[4] = {sl.x, sl.y, sl.z, sl.w};
    f32x4 acc[4];
#pragma unroll
    for (int j = 0; j < 4; ++j) acc[j] = (f32x4){0.f, 0.f, 0.f, 0.f};
#pragma unroll
    for (int k = 0; k < 4; ++k) { const bf16* yr = Y + (size_t)s[k] * D + 4 * lane; const float w = tw[k];
#pragma unroll
        for (int j = 0; j < 4; ++j) { const uint2 p = *(const uint2*)(yr + 256 * j);
            acc[j][0] += w * __builtin_bit_cast(float, p.x << 16); acc[j][1] += w * __builtin_bit_cast(float, p.x & 0xffff0000u);
            acc[j][2] += w * __builtin_bit_cast(float, p.y << 16); acc[j][3] += w * __builtin_bit_cast(float, p.y & 0xffff0000u); } }
#pragma unroll
    for (int j = 0; j < 4; ++j) { const f32x4 g = *(const f32x4*)(g2 + 4 * lane + 256 * j); v[j] = v[j] + g * acc[j]; }
}
__device__ __forceinline__ float row_rstd(const f32x4 (&v)[4]) {
    float s = 0.f;
#pragma unroll
    for (int j = 0; j < 4; ++j) s += (v[j][0] * v[j][0] + v[j][1] * v[j][1]) + (v[j][2] * v[j][2] + v[j][3] * v[j][3]);
    return 1.0f / sqrtf(wave_sum(s) * (1.0f / D) + EPS);
}
__device__ __forceinline__ void modulate_row(f32x4 (&v)[4], float rstd, const float* nw, const float* sc, const float* sh, bf16* hrow, int lane) {
#pragma unroll
    for (int j = 0; j < 4; ++j) { const int c0 = 4 * lane + 256 * j; const f32x4 w = *(const f32x4*)(nw + c0), s1 = *(const f32x4*)(sc + c0), s0 = *(const f32x4*)(sh + c0);
        v[j] = v[j] * rstd * w * (s1 + 1.0f) + s0;
        uint2 p; p.x = pk2(v[j][0], v[j][1]); p.y = pk2(v[j][2], v[j][3]); *(uint2*)(hrow + c0) = p; }
}


constexpr int LR_SLT = 142976, LR_TWL = 144000, LR_SSR = 145024;
__device__ __forceinline__ void stage_slots(const unsigned char* ws, int row0, LAS unsigned char* lds, int tid) {
    if (tid < 64) { *(LAS v4u*)(lds + LR_SLT + 16 * tid) = *(const v4u*)((const int*)(ws + WS_SLOT) + (size_t)(row0 + tid) * 4);
                    *(LAS f32x4*)(lds + LR_TWL + 16 * tid) = *(const f32x4*)((const float*)(ws + WS_TOPW) + (size_t)(row0 + tid) * 4); }
}
template <bool SS, bool OUTF32>
__device__ __forceinline__ void flat_combine(const bf16* xsrc, void* xdst, int row0, const bf16* Y, const float* g2, LAS unsigned char* lds, int tid, int lane) {
    static_assert(Y8, "expert outputs are stored as fp8");
    typedef float f32x2v __attribute__((ext_vector_type(2)));
    const int c16 = tid & 63, rsub = tid >> 6; const unsigned char* Yb = (const unsigned char*)Y;
    f32x4 g[4];
#pragma unroll
    for (int q = 0; q < 4; ++q) g[q] = *(const f32x4*)(g2 + 16 * c16 + 4 * q);
#pragma unroll 2
    for (int it = 0; it < 8; ++it) { const int i = 8 * it + rsub; const size_t m = (size_t)(row0 + i);
        const v4u x0 = *(const v4u*)(xsrc + m * D + 16 * c16), x1 = *(const v4u*)(xsrc + m * D + 16 * c16 + 8);
        const v4u sl = *(const LAS v4u*)(lds + LR_SLT + 16 * i); const f32x4 tws = *(const LAS f32x4*)(lds + LR_TWL + 16 * i) * (1.0f / S8_Y);
        const v4u y0 = *(const v4u*)(Yb + (size_t)sl.x * D + 16 * c16), y1 = *(const v4u*)(Yb + (size_t)sl.y * D + 16 * c16), y2 = *(const v4u*)(Yb + (size_t)sl.z * D + 16 * c16), y3 = *(const v4u*)(Yb + (size_t)sl.w * D + 16 * c16);
        const unsigned xw[8] = {x0.x, x0.y, x0.z, x0.w, x1.x, x1.y, x1.z, x1.w}, w0[4] = {y0.x, y0.y, y0.z, y0.w}, w1[4] = {y1.x, y1.y, y1.z, y1.w}, w2[4] = {y2.x, y2.y, y2.z, y2.w}, w3[4] = {y3.x, y3.y, y3.z, y3.w};
        float v[16]; float sq = 0.f;
#pragma unroll
        for (int q = 0; q < 4; ++q) {
            const f32x2v a0 = __builtin_amdgcn_cvt_pk_f32_fp8((int)w0[q], false), b0 = __builtin_amdgcn_cvt_pk_f32_fp8((int)w0[q], true), a1 = __builtin_amdgcn_cvt_pk_f32_fp8((int)w1[q], false), b1 = __builtin_amdgcn_cvt_pk_f32_fp8((int)w1[q], true);
            const f32x2v a2 = __builtin_amdgcn_cvt_pk_f32_fp8((int)w2[q], false), b2 = __builtin_amdgcn_cvt_pk_f32_fp8((int)w2[q], true), a3 = __builtin_amdgcn_cvt_pk_f32_fp8((int)w3[q], false), b3 = __builtin_amdgcn_cvt_pk_f32_fp8((int)w3[q], true);
            const float e0 = tws[0] * a0[0] + tws[1] * a1[0] + tws[2] * a2[0] + tws[3] * a3[0], e1 = tws[0] * a0[1] + tws[1] * a1[1] + tws[2] * a2[1] + tws[3] * a3[1];
            const float e2 = tws[0] * b0[0] + tws[1] * b1[0] + tws[2] * b2[0] + tws[3] * b3[0], e3 = tws[0] * b0[1] + tws[1] * b1[1] + tws[2] * b2[1] + tws[3] * b3[1];
            v[4 * q + 0] = __builtin_bit_cast(float, xw[2 * q] << 16) + g[q][0] * e0; v[4 * q + 1] = __builtin_bit_cast(float, xw[2 * q] & 0xffff0000u) + g[q][1] * e1;
            v[4 * q + 2] = __builtin_bit_cast(float, xw[2 * q + 1] << 16) + g[q][2] * e2; v[4 * q + 3] = __builtin_bit_cast(float, xw[2 * q + 1] & 0xffff0000u) + g[q][3] * e3;
            sq += (v[4 * q] * v[4 * q] + v[4 * q + 1] * v[4 * q + 1]) + (v[4 * q + 2] * v[4 * q + 2] + v[4 * q + 3] * v[4 * q + 3]); }
        if (OUTF32) {
#pragma unroll
            for (int q = 0; q < 4; ++q) *(GAS f32x4*)((float*)xdst + m * D + 16 * c16 + 4 * q) = (f32x4){v[4 * q], v[4 * q + 1], v[4 * q + 2], v[4 * q + 3]}; }
        else { v4u o0, o1; o0.x = pk2(v[0], v[1]); o0.y = pk2(v[2], v[3]); o0.z = pk2(v[4], v[5]); o0.w = pk2(v[6], v[7]); o1.x = pk2(v[8], v[9]); o1.y = pk2(v[10], v[11]); o1.z = pk2(v[12], v[13]); o1.w = pk2(v[14], v[15]);
            *(GAS v4u*)((bf16*)xdst + m * D + 16 * c16) = o0; *(GAS v4u*)((bf16*)xdst + m * D + 16 * c16 + 8) = o1; }
        if (SS) { const float sqs = wave_sum(sq); if (lane == 0) __hip_atomic_fetch_add((LAS float*)(lds + LR_SSR) + i, sqs, __ATOMIC_RELAXED, __HIP_MEMORY_SCOPE_WORKGROUP); } }
}
template <bool F8, bool SLOTS>
__device__ __forceinline__ void flat_modulate(const bf16* xin, int row0, const LAS float* rstds, const float* nw, const float* scp, const float* shp, bf16* H, unsigned char* A1, LAS unsigned char* lds, int tid) {
    const int c16 = tid & 63, rsub = tid >> 6; f32x4 ws1[4], s0[4];
#pragma unroll
    for (int q = 0; q < 4; ++q) { const int c0 = 16 * c16 + 4 * q; ws1[q] = *(const f32x4*)(nw + c0) * (*(const f32x4*)(scp + c0) + 1.0f); s0[q] = *(const f32x4*)(shp + c0); }
#pragma unroll 2
    for (int it = 0; it < 8; ++it) { const int i = 8 * it + rsub; const size_t m = (size_t)(row0 + i); const float rs = rstds[i];
        const v4u x0 = *(const v4u*)(xin + m * D + 16 * c16), x1 = *(const v4u*)(xin + m * D + 16 * c16 + 8); const unsigned xw[8] = {x0.x, x0.y, x0.z, x0.w, x1.x, x1.y, x1.z, x1.w};
        f32x4 v[4];
#pragma unroll
        for (int q = 0; q < 4; ++q) v[q] = (f32x4){__builtin_bit_cast(float, xw[2 * q] << 16), __builtin_bit_cast(float, xw[2 * q] & 0xffff0000u), __builtin_bit_cast(float, xw[2 * q + 1] << 16), __builtin_bit_cast(float, xw[2 * q + 1] & 0xffff0000u)} * rs * ws1[q] + s0[q];
        if (F8) { v4u o; o.x = (unsigned)pk4_fp8(v[0][0] * S8_H, v[0][1] * S8_H, v[0][2] * S8_H, v[0][3] * S8_H); o.y = (unsigned)pk4_fp8(v[1][0] * S8_H, v[1][1] * S8_H, v[1][2] * S8_H, v[1][3] * S8_H);
            o.z = (unsigned)pk4_fp8(v[2][0] * S8_H, v[2][1] * S8_H, v[2][2] * S8_H, v[2][3] * S8_H); o.w = (unsigned)pk4_fp8(v[3][0] * S8_H, v[3][1] * S8_H, v[3][2] * S8_H, v[3][3] * S8_H);
            if (SLOTS) { const v4u sl = *(const LAS v4u*)(lds + LR_SLT + 16 * i);
                *(GAS v4u*)(A1 + (size_t)sl.x * D + 16 * c16) = o; *(GAS v4u*)(A1 + (size_t)sl.y * D + 16 * c16) = o; *(GAS v4u*)(A1 + (size_t)sl.z * D + 16 * c16) = o; *(GAS v4u*)(A1 + (size_t)sl.w * D + 16 * c16) = o; }
            else *(GAS v4u*)((unsigned char*)H + m * D + 16 * c16) = o; }
        else { v4u o0, o1; o0.x = pk2(v[0][0], v[0][1]); o0.y = pk2(v[0][2], v[0][3]); o0.z = pk2(v[1][0], v[1][1]); o0.w = pk2(v[1][2], v[1][3]); o1.x = pk2(v[2][0], v[2][1]); o1.y = pk2(v[2][2], v[2][3]); o1.z = pk2(v[3][0], v[3][1]); o1.w = pk2(v[3][2], v[3][3]);
            *(GAS v4u*)(H + m * D + 16 * c16) = o0; *(GAS v4u*)(H + m * D + 16 * c16 + 8) = o1; } }
}

constexpr int WP = 1032;
constexpr int LR_WHI = 0, LR_PART = 132096, LR_SSX = 140288, LR_RSTD = 140544, LR_BIAS = 140800, LR_RED = 140928;
template <int NEO>
__device__ __forceinline__ void rows_mfma(const Args& a, int layer, LAS unsigned char* lds, volatile LAS unsigned* MISC, gu32* ctl, int vcu, int G, int tid, int lane, int wave) {
    constexpr bool P5 = (NEO == 32); constexpr int NET = NEO / 16;
    unsigned char* ws = a.ws; bf16* X = (bf16*)(ws + WS_X); bf16* H = (bf16*)(ws + WS_H); const float* MOD = (const float*)(ws + WS_MOD);
    LAS bf16* Whi = (LAS bf16*)(lds + LR_WHI); LAS bf16* Wlo = Whi + NEO * WP; LAS float* part = (LAS float*)(lds + LR_PART); LAS float* ssx = (LAS float*)(lds + LR_SSX);
    LAS float* rstds = (LAS float*)(lds + LR_RSTD); LAS float* biasl = (LAS float*)(lds + LR_BIAS); LAS float* red = (LAS float*)(lds + LR_RED);
    const float* nw = (P5 ? a.norm2_w : a.norm1_w) + layer * D;
    const float* Wsrc = P5 ? a.w_r + (size_t)layer * D * NE : a.w_in + (size_t)layer * D * DIN + SRC_GA; const int wld = P5 ? NE : DIN;
    if (P5) { if (tid < NE) MISC[MW_HIST + tid] = 0u; }
    for (int row0 = vcu * 64; row0 < MTOK; row0 += G * 64) {
        const int b = row0 / SEQ; const float* mp = MOD + ((size_t)layer * 2 + b) * 6144; const float* scp = mp + (P5 ? 4 : 1) * D; const float* shp = mp + (P5 ? 3 : 0) * D;
        if (!P5 && layer > 0) { stage_slots(ws, row0, lds, tid); __syncthreads(); }
        { constexpr int E4 = NEO / 4, NITT = (D * E4) / NTHR, NIT = 8;
#pragma unroll 1
          for (int ib0 = 0; ib0 < NITT; ib0 += NIT) {
            f32x4 wv[NIT];
#pragma unroll
            for (int it = 0; it < NIT; ++it) { const int idx = tid + NTHR * (ib0 + it), k = idx / E4, e4 = idx - k * E4; wv[it] = *(const f32x4*)(Wsrc + (size_t)k * wld + 4 * e4) * (nw[k] * (1.0f + scp[k])); }
#pragma unroll
            for (int it = 0; it < NIT; ++it) { const int idx = tid + NTHR * (ib0 + it), k = idx / E4, e4 = idx - k * E4;
#pragma unroll
                for (int j = 0; j < 4; ++j) { const float w = wv[it][j]; const unsigned hi = f2bf(w); const float wl = w - __builtin_bit_cast(float, hi << 16); Whi[(4 * e4 + j) * WP + k] = (bf16)hi; Wlo[(4 * e4 + j) * WP + k] = (bf16)f2bf(wl); } } } }
        { const int e = tid % NEO, kq = tid / NEO; constexpr int NPT = NTHR / NEO;
            constexpr int KP = D / NPT; float sacc = 0.f;
#pragma unroll 8
            for (int k = kq * KP; k < kq * KP + KP; ++k) sacc += shp[k] * Wsrc[(size_t)k * wld + e];
            red[kq * NEO + e] = sacc; }
        const bf16* xin = X;
        if (!P5 && layer > 0) { flat_combine<false, false>(X, X, row0, (const bf16*)(ws + WS_Y), MOD + ((size_t)(layer - 1) * 2 + b) * 6144 + 5 * D, lds, tid, lane); asm volatile("s_waitcnt vmcnt(0)" ::: "memory"); }
        __syncthreads();
        if (tid < NEO) { constexpr int NPT = NTHR / NEO; float sacc = P5 ? a.b_r[layer * NE + tid] : 0.f; for (int q = 0; q < NPT; ++q) sacc += red[q * NEO + tid]; biasl[tid] = sacc; }
        const int rg = wave >> 1, kh = wave & 1, r = lane & 15, g = lane >> 4;
        { const bf16* xr = xin + (size_t)(row0 + 16 * rg + r) * D; f32x4 acc[NET]; float ss = 0.f;
#pragma unroll
            for (int et = 0; et < NET; ++et) acc[et] = (f32x4){0.f, 0.f, 0.f, 0.f};
#pragma unroll 4
            for (int s = 16 * kh; s < 16 * kh + 16; ++s) { const int k0 = 32 * s + 8 * g; const v4u xp = *(const v4u*)(xr + k0); const unsigned xw[4] = {xp.x, xp.y, xp.z, xp.w};
#pragma unroll
                for (int j = 0; j < 4; ++j) { const float xa = __builtin_bit_cast(float, xw[j] << 16), xb = __builtin_bit_cast(float, xw[j] & 0xffff0000u); ss += xa * xa + xb * xb; }
                const pg8::bf16x8 ahi = __builtin_bit_cast(pg8::bf16x8, xp);
#pragma unroll
                for (int et = 0; et < NET; ++et) { const pg8::bf16x8 whi = ldfrag(Whi, WP, 16 * et, 32 * s, lane), wlo = ldfrag(Wlo, WP, 16 * et, 32 * s, lane);
                    acc[et] = __builtin_amdgcn_mfma_f32_16x16x32_bf16(ahi, whi, acc[et], 0, 0, 0); acc[et] = __builtin_amdgcn_mfma_f32_16x16x32_bf16(ahi, wlo, acc[et], 0, 0, 0); } }
            ss += __shfl_xor(ss, 16); ss += __shfl_xor(ss, 32);
            if (kh == 1) {
#pragma unroll
                for (int et = 0; et < NET; ++et)
#pragma unroll
                    for (int q = 0; q < 4; ++q) part[(rg * 16 + 4 * g + q) * 32 + 16 * et + r] = acc[et][q];
                if (g == 0) ssx[rg * 16 + r] = ss; }
            __syncthreads();
            if (kh == 0) { const float sst = ss + ssx[rg * 16 + r]; if (g == 0) rstds[rg * 16 + r] = 1.0f / sqrtf(sst * (1.0f / D) + EPS);
                asm volatile("s_waitcnt lgkmcnt(0)" ::: "memory");
#pragma unroll
                for (int et = 0; et < NET; ++et)
#pragma unroll
                    for (int q = 0; q < 4; ++q) { const int i = rg * 16 + 4 * g + q, e = 16 * et + r; const float v = rstds[i] * (acc[et][q] + part[i * 32 + e]) + biasl[e];
                        if (P5) part[i * 32 + e] = v; else ((float*)(ws + WS_GA))[(size_t)(row0 + i) * 16 + e] = v; }
                if (P5) { asm volatile("s_waitcnt lgkmcnt(0)" ::: "memory");
                    if (lane < 16) { const int i = rg * 16 + lane, m = row0 + i; float lv[NE];
#pragma unroll
                        for (int e = 0; e < NE; ++e) lv[e] = part[i * 32 + e];
                        float tv[4]; int te[4];
#pragma unroll
                        for (int t = 0; t < 4; ++t) { float best = -3.0e38f; int bi = 0;
#pragma unroll
                            for (int e = 0; e < NE; ++e) if (lv[e] > best) { best = lv[e]; bi = e; }
#pragma unroll
                            for (int e = 0; e < NE; ++e) if (e == bi) lv[e] = -3.0e38f;
                            tv[t] = best; te[t] = bi; }
                        const float e1 = expf(tv[1] - tv[0]), e2 = expf(tv[2] - tv[0]), e3 = expf(tv[3] - tv[0]); const float inv = 1.0f / (1.0f + e1 + e2 + e3);
                        *(f32x4*)((float*)(ws + WS_TOPW) + (size_t)m * 4) = (f32x4){inv, e1 * inv, e2 * inv, e3 * inv};
#pragma unroll
                        for (int t = 0; t < 4; ++t) { const unsigned rk = __hip_atomic_fetch_add((LAS unsigned*)&MISC[MW_HIST + te[t]], 1u, __ATOMIC_RELAXED, __HIP_MEMORY_SCOPE_WORKGROUP);
                            ((LAS unsigned*)(lds + LR_SLT))[i * 4 + t] = ((unsigned)te[t] << 16) | rk; } } } }
            __syncthreads(); }
        if (P5) { if (tid < NE) { const unsigned hcnt = MISC[MW_HIST + tid]; MISC[MW_BASE + tid] = hcnt ? atomicAdd((unsigned*)(ctl + CW_CNT + layer * NE + tid), hcnt) : 0u; }
            __syncthreads();
            if (tid < 256) { LAS unsigned* sl = (LAS unsigned*)(lds + LR_SLT) + tid; const unsigned v = *sl, e = v >> 16; const unsigned slot = (e << ECAP_SH) + MISC[MW_BASE + e] + (v & 0xffffu);
                *sl = slot; ((int*)(ws + WS_SLOT))[(size_t)row0 * 4 + tid] = (int)slot; }
            if (tid < NE) MISC[MW_HIST + tid] = 0u;
            __syncthreads(); }
        if (P5) flat_modulate<true, true>(xin, row0, rstds, nw, scp, shp, H, ws + WS_A1, lds, tid);
        else flat_modulate<F8_IN, false>(xin, row0, rstds, nw, scp, shp, H, ws + WS_A1, lds, tid);
        __syncthreads();
    }
}

__device__ __forceinline__ void final_rows(const Args& a, LAS unsigned char* lds, int vcu, int G, int tid, int lane) {
    unsigned char* ws = a.ws; const bf16* X = (const bf16*)(ws + WS_X); const float* MOD = (const float*)(ws + WS_MOD); LAS float* ssr = (LAS float*)(lds + LR_SSR);
    for (int row0 = vcu * 64; row0 < MTOK; row0 += G * 64) { const int b = row0 / SEQ;
        stage_slots(ws, row0, lds, tid); if (tid < 64) ssr[tid] = 0.f;
        __syncthreads();
        flat_combine<true, true>(X, a.out, row0, (const bf16*)(ws + WS_Y), MOD + ((size_t)(DEPTH - 1) * 2 + b) * 6144 + 5 * D, lds, tid, lane);
        asm volatile("s_waitcnt vmcnt(0)" ::: "memory");
        __syncthreads();
        { const int c4 = tid & 255, rsub = tid >> 8; const f32x4 w = *(const f32x4*)(a.final_norm_w + 4 * c4);
#pragma unroll 8
            for (int it = 0; it < 32; ++it) { const int i = 2 * it + rsub; float* op = a.out + (size_t)(row0 + i) * D + 4 * c4; const float rstd = 1.0f / sqrtf(ssr[i] * (1.0f / D) + EPS); *(GAS f32x4*)op = *(const GAS f32x4*)op * rstd * w; } }
        __syncthreads();
    }
}

__device__ __noinline__ void moe_tables(gu32* ctl, int layer, volatile LAS unsigned* MISC, int tid) {
    if (tid < NE) MISC[MW_CNT + tid] = __hip_atomic_load(ctl + CW_CNT + layer * NE + tid, RLX_AGENT);
    __syncthreads();
    if (tid == 0) { unsigned n = 0;
        for (int e = 0; e < NE; ++e) { const unsigned nt = (MISC[MW_CNT + e] + 255u) >> 8; for (unsigned t = 0; t < nt; ++t) MISC[MW_TILE + n + t] = (unsigned)(e * 64) + t; n += nt; }
        MISC[MW_NRT] = n; }
    __syncthreads();
}

constexpr int BP = 72;
template <int TYPE> struct MixCfg { static constexpr int DK = (TYPE == 1) ? 64 : 48, DV = (TYPE == 1) ? 64 : 96, NC = 4 * DK, NV = 4 * DV;
    static constexpr int STOFF = (TYPE == 0) ? ST_GLA : (TYPE == 1) ? ST_HG : ST_RET, COFF = (TYPE == 0) ? 0 : 192;
    static constexpr int CQ = (TYPE == 0) ? C_GQ : (TYPE == 1) ? C_HQ : C_RQ, CK = (TYPE == 0) ? C_GK : (TYPE == 1) ? C_HF : C_RK, CV = (TYPE == 0) ? C_GV : (TYPE == 1) ? C_HI : C_RV, CG = (TYPE == 0) ? C_GG : (TYPE == 1) ? C_HG : C_RG;
    static constexpr int MIXOFF = (TYPE == 0) ? 0 : (TYPE == 1) ? 384 : 640, KOFF = (TYPE == 0) ? 0 : (TYPE == 1) ? 192 : 448; };
__device__ __forceinline__ float fast_logsig(float x) { x = fmaxf(x, -80.f); return -__logf(1.0f + __expf(-x)); }
__device__ __forceinline__ float ret_lg(int h) { return logf(1.0f - exp2f(-5.0f - (float)h)); }

template <int NV>
__device__ __forceinline__ void stage_vt(const bf16* pv  , LAS bf16* VT, int tid) {
    constexpr int NIT = (64 * (NV / 8)) / NTHR; static_assert((64 * (NV / 8)) % NTHR == 0, "stage_vt");
    v4u p[NIT];
#pragma unroll
    for (int it = 0; it < NIT; ++it) { const int idx = tid + NTHR * it, j = idx & 63, ch = idx >> 6; p[it] = *(const v4u*)(pv + (size_t)j * NPROJ + 8 * ch); }
#pragma unroll
    for (int it = 0; it < NIT; ++it) { const int idx = tid + NTHR * it, j = idx & 63, ch = idx >> 6; LAS bf16* d = VT + (8 * ch) * BP + j;
        d[0 * BP] = (bf16)(p[it].x & 0xffffu); d[1 * BP] = (bf16)(p[it].x >> 16); d[2 * BP] = (bf16)(p[it].y & 0xffffu); d[3 * BP] = (bf16)(p[it].y >> 16);
        d[4 * BP] = (bf16)(p[it].z & 0xffffu); d[5 * BP] = (bf16)(p[it].z >> 16); d[6 * BP] = (bf16)(p[it].w & 0xffffu); d[7 * BP] = (bf16)(p[it].w >> 16); }
}

constexpr int LA_KT = 0, LA_VT = 36864, LA_TOT = 92160, LA_GA = 94208, LA_KTT = 98304, KTP = 264;
template <int TYPE>
__device__ __forceinline__ void mixa_batch(const Args& a, int layer, int unit, LAS unsigned char* lds, int tid, int lane, int wave) {
    asm volatile("" : "+v"(tid), "+v"(lane));
    typedef MixCfg<TYPE> C; constexpr int DK = C::DK, DV = C::DV, NC = C::NC, NV = C::NV;
    unsigned char* ws = a.ws; const bf16* PROJ = (const bf16*)(ws + WS_PROJ); bf16* F1 = (bf16*)(ws + WS_CUM); float* ECG = (float*)(ws + WS_CUM + 16 * MiB) + (size_t)unit * 4 * NDV; float* DVEC = (float*)(ws + WS_DVEC) + (size_t)unit * NDV;
    bf16* U = (bf16*)(ws + WS_U) + (size_t)unit * ST_TOT + C::STOFF;
    LAS bf16* KT = (LAS bf16*)(lds + LA_KT); LAS bf16* VT = (LAS bf16*)(lds + LA_VT); LAS float* TOT = (LAS float*)(lds + LA_TOT); const LAS float* GAs = (const LAS float*)(lds + LA_GA);
    const int row0 = unit * CH;
    stage_vt<NV>(PROJ + (size_t)row0 * NPROJ + C::CV, VT, tid);
    const bool act = tid < 2 * NC; const int c = act ? tid % NC : 0, half = act ? tid / NC : 0, h = c / DK, d = c - h * DK;
    float cum[32]; float tot = 0.f;
    float w2[16], b2 = 0.f, lbv = 0.f, lg = 0.f, sg = 0.f; int f = 0, d2 = 0;
    if (act) {
        if constexpr (TYPE == 0) { b2 = a.gla_ba2[layer * 192 + c];
#pragma unroll
            for (int r = 0; r < 16; ++r) w2[r] = a.gla_wa2[(layer * 16 + r) * 192 + c]; }
        if constexpr (TYPE == 1) lbv = ((const float*)(ws + WS_LB))[layer * 256 + c];
        if constexpr (TYPE == 2) { lg = ret_lg(h); f = (d < 24) ? d : d - 24; d2 = (d < 24) ? d + 24 : d - 24; sg = (d < 24) ? -1.f : 1.f; }
#pragma unroll
        for (int gq = 0; gq < 2; ++gq) {
            bf16 hraw[16];
            if constexpr (TYPE == 1) {
#pragma unroll
                for (int i = 0; i < 16; ++i) hraw[i] = PROJ[(size_t)(row0 + 32 * half + 16 * gq + i) * NPROJ + C_HF + c]; }
#pragma unroll
            for (int ii = 0; ii < 16; ++ii) { const int i = 16 * gq + ii, t = 32 * half + i; float g;
                if constexpr (TYPE == 0) { float pre = b2;
#pragma unroll
                    for (int r = 0; r < 16; ++r) pre += GAs[t * 16 + r] * w2[r];
                    g = fast_logsig(pre) * (1.0f / 16.0f); }
                else if constexpr (TYPE == 1) { const float hf = fminf(fmaxf(bf2f(hraw[ii]), -80.f), 80.f); const float sgm = __builtin_amdgcn_rcpf(1.0f + __expf(-hf));
                    g = __logf(lbv + (1.0f - lbv) * sgm); }
                else g = lg;
                tot += g; cum[i] = tot;
                if constexpr (TYPE == 0) { if ((ii & 3) == 3) asm volatile("" ::: "memory"); } } }
        TOT[c * 2 + half] = tot;
    }
    __syncthreads();
    if (act) { const float t0 = TOT[c * 2], t1 = TOT[c * 2 + 1]; const float off = half ? t0 : 0.f, last = t0 + t1;
#pragma unroll
        for (int hq = 0; hq < 4; ++hq) {
            bf16 ka[8], kb[8]; float cs[8], sn[8];
            if constexpr (TYPE != 1) {
#pragma unroll
                for (int i = 0; i < 8; ++i) { const size_t row = (size_t)(row0 + 32 * half + 8 * hq + i); const bf16* pr = PROJ + row * NPROJ;
                    if constexpr (TYPE == 0) ka[i] = pr[C_GK + c];
                    else { const float* rp = (const float*)(ws + WS_ROPE) + row * 48; ka[i] = pr[C_RK + h * 48 + d]; kb[i] = pr[C_RK + h * 48 + d2]; cs[i] = rp[f]; sn[i] = rp[24 + f]; } } }
            float kt[8];
#pragma unroll
            for (int j = 0; j < 8; ++j) { const int i = 8 * hq + j; const float cm = cum[i] + off; const size_t row = (size_t)(row0 + 32 * half + i); float k;
                if constexpr (TYPE == 0) k = bf2f(ka[j]);
                else if constexpr (TYPE == 1) k = 1.0f - __expf(cum[i] - (i > 0 ? cum[i - 1] : 0.f));
                else k = bf2f(ka[j]) * cs[j] + sg * bf2f(kb[j]) * sn[j];
                if constexpr (TYPE != 2) *(GAS bf16*)(F1 + row * NDV + C::COFF + c) = (bf16)f2bf(__expf(cm - ((i < 16) ? off : cum[15] + off)));
                { const float eb = cum[(i < 16) ? 15 : 31] + off;
                  ((LAS bf16*)(lds + LA_KTT))[(32 * half + i) * KTP + c] = (bf16)f2bf(k * __expf(eb - cm)); }
                kt[j] = k * __expf(last - cm); }
            v4u w; w.x = pk2(kt[0], kt[1]); w.y = pk2(kt[2], kt[3]); w.z = pk2(kt[4], kt[5]); w.w = pk2(kt[6], kt[7]);
            *(LAS v4u*)(KT + c * BP + 32 * half + 8 * hq) = w; }
        if (TYPE != 2) { *(GAS float*)(ECG + (2 * half + 0) * NDV + C::COFF + c) = cum[15] + off; *(GAS float*)(ECG + (2 * half + 1) * NDV + C::COFF + c) = cum[31] + off; }
        if (TYPE != 2 && half == 0) *(GAS float*)(DVEC + C::COFF + c) = __expf(last);
    }
    __syncthreads();
    { constexpr int CPR = NC / 8;
#pragma unroll
        for (int it = 0; it < (64 * CPR) / NTHR; ++it) { const int idx = tid + NTHR * it, t = idx / CPR, ch = idx - t * CPR;
            *(GAS v4u*)((bf16*)(ws + WS_KT) + (size_t)(row0 + t) * NKT + C::KOFF + 8 * ch) = *(const LAS v4u*)((const LAS bf16*)(lds + LA_KTT) + t * KTP + 8 * ch); } }
    constexpr int TD = DK / 16, NT = (DV / 16) * TD;
    for (int ti = wave; ti < 4 * NT; ti += NWAVES) { const int hh = ti / NT, tr = ti - hh * NT, te = tr / TD, td = tr - te * TD; f32x4 acc = {0.f, 0.f, 0.f, 0.f};
#pragma unroll
        for (int kk = 0; kk < 2; ++kk) acc = __builtin_amdgcn_mfma_f32_16x16x32_bf16(ldfrag(VT, BP, hh * DV + te * 16, kk * 32, lane), ldfrag(KT, BP, hh * DK + td * 16, kk * 32, lane), acc, 0, 0, 0);
        bf16* Uh = U + hh * DK * DV;
#pragma unroll
        for (int r = 0; r < 4; ++r) *(GAS bf16*)(Uh + (te * 16 + (lane >> 4) * 4 + r) * DK + td * 16 + (lane & 15)) = (bf16)f2bf(acc[r]); }
    __syncthreads();
}
__device__ __forceinline__ void p3a_summaries(const Args& a, int layer, LAS unsigned char* lds, int vcu, int G, int tid, int lane, int wave) {
    for (int unit = vcu; unit < NUNIT; unit += G) {
        { LAS float* GAs = (LAS float*)(lds + LA_GA); const float* GA = (const float*)(a.ws + WS_GA); for (int i = tid; i < CH * 16; i += NTHR) GAs[i] = GA[(size_t)unit * CH * 16 + i]; }
        __syncthreads();
        mixa_batch<0>(a, layer, unit, lds, tid, lane, wave);
        mixa_batch<1>(a, layer, unit, lds, tid, lane, wave);
        mixa_batch<2>(a, layer, unit, lds, tid, lane, wave);
    }
}

__device__ __forceinline__ void p3b_scan(const Args& a, int vcu, int G, int tid) {
    unsigned char* ws = a.ws; const bf16* U = (const bf16*)(ws + WS_U); const float* DVEC = (const float*)(ws + WS_DVEC); bf16* SP = (bf16*)(ws + WS_SP);
    for (int gid = vcu * NTHR + tid; gid < BATCH * ST_TOT; gid += G * NTHR) {
        const int b = gid / ST_TOT, el = gid - b * ST_TOT;
        int di = -1; float cdec = 0.f;
        if (el < ST_HG) { const int h = el / 4608, d = (el - h * 4608) % 48; di = h * 48 + d; }
        else if (el < ST_RET) { const int r = el - ST_HG, h = r / 4096, d = r % 64; di = 192 + h * 64 + d; }
        else { const int h = (el - ST_RET) / 4608; cdec = expf(64.0f * logf(1.0f - exp2f(-5.0f - (float)h))); }
        const bf16* up = U + (size_t)b * NCH * ST_TOT + el; const float* dp = DVEC + (size_t)b * NCH * NDV + (di < 0 ? 0 : di); bf16* sp = SP + (size_t)b * NCH * ST_TOT + el;
        float s = 0.f;
#pragma unroll 1
        for (int n0 = 0; n0 < NCH; n0 += 32) { float u[32], dc[32];
#pragma unroll
            for (int i = 0; i < 32; ++i) { u[i] = bf2f(up[(size_t)(n0 + i) * ST_TOT]); dc[i] = (di < 0) ? cdec : dp[(size_t)(n0 + i) * NDV]; }
#pragma unroll
            for (int i = 0; i < 32; ++i) { *(GAS bf16*)(sp + (size_t)(n0 + i) * ST_TOT) = (bf16)f2bf(s); s = dc[i] * s + u[i]; } }
    }
}

#ifndef SUB_MASK
#define SUB_MASK 0
#endif
#define SUBSTRETCH(bit, t0_) do { if ((SUB_MASK >> (bit)) & 1) { const unsigned long long t1_ = __builtin_amdgcn_s_memrealtime(); while (__builtin_amdgcn_s_memrealtime() - t1_ < t1_ - (t0_)) __builtin_amdgcn_s_sleep(8); } } while (0)
constexpr int LC_VT = 0, LC_ST = 55296, LC_AB = 110592, OBP = 104, LC_EC = 137216;
template <int TYPE, bool ISQ>
__device__ __forceinline__ void mix_frag(const Args& a, int h, size_t row, int t, int d0, float (&x)[8], float (&cm)[8]) {
    typedef MixCfg<TYPE> C; constexpr int DK = C::DK; static_assert(ISQ, "query path only");
    unsigned char* ws = a.ws; const bf16* pr = (const bf16*)(ws + WS_PROJ) + row * NPROJ;
    if constexpr (TYPE != 2) {
        const v4u p = *(const v4u*)(pr + C::CQ + h * DK + d0); const unsigned pw[4] = {p.x, p.y, p.z, p.w};
        const v4u f = *(const v4u*)((const bf16*)(ws + WS_CUM) + row * NDV + C::COFF + h * DK + d0); const unsigned fw[4] = {f.x, f.y, f.z, f.w};
#pragma unroll
        for (int j = 0; j < 4; ++j) { x[2 * j] = __builtin_bit_cast(float, pw[j] << 16); x[2 * j + 1] = __builtin_bit_cast(float, pw[j] & 0xffff0000u); cm[2 * j] = __builtin_bit_cast(float, fw[j] << 16); cm[2 * j + 1] = __builtin_bit_cast(float, fw[j] & 0xffff0000u); }
        if constexpr (TYPE == 0) {
#pragma unroll
            for (int j = 0; j < 8; ++j) x[j] *= 0.14433756729740643f; }
    } else {
        const int f0 = (d0 < 24) ? d0 : d0 - 24, dp = (d0 < 24) ? d0 + 24 : d0 - 24; const float sg = (d0 < 24) ? -1.f : 1.f;
        const int cb = C_RQ + h * DK; const v4u p = *(const v4u*)(pr + cb + d0), pp = *(const v4u*)(pr + cb + dp); const unsigned pw[4] = {p.x, p.y, p.z, p.w}, qw[4] = {pp.x, pp.y, pp.z, pp.w};
        const float* rp = (const float*)(ws + WS_ROPE) + row * 48; const f32x4 cs0 = *(const f32x4*)(rp + f0), cs1 = *(const f32x4*)(rp + f0 + 4), sn0 = *(const f32x4*)(rp + 24 + f0), sn1 = *(const f32x4*)(rp + 24 + f0 + 4);
        const float cmv = (float)(t + 1) * ret_lg(h);
#pragma unroll
        for (int j = 0; j < 4; ++j) { const float xa = __builtin_bit_cast(float, pw[j] << 16), xb = __builtin_bit_cast(float, pw[j] & 0xffff0000u), ya = __builtin_bit_cast(float, qw[j] << 16), yb = __builtin_bit_cast(float, qw[j] & 0xffff0000u);
            const float ca = (j < 2) ? cs0[2 * j] : cs1[2 * j - 4], cb2 = (j < 2) ? cs0[2 * j + 1] : cs1[2 * j - 3], sa = (j < 2) ? sn0[2 * j] : sn1[2 * j - 4], sb = (j < 2) ? sn0[2 * j + 1] : sn1[2 * j - 3];
            x[2 * j] = (xa * ca + sg * ya * sa) * 0.14433756729740643f; x[2 * j + 1] = (xb * cb2 + sg * yb * sb) * 0.14433756729740643f; cm[2 * j] = cmv; cm[2 * j + 1] = cmv; }
    }
}

template <int TYPE>
__device__ __forceinline__ void mixc_batch(const Args& a, int layer, int unit, LAS unsigned char* lds, int tid, int lane, int wave) {
    asm volatile("" : "+v"(tid), "+v"(lane));
    typedef MixCfg<TYPE> C; constexpr int DK = C::DK, DV = C::DV, NV = C::NV, TE = DV / 16;
    unsigned char* ws = a.ws; const bf16* PROJ = (const bf16*)(ws + WS_PROJ); bf16* MIX = (bf16*)(ws + WS_MIX);
    LAS bf16* VT = (LAS bf16*)(lds + LC_VT); LAS bf16* ST = (LAS bf16*)(lds + LC_ST); LAS bf16* AB = (LAS bf16*)(lds + LC_AB) + wave * 16 * OBP;
    const int row0 = unit * CH;
    const unsigned long long ts0_ = SUB_MASK ? __builtin_amdgcn_s_memrealtime() : 0ull;
    stage_vt<NV>(PROJ + (size_t)row0 * NPROJ + C::CV, VT, tid);
    SUBSTRETCH(3, ts0_);
    const unsigned long long ts3_ = SUB_MASK ? __builtin_amdgcn_s_memrealtime() : 0ull;
    { const bf16* SPu = (const bf16*)(ws + WS_SP) + (size_t)unit * ST_TOT + C::STOFF;
        constexpr int NIS = (NV * 8) / NTHR; static_assert((NV * 8) % NTHR == 0, "ST staging"); v4u sw[NIS];
#pragma unroll
        for (int it = 0; it < NIS; ++it) { const int idx = tid + NTHR * it, er = idx >> 3, ch = idx & 7; sw[it] = (v4u){0u, 0u, 0u, 0u}; if (ch * 8 < DK) sw[it] = *(const v4u*)(SPu + (size_t)er * DK + ch * 8); }
#pragma unroll
        for (int it = 0; it < NIS; ++it) { const int idx = tid + NTHR * it, er = idx >> 3, ch = idx & 7; *(LAS v4u*)(ST + er * BP + ch * 8) = sw[it]; } }
    SUBSTRETCH(4, ts3_);
    SUBSTRETCH(0, ts0_);
    if constexpr (TYPE != 2) { LAS float* EC = (LAS float*)(lds + LC_EC);
        for (int idx = tid; idx < 4 * C::NC; idx += NTHR) { const int jb = idx / C::NC, cc = idx - jb * C::NC; EC[jb * 256 + cc] = ((const float*)(ws + WS_CUM + 16 * MiB))[((size_t)unit * 4 + jb) * NDV + C::COFF + cc]; } }
    __syncthreads();
    const unsigned long long ts1_ = SUB_MASK ? __builtin_amdgcn_s_memrealtime() : 0ull;
    const int h = wave >> 1, hsel = wave & 1, r = lane & 15, g = lane >> 4;
    const LAS bf16* STh = ST + h * DV * BP; const LAS bf16* VTh = VT + h * DV * BP;
    constexpr int NCHK = DV / 8, NOC = (16 * NCHK) / 64;
#pragma unroll 1
    for (int ib = 0; ib < 2; ++ib) { const int I = ib ? 3 - hsel : hsel;
        pg8::bf16x8 qh[2], qt[2]; float refv[2][8], qhf[2][8];
#pragma unroll
        for (int s = 0; s < 2; ++s) { const int d0 = 32 * s + 8 * g; const bool valid = d0 < DK; const int d0c = valid ? d0 : 0;
            float x[8], cm[8]; mix_frag<TYPE, true>(a, h, (size_t)(row0 + 16 * I + r), 16 * I + r, d0c, x, cm);
            if constexpr (TYPE == 2) {
#pragma unroll
                for (int j = 0; j < 8; ++j) refv[s][j] = (float)(16 * I) * ret_lg(h);
            } else { if (I > 0) { const LAS float* cp = (const LAS float*)(lds + LC_EC) + (I - 1) * 256 + h * DK + d0c; const f32x4 c0 = *(const LAS f32x4*)cp, c1 = *(const LAS f32x4*)(cp + 4);
#pragma unroll
                    for (int j = 0; j < 4; ++j) { refv[s][j] = c0[j]; refv[s][4 + j] = c1[j]; } }
                else {
#pragma unroll
                    for (int j = 0; j < 8; ++j) refv[s][j] = 0.f; } }
            float xt[8];
#pragma unroll
            for (int j = 0; j < 8; ++j) { if constexpr (TYPE == 2) { qhf[s][j] = valid ? x[j] * __expf(cm[j] - refv[s][j]) : 0.f; xt[j] = valid ? x[j] * __expf(cm[j]) : 0.f; }
                else { qhf[s][j] = valid ? x[j] * cm[j] : 0.f; xt[j] = qhf[s][j] * __expf(refv[s][j]); } }
            qh[s] = pack8(qhf[s]); qt[s] = pack8(xt); }
        v4u kf[4][2];
#pragma unroll
        for (int J = 0; J < 4; ++J) { const int Jc = (J < I) ? J : I; const size_t rowJ = (size_t)(row0 + 16 * Jc + r);
#pragma unroll
            for (int s = 0; s < 2; ++s) { const int d0 = 32 * s + 8 * g; const int d0c = (d0 < DK) ? d0 : 0;
                kf[J][s] = *(const v4u*)((const bf16*)(ws + WS_KT) + rowJ * NKT + C::KOFF + h * DK + d0c); } }
#pragma unroll
        for (int J = 0; J < 4; ++J) { if (J <= I) { f32x4 acc = {0.f, 0.f, 0.f, 0.f};
#pragma unroll
            for (int s = 0; s < 2; ++s) { pg8::bf16x8 qop;
                { float xq[8], ej[8]; const int d0 = 32 * s + 8 * g; const int d0c = (d0 < DK) ? d0 : 0;
                    if constexpr (TYPE == 2) {
#pragma unroll
                        for (int j = 0; j < 8; ++j) ej[j] = (float)(16 * (J + 1)) * ret_lg(h); }
                    else { const LAS float* ep = (const LAS float*)(lds + LC_EC) + J * 256 + h * DK + d0c; const f32x4 e0 = *(const LAS f32x4*)ep, e1 = *(const LAS f32x4*)(ep + 4);
#pragma unroll
                        for (int j = 0; j < 4; ++j) { ej[j] = e0[j]; ej[4 + j] = e1[j]; } }
#pragma unroll
                    for (int j = 0; j < 8; ++j) xq[j] = qhf[s][j] * __expf(fminf(refv[s][j] - ej[j], 80.f));
                    qop = pack8(xq); }
                acc = __builtin_amdgcn_mfma_f32_16x16x32_bf16(qop, __builtin_bit_cast(pg8::bf16x8, kf[J][s]), acc, 0, 0, 0); }
#pragma unroll
            for (int q = 0; q < 4; ++q) { const int i = 4 * g + q; const float v = (J < I || r <= i) ? acc[q] : 0.f; AB[i * BP + 16 * J + r] = (bf16)f2bf(v); } } }
        if ((I & 1) == 0) {
#pragma unroll
            for (int q = 0; q < 4; ++q) AB[(4 * g + q) * BP + 16 * (I + 1) + r] = (bf16)0; }
        asm volatile("s_waitcnt lgkmcnt(0)" ::: "memory");
        const pg8::bf16x8 ah0 = *(const LAS pg8::bf16x8*)(AB + r * BP + 8 * g), ah1 = *(const LAS pg8::bf16x8*)(AB + r * BP + 32 + 8 * g);
        f32x4 o[TE];
#pragma unroll
        for (int te = 0; te < TE; ++te) { f32x4 acc = {0.f, 0.f, 0.f, 0.f};
            acc = __builtin_amdgcn_mfma_f32_16x16x32_bf16(qt[0], ldfrag(STh, BP, te * 16, 0, lane), acc, 0, 0, 0);
            acc = __builtin_amdgcn_mfma_f32_16x16x32_bf16(qt[1], ldfrag(STh, BP, te * 16, 32, lane), acc, 0, 0, 0);
            acc = __builtin_amdgcn_mfma_f32_16x16x32_bf16(ah0, ldfrag(VTh, BP, te * 16, 0, lane), acc, 0, 0, 0);
            if (I >= 2) acc = __builtin_amdgcn_mfma_f32_16x16x32_bf16(ah1, ldfrag(VTh, BP, te * 16, 32, lane), acc, 0, 0, 0);
            o[te] = acc; }
        const unsigned long long ts2_ = SUB_MASK ? __builtin_amdgcn_s_memrealtime() : 0ull;
#pragma unroll
        for (int q = 0; q < 4; ++q) { float s1 = 0.f, s2 = 0.f;
#pragma unroll
            for (int te = 0; te < TE; ++te) { s1 += o[te][q]; s2 += o[te][q] * o[te][q]; }
#pragma unroll
            for (int m = 1; m < 16; m <<= 1) { s1 += __shfl_xor(s1, m); s2 += __shfl_xor(s2, m); }
            float mean = 0.f, rstd;
            if constexpr (TYPE == 2) { mean = s1 * (1.0f / DV); rstd = __builtin_amdgcn_rsqf(fmaxf(s2 * (1.0f / DV) - mean * mean, 0.f) + EPS); }
            else rstd = __builtin_amdgcn_rsqf(s2 * (1.0f / DV) + EPS);
#pragma unroll
            for (int te = 0; te < TE; ++te) AB[(4 * g + q) * OBP + te * 16 + r] = (bf16)f2bf((o[te][q] - mean) * rstd); }
        asm volatile("s_waitcnt lgkmcnt(0)" ::: "memory");
#pragma unroll 1
        for (int i = 0; i < NOC; ++i) { const int cidx = lane + 64 * i, orow = cidx / NCHK, ch = cidx - orow * NCHK; const size_t row = (size_t)(row0 + 16 * I + orow);
            const v4u ov = *(const LAS v4u*)(AB + orow * OBP + 8 * ch); const v4u gv = *(const v4u*)(PROJ + row * NPROJ + C::CG + h * DV + 8 * ch);
            const unsigned ow[4] = {ov.x, ov.y, ov.z, ov.w}, gw[4] = {gv.x, gv.y, gv.z, gv.w}; float res[8];
            f32x4 w0 = {1.f, 1.f, 1.f, 1.f}, w1 = {1.f, 1.f, 1.f, 1.f};
            if constexpr (TYPE == 0) { const float* wp = a.gla_norm_w + layer * 384 + h * 96 + 8 * ch; w0 = *(const f32x4*)wp; w1 = *(const f32x4*)(wp + 4); }
            if constexpr (TYPE == 1) { const float* wp = a.hg_norm_w + layer * 256 + h * 64 + 8 * ch; w0 = *(const f32x4*)wp; w1 = *(const f32x4*)(wp + 4); }
#pragma unroll
            for (int j = 0; j < 4; ++j) { const float oa = __builtin_bit_cast(float, ow[j] << 16), ob = __builtin_bit_cast(float, ow[j] & 0xffff0000u), ga = __builtin_bit_cast(float, gw[j] << 16), gb = __builtin_bit_cast(float, gw[j] & 0xffff0000u);
                const float wa = (j < 2) ? w0[2 * j] : w1[2 * j - 4], wb = (j < 2) ? w0[2 * j + 1] : w1[2 * j - 3];
                const float sa = __builtin_amdgcn_rcpf(1.0f + __expf(-ga)), sb = __builtin_amdgcn_rcpf(1.0f + __expf(-gb));
                res[2 * j] = oa * wa * ((TYPE == 1) ? sa : ga * sa); res[2 * j + 1] = ob * wb * ((TYPE == 1) ? sb : gb * sb); }
            if (F8_OUT) { typedef int i32x2 __attribute__((ext_vector_type(2)));
                *(GAS i32x2*)((unsigned char*)MIX + row * D + C::MIXOFF + h * DV + 8 * ch) = (i32x2){pk4_fp8(res[0] * S8_M, res[1] * S8_M, res[2] * S8_M, res[3] * S8_M), pk4_fp8(res[4] * S8_M, res[5] * S8_M, res[6] * S8_M, res[7] * S8_M)}; }
            else { v4u w; w.x = pk2(res[0], res[1]); w.y = pk2(res[2], res[3]); w.z = pk2(res[4], res[5]); w.w = pk2(res[6], res[7]); *(GAS v4u*)(MIX + row * D + C::MIXOFF + h * DV + 8 * ch) = w; } }
        SUBSTRETCH(2, ts2_);
    }
    SUBSTRETCH(1, ts1_);
    __syncthreads();
}
__device__ __forceinline__ void p3c_outputs(const Args& a, int layer, LAS unsigned char* lds, int vcu, int G, int tid, int lane, int wave) {
    for (int unit = vcu; unit < NUNIT; unit += G) {
        mixc_batch<0>(a, layer, unit, lds, tid, lane, wave);
        mixc_batch<1>(a, layer, unit, lds, tid, lane, wave);
        mixc_batch<2>(a, layer, unit, lds, tid, lane, wave);
    }
}


constexpr int MW_ARGS = 800;
__device__ __forceinline__ const void* ld_argp(const volatile LAS unsigned* T, int i) {
    const unsigned lo = __builtin_amdgcn_readfirstlane(T[2 * i]), hi = __builtin_amdgcn_readfirstlane(T[2 * i + 1]);
    return (const void*)(((unsigned long long)hi << 32) | lo);
}
__device__ __forceinline__ Args load_args(LAS unsigned char* lds) {
    const volatile LAS unsigned* T = (const volatile LAS unsigned*)(lds + MISC_OFF) + MW_ARGS;
    Args a;
    a.x = (const float*)ld_argp(T, 0); a.c = (const float*)ld_argp(T, 1); a.pos = (const int*)ld_argp(T, 2); a.w_mod = (const float*)ld_argp(T, 3); a.b_mod = (const float*)ld_argp(T, 4);
    a.norm1_w = (const float*)ld_argp(T, 5); a.w_in = (const float*)ld_argp(T, 6); a.gla_wa2 = (const float*)ld_argp(T, 7); a.gla_ba2 = (const float*)ld_argp(T, 8); a.hg_lb = (const float*)ld_argp(T, 9);
    a.gla_norm_w = (const float*)ld_argp(T, 10); a.hg_norm_w = (const float*)ld_argp(T, 11); a.w_out = (const float*)ld_argp(T, 12); a.norm2_w = (const float*)ld_argp(T, 13); a.w_r = (const float*)ld_argp(T, 14);
    a.b_r = (const float*)ld_argp(T, 15); a.w_gu = (const float*)ld_argp(T, 16); a.b_gu = (const float*)ld_argp(T, 17); a.w_dn = (const float*)ld_argp(T, 18); a.b_dn = (const float*)ld_argp(T, 19);
    a.final_norm_w = (const float*)ld_argp(T, 20); a.out = (float*)ld_argp(T, 21); a.ws = (unsigned char*)ld_argp(T, 22); a.ph_lo = 0; a.ph_hi = 0;
    return a;
}
#define PH_CTX() { unsigned l_ = (unsigned)(size_t)lds; asm volatile("" : "+s"(l_)); lds = (LAS unsigned char*)(size_t)l_; } const Args args = load_args(lds); volatile LAS unsigned* MISC = (volatile LAS unsigned*)(lds + MISC_OFF); int tid_ = wv * 64 + (int)__builtin_amdgcn_mbcnt_hi(~0u, __builtin_amdgcn_mbcnt_lo(~0u, 0u)); asm volatile("" : "+v"(tid_)); const int tid = tid_, lane = tid & 63, wave = __builtin_amdgcn_readfirstlane(tid >> 6); \
    const int G = gridDim.x; const int bx = blockIdx.x; const int vcu = (G % 8 == 0) ? (bx % 8) * (G / 8) + bx / 8 : bx; unsigned char* ws = args.ws; gu32* ctl = (gu32*)(ws + WS_CTL); \
    (void)MISC; (void)lane; (void)wave; (void)vcu; (void)ctl; (void)bx; (void)tid
__device__ __forceinline__ void ph_p0(LAS unsigned char* lds, int wv) { PH_CTX(); p0_prologue(args, lds, vcu, G, tid, lane, wave); }
__device__ __forceinline__ void ph_p1(LAS unsigned char* lds, int wv, int layer_) { int layer = __builtin_amdgcn_readfirstlane(layer_); asm volatile("" : "+s"(layer)); PH_CTX();
    if (layer > 0) { moe_tables(ctl, layer - 1, MISC, tid); const int nrt = __builtin_amdgcn_readfirstlane((int)MISC[MW_NRT]);
        const int done = conv_t2(G) + conv_idle(nrt * 8, G) * NWAVES * CB7 + conv_idle(nrt * 4, G) * NWAVES * CB8; LAS float* scr = (LAS float*)(lds + wave * 16640);
        for (int it = done + vcu * NWAVES + wave; it < IT_LAYER; it += G * NWAVES) convert_item(args, layer, it, scr, lane);
        __syncthreads(); }
    rows_mfma<16>(args, layer, lds, MISC, ctl, vcu, G, tid, lane, wave); }
__device__ __forceinline__ void ph_p2(LAS unsigned char* lds, int wv, int layer_) { int layer = __builtin_amdgcn_readfirstlane(layer_); asm volatile("" : "+s"(layer)); PH_CTX();
    pg8::Gemm g{(const bf16*)(ws + WS_H), (const bf16*)(ws + WS_WIN + (size_t)layer * NPROJ * D * (F8_IN ? 1 : 2)), MTOK, NPROJ, F8_IN ? D / 2 : D}; pg8::StaticOrder S; S.init(MTOK, NPROJ, G, bx);
    pg8::EpiBf16Plain E{(bf16*)(ws + WS_PROJ), NPROJ, F8_IN ? 1.0f / (S8_H * S8_W) : 1.0f};
    pg8::gemm_phase<pg8::EpiBf16Plain, pg8::StaticOrder, true, true, F8_IN>(lds, g, S, E, tid);
    if (layer + 1 < DEPTH && G == 256 && bx >= 64) convert_range(args, layer + 1, ((bx - 64) * NWAVES + wave) * CB2, CB2, lds, lane, wave); }
__device__ __forceinline__ void ph_p3a(LAS unsigned char* lds, int wv, int layer_) { int layer = __builtin_amdgcn_readfirstlane(layer_); asm volatile("" : "+s"(layer)); PH_CTX(); p3a_summaries(args, layer, lds, vcu, G, tid, lane, wave); }
__device__ __forceinline__ void ph_p3b(LAS unsigned char* lds, int wv) { PH_CTX(); p3b_scan(args, vcu, G, tid); }
__device__ __forceinline__ void ph_p3c(LAS unsigned char* lds, int wv, int layer_) { int layer = __builtin_amdgcn_readfirstlane(layer_); asm volatile("" : "+s"(layer)); PH_CTX(); p3c_outputs(args, layer, lds, vcu, G, tid, lane, wave); }
__device__ __forceinline__ void ph_p4(LAS unsigned char* lds, int wv, int layer_) { int layer = __builtin_amdgcn_readfirstlane(layer_); asm volatile("" : "+s"(layer)); PH_CTX();
    pg8::Gemm g{(const bf16*)(ws + WS_MIX), (const bf16*)(ws + WS_WOUT + (size_t)layer * D * D * (F8_OUT ? 1 : 2)), MTOK, D, F8_OUT ? D / 2 : D}; pg8::StaticOrder S; S.init(MTOK, D, G, bx);
    pg8::EpiResGate E{(const bf16*)(ws + WS_X), (bf16*)(ws + WS_X), D, (const float*)(ws + WS_MOD) + (size_t)layer * 2 * 6144 + 2 * D, 6144, SEQ, F8_OUT ? 1.0f / (S8_M * S8_W) : 1.0f};
    pg8::gemm_phase<pg8::EpiResGate, pg8::StaticOrder, true, true, F8_OUT>(lds, g, S, E, tid); }
__device__ __forceinline__ void ph_p5(LAS unsigned char* lds, int wv, int layer_) { int layer = __builtin_amdgcn_readfirstlane(layer_); asm volatile("" : "+s"(layer)); PH_CTX(); rows_mfma<32>(args, layer, lds, MISC, ctl, vcu, G, tid, lane, wave); }
__device__ __forceinline__ void ph_p7(LAS unsigned char* lds, int wv, int layer_) { int layer = __builtin_amdgcn_readfirstlane(layer_); asm volatile("" : "+s"(layer)); PH_CTX();
    moe_tables(ctl, layer, MISC, tid);
    const int nrt = __builtin_amdgcn_readfirstlane((int)MISC[MW_NRT]);
    pg8::Gemm g{(const bf16*)(ws + WS_A1), (const bf16*)(ws + WS_WGU + (size_t)layer * NE * 2048 * D), nrt * 256, NE * 2048, D / 2};
    pg8::MoeOrder S{8, G, vcu, nrt * 8, (const LAS int*)(lds + MISC_OFF + 4 * MW_TILE)};
    pg8::EpiSwiglu E{ws + WS_ACT, FFN, args.b_gu + (size_t)layer * NE * 2048, 1.0f / (S8_H * S8_W), S8_A};
    pg8::gemm_phase<pg8::EpiSwiglu, pg8::MoeOrder, true, true, true>(lds, g, S, E, tid);
    { const int rem = (nrt * 8) % G; if (layer + 1 < DEPTH && rem != 0 && vcu >= rem) convert_range(args, layer + 1, conv_t2(G) + ((vcu - rem) * NWAVES + wave) * CB7, CB7, lds, lane, wave); } }
__device__ __forceinline__ void ph_p8(LAS unsigned char* lds, int wv, int layer_) { int layer = __builtin_amdgcn_readfirstlane(layer_); asm volatile("" : "+s"(layer)); PH_CTX();
    moe_tables(ctl, layer, MISC, tid);
    const int nrt = __builtin_amdgcn_readfirstlane((int)MISC[MW_NRT]);
    pg8::Gemm g{(const bf16*)(ws + WS_ACT), (const bf16*)(ws + WS_WDN + (size_t)layer * NE * D * FFN), nrt * 256, NE * D, FFN / 2};
    pg8::MoeOrder S{4, G, vcu, nrt * 4, (const LAS int*)(lds + MISC_OFF + 4 * MW_TILE)};
    if constexpr (Y8) { pg8::EpiFp8Bias E{ws + WS_Y, D, args.b_dn + (size_t)layer * NE * D, D, 1.0f / (S8_A * S8_W), S8_Y};
        pg8::gemm_phase<pg8::EpiFp8Bias, pg8::MoeOrder, true, true, true>(lds, g, S, E, tid); }
    else { pg8::EpiBf16Bias E{(bf16*)(ws + WS_Y), D, args.b_dn + (size_t)layer * NE * D, D, 1.0f / (S8_A * S8_W)};
        pg8::gemm_phase<pg8::EpiBf16Bias, pg8::MoeOrder, true, true, true>(lds, g, S, E, tid); }
    { const int rem = (nrt * 4) % G; if (layer + 1 < DEPTH && rem != 0 && vcu >= rem) convert_range(args, layer + 1, conv_t2(G) + conv_idle(nrt * 8, G) * NWAVES * CB7 + ((vcu - rem) * NWAVES + wave) * CB8, CB8, lds, lane, wave); } }
__device__ __forceinline__ void ph_final(LAS unsigned char* lds, int wv) { PH_CTX(); final_rows(args, lds, vcu, G, tid, lane); }

#ifndef DBL_MASK
#define DBL_MASK 0
#endif
#if DBL_MASK
#define RUN(bit, call) do { if ((DBL_MASK >> (bit)) & 1) { const unsigned long long t0_ = __builtin_amdgcn_s_memrealtime(); call; const unsigned long long t1_ = __builtin_amdgcn_s_memrealtime(); \
        while (__builtin_amdgcn_s_memrealtime() - t1_ < t1_ - t0_) __builtin_amdgcn_s_sleep(8); } else { call; } } while (0)
#else
#define RUN(bit, call) do { call; } while (0)
#endif
__global__ void __launch_bounds__(NTHR, 2) hybrid_fwd(Args args) {
    extern __shared__ __attribute__((aligned(16))) unsigned char lds_raw[];
    LAS unsigned char* lds = (LAS unsigned char*)lds_raw;
    volatile LAS unsigned* MISC = (volatile LAS unsigned*)(lds + MISC_OFF);
    const int tid = threadIdx.x; const int wv = __builtin_amdgcn_readfirstlane(tid >> 6);
    gu32* ctl = (gu32*)(args.ws + WS_CTL);
    for (int u = tid; u < (LDS_BYTES - MISC_OFF) / 4; u += NTHR) MISC[u] = 0u;
    __syncthreads();
    if (tid == 0) {
#define ST_ARG(i, p) do { const unsigned long long v_ = (unsigned long long)(p); MISC[MW_ARGS + 2 * (i)] = (unsigned)v_; MISC[MW_ARGS + 2 * (i) + 1] = (unsigned)(v_ >> 32); } while (0)
        ST_ARG(0, args.x); ST_ARG(1, args.c); ST_ARG(2, args.pos); ST_ARG(3, args.w_mod); ST_ARG(4, args.b_mod); ST_ARG(5, args.norm1_w); ST_ARG(6, args.w_in); ST_ARG(7, args.gla_wa2); ST_ARG(8, args.gla_ba2);
        ST_ARG(9, args.hg_lb); ST_ARG(10, args.gla_norm_w); ST_ARG(11, args.hg_norm_w); ST_ARG(12, args.w_out); ST_ARG(13, args.norm2_w); ST_ARG(14, args.w_r); ST_ARG(15, args.b_r); ST_ARG(16, args.w_gu);
        ST_ARG(17, args.b_gu); ST_ARG(18, args.w_dn); ST_ARG(19, args.b_dn); ST_ARG(20, args.final_norm_w); ST_ARG(21, args.out); ST_ARG(22, args.ws);
#undef ST_ARG
    }
    __syncthreads();
    const int lo = args.ph_lo, hi = args.ph_hi;
    const bool multi = (hi - lo) > 1;
    XcdBarrier bar; bar.bar = (unsigned*)(ctl + CW_BAR); bar.x = 0; bar.st = nullptr;
    if (multi) bar = xcd_barrier_post((unsigned*)(ctl + CW_BAR), MISC + MW_BAR);
#define IN(k) (lo <= (k) && (k) < hi)
#define SEAM(k) do { if (IN(k) && IN((k) + 1)) xcd_barrier(bar); } while (0)

    if (IN(0)) RUN(0, ph_p0(lds, wv));
    SEAM(0);
    for (int layer = 0; layer < DEPTH; ++layer) {
        const int pb = 1 + 9 * layer;
        if (IN(pb + 0)) RUN(1, ph_p1(lds, wv, layer));
        SEAM(pb + 0);
        if (IN(pb + 1)) RUN(2, ph_p2(lds, wv, layer));
        SEAM(pb + 1);
        if (IN(pb + 2)) RUN(3, ph_p3a(lds, wv, layer));
        SEAM(pb + 2);
        if (IN(pb + 3)) RUN(4, ph_p3b(lds, wv));
        SEAM(pb + 3);
        if (IN(pb + 4)) RUN(5, ph_p3c(lds, wv, layer));
        SEAM(pb + 4);
        if (IN(pb + 5)) RUN(6, ph_p4(lds, wv, layer));
        SEAM(pb + 5);
        if (IN(pb + 6)) RUN(7, ph_p5(lds, wv, layer));
        SEAM(pb + 6);
        if (IN(pb + 7)) RUN(9, ph_p7(lds, wv, layer));
        SEAM(pb + 7);
        if (IN(pb + 8)) RUN(10, ph_p8(lds, wv, layer));
        SEAM(pb + 8);
    }
    if (IN(NPHASE - 1)) RUN(11, ph_final(lds, wv));
#undef IN
#undef SEAM
}

#ifndef MK_SINGLE
#define MK_SINGLE 1
#endif
extern "C" void kernel_launch(void* const* d_in, const int* in_sizes, int n_in, void* d_out, int out_size, void* d_ws, size_t ws_size, hipStream_t stream) {
    static int grid = 0;
    if (grid == 0) {
        if (n_in != 21 || in_sizes[0] != MTOK * D || out_size != MTOK * D || ws_size < WS_END) { fprintf(stderr, "kernel_launch: unexpected problem shape (n_in %d, in0 %d, out %d, ws %zu)\n", n_in, n_in > 0 ? in_sizes[0] : -1, out_size, ws_size); grid = -1; return; }
        int dev = 0, cus = 0, per_cu = 0;
        if (hipGetDevice(&dev) != hipSuccess || hipDeviceGetAttribute(&cus, hipDeviceAttributeMultiprocessorCount, dev) != hipSuccess) { grid = -1; return; }
        if (hipFuncSetAttribute((const void*)hybrid_fwd, hipFuncAttributeMaxDynamicSharedMemorySize, LDS_BYTES) != hipSuccess) { fprintf(stderr, "kernel_launch: hipFuncSetAttribute failed\n"); grid = -1; return; }
        if (hipOccupancyMaxActiveBlocksPerMultiprocessor(&per_cu, (const void*)hybrid_fwd, NTHR, LDS_BYTES) != hipSuccess || per_cu < 1) fprintf(stderr, "kernel_launch: occupancy query says %d\n", per_cu);
        (void)hipGetLastError();
        grid = cus;
    }
    if (grid < 0) return;
    (void)hipMemsetAsync((char*)d_ws + WS_CTL, 0, CTL_ZERO_BYTES, stream);
    Args a{};
    a.x = (const float*)d_in[0]; a.c = (const float*)d_in[1]; a.pos = (const int*)d_in[2]; a.w_mod = (const float*)d_in[3]; a.b_mod = (const float*)d_in[4]; a.norm1_w = (const float*)d_in[5];
    a.w_in = (const float*)d_in[6]; a.gla_wa2 = (const float*)d_in[7]; a.gla_ba2 = (const float*)d_in[8]; a.hg_lb = (const float*)d_in[9]; a.gla_norm_w = (const float*)d_in[10]; a.hg_norm_w = (const float*)d_in[11];
    a.w_out = (const float*)d_in[12]; a.norm2_w = (const float*)d_in[13]; a.w_r = (const float*)d_in[14]; a.b_r = (const float*)d_in[15]; a.w_gu = (const float*)d_in[16]; a.b_gu = (const float*)d_in[17];
    a.w_dn = (const float*)d_in[18]; a.b_dn = (const float*)d_in[19]; a.final_norm_w = (const float*)d_in[20]; a.out = (float*)d_out; a.ws = (unsigned char*)d_ws;
#if MK_SINGLE
    a.ph_lo = 0; a.ph_hi = NPHASE;
    hipLaunchKernelGGL(hybrid_fwd, dim3(grid), dim3(NTHR), LDS_BYTES, stream, a);
#else
    for (int p = 0; p < NPHASE; ++p) { a.ph_lo = p; a.ph_hi = p + 1; hipLaunchKernelGGL(hybrid_fwd, dim3(grid), dim3(NTHR), LDS_BYTES, stream, a); }
#endif
}
```

```cpp
#include <hip/hip_runtime.h>
#include <cstdio>
#include <cstdint>
namespace pg8 {
#define PG8_LAS __attribute__((address_space(3)))
typedef unsigned short bf16_t;
typedef short bf16x8 __attribute__((ext_vector_type(8)));
typedef float f32x4 __attribute__((ext_vector_type(4)));
typedef unsigned u32x4 __attribute__((ext_vector_type(4)));
constexpr int BM = 256, BK = 64, HALF = 128, HTB = HALF * BK * 2  , STAGE_BYTES = 8 * HTB, NXCD = 8, WGM = 8;

__host__ __device__ __forceinline__ int lds_byte(int r, int c) { const int st = (r >> 4) * 2 + (c >> 5), rr = r & 15, cc = c & 31, ob = rr * 64 + cc * 2; return st * 1024 + (ob ^ (((ob >> 9) & 1) << 5)); }
__host__ __device__ __forceinline__ void stage_rc(int b, int& R, int& C) { const int st = b / 1024, sb = b % 1024, swz = sb ^ (((sb >> 9) & 1) << 5); R = (st >> 1) * 16 + swz / 64; C = (st & 1) * 32 + (swz % 64) / 2; }
__host__ __device__ __forceinline__ int perm32(int rho) { const int n = rho >> 4, i = rho & 15; return 8 * (i >> 2) + 4 * n + (i & 3); }

struct Unit { int pm, pn, e, pl; };
struct Gemm { const bf16_t* A; const bf16_t* Bt; int M, N, K; };

struct StaticOrder {
    int nM, nN, nwg, G, c;
    __host__ __device__ void init(int M, int N, int G_, int c_) { nM = M / BM; nN = N / BM; nwg = nM * nN; G = G_; c = c_; }
    __host__ __device__ bool next(int i, Unit& u) const {
        const long L = (long)i * G + c; if (L >= nwg) return false;
        int wgid = (int)L; { const int q = nwg / NXCD, r = nwg % NXCD, xcd = wgid % NXCD, off = wgid / NXCD; wgid = (xcd < r ? xcd * (q + 1) : r * (q + 1) + (xcd - r) * q) + off; }
        const int nig = WGM * nN, gid = wgid / nig, fm = gid * WGM, gsz = (nM - fm) < WGM ? (nM - fm) : WGM;
        u.pm = fm + ((wgid % nig) % gsz); u.pn = (wgid % nig) / gsz; u.e = 0; u.pl = u.pn; return true;
    }
    __device__ __forceinline__ void a_ready(const Unit&) const {}
    __device__ __forceinline__ void done(const Unit&) const {}
};

__device__ __forceinline__ unsigned cvt_pk_bf16(float lo, float hi) { unsigned r; asm volatile("v_cvt_pk_bf16_f32 %0, %1, %2" : "=v"(r) : "v"(lo), "v"(hi)); return r; }

#define PG8_GAS __attribute__((address_space(1)))
struct NoPre {};
struct EpiBf16Plain {
    static constexpr bool PERM = true, AFTER_DRAIN = false; static constexpr int NST = 0; typedef NoPre Pre;
    __device__ __forceinline__ Pre prefetch(const Unit&, int, int) const { return Pre{}; }
    bf16_t* O; int ldc; float sc;
    __device__ __forceinline__ void operator()(const f32x4 (&acc)[2][2][4][2], const Unit& u, int wr, int wc, int fr, int fq, const Pre&) const {
        const int row0 = u.pm * BM + wr * 64 + fr; const int col0 = u.pn * BM + wc * 32 + 8 * fq;
#pragma unroll
        for (int ai = 0; ai < 2; ++ai)
#pragma unroll
            for (int m = 0; m < 4; ++m) { bf16_t* rowp = O + (size_t)(row0 + ai * HALF + m * 16) * ldc + col0;
#pragma unroll
                for (int bj = 0; bj < 2; ++bj) { const f32x4 v0 = acc[ai][bj][m][0] * sc, v1 = acc[ai][bj][m][1] * sc;
                    u32x4 w; w.x = cvt_pk_bf16(v0[0], v0[1]); w.y = cvt_pk_bf16(v0[2], v0[3]); w.z = cvt_pk_bf16(v1[0], v1[1]); w.w = cvt_pk_bf16(v1[2], v1[3]);
                    *(PG8_GAS u32x4*)(rowp + bj * HALF) = w; } }
    }
};
struct EpiResGate {
    static constexpr bool PERM = true, AFTER_DRAIN = false; static constexpr int NST = 0; typedef NoPre Pre;
    __device__ __forceinline__ Pre prefetch(const Unit&, int, int) const { return Pre{}; }
    const bf16_t* base; bf16_t* out; int ldc; const float* gate; int gpitch; int rows_per_batch; float sc;
    __device__ __forceinline__ void operator()(const f32x4 (&acc)[2][2][4][2], const Unit& u, int wr, int wc, int fr, int fq, const Pre&) const {
        const int row0 = u.pm * BM + wr * 64 + fr, col0 = u.pn * BM + wc * 32 + 8 * fq;
        const float* gp = gate + (size_t)((u.pm * BM) / rows_per_batch) * gpitch + col0;
        f32x4 gv[2][2];
#pragma unroll
        for (int bj = 0; bj < 2; ++bj)
#pragma unroll
            for (int n = 0; n < 2; ++n) gv[bj][n] = *(const PG8_GAS f32x4*)(gp + bj * HALF + 4 * n) * sc;
#pragma unroll
        for (int ai = 0; ai < 2; ++ai)
#pragma unroll
            for (int m = 0; m < 4; ++m) { const size_t off = (size_t)(row0 + ai * HALF + m * 16) * ldc + col0;
#pragma unroll
                for (int bj = 0; bj < 2; ++bj) { const u32x4 bs = *(const PG8_GAS u32x4*)(base + off + bj * HALF); const unsigned bw[4] = {bs.x, bs.y, bs.z, bs.w}; float r[8];
#pragma unroll
                    for (int j = 0; j < 4; ++j) { const f32x4& a4 = acc[ai][bj][m][j >> 1]; const f32x4& g4 = gv[bj][j >> 1];
                        r[2 * j] = __builtin_bit_cast(float, bw[j] << 16) + g4[2 * (j & 1)] * a4[2 * (j & 1)]; r[2 * j + 1] = __builtin_bit_cast(float, bw[j] & 0xffff0000u) + g4[2 * (j & 1) + 1] * a4[2 * (j & 1) + 1]; }
                    u32x4 w; w.x = cvt_pk_bf16(r[0], r[1]); w.y = cvt_pk_bf16(r[2], r[3]); w.z = cvt_pk_bf16(r[4], r[5]); w.w = cvt_pk_bf16(r[6], r[7]);
                    *(PG8_GAS u32x4*)(out + off + bj * HALF) = w; }
                asm volatile("" ::: "memory"); }
    }
};
struct EpiSwiglu {
    static constexpr bool PERM = true, AFTER_DRAIN = false; static constexpr int NST = 0; struct Pre { f32x4 bg[2], bu[2]; };
    __device__ __forceinline__ Pre prefetch(const Unit& u, int wc, int fq) const { typedef const __attribute__((address_space(1))) f32x4 gf4;
        const float* bp = bias + (size_t)u.e * 2048 + u.pl * HALF + wc * 32 + 8 * fq; Pre p; p.bg[0] = *(gf4*)bp; p.bg[1] = *(gf4*)(bp + 4); p.bu[0] = *(gf4*)(bp + 1024); p.bu[1] = *(gf4*)(bp + 1028); return p; }
    unsigned char* O; int ldc; const float* bias; float inv_in, out_scale;
    __device__ __forceinline__ float act1(float g, float up) const {
        g = fminf(g, 7.0f); up = fminf(fmaxf(up, -7.0f), 7.0f);
        const float s = __builtin_amdgcn_rcpf(1.0f + __builtin_amdgcn_exp2f(-1.702f * 1.4426950408889634f * g));
        return (up + 1.0f) * g * s * out_scale;
    }
    __device__ __forceinline__ void operator()(const f32x4 (&acc)[2][2][4][2], const Unit& u, int wr, int wc, int fr, int fq, const Pre& pre) const {
        const int row0 = u.pm * BM + wr * 64 + fr; const int jj0 = wc * 32 + 8 * fq; const int col0 = u.pl * HALF + jj0;
        const f32x4 bg[2] = {pre.bg[0], pre.bg[1]}, bu[2] = {pre.bu[0], pre.bu[1]};
#pragma unroll
        for (int ai = 0; ai < 2; ++ai)
#pragma unroll
            for (int m = 0; m < 4; ++m) { unsigned char* rowp = O + (size_t)(row0 + ai * HALF + m * 16) * ldc + col0;
                f32x4 r[2];
#pragma unroll
                for (int n = 0; n < 2; ++n) { const f32x4 g = acc[ai][0][m][n] * inv_in + bg[n], up = acc[ai][1][m][n] * inv_in + bu[n];
#pragma unroll
                    for (int j = 0; j < 4; ++j) r[n][j] = act1(g[j], up[j]); }
                int w0 = 0, w1 = 0;
                w0 = __builtin_amdgcn_cvt_pk_fp8_f32(r[0][0], r[0][1], w0, false); w0 = __builtin_amdgcn_cvt_pk_fp8_f32(r[0][2], r[0][3], w0, true);
                w1 = __builtin_amdgcn_cvt_pk_fp8_f32(r[1][0], r[1][1], w1, false); w1 = __builtin_amdgcn_cvt_pk_fp8_f32(r[1][2], r[1][3], w1, true);
                typedef int i32x2 __attribute__((ext_vector_type(2))); *(PG8_GAS i32x2*)rowp = (i32x2){w0, w1}; }
    }
};
struct EpiBf16Bias {
    static constexpr bool PERM = true, AFTER_DRAIN = false; static constexpr int NST = 0; typedef NoPre Pre;
    __device__ __forceinline__ Pre prefetch(const Unit&, int, int) const { return Pre{}; }
    bf16_t* O; int ldc; const float* bias; int bpitch; float inv_in;
    __device__ __forceinline__ void operator()(const f32x4 (&acc)[2][2][4][2], const Unit& u, int wr, int wc, int fr, int fq, const Pre&) const {
        const int row0 = u.pm * BM + wr * 64 + fr; const int col0 = u.pl * BM + wc * 32 + 8 * fq;
        const float* bp = bias + (size_t)u.e * bpitch + col0;
        f32x4 bv[2][2];
#pragma unroll
        for (int bj = 0; bj < 2; ++bj)
#pragma unroll
            for (int n = 0; n < 2; ++n) bv[bj][n] = *(const PG8_GAS f32x4*)(bp + bj * HALF + 4 * n);
#pragma unroll
        for (int ai = 0; ai < 2; ++ai)
#pragma unroll
            for (int m = 0; m < 4; ++m) { bf16_t* rowp = O + (size_t)(row0 + ai * HALF + m * 16) * ldc + col0;
#pragma unroll
                for (int bj = 0; bj < 2; ++bj) { const f32x4 v0 = acc[ai][bj][m][0] * inv_in + bv[bj][0], v1 = acc[ai][bj][m][1] * inv_in + bv[bj][1];
                    u32x4 w; w.x = cvt_pk_bf16(v0[0], v0[1]); w.y = cvt_pk_bf16(v0[2], v0[3]); w.z = cvt_pk_bf16(v1[0], v1[1]); w.w = cvt_pk_bf16(v1[2], v1[3]);
                    *(PG8_GAS u32x4*)(rowp + bj * HALF) = w; } }
    }
};
struct EpiFp8Bias {
    static constexpr bool PERM = true, AFTER_DRAIN = false; static constexpr int NST = 0; struct Pre { f32x4 bv[2][2]; };
    __device__ __forceinline__ Pre prefetch(const Unit& u, int wc, int fq) const { typedef const __attribute__((address_space(1))) f32x4 gf4;
        const float* bp = bias + (size_t)u.e * bpitch + u.pl * BM + wc * 32 + 8 * fq; Pre p; p.bv[0][0] = *(gf4*)bp; p.bv[0][1] = *(gf4*)(bp + 4); p.bv[1][0] = *(gf4*)(bp + HALF); p.bv[1][1] = *(gf4*)(bp + HALF + 4); return p; }
    unsigned char* O; int ldc; const float* bias; int bpitch; float inv_in, out_scale;
    __device__ __forceinline__ int pk4(f32x4 v) const { int w = 0; w = __builtin_amdgcn_cvt_pk_fp8_f32(__builtin_amdgcn_fmed3f(v[0], -448.f, 448.f), __builtin_amdgcn_fmed3f(v[1], -448.f, 448.f), w, false);
        return __builtin_amdgcn_cvt_pk_fp8_f32(__builtin_amdgcn_fmed3f(v[2], -448.f, 448.f), __builtin_amdgcn_fmed3f(v[3], -448.f, 448.f), w, true); }
    __device__ __forceinline__ void operator()(const f32x4 (&acc)[2][2][4][2], const Unit& u, int wr, int wc, int fr, int fq, const Pre& pre) const {
        const int row0 = u.pm * BM + wr * 64 + fr; const int col0 = u.pl * BM + wc * 32 + 8 * fq;
        const f32x4 bv[2][2] = {{pre.bv[0][0], pre.bv[0][1]}, {pre.bv[1][0], pre.bv[1][1]}};
#pragma unroll
        for (int ai = 0; ai < 2; ++ai)
#pragma unroll
            for (int m = 0; m < 4; ++m) { unsigned char* rowp = O + (size_t)(row0 + ai * HALF + m * 16) * ldc + col0;
#pragma unroll
                for (int bj = 0; bj < 2; ++bj) { const f32x4 v0 = (acc[ai][bj][m][0] * inv_in + bv[bj][0]) * out_scale, v1 = (acc[ai][bj][m][1] * inv_in + bv[bj][1]) * out_scale;
                    typedef int i32x2 __attribute__((ext_vector_type(2))); *(PG8_GAS i32x2*)(rowp + bj * HALF) = (i32x2){pk4(v0), pk4(v1)}; } }
    }
};
struct MoeOrder {
    int nN, G, c, nunits; const PG8_LAS int* tile_pm;
    __device__ __forceinline__ bool next(int i, Unit& u) const {
        const int L = i * G + c; if (L >= nunits) return false;
        const int idx = L / nN, pl = L - idx * nN, pm = __builtin_amdgcn_readfirstlane(tile_pm[idx]), e = pm >> 6;
        u.pm = pm; u.pl = pl; u.e = e; u.pn = e * nN + pl; return true;
    }
    __device__ __forceinline__ void a_ready(const Unit&) const {}
    __device__ __forceinline__ void done(const Unit&) const {}
};
typedef int v4i32_t __attribute__((ext_vector_type(4)));
typedef int v8i32_t __attribute__((ext_vector_type(8)));
template <class Epi, class Sched, bool ALIGN_EPI = false, bool SP2 = false, bool FP8 = false>
__device__ __forceinline__ void gemm_phase(PG8_LAS unsigned char* lds, const Gemm g, const Sched& S, const Epi& E, int tid_in) {
    int tid_ = tid_in; asm volatile("" : "+v"(tid_)); const int tid = tid_, wid = __builtin_amdgcn_readfirstlane(tid >> 6), lane = tid & 63, wr = wid >> 2, wc = wid & 3, fr = lane & 15, fq = lane >> 4;
    const int K = g.K, nt = K / BK;
    unsigned voffA, voffB;
    { int R, C; stage_rc(tid * 16, R, C); const int Rb = Epi::PERM ? ((R & ~31) + perm32(R & 31)) : R;
        voffA = (unsigned)(R * K + C) * 2u; voffB = (unsigned)(Rb * K + C) * 2u; }
    const size_t rstep = (size_t)64 * K * 2;
    const size_t kstep = (size_t)(BK * 2);
    const size_t hstep = (size_t)HALF * K * 2;
    const size_t tstep = 2 * hstep;
    const unsigned ldsw = (unsigned)wid * 1024u;
    const int aoff = lds_byte(wr * 64 + fr, fq * 8), boff = lds_byte(wc * 32 + fr, fq * 8);
#define PG8_SA(b, h) (((b) * 2 + (h)) * HTB)
#define PG8_SB(b, h) ((4 + (b) * 2 + (h)) * HTB)
#define PG8_STAGE(bufoff, gbase, voff) do { _Pragma("unroll") for (int _i = 0; _i < 2; ++_i) \
        __builtin_amdgcn_global_load_lds((const unsigned*)((const char*)(gbase) + _i * rstep + (voff)), (PG8_LAS unsigned*)(lds + (bufoff) + ldsw + _i * 8192), 16, 0, 0); } while (0)
#define PG8_LDA(dst, b, h) do { _Pragma("unroll") for (int m = 0; m < 4; ++m) _Pragma("unroll") for (int k = 0; k < 2; ++k) dst[m][k] = *(const PG8_LAS bf16x8*)(lds + PG8_SA(b, h) + aoff + m * 2048 + k * 1024); } while (0)
#define PG8_LDB(dst, b, h) do { _Pragma("unroll") for (int n = 0; n < 2; ++n) _Pragma("unroll") for (int k = 0; k < 2; ++k) dst[n][k] = *(const PG8_LAS bf16x8*)(lds + PG8_SB(b, h) + boff + n * 2048 + k * 1024); } while (0)
#define PG8_MMA(ai, bj, At, Bt) do { __builtin_amdgcn_s_setprio(1); _Pragma("unroll") for (int m = 0; m < 4; ++m) _Pragma("unroll") for (int n = 0; n < 2; ++n) { \
        if constexpr (FP8) { const v8i32_t a8_ = __builtin_shufflevector(__builtin_bit_cast(v4i32_t, At[m][0]), __builtin_bit_cast(v4i32_t, At[m][1]), 0, 1, 2, 3, 4, 5, 6, 7); \
            const v8i32_t b8_ = __builtin_shufflevector(__builtin_bit_cast(v4i32_t, Bt[n][0]), __builtin_bit_cast(v4i32_t, Bt[n][1]), 0, 1, 2, 3, 4, 5, 6, 7); \
            asm volatile("v_mfma_scale_f32_16x16x128_f8f6f4 %0, %1, %2, %0, %3, %3 op_sel_hi:[0,0,0]" : "+v"(acc[ai][bj][m][n]) : "v"(b8_), "v"(a8_), "v"(one8_)); } \
        else { _Pragma("unroll") for (int k = 0; k < 2; ++k) acc[ai][bj][m][n] = __builtin_amdgcn_mfma_f32_16x16x32_bf16(Bt[n][k], At[m][k], acc[ai][bj][m][n], 0, 0, 0); } } \
        __builtin_amdgcn_s_setprio(0); } while (0)
#define PG8_WAIT_V(n) asm volatile("s_waitcnt vmcnt(" #n ")" ::: "memory")
#define PG8_WAIT_L(n) asm volatile("s_waitcnt lgkmcnt(" #n ")" ::: "memory")
#define PG8_WAIT_V8R(relax) do { if (relax) { if constexpr (Epi::NST == 8) PG8_WAIT_V(16); else if constexpr (Epi::NST == 16) PG8_WAIT_V(24); else PG8_WAIT_V(8); } else PG8_WAIT_V(8); } while (0)
#define PG8_BAR __builtin_amdgcn_s_barrier()
#define PG8_SCHED __builtin_amdgcn_sched_barrier(0)
    Unit cur, nxt; int ui = 0;
    if (!S.next(0, cur)) return;
    f32x4 acc[2][2][4][2];
#pragma unroll
    for (int a = 0; a < 2; ++a)
#pragma unroll
        for (int b = 0; b < 2; ++b)
#pragma unroll
            for (int m = 0; m < 4; ++m)
#pragma unroll
                for (int n = 0; n < 2; ++n) acc[a][b][m][n] = (f32x4){0.f, 0.f, 0.f, 0.f};
    bf16x8 At[4][2], B0[2][2], B1[2][2];
    int one8_ = 0x7f7f7f7f; asm volatile("" : "+v"(one8_));
    const char* cA = (const char*)g.A + (size_t)cur.pm * tstep; const char* cB = (const char*)g.Bt + (size_t)cur.pn * tstep;
    S.a_ready(cur);
    if constexpr (SP2) {
        PG8_STAGE(PG8_SB(0, 0), cB, voffB); PG8_STAGE(PG8_SB(0, 1), cB + hstep, voffB); PG8_STAGE(PG8_SA(0, 0), cA, voffA); PG8_STAGE(PG8_SA(0, 1), cA + hstep, voffA);
        if (wr == 1) PG8_BAR;
        PG8_WAIT_V(2); PG8_BAR;
        PG8_STAGE(PG8_SB(1, 0), cB + kstep, voffB); PG8_STAGE(PG8_SA(1, 0), cA + kstep, voffA); PG8_STAGE(PG8_SB(1, 1), cB + hstep + kstep, voffB);
        PG8_WAIT_V(6); PG8_BAR;
    } else {
        PG8_STAGE(PG8_SB(0, 0), cB, voffB); PG8_STAGE(PG8_SA(0, 0), cA, voffA); PG8_STAGE(PG8_SB(0, 1), cB + hstep, voffB); PG8_STAGE(PG8_SA(0, 1), cA + hstep, voffA);
        if (wr == 1) PG8_BAR;
        PG8_WAIT_V(4); PG8_BAR;
        PG8_STAGE(PG8_SB(1, 0), cB + kstep, voffB); PG8_STAGE(PG8_SA(1, 0), cA + kstep, voffA); PG8_STAGE(PG8_SB(1, 1), cB + hstep + kstep, voffB);
        PG8_WAIT_V(6); PG8_BAR;
    }
    for (;;) {
        const bool has_next = S.next(ui + 1, nxt);
        typename Epi::Pre pre_; { int lp_ = (int)__builtin_amdgcn_mbcnt_hi(~0u, __builtin_amdgcn_mbcnt_lo(~0u, 0u)); asm volatile("" : "+v"(lp_)); pre_ = E.prefetch(cur, wc, lp_ >> 4); }
        const char* nA = has_next ? (const char*)g.A + (size_t)nxt.pm * tstep : cA; const char* nB = has_next ? (const char*)g.Bt + (size_t)nxt.pn * tstep : cB;
#pragma unroll 1
        for (int t = 0; t < nt; t += 2) {
            const bool last = (t == nt - 2);
            const char* a1 = cA + (size_t)(t + 1) * kstep;
            const char* a2 = last ? nA : cA + (size_t)(t + 2) * kstep; const char* b2 = last ? nB : cB + (size_t)(t + 2) * kstep;
            const char* a3 = a2 + kstep; const char* b3 = b2 + kstep;
            if (last && has_next) S.a_ready(nxt);
            const bool relax = (Epi::NST > 0) && (ui > 0) && (t == 0);
            if constexpr (SP2) {
            PG8_LDB(B0, 0, 0); PG8_LDB(B1, 0, 1); PG8_SCHED; PG8_LDA(At, 0, 0); PG8_STAGE(PG8_SA(1, 1), a1 + hstep, voffA);
            PG8_WAIT_V8R(relax); PG8_WAIT_L(0); PG8_BAR; PG8_MMA(0, 0, At, B0); PG8_MMA(0, 1, At, B1); PG8_BAR; PG8_SCHED;
            PG8_LDA(At, 0, 1); PG8_STAGE(PG8_SB(0, 0), b2, voffB); PG8_STAGE(PG8_SB(0, 1), b2 + hstep, voffB); PG8_STAGE(PG8_SA(0, 0), a2, voffA);
            PG8_WAIT_V8R(relax); PG8_WAIT_L(0); PG8_BAR; PG8_MMA(1, 0, At, B0); PG8_MMA(1, 1, At, B1); PG8_BAR; PG8_SCHED;
            PG8_LDB(B0, 1, 0); PG8_LDB(B1, 1, 1); PG8_SCHED; PG8_LDA(At, 1, 0); PG8_STAGE(PG8_SA(0, 1), a2 + hstep, voffA);
            PG8_WAIT_V(8); PG8_WAIT_L(0); PG8_BAR; PG8_MMA(0, 0, At, B0); PG8_MMA(0, 1, At, B1); PG8_BAR; PG8_SCHED;
            PG8_LDA(At, 1, 1); PG8_STAGE(PG8_SB(1, 0), b3, voffB); PG8_STAGE(PG8_SB(1, 1), b3 + hstep, voffB); PG8_STAGE(PG8_SA(1, 0), a3, voffA);
            PG8_WAIT_V(8); PG8_WAIT_L(0); PG8_BAR; PG8_MMA(1, 0, At, B0); PG8_MMA(1, 1, At, B1); PG8_BAR; PG8_SCHED;
            } else {
            PG8_LDB(B0, 0, 0); PG8_SCHED; PG8_LDA(At, 0, 0); PG8_STAGE(PG8_SA(1, 1), a1 + hstep, voffA);
            PG8_WAIT_L(8); PG8_BAR; PG8_WAIT_L(0); PG8_MMA(0, 0, At, B0); PG8_BAR; PG8_SCHED;
            PG8_LDB(B1, 0, 1); PG8_STAGE(PG8_SB(0, 0), b2, voffB);
            PG8_BAR; PG8_WAIT_L(0); PG8_MMA(0, 1, At, B1); PG8_BAR;
            PG8_LDA(At, 0, 1); PG8_STAGE(PG8_SA(0, 0), a2, voffA);
            PG8_BAR; PG8_WAIT_L(0); PG8_MMA(1, 0, At, B0); PG8_BAR; PG8_SCHED;
            PG8_STAGE(PG8_SB(0, 1), b2 + hstep, voffB);
            PG8_WAIT_V(6); PG8_BAR; PG8_MMA(1, 1, At, B1); PG8_BAR;
            PG8_LDB(B0, 1, 0); PG8_SCHED; PG8_LDA(At, 1, 0); PG8_STAGE(PG8_SA(0, 1), a2 + hstep, voffA);
            PG8_WAIT_L(8); PG8_BAR; PG8_WAIT_L(0); PG8_MMA(0, 0, At, B0); PG8_BAR; PG8_SCHED;
            PG8_LDB(B1, 1, 1); PG8_STAGE(PG8_SB(1, 0), b3, voffB);
            PG8_BAR; PG8_WAIT_L(0); PG8_MMA(0, 1, At, B1); PG8_BAR;
            PG8_LDA(At, 1, 1); PG8_STAGE(PG8_SA(1, 0), a3, voffA);
            PG8_BAR; PG8_WAIT_L(0); PG8_MMA(1, 0, At, B0); PG8_BAR; PG8_SCHED;
            PG8_STAGE(PG8_SB(1, 1), b3 + hstep, voffB);
            PG8_WAIT_V(6); PG8_BAR; PG8_MMA(1, 1, At, B1); PG8_BAR;
            }
        }
        if constexpr (FP8) asm volatile("s_nop 7\n\ts_nop 7" ::: "memory");
        if constexpr (ALIGN_EPI) { if (wr == 0) PG8_BAR; }
        if constexpr (!Epi::AFTER_DRAIN) { int ln_ = (int)__builtin_amdgcn_mbcnt_hi(~0u, __builtin_amdgcn_mbcnt_lo(~0u, 0u)); asm volatile("" : "+v"(ln_)); E(acc, cur, wr, wc, ln_ & 15, ln_ >> 4, pre_); S.done(cur); }
        if (!has_next) break;
#pragma unroll
        for (int a = 0; a < 2; ++a)
#pragma unroll
            for (int b = 0; b < 2; ++b)
#pragma unroll
                for (int m = 0; m < 4; ++m)
#pragma unroll
                    for (int n = 0; n < 2; ++n) acc[a][b][m][n] = (f32x4){0.f, 0.f, 0.f, 0.f};
        cur = nxt; cA = nA; cB = nB; ++ui;
        if constexpr (ALIGN_EPI) { if (wr == 1) PG8_BAR; }
    }
    PG8_WAIT_V(0);
    if constexpr (!ALIGN_EPI) { if (wr == 0) PG8_BAR; }
    PG8_BAR;
    if constexpr (Epi::AFTER_DRAIN) { E.fused(acc, cur, wr, wc, fr, fq, lds, wid, lane); S.done(cur); }
#undef PG8_SA
#undef PG8_SB
#undef PG8_STAGE
#undef PG8_LDA
#undef PG8_LDB
#undef PG8_MMA
#undef PG8_WAIT_V
#undef PG8_WAIT_L
#undef PG8_BAR
#undef PG8_SCHED
}
}

constexpr int NWAVES = 8, NTHR = 512;
constexpr int BATCH = 2, SEQ = 8192, D = 1024, DEPTH = 4, MTOK = BATCH * SEQ;
constexpr int DIN = 3344, NPROJ = 3328, SRC_GA = 1152;
constexpr int C_GQ = 0, C_GK = 192, C_GV = 384, C_GG = 768, C_HQ = 1152, C_HF = 1408, C_HI = 1664, C_HG = 1920, C_RQ = 2176, C_RK = 2368, C_RV = 2560, C_RG = 2944;
constexpr int NE = 32, FFN = 1024;
constexpr int CH = 64, NCH = SEQ / CH, NUNIT = BATCH * NCH;
constexpr int ST_GLA = 0, ST_HG = 4 * 48 * 96, ST_RET = ST_HG + 4 * 64 * 64, ST_TOT = ST_RET + 4 * 48 * 96;
constexpr int NDV = 448, NKT = 640;
constexpr int MAXROWS = 65536 + NE * 256, MAXRT = MAXROWS / 256;
constexpr float EPS = 1e-6f;
#ifndef F8_IN_V
#define F8_IN_V false
#endif
#ifndef F8_OUT_V
#define F8_OUT_V false
#endif
constexpr bool F8_IN = F8_IN_V, F8_OUT = F8_OUT_V;
#ifndef Y8_V
#define Y8_V true
#endif
constexpr bool Y8 = Y8_V;
constexpr float S8_Y = 16.f;
constexpr float S8_M = 32.f;
constexpr float S8_W = 2048.f, S8_H = 64.f, S8_A = 8.f;
constexpr int NPHASE = 38;
constexpr int ECAP = 16384, ECAP_SH = 14;

constexpr size_t MiB = 1u << 20;
constexpr size_t WS_CTL = 0, CTL_ZERO_BYTES = 65536;
constexpr size_t WS_MOD = 1 * MiB;
constexpr size_t WS_ROPE = 2 * MiB;
constexpr size_t WS_LB = 5 * MiB;
constexpr size_t WS_WIN = 8 * MiB;
constexpr size_t WS_WOUT = 34 * MiB;
constexpr size_t WS_WGU = 42 * MiB;
constexpr size_t WS_WDN = 554 * MiB;
constexpr size_t WS_X = 810 * MiB;
constexpr size_t WS_H = 874 * MiB;
constexpr size_t WS_GA = 906 * MiB;
constexpr size_t WS_PROJ = 907 * MiB;
constexpr size_t WS_U = 1011 * MiB;
constexpr size_t WS_DVEC = 1063 * MiB;
constexpr size_t WS_SP = 1064 * MiB;
constexpr size_t WS_MIX = 1090 * MiB;
constexpr size_t WS_TOPE = 1122 * MiB;
constexpr size_t WS_TOPW = WS_TOPE + 256 * 1024;
constexpr size_t WS_SLOT = WS_TOPW + 256 * 1024;
constexpr size_t WS_A1 = 1123 * MiB;
constexpr size_t WS_ACT = 1635 * MiB;
constexpr size_t WS_Y = 2147 * MiB;
constexpr size_t WS_CUM = 3171 * MiB;
constexpr size_t WS_KT = 3199 * MiB;
constexpr size_t WS_END = 3239 * MiB;
static_assert(WS_WIN + (size_t)DEPTH * NPROJ * D * 2 <= WS_WOUT && WS_PROJ + (size_t)MTOK * NPROJ * 2 <= WS_U && WS_U + (size_t)NUNIT * ST_TOT * 4 <= WS_DVEC && WS_SP + (size_t)NUNIT * ST_TOT * 2 <= WS_MIX && WS_A1 + (size_t)NE * ECAP * D <= WS_ACT && WS_ACT + (size_t)NE * ECAP * D <= WS_Y && WS_Y + (size_t)NE * ECAP * D * 2 <= WS_CUM, "ws map");
constexpr int CW_TMO = 0, CW_CODE = 1, CW_BAR = 4096, CW_CNT = 8192, CW_FILL = 8192 + 256;
constexpr int RING_BYTES = 131072;
constexpr int MISC_OFF = 147456, LDS_BYTES = MISC_OFF + 4096;
constexpr int MW_BAR = 0, MW_CNT = 16, MW_PST = 48, MW_HIST = 96, MW_BASE = 128, MW_TILE = 192, MW_NRT = 480, MW_SLOTS = 512;

#define GAS __attribute__((address_space(1)))
#define LAS __attribute__((address_space(3)))
typedef unsigned v4u __attribute__((ext_vector_type(4)));
typedef float f32x4 __attribute__((ext_vector_type(4)));
typedef short bf16x8 __attribute__((ext_vector_type(8)));
typedef GAS unsigned gu32;
typedef GAS unsigned long long gu64;
#define RLX_AGENT __ATOMIC_RELAXED, __HIP_MEMORY_SCOPE_AGENT
#define LDS_WAIT() asm volatile("s_waitcnt lgkmcnt(0)" ::: "memory")
#define VM_WAIT() asm volatile("s_waitcnt vmcnt(0)" ::: "memory")
__device__ __forceinline__ unsigned long long rt() { return __builtin_amdgcn_s_memrealtime(); }
typedef unsigned short bf16;
typedef float f32x2_t __attribute__((ext_vector_type(2))); typedef __bf16 bf16x2_t __attribute__((ext_vector_type(2)));
__device__ __forceinline__ unsigned pk2(float lo, float hi) { const f32x2_t v = {lo, hi}; return __builtin_bit_cast(unsigned, __builtin_convertvector(v, bf16x2_t)); }
__device__ __forceinline__ unsigned f2bf(float f) { return pk2(f, 0.f) & 0xffffu; }
__device__ __forceinline__ float bf2f(bf16 b) { return __builtin_bit_cast(float, (unsigned)b << 16); }
#define XB_TMO      128
#define XB_XCNT(j)  (256  + 64 * (j))
#define XB_XSUB(j)  (1280 + 64 * (j))
#define XB_XGEN(j)  (2304 + 64 * (j))
#define XB_TOP      3328
#define XB_TOPGEN   3392
#define XCD_BAR_WORDS 3456
#define XB_SPIN_CAP (1u << 18)

__device__ __forceinline__ unsigned xb_ld(unsigned* p)              { return __hip_atomic_load(p, __ATOMIC_RELAXED, __HIP_MEMORY_SCOPE_AGENT); }
__device__ __forceinline__ unsigned xb_add(unsigned* p, unsigned v) { return __hip_atomic_fetch_add(p, v, __ATOMIC_RELAXED, __HIP_MEMORY_SCOPE_AGENT); }
__device__ __forceinline__ unsigned xb_xcc_id() { return (unsigned)__builtin_amdgcn_s_getreg((3 << 11) | 20) & 0xFu; }
#define XB_SPIN(cond, bar) do { unsigned _sp = 0; while (cond) { __builtin_amdgcn_s_sleep(1); \
    if ((++_sp & 255u) == 0u) { if (xb_ld(&(bar)[XB_TMO])) break; if (_sp > XB_SPIN_CAP) { atomicAdd(&(bar)[XB_TMO], 1u); break; } } } } while (0)

struct XcdBarrier {
    unsigned* bar; unsigned x;
    volatile LAS unsigned* st;
};

__device__ __forceinline__ XcdBarrier xcd_barrier_post(unsigned* bar, volatile LAS unsigned* st) {
    XcdBarrier b; b.bar = bar; b.x = xb_xcc_id(); b.st = st;
    if (threadIdx.x == 0) (void)xb_add(&bar[XB_XCNT(b.x)], 1u);
    return b;
}
__device__ __forceinline__ void xcd_barrier_complete(unsigned* bar, unsigned x, unsigned& nloc, unsigned& nx) {
    const unsigned G = gridDim.x * gridDim.y * gridDim.z;
    unsigned sum, cnt, mine, sp = 0u;
    for (;;) {
        sum = 0u; cnt = 0u; mine = 0u;
#pragma unroll
        for (unsigned j = 0; j < 16; ++j) { const unsigned c = xb_ld(&bar[XB_XCNT(j)]); sum += c; cnt += (c > 0u) ? 1u : 0u; mine = (j == x) ? c : mine; }
        if (sum == G) break;
        __builtin_amdgcn_s_sleep(1);
        if ((++sp & 255u) == 0u) { if (xb_ld(&bar[XB_TMO])) break; if (sp > XB_SPIN_CAP) { atomicAdd(&bar[XB_TMO], 1u); break; } }
    }
    nloc = mine > 0u ? mine : 1u; nx = cnt > 0u ? cnt : 1u;
}

__device__ __forceinline__ void xcd_barrier(const XcdBarrier& b) {
    asm volatile("s_waitcnt vmcnt(0)" ::: "memory");
    __syncthreads();
    if (threadIdx.x == 0) {
        unsigned* bar = b.bar;
        __builtin_amdgcn_s_waitcnt(0);
        unsigned nloc = b.st[0], nx = b.st[1];
        if (nloc == 0u) { xcd_barrier_complete(bar, b.x, nloc, nx); b.st[0] = nloc; b.st[1] = nx; }
        const unsigned old = xb_add(&bar[XB_XSUB(b.x)], 1u);
        const unsigned gen = old / nloc;
        if (old + 1u == (gen + 1u) * nloc) {
            __builtin_amdgcn_fence(__ATOMIC_RELEASE, "agent");
            asm volatile("s_waitcnt vmcnt(0)" ::: "memory");
            const unsigned og = xb_add(&bar[XB_TOP], 1u);
            const unsigned tg = og / nx;
            if (og + 1u == (tg + 1u) * nx) xb_add(&bar[XB_TOPGEN], 1u);
            else XB_SPIN(xb_ld(&bar[XB_TOPGEN]) == tg, bar);
            __builtin_amdgcn_fence(__ATOMIC_ACQUIRE, "agent");
            xb_add(&bar[XB_XGEN(b.x)], 1u);
            asm volatile("s_waitcnt vmcnt(0)" ::: "memory");
        } else {
            XB_SPIN(xb_ld(&bar[XB_XGEN(b.x)]) == gen, bar);
            __builtin_amdgcn_fence(__ATOMIC_ACQUIRE, "agent");
            asm volatile("s_waitcnt vmcnt(0)" ::: "memory");
        }
    }
    __syncthreads();
}

__device__ __forceinline__ float wave_sum(float v) {
#pragma unroll
    for (int o = 1; o < 64; o <<= 1) v += __shfl_xor(v, o);
    return v;
}
__device__ __forceinline__ float log_sigmoid_f(float x) { return fminf(x, 0.f) - log1pf(expf(-fabsf(x))); }
__device__ __forceinline__ float silu_f(float x) { return x / (1.0f + expf(-x)); }
__device__ __forceinline__ float sigmoid_f(float x) { return 1.0f / (1.0f + expf(-x)); }
__device__ __forceinline__ pg8::bf16x8 ldfrag(const LAS bf16* base, int stride, int r0, int k0, int lane) {
    return *(const LAS pg8::bf16x8*)(base + (r0 + (lane & 15)) * stride + k0 + 8 * (lane >> 4));
}
__device__ __forceinline__ pg8::bf16x8 pack8(const float (&v)[8]) { v4u w; w.x = pk2(v[0], v[1]); w.y = pk2(v[2], v[3]); w.z = pk2(v[4], v[5]); w.w = pk2(v[6], v[7]); return __builtin_bit_cast(pg8::bf16x8, w); }

struct Args {
    const float* x; const float* c; const int* pos; const float* w_mod; const float* b_mod; const float* norm1_w; const float* w_in; const float* gla_wa2; const float* gla_ba2; const float* hg_lb;
    const float* gla_norm_w; const float* hg_norm_w; const float* w_out; const float* norm2_w; const float* w_r; const float* b_r; const float* w_gu; const float* b_gu; const float* w_dn; const float* b_dn;
    const float* final_norm_w; float* out; unsigned char* ws; int ph_lo, ph_hi;
};

__device__ __forceinline__ void transpose_block64(const float* src, int ld, bf16* dst, LAS float*, int lane) {
    const int n4 = lane & 15, kg = lane >> 4;
    f32x4 v[16];
#pragma unroll
    for (int i = 0; i < 16; ++i) v[i] = __builtin_nontemporal_load((const f32x4*)(src + (size_t)(16 * kg + i) * ld + 4 * n4));
#pragma unroll
    for (int j = 0; j < 4; ++j) { v4u o0, o1;
        o0.x = pk2(v[0][j], v[1][j]); o0.y = pk2(v[2][j], v[3][j]); o0.z = pk2(v[4][j], v[5][j]); o0.w = pk2(v[6][j], v[7][j]);
        o1.x = pk2(v[8][j], v[9][j]); o1.y = pk2(v[10][j], v[11][j]); o1.z = pk2(v[12][j], v[13][j]); o1.w = pk2(v[14][j], v[15][j]);
        bf16* d = dst + (size_t)(4 * n4 + j) * D + 16 * kg; *(GAS v4u*)d = o0; *(GAS v4u*)(d + 8) = o1; }
}
__device__ __forceinline__ float clamp448(float x) { return __builtin_amdgcn_fmed3f(x, -448.f, 448.f); }
__device__ __forceinline__ int pk4_fp8(float a, float b, float c, float d) { int w = 0; w = __builtin_amdgcn_cvt_pk_fp8_f32(clamp448(a), clamp448(b), w, false);
    return __builtin_amdgcn_cvt_pk_fp8_f32(clamp448(c), clamp448(d), w, true); }
__device__ __forceinline__ void transpose_block64_fp8(const float* src, int ld, unsigned char* dst, LAS float*, int lane, float sc) {
    const int n4 = lane & 15, kg = lane >> 4;
    f32x4 v[16];
#pragma unroll
    for (int i = 0; i < 16; ++i) v[i] = __builtin_nontemporal_load((const f32x4*)(src + (size_t)(16 * kg + i) * ld + 4 * n4)) * sc;
#pragma unroll
    for (int j = 0; j < 4; ++j) { v4u o;
        o.x = (unsigned)pk4_fp8(v[0][j], v[1][j], v[2][j], v[3][j]); o.y = (unsigned)pk4_fp8(v[4][j], v[5][j], v[6][j], v[7][j]);
        o.z = (unsigned)pk4_fp8(v[8][j], v[9][j], v[10][j], v[11][j]); o.w = (unsigned)pk4_fp8(v[12][j], v[13][j], v[14][j], v[15][j]);
        *(GAS v4u*)(dst + (size_t)(4 * n4 + j) * D + 16 * kg) = o; }
}
constexpr int IT_IN = 16 * (NPROJ / 64), IT_OUT = 16 * 16, IT_GU = NE * 16 * 32, IT_DN = NE * 16 * 16, IT_LAYER = IT_IN + IT_OUT + IT_GU + IT_DN, IT_ALL = DEPTH * IT_LAYER;
__device__ __forceinline__ void convert_item(const Args& a, int l, int r, LAS float* scr, int lane) {
    unsigned char* ws = a.ws;
    bf16* WIN = (bf16*)(ws + WS_WIN); bf16* WOUT = (bf16*)(ws + WS_WOUT); unsigned char* WGU = ws + WS_WGU; unsigned char* WDN = ws + WS_WDN;
    if (r < IT_IN) { const int kb = r / (NPROJ / 64), nb = r % (NPROJ / 64), n0 = 64 * nb, sc = n0 + (n0 >= SRC_GA ? 16 : 0);
        if (F8_IN) transpose_block64_fp8(a.w_in + ((size_t)l * D + 64 * kb) * DIN + sc, DIN, (unsigned char*)WIN + ((size_t)l * NPROJ + n0) * D + 64 * kb, scr, lane, S8_W);
        else transpose_block64(a.w_in + ((size_t)l * D + 64 * kb) * DIN + sc, DIN, WIN + ((size_t)l * NPROJ + n0) * D + 64 * kb, scr, lane); return; }
    r -= IT_IN;
    if (r < IT_OUT) { const int kb = r / 16, nb = r % 16;
        if (F8_OUT) transpose_block64_fp8(a.w_out + ((size_t)l * D + 64 * kb) * D + 64 * nb, D, (unsigned char*)WOUT + ((size_t)l * D + 64 * nb) * D + 64 * kb, scr, lane, S8_W);
        else transpose_block64(a.w_out + ((size_t)l * D + 64 * kb) * D + 64 * nb, D, WOUT + ((size_t)l * D + 64 * nb) * D + 64 * kb, scr, lane); return; }
    r -= IT_OUT;
    if (r < IT_GU) { const int e = r / 512, r2 = r % 512, kb = r2 / 32, nb = r2 % 32, cc = 64 * nb;
        const int row = (cc < 1024) ? 256 * (cc / 128) + (cc % 128) : 256 * ((cc - 1024) / 128) + 128 + ((cc - 1024) % 128);
        transpose_block64_fp8(a.w_gu + (((size_t)l * NE + e) * D + 64 * kb) * 2048 + cc, 2048, WGU + (((size_t)l * NE + e) * 2048 + row) * D + 64 * kb, scr, lane, S8_W); return; }
    r -= IT_GU;
    { const int e = r / 256, r2 = r % 256, kb = r2 / 16, nb = r2 % 16;
        transpose_block64_fp8(a.w_dn + (((size_t)l * NE + e) * FFN + 64 * kb) * D + 64 * nb, D, WDN + (((size_t)l * NE + e) * D + 64 * nb) * D + 64 * kb, scr, lane, S8_W); }
}
constexpr int CB2 = 4, CB7 = 2, CB8 = 2;
__device__ __forceinline__ int conv_t2(int G) { return (G == 256) ? 192 * NWAVES * CB2 : 0; }
__device__ __forceinline__ int conv_idle(int nunits, int G) { const int rem = nunits % G; return rem ? G - rem : 0; }
__device__ __forceinline__ void convert_range(const Args& a, int l, int first, int count, LAS unsigned char* lds, int lane, int wave) {
    LAS float* scr = (LAS float*)(lds + wave * 16640);
    for (int k = 0; k < count; ++k) { const int it = first + k; if (it < IT_LAYER) convert_item(a, l, it, scr, lane); }
}
__device__ __forceinline__ void p0_prologue(const Args& a, LAS unsigned char* lds, int vcu, int G, int tid, int lane, int wave) {
    unsigned char* ws = a.ws;
    LAS float* scr = (LAS float*)(lds + wave * 16640);
    const int gw = vcu * NWAVES + wave, NGW = G * NWAVES;
    for (int it = gw; it < IT_LAYER; it += NGW) convert_item(a, 0, it, scr, lane);
    __syncthreads();
    {
        LAS float* cact = (LAS float*)lds;
        LAS float* red = (LAS float*)(lds + 8192);
        for (int i = tid; i < 2 * D; i += NTHR) cact[i] = silu_f(a.c[i]);
        __syncthreads();
        float* MOD = (float*)(ws + WS_MOD);
        for (int it = vcu; it < DEPTH * 96; it += G) {
            const int l = it / 96, n0 = (it % 96) * 64;
            const float* wp = a.w_mod + ((size_t)l * D + 128 * wave) * 6144 + n0 + lane;
            float a0 = 0.f, a1 = 0.f;
#pragma unroll 32
            for (int k = 0; k < 128; ++k) { const float w = __builtin_nontemporal_load(wp + (size_t)k * 6144); a0 += cact[128 * wave + k] * w; a1 += cact[D + 128 * wave + k] * w; }
            red[(wave * 2 + 0) * 64 + lane] = a0; red[(wave * 2 + 1) * 64 + lane] = a1;
            __syncthreads();
            if (tid < 128) { const int b = tid >> 6, ln = tid & 63; float s = a.b_mod[l * 6144 + n0 + ln];
#pragma unroll
                for (int w = 0; w < 8; ++w) s += red[(w * 2 + b) * 64 + ln];
                MOD[((size_t)l * 2 + b) * 6144 + n0 + ln] = s; }
            __syncthreads();
        }
    }
    { const f32x4* xs = (const f32x4*)a.x; uint2* xd = (uint2*)(ws + WS_X);
        for (int i = vcu * NTHR + tid; i < MTOK * D / 4; i += G * NTHR) { const f32x4 v = xs[i]; uint2 p; p.x = pk2(v[0], v[1]); p.y = pk2(v[2], v[3]); xd[i] = p; } }
    {
        float* ROPE = (float*)(ws + WS_ROPE);
        for (int i = vcu * NTHR + tid; i < MTOK * 24; i += G * NTHR) { const int t = i / 24, f = i % 24;
            const float inv = (float)pow(10000.0, -(double)f / 24.0); const float ang = (float)a.pos[t] * inv;
            ROPE[(size_t)t * 48 + f] = cosf(ang); ROPE[(size_t)t * 48 + 24 + f] = sinf(ang); }
    }
    if (vcu == 0 && tid < 256) {
        float v[4], mx = -3.0e38f; for (int l = 0; l < 4; ++l) { v[l] = a.hg_lb[l * 256 + tid]; mx = fmaxf(mx, v[l]); }
        float s = 0.f; for (int l = 0; l < 4; ++l) { v[l] = expf(v[l] - mx); s += v[l]; }
        float* LB = (float*)(ws + WS_LB); float cs = 0.f, first = 0.f;
        for (int l = 0; l < 4; ++l) { cs += v[l] / s; if (l == 0) first = cs; LB[l * 256 + tid] = cs - first; }
    }
}

__device__ __forceinline__ void moe_combine_row(f32x4 (&v)[4], int m, const bf16* Y, const int* SLOT, const float* TOPW, const float* g2, int lane) {
    const int4 sl = *(const int4*)(SLOT + (size_t)m * 4); const f32x4 tw = *(const f32x4*)(TOPW + (size_t)m * 4);
    const int s[4] = {sl.x, sl.y, sl.z, sl.w};
    f32x4 acc[4];
#pragma unroll
    for (int j = 0; j < 4; ++j) acc[j] = (f32x4){0.f, 0.f, 0.f, 0.f};
#pragma unroll
    for (int k = 0; k < 4; ++k) { const bf16* yr = Y + (size_t)s[k] * D + 4 * lane; const float w = tw[k];
#pragma unroll
        for (int j = 0; j < 4; ++j) { const uint2 p = *(const uint2*)(yr + 256 * j);
            acc[j][0] += w * __builtin_bit_cast(float, p.x << 16); acc[j][1] += w * __builtin_bit_cast(float, p.x & 0xffff0000u);
            acc[j][2] += w * __builtin_bit_cast(float, p.y << 16); acc[j][3] += w * __builtin_bit_cast(float, p.y & 0xffff0000u); } }
#pragma unroll
    for (int j = 0; j < 4; ++j) { const f32x4 g = *(const f32x4*)(g2 + 4 * lane + 256 * j); v[j] = v[j] + g * acc[j]; }
}
__device__ __forceinline__ float row_rstd(const f32x4 (&v)[4]) {
    float s = 0.f;
#pragma unroll
    for (int j = 0; j < 4; ++j) s += (v[j][0] * v[j][0] + v[j][1] * v[j][1]) + (v[j][2] * v[j][2] + v[j][3] * v[j][3]);
    return 1.0f / sqrtf(wave_sum(s) * (1.0f / D) + EPS);
}
__device__ __forceinline__ void modulate_row(f32x4 (&v)[4], float rstd, const float* nw, const float* sc, const float* sh, bf16* hrow, int lane) {
#pragma unroll
    for (int j = 0; j < 4; ++j) { const int c0 = 4 * lane + 256 * j; const f32x4 w = *(const f32x4*)(nw + c0), s1 = *(const f32x4*)(sc + c0), s0 = *(const f32x4*)(sh + c0);
        v[j] = v[j] * rstd * w * (s1 + 1.0f) + s0;
        uint2 p; p.x = pk2(v[j][0], v[j][1]); p.y = pk2(v[j][2], v[j][3]); *(uint2*)(hrow + c0) = p; }
}


constexpr int LR_SLT = 142976, LR_TWL = 144000, LR_SSR = 145024;
__device__ __forceinline__ void stage_slots(const unsigned char* ws, int row0, LAS unsigned char* lds, int tid) {
    if (tid < 64) { *(LAS v4u*)(lds + LR_SLT + 16 * tid) = *(const v4u*)((const int*)(ws + WS_SLOT) + (size_t)(row0 + tid) * 4);
                    *(LAS f32x4*)(lds + LR_TWL + 16 * tid) = *(const f32x4*)((const float*)(ws + WS_TOPW) + (size_t)(row0 + tid) * 4); }
}
template <bool SS, bool OUTF32>
__device__ __forceinline__ void flat_combine(const bf16* xsrc, void* xdst, int row0, const bf16* Y, const float* g2, LAS unsigned char* lds, int tid, int lane) {
    static_assert(Y8, "expert outputs are stored as fp8");
    typedef float f32x2v __attribute__((ext_vector_type(2)));
    const int c16 = tid & 63, rsub = tid >> 6; const unsigned char* Yb = (const unsigned char*)Y;
    f32x4 g[4];
#pragma unroll
    for (int q = 0; q < 4; ++q) g[q] = *(const f32x4*)(g2 + 16 * c16 + 4 * q);
#pragma unroll 2
    for (int it = 0; it < 8; ++it) { const int i = 8 * it + rsub; const size_t m = (size_t)(row0 + i);
        const v4u x0 = *(const v4u*)(xsrc + m * D + 16 * c16), x1 = *(const v4u*)(xsrc + m * D + 16 * c16 + 8);
        const v4u sl = *(const LAS v4u*)(lds + LR_SLT + 16 * i); const f32x4 tws = *(const LAS f32x4*)(lds + LR_TWL + 16 * i) * (1.0f / S8_Y);
        const v4u y0 = *(const v4u*)(Yb + (size_t)sl.x * D + 16 * c16), y1 = *(const v4u*)(Yb + (size_t)sl.y * D + 16 * c16), y2 = *(const v4u*)(Yb + (size_t)sl.z * D + 16 * c16), y3 = *(const v4u*)(Yb + (size_t)sl.w * D + 16 * c16);
        const unsigned xw[8] = {x0.x, x0.y, x0.z, x0.w, x1.x, x1.y, x1.z, x1.w}, w0[4] = {y0.x, y0.y, y0.z, y0.w}, w1[4] = {y1.x, y1.y, y1.z, y1.w}, w2[4] = {y2.x, y2.y, y2.z, y2.w}, w3[4] = {y3.x, y3.y, y3.z, y3.w};
        float v[16]; float sq = 0.f;
#pragma unroll
        for (int q = 0; q < 4; ++q) {
            const f32x2v a0 = __builtin_amdgcn_cvt_pk_f32_fp8((int)w0[q], false), b0 = __builtin_amdgcn_cvt_pk_f32_fp8((int)w0[q], true), a1 = __builtin_amdgcn_cvt_pk_f32_fp8((int)w1[q], false), b1 = __builtin_amdgcn_cvt_pk_f32_fp8((int)w1[q], true);
            const f32x2v a2 = __builtin_amdgcn_cvt_pk_f32_fp8((int)w2[q], false), b2 = __builtin_amdgcn_cvt_pk_f32_fp8((int)w2[q], true), a3 = __builtin_amdgcn_cvt_pk_f32_fp8((int)w3[q], false), b3 = __builtin_amdgcn_cvt_pk_f32_fp8((int)w3[q], true);
            const float e0 = tws[0] * a0[0] + tws[1] * a1[0] + tws[2] * a2[0] + tws[3] * a3[0], e1 = tws[0] * a0[1] + tws[1] * a1[1] + tws[2] * a2[1] + tws[3] * a3[1];
            const float e2 = tws[0] * b0[0] + tws[1] * b1[0] + tws[2] * b2[0] + tws[3] * b3[0], e3 = tws[0] * b0[1] + tws[1] * b1[1] + tws[2] * b2[1] + tws[3] * b3[1];
            v[4 * q + 0] = __builtin_bit_cast(float, xw[2 * q] << 16) + g[q][0] * e0; v[4 * q + 1] = __builtin_bit_cast(float, xw[2 * q] & 0xffff0000u) + g[q][1] * e1;
            v[4 * q + 2] = __builtin_bit_cast(float, xw[2 * q + 1] << 16) + g[q][2] * e2; v[4 * q + 3] = __builtin_bit_cast(float, xw[2 * q + 1] & 0xffff0000u) + g[q][3] * e3;
            sq += (v[4 * q] * v[4 * q] + v[4 * q + 1] * v[4 * q + 1]) + (v[4 * q + 2] * v[4 * q + 2] + v[4 * q + 3] * v[4 * q + 3]); }
        if (OUTF32) {
#pragma unroll
            for (int q = 0; q < 4; ++q) *(GAS f32x4*)((float*)xdst + m * D + 16 * c16 + 4 * q) = (f32x4){v[4 * q], v[4 * q + 1], v[4 * q + 2], v[4 * q + 3]}; }
        else { v4u o0, o1; o0.x = pk2(v[0], v[1]); o0.y = pk2(v[2], v[3]); o0.z = pk2(v[4], v[5]); o0.w = pk2(v[6], v[7]); o1.x = pk2(v[8], v[9]); o1.y = pk2(v[10], v[11]); o1.z = pk2(v[12], v[13]); o1.w = pk2(v[14], v[15]);
            *(GAS v4u*)((bf16*)xdst + m * D + 16 * c16) = o0; *(GAS v4u*)((bf16*)xdst + m * D + 16 * c16 + 8) = o1; }
        if (SS) { const float sqs = wave_sum(sq); if (lane == 0) __hip_atomic_fetch_add((LAS float*)(lds + LR_SSR) + i, sqs, __ATOMIC_RELAXED, __HIP_MEMORY_SCOPE_WORKGROUP); } }
}
template <bool F8, bool SLOTS>
__device__ __forceinline__ void flat_modulate(const bf16* xin, int row0, const LAS float* rstds, const float* nw, const float* scp, const float* shp, bf16* H, unsigned char* A1, LAS unsigned char* lds, int tid) {
    const int c16 = tid & 63, rsub = tid >> 6; f32x4 ws1[4], s0[4];
#pragma unroll
    for (int q = 0; q < 4; ++q) { const int c0 = 16 * c16 + 4 * q; ws1[q] = *(const f32x4*)(nw + c0) * (*(const f32x4*)(scp + c0) + 1.0f); s0[q] = *(const f32x4*)(shp + c0); }
#pragma unroll 2
    for (int it = 0; it < 8; ++it) { const int i = 8 * it + rsub; const size_t m = (size_t)(row0 + i); const float rs = rstds[i];
        const v4u x0 = *(const v4u*)(xin + m * D + 16 * c16), x1 = *(const v4u*)(xin + m * D + 16 * c16 + 8); const unsigned xw[8] = {x0.x, x0.y, x0.z, x0.w, x1.x, x1.y, x1.z, x1.w};
        f32x4 v[4];
#pragma unroll
        for (int q = 0; q < 4; ++q) v[q] = (f32x4){__builtin_bit_cast(float, xw[2 * q] << 16), __builtin_bit_cast(float, xw[2 * q] & 0xffff0000u), __builtin_bit_cast(float, xw[2 * q + 1] << 16), __builtin_bit_cast(float, xw[2 * q + 1] & 0xffff0000u)} * rs * ws1[q] + s0[q];
        if (F8) { v4u o; o.x = (unsigned)pk4_fp8(v[0][0] * S8_H, v[0][1] * S8_H, v[0][2] * S8_H, v[0][3] * S8_H); o.y = (unsigned)pk4_fp8(v[1][0] * S8_H, v[1][1] * S8_H, v[1][2] * S8_H, v[1][3] * S8_H);
            o.z = (unsigned)pk4_fp8(v[2][0] * S8_H, v[2][1] * S8_H, v[2][2] * S8_H, v[2][3] * S8_H); o.w = (unsigned)pk4_fp8(v[3][0] * S8_H, v[3][1] * S8_H, v[3][2] * S8_H, v[3][3] * S8_H);
            if (SLOTS) { const v4u sl = *(const LAS v4u*)(lds + LR_SLT + 16 * i);
                *(GAS v4u*)(A1 + (size_t)sl.x * D + 16 * c16) = o; *(GAS v4u*)(A1 + (size_t)sl.y * D + 16 * c16) = o; *(GAS v4u*)(A1 + (size_t)sl.z * D + 16 * c16) = o; *(GAS v4u*)(A1 + (size_t)sl.w * D + 16 * c16) = o; }
            else *(GAS v4u*)((unsigned char*)H + m * D + 16 * c16) = o; }
        else { v4u o0, o1; o0.x = pk2(v[0][0], v[0][1]); o0.y = pk2(v[0][2], v[0][3]); o0.z = pk2(v[1][0], v[1][1]); o0.w = pk2(v[1][2], v[1][3]); o1.x = pk2(v[2][0], v[2][1]); o1.y = pk2(v[2][2], v[2][3]); o1.z = pk2(v[3][0], v[3][1]); o1.w = pk2(v[3][2], v[3][3]);
            *(GAS v4u*)(H + m * D + 16 * c16) = o0; *(GAS v4u*)(H + m * D + 16 * c16 + 8) = o1; } }
}

constexpr int WP = 1032;
constexpr int LR_WHI = 0, LR_PART = 132096, LR_SSX = 140288, LR_RSTD = 140544, LR_BIAS = 140800, LR_RED = 140928;
template <int NEO>
__device__ __forceinline__ void rows_mfma(const Args& a, int layer, LAS unsigned char* lds, volatile LAS unsigned* MISC, gu32* ctl, int vcu, int G, int tid, int lane, int wave) {
    constexpr bool P5 = (NEO == 32); constexpr int NET = NEO / 16;
    unsigned char* ws = a.ws; bf16* X = (bf16*)(ws + WS_X); bf16* H = (bf16*)(ws + WS_H); const float* MOD = (const float*)(ws + WS_MOD);
    LAS bf16* Whi = (LAS bf16*)(lds + LR_WHI); LAS bf16* Wlo = Whi + NEO * WP; LAS float* part = (LAS float*)(lds + LR_PART); LAS float* ssx = (LAS float*)(lds + LR_SSX);
    LAS float* rstds = (LAS float*)(lds + LR_RSTD); LAS float* biasl = (LAS float*)(lds + LR_BIAS); LAS float* red = (LAS float*)(lds + LR_RED);
    const float* nw = (P5 ? a.norm2_w : a.norm1_w) + layer * D;
    const float* Wsrc = P5 ? a.w_r + (size_t)layer * D * NE : a.w_in + (size_t)layer * D * DIN + SRC_GA; const int wld = P5 ? NE : DIN;
    if (P5) { if (tid < NE) MISC[MW_HIST + tid] = 0u; }
    for (int row0 = vcu * 64; row0 < MTOK; row0 += G * 64) {
        const int b = row0 / SEQ; const float* mp = MOD + ((size_t)layer * 2 + b) * 6144; const float* scp = mp + (P5 ? 4 : 1) * D; const float* shp = mp + (P5 ? 3 : 0) * D;
        if (!P5 && layer > 0) { stage_slots(ws, row0, lds, tid); __syncthreads(); }
        { constexpr int E4 = NEO / 4, NITT = (D * E4) / NTHR, NIT = 8;
#pragma unroll 1
          for (int ib0 = 0; ib0 < NITT; ib0 += NIT) {
            f32x4 wv[NIT];
#pragma unroll
            for (int it = 0; it < NIT; ++it) { const int idx = tid + NTHR * (ib0 + it), k = idx / E4, e4 = idx - k * E4; wv[it] = *(const f32x4*)(Wsrc + (size_t)k * wld + 4 * e4) * (nw[k] * (1.0f + scp[k])); }
#pragma unroll
            for (int it = 0; it < NIT; ++it) { const int idx = tid + NTHR * (ib0 + it), k = idx / E4, e4 = idx - k * E4;
#pragma unroll
                for (int j = 0; j < 4; ++j) { const float w = wv[it][j]; const unsigned hi = f2bf(w); const float wl = w - __builtin_bit_cast(float, hi << 16); Whi[(4 * e4 + j) * WP + k] = (bf16)hi; Wlo[(4 * e4 + j) * WP + k] = (bf16)f2bf(wl); } } } }
        { const int e = tid % NEO, kq = tid / NEO; constexpr int NPT = NTHR / NEO;
            constexpr int KP = D / NPT; float sacc = 0.f;
#pragma unroll 8
            for (int k = kq * KP; k < kq * KP + KP; ++k) sacc += shp[k] * Wsrc[(size_t)k * wld + e];
            red[kq * NEO + e] = sacc; }
        const bf16* xin = X;
        if (!P5 && layer > 0) { flat_combine<false, false>(X, X, row0, (const bf16*)(ws + WS_Y), MOD + ((size_t)(layer - 1) * 2 + b) * 6144 + 5 * D, lds, tid, lane); asm volatile("s_waitcnt vmcnt(0)" ::: "memory"); }
        __syncthreads();
        if (tid < NEO) { constexpr int NPT = NTHR / NEO; float sacc = P5 ? a.b_r[layer * NE + tid] : 0.f; for (int q = 0; q < NPT; ++q) sacc += red[q * NEO + tid]; biasl[tid] = sacc; }
        const int rg = wave >> 1, kh = wave & 1, r = lane & 15, g = lane >> 4;
        { const bf16* xr = xin + (size_t)(row0 + 16 * rg + r) * D; f32x4 acc[NET]; float ss = 0.f;
#pragma unroll
            for (int et = 0; et < NET; ++et) acc[et] = (f32x4){0.f, 0.f, 0.f, 0.f};
#pragma unroll 4
            for (int s = 16 * kh; s < 16 * kh + 16; ++s) { const int k0 = 32 * s + 8 * g; const v4u xp = *(const v4u*)(xr + k0); const unsigned xw[4] = {xp.x, xp.y, xp.z, xp.w};
#pragma unroll
                for (int j = 0; j < 4; ++j) { const float xa = __builtin_bit_cast(float, xw[j] << 16), xb = __builtin_bit_cast(float, xw[j] & 0xffff0000u); ss += xa * xa + xb * xb; }
                const pg8::bf16x8 ahi = __builtin_bit_cast(pg8::bf16x8, xp);
#pragma unroll
                for (int et = 0; et < NET; ++et) { const pg8::bf16x8 whi = ldfrag(Whi, WP, 16 * et, 32 * s, lane), wlo = ldfrag(Wlo, WP, 16 * et, 32 * s, lane);
                    acc[et] = __builtin_amdgcn_mfma_f32_16x16x32_bf16(ahi, whi, acc[et], 0, 0, 0); acc[et] = __builtin_amdgcn_mfma_f32_16x16x32_bf16(ahi, wlo, acc[et], 0, 0, 0); } }
            ss += __shfl_xor(ss, 16); ss += __shfl_xor(ss, 32);
            if (kh == 1) {
#pragma unroll
                for (int et = 0; et < NET; ++et)
#pragma unroll
                    for (int q = 0; q < 4; ++q) part[(rg * 16 + 4 * g + q) * 32 + 16 * et + r] = acc[et][q];
                if (g == 0) ssx[rg * 16 + r] = ss; }
            __syncthreads();
            if (kh == 0) { const float sst = ss + ssx[rg * 16 + r]; if (g == 0) rstds[rg * 16 + r] = 1.0f / sqrtf(sst * (1.0f / D) + EPS);
                asm volatile("s_waitcnt lgkmcnt(0)" ::: "memory");
#pragma unroll
                for (int et = 0; et < NET; ++et)
#pragma unroll
                    for (int q = 0; q < 4; ++q) { const int i = rg * 16 + 4 * g + q, e = 16 * et + r; const float v = rstds[i] * (acc[et][q] + part[i * 32 + e]) + biasl[e];
                        if (P5) part[i * 32 + e] = v; else ((float*)(ws + WS_GA))[(size_t)(row0 + i) * 16 + e] = v; }
                if (P5) { asm volatile("s_waitcnt lgkmcnt(0)" ::: "memory");
                    if (lane < 16) { const int i = rg * 16 + lane, m = row0 + i; float lv[NE];
#pragma unroll
                        for (int e = 0; e < NE; ++e) lv[e] = part[i * 32 + e];
                        float tv[4]; int te[4];
#pragma unroll
                        for (int t = 0; t < 4; ++t) { float best = -3.0e38f; int bi = 0;
#pragma unroll
                            for (int e = 0; e < NE; ++e) if (lv[e] > best) { best = lv[e]; bi = e; }
#pragma unroll
                            for (int e = 0; e < NE; ++e) if (e == bi) lv[e] = -3.0e38f;
                            tv[t] = best; te[t] = bi; }
                        const float e1 = expf(tv[1] - tv[0]), e2 = expf(tv[2] - tv[0]), e3 = expf(tv[3] - tv[0]); const float inv = 1.0f / (1.0f + e1 + e2 + e3);
                        *(f32x4*)((float*)(ws + WS_TOPW) + (size_t)m * 4) = (f32x4){inv, e1 * inv, e2 * inv, e3 * inv};
#pragma unroll
                        for (int t = 0; t < 4; ++t) { const unsigned rk = __hip_atomic_fetch_add((LAS unsigned*)&MISC[MW_HIST + te[t]], 1u, __ATOMIC_RELAXED, __HIP_MEMORY_SCOPE_WORKGROUP);
                            ((LAS unsigned*)(lds + LR_SLT))[i * 4 + t] = ((unsigned)te[t] << 16) | rk; } } } }
            __syncthreads(); }
        if (P5) { if (tid < NE) { const unsigned hcnt = MISC[MW_HIST + tid]; MISC[MW_BASE + tid] = hcnt ? atomicAdd((unsigned*)(ctl + CW_CNT + layer * NE + tid), hcnt) : 0u; }
            __syncthreads();
            if (tid < 256) { LAS unsigned* sl = (LAS unsigned*)(lds + LR_SLT) + tid; const unsigned v = *sl, e = v >> 16; const unsigned slot = (e << ECAP_SH) + MISC[MW_BASE + e] + (v & 0xffffu);
                *sl = slot; ((int*)(ws + WS_SLOT))[(size_t)row0 * 4 + tid] = (int)slot; }
            if (tid < NE) MISC[MW_HIST + tid] = 0u;
            __syncthreads(); }
        if (P5) flat_modulate<true, true>(xin, row0, rstds, nw, scp, shp, H, ws + WS_A1, lds, tid);
        else flat_modulate<F8_IN, false>(xin, row0, rstds, nw, scp, shp, H, ws + WS_A1, lds, tid);
        __syncthreads();
    }
}

__device__ __forceinline__ void final_rows(const Args& a, LAS unsigned char* lds, int vcu, int G, int tid, int lane) {
    unsigned char* ws = a.ws; const bf16* X = (const bf16*)(ws + WS_X); const float* MOD = (const float*)(ws + WS_MOD); LAS float* ssr = (LAS float*)(lds + LR_SSR);
    for (int row0 = vcu * 64; row0 < MTOK; row0 += G * 64) { const int b = row0 / SEQ;
        stage_slots(ws, row0, lds, tid); if (tid < 64) ssr[tid] = 0.f;
        __syncthreads();
        flat_combine<true, true>(X, a.out, row0, (const bf16*)(ws + WS_Y), MOD + ((size_t)(DEPTH - 1) * 2 + b) * 6144 + 5 * D, lds, tid, lane);
        asm volatile("s_waitcnt vmcnt(0)" ::: "memory");
        __syncthreads();
        { const int c4 = tid & 255, rsub = tid >> 8; const f32x4 w = *(const f32x4*)(a.final_norm_w + 4 * c4);
#pragma unroll 8
            for (int it = 0; it < 32; ++it) { const int i = 2 * it + rsub; float* op = a.out + (size_t)(row0 + i) * D + 4 * c4; const float rstd = 1.0f / sqrtf(ssr[i] * (1.0f / D) + EPS); *(GAS f32x4*)op = *(const GAS f32x4*)op * rstd * w; } }
        __syncthreads();
    }
}

__device__ __noinline__ void moe_tables(gu32* ctl, int layer, volatile LAS unsigned* MISC, int tid) {
    if (tid < NE) MISC[MW_CNT + tid] = __hip_atomic_load(ctl + CW_CNT + layer * NE + tid, RLX_AGENT);
    __syncthreads();
    if (tid == 0) { unsigned n = 0;
        for (int e = 0; e < NE; ++e) { const unsigned nt = (MISC[MW_CNT + e] + 255u) >> 8; for (unsigned t = 0; t < nt; ++t) MISC[MW_TILE + n + t] = (unsigned)(e * 64) + t; n += nt; }
        MISC[MW_NRT] = n; }
    __syncthreads();
}

constexpr int BP = 72;
template <int TYPE> struct MixCfg { static constexpr int DK = (TYPE == 1) ? 64 : 48, DV = (TYPE == 1) ? 64 : 96, NC = 4 * DK, NV = 4 * DV;
    static constexpr int STOFF = (TYPE == 0) ? ST_GLA : (TYPE == 1) ? ST_HG : ST_RET, COFF = (TYPE == 0) ? 0 : 192;
    static constexpr int CQ = (TYPE == 0) ? C_GQ : (TYPE == 1) ? C_HQ : C_RQ, CK = (TYPE == 0) ? C_GK : (TYPE == 1) ? C_HF : C_RK, CV = (TYPE == 0) ? C_GV : (TYPE == 1) ? C_HI : C_RV, CG = (TYPE == 0) ? C_GG : (TYPE == 1) ? C_HG : C_RG;
    static constexpr int MIXOFF = (TYPE == 0) ? 0 : (TYPE == 1) ? 384 : 640, KOFF = (TYPE == 0) ? 0 : (TYPE == 1) ? 192 : 448; };
__device__ __forceinline__ float fast_logsig(float x) { x = fmaxf(x, -80.f); return -__logf(1.0f + __expf(-x)); }
__device__ __forceinline__ float ret_lg(int h) { return logf(1.0f - exp2f(-5.0f - (float)h)); }

template <int NV>
__device__ __forceinline__ void stage_vt(const bf16* pv  , LAS bf16* VT, int tid) {
    constexpr int NIT = (64 * (NV / 8)) / NTHR; static_assert((64 * (NV / 8)) % NTHR == 0, "stage_vt");
    v4u p[NIT];
#pragma unroll
    for (int it = 0; it < NIT; ++it) { const int idx = tid + NTHR * it, j = idx & 63, ch = idx >> 6; p[it] = *(const v4u*)(pv + (size_t)j * NPROJ + 8 * ch); }
#pragma unroll
    for (int it = 0; it < NIT; ++it) { const int idx = tid + NTHR * it, j = idx & 63, ch = idx >> 6; LAS bf16* d = VT + (8 * ch) * BP + j;
        d[0 * BP] = (bf16)(p[it].x & 0xffffu); d[1 * BP] = (bf16)(p[it].x >> 16); d[2 * BP] = (bf16)(p[it].y & 0xffffu); d[3 * BP] = (bf16)(p[it].y >> 16);
        d[4 * BP] = (bf16)(p[it].z & 0xffffu); d[5 * BP] = (bf16)(p[it].z >> 16); d[6 * BP] = (bf16)(p[it].w & 0xffffu); d[7 * BP] = (bf16)(p[it].w >> 16); }
}

constexpr int LA_KT = 0, LA_VT = 36864, LA_TOT = 92160, LA_GA = 94208, LA_KTT = 98304, KTP = 264;
template <int TYPE>
__device__ __forceinline__ void mixa_batch(const Args& a, int layer, int unit, LAS unsigned char* lds, int tid, int lane, int wave) {
    asm volatile("" : "+v"(tid), "+v"(lane));
    typedef MixCfg<TYPE> C; constexpr int DK = C::DK, DV = C::DV, NC = C::NC, NV = C::NV;
    unsigned char* ws = a.ws; const bf16* PROJ = (const bf16*)(ws + WS_PROJ); bf16* F1 = (bf16*)(ws + WS_CUM); float* ECG = (float*)(ws + WS_CUM + 16 * MiB) + (size_t)unit * 4 * NDV; float* DVEC = (float*)(ws + WS_DVEC) + (size_t)unit * NDV;
    bf16* U = (bf16*)(ws + WS_U) + (size_t)unit * ST_TOT + C::STOFF;
    LAS bf16* KT = (LAS bf16*)(lds + LA_KT); LAS bf16* VT = (LAS bf16*)(lds + LA_VT); LAS float* TOT = (LAS float*)(lds + LA_TOT); const LAS float* GAs = (const LAS float*)(lds + LA_GA);
    const int row0 = unit * CH;
    stage_vt<NV>(PROJ + (size_t)row0 * NPROJ + C::CV, VT, tid);
    const bool act = tid < 2 * NC; const int c = act ? tid % NC : 0, half = act ? tid / NC : 0, h = c / DK, d = c - h * DK;
    float cum[32]; float tot = 0.f;
    float w2[16], b2 = 0.f, lbv = 0.f, lg = 0.f, sg = 0.f; int f = 0, d2 = 0;
    if (act) {
        if constexpr (TYPE == 0) { b2 = a.gla_ba2[layer * 192 + c];
#pragma unroll
            for (int r = 0; r < 16; ++r) w2[r] = a.gla_wa2[(layer * 16 + r) * 192 + c]; }
        if constexpr (TYPE == 1) lbv = ((const float*)(ws + WS_LB))[layer * 256 + c];
        if constexpr (TYPE == 2) { lg = ret_lg(h); f = (d < 24) ? d : d - 24; d2 = (d < 24) ? d + 24 : d - 24; sg = (d < 24) ? -1.f : 1.f; }
#pragma unroll
        for (int gq = 0; gq < 2; ++gq) {
            bf16 hraw[16];
            if constexpr (TYPE == 1) {
#pragma unroll
                for (int i = 0; i < 16; ++i) hraw[i] = PROJ[(size_t)(row0 + 32 * half + 16 * gq + i) * NPROJ + C_HF + c]; }
#pragma unroll
            for (int ii = 0; ii < 16; ++ii) { const int i = 16 * gq + ii, t = 32 * half + i; float g;
                if constexpr (TYPE == 0) { float pre = b2;
#pragma unroll
                    for (int r = 0; r < 16; ++r) pre += GAs[t * 16 + r] * w2[r];
                    g = fast_logsig(pre) * (1.0f / 16.0f); }
                else if constexpr (TYPE == 1) { const float hf = fminf(fmaxf(bf2f(hraw[ii]), -80.f), 80.f); const float sgm = __builtin_amdgcn_rcpf(1.0f + __expf(-hf));
                    g = __logf(lbv + (1.0f - lbv) * sgm); }
                else g = lg;
                tot += g; cum[i] = tot;
                if constexpr (TYPE == 0) { if ((ii & 3) == 3) asm volatile("" ::: "memory"); } } }
        TOT[c * 2 + half] = tot;
    }
    __syncthreads();
    if (act) { const float t0 = TOT[c * 2], t1 = TOT[c * 2 + 1]; const float off = half ? t0 : 0.f, last = t0 + t1;
#pragma unroll
        for (int hq = 0; hq < 4; ++hq) {
            bf16 ka[8], kb[8]; float cs[8], sn[8];
            if constexpr (TYPE != 1) {
#pragma unroll
                for (int i = 0; i < 8; ++i) { const size_t row = (size_t)(row0 + 32 * half + 8 * hq + i); const bf16* pr = PROJ + row * NPROJ;
                    if constexpr (TYPE == 0) ka[i] = pr[C_GK + c];
                    else { const float* rp = (const float*)(ws + WS_ROPE) + row * 48; ka[i] = pr[C_RK + h * 48 + d]; kb[i] = pr[C_RK + h * 48 + d2]; cs[i] = rp[f]; sn[i] = rp[24 + f]; } } }
            float kt[8];
#pragma unroll
            for (int j = 0; j < 8; ++j) { const int i = 8 * hq + j; const float cm = cum[i] + off; const size_t row = (size_t)(row0 + 32 * half + i); float k;
                if constexpr (TYPE == 0) k = bf2f(ka[j]);
                else if constexpr (TYPE == 1) k = 1.0f - __expf(cum[i] - (i > 0 ? cum[i - 1] : 0.f));
                else k = bf2f(ka[j]) * cs[j] + sg * bf2f(kb[j]) * sn[j];
                if constexpr (TYPE != 2) *(GAS bf16*)(F1 + row * NDV + C::COFF + c) = (bf16)f2bf(__expf(cm - ((i < 16) ? off : cum[15] + off)));
                { const float eb = cum[(i < 16) ? 15 : 31] + off;
                  ((LAS bf16*)(lds + LA_KTT))[(32 * half + i) * KTP + c] = (bf16)f2bf(k * __expf(eb - cm)); }
                kt[j] = k * __expf(last - cm); }
            v4u w; w.x = pk2(kt[0], kt[1]); w.y = pk2(kt[2], kt[3]); w.z = pk2(kt[4], kt[5]); w.w = pk2(kt[6], kt[7]);
            *(LAS v4u*)(KT + c * BP + 32 * half + 8 * hq) = w; }
        if (TYPE != 2) { *(GAS float*)(ECG + (2 * half + 0) * NDV + C::COFF + c) = cum[15] + off; *(GAS float*)(ECG + (2 * half + 1) * NDV + C::COFF + c) = cum[31] + off; }
        if (TYPE != 2 && half == 0) *(GAS float*)(DVEC + C::COFF + c) = __expf(last);
    }
    __syncthreads();
    { constexpr int CPR = NC / 8;
#pragma unroll
        for (int it = 0; it < (64 * CPR) / NTHR; ++it) { const int idx = tid + NTHR * it, t = idx / CPR, ch = idx - t * CPR;
            *(GAS v4u*)((bf16*)(ws + WS_KT) + (size_t)(row0 + t) * NKT + C::KOFF + 8 * ch) = *(const LAS v4u*)((const LAS bf16*)(lds + LA_KTT) + t * KTP + 8 * ch); } }
    constexpr int TD = DK / 16, NT = (DV / 16) * TD;
    for (int ti = wave; ti < 4 * NT; ti += NWAVES) { const int hh = ti / NT, tr = ti - hh * NT, te = tr / TD, td = tr - te * TD; f32x4 acc = {0.f, 0.f, 0.f, 0.f};
#pragma unroll
        for (int kk = 0; kk < 2; ++kk) acc = __builtin_amdgcn_mfma_f32_16x16x32_bf16(ldfrag(VT, BP, hh * DV + te * 16, kk * 32, lane), ldfrag(KT, BP, hh * DK + td * 16, kk * 32, lane), acc, 0, 0, 0);
        bf16* Uh = U + hh * DK * DV;
#pragma unroll
        for (int r = 0; r < 4; ++r) *(GAS bf16*)(Uh + (te * 16 + (lane >> 4) * 4 + r) * DK + td * 16 + (lane & 15)) = (bf16)f2bf(acc[r]); }
    __syncthreads();
}
__device__ __forceinline__ void p3a_summaries(const Args& a, int layer, LAS unsigned char* lds, int vcu, int G, int tid, int lane, int wave) {
    for (int unit = vcu; unit < NUNIT; unit += G) {
        { LAS float* GAs = (LAS float*)(lds + LA_GA); const float* GA = (const float*)(a.ws + WS_GA); for (int i = tid; i < CH * 16; i += NTHR) GAs[i] = GA[(size_t)unit * CH * 16 + i]; }
        __syncthreads();
        mixa_batch<0>(a, layer, unit, lds, tid, lane, wave);
        mixa_batch<1>(a, layer, unit, lds, tid, lane, wave);
        mixa_batch<2>(a, layer, unit, lds, tid, lane, wave);
    }
}

__device__ __forceinline__ void p3b_scan(const Args& a, int vcu, int G, int tid) {
    unsigned char* ws = a.ws; const bf16* U = (const bf16*)(ws + WS_U); const float* DVEC = (const float*)(ws + WS_DVEC); bf16* SP = (bf16*)(ws + WS_SP);
    for (int gid = vcu * NTHR + tid; gid < BATCH * ST_TOT; gid += G * NTHR) {
        const int b = gid / ST_TOT, el = gid - b * ST_TOT;
        int di = -1; float cdec = 0.f;
        if (el < ST_HG) { const int h = el / 4608, d = (el - h * 4608) % 48; di = h * 48 + d; }
        else if (el < ST_RET) { const int r = el - ST_HG, h = r / 4096, d = r % 64; di = 192 + h * 64 + d; }
        else { const int h = (el - ST_RET) / 4608; cdec = expf(64.0f * logf(1.0f - exp2f(-5.0f - (float)h))); }
        const bf16* up = U + (size_t)b * NCH * ST_TOT + el; const float* dp = DVEC + (size_t)b * NCH * NDV + (di < 0 ? 0 : di); bf16* sp = SP + (size_t)b * NCH * ST_TOT + el;
        float s = 0.f;
#pragma unroll 1
        for (int n0 = 0; n0 < NCH; n0 += 32) { float u[32], dc[32];
#pragma unroll
            for (int i = 0; i < 32; ++i) { u[i] = bf2f(up[(size_t)(n0 + i) * ST_TOT]); dc[i] = (di < 0) ? cdec : dp[(size_t)(n0 + i) * NDV]; }
#pragma unroll
            for (int i = 0; i < 32; ++i) { *(GAS bf16*)(sp + (size_t)(n0 + i) * ST_TOT) = (bf16)f2bf(s); s = dc[i] * s + u[i]; } }
    }
}

#ifndef SUB_MASK
#define SUB_MASK 0
#endif
#define SUBSTRETCH(bit, t0_) do { if ((SUB_MASK >> (bit)) & 1) { const unsigned long long t1_ = __builtin_amdgcn_s_memrealtime(); while (__builtin_amdgcn_s_memrealtime() - t1_ < t1_ - (t0_)) __builtin_amdgcn_s_sleep(8); } } while (0)
constexpr int LC_VT = 0, LC_ST = 55296, LC_AB = 110592, OBP = 104, LC_EC = 137216;
template <int TYPE, bool ISQ>
__device__ __forceinline__ void mix_frag(const Args& a, int h, size_t row, int t, int d0, float (&x)[8], float (&cm)[8]) {
    typedef MixCfg<TYPE> C; constexpr int DK = C::DK; static_assert(ISQ, "query path only");
    unsigned char* ws = a.ws; const bf16* pr = (const bf16*)(ws + WS_PROJ) + row * NPROJ;
    if constexpr (TYPE != 2) {
        const v4u p = *(const v4u*)(pr + C::CQ + h * DK + d0); const unsigned pw[4] = {p.x, p.y, p.z, p.w};
        const v4u f = *(const v4u*)((const bf16*)(ws + WS_CUM) + row * NDV + C::COFF + h * DK + d0); const unsigned fw[4] = {f.x, f.y, f.z, f.w};
#pragma unroll
        for (int j = 0; j < 4; ++j) { x[2 * j] = __builtin_bit_cast(float, pw[j] << 16); x[2 * j + 1] = __builtin_bit_cast(float, pw[j] & 0xffff0000u); cm[2 * j] = __builtin_bit_cast(float, fw[j] << 16); cm[2 * j + 1] = __builtin_bit_cast(float, fw[j] & 0xffff0000u); }
        if constexpr (TYPE == 0) {
#pragma unroll
            for (int j = 0; j < 8; ++j) x[j] *= 0.14433756729740643f; }
    } else {
        const int f0 = (d0 < 24) ? d0 : d0 - 24, dp = (d0 < 24) ? d0 + 24 : d0 - 24; const float sg = (d0 < 24) ? -1.f : 1.f;
        const int cb = C_RQ + h * DK; const v4u p = *(const v4u*)(pr + cb + d0), pp = *(const v4u*)(pr + cb + dp); const unsigned pw[4] = {p.x, p.y, p.z, p.w}, qw[4] = {pp.x, pp.y, pp.z, pp.w};
        const float* rp = (const float*)(ws + WS_ROPE) + row * 48; const f32x4 cs0 = *(const f32x4*)(rp + f0), cs1 = *(const f32x4*)(rp + f0 + 4), sn0 = *(const f32x4*)(rp + 24 + f0), sn1 = *(const f32x4*)(rp + 24 + f0 + 4);
        const float cmv = (float)(t + 1) * ret_lg(h);
#pragma unroll
        for (int j = 0; j < 4; ++j) { const float xa = __builtin_bit_cast(float, pw[j] << 16), xb = __builtin_bit_cast(float, pw[j] & 0xffff0000u), ya = __builtin_bit_cast(float, qw[j] << 16), yb = __builtin_bit_cast(float, qw[j] & 0xffff0000u);
            const float ca = (j < 2) ? cs0[2 * j] : cs1[2 * j - 4], cb2 = (j < 2) ? cs0[2 * j + 1] : cs1[2 * j - 3], sa = (j < 2) ? sn0[2 * j] : sn1[2 * j - 4], sb = (j < 2) ? sn0[2 * j + 1] : sn1[2 * j - 3];
            x[2 * j] = (xa * ca + sg * ya * sa) * 0.14433756729740643f; x[2 * j + 1] = (xb * cb2 + sg * yb * sb) * 0.14433756729740643f; cm[2 * j] = cmv; cm[2 * j + 1] = cmv; }
    }
}

template <int TYPE>
__device__ __forceinline__ void mixc_batch(const Args& a, int layer, int unit, LAS unsigned char* lds, int tid, int lane, int wave) {
    asm volatile("" : "+v"(tid), "+v"(lane));
    typedef MixCfg<TYPE> C; constexpr int DK = C::DK, DV = C::DV, NV = C::NV, TE = DV / 16;
    unsigned char* ws = a.ws; const bf16* PROJ = (const bf16*)(ws + WS_PROJ); bf16* MIX = (bf16*)(ws + WS_MIX);
    LAS bf16* VT = (LAS bf16*)(lds + LC_VT); LAS bf16* ST = (LAS bf16*)(lds + LC_ST); LAS bf16* AB = (LAS bf16*)(lds + LC_AB) + wave * 16 * OBP;
    const int row0 = unit * CH;
    const unsigned long long ts0_ = SUB_MASK ? __builtin_amdgcn_s_memrealtime() : 0ull;
    stage_vt<NV>(PROJ + (size_t)row0 * NPROJ + C::CV, VT, tid);
    SUBSTRETCH(3, ts0_);
    const unsigned long long ts3_ = SUB_MASK ? __builtin_amdgcn_s_memrealtime() : 0ull;
    { const bf16* SPu = (const bf16*)(ws + WS_SP) + (size_t)unit * ST_TOT + C::STOFF;
        constexpr int NIS = (NV * 8) / NTHR; static_assert((NV * 8) % NTHR == 0, "ST staging"); v4u sw[NIS];
#pragma unroll
        for (int it = 0; it < NIS; ++it) { const int idx = tid + NTHR * it, er = idx >> 3, ch = idx & 7; sw[it] = (v4u){0u, 0u, 0u, 0u}; if (ch * 8 < DK) sw[it] = *(const v4u*)(SPu + (size_t)er * DK + ch * 8); }
#pragma unroll
        for (int it = 0; it < NIS; ++it) { const int idx = tid + NTHR * it, er = idx >> 3, ch = idx & 7; *(LAS v4u*)(ST + er * BP + ch * 8) = sw[it]; } }
    SUBSTRETCH(4, ts3_);
    SUBSTRETCH(0, ts0_);
    if constexpr (TYPE != 2) { LAS float* EC = (LAS float*)(lds + LC_EC);
        for (int idx = tid; idx < 4 * C::NC; idx += NTHR) { const int jb = idx / C::NC, cc = idx - jb * C::NC; EC[jb * 256 + cc] = ((const float*)(ws + WS_CUM + 16 * MiB))[((size_t)unit * 4 + jb) * NDV + C::COFF + cc]; } }
    __syncthreads();
    const unsigned long long ts1_ = SUB_MASK ? __builtin_amdgcn_s_memrealtime() : 0ull;
    const int h = wave >> 1, hsel = wave & 1, r = lane & 15, g = lane >> 4;
    const LAS bf16* STh = ST + h * DV * BP; const LAS bf16* VTh = VT + h * DV * BP;
    constexpr int NCHK = DV / 8, NOC = (16 * NCHK) / 64;
#pragma unroll 1
    for (int ib = 0; ib < 2; ++ib) { const int I = ib ? 3 - hsel : hsel;
        pg8::bf16x8 qh[2], qt[2]; float refv[2][8], qhf[2][8];
#pragma unroll
        for (int s = 0; s < 2; ++s) { const int d0 = 32 * s + 8 * g; const bool valid = d0 < DK; const int d0c = valid ? d0 : 0;
            float x[8], cm[8]; mix_frag<TYPE, true>(a, h, (size_t)(row0 + 16 * I + r), 16 * I + r, d0c, x, cm);
            if constexpr (TYPE == 2) {
#pragma unroll
                for (int j = 0; j < 8; ++j) refv[s][j] = (float)(16 * I) * ret_lg(h);
            } else { if (I > 0) { const LAS float* cp = (const LAS float*)(lds + LC_EC) + (I - 1) * 256 + h * DK + d0c; const f32x4 c0 = *(const LAS f32x4*)cp, c1 = *(const LAS f32x4*)(cp + 4);
#pragma unroll
                    for (int j = 0; j < 4; ++j) { refv[s][j] = c0[j]; refv[s][4 + j] = c1[j]; } }
                else {
#pragma unroll
                    for (int j = 0; j < 8; ++j) refv[s][j] = 0.f; } }
            float xt[8];
#pragma unroll
            for (int j = 0; j < 8; ++j) { if constexpr (TYPE == 2) { qhf[s][j] = valid ? x[j] * __expf(cm[j] - refv[s][j]) : 0.f; xt[j] = valid ? x[j] * __expf(cm[j]) : 0.f; }
                else { qhf[s][j] = valid ? x[j] * cm[j] : 0.f; xt[j] = qhf[s][j] * __expf(refv[s][j]); } }
            qh[s] = pack8(qhf[s]); qt[s] = pack8(xt); }
        v4u kf[4][2];
#pragma unroll
        for (int J = 0; J < 4; ++J) { const int Jc = (J < I) ? J : I; const size_t rowJ = (size_t)(row0 + 16 * Jc + r);
#pragma unroll
            for (int s = 0; s < 2; ++s) { const int d0 = 32 * s + 8 * g; const int d0c = (d0 < DK) ? d0 : 0;
                kf[J][s] = *(const v4u*)((const bf16*)(ws + WS_KT) + rowJ * NKT + C::KOFF + h * DK + d0c); } }
#pragma unroll
        for (int J = 0; J < 4; ++J) { if (J <= I) { f32x4 acc = {0.f, 0.f, 0.f, 0.f};
#pragma unroll
            for (int s = 0; s < 2; ++s) { pg8::bf16x8 qop;
                { float xq[8], ej[8]; const int d0 = 32 * s + 8 * g; const int d0c = (d0 < DK) ? d0 : 0;
                    if constexpr (TYPE == 2) {
#pragma unroll
                        for (int j = 0; j < 8; ++j) ej[j] = (float)(16 * (J + 1)) * ret_lg(h); }
                    else { const LAS float* ep = (const LAS float*)(lds + LC_EC) + J * 256 + h * DK + d0c; const f32x4 e0 = *(const LAS f32x4*)ep, e1 = *(const LAS f32x4*)(ep + 4);
#pragma unroll
                        for (int j = 0; j < 4; ++j) { ej[j] = e0[j]; ej[4 + j] = e1[j]; } }
#pragma unroll
                    for (int j = 0; j < 8; ++j) xq[j] = qhf[s][j] * __expf(fminf(refv[s][j] - ej[j], 80.f));
                    qop = pack8(xq); }
                acc = __builtin_amdgcn_mfma_f32_16x16x32_bf16(qop, __builtin_bit_cast(pg8::bf16x8, kf[J][s]), acc, 0, 0, 0); }
#pragma unroll
            for (int q = 0; q < 4; ++q) { const int i = 4 * g + q; const float v = (J < I || r <= i) ? acc[q] : 0.f; AB[i * BP + 16 * J + r] = (bf16)f2bf(v); } } }
        if ((I & 1) == 0) {
#pragma unroll
            for (int q = 0; q < 4; ++q) AB[(4 * g + q) * BP + 16 * (I + 1) + r] = (bf16)0; }
        asm volatile("s_waitcnt lgkmcnt(0)" ::: "memory");
        const pg8::bf16x8 ah0 = *(const LAS pg8::bf16x8*)(AB + r * BP + 8 * g), ah1 = *(const LAS pg8::bf16x8*)(AB + r * BP + 32 + 8 * g);
        f32x4 o[TE];
#pragma unroll
        for (int te = 0; te < TE; ++te) { f32x4 acc = {0.f, 0.f, 0.f, 0.f};
            acc = __builtin_amdgcn_mfma_f32_16x16x32_bf16(qt[0], ldfrag(STh, BP, te * 16, 0, lane), acc, 0, 0, 0);
            acc = __builtin_amdgcn_mfma_f32_16x16x32_bf16(qt[1], ldfrag(STh, BP, te * 16, 32, lane), acc, 0, 0, 0);
            acc = __builtin_amdgcn_mfma_f32_16x16x32_bf16(ah0, ldfrag(VTh, BP, te * 16, 0, lane), acc, 0, 0, 0);
            if (I >= 2) acc = __builtin_amdgcn_mfma_f32_16x16x32_bf16(ah1, ldfrag(VTh, BP, te * 16, 32, lane), acc, 0, 0, 0);
            o[te] = acc; }
        const unsigned long long ts2_ = SUB_MASK ? __builtin_amdgcn_s_memrealtime() : 0ull;
#pragma unroll
        for (int q = 0; q < 4; ++q) { float s1 = 0.f, s2 = 0.f;
#pragma unroll
            for (int te = 0; te < TE; ++te) { s1 += o[te][q]; s2 += o[te][q] * o[te][q]; }
#pragma unroll
            for (int m = 1; m < 16; m <<= 1) { s1 += __shfl_xor(s1, m); s2 += __shfl_xor(s2, m); }
            float mean = 0.f, rstd;
            if constexpr (TYPE == 2) { mean = s1 * (1.0f / DV); rstd = __builtin_amdgcn_rsqf(fmaxf(s2 * (1.0f / DV) - mean * mean, 0.f) + EPS); }
            else rstd = __builtin_amdgcn_rsqf(s2 * (1.0f / DV) + EPS);
#pragma unroll
            for (int te = 0; te < TE; ++te) AB[(4 * g + q) * OBP + te * 16 + r] = (bf16)f2bf((o[te][q] - mean) * rstd); }
        asm volatile("s_waitcnt lgkmcnt(0)" ::: "memory");
#pragma unroll 1
        for (int i = 0; i < NOC; ++i) { const int cidx = lane + 64 * i, orow = cidx / NCHK, ch = cidx - orow * NCHK; const size_t row = (size_t)(row0 + 16 * I + orow);
            const v4u ov = *(const LAS v4u*)(AB + orow * OBP + 8 * ch); const v4u gv = *(const v4u*)(PROJ + row * NPROJ + C::CG + h * DV + 8 * ch);
            const unsigned ow[4] = {ov.x, ov.y, ov.z, ov.w}, gw[4] = {gv.x, gv.y, gv.z, gv.w}; float res[8];
            f32x4 w0 = {1.f, 1.f, 1.f, 1.f}, w1 = {1.f, 1.f, 1.f, 1.f};
            if constexpr (TYPE == 0) { const float* wp = a.gla_norm_w + layer * 384 + h * 96 + 8 * ch; w0 = *(const f32x4*)wp; w1 = *(const f32x4*)(wp + 4); }
            if constexpr (TYPE == 1) { const float* wp = a.hg_norm_w + layer * 256 + h * 64 + 8 * ch; w0 = *(const f32x4*)wp; w1 = *(const f32x4*)(wp + 4); }
#pragma unroll
            for (int j = 0; j < 4; ++j) { const float oa = __builtin_bit_cast(float, ow[j] << 16), ob = __builtin_bit_cast(float, ow[j] & 0xffff0000u), ga = __builtin_bit_cast(float, gw[j] << 16), gb = __builtin_bit_cast(float, gw[j] & 0xffff0000u);
                const float wa = (j < 2) ? w0[2 * j] : w1[2 * j - 4], wb = (j < 2) ? w0[2 * j + 1] : w1[2 * j - 3];
                const float sa = __builtin_amdgcn_rcpf(1.0f + __expf(-ga)), sb = __builtin_amdgcn_rcpf(1.0f + __expf(-gb));
                res[2 * j] = oa * wa * ((TYPE == 1) ? sa : ga * sa); res[2 * j + 1] = ob * wb * ((TYPE == 1) ? sb : gb * sb); }
            if (F8_OUT) { typedef int i32x2 __attribute__((ext_vector_type(2)));
                *(GAS i32x2*)((unsigned char*)MIX + row * D + C::MIXOFF + h * DV + 8 * ch) = (i32x2){pk4_fp8(res[0] * S8_M, res[1] * S8_M, res[2] * S8_M, res[3] * S8_M), pk4_fp8(res[4] * S8_M, res[5] * S8_M, res[6] * S8_M, res[7] * S8_M)}; }
            else { v4u w; w.x = pk2(res[0], res[1]); w.y = pk2(res[2], res[3]); w.z = pk2(res[4], res[5]); w.w = pk2(res[6], res[7]); *(GAS v4u*)(MIX + row * D + C::MIXOFF + h * DV + 8 * ch) = w; } }
        SUBSTRETCH(2, ts2_);
    }
    SUBSTRETCH(1, ts1_);
    __syncthreads();
}
__device__ __forceinline__ void p3c_outputs(const Args& a, int layer, LAS unsigned char* lds, int vcu, int G, int tid, int lane, int wave) {
    for (int unit = vcu; unit < NUNIT; unit += G) {
        mixc_batch<0>(a, layer, unit, lds, tid, lane, wave);
        mixc_batch<1>(a, layer, unit, lds, tid, lane, wave);
        mixc_batch<2>(a, layer, unit, lds, tid, lane, wave);
    }
}


constexpr int MW_ARGS = 800;
__device__ __forceinline__ const void* ld_argp(const volatile LAS unsigned* T, int i) {
    const unsigned lo = __builtin_amdgcn_readfirstlane(T[2 * i]), hi = __builtin_amdgcn_readfirstlane(T[2 * i + 1]);
    return (const void*)(((unsigned long long)hi << 32) | lo);
}
__device__ __forceinline__ Args load_args(LAS unsigned char* lds) {
    const volatile LAS unsigned* T = (const volatile LAS unsigned*)(lds + MISC_OFF) + MW_ARGS;
    Args a;
    a.x = (const float*)ld_argp(T, 0); a.c = (const float*)ld_argp(T, 1); a.pos = (const int*)ld_argp(T, 2); a.w_mod = (const float*)ld_argp(T, 3); a.b_mod = (const float*)ld_argp(T, 4);
    a.norm1_w = (const float*)ld_argp(T, 5); a.w_in = (const float*)ld_argp(T, 6); a.gla_wa2 = (const float*)ld_argp(T, 7); a.gla_ba2 = (const float*)ld_argp(T, 8); a.hg_lb = (const float*)ld_argp(T, 9);
    a.gla_norm_w = (const float*)ld_argp(T, 10); a.hg_norm_w = (const float*)ld_argp(T, 11); a.w_out = (const float*)ld_argp(T, 12); a.norm2_w = (const float*)ld_argp(T, 13); a.w_r = (const float*)ld_argp(T, 14);
    a.b_r = (const float*)ld_argp(T, 15); a.w_gu = (const float*)ld_argp(T, 16); a.b_gu = (const float*)ld_argp(T, 17); a.w_dn = (const float*)ld_argp(T, 18); a.b_dn = (const float*)ld_argp(T, 19);
    a.final_norm_w = (const float*)ld_argp(T, 20); a.out = (float*)ld_argp(T, 21); a.ws = (unsigned char*)ld_argp(T, 22); a.ph_lo = 0; a.ph_hi = 0;
    return a;
}
#define PH_CTX() { unsigned l_ = (unsigned)(size_t)lds; asm volatile("" : "+s"(l_)); lds = (LAS unsigned char*)(size_t)l_; } const Args args = load_args(lds); volatile LAS unsigned* MISC = (volatile LAS unsigned*)(lds + MISC_OFF); int tid_ = wv * 64 + (int)__builtin_amdgcn_mbcnt_hi(~0u, __builtin_amdgcn_mbcnt_lo(~0u, 0u)); asm volatile("" : "+v"(tid_)); const int tid = tid_, lane = tid & 63, wave = __builtin_amdgcn_readfirstlane(tid >> 6); \
    const int G = gridDim.x; const int bx = blockIdx.x; const int vcu = (G % 8 == 0) ? (bx % 8) * (G / 8) + bx / 8 : bx; unsigned char* ws = args.ws; gu32* ctl = (gu32*)(ws + WS_CTL); \
    (void)MISC; (void)lane; (void)wave; (void)vcu; (void)ctl; (void)bx; (void)tid
__device__ __forceinline__ void ph_p0(LAS unsigned char* lds, int wv) { PH_CTX(); p0_prologue(args, lds, vcu, G, tid, lane, wave); }
__device__ __forceinline__ void ph_p1(LAS unsigned char* lds, int wv, int layer_) { int layer = __builtin_amdgcn_readfirstlane(layer_); asm volatile("" : "+s"(layer)); PH_CTX();
    if (layer > 0) { moe_tables(ctl, layer - 1, MISC, tid); const int nrt = __builtin_amdgcn_readfirstlane((int)MISC[MW_NRT]);
        const int done = conv_t2(G) + conv_idle(nrt * 8, G) * NWAVES * CB7 + conv_idle(nrt * 4, G) * NWAVES * CB8; LAS float* scr = (LAS float*)(lds + wave * 16640);
        for (int it = done + vcu * NWAVES + wave; it < IT_LAYER; it += G * NWAVES) convert_item(args, layer, it, scr, lane);
        __syncthreads(); }
    rows_mfma<16>(args, layer, lds, MISC, ctl, vcu, G, tid, lane, wave); }
__device__ __forceinline__ void ph_p2(LAS unsigned char* lds, int wv, int layer_) { int layer = __builtin_amdgcn_readfirstlane(layer_); asm volatile("" : "+s"(layer)); PH_CTX();
    pg8::Gemm g{(const bf16*)(ws + WS_H), (const bf16*)(ws + WS_WIN + (size_t)layer * NPROJ * D * (F8_IN ? 1 : 2)), MTOK, NPROJ, F8_IN ? D / 2 : D}; pg8::StaticOrder S; S.init(MTOK, NPROJ, G, bx);
    pg8::EpiBf16Plain E{(bf16*)(ws + WS_PROJ), NPROJ, F8_IN ? 1.0f / (S8_H * S8_W) : 1.0f};
    pg8::gemm_phase<pg8::EpiBf16Plain, pg8::StaticOrder, true, true, F8_IN>(lds, g, S, E, tid);
    if (layer + 1 < DEPTH && G == 256 && bx >= 64) convert_range(args, layer + 1, ((bx - 64) * NWAVES + wave) * CB2, CB2, lds, lane, wave); }
__device__ __forceinline__ void ph_p3a(LAS unsigned char* lds, int wv, int layer_) { int layer = __builtin_amdgcn_readfirstlane(layer_); asm volatile("" : "+s"(layer)); PH_CTX(); p3a_summaries(args, layer, lds, vcu, G, tid, lane, wave); }
__device__ __forceinline__ void ph_p3b(LAS unsigned char* lds, int wv) { PH_CTX(); p3b_scan(args, vcu, G, tid); }
__device__ __forceinline__ void ph_p3c(LAS unsigned char* lds, int wv, int layer_) { int layer = __builtin_amdgcn_readfirstlane(layer_); asm volatile("" : "+s"(layer)); PH_CTX(); p3c_outputs(args, layer, lds, vcu, G, tid, lane, wave); }
__device__ __forceinline__ void ph_p4(LAS unsigned char* lds, int wv, int layer_) { int layer = __builtin_amdgcn_readfirstlane(layer_); asm volatile("" : "+s"(layer)); PH_CTX();
    pg8::Gemm g{(const bf16*)(ws + WS_MIX), (const bf16*)(ws + WS_WOUT + (size_t)layer * D * D * (F8_OUT ? 1 : 2)), MTOK, D, F8_OUT ? D / 2 : D}; pg8::StaticOrder S; S.init(MTOK, D, G, bx);
    pg8::EpiResGate E{(const bf16*)(ws + WS_X), (bf16*)(ws + WS_X), D, (const float*)(ws + WS_MOD) + (size_t)layer * 2 * 6144 + 2 * D, 6144, SEQ, F8_OUT ? 1.0f / (S8_M * S8_W) : 1.0f};
    pg8::gemm_phase<pg8::EpiResGate, pg8::StaticOrder, true, true, F8_OUT>(lds, g, S, E, tid); }
__device__ __forceinline__ void ph_p5(LAS unsigned char* lds, int wv, int layer_) { int layer = __builtin_amdgcn_readfirstlane(layer_); asm volatile("" : "+s"(layer)); PH_CTX(); rows_mfma<32>(args, layer, lds, MISC, ctl, vcu, G, tid, lane, wave); }
__device__ __forceinline__ void ph_p7(LAS unsigned char* lds, int wv, int layer_) { int layer = __builtin_amdgcn_readfirstlane(layer_); asm volatile("" : "+s"(layer)); PH_CTX();
    moe_tables(ctl, layer, MISC, tid);
    const int nrt = __builtin_amdgcn_readfirstlane((int)MISC[MW_NRT]);
    pg8::Gemm g{(const bf16*)(ws + WS_A1), (const bf16*)(ws + WS_WGU + (size_t)layer * NE * 2048 * D), nrt * 256, NE * 2048, D / 2};
    pg8::MoeOrder S{8, G, vcu, nrt * 8, (const LAS int*)(lds + MISC_OFF + 4 * MW_TILE)};
    pg8::EpiSwiglu E{ws + WS_ACT, FFN, args.b_gu + (size_t)layer * NE * 2048, 1.0f / (S8_H * S8_W), S8_A};
    pg8::gemm_phase<pg8::EpiSwiglu, pg8::MoeOrder, true, true, true>(lds, g, S, E, tid);
    { const int rem = (nrt * 8) % G; if (layer + 1 < DEPTH && rem != 0 && vcu >= rem) convert_range(args, layer + 1, conv_t2(G) + ((vcu - rem) * NWAVES + wave) * CB7, CB7, lds, lane, wave); } }
__device__ __forceinline__ void ph_p8(LAS unsigned char* lds, int wv, int layer_) { int layer = __builtin_amdgcn_readfirstlane(layer_); asm volatile("" : "+s"(layer)); PH_CTX();
    moe_tables(ctl, layer, MISC, tid);
    const int nrt = __builtin_amdgcn_readfirstlane((int)MISC[MW_NRT]);
    pg8::Gemm g{(const bf16*)(ws + WS_ACT), (const bf16*)(ws + WS_WDN + (size_t)layer * NE * D * FFN), nrt * 256, NE * D, FFN / 2};
    pg8::MoeOrder S{4, G, vcu, nrt * 4, (const LAS int*)(lds + MISC_OFF + 4 * MW_TILE)};
    if constexpr (Y8) { pg8::EpiFp8Bias E{ws + WS_Y, D, args.b_dn + (size_t)layer * NE * D, D, 1.0f / (S8_A * S8_W), S8_Y};
        pg8::gemm_phase<pg8::EpiFp8Bias, pg8::MoeOrder, true, true, true>(lds, g, S, E, tid); }
    else { pg8::EpiBf16Bias E{(bf16*)(ws + WS_Y), D, args.b_dn + (size_t)layer * NE * D, D, 1.0f / (S8_A * S8_W)};
        pg8::gemm_phase<pg8::EpiBf16Bias, pg8::MoeOrder, true, true, true>(lds, g, S, E, tid); }
    { const int rem = (nrt * 4) % G; if (layer + 1 < DEPTH && rem != 0 && vcu >= rem) convert_range(args, layer + 1, conv_t2(G) + conv_idle(nrt * 8, G) * NWAVES * CB7 + ((vcu - rem) * NWAVES + wave) * CB8, CB8, lds, lane, wave); } }
__device__ __forceinline__ void ph_final(LAS unsigned char* lds, int wv) { PH_CTX(); final_rows(args, lds, vcu, G, tid, lane); }

#ifndef DBL_MASK
#define DBL_MASK 0
#endif
#if DBL_MASK
#define RUN(bit, call) do { if ((DBL_MASK >> (bit)) & 1) { const unsigned long long t0_ = __builtin_amdgcn_s_memrealtime(); call; const unsigned long long t1_ = __builtin_amdgcn_s_memrealtime(); \
        while (__builtin_amdgcn_s_memrealtime() - t1_ < t1_ - t0_) __builtin_amdgcn_s_sleep(8); } else { call; } } while (0)
#else
#define RUN(bit, call) do { call; } while (0)
#endif
__global__ void __launch_bounds__(NTHR, 2) hybrid_fwd(Args args) {
    extern __shared__ __attribute__((aligned(16))) unsigned char lds_raw[];
    LAS unsigned char* lds = (LAS unsigned char*)lds_raw;
    volatile LAS unsigned* MISC = (volatile LAS unsigned*)(lds + MISC_OFF);
    const int tid = threadIdx.x; const int wv = __builtin_amdgcn_readfirstlane(tid >> 6);
    gu32* ctl = (gu32*)(args.ws + WS_CTL);
    for (int u = tid; u < (LDS_BYTES - MISC_OFF) / 4; u += NTHR) MISC[u] = 0u;
    __syncthreads();
    if (tid == 0) {
#define ST_ARG(i, p) do { const unsigned long long v_ = (unsigned long long)(p); MISC[MW_ARGS + 2 * (i)] = (unsigned)v_; MISC[MW_ARGS + 2 * (i) + 1] = (unsigned)(v_ >> 32); } while (0)
        ST_ARG(0, args.x); ST_ARG(1, args.c); ST_ARG(2, args.pos); ST_ARG(3, args.w_mod); ST_ARG(4, args.b_mod); ST_ARG(5, args.norm1_w); ST_ARG(6, args.w_in); ST_ARG(7, args.gla_wa2); ST_ARG(8, args.gla_ba2);
        ST_ARG(9, args.hg_lb); ST_ARG(10, args.gla_norm_w); ST_ARG(11, args.hg_norm_w); ST_ARG(12, args.w_out); ST_ARG(13, args.norm2_w); ST_ARG(14, args.w_r); ST_ARG(15, args.b_r); ST_ARG(16, args.w_gu);
        ST_ARG(17, args.b_gu); ST_ARG(18, args.w_dn); ST_ARG(19, args.b_dn); ST_ARG(20, args.final_norm_w); ST_ARG(21, args.out); ST_ARG(22, args.ws);
#undef ST_ARG
    }
    __syncthreads();
    const int lo = args.ph_lo, hi = args.ph_hi;
    const bool multi = (hi - lo) > 1;
    XcdBarrier bar; bar.bar = (unsigned*)(ctl + CW_BAR); bar.x = 0; bar.st = nullptr;
    if (multi) bar = xcd_barrier_post((unsigned*)(ctl + CW_BAR), MISC + MW_BAR);
#define IN(k) (lo <= (k) && (k) < hi)
#define SEAM(k) do { if (IN(k) && IN((k) + 1)) xcd_barrier(bar); } while (0)

    if (IN(0)) RUN(0, ph_p0(lds, wv));
    SEAM(0);
    for (int layer = 0; layer < DEPTH; ++layer) {
        const int pb = 1 + 9 * layer;
        if (IN(pb + 0)) RUN(1, ph_p1(lds, wv, layer));
        SEAM(pb + 0);
        if (IN(pb + 1)) RUN(2, ph_p2(lds, wv, layer));
        SEAM(pb + 1);
        if (IN(pb + 2)) RUN(3, ph_p3a(lds, wv, layer));
        SEAM(pb + 2);
        if (IN(pb + 3)) RUN(4, ph_p3b(lds, wv));
        SEAM(pb + 3);
        if (IN(pb + 4)) RUN(5, ph_p3c(lds, wv, layer));
        SEAM(pb + 4);
        if (IN(pb + 5)) RUN(6, ph_p4(lds, wv, layer));
        SEAM(pb + 5);
        if (IN(pb + 6)) RUN(7, ph_p5(lds, wv, layer));
        SEAM(pb + 6);
        if (IN(pb + 7)) RUN(9, ph_p7(lds, wv, layer));
        SEAM(pb + 7);
        if (IN(pb + 8)) RUN(10, ph_p8(lds, wv, layer));
        SEAM(pb + 8);
    }
    if (IN(NPHASE - 1)) RUN(11, ph_final(lds, wv));
#undef IN
#undef SEAM
}

#ifndef MK_SINGLE
#define MK_SINGLE 1
#endif
extern "C" void kernel_launch(void* const* d_in, const int* in_sizes, int n_in, void* d_out, int out_size, void* d_ws, size_t ws_size, hipStream_t stream) {
    static int grid = 0;
    if (grid == 0) {
        if (n_in != 21 || in_sizes[0] != MTOK * D || out_size != MTOK * D || ws_size < WS_END) { fprintf(stderr, "kernel_launch: unexpected problem shape (n_in %d, in0 %d, out %d, ws %zu)\n", n_in, n_in > 0 ? in_sizes[0] : -1, out_size, ws_size); grid = -1; return; }
        int dev = 0, cus = 0, per_cu = 0;
        if (hipGetDevice(&dev) != hipSuccess || hipDeviceGetAttribute(&cus, hipDeviceAttributeMultiprocessorCount, dev) != hipSuccess) { grid = -1; return; }
        if (hipFuncSetAttribute((const void*)hybrid_fwd, hipFuncAttributeMaxDynamicSharedMemorySize, LDS_BYTES) != hipSuccess) { fprintf(stderr, "kernel_launch: hipFuncSetAttribute failed\n"); grid = -1; return; }
        if (hipOccupancyMaxActiveBlocksPerMultiprocessor(&per_cu, (const void*)hybrid_fwd, NTHR, LDS_BYTES) != hipSuccess || per_cu < 1) fprintf(stderr, "kernel_launch: occupancy query says %d\n", per_cu);
        (void)hipGetLastError();
        grid = cus;
    }
    if (grid < 0) return;
    (void)hipMemsetAsync((char*)d_ws + WS_CTL, 0, CTL_ZERO_BYTES, stream);
    Args a{};
    a.x = (const float*)d_in[0]; a.c = (const float*)d_in[1]; a.pos = (const int*)d_in[2]; a.w_mod = (const float*)d_in[3]; a.b_mod = (const float*)d_in[4]; a.norm1_w = (const float*)d_in[5];
    a.w_in = (const float*)d_in[6]; a.gla_wa2 = (const float*)d_in[7]; a.gla_ba2 = (const float*)d_in[8]; a.hg_lb = (const float*)d_in[9]; a.gla_norm_w = (const float*)d_in[10]; a.hg_norm_w = (const float*)d_in[11];
    a.w_out = (const float*)d_in[12]; a.norm2_w = (const float*)d_in[13]; a.w_r = (const float*)d_in[14]; a.b_r = (const float*)d_in[15]; a.w_gu = (const float*)d_in[16]; a.b_gu = (const float*)d_in[17];
    a.w_dn = (const float*)d_in[18]; a.b_dn = (const float*)d_in[19]; a.final_norm_w = (const float*)d_in[20]; a.out = (float*)d_out; a.ws = (unsigned char*)d_ws;
#if MK_SINGLE
    a.ph_lo = 0; a.ph_hi = NPHASE;
    hipLaunchKernelGGL(hybrid_fwd, dim3(grid), dim3(NTHR), LDS_BYTES, stream, a);
#else
    for (int p = 0; p < NPHASE; ++p) { a.ph_lo = p; a.ph_hi = p + 1; hipLaunchKernelGGL(hybrid_fwd, dim3(grid), dim3(NTHR), LDS_BYTES, stream, a); }
#endif
}
```

```cpp
#include <hip/hip_runtime.h>
#include <cstdio>
#include <cstdint>
namespace pg8 {
#define PG8_LAS __attribute__((address_space(3)))
typedef unsigned short bf16_t;
typedef short bf16x8 __attribute__((ext_vector_type(8)));
typedef float f32x4 __attribute__((ext_vector_type(4)));
typedef unsigned u32x4 __attribute__((ext_vector_type(4)));
constexpr int BM = 256, BK = 64, HALF = 128, HTB = HALF * BK * 2  , STAGE_BYTES = 8 * HTB, NXCD = 8, WGM = 8;

__host__ __device__ __forceinline__ int lds_byte(int r, int c) { const int st = (r >> 4) * 2 + (c >> 5), rr = r & 15, cc = c & 31, ob = rr * 64 + cc * 2; return st * 1024 + (ob ^ (((ob >> 9) & 1) << 5)); }
__host__ __device__ __forceinline__ void stage_rc(int b, int& R, int& C) { const int st = b / 1024, sb = b % 1024, swz = sb ^ (((sb >> 9) & 1) << 5); R = (st >> 1) * 16 + swz / 64; C = (st & 1) * 32 + (swz % 64) / 2; }
__host__ __device__ __forceinline__ int perm32(int rho) { const int n = rho >> 4, i = rho & 15; return 8 * (i >> 2) + 4 * n + (i & 3); }

struct Unit { int pm, pn, e, pl; };
struct Gemm { const bf16_t* A; const bf16_t* Bt; int M, N, K; };

struct StaticOrder {
    int nM, nN, nwg, G, c;
    __host__ __device__ void init(int M, int N, int G_, int c_) { nM = M / BM; nN = N / BM; nwg = nM * nN; G = G_; c = c_; }
    __host__ __device__ bool next(int i, Unit& u) const {
        const long L = (long)i * G + c; if (L >= nwg) return false;
        int wgid = (int)L; { const int q = nwg / NXCD, r = nwg % NXCD, xcd = wgid % NXCD, off = wgid / NXCD; wgid = (xcd < r ? xcd * (q + 1) : r * (q + 1) + (xcd - r) * q) + off; }
        const int nig = WGM * nN, gid = wgid / nig, fm = gid * WGM, gsz = (nM - fm) < WGM ? (nM - fm) : WGM;
        u.pm = fm + ((wgid % nig) % gsz); u.pn = (wgid % nig) / gsz; u.e = 0; u.pl = u.pn; return true;
    }
    __device__ __forceinline__ void a_ready(const Unit&) const {}
    __device__ __forceinline__ void done(const Unit&) const {}
};

__device__ __forceinline__ unsigned cvt_pk_bf16(float lo, float hi) { unsigned r; asm volatile("v_cvt_pk_bf16_f32 %0, %1, %2" : "=v"(r) : "v"(lo), "v"(hi)); return r; }

#define PG8_GAS __attribute__((address_space(1)))
struct NoPre {};
struct EpiBf16Plain {
    static constexpr bool PERM = true, AFTER_DRAIN = false; static constexpr int NST = 0; typedef NoPre Pre;
    __device__ __forceinline__ Pre prefetch(const Unit&, int, int) const { return Pre{}; }
    bf16_t* O; int ldc; float sc;
    __device__ __forceinline__ void operator()(const f32x4 (&acc)[2][2][4][2], const Unit& u, int wr, int wc, int fr, int fq, const Pre&) const {
        const int row0 = u.pm * BM + wr * 64 + fr; const int col0 = u.pn * BM + wc * 32 + 8 * fq;
#pragma unroll
        for (int ai = 0; ai < 2; ++ai)
#pragma unroll
            for (int m = 0; m < 4; ++m) { bf16_t* rowp = O + (size_t)(row0 + ai * HALF + m * 16) * ldc + col0;
#pragma unroll
                for (int bj = 0; bj < 2; ++bj) { const f32x4 v0 = acc[ai][bj][m][0] * sc, v1 = acc[ai][bj][m][1] * sc;
                    u32x4 w; w.x = cvt_pk_bf16(v0[0], v0[1]); w.y = cvt_pk_bf16(v0[2], v0[3]); w.z = cvt_pk_bf16(v1[0], v1[1]); w.w = cvt_pk_bf16(v1[2], v1[3]);
                    *(PG8_GAS u32x4*)(rowp + bj * HALF) = w; } }
    }
};
struct EpiResGate {
    static constexpr bool PERM = true, AFTER_DRAIN = false; static constexpr int NST = 0; typedef NoPre Pre;
    __device__ __forceinline__ Pre prefetch(const Unit&, int, int) const { return Pre{}; }
    const bf16_t* base; bf16_t* out; int ldc; const float* gate; int gpitch; int rows_per_batch; float sc;
    __device__ __forceinline__ void operator()(const f32x4 (&acc)[2][2][4][2], const Unit& u, int wr, int wc, int fr, int fq, const Pre&) const {
        const int row0 = u.pm * BM + wr * 64 + fr, col0 = u.pn * BM + wc * 32 + 8 * fq;
        const float* gp = gate + (size_t)((u.pm * BM) / rows_per_batch) * gpitch + col0;
        f32x4 gv[2][2];
#pragma unroll
        for (int bj = 0; bj < 2; ++bj)
#pragma unroll
            for (int n = 0; n < 2; ++n) gv[bj][n] = *(const PG8_GAS f32x4*)(gp + bj * HALF + 4 * n) * sc;
#pragma unroll
        for (int ai = 0; ai < 2; ++ai)
#pragma unroll
            for (int m = 0; m < 4; ++m) { const size_t off = (size_t)(row0 + ai * HALF + m * 16) * ldc + col0;
#pragma unroll
                for (int bj = 0; bj < 2; ++bj) { const u32x4 bs = *(const PG8_GAS u32x4*)(base + off + bj * HALF); const unsigned bw[4] = {bs.x, bs.y, bs.z, bs.w}; float r[8];
#pragma unroll
                    for (int j = 0; j < 4; ++j) { const f32x4& a4 = acc[ai][bj][m][j >> 1]; const f32x4& g4 = gv[bj][j >> 1];
                        r[2 * j] = __builtin_bit_cast(float, bw[j] << 16) + g4[2 * (j & 1)] * a4[2 * (j & 1)]; r[2 * j + 1] = __builtin_bit_cast(float, bw[j] & 0xffff0000u) + g4[2 * (j & 1) + 1] * a4[2 * (j & 1) + 1]; }
                    u32x4 w; w.x = cvt_pk_bf16(r[0], r[1]); w.y = cvt_pk_bf16(r[2], r[3]); w.z = cvt_pk_bf16(r[4], r[5]); w.w = cvt_pk_bf16(r[6], r[7]);
                    *(PG8_GAS u32x4*)(out + off + bj * HALF) = w; }
                asm volatile("" ::: "memory"); }
    }
};
struct EpiSwiglu {
    static constexpr bool PERM = true, AFTER_DRAIN = false; static constexpr int NST = 0; struct Pre { f32x4 bg[2], bu[2]; };
    __device__ __forceinline__ Pre prefetch(const Unit& u, int wc, int fq) const { typedef const __attribute__((address_space(1))) f32x4 gf4;
        const float* bp = bias + (size_t)u.e * 2048 + u.pl * HALF + wc * 32 + 8 * fq; Pre p; p.bg[0] = *(gf4*)bp; p.bg[1] = *(gf4*)(bp + 4); p.bu[0] = *(gf4*)(bp + 1024); p.bu[1] = *(gf4*)(bp + 1028); return p; }
    unsigned char* O; int ldc; const float* bias; float inv_in, out_scale;
    __device__ __forceinline__ float act1(float g, float up) const {
        g = fminf(g, 7.0f); up = fminf(fmaxf(up, -7.0f), 7.0f);
        const float s = __builtin_amdgcn_rcpf(1.0f + __builtin_amdgcn_exp2f(-1.702f * 1.4426950408889634f * g));
        return (up + 1.0f) * g * s * out_scale;
    }
    __device__ __forceinline__ void operator()(const f32x4 (&acc)[2][2][4][2], const Unit& u, int wr, int wc, int fr, int fq, const Pre& pre) const {
        const int row0 = u.pm * BM + wr * 64 + fr; const int jj0 = wc * 32 + 8 * fq; const int col0 = u.pl * HALF + jj0;
        const f32x4 bg[2] = {pre.bg[0], pre.bg[1]}, bu[2] = {pre.bu[0], pre.bu[1]};
#pragma unroll
        for (int ai = 0; ai < 2; ++ai)
#pragma unroll
            for (int m = 0; m < 4; ++m) { unsigned char* rowp = O + (size_t)(row0 + ai * HALF + m * 16) * ldc + col0;
                f32x4 r[2];
#pragma unroll
                for (int n = 0; n < 2; ++n) { const f32x4 g = acc[ai][0][m][n] * inv_in + bg[n], up = acc[ai][1][m][n] * inv_in + bu[n];
#pragma unroll
                    for (int j = 0; j < 4; ++j) r[n][j] = act1(g[j], up[j]); }
                int w0 = 0, w1 = 0;
                w0 = __builtin_amdgcn_cvt_pk_fp8_f32(r[0][0], r[0][1], w0, false); w0 = __builtin_amdgcn_cvt_pk_fp8_f32(r[0][2], r[0][3], w0, true);
                w1 = __builtin_amdgcn_cvt_pk_fp8_f32(r[1][0], r[1][1], w1, false); w1 = __builtin_amdgcn_cvt_pk_fp8_f32(r[1][2], r[1][3], w1, true);
                typedef int i32x2 __attribute__((ext_vector_type(2))); *(PG8_GAS i32x2*)rowp = (i32x2){w0, w1}; }
    }
};
struct EpiBf16Bias {
    static constexpr bool PERM = true, AFTER_DRAIN = false; static constexpr int NST = 0; typedef NoPre Pre;
    __device__ __forceinline__ Pre prefetch(const Unit&, int, int) const { return Pre{}; }
    bf16_t* O; int ldc; const float* bias; int bpitch; float inv_in;
    __device__ __forceinline__ void operator()(const f32x4 (&acc)[2][2][4][2], const Unit& u, int wr, int wc, int fr, int fq, const Pre&) const {
        const int row0 = u.pm * BM + wr * 64 + fr; const int col0 = u.pl * BM + wc * 32 + 8 * fq;
        const float* bp = bias + (size_t)u.e * bpitch + col0;
        f32x4 bv[2][2];
#pragma unroll
        for (int bj = 0; bj < 2; ++bj)
#pragma unroll
            for (int n = 0; n < 2; ++n) bv[bj][n] = *(const PG8_GAS f32x4*)(bp + bj * HALF + 4 * n);
#pragma unroll
        for (int ai = 0; ai < 2; ++ai)
#pragma unroll
            for (int m = 0; m < 4; ++m) { bf16_t* rowp = O + (size_t)(row0 + ai * HALF + m * 16) * ldc + col0;
#pragma unroll
                for (int bj = 0; bj < 2; ++bj) { const f32x4 v0 = acc[ai][bj][m][0] * inv_in + bv[bj][0], v1 = acc[ai][bj][m][1] * inv_in + bv[bj][1];
                    u32x4 w; w.x = cvt_pk_bf16(v0[0], v0[1]); w.y = cvt_pk_bf16(v0[2], v0[3]); w.z = cvt_pk_bf16(v1[0], v1[1]); w.w = cvt_pk_bf16(v1[2], v1[3]);
                    *(PG8_GAS u32x4*)(rowp + bj * HALF) = w; } }
    }
};
struct EpiFp8Bias {
    static constexpr bool PERM = true, AFTER_DRAIN = false; static constexpr int NST = 0; struct Pre { f32x4 bv[2][2]; };
    __device__ __forceinline__ Pre prefetch(const Unit& u, int wc, int fq) const { typedef const __attribute__((address_space(1))) f32x4 gf4;
        const float* bp = bias + (size_t)u.e * bpitch + u.pl * BM + wc * 32 + 8 * fq; Pre p; p.bv[0][0] = *(gf4*)bp; p.bv[0][1] = *(gf4*)(bp + 4); p.bv[1][0] = *(gf4*)(bp + HALF); p.bv[1][1] = *(gf4*)(bp + HALF + 4); return p; }
    unsigned char* O; int ldc; const float* bias; int bpitch; float inv_in, out_scale;
    __device__ __forceinline__ int pk4(f32x4 v) const { int w = 0; w = __builtin_amdgcn_cvt_pk_fp8_f32(__builtin_amdgcn_fmed3f(v[0], -448.f, 448.f), __builtin_amdgcn_fmed3f(v[1], -448.f, 448.f), w, false);
        return __builtin_amdgcn_cvt_pk_fp8_f32(__builtin_amdgcn_fmed3f(v[2], -448.f, 448.f), __builtin_amdgcn_fmed3f(v[3], -448.f, 448.f), w, true); }
    __device__ __forceinline__ void operator()(const f32x4 (&acc)[2][2][4][2], const Unit& u, int wr, int wc, int fr, int fq, const Pre& pre) const {
        const int row0 = u.pm * BM + wr * 64 + fr; const int col0 = u.pl * BM + wc * 32 + 8 * fq;
        const f32x4 bv[2][2] = {{pre.bv[0][0], pre.bv[0][1]}, {pre.bv[1][0], pre.bv[1][1]}};
#pragma unroll
        for (int ai = 0; ai < 2; ++ai)
#pragma unroll
            for (int m = 0; m < 4; ++m) { unsigned char* rowp = O + (size_t)(row0 + ai * HALF + m * 16) * ldc + col0;
#pragma unroll
                for (int bj = 0; bj < 2; ++bj) { const f32x4 v0 = (acc[ai][bj][m][0] * inv_in + bv[bj][0]) * out_scale, v1 = (acc[ai][bj][m][1] * inv_in + bv[bj][1]) * out_scale;
                    typedef int i32x2 __attribute__((ext_vector_type(2))); *(PG8_GAS i32x2*)(rowp + bj * HALF) = (i32x2){pk4(v0), pk4(v1)}; } }
    }
};
struct MoeOrder {
    int nN, G, c, nunits; const PG8_LAS int* tile_pm;
    __device__ __forceinline__ bool next(int i, Unit& u) const {
        const int L = i * G + c; if (L >= nunits) return false;
        const int idx = L / nN, pl = L - idx * nN, pm = __builtin_amdgcn_readfirstlane(tile_pm[idx]), e = pm >> 6;
        u.pm = pm; u.pl = pl; u.e = e; u.pn = e * nN + pl; return true;
    }
    __device__ __forceinline__ void a_ready(const Unit&) const {}
    __device__ __forceinline__ void done(const Unit&) const {}
};
typedef int v4i32_t __attribute__((ext_vector_type(4)));
typedef int v8i32_t __attribute__((ext_vector_type(8)));
template <class Epi, class Sched, bool ALIGN_EPI = false, bool SP2 = false, bool FP8 = false>
__device__ __forceinline__ void gemm_phase(PG8_LAS unsigned char* lds, const Gemm g, const Sched& S, const Epi& E, int tid_in) {
    int tid_ = tid_in; asm volatile("" : "+v"(tid_)); const int tid = tid_, wid = __builtin_amdgcn_readfirstlane(tid >> 6), lane = tid & 63, wr = wid >> 2, wc = wid & 3, fr = lane & 15, fq = lane >> 4;
    const int K = g.K, nt = K / BK;
    unsigned voffA, voffB;
    { int R, C; stage_rc(tid * 16, R, C); const int Rb = Epi::PERM ? ((R & ~31) + perm32(R & 31)) : R;
        voffA = (unsigned)(R * K + C) * 2u; voffB = (unsigned)(Rb * K + C) * 2u; }
    const size_t rstep = (size_t)64 * K * 2;
    const size_t kstep = (size_t)(BK * 2);
    const size_t hstep = (size_t)HALF * K * 2;
    const size_t tstep = 2 * hstep;
    const unsigned ldsw = (unsigned)wid * 1024u;
    const int aoff = lds_byte(wr * 64 + fr, fq * 8), boff = lds_byte(wc * 32 + fr, fq * 8);
#define PG8_SA(b, h) (((b) * 2 + (h)) * HTB)
#define PG8_SB(b, h) ((4 + (b) * 2 + (h)) * HTB)
#define PG8_STAGE(bufoff, gbase, voff) do { _Pragma("unroll") for (int _i = 0; _i < 2; ++_i) \
        __builtin_amdgcn_global_load_lds((const unsigned*)((const char*)(gbase) + _i * rstep + (voff)), (PG8_LAS unsigned*)(lds + (bufoff) + ldsw + _i * 8192), 16, 0, 0); } while (0)
#define PG8_LDA(dst, b, h) do { _Pragma("unroll") for (int m = 0; m < 4; ++m) _Pragma("unroll") for (int k = 0; k < 2; ++k) dst[m][k] = *(const PG8_LAS bf16x8*)(lds + PG8_SA(b, h) + aoff + m * 2048 + k * 1024); } while (0)
#define PG8_LDB(dst, b, h) do { _Pragma("unroll") for (int n = 0; n < 2; ++n) _Pragma("unroll") for (int k = 0; k < 2; ++k) dst[n][k] = *(const PG8_LAS bf16x8*)(lds + PG8_SB(b, h) + boff + n * 2048 + k * 1024); } while (0)
#define PG8_MMA(ai, bj, At, Bt) do { __builtin_amdgcn_s_setprio(1); _Pragma("unroll") for (int m = 0; m < 4; ++m) _Pragma("unroll") for (int n = 0; n < 2; ++n) { \
        if constexpr (FP8) { const v8i32_t a8_ = __builtin_shufflevector(__builtin_bit_cast(v4i32_t, At[m][0]), __builtin_bit_cast(v4i32_t, At[m][1]), 0, 1, 2, 3, 4, 5, 6, 7); \
            const v8i32_t b8_ = __builtin_shufflevector(__builtin_bit_cast(v4i32_t, Bt[n][0]), __builtin_bit_cast(v4i32_t, Bt[n][1]), 0, 1, 2, 3, 4, 5, 6, 7); \
            asm volatile("v_mfma_scale_f32_16x16x128_f8f6f4 %0, %1, %2, %0, %3, %3 op_sel_hi:[0,0,0]" : "+v"(acc[ai][bj][m][n]) : "v"(b8_), "v"(a8_), "v"(one8_)); } \
        else { _Pragma("unroll") for (int k = 0; k < 2; ++k) acc[ai][bj][m][n] = __builtin_amdgcn_mfma_f32_16x16x32_bf16(Bt[n][k], At[m][k], acc[ai][bj][m][n], 0, 0, 0); } } \
        __builtin_amdgcn_s_setprio(0); } while (0)
#define PG8_WAIT_V(n) asm volatile("s_waitcnt vmcnt(" #n ")" ::: "memory")
#define PG8_WAIT_L(n) asm volatile("s_waitcnt lgkmcnt(" #n ")" ::: "memory")
#define PG8_WAIT_V8R(relax) do { if (relax) { if constexpr (Epi::NST == 8) PG8_WAIT_V(16); else if constexpr (Epi::NST == 16) PG8_WAIT_V(24); else PG8_WAIT_V(8); } else PG8_WAIT_V(8); } while (0)
#define PG8_BAR __builtin_amdgcn_s_barrier()
#define PG8_SCHED __builtin_amdgcn_sched_barrier(0)
    Unit cur, nxt; int ui = 0;
    if (!S.next(0, cur)) return;
    f32x4 acc[2][2][4][2];
#pragma unroll
    for (int a = 0; a < 2; ++a)
#pragma unroll
        for (int b = 0; b < 2; ++b)
#pragma unroll
            for (int m = 0; m < 4; ++m)
#pragma unroll
                for (int n = 0; n < 2; ++n) acc[a][b][m][n] = (f32x4){0.f, 0.f, 0.f, 0.f};
    bf16x8 At[4][2], B0[2][2], B1[2][2];
    int one8_ = 0x7f7f7f7f; asm volatile("" : "+v"(one8_));
    const char* cA = (const char*)g.A + (size_t)cur.pm * tstep; const char* cB = (const char*)g.Bt + (size_t)cur.pn * tstep;
    S.a_ready(cur);
    if constexpr (SP2) {
        PG8_STAGE(PG8_SB(0, 0), cB, voffB); PG8_STAGE(PG8_SB(0, 1), cB + hstep, voffB); PG8_STAGE(PG8_SA(0, 0), cA, voffA); PG8_STAGE(PG8_SA(0, 1), cA + hstep, voffA);
        if (wr == 1) PG8_BAR;
        PG8_WAIT_V(2); PG8_BAR;
        PG8_STAGE(PG8_SB(1, 0), cB + kstep, voffB); PG8_STAGE(PG8_SA(1, 0), cA + kstep, voffA); PG8_STAGE(PG8_SB(1, 1), cB + hstep + kstep, voffB);
        PG8_WAIT_V(6); PG8_BAR;
    } else {
        PG8_STAGE(PG8_SB(0, 0), cB, voffB); PG8_STAGE(PG8_SA(0, 0), cA, voffA); PG8_STAGE(PG8_SB(0, 1), cB + hstep, voffB); PG8_STAGE(PG8_SA(0, 1), cA + hstep, voffA);
        if (wr == 1) PG8_BAR;
        PG8_WAIT_V(4); PG8_BAR;
        PG8_STAGE(PG8_SB(1, 0), cB + kstep, voffB); PG8_STAGE(PG8_SA(1, 0), cA + kstep, voffA); PG8_STAGE(PG8_SB(1, 1), cB + hstep + kstep, voffB);
        PG8_WAIT_V(6); PG8_BAR;
    }
    for (;;) {
        const bool has_next = S.next(ui + 1, nxt);
        typename Epi::Pre pre_; { int lp_ = (int)__builtin_amdgcn_mbcnt_hi(~0u, __builtin_amdgcn_mbcnt_lo(~0u, 0u)); asm volatile("" : "+v"(lp_)); pre_ = E.prefetch(cur, wc, lp_ >> 4); }
        const char* nA = has_next ? (const char*)g.A + (size_t)nxt.pm * tstep : cA; const char* nB = has_next ? (const char*)g.Bt + (size_t)nxt.pn * tstep : cB;
#pragma unroll 1
        for (int t = 0; t < nt; t += 2) {
            const bool last = (t == nt - 2);
            const char* a1 = cA + (size_t)(t + 1) * kstep;
            const char* a2 = last ? nA : cA + (size_t)(t + 2) * kstep; const char* b2 = last ? nB : cB + (size_t)(t + 2) * kstep;
            const char* a3 = a2 + kstep; const char* b3 = b2 + kstep;
            if (last && has_next) S.a_ready(nxt);
            const bool relax = (Epi::NST > 0) && (ui > 0) && (t == 0);
            if constexpr (SP2) {
            PG8_LDB(B0, 0, 0); PG8_LDB(B1, 0, 1); PG8_SCHED; PG8_LDA(At, 0, 0); PG8_STAGE(PG8_SA(1, 1), a1 + hstep, voffA);
            PG8_WAIT_V8R(relax); PG8_WAIT_L(0); PG8_BAR; PG8_MMA(0, 0, At, B0); PG8_MMA(0, 1, At, B1); PG8_BAR; PG8_SCHED;
            PG8_LDA(At, 0, 1); PG8_STAGE(PG8_SB(0, 0), b2, voffB); PG8_STAGE(PG8_SB(0, 1), b2 + hstep, voffB); PG8_STAGE(PG8_SA(0, 0), a2, voffA);
            PG8_WAIT_V8R(relax); PG8_WAIT_L(0); PG8_BAR; PG8_MMA(1, 0, At, B0); PG8_MMA(1, 1, At, B1); PG8_BAR; PG8_SCHED;
            PG8_LDB(B0, 1, 0); PG8_LDB(B1, 1, 1); PG8_SCHED; PG8_LDA(At, 1, 0); PG8_STAGE(PG8_SA(0, 1), a2 + hstep, voffA);
            PG8_WAIT_V(8); PG8_WAIT_L(0); PG8_BAR; PG8_MMA(0, 0, At, B0); PG8_MMA(0, 1, At, B1); PG8_BAR; PG8_SCHED;
            PG8_LDA(At, 1, 1); PG8_STAGE(PG8_SB(1, 0), b3, voffB); PG8_STAGE(PG8_SB(1, 1), b3 + hstep, voffB); PG8_STAGE(PG8_SA(1, 0), a3, voffA);
            PG8_WAIT_V(8); PG8_WAIT_L(0); PG8_BAR; PG8_MMA(1, 0, At, B0); PG8_MMA(1, 1, At, B1); PG8_BAR; PG8_SCHED;
            } else {
            PG8_LDB(B0, 0, 0); PG8_SCHED; PG8_LDA(At, 0, 0); PG8_STAGE(PG8_SA(1, 1), a1 + hstep, voffA);
            PG8_WAIT_L(8); PG8_BAR; PG8_WAIT_L(0); PG8_MMA(0, 0, At, B0); PG8_BAR; PG8_SCHED;
            PG8_LDB(B1, 0, 1); PG8_STAGE(PG8_SB(0, 0), b2, voffB);
            PG8_BAR; PG8_WAIT_L(0); PG8_MMA(0, 1, At, B1); PG8_BAR;
            PG8_LDA(At, 0, 1); PG8_STAGE(PG8_SA(0, 0), a2, voffA);
            PG8_BAR; PG8_WAIT_L(0); PG8_MMA(1, 0, At, B0); PG8_BAR; PG8_SCHED;
            PG8_STAGE(PG8_SB(0, 1), b2 + hstep, voffB);
            PG8_WAIT_V(6); PG8_BAR; PG8_MMA(1, 1, At, B1); PG8_BAR;
            PG8_LDB(B0, 1, 0); PG8_SCHED; PG8_LDA(At, 1, 0); PG8_STAGE(PG8_SA(0, 1), a2 + hstep, voffA);
            PG8_WAIT_L(8); PG8_BAR; PG8_WAIT_L(0); PG8_MMA(0, 0, At, B0); PG8_BAR; PG8_SCHED;
            PG8_LDB(B1, 1, 1); PG8_STAGE(PG8_SB(1, 0), b3, voffB);
            PG8_BAR; PG8_WAIT_L(0); PG8_MMA(0, 1, At, B1); PG8_BAR;
            PG8_LDA(At, 1, 1); PG8_STAGE(PG8_SA(1, 0), a3, voffA);
            PG8_BAR; PG8_WAIT_L(0); PG8_MMA(1, 0, At, B0); PG8_BAR; PG8_SCHED;
            PG8_STAGE(PG8_SB(1, 1), b3 + hstep, voffB);
            PG8_WAIT_V(6); PG8_BAR; PG8_MMA(1, 1, At, B1); PG8_BAR;
            }
        }
        if constexpr (FP8) asm volatile("s_nop 7\n\ts_nop 7" ::: "memory");
        if constexpr (ALIGN_EPI) { if (wr == 0) PG8_BAR; }
        if constexpr (!Epi::AFTER_DRAIN) { int ln_ = (int)__builtin_amdgcn_mbcnt_hi(~0u, __builtin_amdgcn_mbcnt_lo(~0u, 0u)); asm volatile("" : "+v"(ln_)); E(acc, cur, wr, wc, ln_ & 15, ln_ >> 4, pre_); S.done(cur); }
        if (!has_next) break;
#pragma unroll
        for (int a = 0; a < 2; ++a)
#pragma unroll
            for (int b = 0; b < 2; ++b)
#pragma unroll
                for (int m = 0; m < 4; ++m)
#pragma unroll
                    for (int n = 0; n < 2; ++n) acc[a][b][m][n] = (f32x4){0.f, 0.f, 0.f, 0.f};
        cur = nxt; cA = nA; cB = nB; ++ui;
        if constexpr (ALIGN_EPI) { if (wr == 1) PG8_BAR; }
    }
    PG8_WAIT_V(0);
    if constexpr (!ALIGN_EPI) { if (wr == 0) PG8_BAR; }
    PG8_BAR;
    if constexpr (Epi::AFTER_DRAIN) { E.fused(acc, cur, wr, wc, fr, fq, lds, wid, lane); S.done(cur); }
#undef PG8_SA
#undef PG8_SB
#undef PG8_STAGE
#undef PG8_LDA
#undef PG8_LDB
#undef PG8_MMA
#undef PG8_WAIT_V
#undef PG8_WAIT_L
#undef PG8_BAR
#undef PG8_SCHED
}
}

constexpr int NWAVES = 8, NTHR = 512;
constexpr int BATCH = 2, SEQ = 8192, D = 1024, DEPTH = 4, MTOK = BATCH * SEQ;
constexpr int DIN = 3344, NPROJ = 3328, SRC_GA = 1152;
constexpr int C_GQ = 0, C_GK = 192, C_GV = 384, C_GG = 768, C_HQ = 1152, C_HF = 1408, C_HI = 1664, C_HG = 1920, C_RQ = 2176, C_RK = 2368, C_RV = 2560, C_RG = 2944;
constexpr int NE = 32, FFN = 1024;
constexpr int CH = 64, NCH = SEQ / CH, NUNIT = BATCH * NCH;
constexpr int ST_GLA = 0, ST_HG = 4 * 48 * 96, ST_RET = ST_HG + 4 * 64 * 64, ST_TOT = ST_RET + 4 * 48 * 96;
constexpr int NDV = 448, NKT = 640;
constexpr int MAXROWS = 65536 + NE * 256, MAXRT = MAXROWS / 256;
constexpr float EPS = 1e-6f;
#ifndef F8_IN_V
#define F8_IN_V false
#endif
#ifndef F8_OUT_V
#define F8_OUT_V false
#endif
constexpr bool F8_IN = F8_IN_V, F8_OUT = F8_OUT_V;
#ifndef Y8_V
#define Y8_V true
#endif
constexpr bool Y8 = Y8_V;
constexpr float S8_Y = 16.f;
constexpr float S8_M = 32.f;
constexpr float S8_W = 2048.f, S8_H = 64.f, S8_A = 8.f;
constexpr int NPHASE = 38;
constexpr int ECAP = 16384, ECAP_SH = 14;

constexpr size_t MiB = 1u << 20;
constexpr size_t WS_CTL = 0, CTL_ZERO_BYTES = 65536;
constexpr size_t WS_MOD = 1 * MiB;
constexpr size_t WS_ROPE = 2 * MiB;
constexpr size_t WS_LB = 5 * MiB;
constexpr size_t WS_WIN = 8 * MiB;
constexpr size_t WS_WOUT = 34 * MiB;
constexpr size_t WS_WGU = 42 * MiB;
constexpr size_t WS_WDN = 554 * MiB;
constexpr size_t WS_X = 810 * MiB;
constexpr size_t WS_H = 874 * MiB;
constexpr size_t WS_GA = 906 * MiB;
constexpr size_t WS_PROJ = 907 * MiB;
constexpr size_t WS_U = 1011 * MiB;
constexpr size_t WS_DVEC = 1063 * MiB;
constexpr size_t WS_SP = 1064 * MiB;
constexpr size_t WS_MIX = 1090 * MiB;
constexpr size_t WS_TOPE = 1122 * MiB;
constexpr size_t WS_TOPW = WS_TOPE + 256 * 1024;
constexpr size_t WS_SLOT = WS_TOPW + 256 * 1024;
constexpr size_t WS_A1 = 1123 * MiB;
constexpr size_t WS_ACT = 1635 * MiB;
constexpr size_t WS_Y = 2147 * MiB;
constexpr size_t WS_CUM = 3171 * MiB;
constexpr size_t WS_KT = 3199 * MiB;
constexpr size_t WS_END = 3239 * MiB;
static_assert(WS_WIN + (size_t)DEPTH * NPROJ * D * 2 <= WS_WOUT && WS_PROJ + (size_t)MTOK * NPROJ * 2 <= WS_U && WS_U + (size_t)NUNIT * ST_TOT * 4 <= WS_DVEC && WS_SP + (size_t)NUNIT * ST_TOT * 2 <= WS_MIX && WS_A1 + (size_t)NE * ECAP * D <= WS_ACT && WS_ACT + (size_t)NE * ECAP * D <= WS_Y && WS_Y + (size_t)NE * ECAP * D * 2 <= WS_CUM, "ws map");
constexpr int CW_TMO = 0, CW_CODE = 1, CW_BAR = 4096, CW_CNT = 8192, CW_FILL = 8192 + 256;
constexpr int RING_BYTES = 131072;
constexpr int MISC_OFF = 147456, LDS_BYTES = MISC_OFF + 4096;
constexpr int MW_BAR = 0, MW_CNT = 16, MW_PST = 48, MW_HIST = 96, MW_BASE = 128, MW_TILE = 192, MW_NRT = 480, MW_SLOTS = 512;

#define GAS __attribute__((address_space(1)))
#define LAS __attribute__((address_space(3)))
typedef unsigned v4u __attribute__((ext_vector_type(4)));
typedef float f32x4 __attribute__((ext_vector_type(4)));
typedef short bf16x8 __attribute__((ext_vector_type(8)));
typedef GAS unsigned gu32;
typedef GAS unsigned long long gu64;
#define RLX_AGENT __ATOMIC_RELAXED, __HIP_MEMORY_SCOPE_AGENT
#define LDS_WAIT() asm volatile("s_waitcnt lgkmcnt(0)" ::: "memory")
#define VM_WAIT() asm volatile("s_waitcnt vmcnt(0)" ::: "memory")
__device__ __forceinline__ unsigned long long rt() { return __builtin_amdgcn_s_memrealtime(); }
typedef unsigned short bf16;
typedef float f32x2_t __attribute__((ext_vector_type(2))); typedef __bf16 bf16x2_t __attribute__((ext_vector_type(2)));
__device__ __forceinline__ unsigned pk2(float lo, float hi) { const f32x2_t v = {lo, hi}; return __builtin_bit_cast(unsigned, __builtin_convertvector(v, bf16x2_t)); }
__device__ __forceinline__ unsigned f2bf(float f) { return pk2(f, 0.f) & 0xffffu; }
__device__ __forceinline__ float bf2f(bf16 b) { return __builtin_bit_cast(float, (unsigned)b << 16); }
#define XB_TMO      128
#define XB_XCNT(j)  (256  + 64 * (j))
#define XB_XSUB(j)  (1280 + 64 * (j))
#define XB_XGEN(j)  (2304 + 64 * (j))
#define XB_TOP      3328
#define XB_TOPGEN   3392
#define XCD_BAR_WORDS 3456
#define XB_SPIN_CAP (1u << 18)

__device__ __forceinline__ unsigned xb_ld(unsigned* p)              { return __hip_atomic_load(p, __ATOMIC_RELAXED, __HIP_MEMORY_SCOPE_AGENT); }
__device__ __forceinline__ unsigned xb_add(unsigned* p, unsigned v) { return __hip_atomic_fetch_add(p, v, __ATOMIC_RELAXED, __HIP_MEMORY_SCOPE_AGENT); }
__device__ __forceinline__ unsigned xb_xcc_id() { return (unsigned)__builtin_amdgcn_s_getreg((3 << 11) | 20) & 0xFu; }
#define XB_SPIN(cond, bar) do { unsigned _sp = 0; while (cond) { __builtin_amdgcn_s_sleep(1); \
    if ((++_sp & 255u) == 0u) { if (xb_ld(&(bar)[XB_TMO])) break; if (_sp > XB_SPIN_CAP) { atomicAdd(&(bar)[XB_TMO], 1u); break; } } } } while (0)

struct XcdBarrier {
    unsigned* bar; unsigned x;
    volatile LAS unsigned* st;
};

__device__ __forceinline__ XcdBarrier xcd_barrier_post(unsigned* bar, volatile LAS unsigned* st) {
    XcdBarrier b; b.bar = bar; b.x = xb_xcc_id(); b.st = st;
    if (threadIdx.x == 0) (void)xb_add(&bar[XB_XCNT(b.x)], 1u);
    return b;
}
__device__ __forceinline__ void xcd_barrier_complete(unsigned* bar, unsigned x, unsigned& nloc, unsigned& nx) {
    const unsigned G = gridDim.x * gridDim.y * gridDim.z;
    unsigned sum, cnt, mine, sp = 0u;
    for (;;) {
        sum = 0u; cnt = 0u; mine = 0u;
#pragma unroll
        for (unsigned j = 0; j < 16; ++j) { const unsigned c = xb_ld(&bar[XB_XCNT(j)]); sum += c; cnt += (c > 0u) ? 1u : 0u; mine = (j == x) ? c : mine; }
        if (sum == G) break;
        __builtin_amdgcn_s_sleep(1);
        if ((++sp & 255u) == 0u) { if (xb_ld(&bar[XB_TMO])) break; if (sp > XB_SPIN_CAP) { atomicAdd(&bar[XB_TMO], 1u); break; } }
    }
    nloc = mine > 0u ? mine : 1u; nx = cnt > 0u ? cnt : 1u;
}

__device__ __forceinline__ void xcd_barrier(const XcdBarrier& b) {
    asm volatile("s_waitcnt vmcnt(0)" ::: "memory");
    __syncthreads();
    if (threadIdx.x == 0) {
        unsigned* bar = b.bar;
        __builtin_amdgcn_s_waitcnt(0);
        unsigned nloc = b.st[0], nx = b.st[1];
        if (nloc == 0u) { xcd_barrier_complete(bar, b.x, nloc, nx); b.st[0] = nloc; b.st[1] = nx; }
        const unsigned old = xb_add(&bar[XB_XSUB(b.x)], 1u);
        const unsigned gen = old / nloc;
        if (old + 1u == (gen + 1u) * nloc) {
            __builtin_amdgcn_fence(__ATOMIC_RELEASE, "agent");
            asm volatile("s_waitcnt vmcnt(0)" ::: "memory");
            const unsigned og = xb_add(&bar[XB_TOP], 1u);
            const unsigned tg = og / nx;
            if (og + 1u == (tg + 1u) * nx) xb_add(&bar[XB_TOPGEN], 1u);
            else XB_SPIN(xb_ld(&bar[XB_TOPGEN]) == tg, bar);
            __builtin_amdgcn_fence(__ATOMIC_ACQUIRE, "agent");
            xb_add(&bar[XB_XGEN(b.x)], 1u);
            asm volatile("s_waitcnt vmcnt(0)" ::: "memory");
        } else {
            XB_SPIN(xb_ld(&bar[XB_XGEN(b.x)]) == gen, bar);
            __builtin_amdgcn_fence(__ATOMIC_ACQUIRE, "agent");
            asm volatile("s_waitcnt vmcnt(0)" ::: "memory");
        }
    }
    __syncthreads();
}

__device__ __forceinline__ float wave_sum(float v) {
#pragma unroll
    for (int o = 1; o < 64; o <<= 1) v += __shfl_xor(v, o);
    return v;
}
__device__ __forceinline__ float log_sigmoid_f(float x) { return fminf(x, 0.f) - log1pf(expf(-fabsf(x))); }
__device__ __forceinline__ float silu_f(float x) { return x / (1.0f + expf(-x)); }
__device__ __forceinline__ float sigmoid_f(float x) { return 1.0f / (1.0f + expf(-x)); }
__device__ __forceinline__ pg8::bf16x8 ldfrag(const LAS bf16* base, int stride, int r0, int k0, int lane) {
    return *(const LAS pg8::bf16x8*)(base + (r0 + (lane & 15)) * stride + k0 + 8 * (lane >> 4));
}
__device__ __forceinline__ pg8::bf16x8 pack8(const float (&v)[8]) { v4u w; w.x = pk2(v[0], v[1]); w.y = pk2(v[2], v[3]); w.z = pk2(v[4], v[5]); w.w = pk2(v[6], v[7]); return __builtin_bit_cast(pg8::bf16x8, w); }

struct Args {
    const float* x; const float* c; const int* pos; const float* w_mod; const float* b_mod; const float* norm1_w; const float* w_in; const float* gla_wa2; const float* gla_ba2; const float* hg_lb;
    const float* gla_norm_w; const float* hg_norm_w; const float* w_out; const float* norm2_w; const float* w_r; const float* b_r; const float* w_gu; const float* b_gu; const float* w_dn; const float* b_dn;
    const float* final_norm_w; float* out; unsigned char* ws; int ph_lo, ph_hi;
};

__device__ __forceinline__ void transpose_block64(const float* src, int ld, bf16* dst, LAS float*, int lane) {
    const int n4 = lane & 15, kg = lane >> 4;
    f32x4 v[16];
#pragma unroll
    for (int i = 0; i < 16; ++i) v[i] = __builtin_nontemporal_load((const f32x4*)(src + (size_t)(16 * kg + i) * ld + 4 * n4));
#pragma unroll
    for (int j = 0; j < 4; ++j) { v4u o0, o1;
        o0.x = pk2(v[0][j], v[1][j]); o0.y = pk2(v[2][j], v[3][j]); o0.z = pk2(v[4][j], v[5][j]); o0.w = pk2(v[6][j], v[7][j]);
        o1.x = pk2(v[8][j], v[9][j]); o1.y = pk2(v[10][j], v[11][j]); o1.z = pk2(v[12][j], v[13][j]); o1.w = pk2(v[14][j], v[15][j]);
        bf16* d = dst + (size_t)(4 * n4 + j) * D + 16 * kg; *(GAS v4u*)d = o0; *(GAS v4u*)(d + 8) = o1; }
}
__device__ __forceinline__ float clamp448(float x) { return __builtin_amdgcn_fmed3f(x, -448.f, 448.f); }
__device__ __forceinline__ int pk4_fp8(float a, float b, float c, float d) { int w = 0; w = __builtin_amdgcn_cvt_pk_fp8_f32(clamp448(a), clamp448(b), w, false);
    return __builtin_amdgcn_cvt_pk_fp8_f32(clamp448(c), clamp448(d), w, true); }
__device__ __forceinline__ void transpose_block64_fp8(const float* src, int ld, unsigned char* dst, LAS float*, int lane, float sc) {
    const int n4 = lane & 15, kg = lane >> 4;
    f32x4 v[16];
#pragma unroll
    for (int i = 0; i < 16; ++i) v[i] = __builtin_nontemporal_load((const f32x4*)(src + (size_t)(16 * kg + i) * ld + 4 * n4)) * sc;
#pragma unroll
    for (int j = 0; j < 4; ++j) { v4u o;
        o.x = (unsigned)pk4_fp8(v[0][j], v[1][j], v[2][j], v[3][j]); o.y = (unsigned)pk4_fp8(v[4][j], v[5][j], v[6][j], v[7][j]);
        o.z = (unsigned)pk4_fp8(v[8][j], v[9][j], v[10][j], v[11][j]); o.w = (unsigned)pk4_fp8(v[12][j], v[13][j], v[14][j], v[15][j]);
        *(GAS v4u*)(dst + (size_t)(4 * n4 + j) * D + 16 * kg) = o; }
}
constexpr int IT_IN = 16 * (NPROJ / 64), IT_OUT = 16 * 16, IT_GU = NE * 16 * 32, IT_DN = NE * 16 * 16, IT_LAYER = IT_IN + IT_OUT + IT_GU + IT_DN, IT_ALL = DEPTH * IT_LAYER;
__device__ __forceinline__ void convert_item(const Args& a, int l, int r, LAS float* scr, int lane) {
    unsigned char* ws = a.ws;
    bf16* WIN = (bf16*)(ws + WS_WIN); bf16* WOUT = (bf16*)(ws + WS_WOUT); unsigned char* WGU = ws + WS_WGU; unsigned char* WDN = ws + WS_WDN;
    if (r < IT_IN) { const int kb = r / (NPROJ / 64), nb = r % (NPROJ / 64), n0 = 64 * nb, sc = n0 + (n0 >= SRC_GA ? 16 : 0);
        if (F8_IN) transpose_block64_fp8(a.w_in + ((size_t)l * D + 64 * kb) * DIN + sc, DIN, (unsigned char*)WIN + ((size_t)l * NPROJ + n0) * D + 64 * kb, scr, lane, S8_W);
        else transpose_block64(a.w_in + ((size_t)l * D + 64 * kb) * DIN + sc, DIN, WIN + ((size_t)l * NPROJ + n0) * D + 64 * kb, scr, lane); return; }
    r -= IT_IN;
    if (r < IT_OUT) { const int kb = r / 16, nb = r % 16;
        if (F8_OUT) transpose_block64_fp8(a.w_out + ((size_t)l * D + 64 * kb) * D + 64 * nb, D, (unsigned char*)WOUT + ((size_t)l * D + 64 * nb) * D + 64 * kb, scr, lane, S8_W);
        else transpose_block64(a.w_out + ((size_t)l * D + 64 * kb) * D + 64 * nb, D, WOUT + ((size_t)l * D + 64 * nb) * D + 64 * kb, scr, lane); return; }
    r -= IT_OUT;
    if (r < IT_GU) { const int e = r / 512, r2 = r % 512, kb = r2 / 32, nb = r2 % 32, cc = 64 * nb;
        const int row = (cc < 1024) ? 256 * (cc / 128) + (cc % 128) : 256 * ((cc - 1024) / 128) + 128 + ((cc - 1024) % 128);
        transpose_block64_fp8(a.w_gu + (((size_t)l * NE + e) * D + 64 * kb) * 2048 + cc, 2048, WGU + (((size_t)l * NE + e) * 2048 + row) * D + 64 * kb, scr, lane, S8_W); return; }
    r -= IT_GU;
    { const int e = r / 256, r2 = r % 256, kb = r2 / 16, nb = r2 % 16;
        transpose_block64_fp8(a.w_dn + (((size_t)l * NE + e) * FFN + 64 * kb) * D + 64 * nb, D, WDN + (((size_t)l * NE + e) * D + 64 * nb) * D + 64 * kb, scr, lane, S8_W); }
}
constexpr int CB2 = 4, CB7 = 2, CB8 = 2;
__device__ __forceinline__ int conv_t2(int G) { return (G == 256) ? 192 * NWAVES * CB2 : 0; }
__device__ __forceinline__ int conv_idle(int nunits, int G) { const int rem = nunits % G; return rem ? G - rem : 0; }
__device__ __forceinline__ void convert_range(const Args& a, int l, int first, int count, LAS unsigned char* lds, int lane, int wave) {
    LAS float* scr = (LAS float*)(lds + wave * 16640);
    for (int k = 0; k < count; ++k) { const int it = first + k; if (it < IT_LAYER) convert_item(a, l, it, scr, lane); }
}
__device__ __forceinline__ void p0_prologue(const Args& a, LAS unsigned char* lds, int vcu, int G, int tid, int lane, int wave) {
    unsigned char* ws = a.ws;
    LAS float* scr = (LAS float*)(lds + wave * 16640);
    const int gw = vcu * NWAVES + wave, NGW = G * NWAVES;
    for (int it = gw; it < IT_LAYER; it += NGW) convert_item(a, 0, it, scr, lane);
    __syncthreads();
    {
        LAS float* cact = (LAS float*)lds;
        LAS float* red = (LAS float*)(lds + 8192);
        for (int i = tid; i < 2 * D; i += NTHR) cact[i] = silu_f(a.c[i]);
        __syncthreads();
        float* MOD = (float*)(ws + WS_MOD);
        for (int it = vcu; it < DEPTH * 96; it += G) {
            const int l = it / 96, n0 = (it % 96) * 64;
            const float* wp = a.w_mod + ((size_t)l * D + 128 * wave) * 6144 + n0 + lane;
            float a0 = 0.f, a1 = 0.f;
#pragma unroll 32
            for (int k = 0; k < 128; ++k) { const float w = __builtin_nontemporal_load(wp + (size_t)k * 6144); a0 += cact[128 * wave + k] * w; a1 += cact[D + 128 * wave + k] * w; }
            red[(wave * 2 + 0) * 64 + lane] = a0; red[(wave * 2 + 1) * 64 + lane] = a1;
            __syncthreads();
            if (tid < 128) { const int b = tid >> 6, ln = tid & 63; float s = a.b_mod[l * 6144 + n0 + ln];
#pragma unroll
                for (int w = 0; w < 8; ++w) s += red[(w * 2 + b) * 64 + ln];
                MOD[((size_t)l * 2 + b) * 6144 + n0 + ln] = s; }
            __syncthreads();
        }
    }
    { const f32x4* xs = (const f32x4*)a.x; uint2* xd = (uint2*)(ws + WS_X);
        for (int i = vcu * NTHR + tid; i < MTOK * D / 4; i += G * NTHR) { const f32x4 v = xs[i]; uint2 p; p.x = pk2(v[0], v[1]); p.y = pk2(v[2], v[3]); xd[i] = p; } }
    {
        float* ROPE = (float*)(ws + WS_ROPE);
        for (int i = vcu * NTHR + tid; i < MTOK * 24; i += G * NTHR) { const int t = i / 24, f = i % 24;
            const float inv = (float)pow(10000.0, -(double)f / 24.0); const float ang = (float)a.pos[t] * inv;
            ROPE[(size_t)t * 48 + f] = cosf(ang); ROPE[(size_t)t * 48 + 24 + f] = sinf(ang); }
    }
    if (vcu == 0 && tid < 256) {
        float v[4], mx = -3.0e38f; for (int l = 0; l < 4; ++l) { v[l] = a.hg_lb[l * 256 + tid]; mx = fmaxf(mx, v[l]); }
        float s = 0.f; for (int l = 0; l < 4; ++l) { v[l] = expf(v[l] - mx); s += v[l]; }
        float* LB = (float*)(ws + WS_LB); float cs = 0.f, first = 0.f;
        for (int l = 0; l < 4; ++l) { cs += v[l] / s; if (l == 0) first = cs; LB[l * 256 + tid] = cs - first; }
    }
}

__device__ __forceinline__ void moe_combine_row(f32x4 (&v)[4], int m, const bf16* Y, const int* SLOT, const float* TOPW, const float* g2, int lane) {
    const int4 sl = *(const int4*)(SLOT + (size_t)m * 4); const f32x4 tw = *(const f32x4*)(TOPW + (size_t)m * 4);
    const int s[4] = {sl.x, sl.y, sl.z, sl.w};
    f32x4 acc[4];
#pragma unroll
    for (int j = 0; j < 4; ++j) acc[j] = (f32x4){0.f, 0.f, 0.f, 0.f};
#pragma unroll
    for (int k = 0; k < 4; ++k) { const bf16* yr = Y + (size_t)s[k] * D + 4 * lane; const float w = tw[k];
#pragma unroll
        for (int j = 0; j < 4; ++j) { const uint2 p = *(const uint2*)(yr + 256 * j);
            acc[j][0] += w * __builtin_bit_cast(float, p.x << 16); acc[j][1] += w * __builtin_bit_cast(float, p.x & 0xffff0000u);
            acc[j][2] += w * __builtin_bit_cast(float, p.y << 16); acc[j][3] += w * __builtin_bit_cast(float, p.y & 0xffff0000u); } }
#pragma unroll
    for (int j = 0; j < 4; ++j) { const f32x4 g = *(const f32x4*)(g2 + 4 * lane + 256 * j); v[j] = v[j] + g * acc[j]; }
}
__device__ __forceinline__ float row_rstd(const f32x4 (&v)[4]) {
    float s = 0.f;
#pragma unroll
    for (int j = 0; j < 4; ++j) s += (v[j][0] * v[j][0] + v[j][1] * v[j][1]) + (v[j][2] * v[j][2] + v[j][3] * v[j][3]);
    return 1.0f / sqrtf(wave_sum(s) * (1.0f / D) + EPS);
}
__device__ __forceinline__ void modulate_row(f32x4 (&v)[4], float rstd, const float* nw, const float* sc, const float* sh, bf16* hrow, int lane) {
#pragma unroll
    for (int j = 0; j < 4; ++j) { const int c0 = 4 * lane + 256 * j; const f32x4 w = *(const f32x4*)(nw + c0), s1 = *(const f32x4*)(sc + c0), s0 = *(const f32x4*)(sh + c0);
        v[j] = v[j] * rstd * w * (s1 + 1.0f) + s0;
        uint2 p; p.x = pk2(v[j][0], v[j][1]); p.y = pk2(v[j][2], v[j][3]); *(uint2*)(hrow + c0) = p; }
}


constexpr int LR_SLT = 142976, LR_TWL = 144000, LR_SSR = 145024;
__device__ __forceinline__ void stage_slots(const unsigned char* ws, int row0, LAS unsigned char* lds, int tid) {
    if (tid < 64) { *(LAS v4u*)(lds + LR_SLT + 16 * tid) = *(const v4u*)((const int*)(ws + WS_SLOT) + (size_t)(row0 + tid) * 4);
                    *(LAS f32x4*)(lds + LR_TWL + 16 * tid) = *(const f32x4*)((const float*)(ws + WS_TOPW) + (size_t)(row0 + tid) * 4); }
}
template <bool SS, bool OUTF32>
__device__ __forceinline__ void flat_combine(const bf16* xsrc, void* xdst, int row0, const bf16* Y, const float* g2, LAS unsigned char* lds, int tid, int lane) {
    static_assert(Y8, "expert outputs are stored as fp8");
    typedef float f32x2v __attribute__((ext_vector_type(2)));
    const int c16 = tid & 63, rsub = tid >> 6; const unsigned char* Yb = (const unsigned char*)Y;
    f32x4 g[4];
#pragma unroll
    for (int q = 0; q < 4; ++q) g[q] = *(const f32x4*)(g2 + 16 * c16 + 4 * q);
#pragma unroll 2
    for (int it = 0; it < 8; ++it) { const int i = 8 * it + rsub; const size_t m = (size_t)(row0 + i);
        const v4u x0 = *(const v4u*)(xsrc + m * D + 16 * c16), x1 = *(const v4u*)(xsrc + m * D + 16 * c16 + 8);
        const v4u sl = *(const LAS v4u*)(lds + LR_SLT + 16 * i); const f32x4 tws = *(const LAS f32x4*)(lds + LR_TWL + 16 * i) * (1.0f / S8_Y);
        const v4u y0 = *(const v4u*)(Yb + (size_t)sl.x * D + 16 * c16), y1 = *(const v4u*)(Yb + (size_t)sl.y * D + 16 * c16), y2 = *(const v4u*)(Yb + (size_t)sl.z * D + 16 * c16), y3 = *(const v4u*)(Yb + (size_t)sl.w * D + 16 * c16);
        const unsigned xw[8] = {x0.x, x0.y, x0.z, x0.w, x1.x, x1.y, x1.z, x1.w}, w0[4] = {y0.x, y0.y, y0.z, y0.w}, w1[4] = {y1.x, y1.y, y1.z, y1.w}, w2[4] = {y2.x, y2.y, y2.z, y2.w}, w3[4] = {y3.x, y3.y, y3.z, y3.w};
        float v[16]; float sq = 0.f;
#pragma unroll
        for (int q = 0; q < 4; ++q) {
            const f32x2v a0 = __builtin_amdgcn_cvt_pk_f32_fp8((int)w0[q], false), b0 = __builtin_amdgcn_cvt_pk_f32_fp8((int)w0[q], true), a1 = __builtin_amdgcn_cvt_pk_f32_fp8((int)w1[q], false), b1 = __builtin_amdgcn_cvt_pk_f32_fp8((int)w1[q], true);
            const f32x2v a2 = __builtin_amdgcn_cvt_pk_f32_fp8((int)w2[q], false), b2 = __builtin_amdgcn_cvt_pk_f32_fp8((int)w2[q], true), a3 = __builtin_amdgcn_cvt_pk_f32_fp8((int)w3[q], false), b3 = __builtin_amdgcn_cvt_pk_f32_fp8((int)w3[q], true);
            const float e0 = tws[0] * a0[0] + tws[1] * a1[0] + tws[2] * a2[0] + tws[3] * a3[0], e1 = tws[0] * a0[1] + tws[1] * a1[1] + tws[2] * a2[1] + tws[3] * a3[1];
            const float e2 = tws[0] * b0[0] + tws[1] * b1[0] + tws[2] * b2[0] + tws[3] * b3[0], e3 = tws[0] * b0[1] + tws[1] * b1[1] + tws[2] * b2[1] + tws[3] * b3[1];
            v[4 * q + 0] = __builtin_bit_cast(float, xw[2 * q] << 16) + g[q][0] * e0; v[4 * q + 1] = __builtin_bit_cast(float, xw[2 * q] & 0xffff0000u) + g[q][1] * e1;
            v[4 * q + 2] = __builtin_bit_cast(float, xw[2 * q + 1] << 16) + g[q][2] * e2; v[4 * q + 3] = __builtin_bit_cast(float, xw[2 * q + 1] & 0xffff0000u) + g[q][3] * e3;
            sq += (v[4 * q] * v[4 * q] + v[4 * q + 1] * v[4 * q + 1]) + (v[4 * q + 2] * v[4 * q + 2] + v[4 * q + 3] * v[4 * q + 3]); }
        if (OUTF32) {
#pragma unroll
            for (int q = 0; q < 4; ++q) *(GAS f32x4*)((float*)xdst + m * D + 16 * c16 + 4 * q) = (f32x4){v[4 * q], v[4 * q + 1], v[4 * q + 2], v[4 * q + 3]}; }
        else { v4u o0, o1; o0.x = pk2(v[0], v[1]); o0.y = pk2(v[2], v[3]); o0.z = pk2(v[4], v[5]); o0.w = pk2(v[6], v[7]); o1.x = pk2(v[8], v[9]); o1.y = pk2(v[10], v[11]); o1.z = pk2(v[12], v[13]); o1.w = pk2(v[14], v[15]);
            *(GAS v4u*)((bf16*)xdst + m * D + 16 * c16) = o0; *(GAS v4u*)((bf16*)xdst + m * D + 16 * c16 + 8) = o1; }
        if (SS) { const float sqs = wave_sum(sq); if (lane == 0) __hip_atomic_fetch_add((LAS float*)(lds + LR_SSR) + i, sqs, __ATOMIC_RELAXED, __HIP_MEMORY_SCOPE_WORKGROUP); } }
}
template <bool F8, bool SLOTS>
__device__ __forceinline__ void flat_modulate(const bf16* xin, int row0, const LAS float* rstds, const float* nw, const float* scp, const float* shp, bf16* H, unsigned char* A1, LAS unsigned char* lds, int tid) {
    const int c16 = tid & 63, rsub = tid >> 6; f32x4 ws1[4], s0[4];
#pragma unroll
    for (int q = 0; q < 4; ++q) { const int c0 = 16 * c16 + 4 * q; ws1[q] = *(const f32x4*)(nw + c0) * (*(const f32x4*)(scp + c0) + 1.0f); s0[q] = *(const f32x4*)(shp + c0); }
#pragma unroll 2
    for (int it = 0; it < 8; ++it) { const int i = 8 * it + rsub; const size_t m = (size_t)(row0 + i); const float rs = rstds[i];
        const v4u x0 = *(const v4u*)(xin + m * D + 16 * c16), x1 = *(const v4u*)(xin + m * D + 16 * c16 + 8); const unsigned xw[8] = {x0.x, x0.y, x0.z, x0.w, x1.x, x1.y, x1.z, x1.w};
        f32x4 v[4];
#pragma unroll
        for (int q = 0; q < 4; ++q) v[q] = (f32x4){__builtin_bit_cast(float, xw[2 * q] << 16), __builtin_bit_cast(float, xw[2 * q] & 0xffff0000u), __builtin_bit_cast(float, xw[2 * q + 1] << 16), __builtin_bit_cast(float, xw[2 * q + 1] & 0xffff0000u)} * rs * ws1[q] + s0[q];
        if (F8) { v4u o; o.x = (unsigned)pk4_fp8(v[0][0] * S8_H, v[0][1] * S8_H, v[0][2] * S8_H, v[0][3] * S8_H); o.y = (unsigned)pk4_fp8(v[1][0] * S8_H, v[1][1] * S8_H, v[1][2] * S8_H, v[1][3] * S8_H);
            o.z = (unsigned)pk4_fp8(v[2][0] * S8_H, v[2][1] * S8_H, v[2][2] * S8_H, v[2][3] * S8_H); o.w = (unsigned)pk4_fp8(v[3][0] * S8_H, v[3][1] * S8_H, v[3][2] * S8_H, v[3][3] * S8_H);
            if (SLOTS) { const v4u sl = *(const LAS v4u*)(lds + LR_SLT + 16 * i);
                *(GAS v4u*)(A1 + (size_t)sl.x * D + 16 * c16) = o; *(GAS v4u*)(A1 + (size_t)sl.y * D + 16 * c16) = o; *(GAS v4u*)(A1 + (size_t)sl.z * D + 16 * c16) = o; *(GAS v4u*)(A1 + (size_t)sl.w * D + 16 * c16) = o; }
            else *(GAS v4u*)((unsigned char*)H + m * D + 16 * c16) = o; }
        else { v4u o0, o1; o0.x = pk2(v[0][0], v[0][1]); o0.y = pk2(v[0][2], v[0][3]); o0.z = pk2(v[1][0], v[1][1]); o0.w = pk2(v[1][2], v[1][3]); o1.x = pk2(v[2][0], v[2][1]); o1.y = pk2(v[2][2], v[2][3]); o1.z = pk2(v[3][0], v[3][1]); o1.w = pk2(v[3][2], v[3][3]);
            *(GAS v4u*)(H + m * D + 16 * c16) = o0; *(GAS v4u*)(H + m * D + 16 * c16 + 8) = o1; } }
}

constexpr int WP = 1032;
constexpr int LR_WHI = 0, LR_PART = 132096, LR_SSX = 140288, LR_RSTD = 140544, LR_BIAS = 140800, LR_RED = 140928;
template <int NEO>
__device__ __forceinline__ void rows_mfma(const Args& a, int layer, LAS unsigned char* lds, volatile LAS unsigned* MISC, gu32* ctl, int vcu, int G, int tid, int lane, int wave) {
    constexpr bool P5 = (NEO == 32); constexpr int NET = NEO / 16;
    unsigned char* ws = a.ws; bf16* X = (bf16*)(ws + WS_X); bf16* H = (bf16*)(ws + WS_H); const float* MOD = (const float*)(ws + WS_MOD);
    LAS bf16* Whi = (LAS bf16*)(lds + LR_WHI); LAS bf16* Wlo = Whi + NEO * WP; LAS float* part = (LAS float*)(lds + LR_PART); LAS float* ssx = (LAS float*)(lds + LR_SSX);
    LAS float* rstds = (LAS float*)(lds + LR_RSTD); LAS float* biasl = (LAS float*)(lds + LR_BIAS); LAS float* red = (LAS float*)(lds + LR_RED);
    const float* nw = (P5 ? a.norm2_w : a.norm1_w) + layer * D;
    const float* Wsrc = P5 ? a.w_r + (size_t)layer * D * NE : a.w_in + (size_t)layer * D * DIN + SRC_GA; const int wld = P5 ? NE : DIN;
    if (P5) { if (tid < NE) MISC[MW_HIST + tid] = 0u; }
    for (int row0 = vcu * 64; row0 < MTOK; row0 += G * 64) {
        const int b = row0 / SEQ; const float* mp = MOD + ((size_t)layer * 2 + b) * 6144; const float* scp = mp + (P5 ? 4 : 1) * D; const float* shp = mp + (P5 ? 3 : 0) * D;
        if (!P5 && layer > 0) { stage_slots(ws, row0, lds, tid); __syncthreads(); }
        { constexpr int E4 = NEO / 4, NITP = (D / 2 * E4) / NTHR, NIT = 4;
          f32x4 bacc = {0.f, 0.f, 0.f, 0.f};
#pragma unroll 1
          for (int ib0 = 0; ib0 < NITP; ib0 += NIT) {
            f32x4 wa[NIT], wb[NIT]; f32x2_t nv[NIT], sv[NIT], hv[NIT];
#pragma unroll
            for (int it = 0; it < NIT; ++it) { const int idx = tid + NTHR * (ib0 + it), k2 = idx / E4, e4 = idx - k2 * E4, k = 2 * k2;
                wa[it] = *(const f32x4*)(Wsrc + (size_t)k * wld + 4 * e4); wb[it] = *(const f32x4*)(Wsrc + (size_t)(k + 1) * wld + 4 * e4);
                nv[it] = *(const f32x2_t*)(nw + k); sv[it] = *(const f32x2_t*)(scp + k); hv[it] = *(const f32x2_t*)(shp + k); }
#pragma unroll
            for (int it = 0; it < NIT; ++it) { const int idx = tid + NTHR * (ib0 + it), k2 = idx / E4, e4 = idx - k2 * E4, k = 2 * k2;
                bacc += wa[it] * hv[it][0] + wb[it] * hv[it][1];
                const f32x4 w0 = wa[it] * (nv[it][0] * (1.0f + sv[it][0])), w1 = wb[it] * (nv[it][1] * (1.0f + sv[it][1]));
#pragma unroll
                for (int j = 0; j < 4; ++j) { const unsigned h0 = f2bf(w0[j]), h1 = f2bf(w1[j]); const float l0 = w0[j] - __builtin_bit_cast(float, h0 << 16), l1 = w1[j] - __builtin_bit_cast(float, h1 << 16);
                    *(LAS unsigned*)(Whi + (4 * e4 + j) * WP + k) = h0 | (h1 << 16); *(LAS unsigned*)(Wlo + (4 * e4 + j) * WP + k) = pk2(l0, l1); } } }
#pragma unroll
          for (int j = 0; j < 4; ++j) { float v = bacc[j];
#pragma unroll
              for (int sh = E4; sh < 64; sh <<= 1) v += __shfl_xor(v, sh);
              bacc[j] = v; }
          if (lane < E4) *(LAS f32x4*)(red + wave * NEO + 4 * lane) = bacc; }
        const bf16* xin = X;
        if (!P5 && layer > 0) { flat_combine<false, false>(X, X, row0, (const bf16*)(ws + WS_Y), MOD + ((size_t)(layer - 1) * 2 + b) * 6144 + 5 * D, lds, tid, lane); asm volatile("s_waitcnt vmcnt(0)" ::: "memory"); }
        __syncthreads();
        if (tid < NEO) { float sacc = P5 ? a.b_r[layer * NE + tid] : 0.f; for (int q = 0; q < NWAVES; ++q) sacc += red[q * NEO + tid]; biasl[tid] = sacc; }
        const int rg = wave >> 1, kh = wave & 1, r = lane & 15, g = lane >> 4;
        { const bf16* xr = xin + (size_t)(row0 + 16 * rg + r) * D; f32x4 acc[NET]; float ss = 0.f;
#pragma unroll
            for (int et = 0; et < NET; ++et) acc[et] = (f32x4){0.f, 0.f, 0.f, 0.f};
#pragma unroll 4
            for (int s = 16 * kh; s < 16 * kh + 16; ++s) { const int k0 = 32 * s + 8 * g; const v4u xp = *(const v4u*)(xr + k0); const unsigned xw[4] = {xp.x, xp.y, xp.z, xp.w};
#pragma unroll
                for (int j = 0; j < 4; ++j) { const float xa = __builtin_bit_cast(float, xw[j] << 16), xb = __builtin_bit_cast(float, xw[j] & 0xffff0000u); ss += xa * xa + xb * xb; }
                const pg8::bf16x8 ahi = __builtin_bit_cast(pg8::bf16x8, xp);
#pragma unroll
                for (int et = 0; et < NET; ++et) { const pg8::bf16x8 whi = ldfrag(Whi, WP, 16 * et, 32 * s, lane), wlo = ldfrag(Wlo, WP, 16 * et, 32 * s, lane);
                    acc[et] = __builtin_amdgcn_mfma_f32_16x16x32_bf16(ahi, whi, acc[et], 0, 0, 0); acc[et] = __builtin_amdgcn_mfma_f32_16x16x32_bf16(ahi, wlo, acc[et], 0, 0, 0); } }
            ss += __shfl_xor(ss, 16); ss += __shfl_xor(ss, 32);
            if (kh == 1) {
#pragma unroll
                for (int et = 0; et < NET; ++et)
#pragma unroll
                    for (int q = 0; q < 4; ++q) part[(rg * 16 + 4 * g + q) * 32 + 16 * et + r] = acc[et][q];
                if (g == 0) ssx[rg * 16 + r] = ss; }
            __syncthreads();
            if (kh == 0) { const float sst = ss + ssx[rg * 16 + r]; if (g == 0) rstds[rg * 16 + r] = 1.0f / sqrtf(sst * (1.0f / D) + EPS);
                asm volatile("s_waitcnt lgkmcnt(0)" ::: "memory");
#pragma unroll
                for (int et = 0; et < NET; ++et)
#pragma unroll
                    for (int q = 0; q < 4; ++q) { const int i = rg * 16 + 4 * g + q, e = 16 * et + r; const float v = rstds[i] * (acc[et][q] + part[i * 32 + e]) + biasl[e];
                        if (P5) part[i * 32 + e] = v; else ((float*)(ws + WS_GA))[(size_t)(row0 + i) * 16 + e] = v; }
                if (P5) { asm volatile("s_waitcnt lgkmcnt(0)" ::: "memory");
                    if (lane < 16) { const int i = rg * 16 + lane, m = row0 + i; float lv[NE];
#pragma unroll
                        for (int e = 0; e < NE; ++e) lv[e] = part[i * 32 + e];
                        float tv[4]; int te[4];
#pragma unroll
                        for (int t = 0; t < 4; ++t) { float best = -3.0e38f; int bi = 0;
#pragma unroll
                            for (int e = 0; e < NE; ++e) if (lv[e] > best) { best = lv[e]; bi = e; }
#pragma unroll
                            for (int e = 0; e < NE; ++e) if (e == bi) lv[e] = -3.0e38f;
                            tv[t] = best; te[t] = bi; }
                        const float e1 = expf(tv[1] - tv[0]), e2 = expf(tv[2] - tv[0]), e3 = expf(tv[3] - tv[0]); const float inv = 1.0f / (1.0f + e1 + e2 + e3);
                        *(f32x4*)((float*)(ws + WS_TOPW) + (size_t)m * 4) = (f32x4){inv, e1 * inv, e2 * inv, e3 * inv};
#pragma unroll
                        for (int t = 0; t < 4; ++t) { const unsigned rk = __hip_atomic_fetch_add((LAS unsigned*)&MISC[MW_HIST + te[t]], 1u, __ATOMIC_RELAXED, __HIP_MEMORY_SCOPE_WORKGROUP);
                            ((LAS unsigned*)(lds + LR_SLT))[i * 4 + t] = ((unsigned)te[t] << 16) | rk; } } } }
            __syncthreads(); }
        if (P5) { if (tid < NE) { const unsigned hcnt = MISC[MW_HIST + tid]; MISC[MW_BASE + tid] = hcnt ? atomicAdd((unsigned*)(ctl + CW_CNT + layer * NE + tid), hcnt) : 0u; }
            __syncthreads();
            if (tid < 256) { LAS unsigned* sl = (LAS unsigned*)(lds + LR_SLT) + tid; const unsigned v = *sl, e = v >> 16; const unsigned slot = (e << ECAP_SH) + MISC[MW_BASE + e] + (v & 0xffffu);
                *sl = slot; ((int*)(ws + WS_SLOT))[(size_t)row0 * 4 + tid] = (int)slot; }
            if (tid < NE) MISC[MW_HIST + tid] = 0u;
            __syncthreads(); }
        if (P5) flat_modulate<true, true>(xin, row0, rstds, nw, scp, shp, H, ws + WS_A1, lds, tid);
        else flat_modulate<F8_IN, false>(xin, row0, rstds, nw, scp, shp, H, ws + WS_A1, lds, tid);
        __syncthreads();
    }
}

__device__ __forceinline__ void final_rows(const Args& a, LAS unsigned char* lds, int vcu, int G, int tid, int lane) {
    unsigned char* ws = a.ws; const bf16* X = (const bf16*)(ws + WS_X); const float* MOD = (const float*)(ws + WS_MOD); LAS float* ssr = (LAS float*)(lds + LR_SSR);
    for (int row0 = vcu * 64; row0 < MTOK; row0 += G * 64) { const int b = row0 / SEQ;
        stage_slots(ws, row0, lds, tid); if (tid < 64) ssr[tid] = 0.f;
        __syncthreads();
        flat_combine<true, true>(X, a.out, row0, (const bf16*)(ws + WS_Y), MOD + ((size_t)(DEPTH - 1) * 2 + b) * 6144 + 5 * D, lds, tid, lane);
        asm volatile("s_waitcnt vmcnt(0)" ::: "memory");
        __syncthreads();
        { const int c4 = tid & 255, rsub = tid >> 8; const f32x4 w = *(const f32x4*)(a.final_norm_w + 4 * c4);
#pragma unroll 8
            for (int it = 0; it < 32; ++it) { const int i = 2 * it + rsub; float* op = a.out + (size_t)(row0 + i) * D + 4 * c4; const float rstd = 1.0f / sqrtf(ssr[i] * (1.0f / D) + EPS); *(GAS f32x4*)op = *(const GAS f32x4*)op * rstd * w; } }
        __syncthreads();
    }
}

__device__ __noinline__ void moe_tables(gu32* ctl, int layer, volatile LAS unsigned* MISC, int tid) {
    if (tid < NE) MISC[MW_CNT + tid] = __hip_atomic_load(ctl + CW_CNT + layer * NE + tid, RLX_AGENT);
    __syncthreads();
    if (tid == 0) { unsigned n = 0;
        for (int e = 0; e < NE; ++e) { const unsigned nt = (MISC[MW_CNT + e] + 255u) >> 8; for (unsigned t = 0; t < nt; ++t) MISC[MW_TILE + n + t] = (unsigned)(e * 64) + t; n += nt; }
        MISC[MW_NRT] = n; }
    __syncthreads();
}

constexpr int BP = 72;
template <int TYPE> struct MixCfg { static constexpr int DK = (TYPE == 1) ? 64 : 48, DV = (TYPE == 1) ? 64 : 96, NC = 4 * DK, NV = 4 * DV;
    static constexpr int STOFF = (TYPE == 0) ? ST_GLA : (TYPE == 1) ? ST_HG : ST_RET, COFF = (TYPE == 0) ? 0 : 192;
    static constexpr int CQ = (TYPE == 0) ? C_GQ : (TYPE == 1) ? C_HQ : C_RQ, CK = (TYPE == 0) ? C_GK : (TYPE == 1) ? C_HF : C_RK, CV = (TYPE == 0) ? C_GV : (TYPE == 1) ? C_HI : C_RV, CG = (TYPE == 0) ? C_GG : (TYPE == 1) ? C_HG : C_RG;
    static constexpr int MIXOFF = (TYPE == 0) ? 0 : (TYPE == 1) ? 384 : 640, KOFF = (TYPE == 0) ? 0 : (TYPE == 1) ? 192 : 448; };
__device__ __forceinline__ float fast_logsig(float x) { x = fmaxf(x, -80.f); return -__logf(1.0f + __expf(-x)); }
__device__ __forceinline__ float ret_lg(int h) { return logf(1.0f - exp2f(-5.0f - (float)h)); }

template <int NV>
__device__ __forceinline__ void stage_vt(const bf16* pv  , LAS bf16* VT, int tid) {
    constexpr int NIT = (64 * (NV / 8)) / NTHR; static_assert((64 * (NV / 8)) % NTHR == 0, "stage_vt");
    v4u p[NIT];
#pragma unroll
    for (int it = 0; it < NIT; ++it) { const int idx = tid + NTHR * it, j = idx & 63, ch = idx >> 6; p[it] = *(const v4u*)(pv + (size_t)j * NPROJ + 8 * ch); }
#pragma unroll
    for (int it = 0; it < NIT; ++it) { const int idx = tid + NTHR * it, j = idx & 63, ch = idx >> 6; LAS bf16* d = VT + (8 * ch) * BP + j;
        d[0 * BP] = (bf16)(p[it].x & 0xffffu); d[1 * BP] = (bf16)(p[it].x >> 16); d[2 * BP] = (bf16)(p[it].y & 0xffffu); d[3 * BP] = (bf16)(p[it].y >> 16);
        d[4 * BP] = (bf16)(p[it].z & 0xffffu); d[5 * BP] = (bf16)(p[it].z >> 16); d[6 * BP] = (bf16)(p[it].w & 0xffffu); d[7 * BP] = (bf16)(p[it].w >> 16); }
}

constexpr int LA_KT = 0, LA_VT = 36864, LA_TOT = 92160, LA_GA = 94208, LA_KTT = 98304, KTP = 264;
template <int TYPE>
__device__ __forceinline__ void mixa_batch(const Args& a, int layer, int unit, LAS unsigned char* lds, int tid, int lane, int wave) {
    asm volatile("" : "+v"(tid), "+v"(lane));
    typedef MixCfg<TYPE> C; constexpr int DK = C::DK, DV = C::DV, NC = C::NC, NV = C::NV;
    unsigned char* ws = a.ws; const bf16* PROJ = (const bf16*)(ws + WS_PROJ); bf16* F1 = (bf16*)(ws + WS_CUM); float* ECG = (float*)(ws + WS_CUM + 16 * MiB) + (size_t)unit * 4 * NDV; float* DVEC = (float*)(ws + WS_DVEC) + (size_t)unit * NDV;
    bf16* U = (bf16*)(ws + WS_U) + (size_t)unit * ST_TOT + C::STOFF;
    LAS bf16* KT = (LAS bf16*)(lds + LA_KT); LAS bf16* VT = (LAS bf16*)(lds + LA_VT); LAS float* TOT = (LAS float*)(lds + LA_TOT); const LAS float* GAs = (const LAS float*)(lds + LA_GA);
    const int row0 = unit * CH;
    stage_vt<NV>(PROJ + (size_t)row0 * NPROJ + C::CV, VT, tid);
    const bool act = tid < 2 * NC; const int c = act ? tid % NC : 0, half = act ? tid / NC : 0, h = c / DK, d = c - h * DK;
    float cum[32]; float tot = 0.f;
    float w2[16], b2 = 0.f, lbv = 0.f, lg = 0.f, sg = 0.f; int f = 0, d2 = 0;
    if (act) {
        if constexpr (TYPE == 0) { b2 = a.gla_ba2[layer * 192 + c];
#pragma unroll
            for (int r = 0; r < 16; ++r) w2[r] = a.gla_wa2[(layer * 16 + r) * 192 + c]; }
        if constexpr (TYPE == 1) lbv = ((const float*)(ws + WS_LB))[layer * 256 + c];
        if constexpr (TYPE == 2) { lg = ret_lg(h); f = (d < 24) ? d : d - 24; d2 = (d < 24) ? d + 24 : d - 24; sg = (d < 24) ? -1.f : 1.f; }
#pragma unroll
        for (int gq = 0; gq < 2; ++gq) {
            bf16 hraw[16];
            if constexpr (TYPE == 1) {
#pragma unroll
                for (int i = 0; i < 16; ++i) hraw[i] = PROJ[(size_t)(row0 + 32 * half + 16 * gq + i) * NPROJ + C_HF + c]; }
#pragma unroll
            for (int ii = 0; ii < 16; ++ii) { const int i = 16 * gq + ii, t = 32 * half + i; float g;
                if constexpr (TYPE == 0) { float pre = b2;
#pragma unroll
                    for (int r = 0; r < 16; ++r) pre += GAs[t * 16 + r] * w2[r];
                    g = fast_logsig(pre) * (1.0f / 16.0f); }
                else if constexpr (TYPE == 1) { const float hf = fminf(fmaxf(bf2f(hraw[ii]), -80.f), 80.f); const float sgm = __builtin_amdgcn_rcpf(1.0f + __expf(-hf));
                    g = __logf(lbv + (1.0f - lbv) * sgm); }
                else g = lg;
                tot += g; cum[i] = tot;
                if constexpr (TYPE == 0) { if ((ii & 3) == 3) asm volatile("" ::: "memory"); } } }
        TOT[c * 2 + half] = tot;
    }
    __syncthreads();
    if (act) { const float t0 = TOT[c * 2], t1 = TOT[c * 2 + 1]; const float off = half ? t0 : 0.f, last = t0 + t1;
#pragma unroll
        for (int hq = 0; hq < 4; ++hq) {
            bf16 ka[8], kb[8]; float cs[8], sn[8];
            if constexpr (TYPE != 1) {
#pragma unroll
                for (int i = 0; i < 8; ++i) { const size_t row = (size_t)(row0 + 32 * half + 8 * hq + i); const bf16* pr = PROJ + row * NPROJ;
                    if constexpr (TYPE == 0) ka[i] = pr[C_GK + c];
                    else { const float* rp = (const float*)(ws + WS_ROPE) + row * 48; ka[i] = pr[C_RK + h * 48 + d]; kb[i] = pr[C_RK + h * 48 + d2]; cs[i] = rp[f]; sn[i] = rp[24 + f]; } } }
            float kt[8];
#pragma unroll
            for (int j = 0; j < 8; ++j) { const int i = 8 * hq + j; const float cm = cum[i] + off; const size_t row = (size_t)(row0 + 32 * half + i); float k;
                if constexpr (TYPE == 0) k = bf2f(ka[j]);
                else if constexpr (TYPE == 1) k = 1.0f - __expf(cum[i] - (i > 0 ? cum[i - 1] : 0.f));
                else k = bf2f(ka[j]) * cs[j] + sg * bf2f(kb[j]) * sn[j];
                if constexpr (TYPE != 2) *(GAS bf16*)(F1 + row * NDV + C::COFF + c) = (bf16)f2bf(__expf(cm - ((i < 16) ? off : cum[15] + off)));
                { const float eb = cum[(i < 16) ? 15 : 31] + off;
                  ((LAS bf16*)(lds + LA_KTT))[(32 * half + i) * KTP + c] = (bf16)f2bf(k * __expf(eb - cm)); }
                kt[j] = k * __expf(last - cm); }
            v4u w; w.x = pk2(kt[0], kt[1]); w.y = pk2(kt[2], kt[3]); w.z = pk2(kt[4], kt[5]); w.w = pk2(kt[6], kt[7]);
            *(LAS v4u*)(KT + c * BP + 32 * half + 8 * hq) = w; }
        if (TYPE != 2) { *(GAS float*)(ECG + (2 * half + 0) * NDV + C::COFF + c) = cum[15] + off; *(GAS float*)(ECG + (2 * half + 1) * NDV + C::COFF + c) = cum[31] + off; }
        if (TYPE != 2 && half == 0) *(GAS float*)(DVEC + C::COFF + c) = __expf(last);
    }
    __syncthreads();
    { constexpr int CPR = NC / 8;
#pragma unroll
        for (int it = 0; it < (64 * CPR) / NTHR; ++it) { const int idx = tid + NTHR * it, t = idx / CPR, ch = idx - t * CPR;
            *(GAS v4u*)((bf16*)(ws + WS_KT) + (size_t)(row0 + t) * NKT + C::KOFF + 8 * ch) = *(const LAS v4u*)((const LAS bf16*)(lds + LA_KTT) + t * KTP + 8 * ch); } }
    constexpr int TD = DK / 16, NT = (DV / 16) * TD;
    for (int ti = wave; ti < 4 * NT; ti += NWAVES) { const int hh = ti / NT, tr = ti - hh * NT, te = tr / TD, td = tr - te * TD; f32x4 acc = {0.f, 0.f, 0.f, 0.f};
#pragma unroll
        for (int kk = 0; kk < 2; ++kk) acc = __builtin_amdgcn_mfma_f32_16x16x32_bf16(ldfrag(VT, BP, hh * DV + te * 16, kk * 32, lane), ldfrag(KT, BP, hh * DK + td * 16, kk * 32, lane), acc, 0, 0, 0);
        bf16* Uh = U + hh * DK * DV;
#pragma unroll
        for (int r = 0; r < 4; ++r) *(GAS bf16*)(Uh + (te * 16 + (lane >> 4) * 4 + r) * DK + td * 16 + (lane & 15)) = (bf16)f2bf(acc[r]); }
    __syncthreads();
}
__device__ __forceinline__ void p3a_summaries(const Args& a, int layer, LAS unsigned char* lds, int vcu, int G, int tid, int lane, int wave) {
    for (int unit = vcu; unit < NUNIT; unit += G) {
        { LAS float* GAs = (LAS float*)(lds + LA_GA); const float* GA = (const float*)(a.ws + WS_GA); for (int i = tid; i < CH * 16; i += NTHR) GAs[i] = GA[(size_t)unit * CH * 16 + i]; }
        __syncthreads();
        mixa_batch<0>(a, layer, unit, lds, tid, lane, wave);
        mixa_batch<1>(a, layer, unit, lds, tid, lane, wave);
        mixa_batch<2>(a, layer, unit, lds, tid, lane, wave);
    }
}

__device__ __forceinline__ void p3b_scan(const Args& a, int vcu, int G, int tid) {
    unsigned char* ws = a.ws; const bf16* U = (const bf16*)(ws + WS_U); const float* DVEC = (const float*)(ws + WS_DVEC); bf16* SP = (bf16*)(ws + WS_SP);
    for (int gid = vcu * NTHR + tid; gid < BATCH * ST_TOT; gid += G * NTHR) {
        const int b = gid / ST_TOT, el = gid - b * ST_TOT;
        int di = -1; float cdec = 0.f;
        if (el < ST_HG) { const int h = el / 4608, d = (el - h * 4608) % 48; di = h * 48 + d; }
        else if (el < ST_RET) { const int r = el - ST_HG, h = r / 4096, d = r % 64; di = 192 + h * 64 + d; }
        else { const int h = (el - ST_RET) / 4608; cdec = expf(64.0f * logf(1.0f - exp2f(-5.0f - (float)h))); }
        const bf16* up = U + (size_t)b * NCH * ST_TOT + el; const float* dp = DVEC + (size_t)b * NCH * NDV + (di < 0 ? 0 : di); bf16* sp = SP + (size_t)b * NCH * ST_TOT + el;
        float s = 0.f;
#pragma unroll 1
        for (int n0 = 0; n0 < NCH; n0 += 32) { float u[32], dc[32];
#pragma unroll
            for (int i = 0; i < 32; ++i) { u[i] = bf2f(up[(size_t)(n0 + i) * ST_TOT]); dc[i] = (di < 0) ? cdec : dp[(size_t)(n0 + i) * NDV]; }
#pragma unroll
            for (int i = 0; i < 32; ++i) { *(GAS bf16*)(sp + (size_t)(n0 + i) * ST_TOT) = (bf16)f2bf(s); s = dc[i] * s + u[i]; } }
    }
}

#ifndef SUB_MASK
#define SUB_MASK 0
#endif
#define SUBSTRETCH(bit, t0_) do { if ((SUB_MASK >> (bit)) & 1) { const unsigned long long t1_ = __builtin_amdgcn_s_memrealtime(); while (__builtin_amdgcn_s_memrealtime() - t1_ < t1_ - (t0_)) __builtin_amdgcn_s_sleep(8); } } while (0)
constexpr int LC_VT = 0, LC_ST = 55296, LC_AB = 110592, OBP = 104, LC_EC = 137216;
template <int TYPE, bool ISQ>
__device__ __forceinline__ void mix_frag(const Args& a, int h, size_t row, int t, int d0, float (&x)[8], float (&cm)[8]) {
    typedef MixCfg<TYPE> C; constexpr int DK = C::DK; static_assert(ISQ, "query path only");
    unsigned char* ws = a.ws; const bf16* pr = (const bf16*)(ws + WS_PROJ) + row * NPROJ;
    if constexpr (TYPE != 2) {
        const v4u p = *(const v4u*)(pr + C::CQ + h * DK + d0); const unsigned pw[4] = {p.x, p.y, p.z, p.w};
        const v4u f = *(const v4u*)((const bf16*)(ws + WS_CUM) + row * NDV + C::COFF + h * DK + d0); const unsigned fw[4] = {f.x, f.y, f.z, f.w};
#pragma unroll
        for (int j = 0; j < 4; ++j) { x[2 * j] = __builtin_bit_cast(float, pw[j] << 16); x[2 * j + 1] = __builtin_bit_cast(float, pw[j] & 0xffff0000u); cm[2 * j] = __builtin_bit_cast(float, fw[j] << 16); cm[2 * j + 1] = __builtin_bit_cast(float, fw[j] & 0xffff0000u); }
        if constexpr (TYPE == 0) {
#pragma unroll
            for (int j = 0; j < 8; ++j) x[j] *= 0.14433756729740643f; }
    } else {
        const int f0 = (d0 < 24) ? d0 : d0 - 24, dp = (d0 < 24) ? d0 + 24 : d0 - 24; const float sg = (d0 < 24) ? -1.f : 1.f;
        const int cb = C_RQ + h * DK; const v4u p = *(const v4u*)(pr + cb + d0), pp = *(const v4u*)(pr + cb + dp); const unsigned pw[4] = {p.x, p.y, p.z, p.w}, qw[4] = {pp.x, pp.y, pp.z, pp.w};
        const float* rp = (const float*)(ws + WS_ROPE) + row * 48; const f32x4 cs0 = *(const f32x4*)(rp + f0), cs1 = *(const f32x4*)(rp + f0 + 4), sn0 = *(const f32x4*)(rp + 24 + f0), sn1 = *(const f32x4*)(rp + 24 + f0 + 4);
        const float cmv = (float)(t + 1) * ret_lg(h);
#pragma unroll
        for (int j = 0; j < 4; ++j) { const float xa = __builtin_bit_cast(float, pw[j] << 16), xb = __builtin_bit_cast(float, pw[j] & 0xffff0000u), ya = __builtin_bit_cast(float, qw[j] << 16), yb = __builtin_bit_cast(float, qw[j] & 0xffff0000u);
            const float ca = (j < 2) ? cs0[2 * j] : cs1[2 * j - 4], cb2 = (j < 2) ? cs0[2 * j + 1] : cs1[2 * j - 3], sa = (j < 2) ? sn0[2 * j] : sn1[2 * j - 4], sb = (j < 2) ? sn0[2 * j + 1] : sn1[2 * j - 3];
            x[2 * j] = (xa * ca + sg * ya * sa) * 0.14433756729740643f; x[2 * j + 1] = (xb * cb2 + sg * yb * sb) * 0.14433756729740643f; cm[2 * j] = cmv; cm[2 * j + 1] = cmv; }
    }
}

template <int TYPE>
__device__ __forceinline__ void mixc_batch(const Args& a, int layer, int unit, LAS unsigned char* lds, int tid, int lane, int wave) {
    asm volatile("" : "+v"(tid), "+v"(lane));
    typedef MixCfg<TYPE> C; constexpr int DK = C::DK, DV = C::DV, NV = C::NV, TE = DV / 16;
    unsigned char* ws = a.ws; const bf16* PROJ = (const bf16*)(ws + WS_PROJ); bf16* MIX = (bf16*)(ws + WS_MIX);
    LAS bf16* VT = (LAS bf16*)(lds + LC_VT); LAS bf16* ST = (LAS bf16*)(lds + LC_ST); LAS bf16* AB = (LAS bf16*)(lds + LC_AB) + wave * 16 * OBP;
    const int row0 = unit * CH;
    const unsigned long long ts0_ = SUB_MASK ? __builtin_amdgcn_s_memrealtime() : 0ull;
    stage_vt<NV>(PROJ + (size_t)row0 * NPROJ + C::CV, VT, tid);
    SUBSTRETCH(3, ts0_);
    const unsigned long long ts3_ = SUB_MASK ? __builtin_amdgcn_s_memrealtime() : 0ull;
    { const bf16* SPu = (const bf16*)(ws + WS_SP) + (size_t)unit * ST_TOT + C::STOFF;
        constexpr int NIS = (NV * 8) / NTHR; static_assert((NV * 8) % NTHR == 0, "ST staging"); v4u sw[NIS];
#pragma unroll
        for (int it = 0; it < NIS; ++it) { const int idx = tid + NTHR * it, er = idx >> 3, ch = idx & 7; sw[it] = (v4u){0u, 0u, 0u, 0u}; if (ch * 8 < DK) sw[it] = *(const v4u*)(SPu + (size_t)er * DK + ch * 8); }
#pragma unroll
        for (int it = 0; it < NIS; ++it) { const int idx = tid + NTHR * it, er = idx >> 3, ch = idx & 7; *(LAS v4u*)(ST + er * BP + ch * 8) = sw[it]; } }
    SUBSTRETCH(4, ts3_);
    SUBSTRETCH(0, ts0_);
    if constexpr (TYPE != 2) { LAS float* EC = (LAS float*)(lds + LC_EC);
        for (int idx = tid; idx < 4 * C::NC; idx += NTHR) { const int jb = idx / C::NC, cc = idx - jb * C::NC; EC[jb * 256 + cc] = ((const float*)(ws + WS_CUM + 16 * MiB))[((size_t)unit * 4 + jb) * NDV + C::COFF + cc]; } }
    __syncthreads();
    const unsigned long long ts1_ = SUB_MASK ? __builtin_amdgcn_s_memrealtime() : 0ull;
    const int h = wave >> 1, hsel = wave & 1, r = lane & 15, g = lane >> 4;
    const LAS bf16* STh = ST + h * DV * BP; const LAS bf16* VTh = VT + h * DV * BP;
    constexpr int NCHK = DV / 8, NOC = (16 * NCHK) / 64;
#pragma unroll 1
    for (int ib = 0; ib < 2; ++ib) { const int I = ib ? 3 - hsel : hsel;
        pg8::bf16x8 qh[2], qt[2]; float refv[2][8], qhf[2][8];
#pragma unroll
        for (int s = 0; s < 2; ++s) { const int d0 = 32 * s + 8 * g; const bool valid = d0 < DK; const int d0c = valid ? d0 : 0;
            float x[8], cm[8]; mix_frag<TYPE, true>(a, h, (size_t)(row0 + 16 * I + r), 16 * I + r, d0c, x, cm);
            if constexpr (TYPE == 2) {
#pragma unroll
                for (int j = 0; j < 8; ++j) refv[s][j] = (float)(16 * I) * ret_lg(h);
            } else { if (I > 0) { const LAS float* cp = (const LAS float*)(lds + LC_EC) + (I - 1) * 256 + h * DK + d0c; const f32x4 c0 = *(const LAS f32x4*)cp, c1 = *(const LAS f32x4*)(cp + 4);
#pragma unroll
                    for (int j = 0; j < 4; ++j) { refv[s][j] = c0[j]; refv[s][4 + j] = c1[j]; } }
                else {
#pragma unroll
                    for (int j = 0; j < 8; ++j) refv[s][j] = 0.f; } }
            float xt[8];
#pragma unroll
            for (int j = 0; j < 8; ++j) { if constexpr (TYPE == 2) { qhf[s][j] = valid ? x[j] * __expf(cm[j] - refv[s][j]) : 0.f; xt[j] = valid ? x[j] * __expf(cm[j]) : 0.f; }
                else { qhf[s][j] = valid ? x[j] * cm[j] : 0.f; xt[j] = qhf[s][j] * __expf(refv[s][j]); } }
            qh[s] = pack8(qhf[s]); qt[s] = pack8(xt); }
        v4u kf[4][2];
#pragma unroll
        for (int J = 0; J < 4; ++J) { const int Jc = (J < I) ? J : I; const size_t rowJ = (size_t)(row0 + 16 * Jc + r);
#pragma unroll
            for (int s = 0; s < 2; ++s) { const int d0 = 32 * s + 8 * g; const int d0c = (d0 < DK) ? d0 : 0;
                kf[J][s] = *(const v4u*)((const bf16*)(ws + WS_KT) + rowJ * NKT + C::KOFF + h * DK + d0c); } }
#pragma unroll
        for (int J = 0; J < 4; ++J) { if (J <= I) { f32x4 acc = {0.f, 0.f, 0.f, 0.f};
#pragma unroll
            for (int s = 0; s < 2; ++s) { pg8::bf16x8 qop;
                { float xq[8], ej[8]; const int d0 = 32 * s + 8 * g; const int d0c = (d0 < DK) ? d0 : 0;
                    if constexpr (TYPE == 2) {
#pragma unroll
                        for (int j = 0; j < 8; ++j) ej[j] = (float)(16 * (J + 1)) * ret_lg(h); }
                    else { const LAS float* ep = (const LAS float*)(lds + LC_EC) + J * 256 + h * DK + d0c; const f32x4 e0 = *(const LAS f32x4*)ep, e1 = *(const LAS f32x4*)(ep + 4);
#pragma unroll
                        for (int j = 0; j < 4; ++j) { ej[j] = e0[j]; ej[4 + j] = e1[j]; } }
#pragma unroll
                    for (int j = 0; j < 8; ++j) xq[j] = qhf[s][j] * __expf(fminf(refv[s][j] - ej[j], 80.f));
                    qop = pack8(xq); }
                acc = __builtin_amdgcn_mfma_f32_16x16x32_bf16(qop, __builtin_bit_cast(pg8::bf16x8, kf[J][s]), acc, 0, 0, 0); }
#pragma unroll
            for (int q = 0; q < 4; ++q) { const int i = 4 * g + q; const float v = (J < I || r <= i) ? acc[q] : 0.f; AB[i * BP + 16 * J + r] = (bf16)f2bf(v); } } }
        if ((I & 1) == 0) {
#pragma unroll
            for (int q = 0; q < 4; ++q) AB[(4 * g + q) * BP + 16 * (I + 1) + r] = (bf16)0; }
        asm volatile("s_waitcnt lgkmcnt(0)" ::: "memory");
        const pg8::bf16x8 ah0 = *(const LAS pg8::bf16x8*)(AB + r * BP + 8 * g), ah1 = *(const LAS pg8::bf16x8*)(AB + r * BP + 32 + 8 * g);
        f32x4 o[TE];
#pragma unroll
        for (int te = 0; te < TE; ++te) { f32x4 acc = {0.f, 0.f, 0.f, 0.f};
            acc = __builtin_amdgcn_mfma_f32_16x16x32_bf16(qt[0], ldfrag(STh, BP, te * 16, 0, lane), acc, 0, 0, 0);
            acc = __builtin_amdgcn_mfma_f32_16x16x32_bf16(qt[1], ldfrag(STh, BP, te * 16, 32, lane), acc, 0, 0, 0);
            acc = __builtin_amdgcn_mfma_f32_16x16x32_bf16(ah0, ldfrag(VTh, BP, te * 16, 0, lane), acc, 0, 0, 0);
            if (I >= 2) acc = __builtin_amdgcn_mfma_f32_16x16x32_bf16(ah1, ldfrag(VTh, BP, te * 16, 32, lane), acc, 0, 0, 0);
            o[te] = acc; }
        const unsigned long long ts2_ = SUB_MASK ? __builtin_amdgcn_s_memrealtime() : 0ull;
#pragma unroll
        for (int q = 0; q < 4; ++q) { float s1 = 0.f, s2 = 0.f;
#pragma unroll
            for (int te = 0; te < TE; ++te) { s1 += o[te][q]; s2 += o[te][q] * o[te][q]; }
#pragma unroll
            for (int m = 1; m < 16; m <<= 1) { s1 += __shfl_xor(s1, m); s2 += __shfl_xor(s2, m); }
            float mean = 0.f, rstd;
            if constexpr (TYPE == 2) { mean = s1 * (1.0f / DV); rstd = __builtin_amdgcn_rsqf(fmaxf(s2 * (1.0f / DV) - mean * mean, 0.f) + EPS); }
            else rstd = __builtin_amdgcn_rsqf(s2 * (1.0f / DV) + EPS);
#pragma unroll
            for (int te = 0; te < TE; ++te) AB[(4 * g + q) * OBP + te * 16 + r] = (bf16)f2bf((o[te][q] - mean) * rstd); }
        asm volatile("s_waitcnt lgkmcnt(0)" ::: "memory");
#pragma unroll 1
        for (int i = 0; i < NOC; ++i) { const int cidx = lane + 64 * i, orow = cidx / NCHK, ch = cidx - orow * NCHK; const size_t row = (size_t)(row0 + 16 * I + orow);
            const v4u ov = *(const LAS v4u*)(AB + orow * OBP + 8 * ch); const v4u gv = *(const v4u*)(PROJ + row * NPROJ + C::CG + h * DV + 8 * ch);
            const unsigned ow[4] = {ov.x, ov.y, ov.z, ov.w}, gw[4] = {gv.x, gv.y, gv.z, gv.w}; float res[8];
            f32x4 w0 = {1.f, 1.f, 1.f, 1.f}, w1 = {1.f, 1.f, 1.f, 1.f};
            if constexpr (TYPE == 0) { const float* wp = a.gla_norm_w + layer * 384 + h * 96 + 8 * ch; w0 = *(const f32x4*)wp; w1 = *(const f32x4*)(wp + 4); }
            if constexpr (TYPE == 1) { const float* wp = a.hg_norm_w + layer * 256 + h * 64 + 8 * ch; w0 = *(const f32x4*)wp; w1 = *(const f32x4*)(wp + 4); }
#pragma unroll
            for (int j = 0; j < 4; ++j) { const float oa = __builtin_bit_cast(float, ow[j] << 16), ob = __builtin_bit_cast(float, ow[j] & 0xffff0000u), ga = __builtin_bit_cast(float, gw[j] << 16), gb = __builtin_bit_cast(float, gw[j] & 0xffff0000u);
                const float wa = (j < 2) ? w0[2 * j] : w1[2 * j - 4], wb = (j < 2) ? w0[2 * j + 1] : w1[2 * j - 3];
                const float sa = __builtin_amdgcn_rcpf(1.0f + __expf(-ga)), sb = __builtin_amdgcn_rcpf(1.0f + __expf(-gb));
                res[2 * j] = oa * wa * ((TYPE == 1) ? sa : ga * sa); res[2 * j + 1] = ob * wb * ((TYPE == 1) ? sb : gb * sb); }
            if (F8_OUT) { typedef int i32x2 __attribute__((ext_vector_type(2)));
                *(GAS i32x2*)((unsigned char*)MIX + row * D + C::MIXOFF + h * DV + 8 * ch) = (i32x2){pk4_fp8(res[0] * S8_M, res[1] * S8_M, res[2] * S8_M, res[3] * S8_M), pk4_fp8(res[4] * S8_M, res[5] * S8_M, res[6] * S8_M, res[7] * S8_M)}; }
            else { v4u w; w.x = pk2(res[0], res[1]); w.y = pk2(res[2], res[3]); w.z = pk2(res[4], res[5]); w.w = pk2(res[6], res[7]); *(GAS v4u*)(MIX + row * D + C::MIXOFF + h * DV + 8 * ch) = w; } }
        SUBSTRETCH(2, ts2_);
    }
    SUBSTRETCH(1, ts1_);
    __syncthreads();
}
__device__ __forceinline__ void p3c_outputs(const Args& a, int layer, LAS unsigned char* lds, int vcu, int G, int tid, int lane, int wave) {
    for (int unit = vcu; unit < NUNIT; unit += G) {
        mixc_batch<0>(a, layer, unit, lds, tid, lane, wave);
        mixc_batch<1>(a, layer, unit, lds, tid, lane, wave);
        mixc_batch<2>(a, layer, unit, lds, tid, lane, wave);
    }
}


constexpr int MW_ARGS = 800;
__device__ __forceinline__ const void* ld_argp(const volatile LAS unsigned* T, int i) {
    const unsigned lo = __builtin_amdgcn_readfirstlane(T[2 * i]), hi = __builtin_amdgcn_readfirstlane(T[2 * i + 1]);
    return (const void*)(((unsigned long long)hi << 32) | lo);
}
__device__ __forceinline__ Args load_args(LAS unsigned char* lds) {
    const volatile LAS unsigned* T = (const volatile LAS unsigned*)(lds + MISC_OFF) + MW_ARGS;
    Args a;
    a.x = (const float*)ld_argp(T, 0); a.c = (const float*)ld_argp(T, 1); a.pos = (const int*)ld_argp(T, 2); a.w_mod = (const float*)ld_argp(T, 3); a.b_mod = (const float*)ld_argp(T, 4);
    a.norm1_w = (const float*)ld_argp(T, 5); a.w_in = (const float*)ld_argp(T, 6); a.gla_wa2 = (const float*)ld_argp(T, 7); a.gla_ba2 = (const float*)ld_argp(T, 8); a.hg_lb = (const float*)ld_argp(T, 9);
    a.gla_norm_w = (const float*)ld_argp(T, 10); a.hg_norm_w = (const float*)ld_argp(T, 11); a.w_out = (const float*)ld_argp(T, 12); a.norm2_w = (const float*)ld_argp(T, 13); a.w_r = (const float*)ld_argp(T, 14);
    a.b_r = (const float*)ld_argp(T, 15); a.w_gu = (const float*)ld_argp(T, 16); a.b_gu = (const float*)ld_argp(T, 17); a.w_dn = (const float*)ld_argp(T, 18); a.b_dn = (const float*)ld_argp(T, 19);
    a.final_norm_w = (const float*)ld_argp(T, 20); a.out = (float*)ld_argp(T, 21); a.ws = (unsigned char*)ld_argp(T, 22); a.ph_lo = 0; a.ph_hi = 0;
    return a;
}
#define PH_CTX() { unsigned l_ = (unsigned)(size_t)lds; asm volatile("" : "+s"(l_)); lds = (LAS unsigned char*)(size_t)l_; } const Args args = load_args(lds); volatile LAS unsigned* MISC = (volatile LAS unsigned*)(lds + MISC_OFF); int tid_ = wv * 64 + (int)__builtin_amdgcn_mbcnt_hi(~0u, __builtin_amdgcn_mbcnt_lo(~0u, 0u)); asm volatile("" : "+v"(tid_)); const int tid = tid_, lane = tid & 63, wave = __builtin_amdgcn_readfirstlane(tid >> 6); \
    const int G = gridDim.x; const int bx = blockIdx.x; const int vcu = (G % 8 == 0) ? (bx % 8) * (G / 8) + bx / 8 : bx; unsigned char* ws = args.ws; gu32* ctl = (gu32*)(ws + WS_CTL); \
    (void)MISC; (void)lane; (void)wave; (void)vcu; (void)ctl; (void)bx; (void)tid
__device__ __forceinline__ void ph_p0(LAS unsigned char* lds, int wv) { PH_CTX(); p0_prologue(args, lds, vcu, G, tid, lane, wave); }
__device__ __forceinline__ void ph_p1(LAS unsigned char* lds, int wv, int layer_) { int layer = __builtin_amdgcn_readfirstlane(layer_); asm volatile("" : "+s"(layer)); PH_CTX();
    if (layer > 0) { moe_tables(ctl, layer - 1, MISC, tid); const int nrt = __builtin_amdgcn_readfirstlane((int)MISC[MW_NRT]);
        const int done = conv_t2(G) + conv_idle(nrt * 8, G) * NWAVES * CB7 + conv_idle(nrt * 4, G) * NWAVES * CB8; LAS float* scr = (LAS float*)(lds + wave * 16640);
        for (int it = done + vcu * NWAVES + wave; it < IT_LAYER; it += G * NWAVES) convert_item(args, layer, it, scr, lane);
        __syncthreads(); }
    rows_mfma<16>(args, layer, lds, MISC, ctl, vcu, G, tid, lane, wave); }
__device__ __forceinline__ void ph_p2(LAS unsigned char* lds, int wv, int layer_) { int layer = __builtin_amdgcn_readfirstlane(layer_); asm volatile("" : "+s"(layer)); PH_CTX();
    pg8::Gemm g{(const bf16*)(ws + WS_H), (const bf16*)(ws + WS_WIN + (size_t)layer * NPROJ * D * (F8_IN ? 1 : 2)), MTOK, NPROJ, F8_IN ? D / 2 : D}; pg8::StaticOrder S; S.init(MTOK, NPROJ, G, bx);
    pg8::EpiBf16Plain E{(bf16*)(ws + WS_PROJ), NPROJ, F8_IN ? 1.0f / (S8_H * S8_W) : 1.0f};
    pg8::gemm_phase<pg8::EpiBf16Plain, pg8::StaticOrder, true, true, F8_IN>(lds, g, S, E, tid);
    if (layer + 1 < DEPTH && G == 256 && bx >= 64) convert_range(args, layer + 1, ((bx - 64) * NWAVES + wave) * CB2, CB2, lds, lane, wave); }
__device__ __forceinline__ void ph_p3a(LAS unsigned char* lds, int wv, int layer_) { int layer = __builtin_amdgcn_readfirstlane(layer_); asm volatile("" : "+s"(layer)); PH_CTX(); p3a_summaries(args, layer, lds, vcu, G, tid, lane, wave); }
__device__ __forceinline__ void ph_p3b(LAS unsigned char* lds, int wv) { PH_CTX(); p3b_scan(args, vcu, G, tid); }
__device__ __forceinline__ void ph_p3c(LAS unsigned char* lds, int wv, int layer_) { int layer = __builtin_amdgcn_readfirstlane(layer_); asm volatile("" : "+s"(layer)); PH_CTX(); p3c_outputs(args, layer, lds, vcu, G, tid, lane, wave); }
__device__ __forceinline__ void ph_p4(LAS unsigned char* lds, int wv, int layer_) { int layer = __builtin_amdgcn_readfirstlane(layer_); asm volatile("" : "+s"(layer)); PH_CTX();
    pg8::Gemm g{(const bf16*)(ws + WS_MIX), (const bf16*)(ws + WS_WOUT + (size_t)layer * D * D * (F8_OUT ? 1 : 2)), MTOK, D, F8_OUT ? D / 2 : D}; pg8::StaticOrder S; S.init(MTOK, D, G, bx);
    pg8::EpiResGate E{(const bf16*)(ws + WS_X), (bf16*)(ws + WS_X), D, (const float*)(ws + WS_MOD) + (size_t)layer * 2 * 6144 + 2 * D, 6144, SEQ, F8_OUT ? 1.0f / (S8_M * S8_W) : 1.0f};
    pg8::gemm_phase<pg8::EpiResGate, pg8::StaticOrder, true, true, F8_OUT>(lds, g, S, E, tid); }
__device__ __forceinline__ void ph_p5(LAS unsigned char* lds, int wv, int layer_) { int layer = __builtin_amdgcn_readfirstlane(layer_); asm volatile("" : "+s"(layer)); PH_CTX(); rows_mfma<32>(args, layer, lds, MISC, ctl, vcu, G, tid, lane, wave); }
__device__ __forceinline__ void ph_p7(LAS unsigned char* lds, int wv, int layer_) { int layer = __builtin_amdgcn_readfirstlane(layer_); asm volatile("" : "+s"(layer)); PH_CTX();
    moe_tables(ctl, layer, MISC, tid);
    const int nrt = __builtin_amdgcn_readfirstlane((int)MISC[MW_NRT]);
    pg8::Gemm g{(const bf16*)(ws + WS_A1), (const bf16*)(ws + WS_WGU + (size_t)layer * NE * 2048 * D), nrt * 256, NE * 2048, D / 2};
    pg8::MoeOrder S{8, G, vcu, nrt * 8, (const LAS int*)(lds + MISC_OFF + 4 * MW_TILE)};
    pg8::EpiSwiglu E{ws + WS_ACT, FFN, args.b_gu + (size_t)layer * NE * 2048, 1.0f / (S8_H * S8_W), S8_A};
    pg8::gemm_phase<pg8::EpiSwiglu, pg8::MoeOrder, true, true, true>(lds, g, S, E, tid);
    { const int rem = (nrt * 8) % G; if (layer + 1 < DEPTH && rem != 0 && vcu >= rem) convert_range(args, layer + 1, conv_t2(G) + ((vcu - rem) * NWAVES + wave) * CB7, CB7, lds, lane, wave); } }
__device__ __forceinline__ void ph_p8(LAS unsigned char* lds, int wv, int layer_) { int layer = __builtin_amdgcn_readfirstlane(layer_); asm volatile("" : "+s"(layer)); PH_CTX();
    moe_tables(ctl, layer, MISC, tid);
    const int nrt = __builtin_amdgcn_readfirstlane((int)MISC[MW_NRT]);
    pg8::Gemm g{(const bf16*)(ws + WS_ACT), (const bf16*)(ws + WS_WDN + (size_t)layer * NE * D * FFN), nrt * 256, NE * D, FFN / 2};
    pg8::MoeOrder S{4, G, vcu, nrt * 4, (const LAS int*)(lds + MISC_OFF + 4 * MW_TILE)};
    if constexpr (Y8) { pg8::EpiFp8Bias E{ws + WS_Y, D, args.b_dn + (size_t)layer * NE * D, D, 1.0f / (S8_A * S8_W), S8_Y};
        pg8::gemm_phase<pg8::EpiFp8Bias, pg8::MoeOrder, true, true, true>(lds, g, S, E, tid); }
    else { pg8::EpiBf16Bias E{(bf16*)(ws + WS_Y), D, args.b_dn + (size_t)layer * NE * D, D, 1.0f / (S8_A * S8_W)};
        pg8::gemm_phase<pg8::EpiBf16Bias, pg8::MoeOrder, true, true, true>(lds, g, S, E, tid); }
    { const int rem = (nrt * 4) % G; if (layer + 1 < DEPTH && rem != 0 && vcu >= rem) convert_range(args, layer + 1, conv_t2(G) + conv_idle(nrt * 8, G) * NWAVES * CB7 + ((vcu - rem) * NWAVES + wave) * CB8, CB8, lds, lane, wave); } }
__device__ __forceinline__ void ph_final(LAS unsigned char* lds, int wv) { PH_CTX(); final_rows(args, lds, vcu, G, tid, lane); }

#ifndef DBL_MASK
#define DBL_MASK 0
#endif
#if DBL_MASK
#define RUN(bit, call) do { if ((DBL_MASK >> (bit)) & 1) { const unsigned long long t0_ = __builtin_amdgcn_s_memrealtime(); call; const unsigned long long t1_ = __builtin_amdgcn_s_memrealtime(); \
        while (__builtin_amdgcn_s_memrealtime() - t1_ < t1_ - t0_) __builtin_amdgcn_s_sleep(8); } else { call; } } while (0)
#else
#define RUN(bit, call) do { call; } while (0)
#endif
__global__ void __launch_bounds__(NTHR, 2) hybrid_fwd(Args args) {
    extern __shared__ __attribute__((aligned(16))) unsigned char lds_raw[];
    LAS unsigned char* lds = (LAS unsigned char*)lds_raw;
    volatile LAS unsigned* MISC = (volatile LAS unsigned*)(lds + MISC_OFF);
    const int tid = threadIdx.x; const int wv = __builtin_amdgcn_readfirstlane(tid >> 6);
    gu32* ctl = (gu32*)(args.ws + WS_CTL);
    for (int u = tid; u < (LDS_BYTES - MISC_OFF) / 4; u += NTHR) MISC[u] = 0u;
    __syncthreads();
    if (tid == 0) {
#define ST_ARG(i, p) do { const unsigned long long v_ = (unsigned long long)(p); MISC[MW_ARGS + 2 * (i)] = (unsigned)v_; MISC[MW_ARGS + 2 * (i) + 1] = (unsigned)(v_ >> 32); } while (0)
        ST_ARG(0, args.x); ST_ARG(1, args.c); ST_ARG(2, args.pos); ST_ARG(3, args.w_mod); ST_ARG(4, args.b_mod); ST_ARG(5, args.norm1_w); ST_ARG(6, args.w_in); ST_ARG(7, args.gla_wa2); ST_ARG(8, args.gla_ba2);
        ST_ARG(9, args.hg_lb); ST_ARG(10, args.gla_norm_w); ST_ARG(11, args.hg_norm_w); ST_ARG(12, args.w_out); ST_ARG(13, args.norm2_w); ST_ARG(14, args.w_r); ST_ARG(15, args.b_r); ST_ARG(16, args.w_gu);
        ST_ARG(17, args.b_gu); ST_ARG(18, args.w_dn); ST_ARG(19, args.b_dn); ST_ARG(20, args.final_norm_w); ST_ARG(21, args.out); ST_ARG(22, args.ws);
#undef ST_ARG
    }
    __syncthreads();
    const int lo = args.ph_lo, hi = args.ph_hi;
    const bool multi = (hi - lo) > 1;
    XcdBarrier bar; bar.bar = (unsigned*)(ctl + CW_BAR); bar.x = 0; bar.st = nullptr;
    if (multi) bar = xcd_barrier_post((unsigned*)(ctl + CW_BAR), MISC + MW_BAR);
#define IN(k) (lo <= (k) && (k) < hi)
#define SEAM(k) do { if (IN(k) && IN((k) + 1)) xcd_barrier(bar); } while (0)

    if (IN(0)) RUN(0, ph_p0(lds, wv));
    SEAM(0);
    for (int layer = 0; layer < DEPTH; ++layer) {
        const int pb = 1 + 9 * layer;
        if (IN(pb + 0)) RUN(1, ph_p1(lds, wv, layer));
        SEAM(pb + 0);
        if (IN(pb + 1)) RUN(2, ph_p2(lds, wv, layer));
        SEAM(pb + 1);
        if (IN(pb + 2)) RUN(3, ph_p3a(lds, wv, layer));
        SEAM(pb + 2);
        if (IN(pb + 3)) RUN(4, ph_p3b(lds, wv));
        SEAM(pb + 3);
        if (IN(pb + 4)) RUN(5, ph_p3c(lds, wv, layer));
        SEAM(pb + 4);
        if (IN(pb + 5)) RUN(6, ph_p4(lds, wv, layer));
        SEAM(pb + 5);
        if (IN(pb + 6)) RUN(7, ph_p5(lds, wv, layer));
        SEAM(pb + 6);
        if (IN(pb + 7)) RUN(9, ph_p7(lds, wv, layer));
        SEAM(pb + 7);
        if (IN(pb + 8)) RUN(10, ph_p8(lds, wv, layer));
        SEAM(pb + 8);
    }
    if (IN(NPHASE - 1)) RUN(11, ph_final(lds, wv));
#undef IN
#undef SEAM
}

#ifndef MK_SINGLE
#define MK_SINGLE 1
#endif
extern "C" void kernel_launch(void* const* d_in, const int* in_sizes, int n_in, void* d_out, int out_size, void* d_ws, size_t ws_size, hipStream_t stream) {
    static int grid = 0;
    if (grid == 0) {
        if (n_in != 21 || in_sizes[0] != MTOK * D || out_size != MTOK * D || ws_size < WS_END) { fprintf(stderr, "kernel_launch: unexpected problem shape (n_in %d, in0 %d, out %d, ws %zu)\n", n_in, n_in > 0 ? in_sizes[0] : -1, out_size, ws_size); grid = -1; return; }
        int dev = 0, cus = 0, per_cu = 0;
        if (hipGetDevice(&dev) != hipSuccess || hipDeviceGetAttribute(&cus, hipDeviceAttributeMultiprocessorCount, dev) != hipSuccess) { grid = -1; return; }
        if (hipFuncSetAttribute((const void*)hybrid_fwd, hipFuncAttributeMaxDynamicSharedMemorySize, LDS_BYTES) != hipSuccess) { fprintf(stderr, "kernel_launch: hipFuncSetAttribute failed\n"); grid = -1; return; }
        if (hipOccupancyMaxActiveBlocksPerMultiprocessor(&per_cu, (const void*)hybrid_fwd, NTHR, LDS_BYTES) != hipSuccess || per_cu < 1) fprintf(stderr, "kernel_launch: occupancy query says %d\n", per_cu);
        (void)hipGetLastError();
        grid = cus;
    }
    if (grid < 0) return;
    (void)hipMemsetAsync((char*)d_ws + WS_CTL, 0, CTL_ZERO_BYTES, stream);
    Args a{};
    a.x = (const float*)d_in[0]; a.c = (const float*)d_in[1]; a.pos = (const int*)d_in[2]; a.w_mod = (const float*)d_in[3]; a.b_mod = (const float*)d_in[4]; a.norm1_w = (const float*)d_in[5];
    a.w_in = (const float*)d_in[6]; a.gla_wa2 = (const float*)d_in[7]; a.gla_ba2 = (const float*)d_in[8]; a.hg_lb = (const float*)d_in[9]; a.gla_norm_w = (const float*)d_in[10]; a.hg_norm_w = (const float*)d_in[11];
    a.w_out = (const float*)d_in[12]; a.norm2_w = (const float*)d_in[13]; a.w_r = (const float*)d_in[14]; a.b_r = (const float*)d_in[15]; a.w_gu = (const float*)d_in[16]; a.b_gu = (const float*)d_in[17];
    a.w_dn = (const float*)d_in[18]; a.b_dn = (const float*)d_in[19]; a.final_norm_w = (const float*)d_in[20]; a.out = (float*)d_out; a.ws = (unsigned char*)d_ws;
#if MK_SINGLE
    a.ph_lo = 0; a.ph_hi = NPHASE;
    hipLaunchKernelGGL(hybrid_fwd, dim3(grid), dim3(NTHR), LDS_BYTES, stream, a);
#else
    for (int p = 0; p < NPHASE; ++p) { a.ph_lo = p; a.ph_hi = p + 1; hipLaunchKernelGGL(hybrid_fwd, dim3(grid), dim3(NTHR), LDS_BYTES, stream, a); }
#endif
}
```

```cpp
#include <hip/hip_runtime.h>
#include <cstdio>
#include <cstdint>
namespace pg8 {
#define PG8_LAS __attribute__((address_space(3)))
typedef unsigned short bf16_t;
typedef short bf16x8 __attribute__((ext_vector_type(8)));
typedef float f32x4 __attribute__((ext_vector_type(4)));
typedef unsigned u32x4 __attribute__((ext_vector_type(4)));
constexpr int BM = 256, BK = 64, HALF = 128, HTB = HALF * BK * 2  , STAGE_BYTES = 8 * HTB, NXCD = 8, WGM = 8;

__host__ __device__ __forceinline__ int lds_byte(int r, int c) { const int st = (r >> 4) * 2 + (c >> 5), rr = r & 15, cc = c & 31, ob = rr * 64 + cc * 2; return st * 1024 + (ob ^ (((ob >> 9) & 1) << 5)); }
__host__ __device__ __forceinline__ void stage_rc(int b, int& R, int& C) { const int st = b / 1024, sb = b % 1024, swz = sb ^ (((sb >> 9) & 1) << 5); R = (st >> 1) * 16 + swz / 64; C = (st & 1) * 32 + (swz % 64) / 2; }
__host__ __device__ __forceinline__ int perm32(int rho) { const int n = rho >> 4, i = rho & 15; return 8 * (i >> 2) + 4 * n + (i & 3); }

struct Unit { int pm, pn, e, pl; };
struct Gemm { const bf16_t* A; const bf16_t* Bt; int M, N, K; };

struct StaticOrder {
    int nM, nN, nwg, G, c;
    __host__ __device__ void init(int M, int N, int G_, int c_) { nM = M / BM; nN = N / BM; nwg = nM * nN; G = G_; c = c_; }
    __host__ __device__ bool next(int i, Unit& u) const {
        const long L = (long)i * G + c; if (L >= nwg) return false;
        int wgid = (int)L; { const int q = nwg / NXCD, r = nwg % NXCD, xcd = wgid % NXCD, off = wgid / NXCD; wgid = (xcd < r ? xcd * (q + 1) : r * (q + 1) + (xcd - r) * q) + off; }
        const int nig = WGM * nN, gid = wgid / nig, fm = gid * WGM, gsz = (nM - fm) < WGM ? (nM - fm) : WGM;
        u.pm = fm + ((wgid % nig) % gsz); u.pn = (wgid % nig) / gsz; u.e = 0; u.pl = u.pn; return true;
    }
    __device__ __forceinline__ void a_ready(const Unit&) const {}
    __device__ __forceinline__ void done(const Unit&) const {}
};

__device__ __forceinline__ unsigned cvt_pk_bf16(float lo, float hi) { unsigned r; asm volatile("v_cvt_pk_bf16_f32 %0, %1, %2" : "=v"(r) : "v"(lo), "v"(hi)); return r; }

#define PG8_GAS __attribute__((address_space(1)))
struct NoPre {};
struct EpiBf16Plain {
    static constexpr bool PERM = true, AFTER_DRAIN = false; static constexpr int NST = 0; typedef NoPre Pre;
    __device__ __forceinline__ Pre prefetch(const Unit&, int, int) const { return Pre{}; }
    bf16_t* O; int ldc; float sc;
    __device__ __forceinline__ void operator()(const f32x4 (&acc)[2][2][4][2], const Unit& u, int wr, int wc, int fr, int fq, const Pre&) const {
        const int row0 = u.pm * BM + wr * 64 + fr; const int col0 = u.pn * BM + wc * 32 + 8 * fq;
#pragma unroll
        for (int ai = 0; ai < 2; ++ai)
#pragma unroll
            for (int m = 0; m < 4; ++m) { bf16_t* rowp = O + (size_t)(row0 + ai * HALF + m * 16) * ldc + col0;
#pragma unroll
                for (int bj = 0; bj < 2; ++bj) { const f32x4 v0 = acc[ai][bj][m][0] * sc, v1 = acc[ai][bj][m][1] * sc;
                    u32x4 w; w.x = cvt_pk_bf16(v0[0], v0[1]); w.y = cvt_pk_bf16(v0[2], v0[3]); w.z = cvt_pk_bf16(v1[0], v1[1]); w.w = cvt_pk_bf16(v1[2], v1[3]);
                    *(PG8_GAS u32x4*)(rowp + bj * HALF) = w; } }
    }
};
struct EpiResGate {
    static constexpr bool PERM = true, AFTER_DRAIN = false; static constexpr int NST = 0; typedef NoPre Pre;
    __device__ __forceinline__ Pre prefetch(const Unit&, int, int) const { return Pre{}; }
    const bf16_t* base; bf16_t* out; int ldc; const float* gate; int gpitch; int rows_per_batch; float sc;
    __device__ __forceinline__ void operator()(const f32x4 (&acc)[2][2][4][2], const Unit& u, int wr, int wc, int fr, int fq, const Pre&) const {
        const int row0 = u.pm * BM + wr * 64 + fr, col0 = u.pn * BM + wc * 32 + 8 * fq;
        const float* gp = gate + (size_t)((u.pm * BM) / rows_per_batch) * gpitch + col0;
        f32x4 gv[2][2];
#pragma unroll
        for (int bj = 0; bj < 2; ++bj)
#pragma unroll
            for (int n = 0; n < 2; ++n) gv[bj][n] = *(const PG8_GAS f32x4*)(gp + bj * HALF + 4 * n) * sc;
#pragma unroll
        for (int ai = 0; ai < 2; ++ai)
#pragma unroll
            for (int m = 0; m < 4; ++m) { const size_t off = (size_t)(row0 + ai * HALF + m * 16) * ldc + col0;
#pragma unroll
                for (int bj = 0; bj < 2; ++bj) { const u32x4 bs = *(const PG8_GAS u32x4*)(base + off + bj * HALF); const unsigned bw[4] = {bs.x, bs.y, bs.z, bs.w}; float r[8];
#pragma unroll
                    for (int j = 0; j < 4; ++j) { const f32x4& a4 = acc[ai][bj][m][j >> 1]; const f32x4& g4 = gv[bj][j >> 1];
                        r[2 * j] = __builtin_bit_cast(float, bw[j] << 16) + g4[2 * (j & 1)] * a4[2 * (j & 1)]; r[2 * j + 1] = __builtin_bit_cast(float, bw[j] & 0xffff0000u) + g4[2 * (j & 1) + 1] * a4[2 * (j & 1) + 1]; }
                    u32x4 w; w.x = cvt_pk_bf16(r[0], r[1]); w.y = cvt_pk_bf16(r[2], r[3]); w.z = cvt_pk_bf16(r[4], r[5]); w.w = cvt_pk_bf16(r[6], r[7]);
                    *(PG8_GAS u32x4*)(out + off + bj * HALF) = w; }
                asm volatile("" ::: "memory"); }
    }
};
struct EpiSwiglu {
    static constexpr bool PERM = true, AFTER_DRAIN = false; static constexpr int NST = 0; struct Pre { f32x4 bg[2], bu[2]; };
    __device__ __forceinline__ Pre prefetch(const Unit& u, int wc, int fq) const { typedef const __attribute__((address_space(1))) f32x4 gf4;
        const float* bp = bias + (size_t)u.e * 2048 + u.pl * HALF + wc * 32 + 8 * fq; Pre p; p.bg[0] = *(gf4*)bp; p.bg[1] = *(gf4*)(bp + 4); p.bu[0] = *(gf4*)(bp + 1024); p.bu[1] = *(gf4*)(bp + 1028); return p; }
    unsigned char* O; int ldc; const float* bias; float inv_in, out_scale;
    __device__ __forceinline__ float act1(float g, float up) const {
        g = fminf(g, 7.0f); up = fminf(fmaxf(up, -7.0f), 7.0f);
        const float s = __builtin_amdgcn_rcpf(1.0f + __builtin_amdgcn_exp2f(-1.702f * 1.4426950408889634f * g));
        return (up + 1.0f) * g * s * out_scale;
    }
    __device__ __forceinline__ void operator()(const f32x4 (&acc)[2][2][4][2], const Unit& u, int wr, int wc, int fr, int fq, const Pre& pre) const {
        const int row0 = u.pm * BM + wr * 64 + fr; const int jj0 = wc * 32 + 8 * fq; const int col0 = u.pl * HALF + jj0;
        const f32x4 bg[2] = {pre.bg[0], pre.bg[1]}, bu[2] = {pre.bu[0], pre.bu[1]};
#pragma unroll
        for (int ai = 0; ai < 2; ++ai)
#pragma unroll
            for (int m = 0; m < 4; ++m) { unsigned char* rowp = O + (size_t)(row0 + ai * HALF + m * 16) * ldc + col0;
                f32x4 r[2];
#pragma unroll
                for (int n = 0; n < 2; ++n) { const f32x4 g = acc[ai][0][m][n] * inv_in + bg[n], up = acc[ai][1][m][n] * inv_in + bu[n];
#pragma unroll
                    for (int j = 0; j < 4; ++j) r[n][j] = act1(g[j], up[j]); }
                int w0 = 0, w1 = 0;
                w0 = __builtin_amdgcn_cvt_pk_fp8_f32(r[0][0], r[0][1], w0, false); w0 = __builtin_amdgcn_cvt_pk_fp8_f32(r[0][2], r[0][3], w0, true);
                w1 = __builtin_amdgcn_cvt_pk_fp8_f32(r[1][0], r[1][1], w1, false); w1 = __builtin_amdgcn_cvt_pk_fp8_f32(r[1][2], r[1][3], w1, true);
                typedef int i32x2 __attribute__((ext_vector_type(2))); *(PG8_GAS i32x2*)rowp = (i32x2){w0, w1}; }
    }
};
struct EpiBf16Bias {
    static constexpr bool PERM = true, AFTER_DRAIN = false; static constexpr int NST = 0; typedef NoPre Pre;
    __device__ __forceinline__ Pre prefetch(const Unit&, int, int) const { return Pre{}; }
    bf16_t* O; int ldc; const float* bias; int bpitch; float inv_in;
    __device__ __forceinline__ void operator()(const f32x4 (&acc)[2][2][4][2], const Unit& u, int wr, int wc, int fr, int fq, const Pre&) const {
        const int row0 = u.pm * BM + wr * 64 + fr; const int col0 = u.pl * BM + wc * 32 + 8 * fq;
        const float* bp = bias + (size_t)u.e * bpitch + col0;
        f32x4 bv[2][2];
#pragma unroll
        for (int bj = 0; bj < 2; ++bj)
#pragma unroll
            for (int n = 0; n < 2; ++n) bv[bj][n] = *(const PG8_GAS f32x4*)(bp + bj * HALF + 4 * n);
#pragma unroll
        for (int ai = 0; ai < 2; ++ai)
#pragma unroll
            for (int m = 0; m < 4; ++m) { bf16_t* rowp = O + (size_t)(row0 + ai * HALF + m * 16) * ldc + col0;
#pragma unroll
                for (int bj = 0; bj < 2; ++bj) { const f32x4 v0 = acc[ai][bj][m][0] * inv_in + bv[bj][0], v1 = acc[ai][bj][m][1] * inv_in + bv[bj][1];
                    u32x4 w; w.x = cvt_pk_bf16(v0[0], v0[1]); w.y = cvt_pk_bf16(v0[2], v0[3]); w.z = cvt_pk_bf16(v1[0], v1[1]); w.w = cvt_pk_bf16(v1[2], v1[3]);
                    *(PG8_GAS u32x4*)(rowp + bj * HALF) = w; } }
    }
};
struct EpiFp8Bias {
    static constexpr bool PERM = true, AFTER_DRAIN = false; static constexpr int NST = 0; struct Pre { f32x4 bv[2][2]; };
    __device__ __forceinline__ Pre prefetch(const Unit& u, int wc, int fq) const { typedef const __attribute__((address_space(1))) f32x4 gf4;
        const float* bp = bias + (size_t)u.e * bpitch + u.pl * BM + wc * 32 + 8 * fq; Pre p; p.bv[0][0] = *(gf4*)bp; p.bv[0][1] = *(gf4*)(bp + 4); p.bv[1][0] = *(gf4*)(bp + HALF); p.bv[1][1] = *(gf4*)(bp + HALF + 4); return p; }
    unsigned char* O; int ldc; const float* bias; int bpitch; float inv_in, out_scale;
    __device__ __forceinline__ int pk4(f32x4 v) const { int w = 0; w = __builtin_amdgcn_cvt_pk_fp8_f32(__builtin_amdgcn_fmed3f(v[0], -448.f, 448.f), __builtin_amdgcn_fmed3f(v[1], -448.f, 448.f), w, false);
        return __builtin_amdgcn_cvt_pk_fp8_f32(__builtin_amdgcn_fmed3f(v[2], -448.f, 448.f), __builtin_amdgcn_fmed3f(v[3], -448.f, 448.f), w, true); }
    __device__ __forceinline__ void operator()(const f32x4 (&acc)[2][2][4][2], const Unit& u, int wr, int wc, int fr, int fq, const Pre& pre) const {
        const int row0 = u.pm * BM + wr * 64 + fr; const int col0 = u.pl * BM + wc * 32 + 8 * fq;
        const f32x4 bv[2][2] = {{pre.bv[0][0], pre.bv[0][1]}, {pre.bv[1][0], pre.bv[1][1]}};
#pragma unroll
        for (int ai = 0; ai < 2; ++ai)
#pragma unroll
            for (int m = 0; m < 4; ++m) { unsigned char* rowp = O + (size_t)(row0 + ai * HALF + m * 16) * ldc + col0;
#pragma unroll
                for (int bj = 0; bj < 2; ++bj) { const f32x4 v0 = (acc[ai][bj][m][0] * inv_in + bv[bj][0]) * out_scale, v1 = (acc[ai][bj][m][1] * inv_in + bv[bj][1]) * out_scale;
                    typedef int i32x2 __attribute__((ext_vector_type(2))); *(PG8_GAS i32x2*)(rowp + bj * HALF) = (i32x2){pk4(v0), pk4(v1)}; } }
    }
};
struct MoeOrder {
    int nN, G, c, nunits; const PG8_LAS int* tile_pm;
    __device__ __forceinline__ bool next(int i, Unit& u) const {
        const int L = i * G + c; if (L >= nunits) return false;
        const int idx = L / nN, pl = L - idx * nN, pm = __builtin_amdgcn_readfirstlane(tile_pm[idx]), e = pm >> 6;
        u.pm = pm; u.pl = pl; u.e = e; u.pn = e * nN + pl; return true;
    }
    __device__ __forceinline__ void a_ready(const Unit&) const {}
    __device__ __forceinline__ void done(const Unit&) const {}
};
typedef int v4i32_t __attribute__((ext_vector_type(4)));
typedef int v8i32_t __attribute__((ext_vector_type(8)));
template <class Epi, class Sched, bool ALIGN_EPI = false, bool SP2 = false, bool FP8 = false>
__device__ __forceinline__ void gemm_phase(PG8_LAS unsigned char* lds, const Gemm g, const Sched& S, const Epi& E, int tid_in) {
    int tid_ = tid_in; asm volatile("" : "+v"(tid_)); const int tid = tid_, wid = __builtin_amdgcn_readfirstlane(tid >> 6), lane = tid & 63, wr = wid >> 2, wc = wid & 3, fr = lane & 15, fq = lane >> 4;
    const int K = g.K, nt = K / BK;
    unsigned voffA, voffB;
    { int R, C; stage_rc(tid * 16, R, C); const int Rb = Epi::PERM ? ((R & ~31) + perm32(R & 31)) : R;
        voffA = (unsigned)(R * K + C) * 2u; voffB = (unsigned)(Rb * K + C) * 2u; }
    const size_t rstep = (size_t)64 * K * 2;
    const size_t kstep = (size_t)(BK * 2);
    const size_t hstep = (size_t)HALF * K * 2;
    const size_t tstep = 2 * hstep;
    const unsigned ldsw = (unsigned)wid * 1024u;
    const int aoff = lds_byte(wr * 64 + fr, fq * 8), boff = lds_byte(wc * 32 + fr, fq * 8);
#define PG8_SA(b, h) (((b) * 2 + (h)) * HTB)
#define PG8_SB(b, h) ((4 + (b) * 2 + (h)) * HTB)
#define PG8_STAGE(bufoff, gbase, voff) do { _Pragma("unroll") for (int _i = 0; _i < 2; ++_i) \
        __builtin_amdgcn_global_load_lds((const unsigned*)((const char*)(gbase) + _i * rstep + (voff)), (PG8_LAS unsigned*)(lds + (bufoff) + ldsw + _i * 8192), 16, 0, 0); } while (0)
#define PG8_LDA(dst, b, h) do { _Pragma("unroll") for (int m = 0; m < 4; ++m) _Pragma("unroll") for (int k = 0; k < 2; ++k) dst[m][k] = *(const PG8_LAS bf16x8*)(lds + PG8_SA(b, h) + aoff + m * 2048 + k * 1024); } while (0)
#define PG8_LDB(dst, b, h) do { _Pragma("unroll") for (int n = 0; n < 2; ++n) _Pragma("unroll") for (int k = 0; k < 2; ++k) dst[n][k] = *(const PG8_LAS bf16x8*)(lds + PG8_SB(b, h) + boff + n * 2048 + k * 1024); } while (0)
#define PG8_MMA(ai, bj, At, Bt) do { __builtin_amdgcn_s_setprio(1); _Pragma("unroll") for (int m = 0; m < 4; ++m) _Pragma("unroll") for (int n = 0; n < 2; ++n) { \
        if constexpr (FP8) { const v8i32_t a8_ = __builtin_shufflevector(__builtin_bit_cast(v4i32_t, At[m][0]), __builtin_bit_cast(v4i32_t, At[m][1]), 0, 1, 2, 3, 4, 5, 6, 7); \
            const v8i32_t b8_ = __builtin_shufflevector(__builtin_bit_cast(v4i32_t, Bt[n][0]), __builtin_bit_cast(v4i32_t, Bt[n][1]), 0, 1, 2, 3, 4, 5, 6, 7); \
            asm volatile("v_mfma_scale_f32_16x16x128_f8f6f4 %0, %1, %2, %0, %3, %3 op_sel_hi:[0,0,0]" : "+v"(acc[ai][bj][m][n]) : "v"(b8_), "v"(a8_), "v"(one8_)); } \
        else { _Pragma("unroll") for (int k = 0; k < 2; ++k) acc[ai][bj][m][n] = __builtin_amdgcn_mfma_f32_16x16x32_bf16(Bt[n][k], At[m][k], acc[ai][bj][m][n], 0, 0, 0); } } \
        __builtin_amdgcn_s_setprio(0); } while (0)
#define PG8_WAIT_V(n) asm volatile("s_waitcnt vmcnt(" #n ")" ::: "memory")
#define PG8_WAIT_L(n) asm volatile("s_waitcnt lgkmcnt(" #n ")" ::: "memory")
#define PG8_WAIT_V8R(relax) do { if (relax) { if constexpr (Epi::NST == 8) PG8_WAIT_V(16); else if constexpr (Epi::NST == 16) PG8_WAIT_V(24); else PG8_WAIT_V(8); } else PG8_WAIT_V(8); } while (0)
#define PG8_BAR __builtin_amdgcn_s_barrier()
#define PG8_SCHED __builtin_amdgcn_sched_barrier(0)
    Unit cur, nxt; int ui = 0;
    if (!S.next(0, cur)) return;
    f32x4 acc[2][2][4][2];
#pragma unroll
    for (int a = 0; a < 2; ++a)
#pragma unroll
        for (int b = 0; b < 2; ++b)
#pragma unroll
            for (int m = 0; m < 4; ++m)
#pragma unroll
                for (int n = 0; n < 2; ++n) acc[a][b][m][n] = (f32x4){0.f, 0.f, 0.f, 0.f};
    bf16x8 At[4][2], B0[2][2], B1[2][2];
    int one8_ = 0x7f7f7f7f; asm volatile("" : "+v"(one8_));
    const char* cA = (const char*)g.A + (size_t)cur.pm * tstep; const char* cB = (const char*)g.Bt + (size_t)cur.pn * tstep;
    S.a_ready(cur);
    if constexpr (SP2) {
        PG8_STAGE(PG8_SB(0, 0), cB, voffB); PG8_STAGE(PG8_SB(0, 1), cB + hstep, voffB); PG8_STAGE(PG8_SA(0, 0), cA, voffA); PG8_STAGE(PG8_SA(0, 1), cA + hstep, voffA);
        if (wr == 1) PG8_BAR;
        PG8_WAIT_V(2); PG8_BAR;
        PG8_STAGE(PG8_SB(1, 0), cB + kstep, voffB); PG8_STAGE(PG8_SA(1, 0), cA + kstep, voffA); PG8_STAGE(PG8_SB(1, 1), cB + hstep + kstep, voffB);
        PG8_WAIT_V(6); PG8_BAR;
    } else {
        PG8_STAGE(PG8_SB(0, 0), cB, voffB); PG8_STAGE(PG8_SA(0, 0), cA, voffA); PG8_STAGE(PG8_SB(0, 1), cB + hstep, voffB); PG8_STAGE(PG8_SA(0, 1), cA + hstep, voffA);
        if (wr == 1) PG8_BAR;
        PG8_WAIT_V(4); PG8_BAR;
        PG8_STAGE(PG8_SB(1, 0), cB + kstep, voffB); PG8_STAGE(PG8_SA(1, 0), cA + kstep, voffA); PG8_STAGE(PG8_SB(1, 1), cB + hstep + kstep, voffB);
        PG8_WAIT_V(6); PG8_BAR;
    }
    for (;;) {
        const bool has_next = S.next(ui + 1, nxt);
        typename Epi::Pre pre_; { int lp_ = (int)__builtin_amdgcn_mbcnt_hi(~0u, __builtin_amdgcn_mbcnt_lo(~0u, 0u)); asm volatile("" : "+v"(lp_)); pre_ = E.prefetch(cur, wc, lp_ >> 4); }
        const char* nA = has_next ? (const char*)g.A + (size_t)nxt.pm * tstep : cA; const char* nB = has_next ? (const char*)g.Bt + (size_t)nxt.pn * tstep : cB;
#pragma unroll 1
        for (int t = 0; t < nt; t += 2) {
            const bool last = (t == nt - 2);
            const char* a1 = cA + (size_t)(t + 1) * kstep;
            const char* a2 = last ? nA : cA + (size_t)(t + 2) * kstep; const char* b2 = last ? nB : cB + (size_t)(t + 2) * kstep;
            const char* a3 = a2 + kstep; const char* b3 = b2 + kstep;
            if (last && has_next) S.a_ready(nxt);
            const bool relax = (Epi::NST > 0) && (ui > 0) && (t == 0);
            if constexpr (SP2) {
            PG8_LDB(B0, 0, 0); PG8_LDB(B1, 0, 1); PG8_SCHED; PG8_LDA(At, 0, 0); PG8_STAGE(PG8_SA(1, 1), a1 + hstep, voffA);
            PG8_WAIT_V8R(relax); PG8_WAIT_L(0); PG8_BAR; PG8_MMA(0, 0, At, B0); PG8_MMA(0, 1, At, B1); PG8_BAR; PG8_SCHED;
            PG8_LDA(At, 0, 1); PG8_STAGE(PG8_SB(0, 0), b2, voffB); PG8_STAGE(PG8_SB(0, 1), b2 + hstep, voffB); PG8_STAGE(PG8_SA(0, 0), a2, voffA);
            PG8_WAIT_V8R(relax); PG8_WAIT_L(0); PG8_BAR; PG8_MMA(1, 0, At, B0); PG8_MMA(1, 1, At, B1); PG8_BAR; PG8_SCHED;
            PG8_LDB(B0, 1, 0); PG8_LDB(B1, 1, 1); PG8_SCHED; PG8_LDA(At, 1, 0); PG8_STAGE(PG8_SA(0, 1), a2 + hstep, voffA);
            PG8_WAIT_V(8); PG8_WAIT_L(0); PG8_BAR; PG8_MMA(0, 0, At, B0); PG8_MMA(0, 1, At, B1); PG8_BAR; PG8_SCHED;
            PG8_LDA(At, 1, 1); PG8_STAGE(PG8_SB(1, 0), b3, voffB); PG8_STAGE(PG8_SB(1, 1), b3 + hstep, voffB); PG8_STAGE(PG8_SA(1, 0), a3, voffA);
            PG8_WAIT_V(8); PG8_WAIT_L(0); PG8_BAR; PG8_MMA(1, 0, At, B0); PG8_MMA(1, 1, At, B1); PG8_BAR; PG8_SCHED;
            } else {
            PG8_LDB(B0, 0, 0); PG8_SCHED; PG8_LDA(At, 0, 0); PG8_STAGE(PG8_SA(1, 1), a1 + hstep, voffA);
            PG8_WAIT_L(8); PG8_BAR; PG8_WAIT_L(0); PG8_MMA(0, 0, At, B0); PG8_BAR; PG8_SCHED;
            PG8_LDB(B1, 0, 1); PG8_STAGE(PG8_SB(0, 0), b2, voffB);
            PG8_BAR; PG8_WAIT_L(0); PG8_MMA(0, 1, At, B1); PG8_BAR;
            PG8_LDA(At, 0, 1); PG8_STAGE(PG8_SA(0, 0), a2, voffA);
            PG8_BAR; PG8_WAIT_L(0); PG8_MMA(1, 0, At, B0); PG8_BAR; PG8_SCHED;
            PG8_STAGE(PG8_SB(0, 1), b2 + hstep, voffB);
            PG8_WAIT_V(6); PG8_BAR; PG8_MMA(1, 1, At, B1); PG8_BAR;
            PG8_LDB(B0, 1, 0); PG8_SCHED; PG8_LDA(At, 1, 0); PG8_STAGE(PG8_SA(0, 1), a2 + hstep, voffA);
            PG8_WAIT_L(8); PG8_BAR; PG8_WAIT_L(0); PG8_MMA(0, 0, At, B0); PG8_BAR; PG8_SCHED;
            PG8_LDB(B1, 1, 1); PG8_STAGE(PG8_SB(1, 0), b3, voffB);
            PG8_BAR; PG8_WAIT_L(0); PG8_MMA(0, 1, At, B1); PG8_BAR;
            PG8_LDA(At, 1, 1); PG8_STAGE(PG8_SA(1, 0), a3, voffA);
            PG8_BAR; PG8_WAIT_L(0); PG8_MMA(1, 0, At, B0); PG8_BAR; PG8_SCHED;
            PG8_STAGE(PG8_SB(1, 1), b3 + hstep, voffB);
            PG8_WAIT_V(6); PG8_BAR; PG8_MMA(1, 1, At, B1); PG8_BAR;
            }
        }
        if constexpr (FP8) asm volatile("s_nop 7\n\ts_nop 7" ::: "memory");
        if constexpr (ALIGN_EPI) { if (wr == 0) PG8_BAR; }
        if constexpr (!Epi::AFTER_DRAIN) { int ln_ = (int)__builtin_amdgcn_mbcnt_hi(~0u, __builtin_amdgcn_mbcnt_lo(~0u, 0u)); asm volatile("" : "+v"(ln_)); E(acc, cur, wr, wc, ln_ & 15, ln_ >> 4, pre_); S.done(cur); }
        if (!has_next) break;
#pragma unroll
        for (int a = 0; a < 2; ++a)
#pragma unroll
            for (int b = 0; b < 2; ++b)
#pragma unroll
                for (int m = 0; m < 4; ++m)
#pragma unroll
                    for (int n = 0; n < 2; ++n) acc[a][b][m][n] = (f32x4){0.f, 0.f, 0.f, 0.f};
        cur = nxt; cA = nA; cB = nB; ++ui;
        if constexpr (ALIGN_EPI) { if (wr == 1) PG8_BAR; }
    }
    PG8_WAIT_V(0);
    if constexpr (!ALIGN_EPI) { if (wr == 0) PG8_BAR; }
    PG8_BAR;
    if constexpr (Epi::AFTER_DRAIN) { E.fused(acc, cur, wr, wc, fr, fq, lds, wid, lane); S.done(cur); }
#undef PG8_SA
#undef PG8_SB
#undef PG8_STAGE
#undef PG8_LDA
#undef PG8_LDB
#undef PG8_MMA
#undef PG8_WAIT_V
#undef PG8_WAIT_L
#undef PG8_BAR
#undef PG8_SCHED
}
}

constexpr int NWAVES = 8, NTHR = 512;
constexpr int BATCH = 2, SEQ = 8192, D = 1024, DEPTH = 4, MTOK = BATCH * SEQ;
constexpr int DIN = 3344, NPROJ = 3328, SRC_GA = 1152;
constexpr int C_GQ = 0, C_GK = 192, C_GV = 384, C_GG = 768, C_HQ = 1152, C_HF = 1408, C_HI = 1664, C_HG = 1920, C_RQ = 2176, C_RK = 2368, C_RV = 2560, C_RG = 2944;
constexpr int NE = 32, FFN = 1024;
constexpr int CH = 64, NCH = SEQ / CH, NUNIT = BATCH * NCH;
constexpr int ST_GLA = 0, ST_HG = 4 * 48 * 96, ST_RET = ST_HG + 4 * 64 * 64, ST_TOT = ST_RET + 4 * 48 * 96;
constexpr int NDV = 448, NKT = 640;
constexpr int MAXROWS = 65536 + NE * 256, MAXRT = MAXROWS / 256;
constexpr float EPS = 1e-6f;
#ifndef F8_IN_V
#define F8_IN_V false
#endif
#ifndef F8_OUT_V
#define F8_OUT_V true
#endif
constexpr bool F8_IN = F8_IN_V, F8_OUT = F8_OUT_V;
#ifndef Y8_V
#define Y8_V true
#endif
constexpr bool Y8 = Y8_V;
constexpr float S8_Y = 16.f;
constexpr float S8_M = 32.f;
constexpr float S8_W = 2048.f, S8_H = 64.f, S8_A = 8.f;
constexpr int NPHASE = 38;
constexpr int ECAP = 16384, ECAP_SH = 14;

constexpr size_t MiB = 1u << 20;
constexpr size_t WS_CTL = 0, CTL_ZERO_BYTES = 65536;
constexpr size_t WS_MOD = 1 * MiB;
constexpr size_t WS_ROPE = 2 * MiB;
constexpr size_t WS_LB = 5 * MiB;
constexpr size_t WS_WIN = 8 * MiB;
constexpr size_t WS_WOUT = 34 * MiB;
constexpr size_t WS_WGU = 42 * MiB;
constexpr size_t WS_WDN = 554 * MiB;
constexpr size_t WS_X = 810 * MiB;
constexpr size_t WS_H = 874 * MiB;
constexpr size_t WS_GA = 906 * MiB;
constexpr size_t WS_PROJ = 907 * MiB;
constexpr size_t WS_U = 1011 * MiB;
constexpr size_t WS_DVEC = 1063 * MiB;
constexpr size_t WS_SP = 1064 * MiB;
constexpr size_t WS_MIX = 1090 * MiB;
constexpr size_t WS_TOPE = 1122 * MiB;
constexpr size_t WS_TOPW = WS_TOPE + 256 * 1024;
constexpr size_t WS_SLOT = WS_TOPW + 256 * 1024;
constexpr size_t WS_A1 = 1123 * MiB;
constexpr size_t WS_ACT = 1635 * MiB;
constexpr size_t WS_Y = 2147 * MiB;
constexpr size_t WS_CUM = 3171 * MiB;
constexpr size_t WS_KT = 3199 * MiB;
constexpr size_t WS_END = 3239 * MiB;
static_assert(WS_WIN + (size_t)DEPTH * NPROJ * D * 2 <= WS_WOUT && WS_PROJ + (size_t)MTOK * NPROJ * 2 <= WS_U && WS_U + (size_t)NUNIT * ST_TOT * 4 <= WS_DVEC && WS_SP + (size_t)NUNIT * ST_TOT * 2 <= WS_MIX && WS_A1 + (size_t)NE * ECAP * D <= WS_ACT && WS_ACT + (size_t)NE * ECAP * D <= WS_Y && WS_Y + (size_t)NE * ECAP * D * 2 <= WS_CUM, "ws map");
constexpr int CW_TMO = 0, CW_CODE = 1, CW_BAR = 4096, CW_CNT = 8192, CW_FILL = 8192 + 256;
constexpr int RING_BYTES = 131072;
constexpr int MISC_OFF = 147456, LDS_BYTES = MISC_OFF + 4096;
constexpr int MW_BAR = 0, MW_CNT = 16, MW_PST = 48, MW_HIST = 96, MW_BASE = 128, MW_TILE = 192, MW_NRT = 480, MW_SLOTS = 512;

#define GAS __attribute__((address_space(1)))
#define LAS __attribute__((address_space(3)))
typedef unsigned v4u __attribute__((ext_vector_type(4)));
typedef float f32x4 __attribute__((ext_vector_type(4)));
typedef short bf16x8 __attribute__((ext_vector_type(8)));
typedef GAS unsigned gu32;
typedef GAS unsigned long long gu64;
#define RLX_AGENT __ATOMIC_RELAXED, __HIP_MEMORY_SCOPE_AGENT
#define LDS_WAIT() asm volatile("s_waitcnt lgkmcnt(0)" ::: "memory")
#define VM_WAIT() asm volatile("s_waitcnt vmcnt(0)" ::: "memory")
__device__ __forceinline__ unsigned long long rt() { return __builtin_amdgcn_s_memrealtime(); }
typedef unsigned short bf16;
typedef float f32x2_t __attribute__((ext_vector_type(2))); typedef __bf16 bf16x2_t __attribute__((ext_vector_type(2)));
__device__ __forceinline__ unsigned pk2(float lo, float hi) { const f32x2_t v = {lo, hi}; return __builtin_bit_cast(unsigned, __builtin_convertvector(v, bf16x2_t)); }
__device__ __forceinline__ unsigned f2bf(float f) { return pk2(f, 0.f) & 0xffffu; }
__device__ __forceinline__ float bf2f(bf16 b) { return __builtin_bit_cast(float, (unsigned)b << 16); }
#define XB_TMO      128
#define XB_XCNT(j)  (256  + 64 * (j))
#define XB_XSUB(j)  (1280 + 64 * (j))
#define XB_XGEN(j)  (2304 + 64 * (j))
#define XB_TOP      3328
#define XB_TOPGEN   3392
#define XCD_BAR_WORDS 3456
#define XB_SPIN_CAP (1u << 18)

__device__ __forceinline__ unsigned xb_ld(unsigned* p)              { return __hip_atomic_load(p, __ATOMIC_RELAXED, __HIP_MEMORY_SCOPE_AGENT); }
__device__ __forceinline__ unsigned xb_add(unsigned* p, unsigned v) { return __hip_atomic_fetch_add(p, v, __ATOMIC_RELAXED, __HIP_MEMORY_SCOPE_AGENT); }
__device__ __forceinline__ unsigned xb_xcc_id() { return (unsigned)__builtin_amdgcn_s_getreg((3 << 11) | 20) & 0xFu; }
#define XB_SPIN(cond, bar) do { unsigned _sp = 0; while (cond) { __builtin_amdgcn_s_sleep(1); \
    if ((++_sp & 255u) == 0u) { if (xb_ld(&(bar)[XB_TMO])) break; if (_sp > XB_SPIN_CAP) { atomicAdd(&(bar)[XB_TMO], 1u); break; } } } } while (0)

struct XcdBarrier {
    unsigned* bar; unsigned x;
    volatile LAS unsigned* st;
};

__device__ __forceinline__ XcdBarrier xcd_barrier_post(unsigned* bar, volatile LAS unsigned* st) {
    XcdBarrier b; b.bar = bar; b.x = xb_xcc_id(); b.st = st;
    if (threadIdx.x == 0) (void)xb_add(&bar[XB_XCNT(b.x)], 1u);
    return b;
}
__device__ __forceinline__ void xcd_barrier_complete(unsigned* bar, unsigned x, unsigned& nloc, unsigned& nx) {
    const unsigned G = gridDim.x * gridDim.y * gridDim.z;
    unsigned sum, cnt, mine, sp = 0u;
    for (;;) {
        sum = 0u; cnt = 0u; mine = 0u;
#pragma unroll
        for (unsigned j = 0; j < 16; ++j) { const unsigned c = xb_ld(&bar[XB_XCNT(j)]); sum += c; cnt += (c > 0u) ? 1u : 0u; mine = (j == x) ? c : mine; }
        if (sum == G) break;
        __builtin_amdgcn_s_sleep(1);
        if ((++sp & 255u) == 0u) { if (xb_ld(&bar[XB_TMO])) break; if (sp > XB_SPIN_CAP) { atomicAdd(&bar[XB_TMO], 1u); break; } }
    }
    nloc = mine > 0u ? mine : 1u; nx = cnt > 0u ? cnt : 1u;
}

__device__ __forceinline__ void xcd_barrier(const XcdBarrier& b) {
    asm volatile("s_waitcnt vmcnt(0)" ::: "memory");
    __syncthreads();
    if (threadIdx.x == 0) {
        unsigned* bar = b.bar;
        __builtin_amdgcn_s_waitcnt(0);
        unsigned nloc = b.st[0], nx = b.st[1];
        if (nloc == 0u) { xcd_barrier_complete(bar, b.x, nloc, nx); b.st[0] = nloc; b.st[1] = nx; }
        const unsigned old = xb_add(&bar[XB_XSUB(b.x)], 1u);
        const unsigned gen = old / nloc;
        if (old + 1u == (gen + 1u) * nloc) {
            __builtin_amdgcn_fence(__ATOMIC_RELEASE, "agent");
            asm volatile("s_waitcnt vmcnt(0)" ::: "memory");
            const unsigned og = xb_add(&bar[XB_TOP], 1u);
            const unsigned tg = og / nx;
            if (og + 1u == (tg + 1u) * nx) xb_add(&bar[XB_TOPGEN], 1u);
            else XB_SPIN(xb_ld(&bar[XB_TOPGEN]) == tg, bar);
            __builtin_amdgcn_fence(__ATOMIC_ACQUIRE, "agent");
            xb_add(&bar[XB_XGEN(b.x)], 1u);
            asm volatile("s_waitcnt vmcnt(0)" ::: "memory");
        } else {
            XB_SPIN(xb_ld(&bar[XB_XGEN(b.x)]) == gen, bar);
            __builtin_amdgcn_fence(__ATOMIC_ACQUIRE, "agent");
            asm volatile("s_waitcnt vmcnt(0)" ::: "memory");
        }
    }
    __syncthreads();
}

__device__ __forceinline__ float wave_sum(float v) {
#pragma unroll
    for (int o = 1; o < 64; o <<= 1) v += __shfl_xor(v, o);
    return v;
}
__device__ __forceinline__ float log_sigmoid_f(float x) { return fminf(x, 0.f) - log1pf(expf(-fabsf(x))); }
__device__ __forceinline__ float silu_f(float x) { return x / (1.0f + expf(-x)); }
__device__ __forceinline__ float sigmoid_f(float x) { return 1.0f / (1.0f + expf(-x)); }
__device__ __forceinline__ pg8::bf16x8 ldfrag(const LAS bf16* base, int stride, int r0, int k0, int lane) {
    return *(const LAS pg8::bf16x8*)(base + (r0 + (lane & 15)) * stride + k0 + 8 * (lane >> 4));
}
__device__ __forceinline__ pg8::bf16x8 pack8(const float (&v)[8]) { v4u w; w.x = pk2(v[0], v[1]); w.y = pk2(v[2], v[3]); w.z = pk2(v[4], v[5]); w.w = pk2(v[6], v[7]); return __builtin_bit_cast(pg8::bf16x8, w); }

struct Args {
    const float* x; const float* c; const int* pos; const float* w_mod; const float* b_mod; const float* norm1_w; const float* w_in; const float* gla_wa2; const float* gla_ba2; const float* hg_lb;
    const float* gla_norm_w; const float* hg_norm_w; const float* w_out; const float* norm2_w; const float* w_r; const float* b_r; const float* w_gu; const float* b_gu; const float* w_dn; const float* b_dn;
    const float* final_norm_w; float* out; unsigned char* ws; int ph_lo, ph_hi;
};

__device__ __forceinline__ void transpose_block64(const float* src, int ld, bf16* dst, LAS float*, int lane) {
    const int n4 = lane & 15, kg = lane >> 4;
    f32x4 v[16];
#pragma unroll
    for (int i = 0; i < 16; ++i) v[i] = __builtin_nontemporal_load((const f32x4*)(src + (size_t)(16 * kg + i) * ld + 4 * n4));
#pragma unroll
    for (int j = 0; j < 4; ++j) { v4u o0, o1;
        o0.x = pk2(v[0][j], v[1][j]); o0.y = pk2(v[2][j], v[3][j]); o0.z = pk2(v[4][j], v[5][j]); o0.w = pk2(v[6][j], v[7][j]);
        o1.x = pk2(v[8][j], v[9][j]); o1.y = pk2(v[10][j], v[11][j]); o1.z = pk2(v[12][j], v[13][j]); o1.w = pk2(v[14][j], v[15][j]);
        bf16* d = dst + (size_t)(4 * n4 + j) * D + 16 * kg; *(GAS v4u*)d = o0; *(GAS v4u*)(d + 8) = o1; }
}
__device__ __forceinline__ float clamp448(float x) { return __builtin_amdgcn_fmed3f(x, -448.f, 448.f); }
__device__ __forceinline__ int pk4_fp8(float a, float b, float c, float d) { int w = 0; w = __builtin_amdgcn_cvt_pk_fp8_f32(clamp448(a), clamp448(b), w, false);
    return __builtin_amdgcn_cvt_pk_fp8_f32(clamp448(c), clamp448(d), w, true); }
__device__ __forceinline__ void transpose_block64_fp8(const float* src, int ld, unsigned char* dst, LAS float*, int lane, float sc) {
    const int n4 = lane & 15, kg = lane >> 4;
    f32x4 v[16];
#pragma unroll
    for (int i = 0; i < 16; ++i) v[i] = __builtin_nontemporal_load((const f32x4*)(src + (size_t)(16 * kg + i) * ld + 4 * n4)) * sc;
#pragma unroll
    for (int j = 0; j < 4; ++j) { v4u o;
        o.x = (unsigned)pk4_fp8(v[0][j], v[1][j], v[2][j], v[3][j]); o.y = (unsigned)pk4_fp8(v[4][j], v[5][j], v[6][j], v[7][j]);
        o.z = (unsigned)pk4_fp8(v[8][j], v[9][j], v[10][j], v[11][j]); o.w = (unsigned)pk4_fp8(v[12][j], v[13][j], v[14][j], v[15][j]);
        *(GAS v4u*)(dst + (size_t)(4 * n4 + j) * D + 16 * kg) = o; }
}
constexpr int IT_IN = 16 * (NPROJ / 64), IT_OUT = 16 * 16, IT_GU = NE * 16 * 32, IT_DN = NE * 16 * 16, IT_LAYER = IT_IN + IT_OUT + IT_GU + IT_DN, IT_ALL = DEPTH * IT_LAYER;
__device__ __forceinline__ void convert_item(const Args& a, int l, int r, LAS float* scr, int lane) {
    unsigned char* ws = a.ws;
    bf16* WIN = (bf16*)(ws + WS_WIN); bf16* WOUT = (bf16*)(ws + WS_WOUT); unsigned char* WGU = ws + WS_WGU; unsigned char* WDN = ws + WS_WDN;
    if (r < IT_IN) { const int kb = r / (NPROJ / 64), nb = r % (NPROJ / 64), n0 = 64 * nb, sc = n0 + (n0 >= SRC_GA ? 16 : 0);
        if (F8_IN) transpose_block64_fp8(a.w_in + ((size_t)l * D + 64 * kb) * DIN + sc, DIN, (unsigned char*)WIN + ((size_t)l * NPROJ + n0) * D + 64 * kb, scr, lane, S8_W);
        else transpose_block64(a.w_in + ((size_t)l * D + 64 * kb) * DIN + sc, DIN, WIN + ((size_t)l * NPROJ + n0) * D + 64 * kb, scr, lane); return; }
    r -= IT_IN;
    if (r < IT_OUT) { const int kb = r / 16, nb = r % 16;
        if (F8_OUT) transpose_block64_fp8(a.w_out + ((size_t)l * D + 64 * kb) * D + 64 * nb, D, (unsigned char*)WOUT + ((size_t)l * D + 64 * nb) * D + 64 * kb, scr, lane, S8_W);
        else transpose_block64(a.w_out + ((size_t)l * D + 64 * kb) * D + 64 * nb, D, WOUT + ((size_t)l * D + 64 * nb) * D + 64 * kb, scr, lane); return; }
    r -= IT_OUT;
    if (r < IT_GU) { const int e = r / 512, r2 = r % 512, kb = r2 / 32, nb = r2 % 32, cc = 64 * nb;
        const int row = (cc < 1024) ? 256 * (cc / 128) + (cc % 128) : 256 * ((cc - 1024) / 128) + 128 + ((cc - 1024) % 128);
        transpose_block64_fp8(a.w_gu + (((size_t)l * NE + e) * D + 64 * kb) * 2048 + cc, 2048, WGU + (((size_t)l * NE + e) * 2048 + row) * D + 64 * kb, scr, lane, S8_W); return; }
    r -= IT_GU;
    { const int e = r / 256, r2 = r % 256, kb = r2 / 16, nb = r2 % 16;
        transpose_block64_fp8(a.w_dn + (((size_t)l * NE + e) * FFN + 64 * kb) * D + 64 * nb, D, WDN + (((size_t)l * NE + e) * D + 64 * nb) * D + 64 * kb, scr, lane, S8_W); }
}
constexpr int CB2 = 4, CB7 = 2, CB8 = 2;
__device__ __forceinline__ int conv_t2(int G) { return (G == 256) ? 192 * NWAVES * CB2 : 0; }
__device__ __forceinline__ int conv_idle(int nunits, int G) { const int rem = nunits % G; return rem ? G - rem : 0; }
__device__ __forceinline__ void convert_range(const Args& a, int l, int first, int count, LAS unsigned char* lds, int lane, int wave) {
    LAS float* scr = (LAS float*)(lds + wave * 16640);
    for (int k = 0; k < count; ++k) { const int it = first + k; if (it < IT_LAYER) convert_item(a, l, it, scr, lane); }
}
__device__ __forceinline__ void p0_prologue(const Args& a, LAS unsigned char* lds, int vcu, int G, int tid, int lane, int wave) {
    unsigned char* ws = a.ws;
    LAS float* scr = (LAS float*)(lds + wave * 16640);
    const int gw = vcu * NWAVES + wave, NGW = G * NWAVES;
    for (int it = gw; it < IT_LAYER; it += NGW) convert_item(a, 0, it, scr, lane);
    __syncthreads();
    {
        LAS float* cact = (LAS float*)lds;
        LAS float* red = (LAS float*)(lds + 8192);
        for (int i = tid; i < 2 * D; i += NTHR) cact[i] = silu_f(a.c[i]);
        __syncthreads();
        float* MOD = (float*)(ws + WS_MOD);
        for (int it = vcu; it < DEPTH * 96; it += G) {
            const int l = it / 96, n0 = (it % 96) * 64;
            const float* wp = a.w_mod + ((size_t)l * D + 128 * wave) * 6144 + n0 + lane;
            float a0 = 0.f, a1 = 0.f;
#pragma unroll 32
            for (int k = 0; k < 128; ++k) { const float w = __builtin_nontemporal_load(wp + (size_t)k * 6144); a0 += cact[128 * wave + k] * w; a1 += cact[D + 128 * wave + k] * w; }
            red[(wave * 2 + 0) * 64 + lane] = a0; red[(wave * 2 + 1) * 64 + lane] = a1;
            __syncthreads();
            if (tid < 128) { const int b = tid >> 6, ln = tid & 63; float s = a.b_mod[l * 6144 + n0 + ln];
#pragma unroll
                for (int w = 0; w < 8; ++w) s += red[(w * 2 + b) * 64 + ln];
                MOD[((size_t)l * 2 + b) * 6144 + n0 + ln] = s; }
            __syncthreads();
        }
    }
    { const f32x4* xs = (const f32x4*)a.x; uint2* xd = (uint2*)(ws + WS_X);
        for (int i = vcu * NTHR + tid; i < MTOK * D / 4; i += G * NTHR) { const f32x4 v = xs[i]; uint2 p; p.x = pk2(v[0], v[1]); p.y = pk2(v[2], v[3]); xd[i] = p; } }
    {
        float* ROPE = (float*)(ws + WS_ROPE);
        for (int i = vcu * NTHR + tid; i < MTOK * 24; i += G * NTHR) { const int t = i / 24, f = i % 24;
            const float inv = (float)pow(10000.0, -(double)f / 24.0); const float ang = (float)a.pos[t] * inv;
            ROPE[(size_t)t * 48 + f] = cosf(ang); ROPE[(size_t)t * 48 + 24 + f] = sinf(ang); }
    }
    if (vcu == 0 && tid < 256) {
        float v[4], mx = -3.0e38f; for (int l = 0; l < 4; ++l) { v[l] = a.hg_lb[l * 256 + tid]; mx = fmaxf(mx, v[l]); }
        float s = 0.f; for (int l = 0; l < 4; ++l) { v[l] = expf(v[l] - mx); s += v[l]; }
        float* LB = (float*)(ws + WS_LB); float cs = 0.f, first = 0.f;
        for (int l = 0; l < 4; ++l) { cs += v[l] / s; if (l == 0) first = cs; LB[l * 256 + tid] = cs - first; }
    }
}

__device__ __forceinline__ void moe_combine_row(f32x4 (&v)[4], int m, const bf16* Y, const int* SLOT, const float* TOPW, const float* g2, int lane) {
    const int4 sl = *(const int4*)(SLOT + (size_t)m * 4); const f32x4 tw = *(const f32x4*)(TOPW + (size_t)m * 4);
    const int s[4] = {sl.x, sl.y, sl.z, sl.w};
    f32x4 acc[4];
#pragma unroll
    for (int j = 0; j < 4; ++j) acc[j] = (f32x4){0.f, 0.f, 0.f, 0.f};
#pragma unroll
    for (int k = 0; k < 4; ++k) { const bf16* yr = Y + (size_t)s[k] * D + 4 * lane; const float w = tw[k];
#pragma unroll
        for (int j = 0; j < 4; ++j) { const uint2 p = *(const uint2*)(yr + 256 * j);
            acc[j][0] += w * __builtin_bit_cast(float, p.x << 16); acc[j][1] += w * __builtin_bit_cast(float, p.x & 0xffff0000u);
            acc[j][2] += w * __builtin_bit_cast(float, p.y << 16); acc[j][3] += w * __builtin_bit_cast(float, p.y & 0xffff0000u); } }
#pragma unroll
    for (int j = 0; j < 4; ++j) { const f32x4 g = *(const f32x4*)(g2 + 4 * lane + 256 * j); v[j] = v[j] + g * acc[j]; }
}
__device__ __forceinline__ float row_rstd(const f32x4 (&v)[4]) {
    float s = 0.f;
#pragma unroll
    for (int j = 0; j < 4; ++j) s += (v[j][0] * v[j][0] + v[j][1] * v[j][1]) + (v[j][2] * v[j][2] + v[j][3] * v[j][3]);
    return 1.0f / sqrtf(wave_sum(s) * (1.0f / D) + EPS);
}
__device__ __forceinline__ void modulate_row(f32x4 (&v)[4], float rstd, const float* nw, const float* sc, const float* sh, bf16* hrow, int lane) {
#pragma unroll
    for (int j = 0; j < 4; ++j) { const int c0 = 4 * lane + 256 * j; const f32x4 w = *(const f32x4*)(nw + c0), s1 = *(const f32x4*)(sc + c0), s0 = *(const f32x4*)(sh + c0);
        v[j] = v[j] * rstd * w * (s1 + 1.0f) + s0;
        uint2 p; p.x = pk2(v[j][0], v[j][1]); p.y = pk2(v[j][2], v[j][3]); *(uint2*)(hrow + c0) = p; }
}


constexpr int LR_SLT = 142976, LR_TWL = 144000, LR_SSR = 145024;
__device__ __forceinline__ void stage_slots(const unsigned char* ws, int row0, LAS unsigned char* lds, int tid) {
    if (tid < 64) { *(LAS v4u*)(lds + LR_SLT + 16 * tid) = *(const v4u*)((const int*)(ws + WS_SLOT) + (size_t)(row0 + tid) * 4);
                    *(LAS f32x4*)(lds + LR_TWL + 16 * tid) = *(const f32x4*)((const float*)(ws + WS_TOPW) + (size_t)(row0 + tid) * 4); }
}
template <bool SS, bool OUTF32>
__device__ __forceinline__ void flat_combine(const bf16* xsrc, void* xdst, int row0, const bf16* Y, const float* g2, LAS unsigned char* lds, int tid, int lane) {
    static_assert(Y8, "expert outputs are stored as fp8");
    typedef float f32x2v __attribute__((ext_vector_type(2)));
    const int c16 = tid & 63, rsub = tid >> 6; const unsigned char* Yb = (const unsigned char*)Y;
    f32x4 g[4];
#pragma unroll
    for (int q = 0; q < 4; ++q) g[q] = *(const f32x4*)(g2 + 16 * c16 + 4 * q);
#pragma unroll 2
    for (int it = 0; it < 8; ++it) { const int i = 8 * it + rsub; const size_t m = (size_t)(row0 + i);
        const v4u x0 = *(const v4u*)(xsrc + m * D + 16 * c16), x1 = *(const v4u*)(xsrc + m * D + 16 * c16 + 8);
        const v4u sl = *(const LAS v4u*)(lds + LR_SLT + 16 * i); const f32x4 tws = *(const LAS f32x4*)(lds + LR_TWL + 16 * i) * (1.0f / S8_Y);
        const v4u y0 = *(const v4u*)(Yb + (size_t)sl.x * D + 16 * c16), y1 = *(const v4u*)(Yb + (size_t)sl.y * D + 16 * c16), y2 = *(const v4u*)(Yb + (size_t)sl.z * D + 16 * c16), y3 = *(const v4u*)(Yb + (size_t)sl.w * D + 16 * c16);
        const unsigned xw[8] = {x0.x, x0.y, x0.z, x0.w, x1.x, x1.y, x1.z, x1.w}, w0[4] = {y0.x, y0.y, y0.z, y0.w}, w1[4] = {y1.x, y1.y, y1.z, y1.w}, w2[4] = {y2.x, y2.y, y2.z, y2.w}, w3[4] = {y3.x, y3.y, y3.z, y3.w};
        float v[16]; float sq = 0.f;
#pragma unroll
        for (int q = 0; q < 4; ++q) {
            const f32x2v a0 = __builtin_amdgcn_cvt_pk_f32_fp8((int)w0[q], false), b0 = __builtin_amdgcn_cvt_pk_f32_fp8((int)w0[q], true), a1 = __builtin_amdgcn_cvt_pk_f32_fp8((int)w1[q], false), b1 = __builtin_amdgcn_cvt_pk_f32_fp8((int)w1[q], true);
            const f32x2v a2 = __builtin_amdgcn_cvt_pk_f32_fp8((int)w2[q], false), b2 = __builtin_amdgcn_cvt_pk_f32_fp8((int)w2[q], true), a3 = __builtin_amdgcn_cvt_pk_f32_fp8((int)w3[q], false), b3 = __builtin_amdgcn_cvt_pk_f32_fp8((int)w3[q], true);
            const float e0 = tws[0] * a0[0] + tws[1] * a1[0] + tws[2] * a2[0] + tws[3] * a3[0], e1 = tws[0] * a0[1] + tws[1] * a1[1] + tws[2] * a2[1] + tws[3] * a3[1];
            const float e2 = tws[0] * b0[0] + tws[1] * b1[0] + tws[2] * b2[0] + tws[3] * b3[0], e3 = tws[0] * b0[1] + tws[1] * b1[1] + tws[2] * b2[1] + tws[3] * b3[1];
            v[4 * q + 0] = __builtin_bit_cast(float, xw[2 * q] << 16) + g[q][0] * e0; v[4 * q + 1] = __builtin_bit_cast(float, xw[2 * q] & 0xffff0000u) + g[q][1] * e1;
            v[4 * q + 2] = __builtin_bit_cast(float, xw[2 * q + 1] << 16) + g[q][2] * e2; v[4 * q + 3] = __builtin_bit_cast(float, xw[2 * q + 1] & 0xffff0000u) + g[q][3] * e3;
            sq += (v[4 * q] * v[4 * q] + v[4 * q + 1] * v[4 * q + 1]) + (v[4 * q + 2] * v[4 * q + 2] + v[4 * q + 3] * v[4 * q + 3]); }
        if (OUTF32) {
#pragma unroll
            for (int q = 0; q < 4; ++q) *(GAS f32x4*)((float*)xdst + m * D + 16 * c16 + 4 * q) = (f32x4){v[4 * q], v[4 * q + 1], v[4 * q + 2], v[4 * q + 3]}; }
        else { v4u o0, o1; o0.x = pk2(v[0], v[1]); o0.y = pk2(v[2], v[3]); o0.z = pk2(v[4], v[5]); o0.w = pk2(v[6], v[7]); o1.x = pk2(v[8], v[9]); o1.y = pk2(v[10], v[11]); o1.z = pk2(v[12], v[13]); o1.w = pk2(v[14], v[15]);
            *(GAS v4u*)((bf16*)xdst + m * D + 16 * c16) = o0; *(GAS v4u*)((bf16*)xdst + m * D + 16 * c16 + 8) = o1; }
        if (SS) { const float sqs = wave_sum(sq); if (lane == 0) __hip_atomic_fetch_add((LAS float*)(lds + LR_SSR) + i, sqs, __ATOMIC_RELAXED, __HIP_MEMORY_SCOPE_WORKGROUP); } }
}
template <bool F8, bool SLOTS>
__device__ __forceinline__ void flat_modulate(const bf16* xin, int row0, const LAS float* rstds, const float* nw, const float* scp, const float* shp, bf16* H, unsigned char* A1, LAS unsigned char* lds, int tid) {
    const int c16 = tid & 63, rsub = tid >> 6; f32x4 ws1[4], s0[4];
#pragma unroll
    for (int q = 0; q < 4; ++q) { const int c0 = 16 * c16 + 4 * q; ws1[q] = *(const f32x4*)(nw + c0) * (*(const f32x4*)(scp + c0) + 1.0f); s0[q] = *(const f32x4*)(shp + c0); }
#pragma unroll 2
    for (int it = 0; it < 8; ++it) { const int i = 8 * it + rsub; const size_t m = (size_t)(row0 + i); const float rs = rstds[i];
        const v4u x0 = *(const v4u*)(xin + m * D + 16 * c16), x1 = *(const v4u*)(xin + m * D + 16 * c16 + 8); const unsigned xw[8] = {x0.x, x0.y, x0.z, x0.w, x1.x, x1.y, x1.z, x1.w};
        f32x4 v[4];
#pragma unroll
        for (int q = 0; q < 4; ++q) v[q] = (f32x4){__builtin_bit_cast(float, xw[2 * q] << 16), __builtin_bit_cast(float, xw[2 * q] & 0xffff0000u), __builtin_bit_cast(float, xw[2 * q + 1] << 16), __builtin_bit_cast(float, xw[2 * q + 1] & 0xffff0000u)} * rs * ws1[q] + s0[q];
        if (F8) { v4u o; o.x = (unsigned)pk4_fp8(v[0][0] * S8_H, v[0][1] * S8_H, v[0][2] * S8_H, v[0][3] * S8_H); o.y = (unsigned)pk4_fp8(v[1][0] * S8_H, v[1][1] * S8_H, v[1][2] * S8_H, v[1][3] * S8_H);
            o.z = (unsigned)pk4_fp8(v[2][0] * S8_H, v[2][1] * S8_H, v[2][2] * S8_H, v[2][3] * S8_H); o.w = (unsigned)pk4_fp8(v[3][0] * S8_H, v[3][1] * S8_H, v[3][2] * S8_H, v[3][3] * S8_H);
            if (SLOTS) { const v4u sl = *(const LAS v4u*)(lds + LR_SLT + 16 * i);
                *(GAS v4u*)(A1 + (size_t)sl.x * D + 16 * c16) = o; *(GAS v4u*)(A1 + (size_t)sl.y * D + 16 * c16) = o; *(GAS v4u*)(A1 + (size_t)sl.z * D + 16 * c16) = o; *(GAS v4u*)(A1 + (size_t)sl.w * D + 16 * c16) = o; }
            else *(GAS v4u*)((unsigned char*)H + m * D + 16 * c16) = o; }
        else { v4u o0, o1; o0.x = pk2(v[0][0], v[0][1]); o0.y = pk2(v[0][2], v[0][3]); o0.z = pk2(v[1][0], v[1][1]); o0.w = pk2(v[1][2], v[1][3]); o1.x = pk2(v[2][0], v[2][1]); o1.y = pk2(v[2][2], v[2][3]); o1.z = pk2(v[3][0], v[3][1]); o1.w = pk2(v[3][2], v[3][3]);
            *(GAS v4u*)(H + m * D + 16 * c16) = o0; *(GAS v4u*)(H + m * D + 16 * c16 + 8) = o1; } }
}

constexpr int WP = 1032;
constexpr int LR_WHI = 0, LR_PART = 132096, LR_SSX = 140288, LR_RSTD = 140544, LR_BIAS = 140800, LR_RED = 140928;
template <int NEO>
__device__ __forceinline__ void rows_mfma(const Args& a, int layer, LAS unsigned char* lds, volatile LAS unsigned* MISC, gu32* ctl, int vcu, int G, int tid, int lane, int wave) {
    constexpr bool P5 = (NEO == 32); constexpr int NET = NEO / 16;
    unsigned char* ws = a.ws; bf16* X = (bf16*)(ws + WS_X); bf16* H = (bf16*)(ws + WS_H); const float* MOD = (const float*)(ws + WS_MOD);
    LAS bf16* Whi = (LAS bf16*)(lds + LR_WHI); LAS bf16* Wlo = Whi + NEO * WP; LAS float* part = (LAS float*)(lds + LR_PART); LAS float* ssx = (LAS float*)(lds + LR_SSX);
    LAS float* rstds = (LAS float*)(lds + LR_RSTD); LAS float* biasl = (LAS float*)(lds + LR_BIAS); LAS float* red = (LAS float*)(lds + LR_RED);
    const float* nw = (P5 ? a.norm2_w : a.norm1_w) + layer * D;
    const float* Wsrc = P5 ? a.w_r + (size_t)layer * D * NE : a.w_in + (size_t)layer * D * DIN + SRC_GA; const int wld = P5 ? NE : DIN;
    if (P5) { if (tid < NE) MISC[MW_HIST + tid] = 0u; }
    for (int row0 = vcu * 64; row0 < MTOK; row0 += G * 64) {
        const int b = row0 / SEQ; const float* mp = MOD + ((size_t)layer * 2 + b) * 6144; const float* scp = mp + (P5 ? 4 : 1) * D; const float* shp = mp + (P5 ? 3 : 0) * D;
        if (!P5 && layer > 0) { stage_slots(ws, row0, lds, tid); __syncthreads(); }
        { constexpr int E4 = NEO / 4, NITP = (D / 2 * E4) / NTHR, NIT = 4;
          f32x4 bacc = {0.f, 0.f, 0.f, 0.f};
#pragma unroll 1
          for (int ib0 = 0; ib0 < NITP; ib0 += NIT) {
            f32x4 wa[NIT], wb[NIT]; f32x2_t nv[NIT], sv[NIT], hv[NIT];
#pragma unroll
            for (int it = 0; it < NIT; ++it) { const int idx = tid + NTHR * (ib0 + it), k2 = idx / E4, e4 = idx - k2 * E4, k = 2 * k2;
                wa[it] = *(const f32x4*)(Wsrc + (size_t)k * wld + 4 * e4); wb[it] = *(const f32x4*)(Wsrc + (size_t)(k + 1) * wld + 4 * e4);
                nv[it] = *(const f32x2_t*)(nw + k); sv[it] = *(const f32x2_t*)(scp + k); hv[it] = *(const f32x2_t*)(shp + k); }
#pragma unroll
            for (int it = 0; it < NIT; ++it) { const int idx = tid + NTHR * (ib0 + it), k2 = idx / E4, e4 = idx - k2 * E4, k = 2 * k2;
                bacc += wa[it] * hv[it][0] + wb[it] * hv[it][1];
                const f32x4 w0 = wa[it] * (nv[it][0] * (1.0f + sv[it][0])), w1 = wb[it] * (nv[it][1] * (1.0f + sv[it][1]));
#pragma unroll
                for (int j = 0; j < 4; ++j) { const unsigned h0 = f2bf(w0[j]), h1 = f2bf(w1[j]); const float l0 = w0[j] - __builtin_bit_cast(float, h0 << 16), l1 = w1[j] - __builtin_bit_cast(float, h1 << 16);
                    *(LAS unsigned*)(Whi + (4 * e4 + j) * WP + k) = h0 | (h1 << 16); *(LAS unsigned*)(Wlo + (4 * e4 + j) * WP + k) = pk2(l0, l1); } } }
#pragma unroll
          for (int j = 0; j < 4; ++j) { float v = bacc[j];
#pragma unroll
              for (int sh = E4; sh < 64; sh <<= 1) v += __shfl_xor(v, sh);
              bacc[j] = v; }
          if (lane < E4) *(LAS f32x4*)(red + wave * NEO + 4 * lane) = bacc; }
        const bf16* xin = X;
        if (!P5 && layer > 0) { flat_combine<false, false>(X, X, row0, (const bf16*)(ws + WS_Y), MOD + ((size_t)(layer - 1) * 2 + b) * 6144 + 5 * D, lds, tid, lane); asm volatile("s_waitcnt vmcnt(0)" ::: "memory"); }
        __syncthreads();
        if (tid < NEO) { float sacc = P5 ? a.b_r[layer * NE + tid] : 0.f; for (int q = 0; q < NWAVES; ++q) sacc += red[q * NEO + tid]; biasl[tid] = sacc; }
        const int rg = wave >> 1, kh = wave & 1, r = lane & 15, g = lane >> 4;
        { const bf16* xr = xin + (size_t)(row0 + 16 * rg + r) * D; f32x4 acc[NET]; float ss = 0.f;
#pragma unroll
            for (int et = 0; et < NET; ++et) acc[et] = (f32x4){0.f, 0.f, 0.f, 0.f};
#pragma unroll 4
            for (int s = 16 * kh; s < 16 * kh + 16; ++s) { const int k0 = 32 * s + 8 * g; const v4u xp = *(const v4u*)(xr + k0); const unsigned xw[4] = {xp.x, xp.y, xp.z, xp.w};
#pragma unroll
                for (int j = 0; j < 4; ++j) { const float xa = __builtin_bit_cast(float, xw[j] << 16), xb = __builtin_bit_cast(float, xw[j] & 0xffff0000u); ss += xa * xa + xb * xb; }
                const pg8::bf16x8 ahi = __builtin_bit_cast(pg8::bf16x8, xp);
#pragma unroll
                for (int et = 0; et < NET; ++et) { const pg8::bf16x8 whi = ldfrag(Whi, WP, 16 * et, 32 * s, lane), wlo = ldfrag(Wlo, WP, 16 * et, 32 * s, lane);
                    acc[et] = __builtin_amdgcn_mfma_f32_16x16x32_bf16(ahi, whi, acc[et], 0, 0, 0); acc[et] = __builtin_amdgcn_mfma_f32_16x16x32_bf16(ahi, wlo, acc[et], 0, 0, 0); } }
            ss += __shfl_xor(ss, 16); ss += __shfl_xor(ss, 32);
            if (kh == 1) {
#pragma unroll
                for (int et = 0; et < NET; ++et)
#pragma unroll
                    for (int q = 0; q < 4; ++q) part[(rg * 16 + 4 * g + q) * 32 + 16 * et + r] = acc[et][q];
                if (g == 0) ssx[rg * 16 + r] = ss; }
            __syncthreads();
            if (kh == 0) { const float sst = ss + ssx[rg * 16 + r]; if (g == 0) rstds[rg * 16 + r] = 1.0f / sqrtf(sst * (1.0f / D) + EPS);
                asm volatile("s_waitcnt lgkmcnt(0)" ::: "memory");
#pragma unroll
                for (int et = 0; et < NET; ++et)
#pragma unroll
                    for (int q = 0; q < 4; ++q) { const int i = rg * 16 + 4 * g + q, e = 16 * et + r; const float v = rstds[i] * (acc[et][q] + part[i * 32 + e]) + biasl[e];
                        if (P5) part[i * 32 + e] = v; else ((float*)(ws + WS_GA))[(size_t)(row0 + i) * 16 + e] = v; }
                if (P5) { asm volatile("s_waitcnt lgkmcnt(0)" ::: "memory");
                    if (lane < 16) { const int i = rg * 16 + lane, m = row0 + i; float lv[NE];
#pragma unroll
                        for (int e = 0; e < NE; ++e) lv[e] = part[i * 32 + e];
                        float tv[4]; int te[4];
#pragma unroll
                        for (int t = 0; t < 4; ++t) { float best = -3.0e38f; int bi = 0;
#pragma unroll
                            for (int e = 0; e < NE; ++e) if (lv[e] > best) { best = lv[e]; bi = e; }
#pragma unroll
                            for (int e = 0; e < NE; ++e) if (e == bi) lv[e] = -3.0e38f;
                            tv[t] = best; te[t] = bi; }
                        const float e1 = expf(tv[1] - tv[0]), e2 = expf(tv[2] - tv[0]), e3 = expf(tv[3] - tv[0]); const float inv = 1.0f / (1.0f + e1 + e2 + e3);
                        *(f32x4*)((float*)(ws + WS_TOPW) + (size_t)m * 4) = (f32x4){inv, e1 * inv, e2 * inv, e3 * inv};
#pragma unroll
                        for (int t = 0; t < 4; ++t) { const unsigned rk = __hip_atomic_fetch_add((LAS unsigned*)&MISC[MW_HIST + te[t]], 1u, __ATOMIC_RELAXED, __HIP_MEMORY_SCOPE_WORKGROUP);
                            ((LAS unsigned*)(lds + LR_SLT))[i * 4 + t] = ((unsigned)te[t] << 16) | rk; } } } }
            __syncthreads(); }
        if (P5) { if (tid < NE) { const unsigned hcnt = MISC[MW_HIST + tid]; MISC[MW_BASE + tid] = hcnt ? atomicAdd((unsigned*)(ctl + CW_CNT + layer * NE + tid), hcnt) : 0u; }
            __syncthreads();
            if (tid < 256) { LAS unsigned* sl = (LAS unsigned*)(lds + LR_SLT) + tid; const unsigned v = *sl, e = v >> 16; const unsigned slot = (e << ECAP_SH) + MISC[MW_BASE + e] + (v & 0xffffu);
                *sl = slot; ((int*)(ws + WS_SLOT))[(size_t)row0 * 4 + tid] = (int)slot; }
            if (tid < NE) MISC[MW_HIST + tid] = 0u;
            __syncthreads(); }
        if (P5) flat_modulate<true, true>(xin, row0, rstds, nw, scp, shp, H, ws + WS_A1, lds, tid);
        else flat_modulate<F8_IN, false>(xin, row0, rstds, nw, scp, shp, H, ws + WS_A1, lds, tid);
        __syncthreads();
    }
}

__device__ __forceinline__ void final_rows(const Args& a, LAS unsigned char* lds, int vcu, int G, int tid, int lane) {
    unsigned char* ws = a.ws; const bf16* X = (const bf16*)(ws + WS_X); const float* MOD = (const float*)(ws + WS_MOD); LAS float* ssr = (LAS float*)(lds + LR_SSR);
    for (int row0 = vcu * 64; row0 < MTOK; row0 += G * 64) { const int b = row0 / SEQ;
        stage_slots(ws, row0, lds, tid); if (tid < 64) ssr[tid] = 0.f;
        __syncthreads();
        flat_combine<true, true>(X, a.out, row0, (const bf16*)(ws + WS_Y), MOD + ((size_t)(DEPTH - 1) * 2 + b) * 6144 + 5 * D, lds, tid, lane);
        asm volatile("s_waitcnt vmcnt(0)" ::: "memory");
        __syncthreads();
        { const int c4 = tid & 255, rsub = tid >> 8; const f32x4 w = *(const f32x4*)(a.final_norm_w + 4 * c4);
#pragma unroll 8
            for (int it = 0; it < 32; ++it) { const int i = 2 * it + rsub; float* op = a.out + (size_t)(row0 + i) * D + 4 * c4; const float rstd = 1.0f / sqrtf(ssr[i] * (1.0f / D) + EPS); *(GAS f32x4*)op = *(const GAS f32x4*)op * rstd * w; } }
        __syncthreads();
    }
}

__device__ __noinline__ void moe_tables(gu32* ctl, int layer, volatile LAS unsigned* MISC, int tid) {
    if (tid < NE) MISC[MW_CNT + tid] = __hip_atomic_load(ctl + CW_CNT + layer * NE + tid, RLX_AGENT);
    __syncthreads();
    if (tid == 0) { unsigned n = 0;
        for (int e = 0; e < NE; ++e) { const unsigned nt = (MISC[MW_CNT + e] + 255u) >> 8; for (unsigned t = 0; t < nt; ++t) MISC[MW_TILE + n + t] = (unsigned)(e * 64) + t; n += nt; }
        MISC[MW_NRT] = n; }
    __syncthreads();
}

constexpr int BP = 72;
template <int TYPE> struct MixCfg { static constexpr int DK = (TYPE == 1) ? 64 : 48, DV = (TYPE == 1) ? 64 : 96, NC = 4 * DK, NV = 4 * DV;
    static constexpr int STOFF = (TYPE == 0) ? ST_GLA : (TYPE == 1) ? ST_HG : ST_RET, COFF = (TYPE == 0) ? 0 : 192;
    static constexpr int CQ = (TYPE == 0) ? C_GQ : (TYPE == 1) ? C_HQ : C_RQ, CK = (TYPE == 0) ? C_GK : (TYPE == 1) ? C_HF : C_RK, CV = (TYPE == 0) ? C_GV : (TYPE == 1) ? C_HI : C_RV, CG = (TYPE == 0) ? C_GG : (TYPE == 1) ? C_HG : C_RG;
    static constexpr int MIXOFF = (TYPE == 0) ? 0 : (TYPE == 1) ? 384 : 640, KOFF = (TYPE == 0) ? 0 : (TYPE == 1) ? 192 : 448; };
__device__ __forceinline__ float fast_logsig(float x) { x = fmaxf(x, -80.f); return -__logf(1.0f + __expf(-x)); }
__device__ __forceinline__ float ret_lg(int h) { return logf(1.0f - exp2f(-5.0f - (float)h)); }

template <int NV>
__device__ __forceinline__ void stage_vt(const bf16* pv  , LAS bf16* VT, int tid) {
    constexpr int NIT = (64 * (NV / 8)) / NTHR; static_assert((64 * (NV / 8)) % NTHR == 0, "stage_vt");
    v4u p[NIT];
#pragma unroll
    for (int it = 0; it < NIT; ++it) { const int idx = tid + NTHR * it, j = idx & 63, ch = idx >> 6; p[it] = *(const v4u*)(pv + (size_t)j * NPROJ + 8 * ch); }
#pragma unroll
    for (int it = 0; it < NIT; ++it) { const int idx = tid + NTHR * it, j = idx & 63, ch = idx >> 6; LAS bf16* d = VT + (8 * ch) * BP + j;
        d[0 * BP] = (bf16)(p[it].x & 0xffffu); d[1 * BP] = (bf16)(p[it].x >> 16); d[2 * BP] = (bf16)(p[it].y & 0xffffu); d[3 * BP] = (bf16)(p[it].y >> 16);
        d[4 * BP] = (bf16)(p[it].z & 0xffffu); d[5 * BP] = (bf16)(p[it].z >> 16); d[6 * BP] = (bf16)(p[it].w & 0xffffu); d[7 * BP] = (bf16)(p[it].w >> 16); }
}

constexpr int LA_KT = 0, LA_VT = 36864, LA_TOT = 92160, LA_GA = 94208, LA_KTT = 98304, KTP = 264;
template <int TYPE>
__device__ __forceinline__ void mixa_batch(const Args& a, int layer, int unit, LAS unsigned char* lds, int tid, int lane, int wave) {
    asm volatile("" : "+v"(tid), "+v"(lane));
    typedef MixCfg<TYPE> C; constexpr int DK = C::DK, DV = C::DV, NC = C::NC, NV = C::NV;
    unsigned char* ws = a.ws; const bf16* PROJ = (const bf16*)(ws + WS_PROJ); bf16* F1 = (bf16*)(ws + WS_CUM); float* ECG = (float*)(ws + WS_CUM + 16 * MiB) + (size_t)unit * 4 * NDV; float* DVEC = (float*)(ws + WS_DVEC) + (size_t)unit * NDV;
    bf16* U = (bf16*)(ws + WS_U) + (size_t)unit * ST_TOT + C::STOFF;
    LAS bf16* KT = (LAS bf16*)(lds + LA_KT); LAS bf16* VT = (LAS bf16*)(lds + LA_VT); LAS float* TOT = (LAS float*)(lds + LA_TOT); const LAS float* GAs = (const LAS float*)(lds + LA_GA);
    const int row0 = unit * CH;
    stage_vt<NV>(PROJ + (size_t)row0 * NPROJ + C::CV, VT, tid);
    const bool act = tid < 2 * NC; const int c = act ? tid % NC : 0, half = act ? tid / NC : 0, h = c / DK, d = c - h * DK;
    float cum[32]; float tot = 0.f;
    float w2[16], b2 = 0.f, lbv = 0.f, lg = 0.f, sg = 0.f; int f = 0, d2 = 0;
    if (act) {
        if constexpr (TYPE == 0) { b2 = a.gla_ba2[layer * 192 + c];
#pragma unroll
            for (int r = 0; r < 16; ++r) w2[r] = a.gla_wa2[(layer * 16 + r) * 192 + c]; }
        if constexpr (TYPE == 1) lbv = ((const float*)(ws + WS_LB))[layer * 256 + c];
        if constexpr (TYPE == 2) { lg = ret_lg(h); f = (d < 24) ? d : d - 24; d2 = (d < 24) ? d + 24 : d - 24; sg = (d < 24) ? -1.f : 1.f; }
#pragma unroll
        for (int gq = 0; gq < 2; ++gq) {
            bf16 hraw[16];
            if constexpr (TYPE == 1) {
#pragma unroll
                for (int i = 0; i < 16; ++i) hraw[i] = PROJ[(size_t)(row0 + 32 * half + 16 * gq + i) * NPROJ + C_HF + c]; }
#pragma unroll
            for (int ii = 0; ii < 16; ++ii) { const int i = 16 * gq + ii, t = 32 * half + i; float g;
                if constexpr (TYPE == 0) { float pre = b2;
#pragma unroll
                    for (int r = 0; r < 16; ++r) pre += GAs[t * 16 + r] * w2[r];
                    g = fast_logsig(pre) * (1.0f / 16.0f); }
                else if constexpr (TYPE == 1) { const float hf = fminf(fmaxf(bf2f(hraw[ii]), -80.f), 80.f); const float sgm = __builtin_amdgcn_rcpf(1.0f + __expf(-hf));
                    g = __logf(lbv + (1.0f - lbv) * sgm); }
                else g = lg;
                tot += g; cum[i] = tot;
                if constexpr (TYPE == 0) { if ((ii & 3) == 3) asm volatile("" ::: "memory"); } } }
        TOT[c * 2 + half] = tot;
    }
    __syncthreads();
    if (act) { const float t0 = TOT[c * 2], t1 = TOT[c * 2 + 1]; const float off = half ? t0 : 0.f, last = t0 + t1;
#pragma unroll
        for (int hq = 0; hq < 4; ++hq) {
            bf16 ka[8], kb[8]; float cs[8], sn[8];
            if constexpr (TYPE != 1) {
#pragma unroll
                for (int i = 0; i < 8; ++i) { const size_t row = (size_t)(row0 + 32 * half + 8 * hq + i); const bf16* pr = PROJ + row * NPROJ;
                    if constexpr (TYPE == 0) ka[i] = pr[C_GK + c];
                    else { const float* rp = (const float*)(ws + WS_ROPE) + row * 48; ka[i] = pr[C_RK + h * 48 + d]; kb[i] = pr[C_RK + h * 48 + d2]; cs[i] = rp[f]; sn[i] = rp[24 + f]; } } }
            float kt[8];
#pragma unroll
            for (int j = 0; j < 8; ++j) { const int i = 8 * hq + j; const float cm = cum[i] + off; const size_t row = (size_t)(row0 + 32 * half + i); float k;
                if constexpr (TYPE == 0) k = bf2f(ka[j]);
                else if constexpr (TYPE == 1) k = 1.0f - __expf(cum[i] - (i > 0 ? cum[i - 1] : 0.f));
                else k = bf2f(ka[j]) * cs[j] + sg * bf2f(kb[j]) * sn[j];
                if constexpr (TYPE != 2) *(GAS bf16*)(F1 + row * NDV + C::COFF + c) = (bf16)f2bf(__expf(cm - ((i < 16) ? off : cum[15] + off)));
                { const float eb = cum[(i < 16) ? 15 : 31] + off;
                  ((LAS bf16*)(lds + LA_KTT))[(32 * half + i) * KTP + c] = (bf16)f2bf(k * __expf(eb - cm)); }
                kt[j] = k * __expf(last - cm); }
            v4u w; w.x = pk2(kt[0], kt[1]); w.y = pk2(kt[2], kt[3]); w.z = pk2(kt[4], kt[5]); w.w = pk2(kt[6], kt[7]);
            *(LAS v4u*)(KT + c * BP + 32 * half + 8 * hq) = w; }
        if (TYPE != 2) { *(GAS float*)(ECG + (2 * half + 0) * NDV + C::COFF + c) = cum[15] + off; *(GAS float*)(ECG + (2 * half + 1) * NDV + C::COFF + c) = cum[31] + off; }
        if (TYPE != 2 && half == 0) *(GAS float*)(DVEC + C::COFF + c) = __expf(last);
    }
    __syncthreads();
    { constexpr int CPR = NC / 8;
#pragma unroll
        for (int it = 0; it < (64 * CPR) / NTHR; ++it) { const int idx = tid + NTHR * it, t = idx / CPR, ch = idx - t * CPR;
            *(GAS v4u*)((bf16*)(ws + WS_KT) + (size_t)(row0 + t) * NKT + C::KOFF + 8 * ch) = *(const LAS v4u*)((const LAS bf16*)(lds + LA_KTT) + t * KTP + 8 * ch); } }
    constexpr int TD = DK / 16, NT = (DV / 16) * TD;
    for (int ti = wave; ti < 4 * NT; ti += NWAVES) { const int hh = ti / NT, tr = ti - hh * NT, te = tr / TD, td = tr - te * TD; f32x4 acc = {0.f, 0.f, 0.f, 0.f};
#pragma unroll
        for (int kk = 0; kk < 2; ++kk) acc = __builtin_amdgcn_mfma_f32_16x16x32_bf16(ldfrag(VT, BP, hh * DV + te * 16, kk * 32, lane), ldfrag(KT, BP, hh * DK + td * 16, kk * 32, lane), acc, 0, 0, 0);
        bf16* Uh = U + hh * DK * DV;
#pragma unroll
        for (int r = 0; r < 4; ++r) *(GAS bf16*)(Uh + (te * 16 + (lane >> 4) * 4 + r) * DK + td * 16 + (lane & 15)) = (bf16)f2bf(acc[r]); }
    __syncthreads();
}
__device__ __forceinline__ void p3a_summaries(const Args& a, int layer, LAS unsigned char* lds, int vcu, int G, int tid, int lane, int wave) {
    for (int unit = vcu; unit < NUNIT; unit += G) {
        { LAS float* GAs = (LAS float*)(lds + LA_GA); const float* GA = (const float*)(a.ws + WS_GA); for (int i = tid; i < CH * 16; i += NTHR) GAs[i] = GA[(size_t)unit * CH * 16 + i]; }
        __syncthreads();
        mixa_batch<0>(a, layer, unit, lds, tid, lane, wave);
        mixa_batch<1>(a, layer, unit, lds, tid, lane, wave);
        mixa_batch<2>(a, layer, unit, lds, tid, lane, wave);
    }
}

__device__ __forceinline__ void p3b_scan(const Args& a, int vcu, int G, int tid) {
    unsigned char* ws = a.ws; const bf16* U = (const bf16*)(ws + WS_U); const float* DVEC = (const float*)(ws + WS_DVEC); bf16* SP = (bf16*)(ws + WS_SP);
    for (int gid = vcu * NTHR + tid; gid < BATCH * ST_TOT; gid += G * NTHR) {
        const int b = gid / ST_TOT, el = gid - b * ST_TOT;
        int di = -1; float cdec = 0.f;
        if (el < ST_HG) { const int h = el / 4608, d = (el - h * 4608) % 48; di = h * 48 + d; }
        else if (el < ST_RET) { const int r = el - ST_HG, h = r / 4096, d = r % 64; di = 192 + h * 64 + d; }
        else { const int h = (el - ST_RET) / 4608; cdec = expf(64.0f * logf(1.0f - exp2f(-5.0f - (float)h))); }
        const bf16* up = U + (size_t)b * NCH * ST_TOT + el; const float* dp = DVEC + (size_t)b * NCH * NDV + (di < 0 ? 0 : di); bf16* sp = SP + (size_t)b * NCH * ST_TOT + el;
        float s = 0.f;
#pragma unroll 1
        for (int n0 = 0; n0 < NCH; n0 += 32) { float u[32], dc[32];
#pragma unroll
            for (int i = 0; i < 32; ++i) { u[i] = bf2f(up[(size_t)(n0 + i) * ST_TOT]); dc[i] = (di < 0) ? cdec : dp[(size_t)(n0 + i) * NDV]; }
#pragma unroll
            for (int i = 0; i < 32; ++i) { *(GAS bf16*)(sp + (size_t)(n0 + i) * ST_TOT) = (bf16)f2bf(s); s = dc[i] * s + u[i]; } }
    }
}

#ifndef SUB_MASK
#define SUB_MASK 0
#endif
#define SUBSTRETCH(bit, t0_) do { if ((SUB_MASK >> (bit)) & 1) { const unsigned long long t1_ = __builtin_amdgcn_s_memrealtime(); while (__builtin_amdgcn_s_memrealtime() - t1_ < t1_ - (t0_)) __builtin_amdgcn_s_sleep(8); } } while (0)
constexpr int LC_VT = 0, LC_ST = 55296, LC_AB = 110592, OBP = 104, LC_EC = 137216;
template <int TYPE, bool ISQ>
__device__ __forceinline__ void mix_frag(const Args& a, int h, size_t row, int t, int d0, float (&x)[8], float (&cm)[8]) {
    typedef MixCfg<TYPE> C; constexpr int DK = C::DK; static_assert(ISQ, "query path only");
    unsigned char* ws = a.ws; const bf16* pr = (const bf16*)(ws + WS_PROJ) + row * NPROJ;
    if constexpr (TYPE != 2) {
        const v4u p = *(const v4u*)(pr + C::CQ + h * DK + d0); const unsigned pw[4] = {p.x, p.y, p.z, p.w};
        const v4u f = *(const v4u*)((const bf16*)(ws + WS_CUM) + row * NDV + C::COFF + h * DK + d0); const unsigned fw[4] = {f.x, f.y, f.z, f.w};
#pragma unroll
        for (int j = 0; j < 4; ++j) { x[2 * j] = __builtin_bit_cast(float, pw[j] << 16); x[2 * j + 1] = __builtin_bit_cast(float, pw[j] & 0xffff0000u); cm[2 * j] = __builtin_bit_cast(float, fw[j] << 16); cm[2 * j + 1] = __builtin_bit_cast(float, fw[j] & 0xffff0000u); }
        if constexpr (TYPE == 0) {
#pragma unroll
            for (int j = 0; j < 8; ++j) x[j] *= 0.14433756729740643f; }
    } else {
        const int f0 = (d0 < 24) ? d0 : d0 - 24, dp = (d0 < 24) ? d0 + 24 : d0 - 24; const float sg = (d0 < 24) ? -1.f : 1.f;
        const int cb = C_RQ + h * DK; const v4u p = *(const v4u*)(pr + cb + d0), pp = *(const v4u*)(pr + cb + dp); const unsigned pw[4] = {p.x, p.y, p.z, p.w}, qw[4] = {pp.x, pp.y, pp.z, pp.w};
        const float* rp = (const float*)(ws + WS_ROPE) + row * 48; const f32x4 cs0 = *(const f32x4*)(rp + f0), cs1 = *(const f32x4*)(rp + f0 + 4), sn0 = *(const f32x4*)(rp + 24 + f0), sn1 = *(const f32x4*)(rp + 24 + f0 + 4);
        const float cmv = (float)(t + 1) * ret_lg(h);
#pragma unroll
        for (int j = 0; j < 4; ++j) { const float xa = __builtin_bit_cast(float, pw[j] << 16), xb = __builtin_bit_cast(float, pw[j] & 0xffff0000u), ya = __builtin_bit_cast(float, qw[j] << 16), yb = __builtin_bit_cast(float, qw[j] & 0xffff0000u);
            const float ca = (j < 2) ? cs0[2 * j] : cs1[2 * j - 4], cb2 = (j < 2) ? cs0[2 * j + 1] : cs1[2 * j - 3], sa = (j < 2) ? sn0[2 * j] : sn1[2 * j - 4], sb = (j < 2) ? sn0[2 * j + 1] : sn1[2 * j - 3];
            x[2 * j] = (xa * ca + sg * ya * sa) * 0.14433756729740643f; x[2 * j + 1] = (xb * cb2 + sg * yb * sb) * 0.14433756729740643f; cm[2 * j] = cmv; cm[2 * j + 1] = cmv; }
    }
}

template <int TYPE>
__device__ __forceinline__ void mixc_batch(const Args& a, int layer, int unit, LAS unsigned char* lds, int tid, int lane, int wave) {
    asm volatile("" : "+v"(tid), "+v"(lane));
    typedef MixCfg<TYPE> C; constexpr int DK = C::DK, DV = C::DV, NV = C::NV, TE = DV / 16;
    unsigned char* ws = a.ws; const bf16* PROJ = (const bf16*)(ws + WS_PROJ); bf16* MIX = (bf16*)(ws + WS_MIX);
    LAS bf16* VT = (LAS bf16*)(lds + LC_VT); LAS bf16* ST = (LAS bf16*)(lds + LC_ST); LAS bf16* AB = (LAS bf16*)(lds + LC_AB) + wave * 16 * OBP;
    const int row0 = unit * CH;
    const unsigned long long ts0_ = SUB_MASK ? __builtin_amdgcn_s_memrealtime() : 0ull;
    stage_vt<NV>(PROJ + (size_t)row0 * NPROJ + C::CV, VT, tid);
    SUBSTRETCH(3, ts0_);
    const unsigned long long ts3_ = SUB_MASK ? __builtin_amdgcn_s_memrealtime() : 0ull;
    { const bf16* SPu = (const bf16*)(ws + WS_SP) + (size_t)unit * ST_TOT + C::STOFF;
        constexpr int NIS = (NV * 8) / NTHR; static_assert((NV * 8) % NTHR == 0, "ST staging"); v4u sw[NIS];
#pragma unroll
        for (int it = 0; it < NIS; ++it) { const int idx = tid + NTHR * it, er = idx >> 3, ch = idx & 7; sw[it] = (v4u){0u, 0u, 0u, 0u}; if (ch * 8 < DK) sw[it] = *(const v4u*)(SPu + (size_t)er * DK + ch * 8); }
#pragma unroll
        for (int it = 0; it < NIS; ++it) { const int idx = tid + NTHR * it, er = idx >> 3, ch = idx & 7; *(LAS v4u*)(ST + er * BP + ch * 8) = sw[it]; } }
    SUBSTRETCH(4, ts3_);
    SUBSTRETCH(0, ts0_);
    if constexpr (TYPE != 2) { LAS float* EC = (LAS float*)(lds + LC_EC);
        for (int idx = tid; idx < 4 * C::NC; idx += NTHR) { const int jb = idx / C::NC, cc = idx - jb * C::NC; EC[jb * 256 + cc] = ((const float*)(ws + WS_CUM + 16 * MiB))[((size_t)unit * 4 + jb) * NDV + C::COFF + cc]; } }
    __syncthreads();
    const unsigned long long ts1_ = SUB_MASK ? __builtin_amdgcn_s_memrealtime() : 0ull;
    const int h = wave >> 1, hsel = wave & 1, r = lane & 15, g = lane >> 4;
    const LAS bf16* STh = ST + h * DV * BP; const LAS bf16* VTh = VT + h * DV * BP;
    constexpr int NCHK = DV / 8, NOC = (16 * NCHK) / 64;
#pragma unroll 1
    for (int ib = 0; ib < 2; ++ib) { const int I = ib ? 3 - hsel : hsel;
        pg8::bf16x8 qh[2], qt[2]; float refv[2][8], qhf[2][8];
#pragma unroll
        for (int s = 0; s < 2; ++s) { const int d0 = 32 * s + 8 * g; const bool valid = d0 < DK; const int d0c = valid ? d0 : 0;
            float x[8], cm[8]; mix_frag<TYPE, true>(a, h, (size_t)(row0 + 16 * I + r), 16 * I + r, d0c, x, cm);
            if constexpr (TYPE == 2) {
#pragma unroll
                for (int j = 0; j < 8; ++j) refv[s][j] = (float)(16 * I) * ret_lg(h);
            } else { if (I > 0) { const LAS float* cp = (const LAS float*)(lds + LC_EC) + (I - 1) * 256 + h * DK + d0c; const f32x4 c0 = *(const LAS f32x4*)cp, c1 = *(const LAS f32x4*)(cp + 4);
#pragma unroll
                    for (int j = 0; j < 4; ++j) { refv[s][j] = c0[j]; refv[s][4 + j] = c1[j]; } }
                else {
#pragma unroll
                    for (int j = 0; j < 8; ++j) refv[s][j] = 0.f; } }
            float xt[8];
#pragma unroll
            for (int j = 0; j < 8; ++j) { if constexpr (TYPE == 2) { qhf[s][j] = valid ? x[j] * __expf(cm[j] - refv[s][j]) : 0.f; xt[j] = valid ? x[j] * __expf(cm[j]) : 0.f; }
                else { qhf[s][j] = valid ? x[j] * cm[j] : 0.f; xt[j] = qhf[s][j] * __expf(refv[s][j]); } }
            qh[s] = pack8(qhf[s]); qt[s] = pack8(xt); }
        v4u kf[4][2];
#pragma unroll
        for (int J = 0; J < 4; ++J) { const int Jc = (J < I) ? J : I; const size_t rowJ = (size_t)(row0 + 16 * Jc + r);
#pragma unroll
            for (int s = 0; s < 2; ++s) { const int d0 = 32 * s + 8 * g; const int d0c = (d0 < DK) ? d0 : 0;
                kf[J][s] = *(const v4u*)((const bf16*)(ws + WS_KT) + rowJ * NKT + C::KOFF + h * DK + d0c); } }
#pragma unroll
        for (int J = 0; J < 4; ++J) { if (J <= I) { f32x4 acc = {0.f, 0.f, 0.f, 0.f};
#pragma unroll
            for (int s = 0; s < 2; ++s) { pg8::bf16x8 qop;
                { float xq[8], ej[8]; const int d0 = 32 * s + 8 * g; const int d0c = (d0 < DK) ? d0 : 0;
                    if constexpr (TYPE == 2) {
#pragma unroll
                        for (int j = 0; j < 8; ++j) ej[j] = (float)(16 * (J + 1)) * ret_lg(h); }
                    else { const LAS float* ep = (const LAS float*)(lds + LC_EC) + J * 256 + h * DK + d0c; const f32x4 e0 = *(const LAS f32x4*)ep, e1 = *(const LAS f32x4*)(ep + 4);
#pragma unroll
                        for (int j = 0; j < 4; ++j) { ej[j] = e0[j]; ej[4 + j] = e1[j]; } }
#pragma unroll
                    for (int j = 0; j < 8; ++j) xq[j] = qhf[s][j] * __expf(fminf(refv[s][j] - ej[j], 80.f));
                    qop = pack8(xq); }
                acc = __builtin_amdgcn_mfma_f32_16x16x32_bf16(qop, __builtin_bit_cast(pg8::bf16x8, kf[J][s]), acc, 0, 0, 0); }
#pragma unroll
            for (int q = 0; q < 4; ++q) { const int i = 4 * g + q; const float v = (J < I || r <= i) ? acc[q] : 0.f; AB[i * BP + 16 * J + r] = (bf16)f2bf(v); } } }
        if ((I & 1) == 0) {
#pragma unroll
            for (int q = 0; q < 4; ++q) AB[(4 * g + q) * BP + 16 * (I + 1) + r] = (bf16)0; }
        asm volatile("s_waitcnt lgkmcnt(0)" ::: "memory");
        const pg8::bf16x8 ah0 = *(const LAS pg8::bf16x8*)(AB + r * BP + 8 * g), ah1 = *(const LAS pg8::bf16x8*)(AB + r * BP + 32 + 8 * g);
        f32x4 o[TE];
#pragma unroll
        for (int te = 0; te < TE; ++te) { f32x4 acc = {0.f, 0.f, 0.f, 0.f};
            acc = __builtin_amdgcn_mfma_f32_16x16x32_bf16(qt[0], ldfrag(STh, BP, te * 16, 0, lane), acc, 0, 0, 0);
            acc = __builtin_amdgcn_mfma_f32_16x16x32_bf16(qt[1], ldfrag(STh, BP, te * 16, 32, lane), acc, 0, 0, 0);
            acc = __builtin_amdgcn_mfma_f32_16x16x32_bf16(ah0, ldfrag(VTh, BP, te * 16, 0, lane), acc, 0, 0, 0);
            if (I >= 2) acc = __builtin_amdgcn_mfma_f32_16x16x32_bf16(ah1, ldfrag(VTh, BP, te * 16, 32, lane), acc, 0, 0, 0);
            o[te] = acc; }
        const unsigned long long ts2_ = SUB_MASK ? __builtin_amdgcn_s_memrealtime() : 0ull;
#pragma unroll
        for (int q = 0; q < 4; ++q) { float s1 = 0.f, s2 = 0.f;
#pragma unroll
            for (int te = 0; te < TE; ++te) { s1 += o[te][q]; s2 += o[te][q] * o[te][q]; }
#pragma unroll
            for (int m = 1; m < 16; m <<= 1) { s1 += __shfl_xor(s1, m); s2 += __shfl_xor(s2, m); }
            float mean = 0.f, rstd;
            if constexpr (TYPE == 2) { mean = s1 * (1.0f / DV); rstd = __builtin_amdgcn_rsqf(fmaxf(s2 * (1.0f / DV) - mean * mean, 0.f) + EPS); }
            else rstd = __builtin_amdgcn_rsqf(s2 * (1.0f / DV) + EPS);
#pragma unroll
            for (int te = 0; te < TE; ++te) AB[(4 * g + q) * OBP + te * 16 + r] = (bf16)f2bf((o[te][q] - mean) * rstd); }
        asm volatile("s_waitcnt lgkmcnt(0)" ::: "memory");
#pragma unroll 1
        for (int i = 0; i < NOC; ++i) { const int cidx = lane + 64 * i, orow = cidx / NCHK, ch = cidx - orow * NCHK; const size_t row = (size_t)(row0 + 16 * I + orow);
            const v4u ov = *(const LAS v4u*)(AB + orow * OBP + 8 * ch); const v4u gv = *(const v4u*)(PROJ + row * NPROJ + C::CG + h * DV + 8 * ch);
            const unsigned ow[4] = {ov.x, ov.y, ov.z, ov.w}, gw[4] = {gv.x, gv.y, gv.z, gv.w}; float res[8];
            f32x4 w0 = {1.f, 1.f, 1.f, 1.f}, w1 = {1.f, 1.f, 1.f, 1.f};
            if constexpr (TYPE == 0) { const float* wp = a.gla_norm_w + layer * 384 + h * 96 + 8 * ch; w0 = *(const f32x4*)wp; w1 = *(const f32x4*)(wp + 4); }
            if constexpr (TYPE == 1) { const float* wp = a.hg_norm_w + layer * 256 + h * 64 + 8 * ch; w0 = *(const f32x4*)wp; w1 = *(const f32x4*)(wp + 4); }
#pragma unroll
            for (int j = 0; j < 4; ++j) { const float oa = __builtin_bit_cast(float, ow[j] << 16), ob = __builtin_bit_cast(float, ow[j] & 0xffff0000u), ga = __builtin_bit_cast(float, gw[j] << 16), gb = __builtin_bit_cast(float, gw[j] & 0xffff0000u);
                const float wa = (j < 2) ? w0[2 * j] : w1[2 * j - 4], wb = (j < 2) ? w0[2 * j + 1] : w1[2 * j - 3];
                const float sa = __builtin_amdgcn_rcpf(1.0f + __expf(-ga)), sb = __builtin_amdgcn_rcpf(1.0f + __expf(-gb));
                res[2 * j] = oa * wa * ((TYPE == 1) ? sa : ga * sa); res[2 * j + 1] = ob * wb * ((TYPE == 1) ? sb : gb * sb); }
            if (F8_OUT) { typedef int i32x2 __attribute__((ext_vector_type(2)));
                *(GAS i32x2*)((unsigned char*)MIX + row * D + C::MIXOFF + h * DV + 8 * ch) = (i32x2){pk4_fp8(res[0] * S8_M, res[1] * S8_M, res[2] * S8_M, res[3] * S8_M), pk4_fp8(res[4] * S8_M, res[5] * S8_M, res[6] * S8_M, res[7] * S8_M)}; }
            else { v4u w; w.x = pk2(res[0], res[1]); w.y = pk2(res[2], res[3]); w.z = pk2(res[4], res[5]); w.w = pk2(res[6], res[7]); *(GAS v4u*)(MIX + row * D + C::MIXOFF + h * DV + 8 * ch) = w; } }
        SUBSTRETCH(2, ts2_);
    }
    SUBSTRETCH(1, ts1_);
    __syncthreads();
}
__device__ __forceinline__ void p3c_outputs(const Args& a, int layer, LAS unsigned char* lds, int vcu, int G, int tid, int lane, int wave) {
    for (int unit = vcu; unit < NUNIT; unit += G) {
        mixc_batch<0>(a, layer, unit, lds, tid, lane, wave);
        mixc_batch<1>(a, layer, unit, lds, tid, lane, wave);
        mixc_batch<2>(a, layer, unit, lds, tid, lane, wave);
    }
}


constexpr int MW_ARGS = 800;
__device__ __forceinline__ const void* ld_argp(const volatile LAS unsigned* T, int i) {
    const unsigned lo = __builtin_amdgcn_readfirstlane(T[2 * i]), hi = __builtin_amdgcn_readfirstlane(T[2 * i + 1]);
    return (const void*)(((unsigned long long)hi << 32) | lo);
}
__device__ __forceinline__ Args load_args(LAS unsigned char* lds) {
    const volatile LAS unsigned* T = (const volatile LAS unsigned*)(lds + MISC_OFF) + MW_ARGS;
    Args a;
    a.x = (const float*)ld_argp(T, 0); a.c = (const float*)ld_argp(T, 1); a.pos = (const int*)ld_argp(T, 2); a.w_mod = (const float*)ld_argp(T, 3); a.b_mod = (const float*)ld_argp(T, 4);
    a.norm1_w = (const float*)ld_argp(T, 5); a.w_in = (const float*)ld_argp(T, 6); a.gla_wa2 = (const float*)ld_argp(T, 7); a.gla_ba2 = (const float*)ld_argp(T, 8); a.hg_lb = (const float*)ld_argp(T, 9);
    a.gla_norm_w = (const float*)ld_argp(T, 10); a.hg_norm_w = (const float*)ld_argp(T, 11); a.w_out = (const float*)ld_argp(T, 12); a.norm2_w = (const float*)ld_argp(T, 13); a.w_r = (const float*)ld_argp(T, 14);
    a.b_r = (const float*)ld_argp(T, 15); a.w_gu = (const float*)ld_argp(T, 16); a.b_gu = (const float*)ld_argp(T, 17); a.w_dn = (const float*)ld_argp(T, 18); a.b_dn = (const float*)ld_argp(T, 19);
    a.final_norm_w = (const float*)ld_argp(T, 20); a.out = (float*)ld_argp(T, 21); a.ws = (unsigned char*)ld_argp(T, 22); a.ph_lo = 0; a.ph_hi = 0;
    return a;
}
#define PH_CTX() { unsigned l_ = (unsigned)(size_t)lds; asm volatile("" : "+s"(l_)); lds = (LAS unsigned char*)(size_t)l_; } const Args args = load_args(lds); volatile LAS unsigned* MISC = (volatile LAS unsigned*)(lds + MISC_OFF); int tid_ = wv * 64 + (int)__builtin_amdgcn_mbcnt_hi(~0u, __builtin_amdgcn_mbcnt_lo(~0u, 0u)); asm volatile("" : "+v"(tid_)); const int tid = tid_, lane = tid & 63, wave = __builtin_amdgcn_readfirstlane(tid >> 6); \
    const int G = gridDim.x; const int bx = blockIdx.x; const int vcu = (G % 8 == 0) ? (bx % 8) * (G / 8) + bx / 8 : bx; unsigned char* ws = args.ws; gu32* ctl = (gu32*)(ws + WS_CTL); \
    (void)MISC; (void)lane; (void)wave; (void)vcu; (void)ctl; (void)bx; (void)tid
__device__ __forceinline__ void ph_p0(LAS unsigned char* lds, int wv) { PH_CTX(); p0_prologue(args, lds, vcu, G, tid, lane, wave); }
__device__ __forceinline__ void ph_p1(LAS unsigned char* lds, int wv, int layer_) { int layer = __builtin_amdgcn_readfirstlane(layer_); asm volatile("" : "+s"(layer)); PH_CTX();
    if (layer > 0) { moe_tables(ctl, layer - 1, MISC, tid); const int nrt = __builtin_amdgcn_readfirstlane((int)MISC[MW_NRT]);
        const int done = conv_t2(G) + conv_idle(nrt * 8, G) * NWAVES * CB7 + conv_idle(nrt * 4, G) * NWAVES * CB8; LAS float* scr = (LAS float*)(lds + wave * 16640);
        for (int it = done + vcu * NWAVES + wave; it < IT_LAYER; it += G * NWAVES) convert_item(args, layer, it, scr, lane);
        __syncthreads(); }
    rows_mfma<16>(args, layer, lds, MISC, ctl, vcu, G, tid, lane, wave); }
__device__ __forceinline__ void ph_p2(LAS unsigned char* lds, int wv, int layer_) { int layer = __builtin_amdgcn_readfirstlane(layer_); asm volatile("" : "+s"(layer)); PH_CTX();
    pg8::Gemm g{(const bf16*)(ws + WS_H), (const bf16*)(ws + WS_WIN + (size_t)layer * NPROJ * D * (F8_IN ? 1 : 2)), MTOK, NPROJ, F8_IN ? D / 2 : D}; pg8::StaticOrder S; S.init(MTOK, NPROJ, G, bx);
    pg8::EpiBf16Plain E{(bf16*)(ws + WS_PROJ), NPROJ, F8_IN ? 1.0f / (S8_H * S8_W) : 1.0f};
    pg8::gemm_phase<pg8::EpiBf16Plain, pg8::StaticOrder, true, true, F8_IN>(lds, g, S, E, tid);
    if (layer + 1 < DEPTH && G == 256 && bx >= 64) convert_range(args, layer + 1, ((bx - 64) * NWAVES + wave) * CB2, CB2, lds, lane, wave); }
__device__ __forceinline__ void ph_p3a(LAS unsigned char* lds, int wv, int layer_) { int layer = __builtin_amdgcn_readfirstlane(layer_); asm volatile("" : "+s"(layer)); PH_CTX(); p3a_summaries(args, layer, lds, vcu, G, tid, lane, wave); }
__device__ __forceinline__ void ph_p3b(LAS unsigned char* lds, int wv) { PH_CTX(); p3b_scan(args, vcu, G, tid); }
__device__ __forceinline__ void ph_p3c(LAS unsigned char* lds, int wv, int layer_) { int layer = __builtin_amdgcn_readfirstlane(layer_); asm volatile("" : "+s"(layer)); PH_CTX(); p3c_outputs(args, layer, lds, vcu, G, tid, lane, wave); }
__device__ __forceinline__ void ph_p4(LAS unsigned char* lds, int wv, int layer_) { int layer = __builtin_amdgcn_readfirstlane(layer_); asm volatile("" : "+s"(layer)); PH_CTX();
    pg8::Gemm g{(const bf16*)(ws + WS_MIX), (const bf16*)(ws + WS_WOUT + (size_t)layer * D * D * (F8_OUT ? 1 : 2)), MTOK, D, F8_OUT ? D / 2 : D}; pg8::StaticOrder S; S.init(MTOK, D, G, bx);
    pg8::EpiResGate E{(const bf16*)(ws + WS_X), (bf16*)(ws + WS_X), D, (const float*)(ws + WS_MOD) + (size_t)layer * 2 * 6144 + 2 * D, 6144, SEQ, F8_OUT ? 1.0f / (S8_M * S8_W) : 1.0f};
    pg8::gemm_phase<pg8::EpiResGate, pg8::StaticOrder, true, true, F8_OUT>(lds, g, S, E, tid); }
__device__ __forceinline__ void ph_p5(LAS unsigned char* lds, int wv, int layer_) { int layer = __builtin_amdgcn_readfirstlane(layer_); asm volatile("" : "+s"(layer)); PH_CTX(); rows_mfma<32>(args, layer, lds, MISC, ctl, vcu, G, tid, lane, wave); }
__device__ __forceinline__ void ph_p7(LAS unsigned char* lds, int wv, int layer_) { int layer = __builtin_amdgcn_readfirstlane(layer_); asm volatile("" : "+s"(layer)); PH_CTX();
    moe_tables(ctl, layer, MISC, tid);
    const int nrt = __builtin_amdgcn_readfirstlane((int)MISC[MW_NRT]);
    pg8::Gemm g{(const bf16*)(ws + WS_A1), (const bf16*)(ws + WS_WGU + (size_t)layer * NE * 2048 * D), nrt * 256, NE * 2048, D / 2};
    pg8::MoeOrder S{8, G, vcu, nrt * 8, (const LAS int*)(lds + MISC_OFF + 4 * MW_TILE)};
    pg8::EpiSwiglu E{ws + WS_ACT, FFN, args.b_gu + (size_t)layer * NE * 2048, 1.0f / (S8_H * S8_W), S8_A};
    pg8::gemm_phase<pg8::EpiSwiglu, pg8::MoeOrder, true, true, true>(lds, g, S, E, tid);
    { const int rem = (nrt * 8) % G; if (layer + 1 < DEPTH && rem != 0 && vcu >= rem) convert_range(args, layer + 1, conv_t2(G) + ((vcu - rem) * NWAVES + wave) * CB7, CB7, lds, lane, wave); } }
__device__ __forceinline__ void ph_p8(LAS unsigned char* lds, int wv, int layer_) { int layer = __builtin_amdgcn_readfirstlane(layer_); asm volatile("" : "+s"(layer)); PH_CTX();
    moe_tables(ctl, layer, MISC, tid);
    const int nrt = __builtin_amdgcn_readfirstlane((int)MISC[MW_NRT]);
    pg8::Gemm g{(const bf16*)(ws + WS_ACT), (const bf16*)(ws + WS_WDN + (size_t)layer * NE * D * FFN), nrt * 256, NE * D, FFN / 2};
    pg8::MoeOrder S{4, G, vcu, nrt * 4, (const LAS int*)(lds + MISC_OFF + 4 * MW_TILE)};
    if constexpr (Y8) { pg8::EpiFp8Bias E{ws + WS_Y, D, args.b_dn + (size_t)layer * NE * D, D, 1.0f / (S8_A * S8_W), S8_Y};
        pg8::gemm_phase<pg8::EpiFp8Bias, pg8::MoeOrder, true, true, true>(lds, g, S, E, tid); }
    else { pg8::EpiBf16Bias E{(bf16*)(ws + WS_Y), D, args.b_dn + (size_t)layer * NE * D, D, 1.0f / (S8_A * S8_W)};
        pg8::gemm_phase<pg8::EpiBf16Bias, pg8::MoeOrder, true, true, true>(lds, g, S, E, tid); }
    { const int rem = (nrt * 4) % G; if (layer + 1 < DEPTH && rem != 0 && vcu >= rem) convert_range(args, layer + 1, conv_t2(G) + conv_idle(nrt * 8, G) * NWAVES * CB7 + ((vcu - rem) * NWAVES + wave) * CB8, CB8, lds, lane, wave); } }
__device__ __forceinline__ void ph_final(LAS unsigned char* lds, int wv) { PH_CTX(); final_rows(args, lds, vcu, G, tid, lane); }

#ifndef DBL_MASK
#define DBL_MASK 0
#endif
#if DBL_MASK
#define RUN(bit, call) do { if ((DBL_MASK >> (bit)) & 1) { const unsigned long long t0_ = __builtin_amdgcn_s_memrealtime(); call; const unsigned long long t1_ = __builtin_amdgcn_s_memrealtime(); \
        while (__builtin_amdgcn_s_memrealtime() - t1_ < t1_ - t0_) __builtin_amdgcn_s_sleep(8); } else { call; } } while (0)
#else
#define RUN(bit, call) do { call; } while (0)
#endif
__global__ void __launch_bounds__(NTHR, 2) hybrid_fwd(Args args) {
    extern __shared__ __attribute__((aligned(16))) unsigned char lds_raw[];
    LAS unsigned char* lds = (LAS unsigned char*)lds_raw;
    volatile LAS unsigned* MISC = (volatile LAS unsigned*)(lds + MISC_OFF);
    const int tid = threadIdx.x; const int wv = __builtin_amdgcn_readfirstlane(tid >> 6);
    gu32* ctl = (gu32*)(args.ws + WS_CTL);
    for (int u = tid; u < (LDS_BYTES - MISC_OFF) / 4; u += NTHR) MISC[u] = 0u;
    __syncthreads();
    if (tid == 0) {
#define ST_ARG(i, p) do { const unsigned long long v_ = (unsigned long long)(p); MISC[MW_ARGS + 2 * (i)] = (unsigned)v_; MISC[MW_ARGS + 2 * (i) + 1] = (unsigned)(v_ >> 32); } while (0)
        ST_ARG(0, args.x); ST_ARG(1, args.c); ST_ARG(2, args.pos); ST_ARG(3, args.w_mod); ST_ARG(4, args.b_mod); ST_ARG(5, args.norm1_w); ST_ARG(6, args.w_in); ST_ARG(7, args.gla_wa2); ST_ARG(8, args.gla_ba2);
        ST_ARG(9, args.hg_lb); ST_ARG(10, args.gla_norm_w); ST_ARG(11, args.hg_norm_w); ST_ARG(12, args.w_out); ST_ARG(13, args.norm2_w); ST_ARG(14, args.w_r); ST_ARG(15, args.b_r); ST_ARG(16, args.w_gu);
        ST_ARG(17, args.b_gu); ST_ARG(18, args.w_dn); ST_ARG(19, args.b_dn); ST_ARG(20, args.final_norm_w); ST_ARG(21, args.out); ST_ARG(22, args.ws);
#undef ST_ARG
    }
    __syncthreads();
    const int lo = args.ph_lo, hi = args.ph_hi;
    const bool multi = (hi - lo) > 1;
    XcdBarrier bar; bar.bar = (unsigned*)(ctl + CW_BAR); bar.x = 0; bar.st = nullptr;
    if (multi) bar = xcd_barrier_post((unsigned*)(ctl + CW_BAR), MISC + MW_BAR);
#define IN(k) (lo <= (k) && (k) < hi)
#define SEAM(k) do { if (IN(k) && IN((k) + 1)) xcd_barrier(bar); } while (0)

    if (IN(0)) RUN(0, ph_p0(lds, wv));
    SEAM(0);
    for (int layer = 0; layer < DEPTH; ++layer) {
        const int pb = 1 + 9 * layer;
        if (IN(pb + 0)) RUN(1, ph_p1(lds, wv, layer));
        SEAM(pb + 0);
        if (IN(pb + 1)) RUN(2, ph_p2(lds, wv, layer));
        SEAM(pb + 1);
        if (IN(pb + 2)) RUN(3, ph_p3a(lds, wv, layer));
        SEAM(pb + 2);
        if (IN(pb + 3)) RUN(4, ph_p3b(lds, wv));
        SEAM(pb + 3);
        if (IN(pb + 4)) RUN(5, ph_p3c(lds, wv, layer));
        SEAM(pb + 4);
        if (IN(pb + 5)) RUN(6, ph_p4(lds, wv, layer));
        SEAM(pb + 5);
        if (IN(pb + 6)) RUN(7, ph_p5(lds, wv, layer));
        SEAM(pb + 6);
        if (IN(pb + 7)) RUN(9, ph_p7(lds, wv, layer));
        SEAM(pb + 7);
        if (IN(pb + 8)) RUN(10, ph_p8(lds, wv, layer));
        SEAM(pb + 8);
    }
    if (IN(NPHASE - 1)) RUN(11, ph_final(lds, wv));
#undef IN
#undef SEAM
}

#ifndef MK_SINGLE
#define MK_SINGLE 1
#endif
extern "C" void kernel_launch(void* const* d_in, const int* in_sizes, int n_in, void* d_out, int out_size, void* d_ws, size_t ws_size, hipStream_t stream) {
    static int grid = 0;
    if (grid == 0) {
        if (n_in != 21 || in_sizes[0] != MTOK * D || out_size != MTOK * D || ws_size < WS_END) { fprintf(stderr, "kernel_launch: unexpected problem shape (n_in %d, in0 %d, out %d, ws %zu)\n", n_in, n_in > 0 ? in_sizes[0] : -1, out_size, ws_size); grid = -1; return; }
        int dev = 0, cus = 0, per_cu = 0;
        if (hipGetDevice(&dev) != hipSuccess || hipDeviceGetAttribute(&cus, hipDeviceAttributeMultiprocessorCount, dev) != hipSuccess) { grid = -1; return; }
        if (hipFuncSetAttribute((const void*)hybrid_fwd, hipFuncAttributeMaxDynamicSharedMemorySize, LDS_BYTES) != hipSuccess) { fprintf(stderr, "kernel_launch: hipFuncSetAttribute failed\n"); grid = -1; return; }
        if (hipOccupancyMaxActiveBlocksPerMultiprocessor(&per_cu, (const void*)hybrid_fwd, NTHR, LDS_BYTES) != hipSuccess || per_cu < 1) fprintf(stderr, "kernel_launch: occupancy query says %d\n", per_cu);
        (void)hipGetLastError();
        grid = cus;
    }
    if (grid < 0) return;
    (void)hipMemsetAsync((char*)d_ws + WS_CTL, 0, CTL_ZERO_BYTES, stream);
    Args a{};
    a.x = (const float*)d_in[0]; a.c = (const float*)d_in[1]; a.pos = (const int*)d_in[2]; a.w_mod = (const float*)d_in[3]; a.b_mod = (const float*)d_in[4]; a.norm1_w = (const float*)d_in[5];
    a.w_in = (const float*)d_in[6]; a.gla_wa2 = (const float*)d_in[7]; a.gla_ba2 = (const float*)d_in[8]; a.hg_lb = (const float*)d_in[9]; a.gla_norm_w = (const float*)d_in[10]; a.hg_norm_w = (const float*)d_in[11];
    a.w_out = (const float*)d_in[12]; a.norm2_w = (const float*)d_in[13]; a.w_r = (const float*)d_in[14]; a.b_r = (const float*)d_in[15]; a.w_gu = (const float*)d_in[16]; a.b_gu = (const float*)d_in[17];
    a.w_dn = (const float*)d_in[18]; a.b_dn = (const float*)d_in[19]; a.final_norm_w = (const float*)d_in[20]; a.out = (float*)d_out; a.ws = (unsigned char*)d_ws;
#if MK_SINGLE
    a.ph_lo = 0; a.ph_hi = NPHASE;
    hipLaunchKernelGGL(hybrid_fwd, dim3(grid), dim3(NTHR), LDS_BYTES, stream, a);
#else
    for (int p = 0; p < NPHASE; ++p) { a.ph_lo = p; a.ph_hi = p + 1; hipLaunchKernelGGL(hybrid_fwd, dim3(grid), dim3(NTHR), LDS_BYTES, stream, a); }
#endif
}
```

```cpp
#include <hip/hip_runtime.h>
#include <cstdio>
#include <cstdint>
namespace pg8 {
#define PG8_LAS __attribute__((address_space(3)))
typedef unsigned short bf16_t;
typedef short bf16x8 __attribute__((ext_vector_type(8)));
typedef float f32x4 __attribute__((ext_vector_type(4)));
typedef unsigned u32x4 __attribute__((ext_vector_type(4)));
constexpr int BM = 256, BK = 64, HALF = 128, HTB = HALF * BK * 2  , STAGE_BYTES = 8 * HTB, NXCD = 8, WGM = 8;

__host__ __device__ __forceinline__ int lds_byte(int r, int c) { const int st = (r >> 4) * 2 + (c >> 5), rr = r & 15, cc = c & 31, ob = rr * 64 + cc * 2; return st * 1024 + (ob ^ (((ob >> 9) & 1) << 5)); }
__host__ __device__ __forceinline__ void stage_rc(int b, int& R, int& C) { const int st = b / 1024, sb = b % 1024, swz = sb ^ (((sb >> 9) & 1) << 5); R = (st >> 1) * 16 + swz / 64; C = (st & 1) * 32 + (swz % 64) / 2; }
__host__ __device__ __forceinline__ int perm32(int rho) { const int n = rho >> 4, i = rho & 15; return 8 * (i >> 2) + 4 * n + (i & 3); }

struct Unit { int pm, pn, e, pl; };
struct Gemm { const bf16_t* A; const bf16_t* Bt; int M, N, K; };

struct StaticOrder {
    int nM, nN, nwg, G, c;
    __host__ __device__ void init(int M, int N, int G_, int c_) { nM = M / BM; nN = N / BM; nwg = nM * nN; G = G_; c = c_; }
    __host__ __device__ bool next(int i, Unit& u) const {
        const long L = (long)i * G + c; if (L >= nwg) return false;
        int wgid = (int)L; { const int q = nwg / NXCD, r = nwg % NXCD, xcd = wgid % NXCD, off = wgid / NXCD; wgid = (xcd < r ? xcd * (q + 1) : r * (q + 1) + (xcd - r) * q) + off; }
        const int nig = WGM * nN, gid = wgid / nig, fm = gid * WGM, gsz = (nM - fm) < WGM ? (nM - fm) : WGM;
        u.pm = fm + ((wgid % nig) % gsz); u.pn = (wgid % nig) / gsz; u.e = 0; u.pl = u.pn; return true;
    }
    __device__ __forceinline__ void a_ready(const Unit&) const {}
    __device__ __forceinline__ void done(const Unit&) const {}
};

__device__ __forceinline__ unsigned cvt_pk_bf16(float lo, float hi) { unsigned r; asm volatile("v_cvt_pk_bf16_f32 %0, %1, %2" : "=v"(r) : "v"(lo), "v"(hi)); return r; }

#define PG8_GAS __attribute__((address_space(1)))
struct NoPre {};
struct EpiBf16Plain {
    static constexpr bool PERM = true, AFTER_DRAIN = false; static constexpr int NST = 0; typedef NoPre Pre;
    __device__ __forceinline__ Pre prefetch(const Unit&, int, int) const { return Pre{}; }
    bf16_t* O; int ldc; float sc;
    __device__ __forceinline__ void operator()(const f32x4 (&acc)[2][2][4][2], const Unit& u, int wr, int wc, int fr, int fq, const Pre&) const {
        const int row0 = u.pm * BM + wr * 64 + fr; const int col0 = u.pn * BM + wc * 32 + 8 * fq;
#pragma unroll
        for (int ai = 0; ai < 2; ++ai)
#pragma unroll
            for (int m = 0; m < 4; ++m) { bf16_t* rowp = O + (size_t)(row0 + ai * HALF + m * 16) * ldc + col0;
#pragma unroll
                for (int bj = 0; bj < 2; ++bj) { const f32x4 v0 = acc[ai][bj][m][0] * sc, v1 = acc[ai][bj][m][1] * sc;
                    u32x4 w; w.x = cvt_pk_bf16(v0[0], v0[1]); w.y = cvt_pk_bf16(v0[2], v0[3]); w.z = cvt_pk_bf16(v1[0], v1[1]); w.w = cvt_pk_bf16(v1[2], v1[3]);
                    *(PG8_GAS u32x4*)(rowp + bj * HALF) = w; } }
    }
};
struct EpiResGate {
    static constexpr bool PERM = true, AFTER_DRAIN = false; static constexpr int NST = 0; typedef NoPre Pre;
    __device__ __forceinline__ Pre prefetch(const Unit&, int, int) const { return Pre{}; }
    const bf16_t* base; bf16_t* out; int ldc; const float* gate; int gpitch; int rows_per_batch; float sc;
    __device__ __forceinline__ void operator()(const f32x4 (&acc)[2][2][4][2], const Unit& u, int wr, int wc, int fr, int fq, const Pre&) const {
        const int row0 = u.pm * BM + wr * 64 + fr, col0 = u.pn * BM + wc * 32 + 8 * fq;
        const float* gp = gate + (size_t)((u.pm * BM) / rows_per_batch) * gpitch + col0;
        f32x4 gv[2][2];
#pragma unroll
        for (int bj = 0; bj < 2; ++bj)
#pragma unroll
            for (int n = 0; n < 2; ++n) gv[bj][n] = *(const PG8_GAS f32x4*)(gp + bj * HALF + 4 * n) * sc;
#pragma unroll
        for (int ai = 0; ai < 2; ++ai)
#pragma unroll
            for (int m = 0; m < 4; ++m) { const size_t off = (size_t)(row0 + ai * HALF + m * 16) * ldc + col0;
#pragma unroll
                for (int bj = 0; bj < 2; ++bj) { const u32x4 bs = *(const PG8_GAS u32x4*)(base + off + bj * HALF); const unsigned bw[4] = {bs.x, bs.y, bs.z, bs.w}; float r[8];
#pragma unroll
                    for (int j = 0; j < 4; ++j) { const f32x4& a4 = acc[ai][bj][m][j >> 1]; const f32x4& g4 = gv[bj][j >> 1];
                        r[2 * j] = __builtin_bit_cast(float, bw[j] << 16) + g4[2 * (j & 1)] * a4[2 * (j & 1)]; r[2 * j + 1] = __builtin_bit_cast(float, bw[j] & 0xffff0000u) + g4[2 * (j & 1) + 1] * a4[2 * (j & 1) + 1]; }
                    u32x4 w; w.x = cvt_pk_bf16(r[0], r[1]); w.y = cvt_pk_bf16(r[2], r[3]); w.z = cvt_pk_bf16(r[4], r[5]); w.w = cvt_pk_bf16(r[6], r[7]);
                    *(PG8_GAS u32x4*)(out + off + bj * HALF) = w; }
                asm volatile("" ::: "memory"); }
    }
};
struct EpiSwiglu {
    static constexpr bool PERM = true, AFTER_DRAIN = false; static constexpr int NST = 0; struct Pre { f32x4 bg[2], bu[2]; };
    __device__ __forceinline__ Pre prefetch(const Unit& u, int wc, int fq) const { typedef const __attribute__((address_space(1))) f32x4 gf4;
        const float* bp = bias + (size_t)u.e * 2048 + u.pl * HALF + wc * 32 + 8 * fq; Pre p; p.bg[0] = *(gf4*)bp; p.bg[1] = *(gf4*)(bp + 4); p.bu[0] = *(gf4*)(bp + 1024); p.bu[1] = *(gf4*)(bp + 1028); return p; }
    unsigned char* O; int ldc; const float* bias; float inv_in, out_scale;
    __device__ __forceinline__ float act1(float g, float up) const {
        g = fminf(g, 7.0f); up = fminf(fmaxf(up, -7.0f), 7.0f);
        const float s = __builtin_amdgcn_rcpf(1.0f + __builtin_amdgcn_exp2f(-1.702f * 1.4426950408889634f * g));
        return (up + 1.0f) * g * s * out_scale;
    }
    __device__ __forceinline__ void operator()(const f32x4 (&acc)[2][2][4][2], const Unit& u, int wr, int wc, int fr, int fq, const Pre& pre) const {
        const int row0 = u.pm * BM + wr * 64 + fr; const int jj0 = wc * 32 + 8 * fq; const int col0 = u.pl * HALF + jj0;
        const f32x4 bg[2] = {pre.bg[0], pre.bg[1]}, bu[2] = {pre.bu[0], pre.bu[1]};
#pragma unroll
        for (int ai = 0; ai < 2; ++ai)
#pragma unroll
            for (int m = 0; m < 4; ++m) { unsigned char* rowp = O + (size_t)(row0 + ai * HALF + m * 16) * ldc + col0;
                f32x4 r[2];
#pragma unroll
                for (int n = 0; n < 2; ++n) { const f32x4 g = acc[ai][0][m][n] * inv_in + bg[n], up = acc[ai][1][m][n] * inv_in + bu[n];
#pragma unroll
                    for (int j = 0; j < 4; ++j) r[n][j] = act1(g[j], up[j]); }
                int w0 = 0, w1 = 0;
                w0 = __builtin_amdgcn_cvt_pk_fp8_f32(r[0][0], r[0][1], w0, false); w0 = __builtin_amdgcn_cvt_pk_fp8_f32(r[0][2], r[0][3], w0, true);
                w1 = __builtin_amdgcn_cvt_pk_fp8_f32(r[1][0], r[1][1], w1, false); w1 = __builtin_amdgcn_cvt_pk_fp8_f32(r[1][2], r[1][3], w1, true);
                typedef int i32x2 __attribute__((ext_vector_type(2))); *(PG8_GAS i32x2*)rowp = (i32x2){w0, w1}; }
    }
};
struct EpiBf16Bias {
    static constexpr bool PERM = true, AFTER_DRAIN = false; static constexpr int NST = 0; typedef NoPre Pre;
    __device__ __forceinline__ Pre prefetch(const Unit&, int, int) const { return Pre{}; }
    bf16_t* O; int ldc; const float* bias; int bpitch; float inv_in;
    __device__ __forceinline__ void operator()(const f32x4 (&acc)[2][2][4][2], const Unit& u, int wr, int wc, int fr, int fq, const Pre&) const {
        const int row0 = u.pm * BM + wr * 64 + fr; const int col0 = u.pl * BM + wc * 32 + 8 * fq;
        const float* bp = bias + (size_t)u.e * bpitch + col0;
        f32x4 bv[2][2];
#pragma unroll
        for (int bj = 0; bj < 2; ++bj)
#pragma unroll
            for (int n = 0; n < 2; ++n) bv[bj][n] = *(const PG8_GAS f32x4*)(bp + bj * HALF + 4 * n);
#pragma unroll
        for (int ai = 0; ai < 2; ++ai)
#pragma unroll
            for (int m = 0; m < 4; ++m) { bf16_t* rowp = O + (size_t)(row0 + ai * HALF + m * 16) * ldc + col0;
#pragma unroll
                for (int bj = 0; bj < 2; ++bj) { const f32x4 v0 = acc[ai][bj][m][0] * inv_in + bv[bj][0], v1 = acc[ai][bj][m][1] * inv_in + bv[bj][1];
                    u32x4 w; w.x = cvt_pk_bf16(v0[0], v0[1]); w.y = cvt_pk_bf16(v0[2], v0[3]); w.z = cvt_pk_bf16(v1[0], v1[1]); w.w = cvt_pk_bf16(v1[2], v1[3]);
                    *(PG8_GAS u32x4*)(rowp + bj * HALF) = w; } }
    }
};
struct EpiFp8Bias {
    static constexpr bool PERM = true, AFTER_DRAIN = false; static constexpr int NST = 0; struct Pre { f32x4 bv[2][2]; };
    __device__ __forceinline__ Pre prefetch(const Unit& u, int wc, int fq) const { typedef const __attribute__((address_space(1))) f32x4 gf4;
        const float* bp = bias + (size_t)u.e * bpitch + u.pl * BM + wc * 32 + 8 * fq; Pre p; p.bv[0][0] = *(gf4*)bp; p.bv[0][1] = *(gf4*)(bp + 4); p.bv[1][0] = *(gf4*)(bp + HALF); p.bv[1][1] = *(gf4*)(bp + HALF + 4); return p; }
    unsigned char* O; int ldc; const float* bias; int bpitch; float inv_in, out_scale;
    __device__ __forceinline__ int pk4(f32x4 v) const { int w = 0; w = __builtin_amdgcn_cvt_pk_fp8_f32(__builtin_amdgcn_fmed3f(v[0], -448.f, 448.f), __builtin_amdgcn_fmed3f(v[1], -448.f, 448.f), w, false);
        return __builtin_amdgcn_cvt_pk_fp8_f32(__builtin_amdgcn_fmed3f(v[2], -448.f, 448.f), __builtin_amdgcn_fmed3f(v[3], -448.f, 448.f), w, true); }
    __device__ __forceinline__ void operator()(const f32x4 (&acc)[2][2][4][2], const Unit& u, int wr, int wc, int fr, int fq, const Pre& pre) const {
        const int row0 = u.pm * BM + wr * 64 + fr; const int col0 = u.pl * BM + wc * 32 + 8 * fq;
        const f32x4 bv[2][2] = {{pre.bv[0][0], pre.bv[0][1]}, {pre.bv[1][0], pre.bv[1][1]}};
#pragma unroll
        for (int ai = 0; ai < 2; ++ai)
#pragma unroll
            for (int m = 0; m < 4; ++m) { unsigned char* rowp = O + (size_t)(row0 + ai * HALF + m * 16) * ldc + col0;
#pragma unroll
                for (int bj = 0; bj < 2; ++bj) { const f32x4 v0 = (acc[ai][bj][m][0] * inv_in + bv[bj][0]) * out_scale, v1 = (acc[ai][bj][m][1] * inv_in + bv[bj][1]) * out_scale;
                    typedef int i32x2 __attribute__((ext_vector_type(2))); *(PG8_GAS i32x2*)(rowp + bj * HALF) = (i32x2){pk4(v0), pk4(v1)}; } }
    }
};
struct MoeOrder {
    int nN, G, c, nunits; const PG8_LAS int* tile_pm;
    __device__ __forceinline__ bool next(int i, Unit& u) const {
        const int L = i * G + c; if (L >= nunits) return false;
        const int idx = L / nN, pl = L - idx * nN, pm = __builtin_amdgcn_readfirstlane(tile_pm[idx]), e = pm >> 6;
        u.pm = pm; u.pl = pl; u.e = e; u.pn = e * nN + pl; return true;
    }
    __device__ __forceinline__ void a_ready(const Unit&) const {}
    __device__ __forceinline__ void done(const Unit&) const {}
};
typedef int v4i32_t __attribute__((ext_vector_type(4)));
typedef int v8i32_t __attribute__((ext_vector_type(8)));
template <class Epi, class Sched, bool ALIGN_EPI = false, bool SP2 = false, bool FP8 = false>
__device__ __forceinline__ void gemm_phase(PG8_LAS unsigned char* lds, const Gemm g, const Sched& S, const Epi& E, int tid_in) {
    int tid_ = tid_in; asm volatile("" : "+v"(tid_)); const int tid = tid_, wid = __builtin_amdgcn_readfirstlane(tid >> 6), lane = tid & 63, wr = wid >> 2, wc = wid & 3, fr = lane & 15, fq = lane >> 4;
    const int K = g.K, nt = K / BK;
    unsigned voffA, voffB;
    { int R, C; stage_rc(tid * 16, R, C); const int Rb = Epi::PERM ? ((R & ~31) + perm32(R & 31)) : R;
        voffA = (unsigned)(R * K + C) * 2u; voffB = (unsigned)(Rb * K + C) * 2u; }
    const size_t rstep = (size_t)64 * K * 2;
    const size_t kstep = (size_t)(BK * 2);
    const size_t hstep = (size_t)HALF * K * 2;
    const size_t tstep = 2 * hstep;
    const unsigned ldsw = (unsigned)wid * 1024u;
    const int aoff = lds_byte(wr * 64 + fr, fq * 8), boff = lds_byte(wc * 32 + fr, fq * 8);
#define PG8_SA(b, h) (((b) * 2 + (h)) * HTB)
#define PG8_SB(b, h) ((4 + (b) * 2 + (h)) * HTB)
#define PG8_STAGE(bufoff, gbase, voff) do { _Pragma("unroll") for (int _i = 0; _i < 2; ++_i) \
        __builtin_amdgcn_global_load_lds((const unsigned*)((const char*)(gbase) + _i * rstep + (voff)), (PG8_LAS unsigned*)(lds + (bufoff) + ldsw + _i * 8192), 16, 0, 0); } while (0)
#define PG8_LDA(dst, b, h) do { _Pragma("unroll") for (int m = 0; m < 4; ++m) _Pragma("unroll") for (int k = 0; k < 2; ++k) dst[m][k] = *(const PG8_LAS bf16x8*)(lds + PG8_SA(b, h) + aoff + m * 2048 + k * 1024); } while (0)
#define PG8_LDB(dst, b, h) do { _Pragma("unroll") for (int n = 0; n < 2; ++n) _Pragma("unroll") for (int k = 0; k < 2; ++k) dst[n][k] = *(const PG8_LAS bf16x8*)(lds + PG8_SB(b, h) + boff + n * 2048 + k * 1024); } while (0)
#define PG8_MMA(ai, bj, At, Bt) do { __builtin_amdgcn_s_setprio(1); _Pragma("unroll") for (int m = 0; m < 4; ++m) _Pragma("unroll") for (int n = 0; n < 2; ++n) { \
        if constexpr (FP8) { const v8i32_t a8_ = __builtin_shufflevector(__builtin_bit_cast(v4i32_t, At[m][0]), __builtin_bit_cast(v4i32_t, At[m][1]), 0, 1, 2, 3, 4, 5, 6, 7); \
            const v8i32_t b8_ = __builtin_shufflevector(__builtin_bit_cast(v4i32_t, Bt[n][0]), __builtin_bit_cast(v4i32_t, Bt[n][1]), 0, 1, 2, 3, 4, 5, 6, 7); \
            asm volatile("v_mfma_scale_f32_16x16x128_f8f6f4 %0, %1, %2, %0, %3, %3 op_sel_hi:[0,0,0]" : "+v"(acc[ai][bj][m][n]) : "v"(b8_), "v"(a8_), "v"(one8_)); } \
        else { _Pragma("unroll") for (int k = 0; k < 2; ++k) acc[ai][bj][m][n] = __builtin_amdgcn_mfma_f32_16x16x32_bf16(Bt[n][k], At[m][k], acc[ai][bj][m][n], 0, 0, 0); } } \
        __builtin_amdgcn_s_setprio(0); } while (0)
#define PG8_WAIT_V(n) asm volatile("s_waitcnt vmcnt(" #n ")" ::: "memory")
#define PG8_WAIT_L(n) asm volatile("s_waitcnt lgkmcnt(" #n ")" ::: "memory")
#define PG8_WAIT_V8R(relax) do { if (relax) { if constexpr (Epi::NST == 8) PG8_WAIT_V(16); else if constexpr (Epi::NST == 16) PG8_WAIT_V(24); else PG8_WAIT_V(8); } else PG8_WAIT_V(8); } while (0)
#define PG8_BAR __builtin_amdgcn_s_barrier()
#define PG8_SCHED __builtin_amdgcn_sched_barrier(0)
    Unit cur, nxt; int ui = 0;
    if (!S.next(0, cur)) return;
    f32x4 acc[2][2][4][2];
#pragma unroll
    for (int a = 0; a < 2; ++a)
#pragma unroll
        for (int b = 0; b < 2; ++b)
#pragma unroll
            for (int m = 0; m < 4; ++m)
#pragma unroll
                for (int n = 0; n < 2; ++n) acc[a][b][m][n] = (f32x4){0.f, 0.f, 0.f, 0.f};
    bf16x8 At[4][2], B0[2][2], B1[2][2];
    int one8_ = 0x7f7f7f7f; asm volatile("" : "+v"(one8_));
    const char* cA = (const char*)g.A + (size_t)cur.pm * tstep; const char* cB = (const char*)g.Bt + (size_t)cur.pn * tstep;
    S.a_ready(cur);
    if constexpr (SP2) {
        PG8_STAGE(PG8_SB(0, 0), cB, voffB); PG8_STAGE(PG8_SB(0, 1), cB + hstep, voffB); PG8_STAGE(PG8_SA(0, 0), cA, voffA); PG8_STAGE(PG8_SA(0, 1), cA + hstep, voffA);
        if (wr == 1) PG8_BAR;
        PG8_WAIT_V(2); PG8_BAR;
        PG8_STAGE(PG8_SB(1, 0), cB + kstep, voffB); PG8_STAGE(PG8_SA(1, 0), cA + kstep, voffA); PG8_STAGE(PG8_SB(1, 1), cB + hstep + kstep, voffB);
        PG8_WAIT_V(6); PG8_BAR;
    } else {
        PG8_STAGE(PG8_SB(0, 0), cB, voffB); PG8_STAGE(PG8_SA(0, 0), cA, voffA); PG8_STAGE(PG8_SB(0, 1), cB + hstep, voffB); PG8_STAGE(PG8_SA(0, 1), cA + hstep, voffA);
        if (wr == 1) PG8_BAR;
        PG8_WAIT_V(4); PG8_BAR;
        PG8_STAGE(PG8_SB(1, 0), cB + kstep, voffB); PG8_STAGE(PG8_SA(1, 0), cA + kstep, voffA); PG8_STAGE(PG8_SB(1, 1), cB + hstep + kstep, voffB);
        PG8_WAIT_V(6); PG8_BAR;
    }
    for (;;) {
        const bool has_next = S.next(ui + 1, nxt);
        typename Epi::Pre pre_; { int lp_ = (int)__builtin_amdgcn_mbcnt_hi(~0u, __builtin_amdgcn_mbcnt_lo(~0u, 0u)); asm volatile("" : "+v"(lp_)); pre_ = E.prefetch(cur, wc, lp_ >> 4); }
        const char* nA = has_next ? (const char*)g.A + (size_t)nxt.pm * tstep : cA; const char* nB = has_next ? (const char*)g.Bt + (size_t)nxt.pn * tstep : cB;
#pragma unroll 1
        for (int t = 0; t < nt; t += 2) {
            const bool last = (t == nt - 2);
            const char* a1 = cA + (size_t)(t + 1) * kstep;
            const char* a2 = last ? nA : cA + (size_t)(t + 2) * kstep; const char* b2 = last ? nB : cB + (size_t)(t + 2) * kstep;
            const char* a3 = a2 + kstep; const char* b3 = b2 + kstep;
            if (last && has_next) S.a_ready(nxt);
            const bool relax = (Epi::NST > 0) && (ui > 0) && (t == 0);
            if constexpr (SP2) {
            PG8_LDB(B0, 0, 0); PG8_LDB(B1, 0, 1); PG8_SCHED; PG8_LDA(At, 0, 0); PG8_STAGE(PG8_SA(1, 1), a1 + hstep, voffA);
            PG8_WAIT_V8R(relax); PG8_WAIT_L(0); PG8_BAR; PG8_MMA(0, 0, At, B0); PG8_MMA(0, 1, At, B1); PG8_BAR; PG8_SCHED;
            PG8_LDA(At, 0, 1); PG8_STAGE(PG8_SB(0, 0), b2, voffB); PG8_STAGE(PG8_SB(0, 1), b2 + hstep, voffB); PG8_STAGE(PG8_SA(0, 0), a2, voffA);
            PG8_WAIT_V8R(relax); PG8_WAIT_L(0); PG8_BAR; PG8_MMA(1, 0, At, B0); PG8_MMA(1, 1, At, B1); PG8_BAR; PG8_SCHED;
            PG8_LDB(B0, 1, 0); PG8_LDB(B1, 1, 1); PG8_SCHED; PG8_LDA(At, 1, 0); PG8_STAGE(PG8_SA(0, 1), a2 + hstep, voffA);
            PG8_WAIT_V(8); PG8_WAIT_L(0); PG8_BAR; PG8_MMA(0, 0, At, B0); PG8_MMA(0, 1, At, B1); PG8_BAR; PG8_SCHED;
            PG8_LDA(At, 1, 1); PG8_STAGE(PG8_SB(1, 0), b3, voffB); PG8_STAGE(PG8_SB(1, 1), b3 + hstep, voffB); PG8_STAGE(PG8_SA(1, 0), a3, voffA);
            PG8_WAIT_V(8); PG8_WAIT_L(0); PG8_BAR; PG8_MMA(1, 0, At, B0); PG8_MMA(1, 1, At, B1); PG8_BAR; PG8_SCHED;
            } else {
            PG8_LDB(B0, 0, 0); PG8_SCHED; PG8_LDA(At, 0, 0); PG8_STAGE(PG8_SA(1, 1), a1 + hstep, voffA);
            PG8_WAIT_L(8); PG8_BAR; PG8_WAIT_L(0); PG8_MMA(0, 0, At, B0); PG8_BAR; PG8_SCHED;
            PG8_LDB(B1, 0, 1); PG8_STAGE(PG8_SB(0, 0), b2, voffB);
            PG8_BAR; PG8_WAIT_L(0); PG8_MMA(0, 1, At, B1); PG8_BAR;
            PG8_LDA(At, 0, 1); PG8_STAGE(PG8_SA(0, 0), a2, voffA);
            PG8_BAR; PG8_WAIT_L(0); PG8_MMA(1, 0, At, B0); PG8_BAR; PG8_SCHED;
            PG8_STAGE(PG8_SB(0, 1), b2 + hstep, voffB);
            PG8_WAIT_V(6); PG8_BAR; PG8_MMA(1, 1, At, B1); PG8_BAR;
            PG8_LDB(B0, 1, 0); PG8_SCHED; PG8_LDA(At, 1, 0); PG8_STAGE(PG8_SA(0, 1), a2 + hstep, voffA);
            PG8_WAIT_L(8); PG8_BAR; PG8_WAIT_L(0); PG8_MMA(0, 0, At, B0); PG8_BAR; PG8_SCHED;
            PG8_LDB(B1, 1, 1); PG8_STAGE(PG8_SB(1, 0), b3, voffB);
            PG8_BAR; PG8_WAIT_L(0); PG8_MMA(0, 1, At, B1); PG8_BAR;
            PG8_LDA(At, 1, 1); PG8_STAGE(PG8_SA(1, 0), a3, voffA);
            PG8_BAR; PG8_WAIT_L(0); PG8_MMA(1, 0, At, B0); PG8_BAR; PG8_SCHED;
            PG8_STAGE(PG8_SB(1, 1), b3 + hstep, voffB);
            PG8_WAIT_V(6); PG8_BAR; PG8_MMA(1, 1, At, B1); PG8_BAR;
            }
        }
        if constexpr (FP8) asm volatile("s_nop 7\n\ts_nop 7" ::: "memory");
        if constexpr (ALIGN_EPI) { if (wr == 0) PG8_BAR; }
        if constexpr (!Epi::AFTER_DRAIN) { int ln_ = (int)__builtin_amdgcn_mbcnt_hi(~0u, __builtin_amdgcn_mbcnt_lo(~0u, 0u)); asm volatile("" : "+v"(ln_)); E(acc, cur, wr, wc, ln_ & 15, ln_ >> 4, pre_); S.done(cur); }
        if (!has_next) break;
#pragma unroll
        for (int a = 0; a < 2; ++a)
#pragma unroll
            for (int b = 0; b < 2; ++b)
#pragma unroll
                for (int m = 0; m < 4; ++m)
#pragma unroll
                    for (int n = 0; n < 2; ++n) acc[a][b][m][n] = (f32x4){0.f, 0.f, 0.f, 0.f};
        cur = nxt; cA = nA; cB = nB; ++ui;
        if constexpr (ALIGN_EPI) { if (wr == 1) PG8_BAR; }
    }
    PG8_WAIT_V(0);
    if constexpr (!ALIGN_EPI) { if (wr == 0) PG8_BAR; }
    PG8_BAR;
    if constexpr (Epi::AFTER_DRAIN) { E.fused(acc, cur, wr, wc, fr, fq, lds, wid, lane); S.done(cur); }
#undef PG8_SA
#undef PG8_SB
#undef PG8_STAGE
#undef PG8_LDA
#undef PG8_LDB
#undef PG8_MMA
#undef PG8_WAIT_V
#undef PG8_WAIT_L
#undef PG8_BAR
#undef PG8_SCHED
}
}

constexpr int NWAVES = 8, NTHR = 512;
constexpr int BATCH = 2, SEQ = 8192, D = 1024, DEPTH = 4, MTOK = BATCH * SEQ;
constexpr int DIN = 3344, NPROJ = 3328, SRC_GA = 1152;
constexpr int C_GQ = 0, C_GK = 192, C_GV = 384, C_GG = 768, C_HQ = 1152, C_HF = 1408, C_HI = 1664, C_HG = 1920, C_RQ = 2176, C_RK = 2368, C_RV = 2560, C_RG = 2944;
constexpr int NE = 32, FFN = 1024;
constexpr int CH = 64, NCH = SEQ / CH, NUNIT = BATCH * NCH;
constexpr int ST_GLA = 0, ST_HG = 4 * 48 * 96, ST_RET = ST_HG + 4 * 64 * 64, ST_TOT = ST_RET + 4 * 48 * 96;
constexpr int NDV = 448, NKT = 640;
constexpr int MAXROWS = 65536 + NE * 256, MAXRT = MAXROWS / 256;
constexpr float EPS = 1e-6f;
#ifndef F8_IN_V
#define F8_IN_V false
#endif
#ifndef F8_OUT_V
#define F8_OUT_V true
#endif
constexpr bool F8_IN = F8_IN_V, F8_OUT = F8_OUT_V;
#ifndef Y8_V
#define Y8_V true
#endif
constexpr bool Y8 = Y8_V;
constexpr float S8_Y = 16.f;
constexpr float S8_M = 32.f;
constexpr float S8_W = 2048.f, S8_H = 64.f, S8_A = 8.f;
constexpr int NPHASE = 38;
constexpr int ECAP = 16384, ECAP_SH = 14;

constexpr size_t MiB = 1u << 20;
constexpr size_t WS_CTL = 0, CTL_ZERO_BYTES = 65536;
constexpr size_t WS_MOD = 1 * MiB;
constexpr size_t WS_ROPE = 2 * MiB;
constexpr size_t WS_LB = 5 * MiB;
constexpr size_t WS_WIN = 8 * MiB;
constexpr size_t WS_WOUT = 34 * MiB;
constexpr size_t WS_WGU = 42 * MiB;
constexpr size_t WS_WDN = 554 * MiB;
constexpr size_t WS_X = 810 * MiB;
constexpr size_t WS_H = 874 * MiB;
constexpr size_t WS_GA = 906 * MiB;
constexpr size_t WS_PROJ = 907 * MiB;
constexpr size_t WS_U = 1011 * MiB;
constexpr size_t WS_DVEC = 1063 * MiB;
constexpr size_t WS_SP = 1064 * MiB;
constexpr size_t WS_MIX = 1090 * MiB;
constexpr size_t WS_TOPE = 1122 * MiB;
constexpr size_t WS_TOPW = WS_TOPE + 256 * 1024;
constexpr size_t WS_SLOT = WS_TOPW + 256 * 1024;
constexpr size_t WS_A1 = 1123 * MiB;
constexpr size_t WS_ACT = 1635 * MiB;
constexpr size_t WS_Y = 2147 * MiB;
constexpr size_t WS_CUM = 3171 * MiB;
constexpr size_t WS_KT = 3199 * MiB;
constexpr size_t WS_END = 3239 * MiB;
static_assert(WS_WIN + (size_t)DEPTH * NPROJ * D * 2 <= WS_WOUT && WS_PROJ + (size_t)MTOK * NPROJ * 2 <= WS_U && WS_U + (size_t)NUNIT * ST_TOT * 4 <= WS_DVEC && WS_SP + (size_t)NUNIT * ST_TOT * 2 <= WS_MIX && WS_A1 + (size_t)NE * ECAP * D <= WS_ACT && WS_ACT + (size_t)NE * ECAP * D <= WS_Y && WS_Y + (size_t)NE * ECAP * D * 2 <= WS_CUM, "ws map");
constexpr int CW_TMO = 0, CW_CODE = 1, CW_BAR = 4096, CW_CNT = 8192, CW_FILL = 8192 + 256;
constexpr int RING_BYTES = 131072;
constexpr int MISC_OFF = 147456, LDS_BYTES = MISC_OFF + 4096;
constexpr int MW_BAR = 0, MW_CNT = 16, MW_PST = 48, MW_HIST = 96, MW_BASE = 128, MW_TILE = 192, MW_NRT = 480, MW_SLOTS = 512;

#define GAS __attribute__((address_space(1)))
#define LAS __attribute__((address_space(3)))
typedef unsigned v4u __attribute__((ext_vector_type(4)));
typedef float f32x4 __attribute__((ext_vector_type(4)));
typedef short bf16x8 __attribute__((ext_vector_type(8)));
typedef GAS unsigned gu32;
typedef GAS unsigned long long gu64;
#define RLX_AGENT __ATOMIC_RELAXED, __HIP_MEMORY_SCOPE_AGENT
#define LDS_WAIT() asm volatile("s_waitcnt lgkmcnt(0)" ::: "memory")
#define VM_WAIT() asm volatile("s_waitcnt vmcnt(0)" ::: "memory")
__device__ __forceinline__ unsigned long long rt() { return __builtin_amdgcn_s_memrealtime(); }
typedef unsigned short bf16;
typedef float f32x2_t __attribute__((ext_vector_type(2))); typedef __bf16 bf16x2_t __attribute__((ext_vector_type(2)));
__device__ __forceinline__ unsigned pk2(float lo, float hi) { const f32x2_t v = {lo, hi}; return __builtin_bit_cast(unsigned, __builtin_convertvector(v, bf16x2_t)); }
__device__ __forceinline__ unsigned f2bf(float f) { return pk2(f, 0.f) & 0xffffu; }
__device__ __forceinline__ float bf2f(bf16 b) { return __builtin_bit_cast(float, (unsigned)b << 16); }
#define XB_TMO      128
#define XB_XCNT(j)  (256  + 64 * (j))
#define XB_XSUB(j)  (1280 + 64 * (j))
#define XB_XGEN(j)  (2304 + 64 * (j))
#define XB_TOP      3328
#define XB_TOPGEN   3392
#define XCD_BAR_WORDS 3456
#define XB_SPIN_CAP (1u << 18)

__device__ __forceinline__ unsigned xb_ld(unsigned* p)              { return __hip_atomic_load(p, __ATOMIC_RELAXED, __HIP_MEMORY_SCOPE_AGENT); }
__device__ __forceinline__ unsigned xb_add(unsigned* p, unsigned v) { return __hip_atomic_fetch_add(p, v, __ATOMIC_RELAXED, __HIP_MEMORY_SCOPE_AGENT); }
__device__ __forceinline__ unsigned xb_xcc_id() { return (unsigned)__builtin_amdgcn_s_getreg((3 << 11) | 20) & 0xFu; }
#define XB_SPIN(cond, bar) do { unsigned _sp = 0; while (cond) { __builtin_amdgcn_s_sleep(1); \
    if ((++_sp & 255u) == 0u) { if (xb_ld(&(bar)[XB_TMO])) break; if (_sp > XB_SPIN_CAP) { atomicAdd(&(bar)[XB_TMO], 1u); break; } } } } while (0)

struct XcdBarrier {
    unsigned* bar; unsigned x;
    volatile LAS unsigned* st;
};

__device__ __forceinline__ XcdBarrier xcd_barrier_post(unsigned* bar, volatile LAS unsigned* st) {
    XcdBarrier b; b.bar = bar; b.x = xb_xcc_id(); b.st = st;
    if (threadIdx.x == 0) (void)xb_add(&bar[XB_XCNT(b.x)], 1u);
    return b;
}
__device__ __forceinline__ void xcd_barrier_complete(unsigned* bar, unsigned x, unsigned& nloc, unsigned& nx) {
    const unsigned G = gridDim.x * gridDim.y * gridDim.z;
    unsigned sum, cnt, mine, sp = 0u;
    for (;;) {
        sum = 0u; cnt = 0u; mine = 0u;
#pragma unroll
        for (unsigned j = 0; j < 16; ++j) { const unsigned c = xb_ld(&bar[XB_XCNT(j)]); sum += c; cnt += (c > 0u) ? 1u : 0u; mine = (j == x) ? c : mine; }
        if (sum == G) break;
        __builtin_amdgcn_s_sleep(1);
        if ((++sp & 255u) == 0u) { if (xb_ld(&bar[XB_TMO])) break; if (sp > XB_SPIN_CAP) { atomicAdd(&bar[XB_TMO], 1u); break; } }
    }
    nloc = mine > 0u ? mine : 1u; nx = cnt > 0u ? cnt : 1u;
}

__device__ __forceinline__ void xcd_barrier(const XcdBarrier& b) {
    asm volatile("s_waitcnt vmcnt(0)" ::: "memory");
    __syncthreads();
    if (threadIdx.x == 0) {
        unsigned* bar = b.bar;
        __builtin_amdgcn_s_waitcnt(0);
        unsigned nloc = b.st[0], nx = b.st[1];
        if (nloc == 0u) { xcd_barrier_complete(bar, b.x, nloc, nx); b.st[0] = nloc; b.st[1] = nx; }
        const unsigned old = xb_add(&bar[XB_XSUB(b.x)], 1u);
        const unsigned gen = old / nloc;
        if (old + 1u == (gen + 1u) * nloc) {
            __builtin_amdgcn_fence(__ATOMIC_RELEASE, "agent");
            asm volatile("s_waitcnt vmcnt(0)" ::: "memory");
            const unsigned og = xb_add(&bar[XB_TOP], 1u);
            const unsigned tg = og / nx;
            if (og + 1u == (tg + 1u) * nx) xb_add(&bar[XB_TOPGEN], 1u);
            else XB_SPIN(xb_ld(&bar[XB_TOPGEN]) == tg, bar);
            __builtin_amdgcn_fence(__ATOMIC_ACQUIRE, "agent");
            xb_add(&bar[XB_XGEN(b.x)], 1u);
            asm volatile("s_waitcnt vmcnt(0)" ::: "memory");
        } else {
            XB_SPIN(xb_ld(&bar[XB_XGEN(b.x)]) == gen, bar);
            __builtin_amdgcn_fence(__ATOMIC_ACQUIRE, "agent");
            asm volatile("s_waitcnt vmcnt(0)" ::: "memory");
        }
    }
    __syncthreads();
}

__device__ __forceinline__ float wave_sum(float v) {
#pragma unroll
    for (int o = 1; o < 64; o <<= 1) v += __shfl_xor(v, o);
    return v;
}
__device__ __forceinline__ float log_sigmoid_f(float x) { return fminf(x, 0.f) - log1pf(expf(-fabsf(x))); }
__device__ __forceinline__ float silu_f(float x) { return x / (1.0f + expf(-x)); }
__device__ __forceinline__ float sigmoid_f(float x) { return 1.0f / (1.0f + expf(-x)); }
__device__ __forceinline__ pg8::bf16x8 ldfrag(const LAS bf16* base, int stride, int r0, int k0, int lane) {
    return *(const LAS pg8::bf16x8*)(base + (r0 + (lane & 15)) * stride + k0 + 8 * (lane >> 4));
}
__device__ __forceinline__ pg8::bf16x8 pack8(const float (&v)[8]) { v4u w; w.x = pk2(v[0], v[1]); w.y = pk2(v[2], v[3]); w.z = pk2(v[4], v[5]); w.w = pk2(v[6], v[7]); return __builtin_bit_cast(pg8::bf16x8, w); }

struct Args {
    const float* x; const float* c; const int* pos; const float* w_mod; const float* b_mod; const float* norm1_w; const float* w_in; const float* gla_wa2; const float* gla_ba2; const float* hg_lb;
    const float* gla_norm_w; const float* hg_norm_w; const float* w_out; const float* norm2_w; const float* w_r; const float* b_r; const float* w_gu; const float* b_gu; const float* w_dn; const float* b_dn;
    const float* final_norm_w; float* out; unsigned char* ws; int ph_lo, ph_hi;
};

__device__ __forceinline__ void transpose_block64(const float* src, int ld, bf16* dst, LAS float*, int lane) {
    const int n4 = lane & 15, kg = lane >> 4;
    f32x4 v[16];
#pragma unroll
    for (int i = 0; i < 16; ++i) v[i] = __builtin_nontemporal_load((const f32x4*)(src + (size_t)(16 * kg + i) * ld + 4 * n4));
#pragma unroll
    for (int j = 0; j < 4; ++j) { v4u o0, o1;
        o0.x = pk2(v[0][j], v[1][j]); o0.y = pk2(v[2][j], v[3][j]); o0.z = pk2(v[4][j], v[5][j]); o0.w = pk2(v[6][j], v[7][j]);
        o1.x = pk2(v[8][j], v[9][j]); o1.y = pk2(v[10][j], v[11][j]); o1.z = pk2(v[12][j], v[13][j]); o1.w = pk2(v[14][j], v[15][j]);
        bf16* d = dst + (size_t)(4 * n4 + j) * D + 16 * kg; *(GAS v4u*)d = o0; *(GAS v4u*)(d + 8) = o1; }
}
__device__ __forceinline__ float clamp448(float x) { return __builtin_amdgcn_fmed3f(x, -448.f, 448.f); }
__device__ __forceinline__ int pk4_fp8(float a, float b, float c, float d) { int w = 0; w = __builtin_amdgcn_cvt_pk_fp8_f32(clamp448(a), clamp448(b), w, false);
    return __builtin_amdgcn_cvt_pk_fp8_f32(clamp448(c), clamp448(d), w, true); }
__device__ __forceinline__ void transpose_block64_fp8(const float* src, int ld, unsigned char* dst, LAS float*, int lane, float sc) {
    const int n4 = lane & 15, kg = lane >> 4;
    f32x4 v[16];
#pragma unroll
    for (int i = 0; i < 16; ++i) v[i] = __builtin_nontemporal_load((const f32x4*)(src + (size_t)(16 * kg + i) * ld + 4 * n4)) * sc;
#pragma unroll
    for (int j = 0; j < 4; ++j) { v4u o;
        o.x = (unsigned)pk4_fp8(v[0][j], v[1][j], v[2][j], v[3][j]); o.y = (unsigned)pk4_fp8(v[4][j], v[5][j], v[6][j], v[7][j]);
        o.z = (unsigned)pk4_fp8(v[8][j], v[9][j], v[10][j], v[11][j]); o.w = (unsigned)pk4_fp8(v[12][j], v[13][j], v[14][j], v[15][j]);
        *(GAS v4u*)(dst + (size_t)(4 * n4 + j) * D + 16 * kg) = o; }
}
constexpr int IT_IN = 16 * (NPROJ / 64), IT_OUT = 16 * 16, IT_GU = NE * 16 * 32, IT_DN = NE * 16 * 16, IT_LAYER = IT_IN + IT_OUT + IT_GU + IT_DN, IT_ALL = DEPTH * IT_LAYER;
__device__ __forceinline__ void convert_item(const Args& a, int l, int r, LAS float* scr, int lane) {
    unsigned char* ws = a.ws;
    bf16* WIN = (bf16*)(ws + WS_WIN); bf16* WOUT = (bf16*)(ws + WS_WOUT); unsigned char* WGU = ws + WS_WGU; unsigned char* WDN = ws + WS_WDN;
    if (r < IT_IN) { const int kb = r / (NPROJ / 64), nb = r % (NPROJ / 64), n0 = 64 * nb, sc = n0 + (n0 >= SRC_GA ? 16 : 0);
        if (F8_IN) transpose_block64_fp8(a.w_in + ((size_t)l * D + 64 * kb) * DIN + sc, DIN, (unsigned char*)WIN + ((size_t)l * NPROJ + n0) * D + 64 * kb, scr, lane, S8_W);
        else transpose_block64(a.w_in + ((size_t)l * D + 64 * kb) * DIN + sc, DIN, WIN + ((size_t)l * NPROJ + n0) * D + 64 * kb, scr, lane); return; }
    r -= IT_IN;
    if (r < IT_OUT) { const int kb = r / 16, nb = r % 16;
        if (F8_OUT) transpose_block64_fp8(a.w_out + ((size_t)l * D + 64 * kb) * D + 64 * nb, D, (unsigned char*)WOUT + ((size_t)l * D + 64 * nb) * D + 64 * kb, scr, lane, S8_W);
        else transpose_block64(a.w_out + ((size_t)l * D + 64 * kb) * D + 64 * nb, D, WOUT + ((size_t)l * D + 64 * nb) * D + 64 * kb, scr, lane); return; }
    r -= IT_OUT;
    if (r < IT_GU) { const int e = r / 512, r2 = r % 512, kb = r2 / 32, nb = r2 % 32, cc = 64 * nb;
        const int row = (cc < 1024) ? 256 * (cc / 128) + (cc % 128) : 256 * ((cc - 1024) / 128) + 128 + ((cc - 1024) % 128);
        transpose_block64_fp8(a.w_gu + (((size_t)l * NE + e) * D + 64 * kb) * 2048 + cc, 2048, WGU + (((size_t)l * NE + e) * 2048 + row) * D + 64 * kb, scr, lane, S8_W); return; }
    r -= IT_GU;
    { const int e = r / 256, r2 = r % 256, kb = r2 / 16, nb = r2 % 16;
        transpose_block64_fp8(a.w_dn + (((size_t)l * NE + e) * FFN + 64 * kb) * D + 64 * nb, D, WDN + (((size_t)l * NE + e) * D + 64 * nb) * D + 64 * kb, scr, lane, S8_W); }
}
constexpr int CB2 = 4, CB7 = 2, CB8 = 2;
__device__ __forceinline__ int conv_t2(int G) { return (G == 256) ? 192 * NWAVES * CB2 : 0; }
__device__ __forceinline__ int conv_idle(int nunits, int G) { const int rem = nunits % G; return rem ? G - rem : 0; }
__device__ __forceinline__ void convert_range(const Args& a, int l, int first, int count, LAS unsigned char* lds, int lane, int wave) {
    LAS float* scr = (LAS float*)(lds + wave * 16640);
    for (int k = 0; k < count; ++k) { const int it = first + k; if (it < IT_LAYER) convert_item(a, l, it, scr, lane); }
}
__device__ __forceinline__ void p0_prologue(const Args& a, LAS unsigned char* lds, int vcu, int G, int tid, int lane, int wave) {
    unsigned char* ws = a.ws;
    LAS float* scr = (LAS float*)(lds + wave * 16640);
    const int gw = vcu * NWAVES + wave, NGW = G * NWAVES;
    for (int it = gw; it < IT_LAYER; it += NGW) convert_item(a, 0, it, scr, lane);
    __syncthreads();
    {
        LAS float* cact = (LAS float*)lds;
        LAS float* red = (LAS float*)(lds + 8192);
        for (int i = tid; i < 2 * D; i += NTHR) cact[i] = silu_f(a.c[i]);
        __syncthreads();
        float* MOD = (float*)(ws + WS_MOD);
        for (int it = vcu; it < DEPTH * 96; it += G) {
            const int l = it / 96, n0 = (it % 96) * 64;
            const float* wp = a.w_mod + ((size_t)l * D + 128 * wave) * 6144 + n0 + lane;
            float a0 = 0.f, a1 = 0.f;
#pragma unroll 32
            for (int k = 0; k < 128; ++k) { const float w = __builtin_nontemporal_load(wp + (size_t)k * 6144); a0 += cact[128 * wave + k] * w; a1 += cact[D + 128 * wave + k] * w; }
            red[(wave * 2 + 0) * 64 + lane] = a0; red[(wave * 2 + 1) * 64 + lane] = a1;
            __syncthreads();
            if (tid < 128) { const int b = tid >> 6, ln = tid & 63; float s = a.b_mod[l * 6144 + n0 + ln];
#pragma unroll
                for (int w = 0; w < 8; ++w) s += red[(w * 2 + b) * 64 + ln];
                MOD[((size_t)l * 2 + b) * 6144 + n0 + ln] = s; }
            __syncthreads();
        }
    }
    { const f32x4* xs = (const f32x4*)a.x; uint2* xd = (uint2*)(ws + WS_X);
        for (int i = vcu * NTHR + tid; i < MTOK * D / 4; i += G * NTHR) { const f32x4 v = xs[i]; uint2 p; p.x = pk2(v[0], v[1]); p.y = pk2(v[2], v[3]); xd[i] = p; } }
    {
        float* ROPE = (float*)(ws + WS_ROPE);
        for (int i = vcu * NTHR + tid; i < MTOK * 24; i += G * NTHR) { const int t = i / 24, f = i % 24;
            const float inv = (float)pow(10000.0, -(double)f / 24.0); const float ang = (float)a.pos[t] * inv;
            ROPE[(size_t)t * 48 + f] = cosf(ang); ROPE[(size_t)t * 48 + 24 + f] = sinf(ang); }
    }
    if (vcu == 0 && tid < 256) {
        float v[4], mx = -3.0e38f; for (int l = 0; l < 4; ++l) { v[l] = a.hg_lb[l * 256 + tid]; mx = fmaxf(mx, v[l]); }
        float s = 0.f; for (int l = 0; l < 4; ++l) { v[l] = expf(v[l] - mx); s += v[l]; }
        float* LB = (float*)(ws + WS_LB); float cs = 0.f, first = 0.f;
        for (int l = 0; l < 4; ++l) { cs += v[l] / s; if (l == 0) first = cs; LB[l * 256 + tid] = cs - first; }
    }
}

__device__ __forceinline__ void moe_combine_row(f32x4 (&v)[4], int m, const bf16* Y, const int* SLOT, const float* TOPW, const float* g2, int lane) {
    const int4 sl = *(const int4*)(SLOT + (size_t)m * 4); const f32x4 tw = *(const f32x4*)(TOPW + (size_t)m * 4);
    const int s[4] = {sl.x, sl.y, sl.z, sl.w};
    f32x4 acc[4];
#pragma unroll
    for (int j = 0; j < 4; ++j) acc[j] = (f32x4){0.f, 0.f, 0.f, 0.f};
#pragma unroll
    for (int k = 0; k < 4; ++k) { const bf16* yr = Y + (size_t)s[k] * D + 4 * lane; const float w = tw[k];
#pragma unroll
        for (int j = 0; j < 4; ++j) { const uint2 p = *(const uint2*)(yr + 256 * j);
            acc[j][0] += w * __builtin_bit_cast(float, p.x << 16); acc[j][1] += w * __builtin_bit_cast(float, p.x & 0xffff0000u);
            acc[j][2] += w * __builtin_bit_cast(float, p.y << 16); acc[j][3] += w * __builtin_bit_cast(float, p.y & 0xffff0000u); } }
#pragma unroll
    for (int j = 0; j < 4; ++j) { const f32x4 g = *(const f32x4*)(g2 + 4 * lane + 256 * j); v[j] = v[j] + g * acc[j]; }
}
__device__ __forceinline__ float row_rstd(const f32x4 (&v)[4]) {
    float s = 0.f;
#pragma unroll
    for (int j = 0; j < 4; ++j) s += (v[j][0] * v[j][0] + v[j][1] * v[j][1]) + (v[j][2] * v[j][2] + v[j][3] * v[j][3]);
    return 1.0f / sqrtf(wave_sum(s) * (1.0f / D) + EPS);
}
__device__ __forceinline__ void modulate_row(f32x4 (&v)[4], float rstd, const float* nw, const float* sc, const float* sh, bf16* hrow, int lane) {
#pragma unroll
    for (int j = 0; j < 4; ++j) { const int c0 = 4 * lane + 256 * j; const f32x4 w = *(const f32x4*)(nw + c0), s1 = *(const f32x4*)(sc + c0), s0 = *(const f32x4*)(sh + c0);
        v[j] = v[j] * rstd * w * (s1 + 1.0f) + s0;
        uint2 p; p.x = pk2(v[j][0], v[j][1]); p.y = pk2(v[j][2], v[j][3]); *(uint2*)(hrow + c0) = p; }
}


constexpr int LR_SLT = 142976, LR_TWL = 144000, LR_SSR = 145024;
__device__ __forceinline__ void stage_slots(const unsigned char* ws, int row0, LAS unsigned char* lds, int tid) {
    if (tid < 64) { *(LAS v4u*)(lds + LR_SLT + 16 * tid) = *(const v4u*)((const int*)(ws + WS_SLOT) + (size_t)(row0 + tid) * 4);
                    *(LAS f32x4*)(lds + LR_TWL + 16 * tid) = *(const f32x4*)((const float*)(ws + WS_TOPW) + (size_t)(row0 + tid) * 4); }
}
template <bool SS, bool OUTF32>
__device__ __forceinline__ void flat_combine(const bf16* xsrc, void* xdst, int row0, const bf16* Y, const float* g2, LAS unsigned char* lds, int tid, int lane, const float* fw = nullptr) {
    static_assert(Y8, "expert outputs are stored as fp8");
    typedef float f32x2v __attribute__((ext_vector_type(2)));
    const int c16 = tid & 63, rsub = tid >> 6; const unsigned char* Yb = (const unsigned char*)Y;
    f32x4 g[4];
#pragma unroll
    for (int q = 0; q < 4; ++q) g[q] = *(const f32x4*)(g2 + 16 * c16 + 4 * q);
    f32x4 fwv[4];
    if (SS) {
#pragma unroll
        for (int q = 0; q < 4; ++q) fwv[q] = *(const f32x4*)(fw + 16 * c16 + 4 * q); }
#pragma unroll 2
    for (int it = 0; it < 8; ++it) { const int i = 8 * it + rsub; const size_t m = (size_t)(row0 + i);
        const v4u x0 = *(const v4u*)(xsrc + m * D + 16 * c16), x1 = *(const v4u*)(xsrc + m * D + 16 * c16 + 8);
        const v4u sl = *(const LAS v4u*)(lds + LR_SLT + 16 * i); const f32x4 tws = *(const LAS f32x4*)(lds + LR_TWL + 16 * i) * (1.0f / S8_Y);
        const v4u y0 = *(const v4u*)(Yb + (size_t)sl.x * D + 16 * c16), y1 = *(const v4u*)(Yb + (size_t)sl.y * D + 16 * c16), y2 = *(const v4u*)(Yb + (size_t)sl.z * D + 16 * c16), y3 = *(const v4u*)(Yb + (size_t)sl.w * D + 16 * c16);
        const unsigned xw[8] = {x0.x, x0.y, x0.z, x0.w, x1.x, x1.y, x1.z, x1.w}, w0[4] = {y0.x, y0.y, y0.z, y0.w}, w1[4] = {y1.x, y1.y, y1.z, y1.w}, w2[4] = {y2.x, y2.y, y2.z, y2.w}, w3[4] = {y3.x, y3.y, y3.z, y3.w};
        float v[16]; float sq = 0.f;
#pragma unroll
        for (int q = 0; q < 4; ++q) {
            const f32x2v a0 = __builtin_amdgcn_cvt_pk_f32_fp8((int)w0[q], false), b0 = __builtin_amdgcn_cvt_pk_f32_fp8((int)w0[q], true), a1 = __builtin_amdgcn_cvt_pk_f32_fp8((int)w1[q], false), b1 = __builtin_amdgcn_cvt_pk_f32_fp8((int)w1[q], true);
            const f32x2v a2 = __builtin_amdgcn_cvt_pk_f32_fp8((int)w2[q], false), b2 = __builtin_amdgcn_cvt_pk_f32_fp8((int)w2[q], true), a3 = __builtin_amdgcn_cvt_pk_f32_fp8((int)w3[q], false), b3 = __builtin_amdgcn_cvt_pk_f32_fp8((int)w3[q], true);
            const float e0 = tws[0] * a0[0] + tws[1] * a1[0] + tws[2] * a2[0] + tws[3] * a3[0], e1 = tws[0] * a0[1] + tws[1] * a1[1] + tws[2] * a2[1] + tws[3] * a3[1];
            const float e2 = tws[0] * b0[0] + tws[1] * b1[0] + tws[2] * b2[0] + tws[3] * b3[0], e3 = tws[0] * b0[1] + tws[1] * b1[1] + tws[2] * b2[1] + tws[3] * b3[1];
            v[4 * q + 0] = __builtin_bit_cast(float, xw[2 * q] << 16) + g[q][0] * e0; v[4 * q + 1] = __builtin_bit_cast(float, xw[2 * q] & 0xffff0000u) + g[q][1] * e1;
            v[4 * q + 2] = __builtin_bit_cast(float, xw[2 * q + 1] << 16) + g[q][2] * e2; v[4 * q + 3] = __builtin_bit_cast(float, xw[2 * q + 1] & 0xffff0000u) + g[q][3] * e3;
            sq += (v[4 * q] * v[4 * q] + v[4 * q + 1] * v[4 * q + 1]) + (v[4 * q + 2] * v[4 * q + 2] + v[4 * q + 3] * v[4 * q + 3]); }
        if (SS) { const float rstd = 1.0f / sqrtf(wave_sum(sq) * (1.0f / D) + EPS);
#pragma unroll
            for (int q = 0; q < 4; ++q) { v[4 * q] *= rstd * fwv[q][0]; v[4 * q + 1] *= rstd * fwv[q][1]; v[4 * q + 2] *= rstd * fwv[q][2]; v[4 * q + 3] *= rstd * fwv[q][3]; } }
        if (OUTF32) {
#pragma unroll
            for (int q = 0; q < 4; ++q) *(GAS f32x4*)((float*)xdst + m * D + 16 * c16 + 4 * q) = (f32x4){v[4 * q], v[4 * q + 1], v[4 * q + 2], v[4 * q + 3]}; }
        else { v4u o0, o1; o0.x = pk2(v[0], v[1]); o0.y = pk2(v[2], v[3]); o0.z = pk2(v[4], v[5]); o0.w = pk2(v[6], v[7]); o1.x = pk2(v[8], v[9]); o1.y = pk2(v[10], v[11]); o1.z = pk2(v[12], v[13]); o1.w = pk2(v[14], v[15]);
            *(GAS v4u*)((bf16*)xdst + m * D + 16 * c16) = o0; *(GAS v4u*)((bf16*)xdst + m * D + 16 * c16 + 8) = o1; }
    }
}
template <bool F8, bool SLOTS>
__device__ __forceinline__ void flat_modulate(const bf16* xin, int row0, const LAS float* rstds, const float* nw, const float* scp, const float* shp, bf16* H, unsigned char* A1, LAS unsigned char* lds, int tid) {
    const int c16 = tid & 63, rsub = tid >> 6; f32x4 ws1[4], s0[4];
#pragma unroll
    for (int q = 0; q < 4; ++q) { const int c0 = 16 * c16 + 4 * q; ws1[q] = *(const f32x4*)(nw + c0) * (*(const f32x4*)(scp + c0) + 1.0f); s0[q] = *(const f32x4*)(shp + c0); }
#pragma unroll 2
    for (int it = 0; it < 8; ++it) { const int i = 8 * it + rsub; const size_t m = (size_t)(row0 + i); const float rs = rstds[i];
        const v4u x0 = *(const v4u*)(xin + m * D + 16 * c16), x1 = *(const v4u*)(xin + m * D + 16 * c16 + 8); const unsigned xw[8] = {x0.x, x0.y, x0.z, x0.w, x1.x, x1.y, x1.z, x1.w};
        f32x4 v[4];
#pragma unroll
        for (int q = 0; q < 4; ++q) v[q] = (f32x4){__builtin_bit_cast(float, xw[2 * q] << 16), __builtin_bit_cast(float, xw[2 * q] & 0xffff0000u), __builtin_bit_cast(float, xw[2 * q + 1] << 16), __builtin_bit_cast(float, xw[2 * q + 1] & 0xffff0000u)} * rs * ws1[q] + s0[q];
        if (F8) { v4u o; o.x = (unsigned)pk4_fp8(v[0][0] * S8_H, v[0][1] * S8_H, v[0][2] * S8_H, v[0][3] * S8_H); o.y = (unsigned)pk4_fp8(v[1][0] * S8_H, v[1][1] * S8_H, v[1][2] * S8_H, v[1][3] * S8_H);
            o.z = (unsigned)pk4_fp8(v[2][0] * S8_H, v[2][1] * S8_H, v[2][2] * S8_H, v[2][3] * S8_H); o.w = (unsigned)pk4_fp8(v[3][0] * S8_H, v[3][1] * S8_H, v[3][2] * S8_H, v[3][3] * S8_H);
            if (SLOTS) { const v4u sl = *(const LAS v4u*)(lds + LR_SLT + 16 * i);
                *(GAS v4u*)(A1 + (size_t)sl.x * D + 16 * c16) = o; *(GAS v4u*)(A1 + (size_t)sl.y * D + 16 * c16) = o; *(GAS v4u*)(A1 + (size_t)sl.z * D + 16 * c16) = o; *(GAS v4u*)(A1 + (size_t)sl.w * D + 16 * c16) = o; }
            else *(GAS v4u*)((unsigned char*)H + m * D + 16 * c16) = o; }
        else { v4u o0, o1; o0.x = pk2(v[0][0], v[0][1]); o0.y = pk2(v[0][2], v[0][3]); o0.z = pk2(v[1][0], v[1][1]); o0.w = pk2(v[1][2], v[1][3]); o1.x = pk2(v[2][0], v[2][1]); o1.y = pk2(v[2][2], v[2][3]); o1.z = pk2(v[3][0], v[3][1]); o1.w = pk2(v[3][2], v[3][3]);
            *(GAS v4u*)(H + m * D + 16 * c16) = o0; *(GAS v4u*)(H + m * D + 16 * c16 + 8) = o1; } }
}

constexpr int WP = 1032;
constexpr int LR_WHI = 0, LR_PART = 132096, LR_SSX = 140288, LR_RSTD = 140544, LR_BIAS = 140800, LR_RED = 140928;
template <int NEO>
__device__ __forceinline__ void rows_mfma(const Args& a, int layer, LAS unsigned char* lds, volatile LAS unsigned* MISC, gu32* ctl, int vcu, int G, int tid, int lane, int wave) {
    constexpr bool P5 = (NEO == 32); constexpr int NET = NEO / 16;
    unsigned char* ws = a.ws; bf16* X = (bf16*)(ws + WS_X); bf16* H = (bf16*)(ws + WS_H); const float* MOD = (const float*)(ws + WS_MOD);
    LAS bf16* Whi = (LAS bf16*)(lds + LR_WHI); LAS bf16* Wlo = Whi + NEO * WP; LAS float* part = (LAS float*)(lds + LR_PART); LAS float* ssx = (LAS float*)(lds + LR_SSX);
    LAS float* rstds = (LAS float*)(lds + LR_RSTD); LAS float* biasl = (LAS float*)(lds + LR_BIAS); LAS float* red = (LAS float*)(lds + LR_RED);
    const float* nw = (P5 ? a.norm2_w : a.norm1_w) + layer * D;
    const float* Wsrc = P5 ? a.w_r + (size_t)layer * D * NE : a.w_in + (size_t)layer * D * DIN + SRC_GA; const int wld = P5 ? NE : DIN;
    if (P5) { if (tid < NE) MISC[MW_HIST + tid] = 0u; }
    for (int row0 = vcu * 64; row0 < MTOK; row0 += G * 64) {
        const int b = row0 / SEQ; const float* mp = MOD + ((size_t)layer * 2 + b) * 6144; const float* scp = mp + (P5 ? 4 : 1) * D; const float* shp = mp + (P5 ? 3 : 0) * D;
        if (!P5 && layer > 0) { stage_slots(ws, row0, lds, tid); __syncthreads(); }
        { constexpr int E4 = NEO / 4, NITP = (D / 2 * E4) / NTHR, NIT = 4;
          f32x4 bacc = {0.f, 0.f, 0.f, 0.f};
#pragma unroll 1
          for (int ib0 = 0; ib0 < NITP; ib0 += NIT) {
            f32x4 wa[NIT], wb[NIT]; f32x2_t nv[NIT], sv[NIT], hv[NIT];
#pragma unroll
            for (int it = 0; it < NIT; ++it) { const int idx = tid + NTHR * (ib0 + it), k2 = idx / E4, e4 = idx - k2 * E4, k = 2 * k2;
                wa[it] = *(const f32x4*)(Wsrc + (size_t)k * wld + 4 * e4); wb[it] = *(const f32x4*)(Wsrc + (size_t)(k + 1) * wld + 4 * e4);
                nv[it] = *(const f32x2_t*)(nw + k); sv[it] = *(const f32x2_t*)(scp + k); hv[it] = *(const f32x2_t*)(shp + k); }
#pragma unroll
            for (int it = 0; it < NIT; ++it) { const int idx = tid + NTHR * (ib0 + it), k2 = idx / E4, e4 = idx - k2 * E4, k = 2 * k2;
                bacc += wa[it] * hv[it][0] + wb[it] * hv[it][1];
                const f32x4 w0 = wa[it] * (nv[it][0] * (1.0f + sv[it][0])), w1 = wb[it] * (nv[it][1] * (1.0f + sv[it][1]));
#pragma unroll
                for (int j = 0; j < 4; ++j) { const unsigned h0 = f2bf(w0[j]), h1 = f2bf(w1[j]); const float l0 = w0[j] - __builtin_bit_cast(float, h0 << 16), l1 = w1[j] - __builtin_bit_cast(float, h1 << 16);
                    *(LAS unsigned*)(Whi + (4 * e4 + j) * WP + k) = h0 | (h1 << 16); *(LAS unsigned*)(Wlo + (4 * e4 + j) * WP + k) = pk2(l0, l1); } } }
#pragma unroll
          for (int j = 0; j < 4; ++j) { float v = bacc[j];
#pragma unroll
              for (int sh = E4; sh < 64; sh <<= 1) v += __shfl_xor(v, sh);
              bacc[j] = v; }
          if (lane < E4) *(LAS f32x4*)(red + wave * NEO + 4 * lane) = bacc; }
        const bf16* xin = X;
        if (!P5 && layer > 0) { flat_combine<false, false>(X, X, row0, (const bf16*)(ws + WS_Y), MOD + ((size_t)(layer - 1) * 2 + b) * 6144 + 5 * D, lds, tid, lane); asm volatile("s_waitcnt vmcnt(0)" ::: "memory"); }
        __syncthreads();
        if (tid < NEO) { float sacc = P5 ? a.b_r[layer * NE + tid] : 0.f; for (int q = 0; q < NWAVES; ++q) sacc += red[q * NEO + tid]; biasl[tid] = sacc; }
        const int rg = wave >> 1, kh = wave & 1, r = lane & 15, g = lane >> 4;
        { const bf16* xr = xin + (size_t)(row0 + 16 * rg + r) * D; f32x4 acc[NET]; float ss = 0.f;
#pragma unroll
            for (int et = 0; et < NET; ++et) acc[et] = (f32x4){0.f, 0.f, 0.f, 0.f};
#pragma unroll 4
            for (int s = 16 * kh; s < 16 * kh + 16; ++s) { const int k0 = 32 * s + 8 * g; const v4u xp = *(const v4u*)(xr + k0); const unsigned xw[4] = {xp.x, xp.y, xp.z, xp.w};
#pragma unroll
                for (int j = 0; j < 4; ++j) { const float xa = __builtin_bit_cast(float, xw[j] << 16), xb = __builtin_bit_cast(float, xw[j] & 0xffff0000u); ss += xa * xa + xb * xb; }
                const pg8::bf16x8 ahi = __builtin_bit_cast(pg8::bf16x8, xp);
#pragma unroll
                for (int et = 0; et < NET; ++et) { const pg8::bf16x8 whi = ldfrag(Whi, WP, 16 * et, 32 * s, lane), wlo = ldfrag(Wlo, WP, 16 * et, 32 * s, lane);
                    acc[et] = __builtin_amdgcn_mfma_f32_16x16x32_bf16(ahi, whi, acc[et], 0, 0, 0); acc[et] = __builtin_amdgcn_mfma_f32_16x16x32_bf16(ahi, wlo, acc[et], 0, 0, 0); } }
            ss += __shfl_xor(ss, 16); ss += __shfl_xor(ss, 32);
            if (kh == 1) {
#pragma unroll
                for (int et = 0; et < NET; ++et)
#pragma unroll
                    for (int q = 0; q < 4; ++q) part[(rg * 16 + 4 * g + q) * 32 + 16 * et + r] = acc[et][q];
                if (g == 0) ssx[rg * 16 + r] = ss; }
            __syncthreads();
            if (kh == 0) { const float sst = ss + ssx[rg * 16 + r]; if (g == 0) rstds[rg * 16 + r] = 1.0f / sqrtf(sst * (1.0f / D) + EPS);
                asm volatile("s_waitcnt lgkmcnt(0)" ::: "memory");
#pragma unroll
                for (int et = 0; et < NET; ++et)
#pragma unroll
                    for (int q = 0; q < 4; ++q) { const int i = rg * 16 + 4 * g + q, e = 16 * et + r; const float v = rstds[i] * (acc[et][q] + part[i * 32 + e]) + biasl[e];
                        if (P5) part[i * 32 + e] = v; else ((float*)(ws + WS_GA))[(size_t)(row0 + i) * 16 + e] = v; }
                if (P5) { asm volatile("s_waitcnt lgkmcnt(0)" ::: "memory");
                    if (lane < 16) { const int i = rg * 16 + lane, m = row0 + i; float lv[NE];
#pragma unroll
                        for (int e = 0; e < NE; ++e) lv[e] = part[i * 32 + e];
                        float tv[4]; int te[4];
#pragma unroll
                        for (int t = 0; t < 4; ++t) { float best = -3.0e38f; int bi = 0;
#pragma unroll
                            for (int e = 0; e < NE; ++e) if (lv[e] > best) { best = lv[e]; bi = e; }
#pragma unroll
                            for (int e = 0; e < NE; ++e) if (e == bi) lv[e] = -3.0e38f;
                            tv[t] = best; te[t] = bi; }
                        const float e1 = expf(tv[1] - tv[0]), e2 = expf(tv[2] - tv[0]), e3 = expf(tv[3] - tv[0]); const float inv = 1.0f / (1.0f + e1 + e2 + e3);
                        *(f32x4*)((float*)(ws + WS_TOPW) + (size_t)m * 4) = (f32x4){inv, e1 * inv, e2 * inv, e3 * inv};
#pragma unroll
                        for (int t = 0; t < 4; ++t) { const unsigned rk = __hip_atomic_fetch_add((LAS unsigned*)&MISC[MW_HIST + te[t]], 1u, __ATOMIC_RELAXED, __HIP_MEMORY_SCOPE_WORKGROUP);
                            ((LAS unsigned*)(lds + LR_SLT))[i * 4 + t] = ((unsigned)te[t] << 16) | rk; } } } }
            __syncthreads(); }
        if (P5) { if (tid < NE) { const unsigned hcnt = MISC[MW_HIST + tid]; MISC[MW_BASE + tid] = hcnt ? atomicAdd((unsigned*)(ctl + CW_CNT + layer * NE + tid), hcnt) : 0u; }
            __syncthreads();
            if (tid < 256) { LAS unsigned* sl = (LAS unsigned*)(lds + LR_SLT) + tid; const unsigned v = *sl, e = v >> 16; const unsigned slot = (e << ECAP_SH) + MISC[MW_BASE + e] + (v & 0xffffu);
                *sl = slot; ((int*)(ws + WS_SLOT))[(size_t)row0 * 4 + tid] = (int)slot; }
            if (tid < NE) MISC[MW_HIST + tid] = 0u;
            __syncthreads(); }
        if (P5) flat_modulate<true, true>(xin, row0, rstds, nw, scp, shp, H, ws + WS_A1, lds, tid);
        else flat_modulate<F8_IN, false>(xin, row0, rstds, nw, scp, shp, H, ws + WS_A1, lds, tid);
        __syncthreads();
    }
}

__device__ __forceinline__ void final_rows(const Args& a, LAS unsigned char* lds, int vcu, int G, int tid, int lane) {
    unsigned char* ws = a.ws; const bf16* X = (const bf16*)(ws + WS_X); const float* MOD = (const float*)(ws + WS_MOD);
    for (int row0 = vcu * 64; row0 < MTOK; row0 += G * 64) { const int b = row0 / SEQ;
        stage_slots(ws, row0, lds, tid);
        __syncthreads();
        flat_combine<true, true>(X, a.out, row0, (const bf16*)(ws + WS_Y), MOD + ((size_t)(DEPTH - 1) * 2 + b) * 6144 + 5 * D, lds, tid, lane, a.final_norm_w);
        __syncthreads();
    }
}

__device__ __noinline__ void moe_tables(gu32* ctl, int layer, volatile LAS unsigned* MISC, int tid) {
    if (tid < NE) MISC[MW_CNT + tid] = __hip_atomic_load(ctl + CW_CNT + layer * NE + tid, RLX_AGENT);
    __syncthreads();
    if (tid == 0) { unsigned n = 0;
        for (int e = 0; e < NE; ++e) { const unsigned nt = (MISC[MW_CNT + e] + 255u) >> 8; for (unsigned t = 0; t < nt; ++t) MISC[MW_TILE + n + t] = (unsigned)(e * 64) + t; n += nt; }
        MISC[MW_NRT] = n; }
    __syncthreads();
}

constexpr int BP = 72;
template <int TYPE> struct MixCfg { static constexpr int DK = (TYPE == 1) ? 64 : 48, DV = (TYPE == 1) ? 64 : 96, NC = 4 * DK, NV = 4 * DV;
    static constexpr int STOFF = (TYPE == 0) ? ST_GLA : (TYPE == 1) ? ST_HG : ST_RET, COFF = (TYPE == 0) ? 0 : 192;
    static constexpr int CQ = (TYPE == 0) ? C_GQ : (TYPE == 1) ? C_HQ : C_RQ, CK = (TYPE == 0) ? C_GK : (TYPE == 1) ? C_HF : C_RK, CV = (TYPE == 0) ? C_GV : (TYPE == 1) ? C_HI : C_RV, CG = (TYPE == 0) ? C_GG : (TYPE == 1) ? C_HG : C_RG;
    static constexpr int MIXOFF = (TYPE == 0) ? 0 : (TYPE == 1) ? 384 : 640, KOFF = (TYPE == 0) ? 0 : (TYPE == 1) ? 192 : 448; };
__device__ __forceinline__ float fast_logsig(float x) { x = fmaxf(x, -80.f); return -__logf(1.0f + __expf(-x)); }
__device__ __forceinline__ float ret_lg(int h) { return logf(1.0f - exp2f(-5.0f - (float)h)); }

template <int NV>
__device__ __forceinline__ void stage_vt(const bf16* pv  , LAS bf16* VT, int tid) {
    constexpr int NIT = (64 * (NV / 8)) / NTHR; static_assert((64 * (NV / 8)) % NTHR == 0, "stage_vt");
    v4u p[NIT];
#pragma unroll
    for (int it = 0; it < NIT; ++it) { const int idx = tid + NTHR * it, j = idx & 63, ch = idx >> 6; p[it] = *(const v4u*)(pv + (size_t)j * NPROJ + 8 * ch); }
#pragma unroll
    for (int it = 0; it < NIT; ++it) { const int idx = tid + NTHR * it, j = idx & 63, ch = idx >> 6; LAS bf16* d = VT + (8 * ch) * BP + j;
        d[0 * BP] = (bf16)(p[it].x & 0xffffu); d[1 * BP] = (bf16)(p[it].x >> 16); d[2 * BP] = (bf16)(p[it].y & 0xffffu); d[3 * BP] = (bf16)(p[it].y >> 16);
        d[4 * BP] = (bf16)(p[it].z & 0xffffu); d[5 * BP] = (bf16)(p[it].z >> 16); d[6 * BP] = (bf16)(p[it].w & 0xffffu); d[7 * BP] = (bf16)(p[it].w >> 16); }
}

constexpr int LA_KT = 0, LA_VT = 36864, LA_TOT = 92160, LA_GA = 94208, LA_KTT = 98304, KTP = 264;
template <int TYPE>
__device__ __forceinline__ void mixa_batch(const Args& a, int layer, int unit, LAS unsigned char* lds, int tid, int lane, int wave) {
    asm volatile("" : "+v"(tid), "+v"(lane));
    typedef MixCfg<TYPE> C; constexpr int DK = C::DK, DV = C::DV, NC = C::NC, NV = C::NV;
    unsigned char* ws = a.ws; const bf16* PROJ = (const bf16*)(ws + WS_PROJ); bf16* F1 = (bf16*)(ws + WS_CUM); float* ECG = (float*)(ws + WS_CUM + 16 * MiB) + (size_t)unit * 4 * NDV; float* DVEC = (float*)(ws + WS_DVEC) + (size_t)unit * NDV;
    bf16* U = (bf16*)(ws + WS_U) + (size_t)unit * ST_TOT + C::STOFF;
    LAS bf16* KT = (LAS bf16*)(lds + LA_KT); LAS bf16* VT = (LAS bf16*)(lds + LA_VT); LAS float* TOT = (LAS float*)(lds + LA_TOT); const LAS float* GAs = (const LAS float*)(lds + LA_GA);
    const int row0 = unit * CH;
    stage_vt<NV>(PROJ + (size_t)row0 * NPROJ + C::CV, VT, tid);
    const bool act = tid < 2 * NC; const int c = act ? tid % NC : 0, half = act ? tid / NC : 0, h = c / DK, d = c - h * DK;
    float cum[32]; float tot = 0.f;
    float w2[16], b2 = 0.f, lbv = 0.f, lg = 0.f, sg = 0.f; int f = 0, d2 = 0;
    if (act) {
        if constexpr (TYPE == 0) { b2 = a.gla_ba2[layer * 192 + c];
#pragma unroll
            for (int r = 0; r < 16; ++r) w2[r] = a.gla_wa2[(layer * 16 + r) * 192 + c]; }
        if constexpr (TYPE == 1) lbv = ((const float*)(ws + WS_LB))[layer * 256 + c];
        if constexpr (TYPE == 2) { lg = ret_lg(h); f = (d < 24) ? d : d - 24; d2 = (d < 24) ? d + 24 : d - 24; sg = (d < 24) ? -1.f : 1.f; }
#pragma unroll
        for (int gq = 0; gq < 2; ++gq) {
            bf16 hraw[16];
            if constexpr (TYPE == 1) {
#pragma unroll
                for (int i = 0; i < 16; ++i) hraw[i] = PROJ[(size_t)(row0 + 32 * half + 16 * gq + i) * NPROJ + C_HF + c]; }
#pragma unroll
            for (int ii = 0; ii < 16; ++ii) { const int i = 16 * gq + ii, t = 32 * half + i; float g;
                if constexpr (TYPE == 0) { float pre = b2;
#pragma unroll
                    for (int r = 0; r < 16; ++r) pre += GAs[t * 16 + r] * w2[r];
                    g = fast_logsig(pre) * (1.0f / 16.0f); }
                else if constexpr (TYPE == 1) { const float hf = fminf(fmaxf(bf2f(hraw[ii]), -80.f), 80.f); const float sgm = __builtin_amdgcn_rcpf(1.0f + __expf(-hf));
                    g = __logf(lbv + (1.0f - lbv) * sgm); }
                else g = lg;
                tot += g; cum[i] = tot;
                if constexpr (TYPE == 0) { if ((ii & 3) == 3) asm volatile("" ::: "memory"); } } }
        TOT[c * 2 + half] = tot;
    }
    __syncthreads();
    if (act) { const float t0 = TOT[c * 2], t1 = TOT[c * 2 + 1]; const float off = half ? t0 : 0.f, last = t0 + t1;
#pragma unroll
        for (int hq = 0; hq < 4; ++hq) {
            bf16 ka[8], kb[8]; float cs[8], sn[8];
            if constexpr (TYPE != 1) {
#pragma unroll
                for (int i = 0; i < 8; ++i) { const size_t row = (size_t)(row0 + 32 * half + 8 * hq + i); const bf16* pr = PROJ + row * NPROJ;
                    if constexpr (TYPE == 0) ka[i] = pr[C_GK + c];
                    else { const float* rp = (const float*)(ws + WS_ROPE) + row * 48; ka[i] = pr[C_RK + h * 48 + d]; kb[i] = pr[C_RK + h * 48 + d2]; cs[i] = rp[f]; sn[i] = rp[24 + f]; } } }
            float kt[8];
#pragma unroll
            for (int j = 0; j < 8; ++j) { const int i = 8 * hq + j; const float cm = cum[i] + off; const size_t row = (size_t)(row0 + 32 * half + i); float k;
                if constexpr (TYPE == 0) k = bf2f(ka[j]);
                else if constexpr (TYPE == 1) k = 1.0f - __expf(cum[i] - (i > 0 ? cum[i - 1] : 0.f));
                else k = bf2f(ka[j]) * cs[j] + sg * bf2f(kb[j]) * sn[j];
                if constexpr (TYPE != 2) *(GAS bf16*)(F1 + row * NDV + C::COFF + c) = (bf16)f2bf(__expf(cm - ((i < 16) ? off : cum[15] + off)));
                { const float eb = cum[(i < 16) ? 15 : 31] + off;
                  ((LAS bf16*)(lds + LA_KTT))[(32 * half + i) * KTP + c] = (bf16)f2bf(k * __expf(eb - cm)); }
                kt[j] = k * __expf(last - cm); }
            v4u w; w.x = pk2(kt[0], kt[1]); w.y = pk2(kt[2], kt[3]); w.z = pk2(kt[4], kt[5]); w.w = pk2(kt[6], kt[7]);
            *(LAS v4u*)(KT + c * BP + 32 * half + 8 * hq) = w; }
        if (TYPE != 2) { *(GAS float*)(ECG + (2 * half + 0) * NDV + C::COFF + c) = cum[15] + off; *(GAS float*)(ECG + (2 * half + 1) * NDV + C::COFF + c) = cum[31] + off; }
        if (TYPE != 2 && half == 0) *(GAS float*)(DVEC + C::COFF + c) = __expf(last);
    }
    __syncthreads();
    { constexpr int CPR = NC / 8;
#pragma unroll
        for (int it = 0; it < (64 * CPR) / NTHR; ++it) { const int idx = tid + NTHR * it, t = idx / CPR, ch = idx - t * CPR;
            *(GAS v4u*)((bf16*)(ws + WS_KT) + (size_t)(row0 + t) * NKT + C::KOFF + 8 * ch) = *(const LAS v4u*)((const LAS bf16*)(lds + LA_KTT) + t * KTP + 8 * ch); } }
    constexpr int TD = DK / 16, NT = (DV / 16) * TD;
    for (int ti = wave; ti < 4 * NT; ti += NWAVES) { const int hh = ti / NT, tr = ti - hh * NT, te = tr / TD, td = tr - te * TD; f32x4 acc = {0.f, 0.f, 0.f, 0.f};
#pragma unroll
        for (int kk = 0; kk < 2; ++kk) acc = __builtin_amdgcn_mfma_f32_16x16x32_bf16(ldfrag(VT, BP, hh * DV + te * 16, kk * 32, lane), ldfrag(KT, BP, hh * DK + td * 16, kk * 32, lane), acc, 0, 0, 0);
        bf16* Uh = U + hh * DK * DV;
#pragma unroll
        for (int r = 0; r < 4; ++r) *(GAS bf16*)(Uh + (te * 16 + (lane >> 4) * 4 + r) * DK + td * 16 + (lane & 15)) = (bf16)f2bf(acc[r]); }
    __syncthreads();
}
__device__ __forceinline__ void p3a_summaries(const Args& a, int layer, LAS unsigned char* lds, int vcu, int G, int tid, int lane, int wave) {
    for (int unit = vcu; unit < NUNIT; unit += G) {
        { LAS float* GAs = (LAS float*)(lds + LA_GA); const float* GA = (const float*)(a.ws + WS_GA); for (int i = tid; i < CH * 16; i += NTHR) GAs[i] = GA[(size_t)unit * CH * 16 + i]; }
        __syncthreads();
        mixa_batch<0>(a, layer, unit, lds, tid, lane, wave);
        mixa_batch<1>(a, layer, unit, lds, tid, lane, wave);
        mixa_batch<2>(a, layer, unit, lds, tid, lane, wave);
    }
}

__device__ __forceinline__ void p3b_scan(const Args& a, int vcu, int G, int tid) {
    unsigned char* ws = a.ws; const bf16* U = (const bf16*)(ws + WS_U); const float* DVEC = (const float*)(ws + WS_DVEC); bf16* SP = (bf16*)(ws + WS_SP);
    for (int gid = vcu * NTHR + tid; gid < BATCH * ST_TOT; gid += G * NTHR) {
        const int b = gid / ST_TOT, el = gid - b * ST_TOT;
        int di = -1; float cdec = 0.f;
        if (el < ST_HG) { const int h = el / 4608, d = (el - h * 4608) % 48; di = h * 48 + d; }
        else if (el < ST_RET) { const int r = el - ST_HG, h = r / 4096, d = r % 64; di = 192 + h * 64 + d; }
        else { const int h = (el - ST_RET) / 4608; cdec = expf(64.0f * logf(1.0f - exp2f(-5.0f - (float)h))); }
        const bf16* up = U + (size_t)b * NCH * ST_TOT + el; const float* dp = DVEC + (size_t)b * NCH * NDV + (di < 0 ? 0 : di); bf16* sp = SP + (size_t)b * NCH * ST_TOT + el;
        float s = 0.f;
#pragma unroll 1
        for (int n0 = 0; n0 < NCH; n0 += 32) { float u[32], dc[32];
#pragma unroll
            for (int i = 0; i < 32; ++i) { u[i] = bf2f(up[(size_t)(n0 + i) * ST_TOT]); dc[i] = (di < 0) ? cdec : dp[(size_t)(n0 + i) * NDV]; }
#pragma unroll
            for (int i = 0; i < 32; ++i) { *(GAS bf16*)(sp + (size_t)(n0 + i) * ST_TOT) = (bf16)f2bf(s); s = dc[i] * s + u[i]; } }
    }
}

#ifndef SUB_MASK
#define SUB_MASK 0
#endif
#define SUBSTRETCH(bit, t0_) do { if ((SUB_MASK >> (bit)) & 1) { const unsigned long long t1_ = __builtin_amdgcn_s_memrealtime(); while (__builtin_amdgcn_s_memrealtime() - t1_ < t1_ - (t0_)) __builtin_amdgcn_s_sleep(8); } } while (0)
constexpr int LC_VT = 0, LC_ST = 55296, LC_AB = 110592, OBP = 104, LC_EC = 137216;
template <int TYPE, bool ISQ>
__device__ __forceinline__ void mix_frag(const Args& a, int h, size_t row, int t, int d0, float (&x)[8], float (&cm)[8]) {
    typedef MixCfg<TYPE> C; constexpr int DK = C::DK; static_assert(ISQ, "query path only");
    unsigned char* ws = a.ws; const bf16* pr = (const bf16*)(ws + WS_PROJ) + row * NPROJ;
    if constexpr (TYPE != 2) {
        const v4u p = *(const v4u*)(pr + C::CQ + h * DK + d0); const unsigned pw[4] = {p.x, p.y, p.z, p.w};
        const v4u f = *(const v4u*)((const bf16*)(ws + WS_CUM) + row * NDV + C::COFF + h * DK + d0); const unsigned fw[4] = {f.x, f.y, f.z, f.w};
#pragma unroll
        for (int j = 0; j < 4; ++j) { x[2 * j] = __builtin_bit_cast(float, pw[j] << 16); x[2 * j + 1] = __builtin_bit_cast(float, pw[j] & 0xffff0000u); cm[2 * j] = __builtin_bit_cast(float, fw[j] << 16); cm[2 * j + 1] = __builtin_bit_cast(float, fw[j] & 0xffff0000u); }
        if constexpr (TYPE == 0) {
#pragma unroll
            for (int j = 0; j < 8; ++j) x[j] *= 0.14433756729740643f; }
    } else {
        const int f0 = (d0 < 24) ? d0 : d0 - 24, dp = (d0 < 24) ? d0 + 24 : d0 - 24; const float sg = (d0 < 24) ? -1.f : 1.f;
        const int cb = C_RQ + h * DK; const v4u p = *(const v4u*)(pr + cb + d0), pp = *(const v4u*)(pr + cb + dp); const unsigned pw[4] = {p.x, p.y, p.z, p.w}, qw[4] = {pp.x, pp.y, pp.z, pp.w};
        const float* rp = (const float*)(ws + WS_ROPE) + row * 48; const f32x4 cs0 = *(const f32x4*)(rp + f0), cs1 = *(const f32x4*)(rp + f0 + 4), sn0 = *(const f32x4*)(rp + 24 + f0), sn1 = *(const f32x4*)(rp + 24 + f0 + 4);
        const float cmv = (float)(t + 1) * ret_lg(h);
#pragma unroll
        for (int j = 0; j < 4; ++j) { const float xa = __builtin_bit_cast(float, pw[j] << 16), xb = __builtin_bit_cast(float, pw[j] & 0xffff0000u), ya = __builtin_bit_cast(float, qw[j] << 16), yb = __builtin_bit_cast(float, qw[j] & 0xffff0000u);
            const float ca = (j < 2) ? cs0[2 * j] : cs1[2 * j - 4], cb2 = (j < 2) ? cs0[2 * j + 1] : cs1[2 * j - 3], sa = (j < 2) ? sn0[2 * j] : sn1[2 * j - 4], sb = (j < 2) ? sn0[2 * j + 1] : sn1[2 * j - 3];
            x[2 * j] = (xa * ca + sg * ya * sa) * 0.14433756729740643f; x[2 * j + 1] = (xb * cb2 + sg * yb * sb) * 0.14433756729740643f; cm[2 * j] = cmv; cm[2 * j + 1] = cmv; }
    }
}

template <int TYPE>
__device__ __forceinline__ void mixc_batch(const Args& a, int layer, int unit, LAS unsigned char* lds, int tid, int lane, int wave) {
    asm volatile("" : "+v"(tid), "+v"(lane));
    typedef MixCfg<TYPE> C; constexpr int DK = C::DK, DV = C::DV, NV = C::NV, TE = DV / 16;
    unsigned char* ws = a.ws; const bf16* PROJ = (const bf16*)(ws + WS_PROJ); bf16* MIX = (bf16*)(ws + WS_MIX);
    LAS bf16* VT = (LAS bf16*)(lds + LC_VT); LAS bf16* ST = (LAS bf16*)(lds + LC_ST); LAS bf16* AB = (LAS bf16*)(lds + LC_AB) + wave * 16 * OBP;
    const int row0 = unit * CH;
    const unsigned long long ts0_ = SUB_MASK ? __builtin_amdgcn_s_memrealtime() : 0ull;
    stage_vt<NV>(PROJ + (size_t)row0 * NPROJ + C::CV, VT, tid);
    SUBSTRETCH(3, ts0_);
    const unsigned long long ts3_ = SUB_MASK ? __builtin_amdgcn_s_memrealtime() : 0ull;
    { const bf16* SPu = (const bf16*)(ws + WS_SP) + (size_t)unit * ST_TOT + C::STOFF;
        constexpr int NIS = (NV * 8) / NTHR; static_assert((NV * 8) % NTHR == 0, "ST staging"); v4u sw[NIS];
#pragma unroll
        for (int it = 0; it < NIS; ++it) { const int idx = tid + NTHR * it, er = idx >> 3, ch = idx & 7; sw[it] = (v4u){0u, 0u, 0u, 0u}; if (ch * 8 < DK) sw[it] = *(const v4u*)(SPu + (size_t)er * DK + ch * 8); }
#pragma unroll
        for (int it = 0; it < NIS; ++it) { const int idx = tid + NTHR * it, er = idx >> 3, ch = idx & 7; *(LAS v4u*)(ST + er * BP + ch * 8) = sw[it]; } }
    SUBSTRETCH(4, ts3_);
    SUBSTRETCH(0, ts0_);
    if constexpr (TYPE != 2) { LAS float* EC = (LAS float*)(lds + LC_EC);
        for (int idx = tid; idx < 4 * C::NC; idx += NTHR) { const int jb = idx / C::NC, cc = idx - jb * C::NC; EC[jb * 256 + cc] = ((const float*)(ws + WS_CUM + 16 * MiB))[((size_t)unit * 4 + jb) * NDV + C::COFF + cc]; } }
    __syncthreads();
    const unsigned long long ts1_ = SUB_MASK ? __builtin_amdgcn_s_memrealtime() : 0ull;
    const int h = wave >> 1, hsel = wave & 1, r = lane & 15, g = lane >> 4;
    const LAS bf16* STh = ST + h * DV * BP; const LAS bf16* VTh = VT + h * DV * BP;
    constexpr int NCHK = DV / 8, NOC = (16 * NCHK) / 64;
#pragma unroll 1
    for (int ib = 0; ib < 2; ++ib) { const int I = ib ? 3 - hsel : hsel;
        pg8::bf16x8 qh[2], qt[2]; float refv[2][8], qhf[2][8];
#pragma unroll
        for (int s = 0; s < 2; ++s) { const int d0 = 32 * s + 8 * g; const bool valid = d0 < DK; const int d0c = valid ? d0 : 0;
            float x[8], cm[8]; mix_frag<TYPE, true>(a, h, (size_t)(row0 + 16 * I + r), 16 * I + r, d0c, x, cm);
            if constexpr (TYPE == 2) {
#pragma unroll
                for (int j = 0; j < 8; ++j) refv[s][j] = (float)(16 * I) * ret_lg(h);
            } else { if (I > 0) { const LAS float* cp = (const LAS float*)(lds + LC_EC) + (I - 1) * 256 + h * DK + d0c; const f32x4 c0 = *(const LAS f32x4*)cp, c1 = *(const LAS f32x4*)(cp + 4);
#pragma unroll
                    for (int j = 0; j < 4; ++j) { refv[s][j] = c0[j]; refv[s][4 + j] = c1[j]; } }
                else {
#pragma unroll
                    for (int j = 0; j < 8; ++j) refv[s][j] = 0.f; } }
            float xt[8];
#pragma unroll
            for (int j = 0; j < 8; ++j) { if constexpr (TYPE == 2) { qhf[s][j] = valid ? x[j] * __expf(cm[j] - refv[s][j]) : 0.f; xt[j] = valid ? x[j] * __expf(cm[j]) : 0.f; }
                else { qhf[s][j] = valid ? x[j] * cm[j] : 0.f; xt[j] = qhf[s][j] * __expf(refv[s][j]); } }
            qh[s] = pack8(qhf[s]); qt[s] = pack8(xt); }
        v4u kf[4][2];
#pragma unroll
        for (int J = 0; J < 4; ++J) { const int Jc = (J < I) ? J : I; const size_t rowJ = (size_t)(row0 + 16 * Jc + r);
#pragma unroll
            for (int s = 0; s < 2; ++s) { const int d0 = 32 * s + 8 * g; const int d0c = (d0 < DK) ? d0 : 0;
                kf[J][s] = *(const v4u*)((const bf16*)(ws + WS_KT) + rowJ * NKT + C::KOFF + h * DK + d0c); } }
#pragma unroll
        for (int J = 0; J < 4; ++J) { if (J <= I) { f32x4 acc = {0.f, 0.f, 0.f, 0.f};
#pragma unroll
            for (int s = 0; s < 2; ++s) { pg8::bf16x8 qop;
                { float xq[8], ej[8]; const int d0 = 32 * s + 8 * g; const int d0c = (d0 < DK) ? d0 : 0;
                    if constexpr (TYPE == 2) {
#pragma unroll
                        for (int j = 0; j < 8; ++j) ej[j] = (float)(16 * (J + 1)) * ret_lg(h); }
                    else { const LAS float* ep = (const LAS float*)(lds + LC_EC) + J * 256 + h * DK + d0c; const f32x4 e0 = *(const LAS f32x4*)ep, e1 = *(const LAS f32x4*)(ep + 4);
#pragma unroll
                        for (int j = 0; j < 4; ++j) { ej[j] = e0[j]; ej[4 + j] = e1[j]; } }
#pragma unroll
                    for (int j = 0; j < 8; ++j) xq[j] = qhf[s][j] * __expf(fminf(refv[s][j] - ej[j], 80.f));
                    qop = pack8(xq); }
                acc = __builtin_amdgcn_mfma_f32_16x16x32_bf16(qop, __builtin_bit_cast(pg8::bf16x8, kf[J][s]), acc, 0, 0, 0); }
#pragma unroll
            for (int q = 0; q < 4; ++q) { const int i = 4 * g + q; const float v = (J < I || r <= i) ? acc[q] : 0.f; AB[i * BP + 16 * J + r] = (bf16)f2bf(v); } } }
        if ((I & 1) == 0) {
#pragma unroll
            for (int q = 0; q < 4; ++q) AB[(4 * g + q) * BP + 16 * (I + 1) + r] = (bf16)0; }
        asm volatile("s_waitcnt lgkmcnt(0)" ::: "memory");
        const pg8::bf16x8 ah0 = *(const LAS pg8::bf16x8*)(AB + r * BP + 8 * g), ah1 = *(const LAS pg8::bf16x8*)(AB + r * BP + 32 + 8 * g);
        f32x4 o[TE];
#pragma unroll
        for (int te = 0; te < TE; ++te) { f32x4 acc = {0.f, 0.f, 0.f, 0.f};
            acc = __builtin_amdgcn_mfma_f32_16x16x32_bf16(qt[0], ldfrag(STh, BP, te * 16, 0, lane), acc, 0, 0, 0);
            acc = __builtin_amdgcn_mfma_f32_16x16x32_bf16(qt[1], ldfrag(STh, BP, te * 16, 32, lane), acc, 0, 0, 0);
            acc = __builtin_amdgcn_mfma_f32_16x16x32_bf16(ah0, ldfrag(VTh, BP, te * 16, 0, lane), acc, 0, 0, 0);
            if (I >= 2) acc = __builtin_amdgcn_mfma_f32_16x16x32_bf16(ah1, ldfrag(VTh, BP, te * 16, 32, lane), acc, 0, 0, 0);
            o[te] = acc; }
        const unsigned long long ts2_ = SUB_MASK ? __builtin_amdgcn_s_memrealtime() : 0ull;
#pragma unroll
        for (int q = 0; q < 4; ++q) { float s1 = 0.f, s2 = 0.f;
#pragma unroll
            for (int te = 0; te < TE; ++te) { s1 += o[te][q]; s2 += o[te][q] * o[te][q]; }
#pragma unroll
            for (int m = 1; m < 16; m <<= 1) { s1 += __shfl_xor(s1, m); s2 += __shfl_xor(s2, m); }
            float mean = 0.f, rstd;
            if constexpr (TYPE == 2) { mean = s1 * (1.0f / DV); rstd = __builtin_amdgcn_rsqf(fmaxf(s2 * (1.0f / DV) - mean * mean, 0.f) + EPS); }
            else rstd = __builtin_amdgcn_rsqf(s2 * (1.0f / DV) + EPS);
#pragma unroll
            for (int te = 0; te < TE; ++te) AB[(4 * g + q) * OBP + te * 16 + r] = (bf16)f2bf((o[te][q] - mean) * rstd); }
        asm volatile("s_waitcnt lgkmcnt(0)" ::: "memory");
#pragma unroll 1
        for (int i = 0; i < NOC; ++i) { const int cidx = lane + 64 * i, orow = cidx / NCHK, ch = cidx - orow * NCHK; const size_t row = (size_t)(row0 + 16 * I + orow);
            const v4u ov = *(const LAS v4u*)(AB + orow * OBP + 8 * ch); const v4u gv = *(const v4u*)(PROJ + row * NPROJ + C::CG + h * DV + 8 * ch);
            const unsigned ow[4] = {ov.x, ov.y, ov.z, ov.w}, gw[4] = {gv.x, gv.y, gv.z, gv.w}; float res[8];
            f32x4 w0 = {1.f, 1.f, 1.f, 1.f}, w1 = {1.f, 1.f, 1.f, 1.f};
            if constexpr (TYPE == 0) { const float* wp = a.gla_norm_w + layer * 384 + h * 96 + 8 * ch; w0 = *(const f32x4*)wp; w1 = *(const f32x4*)(wp + 4); }
            if constexpr (TYPE == 1) { const float* wp = a.hg_norm_w + layer * 256 + h * 64 + 8 * ch; w0 = *(const f32x4*)wp; w1 = *(const f32x4*)(wp + 4); }
#pragma unroll
            for (int j = 0; j < 4; ++j) { const float oa = __builtin_bit_cast(float, ow[j] << 16), ob = __builtin_bit_cast(float, ow[j] & 0xffff0000u), ga = __builtin_bit_cast(float, gw[j] << 16), gb = __builtin_bit_cast(float, gw[j] & 0xffff0000u);
                const float wa = (j < 2) ? w0[2 * j] : w1[2 * j - 4], wb = (j < 2) ? w0[2 * j + 1] : w1[2 * j - 3];
                const float sa = __builtin_amdgcn_rcpf(1.0f + __expf(-ga)), sb = __builtin_amdgcn_rcpf(1.0f + __expf(-gb));
                res[2 * j] = oa * wa * ((TYPE == 1) ? sa : ga * sa); res[2 * j + 1] = ob * wb * ((TYPE == 1) ? sb : gb * sb); }
            if (F8_OUT) { typedef int i32x2 __attribute__((ext_vector_type(2)));
                *(GAS i32x2*)((unsigned char*)MIX + row * D + C::MIXOFF + h * DV + 8 * ch) = (i32x2){pk4_fp8(res[0] * S8_M, res[1] * S8_M, res[2] * S8_M, res[3] * S8_M), pk4_fp8(res[4] * S8_M, res[5] * S8_M, res[6] * S8_M, res[7] * S8_M)}; }
            else { v4u w; w.x = pk2(res[0], res[1]); w.y = pk2(res[2], res[3]); w.z = pk2(res[4], res[5]); w.w = pk2(res[6], res[7]); *(GAS v4u*)(MIX + row * D + C::MIXOFF + h * DV + 8 * ch) = w; } }
        SUBSTRETCH(2, ts2_);
    }
    SUBSTRETCH(1, ts1_);
    __syncthreads();
}
__device__ __forceinline__ void p3c_outputs(const Args& a, int layer, LAS unsigned char* lds, int vcu, int G, int tid, int lane, int wave) {
    for (int unit = vcu; unit < NUNIT; unit += G) {
        mixc_batch<0>(a, layer, unit, lds, tid, lane, wave);
        mixc_batch<1>(a, layer, unit, lds, tid, lane, wave);
        mixc_batch<2>(a, layer, unit, lds, tid, lane, wave);
    }
}


constexpr int MW_ARGS = 800;
__device__ __forceinline__ const void* ld_argp(const volatile LAS unsigned* T, int i) {
    const unsigned lo = __builtin_amdgcn_readfirstlane(T[2 * i]), hi = __builtin_amdgcn_readfirstlane(T[2 * i + 1]);
    return (const void*)(((unsigned long long)hi << 32) | lo);
}
__device__ __forceinline__ Args load_args(LAS unsigned char* lds) {
    const volatile LAS unsigned* T = (const volatile LAS unsigned*)(lds + MISC_OFF) + MW_ARGS;
    Args a;
    a.x = (const float*)ld_argp(T, 0); a.c = (const float*)ld_argp(T, 1); a.pos = (const int*)ld_argp(T, 2); a.w_mod = (const float*)ld_argp(T, 3); a.b_mod = (const float*)ld_argp(T, 4);
    a.norm1_w = (const float*)ld_argp(T, 5); a.w_in = (const float*)ld_argp(T, 6); a.gla_wa2 = (const float*)ld_argp(T, 7); a.gla_ba2 = (const float*)ld_argp(T, 8); a.hg_lb = (const float*)ld_argp(T, 9);
    a.gla_norm_w = (const float*)ld_argp(T, 10); a.hg_norm_w = (const float*)ld_argp(T, 11); a.w_out = (const float*)ld_argp(T, 12); a.norm2_w = (const float*)ld_argp(T, 13); a.w_r = (const float*)ld_argp(T, 14);
    a.b_r = (const float*)ld_argp(T, 15); a.w_gu = (const float*)ld_argp(T, 16); a.b_gu = (const float*)ld_argp(T, 17); a.w_dn = (const float*)ld_argp(T, 18); a.b_dn = (const float*)ld_argp(T, 19);
    a.final_norm_w = (const float*)ld_argp(T, 20); a.out = (float*)ld_argp(T, 21); a.ws = (unsigned char*)ld_argp(T, 22); a.ph_lo = 0; a.ph_hi = 0;
    return a;
}
#define PH_CTX() { unsigned l_ = (unsigned)(size_t)lds; asm volatile("" : "+s"(l_)); lds = (LAS unsigned char*)(size_t)l_; } const Args args = load_args(lds); volatile LAS unsigned* MISC = (volatile LAS unsigned*)(lds + MISC_OFF); int tid_ = wv * 64 + (int)__builtin_amdgcn_mbcnt_hi(~0u, __builtin_amdgcn_mbcnt_lo(~0u, 0u)); asm volatile("" : "+v"(tid_)); const int tid = tid_, lane = tid & 63, wave = __builtin_amdgcn_readfirstlane(tid >> 6); \
    const int G = gridDim.x; const int bx = blockIdx.x; const int vcu = (G % 8 == 0) ? (bx % 8) * (G / 8) + bx / 8 : bx; unsigned char* ws = args.ws; gu32* ctl = (gu32*)(ws + WS_CTL); \
    (void)MISC; (void)lane; (void)wave; (void)vcu; (void)ctl; (void)bx; (void)tid
__device__ __forceinline__ void ph_p0(LAS unsigned char* lds, int wv) { PH_CTX(); p0_prologue(args, lds, vcu, G, tid, lane, wave); }
__device__ __forceinline__ void ph_p1(LAS unsigned char* lds, int wv, int layer_) { int layer = __builtin_amdgcn_readfirstlane(layer_); asm volatile("" : "+s"(layer)); PH_CTX();
    if (layer > 0) { moe_tables(ctl, layer - 1, MISC, tid); const int nrt = __builtin_amdgcn_readfirstlane((int)MISC[MW_NRT]);
        const int done = conv_t2(G) + conv_idle(nrt * 8, G) * NWAVES * CB7 + conv_idle(nrt * 4, G) * NWAVES * CB8; LAS float* scr = (LAS float*)(lds + wave * 16640);
        for (int it = done + vcu * NWAVES + wave; it < IT_LAYER; it += G * NWAVES) convert_item(args, layer, it, scr, lane);
        __syncthreads(); }
    rows_mfma<16>(args, layer, lds, MISC, ctl, vcu, G, tid, lane, wave); }
__device__ __forceinline__ void ph_p2(LAS unsigned char* lds, int wv, int layer_) { int layer = __builtin_amdgcn_readfirstlane(layer_); asm volatile("" : "+s"(layer)); PH_CTX();
    pg8::Gemm g{(const bf16*)(ws + WS_H), (const bf16*)(ws + WS_WIN + (size_t)layer * NPROJ * D * (F8_IN ? 1 : 2)), MTOK, NPROJ, F8_IN ? D / 2 : D}; pg8::StaticOrder S; S.init(MTOK, NPROJ, G, bx);
    pg8::EpiBf16Plain E{(bf16*)(ws + WS_PROJ), NPROJ, F8_IN ? 1.0f / (S8_H * S8_W) : 1.0f};
    pg8::gemm_phase<pg8::EpiBf16Plain, pg8::StaticOrder, true, true, F8_IN>(lds, g, S, E, tid);
    if (layer + 1 < DEPTH && G == 256 && bx >= 64) convert_range(args, layer + 1, ((bx - 64) * NWAVES + wave) * CB2, CB2, lds, lane, wave); }
__device__ __forceinline__ void ph_p3a(LAS unsigned char* lds, int wv, int layer_) { int layer = __builtin_amdgcn_readfirstlane(layer_); asm volatile("" : "+s"(layer)); PH_CTX(); p3a_summaries(args, layer, lds, vcu, G, tid, lane, wave); }
__device__ __forceinline__ void ph_p3b(LAS unsigned char* lds, int wv) { PH_CTX(); p3b_scan(args, vcu, G, tid); }
__device__ __forceinline__ void ph_p3c(LAS unsigned char* lds, int wv, int layer_) { int layer = __builtin_amdgcn_readfirstlane(layer_); asm volatile("" : "+s"(layer)); PH_CTX(); p3c_outputs(args, layer, lds, vcu, G, tid, lane, wave); }
__device__ __forceinline__ void ph_p4(LAS unsigned char* lds, int wv, int layer_) { int layer = __builtin_amdgcn_readfirstlane(layer_); asm volatile("" : "+s"(layer)); PH_CTX();
    pg8::Gemm g{(const bf16*)(ws + WS_MIX), (const bf16*)(ws + WS_WOUT + (size_t)layer * D * D * (F8_OUT ? 1 : 2)), MTOK, D, F8_OUT ? D / 2 : D}; pg8::StaticOrder S; S.init(MTOK, D, G, bx);
    pg8::EpiResGate E{(const bf16*)(ws + WS_X), (bf16*)(ws + WS_X), D, (const float*)(ws + WS_MOD) + (size_t)layer * 2 * 6144 + 2 * D, 6144, SEQ, F8_OUT ? 1.0f / (S8_M * S8_W) : 1.0f};
    pg8::gemm_phase<pg8::EpiResGate, pg8::StaticOrder, true, true, F8_OUT>(lds, g, S, E, tid); }
__device__ __forceinline__ void ph_p5(LAS unsigned char* lds, int wv, int layer_) { int layer = __builtin_amdgcn_readfirstlane(layer_); asm volatile("" : "+s"(layer)); PH_CTX(); rows_mfma<32>(args, layer, lds, MISC, ctl, vcu, G, tid, lane, wave); }
__device__ __forceinline__ void ph_p7(LAS unsigned char* lds, int wv, int layer_) { int layer = __builtin_amdgcn_readfirstlane(layer_); asm volatile("" : "+s"(layer)); PH_CTX();
    moe_tables(ctl, layer, MISC, tid);
    const int nrt = __builtin_amdgcn_readfirstlane((int)MISC[MW_NRT]);
    pg8::Gemm g{(const bf16*)(ws + WS_A1), (const bf16*)(ws + WS_WGU + (size_t)layer * NE * 2048 * D), nrt * 256, NE * 2048, D / 2};
    pg8::MoeOrder S{8, G, vcu, nrt * 8, (const LAS int*)(lds + MISC_OFF + 4 * MW_TILE)};
    pg8::EpiSwiglu E{ws + WS_ACT, FFN, args.b_gu + (size_t)layer * NE * 2048, 1.0f / (S8_H * S8_W), S8_A};
    pg8::gemm_phase<pg8::EpiSwiglu, pg8::MoeOrder, true, true, true>(lds, g, S, E, tid);
    { const int rem = (nrt * 8) % G; if (layer + 1 < DEPTH && rem != 0 && vcu >= rem) convert_range(args, layer + 1, conv_t2(G) + ((vcu - rem) * NWAVES + wave) * CB7, CB7, lds, lane, wave); } }
__device__ __forceinline__ void ph_p8(LAS unsigned char* lds, int wv, int layer_) { int layer = __builtin_amdgcn_readfirstlane(layer_); asm volatile("" : "+s"(layer)); PH_CTX();
    moe_tables(ctl, layer, MISC, tid);
    const int nrt = __builtin_amdgcn_readfirstlane((int)MISC[MW_NRT]);
    pg8::Gemm g{(const bf16*)(ws + WS_ACT), (const bf16*)(ws + WS_WDN + (size_t)layer * NE * D * FFN), nrt * 256, NE * D, FFN / 2};
    pg8::MoeOrder S{4, G, vcu, nrt * 4, (const LAS int*)(lds + MISC_OFF + 4 * MW_TILE)};
    if constexpr (Y8) { pg8::EpiFp8Bias E{ws + WS_Y, D, args.b_dn + (size_t)layer * NE * D, D, 1.0f / (S8_A * S8_W), S8_Y};
        pg8::gemm_phase<pg8::EpiFp8Bias, pg8::MoeOrder, true, true, true>(lds, g, S, E, tid); }
    else { pg8::EpiBf16Bias E{(bf16*)(ws + WS_Y), D, args.b_dn + (size_t)layer * NE * D, D, 1.0f / (S8_A * S8_W)};
        pg8::gemm_phase<pg8::EpiBf16Bias, pg8::MoeOrder, true, true, true>(lds, g, S, E, tid); }
    { const int rem = (nrt * 4) % G; if (layer + 1 < DEPTH && rem != 0 && vcu >= rem) convert_range(args, layer + 1, conv_t2(G) + conv_idle(nrt * 8, G) * NWAVES * CB7 + ((vcu - rem) * NWAVES + wave) * CB8, CB8, lds, lane, wave); } }
__device__ __forceinline__ void ph_final(LAS unsigned char* lds, int wv) { PH_CTX(); final_rows(args, lds, vcu, G, tid, lane); }

#ifndef DBL_MASK
#define DBL_MASK 0
#endif
#if DBL_MASK
#define RUN(bit, call) do { if ((DBL_MASK >> (bit)) & 1) { const unsigned long long t0_ = __builtin_amdgcn_s_memrealtime(); call; const unsigned long long t1_ = __builtin_amdgcn_s_memrealtime(); \
        while (__builtin_amdgcn_s_memrealtime() - t1_ < t1_ - t0_) __builtin_amdgcn_s_sleep(8); } else { call; } } while (0)
#else
#define RUN(bit, call) do { call; } while (0)
#endif
__global__ void __launch_bounds__(NTHR, 2) hybrid_fwd(Args args) {
    extern __shared__ __attribute__((aligned(16))) unsigned char lds_raw[];
    LAS unsigned char* lds = (LAS unsigned char*)lds_raw;
    volatile LAS unsigned* MISC = (volatile LAS unsigned*)(lds + MISC_OFF);
    const int tid = threadIdx.x; const int wv = __builtin_amdgcn_readfirstlane(tid >> 6);
    gu32* ctl = (gu32*)(args.ws + WS_CTL);
    for (int u = tid; u < (LDS_BYTES - MISC_OFF) / 4; u += NTHR) MISC[u] = 0u;
    __syncthreads();
    if (tid == 0) {
#define ST_ARG(i, p) do { const unsigned long long v_ = (unsigned long long)(p); MISC[MW_ARGS + 2 * (i)] = (unsigned)v_; MISC[MW_ARGS + 2 * (i) + 1] = (unsigned)(v_ >> 32); } while (0)
        ST_ARG(0, args.x); ST_ARG(1, args.c); ST_ARG(2, args.pos); ST_ARG(3, args.w_mod); ST_ARG(4, args.b_mod); ST_ARG(5, args.norm1_w); ST_ARG(6, args.w_in); ST_ARG(7, args.gla_wa2); ST_ARG(8, args.gla_ba2);
        ST_ARG(9, args.hg_lb); ST_ARG(10, args.gla_norm_w); ST_ARG(11, args.hg_norm_w); ST_ARG(12, args.w_out); ST_ARG(13, args.norm2_w); ST_ARG(14, args.w_r); ST_ARG(15, args.b_r); ST_ARG(16, args.w_gu);
        ST_ARG(17, args.b_gu); ST_ARG(18, args.w_dn); ST_ARG(19, args.b_dn); ST_ARG(20, args.final_norm_w); ST_ARG(21, args.out); ST_ARG(22, args.ws);
#undef ST_ARG
    }
    __syncthreads();
    const int lo = args.ph_lo, hi = args.ph_hi;
    const bool multi = (hi - lo) > 1;
    XcdBarrier bar; bar.bar = (unsigned*)(ctl + CW_BAR); bar.x = 0; bar.st = nullptr;
    if (multi) bar = xcd_barrier_post((unsigned*)(ctl + CW_BAR), MISC + MW_BAR);
#define IN(k) (lo <= (k) && (k) < hi)
#define SEAM(k) do { if (IN(k) && IN((k) + 1)) xcd_barrier(bar); } while (0)

    if (IN(0)) RUN(0, ph_p0(lds, wv));
    SEAM(0);
    for (int layer = 0; layer < DEPTH; ++layer) {
        const int pb = 1 + 9 * layer;
        if (IN(pb + 0)) RUN(1, ph_p1(lds, wv, layer));
        SEAM(pb + 0);
        if (IN(pb + 1)) RUN(2, ph_p2(lds, wv, layer));
        SEAM(pb + 1);
        if (IN(pb + 2)) RUN(3, ph_p3a(lds, wv, layer));
        SEAM(pb + 2);
        if (IN(pb + 3)) RUN(4, ph_p3b(lds, wv));
        SEAM(pb + 3);
        if (IN(pb + 4)) RUN(5, ph_p3c(lds, wv, layer));
        SEAM(pb + 4);
        if (IN(pb + 5)) RUN(6, ph_p4(lds, wv, layer));
        SEAM(pb + 5);
        if (IN(pb + 6)) RUN(7, ph_p5(lds, wv, layer));
        SEAM(pb + 6);
        if (IN(pb + 7)) RUN(9, ph_p7(lds, wv, layer));
        SEAM(pb + 7);
        if (IN(pb + 8)) RUN(10, ph_p8(lds, wv, layer));
        SEAM(pb + 8);
    }
    if (IN(NPHASE - 1)) RUN(11, ph_final(lds, wv));
#undef IN
#undef SEAM
}

#ifndef MK_SINGLE
#define MK_SINGLE 1
#endif
extern "C" void kernel_launch(void* const* d_in, const int* in_sizes, int n_in, void* d_out, int out_size, void* d_ws, size_t ws_size, hipStream_t stream) {
    static int grid = 0;
    if (grid == 0) {
        if (n_in != 21 || in_sizes[0] != MTOK * D || out_size != MTOK * D || ws_size < WS_END) { fprintf(stderr, "kernel_launch: unexpected problem shape (n_in %d, in0 %d, out %d, ws %zu)\n", n_in, n_in > 0 ? in_sizes[0] : -1, out_size, ws_size); grid = -1; return; }
        int dev = 0, cus = 0, per_cu = 0;
        if (hipGetDevice(&dev) != hipSuccess || hipDeviceGetAttribute(&cus, hipDeviceAttributeMultiprocessorCount, dev) != hipSuccess) { grid = -1; return; }
        if (hipFuncSetAttribute((const void*)hybrid_fwd, hipFuncAttributeMaxDynamicSharedMemorySize, LDS_BYTES) != hipSuccess) { fprintf(stderr, "kernel_launch: hipFuncSetAttribute failed\n"); grid = -1; return; }
        if (hipOccupancyMaxActiveBlocksPerMultiprocessor(&per_cu, (const void*)hybrid_fwd, NTHR, LDS_BYTES) != hipSuccess || per_cu < 1) fprintf(stderr, "kernel_launch: occupancy query says %d\n", per_cu);
        (void)hipGetLastError();
        grid = cus;
    }
    if (grid < 0) return;
    (void)hipMemsetAsync((char*)d_ws + WS_CTL, 0, CTL_ZERO_BYTES, stream);
    Args a{};
    a.x = (const float*)d_in[0]; a.c = (const float*)d_in[1]; a.pos = (const int*)d_in[2]; a.w_mod = (const float*)d_in[3]; a.b_mod = (const float*)d_in[4]; a.norm1_w = (const float*)d_in[5];
    a.w_in = (const float*)d_in[6]; a.gla_wa2 = (const float*)d_in[7]; a.gla_ba2 = (const float*)d_in[8]; a.hg_lb = (const float*)d_in[9]; a.gla_norm_w = (const float*)d_in[10]; a.hg_norm_w = (const float*)d_in[11];
    a.w_out = (const float*)d_in[12]; a.norm2_w = (const float*)d_in[13]; a.w_r = (const float*)d_in[14]; a.b_r = (const float*)d_in[15]; a.w_gu = (const float*)d_in[16]; a.b_gu = (const float*)d_in[17];
    a.w_dn = (const float*)d_in[18]; a.b_dn = (const float*)d_in[19]; a.final_norm_w = (const float*)d_in[20]; a.out = (float*)d_out; a.ws = (unsigned char*)d_ws;
#if MK_SINGLE
    a.ph_lo = 0; a.ph_hi = NPHASE;
    hipLaunchKernelGGL(hybrid_fwd, dim3(grid), dim3(NTHR), LDS_BYTES, stream, a);
#else
    for (int p = 0; p < NPHASE; ++p) { a.ph_lo = p; a.ph_hi = p + 1; hipLaunchKernelGGL(hybrid_fwd, dim3(grid), dim3(NTHR), LDS_BYTES, stream, a); }
#endif
}
```

```cpp
#include <hip/hip_runtime.h>
#include <cstdio>
#include <cstdint>
namespace pg8 {
#define PG8_LAS __attribute__((address_space(3)))
typedef unsigned short bf16_t;
typedef short bf16x8 __attribute__((ext_vector_type(8)));
typedef float f32x4 __attribute__((ext_vector_type(4)));
typedef unsigned u32x4 __attribute__((ext_vector_type(4)));
constexpr int BM = 256, BK = 64, HALF = 128, HTB = HALF * BK * 2  , STAGE_BYTES = 8 * HTB, NXCD = 8, WGM = 8;

__host__ __device__ __forceinline__ int lds_byte(int r, int c) { const int st = (r >> 4) * 2 + (c >> 5), rr = r & 15, cc = c & 31, ob = rr * 64 + cc * 2; return st * 1024 + (ob ^ (((ob >> 9) & 1) << 5)); }
__host__ __device__ __forceinline__ void stage_rc(int b, int& R, int& C) { const int st = b / 1024, sb = b % 1024, swz = sb ^ (((sb >> 9) & 1) << 5); R = (st >> 1) * 16 + swz / 64; C = (st & 1) * 32 + (swz % 64) / 2; }
__host__ __device__ __forceinline__ int perm32(int rho) { const int n = rho >> 4, i = rho & 15; return 8 * (i >> 2) + 4 * n + (i & 3); }

struct Unit { int pm, pn, e, pl; };
struct Gemm { const bf16_t* A; const bf16_t* Bt; int M, N, K; };

struct StaticOrder {
    int nM, nN, nwg, G, c;
    __host__ __device__ void init(int M, int N, int G_, int c_) { nM = M / BM; nN = N / BM; nwg = nM * nN; G = G_; c = c_; }
    __host__ __device__ bool next(int i, Unit& u) const {
        const long L = (long)i * G + c; if (L >= nwg) return false;
        int wgid = (int)L; { const int q = nwg / NXCD, r = nwg % NXCD, xcd = wgid % NXCD, off = wgid / NXCD; wgid = (xcd < r ? xcd * (q + 1) : r * (q + 1) + (xcd - r) * q) + off; }
        const int nig = WGM * nN, gid = wgid / nig, fm = gid * WGM, gsz = (nM - fm) < WGM ? (nM - fm) : WGM;
        u.pm = fm + ((wgid % nig) % gsz); u.pn = (wgid % nig) / gsz; u.e = 0; u.pl = u.pn; return true;
    }
    __device__ __forceinline__ void a_ready(const Unit&) const {}
    __device__ __forceinline__ void done(const Unit&) const {}
};

__device__ __forceinline__ unsigned cvt_pk_bf16(float lo, float hi) { unsigned r; asm volatile("v_cvt_pk_bf16_f32 %0, %1, %2" : "=v"(r) : "v"(lo), "v"(hi)); return r; }

#define PG8_GAS __attribute__((address_space(1)))
struct NoPre {};
struct EpiBf16Plain {
    static constexpr bool PERM = true, AFTER_DRAIN = false; static constexpr int NST = 0; typedef NoPre Pre;
    __device__ __forceinline__ Pre prefetch(const Unit&, int, int) const { return Pre{}; }
    bf16_t* O; int ldc; float sc;
    __device__ __forceinline__ void operator()(const f32x4 (&acc)[2][2][4][2], const Unit& u, int wr, int wc, int fr, int fq, const Pre&) const {
        const int row0 = u.pm * BM + wr * 64 + fr; const int col0 = u.pn * BM + wc * 32 + 8 * fq;
#pragma unroll
        for (int ai = 0; ai < 2; ++ai)
#pragma unroll
            for (int m = 0; m < 4; ++m) { bf16_t* rowp = O + (size_t)(row0 + ai * HALF + m * 16) * ldc + col0;
#pragma unroll
                for (int bj = 0; bj < 2; ++bj) { const f32x4 v0 = acc[ai][bj][m][0] * sc, v1 = acc[ai][bj][m][1] * sc;
                    u32x4 w; w.x = cvt_pk_bf16(v0[0], v0[1]); w.y = cvt_pk_bf16(v0[2], v0[3]); w.z = cvt_pk_bf16(v1[0], v1[1]); w.w = cvt_pk_bf16(v1[2], v1[3]);
                    *(PG8_GAS u32x4*)(rowp + bj * HALF) = w; } }
    }
};
struct EpiResGate {
    static constexpr bool PERM = true, AFTER_DRAIN = false; static constexpr int NST = 0; typedef NoPre Pre;
    __device__ __forceinline__ Pre prefetch(const Unit&, int, int) const { return Pre{}; }
    const bf16_t* base; bf16_t* out; int ldc; const float* gate; int gpitch; int rows_per_batch; float sc;
    __device__ __forceinline__ void operator()(const f32x4 (&acc)[2][2][4][2], const Unit& u, int wr, int wc, int fr, int fq, const Pre&) const {
        const int row0 = u.pm * BM + wr * 64 + fr, col0 = u.pn * BM + wc * 32 + 8 * fq;
        const float* gp = gate + (size_t)((u.pm * BM) / rows_per_batch) * gpitch + col0;
        f32x4 gv[2][2];
#pragma unroll
        for (int bj = 0; bj < 2; ++bj)
#pragma unroll
            for (int n = 0; n < 2; ++n) gv[bj][n] = *(const PG8_GAS f32x4*)(gp + bj * HALF + 4 * n) * sc;
#pragma unroll
        for (int ai = 0; ai < 2; ++ai)
#pragma unroll
            for (int m = 0; m < 4; ++m) { const size_t off = (size_t)(row0 + ai * HALF + m * 16) * ldc + col0;
#pragma unroll
                for (int bj = 0; bj < 2; ++bj) { const u32x4 bs = *(const PG8_GAS u32x4*)(base + off + bj * HALF); const unsigned bw[4] = {bs.x, bs.y, bs.z, bs.w}; float r[8];
#pragma unroll
                    for (int j = 0; j < 4; ++j) { const f32x4& a4 = acc[ai][bj][m][j >> 1]; const f32x4& g4 = gv[bj][j >> 1];
                        r[2 * j] = __builtin_bit_cast(float, bw[j] << 16) + g4[2 * (j & 1)] * a4[2 * (j & 1)]; r[2 * j + 1] = __builtin_bit_cast(float, bw[j] & 0xffff0000u) + g4[2 * (j & 1) + 1] * a4[2 * (j & 1) + 1]; }
                    u32x4 w; w.x = cvt_pk_bf16(r[0], r[1]); w.y = cvt_pk_bf16(r[2], r[3]); w.z = cvt_pk_bf16(r[4], r[5]); w.w = cvt_pk_bf16(r[6], r[7]);
                    *(PG8_GAS u32x4*)(out + off + bj * HALF) = w; }
                asm volatile("" ::: "memory"); }
    }
};
struct EpiSwiglu {
    static constexpr bool PERM = true, AFTER_DRAIN = false; static constexpr int NST = 0; struct Pre { f32x4 bg[2], bu[2]; };
    __device__ __forceinline__ Pre prefetch(const Unit& u, int wc, int fq) const { typedef const __attribute__((address_space(1))) f32x4 gf4;
        const float* bp = bias + (size_t)u.e * 2048 + u.pl * HALF + wc * 32 + 8 * fq; Pre p; p.bg[0] = *(gf4*)bp; p.bg[1] = *(gf4*)(bp + 4); p.bu[0] = *(gf4*)(bp + 1024); p.bu[1] = *(gf4*)(bp + 1028); return p; }
    unsigned char* O; int ldc; const float* bias; float inv_in, out_scale;
    __device__ __forceinline__ void operator()(const f32x4 (&acc)[2][2][4][2], const Unit& u, int wr, int wc, int fr, int fq, const Pre& pre) const {
        const int row0 = u.pm * BM + wr * 64 + fr; const int jj0 = wc * 32 + 8 * fq; const int col0 = u.pl * HALF + jj0;
        const float rinv = 1.0f / inv_in, lim = 7.0f * rinv, kc = -1.702f * 1.4426950408889634f * inv_in, k2 = inv_in * inv_in * out_scale, k3 = inv_in * out_scale;
        const f32x4 bg[2] = {pre.bg[0] * rinv, pre.bg[1] * rinv}, bu[2] = {pre.bu[0] * rinv, pre.bu[1] * rinv};
#pragma unroll
        for (int ai = 0; ai < 2; ++ai)
#pragma unroll
            for (int m = 0; m < 4; ++m) { unsigned char* rowp = O + (size_t)(row0 + ai * HALF + m * 16) * ldc + col0;
                f32x4 r[2];
#pragma unroll
                for (int n = 0; n < 2; ++n) { f32x4 A = acc[ai][0][m][n] + bg[n], B = acc[ai][1][m][n] + bu[n];
#pragma unroll
                    for (int j = 0; j < 4; ++j) { A[j] = fminf(A[j], lim); B[j] = __builtin_amdgcn_fmed3f(B[j], -lim, lim); }
                    f32x4 e = A * kc;
#pragma unroll
                    for (int j = 0; j < 4; ++j) e[j] = __builtin_amdgcn_exp2f(e[j]);
                    e = e + 1.0f;
#pragma unroll
                    for (int j = 0; j < 4; ++j) e[j] = __builtin_amdgcn_rcpf(e[j]);
                    r[n] = (B * k2 + k3) * (A * e); }
                int w0 = 0, w1 = 0;
                w0 = __builtin_amdgcn_cvt_pk_fp8_f32(r[0][0], r[0][1], w0, false); w0 = __builtin_amdgcn_cvt_pk_fp8_f32(r[0][2], r[0][3], w0, true);
                w1 = __builtin_amdgcn_cvt_pk_fp8_f32(r[1][0], r[1][1], w1, false); w1 = __builtin_amdgcn_cvt_pk_fp8_f32(r[1][2], r[1][3], w1, true);
                typedef int i32x2 __attribute__((ext_vector_type(2))); *(PG8_GAS i32x2*)rowp = (i32x2){w0, w1}; }
    }
};
struct EpiBf16Bias {
    static constexpr bool PERM = true, AFTER_DRAIN = false; static constexpr int NST = 0; typedef NoPre Pre;
    __device__ __forceinline__ Pre prefetch(const Unit&, int, int) const { return Pre{}; }
    bf16_t* O; int ldc; const float* bias; int bpitch; float inv_in;
    __device__ __forceinline__ void operator()(const f32x4 (&acc)[2][2][4][2], const Unit& u, int wr, int wc, int fr, int fq, const Pre&) const {
        const int row0 = u.pm * BM + wr * 64 + fr; const int col0 = u.pl * BM + wc * 32 + 8 * fq;
        const float* bp = bias + (size_t)u.e * bpitch + col0;
        f32x4 bv[2][2];
#pragma unroll
        for (int bj = 0; bj < 2; ++bj)
#pragma unroll
            for (int n = 0; n < 2; ++n) bv[bj][n] = *(const PG8_GAS f32x4*)(bp + bj * HALF + 4 * n);
#pragma unroll
        for (int ai = 0; ai < 2; ++ai)
#pragma unroll
            for (int m = 0; m < 4; ++m) { bf16_t* rowp = O + (size_t)(row0 + ai * HALF + m * 16) * ldc + col0;
#pragma unroll
                for (int bj = 0; bj < 2; ++bj) { const f32x4 v0 = acc[ai][bj][m][0] * inv_in + bv[bj][0], v1 = acc[ai][bj][m][1] * inv_in + bv[bj][1];
                    u32x4 w; w.x = cvt_pk_bf16(v0[0], v0[1]); w.y = cvt_pk_bf16(v0[2], v0[3]); w.z = cvt_pk_bf16(v1[0], v1[1]); w.w = cvt_pk_bf16(v1[2], v1[3]);
                    *(PG8_GAS u32x4*)(rowp + bj * HALF) = w; } }
    }
};
struct EpiFp8Bias {
    static constexpr bool PERM = true, AFTER_DRAIN = false; static constexpr int NST = 0; struct Pre { f32x4 bv[2][2]; };
    __device__ __forceinline__ Pre prefetch(const Unit& u, int wc, int fq) const { typedef const __attribute__((address_space(1))) f32x4 gf4;
        const float* bp = bias + (size_t)u.e * bpitch + u.pl * BM + wc * 32 + 8 * fq; Pre p; p.bv[0][0] = *(gf4*)bp; p.bv[0][1] = *(gf4*)(bp + 4); p.bv[1][0] = *(gf4*)(bp + HALF); p.bv[1][1] = *(gf4*)(bp + HALF + 4); return p; }
    unsigned char* O; int ldc; const float* bias; int bpitch; float inv_in, out_scale;
    __device__ __forceinline__ int pk4(f32x4 v) const { int w = 0; w = __builtin_amdgcn_cvt_pk_fp8_f32(__builtin_amdgcn_fmed3f(v[0], -448.f, 448.f), __builtin_amdgcn_fmed3f(v[1], -448.f, 448.f), w, false);
        return __builtin_amdgcn_cvt_pk_fp8_f32(__builtin_amdgcn_fmed3f(v[2], -448.f, 448.f), __builtin_amdgcn_fmed3f(v[3], -448.f, 448.f), w, true); }
    __device__ __forceinline__ void operator()(const f32x4 (&acc)[2][2][4][2], const Unit& u, int wr, int wc, int fr, int fq, const Pre& pre) const {
        const int row0 = u.pm * BM + wr * 64 + fr; const int col0 = u.pl * BM + wc * 32 + 8 * fq;
        const float ks = inv_in * out_scale; const f32x4 bv[2][2] = {{pre.bv[0][0] * out_scale, pre.bv[0][1] * out_scale}, {pre.bv[1][0] * out_scale, pre.bv[1][1] * out_scale}};
#pragma unroll
        for (int ai = 0; ai < 2; ++ai)
#pragma unroll
            for (int m = 0; m < 4; ++m) { unsigned char* rowp = O + (size_t)(row0 + ai * HALF + m * 16) * ldc + col0;
#pragma unroll
                for (int bj = 0; bj < 2; ++bj) { const f32x4 v0 = acc[ai][bj][m][0] * ks + bv[bj][0], v1 = acc[ai][bj][m][1] * ks + bv[bj][1];
                    typedef int i32x2 __attribute__((ext_vector_type(2))); *(PG8_GAS i32x2*)(rowp + bj * HALF) = (i32x2){pk4(v0), pk4(v1)}; } }
    }
};
struct MoeOrder {
    int nN, G, c, nunits; const PG8_LAS int* tile_pm;
    __device__ __forceinline__ bool next(int i, Unit& u) const {
        const int L = i * G + c; if (L >= nunits) return false;
        const int idx = L / nN, pl = L - idx * nN, pm = __builtin_amdgcn_readfirstlane(tile_pm[idx]), e = pm >> 6;
        u.pm = pm; u.pl = pl; u.e = e; u.pn = e * nN + pl; return true;
    }
    __device__ __forceinline__ void a_ready(const Unit&) const {}
    __device__ __forceinline__ void done(const Unit&) const {}
};
typedef int v4i32_t __attribute__((ext_vector_type(4)));
typedef int v8i32_t __attribute__((ext_vector_type(8)));
template <class Epi, class Sched, bool ALIGN_EPI = false, bool SP2 = false, bool FP8 = false>
__device__ __forceinline__ void gemm_phase(PG8_LAS unsigned char* lds, const Gemm g, const Sched& S, const Epi& E, int tid_in) {
    int tid_ = tid_in; asm volatile("" : "+v"(tid_)); const int tid = tid_, wid = __builtin_amdgcn_readfirstlane(tid >> 6), lane = tid & 63, wr = wid >> 2, wc = wid & 3, fr = lane & 15, fq = lane >> 4;
    const int K = g.K, nt = K / BK;
    unsigned voffA, voffB;
    { int R, C; stage_rc(tid * 16, R, C); const int Rb = Epi::PERM ? ((R & ~31) + perm32(R & 31)) : R;
        voffA = (unsigned)(R * K + C) * 2u; voffB = (unsigned)(Rb * K + C) * 2u; }
    const size_t rstep = (size_t)64 * K * 2;
    const size_t kstep = (size_t)(BK * 2);
    const size_t hstep = (size_t)HALF * K * 2;
    const size_t tstep = 2 * hstep;
    const unsigned ldsw = (unsigned)wid * 1024u;
    const int aoff = lds_byte(wr * 64 + fr, fq * 8), boff = lds_byte(wc * 32 + fr, fq * 8);
#define PG8_SA(b, h) (((b) * 2 + (h)) * HTB)
#define PG8_SB(b, h) ((4 + (b) * 2 + (h)) * HTB)
#define PG8_STAGE(bufoff, gbase, voff) do { _Pragma("unroll") for (int _i = 0; _i < 2; ++_i) \
        __builtin_amdgcn_global_load_lds((const unsigned*)((const char*)(gbase) + _i * rstep + (voff)), (PG8_LAS unsigned*)(lds + (bufoff) + ldsw + _i * 8192), 16, 0, 0); } while (0)
#define PG8_LDA(dst, b, h) do { _Pragma("unroll") for (int m = 0; m < 4; ++m) _Pragma("unroll") for (int k = 0; k < 2; ++k) dst[m][k] = *(const PG8_LAS bf16x8*)(lds + PG8_SA(b, h) + aoff + m * 2048 + k * 1024); } while (0)
#define PG8_LDB(dst, b, h) do { _Pragma("unroll") for (int n = 0; n < 2; ++n) _Pragma("unroll") for (int k = 0; k < 2; ++k) dst[n][k] = *(const PG8_LAS bf16x8*)(lds + PG8_SB(b, h) + boff + n * 2048 + k * 1024); } while (0)
#define PG8_MMA(ai, bj, At, Bt) do { __builtin_amdgcn_s_setprio(1); _Pragma("unroll") for (int m = 0; m < 4; ++m) _Pragma("unroll") for (int n = 0; n < 2; ++n) { \
        if constexpr (FP8) { const v8i32_t a8_ = __builtin_shufflevector(__builtin_bit_cast(v4i32_t, At[m][0]), __builtin_bit_cast(v4i32_t, At[m][1]), 0, 1, 2, 3, 4, 5, 6, 7); \
            const v8i32_t b8_ = __builtin_shufflevector(__builtin_bit_cast(v4i32_t, Bt[n][0]), __builtin_bit_cast(v4i32_t, Bt[n][1]), 0, 1, 2, 3, 4, 5, 6, 7); \
            asm volatile("v_mfma_scale_f32_16x16x128_f8f6f4 %0, %1, %2, %0, %3, %3 op_sel_hi:[0,0,0]" : "+v"(acc[ai][bj][m][n]) : "v"(b8_), "v"(a8_), "v"(one8_)); } \
        else { _Pragma("unroll") for (int k = 0; k < 2; ++k) acc[ai][bj][m][n] = __builtin_amdgcn_mfma_f32_16x16x32_bf16(Bt[n][k], At[m][k], acc[ai][bj][m][n], 0, 0, 0); } } \
        __builtin_amdgcn_s_setprio(0); } while (0)
#define PG8_WAIT_V(n) asm volatile("s_waitcnt vmcnt(" #n ")" ::: "memory")
#define PG8_WAIT_L(n) asm volatile("s_waitcnt lgkmcnt(" #n ")" ::: "memory")
#define PG8_WAIT_V8R(relax) do { if (relax) { if constexpr (Epi::NST == 8) PG8_WAIT_V(16); else if constexpr (Epi::NST == 16) PG8_WAIT_V(24); else PG8_WAIT_V(8); } else PG8_WAIT_V(8); } while (0)
#define PG8_BAR __builtin_amdgcn_s_barrier()
#define PG8_SCHED __builtin_amdgcn_sched_barrier(0)
    Unit cur, nxt; int ui = 0;
    if (!S.next(0, cur)) return;
    f32x4 acc[2][2][4][2];
#pragma unroll
    for (int a = 0; a < 2; ++a)
#pragma unroll
        for (int b = 0; b < 2; ++b)
#pragma unroll
            for (int m = 0; m < 4; ++m)
#pragma unroll
                for (int n = 0; n < 2; ++n) acc[a][b][m][n] = (f32x4){0.f, 0.f, 0.f, 0.f};
    bf16x8 At[4][2], B0[2][2], B1[2][2];
    int one8_ = 0x7f7f7f7f; asm volatile("" : "+v"(one8_));
    const char* cA = (const char*)g.A + (size_t)cur.pm * tstep; const char* cB = (const char*)g.Bt + (size_t)cur.pn * tstep;
    S.a_ready(cur);
    if constexpr (SP2) {
        PG8_STAGE(PG8_SB(0, 0), cB, voffB); PG8_STAGE(PG8_SB(0, 1), cB + hstep, voffB); PG8_STAGE(PG8_SA(0, 0), cA, voffA); PG8_STAGE(PG8_SA(0, 1), cA + hstep, voffA);
        if (wr == 1) PG8_BAR;
        PG8_WAIT_V(2); PG8_BAR;
        PG8_STAGE(PG8_SB(1, 0), cB + kstep, voffB); PG8_STAGE(PG8_SA(1, 0), cA + kstep, voffA); PG8_STAGE(PG8_SB(1, 1), cB + hstep + kstep, voffB);
        PG8_WAIT_V(6); PG8_BAR;
    } else {
        PG8_STAGE(PG8_SB(0, 0), cB, voffB); PG8_STAGE(PG8_SA(0, 0), cA, voffA); PG8_STAGE(PG8_SB(0, 1), cB + hstep, voffB); PG8_STAGE(PG8_SA(0, 1), cA + hstep, voffA);
        if (wr == 1) PG8_BAR;
        PG8_WAIT_V(4); PG8_BAR;
        PG8_STAGE(PG8_SB(1, 0), cB + kstep, voffB); PG8_STAGE(PG8_SA(1, 0), cA + kstep, voffA); PG8_STAGE(PG8_SB(1, 1), cB + hstep + kstep, voffB);
        PG8_WAIT_V(6); PG8_BAR;
    }
    for (;;) {
        const bool has_next = S.next(ui + 1, nxt);
        typename Epi::Pre pre_; { int lp_ = (int)__builtin_amdgcn_mbcnt_hi(~0u, __builtin_amdgcn_mbcnt_lo(~0u, 0u)); asm volatile("" : "+v"(lp_)); pre_ = E.prefetch(cur, wc, lp_ >> 4); }
        const char* nA = has_next ? (const char*)g.A + (size_t)nxt.pm * tstep : cA; const char* nB = has_next ? (const char*)g.Bt + (size_t)nxt.pn * tstep : cB;
#pragma unroll 1
        for (int t = 0; t < nt; t += 2) {
            const bool last = (t == nt - 2);
            const char* a1 = cA + (size_t)(t + 1) * kstep;
            const char* a2 = last ? nA : cA + (size_t)(t + 2) * kstep; const char* b2 = last ? nB : cB + (size_t)(t + 2) * kstep;
            const char* a3 = a2 + kstep; const char* b3 = b2 + kstep;
            if (last && has_next) S.a_ready(nxt);
            const bool relax = (Epi::NST > 0) && (ui > 0) && (t == 0);
            if constexpr (SP2) {
            PG8_LDB(B0, 0, 0); PG8_LDB(B1, 0, 1); PG8_SCHED; PG8_LDA(At, 0, 0); PG8_STAGE(PG8_SA(1, 1), a1 + hstep, voffA);
            PG8_WAIT_V8R(relax); PG8_WAIT_L(0); PG8_BAR; PG8_MMA(0, 0, At, B0); PG8_MMA(0, 1, At, B1); PG8_BAR; PG8_SCHED;
            PG8_LDA(At, 0, 1); PG8_STAGE(PG8_SB(0, 0), b2, voffB); PG8_STAGE(PG8_SB(0, 1), b2 + hstep, voffB); PG8_STAGE(PG8_SA(0, 0), a2, voffA);
            PG8_WAIT_V8R(relax); PG8_WAIT_L(0); PG8_BAR; PG8_MMA(1, 0, At, B0); PG8_MMA(1, 1, At, B1); PG8_BAR; PG8_SCHED;
            PG8_LDB(B0, 1, 0); PG8_LDB(B1, 1, 1); PG8_SCHED; PG8_LDA(At, 1, 0); PG8_STAGE(PG8_SA(0, 1), a2 + hstep, voffA);
            PG8_WAIT_V(8); PG8_WAIT_L(0); PG8_BAR; PG8_MMA(0, 0, At, B0); PG8_MMA(0, 1, At, B1); PG8_BAR; PG8_SCHED;
            PG8_LDA(At, 1, 1); PG8_STAGE(PG8_SB(1, 0), b3, voffB); PG8_STAGE(PG8_SB(1, 1), b3 + hstep, voffB); PG8_STAGE(PG8_SA(1, 0), a3, voffA);
            PG8_WAIT_V(8); PG8_WAIT_L(0); PG8_BAR; PG8_MMA(1, 0, At, B0); PG8_MMA(1, 1, At, B1); PG8_BAR; PG8_SCHED;
            } else {
            PG8_LDB(B0, 0, 0); PG8_SCHED; PG8_LDA(At, 0, 0); PG8_STAGE(PG8_SA(1, 1), a1 + hstep, voffA);
            PG8_WAIT_L(8); PG8_BAR; PG8_WAIT_L(0); PG8_MMA(0, 0, At, B0); PG8_BAR; PG8_SCHED;
            PG8_LDB(B1, 0, 1); PG8_STAGE(PG8_SB(0, 0), b2, voffB);
            PG8_BAR; PG8_WAIT_L(0); PG8_MMA(0, 1, At, B1); PG8_BAR;
            PG8_LDA(At, 0, 1); PG8_STAGE(PG8_SA(0, 0), a2, voffA);
            PG8_BAR; PG8_WAIT_L(0); PG8_MMA(1, 0, At, B0); PG8_BAR; PG8_SCHED;
            PG8_STAGE(PG8_SB(0, 1), b2 + hstep, voffB);
            PG8_WAIT_V(6); PG8_BAR; PG8_MMA(1, 1, At, B1); PG8_BAR;
            PG8_LDB(B0, 1, 0); PG8_SCHED; PG8_LDA(At, 1, 0); PG8_STAGE(PG8_SA(0, 1), a2 + hstep, voffA);
            PG8_WAIT_L(8); PG8_BAR; PG8_WAIT_L(0); PG8_MMA(0, 0, At, B0); PG8_BAR; PG8_SCHED;
            PG8_LDB(B1, 1, 1); PG8_STAGE(PG8_SB(1, 0), b3, voffB);
            PG8_BAR; PG8_WAIT_L(0); PG8_MMA(0, 1, At, B1); PG8_BAR;
            PG8_LDA(At, 1, 1); PG8_STAGE(PG8_SA(1, 0), a3, voffA);
            PG8_BAR; PG8_WAIT_L(0); PG8_MMA(1, 0, At, B0); PG8_BAR; PG8_SCHED;
            PG8_STAGE(PG8_SB(1, 1), b3 + hstep, voffB);
            PG8_WAIT_V(6); PG8_BAR; PG8_MMA(1, 1, At, B1); PG8_BAR;
            }
        }
        if constexpr (FP8) asm volatile("s_nop 7\n\ts_nop 7" ::: "memory");
        if constexpr (ALIGN_EPI) { if (wr == 0) PG8_BAR; }
        if constexpr (!Epi::AFTER_DRAIN) { int ln_ = (int)__builtin_amdgcn_mbcnt_hi(~0u, __builtin_amdgcn_mbcnt_lo(~0u, 0u)); asm volatile("" : "+v"(ln_)); E(acc, cur, wr, wc, ln_ & 15, ln_ >> 4, pre_); S.done(cur); }
        if (!has_next) break;
#pragma unroll
        for (int a = 0; a < 2; ++a)
#pragma unroll
            for (int b = 0; b < 2; ++b)
#pragma unroll
                for (int m = 0; m < 4; ++m)
#pragma unroll
                    for (int n = 0; n < 2; ++n) acc[a][b][m][n] = (f32x4){0.f, 0.f, 0.f, 0.f};
        cur = nxt; cA = nA; cB = nB; ++ui;
        if constexpr (ALIGN_EPI) { if (wr == 1) PG8_BAR; }
    }
    PG8_WAIT_V(0);
    if constexpr (!ALIGN_EPI) { if (wr == 0) PG8_BAR; }
    PG8_BAR;
    if constexpr (Epi::AFTER_DRAIN) { E.fused(acc, cur, wr, wc, fr, fq, lds, wid, lane); S.done(cur); }
#undef PG8_SA
#undef PG8_SB
#undef PG8_STAGE
#undef PG8_LDA
#undef PG8_LDB
#undef PG8_MMA
#undef PG8_WAIT_V
#undef PG8_WAIT_L
#undef PG8_BAR
#undef PG8_SCHED
}
}

constexpr int NWAVES = 8, NTHR = 512;
constexpr int BATCH = 2, SEQ = 8192, D = 1024, DEPTH = 4, MTOK = BATCH * SEQ;
constexpr int DIN = 3344, NPROJ = 3328, SRC_GA = 1152;
constexpr int C_GQ = 0, C_GK = 192, C_GV = 384, C_GG = 768, C_HQ = 1152, C_HF = 1408, C_HI = 1664, C_HG = 1920, C_RQ = 2176, C_RK = 2368, C_RV = 2560, C_RG = 2944;
constexpr int NE = 32, FFN = 1024;
constexpr int CH = 64, NCH = SEQ / CH, NUNIT = BATCH * NCH;
constexpr int ST_GLA = 0, ST_HG = 4 * 48 * 96, ST_RET = ST_HG + 4 * 64 * 64, ST_TOT = ST_RET + 4 * 48 * 96;
constexpr int NDV = 448, NKT = 640;
constexpr int MAXROWS = 65536 + NE * 256, MAXRT = MAXROWS / 256;
constexpr float EPS = 1e-6f;
#ifndef F8_IN_V
#define F8_IN_V false
#endif
#ifndef F8_OUT_V
#define F8_OUT_V true
#endif
constexpr bool F8_IN = F8_IN_V, F8_OUT = F8_OUT_V;
#ifndef Y8_V
#define Y8_V true
#endif
constexpr bool Y8 = Y8_V;
constexpr float S8_Y = 16.f;
constexpr float S8_M = 32.f;
constexpr float S8_W = 2048.f, S8_H = 64.f, S8_A = 8.f;
constexpr int NPHASE = 38;
constexpr int ECAP = 16384, ECAP_SH = 14;

constexpr size_t MiB = 1u << 20;
constexpr size_t WS_CTL = 0, CTL_ZERO_BYTES = 65536;
constexpr size_t WS_MOD = 1 * MiB;
constexpr size_t WS_ROPE = 2 * MiB;
constexpr size_t WS_LB = 5 * MiB;
constexpr size_t WS_WIN = 8 * MiB;
constexpr size_t WS_WOUT = 34 * MiB;
constexpr size_t WS_WGU = 42 * MiB;
constexpr size_t WS_WDN = 554 * MiB;
constexpr size_t WS_X = 810 * MiB;
constexpr size_t WS_H = 874 * MiB;
constexpr size_t WS_GA = 906 * MiB;
constexpr size_t WS_PROJ = 907 * MiB;
constexpr size_t WS_U = 1011 * MiB;
constexpr size_t WS_DVEC = 1063 * MiB;
constexpr size_t WS_SP = 1064 * MiB;
constexpr size_t WS_MIX = 1090 * MiB;
constexpr size_t WS_TOPE = 1122 * MiB;
constexpr size_t WS_TOPW = WS_TOPE + 256 * 1024;
constexpr size_t WS_SLOT = WS_TOPW + 256 * 1024;
constexpr size_t WS_A1 = 1123 * MiB;
constexpr size_t WS_ACT = 1635 * MiB;
constexpr size_t WS_Y = 2147 * MiB;
constexpr size_t WS_CUM = 3171 * MiB;
constexpr size_t WS_KT = 3199 * MiB;
constexpr size_t WS_END = 3239 * MiB;
static_assert(WS_WIN + (size_t)DEPTH * NPROJ * D * 2 <= WS_WOUT && WS_PROJ + (size_t)MTOK * NPROJ * 2 <= WS_U && WS_U + (size_t)NUNIT * ST_TOT * 4 <= WS_DVEC && WS_SP + (size_t)NUNIT * ST_TOT * 2 <= WS_MIX && WS_A1 + (size_t)NE * ECAP * D <= WS_ACT && WS_ACT + (size_t)NE * ECAP * D <= WS_Y && WS_Y + (size_t)NE * ECAP * D * 2 <= WS_CUM, "ws map");
constexpr int CW_TMO = 0, CW_CODE = 1, CW_BAR = 4096, CW_CNT = 8192, CW_FILL = 8192 + 256;
constexpr int RING_BYTES = 131072;
constexpr int MISC_OFF = 147456, LDS_BYTES = MISC_OFF + 4096;
constexpr int MW_BAR = 0, MW_CNT = 16, MW_PST = 48, MW_HIST = 96, MW_BASE = 128, MW_TILE = 192, MW_NRT = 480, MW_SLOTS = 512;

#define GAS __attribute__((address_space(1)))
#define LAS __attribute__((address_space(3)))
typedef unsigned v4u __attribute__((ext_vector_type(4)));
typedef float f32x4 __attribute__((ext_vector_type(4)));
typedef short bf16x8 __attribute__((ext_vector_type(8)));
typedef GAS unsigned gu32;
typedef GAS unsigned long long gu64;
#define RLX_AGENT __ATOMIC_RELAXED, __HIP_MEMORY_SCOPE_AGENT
#define LDS_WAIT() asm volatile("s_waitcnt lgkmcnt(0)" ::: "memory")
#define VM_WAIT() asm volatile("s_waitcnt vmcnt(0)" ::: "memory")
__device__ __forceinline__ unsigned long long rt() { return __builtin_amdgcn_s_memrealtime(); }
typedef unsigned short bf16;
typedef float f32x2_t __attribute__((ext_vector_type(2))); typedef __bf16 bf16x2_t __attribute__((ext_vector_type(2)));
__device__ __forceinline__ unsigned pk2(float lo, float hi) { const f32x2_t v = {lo, hi}; return __builtin_bit_cast(unsigned, __builtin_convertvector(v, bf16x2_t)); }
__device__ __forceinline__ unsigned f2bf(float f) { return pk2(f, 0.f) & 0xffffu; }
__device__ __forceinline__ float bf2f(bf16 b) { return __builtin_bit_cast(float, (unsigned)b << 16); }
#define XB_TMO      128
#define XB_XCNT(j)  (256  + 64 * (j))
#define XB_XSUB(j)  (1280 + 64 * (j))
#define XB_XGEN(j)  (2304 + 64 * (j))
#define XB_TOP      3328
#define XB_TOPGEN   3392
#define XCD_BAR_WORDS 3456
#define XB_SPIN_CAP (1u << 18)

__device__ __forceinline__ unsigned xb_ld(unsigned* p)              { return __hip_atomic_load(p, __ATOMIC_RELAXED, __HIP_MEMORY_SCOPE_AGENT); }
__device__ __forceinline__ unsigned xb_add(unsigned* p, unsigned v) { return __hip_atomic_fetch_add(p, v, __ATOMIC_RELAXED, __HIP_MEMORY_SCOPE_AGENT); }
__device__ __forceinline__ unsigned xb_xcc_id() { return (unsigned)__builtin_amdgcn_s_getreg((3 << 11) | 20) & 0xFu; }
#define XB_SPIN(cond, bar) do { unsigned _sp = 0; while (cond) { __builtin_amdgcn_s_sleep(1); \
    if ((++_sp & 255u) == 0u) { if (xb_ld(&(bar)[XB_TMO])) break; if (_sp > XB_SPIN_CAP) { atomicAdd(&(bar)[XB_TMO], 1u); break; } } } } while (0)

struct XcdBarrier {
    unsigned* bar; unsigned x;
    volatile LAS unsigned* st;
};

__device__ __forceinline__ XcdBarrier xcd_barrier_post(unsigned* bar, volatile LAS unsigned* st) {
    XcdBarrier b; b.bar = bar; b.x = xb_xcc_id(); b.st = st;
    if (threadIdx.x == 0) (void)xb_add(&bar[XB_XCNT(b.x)], 1u);
    return b;
}
__device__ __forceinline__ void xcd_barrier_complete(unsigned* bar, unsigned x, unsigned& nloc, unsigned& nx) {
    const unsigned G = gridDim.x * gridDim.y * gridDim.z;
    unsigned sum, cnt, mine, sp = 0u;
    for (;;) {
        sum = 0u; cnt = 0u; mine = 0u;
#pragma unroll
        for (unsigned j = 0; j < 16; ++j) { const unsigned c = xb_ld(&bar[XB_XCNT(j)]); sum += c; cnt += (c > 0u) ? 1u : 0u; mine = (j == x) ? c : mine; }
        if (sum == G) break;
        __builtin_amdgcn_s_sleep(1);
        if ((++sp & 255u) == 0u) { if (xb_ld(&bar[XB_TMO])) break; if (sp > XB_SPIN_CAP) { atomicAdd(&bar[XB_TMO], 1u); break; } }
    }
    nloc = mine > 0u ? mine : 1u; nx = cnt > 0u ? cnt : 1u;
}

__device__ __forceinline__ void xcd_barrier(const XcdBarrier& b) {
    asm volatile("s_waitcnt vmcnt(0)" ::: "memory");
    __syncthreads();
    if (threadIdx.x == 0) {
        unsigned* bar = b.bar;
        __builtin_amdgcn_s_waitcnt(0);
        unsigned nloc = b.st[0], nx = b.st[1];
        if (nloc == 0u) { xcd_barrier_complete(bar, b.x, nloc, nx); b.st[0] = nloc; b.st[1] = nx; }
        const unsigned old = xb_add(&bar[XB_XSUB(b.x)], 1u);
        const unsigned gen = old / nloc;
        if (old + 1u == (gen + 1u) * nloc) {
            __builtin_amdgcn_fence(__ATOMIC_RELEASE, "agent");
            asm volatile("s_waitcnt vmcnt(0)" ::: "memory");
            const unsigned og = xb_add(&bar[XB_TOP], 1u);
            const unsigned tg = og / nx;
            if (og + 1u == (tg + 1u) * nx) xb_add(&bar[XB_TOPGEN], 1u);
            else XB_SPIN(xb_ld(&bar[XB_TOPGEN]) == tg, bar);
            __builtin_amdgcn_fence(__ATOMIC_ACQUIRE, "agent");
            xb_add(&bar[XB_XGEN(b.x)], 1u);
            asm volatile("s_waitcnt vmcnt(0)" ::: "memory");
        } else {
            XB_SPIN(xb_ld(&bar[XB_XGEN(b.x)]) == gen, bar);
            __builtin_amdgcn_fence(__ATOMIC_ACQUIRE, "agent");
            asm volatile("s_waitcnt vmcnt(0)" ::: "memory");
        }
    }
    __syncthreads();
}

__device__ __forceinline__ float wave_sum(float v) {
#pragma unroll
    for (int o = 1; o < 64; o <<= 1) v += __shfl_xor(v, o);
    return v;
}
__device__ __forceinline__ float log_sigmoid_f(float x) { return fminf(x, 0.f) - log1pf(expf(-fabsf(x))); }
__device__ __forceinline__ float silu_f(float x) { return x / (1.0f + expf(-x)); }
__device__ __forceinline__ float sigmoid_f(float x) { return 1.0f / (1.0f + expf(-x)); }
__device__ __forceinline__ pg8::bf16x8 ldfrag(const LAS bf16* base, int stride, int r0, int k0, int lane) {
    return *(const LAS pg8::bf16x8*)(base + (r0 + (lane & 15)) * stride + k0 + 8 * (lane >> 4));
}
__device__ __forceinline__ pg8::bf16x8 pack8(const float (&v)[8]) { v4u w; w.x = pk2(v[0], v[1]); w.y = pk2(v[2], v[3]); w.z = pk2(v[4], v[5]); w.w = pk2(v[6], v[7]); return __builtin_bit_cast(pg8::bf16x8, w); }

struct Args {
    const float* x; const float* c; const int* pos; const float* w_mod; const float* b_mod; const float* norm1_w; const float* w_in; const float* gla_wa2; const float* gla_ba2; const float* hg_lb;
    const float* gla_norm_w; const float* hg_norm_w; const float* w_out; const float* norm2_w; const float* w_r; const float* b_r; const float* w_gu; const float* b_gu; const float* w_dn; const float* b_dn;
    const float* final_norm_w; float* out; unsigned char* ws; int ph_lo, ph_hi;
};

__device__ __forceinline__ void transpose_block64(const float* src, int ld, bf16* dst, LAS float*, int lane) {
    const int n4 = lane & 15, kg = lane >> 4;
    f32x4 v[16];
#pragma unroll
    for (int i = 0; i < 16; ++i) v[i] = __builtin_nontemporal_load((const f32x4*)(src + (size_t)(16 * kg + i) * ld + 4 * n4));
#pragma unroll
    for (int j = 0; j < 4; ++j) { v4u o0, o1;
        o0.x = pk2(v[0][j], v[1][j]); o0.y = pk2(v[2][j], v[3][j]); o0.z = pk2(v[4][j], v[5][j]); o0.w = pk2(v[6][j], v[7][j]);
        o1.x = pk2(v[8][j], v[9][j]); o1.y = pk2(v[10][j], v[11][j]); o1.z = pk2(v[12][j], v[13][j]); o1.w = pk2(v[14][j], v[15][j]);
        bf16* d = dst + (size_t)(4 * n4 + j) * D + 16 * kg; *(GAS v4u*)d = o0; *(GAS v4u*)(d + 8) = o1; }
}
__device__ __forceinline__ float clamp448(float x) { return __builtin_amdgcn_fmed3f(x, -448.f, 448.f); }
__device__ __forceinline__ int pk4_fp8(float a, float b, float c, float d) { int w = 0; w = __builtin_amdgcn_cvt_pk_fp8_f32(clamp448(a), clamp448(b), w, false);
    return __builtin_amdgcn_cvt_pk_fp8_f32(clamp448(c), clamp448(d), w, true); }
__device__ __forceinline__ void transpose_block64_fp8(const float* src, int ld, unsigned char* dst, LAS float*, int lane, float sc) {
    const int n4 = lane & 15, kg = lane >> 4;
    f32x4 v[16];
#pragma unroll
    for (int i = 0; i < 16; ++i) v[i] = __builtin_nontemporal_load((const f32x4*)(src + (size_t)(16 * kg + i) * ld + 4 * n4)) * sc;
#pragma unroll
    for (int j = 0; j < 4; ++j) { v4u o;
        o.x = (unsigned)pk4_fp8(v[0][j], v[1][j], v[2][j], v[3][j]); o.y = (unsigned)pk4_fp8(v[4][j], v[5][j], v[6][j], v[7][j]);
        o.z = (unsigned)pk4_fp8(v[8][j], v[9][j], v[10][j], v[11][j]); o.w = (unsigned)pk4_fp8(v[12][j], v[13][j], v[14][j], v[15][j]);
        *(GAS v4u*)(dst + (size_t)(4 * n4 + j) * D + 16 * kg) = o; }
}
constexpr int IT_IN = 16 * (NPROJ / 64), IT_OUT = 16 * 16, IT_GU = NE * 16 * 32, IT_DN = NE * 16 * 16, IT_LAYER = IT_IN + IT_OUT + IT_GU + IT_DN, IT_ALL = DEPTH * IT_LAYER;
__device__ __forceinline__ void convert_item(const Args& a, int l, int r, LAS float* scr, int lane) {
    unsigned char* ws = a.ws;
    bf16* WIN = (bf16*)(ws + WS_WIN); bf16* WOUT = (bf16*)(ws + WS_WOUT); unsigned char* WGU = ws + WS_WGU; unsigned char* WDN = ws + WS_WDN;
    if (r < IT_IN) { const int kb = r / (NPROJ / 64), nb = r % (NPROJ / 64), n0 = 64 * nb, sc = n0 + (n0 >= SRC_GA ? 16 : 0);
        if (F8_IN) transpose_block64_fp8(a.w_in + ((size_t)l * D + 64 * kb) * DIN + sc, DIN, (unsigned char*)WIN + ((size_t)l * NPROJ + n0) * D + 64 * kb, scr, lane, S8_W);
        else transpose_block64(a.w_in + ((size_t)l * D + 64 * kb) * DIN + sc, DIN, WIN + ((size_t)l * NPROJ + n0) * D + 64 * kb, scr, lane); return; }
    r -= IT_IN;
    if (r < IT_OUT) { const int kb = r / 16, nb = r % 16;
        if (F8_OUT) transpose_block64_fp8(a.w_out + ((size_t)l * D + 64 * kb) * D + 64 * nb, D, (unsigned char*)WOUT + ((size_t)l * D + 64 * nb) * D + 64 * kb, scr, lane, S8_W);
        else transpose_block64(a.w_out + ((size_t)l * D + 64 * kb) * D + 64 * nb, D, WOUT + ((size_t)l * D + 64 * nb) * D + 64 * kb, scr, lane); return; }
    r -= IT_OUT;
    if (r < IT_GU) { const int e = r / 512, r2 = r % 512, kb = r2 / 32, nb = r2 % 32, cc = 64 * nb;
        const int row = (cc < 1024) ? 256 * (cc / 128) + (cc % 128) : 256 * ((cc - 1024) / 128) + 128 + ((cc - 1024) % 128);
        transpose_block64_fp8(a.w_gu + (((size_t)l * NE + e) * D + 64 * kb) * 2048 + cc, 2048, WGU + (((size_t)l * NE + e) * 2048 + row) * D + 64 * kb, scr, lane, S8_W); return; }
    r -= IT_GU;
    { const int e = r / 256, r2 = r % 256, kb = r2 / 16, nb = r2 % 16;
        transpose_block64_fp8(a.w_dn + (((size_t)l * NE + e) * FFN + 64 * kb) * D + 64 * nb, D, WDN + (((size_t)l * NE + e) * D + 64 * nb) * D + 64 * kb, scr, lane, S8_W); }
}
constexpr int CB2 = 4, CB7 = 2, CB8 = 2;
__device__ __forceinline__ int conv_t2(int G) { return (G == 256) ? 192 * NWAVES * CB2 : 0; }
__device__ __forceinline__ int conv_idle(int nunits, int G) { const int rem = nunits % G; return rem ? G - rem : 0; }
__device__ __forceinline__ void convert_range(const Args& a, int l, int first, int count, LAS unsigned char* lds, int lane, int wave) {
    LAS float* scr = (LAS float*)(lds + wave * 16640);
    for (int k = 0; k < count; ++k) { const int it = first + k; if (it < IT_LAYER) convert_item(a, l, it, scr, lane); }
}
__device__ __forceinline__ void p0_prologue(const Args& a, LAS unsigned char* lds, int vcu, int G, int tid, int lane, int wave) {
    unsigned char* ws = a.ws;
    LAS float* scr = (LAS float*)(lds + wave * 16640);
    const int gw = vcu * NWAVES + wave, NGW = G * NWAVES;
    for (int it = gw; it < IT_LAYER; it += NGW) convert_item(a, 0, it, scr, lane);
    __syncthreads();
    {
        LAS float* cact = (LAS float*)lds;
        LAS float* red = (LAS float*)(lds + 8192);
        for (int i = tid; i < 2 * D; i += NTHR) cact[i] = silu_f(a.c[i]);
        __syncthreads();
        float* MOD = (float*)(ws + WS_MOD);
        for (int it = vcu; it < DEPTH * 96; it += G) {
            const int l = it / 96, n0 = (it % 96) * 64;
            const float* wp = a.w_mod + ((size_t)l * D + 128 * wave) * 6144 + n0 + lane;
            float a0 = 0.f, a1 = 0.f;
#pragma unroll 32
            for (int k = 0; k < 128; ++k) { const float w = __builtin_nontemporal_load(wp + (size_t)k * 6144); a0 += cact[128 * wave + k] * w; a1 += cact[D + 128 * wave + k] * w; }
            red[(wave * 2 + 0) * 64 + lane] = a0; red[(wave * 2 + 1) * 64 + lane] = a1;
            __syncthreads();
            if (tid < 128) { const int b = tid >> 6, ln = tid & 63; float s = a.b_mod[l * 6144 + n0 + ln];
#pragma unroll
                for (int w = 0; w < 8; ++w) s += red[(w * 2 + b) * 64 + ln];
                MOD[((size_t)l * 2 + b) * 6144 + n0 + ln] = s; }
            __syncthreads();
        }
    }
    { const f32x4* xs = (const f32x4*)a.x; uint2* xd = (uint2*)(ws + WS_X);
        for (int i = vcu * NTHR + tid; i < MTOK * D / 4; i += G * NTHR) { const f32x4 v = xs[i]; uint2 p; p.x = pk2(v[0], v[1]); p.y = pk2(v[2], v[3]); xd[i] = p; } }
    {
        float* ROPE = (float*)(ws + WS_ROPE);
        for (int i = vcu * NTHR + tid; i < MTOK * 24; i += G * NTHR) { const int t = i / 24, f = i % 24;
            const float inv = (float)pow(10000.0, -(double)f / 24.0); const float ang = (float)a.pos[t] * inv;
            ROPE[(size_t)t * 48 + f] = cosf(ang); ROPE[(size_t)t * 48 + 24 + f] = sinf(ang); }
    }
    if (vcu == 0 && tid < 256) {
        float v[4], mx = -3.0e38f; for (int l = 0; l < 4; ++l) { v[l] = a.hg_lb[l * 256 + tid]; mx = fmaxf(mx, v[l]); }
        float s = 0.f; for (int l = 0; l < 4; ++l) { v[l] = expf(v[l] - mx); s += v[l]; }
        float* LB = (float*)(ws + WS_LB); float cs = 0.f, first = 0.f;
        for (int l = 0; l < 4; ++l) { cs += v[l] / s; if (l == 0) first = cs; LB[l * 256 + tid] = cs - first; }
    }
}

__device__ __forceinline__ void moe_combine_row(f32x4 (&v)[4], int m, const bf16* Y, const int* SLOT, const float* TOPW, const float* g2, int lane) {
    const int4 sl = *(const int4*)(SLOT + (size_t)m * 4); const f32x4 tw = *(const f32x4*)(TOPW + (size_t)m * 4);
    const int s[4] = {sl.x, sl.y, sl.z, sl.w};
    f32x4 acc[4];
#pragma unroll
    for (int j = 0; j < 4; ++j) acc[j] = (f32x4){0.f, 0.f, 0.f, 0.f};
#pragma unroll
    for (int k = 0; k < 4; ++k) { const bf16* yr = Y + (size_t)s[k] * D + 4 * lane; const float w = tw[k];
#pragma unroll
        for (int j = 0; j < 4; ++j) { const uint2 p = *(const uint2*)(yr + 256 * j);
            acc[j][0] += w * __builtin_bit_cast(float, p.x << 16); acc[j][1] += w * __builtin_bit_cast(float, p.x & 0xffff0000u);
            acc[j][2] += w * __builtin_bit_cast(float, p.y << 16); acc[j][3] += w * __builtin_bit_cast(float, p.y & 0xffff0000u); } }
#pragma unroll
    for (int j = 0; j < 4; ++j) { const f32x4 g = *(const f32x4*)(g2 + 4 * lane + 256 * j); v[j] = v[j] + g * acc[j]; }
}
__device__ __forceinline__ float row_rstd(const f32x4 (&v)[4]) {
    float s = 0.f;
#pragma unroll
    for (int j = 0; j < 4; ++j) s += (v[j][0] * v[j][0] + v[j][1] * v[j][1]) + (v[j][2] * v[j][2] + v[j][3] * v[j][3]);
    return 1.0f / sqrtf(wave_sum(s) * (1.0f / D) + EPS);
}
__device__ __forceinline__ void modulate_row(f32x4 (&v)[4], float rstd, const float* nw, const float* sc, const float* sh, bf16* hrow, int lane) {
#pragma unroll
    for (int j = 0; j < 4; ++j) { const int c0 = 4 * lane + 256 * j; const f32x4 w = *(const f32x4*)(nw + c0), s1 = *(const f32x4*)(sc + c0), s0 = *(const f32x4*)(sh + c0);
        v[j] = v[j] * rstd * w * (s1 + 1.0f) + s0;
        uint2 p; p.x = pk2(v[j][0], v[j][1]); p.y = pk2(v[j][2], v[j][3]); *(uint2*)(hrow + c0) = p; }
}


constexpr int LR_SLT = 142976, LR_TWL = 144000, LR_SSR = 145024;
__device__ __forceinline__ void stage_slots(const unsigned char* ws, int row0, LAS unsigned char* lds, int tid) {
    if (tid < 64) { *(LAS v4u*)(lds + LR_SLT + 16 * tid) = *(const v4u*)((const int*)(ws + WS_SLOT) + (size_t)(row0 + tid) * 4);
                    *(LAS f32x4*)(lds + LR_TWL + 16 * tid) = *(const f32x4*)((const float*)(ws + WS_TOPW) + (size_t)(row0 + tid) * 4); }
}
template <bool SS, bool OUTF32>
__device__ __forceinline__ void flat_combine(const bf16* xsrc, void* xdst, int row0, const bf16* Y, const float* g2, LAS unsigned char* lds, int tid, int lane, const float* fw = nullptr) {
    static_assert(Y8, "expert outputs are stored as fp8");
    typedef float f32x2v __attribute__((ext_vector_type(2)));
    const int c16 = tid & 63, rsub = tid >> 6; const unsigned char* Yb = (const unsigned char*)Y;
    f32x4 g[4];
#pragma unroll
    for (int q = 0; q < 4; ++q) g[q] = *(const f32x4*)(g2 + 16 * c16 + 4 * q);
    f32x4 fwv[4];
    if (SS) {
#pragma unroll
        for (int q = 0; q < 4; ++q) fwv[q] = *(const f32x4*)(fw + 16 * c16 + 4 * q); }
#pragma unroll 2
    for (int it = 0; it < 8; ++it) { const int i = 8 * it + rsub; const size_t m = (size_t)(row0 + i);
        const v4u x0 = *(const v4u*)(xsrc + m * D + 16 * c16), x1 = *(const v4u*)(xsrc + m * D + 16 * c16 + 8);
        const v4u sl = *(const LAS v4u*)(lds + LR_SLT + 16 * i); const f32x4 tws = *(const LAS f32x4*)(lds + LR_TWL + 16 * i) * (1.0f / S8_Y);
        const v4u y0 = *(const v4u*)(Yb + (size_t)sl.x * D + 16 * c16), y1 = *(const v4u*)(Yb + (size_t)sl.y * D + 16 * c16), y2 = *(const v4u*)(Yb + (size_t)sl.z * D + 16 * c16), y3 = *(const v4u*)(Yb + (size_t)sl.w * D + 16 * c16);
        const unsigned xw[8] = {x0.x, x0.y, x0.z, x0.w, x1.x, x1.y, x1.z, x1.w}, w0[4] = {y0.x, y0.y, y0.z, y0.w}, w1[4] = {y1.x, y1.y, y1.z, y1.w}, w2[4] = {y2.x, y2.y, y2.z, y2.w}, w3[4] = {y3.x, y3.y, y3.z, y3.w};
        float v[16]; float sq = 0.f;
#pragma unroll
        for (int q = 0; q < 4; ++q) {
            const f32x2v a0 = __builtin_amdgcn_cvt_pk_f32_fp8((int)w0[q], false), b0 = __builtin_amdgcn_cvt_pk_f32_fp8((int)w0[q], true), a1 = __builtin_amdgcn_cvt_pk_f32_fp8((int)w1[q], false), b1 = __builtin_amdgcn_cvt_pk_f32_fp8((int)w1[q], true);
            const f32x2v a2 = __builtin_amdgcn_cvt_pk_f32_fp8((int)w2[q], false), b2 = __builtin_amdgcn_cvt_pk_f32_fp8((int)w2[q], true), a3 = __builtin_amdgcn_cvt_pk_f32_fp8((int)w3[q], false), b3 = __builtin_amdgcn_cvt_pk_f32_fp8((int)w3[q], true);
            const float e0 = tws[0] * a0[0] + tws[1] * a1[0] + tws[2] * a2[0] + tws[3] * a3[0], e1 = tws[0] * a0[1] + tws[1] * a1[1] + tws[2] * a2[1] + tws[3] * a3[1];
            const float e2 = tws[0] * b0[0] + tws[1] * b1[0] + tws[2] * b2[0] + tws[3] * b3[0], e3 = tws[0] * b0[1] + tws[1] * b1[1] + tws[2] * b2[1] + tws[3] * b3[1];
            v[4 * q + 0] = __builtin_bit_cast(float, xw[2 * q] << 16) + g[q][0] * e0; v[4 * q + 1] = __builtin_bit_cast(float, xw[2 * q] & 0xffff0000u) + g[q][1] * e1;
            v[4 * q + 2] = __builtin_bit_cast(float, xw[2 * q + 1] << 16) + g[q][2] * e2; v[4 * q + 3] = __builtin_bit_cast(float, xw[2 * q + 1] & 0xffff0000u) + g[q][3] * e3;
            sq += (v[4 * q] * v[4 * q] + v[4 * q + 1] * v[4 * q + 1]) + (v[4 * q + 2] * v[4 * q + 2] + v[4 * q + 3] * v[4 * q + 3]); }
        if (SS) { const float rstd = 1.0f / sqrtf(wave_sum(sq) * (1.0f / D) + EPS);
#pragma unroll
            for (int q = 0; q < 4; ++q) { v[4 * q] *= rstd * fwv[q][0]; v[4 * q + 1] *= rstd * fwv[q][1]; v[4 * q + 2] *= rstd * fwv[q][2]; v[4 * q + 3] *= rstd * fwv[q][3]; } }
        if (OUTF32) {
#pragma unroll
            for (int q = 0; q < 4; ++q) *(GAS f32x4*)((float*)xdst + m * D + 16 * c16 + 4 * q) = (f32x4){v[4 * q], v[4 * q + 1], v[4 * q + 2], v[4 * q + 3]}; }
        else { v4u o0, o1; o0.x = pk2(v[0], v[1]); o0.y = pk2(v[2], v[3]); o0.z = pk2(v[4], v[5]); o0.w = pk2(v[6], v[7]); o1.x = pk2(v[8], v[9]); o1.y = pk2(v[10], v[11]); o1.z = pk2(v[12], v[13]); o1.w = pk2(v[14], v[15]);
            *(GAS v4u*)((bf16*)xdst + m * D + 16 * c16) = o0; *(GAS v4u*)((bf16*)xdst + m * D + 16 * c16 + 8) = o1; }
    }
}
template <bool F8, bool SLOTS>
__device__ __forceinline__ void flat_modulate(const bf16* xin, int row0, const LAS float* rstds, const float* nw, const float* scp, const float* shp, bf16* H, unsigned char* A1, LAS unsigned char* lds, int tid) {
    const int c16 = tid & 63, rsub = tid >> 6; f32x4 ws1[4], s0[4];
#pragma unroll
    for (int q = 0; q < 4; ++q) { const int c0 = 16 * c16 + 4 * q; ws1[q] = *(const f32x4*)(nw + c0) * (*(const f32x4*)(scp + c0) + 1.0f); s0[q] = *(const f32x4*)(shp + c0); }
#pragma unroll 2
    for (int it = 0; it < 8; ++it) { const int i = 8 * it + rsub; const size_t m = (size_t)(row0 + i); const float rs = rstds[i];
        const v4u x0 = *(const v4u*)(xin + m * D + 16 * c16), x1 = *(const v4u*)(xin + m * D + 16 * c16 + 8); const unsigned xw[8] = {x0.x, x0.y, x0.z, x0.w, x1.x, x1.y, x1.z, x1.w};
        f32x4 v[4];
#pragma unroll
        for (int q = 0; q < 4; ++q) v[q] = (f32x4){__builtin_bit_cast(float, xw[2 * q] << 16), __builtin_bit_cast(float, xw[2 * q] & 0xffff0000u), __builtin_bit_cast(float, xw[2 * q + 1] << 16), __builtin_bit_cast(float, xw[2 * q + 1] & 0xffff0000u)} * rs * ws1[q] + s0[q];
        if (F8) { v4u o; o.x = (unsigned)pk4_fp8(v[0][0] * S8_H, v[0][1] * S8_H, v[0][2] * S8_H, v[0][3] * S8_H); o.y = (unsigned)pk4_fp8(v[1][0] * S8_H, v[1][1] * S8_H, v[1][2] * S8_H, v[1][3] * S8_H);
            o.z = (unsigned)pk4_fp8(v[2][0] * S8_H, v[2][1] * S8_H, v[2][2] * S8_H, v[2][3] * S8_H); o.w = (unsigned)pk4_fp8(v[3][0] * S8_H, v[3][1] * S8_H, v[3][2] * S8_H, v[3][3] * S8_H);
            if (SLOTS) { const v4u sl = *(const LAS v4u*)(lds + LR_SLT + 16 * i);
                *(GAS v4u*)(A1 + (size_t)sl.x * D + 16 * c16) = o; *(GAS v4u*)(A1 + (size_t)sl.y * D + 16 * c16) = o; *(GAS v4u*)(A1 + (size_t)sl.z * D + 16 * c16) = o; *(GAS v4u*)(A1 + (size_t)sl.w * D + 16 * c16) = o; }
            else *(GAS v4u*)((unsigned char*)H + m * D + 16 * c16) = o; }
        else { v4u o0, o1; o0.x = pk2(v[0][0], v[0][1]); o0.y = pk2(v[0][2], v[0][3]); o0.z = pk2(v[1][0], v[1][1]); o0.w = pk2(v[1][2], v[1][3]); o1.x = pk2(v[2][0], v[2][1]); o1.y = pk2(v[2][2], v[2][3]); o1.z = pk2(v[3][0], v[3][1]); o1.w = pk2(v[3][2], v[3][3]);
            *(GAS v4u*)(H + m * D + 16 * c16) = o0; *(GAS v4u*)(H + m * D + 16 * c16 + 8) = o1; } }
}

constexpr int WP = 1032;
constexpr int LR_WHI = 0, LR_PART = 132096, LR_SSX = 140288, LR_RSTD = 140544, LR_BIAS = 140800, LR_RED = 140928;
template <int NEO>
__device__ __forceinline__ void rows_mfma(const Args& a, int layer, LAS unsigned char* lds, volatile LAS unsigned* MISC, gu32* ctl, int vcu, int G, int tid, int lane, int wave) {
    constexpr bool P5 = (NEO == 32); constexpr int NET = NEO / 16;
    unsigned char* ws = a.ws; bf16* X = (bf16*)(ws + WS_X); bf16* H = (bf16*)(ws + WS_H); const float* MOD = (const float*)(ws + WS_MOD);
    LAS bf16* Whi = (LAS bf16*)(lds + LR_WHI); LAS bf16* Wlo = Whi + NEO * WP; LAS float* part = (LAS float*)(lds + LR_PART); LAS float* ssx = (LAS float*)(lds + LR_SSX);
    LAS float* rstds = (LAS float*)(lds + LR_RSTD); LAS float* biasl = (LAS float*)(lds + LR_BIAS); LAS float* red = (LAS float*)(lds + LR_RED);
    const float* nw = (P5 ? a.norm2_w : a.norm1_w) + layer * D;
    const float* Wsrc = P5 ? a.w_r + (size_t)layer * D * NE : a.w_in + (size_t)layer * D * DIN + SRC_GA; const int wld = P5 ? NE : DIN;
    if (P5) { if (tid < NE) MISC[MW_HIST + tid] = 0u; }
    for (int row0 = vcu * 64; row0 < MTOK; row0 += G * 64) {
        const int b = row0 / SEQ; const float* mp = MOD + ((size_t)layer * 2 + b) * 6144; const float* scp = mp + (P5 ? 4 : 1) * D; const float* shp = mp + (P5 ? 3 : 0) * D;
        if (!P5 && layer > 0) { stage_slots(ws, row0, lds, tid); __syncthreads(); }
        { constexpr int E4 = NEO / 4, NITP = (D / 2 * E4) / NTHR, NIT = 4;
          f32x4 bacc = {0.f, 0.f, 0.f, 0.f};
#pragma unroll 1
          for (int ib0 = 0; ib0 < NITP; ib0 += NIT) {
            f32x4 wa[NIT], wb[NIT]; f32x2_t nv[NIT], sv[NIT], hv[NIT];
#pragma unroll
            for (int it = 0; it < NIT; ++it) { const int idx = tid + NTHR * (ib0 + it), k2 = idx / E4, e4 = idx - k2 * E4, k = 2 * k2;
                wa[it] = *(const f32x4*)(Wsrc + (size_t)k * wld + 4 * e4); wb[it] = *(const f32x4*)(Wsrc + (size_t)(k + 1) * wld + 4 * e4);
                nv[it] = *(const f32x2_t*)(nw + k); sv[it] = *(const f32x2_t*)(scp + k); hv[it] = *(const f32x2_t*)(shp + k); }
#pragma unroll
            for (int it = 0; it < NIT; ++it) { const int idx = tid + NTHR * (ib0 + it), k2 = idx / E4, e4 = idx - k2 * E4, k = 2 * k2;
                bacc += wa[it] * hv[it][0] + wb[it] * hv[it][1];
                const f32x4 w0 = wa[it] * (nv[it][0] * (1.0f + sv[it][0])), w1 = wb[it] * (nv[it][1] * (1.0f + sv[it][1]));
#pragma unroll
                for (int j = 0; j < 4; ++j) { const unsigned h0 = f2bf(w0[j]), h1 = f2bf(w1[j]); const float l0 = w0[j] - __builtin_bit_cast(float, h0 << 16), l1 = w1[j] - __builtin_bit_cast(float, h1 << 16);
                    *(LAS unsigned*)(Whi + (4 * e4 + j) * WP + k) = h0 | (h1 << 16); *(LAS unsigned*)(Wlo + (4 * e4 + j) * WP + k) = pk2(l0, l1); } } }
#pragma unroll
          for (int j = 0; j < 4; ++j) { float v = bacc[j];
#pragma unroll
              for (int sh = E4; sh < 64; sh <<= 1) v += __shfl_xor(v, sh);
              bacc[j] = v; }
          if (lane < E4) *(LAS f32x4*)(red + wave * NEO + 4 * lane) = bacc; }
        const bf16* xin = X;
        if (!P5 && layer > 0) { flat_combine<false, false>(X, X, row0, (const bf16*)(ws + WS_Y), MOD + ((size_t)(layer - 1) * 2 + b) * 6144 + 5 * D, lds, tid, lane); asm volatile("s_waitcnt vmcnt(0)" ::: "memory"); }
        __syncthreads();
        if (tid < NEO) { float sacc = P5 ? a.b_r[layer * NE + tid] : 0.f; for (int q = 0; q < NWAVES; ++q) sacc += red[q * NEO + tid]; biasl[tid] = sacc; }
        const int rg = wave >> 1, kh = wave & 1, r = lane & 15, g = lane >> 4;
        { const bf16* xr = xin + (size_t)(row0 + 16 * rg + r) * D; f32x4 acc[NET]; float ss = 0.f;
#pragma unroll
            for (int et = 0; et < NET; ++et) acc[et] = (f32x4){0.f, 0.f, 0.f, 0.f};
#pragma unroll 4
            for (int s = 16 * kh; s < 16 * kh + 16; ++s) { const int k0 = 32 * s + 8 * g; const v4u xp = *(const v4u*)(xr + k0); const unsigned xw[4] = {xp.x, xp.y, xp.z, xp.w};
#pragma unroll
                for (int j = 0; j < 4; ++j) { const float xa = __builtin_bit_cast(float, xw[j] << 16), xb = __builtin_bit_cast(float, xw[j] & 0xffff0000u); ss += xa * xa + xb * xb; }
                const pg8::bf16x8 ahi = __builtin_bit_cast(pg8::bf16x8, xp);
#pragma unroll
                for (int et = 0; et < NET; ++et) { const pg8::bf16x8 whi = ldfrag(Whi, WP, 16 * et, 32 * s, lane), wlo = ldfrag(Wlo, WP, 16 * et, 32 * s, lane);
                    acc[et] = __builtin_amdgcn_mfma_f32_16x16x32_bf16(ahi, whi, acc[et], 0, 0, 0); acc[et] = __builtin_amdgcn_mfma_f32_16x16x32_bf16(ahi, wlo, acc[et], 0, 0, 0); } }
            ss += __shfl_xor(ss, 16); ss += __shfl_xor(ss, 32);
            if (kh == 1) {
#pragma unroll
                for (int et = 0; et < NET; ++et)
#pragma unroll
                    for (int q = 0; q < 4; ++q) part[(rg * 16 + 4 * g + q) * 32 + 16 * et + r] = acc[et][q];
                if (g == 0) ssx[rg * 16 + r] = ss; }
            __syncthreads();
            if (kh == 0) { const float sst = ss + ssx[rg * 16 + r]; if (g == 0) rstds[rg * 16 + r] = 1.0f / sqrtf(sst * (1.0f / D) + EPS);
                asm volatile("s_waitcnt lgkmcnt(0)" ::: "memory");
#pragma unroll
                for (int et = 0; et < NET; ++et)
#pragma unroll
                    for (int q = 0; q < 4; ++q) { const int i = rg * 16 + 4 * g + q, e = 16 * et + r; const float v = rstds[i] * (acc[et][q] + part[i * 32 + e]) + biasl[e];
                        if (P5) part[i * 32 + e] = v; else ((float*)(ws + WS_GA))[(size_t)(row0 + i) * 16 + e] = v; }
                if (P5) { asm volatile("s_waitcnt lgkmcnt(0)" ::: "memory");
                    if (lane < 16) { const int i = rg * 16 + lane, m = row0 + i; float lv[NE];
#pragma unroll
                        for (int e = 0; e < NE; ++e) lv[e] = part[i * 32 + e];
                        float tv[4]; int te[4];
#pragma unroll
                        for (int t = 0; t < 4; ++t) { float best = -3.0e38f; int bi = 0;
#pragma unroll
                            for (int e = 0; e < NE; ++e) if (lv[e] > best) { best = lv[e]; bi = e; }
#pragma unroll
                            for (int e = 0; e < NE; ++e) if (e == bi) lv[e] = -3.0e38f;
                            tv[t] = best; te[t] = bi; }
                        const float e1 = expf(tv[1] - tv[0]), e2 = expf(tv[2] - tv[0]), e3 = expf(tv[3] - tv[0]); const float inv = 1.0f / (1.0f + e1 + e2 + e3);
                        *(f32x4*)((float*)(ws + WS_TOPW) + (size_t)m * 4) = (f32x4){inv, e1 * inv, e2 * inv, e3 * inv};
#pragma unroll
                        for (int t = 0; t < 4; ++t) { const unsigned rk = __hip_atomic_fetch_add((LAS unsigned*)&MISC[MW_HIST + te[t]], 1u, __ATOMIC_RELAXED, __HIP_MEMORY_SCOPE_WORKGROUP);
                            ((LAS unsigned*)(lds + LR_SLT))[i * 4 + t] = ((unsigned)te[t] << 16) | rk; } } } }
            __syncthreads(); }
        if (P5) { if (tid < NE) { const unsigned hcnt = MISC[MW_HIST + tid]; MISC[MW_BASE + tid] = hcnt ? atomicAdd((unsigned*)(ctl + CW_CNT + layer * NE + tid), hcnt) : 0u; }
            __syncthreads();
            if (tid < 256) { LAS unsigned* sl = (LAS unsigned*)(lds + LR_SLT) + tid; const unsigned v = *sl, e = v >> 16; const unsigned slot = (e << ECAP_SH) + MISC[MW_BASE + e] + (v & 0xffffu);
                *sl = slot; ((int*)(ws + WS_SLOT))[(size_t)row0 * 4 + tid] = (int)slot; }
            if (tid < NE) MISC[MW_HIST + tid] = 0u;
            __syncthreads(); }
        if (P5) flat_modulate<true, true>(xin, row0, rstds, nw, scp, shp, H, ws + WS_A1, lds, tid);
        else flat_modulate<F8_IN, false>(xin, row0, rstds, nw, scp, shp, H, ws + WS_A1, lds, tid);
        __syncthreads();
    }
}

__device__ __forceinline__ void final_rows(const Args& a, LAS unsigned char* lds, int vcu, int G, int tid, int lane) {
    unsigned char* ws = a.ws; const bf16* X = (const bf16*)(ws + WS_X); const float* MOD = (const float*)(ws + WS_MOD);
    for (int row0 = vcu * 64; row0 < MTOK; row0 += G * 64) { const int b = row0 / SEQ;
        stage_slots(ws, row0, lds, tid);
        __syncthreads();
        flat_combine<true, true>(X, a.out, row0, (const bf16*)(ws + WS_Y), MOD + ((size_t)(DEPTH - 1) * 2 + b) * 6144 + 5 * D, lds, tid, lane, a.final_norm_w);
        __syncthreads();
    }
}

__device__ __noinline__ void moe_tables(gu32* ctl, int layer, volatile LAS unsigned* MISC, int tid) {
    if (tid < NE) MISC[MW_CNT + tid] = __hip_atomic_load(ctl + CW_CNT + layer * NE + tid, RLX_AGENT);
    __syncthreads();
    if (tid == 0) { unsigned n = 0;
        for (int e = 0; e < NE; ++e) { const unsigned nt = (MISC[MW_CNT + e] + 255u) >> 8; for (unsigned t = 0; t < nt; ++t) MISC[MW_TILE + n + t] = (unsigned)(e * 64) + t; n += nt; }
        MISC[MW_NRT] = n; }
    __syncthreads();
}

constexpr int BP = 72;
template <int TYPE> struct MixCfg { static constexpr int DK = (TYPE == 1) ? 64 : 48, DV = (TYPE == 1) ? 64 : 96, NC = 4 * DK, NV = 4 * DV;
    static constexpr int STOFF = (TYPE == 0) ? ST_GLA : (TYPE == 1) ? ST_HG : ST_RET, COFF = (TYPE == 0) ? 0 : 192;
    static constexpr int CQ = (TYPE == 0) ? C_GQ : (TYPE == 1) ? C_HQ : C_RQ, CK = (TYPE == 0) ? C_GK : (TYPE == 1) ? C_HF : C_RK, CV = (TYPE == 0) ? C_GV : (TYPE == 1) ? C_HI : C_RV, CG = (TYPE == 0) ? C_GG : (TYPE == 1) ? C_HG : C_RG;
    static constexpr int MIXOFF = (TYPE == 0) ? 0 : (TYPE == 1) ? 384 : 640, KOFF = (TYPE == 0) ? 0 : (TYPE == 1) ? 192 : 448; };
__device__ __forceinline__ float fast_logsig(float x) { x = fmaxf(x, -80.f); return -__logf(1.0f + __expf(-x)); }
__device__ __forceinline__ float ret_lg(int h) { return logf(1.0f - exp2f(-5.0f - (float)h)); }

template <int NV>
__device__ __forceinline__ void stage_vt(const bf16* pv  , LAS bf16* VT, int tid) {
    constexpr int NIT = (64 * (NV / 8)) / NTHR; static_assert((64 * (NV / 8)) % NTHR == 0, "stage_vt");
    v4u p[NIT];
#pragma unroll
    for (int it = 0; it < NIT; ++it) { const int idx = tid + NTHR * it, j = idx & 63, ch = idx >> 6; p[it] = *(const v4u*)(pv + (size_t)j * NPROJ + 8 * ch); }
#pragma unroll
    for (int it = 0; it < NIT; ++it) { const int idx = tid + NTHR * it, j = idx & 63, ch = idx >> 6; LAS bf16* d = VT + (8 * ch) * BP + j;
        d[0 * BP] = (bf16)(p[it].x & 0xffffu); d[1 * BP] = (bf16)(p[it].x >> 16); d[2 * BP] = (bf16)(p[it].y & 0xffffu); d[3 * BP] = (bf16)(p[it].y >> 16);
        d[4 * BP] = (bf16)(p[it].z & 0xffffu); d[5 * BP] = (bf16)(p[it].z >> 16); d[6 * BP] = (bf16)(p[it].w & 0xffffu); d[7 * BP] = (bf16)(p[it].w >> 16); }
}

constexpr int LA_KT = 0, LA_VT = 36864, LA_TOT = 92160, LA_GA = 94208, LA_KTT = 98304, KTP = 264;
template <int TYPE>
__device__ __forceinline__ void mixa_batch(const Args& a, int layer, int unit, LAS unsigned char* lds, int tid, int lane, int wave) {
    asm volatile("" : "+v"(tid), "+v"(lane));
    typedef MixCfg<TYPE> C; constexpr int DK = C::DK, DV = C::DV, NC = C::NC, NV = C::NV;
    unsigned char* ws = a.ws; const bf16* PROJ = (const bf16*)(ws + WS_PROJ); bf16* F1 = (bf16*)(ws + WS_CUM); float* ECG = (float*)(ws + WS_CUM + 16 * MiB) + (size_t)unit * 4 * NDV; float* DVEC = (float*)(ws + WS_DVEC) + (size_t)unit * NDV;
    bf16* U = (bf16*)(ws + WS_U) + (size_t)unit * ST_TOT + C::STOFF;
    LAS bf16* KT = (LAS bf16*)(lds + LA_KT); LAS bf16* VT = (LAS bf16*)(lds + LA_VT); LAS float* TOT = (LAS float*)(lds + LA_TOT); const LAS float* GAs = (const LAS float*)(lds + LA_GA);
    const int row0 = unit * CH;
    stage_vt<NV>(PROJ + (size_t)row0 * NPROJ + C::CV, VT, tid);
    const bool act = tid < 2 * NC; const int c = act ? tid % NC : 0, half = act ? tid / NC : 0, h = c / DK, d = c - h * DK;
    float cum[32]; float tot = 0.f;
    float w2[16], b2 = 0.f, lbv = 0.f, lg = 0.f, sg = 0.f; int f = 0, d2 = 0;
    if (act) {
        if constexpr (TYPE == 0) { b2 = a.gla_ba2[layer * 192 + c];
#pragma unroll
            for (int r = 0; r < 16; ++r) w2[r] = a.gla_wa2[(layer * 16 + r) * 192 + c]; }
        if constexpr (TYPE == 1) lbv = ((const float*)(ws + WS_LB))[layer * 256 + c];
        if constexpr (TYPE == 2) { lg = ret_lg(h); f = (d < 24) ? d : d - 24; d2 = (d < 24) ? d + 24 : d - 24; sg = (d < 24) ? -1.f : 1.f; }
#pragma unroll
        for (int gq = 0; gq < 2; ++gq) {
            bf16 hraw[16];
            if constexpr (TYPE == 1) {
#pragma unroll
                for (int i = 0; i < 16; ++i) hraw[i] = PROJ[(size_t)(row0 + 32 * half + 16 * gq + i) * NPROJ + C_HF + c]; }
#pragma unroll
            for (int ii = 0; ii < 16; ++ii) { const int i = 16 * gq + ii, t = 32 * half + i; float g;
                if constexpr (TYPE == 0) { float pre = b2;
#pragma unroll
                    for (int r = 0; r < 16; ++r) pre += GAs[t * 16 + r] * w2[r];
                    g = fast_logsig(pre) * (1.0f / 16.0f); }
                else if constexpr (TYPE == 1) { const float hf = fminf(fmaxf(bf2f(hraw[ii]), -80.f), 80.f); const float sgm = __builtin_amdgcn_rcpf(1.0f + __expf(-hf));
                    g = __logf(lbv + (1.0f - lbv) * sgm); }
                else g = lg;
                tot += g; cum[i] = tot;
                if constexpr (TYPE == 0) { if ((ii & 3) == 3) asm volatile("" ::: "memory"); } } }
        TOT[c * 2 + half] = tot;
    }
    __syncthreads();
    if (act) { const float t0 = TOT[c * 2], t1 = TOT[c * 2 + 1]; const float off = half ? t0 : 0.f, last = t0 + t1;
#pragma unroll
        for (int hq = 0; hq < 4; ++hq) {
            bf16 ka[8], kb[8]; float cs[8], sn[8];
            if constexpr (TYPE != 1) {
#pragma unroll
                for (int i = 0; i < 8; ++i) { const size_t row = (size_t)(row0 + 32 * half + 8 * hq + i); const bf16* pr = PROJ + row * NPROJ;
                    if constexpr (TYPE == 0) ka[i] = pr[C_GK + c];
                    else { const float* rp = (const float*)(ws + WS_ROPE) + row * 48; ka[i] = pr[C_RK + h * 48 + d]; kb[i] = pr[C_RK + h * 48 + d2]; cs[i] = rp[f]; sn[i] = rp[24 + f]; } } }
            float kt[8];
#pragma unroll
            for (int j = 0; j < 8; ++j) { const int i = 8 * hq + j; const float cm = cum[i] + off; const size_t row = (size_t)(row0 + 32 * half + i); float k;
                if constexpr (TYPE == 0) k = bf2f(ka[j]);
                else if constexpr (TYPE == 1) k = 1.0f - __expf(cum[i] - (i > 0 ? cum[i - 1] : 0.f));
                else k = bf2f(ka[j]) * cs[j] + sg * bf2f(kb[j]) * sn[j];
                if constexpr (TYPE != 2) *(GAS bf16*)(F1 + row * NDV + C::COFF + c) = (bf16)f2bf(__expf(cm - ((i < 16) ? off : cum[15] + off)));
                { const float eb = cum[(i < 16) ? 15 : 31] + off;
                  ((LAS bf16*)(lds + LA_KTT))[(32 * half + i) * KTP + c] = (bf16)f2bf(k * __expf(eb - cm)); }
                kt[j] = k * __expf(last - cm); }
            v4u w; w.x = pk2(kt[0], kt[1]); w.y = pk2(kt[2], kt[3]); w.z = pk2(kt[4], kt[5]); w.w = pk2(kt[6], kt[7]);
            *(LAS v4u*)(KT + c * BP + 32 * half + 8 * hq) = w; }
        if (TYPE != 2) { *(GAS float*)(ECG + (2 * half + 0) * NDV + C::COFF + c) = cum[15] + off; *(GAS float*)(ECG + (2 * half + 1) * NDV + C::COFF + c) = cum[31] + off; }
        if (TYPE != 2 && half == 0) *(GAS float*)(DVEC + C::COFF + c) = __expf(last);
    }
    __syncthreads();
    { constexpr int CPR = NC / 8;
#pragma unroll
        for (int it = 0; it < (64 * CPR) / NTHR; ++it) { const int idx = tid + NTHR * it, t = idx / CPR, ch = idx - t * CPR;
            *(GAS v4u*)((bf16*)(ws + WS_KT) + (size_t)(row0 + t) * NKT + C::KOFF + 8 * ch) = *(const LAS v4u*)((const LAS bf16*)(lds + LA_KTT) + t * KTP + 8 * ch); } }
    constexpr int TD = DK / 16, NT = (DV / 16) * TD;
    for (int ti = wave; ti < 4 * NT; ti += NWAVES) { const int hh = ti / NT, tr = ti - hh * NT, te = tr / TD, td = tr - te * TD; f32x4 acc = {0.f, 0.f, 0.f, 0.f};
#pragma unroll
        for (int kk = 0; kk < 2; ++kk) acc = __builtin_amdgcn_mfma_f32_16x16x32_bf16(ldfrag(VT, BP, hh * DV + te * 16, kk * 32, lane), ldfrag(KT, BP, hh * DK + td * 16, kk * 32, lane), acc, 0, 0, 0);
        bf16* Uh = U + hh * DK * DV;
#pragma unroll
        for (int r = 0; r < 4; ++r) *(GAS bf16*)(Uh + (te * 16 + (lane >> 4) * 4 + r) * DK + td * 16 + (lane & 15)) = (bf16)f2bf(acc[r]); }
    __syncthreads();
}
__device__ __forceinline__ void p3a_summaries(const Args& a, int layer, LAS unsigned char* lds, int vcu, int G, int tid, int lane, int wave) {
    for (int unit = vcu; unit < NUNIT; unit += G) {
        { LAS float* GAs = (LAS float*)(lds + LA_GA); const float* GA = (const float*)(a.ws + WS_GA); for (int i = tid; i < CH * 16; i += NTHR) GAs[i] = GA[(size_t)unit * CH * 16 + i]; }
        __syncthreads();
        mixa_batch<0>(a, layer, unit, lds, tid, lane, wave);
        mixa_batch<1>(a, layer, unit, lds, tid, lane, wave);
        mixa_batch<2>(a, layer, unit, lds, tid, lane, wave);
    }
}

__device__ __forceinline__ void p3b_scan(const Args& a, int vcu, int G, int tid) {
    unsigned char* ws = a.ws; const bf16* U = (const bf16*)(ws + WS_U); const float* DVEC = (const float*)(ws + WS_DVEC); bf16* SP = (bf16*)(ws + WS_SP);
    for (int gid = vcu * NTHR + tid; gid < BATCH * ST_TOT; gid += G * NTHR) {
        const int b = gid / ST_TOT, el = gid - b * ST_TOT;
        int di = -1; float cdec = 0.f;
        if (el < ST_HG) { const int h = el / 4608, d = (el - h * 4608) % 48; di = h * 48 + d; }
        else if (el < ST_RET) { const int r = el - ST_HG, h = r / 4096, d = r % 64; di = 192 + h * 64 + d; }
        else { const int h = (el - ST_RET) / 4608; cdec = expf(64.0f * logf(1.0f - exp2f(-5.0f - (float)h))); }
        const bf16* up = U + (size_t)b * NCH * ST_TOT + el; const float* dp = DVEC + (size_t)b * NCH * NDV + (di < 0 ? 0 : di); bf16* sp = SP + (size_t)b * NCH * ST_TOT + el;
        float s = 0.f;
#pragma unroll 1
        for (int n0 = 0; n0 < NCH; n0 += 32) { float u[32], dc[32];
#pragma unroll
            for (int i = 0; i < 32; ++i) { u[i] = bf2f(up[(size_t)(n0 + i) * ST_TOT]); dc[i] = (di < 0) ? cdec : dp[(size_t)(n0 + i) * NDV]; }
#pragma unroll
            for (int i = 0; i < 32; ++i) { *(GAS bf16*)(sp + (size_t)(n0 + i) * ST_TOT) = (bf16)f2bf(s); s = dc[i] * s + u[i]; } }
    }
}

#ifndef SUB_MASK
#define SUB_MASK 0
#endif
#define SUBSTRETCH(bit, t0_) do { if ((SUB_MASK >> (bit)) & 1) { const unsigned long long t1_ = __builtin_amdgcn_s_memrealtime(); while (__builtin_amdgcn_s_memrealtime() - t1_ < t1_ - (t0_)) __builtin_amdgcn_s_sleep(8); } } while (0)
constexpr int LC_VT = 0, LC_ST = 55296, LC_AB = 110592, OBP = 104, LC_EC = 137216;
template <int TYPE, bool ISQ>
__device__ __forceinline__ void mix_frag(const Args& a, int h, size_t row, int t, int d0, float (&x)[8], float (&cm)[8]) {
    typedef MixCfg<TYPE> C; constexpr int DK = C::DK; static_assert(ISQ, "query path only");
    unsigned char* ws = a.ws; const bf16* pr = (const bf16*)(ws + WS_PROJ) + row * NPROJ;
    if constexpr (TYPE != 2) {
        const v4u p = *(const v4u*)(pr + C::CQ + h * DK + d0); const unsigned pw[4] = {p.x, p.y, p.z, p.w};
        const v4u f = *(const v4u*)((const bf16*)(ws + WS_CUM) + row * NDV + C::COFF + h * DK + d0); const unsigned fw[4] = {f.x, f.y, f.z, f.w};
#pragma unroll
        for (int j = 0; j < 4; ++j) { x[2 * j] = __builtin_bit_cast(float, pw[j] << 16); x[2 * j + 1] = __builtin_bit_cast(float, pw[j] & 0xffff0000u); cm[2 * j] = __builtin_bit_cast(float, fw[j] << 16); cm[2 * j + 1] = __builtin_bit_cast(float, fw[j] & 0xffff0000u); }
        if constexpr (TYPE == 0) {
#pragma unroll
            for (int j = 0; j < 8; ++j) x[j] *= 0.14433756729740643f; }
    } else {
        const int f0 = (d0 < 24) ? d0 : d0 - 24, dp = (d0 < 24) ? d0 + 24 : d0 - 24; const float sg = (d0 < 24) ? -1.f : 1.f;
        const int cb = C_RQ + h * DK; const v4u p = *(const v4u*)(pr + cb + d0), pp = *(const v4u*)(pr + cb + dp); const unsigned pw[4] = {p.x, p.y, p.z, p.w}, qw[4] = {pp.x, pp.y, pp.z, pp.w};
        const float* rp = (const float*)(ws + WS_ROPE) + row * 48; const f32x4 cs0 = *(const f32x4*)(rp + f0), cs1 = *(const f32x4*)(rp + f0 + 4), sn0 = *(const f32x4*)(rp + 24 + f0), sn1 = *(const f32x4*)(rp + 24 + f0 + 4);
        const float cmv = (float)(t + 1) * ret_lg(h);
#pragma unroll
        for (int j = 0; j < 4; ++j) { const float xa = __builtin_bit_cast(float, pw[j] << 16), xb = __builtin_bit_cast(float, pw[j] & 0xffff0000u), ya = __builtin_bit_cast(float, qw[j] << 16), yb = __builtin_bit_cast(float, qw[j] & 0xffff0000u);
            const float ca = (j < 2) ? cs0[2 * j] : cs1[2 * j - 4], cb2 = (j < 2) ? cs0[2 * j + 1] : cs1[2 * j - 3], sa = (j < 2) ? sn0[2 * j] : sn1[2 * j - 4], sb = (j < 2) ? sn0[2 * j + 1] : sn1[2 * j - 3];
            x[2 * j] = (xa * ca + sg * ya * sa) * 0.14433756729740643f; x[2 * j + 1] = (xb * cb2 + sg * yb * sb) * 0.14433756729740643f; cm[2 * j] = cmv; cm[2 * j + 1] = cmv; }
    }
}

template <int TYPE>
__device__ __forceinline__ void mixc_batch(const Args& a, int layer, int unit, LAS unsigned char* lds, int tid, int lane, int wave) {
    asm volatile("" : "+v"(tid), "+v"(lane));
    typedef MixCfg<TYPE> C; constexpr int DK = C::DK, DV = C::DV, NV = C::NV, TE = DV / 16;
    unsigned char* ws = a.ws; const bf16* PROJ = (const bf16*)(ws + WS_PROJ); bf16* MIX = (bf16*)(ws + WS_MIX);
    LAS bf16* VT = (LAS bf16*)(lds + LC_VT); LAS bf16* ST = (LAS bf16*)(lds + LC_ST); LAS bf16* AB = (LAS bf16*)(lds + LC_AB) + wave * 16 * OBP;
    const int row0 = unit * CH;
    const unsigned long long ts0_ = SUB_MASK ? __builtin_amdgcn_s_memrealtime() : 0ull;
    stage_vt<NV>(PROJ + (size_t)row0 * NPROJ + C::CV, VT, tid);
    SUBSTRETCH(3, ts0_);
    const unsigned long long ts3_ = SUB_MASK ? __builtin_amdgcn_s_memrealtime() : 0ull;
    { const bf16* SPu = (const bf16*)(ws + WS_SP) + (size_t)unit * ST_TOT + C::STOFF;
        constexpr int NIS = (NV * 8) / NTHR; static_assert((NV * 8) % NTHR == 0, "ST staging"); v4u sw[NIS];
#pragma unroll
        for (int it = 0; it < NIS; ++it) { const int idx = tid + NTHR * it, er = idx >> 3, ch = idx & 7; sw[it] = (v4u){0u, 0u, 0u, 0u}; if (ch * 8 < DK) sw[it] = *(const v4u*)(SPu + (size_t)er * DK + ch * 8); }
#pragma unroll
        for (int it = 0; it < NIS; ++it) { const int idx = tid + NTHR * it, er = idx >> 3, ch = idx & 7; *(LAS v4u*)(ST + er * BP + ch * 8) = sw[it]; } }
    SUBSTRETCH(4, ts3_);
    SUBSTRETCH(0, ts0_);
    if constexpr (TYPE != 2) { LAS float* EC = (LAS float*)(lds + LC_EC);
        for (int idx = tid; idx < 4 * C::NC; idx += NTHR) { const int jb = idx / C::NC, cc = idx - jb * C::NC; EC[jb * 256 + cc] = ((const float*)(ws + WS_CUM + 16 * MiB))[((size_t)unit * 4 + jb) * NDV + C::COFF + cc]; } }
    __syncthreads();
    const unsigned long long ts1_ = SUB_MASK ? __builtin_amdgcn_s_memrealtime() : 0ull;
    const int h = wave >> 1, hsel = wave & 1, r = lane & 15, g = lane >> 4;
    const LAS bf16* STh = ST + h * DV * BP; const LAS bf16* VTh = VT + h * DV * BP;
    constexpr int NCHK = DV / 8, NOC = (16 * NCHK) / 64;
#pragma unroll 1
    for (int ib = 0; ib < 2; ++ib) { const int I = ib ? 3 - hsel : hsel;
        pg8::bf16x8 qh[2], qt[2]; float refv[2][8], qhf[2][8];
#pragma unroll
        for (int s = 0; s < 2; ++s) { const int d0 = 32 * s + 8 * g; const bool valid = d0 < DK; const int d0c = valid ? d0 : 0;
            float x[8], cm[8]; mix_frag<TYPE, true>(a, h, (size_t)(row0 + 16 * I + r), 16 * I + r, d0c, x, cm);
            if constexpr (TYPE == 2) {
#pragma unroll
                for (int j = 0; j < 8; ++j) refv[s][j] = (float)(16 * I) * ret_lg(h);
            } else { if (I > 0) { const LAS float* cp = (const LAS float*)(lds + LC_EC) + (I - 1) * 256 + h * DK + d0c; const f32x4 c0 = *(const LAS f32x4*)cp, c1 = *(const LAS f32x4*)(cp + 4);
#pragma unroll
                    for (int j = 0; j < 4; ++j) { refv[s][j] = c0[j]; refv[s][4 + j] = c1[j]; } }
                else {
#pragma unroll
                    for (int j = 0; j < 8; ++j) refv[s][j] = 0.f; } }
            float xt[8];
#pragma unroll
            for (int j = 0; j < 8; ++j) { if constexpr (TYPE == 2) { qhf[s][j] = valid ? x[j] * __expf(cm[j] - refv[s][j]) : 0.f; xt[j] = valid ? x[j] * __expf(cm[j]) : 0.f; }
                else { qhf[s][j] = valid ? x[j] * cm[j] : 0.f; xt[j] = qhf[s][j] * __expf(refv[s][j]); } }
            qh[s] = pack8(qhf[s]); qt[s] = pack8(xt); }
        v4u kf[4][2];
#pragma unroll
        for (int J = 0; J < 4; ++J) { const int Jc = (J < I) ? J : I; const size_t rowJ = (size_t)(row0 + 16 * Jc + r);
#pragma unroll
            for (int s = 0; s < 2; ++s) { const int d0 = 32 * s + 8 * g; const int d0c = (d0 < DK) ? d0 : 0;
                kf[J][s] = *(const v4u*)((const bf16*)(ws + WS_KT) + rowJ * NKT + C::KOFF + h * DK + d0c); } }
#pragma unroll
        for (int J = 0; J < 4; ++J) { if (J <= I) { f32x4 acc = {0.f, 0.f, 0.f, 0.f};
#pragma unroll
            for (int s = 0; s < 2; ++s) { pg8::bf16x8 qop;
                { float xq[8], ej[8]; const int d0 = 32 * s + 8 * g; const int d0c = (d0 < DK) ? d0 : 0;
                    if constexpr (TYPE == 2) {
#pragma unroll
                        for (int j = 0; j < 8; ++j) ej[j] = (float)(16 * (J + 1)) * ret_lg(h); }
                    else { const LAS float* ep = (const LAS float*)(lds + LC_EC) + J * 256 + h * DK + d0c; const f32x4 e0 = *(const LAS f32x4*)ep, e1 = *(const LAS f32x4*)(ep + 4);
#pragma unroll
                        for (int j = 0; j < 4; ++j) { ej[j] = e0[j]; ej[4 + j] = e1[j]; } }
#pragma unroll
                    for (int j = 0; j < 8; ++j) xq[j] = qhf[s][j] * __expf(fminf(refv[s][j] - ej[j], 80.f));
                    qop = pack8(xq); }
                acc = __builtin_amdgcn_mfma_f32_16x16x32_bf16(qop, __builtin_bit_cast(pg8::bf16x8, kf[J][s]), acc, 0, 0, 0); }
#pragma unroll
            for (int q = 0; q < 4; ++q) { const int i = 4 * g + q; const float v = (J < I || r <= i) ? acc[q] : 0.f; AB[i * BP + 16 * J + r] = (bf16)f2bf(v); } } }
        if ((I & 1) == 0) {
#pragma unroll
            for (int q = 0; q < 4; ++q) AB[(4 * g + q) * BP + 16 * (I + 1) + r] = (bf16)0; }
        asm volatile("s_waitcnt lgkmcnt(0)" ::: "memory");
        const pg8::bf16x8 ah0 = *(const LAS pg8::bf16x8*)(AB + r * BP + 8 * g), ah1 = *(const LAS pg8::bf16x8*)(AB + r * BP + 32 + 8 * g);
        f32x4 o[TE];
#pragma unroll
        for (int te = 0; te < TE; ++te) { f32x4 acc = {0.f, 0.f, 0.f, 0.f};
            acc = __builtin_amdgcn_mfma_f32_16x16x32_bf16(qt[0], ldfrag(STh, BP, te * 16, 0, lane), acc, 0, 0, 0);
            acc = __builtin_amdgcn_mfma_f32_16x16x32_bf16(qt[1], ldfrag(STh, BP, te * 16, 32, lane), acc, 0, 0, 0);
            acc = __builtin_amdgcn_mfma_f32_16x16x32_bf16(ah0, ldfrag(VTh, BP, te * 16, 0, lane), acc, 0, 0, 0);
            if (I >= 2) acc = __builtin_amdgcn_mfma_f32_16x16x32_bf16(ah1, ldfrag(VTh, BP, te * 16, 32, lane), acc, 0, 0, 0);
            o[te] = acc; }
        const unsigned long long ts2_ = SUB_MASK ? __builtin_amdgcn_s_memrealtime() : 0ull;
#pragma unroll
        for (int q = 0; q < 4; ++q) { float s1 = 0.f, s2 = 0.f;
#pragma unroll
            for (int te = 0; te < TE; ++te) { s1 += o[te][q]; s2 += o[te][q] * o[te][q]; }
#pragma unroll
            for (int m = 1; m < 16; m <<= 1) { s1 += __shfl_xor(s1, m); s2 += __shfl_xor(s2, m); }
            float mean = 0.f, rstd;
            if constexpr (TYPE == 2) { mean = s1 * (1.0f / DV); rstd = __builtin_amdgcn_rsqf(fmaxf(s2 * (1.0f / DV) - mean * mean, 0.f) + EPS); }
            else rstd = __builtin_amdgcn_rsqf(s2 * (1.0f / DV) + EPS);
#pragma unroll
            for (int te = 0; te < TE; ++te) AB[(4 * g + q) * OBP + te * 16 + r] = (bf16)f2bf((o[te][q] - mean) * rstd); }
        asm volatile("s_waitcnt lgkmcnt(0)" ::: "memory");
#pragma unroll 1
        for (int i = 0; i < NOC; ++i) { const int cidx = lane + 64 * i, orow = cidx / NCHK, ch = cidx - orow * NCHK; const size_t row = (size_t)(row0 + 16 * I + orow);
            const v4u ov = *(const LAS v4u*)(AB + orow * OBP + 8 * ch); const v4u gv = *(const v4u*)(PROJ + row * NPROJ + C::CG + h * DV + 8 * ch);
            const unsigned ow[4] = {ov.x, ov.y, ov.z, ov.w}, gw[4] = {gv.x, gv.y, gv.z, gv.w}; float res[8];
            f32x4 w0 = {1.f, 1.f, 1.f, 1.f}, w1 = {1.f, 1.f, 1.f, 1.f};
            if constexpr (TYPE == 0) { const float* wp = a.gla_norm_w + layer * 384 + h * 96 + 8 * ch; w0 = *(const f32x4*)wp; w1 = *(const f32x4*)(wp + 4); }
            if constexpr (TYPE == 1) { const float* wp = a.hg_norm_w + layer * 256 + h * 64 + 8 * ch; w0 = *(const f32x4*)wp; w1 = *(const f32x4*)(wp + 4); }
#pragma unroll
            for (int j = 0; j < 4; ++j) { const float oa = __builtin_bit_cast(float, ow[j] << 16), ob = __builtin_bit_cast(float, ow[j] & 0xffff0000u), ga = __builtin_bit_cast(float, gw[j] << 16), gb = __builtin_bit_cast(float, gw[j] & 0xffff0000u);
                const float wa = (j < 2) ? w0[2 * j] : w1[2 * j - 4], wb = (j < 2) ? w0[2 * j + 1] : w1[2 * j - 3];
                const float sa = __builtin_amdgcn_rcpf(1.0f + __expf(-ga)), sb = __builtin_amdgcn_rcpf(1.0f + __expf(-gb));
                res[2 * j] = oa * wa * ((TYPE == 1) ? sa : ga * sa); res[2 * j + 1] = ob * wb * ((TYPE == 1) ? sb : gb * sb); }
            if (F8_OUT) { typedef int i32x2 __attribute__((ext_vector_type(2)));
                *(GAS i32x2*)((unsigned char*)MIX + row * D + C::MIXOFF + h * DV + 8 * ch) = (i32x2){pk4_fp8(res[0] * S8_M, res[1] * S8_M, res[2] * S8_M, res[3] * S8_M), pk4_fp8(res[4] * S8_M, res[5] * S8_M, res[6] * S8_M, res[7] * S8_M)}; }
            else { v4u w; w.x = pk2(res[0], res[1]); w.y = pk2(res[2], res[3]); w.z = pk2(res[4], res[5]); w.w = pk2(res[6], res[7]); *(GAS v4u*)(MIX + row * D + C::MIXOFF + h * DV + 8 * ch) = w; } }
        SUBSTRETCH(2, ts2_);
    }
    SUBSTRETCH(1, ts1_);
    __syncthreads();
}
__device__ __forceinline__ void p3c_outputs(const Args& a, int layer, LAS unsigned char* lds, int vcu, int G, int tid, int lane, int wave) {
    for (int unit = vcu; unit < NUNIT; unit += G) {
        mixc_batch<0>(a, layer, unit, lds, tid, lane, wave);
        mixc_batch<1>(a, layer, unit, lds, tid, lane, wave);
        mixc_batch<2>(a, layer, unit, lds, tid, lane, wave);
    }
}


constexpr int MW_ARGS = 800;
__device__ __forceinline__ const void* ld_argp(const volatile LAS unsigned* T, int i) {
    const unsigned lo = __builtin_amdgcn_readfirstlane(T[2 * i]), hi = __builtin_amdgcn_readfirstlane(T[2 * i + 1]);
    return (const void*)(((unsigned long long)hi << 32) | lo);
}
__device__ __forceinline__ Args load_args(LAS unsigned char* lds) {
    const volatile LAS unsigned* T = (const volatile LAS unsigned*)(lds + MISC_OFF) + MW_ARGS;
    Args a;
    a.x = (const float*)ld_argp(T, 0); a.c = (const float*)ld_argp(T, 1); a.pos = (const int*)ld_argp(T, 2); a.w_mod = (const float*)ld_argp(T, 3); a.b_mod = (const float*)ld_argp(T, 4);
    a.norm1_w = (const float*)ld_argp(T, 5); a.w_in = (const float*)ld_argp(T, 6); a.gla_wa2 = (const float*)ld_argp(T, 7); a.gla_ba2 = (const float*)ld_argp(T, 8); a.hg_lb = (const float*)ld_argp(T, 9);
    a.gla_norm_w = (const float*)ld_argp(T, 10); a.hg_norm_w = (const float*)ld_argp(T, 11); a.w_out = (const float*)ld_argp(T, 12); a.norm2_w = (const float*)ld_argp(T, 13); a.w_r = (const float*)ld_argp(T, 14);
    a.b_r = (const float*)ld_argp(T, 15); a.w_gu = (const float*)ld_argp(T, 16); a.b_gu = (const float*)ld_argp(T, 17); a.w_dn = (const float*)ld_argp(T, 18); a.b_dn = (const float*)ld_argp(T, 19);
    a.final_norm_w = (const float*)ld_argp(T, 20); a.out = (float*)ld_argp(T, 21); a.ws = (unsigned char*)ld_argp(T, 22); a.ph_lo = 0; a.ph_hi = 0;
    return a;
}
#define PH_CTX() { unsigned l_ = (unsigned)(size_t)lds; asm volatile("" : "+s"(l_)); lds = (LAS unsigned char*)(size_t)l_; } const Args args = load_args(lds); volatile LAS unsigned* MISC = (volatile LAS unsigned*)(lds + MISC_OFF); int tid_ = wv * 64 + (int)__builtin_amdgcn_mbcnt_hi(~0u, __builtin_amdgcn_mbcnt_lo(~0u, 0u)); asm volatile("" : "+v"(tid_)); const int tid = tid_, lane = tid & 63, wave = __builtin_amdgcn_readfirstlane(tid >> 6); \
    const int G = gridDim.x; const int bx = blockIdx.x; const int vcu = (G % 8 == 0) ? (bx % 8) * (G / 8) + bx / 8 : bx; unsigned char* ws = args.ws; gu32* ctl = (gu32*)(ws + WS_CTL); \
    (void)MISC; (void)lane; (void)wave; (void)vcu; (void)ctl; (void)bx; (void)tid
__device__ __forceinline__ void ph_p0(LAS unsigned char* lds, int wv) { PH_CTX(); p0_prologue(args, lds, vcu, G, tid, lane, wave); }
__device__ __forceinline__ void ph_p1(LAS unsigned char* lds, int wv, int layer_) { int layer = __builtin_amdgcn_readfirstlane(layer_); asm volatile("" : "+s"(layer)); PH_CTX();
    if (layer > 0) { moe_tables(ctl, layer - 1, MISC, tid); const int nrt = __builtin_amdgcn_readfirstlane((int)MISC[MW_NRT]);
        const int done = conv_t2(G) + conv_idle(nrt * 8, G) * NWAVES * CB7 + conv_idle(nrt * 4, G) * NWAVES * CB8; LAS float* scr = (LAS float*)(lds + wave * 16640);
        for (int it = done + vcu * NWAVES + wave; it < IT_LAYER; it += G * NWAVES) convert_item(args, layer, it, scr, lane);
        __syncthreads(); }
    rows_mfma<16>(args, layer, lds, MISC, ctl, vcu, G, tid, lane, wave); }
__device__ __forceinline__ void ph_p2(LAS unsigned char* lds, int wv, int layer_) { int layer = __builtin_amdgcn_readfirstlane(layer_); asm volatile("" : "+s"(layer)); PH_CTX();
    pg8::Gemm g{(const bf16*)(ws + WS_H), (const bf16*)(ws + WS_WIN + (size_t)layer * NPROJ * D * (F8_IN ? 1 : 2)), MTOK, NPROJ, F8_IN ? D / 2 : D}; pg8::StaticOrder S; S.init(MTOK, NPROJ, G, bx);
    pg8::EpiBf16Plain E{(bf16*)(ws + WS_PROJ), NPROJ, F8_IN ? 1.0f / (S8_H * S8_W) : 1.0f};
    pg8::gemm_phase<pg8::EpiBf16Plain, pg8::StaticOrder, true, true, F8_IN>(lds, g, S, E, tid);
    if (layer + 1 < DEPTH && G == 256 && bx >= 64) convert_range(args, layer + 1, ((bx - 64) * NWAVES + wave) * CB2, CB2, lds, lane, wave); }
__device__ __forceinline__ void ph_p3a(LAS unsigned char* lds, int wv, int layer_) { int layer = __builtin_amdgcn_readfirstlane(layer_); asm volatile("" : "+s"(layer)); PH_CTX(); p3a_summaries(args, layer, lds, vcu, G, tid, lane, wave); }
__device__ __forceinline__ void ph_p3b(LAS unsigned char* lds, int wv) { PH_CTX(); p3b_scan(args, vcu, G, tid); }
__device__ __forceinline__ void ph_p3c(LAS unsigned char* lds, int wv, int layer_) { int layer = __builtin_amdgcn_readfirstlane(layer_); asm volatile("" : "+s"(layer)); PH_CTX(); p3c_outputs(args, layer, lds, vcu, G, tid, lane, wave); }
__device__ __forceinline__ void ph_p4(LAS unsigned char* lds, int wv, int layer_) { int layer = __builtin_amdgcn_readfirstlane(layer_); asm volatile("" : "+s"(layer)); PH_CTX();
    pg8::Gemm g{(const bf16*)(ws + WS_MIX), (const bf16*)(ws + WS_WOUT + (size_t)layer * D * D * (F8_OUT ? 1 : 2)), MTOK, D, F8_OUT ? D / 2 : D}; pg8::StaticOrder S; S.init(MTOK, D, G, bx);
    pg8::EpiResGate E{(const bf16*)(ws + WS_X), (bf16*)(ws + WS_X), D, (const float*)(ws + WS_MOD) + (size_t)layer * 2 * 6144 + 2 * D, 6144, SEQ, F8_OUT ? 1.0f / (S8_M * S8_W) : 1.0f};
    pg8::gemm_phase<pg8::EpiResGate, pg8::StaticOrder, true, true, F8_OUT>(lds, g, S, E, tid); }
__device__ __forceinline__ void ph_p5(LAS unsigned char* lds, int wv, int layer_) { int layer = __builtin_amdgcn_readfirstlane(layer_); asm volatile("" : "+s"(layer)); PH_CTX(); rows_mfma<32>(args, layer, lds, MISC, ctl, vcu, G, tid, lane, wave); }
__device__ __forceinline__ void ph_p7(LAS unsigned char* lds, int wv, int layer_) { int layer = __builtin_amdgcn_readfirstlane(layer_); asm volatile("" : "+s"(layer)); PH_CTX();
    moe_tables(ctl, layer, MISC, tid);
    const int nrt = __builtin_amdgcn_readfirstlane((int)MISC[MW_NRT]);
    pg8::Gemm g{(const bf16*)(ws + WS_A1), (const bf16*)(ws + WS_WGU + (size_t)layer * NE * 2048 * D), nrt * 256, NE * 2048, D / 2};
    pg8::MoeOrder S{8, G, vcu, nrt * 8, (const LAS int*)(lds + MISC_OFF + 4 * MW_TILE)};
    pg8::EpiSwiglu E{ws + WS_ACT, FFN, args.b_gu + (size_t)layer * NE * 2048, 1.0f / (S8_H * S8_W), S8_A};
    pg8::gemm_phase<pg8::EpiSwiglu, pg8::MoeOrder, true, true, true>(lds, g, S, E, tid);
    { const int rem = (nrt * 8) % G; if (layer + 1 < DEPTH && rem != 0 && vcu >= rem) convert_range(args, layer + 1, conv_t2(G) + ((vcu - rem) * NWAVES + wave) * CB7, CB7, lds, lane, wave); } }
__device__ __forceinline__ void ph_p8(LAS unsigned char* lds, int wv, int layer_) { int layer = __builtin_amdgcn_readfirstlane(layer_); asm volatile("" : "+s"(layer)); PH_CTX();
    moe_tables(ctl, layer, MISC, tid);
    const int nrt = __builtin_amdgcn_readfirstlane((int)MISC[MW_NRT]);
    pg8::Gemm g{(const bf16*)(ws + WS_ACT), (const bf16*)(ws + WS_WDN + (size_t)layer * NE * D * FFN), nrt * 256, NE * D, FFN / 2};
    pg8::MoeOrder S{4, G, vcu, nrt * 4, (const LAS int*)(lds + MISC_OFF + 4 * MW_TILE)};
    if constexpr (Y8) { pg8::EpiFp8Bias E{ws + WS_Y, D, args.b_dn + (size_t)layer * NE * D, D, 1.0f / (S8_A * S8_W), S8_Y};
        pg8::gemm_phase<pg8::EpiFp8Bias, pg8::MoeOrder, true, true, true>(lds, g, S, E, tid); }
    else { pg8::EpiBf16Bias E{(bf16*)(ws + WS_Y), D, args.b_dn + (size_t)layer * NE * D, D, 1.0f / (S8_A * S8_W)};
        pg8::gemm_phase<pg8::EpiBf16Bias, pg8::MoeOrder, true, true, true>(lds, g, S, E, tid); }
    { const int rem = (nrt * 4) % G; if (layer + 1 < DEPTH && rem != 0 && vcu >= rem) convert_range(args, layer + 1, conv_t2(G) + conv_idle(nrt * 8, G) * NWAVES * CB7 + ((vcu - rem) * NWAVES + wave) * CB8, CB8, lds, lane, wave); } }
__device__ __forceinline__ void ph_final(LAS unsigned char* lds, int wv) { PH_CTX(); final_rows(args, lds, vcu, G, tid, lane); }

#ifndef DBL_MASK
#define DBL_MASK 0
#endif
#if DBL_MASK
#define RUN(bit, call) do { if ((DBL_MASK >> (bit)) & 1) { const unsigned long long t0_ = __builtin_amdgcn_s_memrealtime(); call; const unsigned long long t1_ = __builtin_amdgcn_s_memrealtime(); \
        while (__builtin_amdgcn_s_memrealtime() - t1_ < t1_ - t0_) __builtin_amdgcn_s_sleep(8); } else { call; } } while (0)
#else
#define RUN(bit, call) do { call; } while (0)
#endif
__global__ void __launch_bounds__(NTHR, 2) hybrid_fwd(Args args) {
    extern __shared__ __attribute__((aligned(16))) unsigned char lds_raw[];
    LAS unsigned char* lds = (LAS unsigned char*)lds_raw;
    volatile LAS unsigned* MISC = (volatile LAS unsigned*)(lds + MISC_OFF);
    const int tid = threadIdx.x; const int wv = __builtin_amdgcn_readfirstlane(tid >> 6);
    gu32* ctl = (gu32*)(args.ws + WS_CTL);
    for (int u = tid; u < (LDS_BYTES - MISC_OFF) / 4; u += NTHR) MISC[u] = 0u;
    __syncthreads();
    if (tid == 0) {
#define ST_ARG(i, p) do { const unsigned long long v_ = (unsigned long long)(p); MISC[MW_ARGS + 2 * (i)] = (unsigned)v_; MISC[MW_ARGS + 2 * (i) + 1] = (unsigned)(v_ >> 32); } while (0)
        ST_ARG(0, args.x); ST_ARG(1, args.c); ST_ARG(2, args.pos); ST_ARG(3, args.w_mod); ST_ARG(4, args.b_mod); ST_ARG(5, args.norm1_w); ST_ARG(6, args.w_in); ST_ARG(7, args.gla_wa2); ST_ARG(8, args.gla_ba2);
        ST_ARG(9, args.hg_lb); ST_ARG(10, args.gla_norm_w); ST_ARG(11, args.hg_norm_w); ST_ARG(12, args.w_out); ST_ARG(13, args.norm2_w); ST_ARG(14, args.w_r); ST_ARG(15, args.b_r); ST_ARG(16, args.w_gu);
        ST_ARG(17, args.b_gu); ST_ARG(18, args.w_dn); ST_ARG(19, args.b_dn); ST_ARG(20, args.final_norm_w); ST_ARG(21, args.out); ST_ARG(22, args.ws);
#undef ST_ARG
    }
    __syncthreads();
    const int lo = args.ph_lo, hi = args.ph_hi;
    const bool multi = (hi - lo) > 1;
    XcdBarrier bar; bar.bar = (unsigned*)(ctl + CW_BAR); bar.x = 0; bar.st = nullptr;
    if (multi) bar = xcd_barrier_post((unsigned*)(ctl + CW_BAR), MISC + MW_BAR);
#define IN(k) (lo <= (k) && (k) < hi)
#define SEAM(k) do { if (IN(k) && IN((k) + 1)) xcd_barrier(bar); } while (0)

    if (IN(0)) RUN(0, ph_p0(lds, wv));
    SEAM(0);
    for (int layer = 0; layer < DEPTH; ++layer) {
        const int pb = 1 + 9 * layer;
        if (IN(pb + 0)) RUN(1, ph_p1(lds, wv, layer));
        SEAM(pb + 0);
        if (IN(pb + 1)) RUN(2, ph_p2(lds, wv, layer));
        SEAM(pb + 1);
        if (IN(pb + 2)) RUN(3, ph_p3a(lds, wv, layer));
        SEAM(pb + 2);
        if (IN(pb + 3)) RUN(4, ph_p3b(lds, wv));
        SEAM(pb + 3);
        if (IN(pb + 4)) RUN(5, ph_p3c(lds, wv, layer));
        SEAM(pb + 4);
        if (IN(pb + 5)) RUN(6, ph_p4(lds, wv, layer));
        SEAM(pb + 5);
        if (IN(pb + 6)) RUN(7, ph_p5(lds, wv, layer));
        SEAM(pb + 6);
        if (IN(pb + 7)) RUN(9, ph_p7(lds, wv, layer));
        SEAM(pb + 7);
        if (IN(pb + 8)) RUN(10, ph_p8(lds, wv, layer));
        SEAM(pb + 8);
    }
    if (IN(NPHASE - 1)) RUN(11, ph_final(lds, wv));
#undef IN
#undef SEAM
}

#ifndef MK_SINGLE
#define MK_SINGLE 1
#endif
extern "C" void kernel_launch(void* const* d_in, const int* in_sizes, int n_in, void* d_out, int out_size, void* d_ws, size_t ws_size, hipStream_t stream) {
    static int grid = 0;
    if (grid == 0) {
        if (n_in != 21 || in_sizes[0] != MTOK * D || out_size != MTOK * D || ws_size < WS_END) { fprintf(stderr, "kernel_launch: unexpected problem shape (n_in %d, in0 %d, out %d, ws %zu)\n", n_in, n_in > 0 ? in_sizes[0] : -1, out_size, ws_size); grid = -1; return; }
        int dev = 0, cus = 0, per_cu = 0;
        if (hipGetDevice(&dev) != hipSuccess || hipDeviceGetAttribute(&cus, hipDeviceAttributeMultiprocessorCount, dev) != hipSuccess) { grid = -1; return; }
        if (hipFuncSetAttribute((const void*)hybrid_fwd, hipFuncAttributeMaxDynamicSharedMemorySize, LDS_BYTES) != hipSuccess) { fprintf(stderr, "kernel_launch: hipFuncSetAttribute failed\n"); grid = -1; return; }
        if (hipOccupancyMaxActiveBlocksPerMultiprocessor(&per_cu, (const void*)hybrid_fwd, NTHR, LDS_BYTES) != hipSuccess || per_cu < 1) fprintf(stderr, "kernel_launch: occupancy query says %d\n", per_cu);
        (void)hipGetLastError();
        grid = cus;
    }
    if (grid < 0) return;
    (void)hipMemsetAsync((char*)d_ws + WS_CTL, 0, CTL_ZERO_BYTES, stream);
    Args a{};
    a.x = (const float*)d_in[0]; a.c = (const float*)d_in[1]; a.pos = (const int*)d_in[2]; a.w_mod = (const float*)d_in[3]; a.b_mod = (const float*)d_in[4]; a.norm1_w = (const float*)d_in[5];
    a.w_in = (const float*)d_in[6]; a.gla_wa2 = (const float*)d_in[7]; a.gla_ba2 = (const float*)d_in[8]; a.hg_lb = (const float*)d_in[9]; a.gla_norm_w = (const float*)d_in[10]; a.hg_norm_w = (const float*)d_in[11];
    a.w_out = (const float*)d_in[12]; a.norm2_w = (const float*)d_in[13]; a.w_r = (const float*)d_in[14]; a.b_r = (const float*)d_in[15]; a.w_gu = (const float*)d_in[16]; a.b_gu = (const float*)d_in[17];
    a.w_dn = (const float*)d_in[18]; a.b_dn = (const float*)d_in[19]; a.final_norm_w = (const float*)d_in[20]; a.out = (float*)d_out; a.ws = (unsigned char*)d_ws;
#if MK_SINGLE
    a.ph_lo = 0; a.ph_hi = NPHASE;
    hipLaunchKernelGGL(hybrid_fwd, dim3(grid), dim3(NTHR), LDS_BYTES, stream, a);
#else
    for (int p = 0; p < NPHASE; ++p) { a.ph_lo = p; a.ph_hi = p + 1; hipLaunchKernelGGL(hybrid_fwd, dim3(grid), dim3(NTHR), LDS_BYTES, stream, a); }
#endif
}
```

```cpp
#include <hip/hip_runtime.h>
#include <cstdio>
#include <cstdint>
namespace pg8 {
#define PG8_LAS __attribute__((address_space(3)))
typedef unsigned short bf16_t;
typedef short bf16x8 __attribute__((ext_vector_type(8)));
typedef float f32x4 __attribute__((ext_vector_type(4)));
typedef unsigned u32x4 __attribute__((ext_vector_type(4)));
constexpr int BM = 256, BK = 64, HALF = 128, HTB = HALF * BK * 2  , STAGE_BYTES = 8 * HTB, NXCD = 8, WGM = 8;

__host__ __device__ __forceinline__ int lds_byte(int r, int c) { const int st = (r >> 4) * 2 + (c >> 5), rr = r & 15, cc = c & 31, ob = rr * 64 + cc * 2; return st * 1024 + (ob ^ (((ob >> 9) & 1) << 5)); }
__host__ __device__ __forceinline__ void stage_rc(int b, int& R, int& C) { const int st = b / 1024, sb = b % 1024, swz = sb ^ (((sb >> 9) & 1) << 5); R = (st >> 1) * 16 + swz / 64; C = (st & 1) * 32 + (swz % 64) / 2; }
__host__ __device__ __forceinline__ int perm32(int rho) { const int n = rho >> 4, i = rho & 15; return 8 * (i >> 2) + 4 * n + (i & 3); }

struct Unit { int pm, pn, e, pl; };
struct Gemm { const bf16_t* A; const bf16_t* Bt; int M, N, K; };

struct StaticOrder {
    int nM, nN, nwg, G, c;
    __host__ __device__ void init(int M, int N, int G_, int c_) { nM = M / BM; nN = N / BM; nwg = nM * nN; G = G_; c = c_; }
    __host__ __device__ bool next(int i, Unit& u) const {
        const long L = (long)i * G + c; if (L >= nwg) return false;
        int wgid = (int)L; { const int q = nwg / NXCD, r = nwg % NXCD, xcd = wgid % NXCD, off = wgid / NXCD; wgid = (xcd < r ? xcd * (q + 1) : r * (q + 1) + (xcd - r) * q) + off; }
        const int nig = WGM * nN, gid = wgid / nig, fm = gid * WGM, gsz = (nM - fm) < WGM ? (nM - fm) : WGM;
        u.pm = fm + ((wgid % nig) % gsz); u.pn = (wgid % nig) / gsz; u.e = 0; u.pl = u.pn; return true;
    }
    __device__ __forceinline__ void a_ready(const Unit&) const {}
    __device__ __forceinline__ void done(const Unit&) const {}
};

__device__ __forceinline__ unsigned cvt_pk_bf16(float lo, float hi) { unsigned r; asm volatile("v_cvt_pk_bf16_f32 %0, %1, %2" : "=v"(r) : "v"(lo), "v"(hi)); return r; }

#define PG8_GAS __attribute__((address_space(1)))
struct NoPre {};
struct EpiBf16Plain {
    static constexpr bool PERM = true, AFTER_DRAIN = false; static constexpr int NST = 0; typedef NoPre Pre;
    __device__ __forceinline__ Pre prefetch(const Unit&, int, int) const { return Pre{}; }
    bf16_t* O; int ldc; float sc;
    __device__ __forceinline__ void operator()(const f32x4 (&acc)[2][2][4][2], const Unit& u, int wr, int wc, int fr, int fq, const Pre&) const {
        const int row0 = u.pm * BM + wr * 64 + fr; const int col0 = u.pn * BM + wc * 32 + 8 * fq;
#pragma unroll
        for (int ai = 0; ai < 2; ++ai)
#pragma unroll
            for (int m = 0; m < 4; ++m) { bf16_t* rowp = O + (size_t)(row0 + ai * HALF + m * 16) * ldc + col0;
#pragma unroll
                for (int bj = 0; bj < 2; ++bj) { const f32x4 v0 = acc[ai][bj][m][0] * sc, v1 = acc[ai][bj][m][1] * sc;
                    u32x4 w; w.x = cvt_pk_bf16(v0[0], v0[1]); w.y = cvt_pk_bf16(v0[2], v0[3]); w.z = cvt_pk_bf16(v1[0], v1[1]); w.w = cvt_pk_bf16(v1[2], v1[3]);
                    *(PG8_GAS u32x4*)(rowp + bj * HALF) = w; } }
    }
};
struct EpiResGate {
    static constexpr bool PERM = true, AFTER_DRAIN = false; static constexpr int NST = 0; typedef NoPre Pre;
    __device__ __forceinline__ Pre prefetch(const Unit&, int, int) const { return Pre{}; }
    const bf16_t* base; bf16_t* out; int ldc; const float* gate; int gpitch; int rows_per_batch; float sc;
    __device__ __forceinline__ void operator()(const f32x4 (&acc)[2][2][4][2], const Unit& u, int wr, int wc, int fr, int fq, const Pre&) const {
        const int row0 = u.pm * BM + wr * 64 + fr, col0 = u.pn * BM + wc * 32 + 8 * fq;
        const float* gp = gate + (size_t)((u.pm * BM) / rows_per_batch) * gpitch + col0;
        f32x4 gv[2][2];
#pragma unroll
        for (int bj = 0; bj < 2; ++bj)
#pragma unroll
            for (int n = 0; n < 2; ++n) gv[bj][n] = *(const PG8_GAS f32x4*)(gp + bj * HALF + 4 * n) * sc;
#pragma unroll
        for (int ai = 0; ai < 2; ++ai)
#pragma unroll
            for (int m = 0; m < 4; ++m) { const size_t off = (size_t)(row0 + ai * HALF + m * 16) * ldc + col0;
#pragma unroll
                for (int bj = 0; bj < 2; ++bj) { const u32x4 bs = *(const PG8_GAS u32x4*)(base + off + bj * HALF); const unsigned bw[4] = {bs.x, bs.y, bs.z, bs.w}; float r[8];
#pragma unroll
                    for (int j = 0; j < 4; ++j) { const f32x4& a4 = acc[ai][bj][m][j >> 1]; const f32x4& g4 = gv[bj][j >> 1];
                        r[2 * j] = __builtin_bit_cast(float, bw[j] << 16) + g4[2 * (j & 1)] * a4[2 * (j & 1)]; r[2 * j + 1] = __builtin_bit_cast(float, bw[j] & 0xffff0000u) + g4[2 * (j & 1) + 1] * a4[2 * (j & 1) + 1]; }
                    u32x4 w; w.x = cvt_pk_bf16(r[0], r[1]); w.y = cvt_pk_bf16(r[2], r[3]); w.z = cvt_pk_bf16(r[4], r[5]); w.w = cvt_pk_bf16(r[6], r[7]);
                    *(PG8_GAS u32x4*)(out + off + bj * HALF) = w; }
                asm volatile("" ::: "memory"); }
    }
};
struct EpiSwiglu {
    static constexpr bool PERM = true, AFTER_DRAIN = false; static constexpr int NST = 0; struct Pre { f32x4 bg[2], bu[2]; };
    __device__ __forceinline__ Pre prefetch(const Unit& u, int wc, int fq) const { typedef const __attribute__((address_space(1))) f32x4 gf4;
        const float* bp = bias + (size_t)u.e * 2048 + u.pl * HALF + wc * 32 + 8 * fq; Pre p; p.bg[0] = *(gf4*)bp; p.bg[1] = *(gf4*)(bp + 4); p.bu[0] = *(gf4*)(bp + 1024); p.bu[1] = *(gf4*)(bp + 1028); return p; }
    unsigned char* O; int ldc; const float* bias; float inv_in, out_scale;
    __device__ __forceinline__ void operator()(const f32x4 (&acc)[2][2][4][2], const Unit& u, int wr, int wc, int fr, int fq, const Pre& pre) const {
        const int row0 = u.pm * BM + wr * 64 + fr; const int jj0 = wc * 32 + 8 * fq; const int col0 = u.pl * HALF + jj0;
        const float rinv = 1.0f / inv_in, lim = 7.0f * rinv, kc = -1.702f * 1.4426950408889634f * inv_in, k2 = inv_in * inv_in * out_scale, k3 = inv_in * out_scale;
        const f32x4 bg[2] = {pre.bg[0] * rinv, pre.bg[1] * rinv}, bu[2] = {pre.bu[0] * rinv, pre.bu[1] * rinv};
#pragma unroll
        for (int ai = 0; ai < 2; ++ai)
#pragma unroll
            for (int m = 0; m < 4; ++m) { unsigned char* rowp = O + (size_t)(row0 + ai * HALF + m * 16) * ldc + col0;
                f32x4 r[2];
#pragma unroll
                for (int n = 0; n < 2; ++n) { f32x4 A = acc[ai][0][m][n] + bg[n], B = acc[ai][1][m][n] + bu[n];
#pragma unroll
                    for (int j = 0; j < 4; ++j) { A[j] = fminf(A[j], lim); B[j] = __builtin_amdgcn_fmed3f(B[j], -lim, lim); }
                    f32x4 e = A * kc;
#pragma unroll
                    for (int j = 0; j < 4; ++j) e[j] = __builtin_amdgcn_exp2f(e[j]);
                    e = e + 1.0f;
#pragma unroll
                    for (int j = 0; j < 4; ++j) e[j] = __builtin_amdgcn_rcpf(e[j]);
                    r[n] = (B * k2 + k3) * (A * e); }
                int w0 = 0, w1 = 0;
                w0 = __builtin_amdgcn_cvt_pk_fp8_f32(r[0][0], r[0][1], w0, false); w0 = __builtin_amdgcn_cvt_pk_fp8_f32(r[0][2], r[0][3], w0, true);
                w1 = __builtin_amdgcn_cvt_pk_fp8_f32(r[1][0], r[1][1], w1, false); w1 = __builtin_amdgcn_cvt_pk_fp8_f32(r[1][2], r[1][3], w1, true);
                typedef int i32x2 __attribute__((ext_vector_type(2))); *(PG8_GAS i32x2*)rowp = (i32x2){w0, w1}; }
    }
};
struct EpiBf16Bias {
    static constexpr bool PERM = true, AFTER_DRAIN = false; static constexpr int NST = 0; typedef NoPre Pre;
    __device__ __forceinline__ Pre prefetch(const Unit&, int, int) const { return Pre{}; }
    bf16_t* O; int ldc; const float* bias; int bpitch; float inv_in;
    __device__ __forceinline__ void operator()(const f32x4 (&acc)[2][2][4][2], const Unit& u, int wr, int wc, int fr, int fq, const Pre&) const {
        const int row0 = u.pm * BM + wr * 64 + fr; const int col0 = u.pl * BM + wc * 32 + 8 * fq;
        const float* bp = bias + (size_t)u.e * bpitch + col0;
        f32x4 bv[2][2];
#pragma unroll
        for (int bj = 0; bj < 2; ++bj)
#pragma unroll
            for (int n = 0; n < 2; ++n) bv[bj][n] = *(const PG8_GAS f32x4*)(bp + bj * HALF + 4 * n);
#pragma unroll
        for (int ai = 0; ai < 2; ++ai)
#pragma unroll
            for (int m = 0; m < 4; ++m) { bf16_t* rowp = O + (size_t)(row0 + ai * HALF + m * 16) * ldc + col0;
#pragma unroll
                for (int bj = 0; bj < 2; ++bj) { const f32x4 v0 = acc[ai][bj][m][0] * inv_in + bv[bj][0], v1 = acc[ai][bj][m][1] * inv_in + bv[bj][1];
                    u32x4 w; w.x = cvt_pk_bf16(v0[0], v0[1]); w.y = cvt_pk_bf16(v0[2], v0[3]); w.z = cvt_pk_bf16(v1[0], v1[1]); w.w = cvt_pk_bf16(v1[2], v1[3]);
                    *(PG8_GAS u32x4*)(rowp + bj * HALF) = w; } }
    }
};
struct EpiFp8Bias {
    static constexpr bool PERM = true, AFTER_DRAIN = false; static constexpr int NST = 0; struct Pre { f32x4 bv[2][2]; };
    __device__ __forceinline__ Pre prefetch(const Unit& u, int wc, int fq) const { typedef const __attribute__((address_space(1))) f32x4 gf4;
        const float* bp = bias + (size_t)u.e * bpitch + u.pl * BM + wc * 32 + 8 * fq; Pre p; p.bv[0][0] = *(gf4*)bp; p.bv[0][1] = *(gf4*)(bp + 4); p.bv[1][0] = *(gf4*)(bp + HALF); p.bv[1][1] = *(gf4*)(bp + HALF + 4); return p; }
    unsigned char* O; int ldc; const float* bias; int bpitch; float inv_in, out_scale;
    __device__ __forceinline__ int pk4(f32x4 v) const { int w = 0; w = __builtin_amdgcn_cvt_pk_fp8_f32(__builtin_amdgcn_fmed3f(v[0], -448.f, 448.f), __builtin_amdgcn_fmed3f(v[1], -448.f, 448.f), w, false);
        return __builtin_amdgcn_cvt_pk_fp8_f32(__builtin_amdgcn_fmed3f(v[2], -448.f, 448.f), __builtin_amdgcn_fmed3f(v[3], -448.f, 448.f), w, true); }
    __device__ __forceinline__ void operator()(const f32x4 (&acc)[2][2][4][2], const Unit& u, int wr, int wc, int fr, int fq, const Pre& pre) const {
        const int row0 = u.pm * BM + wr * 64 + fr; const int col0 = u.pl * BM + wc * 32 + 8 * fq;
        const float ks = inv_in * out_scale; const f32x4 bv[2][2] = {{pre.bv[0][0] * out_scale, pre.bv[0][1] * out_scale}, {pre.bv[1][0] * out_scale, pre.bv[1][1] * out_scale}};
#pragma unroll
        for (int ai = 0; ai < 2; ++ai)
#pragma unroll
            for (int m = 0; m < 4; ++m) { unsigned char* rowp = O + (size_t)(row0 + ai * HALF + m * 16) * ldc + col0;
#pragma unroll
                for (int bj = 0; bj < 2; ++bj) { const f32x4 v0 = acc[ai][bj][m][0] * ks + bv[bj][0], v1 = acc[ai][bj][m][1] * ks + bv[bj][1];
                    typedef int i32x2 __attribute__((ext_vector_type(2))); *(PG8_GAS i32x2*)(rowp + bj * HALF) = (i32x2){pk4(v0), pk4(v1)}; } }
    }
};
struct MoeOrder {
    int nN, G, c, nunits; const PG8_LAS int* tile_pm;
    __device__ __forceinline__ bool next(int i, Unit& u) const {
        const int L = i * G + c; if (L >= nunits) return false;
        const int idx = L / nN, pl = L - idx * nN, pm = __builtin_amdgcn_readfirstlane(tile_pm[idx]), e = pm >> 6;
        u.pm = pm; u.pl = pl; u.e = e; u.pn = e * nN + pl; return true;
    }
    __device__ __forceinline__ void a_ready(const Unit&) const {}
    __device__ __forceinline__ void done(const Unit&) const {}
};
typedef int v4i32_t __attribute__((ext_vector_type(4)));
typedef int v8i32_t __attribute__((ext_vector_type(8)));
template <class Epi, class Sched, bool ALIGN_EPI = false, bool SP2 = false, bool FP8 = false>
__device__ __forceinline__ void gemm_phase(PG8_LAS unsigned char* lds, const Gemm g, const Sched& S, const Epi& E, int tid_in) {
    int tid_ = tid_in; asm volatile("" : "+v"(tid_)); const int tid = tid_, wid = __builtin_amdgcn_readfirstlane(tid >> 6), lane = tid & 63, wr = wid >> 2, wc = wid & 3, fr = lane & 15, fq = lane >> 4;
    const int K = g.K, nt = K / BK;
    unsigned voffA, voffB;
    { int R, C; stage_rc(tid * 16, R, C); const int Rb = Epi::PERM ? ((R & ~31) + perm32(R & 31)) : R;
        voffA = (unsigned)(R * K + C) * 2u; voffB = (unsigned)(Rb * K + C) * 2u; }
    const size_t rstep = (size_t)64 * K * 2;
    const size_t kstep = (size_t)(BK * 2);
    const size_t hstep = (size_t)HALF * K * 2;
    const size_t tstep = 2 * hstep;
    const unsigned ldsw = (unsigned)wid * 1024u;
    const int aoff = lds_byte(wr * 64 + fr, fq * 8), boff = lds_byte(wc * 32 + fr, fq * 8);
#define PG8_SA(b, h) (((b) * 2 + (h)) * HTB)
#define PG8_SB(b, h) ((4 + (b) * 2 + (h)) * HTB)
#define PG8_STAGE(bufoff, gbase, voff) do { _Pragma("unroll") for (int _i = 0; _i < 2; ++_i) \
        __builtin_amdgcn_global_load_lds((const unsigned*)((const char*)(gbase) + _i * rstep + (voff)), (PG8_LAS unsigned*)(lds + (bufoff) + ldsw + _i * 8192), 16, 0, 0); } while (0)
#define PG8_LDA(dst, b, h) do { _Pragma("unroll") for (int m = 0; m < 4; ++m) _Pragma("unroll") for (int k = 0; k < 2; ++k) dst[m][k] = *(const PG8_LAS bf16x8*)(lds + PG8_SA(b, h) + aoff + m * 2048 + k * 1024); } while (0)
#define PG8_LDB(dst, b, h) do { _Pragma("unroll") for (int n = 0; n < 2; ++n) _Pragma("unroll") for (int k = 0; k < 2; ++k) dst[n][k] = *(const PG8_LAS bf16x8*)(lds + PG8_SB(b, h) + boff + n * 2048 + k * 1024); } while (0)
#define PG8_MMA(ai, bj, At, Bt) do { __builtin_amdgcn_s_setprio(1); _Pragma("unroll") for (int m = 0; m < 4; ++m) _Pragma("unroll") for (int n = 0; n < 2; ++n) { \
        if constexpr (FP8) { const v8i32_t a8_ = __builtin_shufflevector(__builtin_bit_cast(v4i32_t, At[m][0]), __builtin_bit_cast(v4i32_t, At[m][1]), 0, 1, 2, 3, 4, 5, 6, 7); \
            const v8i32_t b8_ = __builtin_shufflevector(__builtin_bit_cast(v4i32_t, Bt[n][0]), __builtin_bit_cast(v4i32_t, Bt[n][1]), 0, 1, 2, 3, 4, 5, 6, 7); \
            asm volatile("v_mfma_scale_f32_16x16x128_f8f6f4 %0, %1, %2, %0, %3, %3 op_sel_hi:[0,0,0]" : "+v"(acc[ai][bj][m][n]) : "v"(b8_), "v"(a8_), "v"(one8_)); } \
        else { _Pragma("unroll") for (int k = 0; k < 2; ++k) acc[ai][bj][m][n] = __builtin_amdgcn_mfma_f32_16x16x32_bf16(Bt[n][k], At[m][k], acc[ai][bj][m][n], 0, 0, 0); } } \
        __builtin_amdgcn_s_setprio(0); } while (0)
#define PG8_WAIT_V(n) asm volatile("s_waitcnt vmcnt(" #n ")" ::: "memory")
#define PG8_WAIT_L(n) asm volatile("s_waitcnt lgkmcnt(" #n ")" ::: "memory")
#define PG8_WAIT_V8R(relax) do { if (relax) { if constexpr (Epi::NST == 8) PG8_WAIT_V(16); else if constexpr (Epi::NST == 16) PG8_WAIT_V(24); else PG8_WAIT_V(8); } else PG8_WAIT_V(8); } while (0)
#define PG8_BAR __builtin_amdgcn_s_barrier()
#define PG8_SCHED __builtin_amdgcn_sched_barrier(0)
    Unit cur, nxt; int ui = 0;
    if (!S.next(0, cur)) return;
    f32x4 acc[2][2][4][2];
#pragma unroll
    for (int a = 0; a < 2; ++a)
#pragma unroll
        for (int b = 0; b < 2; ++b)
#pragma unroll
            for (int m = 0; m < 4; ++m)
#pragma unroll
                for (int n = 0; n < 2; ++n) acc[a][b][m][n] = (f32x4){0.f, 0.f, 0.f, 0.f};
    bf16x8 At[4][2], B0[2][2], B1[2][2];
    int one8_ = 0x7f7f7f7f; asm volatile("" : "+v"(one8_));
    const char* cA = (const char*)g.A + (size_t)cur.pm * tstep; const char* cB = (const char*)g.Bt + (size_t)cur.pn * tstep;
    S.a_ready(cur);
    if constexpr (SP2) {
        PG8_STAGE(PG8_SB(0, 0), cB, voffB); PG8_STAGE(PG8_SB(0, 1), cB + hstep, voffB); PG8_STAGE(PG8_SA(0, 0), cA, voffA); PG8_STAGE(PG8_SA(0, 1), cA + hstep, voffA);
        if (wr == 1) PG8_BAR;
        PG8_WAIT_V(2); PG8_BAR;
        PG8_STAGE(PG8_SB(1, 0), cB + kstep, voffB); PG8_STAGE(PG8_SA(1, 0), cA + kstep, voffA); PG8_STAGE(PG8_SB(1, 1), cB + hstep + kstep, voffB);
        PG8_WAIT_V(6); PG8_BAR;
    } else {
        PG8_STAGE(PG8_SB(0, 0), cB, voffB); PG8_STAGE(PG8_SA(0, 0), cA, voffA); PG8_STAGE(PG8_SB(0, 1), cB + hstep, voffB); PG8_STAGE(PG8_SA(0, 1), cA + hstep, voffA);
        if (wr == 1) PG8_BAR;
        PG8_WAIT_V(4); PG8_BAR;
        PG8_STAGE(PG8_SB(1, 0), cB + kstep, voffB); PG8_STAGE(PG8_SA(1, 0), cA + kstep, voffA); PG8_STAGE(PG8_SB(1, 1), cB + hstep + kstep, voffB);
        PG8_WAIT_V(6); PG8_BAR;
    }
    for (;;) {
        const bool has_next = S.next(ui + 1, nxt);
        typename Epi::Pre pre_; { int lp_ = (int)__builtin_amdgcn_mbcnt_hi(~0u, __builtin_amdgcn_mbcnt_lo(~0u, 0u)); asm volatile("" : "+v"(lp_)); pre_ = E.prefetch(cur, wc, lp_ >> 4); }
        const char* nA = has_next ? (const char*)g.A + (size_t)nxt.pm * tstep : cA; const char* nB = has_next ? (const char*)g.Bt + (size_t)nxt.pn * tstep : cB;
#pragma unroll 1
        for (int t = 0; t < nt; t += 2) {
            const bool last = (t == nt - 2);
            const char* a1 = cA + (size_t)(t + 1) * kstep;
            const char* a2 = last ? nA : cA + (size_t)(t + 2) * kstep; const char* b2 = last ? nB : cB + (size_t)(t + 2) * kstep;
            const char* a3 = a2 + kstep; const char* b3 = b2 + kstep;
            if (last && has_next) S.a_ready(nxt);
            const bool relax = (Epi::NST > 0) && (ui > 0) && (t == 0);
            if constexpr (SP2) {
            PG8_LDB(B0, 0, 0); PG8_LDB(B1, 0, 1); PG8_SCHED; PG8_LDA(At, 0, 0); PG8_STAGE(PG8_SA(1, 1), a1 + hstep, voffA);
            PG8_WAIT_V8R(relax); PG8_WAIT_L(0); PG8_BAR; PG8_MMA(0, 0, At, B0); PG8_MMA(0, 1, At, B1); PG8_BAR; PG8_SCHED;
            PG8_LDA(At, 0, 1); PG8_STAGE(PG8_SB(0, 0), b2, voffB); PG8_STAGE(PG8_SB(0, 1), b2 + hstep, voffB); PG8_STAGE(PG8_SA(0, 0), a2, voffA);
            PG8_WAIT_V8R(relax); PG8_WAIT_L(0); PG8_BAR; PG8_MMA(1, 0, At, B0); PG8_MMA(1, 1, At, B1); PG8_BAR; PG8_SCHED;
            PG8_LDB(B0, 1, 0); PG8_LDB(B1, 1, 1); PG8_SCHED; PG8_LDA(At, 1, 0); PG8_STAGE(PG8_SA(0, 1), a2 + hstep, voffA);
            PG8_WAIT_V(8); PG8_WAIT_L(0); PG8_BAR; PG8_MMA(0, 0, At, B0); PG8_MMA(0, 1, At, B1); PG8_BAR; PG8_SCHED;
            PG8_LDA(At, 1, 1); PG8_STAGE(PG8_SB(1, 0), b3, voffB); PG8_STAGE(PG8_SB(1, 1), b3 + hstep, voffB); PG8_STAGE(PG8_SA(1, 0), a3, voffA);
            PG8_WAIT_V(8); PG8_WAIT_L(0); PG8_BAR; PG8_MMA(1, 0, At, B0); PG8_MMA(1, 1, At, B1); PG8_BAR; PG8_SCHED;
            } else {
            PG8_LDB(B0, 0, 0); PG8_SCHED; PG8_LDA(At, 0, 0); PG8_STAGE(PG8_SA(1, 1), a1 + hstep, voffA);
            PG8_WAIT_L(8); PG8_BAR; PG8_WAIT_L(0); PG8_MMA(0, 0, At, B0); PG8_BAR; PG8_SCHED;
            PG8_LDB(B1, 0, 1); PG8_STAGE(PG8_SB(0, 0), b2, voffB);
            PG8_BAR; PG8_WAIT_L(0); PG8_MMA(0, 1, At, B1); PG8_BAR;
            PG8_LDA(At, 0, 1); PG8_STAGE(PG8_SA(0, 0), a2, voffA);
            PG8_BAR; PG8_WAIT_L(0); PG8_MMA(1, 0, At, B0); PG8_BAR; PG8_SCHED;
            PG8_STAGE(PG8_SB(0, 1), b2 + hstep, voffB);
            PG8_WAIT_V(6); PG8_BAR; PG8_MMA(1, 1, At, B1); PG8_BAR;
            PG8_LDB(B0, 1, 0); PG8_SCHED; PG8_LDA(At, 1, 0); PG8_STAGE(PG8_SA(0, 1), a2 + hstep, voffA);
            PG8_WAIT_L(8); PG8_BAR; PG8_WAIT_L(0); PG8_MMA(0, 0, At, B0); PG8_BAR; PG8_SCHED;
            PG8_LDB(B1, 1, 1); PG8_STAGE(PG8_SB(1, 0), b3, voffB);
            PG8_BAR; PG8_WAIT_L(0); PG8_MMA(0, 1, At, B1); PG8_BAR;
            PG8_LDA(At, 1, 1); PG8_STAGE(PG8_SA(1, 0), a3, voffA);
            PG8_BAR; PG8_WAIT_L(0); PG8_MMA(1, 0, At, B0); PG8_BAR; PG8_SCHED;
            PG8_STAGE(PG8_SB(1, 1), b3 + hstep, voffB);
            PG8_WAIT_V(6); PG8_BAR; PG8_MMA(1, 1, At, B1); PG8_BAR;
            }
        }
        if constexpr (FP8) asm volatile("s_nop 7\n\ts_nop 7" ::: "memory");
        if constexpr (ALIGN_EPI) { if (wr == 0) PG8_BAR; }
        if constexpr (!Epi::AFTER_DRAIN) { int ln_ = (int)__builtin_amdgcn_mbcnt_hi(~0u, __builtin_amdgcn_mbcnt_lo(~0u, 0u)); asm volatile("" : "+v"(ln_)); E(acc, cur, wr, wc, ln_ & 15, ln_ >> 4, pre_); S.done(cur); }
        if (!has_next) break;
#pragma unroll
        for (int a = 0; a < 2; ++a)
#pragma unroll
            for (int b = 0; b < 2; ++b)
#pragma unroll
                for (int m = 0; m < 4; ++m)
#pragma unroll
                    for (int n = 0; n < 2; ++n) acc[a][b][m][n] = (f32x4){0.f, 0.f, 0.f, 0.f};
        cur = nxt; cA = nA; cB = nB; ++ui;
        if constexpr (ALIGN_EPI) { if (wr == 1) PG8_BAR; }
    }
    PG8_WAIT_V(0);
    if constexpr (!ALIGN_EPI) { if (wr == 0) PG8_BAR; }
    PG8_BAR;
    if constexpr (Epi::AFTER_DRAIN) { E.fused(acc, cur, wr, wc, fr, fq, lds, wid, lane); S.done(cur); }
#undef PG8_SA
#undef PG8_SB
#undef PG8_STAGE
#undef PG8_LDA
#undef PG8_LDB
#undef PG8_MMA
#undef PG8_WAIT_V
#undef PG8_WAIT_L
#undef PG8_BAR
#undef PG8_SCHED
}
}

constexpr int NWAVES = 8, NTHR = 512;
constexpr int BATCH = 2, SEQ = 8192, D = 1024, DEPTH = 4, MTOK = BATCH * SEQ;
constexpr int DIN = 3344, NPROJ = 3328, SRC_GA = 1152;
constexpr int C_GQ = 0, C_GK = 192, C_GV = 384, C_GG = 768, C_HQ = 1152, C_HF = 1408, C_HI = 1664, C_HG = 1920, C_RQ = 2176, C_RK = 2368, C_RV = 2560, C_RG = 2944;
constexpr int NE = 32, FFN = 1024;
constexpr int CH = 64, NCH = SEQ / CH, NUNIT = BATCH * NCH;
constexpr int ST_GLA = 0, ST_HG = 4 * 48 * 96, ST_RET = ST_HG + 4 * 64 * 64, ST_TOT = ST_RET + 4 * 48 * 96;
constexpr int NDV = 448, NKT = 640;
constexpr int MAXROWS = 65536 + NE * 256, MAXRT = MAXROWS / 256;
constexpr float EPS = 1e-6f;
#ifndef F8_IN_V
#define F8_IN_V false
#endif
#ifndef F8_OUT_V
#define F8_OUT_V true
#endif
constexpr bool F8_IN = F8_IN_V, F8_OUT = F8_OUT_V;
#ifndef Y8_V
#define Y8_V true
#endif
constexpr bool Y8 = Y8_V;
constexpr float S8_Y = 16.f;
constexpr float S8_M = 32.f;
constexpr float S8_W = 2048.f, S8_H = 64.f, S8_A = 8.f;
constexpr int NPHASE = 38;
constexpr int ECAP = 16384, ECAP_SH = 14;

constexpr size_t MiB = 1u << 20;
constexpr size_t WS_CTL = 0, CTL_ZERO_BYTES = 65536;
constexpr size_t WS_MOD = 1 * MiB;
constexpr size_t WS_ROPE = 2 * MiB;
constexpr size_t WS_LB = 5 * MiB;
constexpr size_t WS_WIN = 8 * MiB;
constexpr size_t WS_WOUT = 34 * MiB;
constexpr size_t WS_WGU = 42 * MiB;
constexpr size_t WS_WDN = 554 * MiB;
constexpr size_t WS_X = 810 * MiB;
constexpr size_t WS_H = 874 * MiB;
constexpr size_t WS_GA = 906 * MiB;
constexpr size_t WS_PROJ = 907 * MiB;
constexpr size_t WS_U = 1011 * MiB;
constexpr size_t WS_DVEC = 1063 * MiB;
constexpr size_t WS_SP = 1064 * MiB;
constexpr size_t WS_MIX = 1090 * MiB;
constexpr size_t WS_TOPE = 1122 * MiB;
constexpr size_t WS_TOPW = WS_TOPE + 256 * 1024;
constexpr size_t WS_SLOT = WS_TOPW + 256 * 1024;
constexpr size_t WS_A1 = 1123 * MiB;
constexpr size_t WS_ACT = 1635 * MiB;
constexpr size_t WS_Y = 2147 * MiB;
constexpr size_t WS_CUM = 3171 * MiB;
constexpr size_t WS_KT = 3199 * MiB;
constexpr size_t WS_END = 3239 * MiB;
static_assert(WS_WIN + (size_t)DEPTH * NPROJ * D * 2 <= WS_WOUT && WS_PROJ + (size_t)MTOK * NPROJ * 2 <= WS_U && WS_U + (size_t)NUNIT * ST_TOT * 4 <= WS_DVEC && WS_SP + (size_t)NUNIT * ST_TOT * 2 <= WS_MIX && WS_A1 + (size_t)NE * ECAP * D <= WS_ACT && WS_ACT + (size_t)NE * ECAP * D <= WS_Y && WS_Y + (size_t)NE * ECAP * D * 2 <= WS_CUM, "ws map");
constexpr int CW_TMO = 0, CW_CODE = 1, CW_BAR = 4096, CW_CNT = 8192, CW_FILL = 8192 + 256;
constexpr int RING_BYTES = 131072;
constexpr int MISC_OFF = 147456, LDS_BYTES = MISC_OFF + 4096;
constexpr int MW_BAR = 0, MW_CNT = 16, MW_PST = 48, MW_HIST = 96, MW_BASE = 128, MW_TILE = 192, MW_NRT = 480, MW_SLOTS = 512;

#define GAS __attribute__((address_space(1)))
#define LAS __attribute__((address_space(3)))
typedef unsigned v4u __attribute__((ext_vector_type(4)));
typedef float f32x4 __attribute__((ext_vector_type(4)));
typedef short bf16x8 __attribute__((ext_vector_type(8)));
typedef GAS unsigned gu32;
typedef GAS unsigned long long gu64;
#define RLX_AGENT __ATOMIC_RELAXED, __HIP_MEMORY_SCOPE_AGENT
#define LDS_WAIT() asm volatile("s_waitcnt lgkmcnt(0)" ::: "memory")
#define VM_WAIT() asm volatile("s_waitcnt vmcnt(0)" ::: "memory")
__device__ __forceinline__ unsigned long long rt() { return __builtin_amdgcn_s_memrealtime(); }
typedef unsigned short bf16;
typedef float f32x2_t __attribute__((ext_vector_type(2))); typedef __bf16 bf16x2_t __attribute__((ext_vector_type(2)));
__device__ __forceinline__ unsigned pk2(float lo, float hi) { const f32x2_t v = {lo, hi}; return __builtin_bit_cast(unsigned, __builtin_convertvector(v, bf16x2_t)); }
__device__ __forceinline__ unsigned f2bf(float f) { return pk2(f, 0.f) & 0xffffu; }
__device__ __forceinline__ float bf2f(bf16 b) { return __builtin_bit_cast(float, (unsigned)b << 16); }
#define XB_TMO      128
#define XB_XCNT(j)  (256  + 64 * (j))
#define XB_XSUB(j)  (1280 + 64 * (j))
#define XB_XGEN(j)  (2304 + 64 * (j))
#define XB_TOP      3328
#define XB_TOPGEN   3392
#define XCD_BAR_WORDS 3456
#define XB_SPIN_CAP (1u << 18)

__device__ __forceinline__ unsigned xb_ld(unsigned* p)              { return __hip_atomic_load(p, __ATOMIC_RELAXED, __HIP_MEMORY_SCOPE_AGENT); }
__device__ __forceinline__ unsigned xb_add(unsigned* p, unsigned v) { return __hip_atomic_fetch_add(p, v, __ATOMIC_RELAXED, __HIP_MEMORY_SCOPE_AGENT); }
__device__ __forceinline__ unsigned xb_xcc_id() { return (unsigned)__builtin_amdgcn_s_getreg((3 << 11) | 20) & 0xFu; }
#define XB_SPIN(cond, bar) do { unsigned _sp = 0; while (cond) { __builtin_amdgcn_s_sleep(1); \
    if ((++_sp & 255u) == 0u) { if (xb_ld(&(bar)[XB_TMO])) break; if (_sp > XB_SPIN_CAP) { atomicAdd(&(bar)[XB_TMO], 1u); break; } } } } while (0)

struct XcdBarrier {
    unsigned* bar; unsigned x;
    volatile LAS unsigned* st;
};

__device__ __forceinline__ XcdBarrier xcd_barrier_post(unsigned* bar, volatile LAS unsigned* st) {
    XcdBarrier b; b.bar = bar; b.x = xb_xcc_id(); b.st = st;
    if (threadIdx.x == 0) (void)xb_add(&bar[XB_XCNT(b.x)], 1u);
    return b;
}
__device__ __forceinline__ void xcd_barrier_complete(unsigned* bar, unsigned x, unsigned& nloc, unsigned& nx) {
    const unsigned G = gridDim.x * gridDim.y * gridDim.z;
    unsigned sum, cnt, mine, sp = 0u;
    for (;;) {
        sum = 0u; cnt = 0u; mine = 0u;
#pragma unroll
        for (unsigned j = 0; j < 16; ++j) { const unsigned c = xb_ld(&bar[XB_XCNT(j)]); sum += c; cnt += (c > 0u) ? 1u : 0u; mine = (j == x) ? c : mine; }
        if (sum == G) break;
        __builtin_amdgcn_s_sleep(1);
        if ((++sp & 255u) == 0u) { if (xb_ld(&bar[XB_TMO])) break; if (sp > XB_SPIN_CAP) { atomicAdd(&bar[XB_TMO], 1u); break; } }
    }
    nloc = mine > 0u ? mine : 1u; nx = cnt > 0u ? cnt : 1u;
}

__device__ __forceinline__ void xcd_barrier(const XcdBarrier& b) {
    asm volatile("s_waitcnt vmcnt(0)" ::: "memory");
    __syncthreads();
    if (threadIdx.x == 0) {
        unsigned* bar = b.bar;
        __builtin_amdgcn_s_waitcnt(0);
        unsigned nloc = b.st[0], nx = b.st[1];
        if (nloc == 0u) { xcd_barrier_complete(bar, b.x, nloc, nx); b.st[0] = nloc; b.st[1] = nx; }
        const unsigned old = xb_add(&bar[XB_XSUB(b.x)], 1u);
        const unsigned gen = old / nloc;
        if (old + 1u == (gen + 1u) * nloc) {
            __builtin_amdgcn_fence(__ATOMIC_RELEASE, "agent");
            asm volatile("s_waitcnt vmcnt(0)" ::: "memory");
            const unsigned og = xb_add(&bar[XB_TOP], 1u);
            const unsigned tg = og / nx;
            if (og + 1u == (tg + 1u) * nx) xb_add(&bar[XB_TOPGEN], 1u);
            else XB_SPIN(xb_ld(&bar[XB_TOPGEN]) == tg, bar);
            __builtin_amdgcn_fence(__ATOMIC_ACQUIRE, "agent");
            xb_add(&bar[XB_XGEN(b.x)], 1u);
            asm volatile("s_waitcnt vmcnt(0)" ::: "memory");
        } else {
            XB_SPIN(xb_ld(&bar[XB_XGEN(b.x)]) == gen, bar);
            __builtin_amdgcn_fence(__ATOMIC_ACQUIRE, "agent");
            asm volatile("s_waitcnt vmcnt(0)" ::: "memory");
        }
    }
    __syncthreads();
}

__device__ __forceinline__ float wave_sum(float v) {
#pragma unroll
    for (int o = 1; o < 64; o <<= 1) v += __shfl_xor(v, o);
    return v;
}
__device__ __forceinline__ float log_sigmoid_f(float x) { return fminf(x, 0.f) - log1pf(expf(-fabsf(x))); }
__device__ __forceinline__ float silu_f(float x) { return x / (1.0f + expf(-x)); }
__device__ __forceinline__ float sigmoid_f(float x) { return 1.0f / (1.0f + expf(-x)); }
__device__ __forceinline__ pg8::bf16x8 ldfrag(const LAS bf16* base, int stride, int r0, int k0, int lane) {
    return *(const LAS pg8::bf16x8*)(base + (r0 + (lane & 15)) * stride + k0 + 8 * (lane >> 4));
}
__device__ __forceinline__ pg8::bf16x8 pack8(const float (&v)[8]) { v4u w; w.x = pk2(v[0], v[1]); w.y = pk2(v[2], v[3]); w.z = pk2(v[4], v[5]); w.w = pk2(v[6], v[7]); return __builtin_bit_cast(pg8::bf16x8, w); }

struct Args {
    const float* x; const float* c; const int* pos; const float* w_mod; const float* b_mod; const float* norm1_w; const float* w_in; const float* gla_wa2; const float* gla_ba2; const float* hg_lb;
    const float* gla_norm_w; const float* hg_norm_w; const float* w_out; const float* norm2_w; const float* w_r; const float* b_r; const float* w_gu; const float* b_gu; const float* w_dn; const float* b_dn;
    const float* final_norm_w; float* out; unsigned char* ws; int ph_lo, ph_hi;
};

__device__ __forceinline__ void transpose_block64(const float* src, int ld, bf16* dst, LAS float*, int lane) {
    const int n4 = lane & 15, kg = lane >> 4;
    f32x4 v[16];
#pragma unroll
    for (int i = 0; i < 16; ++i) v[i] = __builtin_nontemporal_load((const f32x4*)(src + (size_t)(16 * kg + i) * ld + 4 * n4));
#pragma unroll
    for (int j = 0; j < 4; ++j) { v4u o0, o1;
        o0.x = pk2(v[0][j], v[1][j]); o0.y = pk2(v[2][j], v[3][j]); o0.z = pk2(v[4][j], v[5][j]); o0.w = pk2(v[6][j], v[7][j]);
        o1.x = pk2(v[8][j], v[9][j]); o1.y = pk2(v[10][j], v[11][j]); o1.z = pk2(v[12][j], v[13][j]); o1.w = pk2(v[14][j], v[15][j]);
        bf16* d = dst + (size_t)(4 * n4 + j) * D + 16 * kg; *(GAS v4u*)d = o0; *(GAS v4u*)(d + 8) = o1; }
}
__device__ __forceinline__ float clamp448(float x) { return __builtin_amdgcn_fmed3f(x, -448.f, 448.f); }
__device__ __forceinline__ int pk4_fp8(float a, float b, float c, float d) { int w = 0; w = __builtin_amdgcn_cvt_pk_fp8_f32(clamp448(a), clamp448(b), w, false);
    return __builtin_amdgcn_cvt_pk_fp8_f32(clamp448(c), clamp448(d), w, true); }
__device__ __forceinline__ void transpose_block64_fp8(const float* src, int ld, unsigned char* dst, LAS float*, int lane, float sc) {
    const int n4 = lane & 15, kg = lane >> 4;
    f32x4 v[16];
#pragma unroll
    for (int i = 0; i < 16; ++i) v[i] = __builtin_nontemporal_load((const f32x4*)(src + (size_t)(16 * kg + i) * ld + 4 * n4)) * sc;
#pragma unroll
    for (int j = 0; j < 4; ++j) { v4u o;
        o.x = (unsigned)pk4_fp8(v[0][j], v[1][j], v[2][j], v[3][j]); o.y = (unsigned)pk4_fp8(v[4][j], v[5][j], v[6][j], v[7][j]);
        o.z = (unsigned)pk4_fp8(v[8][j], v[9][j], v[10][j], v[11][j]); o.w = (unsigned)pk4_fp8(v[12][j], v[13][j], v[14][j], v[15][j]);
        *(GAS v4u*)(dst + (size_t)(4 * n4 + j) * D + 16 * kg) = o; }
}
constexpr int IT_IN = 16 * (NPROJ / 64), IT_OUT = 16 * 16, IT_GU = NE * 16 * 32, IT_DN = NE * 16 * 16, IT_LAYER = IT_IN + IT_OUT + IT_GU + IT_DN, IT_ALL = DEPTH * IT_LAYER;
__device__ __forceinline__ void convert_item(const Args& a, int l, int r, LAS float* scr, int lane) {
    unsigned char* ws = a.ws;
    bf16* WIN = (bf16*)(ws + WS_WIN); bf16* WOUT = (bf16*)(ws + WS_WOUT); unsigned char* WGU = ws + WS_WGU; unsigned char* WDN = ws + WS_WDN;
    if (r < IT_IN) { const int kb = r / (NPROJ / 64), nb = r % (NPROJ / 64), n0 = 64 * nb, sc = n0 + (n0 >= SRC_GA ? 16 : 0);
        if (F8_IN) transpose_block64_fp8(a.w_in + ((size_t)l * D + 64 * kb) * DIN + sc, DIN, (unsigned char*)WIN + ((size_t)l * NPROJ + n0) * D + 64 * kb, scr, lane, S8_W);
        else transpose_block64(a.w_in + ((size_t)l * D + 64 * kb) * DIN + sc, DIN, WIN + ((size_t)l * NPROJ + n0) * D + 64 * kb, scr, lane); return; }
    r -= IT_IN;
    if (r < IT_OUT) { const int kb = r / 16, nb = r % 16;
        if (F8_OUT) transpose_block64_fp8(a.w_out + ((size_t)l * D + 64 * kb) * D + 64 * nb, D, (unsigned char*)WOUT + ((size_t)l * D + 64 * nb) * D + 64 * kb, scr, lane, S8_W);
        else transpose_block64(a.w_out + ((size_t)l * D + 64 * kb) * D + 64 * nb, D, WOUT + ((size_t)l * D + 64 * nb) * D + 64 * kb, scr, lane); return; }
    r -= IT_OUT;
    if (r < IT_GU) { const int e = r / 512, r2 = r % 512, kb = r2 / 32, nb = r2 % 32, cc = 64 * nb;
        const int row = (cc < 1024) ? 256 * (cc / 128) + (cc % 128) : 256 * ((cc - 1024) / 128) + 128 + ((cc - 1024) % 128);
        transpose_block64_fp8(a.w_gu + (((size_t)l * NE + e) * D + 64 * kb) * 2048 + cc, 2048, WGU + (((size_t)l * NE + e) * 2048 + row) * D + 64 * kb, scr, lane, S8_W); return; }
    r -= IT_GU;
    { const int e = r / 256, r2 = r % 256, kb = r2 / 16, nb = r2 % 16;
        transpose_block64_fp8(a.w_dn + (((size_t)l * NE + e) * FFN + 64 * kb) * D + 64 * nb, D, WDN + (((size_t)l * NE + e) * D + 64 * nb) * D + 64 * kb, scr, lane, S8_W); }
}
constexpr int CB2 = 4, CB7 = 2, CB8 = 2;
__device__ __forceinline__ int conv_t2(int G) { return (G == 256) ? 192 * NWAVES * CB2 : 0; }
__device__ __forceinline__ int conv_idle(int nunits, int G) { const int rem = nunits % G; return rem ? G - rem : 0; }
__device__ __forceinline__ void convert_range(const Args& a, int l, int first, int count, LAS unsigned char* lds, int lane, int wave) {
    LAS float* scr = (LAS float*)(lds + wave * 16640);
    for (int k = 0; k < count; ++k) { const int it = first + k; if (it < IT_LAYER) convert_item(a, l, it, scr, lane); }
}
__device__ __forceinline__ void p0_prologue(const Args& a, LAS unsigned char* lds, int vcu, int G, int tid, int lane, int wave) {
    unsigned char* ws = a.ws;
    LAS float* scr = (LAS float*)(lds + wave * 16640);
    const int gw = vcu * NWAVES + wave, NGW = G * NWAVES;
    for (int it = gw; it < IT_LAYER; it += NGW) convert_item(a, 0, it, scr, lane);
    __syncthreads();
    {
        LAS float* cact = (LAS float*)lds;
        LAS float* red = (LAS float*)(lds + 8192);
        for (int i = tid; i < 2 * D; i += NTHR) cact[i] = silu_f(a.c[i]);
        __syncthreads();
        float* MOD = (float*)(ws + WS_MOD);
        for (int it = vcu; it < DEPTH * 96; it += G) {
            const int l = it / 96, n0 = (it % 96) * 64;
            const float* wp = a.w_mod + ((size_t)l * D + 128 * wave) * 6144 + n0 + lane;
            float a0 = 0.f, a1 = 0.f;
#pragma unroll 32
            for (int k = 0; k < 128; ++k) { const float w = __builtin_nontemporal_load(wp + (size_t)k * 6144); a0 += cact[128 * wave + k] * w; a1 += cact[D + 128 * wave + k] * w; }
            red[(wave * 2 + 0) * 64 + lane] = a0; red[(wave * 2 + 1) * 64 + lane] = a1;
            __syncthreads();
            if (tid < 128) { const int b = tid >> 6, ln = tid & 63; float s = a.b_mod[l * 6144 + n0 + ln];
#pragma unroll
                for (int w = 0; w < 8; ++w) s += red[(w * 2 + b) * 64 + ln];
                MOD[((size_t)l * 2 + b) * 6144 + n0 + ln] = s; }
            __syncthreads();
        }
    }
    { const f32x4* xs = (const f32x4*)a.x; uint2* xd = (uint2*)(ws + WS_X);
        for (int i = vcu * NTHR + tid; i < MTOK * D / 4; i += G * NTHR) { const f32x4 v = xs[i]; uint2 p; p.x = pk2(v[0], v[1]); p.y = pk2(v[2], v[3]); xd[i] = p; } }
    {
        float* ROPE = (float*)(ws + WS_ROPE);
        for (int i = vcu * NTHR + tid; i < MTOK * 24; i += G * NTHR) { const int t = i / 24, f = i % 24;
            const float inv = (float)pow(10000.0, -(double)f / 24.0); const float ang = (float)a.pos[t] * inv;
            ROPE[(size_t)t * 48 + f] = cosf(ang); ROPE[(size_t)t * 48 + 24 + f] = sinf(ang); }
    }
    if (vcu == 0 && tid < 256) {
        float v[4], mx = -3.0e38f; for (int l = 0; l < 4; ++l) { v[l] = a.hg_lb[l * 256 + tid]; mx = fmaxf(mx, v[l]); }
        float s = 0.f; for (int l = 0; l < 4; ++l) { v[l] = expf(v[l] - mx); s += v[l]; }
        float* LB = (float*)(ws + WS_LB); float cs = 0.f, first = 0.f;
        for (int l = 0; l < 4; ++l) { cs += v[l] / s; if (l == 0) first = cs; LB[l * 256 + tid] = cs - first; }
    }
}

__device__ __forceinline__ void moe_combine_row(f32x4 (&v)[4], int m, const bf16* Y, const int* SLOT, const float* TOPW, const float* g2, int lane) {
    const int4 sl = *(const int4*)(SLOT + (size_t)m * 4); const f32x4 tw = *(const f32x4*)(TOPW + (size_t)m * 4);
    const int s[4] = {sl.x, sl.y, sl.z, sl.w};
    f32x4 acc[4];
#pragma unroll
    for (int j = 0; j < 4; ++j) acc[j] = (f32x4){0.f, 0.f, 0.f, 0.f};
#pragma unroll
    for (int k = 0; k < 4; ++k) { const bf16* yr = Y + (size_t)s[k] * D + 4 * lane; const float w = tw[k];
#pragma unroll
        for (int j = 0; j < 4; ++j) { const uint2 p = *(const uint2*)(yr + 256 * j);
            acc[j][0] += w * __builtin_bit_cast(float, p.x << 16); acc[j][1] += w * __builtin_bit_cast(float, p.x & 0xffff0000u);
            acc[j][2] += w * __builtin_bit_cast(float, p.y << 16); acc[j][3] += w * __builtin_bit_cast(float, p.y & 0xffff0000u); } }
#pragma unroll
    for (int j = 0; j < 4; ++j) { const f32x4 g = *(const f32x4*)(g2 + 4 * lane + 256 * j); v[j] = v[j] + g * acc[j]; }
}
__device__ __forceinline__ float row_rstd(const f32x4 (&v)[4]) {
    float s = 0.f;
#pragma unroll
    for (int j = 0; j < 4; ++j) s += (v[j][0] * v[j][0] + v[j][1] * v[j][1]) + (v[j][2] * v[j][2] + v[j][3] * v[j][3]);
    return 1.0f / sqrtf(wave_sum(s) * (1.0f / D) + EPS);
}
__device__ __forceinline__ void modulate_row(f32x4 (&v)[4], float rstd, const float* nw, const float* sc, const float* sh, bf16* hrow, int lane) {
#pragma unroll
    for (int j = 0; j < 4; ++j) { const int c0 = 4 * lane + 256 * j; const f32x4 w = *(const f32x4*)(nw + c0), s1 = *(const f32x4*)(sc + c0), s0 = *(const f32x4*)(sh + c0);
        v[j] = v[j] * rstd * w * (s1 + 1.0f) + s0;
        uint2 p; p.x = pk2(v[j][0], v[j][1]); p.y = pk2(v[j][2], v[j][3]); *(uint2*)(hrow + c0) = p; }
}


constexpr int LR_SLT = 142976, LR_TWL = 144000, LR_SSR = 145024;
__device__ __forceinline__ void stage_slots(const unsigned char* ws, int row0, LAS unsigned char* lds, int tid) {
    if (tid < 64) { *(LAS v4u*)(lds + LR_SLT + 16 * tid) = *(const v4u*)((const int*)(ws + WS_SLOT) + (size_t)(row0 + tid) * 4);
                    *(LAS f32x4*)(lds + LR_TWL + 16 * tid) = *(const f32x4*)((const float*)(ws + WS_TOPW) + (size_t)(row0 + tid) * 4); }
}
template <bool SS, bool OUTF32>
__device__ __forceinline__ void flat_combine(const bf16* xsrc, void* xdst, int row0, const bf16* Y, const float* g2, LAS unsigned char* lds, int tid, int lane, const float* fw = nullptr) {
    static_assert(Y8, "expert outputs are stored as fp8");
    typedef float f32x2v __attribute__((ext_vector_type(2)));
    const int c16 = tid & 63, rsub = tid >> 6; const unsigned char* Yb = (const unsigned char*)Y;
    f32x4 g[4];
#pragma unroll
    for (int q = 0; q < 4; ++q) g[q] = *(const f32x4*)(g2 + 16 * c16 + 4 * q);
    f32x4 fwv[4];
    if (SS) {
#pragma unroll
        for (int q = 0; q < 4; ++q) fwv[q] = *(const f32x4*)(fw + 16 * c16 + 4 * q); }
#pragma unroll 2
    for (int it = 0; it < 8; ++it) { const int i = 8 * it + rsub; const size_t m = (size_t)(row0 + i);
        const v4u x0 = *(const v4u*)(xsrc + m * D + 16 * c16), x1 = *(const v4u*)(xsrc + m * D + 16 * c16 + 8);
        const v4u sl = *(const LAS v4u*)(lds + LR_SLT + 16 * i); const f32x4 tws = *(const LAS f32x4*)(lds + LR_TWL + 16 * i) * (1.0f / S8_Y);
        const v4u y0 = *(const v4u*)(Yb + (size_t)sl.x * D + 16 * c16), y1 = *(const v4u*)(Yb + (size_t)sl.y * D + 16 * c16), y2 = *(const v4u*)(Yb + (size_t)sl.z * D + 16 * c16), y3 = *(const v4u*)(Yb + (size_t)sl.w * D + 16 * c16);
        const unsigned xw[8] = {x0.x, x0.y, x0.z, x0.w, x1.x, x1.y, x1.z, x1.w}, w0[4] = {y0.x, y0.y, y0.z, y0.w}, w1[4] = {y1.x, y1.y, y1.z, y1.w}, w2[4] = {y2.x, y2.y, y2.z, y2.w}, w3[4] = {y3.x, y3.y, y3.z, y3.w};
        float v[16]; float sq = 0.f;
#pragma unroll
        for (int q = 0; q < 4; ++q) {
            const f32x2v a0 = __builtin_amdgcn_cvt_pk_f32_fp8((int)w0[q], false), b0 = __builtin_amdgcn_cvt_pk_f32_fp8((int)w0[q], true), a1 = __builtin_amdgcn_cvt_pk_f32_fp8((int)w1[q], false), b1 = __builtin_amdgcn_cvt_pk_f32_fp8((int)w1[q], true);
            const f32x2v a2 = __builtin_amdgcn_cvt_pk_f32_fp8((int)w2[q], false), b2 = __builtin_amdgcn_cvt_pk_f32_fp8((int)w2[q], true), a3 = __builtin_amdgcn_cvt_pk_f32_fp8((int)w3[q], false), b3 = __builtin_amdgcn_cvt_pk_f32_fp8((int)w3[q], true);
            const float e0 = tws[0] * a0[0] + tws[1] * a1[0] + tws[2] * a2[0] + tws[3] * a3[0], e1 = tws[0] * a0[1] + tws[1] * a1[1] + tws[2] * a2[1] + tws[3] * a3[1];
            const float e2 = tws[0] * b0[0] + tws[1] * b1[0] + tws[2] * b2[0] + tws[3] * b3[0], e3 = tws[0] * b0[1] + tws[1] * b1[1] + tws[2] * b2[1] + tws[3] * b3[1];
            v[4 * q + 0] = __builtin_bit_cast(float, xw[2 * q] << 16) + g[q][0] * e0; v[4 * q + 1] = __builtin_bit_cast(float, xw[2 * q] & 0xffff0000u) + g[q][1] * e1;
            v[4 * q + 2] = __builtin_bit_cast(float, xw[2 * q + 1] << 16) + g[q][2] * e2; v[4 * q + 3] = __builtin_bit_cast(float, xw[2 * q + 1] & 0xffff0000u) + g[q][3] * e3;
            sq += (v[4 * q] * v[4 * q] + v[4 * q + 1] * v[4 * q + 1]) + (v[4 * q + 2] * v[4 * q + 2] + v[4 * q + 3] * v[4 * q + 3]); }
        if (SS) { const float rstd = 1.0f / sqrtf(wave_sum(sq) * (1.0f / D) + EPS);
#pragma unroll
            for (int q = 0; q < 4; ++q) { v[4 * q] *= rstd * fwv[q][0]; v[4 * q + 1] *= rstd * fwv[q][1]; v[4 * q + 2] *= rstd * fwv[q][2]; v[4 * q + 3] *= rstd * fwv[q][3]; } }
        if (OUTF32) {
#pragma unroll
            for (int q = 0; q < 4; ++q) *(GAS f32x4*)((float*)xdst + m * D + 16 * c16 + 4 * q) = (f32x4){v[4 * q], v[4 * q + 1], v[4 * q + 2], v[4 * q + 3]}; }
        else { v4u o0, o1; o0.x = pk2(v[0], v[1]); o0.y = pk2(v[2], v[3]); o0.z = pk2(v[4], v[5]); o0.w = pk2(v[6], v[7]); o1.x = pk2(v[8], v[9]); o1.y = pk2(v[10], v[11]); o1.z = pk2(v[12], v[13]); o1.w = pk2(v[14], v[15]);
            *(GAS v4u*)((bf16*)xdst + m * D + 16 * c16) = o0; *(GAS v4u*)((bf16*)xdst + m * D + 16 * c16 + 8) = o1; }
    }
}
template <bool F8, bool SLOTS>
__device__ __forceinline__ void flat_modulate(const bf16* xin, int row0, const LAS float* rstds, const float* nw, const float* scp, const float* shp, bf16* H, unsigned char* A1, LAS unsigned char* lds, int tid) {
    const int c16 = tid & 63, rsub = tid >> 6; f32x4 ws1[4], s0[4];
#pragma unroll
    for (int q = 0; q < 4; ++q) { const int c0 = 16 * c16 + 4 * q; ws1[q] = *(const f32x4*)(nw + c0) * (*(const f32x4*)(scp + c0) + 1.0f); s0[q] = *(const f32x4*)(shp + c0); }
#pragma unroll 2
    for (int it = 0; it < 8; ++it) { const int i = 8 * it + rsub; const size_t m = (size_t)(row0 + i); const float rs = rstds[i];
        const v4u x0 = *(const v4u*)(xin + m * D + 16 * c16), x1 = *(const v4u*)(xin + m * D + 16 * c16 + 8); const unsigned xw[8] = {x0.x, x0.y, x0.z, x0.w, x1.x, x1.y, x1.z, x1.w};
        f32x4 v[4];
#pragma unroll
        for (int q = 0; q < 4; ++q) v[q] = (f32x4){__builtin_bit_cast(float, xw[2 * q] << 16), __builtin_bit_cast(float, xw[2 * q] & 0xffff0000u), __builtin_bit_cast(float, xw[2 * q + 1] << 16), __builtin_bit_cast(float, xw[2 * q + 1] & 0xffff0000u)} * rs * ws1[q] + s0[q];
        if (F8) { v4u o; o.x = (unsigned)pk4_fp8(v[0][0] * S8_H, v[0][1] * S8_H, v[0][2] * S8_H, v[0][3] * S8_H); o.y = (unsigned)pk4_fp8(v[1][0] * S8_H, v[1][1] * S8_H, v[1][2] * S8_H, v[1][3] * S8_H);
            o.z = (unsigned)pk4_fp8(v[2][0] * S8_H, v[2][1] * S8_H, v[2][2] * S8_H, v[2][3] * S8_H); o.w = (unsigned)pk4_fp8(v[3][0] * S8_H, v[3][1] * S8_H, v[3][2] * S8_H, v[3][3] * S8_H);
            if (SLOTS) { const v4u sl = *(const LAS v4u*)(lds + LR_SLT + 16 * i);
                *(GAS v4u*)(A1 + (size_t)sl.x * D + 16 * c16) = o; *(GAS v4u*)(A1 + (size_t)sl.y * D + 16 * c16) = o; *(GAS v4u*)(A1 + (size_t)sl.z * D + 16 * c16) = o; *(GAS v4u*)(A1 + (size_t)sl.w * D + 16 * c16) = o; }
            else *(GAS v4u*)((unsigned char*)H + m * D + 16 * c16) = o; }
        else { v4u o0, o1; o0.x = pk2(v[0][0], v[0][1]); o0.y = pk2(v[0][2], v[0][3]); o0.z = pk2(v[1][0], v[1][1]); o0.w = pk2(v[1][2], v[1][3]); o1.x = pk2(v[2][0], v[2][1]); o1.y = pk2(v[2][2], v[2][3]); o1.z = pk2(v[3][0], v[3][1]); o1.w = pk2(v[3][2], v[3][3]);
            *(GAS v4u*)(H + m * D + 16 * c16) = o0; *(GAS v4u*)(H + m * D + 16 * c16 + 8) = o1; } }
}

constexpr int WP = 1032;
constexpr int LR_WHI = 0, LR_PART = 132096, LR_SSX = 140288, LR_RSTD = 140544, LR_BIAS = 140800, LR_RED = 140928;
template <int NEO>
__device__ __forceinline__ void rows_mfma(const Args& a, int layer, LAS unsigned char* lds, volatile LAS unsigned* MISC, gu32* ctl, int vcu, int G, int tid, int lane, int wave) {
    constexpr bool P5 = (NEO == 32); constexpr int NET = NEO / 16;
    unsigned char* ws = a.ws; bf16* X = (bf16*)(ws + WS_X); bf16* H = (bf16*)(ws + WS_H); const float* MOD = (const float*)(ws + WS_MOD);
    LAS bf16* Whi = (LAS bf16*)(lds + LR_WHI); LAS bf16* Wlo = Whi + NEO * WP; LAS float* part = (LAS float*)(lds + LR_PART); LAS float* ssx = (LAS float*)(lds + LR_SSX);
    LAS float* rstds = (LAS float*)(lds + LR_RSTD); LAS float* biasl = (LAS float*)(lds + LR_BIAS); LAS float* red = (LAS float*)(lds + LR_RED);
    const float* nw = (P5 ? a.norm2_w : a.norm1_w) + layer * D;
    const float* Wsrc = P5 ? a.w_r + (size_t)layer * D * NE : a.w_in + (size_t)layer * D * DIN + SRC_GA; const int wld = P5 ? NE : DIN;
    if (P5) { if (tid < NE) MISC[MW_HIST + tid] = 0u; }
    for (int row0 = vcu * 64; row0 < MTOK; row0 += G * 64) {
        const int b = row0 / SEQ; const float* mp = MOD + ((size_t)layer * 2 + b) * 6144; const float* scp = mp + (P5 ? 4 : 1) * D; const float* shp = mp + (P5 ? 3 : 0) * D;
        if (!P5 && layer > 0) { stage_slots(ws, row0, lds, tid); __syncthreads(); }
        { constexpr int E4 = NEO / 4, NITP = (D / 2 * E4) / NTHR, NIT = 4;
          f32x4 bacc = {0.f, 0.f, 0.f, 0.f};
#pragma unroll 1
          for (int ib0 = 0; ib0 < NITP; ib0 += NIT) {
            f32x4 wa[NIT], wb[NIT]; f32x2_t nv[NIT], sv[NIT], hv[NIT];
#pragma unroll
            for (int it = 0; it < NIT; ++it) { const int idx = tid + NTHR * (ib0 + it), k2 = idx / E4, e4 = idx - k2 * E4, k = 2 * k2;
                wa[it] = *(const f32x4*)(Wsrc + (size_t)k * wld + 4 * e4); wb[it] = *(const f32x4*)(Wsrc + (size_t)(k + 1) * wld + 4 * e4);
                nv[it] = *(const f32x2_t*)(nw + k); sv[it] = *(const f32x2_t*)(scp + k); hv[it] = *(const f32x2_t*)(shp + k); }
#pragma unroll
            for (int it = 0; it < NIT; ++it) { const int idx = tid + NTHR * (ib0 + it), k2 = idx / E4, e4 = idx - k2 * E4, k = 2 * k2;
                bacc += wa[it] * hv[it][0] + wb[it] * hv[it][1];
                const f32x4 w0 = wa[it] * (nv[it][0] * (1.0f + sv[it][0])), w1 = wb[it] * (nv[it][1] * (1.0f + sv[it][1]));
#pragma unroll
                for (int j = 0; j < 4; ++j) { const unsigned h0 = f2bf(w0[j]), h1 = f2bf(w1[j]); const float l0 = w0[j] - __builtin_bit_cast(float, h0 << 16), l1 = w1[j] - __builtin_bit_cast(float, h1 << 16);
                    *(LAS unsigned*)(Whi + (4 * e4 + j) * WP + k) = h0 | (h1 << 16); *(LAS unsigned*)(Wlo + (4 * e4 + j) * WP + k) = pk2(l0, l1); } } }
#pragma unroll
          for (int j = 0; j < 4; ++j) { float v = bacc[j];
#pragma unroll
              for (int sh = E4; sh < 64; sh <<= 1) v += __shfl_xor(v, sh);
              bacc[j] = v; }
          if (lane < E4) *(LAS f32x4*)(red + wave * NEO + 4 * lane) = bacc; }
        const bf16* xin = X;
        if (!P5 && layer > 0) { flat_combine<false, false>(X, X, row0, (const bf16*)(ws + WS_Y), MOD + ((size_t)(layer - 1) * 2 + b) * 6144 + 5 * D, lds, tid, lane); asm volatile("s_waitcnt vmcnt(0)" ::: "memory"); }
        __syncthreads();
        if (tid < NEO) { float sacc = P5 ? a.b_r[layer * NE + tid] : 0.f; for (int q = 0; q < NWAVES; ++q) sacc += red[q * NEO + tid]; biasl[tid] = sacc; }
        const int rg = wave >> 1, kh = wave & 1, r = lane & 15, g = lane >> 4;
        { const bf16* xr = xin + (size_t)(row0 + 16 * rg + r) * D; f32x4 acc[NET]; float ss = 0.f;
#pragma unroll
            for (int et = 0; et < NET; ++et) acc[et] = (f32x4){0.f, 0.f, 0.f, 0.f};
#pragma unroll 4
            for (int s = 16 * kh; s < 16 * kh + 16; ++s) { const int k0 = 32 * s + 8 * g; const v4u xp = *(const v4u*)(xr + k0); const unsigned xw[4] = {xp.x, xp.y, xp.z, xp.w};
#pragma unroll
                for (int j = 0; j < 4; ++j) { const float xa = __builtin_bit_cast(float, xw[j] << 16), xb = __builtin_bit_cast(float, xw[j] & 0xffff0000u); ss += xa * xa + xb * xb; }
                const pg8::bf16x8 ahi = __builtin_bit_cast(pg8::bf16x8, xp);
#pragma unroll
                for (int et = 0; et < NET; ++et) { const pg8::bf16x8 whi = ldfrag(Whi, WP, 16 * et, 32 * s, lane), wlo = ldfrag(Wlo, WP, 16 * et, 32 * s, lane);
                    acc[et] = __builtin_amdgcn_mfma_f32_16x16x32_bf16(ahi, whi, acc[et], 0, 0, 0); acc[et] = __builtin_amdgcn_mfma_f32_16x16x32_bf16(ahi, wlo, acc[et], 0, 0, 0); } }
            ss += __shfl_xor(ss, 16); ss += __shfl_xor(ss, 32);
            if (kh == 1) {
#pragma unroll
                for (int et = 0; et < NET; ++et)
#pragma unroll
                    for (int q = 0; q < 4; ++q) part[(rg * 16 + 4 * g + q) * 32 + 16 * et + r] = acc[et][q];
                if (g == 0) ssx[rg * 16 + r] = ss; }
            __syncthreads();
            if (kh == 0) { const float sst = ss + ssx[rg * 16 + r]; if (g == 0) rstds[rg * 16 + r] = 1.0f / sqrtf(sst * (1.0f / D) + EPS);
                asm volatile("s_waitcnt lgkmcnt(0)" ::: "memory");
#pragma unroll
                for (int et = 0; et < NET; ++et)
#pragma unroll
                    for (int q = 0; q < 4; ++q) { const int i = rg * 16 + 4 * g + q, e = 16 * et + r; const float v = rstds[i] * (acc[et][q] + part[i * 32 + e]) + biasl[e];
                        if (P5) part[i * 32 + e] = v; else ((float*)(ws + WS_GA))[(size_t)(row0 + i) * 16 + e] = v; }
                if (P5) { asm volatile("s_waitcnt lgkmcnt(0)" ::: "memory");
                    if (lane < 16) { const int i = rg * 16 + lane, m = row0 + i; float lv[NE];
#pragma unroll
                        for (int e = 0; e < NE; ++e) lv[e] = part[i * 32 + e];
                        float tv[4]; int te[4];
#pragma unroll
                        for (int t = 0; t < 4; ++t) { float best = -3.0e38f; int bi = 0;
#pragma unroll
                            for (int e = 0; e < NE; ++e) if (lv[e] > best) { best = lv[e]; bi = e; }
#pragma unroll
                            for (int e = 0; e < NE; ++e) if (e == bi) lv[e] = -3.0e38f;
                            tv[t] = best; te[t] = bi; }
                        const float e1 = expf(tv[1] - tv[0]), e2 = expf(tv[2] - tv[0]), e3 = expf(tv[3] - tv[0]); const float inv = 1.0f / (1.0f + e1 + e2 + e3);
                        *(f32x4*)((float*)(ws + WS_TOPW) + (size_t)m * 4) = (f32x4){inv, e1 * inv, e2 * inv, e3 * inv};
#pragma unroll
                        for (int t = 0; t < 4; ++t) { const unsigned rk = __hip_atomic_fetch_add((LAS unsigned*)&MISC[MW_HIST + te[t]], 1u, __ATOMIC_RELAXED, __HIP_MEMORY_SCOPE_WORKGROUP);
                            ((LAS unsigned*)(lds + LR_SLT))[i * 4 + t] = ((unsigned)te[t] << 16) | rk; } } } }
            __syncthreads(); }
        if (P5) { if (tid < NE) { const unsigned hcnt = MISC[MW_HIST + tid]; MISC[MW_BASE + tid] = hcnt ? atomicAdd((unsigned*)(ctl + CW_CNT + layer * NE + tid), hcnt) : 0u; }
            __syncthreads();
            if (tid < 256) { LAS unsigned* sl = (LAS unsigned*)(lds + LR_SLT) + tid; const unsigned v = *sl, e = v >> 16; const unsigned slot = (e << ECAP_SH) + MISC[MW_BASE + e] + (v & 0xffffu);
                *sl = slot; ((int*)(ws + WS_SLOT))[(size_t)row0 * 4 + tid] = (int)slot; }
            if (tid < NE) MISC[MW_HIST + tid] = 0u;
            __syncthreads(); }
        if (P5) flat_modulate<true, true>(xin, row0, rstds, nw, scp, shp, H, ws + WS_A1, lds, tid);
        else flat_modulate<F8_IN, false>(xin, row0, rstds, nw, scp, shp, H, ws + WS_A1, lds, tid);
        __syncthreads();
    }
}

__device__ __forceinline__ void final_rows(const Args& a, LAS unsigned char* lds, int vcu, int G, int tid, int lane) {
    unsigned char* ws = a.ws; const bf16* X = (const bf16*)(ws + WS_X); const float* MOD = (const float*)(ws + WS_MOD);
    for (int row0 = vcu * 64; row0 < MTOK; row0 += G * 64) { const int b = row0 / SEQ;
        stage_slots(ws, row0, lds, tid);
        __syncthreads();
        flat_combine<true, true>(X, a.out, row0, (const bf16*)(ws + WS_Y), MOD + ((size_t)(DEPTH - 1) * 2 + b) * 6144 + 5 * D, lds, tid, lane, a.final_norm_w);
        __syncthreads();
    }
}

__device__ __noinline__ void moe_tables(gu32* ctl, int layer, volatile LAS unsigned* MISC, int tid) {
    if (tid < NE) MISC[MW_CNT + tid] = __hip_atomic_load(ctl + CW_CNT + layer * NE + tid, RLX_AGENT);
    __syncthreads();
    if (tid == 0) { unsigned n = 0;
        for (int e = 0; e < NE; ++e) { const unsigned nt = (MISC[MW_CNT + e] + 255u) >> 8; for (unsigned t = 0; t < nt; ++t) MISC[MW_TILE + n + t] = (unsigned)(e * 64) + t; n += nt; }
        MISC[MW_NRT] = n; }
    __syncthreads();
}

constexpr int BP = 72;
template <int TYPE> struct MixCfg { static constexpr int DK = (TYPE == 1) ? 64 : 48, DV = (TYPE == 1) ? 64 : 96, NC = 4 * DK, NV = 4 * DV;
    static constexpr int STOFF = (TYPE == 0) ? ST_GLA : (TYPE == 1) ? ST_HG : ST_RET, COFF = (TYPE == 0) ? 0 : 192;
    static constexpr int CQ = (TYPE == 0) ? C_GQ : (TYPE == 1) ? C_HQ : C_RQ, CK = (TYPE == 0) ? C_GK : (TYPE == 1) ? C_HF : C_RK, CV = (TYPE == 0) ? C_GV : (TYPE == 1) ? C_HI : C_RV, CG = (TYPE == 0) ? C_GG : (TYPE == 1) ? C_HG : C_RG;
    static constexpr int MIXOFF = (TYPE == 0) ? 0 : (TYPE == 1) ? 384 : 640, KOFF = (TYPE == 0) ? 0 : (TYPE == 1) ? 192 : 448; };
__device__ __forceinline__ float fast_logsig(float x) { x = fmaxf(x, -80.f); return -__logf(1.0f + __expf(-x)); }
__device__ __forceinline__ float ret_lg(int h) { return logf(1.0f - exp2f(-5.0f - (float)h)); }

template <int NV>
__device__ __forceinline__ void stage_vt(const bf16* pv  , LAS bf16* VT, int tid) {
    constexpr int NIT = (64 * (NV / 8)) / NTHR; static_assert((64 * (NV / 8)) % NTHR == 0, "stage_vt");
    v4u p[NIT];
#pragma unroll
    for (int it = 0; it < NIT; ++it) { const int idx = tid + NTHR * it, j = idx & 63, ch = idx >> 6; p[it] = *(const v4u*)(pv + (size_t)j * NPROJ + 8 * ch); }
#pragma unroll
    for (int it = 0; it < NIT; ++it) { const int idx = tid + NTHR * it, j = idx & 63, ch = idx >> 6; LAS bf16* d = VT + (8 * ch) * BP + j;
        d[0 * BP] = (bf16)(p[it].x & 0xffffu); d[1 * BP] = (bf16)(p[it].x >> 16); d[2 * BP] = (bf16)(p[it].y & 0xffffu); d[3 * BP] = (bf16)(p[it].y >> 16);
        d[4 * BP] = (bf16)(p[it].z & 0xffffu); d[5 * BP] = (bf16)(p[it].z >> 16); d[6 * BP] = (bf16)(p[it].w & 0xffffu); d[7 * BP] = (bf16)(p[it].w >> 16); }
}

constexpr int LA_KT = 0, LA_VT = 36864, LA_TOT = 92160, LA_GA = 94208, LA_KTT = 98304, KTP = 264;
template <int TYPE>
__device__ __forceinline__ void mixa_batch(const Args& a, int layer, int unit, LAS unsigned char* lds, int tid, int lane, int wave) {
    asm volatile("" : "+v"(tid), "+v"(lane));
    typedef MixCfg<TYPE> C; constexpr int DK = C::DK, DV = C::DV, NC = C::NC, NV = C::NV;
    unsigned char* ws = a.ws; const bf16* PROJ = (const bf16*)(ws + WS_PROJ); bf16* F1 = (bf16*)(ws + WS_CUM); float* ECG = (float*)(ws + WS_CUM + 16 * MiB) + (size_t)unit * 4 * NDV; float* DVEC = (float*)(ws + WS_DVEC) + (size_t)unit * NDV;
    bf16* U = (bf16*)(ws + WS_U) + (size_t)unit * ST_TOT + C::STOFF;
    LAS bf16* KT = (LAS bf16*)(lds + LA_KT); LAS bf16* VT = (LAS bf16*)(lds + LA_VT); LAS float* TOT = (LAS float*)(lds + LA_TOT); const LAS float* GAs = (const LAS float*)(lds + LA_GA);
    const int row0 = unit * CH;
    stage_vt<NV>(PROJ + (size_t)row0 * NPROJ + C::CV, VT, tid);
    const bool act = tid < 2 * NC; const int c = act ? tid % NC : 0, half = act ? tid / NC : 0, h = c / DK, d = c - h * DK;
    float cum[32]; float tot = 0.f;
    float w2[16], b2 = 0.f, lbv = 0.f, lg = 0.f, sg = 0.f; int f = 0, d2 = 0;
    if (act) {
        if constexpr (TYPE == 0) { b2 = a.gla_ba2[layer * 192 + c];
#pragma unroll
            for (int r = 0; r < 16; ++r) w2[r] = a.gla_wa2[(layer * 16 + r) * 192 + c]; }
        if constexpr (TYPE == 1) lbv = ((const float*)(ws + WS_LB))[layer * 256 + c];
        if constexpr (TYPE == 2) { lg = ret_lg(h); f = (d < 24) ? d : d - 24; d2 = (d < 24) ? d + 24 : d - 24; sg = (d < 24) ? -1.f : 1.f; }
#pragma unroll
        for (int gq = 0; gq < 2; ++gq) {
            bf16 hraw[16];
            if constexpr (TYPE == 1) {
#pragma unroll
                for (int i = 0; i < 16; ++i) hraw[i] = PROJ[(size_t)(row0 + 32 * half + 16 * gq + i) * NPROJ + C_HF + c]; }
#pragma unroll
            for (int ii = 0; ii < 16; ++ii) { const int i = 16 * gq + ii, t = 32 * half + i; float g;
                if constexpr (TYPE == 0) { float pre = b2;
#pragma unroll
                    for (int r = 0; r < 16; ++r) pre += GAs[t * 16 + r] * w2[r];
                    g = fast_logsig(pre) * (1.0f / 16.0f); }
                else if constexpr (TYPE == 1) { const float hf = fminf(fmaxf(bf2f(hraw[ii]), -80.f), 80.f); const float sgm = __builtin_amdgcn_rcpf(1.0f + __expf(-hf));
                    g = __logf(lbv + (1.0f - lbv) * sgm); }
                else g = lg;
                tot += g; cum[i] = tot;
                if constexpr (TYPE == 0) { if ((ii & 3) == 3) asm volatile("" ::: "memory"); } } }
        TOT[c * 2 + half] = tot;
    }
    __syncthreads();
    if (act) { const float t0 = TOT[c * 2], t1 = TOT[c * 2 + 1]; const float off = half ? t0 : 0.f, last = t0 + t1;
#pragma unroll
        for (int hq = 0; hq < 4; ++hq) {
            bf16 ka[8], kb[8]; float cs[8], sn[8];
            if constexpr (TYPE != 1) {
#pragma unroll
                for (int i = 0; i < 8; ++i) { const size_t row = (size_t)(row0 + 32 * half + 8 * hq + i); const bf16* pr = PROJ + row * NPROJ;
                    if constexpr (TYPE == 0) ka[i] = pr[C_GK + c];
                    else { const float* rp = (const float*)(ws + WS_ROPE) + row * 48; ka[i] = pr[C_RK + h * 48 + d]; kb[i] = pr[C_RK + h * 48 + d2]; cs[i] = rp[f]; sn[i] = rp[24 + f]; } } }
            float kt[8];
#pragma unroll
            for (int j = 0; j < 8; ++j) { const int i = 8 * hq + j; const float cm = cum[i] + off; const size_t row = (size_t)(row0 + 32 * half + i); float k;
                if constexpr (TYPE == 0) k = bf2f(ka[j]);
                else if constexpr (TYPE == 1) k = 1.0f - __expf(cum[i] - (i > 0 ? cum[i - 1] : 0.f));
                else k = bf2f(ka[j]) * cs[j] + sg * bf2f(kb[j]) * sn[j];
                if constexpr (TYPE != 2) *(GAS bf16*)(F1 + row * NDV + C::COFF + c) = (bf16)f2bf(__expf(cm - ((i < 16) ? off : cum[15] + off)));
                { const float eb = cum[(i < 16) ? 15 : 31] + off;
                  ((LAS bf16*)(lds + LA_KTT))[(32 * half + i) * KTP + c] = (bf16)f2bf(k * __expf(eb - cm)); }
                kt[j] = k * __expf(last - cm); }
            v4u w; w.x = pk2(kt[0], kt[1]); w.y = pk2(kt[2], kt[3]); w.z = pk2(kt[4], kt[5]); w.w = pk2(kt[6], kt[7]);
            *(LAS v4u*)(KT + c * BP + 32 * half + 8 * hq) = w; }
        if (TYPE != 2) { *(GAS float*)(ECG + (2 * half + 0) * NDV + C::COFF + c) = cum[15] + off; *(GAS float*)(ECG + (2 * half + 1) * NDV + C::COFF + c) = cum[31] + off; }
        if (TYPE != 2 && half == 0) *(GAS float*)(DVEC + C::COFF + c) = __expf(last);
    }
    __syncthreads();
    { constexpr int CPR = NC / 8;
#pragma unroll
        for (int it = 0; it < (64 * CPR) / NTHR; ++it) { const int idx = tid + NTHR * it, t = idx / CPR, ch = idx - t * CPR;
            *(GAS v4u*)((bf16*)(ws + WS_KT) + (size_t)(row0 + t) * NKT + C::KOFF + 8 * ch) = *(const LAS v4u*)((const LAS bf16*)(lds + LA_KTT) + t * KTP + 8 * ch); } }
    constexpr int TD = DK / 16, NT = (DV / 16) * TD;
    for (int ti = wave; ti < 4 * NT; ti += NWAVES) { const int hh = ti / NT, tr = ti - hh * NT, te = tr / TD, td = tr - te * TD; f32x4 acc = {0.f, 0.f, 0.f, 0.f};
#pragma unroll
        for (int kk = 0; kk < 2; ++kk) acc = __builtin_amdgcn_mfma_f32_16x16x32_bf16(ldfrag(VT, BP, hh * DV + te * 16, kk * 32, lane), ldfrag(KT, BP, hh * DK + td * 16, kk * 32, lane), acc, 0, 0, 0);
        bf16* Uh = U + hh * DK * DV;
#pragma unroll
        for (int r = 0; r < 4; ++r) *(GAS bf16*)(Uh + (te * 16 + (lane >> 4) * 4 + r) * DK + td * 16 + (lane & 15)) = (bf16)f2bf(acc[r]); }
    __syncthreads();
}
__device__ __forceinline__ void p3a_summaries(const Args& a, int layer, LAS unsigned char* lds, int vcu, int G, int tid, int lane, int wave) {
    for (int unit = vcu; unit < NUNIT; unit += G) {
        { LAS float* GAs = (LAS float*)(lds + LA_GA); const float* GA = (const float*)(a.ws + WS_GA); for (int i = tid; i < CH * 16; i += NTHR) GAs[i] = GA[(size_t)unit * CH * 16 + i]; }
        __syncthreads();
        mixa_batch<0>(a, layer, unit, lds, tid, lane, wave);
        mixa_batch<1>(a, layer, unit, lds, tid, lane, wave);
        mixa_batch<2>(a, layer, unit, lds, tid, lane, wave);
    }
}

__device__ __forceinline__ void p3b_scan(const Args& a, int vcu, int G, int tid) {
    unsigned char* ws = a.ws; const bf16* U = (const bf16*)(ws + WS_U); const float* DVEC = (const float*)(ws + WS_DVEC); bf16* SP = (bf16*)(ws + WS_SP);
    for (int gid = vcu * NTHR + tid; gid < BATCH * ST_TOT; gid += G * NTHR) {
        const int b = gid / ST_TOT, el = gid - b * ST_TOT;
        int di = -1; float cdec = 0.f;
        if (el < ST_HG) { const int h = el / 4608, d = (el - h * 4608) % 48; di = h * 48 + d; }
        else if (el < ST_RET) { const int r = el - ST_HG, h = r / 4096, d = r % 64; di = 192 + h * 64 + d; }
        else { const int h = (el - ST_RET) / 4608; cdec = expf(64.0f * logf(1.0f - exp2f(-5.0f - (float)h))); }
        const bf16* up = U + (size_t)b * NCH * ST_TOT + el; const float* dp = DVEC + (size_t)b * NCH * NDV + (di < 0 ? 0 : di); bf16* sp = SP + (size_t)b * NCH * ST_TOT + el;
        float s = 0.f;
#pragma unroll 1
        for (int n0 = 0; n0 < NCH; n0 += 32) { float u[32], dc[32];
#pragma unroll
            for (int i = 0; i < 32; ++i) { u[i] = bf2f(up[(size_t)(n0 + i) * ST_TOT]); dc[i] = (di < 0) ? cdec : dp[(size_t)(n0 + i) * NDV]; }
#pragma unroll
            for (int i = 0; i < 32; ++i) { *(GAS bf16*)(sp + (size_t)(n0 + i) * ST_TOT) = (bf16)f2bf(s); s = dc[i] * s + u[i]; } }
    }
}

#ifndef SUB_MASK
#define SUB_MASK 0
#endif
__device__ __forceinline__ unsigned long long rt_now() { unsigned long long t; asm volatile("s_waitcnt vmcnt(0) lgkmcnt(0)\n\ts_memrealtime %0\n\ts_waitcnt lgkmcnt(0)" : "=s"(t) :: "memory"); return t; }
#define SUBSTRETCH(bit, t0_) do { if ((SUB_MASK >> (bit)) & 1) { const unsigned long long t1_ = rt_now(); while (rt_now() - t1_ < t1_ - (t0_)) __builtin_amdgcn_s_sleep(8); } } while (0)
constexpr int LC_VT = 0, LC_ST = 55296, LC_AB = 110592, OBP = 104, LC_EC = 137216;
template <int TYPE, bool ISQ>
__device__ __forceinline__ void mix_frag(const Args& a, int h, size_t row, int t, int d0, float (&x)[8], float (&cm)[8]) {
    typedef MixCfg<TYPE> C; constexpr int DK = C::DK; static_assert(ISQ, "query path only");
    unsigned char* ws = a.ws; const bf16* pr = (const bf16*)(ws + WS_PROJ) + row * NPROJ;
    if constexpr (TYPE != 2) {
        const v4u p = *(const v4u*)(pr + C::CQ + h * DK + d0); const unsigned pw[4] = {p.x, p.y, p.z, p.w};
        const v4u f = *(const v4u*)((const bf16*)(ws + WS_CUM) + row * NDV + C::COFF + h * DK + d0); const unsigned fw[4] = {f.x, f.y, f.z, f.w};
#pragma unroll
        for (int j = 0; j < 4; ++j) { x[2 * j] = __builtin_bit_cast(float, pw[j] << 16); x[2 * j + 1] = __builtin_bit_cast(float, pw[j] & 0xffff0000u); cm[2 * j] = __builtin_bit_cast(float, fw[j] << 16); cm[2 * j + 1] = __builtin_bit_cast(float, fw[j] & 0xffff0000u); }
        if constexpr (TYPE == 0) {
#pragma unroll
            for (int j = 0; j < 8; ++j) x[j] *= 0.14433756729740643f; }
    } else {
        const int f0 = (d0 < 24) ? d0 : d0 - 24, dp = (d0 < 24) ? d0 + 24 : d0 - 24; const float sg = (d0 < 24) ? -1.f : 1.f;
        const int cb = C_RQ + h * DK; const v4u p = *(const v4u*)(pr + cb + d0), pp = *(const v4u*)(pr + cb + dp); const unsigned pw[4] = {p.x, p.y, p.z, p.w}, qw[4] = {pp.x, pp.y, pp.z, pp.w};
        const float* rp = (const float*)(ws + WS_ROPE) + row * 48; const f32x4 cs0 = *(const f32x4*)(rp + f0), cs1 = *(const f32x4*)(rp + f0 + 4), sn0 = *(const f32x4*)(rp + 24 + f0), sn1 = *(const f32x4*)(rp + 24 + f0 + 4);
        const float cmv = (float)(t + 1) * ret_lg(h);
#pragma unroll
        for (int j = 0; j < 4; ++j) { const float xa = __builtin_bit_cast(float, pw[j] << 16), xb = __builtin_bit_cast(float, pw[j] & 0xffff0000u), ya = __builtin_bit_cast(float, qw[j] << 16), yb = __builtin_bit_cast(float, qw[j] & 0xffff0000u);
            const float ca = (j < 2) ? cs0[2 * j] : cs1[2 * j - 4], cb2 = (j < 2) ? cs0[2 * j + 1] : cs1[2 * j - 3], sa = (j < 2) ? sn0[2 * j] : sn1[2 * j - 4], sb = (j < 2) ? sn0[2 * j + 1] : sn1[2 * j - 3];
            x[2 * j] = (xa * ca + sg * ya * sa) * 0.14433756729740643f; x[2 * j + 1] = (xb * cb2 + sg * yb * sb) * 0.14433756729740643f; cm[2 * j] = cmv; cm[2 * j + 1] = cmv; }
    }
}

template <int TYPE> struct QRaw { v4u p[2], f[2]; f32x4 rp[2][4]; };
template <int TYPE>
__device__ __forceinline__ void q_issue(const Args& a, int h, size_t row, int g, QRaw<TYPE>& R) {
    typedef MixCfg<TYPE> C; constexpr int DK = C::DK; unsigned char* ws = a.ws; const bf16* pr = (const bf16*)(ws + WS_PROJ) + row * NPROJ;
#pragma unroll
    for (int s = 0; s < 2; ++s) { const int d0r = 32 * s + 8 * g; const int d0 = (d0r < DK) ? d0r : 0;
        if constexpr (TYPE != 2) { R.p[s] = *(const v4u*)(pr + C::CQ + h * DK + d0); R.f[s] = *(const v4u*)((const bf16*)(ws + WS_CUM) + row * NDV + C::COFF + h * DK + d0); }
        else { const int f0 = (d0 < 24) ? d0 : d0 - 24, dp = (d0 < 24) ? d0 + 24 : d0 - 24; const int cb = C_RQ + h * DK; R.p[s] = *(const v4u*)(pr + cb + d0); R.f[s] = *(const v4u*)(pr + cb + dp);
            const float* rp = (const float*)(ws + WS_ROPE) + row * 48; R.rp[s][0] = *(const f32x4*)(rp + f0); R.rp[s][1] = *(const f32x4*)(rp + f0 + 4); R.rp[s][2] = *(const f32x4*)(rp + 24 + f0); R.rp[s][3] = *(const f32x4*)(rp + 24 + f0 + 4); } }
}
template <int TYPE>
__device__ __forceinline__ void q_convert(const QRaw<TYPE>& R, int s, int h, int t, int d0, float (&x)[8], float (&cm)[8]) {
    const v4u p = R.p[s], f = R.f[s]; const unsigned pw[4] = {p.x, p.y, p.z, p.w}, fw[4] = {f.x, f.y, f.z, f.w};
    if constexpr (TYPE != 2) {
#pragma unroll
        for (int j = 0; j < 4; ++j) { x[2 * j] = __builtin_bit_cast(float, pw[j] << 16); x[2 * j + 1] = __builtin_bit_cast(float, pw[j] & 0xffff0000u); cm[2 * j] = __builtin_bit_cast(float, fw[j] << 16); cm[2 * j + 1] = __builtin_bit_cast(float, fw[j] & 0xffff0000u); }
        if constexpr (TYPE == 0) {
#pragma unroll
            for (int j = 0; j < 8; ++j) x[j] *= 0.14433756729740643f; }
    } else {
        const float sg = (d0 < 24) ? -1.f : 1.f; const f32x4 cs0 = R.rp[s][0], cs1 = R.rp[s][1], sn0 = R.rp[s][2], sn1 = R.rp[s][3];
        const float cmv = (float)(t + 1) * ret_lg(h);
#pragma unroll
        for (int j = 0; j < 4; ++j) { const float xa = __builtin_bit_cast(float, pw[j] << 16), xb = __builtin_bit_cast(float, pw[j] & 0xffff0000u), ya = __builtin_bit_cast(float, fw[j] << 16), yb = __builtin_bit_cast(float, fw[j] & 0xffff0000u);
            const float ca = (j < 2) ? cs0[2 * j] : cs1[2 * j - 4], cb2 = (j < 2) ? cs0[2 * j + 1] : cs1[2 * j - 3], sa = (j < 2) ? sn0[2 * j] : sn1[2 * j - 4], sb = (j < 2) ? sn0[2 * j + 1] : sn1[2 * j - 3];
            x[2 * j] = (xa * ca + sg * ya * sa) * 0.14433756729740643f; x[2 * j + 1] = (xb * cb2 + sg * yb * sb) * 0.14433756729740643f; cm[2 * j] = cmv; cm[2 * j + 1] = cmv; }
    }
}

template <int TYPE>
__device__ __forceinline__ void mixc_batch(const Args& a, int layer, int unit, LAS unsigned char* lds, int tid, int lane, int wave) {
    asm volatile("" : "+v"(tid), "+v"(lane));
    typedef MixCfg<TYPE> C; constexpr int DK = C::DK, DV = C::DV, NV = C::NV, TE = DV / 16;
    unsigned char* ws = a.ws; const bf16* PROJ = (const bf16*)(ws + WS_PROJ); bf16* MIX = (bf16*)(ws + WS_MIX);
    LAS bf16* VT = (LAS bf16*)(lds + LC_VT); LAS bf16* ST = (LAS bf16*)(lds + LC_ST); LAS bf16* AB = (LAS bf16*)(lds + LC_AB) + wave * 16 * OBP;
    const int row0 = unit * CH;
    const unsigned long long ts0_ = SUB_MASK ? rt_now() : 0ull;
    stage_vt<NV>(PROJ + (size_t)row0 * NPROJ + C::CV, VT, tid);
    SUBSTRETCH(3, ts0_);
    const unsigned long long ts3_ = SUB_MASK ? rt_now() : 0ull;
    { const bf16* SPu = (const bf16*)(ws + WS_SP) + (size_t)unit * ST_TOT + C::STOFF;
        constexpr int NIS = (NV * 8) / NTHR; static_assert((NV * 8) % NTHR == 0, "ST staging"); v4u sw[NIS];
#pragma unroll
        for (int it = 0; it < NIS; ++it) { const int idx = tid + NTHR * it, er = idx >> 3, ch = idx & 7; sw[it] = (v4u){0u, 0u, 0u, 0u}; if (ch * 8 < DK) sw[it] = *(const v4u*)(SPu + (size_t)er * DK + ch * 8); }
#pragma unroll
        for (int it = 0; it < NIS; ++it) { const int idx = tid + NTHR * it, er = idx >> 3, ch = idx & 7; *(LAS v4u*)(ST + er * BP + ch * 8) = sw[it]; } }
    SUBSTRETCH(4, ts3_);
    SUBSTRETCH(0, ts0_);
    if constexpr (TYPE != 2) { LAS float* EC = (LAS float*)(lds + LC_EC);
        for (int idx = tid; idx < 4 * C::NC; idx += NTHR) { const int jb = idx / C::NC, cc = idx - jb * C::NC; EC[jb * 256 + cc] = ((const float*)(ws + WS_CUM + 16 * MiB))[((size_t)unit * 4 + jb) * NDV + C::COFF + cc]; } }
    __syncthreads();
    const unsigned long long ts1_ = SUB_MASK ? rt_now() : 0ull;
    const int h = wave >> 1, hsel = wave & 1, r = lane & 15, g = lane >> 4;
    const LAS bf16* STh = ST + h * DV * BP; const LAS bf16* VTh = VT + h * DV * BP;
    constexpr int NCHK = DV / 8, NOC = (16 * NCHK) / 64;
    f32x4 wn[NOC][2];
#pragma unroll
    for (int i = 0; i < NOC; ++i) { const int cidx = lane + 64 * i, orow = cidx / NCHK, ch = cidx - orow * NCHK; wn[i][0] = (f32x4){1.f, 1.f, 1.f, 1.f}; wn[i][1] = wn[i][0];
        if constexpr (TYPE == 0) { const float* wp = a.gla_norm_w + layer * 384 + h * 96 + 8 * ch; wn[i][0] = *(const f32x4*)wp; wn[i][1] = *(const f32x4*)(wp + 4); }
        if constexpr (TYPE == 1) { const float* wp = a.hg_norm_w + layer * 256 + h * 64 + 8 * ch; wn[i][0] = *(const f32x4*)wp; wn[i][1] = *(const f32x4*)(wp + 4); } }
    QRaw<TYPE> R; v4u kf[4][2]; v4u gvn[NOC];
    auto issue = [&](int I) { q_issue<TYPE>(a, h, (size_t)(row0 + 16 * I + r), g, R);
#pragma unroll
        for (int J = 0; J < 4; ++J) { const int Jc = (J < I) ? J : I; const size_t rowJ = (size_t)(row0 + 16 * Jc + r);
#pragma unroll
            for (int s = 0; s < 2; ++s) { const int d0 = 32 * s + 8 * g; const int d0c = (d0 < DK) ? d0 : 0;
                kf[J][s] = *(const v4u*)((const bf16*)(ws + WS_KT) + rowJ * NKT + C::KOFF + h * DK + d0c); } }
#pragma unroll
        for (int i = 0; i < NOC; ++i) { const int cidx = lane + 64 * i, orow = cidx / NCHK, ch = cidx - orow * NCHK; gvn[i] = *(const v4u*)(PROJ + (size_t)(row0 + 16 * I + orow) * NPROJ + C::CG + h * DV + 8 * ch); } };
    issue(hsel);
#pragma unroll
    for (int ib = 0; ib < 2; ++ib) { const int I = ib ? 3 - hsel : hsel;
        pg8::bf16x8 qh[2], qt[2]; float refv[2][8], qhf[2][8];
#pragma unroll
        for (int s = 0; s < 2; ++s) { const int d0 = 32 * s + 8 * g; const bool valid = d0 < DK; const int d0c = valid ? d0 : 0;
            float x[8], cm[8]; q_convert<TYPE>(R, s, h, 16 * I + r, d0c, x, cm);
            if constexpr (TYPE == 2) {
#pragma unroll
                for (int j = 0; j < 8; ++j) refv[s][j] = (float)(16 * I) * ret_lg(h);
            } else { if (I > 0) { const LAS float* cp = (const LAS float*)(lds + LC_EC) + (I - 1) * 256 + h * DK + d0c; const f32x4 c0 = *(const LAS f32x4*)cp, c1 = *(const LAS f32x4*)(cp + 4);
#pragma unroll
                    for (int j = 0; j < 4; ++j) { refv[s][j] = c0[j]; refv[s][4 + j] = c1[j]; } }
                else {
#pragma unroll
                    for (int j = 0; j < 8; ++j) refv[s][j] = 0.f; } }
            float xt[8];
#pragma unroll
            for (int j = 0; j < 8; ++j) { if constexpr (TYPE == 2) { qhf[s][j] = valid ? x[j] * __expf(cm[j] - refv[s][j]) : 0.f; xt[j] = valid ? x[j] * __expf(cm[j]) : 0.f; }
                else { qhf[s][j] = valid ? x[j] * cm[j] : 0.f; xt[j] = qhf[s][j] * __expf(refv[s][j]); } }
            qh[s] = pack8(qhf[s]); qt[s] = pack8(xt); }
#pragma unroll
        for (int J = 0; J < 4; ++J) { if (J <= I) { f32x4 acc = {0.f, 0.f, 0.f, 0.f};
#pragma unroll
            for (int s = 0; s < 2; ++s) { pg8::bf16x8 qop;
                { float xq[8], ej[8]; const int d0 = 32 * s + 8 * g; const int d0c = (d0 < DK) ? d0 : 0;
                    if constexpr (TYPE == 2) {
#pragma unroll
                        for (int j = 0; j < 8; ++j) ej[j] = (float)(16 * (J + 1)) * ret_lg(h); }
                    else { const LAS float* ep = (const LAS float*)(lds + LC_EC) + J * 256 + h * DK + d0c; const f32x4 e0 = *(const LAS f32x4*)ep, e1 = *(const LAS f32x4*)(ep + 4);
#pragma unroll
                        for (int j = 0; j < 4; ++j) { ej[j] = e0[j]; ej[4 + j] = e1[j]; } }
#pragma unroll
                    for (int j = 0; j < 8; ++j) xq[j] = qhf[s][j] * __expf(fminf(refv[s][j] - ej[j], 80.f));
                    qop = pack8(xq); }
                acc = __builtin_amdgcn_mfma_f32_16x16x32_bf16(qop, __builtin_bit_cast(pg8::bf16x8, kf[J][s]), acc, 0, 0, 0); }
#pragma unroll
            for (int q = 0; q < 4; ++q) { const int i = 4 * g + q; const float v = (J < I || r <= i) ? acc[q] : 0.f; AB[i * BP + 16 * J + r] = (bf16)f2bf(v); } } }
        if ((I & 1) == 0) {
#pragma unroll
            for (int q = 0; q < 4; ++q) AB[(4 * g + q) * BP + 16 * (I + 1) + r] = (bf16)0; }
        v4u gvp[NOC];
#pragma unroll
        for (int i = 0; i < NOC; ++i) gvp[i] = gvn[i];
        if (ib == 0) issue(3 - hsel);
        asm volatile("s_waitcnt lgkmcnt(0)" ::: "memory");
        const pg8::bf16x8 ah0 = *(const LAS pg8::bf16x8*)(AB + r * BP + 8 * g), ah1 = *(const LAS pg8::bf16x8*)(AB + r * BP + 32 + 8 * g);
        f32x4 o[TE];
#pragma unroll
        for (int te = 0; te < TE; ++te) { f32x4 acc = {0.f, 0.f, 0.f, 0.f};
            acc = __builtin_amdgcn_mfma_f32_16x16x32_bf16(qt[0], ldfrag(STh, BP, te * 16, 0, lane), acc, 0, 0, 0);
            acc = __builtin_amdgcn_mfma_f32_16x16x32_bf16(qt[1], ldfrag(STh, BP, te * 16, 32, lane), acc, 0, 0, 0);
            acc = __builtin_amdgcn_mfma_f32_16x16x32_bf16(ah0, ldfrag(VTh, BP, te * 16, 0, lane), acc, 0, 0, 0);
            if (I >= 2) acc = __builtin_amdgcn_mfma_f32_16x16x32_bf16(ah1, ldfrag(VTh, BP, te * 16, 32, lane), acc, 0, 0, 0);
            o[te] = acc; }
        const unsigned long long ts2_ = SUB_MASK ? rt_now() : 0ull;
#pragma unroll
        for (int q = 0; q < 4; ++q) { float s1 = 0.f, s2 = 0.f;
#pragma unroll
            for (int te = 0; te < TE; ++te) { s1 += o[te][q]; s2 += o[te][q] * o[te][q]; }
#pragma unroll
            for (int m = 1; m < 16; m <<= 1) { s1 += __shfl_xor(s1, m); s2 += __shfl_xor(s2, m); }
            float mean = 0.f, rstd;
            if constexpr (TYPE == 2) { mean = s1 * (1.0f / DV); rstd = __builtin_amdgcn_rsqf(fmaxf(s2 * (1.0f / DV) - mean * mean, 0.f) + EPS); }
            else rstd = __builtin_amdgcn_rsqf(s2 * (1.0f / DV) + EPS);
#pragma unroll
            for (int te = 0; te < TE; ++te) AB[(4 * g + q) * OBP + te * 16 + r] = (bf16)f2bf((o[te][q] - mean) * rstd); }
        asm volatile("s_waitcnt lgkmcnt(0)" ::: "memory");
#pragma unroll
        for (int i = 0; i < NOC; ++i) { const int cidx = lane + 64 * i, orow = cidx / NCHK, ch = cidx - orow * NCHK; const size_t row = (size_t)(row0 + 16 * I + orow);
            const v4u ov = *(const LAS v4u*)(AB + orow * OBP + 8 * ch); const v4u gv = gvp[i];
            const unsigned ow[4] = {ov.x, ov.y, ov.z, ov.w}, gw[4] = {gv.x, gv.y, gv.z, gv.w}; float res[8];
            const f32x4 w0 = wn[i][0], w1 = wn[i][1];
#pragma unroll
            for (int j = 0; j < 4; ++j) { const float oa = __builtin_bit_cast(float, ow[j] << 16), ob = __builtin_bit_cast(float, ow[j] & 0xffff0000u), ga = __builtin_bit_cast(float, gw[j] << 16), gb = __builtin_bit_cast(float, gw[j] & 0xffff0000u);
                const float wa = (j < 2) ? w0[2 * j] : w1[2 * j - 4], wb = (j < 2) ? w0[2 * j + 1] : w1[2 * j - 3];
                const float sa = __builtin_amdgcn_rcpf(1.0f + __expf(-ga)), sb = __builtin_amdgcn_rcpf(1.0f + __expf(-gb));
                res[2 * j] = oa * wa * ((TYPE == 1) ? sa : ga * sa); res[2 * j + 1] = ob * wb * ((TYPE == 1) ? sb : gb * sb); }
            if (F8_OUT) { typedef int i32x2 __attribute__((ext_vector_type(2)));
                *(GAS i32x2*)((unsigned char*)MIX + row * D + C::MIXOFF + h * DV + 8 * ch) = (i32x2){pk4_fp8(res[0] * S8_M, res[1] * S8_M, res[2] * S8_M, res[3] * S8_M), pk4_fp8(res[4] * S8_M, res[5] * S8_M, res[6] * S8_M, res[7] * S8_M)}; }
            else { v4u w; w.x = pk2(res[0], res[1]); w.y = pk2(res[2], res[3]); w.z = pk2(res[4], res[5]); w.w = pk2(res[6], res[7]); *(GAS v4u*)(MIX + row * D + C::MIXOFF + h * DV + 8 * ch) = w; } }
        SUBSTRETCH(2, ts2_);
    }
    SUBSTRETCH(1, ts1_);
    __syncthreads();
}
__device__ __forceinline__ void p3c_outputs(const Args& a, int layer, LAS unsigned char* lds, int vcu, int G, int tid, int lane, int wave) {
    for (int unit = vcu; unit < NUNIT; unit += G) {
        mixc_batch<0>(a, layer, unit, lds, tid, lane, wave);
        mixc_batch<1>(a, layer, unit, lds, tid, lane, wave);
        mixc_batch<2>(a, layer, unit, lds, tid, lane, wave);
    }
}


constexpr int MW_ARGS = 800;
__device__ __forceinline__ const void* ld_argp(const volatile LAS unsigned* T, int i) {
    const unsigned lo = __builtin_amdgcn_readfirstlane(T[2 * i]), hi = __builtin_amdgcn_readfirstlane(T[2 * i + 1]);
    return (const void*)(((unsigned long long)hi << 32) | lo);
}
__device__ __forceinline__ Args load_args(LAS unsigned char* lds) {
    const volatile LAS unsigned* T = (const volatile LAS unsigned*)(lds + MISC_OFF) + MW_ARGS;
    Args a;
    a.x = (const float*)ld_argp(T, 0); a.c = (const float*)ld_argp(T, 1); a.pos = (const int*)ld_argp(T, 2); a.w_mod = (const float*)ld_argp(T, 3); a.b_mod = (const float*)ld_argp(T, 4);
    a.norm1_w = (const float*)ld_argp(T, 5); a.w_in = (const float*)ld_argp(T, 6); a.gla_wa2 = (const float*)ld_argp(T, 7); a.gla_ba2 = (const float*)ld_argp(T, 8); a.hg_lb = (const float*)ld_argp(T, 9);
    a.gla_norm_w = (const float*)ld_argp(T, 10); a.hg_norm_w = (const float*)ld_argp(T, 11); a.w_out = (const float*)ld_argp(T, 12); a.norm2_w = (const float*)ld_argp(T, 13); a.w_r = (const float*)ld_argp(T, 14);
    a.b_r = (const float*)ld_argp(T, 15); a.w_gu = (const float*)ld_argp(T, 16); a.b_gu = (const float*)ld_argp(T, 17); a.w_dn = (const float*)ld_argp(T, 18); a.b_dn = (const float*)ld_argp(T, 19);
    a.final_norm_w = (const float*)ld_argp(T, 20); a.out = (float*)ld_argp(T, 21); a.ws = (unsigned char*)ld_argp(T, 22); a.ph_lo = 0; a.ph_hi = 0;
    return a;
}
#define PH_CTX() { unsigned l_ = (unsigned)(size_t)lds; asm volatile("" : "+s"(l_)); lds = (LAS unsigned char*)(size_t)l_; } const Args args = load_args(lds); volatile LAS unsigned* MISC = (volatile LAS unsigned*)(lds + MISC_OFF); int tid_ = wv * 64 + (int)__builtin_amdgcn_mbcnt_hi(~0u, __builtin_amdgcn_mbcnt_lo(~0u, 0u)); asm volatile("" : "+v"(tid_)); const int tid = tid_, lane = tid & 63, wave = __builtin_amdgcn_readfirstlane(tid >> 6); \
    const int G = gridDim.x; const int bx = blockIdx.x; const int vcu = (G % 8 == 0) ? (bx % 8) * (G / 8) + bx / 8 : bx; unsigned char* ws = args.ws; gu32* ctl = (gu32*)(ws + WS_CTL); \
    (void)MISC; (void)lane; (void)wave; (void)vcu; (void)ctl; (void)bx; (void)tid
__device__ __forceinline__ void ph_p0(LAS unsigned char* lds, int wv) { PH_CTX(); p0_prologue(args, lds, vcu, G, tid, lane, wave); }
__device__ __forceinline__ void ph_p1(LAS unsigned char* lds, int wv, int layer_) { int layer = __builtin_amdgcn_readfirstlane(layer_); asm volatile("" : "+s"(layer)); PH_CTX();
    if (layer > 0) { moe_tables(ctl, layer - 1, MISC, tid); const int nrt = __builtin_amdgcn_readfirstlane((int)MISC[MW_NRT]);
        const int done = conv_t2(G) + conv_idle(nrt * 8, G) * NWAVES * CB7 + conv_idle(nrt * 4, G) * NWAVES * CB8; LAS float* scr = (LAS float*)(lds + wave * 16640);
        for (int it = done + vcu * NWAVES + wave; it < IT_LAYER; it += G * NWAVES) convert_item(args, layer, it, scr, lane);
        __syncthreads(); }
    rows_mfma<16>(args, layer, lds, MISC, ctl, vcu, G, tid, lane, wave); }
__device__ __forceinline__ void ph_p2(LAS unsigned char* lds, int wv, int layer_) { int layer = __builtin_amdgcn_readfirstlane(layer_); asm volatile("" : "+s"(layer)); PH_CTX();
    pg8::Gemm g{(const bf16*)(ws + WS_H), (const bf16*)(ws + WS_WIN + (size_t)layer * NPROJ * D * (F8_IN ? 1 : 2)), MTOK, NPROJ, F8_IN ? D / 2 : D}; pg8::StaticOrder S; S.init(MTOK, NPROJ, G, bx);
    pg8::EpiBf16Plain E{(bf16*)(ws + WS_PROJ), NPROJ, F8_IN ? 1.0f / (S8_H * S8_W) : 1.0f};
    pg8::gemm_phase<pg8::EpiBf16Plain, pg8::StaticOrder, true, true, F8_IN>(lds, g, S, E, tid);
    if (layer + 1 < DEPTH && G == 256 && bx >= 64) convert_range(args, layer + 1, ((bx - 64) * NWAVES + wave) * CB2, CB2, lds, lane, wave); }
__device__ __forceinline__ void ph_p3a(LAS unsigned char* lds, int wv, int layer_) { int layer = __builtin_amdgcn_readfirstlane(layer_); asm volatile("" : "+s"(layer)); PH_CTX(); p3a_summaries(args, layer, lds, vcu, G, tid, lane, wave); }
__device__ __forceinline__ void ph_p3b(LAS unsigned char* lds, int wv) { PH_CTX(); p3b_scan(args, vcu, G, tid); }
__device__ __forceinline__ void ph_p3c(LAS unsigned char* lds, int wv, int layer_) { int layer = __builtin_amdgcn_readfirstlane(layer_); asm volatile("" : "+s"(layer)); PH_CTX(); p3c_outputs(args, layer, lds, vcu, G, tid, lane, wave); }
__device__ __forceinline__ void ph_p4(LAS unsigned char* lds, int wv, int layer_) { int layer = __builtin_amdgcn_readfirstlane(layer_); asm volatile("" : "+s"(layer)); PH_CTX();
    pg8::Gemm g{(const bf16*)(ws + WS_MIX), (const bf16*)(ws + WS_WOUT + (size_t)layer * D * D * (F8_OUT ? 1 : 2)), MTOK, D, F8_OUT ? D / 2 : D}; pg8::StaticOrder S; S.init(MTOK, D, G, bx);
    pg8::EpiResGate E{(const bf16*)(ws + WS_X), (bf16*)(ws + WS_X), D, (const float*)(ws + WS_MOD) + (size_t)layer * 2 * 6144 + 2 * D, 6144, SEQ, F8_OUT ? 1.0f / (S8_M * S8_W) : 1.0f};
    pg8::gemm_phase<pg8::EpiResGate, pg8::StaticOrder, true, true, F8_OUT>(lds, g, S, E, tid); }
__device__ __forceinline__ void ph_p5(LAS unsigned char* lds, int wv, int layer_) { int layer = __builtin_amdgcn_readfirstlane(layer_); asm volatile("" : "+s"(layer)); PH_CTX(); rows_mfma<32>(args, layer, lds, MISC, ctl, vcu, G, tid, lane, wave); }
__device__ __forceinline__ void ph_p7(LAS unsigned char* lds, int wv, int layer_) { int layer = __builtin_amdgcn_readfirstlane(layer_); asm volatile("" : "+s"(layer)); PH_CTX();
    moe_tables(ctl, layer, MISC, tid);
    const int nrt = __builtin_amdgcn_readfirstlane((int)MISC[MW_NRT]);
    pg8::Gemm g{(const bf16*)(ws + WS_A1), (const bf16*)(ws + WS_WGU + (size_t)layer * NE * 2048 * D), nrt * 256, NE * 2048, D / 2};
    pg8::MoeOrder S{8, G, vcu, nrt * 8, (const LAS int*)(lds + MISC_OFF + 4 * MW_TILE)};
    pg8::EpiSwiglu E{ws + WS_ACT, FFN, args.b_gu + (size_t)layer * NE * 2048, 1.0f / (S8_H * S8_W), S8_A};
    pg8::gemm_phase<pg8::EpiSwiglu, pg8::MoeOrder, true, true, true>(lds, g, S, E, tid);
    { const int rem = (nrt * 8) % G; if (layer + 1 < DEPTH && rem != 0 && vcu >= rem) convert_range(args, layer + 1, conv_t2(G) + ((vcu - rem) * NWAVES + wave) * CB7, CB7, lds, lane, wave); } }
__device__ __forceinline__ void ph_p8(LAS unsigned char* lds, int wv, int layer_) { int layer = __builtin_amdgcn_readfirstlane(layer_); asm volatile("" : "+s"(layer)); PH_CTX();
    moe_tables(ctl, layer, MISC, tid);
    const int nrt = __builtin_amdgcn_readfirstlane((int)MISC[MW_NRT]);
    pg8::Gemm g{(const bf16*)(ws + WS_ACT), (const bf16*)(ws + WS_WDN + (size_t)layer * NE * D * FFN), nrt * 256, NE * D, FFN / 2};
    pg8::MoeOrder S{4, G, vcu, nrt * 4, (const LAS int*)(lds + MISC_OFF + 4 * MW_TILE)};
    if constexpr (Y8) { pg8::EpiFp8Bias E{ws + WS_Y, D, args.b_dn + (size_t)layer * NE * D, D, 1.0f / (S8_A * S8_W), S8_Y};
        pg8::gemm_phase<pg8::EpiFp8Bias, pg8::MoeOrder, true, true, true>(lds, g, S, E, tid); }
    else { pg8::EpiBf16Bias E{(bf16*)(ws + WS_Y), D, args.b_dn + (size_t)layer * NE * D, D, 1.0f / (S8_A * S8_W)};
        pg8::gemm_phase<pg8::EpiBf16Bias, pg8::MoeOrder, true, true, true>(lds, g, S, E, tid); }
    { const int rem = (nrt * 4) % G; if (layer + 1 < DEPTH && rem != 0 && vcu >= rem) convert_range(args, layer + 1, conv_t2(G) + conv_idle(nrt * 8, G) * NWAVES * CB7 + ((vcu - rem) * NWAVES + wave) * CB8, CB8, lds, lane, wave); } }
__device__ __forceinline__ void ph_final(LAS unsigned char* lds, int wv) { PH_CTX(); final_rows(args, lds, vcu, G, tid, lane); }

#ifndef DBL_MASK
#define DBL_MASK 0
#endif
#if DBL_MASK
#define RUN(bit, call) do { if ((DBL_MASK >> (bit)) & 1) { const unsigned long long t0_ = __builtin_amdgcn_s_memrealtime(); call; const unsigned long long t1_ = __builtin_amdgcn_s_memrealtime(); \
        while (__builtin_amdgcn_s_memrealtime() - t1_ < t1_ - t0_) __builtin_amdgcn_s_sleep(8); } else { call; } } while (0)
#else
#define RUN(bit, call) do { call; } while (0)
#endif
__global__ void __launch_bounds__(NTHR, 2) hybrid_fwd(Args args) {
    extern __shared__ __attribute__((aligned(16))) unsigned char lds_raw[];
    LAS unsigned char* lds = (LAS unsigned char*)lds_raw;
    volatile LAS unsigned* MISC = (volatile LAS unsigned*)(lds + MISC_OFF);
    const int tid = threadIdx.x; const int wv = __builtin_amdgcn_readfirstlane(tid >> 6);
    gu32* ctl = (gu32*)(args.ws + WS_CTL);
    for (int u = tid; u < (LDS_BYTES - MISC_OFF) / 4; u += NTHR) MISC[u] = 0u;
    __syncthreads();
    if (tid == 0) {
#define ST_ARG(i, p) do { const unsigned long long v_ = (unsigned long long)(p); MISC[MW_ARGS + 2 * (i)] = (unsigned)v_; MISC[MW_ARGS + 2 * (i) + 1] = (unsigned)(v_ >> 32); } while (0)
        ST_ARG(0, args.x); ST_ARG(1, args.c); ST_ARG(2, args.pos); ST_ARG(3, args.w_mod); ST_ARG(4, args.b_mod); ST_ARG(5, args.norm1_w); ST_ARG(6, args.w_in); ST_ARG(7, args.gla_wa2); ST_ARG(8, args.gla_ba2);
        ST_ARG(9, args.hg_lb); ST_ARG(10, args.gla_norm_w); ST_ARG(11, args.hg_norm_w); ST_ARG(12, args.w_out); ST_ARG(13, args.norm2_w); ST_ARG(14, args.w_r); ST_ARG(15, args.b_r); ST_ARG(16, args.w_gu);
        ST_ARG(17, args.b_gu); ST_ARG(18, args.w_dn); ST_ARG(19, args.b_dn); ST_ARG(20, args.final_norm_w); ST_ARG(21, args.out); ST_ARG(22, args.ws);
#undef ST_ARG
    }
    __syncthreads();
    const int lo = args.ph_lo, hi = args.ph_hi;
    const bool multi = (hi - lo) > 1;
    XcdBarrier bar; bar.bar = (unsigned*)(ctl + CW_BAR); bar.x = 0; bar.st = nullptr;
    if (multi) bar = xcd_barrier_post((unsigned*)(ctl + CW_BAR), MISC + MW_BAR);
#define IN(k) (lo <= (k) && (k) < hi)
#define SEAM(k) do { if (IN(k) && IN((k) + 1)) xcd_barrier(bar); } while (0)

    if (IN(0)) RUN(0, ph_p0(lds, wv));
    SEAM(0);
    for (int layer = 0; layer < DEPTH; ++layer) {
        const int pb = 1 + 9 * layer;
        if (IN(pb + 0)) RUN(1, ph_p1(lds, wv, layer));
        SEAM(pb + 0);
        if (IN(pb + 1)) RUN(2, ph_p2(lds, wv, layer));
        SEAM(pb + 1);
        if (IN(pb + 2)) RUN(3, ph_p3a(lds, wv, layer));
        SEAM(pb + 2);
        if (IN(pb + 3)) RUN(4, ph_p3b(lds, wv));
        SEAM(pb + 3);
        if (IN(pb + 4)) RUN(5, ph_p3c(lds, wv, layer));
        SEAM(pb + 4);
        if (IN(pb + 5)) RUN(6, ph_p4(lds, wv, layer));
        SEAM(pb + 5);
        if (IN(pb + 6)) RUN(7, ph_p5(lds, wv, layer));
        SEAM(pb + 6);
        if (IN(pb + 7)) RUN(9, ph_p7(lds, wv, layer));
        SEAM(pb + 7);
        if (IN(pb + 8)) RUN(10, ph_p8(lds, wv, layer));
        SEAM(pb + 8);
    }
    if (IN(NPHASE - 1)) RUN(11, ph_final(lds, wv));
#undef IN
#undef SEAM
}

#ifndef MK_SINGLE
#define MK_SINGLE 1
#endif
extern "C" void kernel_launch(void* const* d_in, const int* in_sizes, int n_in, void* d_out, int out_size, void* d_ws, size_t ws_size, hipStream_t stream) {
    static int grid = 0;
    if (grid == 0) {
        if (n_in != 21 || in_sizes[0] != MTOK * D || out_size != MTOK * D || ws_size < WS_END) { fprintf(stderr, "kernel_launch: unexpected problem shape (n_in %d, in0 %d, out %d, ws %zu)\n", n_in, n_in > 0 ? in_sizes[0] : -1, out_size, ws_size); grid = -1; return; }
        int dev = 0, cus = 0, per_cu = 0;
        if (hipGetDevice(&dev) != hipSuccess || hipDeviceGetAttribute(&cus, hipDeviceAttributeMultiprocessorCount, dev) != hipSuccess) { grid = -1; return; }
        if (hipFuncSetAttribute((const void*)hybrid_fwd, hipFuncAttributeMaxDynamicSharedMemorySize, LDS_BYTES) != hipSuccess) { fprintf(stderr, "kernel_launch: hipFuncSetAttribute failed\n"); grid = -1; return; }
        if (hipOccupancyMaxActiveBlocksPerMultiprocessor(&per_cu, (const void*)hybrid_fwd, NTHR, LDS_BYTES) != hipSuccess || per_cu < 1) fprintf(stderr, "kernel_launch: occupancy query says %d\n", per_cu);
        (void)hipGetLastError();
        grid = cus;
    }
    if (grid < 0) return;
    (void)hipMemsetAsync((char*)d_ws + WS_CTL, 0, CTL_ZERO_BYTES, stream);
    Args a{};
    a.x = (const float*)d_in[0]; a.c = (const float*)d_in[1]; a.pos = (const int*)d_in[2]; a.w_mod = (const float*)d_in[3]; a.b_mod = (const float*)d_in[4]; a.norm1_w = (const float*)d_in[5];
    a.w_in = (const float*)d_in[6]; a.gla_wa2 = (const float*)d_in[7]; a.gla_ba2 = (const float*)d_in[8]; a.hg_lb = (const float*)d_in[9]; a.gla_norm_w = (const float*)d_in[10]; a.hg_norm_w = (const float*)d_in[11];
    a.w_out = (const float*)d_in[12]; a.norm2_w = (const float*)d_in[13]; a.w_r = (const float*)d_in[14]; a.b_r = (const float*)d_in[15]; a.w_gu = (const float*)d_in[16]; a.b_gu = (const float*)d_in[17];
    a.w_dn = (const float*)d_in[18]; a.b_dn = (const float*)d_in[19]; a.final_norm_w = (const float*)d_in[20]; a.out = (float*)d_out; a.ws = (unsigned char*)d_ws;
#if MK_SINGLE
    a.ph_lo = 0; a.ph_hi = NPHASE;
    hipLaunchKernelGGL(hybrid_fwd, dim3(grid), dim3(NTHR), LDS_BYTES, stream, a);
#else
    for (int p = 0; p < NPHASE; ++p) { a.ph_lo = p; a.ph_hi = p + 1; hipLaunchKernelGGL(hybrid_fwd, dim3(grid), dim3(NTHR), LDS_BYTES, stream, a); }
#endif
}
```

```cpp
#include <hip/hip_runtime.h>
#include <cstdio>
#include <cstdint>
namespace pg8 {
#define PG8_LAS __attribute__((address_space(3)))
typedef unsigned short bf16_t;
typedef short bf16x8 __attribute__((ext_vector_type(8)));
typedef float f32x4 __attribute__((ext_vector_type(4)));
typedef unsigned u32x4 __attribute__((ext_vector_type(4)));
constexpr int BM = 256, BK = 64, HALF = 128, HTB = HALF * BK * 2  , STAGE_BYTES = 8 * HTB, NXCD = 8, WGM = 8;

__host__ __device__ __forceinline__ int lds_byte(int r, int c) { const int st = (r >> 4) * 2 + (c >> 5), rr = r & 15, cc = c & 31, ob = rr * 64 + cc * 2; return st * 1024 + (ob ^ (((ob >> 9) & 1) << 5)); }
__host__ __device__ __forceinline__ void stage_rc(int b, int& R, int& C) { const int st = b / 1024, sb = b % 1024, swz = sb ^ (((sb >> 9) & 1) << 5); R = (st >> 1) * 16 + swz / 64; C = (st & 1) * 32 + (swz % 64) / 2; }
__host__ __device__ __forceinline__ int perm32(int rho) { const int n = rho >> 4, i = rho & 15; return 8 * (i >> 2) + 4 * n + (i & 3); }

struct Unit { int pm, pn, e, pl; };
struct Gemm { const bf16_t* A; const bf16_t* Bt; int M, N, K; };

struct StaticOrder {
    int nM, nN, nwg, G, c;
    __host__ __device__ void init(int M, int N, int G_, int c_) { nM = M / BM; nN = N / BM; nwg = nM * nN; G = G_; c = c_; }
    __host__ __device__ bool next(int i, Unit& u) const {
        const long L = (long)i * G + c; if (L >= nwg) return false;
        int wgid = (int)L; { const int q = nwg / NXCD, r = nwg % NXCD, xcd = wgid % NXCD, off = wgid / NXCD; wgid = (xcd < r ? xcd * (q + 1) : r * (q + 1) + (xcd - r) * q) + off; }
        const int nig = WGM * nN, gid = wgid / nig, fm = gid * WGM, gsz = (nM - fm) < WGM ? (nM - fm) : WGM;
        u.pm = fm + ((wgid % nig) % gsz); u.pn = (wgid % nig) / gsz; u.e = 0; u.pl = u.pn; return true;
    }
    __device__ __forceinline__ void a_ready(const Unit&) const {}
    __device__ __forceinline__ void done(const Unit&) const {}
};

__device__ __forceinline__ unsigned cvt_pk_bf16(float lo, float hi) { unsigned r; asm volatile("v_cvt_pk_bf16_f32 %0, %1, %2" : "=v"(r) : "v"(lo), "v"(hi)); return r; }

#define PG8_GAS __attribute__((address_space(1)))
struct NoPre {};
struct EpiBf16Plain {
    static constexpr bool PERM = true, AFTER_DRAIN = false; static constexpr int NST = 0; typedef NoPre Pre;
    __device__ __forceinline__ Pre prefetch(const Unit&, int, int) const { return Pre{}; }
    bf16_t* O; int ldc; float sc;
    __device__ __forceinline__ void operator()(const f32x4 (&acc)[2][2][4][2], const Unit& u, int wr, int wc, int fr, int fq, const Pre&) const {
        const int row0 = u.pm * BM + wr * 64 + fr; const int col0 = u.pn * BM + wc * 32 + 8 * fq;
#pragma unroll
        for (int ai = 0; ai < 2; ++ai)
#pragma unroll
            for (int m = 0; m < 4; ++m) { bf16_t* rowp = O + (size_t)(row0 + ai * HALF + m * 16) * ldc + col0;
#pragma unroll
                for (int bj = 0; bj < 2; ++bj) { const f32x4 v0 = acc[ai][bj][m][0] * sc, v1 = acc[ai][bj][m][1] * sc;
                    u32x4 w; w.x = cvt_pk_bf16(v0[0], v0[1]); w.y = cvt_pk_bf16(v0[2], v0[3]); w.z = cvt_pk_bf16(v1[0], v1[1]); w.w = cvt_pk_bf16(v1[2], v1[3]);
                    *(PG8_GAS u32x4*)(rowp + bj * HALF) = w; } }
    }
};
struct EpiResGate {
    static constexpr bool PERM = true, AFTER_DRAIN = false; static constexpr int NST = 0; typedef NoPre Pre;
    __device__ __forceinline__ Pre prefetch(const Unit&, int, int) const { return Pre{}; }
    const bf16_t* base; bf16_t* out; int ldc; const float* gate; int gpitch; int rows_per_batch; float sc;
    __device__ __forceinline__ void operator()(const f32x4 (&acc)[2][2][4][2], const Unit& u, int wr, int wc, int fr, int fq, const Pre&) const {
        const int row0 = u.pm * BM + wr * 64 + fr, col0 = u.pn * BM + wc * 32 + 8 * fq;
        const float* gp = gate + (size_t)((u.pm * BM) / rows_per_batch) * gpitch + col0;
        f32x4 gv[2][2];
#pragma unroll
        for (int bj = 0; bj < 2; ++bj)
#pragma unroll
            for (int n = 0; n < 2; ++n) gv[bj][n] = *(const PG8_GAS f32x4*)(gp + bj * HALF + 4 * n) * sc;
#pragma unroll
        for (int ai = 0; ai < 2; ++ai)
#pragma unroll
            for (int m = 0; m < 4; ++m) { const size_t off = (size_t)(row0 + ai * HALF + m * 16) * ldc + col0;
#pragma unroll
                for (int bj = 0; bj < 2; ++bj) { const u32x4 bs = *(const PG8_GAS u32x4*)(base + off + bj * HALF); const unsigned bw[4] = {bs.x, bs.y, bs.z, bs.w}; float r[8];
#pragma unroll
                    for (int j = 0; j < 4; ++j) { const f32x4& a4 = acc[ai][bj][m][j >> 1]; const f32x4& g4 = gv[bj][j >> 1];
                        r[2 * j] = __builtin_bit_cast(float, bw[j] << 16) + g4[2 * (j & 1)] * a4[2 * (j & 1)]; r[2 * j + 1] = __builtin_bit_cast(float, bw[j] & 0xffff0000u) + g4[2 * (j & 1) + 1] * a4[2 * (j & 1) + 1]; }
                    u32x4 w; w.x = cvt_pk_bf16(r[0], r[1]); w.y = cvt_pk_bf16(r[2], r[3]); w.z = cvt_pk_bf16(r[4], r[5]); w.w = cvt_pk_bf16(r[6], r[7]);
                    *(PG8_GAS u32x4*)(out + off + bj * HALF) = w; }
                asm volatile("" ::: "memory"); }
    }
};
struct EpiSwiglu {
    static constexpr bool PERM = true, AFTER_DRAIN = false; static constexpr int NST = 0; struct Pre { f32x4 bg[2], bu[2]; };
    __device__ __forceinline__ Pre prefetch(const Unit& u, int wc, int fq) const { typedef const __attribute__((address_space(1))) f32x4 gf4;
        const float* bp = bias + (size_t)u.e * 2048 + u.pl * HALF + wc * 32 + 8 * fq; Pre p; p.bg[0] = *(gf4*)bp; p.bg[1] = *(gf4*)(bp + 4); p.bu[0] = *(gf4*)(bp + 1024); p.bu[1] = *(gf4*)(bp + 1028); return p; }
    unsigned char* O; int ldc; const float* bias; float inv_in, out_scale;
    __device__ __forceinline__ void operator()(const f32x4 (&acc)[2][2][4][2], const Unit& u, int wr, int wc, int fr, int fq, const Pre& pre) const {
        const int row0 = u.pm * BM + wr * 64 + fr; const int jj0 = wc * 32 + 8 * fq; const int col0 = u.pl * HALF + jj0;
        const float rinv = 1.0f / inv_in, lim = 7.0f * rinv, kc = -1.702f * 1.4426950408889634f * inv_in, k2 = inv_in * inv_in * out_scale, k3 = inv_in * out_scale;
        const f32x4 bg[2] = {pre.bg[0] * rinv, pre.bg[1] * rinv}, bu[2] = {pre.bu[0] * rinv, pre.bu[1] * rinv};
#pragma unroll
        for (int ai = 0; ai < 2; ++ai)
#pragma unroll
            for (int m = 0; m < 4; ++m) { unsigned char* rowp = O + (size_t)(row0 + ai * HALF + m * 16) * ldc + col0;
                f32x4 r[2];
#pragma unroll
                for (int n = 0; n < 2; ++n) { f32x4 A = acc[ai][0][m][n] + bg[n], B = acc[ai][1][m][n] + bu[n];
#pragma unroll
                    for (int j = 0; j < 4; ++j) { A[j] = fminf(A[j], lim); B[j] = __builtin_amdgcn_fmed3f(B[j], -lim, lim); }
                    f32x4 e = A * kc;
#pragma unroll
                    for (int j = 0; j < 4; ++j) e[j] = __builtin_amdgcn_exp2f(e[j]);
                    e = e + 1.0f;
#pragma unroll
                    for (int j = 0; j < 4; ++j) e[j] = __builtin_amdgcn_rcpf(e[j]);
                    r[n] = (B * k2 + k3) * (A * e); }
                int w0 = 0, w1 = 0;
                w0 = __builtin_amdgcn_cvt_pk_fp8_f32(r[0][0], r[0][1], w0, false); w0 = __builtin_amdgcn_cvt_pk_fp8_f32(r[0][2], r[0][3], w0, true);
                w1 = __builtin_amdgcn_cvt_pk_fp8_f32(r[1][0], r[1][1], w1, false); w1 = __builtin_amdgcn_cvt_pk_fp8_f32(r[1][2], r[1][3], w1, true);
                typedef int i32x2 __attribute__((ext_vector_type(2))); *(PG8_GAS i32x2*)rowp = (i32x2){w0, w1}; }
    }
};
struct EpiBf16Bias {
    static constexpr bool PERM = true, AFTER_DRAIN = false; static constexpr int NST = 0; typedef NoPre Pre;
    __device__ __forceinline__ Pre prefetch(const Unit&, int, int) const { return Pre{}; }
    bf16_t* O; int ldc; const float* bias; int bpitch; float inv_in;
    __device__ __forceinline__ void operator()(const f32x4 (&acc)[2][2][4][2], const Unit& u, int wr, int wc, int fr, int fq, const Pre&) const {
        const int row0 = u.pm * BM + wr * 64 + fr; const int col0 = u.pl * BM + wc * 32 + 8 * fq;
        const float* bp = bias + (size_t)u.e * bpitch + col0;
        f32x4 bv[2][2];
#pragma unroll
        for (int bj = 0; bj < 2; ++bj)
#pragma unroll
            for (int n = 0; n < 2; ++n) bv[bj][n] = *(const PG8_GAS f32x4*)(bp + bj * HALF + 4 * n);
#pragma unroll
        for (int ai = 0; ai < 2; ++ai)
#pragma unroll
            for (int m = 0; m < 4; ++m) { bf16_t* rowp = O + (size_t)(row0 + ai * HALF + m * 16) * ldc + col0;
#pragma unroll
                for (int bj = 0; bj < 2; ++bj) { const f32x4 v0 = acc[ai][bj][m][0] * inv_in + bv[bj][0], v1 = acc[ai][bj][m][1] * inv_in + bv[bj][1];
                    u32x4 w; w.x = cvt_pk_bf16(v0[0], v0[1]); w.y = cvt_pk_bf16(v0[2], v0[3]); w.z = cvt_pk_bf16(v1[0], v1[1]); w.w = cvt_pk_bf16(v1[2], v1[3]);
                    *(PG8_GAS u32x4*)(rowp + bj * HALF) = w; } }
    }
};
struct EpiFp8Bias {
    static constexpr bool PERM = true, AFTER_DRAIN = false; static constexpr int NST = 0; struct Pre { f32x4 bv[2][2]; };
    __device__ __forceinline__ Pre prefetch(const Unit& u, int wc, int fq) const { typedef const __attribute__((address_space(1))) f32x4 gf4;
        const float* bp = bias + (size_t)u.e * bpitch + u.pl * BM + wc * 32 + 8 * fq; Pre p; p.bv[0][0] = *(gf4*)bp; p.bv[0][1] = *(gf4*)(bp + 4); p.bv[1][0] = *(gf4*)(bp + HALF); p.bv[1][1] = *(gf4*)(bp + HALF + 4); return p; }
    unsigned char* O; int ldc; const float* bias; int bpitch; float inv_in, out_scale;
    __device__ __forceinline__ int pk4(f32x4 v) const { int w = 0; w = __builtin_amdgcn_cvt_pk_fp8_f32(__builtin_amdgcn_fmed3f(v[0], -448.f, 448.f), __builtin_amdgcn_fmed3f(v[1], -448.f, 448.f), w, false);
        return __builtin_amdgcn_cvt_pk_fp8_f32(__builtin_amdgcn_fmed3f(v[2], -448.f, 448.f), __builtin_amdgcn_fmed3f(v[3], -448.f, 448.f), w, true); }
    __device__ __forceinline__ void operator()(const f32x4 (&acc)[2][2][4][2], const Unit& u, int wr, int wc, int fr, int fq, const Pre& pre) const {
        const int row0 = u.pm * BM + wr * 64 + fr; const int col0 = u.pl * BM + wc * 32 + 8 * fq;
        const float ks = inv_in * out_scale; const f32x4 bv[2][2] = {{pre.bv[0][0] * out_scale, pre.bv[0][1] * out_scale}, {pre.bv[1][0] * out_scale, pre.bv[1][1] * out_scale}};
#pragma unroll
        for (int ai = 0; ai < 2; ++ai)
#pragma unroll
            for (int m = 0; m < 4; ++m) { unsigned char* rowp = O + (size_t)(row0 + ai * HALF + m * 16) * ldc + col0;
#pragma unroll
                for (int bj = 0; bj < 2; ++bj) { const f32x4 v0 = acc[ai][bj][m][0] * ks + bv[bj][0], v1 = acc[ai][bj][m][1] * ks + bv[bj][1];
                    typedef int i32x2 __attribute__((ext_vector_type(2))); *(PG8_GAS i32x2*)(rowp + bj * HALF) = (i32x2){pk4(v0), pk4(v1)}; } }
    }
};
struct MoeOrder {
    int nN, G, c, nunits; const PG8_LAS int* tile_pm;
    __device__ __forceinline__ bool next(int i, Unit& u) const {
        const int L = i * G + c; if (L >= nunits) return false;
        const int idx = L / nN, pl = L - idx * nN, pm = __builtin_amdgcn_readfirstlane(tile_pm[idx]), e = pm >> 6;
        u.pm = pm; u.pl = pl; u.e = e; u.pn = e * nN + pl; return true;
    }
    __device__ __forceinline__ void a_ready(const Unit&) const {}
    __device__ __forceinline__ void done(const Unit&) const {}
};
typedef int v4i32_t __attribute__((ext_vector_type(4)));
typedef int v8i32_t __attribute__((ext_vector_type(8)));
template <class Epi, class Sched, bool ALIGN_EPI = false, bool SP2 = false, bool FP8 = false>
__device__ __forceinline__ void gemm_phase(PG8_LAS unsigned char* lds, const Gemm g, const Sched& S, const Epi& E, int tid_in) {
    int tid_ = tid_in; asm volatile("" : "+v"(tid_)); const int tid = tid_, wid = __builtin_amdgcn_readfirstlane(tid >> 6), lane = tid & 63, wr = wid >> 2, wc = wid & 3, fr = lane & 15, fq = lane >> 4;
    const int K = g.K, nt = K / BK;
    unsigned voffA, voffB;
    { int R, C; stage_rc(tid * 16, R, C); const int Rb = Epi::PERM ? ((R & ~31) + perm32(R & 31)) : R;
        voffA = (unsigned)(R * K + C) * 2u; voffB = (unsigned)(Rb * K + C) * 2u; }
    const size_t rstep = (size_t)64 * K * 2;
    const size_t kstep = (size_t)(BK * 2);
    const size_t hstep = (size_t)HALF * K * 2;
    const size_t tstep = 2 * hstep;
    const unsigned ldsw = (unsigned)wid * 1024u;
    const int aoff = lds_byte(wr * 64 + fr, fq * 8), boff = lds_byte(wc * 32 + fr, fq * 8);
#define PG8_SA(b, h) (((b) * 2 + (h)) * HTB)
#define PG8_SB(b, h) ((4 + (b) * 2 + (h)) * HTB)
#define PG8_STAGE(bufoff, gbase, voff) do { _Pragma("unroll") for (int _i = 0; _i < 2; ++_i) \
        __builtin_amdgcn_global_load_lds((const unsigned*)((const char*)(gbase) + _i * rstep + (voff)), (PG8_LAS unsigned*)(lds + (bufoff) + ldsw + _i * 8192), 16, 0, 0); } while (0)
#define PG8_LDA(dst, b, h) do { _Pragma("unroll") for (int m = 0; m < 4; ++m) _Pragma("unroll") for (int k = 0; k < 2; ++k) dst[m][k] = *(const PG8_LAS bf16x8*)(lds + PG8_SA(b, h) + aoff + m * 2048 + k * 1024); } while (0)
#define PG8_LDB(dst, b, h) do { _Pragma("unroll") for (int n = 0; n < 2; ++n) _Pragma("unroll") for (int k = 0; k < 2; ++k) dst[n][k] = *(const PG8_LAS bf16x8*)(lds + PG8_SB(b, h) + boff + n * 2048 + k * 1024); } while (0)
#define PG8_MMA(ai, bj, At, Bt) do { __builtin_amdgcn_s_setprio(1); _Pragma("unroll") for (int m = 0; m < 4; ++m) _Pragma("unroll") for (int n = 0; n < 2; ++n) { \
        if constexpr (FP8) { const v8i32_t a8_ = __builtin_shufflevector(__builtin_bit_cast(v4i32_t, At[m][0]), __builtin_bit_cast(v4i32_t, At[m][1]), 0, 1, 2, 3, 4, 5, 6, 7); \
            const v8i32_t b8_ = __builtin_shufflevector(__builtin_bit_cast(v4i32_t, Bt[n][0]), __builtin_bit_cast(v4i32_t, Bt[n][1]), 0, 1, 2, 3, 4, 5, 6, 7); \
            asm volatile("v_mfma_scale_f32_16x16x128_f8f6f4 %0, %1, %2, %0, %3, %3 op_sel_hi:[0,0,0]" : "+v"(acc[ai][bj][m][n]) : "v"(b8_), "v"(a8_), "v"(one8_)); } \
        else { _Pragma("unroll") for (int k = 0; k < 2; ++k) acc[ai][bj][m][n] = __builtin_amdgcn_mfma_f32_16x16x32_bf16(Bt[n][k], At[m][k], acc[ai][bj][m][n], 0, 0, 0); } } \
        __builtin_amdgcn_s_setprio(0); } while (0)
#define PG8_WAIT_V(n) asm volatile("s_waitcnt vmcnt(" #n ")" ::: "memory")
#define PG8_WAIT_L(n) asm volatile("s_waitcnt lgkmcnt(" #n ")" ::: "memory")
#define PG8_WAIT_V8R(relax) do { if (relax) { if constexpr (Epi::NST == 8) PG8_WAIT_V(16); else if constexpr (Epi::NST == 16) PG8_WAIT_V(24); else PG8_WAIT_V(8); } else PG8_WAIT_V(8); } while (0)
#define PG8_BAR __builtin_amdgcn_s_barrier()
#define PG8_SCHED __builtin_amdgcn_sched_barrier(0)
    Unit cur, nxt; int ui = 0;
    if (!S.next(0, cur)) return;
    f32x4 acc[2][2][4][2];
#pragma unroll
    for (int a = 0; a < 2; ++a)
#pragma unroll
        for (int b = 0; b < 2; ++b)
#pragma unroll
            for (int m = 0; m < 4; ++m)
#pragma unroll
                for (int n = 0; n < 2; ++n) acc[a][b][m][n] = (f32x4){0.f, 0.f, 0.f, 0.f};
    bf16x8 At[4][2], B0[2][2], B1[2][2];
    int one8_ = 0x7f7f7f7f; asm volatile("" : "+v"(one8_));
    const char* cA = (const char*)g.A + (size_t)cur.pm * tstep; const char* cB = (const char*)g.Bt + (size_t)cur.pn * tstep;
    S.a_ready(cur);
    if constexpr (SP2) {
        PG8_STAGE(PG8_SB(0, 0), cB, voffB); PG8_STAGE(PG8_SB(0, 1), cB + hstep, voffB); PG8_STAGE(PG8_SA(0, 0), cA, voffA); PG8_STAGE(PG8_SA(0, 1), cA + hstep, voffA);
        if (wr == 1) PG8_BAR;
        PG8_WAIT_V(2); PG8_BAR;
        PG8_STAGE(PG8_SB(1, 0), cB + kstep, voffB); PG8_STAGE(PG8_SA(1, 0), cA + kstep, voffA); PG8_STAGE(PG8_SB(1, 1), cB + hstep + kstep, voffB);
        PG8_WAIT_V(6); PG8_BAR;
    } else {
        PG8_STAGE(PG8_SB(0, 0), cB, voffB); PG8_STAGE(PG8_SA(0, 0), cA, voffA); PG8_STAGE(PG8_SB(0, 1), cB + hstep, voffB); PG8_STAGE(PG8_SA(0, 1), cA + hstep, voffA);
        if (wr == 1) PG8_BAR;
        PG8_WAIT_V(4); PG8_BAR;
        PG8_STAGE(PG8_SB(1, 0), cB + kstep, voffB); PG8_STAGE(PG8_SA(1, 0), cA + kstep, voffA); PG8_STAGE(PG8_SB(1, 1), cB + hstep + kstep, voffB);
        PG8_WAIT_V(6); PG8_BAR;
    }
    for (;;) {
        const bool has_next = S.next(ui + 1, nxt);
        typename Epi::Pre pre_; { int lp_ = (int)__builtin_amdgcn_mbcnt_hi(~0u, __builtin_amdgcn_mbcnt_lo(~0u, 0u)); asm volatile("" : "+v"(lp_)); pre_ = E.prefetch(cur, wc, lp_ >> 4); }
        const char* nA = has_next ? (const char*)g.A + (size_t)nxt.pm * tstep : cA; const char* nB = has_next ? (const char*)g.Bt + (size_t)nxt.pn * tstep : cB;
#pragma unroll 1
        for (int t = 0; t < nt; t += 2) {
            const bool last = (t == nt - 2);
            const char* a1 = cA + (size_t)(t + 1) * kstep;
            const char* a2 = last ? nA : cA + (size_t)(t + 2) * kstep; const char* b2 = last ? nB : cB + (size_t)(t + 2) * kstep;
            const char* a3 = a2 + kstep; const char* b3 = b2 + kstep;
            if (last && has_next) S.a_ready(nxt);
            const bool relax = (Epi::NST > 0) && (ui > 0) && (t == 0);
            if constexpr (SP2) {
            PG8_LDB(B0, 0, 0); PG8_LDB(B1, 0, 1); PG8_SCHED; PG8_LDA(At, 0, 0); PG8_STAGE(PG8_SA(1, 1), a1 + hstep, voffA);
            PG8_WAIT_V8R(relax); PG8_WAIT_L(0); PG8_BAR; PG8_MMA(0, 0, At, B0); PG8_MMA(0, 1, At, B1); PG8_BAR; PG8_SCHED;
            PG8_LDA(At, 0, 1); PG8_STAGE(PG8_SB(0, 0), b2, voffB); PG8_STAGE(PG8_SB(0, 1), b2 + hstep, voffB); PG8_STAGE(PG8_SA(0, 0), a2, voffA);
            PG8_WAIT_V8R(relax); PG8_WAIT_L(0); PG8_BAR; PG8_MMA(1, 0, At, B0); PG8_MMA(1, 1, At, B1); PG8_BAR; PG8_SCHED;
            PG8_LDB(B0, 1, 0); PG8_LDB(B1, 1, 1); PG8_SCHED; PG8_LDA(At, 1, 0); PG8_STAGE(PG8_SA(0, 1), a2 + hstep, voffA);
            PG8_WAIT_V(8); PG8_WAIT_L(0); PG8_BAR; PG8_MMA(0, 0, At, B0); PG8_MMA(0, 1, At, B1); PG8_BAR; PG8_SCHED;
            PG8_LDA(At, 1, 1); PG8_STAGE(PG8_SB(1, 0), b3, voffB); PG8_STAGE(PG8_SB(1, 1), b3 + hstep, voffB); PG8_STAGE(PG8_SA(1, 0), a3, voffA);
            PG8_WAIT_V(8); PG8_WAIT_L(0); PG8_BAR; PG8_MMA(1, 0, At, B0); PG8_MMA(1, 1, At, B1); PG8_BAR; PG8_SCHED;
            } else {
            PG8_LDB(B0, 0, 0); PG8_SCHED; PG8_LDA(At, 0, 0); PG8_STAGE(PG8_SA(1, 1), a1 + hstep, voffA);
            PG8_WAIT_L(8); PG8_BAR; PG8_WAIT_L(0); PG8_MMA(0, 0, At, B0); PG8_BAR; PG8_SCHED;
            PG8_LDB(B1, 0, 1); PG8_STAGE(PG8_SB(0, 0), b2, voffB);
            PG8_BAR; PG8_WAIT_L(0); PG8_MMA(0, 1, At, B1); PG8_BAR;
            PG8_LDA(At, 0, 1); PG8_STAGE(PG8_SA(0, 0), a2, voffA);
            PG8_BAR; PG8_WAIT_L(0); PG8_MMA(1, 0, At, B0); PG8_BAR; PG8_SCHED;
            PG8_STAGE(PG8_SB(0, 1), b2 + hstep, voffB);
            PG8_WAIT_V(6); PG8_BAR; PG8_MMA(1, 1, At, B1); PG8_BAR;
            PG8_LDB(B0, 1, 0); PG8_SCHED; PG8_LDA(At, 1, 0); PG8_STAGE(PG8_SA(0, 1), a2 + hstep, voffA);
            PG8_WAIT_L(8); PG8_BAR; PG8_WAIT_L(0); PG8_MMA(0, 0, At, B0); PG8_BAR; PG8_SCHED;
            PG8_LDB(B1, 1, 1); PG8_STAGE(PG8_SB(1, 0), b3, voffB);
            PG8_BAR; PG8_WAIT_L(0); PG8_MMA(0, 1, At, B1); PG8_BAR;
            PG8_LDA(At, 1, 1); PG8_STAGE(PG8_SA(1, 0), a3, voffA);
            PG8_BAR; PG8_WAIT_L(0); PG8_MMA(1, 0, At, B0); PG8_BAR; PG8_SCHED;
            PG8_STAGE(PG8_SB(1, 1), b3 + hstep, voffB);
            PG8_WAIT_V(6); PG8_BAR; PG8_MMA(1, 1, At, B1); PG8_BAR;
            }
        }
        if constexpr (FP8) asm volatile("s_nop 7\n\ts_nop 7" ::: "memory");
        if constexpr (ALIGN_EPI) { if (wr == 0) PG8_BAR; }
        if constexpr (!Epi::AFTER_DRAIN) { int ln_ = (int)__builtin_amdgcn_mbcnt_hi(~0u, __builtin_amdgcn_mbcnt_lo(~0u, 0u)); asm volatile("" : "+v"(ln_)); E(acc, cur, wr, wc, ln_ & 15, ln_ >> 4, pre_); S.done(cur); }
        if (!has_next) break;
#pragma unroll
        for (int a = 0; a < 2; ++a)
#pragma unroll
            for (int b = 0; b < 2; ++b)
#pragma unroll
                for (int m = 0; m < 4; ++m)
#pragma unroll
                    for (int n = 0; n < 2; ++n) acc[a][b][m][n] = (f32x4){0.f, 0.f, 0.f, 0.f};
        cur = nxt; cA = nA; cB = nB; ++ui;
        if constexpr (ALIGN_EPI) { if (wr == 1) PG8_BAR; }
    }
    PG8_WAIT_V(0);
    if constexpr (!ALIGN_EPI) { if (wr == 0) PG8_BAR; }
    PG8_BAR;
    if constexpr (Epi::AFTER_DRAIN) { E.fused(acc, cur, wr, wc, fr, fq, lds, wid, lane); S.done(cur); }
#undef PG8_SA
#undef PG8_SB
#undef PG8_STAGE
#undef PG8_LDA
#undef PG8_LDB
#undef PG8_MMA
#undef PG8_WAIT_V
#undef PG8_WAIT_L
#undef PG8_BAR
#undef PG8_SCHED
}
}

constexpr int NWAVES = 8, NTHR = 512;
constexpr int BATCH = 2, SEQ = 8192, D = 1024, DEPTH = 4, MTOK = BATCH * SEQ;
constexpr int DIN = 3344, NPROJ = 3328, SRC_GA = 1152;
constexpr int C_GQ = 0, C_GK = 192, C_GV = 384, C_GG = 768, C_HQ = 1152, C_HF = 1408, C_HI = 1664, C_HG = 1920, C_RQ = 2176, C_RK = 2368, C_RV = 2560, C_RG = 2944;
constexpr int NE = 32, FFN = 1024;
constexpr int CH = 64, NCH = SEQ / CH, NUNIT = BATCH * NCH;
constexpr int ST_GLA = 0, ST_HG = 4 * 48 * 96, ST_RET = ST_HG + 4 * 64 * 64, ST_TOT = ST_RET + 4 * 48 * 96;
constexpr int NDV = 448, NKT = 640;
constexpr int MAXROWS = 65536 + NE * 256, MAXRT = MAXROWS / 256;
constexpr float EPS = 1e-6f;
#ifndef F8_IN_V
#define F8_IN_V false
#endif
#ifndef F8_OUT_V
#define F8_OUT_V true
#endif
constexpr bool F8_IN = F8_IN_V, F8_OUT = F8_OUT_V;
#ifndef Y8_V
#define Y8_V true
#endif
constexpr bool Y8 = Y8_V;
constexpr float S8_Y = 16.f;
constexpr float S8_M = 32.f;
constexpr float S8_W = 2048.f, S8_H = 64.f, S8_A = 8.f;
constexpr int NPHASE = 38;
constexpr int ECAP = 16384, ECAP_SH = 14;

constexpr size_t MiB = 1u << 20;
constexpr size_t WS_CTL = 0, CTL_ZERO_BYTES = 65536;
constexpr size_t WS_MOD = 1 * MiB;
constexpr size_t WS_ROPE = 2 * MiB;
constexpr size_t WS_LB = 5 * MiB;
constexpr size_t WS_WIN = 8 * MiB;
constexpr size_t WS_WOUT = 34 * MiB;
constexpr size_t WS_WGU = 42 * MiB;
constexpr size_t WS_WDN = 554 * MiB;
constexpr size_t WS_X = 810 * MiB;
constexpr size_t WS_H = 874 * MiB;
constexpr size_t WS_GA = 906 * MiB;
constexpr size_t WS_PROJ = 907 * MiB;
constexpr size_t WS_U = 1011 * MiB;
constexpr size_t WS_DVEC = 1063 * MiB;
constexpr size_t WS_SP = 1064 * MiB;
constexpr size_t WS_MIX = 1090 * MiB;
constexpr size_t WS_TOPE = 1122 * MiB;
constexpr size_t WS_TOPW = WS_TOPE + 256 * 1024;
constexpr size_t WS_SLOT = WS_TOPW + 256 * 1024;
constexpr size_t WS_A1 = 1123 * MiB;
constexpr size_t WS_ACT = 1635 * MiB;
constexpr size_t WS_Y = 2147 * MiB;
constexpr size_t WS_CUM = 3171 * MiB;
constexpr size_t WS_KT = 3199 * MiB;
constexpr size_t WS_END = 3239 * MiB;
static_assert(WS_WIN + (size_t)DEPTH * NPROJ * D * 2 <= WS_WOUT && WS_PROJ + (size_t)MTOK * NPROJ * 2 <= WS_U && WS_U + (size_t)NUNIT * ST_TOT * 4 <= WS_DVEC && WS_SP + (size_t)NUNIT * ST_TOT * 2 <= WS_MIX && WS_A1 + (size_t)NE * ECAP * D <= WS_ACT && WS_ACT + (size_t)NE * ECAP * D <= WS_Y && WS_Y + (size_t)NE * ECAP * D * 2 <= WS_CUM, "ws map");
constexpr int CW_TMO = 0, CW_CODE = 1, CW_BAR = 4096, CW_CNT = 8192, CW_FILL = 8192 + 256;
constexpr int RING_BYTES = 131072;
constexpr int MISC_OFF = 147456, LDS_BYTES = MISC_OFF + 4096 + 3072;
constexpr int MW_BAR = 0, MW_CNT = 16, MW_PST = 48, MW_HIST = 96, MW_BASE = 128, MW_TILE = 192, MW_NRT = 480, MW_SLOTS = 512;

#define GAS __attribute__((address_space(1)))
#define LAS __attribute__((address_space(3)))
typedef unsigned v4u __attribute__((ext_vector_type(4)));
typedef float f32x4 __attribute__((ext_vector_type(4)));
typedef short bf16x8 __attribute__((ext_vector_type(8)));
typedef GAS unsigned gu32;
typedef GAS unsigned long long gu64;
#define RLX_AGENT __ATOMIC_RELAXED, __HIP_MEMORY_SCOPE_AGENT
#define LDS_WAIT() asm volatile("s_waitcnt lgkmcnt(0)" ::: "memory")
#define VM_WAIT() asm volatile("s_waitcnt vmcnt(0)" ::: "memory")
__device__ __forceinline__ unsigned long long rt() { return __builtin_amdgcn_s_memrealtime(); }
typedef unsigned short bf16;
typedef float f32x2_t __attribute__((ext_vector_type(2))); typedef __bf16 bf16x2_t __attribute__((ext_vector_type(2)));
__device__ __forceinline__ unsigned pk2(float lo, float hi) { const f32x2_t v = {lo, hi}; return __builtin_bit_cast(unsigned, __builtin_convertvector(v, bf16x2_t)); }
__device__ __forceinline__ unsigned f2bf(float f) { return pk2(f, 0.f) & 0xffffu; }
__device__ __forceinline__ float bf2f(bf16 b) { return __builtin_bit_cast(float, (unsigned)b << 16); }
#define XB_TMO      128
#define XB_XCNT(j)  (256  + 64 * (j))
#define XB_XSUB(j)  (1280 + 64 * (j))
#define XB_XGEN(j)  (2304 + 64 * (j))
#define XB_TOP      3328
#define XB_TOPGEN   3392
#define XCD_BAR_WORDS 3456
#define XB_SPIN_CAP (1u << 18)

__device__ __forceinline__ unsigned xb_ld(unsigned* p)              { return __hip_atomic_load(p, __ATOMIC_RELAXED, __HIP_MEMORY_SCOPE_AGENT); }
__device__ __forceinline__ unsigned xb_add(unsigned* p, unsigned v) { return __hip_atomic_fetch_add(p, v, __ATOMIC_RELAXED, __HIP_MEMORY_SCOPE_AGENT); }
__device__ __forceinline__ unsigned xb_xcc_id() { return (unsigned)__builtin_amdgcn_s_getreg((3 << 11) | 20) & 0xFu; }
#define XB_SPIN(cond, bar) do { unsigned _sp = 0; while (cond) { __builtin_amdgcn_s_sleep(1); \
    if ((++_sp & 255u) == 0u) { if (xb_ld(&(bar)[XB_TMO])) break; if (_sp > XB_SPIN_CAP) { atomicAdd(&(bar)[XB_TMO], 1u); break; } } } } while (0)

struct XcdBarrier {
    unsigned* bar; unsigned x;
    volatile LAS unsigned* st;
};

__device__ __forceinline__ XcdBarrier xcd_barrier_post(unsigned* bar, volatile LAS unsigned* st) {
    XcdBarrier b; b.bar = bar; b.x = xb_xcc_id(); b.st = st;
    if (threadIdx.x == 0) (void)xb_add(&bar[XB_XCNT(b.x)], 1u);
    return b;
}
__device__ __forceinline__ void xcd_barrier_complete(unsigned* bar, unsigned x, unsigned& nloc, unsigned& nx) {
    const unsigned G = gridDim.x * gridDim.y * gridDim.z;
    unsigned sum, cnt, mine, sp = 0u;
    for (;;) {
        sum = 0u; cnt = 0u; mine = 0u;
#pragma unroll
        for (unsigned j = 0; j < 16; ++j) { const unsigned c = xb_ld(&bar[XB_XCNT(j)]); sum += c; cnt += (c > 0u) ? 1u : 0u; mine = (j == x) ? c : mine; }
        if (sum == G) break;
        __builtin_amdgcn_s_sleep(1);
        if ((++sp & 255u) == 0u) { if (xb_ld(&bar[XB_TMO])) break; if (sp > XB_SPIN_CAP) { atomicAdd(&bar[XB_TMO], 1u); break; } }
    }
    nloc = mine > 0u ? mine : 1u; nx = cnt > 0u ? cnt : 1u;
}

__device__ __forceinline__ void xcd_barrier(const XcdBarrier& b) {
    asm volatile("s_waitcnt vmcnt(0)" ::: "memory");
    __syncthreads();
    if (threadIdx.x == 0) {
        unsigned* bar = b.bar;
        __builtin_amdgcn_s_waitcnt(0);
        unsigned nloc = b.st[0], nx = b.st[1];
        if (nloc == 0u) { xcd_barrier_complete(bar, b.x, nloc, nx); b.st[0] = nloc; b.st[1] = nx; }
        const unsigned old = xb_add(&bar[XB_XSUB(b.x)], 1u);
        const unsigned gen = old / nloc;
        if (old + 1u == (gen + 1u) * nloc) {
            __builtin_amdgcn_fence(__ATOMIC_RELEASE, "agent");
            asm volatile("s_waitcnt vmcnt(0)" ::: "memory");
            const unsigned og = xb_add(&bar[XB_TOP], 1u);
            const unsigned tg = og / nx;
            if (og + 1u == (tg + 1u) * nx) xb_add(&bar[XB_TOPGEN], 1u);
            else XB_SPIN(xb_ld(&bar[XB_TOPGEN]) == tg, bar);
            __builtin_amdgcn_fence(__ATOMIC_ACQUIRE, "agent");
            xb_add(&bar[XB_XGEN(b.x)], 1u);
            asm volatile("s_waitcnt vmcnt(0)" ::: "memory");
        } else {
            XB_SPIN(xb_ld(&bar[XB_XGEN(b.x)]) == gen, bar);
            __builtin_amdgcn_fence(__ATOMIC_ACQUIRE, "agent");
            asm volatile("s_waitcnt vmcnt(0)" ::: "memory");
        }
    }
    __syncthreads();
}

__device__ __forceinline__ float wave_sum(float v) {
#pragma unroll
    for (int o = 1; o < 64; o <<= 1) v += __shfl_xor(v, o);
    return v;
}
__device__ __forceinline__ float log_sigmoid_f(float x) { return fminf(x, 0.f) - log1pf(expf(-fabsf(x))); }
__device__ __forceinline__ float silu_f(float x) { return x / (1.0f + expf(-x)); }
__device__ __forceinline__ float sigmoid_f(float x) { return 1.0f / (1.0f + expf(-x)); }
__device__ __forceinline__ pg8::bf16x8 ldfrag(const LAS bf16* base, int stride, int r0, int k0, int lane) {
    return *(const LAS pg8::bf16x8*)(base + (r0 + (lane & 15)) * stride + k0 + 8 * (lane >> 4));
}
__device__ __forceinline__ pg8::bf16x8 pack8(const float (&v)[8]) { v4u w; w.x = pk2(v[0], v[1]); w.y = pk2(v[2], v[3]); w.z = pk2(v[4], v[5]); w.w = pk2(v[6], v[7]); return __builtin_bit_cast(pg8::bf16x8, w); }

struct Args {
    const float* x; const float* c; const int* pos; const float* w_mod; const float* b_mod; const float* norm1_w; const float* w_in; const float* gla_wa2; const float* gla_ba2; const float* hg_lb;
    const float* gla_norm_w; const float* hg_norm_w; const float* w_out; const float* norm2_w; const float* w_r; const float* b_r; const float* w_gu; const float* b_gu; const float* w_dn; const float* b_dn;
    const float* final_norm_w; float* out; unsigned char* ws; int ph_lo, ph_hi;
};

__device__ __forceinline__ void transpose_block64(const float* src, int ld, bf16* dst, LAS float*, int lane) {
    const int n4 = lane & 15, kg = lane >> 4;
    f32x4 v[16];
#pragma unroll
    for (int i = 0; i < 16; ++i) v[i] = __builtin_nontemporal_load((const f32x4*)(src + (size_t)(16 * kg + i) * ld + 4 * n4));
#pragma unroll
    for (int j = 0; j < 4; ++j) { v4u o0, o1;
        o0.x = pk2(v[0][j], v[1][j]); o0.y = pk2(v[2][j], v[3][j]); o0.z = pk2(v[4][j], v[5][j]); o0.w = pk2(v[6][j], v[7][j]);
        o1.x = pk2(v[8][j], v[9][j]); o1.y = pk2(v[10][j], v[11][j]); o1.z = pk2(v[12][j], v[13][j]); o1.w = pk2(v[14][j], v[15][j]);
        bf16* d = dst + (size_t)(4 * n4 + j) * D + 16 * kg; *(GAS v4u*)d = o0; *(GAS v4u*)(d + 8) = o1; }
}
__device__ __forceinline__ float clamp448(float x) { return __builtin_amdgcn_fmed3f(x, -448.f, 448.f); }
__device__ __forceinline__ int pk4_fp8(float a, float b, float c, float d) { int w = 0; w = __builtin_amdgcn_cvt_pk_fp8_f32(clamp448(a), clamp448(b), w, false);
    return __builtin_amdgcn_cvt_pk_fp8_f32(clamp448(c), clamp448(d), w, true); }
__device__ __forceinline__ void transpose_block64_fp8(const float* src, int ld, unsigned char* dst, LAS float*, int lane, float sc) {
    const int n4 = lane & 15, kg = lane >> 4;
    f32x4 v[16];
#pragma unroll
    for (int i = 0; i < 16; ++i) v[i] = __builtin_nontemporal_load((const f32x4*)(src + (size_t)(16 * kg + i) * ld + 4 * n4)) * sc;
#pragma unroll
    for (int j = 0; j < 4; ++j) { v4u o;
        o.x = (unsigned)pk4_fp8(v[0][j], v[1][j], v[2][j], v[3][j]); o.y = (unsigned)pk4_fp8(v[4][j], v[5][j], v[6][j], v[7][j]);
        o.z = (unsigned)pk4_fp8(v[8][j], v[9][j], v[10][j], v[11][j]); o.w = (unsigned)pk4_fp8(v[12][j], v[13][j], v[14][j], v[15][j]);
        *(GAS v4u*)(dst + (size_t)(4 * n4 + j) * D + 16 * kg) = o; }
}
constexpr int IT_IN = 16 * (NPROJ / 64), IT_OUT = 16 * 16, IT_GU = NE * 16 * 32, IT_DN = NE * 16 * 16, IT_LAYER = IT_IN + IT_OUT + IT_GU + IT_DN, IT_ALL = DEPTH * IT_LAYER;
__device__ __forceinline__ void convert_item(const Args& a, int l, int r, LAS float* scr, int lane) {
    unsigned char* ws = a.ws;
    bf16* WIN = (bf16*)(ws + WS_WIN); bf16* WOUT = (bf16*)(ws + WS_WOUT); unsigned char* WGU = ws + WS_WGU; unsigned char* WDN = ws + WS_WDN;
    if (r < IT_IN) { const int kb = r / (NPROJ / 64), nb = r % (NPROJ / 64), n0 = 64 * nb, sc = n0 + (n0 >= SRC_GA ? 16 : 0);
        if (F8_IN) transpose_block64_fp8(a.w_in + ((size_t)l * D + 64 * kb) * DIN + sc, DIN, (unsigned char*)WIN + ((size_t)l * NPROJ + n0) * D + 64 * kb, scr, lane, S8_W);
        else transpose_block64(a.w_in + ((size_t)l * D + 64 * kb) * DIN + sc, DIN, WIN + ((size_t)l * NPROJ + n0) * D + 64 * kb, scr, lane); return; }
    r -= IT_IN;
    if (r < IT_OUT) { const int kb = r / 16, nb = r % 16;
        if (F8_OUT) transpose_block64_fp8(a.w_out + ((size_t)l * D + 64 * kb) * D + 64 * nb, D, (unsigned char*)WOUT + ((size_t)l * D + 64 * nb) * D + 64 * kb, scr, lane, S8_W);
        else transpose_block64(a.w_out + ((size_t)l * D + 64 * kb) * D + 64 * nb, D, WOUT + ((size_t)l * D + 64 * nb) * D + 64 * kb, scr, lane); return; }
    r -= IT_OUT;
    if (r < IT_GU) { const int e = r / 512, r2 = r % 512, kb = r2 / 32, nb = r2 % 32, cc = 64 * nb;
        const int row = (cc < 1024) ? 256 * (cc / 128) + (cc % 128) : 256 * ((cc - 1024) / 128) + 128 + ((cc - 1024) % 128);
        transpose_block64_fp8(a.w_gu + (((size_t)l * NE + e) * D + 64 * kb) * 2048 + cc, 2048, WGU + (((size_t)l * NE + e) * 2048 + row) * D + 64 * kb, scr, lane, S8_W); return; }
    r -= IT_GU;
    { const int e = r / 256, r2 = r % 256, kb = r2 / 16, nb = r2 % 16;
        transpose_block64_fp8(a.w_dn + (((size_t)l * NE + e) * FFN + 64 * kb) * D + 64 * nb, D, WDN + (((size_t)l * NE + e) * D + 64 * nb) * D + 64 * kb, scr, lane, S8_W); }
}
constexpr int CB2 = 4, CB7 = 2, CB8 = 2;
__device__ __forceinline__ int conv_t2(int G) { return (G == 256) ? 192 * NWAVES * CB2 : 0; }
__device__ __forceinline__ int conv_idle(int nunits, int G) { const int rem = nunits % G; return rem ? G - rem : 0; }
__device__ __forceinline__ void convert_range(const Args& a, int l, int first, int count, LAS unsigned char* lds, int lane, int wave) {
    LAS float* scr = (LAS float*)(lds + wave * 16640);
    for (int k = 0; k < count; ++k) { const int it = first + k; if (it < IT_LAYER) convert_item(a, l, it, scr, lane); }
}
__device__ __forceinline__ void p0_prologue(const Args& a, LAS unsigned char* lds, int vcu, int G, int tid, int lane, int wave) {
    unsigned char* ws = a.ws;
    LAS float* scr = (LAS float*)(lds + wave * 16640);
    const int gw = vcu * NWAVES + wave, NGW = G * NWAVES;
    for (int it = gw; it < IT_LAYER; it += NGW) convert_item(a, 0, it, scr, lane);
    __syncthreads();
    {
        LAS float* cact = (LAS float*)lds;
        LAS float* red = (LAS float*)(lds + 8192);
        for (int i = tid; i < 2 * D; i += NTHR) cact[i] = silu_f(a.c[i]);
        __syncthreads();
        float* MOD = (float*)(ws + WS_MOD);
        for (int it = vcu; it < DEPTH * 96; it += G) {
            const int l = it / 96, n0 = (it % 96) * 64;
            const float* wp = a.w_mod + ((size_t)l * D + 128 * wave) * 6144 + n0 + lane;
            float a0 = 0.f, a1 = 0.f;
#pragma unroll 32
            for (int k = 0; k < 128; ++k) { const float w = __builtin_nontemporal_load(wp + (size_t)k * 6144); a0 += cact[128 * wave + k] * w; a1 += cact[D + 128 * wave + k] * w; }
            red[(wave * 2 + 0) * 64 + lane] = a0; red[(wave * 2 + 1) * 64 + lane] = a1;
            __syncthreads();
            if (tid < 128) { const int b = tid >> 6, ln = tid & 63; float s = a.b_mod[l * 6144 + n0 + ln];
#pragma unroll
                for (int w = 0; w < 8; ++w) s += red[(w * 2 + b) * 64 + ln];
                MOD[((size_t)l * 2 + b) * 6144 + n0 + ln] = s; }
            __syncthreads();
        }
    }
    { const f32x4* xs = (const f32x4*)a.x; uint2* xd = (uint2*)(ws + WS_X);
        for (int i = vcu * NTHR + tid; i < MTOK * D / 4; i += G * NTHR) { const f32x4 v = xs[i]; uint2 p; p.x = pk2(v[0], v[1]); p.y = pk2(v[2], v[3]); xd[i] = p; } }
    {
        float* ROPE = (float*)(ws + WS_ROPE);
        for (int i = vcu * NTHR + tid; i < MTOK * 24; i += G * NTHR) { const int t = i / 24, f = i % 24;
            const float inv = (float)pow(10000.0, -(double)f / 24.0); const float ang = (float)a.pos[t] * inv;
            ROPE[(size_t)t * 48 + f] = cosf(ang); ROPE[(size_t)t * 48 + 24 + f] = sinf(ang); }
    }
    if (vcu == 0 && tid < 256) {
        float v[4], mx = -3.0e38f; for (int l = 0; l < 4; ++l) { v[l] = a.hg_lb[l * 256 + tid]; mx = fmaxf(mx, v[l]); }
        float s = 0.f; for (int l = 0; l < 4; ++l) { v[l] = expf(v[l] - mx); s += v[l]; }
        float* LB = (float*)(ws + WS_LB); float cs = 0.f, first = 0.f;
        for (int l = 0; l < 4; ++l) { cs += v[l] / s; if (l == 0) first = cs; LB[l * 256 + tid] = cs - first; }
    }
}

__device__ __forceinline__ void moe_combine_row(f32x4 (&v)[4], int m, const bf16* Y, const int* SLOT, const float* TOPW, const float* g2, int lane) {
    const int4 sl = *(const int4*)(SLOT + (size_t)m * 4); const f32x4 tw = *(const f32x4*)(TOPW + (size_t)m * 4);
    const int s[4] = {sl.x, sl.y, sl.z, sl.w};
    f32x4 acc[4];
#pragma unroll
    for (int j = 0; j < 4; ++j) acc[j] = (f32x4){0.f, 0.f, 0.f, 0.f};
#pragma unroll
    for (int k = 0; k < 4; ++k) { const bf16* yr = Y + (size_t)s[k] * D + 4 * lane; const float w = tw[k];
#pragma unroll
        for (int j = 0; j < 4; ++j) { const uint2 p = *(const uint2*)(yr + 256 * j);
            acc[j][0] += w * __builtin_bit_cast(float, p.x << 16); acc[j][1] += w * __builtin_bit_cast(float, p.x & 0xffff0000u);
            acc[j][2] += w * __builtin_bit_cast(float, p.y << 16); acc[j][3] += w * __builtin_bit_cast(float, p.y & 0xffff0000u); } }
#pragma unroll
    for (int j = 0; j < 4; ++j) { const f32x4 g = *(const f32x4*)(g2 + 4 * lane + 256 * j); v[j] = v[j] + g * acc[j]; }
}
__device__ __forceinline__ float row_rstd(const f32x4 (&v)[4]) {
    float s = 0.f;
#pragma unroll
    for (int j = 0; j < 4; ++j) s += (v[j][0] * v[j][0] + v[j][1] * v[j][1]) + (v[j][2] * v[j][2] + v[j][3] * v[j][3]);
    return 1.0f / sqrtf(wave_sum(s) * (1.0f / D) + EPS);
}
__device__ __forceinline__ void modulate_row(f32x4 (&v)[4], float rstd, const float* nw, const float* sc, const float* sh, bf16* hrow, int lane) {
#pragma unroll
    for (int j = 0; j < 4; ++j) { const int c0 = 4 * lane + 256 * j; const f32x4 w = *(const f32x4*)(nw + c0), s1 = *(const f32x4*)(sc + c0), s0 = *(const f32x4*)(sh + c0);
        v[j] = v[j] * rstd * w * (s1 + 1.0f) + s0;
        uint2 p; p.x = pk2(v[j][0], v[j][1]); p.y = pk2(v[j][2], v[j][3]); *(uint2*)(hrow + c0) = p; }
}


constexpr int LR_SLT = 142976, LR_TWL = 144000, LR_SSR = 145024;
__device__ __forceinline__ void stage_slots(const unsigned char* ws, int row0, LAS unsigned char* lds, int tid) {
    if (tid < 64) { *(LAS v4u*)(lds + LR_SLT + 16 * tid) = *(const v4u*)((const int*)(ws + WS_SLOT) + (size_t)(row0 + tid) * 4);
                    *(LAS f32x4*)(lds + LR_TWL + 16 * tid) = *(const f32x4*)((const float*)(ws + WS_TOPW) + (size_t)(row0 + tid) * 4); }
}
template <bool SS, bool OUTF32>
__device__ __forceinline__ void flat_combine(const bf16* xsrc, void* xdst, int row0, const bf16* Y, const float* g2, LAS unsigned char* lds, int tid, int lane, const float* fw = nullptr) {
    static_assert(Y8, "expert outputs are stored as fp8");
    typedef float f32x2v __attribute__((ext_vector_type(2)));
    const int c16 = tid & 63, rsub = tid >> 6; const unsigned char* Yb = (const unsigned char*)Y;
    f32x4 g[4];
#pragma unroll
    for (int q = 0; q < 4; ++q) g[q] = *(const f32x4*)(g2 + 16 * c16 + 4 * q);
    f32x4 fwv[4];
    if (SS) {
#pragma unroll
        for (int q = 0; q < 4; ++q) fwv[q] = *(const f32x4*)(fw + 16 * c16 + 4 * q); }
#pragma unroll 2
    for (int it = 0; it < 8; ++it) { const int i = 8 * it + rsub; const size_t m = (size_t)(row0 + i);
        const v4u x0 = *(const v4u*)(xsrc + m * D + 16 * c16), x1 = *(const v4u*)(xsrc + m * D + 16 * c16 + 8);
        const v4u sl = *(const LAS v4u*)(lds + LR_SLT + 16 * i); const f32x4 tws = *(const LAS f32x4*)(lds + LR_TWL + 16 * i) * (1.0f / S8_Y);
        const v4u y0 = *(const v4u*)(Yb + (size_t)sl.x * D + 16 * c16), y1 = *(const v4u*)(Yb + (size_t)sl.y * D + 16 * c16), y2 = *(const v4u*)(Yb + (size_t)sl.z * D + 16 * c16), y3 = *(const v4u*)(Yb + (size_t)sl.w * D + 16 * c16);
        const unsigned xw[8] = {x0.x, x0.y, x0.z, x0.w, x1.x, x1.y, x1.z, x1.w}, w0[4] = {y0.x, y0.y, y0.z, y0.w}, w1[4] = {y1.x, y1.y, y1.z, y1.w}, w2[4] = {y2.x, y2.y, y2.z, y2.w}, w3[4] = {y3.x, y3.y, y3.z, y3.w};
        float v[16]; float sq = 0.f;
#pragma unroll
        for (int q = 0; q < 4; ++q) {
            const f32x2v a0 = __builtin_amdgcn_cvt_pk_f32_fp8((int)w0[q], false), b0 = __builtin_amdgcn_cvt_pk_f32_fp8((int)w0[q], true), a1 = __builtin_amdgcn_cvt_pk_f32_fp8((int)w1[q], false), b1 = __builtin_amdgcn_cvt_pk_f32_fp8((int)w1[q], true);
            const f32x2v a2 = __builtin_amdgcn_cvt_pk_f32_fp8((int)w2[q], false), b2 = __builtin_amdgcn_cvt_pk_f32_fp8((int)w2[q], true), a3 = __builtin_amdgcn_cvt_pk_f32_fp8((int)w3[q], false), b3 = __builtin_amdgcn_cvt_pk_f32_fp8((int)w3[q], true);
            const float e0 = tws[0] * a0[0] + tws[1] * a1[0] + tws[2] * a2[0] + tws[3] * a3[0], e1 = tws[0] * a0[1] + tws[1] * a1[1] + tws[2] * a2[1] + tws[3] * a3[1];
            const float e2 = tws[0] * b0[0] + tws[1] * b1[0] + tws[2] * b2[0] + tws[3] * b3[0], e3 = tws[0] * b0[1] + tws[1] * b1[1] + tws[2] * b2[1] + tws[3] * b3[1];
            v[4 * q + 0] = __builtin_bit_cast(float, xw[2 * q] << 16) + g[q][0] * e0; v[4 * q + 1] = __builtin_bit_cast(float, xw[2 * q] & 0xffff0000u) + g[q][1] * e1;
            v[4 * q + 2] = __builtin_bit_cast(float, xw[2 * q + 1] << 16) + g[q][2] * e2; v[4 * q + 3] = __builtin_bit_cast(float, xw[2 * q + 1] & 0xffff0000u) + g[q][3] * e3;
            sq += (v[4 * q] * v[4 * q] + v[4 * q + 1] * v[4 * q + 1]) + (v[4 * q + 2] * v[4 * q + 2] + v[4 * q + 3] * v[4 * q + 3]); }
        if (SS) { const float rstd = 1.0f / sqrtf(wave_sum(sq) * (1.0f / D) + EPS);
#pragma unroll
            for (int q = 0; q < 4; ++q) { v[4 * q] *= rstd * fwv[q][0]; v[4 * q + 1] *= rstd * fwv[q][1]; v[4 * q + 2] *= rstd * fwv[q][2]; v[4 * q + 3] *= rstd * fwv[q][3]; } }
        if (OUTF32) {
#pragma unroll
            for (int q = 0; q < 4; ++q) *(GAS f32x4*)((float*)xdst + m * D + 16 * c16 + 4 * q) = (f32x4){v[4 * q], v[4 * q + 1], v[4 * q + 2], v[4 * q + 3]}; }
        else { v4u o0, o1; o0.x = pk2(v[0], v[1]); o0.y = pk2(v[2], v[3]); o0.z = pk2(v[4], v[5]); o0.w = pk2(v[6], v[7]); o1.x = pk2(v[8], v[9]); o1.y = pk2(v[10], v[11]); o1.z = pk2(v[12], v[13]); o1.w = pk2(v[14], v[15]);
            *(GAS v4u*)((bf16*)xdst + m * D + 16 * c16) = o0; *(GAS v4u*)((bf16*)xdst + m * D + 16 * c16 + 8) = o1; }
    }
}
template <bool F8, bool SLOTS>
__device__ __forceinline__ void flat_modulate(const bf16* xin, int row0, const LAS float* rstds, const float* nw, const float* scp, const float* shp, bf16* H, unsigned char* A1, LAS unsigned char* lds, int tid) {
    const int c16 = tid & 63, rsub = tid >> 6; f32x4 ws1[4], s0[4];
#pragma unroll
    for (int q = 0; q < 4; ++q) { const int c0 = 16 * c16 + 4 * q; ws1[q] = *(const f32x4*)(nw + c0) * (*(const f32x4*)(scp + c0) + 1.0f); s0[q] = *(const f32x4*)(shp + c0); }
#pragma unroll 2
    for (int it = 0; it < 8; ++it) { const int i = 8 * it + rsub; const size_t m = (size_t)(row0 + i); const float rs = rstds[i];
        const v4u x0 = *(const v4u*)(xin + m * D + 16 * c16), x1 = *(const v4u*)(xin + m * D + 16 * c16 + 8); const unsigned xw[8] = {x0.x, x0.y, x0.z, x0.w, x1.x, x1.y, x1.z, x1.w};
        f32x4 v[4];
#pragma unroll
        for (int q = 0; q < 4; ++q) v[q] = (f32x4){__builtin_bit_cast(float, xw[2 * q] << 16), __builtin_bit_cast(float, xw[2 * q] & 0xffff0000u), __builtin_bit_cast(float, xw[2 * q + 1] << 16), __builtin_bit_cast(float, xw[2 * q + 1] & 0xffff0000u)} * rs * ws1[q] + s0[q];
        if (F8) { v4u o; o.x = (unsigned)pk4_fp8(v[0][0] * S8_H, v[0][1] * S8_H, v[0][2] * S8_H, v[0][3] * S8_H); o.y = (unsigned)pk4_fp8(v[1][0] * S8_H, v[1][1] * S8_H, v[1][2] * S8_H, v[1][3] * S8_H);
            o.z = (unsigned)pk4_fp8(v[2][0] * S8_H, v[2][1] * S8_H, v[2][2] * S8_H, v[2][3] * S8_H); o.w = (unsigned)pk4_fp8(v[3][0] * S8_H, v[3][1] * S8_H, v[3][2] * S8_H, v[3][3] * S8_H);
            if (SLOTS) { const v4u sl = *(const LAS v4u*)(lds + LR_SLT + 16 * i);
                *(GAS v4u*)(A1 + (size_t)sl.x * D + 16 * c16) = o; *(GAS v4u*)(A1 + (size_t)sl.y * D + 16 * c16) = o; *(GAS v4u*)(A1 + (size_t)sl.z * D + 16 * c16) = o; *(GAS v4u*)(A1 + (size_t)sl.w * D + 16 * c16) = o; }
            else *(GAS v4u*)((unsigned char*)H + m * D + 16 * c16) = o; }
        else { v4u o0, o1; o0.x = pk2(v[0][0], v[0][1]); o0.y = pk2(v[0][2], v[0][3]); o0.z = pk2(v[1][0], v[1][1]); o0.w = pk2(v[1][2], v[1][3]); o1.x = pk2(v[2][0], v[2][1]); o1.y = pk2(v[2][2], v[2][3]); o1.z = pk2(v[3][0], v[3][1]); o1.w = pk2(v[3][2], v[3][3]);
            *(GAS v4u*)(H + m * D + 16 * c16) = o0; *(GAS v4u*)(H + m * D + 16 * c16 + 8) = o1; } }
}

constexpr int WP = 1032;
constexpr int LR_WHI = 0, LR_PART = 132096, LR_SSX = 140288, LR_RSTD = 140544, LR_BIAS = 140800, LR_RED = 140928;
template <int NEO>
__device__ __forceinline__ void rows_mfma(const Args& a, int layer, LAS unsigned char* lds, volatile LAS unsigned* MISC, gu32* ctl, int vcu, int G, int tid, int lane, int wave) {
    constexpr bool P5 = (NEO == 32); constexpr int NET = NEO / 16;
    unsigned char* ws = a.ws; bf16* X = (bf16*)(ws + WS_X); bf16* H = (bf16*)(ws + WS_H); const float* MOD = (const float*)(ws + WS_MOD);
    LAS bf16* Whi = (LAS bf16*)(lds + LR_WHI); LAS bf16* Wlo = Whi + NEO * WP; LAS float* part = (LAS float*)(lds + LR_PART); LAS float* ssx = (LAS float*)(lds + LR_SSX);
    LAS float* rstds = (LAS float*)(lds + LR_RSTD); LAS float* biasl = (LAS float*)(lds + LR_BIAS); LAS float* red = (LAS float*)(lds + LR_RED);
    const float* nw = (P5 ? a.norm2_w : a.norm1_w) + layer * D;
    const float* Wsrc = P5 ? a.w_r + (size_t)layer * D * NE : a.w_in + (size_t)layer * D * DIN + SRC_GA; const int wld = P5 ? NE : DIN;
    if (P5) { if (tid < NE) MISC[MW_HIST + tid] = 0u; }
    for (int row0 = vcu * 64; row0 < MTOK; row0 += G * 64) {
        const int b = row0 / SEQ; const float* mp = MOD + ((size_t)layer * 2 + b) * 6144; const float* scp = mp + (P5 ? 4 : 1) * D; const float* shp = mp + (P5 ? 3 : 0) * D;
        if (!P5 && layer > 0) { stage_slots(ws, row0, lds, tid); __syncthreads(); }
        { constexpr int E4 = NEO / 4, NITP = (D / 2 * E4) / NTHR, NIT = 4;
          f32x4 bacc = {0.f, 0.f, 0.f, 0.f};
#pragma unroll 1
          for (int ib0 = 0; ib0 < NITP; ib0 += NIT) {
            f32x4 wa[NIT], wb[NIT]; f32x2_t nv[NIT], sv[NIT], hv[NIT];
#pragma unroll
            for (int it = 0; it < NIT; ++it) { const int idx = tid + NTHR * (ib0 + it), k2 = idx / E4, e4 = idx - k2 * E4, k = 2 * k2;
                wa[it] = *(const f32x4*)(Wsrc + (size_t)k * wld + 4 * e4); wb[it] = *(const f32x4*)(Wsrc + (size_t)(k + 1) * wld + 4 * e4);
                nv[it] = *(const f32x2_t*)(nw + k); sv[it] = *(const f32x2_t*)(scp + k); hv[it] = *(const f32x2_t*)(shp + k); }
#pragma unroll
            for (int it = 0; it < NIT; ++it) { const int idx = tid + NTHR * (ib0 + it), k2 = idx / E4, e4 = idx - k2 * E4, k = 2 * k2;
                bacc += wa[it] * hv[it][0] + wb[it] * hv[it][1];
                const f32x4 w0 = wa[it] * (nv[it][0] * (1.0f + sv[it][0])), w1 = wb[it] * (nv[it][1] * (1.0f + sv[it][1]));
#pragma unroll
                for (int j = 0; j < 4; ++j) { const unsigned h0 = f2bf(w0[j]), h1 = f2bf(w1[j]); const float l0 = w0[j] - __builtin_bit_cast(float, h0 << 16), l1 = w1[j] - __builtin_bit_cast(float, h1 << 16);
                    *(LAS unsigned*)(Whi + (4 * e4 + j) * WP + k) = h0 | (h1 << 16); *(LAS unsigned*)(Wlo + (4 * e4 + j) * WP + k) = pk2(l0, l1); } } }
#pragma unroll
          for (int j = 0; j < 4; ++j) { float v = bacc[j];
#pragma unroll
              for (int sh = E4; sh < 64; sh <<= 1) v += __shfl_xor(v, sh);
              bacc[j] = v; }
          if (lane < E4) *(LAS f32x4*)(red + wave * NEO + 4 * lane) = bacc; }
        const bf16* xin = X;
        if (!P5 && layer > 0) { flat_combine<false, false>(X, X, row0, (const bf16*)(ws + WS_Y), MOD + ((size_t)(layer - 1) * 2 + b) * 6144 + 5 * D, lds, tid, lane); asm volatile("s_waitcnt vmcnt(0)" ::: "memory"); }
        __syncthreads();
        if (tid < NEO) { float sacc = P5 ? a.b_r[layer * NE + tid] : 0.f; for (int q = 0; q < NWAVES; ++q) sacc += red[q * NEO + tid]; biasl[tid] = sacc; }
        const int rg = wave >> 1, kh = wave & 1, r = lane & 15, g = lane >> 4;
        { const bf16* xr = xin + (size_t)(row0 + 16 * rg + r) * D; f32x4 acc[NET]; float ss = 0.f;
#pragma unroll
            for (int et = 0; et < NET; ++et) acc[et] = (f32x4){0.f, 0.f, 0.f, 0.f};
#pragma unroll 4
            for (int s = 16 * kh; s < 16 * kh + 16; ++s) { const int k0 = 32 * s + 8 * g; const v4u xp = *(const v4u*)(xr + k0); const unsigned xw[4] = {xp.x, xp.y, xp.z, xp.w};
#pragma unroll
                for (int j = 0; j < 4; ++j) { const float xa = __builtin_bit_cast(float, xw[j] << 16), xb = __builtin_bit_cast(float, xw[j] & 0xffff0000u); ss += xa * xa + xb * xb; }
                const pg8::bf16x8 ahi = __builtin_bit_cast(pg8::bf16x8, xp);
#pragma unroll
                for (int et = 0; et < NET; ++et) { const pg8::bf16x8 whi = ldfrag(Whi, WP, 16 * et, 32 * s, lane), wlo = ldfrag(Wlo, WP, 16 * et, 32 * s, lane);
                    acc[et] = __builtin_amdgcn_mfma_f32_16x16x32_bf16(ahi, whi, acc[et], 0, 0, 0); acc[et] = __builtin_amdgcn_mfma_f32_16x16x32_bf16(ahi, wlo, acc[et], 0, 0, 0); } }
            ss += __shfl_xor(ss, 16); ss += __shfl_xor(ss, 32);
            if (kh == 1) {
#pragma unroll
                for (int et = 0; et < NET; ++et)
#pragma unroll
                    for (int q = 0; q < 4; ++q) part[(rg * 16 + 4 * g + q) * 32 + 16 * et + r] = acc[et][q];
                if (g == 0) ssx[rg * 16 + r] = ss; }
            __syncthreads();
            if (kh == 0) { const float sst = ss + ssx[rg * 16 + r]; if (g == 0) rstds[rg * 16 + r] = 1.0f / sqrtf(sst * (1.0f / D) + EPS);
                asm volatile("s_waitcnt lgkmcnt(0)" ::: "memory");
#pragma unroll
                for (int et = 0; et < NET; ++et)
#pragma unroll
                    for (int q = 0; q < 4; ++q) { const int i = rg * 16 + 4 * g + q, e = 16 * et + r; const float v = rstds[i] * (acc[et][q] + part[i * 32 + e]) + biasl[e];
                        if (P5) part[i * 32 + e] = v; else ((float*)(ws + WS_GA))[(size_t)(row0 + i) * 16 + e] = v; }
                if (P5) { asm volatile("s_waitcnt lgkmcnt(0)" ::: "memory");
                    if (lane < 16) { const int i = rg * 16 + lane, m = row0 + i; float lv[NE];
#pragma unroll
                        for (int e = 0; e < NE; ++e) lv[e] = part[i * 32 + e];
                        float tv[4]; int te[4];
#pragma unroll
                        for (int t = 0; t < 4; ++t) { float best = -3.0e38f; int bi = 0;
#pragma unroll
                            for (int e = 0; e < NE; ++e) if (lv[e] > best) { best = lv[e]; bi = e; }
#pragma unroll
                            for (int e = 0; e < NE; ++e) if (e == bi) lv[e] = -3.0e38f;
                            tv[t] = best; te[t] = bi; }
                        const float e1 = expf(tv[1] - tv[0]), e2 = expf(tv[2] - tv[0]), e3 = expf(tv[3] - tv[0]); const float inv = 1.0f / (1.0f + e1 + e2 + e3);
                        *(f32x4*)((float*)(ws + WS_TOPW) + (size_t)m * 4) = (f32x4){inv, e1 * inv, e2 * inv, e3 * inv};
#pragma unroll
                        for (int t = 0; t < 4; ++t) { const unsigned rk = __hip_atomic_fetch_add((LAS unsigned*)&MISC[MW_HIST + te[t]], 1u, __ATOMIC_RELAXED, __HIP_MEMORY_SCOPE_WORKGROUP);
                            ((LAS unsigned*)(lds + LR_SLT))[i * 4 + t] = ((unsigned)te[t] << 16) | rk; } } } }
            __syncthreads(); }
        if (P5) { if (tid < NE) { const unsigned hcnt = MISC[MW_HIST + tid]; MISC[MW_BASE + tid] = hcnt ? atomicAdd((unsigned*)(ctl + CW_CNT + layer * NE + tid), hcnt) : 0u; }
            __syncthreads();
            if (tid < 256) { LAS unsigned* sl = (LAS unsigned*)(lds + LR_SLT) + tid; const unsigned v = *sl, e = v >> 16; const unsigned slot = (e << ECAP_SH) + MISC[MW_BASE + e] + (v & 0xffffu);
                *sl = slot; ((int*)(ws + WS_SLOT))[(size_t)row0 * 4 + tid] = (int)slot; }
            if (tid < NE) MISC[MW_HIST + tid] = 0u;
            __syncthreads(); }
        if (P5) flat_modulate<true, true>(xin, row0, rstds, nw, scp, shp, H, ws + WS_A1, lds, tid);
        else flat_modulate<F8_IN, false>(xin, row0, rstds, nw, scp, shp, H, ws + WS_A1, lds, tid);
        __syncthreads();
    }
}

__device__ __forceinline__ void final_rows(const Args& a, LAS unsigned char* lds, int vcu, int G, int tid, int lane) {
    unsigned char* ws = a.ws; const bf16* X = (const bf16*)(ws + WS_X); const float* MOD = (const float*)(ws + WS_MOD);
    for (int row0 = vcu * 64; row0 < MTOK; row0 += G * 64) { const int b = row0 / SEQ;
        stage_slots(ws, row0, lds, tid);
        __syncthreads();
        flat_combine<true, true>(X, a.out, row0, (const bf16*)(ws + WS_Y), MOD + ((size_t)(DEPTH - 1) * 2 + b) * 6144 + 5 * D, lds, tid, lane, a.final_norm_w);
        __syncthreads();
    }
}

__device__ __noinline__ void moe_tables(gu32* ctl, int layer, volatile LAS unsigned* MISC, int tid) {
    if (tid < NE) MISC[MW_CNT + tid] = __hip_atomic_load(ctl + CW_CNT + layer * NE + tid, RLX_AGENT);
    __syncthreads();
    if (tid == 0) { unsigned n = 0;
        for (int e = 0; e < NE; ++e) { const unsigned nt = (MISC[MW_CNT + e] + 255u) >> 8; for (unsigned t = 0; t < nt; ++t) MISC[MW_TILE + n + t] = (unsigned)(e * 64) + t; n += nt; }
        MISC[MW_NRT] = n; }
    __syncthreads();
}

constexpr int BP = 72;
template <int TYPE> struct MixCfg { static constexpr int DK = (TYPE == 1) ? 64 : 48, DV = (TYPE == 1) ? 64 : 96, NC = 4 * DK, NV = 4 * DV;
    static constexpr int STOFF = (TYPE == 0) ? ST_GLA : (TYPE == 1) ? ST_HG : ST_RET, COFF = (TYPE == 0) ? 0 : 192;
    static constexpr int CQ = (TYPE == 0) ? C_GQ : (TYPE == 1) ? C_HQ : C_RQ, CK = (TYPE == 0) ? C_GK : (TYPE == 1) ? C_HF : C_RK, CV = (TYPE == 0) ? C_GV : (TYPE == 1) ? C_HI : C_RV, CG = (TYPE == 0) ? C_GG : (TYPE == 1) ? C_HG : C_RG;
    static constexpr int MIXOFF = (TYPE == 0) ? 0 : (TYPE == 1) ? 384 : 640, KOFF = (TYPE == 0) ? 0 : (TYPE == 1) ? 192 : 448; };
__device__ __forceinline__ float fast_logsig(float x) { x = fmaxf(x, -80.f); return -__logf(1.0f + __expf(-x)); }
__device__ __forceinline__ float ret_lg(int h) { return logf(1.0f - exp2f(-5.0f - (float)h)); }

template <int NV>
__device__ __forceinline__ void stage_vt(const bf16* pv  , LAS bf16* VT, int tid) {
    constexpr int NIT = (64 * (NV / 8)) / NTHR; static_assert((64 * (NV / 8)) % NTHR == 0, "stage_vt");
    v4u p[NIT];
#pragma unroll
    for (int it = 0; it < NIT; ++it) { const int idx = tid + NTHR * it, j = idx & 63, ch = idx >> 6; p[it] = *(const v4u*)(pv + (size_t)j * NPROJ + 8 * ch); }
#pragma unroll
    for (int it = 0; it < NIT; ++it) { const int idx = tid + NTHR * it, j = idx & 63, ch = idx >> 6; LAS bf16* d = VT + (8 * ch) * BP + j;
        d[0 * BP] = (bf16)(p[it].x & 0xffffu); d[1 * BP] = (bf16)(p[it].x >> 16); d[2 * BP] = (bf16)(p[it].y & 0xffffu); d[3 * BP] = (bf16)(p[it].y >> 16);
        d[4 * BP] = (bf16)(p[it].z & 0xffffu); d[5 * BP] = (bf16)(p[it].z >> 16); d[6 * BP] = (bf16)(p[it].w & 0xffffu); d[7 * BP] = (bf16)(p[it].w >> 16); }
}

constexpr int LA_KT = 0, LA_VT = 36864, LA_TOT = 92160, LA_GA = 94208, LA_KTT = 98304, KTP = 264;
template <int TYPE>
__device__ __forceinline__ void mixa_batch(const Args& a, int layer, int unit, LAS unsigned char* lds, int tid, int lane, int wave) {
    asm volatile("" : "+v"(tid), "+v"(lane));
    typedef MixCfg<TYPE> C; constexpr int DK = C::DK, DV = C::DV, NC = C::NC, NV = C::NV;
    unsigned char* ws = a.ws; const bf16* PROJ = (const bf16*)(ws + WS_PROJ); bf16* F1 = (bf16*)(ws + WS_CUM); float* ECG = (float*)(ws + WS_CUM + 16 * MiB) + (size_t)unit * 4 * NDV; float* DVEC = (float*)(ws + WS_DVEC) + (size_t)unit * NDV;
    bf16* U = (bf16*)(ws + WS_U) + (size_t)unit * ST_TOT + C::STOFF;
    LAS bf16* KT = (LAS bf16*)(lds + LA_KT); LAS bf16* VT = (LAS bf16*)(lds + LA_VT); LAS float* TOT = (LAS float*)(lds + LA_TOT); const LAS float* GAs = (const LAS float*)(lds + LA_GA);
    const int row0 = unit * CH;
    stage_vt<NV>(PROJ + (size_t)row0 * NPROJ + C::CV, VT, tid);
    const bool act = tid < 2 * NC; const int c = act ? tid % NC : 0, half = act ? tid / NC : 0, h = c / DK, d = c - h * DK;
    float cum[32]; float tot = 0.f;
    float w2[16], b2 = 0.f, lbv = 0.f, lg = 0.f, sg = 0.f; int f = 0, d2 = 0;
    if (act) {
        if constexpr (TYPE == 0) { b2 = a.gla_ba2[layer * 192 + c];
#pragma unroll
            for (int r = 0; r < 16; ++r) w2[r] = a.gla_wa2[(layer * 16 + r) * 192 + c]; }
        if constexpr (TYPE == 1) lbv = ((const float*)(ws + WS_LB))[layer * 256 + c];
        if constexpr (TYPE == 2) { lg = ret_lg(h); f = (d < 24) ? d : d - 24; d2 = (d < 24) ? d + 24 : d - 24; sg = (d < 24) ? -1.f : 1.f; }
#pragma unroll
        for (int gq = 0; gq < 2; ++gq) {
            bf16 hraw[16];
            if constexpr (TYPE == 1) {
#pragma unroll
                for (int i = 0; i < 16; ++i) hraw[i] = PROJ[(size_t)(row0 + 32 * half + 16 * gq + i) * NPROJ + C_HF + c]; }
#pragma unroll
            for (int ii = 0; ii < 16; ++ii) { const int i = 16 * gq + ii, t = 32 * half + i; float g;
                if constexpr (TYPE == 0) { float pre = b2;
#pragma unroll
                    for (int r = 0; r < 16; ++r) pre += GAs[t * 16 + r] * w2[r];
                    g = fast_logsig(pre) * (1.0f / 16.0f); }
                else if constexpr (TYPE == 1) { const float hf = fminf(fmaxf(bf2f(hraw[ii]), -80.f), 80.f); const float sgm = __builtin_amdgcn_rcpf(1.0f + __expf(-hf));
                    g = __logf(lbv + (1.0f - lbv) * sgm); }
                else g = lg;
                tot += g; cum[i] = tot;
                if constexpr (TYPE == 0) { if ((ii & 3) == 3) asm volatile("" ::: "memory"); } } }
        TOT[c * 2 + half] = tot;
    }
    __syncthreads();
    if (act) { const float t0 = TOT[c * 2], t1 = TOT[c * 2 + 1]; const float off = half ? t0 : 0.f, last = t0 + t1;
#pragma unroll
        for (int hq = 0; hq < 4; ++hq) {
            bf16 ka[8], kb[8]; float cs[8], sn[8];
            if constexpr (TYPE != 1) {
#pragma unroll
                for (int i = 0; i < 8; ++i) { const size_t row = (size_t)(row0 + 32 * half + 8 * hq + i); const bf16* pr = PROJ + row * NPROJ;
                    if constexpr (TYPE == 0) ka[i] = pr[C_GK + c];
                    else { const float* rp = (const float*)(ws + WS_ROPE) + row * 48; ka[i] = pr[C_RK + h * 48 + d]; kb[i] = pr[C_RK + h * 48 + d2]; cs[i] = rp[f]; sn[i] = rp[24 + f]; } } }
            float kt[8];
#pragma unroll
            for (int j = 0; j < 8; ++j) { const int i = 8 * hq + j; const float cm = cum[i] + off; const size_t row = (size_t)(row0 + 32 * half + i); float k;
                if constexpr (TYPE == 0) k = bf2f(ka[j]);
                else if constexpr (TYPE == 1) k = 1.0f - __expf(cum[i] - (i > 0 ? cum[i - 1] : 0.f));
                else k = bf2f(ka[j]) * cs[j] + sg * bf2f(kb[j]) * sn[j];
                if constexpr (TYPE != 2) *(GAS bf16*)(F1 + row * NDV + C::COFF + c) = (bf16)f2bf(__expf(cm - ((i < 16) ? off : cum[15] + off)));
                { const float eb = cum[(i < 16) ? 15 : 31] + off;
                  ((LAS bf16*)(lds + LA_KTT))[(32 * half + i) * KTP + c] = (bf16)f2bf(k * __expf(eb - cm)); }
                kt[j] = k * __expf(last - cm); }
            v4u w; w.x = pk2(kt[0], kt[1]); w.y = pk2(kt[2], kt[3]); w.z = pk2(kt[4], kt[5]); w.w = pk2(kt[6], kt[7]);
            *(LAS v4u*)(KT + c * BP + 32 * half + 8 * hq) = w; }
        if (TYPE != 2) { *(GAS float*)(ECG + (2 * half + 0) * NDV + C::COFF + c) = cum[15] + off; *(GAS float*)(ECG + (2 * half + 1) * NDV + C::COFF + c) = cum[31] + off; }
        if (TYPE != 2 && half == 0) *(GAS float*)(DVEC + C::COFF + c) = __expf(last);
    }
    __syncthreads();
    { constexpr int CPR = NC / 8;
#pragma unroll
        for (int it = 0; it < (64 * CPR) / NTHR; ++it) { const int idx = tid + NTHR * it, t = idx / CPR, ch = idx - t * CPR;
            *(GAS v4u*)((bf16*)(ws + WS_KT) + (size_t)(row0 + t) * NKT + C::KOFF + 8 * ch) = *(const LAS v4u*)((const LAS bf16*)(lds + LA_KTT) + t * KTP + 8 * ch); } }
    constexpr int TD = DK / 16, NT = (DV / 16) * TD;
    for (int ti = wave; ti < 4 * NT; ti += NWAVES) { const int hh = ti / NT, tr = ti - hh * NT, te = tr / TD, td = tr - te * TD; f32x4 acc = {0.f, 0.f, 0.f, 0.f};
#pragma unroll
        for (int kk = 0; kk < 2; ++kk) acc = __builtin_amdgcn_mfma_f32_16x16x32_bf16(ldfrag(VT, BP, hh * DV + te * 16, kk * 32, lane), ldfrag(KT, BP, hh * DK + td * 16, kk * 32, lane), acc, 0, 0, 0);
        bf16* Uh = U + hh * DK * DV;
#pragma unroll
        for (int r = 0; r < 4; ++r) *(GAS bf16*)(Uh + (te * 16 + (lane >> 4) * 4 + r) * DK + td * 16 + (lane & 15)) = (bf16)f2bf(acc[r]); }
    __syncthreads();
}
__device__ __forceinline__ void p3a_summaries(const Args& a, int layer, LAS unsigned char* lds, int vcu, int G, int tid, int lane, int wave) {
    for (int unit = vcu; unit < NUNIT; unit += G) {
        { LAS float* GAs = (LAS float*)(lds + LA_GA); const float* GA = (const float*)(a.ws + WS_GA); for (int i = tid; i < CH * 16; i += NTHR) GAs[i] = GA[(size_t)unit * CH * 16 + i]; }
        __syncthreads();
        mixa_batch<0>(a, layer, unit, lds, tid, lane, wave);
        mixa_batch<1>(a, layer, unit, lds, tid, lane, wave);
        mixa_batch<2>(a, layer, unit, lds, tid, lane, wave);
    }
}

__device__ __forceinline__ void p3b_scan(const Args& a, int vcu, int G, int tid) {
    unsigned char* ws = a.ws; const bf16* U = (const bf16*)(ws + WS_U); const float* DVEC = (const float*)(ws + WS_DVEC); bf16* SP = (bf16*)(ws + WS_SP);
    for (int gid = vcu * NTHR + tid; gid < BATCH * ST_TOT; gid += G * NTHR) {
        const int b = gid / ST_TOT, el = gid - b * ST_TOT;
        int di = -1; float cdec = 0.f;
        if (el < ST_HG) { const int h = el / 4608, d = (el - h * 4608) % 48; di = h * 48 + d; }
        else if (el < ST_RET) { const int r = el - ST_HG, h = r / 4096, d = r % 64; di = 192 + h * 64 + d; }
        else { const int h = (el - ST_RET) / 4608; cdec = expf(64.0f * logf(1.0f - exp2f(-5.0f - (float)h))); }
        const bf16* up = U + (size_t)b * NCH * ST_TOT + el; const float* dp = DVEC + (size_t)b * NCH * NDV + (di < 0 ? 0 : di); bf16* sp = SP + (size_t)b * NCH * ST_TOT + el;
        float s = 0.f;
#pragma unroll 1
        for (int n0 = 0; n0 < NCH; n0 += 32) { float u[32], dc[32];
#pragma unroll
            for (int i = 0; i < 32; ++i) { u[i] = bf2f(up[(size_t)(n0 + i) * ST_TOT]); dc[i] = (di < 0) ? cdec : dp[(size_t)(n0 + i) * NDV]; }
#pragma unroll
            for (int i = 0; i < 32; ++i) { *(GAS bf16*)(sp + (size_t)(n0 + i) * ST_TOT) = (bf16)f2bf(s); s = dc[i] * s + u[i]; } }
    }
}

#ifndef SUB_MASK
#define SUB_MASK 0
#endif
__device__ __forceinline__ unsigned long long rt_now() { unsigned long long t; asm volatile("s_waitcnt vmcnt(0) lgkmcnt(0)\n\ts_memrealtime %0\n\ts_waitcnt lgkmcnt(0)" : "=s"(t) :: "memory"); return t; }
#define SUBSTRETCH(bit, t0_) do { if ((SUB_MASK >> (bit)) & 1) { const unsigned long long t1_ = rt_now(); while (rt_now() - t1_ < t1_ - (t0_)) __builtin_amdgcn_s_sleep(8); } } while (0)
constexpr int LC_VT = 0, LC_ST = 55296, LC_AB = 110592, OBP = 104, LC_EC = 137216, LC_EQ = MISC_OFF + 4096;
template <int TYPE, bool ISQ>
__device__ __forceinline__ void mix_frag(const Args& a, int h, size_t row, int t, int d0, float (&x)[8], float (&cm)[8]) {
    typedef MixCfg<TYPE> C; constexpr int DK = C::DK; static_assert(ISQ, "query path only");
    unsigned char* ws = a.ws; const bf16* pr = (const bf16*)(ws + WS_PROJ) + row * NPROJ;
    if constexpr (TYPE != 2) {
        const v4u p = *(const v4u*)(pr + C::CQ + h * DK + d0); const unsigned pw[4] = {p.x, p.y, p.z, p.w};
        const v4u f = *(const v4u*)((const bf16*)(ws + WS_CUM) + row * NDV + C::COFF + h * DK + d0); const unsigned fw[4] = {f.x, f.y, f.z, f.w};
#pragma unroll
        for (int j = 0; j < 4; ++j) { x[2 * j] = __builtin_bit_cast(float, pw[j] << 16); x[2 * j + 1] = __builtin_bit_cast(float, pw[j] & 0xffff0000u); cm[2 * j] = __builtin_bit_cast(float, fw[j] << 16); cm[2 * j + 1] = __builtin_bit_cast(float, fw[j] & 0xffff0000u); }
        if constexpr (TYPE == 0) {
#pragma unroll
            for (int j = 0; j < 8; ++j) x[j] *= 0.14433756729740643f; }
    } else {
        const int f0 = (d0 < 24) ? d0 : d0 - 24, dp = (d0 < 24) ? d0 + 24 : d0 - 24; const float sg = (d0 < 24) ? -1.f : 1.f;
        const int cb = C_RQ + h * DK; const v4u p = *(const v4u*)(pr + cb + d0), pp = *(const v4u*)(pr + cb + dp); const unsigned pw[4] = {p.x, p.y, p.z, p.w}, qw[4] = {pp.x, pp.y, pp.z, pp.w};
        const float* rp = (const float*)(ws + WS_ROPE) + row * 48; const f32x4 cs0 = *(const f32x4*)(rp + f0), cs1 = *(const f32x4*)(rp + f0 + 4), sn0 = *(const f32x4*)(rp + 24 + f0), sn1 = *(const f32x4*)(rp + 24 + f0 + 4);
        const float cmv = (float)(t + 1) * ret_lg(h);
#pragma unroll
        for (int j = 0; j < 4; ++j) { const float xa = __builtin_bit_cast(float, pw[j] << 16), xb = __builtin_bit_cast(float, pw[j] & 0xffff0000u), ya = __builtin_bit_cast(float, qw[j] << 16), yb = __builtin_bit_cast(float, qw[j] & 0xffff0000u);
            const float ca = (j < 2) ? cs0[2 * j] : cs1[2 * j - 4], cb2 = (j < 2) ? cs0[2 * j + 1] : cs1[2 * j - 3], sa = (j < 2) ? sn0[2 * j] : sn1[2 * j - 4], sb = (j < 2) ? sn0[2 * j + 1] : sn1[2 * j - 3];
            x[2 * j] = (xa * ca + sg * ya * sa) * 0.14433756729740643f; x[2 * j + 1] = (xb * cb2 + sg * yb * sb) * 0.14433756729740643f; cm[2 * j] = cmv; cm[2 * j + 1] = cmv; }
    }
}

template <int TYPE> struct QRaw { v4u p[2], f[2]; f32x4 rp[2][4]; };
template <int TYPE>
__device__ __forceinline__ void q_issue(const Args& a, int h, size_t row, int g, QRaw<TYPE>& R) {
    typedef MixCfg<TYPE> C; constexpr int DK = C::DK; unsigned char* ws = a.ws; const bf16* pr = (const bf16*)(ws + WS_PROJ) + row * NPROJ;
#pragma unroll
    for (int s = 0; s < 2; ++s) { const int d0r = 32 * s + 8 * g; const int d0 = (d0r < DK) ? d0r : 0;
        if constexpr (TYPE != 2) { R.p[s] = *(const v4u*)(pr + C::CQ + h * DK + d0); R.f[s] = *(const v4u*)((const bf16*)(ws + WS_CUM) + row * NDV + C::COFF + h * DK + d0); }
        else { const int f0 = (d0 < 24) ? d0 : d0 - 24, dp = (d0 < 24) ? d0 + 24 : d0 - 24; const int cb = C_RQ + h * DK; R.p[s] = *(const v4u*)(pr + cb + d0); R.f[s] = *(const v4u*)(pr + cb + dp);
            const float* rp = (const float*)(ws + WS_ROPE) + row * 48; R.rp[s][0] = *(const f32x4*)(rp + f0); R.rp[s][1] = *(const f32x4*)(rp + f0 + 4); R.rp[s][2] = *(const f32x4*)(rp + 24 + f0); R.rp[s][3] = *(const f32x4*)(rp + 24 + f0 + 4); } }
}
template <int TYPE>
__device__ __forceinline__ void q_convert(const QRaw<TYPE>& R, int s, int h, int t, int d0, float (&x)[8], float (&cm)[8]) {
    const v4u p = R.p[s], f = R.f[s]; const unsigned pw[4] = {p.x, p.y, p.z, p.w}, fw[4] = {f.x, f.y, f.z, f.w};
    if constexpr (TYPE != 2) {
#pragma unroll
        for (int j = 0; j < 4; ++j) { x[2 * j] = __builtin_bit_cast(float, pw[j] << 16); x[2 * j + 1] = __builtin_bit_cast(float, pw[j] & 0xffff0000u); cm[2 * j] = __builtin_bit_cast(float, fw[j] << 16); cm[2 * j + 1] = __builtin_bit_cast(float, fw[j] & 0xffff0000u); }
        if constexpr (TYPE == 0) {
#pragma unroll
            for (int j = 0; j < 8; ++j) x[j] *= 0.14433756729740643f; }
    } else {
        const float sg = (d0 < 24) ? -1.f : 1.f; const f32x4 cs0 = R.rp[s][0], cs1 = R.rp[s][1], sn0 = R.rp[s][2], sn1 = R.rp[s][3];
        const float cmv = (float)(t + 1) * ret_lg(h);
#pragma unroll
        for (int j = 0; j < 4; ++j) { const float xa = __builtin_bit_cast(float, pw[j] << 16), xb = __builtin_bit_cast(float, pw[j] & 0xffff0000u), ya = __builtin_bit_cast(float, fw[j] << 16), yb = __builtin_bit_cast(float, fw[j] & 0xffff0000u);
            const float ca = (j < 2) ? cs0[2 * j] : cs1[2 * j - 4], cb2 = (j < 2) ? cs0[2 * j + 1] : cs1[2 * j - 3], sa = (j < 2) ? sn0[2 * j] : sn1[2 * j - 4], sb = (j < 2) ? sn0[2 * j + 1] : sn1[2 * j - 3];
            x[2 * j] = (xa * ca + sg * ya * sa) * 0.14433756729740643f; x[2 * j + 1] = (xb * cb2 + sg * yb * sb) * 0.14433756729740643f; cm[2 * j] = cmv; cm[2 * j + 1] = cmv; }
    }
}

template <int TYPE>
__device__ __forceinline__ void mixc_batch(const Args& a, int layer, int unit, LAS unsigned char* lds, int tid, int lane, int wave) {
    asm volatile("" : "+v"(tid), "+v"(lane));
    typedef MixCfg<TYPE> C; constexpr int DK = C::DK, DV = C::DV, NV = C::NV, TE = DV / 16;
    unsigned char* ws = a.ws; const bf16* PROJ = (const bf16*)(ws + WS_PROJ); bf16* MIX = (bf16*)(ws + WS_MIX);
    LAS bf16* VT = (LAS bf16*)(lds + LC_VT); LAS bf16* ST = (LAS bf16*)(lds + LC_ST); LAS bf16* AB = (LAS bf16*)(lds + LC_AB) + wave * 16 * OBP;
    const int row0 = unit * CH;
    const unsigned long long ts0_ = SUB_MASK ? rt_now() : 0ull;
    stage_vt<NV>(PROJ + (size_t)row0 * NPROJ + C::CV, VT, tid);
    SUBSTRETCH(3, ts0_);
    const unsigned long long ts3_ = SUB_MASK ? rt_now() : 0ull;
    { const bf16* SPu = (const bf16*)(ws + WS_SP) + (size_t)unit * ST_TOT + C::STOFF;
        constexpr int NIS = (NV * 8) / NTHR; static_assert((NV * 8) % NTHR == 0, "ST staging"); v4u sw[NIS];
#pragma unroll
        for (int it = 0; it < NIS; ++it) { const int idx = tid + NTHR * it, er = idx >> 3, ch = idx & 7; sw[it] = (v4u){0u, 0u, 0u, 0u}; if (ch * 8 < DK) sw[it] = *(const v4u*)(SPu + (size_t)er * DK + ch * 8); }
#pragma unroll
        for (int it = 0; it < NIS; ++it) { const int idx = tid + NTHR * it, er = idx >> 3, ch = idx & 7; *(LAS v4u*)(ST + er * BP + ch * 8) = sw[it]; } }
    SUBSTRETCH(4, ts3_);
    SUBSTRETCH(0, ts0_);
    if constexpr (TYPE != 2) { if (tid < C::NC) {
            const float* ep = (const float*)(ws + WS_CUM + 16 * MiB) + (size_t)unit * 4 * NDV + C::COFF + tid; const float ee[4] = {ep[0], ep[NDV], ep[2 * NDV], ep[3 * NDV]};
            LAS float* T = (LAS float*)(lds + LC_EC) + tid; LAS float* Q = (LAS float*)(lds + LC_EQ) + tid;
#pragma unroll
            for (int I = 0; I < 4; ++I) { const float sI = I ? ee[I ? I - 1 : 0] : 0.f;
#pragma unroll
                for (int J = 0; J <= I; ++J) T[(I * (I + 1) / 2 + J) * 256] = __expf(fminf(sI - ee[J], 80.f));
                if (I) Q[(I - 1) * 256] = __expf(sI); } } }
    __syncthreads();
    SUBSTRETCH(5, ts0_);
    const unsigned long long ts1_ = SUB_MASK ? rt_now() : 0ull;
    const int h = wave >> 1, hsel = wave & 1, r = lane & 15, g = lane >> 4;
    const LAS bf16* STh = ST + h * DV * BP; const LAS bf16* VTh = VT + h * DV * BP;
    constexpr int NCHK = DV / 8, NOC = (16 * NCHK) / 64;
    f32x4 wn[NOC][2];
#pragma unroll
    for (int i = 0; i < NOC; ++i) { const int cidx = lane + 64 * i, orow = cidx / NCHK, ch = cidx - orow * NCHK; wn[i][0] = (f32x4){1.f, 1.f, 1.f, 1.f}; wn[i][1] = wn[i][0];
        if constexpr (TYPE == 0) { const float* wp = a.gla_norm_w + layer * 384 + h * 96 + 8 * ch; wn[i][0] = *(const f32x4*)wp; wn[i][1] = *(const f32x4*)(wp + 4); }
        if constexpr (TYPE == 1) { const float* wp = a.hg_norm_w + layer * 256 + h * 64 + 8 * ch; wn[i][0] = *(const f32x4*)wp; wn[i][1] = *(const f32x4*)(wp + 4); } }
    QRaw<TYPE> R; v4u kf[4][2]; v4u gvn[NOC];
    auto issue = [&](int I) { q_issue<TYPE>(a, h, (size_t)(row0 + 16 * I + r), g, R);
#pragma unroll
        for (int J = 0; J < 4; ++J) { const int Jc = (J < I) ? J : I; const size_t rowJ = (size_t)(row0 + 16 * Jc + r);
#pragma unroll
            for (int s = 0; s < 2; ++s) { const int d0 = 32 * s + 8 * g; const int d0c = (d0 < DK) ? d0 : 0;
                kf[J][s] = *(const v4u*)((const bf16*)(ws + WS_KT) + rowJ * NKT + C::KOFF + h * DK + d0c); } }
#pragma unroll
        for (int i = 0; i < NOC; ++i) { const int cidx = lane + 64 * i, orow = cidx / NCHK, ch = cidx - orow * NCHK; gvn[i] = *(const v4u*)(PROJ + (size_t)(row0 + 16 * I + orow) * NPROJ + C::CG + h * DV + 8 * ch); } };
    issue(hsel);
#pragma unroll
    for (int ib = 0; ib < 2; ++ib) { const int I = ib ? 3 - hsel : hsel;
        pg8::bf16x8 qh[2], qt[2]; float refv[2][8], qhf[2][8];
#pragma unroll
        for (int s = 0; s < 2; ++s) { const int d0 = 32 * s + 8 * g; const bool valid = d0 < DK; const int d0c = valid ? d0 : 0;
            float x[8], cm[8]; q_convert<TYPE>(R, s, h, 16 * I + r, d0c, x, cm);
            if constexpr (TYPE == 2) {
#pragma unroll
                for (int j = 0; j < 8; ++j) refv[s][j] = (float)(16 * I) * ret_lg(h);
            } else { if (I > 0) { const LAS float* cp = (const LAS float*)(lds + LC_EQ) + (I - 1) * 256 + h * DK + d0c; const f32x4 c0 = *(const LAS f32x4*)cp, c1 = *(const LAS f32x4*)(cp + 4);
#pragma unroll
                    for (int j = 0; j < 4; ++j) { refv[s][j] = c0[j]; refv[s][4 + j] = c1[j]; } }
                else {
#pragma unroll
                    for (int j = 0; j < 8; ++j) refv[s][j] = 1.f; } }
            float xt[8];
#pragma unroll
            for (int j = 0; j < 8; ++j) { if constexpr (TYPE == 2) { qhf[s][j] = valid ? x[j] * __expf(cm[j] - refv[s][j]) : 0.f; xt[j] = valid ? x[j] * __expf(cm[j]) : 0.f; }
                else { qhf[s][j] = valid ? x[j] * cm[j] : 0.f; xt[j] = qhf[s][j] * refv[s][j]; } }
            qh[s] = pack8(qhf[s]); qt[s] = pack8(xt); }
#pragma unroll
        for (int J = 0; J < 4; ++J) { if (J <= I) { f32x4 acc = {0.f, 0.f, 0.f, 0.f};
#pragma unroll
            for (int s = 0; s < 2; ++s) { pg8::bf16x8 qop;
                { float xq[8], ej[8]; const int d0 = 32 * s + 8 * g; const int d0c = (d0 < DK) ? d0 : 0;
                    if constexpr (TYPE == 2) {
#pragma unroll
                        for (int j = 0; j < 8; ++j) ej[j] = (float)(16 * (J + 1)) * ret_lg(h); }
                    else { const LAS float* ep = (const LAS float*)(lds + LC_EC) + (I * (I + 1) / 2 + J) * 256 + h * DK + d0c; const f32x4 e0 = *(const LAS f32x4*)ep, e1 = *(const LAS f32x4*)(ep + 4);
#pragma unroll
                        for (int j = 0; j < 4; ++j) { ej[j] = e0[j]; ej[4 + j] = e1[j]; } }
#pragma unroll
                    for (int j = 0; j < 8; ++j) xq[j] = qhf[s][j] * ((TYPE == 2) ? __expf(fminf(refv[s][j] - ej[j], 80.f)) : ej[j]);
                    qop = pack8(xq); }
                acc = __builtin_amdgcn_mfma_f32_16x16x32_bf16(qop, __builtin_bit_cast(pg8::bf16x8, kf[J][s]), acc, 0, 0, 0); }
#pragma unroll
            for (int q = 0; q < 4; ++q) { const int i = 4 * g + q; const float v = (J < I || r <= i) ? acc[q] : 0.f; AB[i * BP + 16 * J + r] = (bf16)f2bf(v); } } }
        if ((I & 1) == 0) {
#pragma unroll
            for (int q = 0; q < 4; ++q) AB[(4 * g + q) * BP + 16 * (I + 1) + r] = (bf16)0; }
        v4u gvp[NOC];
#pragma unroll
        for (int i = 0; i < NOC; ++i) gvp[i] = gvn[i];
        if (ib == 0) issue(3 - hsel);
        asm volatile("s_waitcnt lgkmcnt(0)" ::: "memory");
        const pg8::bf16x8 ah0 = *(const LAS pg8::bf16x8*)(AB + r * BP + 8 * g), ah1 = *(const LAS pg8::bf16x8*)(AB + r * BP + 32 + 8 * g);
        f32x4 o[TE];
#pragma unroll
        for (int te = 0; te < TE; ++te) { f32x4 acc = {0.f, 0.f, 0.f, 0.f};
            acc = __builtin_amdgcn_mfma_f32_16x16x32_bf16(qt[0], ldfrag(STh, BP, te * 16, 0, lane), acc, 0, 0, 0);
            acc = __builtin_amdgcn_mfma_f32_16x16x32_bf16(qt[1], ldfrag(STh, BP, te * 16, 32, lane), acc, 0, 0, 0);
            acc = __builtin_amdgcn_mfma_f32_16x16x32_bf16(ah0, ldfrag(VTh, BP, te * 16, 0, lane), acc, 0, 0, 0);
            if (I >= 2) acc = __builtin_amdgcn_mfma_f32_16x16x32_bf16(ah1, ldfrag(VTh, BP, te * 16, 32, lane), acc, 0, 0, 0);
            o[te] = acc; }
        const unsigned long long ts2_ = SUB_MASK ? rt_now() : 0ull;
#pragma unroll
        for (int q = 0; q < 4; ++q) { float s1 = 0.f, s2 = 0.f;
#pragma unroll
            for (int te = 0; te < TE; ++te) { s1 += o[te][q]; s2 += o[te][q] * o[te][q]; }
#pragma unroll
            for (int m = 1; m < 16; m <<= 1) { s1 += __shfl_xor(s1, m); s2 += __shfl_xor(s2, m); }
            float mean = 0.f, rstd;
            if constexpr (TYPE == 2) { mean = s1 * (1.0f / DV); rstd = __builtin_amdgcn_rsqf(fmaxf(s2 * (1.0f / DV) - mean * mean, 0.f) + EPS); }
            else rstd = __builtin_amdgcn_rsqf(s2 * (1.0f / DV) + EPS);
#pragma unroll
            for (int te = 0; te < TE; ++te) AB[(4 * g + q) * OBP + te * 16 + r] = (bf16)f2bf((o[te][q] - mean) * rstd); }
        asm volatile("s_waitcnt lgkmcnt(0)" ::: "memory");
#pragma unroll
        for (int i = 0; i < NOC; ++i) { const int cidx = lane + 64 * i, orow = cidx / NCHK, ch = cidx - orow * NCHK; const size_t row = (size_t)(row0 + 16 * I + orow);
            const v4u ov = *(const LAS v4u*)(AB + orow * OBP + 8 * ch); const v4u gv = gvp[i];
            const unsigned ow[4] = {ov.x, ov.y, ov.z, ov.w}, gw[4] = {gv.x, gv.y, gv.z, gv.w}; float res[8];
            const f32x4 w0 = wn[i][0], w1 = wn[i][1];
#pragma unroll
            for (int j = 0; j < 4; ++j) { const float oa = __builtin_bit_cast(float, ow[j] << 16), ob = __builtin_bit_cast(float, ow[j] & 0xffff0000u), ga = __builtin_bit_cast(float, gw[j] << 16), gb = __builtin_bit_cast(float, gw[j] & 0xffff0000u);
                const float wa = (j < 2) ? w0[2 * j] : w1[2 * j - 4], wb = (j < 2) ? w0[2 * j + 1] : w1[2 * j - 3];
                const float sa = __builtin_amdgcn_rcpf(1.0f + __expf(-ga)), sb = __builtin_amdgcn_rcpf(1.0f + __expf(-gb));
                res[2 * j] = oa * wa * ((TYPE == 1) ? sa : ga * sa); res[2 * j + 1] = ob * wb * ((TYPE == 1) ? sb : gb * sb); }
            if (F8_OUT) { typedef int i32x2 __attribute__((ext_vector_type(2)));
                *(GAS i32x2*)((unsigned char*)MIX + row * D + C::MIXOFF + h * DV + 8 * ch) = (i32x2){pk4_fp8(res[0] * S8_M, res[1] * S8_M, res[2] * S8_M, res[3] * S8_M), pk4_fp8(res[4] * S8_M, res[5] * S8_M, res[6] * S8_M, res[7] * S8_M)}; }
            else { v4u w; w.x = pk2(res[0], res[1]); w.y = pk2(res[2], res[3]); w.z = pk2(res[4], res[5]); w.w = pk2(res[6], res[7]); *(GAS v4u*)(MIX + row * D + C::MIXOFF + h * DV + 8 * ch) = w; } }
        SUBSTRETCH(2, ts2_);
    }
    SUBSTRETCH(1, ts1_);
    const unsigned long long tsE_ = SUB_MASK ? rt_now() : 0ull;
    __syncthreads();
    SUBSTRETCH(6, tsE_);
}
__device__ __forceinline__ void p3c_outputs(const Args& a, int layer, LAS unsigned char* lds, int vcu, int G, int tid, int lane, int wave) {
    for (int unit = vcu; unit < NUNIT; unit += G) {
        mixc_batch<0>(a, layer, unit, lds, tid, lane, wave);
        mixc_batch<1>(a, layer, unit, lds, tid, lane, wave);
        mixc_batch<2>(a, layer, unit, lds, tid, lane, wave);
    }
}


constexpr int MW_ARGS = 800;
__device__ __forceinline__ const void* ld_argp(const volatile LAS unsigned* T, int i) {
    const unsigned lo = __builtin_amdgcn_readfirstlane(T[2 * i]), hi = __builtin_amdgcn_readfirstlane(T[2 * i + 1]);
    return (const void*)(((unsigned long long)hi << 32) | lo);
}
__device__ __forceinline__ Args load_args(LAS unsigned char* lds) {
    const volatile LAS unsigned* T = (const volatile LAS unsigned*)(lds + MISC_OFF) + MW_ARGS;
    Args a;
    a.x = (const float*)ld_argp(T, 0); a.c = (const float*)ld_argp(T, 1); a.pos = (const int*)ld_argp(T, 2); a.w_mod = (const float*)ld_argp(T, 3); a.b_mod = (const float*)ld_argp(T, 4);
    a.norm1_w = (const float*)ld_argp(T, 5); a.w_in = (const float*)ld_argp(T, 6); a.gla_wa2 = (const float*)ld_argp(T, 7); a.gla_ba2 = (const float*)ld_argp(T, 8); a.hg_lb = (const float*)ld_argp(T, 9);
    a.gla_norm_w = (const float*)ld_argp(T, 10); a.hg_norm_w = (const float*)ld_argp(T, 11); a.w_out = (const float*)ld_argp(T, 12); a.norm2_w = (const float*)ld_argp(T, 13); a.w_r = (const float*)ld_argp(T, 14);
    a.b_r = (const float*)ld_argp(T, 15); a.w_gu = (const float*)ld_argp(T, 16); a.b_gu = (const float*)ld_argp(T, 17); a.w_dn = (const float*)ld_argp(T, 18); a.b_dn = (const float*)ld_argp(T, 19);
    a.final_norm_w = (const float*)ld_argp(T, 20); a.out = (float*)ld_argp(T, 21); a.ws = (unsigned char*)ld_argp(T, 22); a.ph_lo = 0; a.ph_hi = 0;
    return a;
}
#define PH_CTX() { unsigned l_ = (unsigned)(size_t)lds; asm volatile("" : "+s"(l_)); lds = (LAS unsigned char*)(size_t)l_; } const Args args = load_args(lds); volatile LAS unsigned* MISC = (volatile LAS unsigned*)(lds + MISC_OFF); int tid_ = wv * 64 + (int)__builtin_amdgcn_mbcnt_hi(~0u, __builtin_amdgcn_mbcnt_lo(~0u, 0u)); asm volatile("" : "+v"(tid_)); const int tid = tid_, lane = tid & 63, wave = __builtin_amdgcn_readfirstlane(tid >> 6); \
    const int G = gridDim.x; const int bx = blockIdx.x; const int vcu = (G % 8 == 0) ? (bx % 8) * (G / 8) + bx / 8 : bx; unsigned char* ws = args.ws; gu32* ctl = (gu32*)(ws + WS_CTL); \
    (void)MISC; (void)lane; (void)wave; (void)vcu; (void)ctl; (void)bx; (void)tid
__device__ __forceinline__ void ph_p0(LAS unsigned char* lds, int wv) { PH_CTX(); p0_prologue(args, lds, vcu, G, tid, lane, wave); }
__device__ __forceinline__ void ph_p1(LAS unsigned char* lds, int wv, int layer_) { int layer = __builtin_amdgcn_readfirstlane(layer_); asm volatile("" : "+s"(layer)); PH_CTX();
    if (layer > 0) { moe_tables(ctl, layer - 1, MISC, tid); const int nrt = __builtin_amdgcn_readfirstlane((int)MISC[MW_NRT]);
        const int done = conv_t2(G) + conv_idle(nrt * 8, G) * NWAVES * CB7 + conv_idle(nrt * 4, G) * NWAVES * CB8; LAS float* scr = (LAS float*)(lds + wave * 16640);
        for (int it = done + vcu * NWAVES + wave; it < IT_LAYER; it += G * NWAVES) convert_item(args, layer, it, scr, lane);
        __syncthreads(); }
    rows_mfma<16>(args, layer, lds, MISC, ctl, vcu, G, tid, lane, wave); }
__device__ __forceinline__ void ph_p2(LAS unsigned char* lds, int wv, int layer_) { int layer = __builtin_amdgcn_readfirstlane(layer_); asm volatile("" : "+s"(layer)); PH_CTX();
    pg8::Gemm g{(const bf16*)(ws + WS_H), (const bf16*)(ws + WS_WIN + (size_t)layer * NPROJ * D * (F8_IN ? 1 : 2)), MTOK, NPROJ, F8_IN ? D / 2 : D}; pg8::StaticOrder S; S.init(MTOK, NPROJ, G, bx);
    pg8::EpiBf16Plain E{(bf16*)(ws + WS_PROJ), NPROJ, F8_IN ? 1.0f / (S8_H * S8_W) : 1.0f};
    pg8::gemm_phase<pg8::EpiBf16Plain, pg8::StaticOrder, true, true, F8_IN>(lds, g, S, E, tid);
    if (layer + 1 < DEPTH && G == 256 && bx >= 64) convert_range(args, layer + 1, ((bx - 64) * NWAVES + wave) * CB2, CB2, lds, lane, wave); }
__device__ __forceinline__ void ph_p3a(LAS unsigned char* lds, int wv, int layer_) { int layer = __builtin_amdgcn_readfirstlane(layer_); asm volatile("" : "+s"(layer)); PH_CTX(); p3a_summaries(args, layer, lds, vcu, G, tid, lane, wave); }
__device__ __forceinline__ void ph_p3b(LAS unsigned char* lds, int wv) { PH_CTX(); p3b_scan(args, vcu, G, tid); }
__device__ __forceinline__ void ph_p3c(LAS unsigned char* lds, int wv, int layer_) { int layer = __builtin_amdgcn_readfirstlane(layer_); asm volatile("" : "+s"(layer)); PH_CTX(); p3c_outputs(args, layer, lds, vcu, G, tid, lane, wave); }
__device__ __forceinline__ void ph_p4(LAS unsigned char* lds, int wv, int layer_) { int layer = __builtin_amdgcn_readfirstlane(layer_); asm volatile("" : "+s"(layer)); PH_CTX();
    pg8::Gemm g{(const bf16*)(ws + WS_MIX), (const bf16*)(ws + WS_WOUT + (size_t)layer * D * D * (F8_OUT ? 1 : 2)), MTOK, D, F8_OUT ? D / 2 : D}; pg8::StaticOrder S; S.init(MTOK, D, G, bx);
    pg8::EpiResGate E{(const bf16*)(ws + WS_X), (bf16*)(ws + WS_X), D, (const float*)(ws + WS_MOD) + (size_t)layer * 2 * 6144 + 2 * D, 6144, SEQ, F8_OUT ? 1.0f / (S8_M * S8_W) : 1.0f};
    pg8::gemm_phase<pg8::EpiResGate, pg8::StaticOrder, true, true, F8_OUT>(lds, g, S, E, tid); }
__device__ __forceinline__ void ph_p5(LAS unsigned char* lds, int wv, int layer_) { int layer = __builtin_amdgcn_readfirstlane(layer_); asm volatile("" : "+s"(layer)); PH_CTX(); rows_mfma<32>(args, layer, lds, MISC, ctl, vcu, G, tid, lane, wave); }
__device__ __forceinline__ void ph_p7(LAS unsigned char* lds, int wv, int layer_) { int layer = __builtin_amdgcn_readfirstlane(layer_); asm volatile("" : "+s"(layer)); PH_CTX();
    moe_tables(ctl, layer, MISC, tid);
    const int nrt = __builtin_amdgcn_readfirstlane((int)MISC[MW_NRT]);
    pg8::Gemm g{(const bf16*)(ws + WS_A1), (const bf16*)(ws + WS_WGU + (size_t)layer * NE * 2048 * D), nrt * 256, NE * 2048, D / 2};
    pg8::MoeOrder S{8, G, vcu, nrt * 8, (const LAS int*)(lds + MISC_OFF + 4 * MW_TILE)};
    pg8::EpiSwiglu E{ws + WS_ACT, FFN, args.b_gu + (size_t)layer * NE * 2048, 1.0f / (S8_H * S8_W), S8_A};
    pg8::gemm_phase<pg8::EpiSwiglu, pg8::MoeOrder, true, true, true>(lds, g, S, E, tid);
    { const int rem = (nrt * 8) % G; if (layer + 1 < DEPTH && rem != 0 && vcu >= rem) convert_range(args, layer + 1, conv_t2(G) + ((vcu - rem) * NWAVES + wave) * CB7, CB7, lds, lane, wave); } }
__device__ __forceinline__ void ph_p8(LAS unsigned char* lds, int wv, int layer_) { int layer = __builtin_amdgcn_readfirstlane(layer_); asm volatile("" : "+s"(layer)); PH_CTX();
    moe_tables(ctl, layer, MISC, tid);
    const int nrt = __builtin_amdgcn_readfirstlane((int)MISC[MW_NRT]);
    pg8::Gemm g{(const bf16*)(ws + WS_ACT), (const bf16*)(ws + WS_WDN + (size_t)layer * NE * D * FFN), nrt * 256, NE * D, FFN / 2};
    pg8::MoeOrder S{4, G, vcu, nrt * 4, (const LAS int*)(lds + MISC_OFF + 4 * MW_TILE)};
    if constexpr (Y8) { pg8::EpiFp8Bias E{ws + WS_Y, D, args.b_dn + (size_t)layer * NE * D, D, 1.0f / (S8_A * S8_W), S8_Y};
        pg8::gemm_phase<pg8::EpiFp8Bias, pg8::MoeOrder, true, true, true>(lds, g, S, E, tid); }
    else { pg8::EpiBf16Bias E{(bf16*)(ws + WS_Y), D, args.b_dn + (size_t)layer * NE * D, D, 1.0f / (S8_A * S8_W)};
        pg8::gemm_phase<pg8::EpiBf16Bias, pg8::MoeOrder, true, true, true>(lds, g, S, E, tid); }
    { const int rem = (nrt * 4) % G; if (layer + 1 < DEPTH && rem != 0 && vcu >= rem) convert_range(args, layer + 1, conv_t2(G) + conv_idle(nrt * 8, G) * NWAVES * CB7 + ((vcu - rem) * NWAVES + wave) * CB8, CB8, lds, lane, wave); } }
__device__ __forceinline__ void ph_final(LAS unsigned char* lds, int wv) { PH_CTX(); final_rows(args, lds, vcu, G, tid, lane); }

#ifndef DBL_MASK
#define DBL_MASK 0
#endif
#if DBL_MASK
#define RUN(bit, call) do { if ((DBL_MASK >> (bit)) & 1) { const unsigned long long t0_ = __builtin_amdgcn_s_memrealtime(); call; const unsigned long long t1_ = __builtin_amdgcn_s_memrealtime(); \
        while (__builtin_amdgcn_s_memrealtime() - t1_ < t1_ - t0_) __builtin_amdgcn_s_sleep(8); } else { call; } } while (0)
#else
#define RUN(bit, call) do { call; } while (0)
#endif
__global__ void __launch_bounds__(NTHR, 2) hybrid_fwd(Args args) {
    extern __shared__ __attribute__((aligned(16))) unsigned char lds_raw[];
    LAS unsigned char* lds = (LAS unsigned char*)lds_raw;
    volatile LAS unsigned* MISC = (volatile LAS unsigned*)(lds + MISC_OFF);
    const int tid = threadIdx.x; const int wv = __builtin_amdgcn_readfirstlane(tid >> 6);
    gu32* ctl = (gu32*)(args.ws + WS_CTL);
    for (int u = tid; u < (LDS_BYTES - MISC_OFF) / 4; u += NTHR) MISC[u] = 0u;
    __syncthreads();
    if (tid == 0) {
#define ST_ARG(i, p) do { const unsigned long long v_ = (unsigned long long)(p); MISC[MW_ARGS + 2 * (i)] = (unsigned)v_; MISC[MW_ARGS + 2 * (i) + 1] = (unsigned)(v_ >> 32); } while (0)
        ST_ARG(0, args.x); ST_ARG(1, args.c); ST_ARG(2, args.pos); ST_ARG(3, args.w_mod); ST_ARG(4, args.b_mod); ST_ARG(5, args.norm1_w); ST_ARG(6, args.w_in); ST_ARG(7, args.gla_wa2); ST_ARG(8, args.gla_ba2);
        ST_ARG(9, args.hg_lb); ST_ARG(10, args.gla_norm_w); ST_ARG(11, args.hg_norm_w); ST_ARG(12, args.w_out); ST_ARG(13, args.norm2_w); ST_ARG(14, args.w_r); ST_ARG(15, args.b_r); ST_ARG(16, args.w_gu);
        ST_ARG(17, args.b_gu); ST_ARG(18, args.w_dn); ST_ARG(19, args.b_dn); ST_ARG(20, args.final_norm_w); ST_ARG(21, args.out); ST_ARG(22, args.ws);
#undef ST_ARG
    }
    __syncthreads();
    const int lo = args.ph_lo, hi = args.ph_hi;
    const bool multi = (hi - lo) > 1;
    XcdBarrier bar; bar.bar = (unsigned*)(ctl + CW_BAR); bar.x = 0; bar.st = nullptr;
    if (multi) bar = xcd_barrier_post((unsigned*)(ctl + CW_BAR), MISC + MW_BAR);
#define IN(k) (lo <= (k) && (k) < hi)
#define SEAM(k) do { if (IN(k) && IN((k) + 1)) xcd_barrier(bar); } while (0)

    if (IN(0)) RUN(0, ph_p0(lds, wv));
    SEAM(0);
    for (int layer = 0; layer < DEPTH; ++layer) {
        const int pb = 1 + 9 * layer;
        if (IN(pb + 0)) RUN(1, ph_p1(lds, wv, layer));
        SEAM(pb + 0);
        if (IN(pb + 1)) RUN(2, ph_p2(lds, wv, layer));
        SEAM(pb + 1);
        if (IN(pb + 2)) RUN(3, ph_p3a(lds, wv, layer));
        SEAM(pb + 2);
        if (IN(pb + 3)) RUN(4, ph_p3b(lds, wv));
        SEAM(pb + 3);
        if (IN(pb + 4)) RUN(5, ph_p3c(lds, wv, layer));
        SEAM(pb + 4);
        if (IN(pb + 5)) RUN(6, ph_p4(lds, wv, layer));
        SEAM(pb + 5);
        if (IN(pb + 6)) RUN(7, ph_p5(lds, wv, layer));
        SEAM(pb + 6);
        if (IN(pb + 7)) RUN(9, ph_p7(lds, wv, layer));
        SEAM(pb + 7);
        if (IN(pb + 8)) RUN(10, ph_p8(lds, wv, layer));
        SEAM(pb + 8);
    }
    if (IN(NPHASE - 1)) RUN(11, ph_final(lds, wv));
#undef IN
#undef SEAM
}

#ifndef MK_SINGLE
#define MK_SINGLE 1
#endif
extern "C" void kernel_launch(void* const* d_in, const int* in_sizes, int n_in, void* d_out, int out_size, void* d_ws, size_t ws_size, hipStream_t stream) {
    static int grid = 0;
    if (grid == 0) {
        if (n_in != 21 || in_sizes[0] != MTOK * D || out_size != MTOK * D || ws_size < WS_END) { fprintf(stderr, "kernel_launch: unexpected problem shape (n_in %d, in0 %d, out %d, ws %zu)\n", n_in, n_in > 0 ? in_sizes[0] : -1, out_size, ws_size); grid = -1; return; }
        int dev = 0, cus = 0, per_cu = 0;
        if (hipGetDevice(&dev) != hipSuccess || hipDeviceGetAttribute(&cus, hipDeviceAttributeMultiprocessorCount, dev) != hipSuccess) { grid = -1; return; }
        if (hipFuncSetAttribute((const void*)hybrid_fwd, hipFuncAttributeMaxDynamicSharedMemorySize, LDS_BYTES) != hipSuccess) { fprintf(stderr, "kernel_launch: hipFuncSetAttribute failed\n"); grid = -1; return; }
        if (hipOccupancyMaxActiveBlocksPerMultiprocessor(&per_cu, (const void*)hybrid_fwd, NTHR, LDS_BYTES) != hipSuccess || per_cu < 1) fprintf(stderr, "kernel_launch: occupancy query says %d\n", per_cu);
        (void)hipGetLastError();
        grid = cus;
    }
    if (grid < 0) return;
    (void)hipMemsetAsync((char*)d_ws + WS_CTL, 0, CTL_ZERO_BYTES, stream);
    Args a{};
    a.x = (const float*)d_in[0]; a.c = (const float*)d_in[1]; a.pos = (const int*)d_in[2]; a.w_mod = (const float*)d_in[3]; a.b_mod = (const float*)d_in[4]; a.norm1_w = (const float*)d_in[5];
    a.w_in = (const float*)d_in[6]; a.gla_wa2 = (const float*)d_in[7]; a.gla_ba2 = (const float*)d_in[8]; a.hg_lb = (const float*)d_in[9]; a.gla_norm_w = (const float*)d_in[10]; a.hg_norm_w = (const float*)d_in[11];
    a.w_out = (const float*)d_in[12]; a.norm2_w = (const float*)d_in[13]; a.w_r = (const float*)d_in[14]; a.b_r = (const float*)d_in[15]; a.w_gu = (const float*)d_in[16]; a.b_gu = (const float*)d_in[17];
    a.w_dn = (const float*)d_in[18]; a.b_dn = (const float*)d_in[19]; a.final_norm_w = (const float*)d_in[20]; a.out = (float*)d_out; a.ws = (unsigned char*)d_ws;
#if MK_SINGLE
    a.ph_lo = 0; a.ph_hi = NPHASE;
    hipLaunchKernelGGL(hybrid_fwd, dim3(grid), dim3(NTHR), LDS_BYTES, stream, a);
#else
    for (int p = 0; p < NPHASE; ++p) { a.ph_lo = p; a.ph_hi = p + 1; hipLaunchKernelGGL(hybrid_fwd, dim3(grid), dim3(NTHR), LDS_BYTES, stream, a); }
#endif
}
```

```cpp
#include <hip/hip_runtime.h>
#include <cstdio>
#include <cstdint>
namespace pg8 {
#define PG8_LAS __attribute__((address_space(3)))
typedef unsigned short bf16_t;
typedef short bf16x8 __attribute__((ext_vector_type(8)));
typedef float f32x4 __attribute__((ext_vector_type(4)));
typedef unsigned u32x4 __attribute__((ext_vector_type(4)));
constexpr int BM = 256, BK = 64, HALF = 128, HTB = HALF * BK * 2  , STAGE_BYTES = 8 * HTB, NXCD = 8, WGM = 8;

__host__ __device__ __forceinline__ int lds_byte(int r, int c) { const int st = (r >> 4) * 2 + (c >> 5), rr = r & 15, cc = c & 31, ob = rr * 64 + cc * 2; return st * 1024 + (ob ^ (((ob >> 9) & 1) << 5)); }
__host__ __device__ __forceinline__ void stage_rc(int b, int& R, int& C) { const int st = b / 1024, sb = b % 1024, swz = sb ^ (((sb >> 9) & 1) << 5); R = (st >> 1) * 16 + swz / 64; C = (st & 1) * 32 + (swz % 64) / 2; }
__host__ __device__ __forceinline__ int perm32(int rho) { const int n = rho >> 4, i = rho & 15; return 8 * (i >> 2) + 4 * n + (i & 3); }

struct Unit { int pm, pn, e, pl; };
struct Gemm { const bf16_t* A; const bf16_t* Bt; int M, N, K; };

struct StaticOrder {
    int nM, nN, nwg, G, c;
    __host__ __device__ void init(int M, int N, int G_, int c_) { nM = M / BM; nN = N / BM; nwg = nM * nN; G = G_; c = c_; }
    __host__ __device__ bool next(int i, Unit& u) const {
        const long L = (long)i * G + c; if (L >= nwg) return false;
        int wgid = (int)L; { const int q = nwg / NXCD, r = nwg % NXCD, xcd = wgid % NXCD, off = wgid / NXCD; wgid = (xcd < r ? xcd * (q + 1) : r * (q + 1) + (xcd - r) * q) + off; }
        const int nig = WGM * nN, gid = wgid / nig, fm = gid * WGM, gsz = (nM - fm) < WGM ? (nM - fm) : WGM;
        u.pm = fm + ((wgid % nig) % gsz); u.pn = (wgid % nig) / gsz; u.e = 0; u.pl = u.pn; return true;
    }
    __device__ __forceinline__ void a_ready(const Unit&) const {}
    __device__ __forceinline__ void done(const Unit&) const {}
};

__device__ __forceinline__ unsigned cvt_pk_bf16(float lo, float hi) { unsigned r; asm volatile("v_cvt_pk_bf16_f32 %0, %1, %2" : "=v"(r) : "v"(lo), "v"(hi)); return r; }

#define PG8_GAS __attribute__((address_space(1)))
struct NoPre {};
struct EpiBf16Plain {
    static constexpr bool PERM = true, AFTER_DRAIN = false; static constexpr int NST = 0; typedef NoPre Pre;
    __device__ __forceinline__ Pre prefetch(const Unit&, int, int) const { return Pre{}; }
    bf16_t* O; int ldc; float sc;
    __device__ __forceinline__ void operator()(const f32x4 (&acc)[2][2][4][2], const Unit& u, int wr, int wc, int fr, int fq, const Pre&) const {
        const int row0 = u.pm * BM + wr * 64 + fr; const int col0 = u.pn * BM + wc * 32 + 8 * fq;
#pragma unroll
        for (int ai = 0; ai < 2; ++ai)
#pragma unroll
            for (int m = 0; m < 4; ++m) { bf16_t* rowp = O + (size_t)(row0 + ai * HALF + m * 16) * ldc + col0;
#pragma unroll
                for (int bj = 0; bj < 2; ++bj) { const f32x4 v0 = acc[ai][bj][m][0] * sc, v1 = acc[ai][bj][m][1] * sc;
                    u32x4 w; w.x = cvt_pk_bf16(v0[0], v0[1]); w.y = cvt_pk_bf16(v0[2], v0[3]); w.z = cvt_pk_bf16(v1[0], v1[1]); w.w = cvt_pk_bf16(v1[2], v1[3]);
                    *(PG8_GAS u32x4*)(rowp + bj * HALF) = w; } }
    }
};
struct EpiResGate {
    static constexpr bool PERM = true, AFTER_DRAIN = false; static constexpr int NST = 0; typedef NoPre Pre;
    __device__ __forceinline__ Pre prefetch(const Unit&, int, int) const { return Pre{}; }
    const bf16_t* base; bf16_t* out; int ldc; const float* gate; int gpitch; int rows_per_batch; float sc;
    __device__ __forceinline__ void operator()(const f32x4 (&acc)[2][2][4][2], const Unit& u, int wr, int wc, int fr, int fq, const Pre&) const {
        const int row0 = u.pm * BM + wr * 64 + fr, col0 = u.pn * BM + wc * 32 + 8 * fq;
        const float* gp = gate + (size_t)((u.pm * BM) / rows_per_batch) * gpitch + col0;
        f32x4 gv[2][2];
#pragma unroll
        for (int bj = 0; bj < 2; ++bj)
#pragma unroll
            for (int n = 0; n < 2; ++n) gv[bj][n] = *(const PG8_GAS f32x4*)(gp + bj * HALF + 4 * n) * sc;
#pragma unroll
        for (int ai = 0; ai < 2; ++ai)
#pragma unroll
            for (int m = 0; m < 4; ++m) { const size_t off = (size_t)(row0 + ai * HALF + m * 16) * ldc + col0;
#pragma unroll
                for (int bj = 0; bj < 2; ++bj) { const u32x4 bs = *(const PG8_GAS u32x4*)(base + off + bj * HALF); const unsigned bw[4] = {bs.x, bs.y, bs.z, bs.w}; float r[8];
#pragma unroll
                    for (int j = 0; j < 4; ++j) { const f32x4& a4 = acc[ai][bj][m][j >> 1]; const f32x4& g4 = gv[bj][j >> 1];
                        r[2 * j] = __builtin_bit_cast(float, bw[j] << 16) + g4[2 * (j & 1)] * a4[2 * (j & 1)]; r[2 * j + 1] = __builtin_bit_cast(float, bw[j] & 0xffff0000u) + g4[2 * (j & 1) + 1] * a4[2 * (j & 1) + 1]; }
                    u32x4 w; w.x = cvt_pk_bf16(r[0], r[1]); w.y = cvt_pk_bf16(r[2], r[3]); w.z = cvt_pk_bf16(r[4], r[5]); w.w = cvt_pk_bf16(r[6], r[7]);
                    *(PG8_GAS u32x4*)(out + off + bj * HALF) = w; }
                asm volatile("" ::: "memory"); }
    }
};
struct EpiSwiglu {
    static constexpr bool PERM = true, AFTER_DRAIN = false; static constexpr int NST = 0; struct Pre { f32x4 bg[2], bu[2]; };
    __device__ __forceinline__ Pre prefetch(const Unit& u, int wc, int fq) const { typedef const __attribute__((address_space(1))) f32x4 gf4;
        const float* bp = bias + (size_t)u.e * 2048 + u.pl * HALF + wc * 32 + 8 * fq; Pre p; p.bg[0] = *(gf4*)bp; p.bg[1] = *(gf4*)(bp + 4); p.bu[0] = *(gf4*)(bp + 1024); p.bu[1] = *(gf4*)(bp + 1028); return p; }
    unsigned char* O; int ldc; const float* bias; float inv_in, out_scale;
    __device__ __forceinline__ void operator()(const f32x4 (&acc)[2][2][4][2], const Unit& u, int wr, int wc, int fr, int fq, const Pre& pre) const {
        const int row0 = u.pm * BM + wr * 64 + fr; const int jj0 = wc * 32 + 8 * fq; const int col0 = u.pl * HALF + jj0;
        const float rinv = 1.0f / inv_in, lim = 7.0f * rinv, kc = -1.702f * 1.4426950408889634f * inv_in, k2 = inv_in * inv_in * out_scale, k3 = inv_in * out_scale;
        const f32x4 bg[2] = {pre.bg[0] * rinv, pre.bg[1] * rinv}, bu[2] = {pre.bu[0] * rinv, pre.bu[1] * rinv};
#pragma unroll
        for (int ai = 0; ai < 2; ++ai)
#pragma unroll
            for (int m = 0; m < 4; ++m) { unsigned char* rowp = O + (size_t)(row0 + ai * HALF + m * 16) * ldc + col0;
                f32x4 r[2];
#pragma unroll
                for (int n = 0; n < 2; ++n) { f32x4 A = acc[ai][0][m][n] + bg[n], B = acc[ai][1][m][n] + bu[n];
#pragma unroll
                    for (int j = 0; j < 4; ++j) { A[j] = fminf(A[j], lim); B[j] = __builtin_amdgcn_fmed3f(B[j], -lim, lim); }
                    f32x4 e = A * kc;
#pragma unroll
                    for (int j = 0; j < 4; ++j) e[j] = __builtin_amdgcn_exp2f(e[j]);
                    e = e + 1.0f;
#pragma unroll
                    for (int j = 0; j < 4; ++j) e[j] = __builtin_amdgcn_rcpf(e[j]);
                    r[n] = (B * k2 + k3) * (A * e); }
                int w0 = 0, w1 = 0;
                w0 = __builtin_amdgcn_cvt_pk_fp8_f32(r[0][0], r[0][1], w0, false); w0 = __builtin_amdgcn_cvt_pk_fp8_f32(r[0][2], r[0][3], w0, true);
                w1 = __builtin_amdgcn_cvt_pk_fp8_f32(r[1][0], r[1][1], w1, false); w1 = __builtin_amdgcn_cvt_pk_fp8_f32(r[1][2], r[1][3], w1, true);
                typedef int i32x2 __attribute__((ext_vector_type(2))); *(PG8_GAS i32x2*)rowp = (i32x2){w0, w1}; }
    }
};
struct EpiBf16Bias {
    static constexpr bool PERM = true, AFTER_DRAIN = false; static constexpr int NST = 0; typedef NoPre Pre;
    __device__ __forceinline__ Pre prefetch(const Unit&, int, int) const { return Pre{}; }
    bf16_t* O; int ldc; const float* bias; int bpitch; float inv_in;
    __device__ __forceinline__ void operator()(const f32x4 (&acc)[2][2][4][2], const Unit& u, int wr, int wc, int fr, int fq, const Pre&) const {
        const int row0 = u.pm * BM + wr * 64 + fr; const int col0 = u.pl * BM + wc * 32 + 8 * fq;
        const float* bp = bias + (size_t)u.e * bpitch + col0;
        f32x4 bv[2][2];
#pragma unroll
        for (int bj = 0; bj < 2; ++bj)
#pragma unroll
            for (int n = 0; n < 2; ++n) bv[bj][n] = *(const PG8_GAS f32x4*)(bp + bj * HALF + 4 * n);
#pragma unroll
        for (int ai = 0; ai < 2; ++ai)
#pragma unroll
            for (int m = 0; m < 4; ++m) { bf16_t* rowp = O + (size_t)(row0 + ai * HALF + m * 16) * ldc + col0;
#pragma unroll
                for (int bj = 0; bj < 2; ++bj) { const f32x4 v0 = acc[ai][bj][m][0] * inv_in + bv[bj][0], v1 = acc[ai][bj][m][1] * inv_in + bv[bj][1];
                    u32x4 w; w.x = cvt_pk_bf16(v0[0], v0[1]); w.y = cvt_pk_bf16(v0[2], v0[3]); w.z = cvt_pk_bf16(v1[0], v1[1]); w.w = cvt_pk_bf16(v1[2], v1[3]);
                    *(PG8_GAS u32x4*)(rowp + bj * HALF) = w; } }
    }
};
struct EpiFp8Bias {
    static constexpr bool PERM = true, AFTER_DRAIN = false; static constexpr int NST = 0; struct Pre { f32x4 bv[2][2]; };
    __device__ __forceinline__ Pre prefetch(const Unit& u, int wc, int fq) const { typedef const __attribute__((address_space(1))) f32x4 gf4;
        const float* bp = bias + (size_t)u.e * bpitch + u.pl * BM + wc * 32 + 8 * fq; Pre p; p.bv[0][0] = *(gf4*)bp; p.bv[0][1] = *(gf4*)(bp + 4); p.bv[1][0] = *(gf4*)(bp + HALF); p.bv[1][1] = *(gf4*)(bp + HALF + 4); return p; }
    unsigned char* O; int ldc; const float* bias; int bpitch; float inv_in, out_scale;
    __device__ __forceinline__ int pk4(f32x4 v) const { int w = 0; w = __builtin_amdgcn_cvt_pk_fp8_f32(__builtin_amdgcn_fmed3f(v[0], -448.f, 448.f), __builtin_amdgcn_fmed3f(v[1], -448.f, 448.f), w, false);
        return __builtin_amdgcn_cvt_pk_fp8_f32(__builtin_amdgcn_fmed3f(v[2], -448.f, 448.f), __builtin_amdgcn_fmed3f(v[3], -448.f, 448.f), w, true); }
    __device__ __forceinline__ void operator()(const f32x4 (&acc)[2][2][4][2], const Unit& u, int wr, int wc, int fr, int fq, const Pre& pre) const {
        const int row0 = u.pm * BM + wr * 64 + fr; const int col0 = u.pl * BM + wc * 32 + 8 * fq;
        const float ks = inv_in * out_scale; const f32x4 bv[2][2] = {{pre.bv[0][0] * out_scale, pre.bv[0][1] * out_scale}, {pre.bv[1][0] * out_scale, pre.bv[1][1] * out_scale}};
#pragma unroll
        for (int ai = 0; ai < 2; ++ai)
#pragma unroll
            for (int m = 0; m < 4; ++m) { unsigned char* rowp = O + (size_t)(row0 + ai * HALF + m * 16) * ldc + col0;
#pragma unroll
                for (int bj = 0; bj < 2; ++bj) { const f32x4 v0 = acc[ai][bj][m][0] * ks + bv[bj][0], v1 = acc[ai][bj][m][1] * ks + bv[bj][1];
                    typedef int i32x2 __attribute__((ext_vector_type(2))); *(PG8_GAS i32x2*)(rowp + bj * HALF) = (i32x2){pk4(v0), pk4(v1)}; } }
    }
};
struct MoeOrder {
    int nN, G, c, nunits; const PG8_LAS int* tile_pm;
    __device__ __forceinline__ bool next(int i, Unit& u) const {
        const int L = i * G + c; if (L >= nunits) return false;
        const int idx = L / nN, pl = L - idx * nN, pm = __builtin_amdgcn_readfirstlane(tile_pm[idx]), e = pm >> 6;
        u.pm = pm; u.pl = pl; u.e = e; u.pn = e * nN + pl; return true;
    }
    __device__ __forceinline__ void a_ready(const Unit&) const {}
    __device__ __forceinline__ void done(const Unit&) const {}
};
typedef int v4i32_t __attribute__((ext_vector_type(4)));
typedef int v8i32_t __attribute__((ext_vector_type(8)));
template <class Epi, class Sched, bool ALIGN_EPI = false, bool SP2 = false, bool FP8 = false>
__device__ __forceinline__ void gemm_phase(PG8_LAS unsigned char* lds, const Gemm g, const Sched& S, const Epi& E, int tid_in) {
    int tid_ = tid_in; asm volatile("" : "+v"(tid_)); const int tid = tid_, wid = __builtin_amdgcn_readfirstlane(tid >> 6), lane = tid & 63, wr = wid >> 2, wc = wid & 3, fr = lane & 15, fq = lane >> 4;
    const int K = g.K, nt = K / BK;
    unsigned voffA, voffB;
    { int R, C; stage_rc(tid * 16, R, C); const int Rb = Epi::PERM ? ((R & ~31) + perm32(R & 31)) : R;
        voffA = (unsigned)(R * K + C) * 2u; voffB = (unsigned)(Rb * K + C) * 2u; }
    const size_t rstep = (size_t)64 * K * 2;
    const size_t kstep = (size_t)(BK * 2);
    const size_t hstep = (size_t)HALF * K * 2;
    const size_t tstep = 2 * hstep;
    const unsigned ldsw = (unsigned)wid * 1024u;
    const int aoff = lds_byte(wr * 64 + fr, fq * 8), boff = lds_byte(wc * 32 + fr, fq * 8);
#define PG8_SA(b, h) (((b) * 2 + (h)) * HTB)
#define PG8_SB(b, h) ((4 + (b) * 2 + (h)) * HTB)
#define PG8_STAGE(bufoff, gbase, voff) do { _Pragma("unroll") for (int _i = 0; _i < 2; ++_i) \
        __builtin_amdgcn_global_load_lds((const unsigned*)((const char*)(gbase) + _i * rstep + (voff)), (PG8_LAS unsigned*)(lds + (bufoff) + ldsw + _i * 8192), 16, 0, 0); } while (0)
#define PG8_LDA(dst, b, h) do { _Pragma("unroll") for (int m = 0; m < 4; ++m) _Pragma("unroll") for (int k = 0; k < 2; ++k) dst[m][k] = *(const PG8_LAS bf16x8*)(lds + PG8_SA(b, h) + aoff + m * 2048 + k * 1024); } while (0)
#define PG8_LDB(dst, b, h) do { _Pragma("unroll") for (int n = 0; n < 2; ++n) _Pragma("unroll") for (int k = 0; k < 2; ++k) dst[n][k] = *(const PG8_LAS bf16x8*)(lds + PG8_SB(b, h) + boff + n * 2048 + k * 1024); } while (0)
#define PG8_MMA(ai, bj, At, Bt) do { __builtin_amdgcn_s_setprio(1); _Pragma("unroll") for (int m = 0; m < 4; ++m) _Pragma("unroll") for (int n = 0; n < 2; ++n) { \
        if constexpr (FP8) { const v8i32_t a8_ = __builtin_shufflevector(__builtin_bit_cast(v4i32_t, At[m][0]), __builtin_bit_cast(v4i32_t, At[m][1]), 0, 1, 2, 3, 4, 5, 6, 7); \
            const v8i32_t b8_ = __builtin_shufflevector(__builtin_bit_cast(v4i32_t, Bt[n][0]), __builtin_bit_cast(v4i32_t, Bt[n][1]), 0, 1, 2, 3, 4, 5, 6, 7); \
            asm volatile("v_mfma_scale_f32_16x16x128_f8f6f4 %0, %1, %2, %0, %3, %3 op_sel_hi:[0,0,0]" : "+v"(acc[ai][bj][m][n]) : "v"(b8_), "v"(a8_), "v"(one8_)); } \
        else { _Pragma("unroll") for (int k = 0; k < 2; ++k) acc[ai][bj][m][n] = __builtin_amdgcn_mfma_f32_16x16x32_bf16(Bt[n][k], At[m][k], acc[ai][bj][m][n], 0, 0, 0); } } \
        __builtin_amdgcn_s_setprio(0); } while (0)
#define PG8_WAIT_V(n) asm volatile("s_waitcnt vmcnt(" #n ")" ::: "memory")
#define PG8_WAIT_L(n) asm volatile("s_waitcnt lgkmcnt(" #n ")" ::: "memory")
#define PG8_WAIT_V8R(relax) do { if (relax) { if constexpr (Epi::NST == 8) PG8_WAIT_V(16); else if constexpr (Epi::NST == 16) PG8_WAIT_V(24); else PG8_WAIT_V(8); } else PG8_WAIT_V(8); } while (0)
#define PG8_BAR __builtin_amdgcn_s_barrier()
#define PG8_SCHED __builtin_amdgcn_sched_barrier(0)
    Unit cur, nxt; int ui = 0;
    if (!S.next(0, cur)) return;
    f32x4 acc[2][2][4][2];
#pragma unroll
    for (int a = 0; a < 2; ++a)
#pragma unroll
        for (int b = 0; b < 2; ++b)
#pragma unroll
            for (int m = 0; m < 4; ++m)
#pragma unroll
                for (int n = 0; n < 2; ++n) acc[a][b][m][n] = (f32x4){0.f, 0.f, 0.f, 0.f};
    bf16x8 At[4][2], B0[2][2], B1[2][2];
    int one8_ = 0x7f7f7f7f; asm volatile("" : "+v"(one8_));
    const char* cA = (const char*)g.A + (size_t)cur.pm * tstep; const char* cB = (const char*)g.Bt + (size_t)cur.pn * tstep;
    S.a_ready(cur);
    if constexpr (SP2) {
        PG8_STAGE(PG8_SB(0, 0), cB, voffB); PG8_STAGE(PG8_SB(0, 1), cB + hstep, voffB); PG8_STAGE(PG8_SA(0, 0), cA, voffA); PG8_STAGE(PG8_SA(0, 1), cA + hstep, voffA);
        if (wr == 1) PG8_BAR;
        PG8_WAIT_V(2); PG8_BAR;
        PG8_STAGE(PG8_SB(1, 0), cB + kstep, voffB); PG8_STAGE(PG8_SA(1, 0), cA + kstep, voffA); PG8_STAGE(PG8_SB(1, 1), cB + hstep + kstep, voffB);
        PG8_WAIT_V(6); PG8_BAR;
    } else {
        PG8_STAGE(PG8_SB(0, 0), cB, voffB); PG8_STAGE(PG8_SA(0, 0), cA, voffA); PG8_STAGE(PG8_SB(0, 1), cB + hstep, voffB); PG8_STAGE(PG8_SA(0, 1), cA + hstep, voffA);
        if (wr == 1) PG8_BAR;
        PG8_WAIT_V(4); PG8_BAR;
        PG8_STAGE(PG8_SB(1, 0), cB + kstep, voffB); PG8_STAGE(PG8_SA(1, 0), cA + kstep, voffA); PG8_STAGE(PG8_SB(1, 1), cB + hstep + kstep, voffB);
        PG8_WAIT_V(6); PG8_BAR;
    }
    for (;;) {
        const bool has_next = S.next(ui + 1, nxt);
        typename Epi::Pre pre_; { int lp_ = (int)__builtin_amdgcn_mbcnt_hi(~0u, __builtin_amdgcn_mbcnt_lo(~0u, 0u)); asm volatile("" : "+v"(lp_)); pre_ = E.prefetch(cur, wc, lp_ >> 4); }
        const char* nA = has_next ? (const char*)g.A + (size_t)nxt.pm * tstep : cA; const char* nB = has_next ? (const char*)g.Bt + (size_t)nxt.pn * tstep : cB;
#pragma unroll 1
        for (int t = 0; t < nt; t += 2) {
            const bool last = (t == nt - 2);
            const char* a1 = cA + (size_t)(t + 1) * kstep;
            const char* a2 = last ? nA : cA + (size_t)(t + 2) * kstep; const char* b2 = last ? nB : cB + (size_t)(t + 2) * kstep;
            const char* a3 = a2 + kstep; const char* b3 = b2 + kstep;
            if (last && has_next) S.a_ready(nxt);
            const bool relax = (Epi::NST > 0) && (ui > 0) && (t == 0);
            if constexpr (SP2) {
            PG8_LDB(B0, 0, 0); PG8_LDB(B1, 0, 1); PG8_SCHED; PG8_LDA(At, 0, 0); PG8_STAGE(PG8_SA(1, 1), a1 + hstep, voffA);
            PG8_WAIT_V8R(relax); PG8_WAIT_L(0); PG8_BAR; PG8_MMA(0, 0, At, B0); PG8_MMA(0, 1, At, B1); PG8_BAR; PG8_SCHED;
            PG8_LDA(At, 0, 1); PG8_STAGE(PG8_SB(0, 0), b2, voffB); PG8_STAGE(PG8_SB(0, 1), b2 + hstep, voffB); PG8_STAGE(PG8_SA(0, 0), a2, voffA);
            PG8_WAIT_V8R(relax); PG8_WAIT_L(0); PG8_BAR; PG8_MMA(1, 0, At, B0); PG8_MMA(1, 1, At, B1); PG8_BAR; PG8_SCHED;
            PG8_LDB(B0, 1, 0); PG8_LDB(B1, 1, 1); PG8_SCHED; PG8_LDA(At, 1, 0); PG8_STAGE(PG8_SA(0, 1), a2 + hstep, voffA);
            PG8_WAIT_V(8); PG8_WAIT_L(0); PG8_BAR; PG8_MMA(0, 0, At, B0); PG8_MMA(0, 1, At, B1); PG8_BAR; PG8_SCHED;
            PG8_LDA(At, 1, 1); PG8_STAGE(PG8_SB(1, 0), b3, voffB); PG8_STAGE(PG8_SB(1, 1), b3 + hstep, voffB); PG8_STAGE(PG8_SA(1, 0), a3, voffA);
            PG8_WAIT_V(8); PG8_WAIT_L(0); PG8_BAR; PG8_MMA(1, 0, At, B0); PG8_MMA(1, 1, At, B1); PG8_BAR; PG8_SCHED;
            } else {
            PG8_LDB(B0, 0, 0); PG8_SCHED; PG8_LDA(At, 0, 0); PG8_STAGE(PG8_SA(1, 1), a1 + hstep, voffA);
            PG8_WAIT_L(8); PG8_BAR; PG8_WAIT_L(0); PG8_MMA(0, 0, At, B0); PG8_BAR; PG8_SCHED;
            PG8_LDB(B1, 0, 1); PG8_STAGE(PG8_SB(0, 0), b2, voffB);
            PG8_BAR; PG8_WAIT_L(0); PG8_MMA(0, 1, At, B1); PG8_BAR;
            PG8_LDA(At, 0, 1); PG8_STAGE(PG8_SA(0, 0), a2, voffA);
            PG8_BAR; PG8_WAIT_L(0); PG8_MMA(1, 0, At, B0); PG8_BAR; PG8_SCHED;
            PG8_STAGE(PG8_SB(0, 1), b2 + hstep, voffB);
            PG8_WAIT_V(6); PG8_BAR; PG8_MMA(1, 1, At, B1); PG8_BAR;
            PG8_LDB(B0, 1, 0); PG8_SCHED; PG8_LDA(At, 1, 0); PG8_STAGE(PG8_SA(0, 1), a2 + hstep, voffA);
            PG8_WAIT_L(8); PG8_BAR; PG8_WAIT_L(0); PG8_MMA(0, 0, At, B0); PG8_BAR; PG8_SCHED;
            PG8_LDB(B1, 1, 1); PG8_STAGE(PG8_SB(1, 0), b3, voffB);
            PG8_BAR; PG8_WAIT_L(0); PG8_MMA(0, 1, At, B1); PG8_BAR;
            PG8_LDA(At, 1, 1); PG8_STAGE(PG8_SA(1, 0), a3, voffA);
            PG8_BAR; PG8_WAIT_L(0); PG8_MMA(1, 0, At, B0); PG8_BAR; PG8_SCHED;
            PG8_STAGE(PG8_SB(1, 1), b3 + hstep, voffB);
            PG8_WAIT_V(6); PG8_BAR; PG8_MMA(1, 1, At, B1); PG8_BAR;
            }
        }
        if constexpr (FP8) asm volatile("s_nop 7\n\ts_nop 7" ::: "memory");
        if constexpr (ALIGN_EPI) { if (wr == 0) PG8_BAR; }
        if constexpr (!Epi::AFTER_DRAIN) { int ln_ = (int)__builtin_amdgcn_mbcnt_hi(~0u, __builtin_amdgcn_mbcnt_lo(~0u, 0u)); asm volatile("" : "+v"(ln_)); E(acc, cur, wr, wc, ln_ & 15, ln_ >> 4, pre_); S.done(cur); }
        if (!has_next) break;
#pragma unroll
        for (int a = 0; a < 2; ++a)
#pragma unroll
            for (int b = 0; b < 2; ++b)
#pragma unroll
                for (int m = 0; m < 4; ++m)
#pragma unroll
                    for (int n = 0; n < 2; ++n) acc[a][b][m][n] = (f32x4){0.f, 0.f, 0.f, 0.f};
        cur = nxt; cA = nA; cB = nB; ++ui;
        if constexpr (ALIGN_EPI) { if (wr == 1) PG8_BAR; }
    }
    PG8_WAIT_V(0);
    if constexpr (!ALIGN_EPI) { if (wr == 0) PG8_BAR; }
    PG8_BAR;
    if constexpr (Epi::AFTER_DRAIN) { E.fused(acc, cur, wr, wc, fr, fq, lds, wid, lane); S.done(cur); }
#undef PG8_SA
#undef PG8_SB
#undef PG8_STAGE
#undef PG8_LDA
#undef PG8_LDB
#undef PG8_MMA
#undef PG8_WAIT_V
#undef PG8_WAIT_L
#undef PG8_BAR
#undef PG8_SCHED
}
}

constexpr int NWAVES = 8, NTHR = 512;
constexpr int BATCH = 2, SEQ = 8192, D = 1024, DEPTH = 4, MTOK = BATCH * SEQ;
constexpr int DIN = 3344, NPROJ = 3328, SRC_GA = 1152;
constexpr int C_GQ = 0, C_GK = 192, C_GV = 384, C_GG = 768, C_HQ = 1152, C_HF = 1408, C_HI = 1664, C_HG = 1920, C_RQ = 2176, C_RK = 2368, C_RV = 2560, C_RG = 2944;
constexpr int NE = 32, FFN = 1024;
constexpr int CH = 64, NCH = SEQ / CH, NUNIT = BATCH * NCH;
constexpr int ST_GLA = 0, ST_HG = 4 * 48 * 96, ST_RET = ST_HG + 4 * 64 * 64, ST_TOT = ST_RET + 4 * 48 * 96;
constexpr int NDV = 448, NKT = 640;
constexpr int MAXROWS = 65536 + NE * 256, MAXRT = MAXROWS / 256;
constexpr float EPS = 1e-6f;
#ifndef F8_IN_V
#define F8_IN_V false
#endif
#ifndef F8_OUT_V
#define F8_OUT_V true
#endif
constexpr bool F8_IN = F8_IN_V, F8_OUT = F8_OUT_V;
#ifndef Y8_V
#define Y8_V true
#endif
constexpr bool Y8 = Y8_V;
constexpr float S8_Y = 16.f;
constexpr float S8_M = 32.f;
constexpr float S8_W = 2048.f, S8_H = 64.f, S8_A = 8.f;
constexpr int NPHASE = 38;
constexpr int ECAP = 16384, ECAP_SH = 14;

constexpr size_t MiB = 1u << 20;
constexpr size_t WS_CTL = 0, CTL_ZERO_BYTES = 65536;
constexpr size_t WS_MOD = 1 * MiB;
constexpr size_t WS_ROPE = 2 * MiB;
constexpr size_t WS_LB = 5 * MiB;
constexpr size_t WS_WIN = 8 * MiB;
constexpr size_t WS_WOUT = 34 * MiB;
constexpr size_t WS_WGU = 42 * MiB;
constexpr size_t WS_WDN = 554 * MiB;
constexpr size_t WS_X = 810 * MiB;
constexpr size_t WS_H = 874 * MiB;
constexpr size_t WS_GA = 906 * MiB;
constexpr size_t WS_PROJ = 907 * MiB;
constexpr size_t WS_U = 1011 * MiB;
constexpr size_t WS_DVEC = 1063 * MiB;
constexpr size_t WS_SP = 1064 * MiB;
constexpr size_t WS_MIX = 1090 * MiB;
constexpr size_t WS_TOPE = 1122 * MiB;
constexpr size_t WS_TOPW = WS_TOPE + 256 * 1024;
constexpr size_t WS_SLOT = WS_TOPW + 256 * 1024;
constexpr size_t WS_A1 = 1123 * MiB;
constexpr size_t WS_ACT = 1635 * MiB;
constexpr size_t WS_Y = 2147 * MiB;
constexpr size_t WS_CUM = 3171 * MiB;
constexpr size_t WS_KT = 3199 * MiB;
constexpr size_t WS_END = 3239 * MiB;
static_assert(WS_WIN + (size_t)DEPTH * NPROJ * D * 2 <= WS_WOUT && WS_PROJ + (size_t)MTOK * NPROJ * 2 <= WS_U && WS_U + (size_t)NUNIT * ST_TOT * 4 <= WS_DVEC && WS_SP + (size_t)NUNIT * ST_TOT * 2 <= WS_MIX && WS_A1 + (size_t)NE * ECAP * D <= WS_ACT && WS_ACT + (size_t)NE * ECAP * D <= WS_Y && WS_Y + (size_t)NE * ECAP * D * 2 <= WS_CUM, "ws map");
constexpr int CW_TMO = 0, CW_CODE = 1, CW_BAR = 4096, CW_CNT = 8192, CW_FILL = 8192 + 256;
constexpr int RING_BYTES = 131072;
constexpr int MISC_OFF = 147456, LDS_BYTES = MISC_OFF + 4096 + 3072;
constexpr int MW_BAR = 0, MW_CNT = 16, MW_PST = 48, MW_HIST = 96, MW_BASE = 128, MW_TILE = 192, MW_NRT = 480, MW_SLOTS = 512;

#define GAS __attribute__((address_space(1)))
#define LAS __attribute__((address_space(3)))
typedef unsigned v4u __attribute__((ext_vector_type(4)));
typedef float f32x4 __attribute__((ext_vector_type(4)));
typedef short bf16x8 __attribute__((ext_vector_type(8)));
typedef GAS unsigned gu32;
typedef GAS unsigned long long gu64;
#define RLX_AGENT __ATOMIC_RELAXED, __HIP_MEMORY_SCOPE_AGENT
#define LDS_WAIT() asm volatile("s_waitcnt lgkmcnt(0)" ::: "memory")
#define VM_WAIT() asm volatile("s_waitcnt vmcnt(0)" ::: "memory")
__device__ __forceinline__ unsigned long long rt() { return __builtin_amdgcn_s_memrealtime(); }
typedef unsigned short bf16;
typedef float f32x2_t __attribute__((ext_vector_type(2))); typedef __bf16 bf16x2_t __attribute__((ext_vector_type(2)));
__device__ __forceinline__ unsigned pk2(float lo, float hi) { const f32x2_t v = {lo, hi}; return __builtin_bit_cast(unsigned, __builtin_convertvector(v, bf16x2_t)); }
__device__ __forceinline__ unsigned f2bf(float f) { return pk2(f, 0.f) & 0xffffu; }
__device__ __forceinline__ float bf2f(bf16 b) { return __builtin_bit_cast(float, (unsigned)b << 16); }
#define XB_TMO      128
#define XB_XCNT(j)  (256  + 64 * (j))
#define XB_XSUB(j)  (1280 + 64 * (j))
#define XB_XGEN(j)  (2304 + 64 * (j))
#define XB_TOP      3328
#define XB_TOPGEN   3392
#define XCD_BAR_WORDS 3456
#define XB_SPIN_CAP (1u << 18)

__device__ __forceinline__ unsigned xb_ld(unsigned* p)              { return __hip_atomic_load(p, __ATOMIC_RELAXED, __HIP_MEMORY_SCOPE_AGENT); }
__device__ __forceinline__ unsigned xb_add(unsigned* p, unsigned v) { return __hip_atomic_fetch_add(p, v, __ATOMIC_RELAXED, __HIP_MEMORY_SCOPE_AGENT); }
__device__ __forceinline__ unsigned xb_xcc_id() { return (unsigned)__builtin_amdgcn_s_getreg((3 << 11) | 20) & 0xFu; }
#define XB_SPIN(cond, bar) do { unsigned _sp = 0; while (cond) { __builtin_amdgcn_s_sleep(1); \
    if ((++_sp & 255u) == 0u) { if (xb_ld(&(bar)[XB_TMO])) break; if (_sp > XB_SPIN_CAP) { atomicAdd(&(bar)[XB_TMO], 1u); break; } } } } while (0)

struct XcdBarrier {
    unsigned* bar; unsigned x;
    volatile LAS unsigned* st;
};

__device__ __forceinline__ XcdBarrier xcd_barrier_post(unsigned* bar, volatile LAS unsigned* st) {
    XcdBarrier b; b.bar = bar; b.x = xb_xcc_id(); b.st = st;
    if (threadIdx.x == 0) (void)xb_add(&bar[XB_XCNT(b.x)], 1u);
    return b;
}
__device__ __forceinline__ void xcd_barrier_complete(unsigned* bar, unsigned x, unsigned& nloc, unsigned& nx) {
    const unsigned G = gridDim.x * gridDim.y * gridDim.z;
    unsigned sum, cnt, mine, sp = 0u;
    for (;;) {
        sum = 0u; cnt = 0u; mine = 0u;
#pragma unroll
        for (unsigned j = 0; j < 16; ++j) { const unsigned c = xb_ld(&bar[XB_XCNT(j)]); sum += c; cnt += (c > 0u) ? 1u : 0u; mine = (j == x) ? c : mine; }
        if (sum == G) break;
        __builtin_amdgcn_s_sleep(1);
        if ((++sp & 255u) == 0u) { if (xb_ld(&bar[XB_TMO])) break; if (sp > XB_SPIN_CAP) { atomicAdd(&bar[XB_TMO], 1u); break; } }
    }
    nloc = mine > 0u ? mine : 1u; nx = cnt > 0u ? cnt : 1u;
}

__device__ __forceinline__ void xcd_barrier(const XcdBarrier& b) {
    asm volatile("s_waitcnt vmcnt(0)" ::: "memory");
    __syncthreads();
    if (threadIdx.x == 0) {
        unsigned* bar = b.bar;
        __builtin_amdgcn_s_waitcnt(0);
        unsigned nloc = b.st[0], nx = b.st[1];
        if (nloc == 0u) { xcd_barrier_complete(bar, b.x, nloc, nx); b.st[0] = nloc; b.st[1] = nx; }
        const unsigned old = xb_add(&bar[XB_XSUB(b.x)], 1u);
        const unsigned gen = old / nloc;
        if (old + 1u == (gen + 1u) * nloc) {
            __builtin_amdgcn_fence(__ATOMIC_RELEASE, "agent");
            asm volatile("s_waitcnt vmcnt(0)" ::: "memory");
            const unsigned og = xb_add(&bar[XB_TOP], 1u);
            const unsigned tg = og / nx;
            if (og + 1u == (tg + 1u) * nx) xb_add(&bar[XB_TOPGEN], 1u);
            else XB_SPIN(xb_ld(&bar[XB_TOPGEN]) == tg, bar);
            __builtin_amdgcn_fence(__ATOMIC_ACQUIRE, "agent");
            xb_add(&bar[XB_XGEN(b.x)], 1u);
            asm volatile("s_waitcnt vmcnt(0)" ::: "memory");
        } else {
            XB_SPIN(xb_ld(&bar[XB_XGEN(b.x)]) == gen, bar);
            __builtin_amdgcn_fence(__ATOMIC_ACQUIRE, "agent");
            asm volatile("s_waitcnt vmcnt(0)" ::: "memory");
        }
    }
    __syncthreads();
}

__device__ __forceinline__ float wave_sum(float v) {
#pragma unroll
    for (int o = 1; o < 64; o <<= 1) v += __shfl_xor(v, o);
    return v;
}
__device__ __forceinline__ float log_sigmoid_f(float x) { return fminf(x, 0.f) - log1pf(expf(-fabsf(x))); }
__device__ __forceinline__ float silu_f(float x) { return x / (1.0f + expf(-x)); }
__device__ __forceinline__ float sigmoid_f(float x) { return 1.0f / (1.0f + expf(-x)); }
__device__ __forceinline__ pg8::bf16x8 ldfrag(const LAS bf16* base, int stride, int r0, int k0, int lane) {
    return *(const LAS pg8::bf16x8*)(base + (r0 + (lane & 15)) * stride + k0 + 8 * (lane >> 4));
}
__device__ __forceinline__ pg8::bf16x8 pack8(const float (&v)[8]) { v4u w; w.x = pk2(v[0], v[1]); w.y = pk2(v[2], v[3]); w.z = pk2(v[4], v[5]); w.w = pk2(v[6], v[7]); return __builtin_bit_cast(pg8::bf16x8, w); }

struct Args {
    const float* x; const float* c; const int* pos; const float* w_mod; const float* b_mod; const float* norm1_w; const float* w_in; const float* gla_wa2; const float* gla_ba2; const float* hg_lb;
    const float* gla_norm_w; const float* hg_norm_w; const float* w_out; const float* norm2_w; const float* w_r; const float* b_r; const float* w_gu; const float* b_gu; const float* w_dn; const float* b_dn;
    const float* final_norm_w; float* out; unsigned char* ws; int ph_lo, ph_hi;
};

__device__ __forceinline__ void transpose_block64(const float* src, int ld, bf16* dst, LAS float*, int lane) {
    const int n4 = lane & 15, kg = lane >> 4;
    f32x4 v[16];
#pragma unroll
    for (int i = 0; i < 16; ++i) v[i] = __builtin_nontemporal_load((const f32x4*)(src + (size_t)(16 * kg + i) * ld + 4 * n4));
#pragma unroll
    for (int j = 0; j < 4; ++j) { v4u o0, o1;
        o0.x = pk2(v[0][j], v[1][j]); o0.y = pk2(v[2][j], v[3][j]); o0.z = pk2(v[4][j], v[5][j]); o0.w = pk2(v[6][j], v[7][j]);
        o1.x = pk2(v[8][j], v[9][j]); o1.y = pk2(v[10][j], v[11][j]); o1.z = pk2(v[12][j], v[13][j]); o1.w = pk2(v[14][j], v[15][j]);
        bf16* d = dst + (size_t)(4 * n4 + j) * D + 16 * kg; *(GAS v4u*)d = o0; *(GAS v4u*)(d + 8) = o1; }
}
__device__ __forceinline__ float clamp448(float x) { return __builtin_amdgcn_fmed3f(x, -448.f, 448.f); }
__device__ __forceinline__ int pk4_fp8(float a, float b, float c, float d) { int w = 0; w = __builtin_amdgcn_cvt_pk_fp8_f32(clamp448(a), clamp448(b), w, false);
    return __builtin_amdgcn_cvt_pk_fp8_f32(clamp448(c), clamp448(d), w, true); }
__device__ __forceinline__ void transpose_block64_fp8(const float* src, int ld, unsigned char* dst, LAS float*, int lane, float sc) {
    const int n4 = lane & 15, kg = lane >> 4;
    f32x4 v[16];
#pragma unroll
    for (int i = 0; i < 16; ++i) v[i] = __builtin_nontemporal_load((const f32x4*)(src + (size_t)(16 * kg + i) * ld + 4 * n4)) * sc;
#pragma unroll
    for (int j = 0; j < 4; ++j) { v4u o;
        o.x = (unsigned)pk4_fp8(v[0][j], v[1][j], v[2][j], v[3][j]); o.y = (unsigned)pk4_fp8(v[4][j], v[5][j], v[6][j], v[7][j]);
        o.z = (unsigned)pk4_fp8(v[8][j], v[9][j], v[10][j], v[11][j]); o.w = (unsigned)pk4_fp8(v[12][j], v[13][j], v[14][j], v[15][j]);
        *(GAS v4u*)(dst + (size_t)(4 * n4 + j) * D + 16 * kg) = o; }
}
constexpr int IT_IN = 16 * (NPROJ / 64), IT_OUT = 16 * 16, IT_GU = NE * 16 * 32, IT_DN = NE * 16 * 16, IT_LAYER = IT_IN + IT_OUT + IT_GU + IT_DN, IT_ALL = DEPTH * IT_LAYER;
__device__ __forceinline__ void convert_item(const Args& a, int l, int r, LAS float* scr, int lane) {
    unsigned char* ws = a.ws;
    bf16* WIN = (bf16*)(ws + WS_WIN); bf16* WOUT = (bf16*)(ws + WS_WOUT); unsigned char* WGU = ws + WS_WGU; unsigned char* WDN = ws + WS_WDN;
    if (r < IT_IN) { const int kb = r / (NPROJ / 64), nb = r % (NPROJ / 64), n0 = 64 * nb, sc = n0 + (n0 >= SRC_GA ? 16 : 0);
        if (F8_IN) transpose_block64_fp8(a.w_in + ((size_t)l * D + 64 * kb) * DIN + sc, DIN, (unsigned char*)WIN + ((size_t)l * NPROJ + n0) * D + 64 * kb, scr, lane, S8_W);
        else transpose_block64(a.w_in + ((size_t)l * D + 64 * kb) * DIN + sc, DIN, WIN + ((size_t)l * NPROJ + n0) * D + 64 * kb, scr, lane); return; }
    r -= IT_IN;
    if (r < IT_OUT) { const int kb = r / 16, nb = r % 16;
        if (F8_OUT) transpose_block64_fp8(a.w_out + ((size_t)l * D + 64 * kb) * D + 64 * nb, D, (unsigned char*)WOUT + ((size_t)l * D + 64 * nb) * D + 64 * kb, scr, lane, S8_W);
        else transpose_block64(a.w_out + ((size_t)l * D + 64 * kb) * D + 64 * nb, D, WOUT + ((size_t)l * D + 64 * nb) * D + 64 * kb, scr, lane); return; }
    r -= IT_OUT;
    if (r < IT_GU) { const int e = r / 512, r2 = r % 512, kb = r2 / 32, nb = r2 % 32, cc = 64 * nb;
        const int row = (cc < 1024) ? 256 * (cc / 128) + (cc % 128) : 256 * ((cc - 1024) / 128) + 128 + ((cc - 1024) % 128);
        transpose_block64_fp8(a.w_gu + (((size_t)l * NE + e) * D + 64 * kb) * 2048 + cc, 2048, WGU + (((size_t)l * NE + e) * 2048 + row) * D + 64 * kb, scr, lane, S8_W); return; }
    r -= IT_GU;
    { const int e = r / 256, r2 = r % 256, kb = r2 / 16, nb = r2 % 16;
        transpose_block64_fp8(a.w_dn + (((size_t)l * NE + e) * FFN + 64 * kb) * D + 64 * nb, D, WDN + (((size_t)l * NE + e) * D + 64 * nb) * D + 64 * kb, scr, lane, S8_W); }
}
constexpr int CB2 = 4, CB7 = 2, CB8 = 2;
__device__ __forceinline__ int conv_t2(int G) { return (G == 256) ? 192 * NWAVES * CB2 : 0; }
__device__ __forceinline__ int conv_idle(int nunits, int G) { const int rem = nunits % G; return rem ? G - rem : 0; }
__device__ __forceinline__ void convert_range(const Args& a, int l, int first, int count, LAS unsigned char* lds, int lane, int wave) {
    LAS float* scr = (LAS float*)(lds + wave * 16640);
    for (int k = 0; k < count; ++k) { const int it = first + k; if (it < IT_LAYER) convert_item(a, l, it, scr, lane); }
}
__device__ __forceinline__ void p0_prologue(const Args& a, LAS unsigned char* lds, int vcu, int G, int tid, int lane, int wave) {
    unsigned char* ws = a.ws;
    LAS float* scr = (LAS float*)(lds + wave * 16640);
    const int gw = vcu * NWAVES + wave, NGW = G * NWAVES;
    for (int it = gw; it < IT_LAYER; it += NGW) convert_item(a, 0, it, scr, lane);
    __syncthreads();
    {
        LAS float* cact = (LAS float*)lds;
        LAS float* red = (LAS float*)(lds + 8192);
        for (int i = tid; i < 2 * D; i += NTHR) cact[i] = silu_f(a.c[i]);
        __syncthreads();
        float* MOD = (float*)(ws + WS_MOD);
        for (int it = vcu; it < DEPTH * 96; it += G) {
            const int l = it / 96, n0 = (it % 96) * 64;
            const float* wp = a.w_mod + ((size_t)l * D + 128 * wave) * 6144 + n0 + lane;
            float a0 = 0.f, a1 = 0.f;
#pragma unroll 32
            for (int k = 0; k < 128; ++k) { const float w = __builtin_nontemporal_load(wp + (size_t)k * 6144); a0 += cact[128 * wave + k] * w; a1 += cact[D + 128 * wave + k] * w; }
            red[(wave * 2 + 0) * 64 + lane] = a0; red[(wave * 2 + 1) * 64 + lane] = a1;
            __syncthreads();
            if (tid < 128) { const int b = tid >> 6, ln = tid & 63; float s = a.b_mod[l * 6144 + n0 + ln];
#pragma unroll
                for (int w = 0; w < 8; ++w) s += red[(w * 2 + b) * 64 + ln];
                MOD[((size_t)l * 2 + b) * 6144 + n0 + ln] = s; }
            __syncthreads();
        }
    }
    { const f32x4* xs = (const f32x4*)a.x; uint2* xd = (uint2*)(ws + WS_X);
        for (int i = vcu * NTHR + tid; i < MTOK * D / 4; i += G * NTHR) { const f32x4 v = xs[i]; uint2 p; p.x = pk2(v[0], v[1]); p.y = pk2(v[2], v[3]); xd[i] = p; } }
    {
        float* ROPE = (float*)(ws + WS_ROPE);
        for (int i = vcu * NTHR + tid; i < MTOK * 24; i += G * NTHR) { const int t = i / 24, f = i % 24;
            const float inv = (float)pow(10000.0, -(double)f / 24.0); const float ang = (float)a.pos[t] * inv;
            ROPE[(size_t)t * 48 + f] = cosf(ang); ROPE[(size_t)t * 48 + 24 + f] = sinf(ang); }
    }
    if (vcu == 0 && tid < 256) {
        float v[4], mx = -3.0e38f; for (int l = 0; l < 4; ++l) { v[l] = a.hg_lb[l * 256 + tid]; mx = fmaxf(mx, v[l]); }
        float s = 0.f; for (int l = 0; l < 4; ++l) { v[l] = expf(v[l] - mx); s += v[l]; }
        float* LB = (float*)(ws + WS_LB); float cs = 0.f, first = 0.f;
        for (int l = 0; l < 4; ++l) { cs += v[l] / s; if (l == 0) first = cs; LB[l * 256 + tid] = cs - first; }
    }
}

__device__ __forceinline__ void moe_combine_row(f32x4 (&v)[4], int m, const bf16* Y, const int* SLOT, const float* TOPW, const float* g2, int lane) {
    const int4 sl = *(const int4*)(SLOT + (size_t)m * 4); const f32x4 tw = *(const f32x4*)(TOPW + (size_t)m * 4);
    const int s[4] = {sl.x, sl.y, sl.z, sl.w};
    f32x4 acc[4];
#pragma unroll
    for (int j = 0; j < 4; ++j) acc[j] = (f32x4){0.f, 0.f, 0.f, 0.f};
#pragma unroll
    for (int k = 0; k < 4; ++k) { const bf16* yr = Y + (size_t)s[k] * D + 4 * lane; const float w = tw[k];
#pragma unroll
        for (int j = 0; j < 4; ++j) { const uint2 p = *(const uint2*)(yr + 256 * j);
            acc[j][0] += w * __builtin_bit_cast(float, p.x << 16); acc[j][1] += w * __builtin_bit_cast(float, p.x & 0xffff0000u);
            acc[j][2] += w * __builtin_bit_cast(float, p.y << 16); acc[j][3] += w * __builtin_bit_cast(float, p.y & 0xffff0000u); } }
#pragma unroll
    for (int j = 0; j < 4; ++j) { const f32x4 g = *(const f32x4*)(g2 + 4 * lane + 256 * j); v[j] = v[j] + g * acc[j]; }
}
__device__ __forceinline__ float row_rstd(const f32x4 (&v)[4]) {
    float s = 0.f;
#pragma unroll
    for (int j = 0; j < 4; ++j) s += (v[j][0] * v[j][0] + v[j][1] * v[j][1]) + (v[j][2] * v[j][2] + v[j][3] * v[j][3]);
    return 1.0f / sqrtf(wave_sum(s) * (1.0f / D) + EPS);
}
__device__ __forceinline__ void modulate_row(f32x4 (&v)[4], float rstd, const float* nw, const float* sc, const float* sh, bf16* hrow, int lane) {
#pragma unroll
    for (int j = 0; j < 4; ++j) { const int c0 = 4 * lane + 256 * j; const f32x4 w = *(const f32x4*)(nw + c0), s1 = *(const f32x4*)(sc + c0), s0 = *(const f32x4*)(sh + c0);
        v[j] = v[j] * rstd * w * (s1 + 1.0f) + s0;
        uint2 p; p.x = pk2(v[j][0], v[j][1]); p.y = pk2(v[j][2], v[j][3]); *(uint2*)(hrow + c0) = p; }
}


constexpr int LR_SLT = 142976, LR_TWL = 144000, LR_SSR = 145024;
__device__ __forceinline__ void stage_slots(const unsigned char* ws, int row0, LAS unsigned char* lds, int tid) {
    if (tid < 64) { *(LAS v4u*)(lds + LR_SLT + 16 * tid) = *(const v4u*)((const int*)(ws + WS_SLOT) + (size_t)(row0 + tid) * 4);
                    *(LAS f32x4*)(lds + LR_TWL + 16 * tid) = *(const f32x4*)((const float*)(ws + WS_TOPW) + (size_t)(row0 + tid) * 4); }
}
template <bool SS, bool OUTF32>
__device__ __forceinline__ void flat_combine(const bf16* xsrc, void* xdst, int row0, const bf16* Y, const float* g2, LAS unsigned char* lds, int tid, int lane, const float* fw = nullptr) {
    static_assert(Y8, "expert outputs are stored as fp8");
    typedef float f32x2v __attribute__((ext_vector_type(2)));
    const int c16 = tid & 63, rsub = tid >> 6; const unsigned char* Yb = (const unsigned char*)Y;
    f32x4 g[4];
#pragma unroll
    for (int q = 0; q < 4; ++q) g[q] = *(const f32x4*)(g2 + 16 * c16 + 4 * q);
    f32x4 fwv[4];
    if (SS) {
#pragma unroll
        for (int q = 0; q < 4; ++q) fwv[q] = *(const f32x4*)(fw + 16 * c16 + 4 * q); }
#pragma unroll 2
    for (int it = 0; it < 8; ++it) { const int i = 8 * it + rsub; const size_t m = (size_t)(row0 + i);
        const v4u x0 = *(const v4u*)(xsrc + m * D + 16 * c16), x1 = *(const v4u*)(xsrc + m * D + 16 * c16 + 8);
        const v4u sl = *(const LAS v4u*)(lds + LR_SLT + 16 * i); const f32x4 tws = *(const LAS f32x4*)(lds + LR_TWL + 16 * i) * (1.0f / S8_Y);
        const v4u y0 = *(const v4u*)(Yb + (size_t)sl.x * D + 16 * c16), y1 = *(const v4u*)(Yb + (size_t)sl.y * D + 16 * c16), y2 = *(const v4u*)(Yb + (size_t)sl.z * D + 16 * c16), y3 = *(const v4u*)(Yb + (size_t)sl.w * D + 16 * c16);
        const unsigned xw[8] = {x0.x, x0.y, x0.z, x0.w, x1.x, x1.y, x1.z, x1.w}, w0[4] = {y0.x, y0.y, y0.z, y0.w}, w1[4] = {y1.x, y1.y, y1.z, y1.w}, w2[4] = {y2.x, y2.y, y2.z, y2.w}, w3[4] = {y3.x, y3.y, y3.z, y3.w};
        float v[16]; float sq = 0.f;
#pragma unroll
        for (int q = 0; q < 4; ++q) {
            const f32x2v a0 = __builtin_amdgcn_cvt_pk_f32_fp8((int)w0[q], false), b0 = __builtin_amdgcn_cvt_pk_f32_fp8((int)w0[q], true), a1 = __builtin_amdgcn_cvt_pk_f32_fp8((int)w1[q], false), b1 = __builtin_amdgcn_cvt_pk_f32_fp8((int)w1[q], true);
            const f32x2v a2 = __builtin_amdgcn_cvt_pk_f32_fp8((int)w2[q], false), b2 = __builtin_amdgcn_cvt_pk_f32_fp8((int)w2[q], true), a3 = __builtin_amdgcn_cvt_pk_f32_fp8((int)w3[q], false), b3 = __builtin_amdgcn_cvt_pk_f32_fp8((int)w3[q], true);
            const float e0 = tws[0] * a0[0] + tws[1] * a1[0] + tws[2] * a2[0] + tws[3] * a3[0], e1 = tws[0] * a0[1] + tws[1] * a1[1] + tws[2] * a2[1] + tws[3] * a3[1];
            const float e2 = tws[0] * b0[0] + tws[1] * b1[0] + tws[2] * b2[0] + tws[3] * b3[0], e3 = tws[0] * b0[1] + tws[1] * b1[1] + tws[2] * b2[1] + tws[3] * b3[1];
            v[4 * q + 0] = __builtin_bit_cast(float, xw[2 * q] << 16) + g[q][0] * e0; v[4 * q + 1] = __builtin_bit_cast(float, xw[2 * q] & 0xffff0000u) + g[q][1] * e1;
            v[4 * q + 2] = __builtin_bit_cast(float, xw[2 * q + 1] << 16) + g[q][2] * e2; v[4 * q + 3] = __builtin_bit_cast(float, xw[2 * q + 1] & 0xffff0000u) + g[q][3] * e3;
            sq += (v[4 * q] * v[4 * q] + v[4 * q + 1] * v[4 * q + 1]) + (v[4 * q + 2] * v[4 * q + 2] + v[4 * q + 3] * v[4 * q + 3]); }
        if (SS) { const float rstd = 1.0f / sqrtf(wave_sum(sq) * (1.0f / D) + EPS);
#pragma unroll
            for (int q = 0; q < 4; ++q) { v[4 * q] *= rstd * fwv[q][0]; v[4 * q + 1] *= rstd * fwv[q][1]; v[4 * q + 2] *= rstd * fwv[q][2]; v[4 * q + 3] *= rstd * fwv[q][3]; } }
        if (OUTF32) {
#pragma unroll
            for (int q = 0; q < 4; ++q) *(GAS f32x4*)((float*)xdst + m * D + 16 * c16 + 4 * q) = (f32x4){v[4 * q], v[4 * q + 1], v[4 * q + 2], v[4 * q + 3]}; }
        else { v4u o0, o1; o0.x = pk2(v[0], v[1]); o0.y = pk2(v[2], v[3]); o0.z = pk2(v[4], v[5]); o0.w = pk2(v[6], v[7]); o1.x = pk2(v[8], v[9]); o1.y = pk2(v[10], v[11]); o1.z = pk2(v[12], v[13]); o1.w = pk2(v[14], v[15]);
            *(GAS v4u*)((bf16*)xdst + m * D + 16 * c16) = o0; *(GAS v4u*)((bf16*)xdst + m * D + 16 * c16 + 8) = o1; }
    }
}
template <bool F8, bool SLOTS>
__device__ __forceinline__ void flat_modulate(const bf16* xin, int row0, const LAS float* rstds, const float* nw, const float* scp, const float* shp, bf16* H, unsigned char* A1, LAS unsigned char* lds, int tid) {
    const int c16 = tid & 63, rsub = tid >> 6; f32x4 ws1[4], s0[4];
#pragma unroll
    for (int q = 0; q < 4; ++q) { const int c0 = 16 * c16 + 4 * q; ws1[q] = *(const f32x4*)(nw + c0) * (*(const f32x4*)(scp + c0) + 1.0f); s0[q] = *(const f32x4*)(shp + c0); }
#pragma unroll 2
    for (int it = 0; it < 8; ++it) { const int i = 8 * it + rsub; const size_t m = (size_t)(row0 + i); const float rs = rstds[i];
        const v4u x0 = *(const v4u*)(xin + m * D + 16 * c16), x1 = *(const v4u*)(xin + m * D + 16 * c16 + 8); const unsigned xw[8] = {x0.x, x0.y, x0.z, x0.w, x1.x, x1.y, x1.z, x1.w};
        f32x4 v[4];
#pragma unroll
        for (int q = 0; q < 4; ++q) v[q] = (f32x4){__builtin_bit_cast(float, xw[2 * q] << 16), __builtin_bit_cast(float, xw[2 * q] & 0xffff0000u), __builtin_bit_cast(float, xw[2 * q + 1] << 16), __builtin_bit_cast(float, xw[2 * q + 1] & 0xffff0000u)} * rs * ws1[q] + s0[q];
        if (F8) { v4u o; o.x = (unsigned)pk4_fp8(v[0][0] * S8_H, v[0][1] * S8_H, v[0][2] * S8_H, v[0][3] * S8_H); o.y = (unsigned)pk4_fp8(v[1][0] * S8_H, v[1][1] * S8_H, v[1][2] * S8_H, v[1][3] * S8_H);
            o.z = (unsigned)pk4_fp8(v[2][0] * S8_H, v[2][1] * S8_H, v[2][2] * S8_H, v[2][3] * S8_H); o.w = (unsigned)pk4_fp8(v[3][0] * S8_H, v[3][1] * S8_H, v[3][2] * S8_H, v[3][3] * S8_H);
            if (SLOTS) { const v4u sl = *(const LAS v4u*)(lds + LR_SLT + 16 * i);
                *(GAS v4u*)(A1 + (size_t)sl.x * D + 16 * c16) = o; *(GAS v4u*)(A1 + (size_t)sl.y * D + 16 * c16) = o; *(GAS v4u*)(A1 + (size_t)sl.z * D + 16 * c16) = o; *(GAS v4u*)(A1 + (size_t)sl.w * D + 16 * c16) = o; }
            else *(GAS v4u*)((unsigned char*)H + m * D + 16 * c16) = o; }
        else { v4u o0, o1; o0.x = pk2(v[0][0], v[0][1]); o0.y = pk2(v[0][2], v[0][3]); o0.z = pk2(v[1][0], v[1][1]); o0.w = pk2(v[1][2], v[1][3]); o1.x = pk2(v[2][0], v[2][1]); o1.y = pk2(v[2][2], v[2][3]); o1.z = pk2(v[3][0], v[3][1]); o1.w = pk2(v[3][2], v[3][3]);
            *(GAS v4u*)(H + m * D + 16 * c16) = o0; *(GAS v4u*)(H + m * D + 16 * c16 + 8) = o1; } }
}

constexpr int WP = 1032;
constexpr int LR_WHI = 0, LR_PART = 132096, LR_SSX = 140288, LR_RSTD = 140544, LR_BIAS = 140800, LR_RED = 140928;
template <int NEO>
__device__ __forceinline__ void rows_mfma(const Args& a, int layer, LAS unsigned char* lds, volatile LAS unsigned* MISC, gu32* ctl, int vcu, int G, int tid, int lane, int wave) {
    constexpr bool P5 = (NEO == 32); constexpr int NET = NEO / 16;
    unsigned char* ws = a.ws; bf16* X = (bf16*)(ws + WS_X); bf16* H = (bf16*)(ws + WS_H); const float* MOD = (const float*)(ws + WS_MOD);
    LAS bf16* Whi = (LAS bf16*)(lds + LR_WHI); LAS bf16* Wlo = Whi + NEO * WP; LAS float* part = (LAS float*)(lds + LR_PART); LAS float* ssx = (LAS float*)(lds + LR_SSX);
    LAS float* rstds = (LAS float*)(lds + LR_RSTD); LAS float* biasl = (LAS float*)(lds + LR_BIAS); LAS float* red = (LAS float*)(lds + LR_RED);
    const float* nw = (P5 ? a.norm2_w : a.norm1_w) + layer * D;
    const float* Wsrc = P5 ? a.w_r + (size_t)layer * D * NE : a.w_in + (size_t)layer * D * DIN + SRC_GA; const int wld = P5 ? NE : DIN;
    if (P5) { if (tid < NE) MISC[MW_HIST + tid] = 0u; }
    for (int row0 = vcu * 64; row0 < MTOK; row0 += G * 64) {
        const int b = row0 / SEQ; const float* mp = MOD + ((size_t)layer * 2 + b) * 6144; const float* scp = mp + (P5 ? 4 : 1) * D; const float* shp = mp + (P5 ? 3 : 0) * D;
        if (!P5 && layer > 0) { stage_slots(ws, row0, lds, tid); __syncthreads(); }
        { constexpr int E4 = NEO / 4, NITP = (D / 2 * E4) / NTHR, NIT = 4;
          f32x4 bacc = {0.f, 0.f, 0.f, 0.f};
#pragma unroll 1
          for (int ib0 = 0; ib0 < NITP; ib0 += NIT) {
            f32x4 wa[NIT], wb[NIT]; f32x2_t nv[NIT], sv[NIT], hv[NIT];
#pragma unroll
            for (int it = 0; it < NIT; ++it) { const int idx = tid + NTHR * (ib0 + it), k2 = idx / E4, e4 = idx - k2 * E4, k = 2 * k2;
                wa[it] = *(const f32x4*)(Wsrc + (size_t)k * wld + 4 * e4); wb[it] = *(const f32x4*)(Wsrc + (size_t)(k + 1) * wld + 4 * e4);
                nv[it] = *(const f32x2_t*)(nw + k); sv[it] = *(const f32x2_t*)(scp + k); hv[it] = *(const f32x2_t*)(shp + k); }
#pragma unroll
            for (int it = 0; it < NIT; ++it) { const int idx = tid + NTHR * (ib0 + it), k2 = idx / E4, e4 = idx - k2 * E4, k = 2 * k2;
                bacc += wa[it] * hv[it][0] + wb[it] * hv[it][1];
                const f32x4 w0 = wa[it] * (nv[it][0] * (1.0f + sv[it][0])), w1 = wb[it] * (nv[it][1] * (1.0f + sv[it][1]));
#pragma unroll
                for (int j = 0; j < 4; ++j) { const unsigned h0 = f2bf(w0[j]), h1 = f2bf(w1[j]); const float l0 = w0[j] - __builtin_bit_cast(float, h0 << 16), l1 = w1[j] - __builtin_bit_cast(float, h1 << 16);
                    *(LAS unsigned*)(Whi + (4 * e4 + j) * WP + k) = h0 | (h1 << 16); *(LAS unsigned*)(Wlo + (4 * e4 + j) * WP + k) = pk2(l0, l1); } } }
#pragma unroll
          for (int j = 0; j < 4; ++j) { float v = bacc[j];
#pragma unroll
              for (int sh = E4; sh < 64; sh <<= 1) v += __shfl_xor(v, sh);
              bacc[j] = v; }
          if (lane < E4) *(LAS f32x4*)(red + wave * NEO + 4 * lane) = bacc; }
        const bf16* xin = X;
        if (!P5 && layer > 0) { flat_combine<false, false>(X, X, row0, (const bf16*)(ws + WS_Y), MOD + ((size_t)(layer - 1) * 2 + b) * 6144 + 5 * D, lds, tid, lane); asm volatile("s_waitcnt vmcnt(0)" ::: "memory"); }
        __syncthreads();
        if (tid < NEO) { float sacc = P5 ? a.b_r[layer * NE + tid] : 0.f; for (int q = 0; q < NWAVES; ++q) sacc += red[q * NEO + tid]; biasl[tid] = sacc; }
        const int rg = wave >> 1, kh = wave & 1, r = lane & 15, g = lane >> 4;
        { const bf16* xr = xin + (size_t)(row0 + 16 * rg + r) * D; f32x4 acc[NET]; float ss = 0.f;
#pragma unroll
            for (int et = 0; et < NET; ++et) acc[et] = (f32x4){0.f, 0.f, 0.f, 0.f};
#pragma unroll 4
            for (int s = 16 * kh; s < 16 * kh + 16; ++s) { const int k0 = 32 * s + 8 * g; const v4u xp = *(const v4u*)(xr + k0); const unsigned xw[4] = {xp.x, xp.y, xp.z, xp.w};
#pragma unroll
                for (int j = 0; j < 4; ++j) { const float xa = __builtin_bit_cast(float, xw[j] << 16), xb = __builtin_bit_cast(float, xw[j] & 0xffff0000u); ss += xa * xa + xb * xb; }
                const pg8::bf16x8 ahi = __builtin_bit_cast(pg8::bf16x8, xp);
#pragma unroll
                for (int et = 0; et < NET; ++et) { const pg8::bf16x8 whi = ldfrag(Whi, WP, 16 * et, 32 * s, lane), wlo = ldfrag(Wlo, WP, 16 * et, 32 * s, lane);
                    acc[et] = __builtin_amdgcn_mfma_f32_16x16x32_bf16(ahi, whi, acc[et], 0, 0, 0); acc[et] = __builtin_amdgcn_mfma_f32_16x16x32_bf16(ahi, wlo, acc[et], 0, 0, 0); } }
            ss += __shfl_xor(ss, 16); ss += __shfl_xor(ss, 32);
            if (kh == 1) {
#pragma unroll
                for (int et = 0; et < NET; ++et)
#pragma unroll
                    for (int q = 0; q < 4; ++q) part[(rg * 16 + 4 * g + q) * 32 + 16 * et + r] = acc[et][q];
                if (g == 0) ssx[rg * 16 + r] = ss; }
            __syncthreads();
            if (kh == 0) { const float sst = ss + ssx[rg * 16 + r]; if (g == 0) rstds[rg * 16 + r] = 1.0f / sqrtf(sst * (1.0f / D) + EPS);
                asm volatile("s_waitcnt lgkmcnt(0)" ::: "memory");
#pragma unroll
                for (int et = 0; et < NET; ++et)
#pragma unroll
                    for (int q = 0; q < 4; ++q) { const int i = rg * 16 + 4 * g + q, e = 16 * et + r; const float v = rstds[i] * (acc[et][q] + part[i * 32 + e]) + biasl[e];
                        if (P5) part[i * 32 + e] = v; else ((float*)(ws + WS_GA))[(size_t)(row0 + i) * 16 + e] = v; }
                if (P5) { asm volatile("s_waitcnt lgkmcnt(0)" ::: "memory");
                    if (lane < 16) { const int i = rg * 16 + lane, m = row0 + i; float lv[NE];
#pragma unroll
                        for (int e = 0; e < NE; ++e) lv[e] = part[i * 32 + e];
                        float tv[4]; int te[4];
#pragma unroll
                        for (int t = 0; t < 4; ++t) { float best = -3.0e38f; int bi = 0;
#pragma unroll
                            for (int e = 0; e < NE; ++e) if (lv[e] > best) { best = lv[e]; bi = e; }
#pragma unroll
                            for (int e = 0; e < NE; ++e) if (e == bi) lv[e] = -3.0e38f;
                            tv[t] = best; te[t] = bi; }
                        const float e1 = expf(tv[1] - tv[0]), e2 = expf(tv[2] - tv[0]), e3 = expf(tv[3] - tv[0]); const float inv = 1.0f / (1.0f + e1 + e2 + e3);
                        *(f32x4*)((float*)(ws + WS_TOPW) + (size_t)m * 4) = (f32x4){inv, e1 * inv, e2 * inv, e3 * inv};
#pragma unroll
                        for (int t = 0; t < 4; ++t) { const unsigned rk = __hip_atomic_fetch_add((LAS unsigned*)&MISC[MW_HIST + te[t]], 1u, __ATOMIC_RELAXED, __HIP_MEMORY_SCOPE_WORKGROUP);
                            ((LAS unsigned*)(lds + LR_SLT))[i * 4 + t] = ((unsigned)te[t] << 16) | rk; } } } }
            __syncthreads(); }
        if (P5) { if (tid < NE) { const unsigned hcnt = MISC[MW_HIST + tid]; MISC[MW_BASE + tid] = hcnt ? atomicAdd((unsigned*)(ctl + CW_CNT + layer * NE + tid), hcnt) : 0u; }
            __syncthreads();
            if (tid < 256) { LAS unsigned* sl = (LAS unsigned*)(lds + LR_SLT) + tid; const unsigned v = *sl, e = v >> 16; const unsigned slot = (e << ECAP_SH) + MISC[MW_BASE + e] + (v & 0xffffu);
                *sl = slot; ((int*)(ws + WS_SLOT))[(size_t)row0 * 4 + tid] = (int)slot; }
            if (tid < NE) MISC[MW_HIST + tid] = 0u;
            __syncthreads(); }
        if (P5) flat_modulate<true, true>(xin, row0, rstds, nw, scp, shp, H, ws + WS_A1, lds, tid);
        else flat_modulate<F8_IN, false>(xin, row0, rstds, nw, scp, shp, H, ws + WS_A1, lds, tid);
        __syncthreads();
    }
}

__device__ __forceinline__ void final_rows(const Args& a, LAS unsigned char* lds, int vcu, int G, int tid, int lane) {
    unsigned char* ws = a.ws; const bf16* X = (const bf16*)(ws + WS_X); const float* MOD = (const float*)(ws + WS_MOD);
    for (int row0 = vcu * 64; row0 < MTOK; row0 += G * 64) { const int b = row0 / SEQ;
        stage_slots(ws, row0, lds, tid);
        __syncthreads();
        flat_combine<true, true>(X, a.out, row0, (const bf16*)(ws + WS_Y), MOD + ((size_t)(DEPTH - 1) * 2 + b) * 6144 + 5 * D, lds, tid, lane, a.final_norm_w);
        __syncthreads();
    }
}

__device__ __noinline__ void moe_tables(gu32* ctl, int layer, volatile LAS unsigned* MISC, int tid) {
    if (tid < NE) MISC[MW_CNT + tid] = __hip_atomic_load(ctl + CW_CNT + layer * NE + tid, RLX_AGENT);
    __syncthreads();
    if (tid == 0) { unsigned n = 0;
        for (int e = 0; e < NE; ++e) { const unsigned nt = (MISC[MW_CNT + e] + 255u) >> 8; for (unsigned t = 0; t < nt; ++t) MISC[MW_TILE + n + t] = (unsigned)(e * 64) + t; n += nt; }
        MISC[MW_NRT] = n; }
    __syncthreads();
}

constexpr int BP = 72;
template <int TYPE> struct MixCfg { static constexpr int DK = (TYPE == 1) ? 64 : 48, DV = (TYPE == 1) ? 64 : 96, NC = 4 * DK, NV = 4 * DV;
    static constexpr int STOFF = (TYPE == 0) ? ST_GLA : (TYPE == 1) ? ST_HG : ST_RET, COFF = (TYPE == 0) ? 0 : 192;
    static constexpr int CQ = (TYPE == 0) ? C_GQ : (TYPE == 1) ? C_HQ : C_RQ, CK = (TYPE == 0) ? C_GK : (TYPE == 1) ? C_HF : C_RK, CV = (TYPE == 0) ? C_GV : (TYPE == 1) ? C_HI : C_RV, CG = (TYPE == 0) ? C_GG : (TYPE == 1) ? C_HG : C_RG;
    static constexpr int MIXOFF = (TYPE == 0) ? 0 : (TYPE == 1) ? 384 : 640, KOFF = (TYPE == 0) ? 0 : (TYPE == 1) ? 192 : 448; };
__device__ __forceinline__ float fast_logsig(float x) { x = fmaxf(x, -80.f); return -__logf(1.0f + __expf(-x)); }
__device__ __forceinline__ float ret_lg(int h) { return logf(1.0f - exp2f(-5.0f - (float)h)); }

template <int NV>
__device__ __forceinline__ void stage_vt(const bf16* pv  , LAS bf16* VT, int tid) {
    constexpr int NIT = (64 * (NV / 8)) / NTHR; static_assert((64 * (NV / 8)) % NTHR == 0, "stage_vt");
    v4u p[NIT];
#pragma unroll
    for (int it = 0; it < NIT; ++it) { const int idx = tid + NTHR * it, j = idx & 63, ch = idx >> 6; p[it] = *(const v4u*)(pv + (size_t)j * NPROJ + 8 * ch); }
#pragma unroll
    for (int it = 0; it < NIT; ++it) { const int idx = tid + NTHR * it, j = idx & 63, ch = idx >> 6; LAS bf16* d = VT + (8 * ch) * BP + j;
        d[0 * BP] = (bf16)(p[it].x & 0xffffu); d[1 * BP] = (bf16)(p[it].x >> 16); d[2 * BP] = (bf16)(p[it].y & 0xffffu); d[3 * BP] = (bf16)(p[it].y >> 16);
        d[4 * BP] = (bf16)(p[it].z & 0xffffu); d[5 * BP] = (bf16)(p[it].z >> 16); d[6 * BP] = (bf16)(p[it].w & 0xffffu); d[7 * BP] = (bf16)(p[it].w >> 16); }
}

constexpr int LA_KT = 0, LA_VT = 36864, LA_TOT = 92160, LA_GA = 94208, LA_KTT = 98304, KTP = 264;
template <int TYPE>
__device__ __forceinline__ void mixa_batch(const Args& a, int layer, int unit, LAS unsigned char* lds, int tid, int lane, int wave) {
    asm volatile("" : "+v"(tid), "+v"(lane));
    typedef MixCfg<TYPE> C; constexpr int DK = C::DK, DV = C::DV, NC = C::NC, NV = C::NV;
    unsigned char* ws = a.ws; const bf16* PROJ = (const bf16*)(ws + WS_PROJ); bf16* F1 = (bf16*)(ws + WS_CUM); float* ECG = (float*)(ws + WS_CUM + 16 * MiB) + (size_t)unit * 4 * NDV; float* DVEC = (float*)(ws + WS_DVEC) + (size_t)unit * NDV;
    bf16* U = (bf16*)(ws + WS_U) + (size_t)unit * ST_TOT + C::STOFF;
    LAS bf16* KT = (LAS bf16*)(lds + LA_KT); LAS bf16* VT = (LAS bf16*)(lds + LA_VT); LAS float* TOT = (LAS float*)(lds + LA_TOT); const LAS float* GAs = (const LAS float*)(lds + LA_GA);
    const int row0 = unit * CH;
    stage_vt<NV>(PROJ + (size_t)row0 * NPROJ + C::CV, VT, tid);
    const bool act = tid < 2 * NC; const int c = act ? tid % NC : 0, half = act ? tid / NC : 0, h = c / DK, d = c - h * DK;
    float cum[32]; float tot = 0.f;
    float w2[16], b2 = 0.f, lbv = 0.f, lg = 0.f, sg = 0.f; int f = 0, d2 = 0;
    if (act) {
        if constexpr (TYPE == 0) { b2 = a.gla_ba2[layer * 192 + c];
#pragma unroll
            for (int r = 0; r < 16; ++r) w2[r] = a.gla_wa2[(layer * 16 + r) * 192 + c]; }
        if constexpr (TYPE == 1) lbv = ((const float*)(ws + WS_LB))[layer * 256 + c];
        if constexpr (TYPE == 2) { lg = ret_lg(h); f = (d < 24) ? d : d - 24; d2 = (d < 24) ? d + 24 : d - 24; sg = (d < 24) ? -1.f : 1.f; }
#pragma unroll
        for (int gq = 0; gq < 2; ++gq) {
            bf16 hraw[16];
            if constexpr (TYPE == 1) {
#pragma unroll
                for (int i = 0; i < 16; ++i) hraw[i] = PROJ[(size_t)(row0 + 32 * half + 16 * gq + i) * NPROJ + C_HF + c]; }
#pragma unroll
            for (int ii = 0; ii < 16; ++ii) { const int i = 16 * gq + ii, t = 32 * half + i; float g;
                if constexpr (TYPE == 0) { float pre = b2;
#pragma unroll
                    for (int r = 0; r < 16; ++r) pre += GAs[t * 16 + r] * w2[r];
                    g = fast_logsig(pre) * (1.0f / 16.0f); }
                else if constexpr (TYPE == 1) { const float hf = fminf(fmaxf(bf2f(hraw[ii]), -80.f), 80.f); const float sgm = __builtin_amdgcn_rcpf(1.0f + __expf(-hf));
                    g = __logf(lbv + (1.0f - lbv) * sgm); }
                else g = lg;
                tot += g; cum[i] = tot;
                if constexpr (TYPE == 0) { if ((ii & 3) == 3) asm volatile("" ::: "memory"); } } }
        TOT[c * 2 + half] = tot;
    }
    __syncthreads();
    if (act) { const float t0 = TOT[c * 2], t1 = TOT[c * 2 + 1]; const float off = half ? t0 : 0.f, last = t0 + t1; const float cend0 = __expf(last - (cum[15] + off)), cend1 = __expf(last - (cum[31] + off));
#pragma unroll
        for (int hq = 0; hq < 4; ++hq) {
            bf16 ka[8], kb[8]; float cs[8], sn[8];
            if constexpr (TYPE != 1) {
#pragma unroll
                for (int i = 0; i < 8; ++i) { const size_t row = (size_t)(row0 + 32 * half + 8 * hq + i); const bf16* pr = PROJ + row * NPROJ;
                    if constexpr (TYPE == 0) ka[i] = pr[C_GK + c];
                    else { const float* rp = (const float*)(ws + WS_ROPE) + row * 48; ka[i] = pr[C_RK + h * 48 + d]; kb[i] = pr[C_RK + h * 48 + d2]; cs[i] = rp[f]; sn[i] = rp[24 + f]; } } }
            float kt[8];
#pragma unroll
            for (int j = 0; j < 8; ++j) { const int i = 8 * hq + j; const float cm = cum[i] + off; const size_t row = (size_t)(row0 + 32 * half + i); float k;
                if constexpr (TYPE == 0) k = bf2f(ka[j]);
                else if constexpr (TYPE == 1) k = 1.0f - __expf(cum[i] - (i > 0 ? cum[i - 1] : 0.f));
                else k = bf2f(ka[j]) * cs[j] + sg * bf2f(kb[j]) * sn[j];
                if constexpr (TYPE != 2) *(GAS bf16*)(F1 + row * NDV + C::COFF + c) = (bf16)f2bf(__expf(cm - ((i < 16) ? off : cum[15] + off)));
                { const float eb = cum[(i < 16) ? 15 : 31] + off;
                  const float kb = k * __expf(eb - cm); ((LAS bf16*)(lds + LA_KTT))[(32 * half + i) * KTP + c] = (bf16)f2bf(kb);
                  kt[j] = kb * ((i < 16) ? cend0 : cend1); } }
            v4u w; w.x = pk2(kt[0], kt[1]); w.y = pk2(kt[2], kt[3]); w.z = pk2(kt[4], kt[5]); w.w = pk2(kt[6], kt[7]);
            *(LAS v4u*)(KT + c * BP + 32 * half + 8 * hq) = w; }
        if (TYPE != 2) { *(GAS float*)(ECG + (2 * half + 0) * NDV + C::COFF + c) = cum[15] + off; *(GAS float*)(ECG + (2 * half + 1) * NDV + C::COFF + c) = cum[31] + off; }
        if (TYPE != 2 && half == 0) *(GAS float*)(DVEC + C::COFF + c) = __expf(last);
    }
    __syncthreads();
    { constexpr int CPR = NC / 8;
#pragma unroll
        for (int it = 0; it < (64 * CPR) / NTHR; ++it) { const int idx = tid + NTHR * it, t = idx / CPR, ch = idx - t * CPR;
            *(GAS v4u*)((bf16*)(ws + WS_KT) + (size_t)(row0 + t) * NKT + C::KOFF + 8 * ch) = *(const LAS v4u*)((const LAS bf16*)(lds + LA_KTT) + t * KTP + 8 * ch); } }
    constexpr int TD = DK / 16, NT = (DV / 16) * TD;
    for (int ti = wave; ti < 4 * NT; ti += NWAVES) { const int hh = ti / NT, tr = ti - hh * NT, te = tr / TD, td = tr - te * TD; f32x4 acc = {0.f, 0.f, 0.f, 0.f};
#pragma unroll
        for (int kk = 0; kk < 2; ++kk) acc = __builtin_amdgcn_mfma_f32_16x16x32_bf16(ldfrag(VT, BP, hh * DV + te * 16, kk * 32, lane), ldfrag(KT, BP, hh * DK + td * 16, kk * 32, lane), acc, 0, 0, 0);
        bf16* Uh = U + hh * DK * DV;
#pragma unroll
        for (int r = 0; r < 4; ++r) *(GAS bf16*)(Uh + (te * 16 + (lane >> 4) * 4 + r) * DK + td * 16 + (lane & 15)) = (bf16)f2bf(acc[r]); }
    __syncthreads();
}
__device__ __forceinline__ void p3a_summaries(const Args& a, int layer, LAS unsigned char* lds, int vcu, int G, int tid, int lane, int wave) {
    for (int unit = vcu; unit < NUNIT; unit += G) {
        { LAS float* GAs = (LAS float*)(lds + LA_GA); const float* GA = (const float*)(a.ws + WS_GA); for (int i = tid; i < CH * 16; i += NTHR) GAs[i] = GA[(size_t)unit * CH * 16 + i]; }
        __syncthreads();
        mixa_batch<0>(a, layer, unit, lds, tid, lane, wave);
        mixa_batch<1>(a, layer, unit, lds, tid, lane, wave);
        mixa_batch<2>(a, layer, unit, lds, tid, lane, wave);
    }
}

__device__ __forceinline__ void p3b_scan(const Args& a, int vcu, int G, int tid) {
    unsigned char* ws = a.ws; const bf16* U = (const bf16*)(ws + WS_U); const float* DVEC = (const float*)(ws + WS_DVEC); bf16* SP = (bf16*)(ws + WS_SP);
    for (int gid = vcu * NTHR + tid; gid < BATCH * ST_TOT; gid += G * NTHR) {
        const int b = gid / ST_TOT, el = gid - b * ST_TOT;
        int di = -1; float cdec = 0.f;
        if (el < ST_HG) { const int h = el / 4608, d = (el - h * 4608) % 48; di = h * 48 + d; }
        else if (el < ST_RET) { const int r = el - ST_HG, h = r / 4096, d = r % 64; di = 192 + h * 64 + d; }
        else { const int h = (el - ST_RET) / 4608; cdec = expf(64.0f * logf(1.0f - exp2f(-5.0f - (float)h))); }
        const bf16* up = U + (size_t)b * NCH * ST_TOT + el; const float* dp = DVEC + (size_t)b * NCH * NDV + (di < 0 ? 0 : di); bf16* sp = SP + (size_t)b * NCH * ST_TOT + el;
        float s = 0.f;
#pragma unroll 1
        for (int n0 = 0; n0 < NCH; n0 += 32) { float u[32], dc[32];
#pragma unroll
            for (int i = 0; i < 32; ++i) { u[i] = bf2f(up[(size_t)(n0 + i) * ST_TOT]); dc[i] = (di < 0) ? cdec : dp[(size_t)(n0 + i) * NDV]; }
#pragma unroll
            for (int i = 0; i < 32; ++i) { *(GAS bf16*)(sp + (size_t)(n0 + i) * ST_TOT) = (bf16)f2bf(s); s = dc[i] * s + u[i]; } }
    }
}

#ifndef SUB_MASK
#define SUB_MASK 0
#endif
__device__ __forceinline__ unsigned long long rt_now() { unsigned long long t; asm volatile("s_waitcnt vmcnt(0) lgkmcnt(0)\n\ts_memrealtime %0\n\ts_waitcnt lgkmcnt(0)" : "=s"(t) :: "memory"); return t; }
#define SUBSTRETCH(bit, t0_) do { if ((SUB_MASK >> (bit)) & 1) { const unsigned long long t1_ = rt_now(); while (rt_now() - t1_ < t1_ - (t0_)) __builtin_amdgcn_s_sleep(8); } } while (0)
constexpr int LC_VT = 0, LC_ST = 55296, LC_AB = 110592, OBP = 104, LC_EC = 137216, LC_EQ = MISC_OFF + 4096;
template <int TYPE, bool ISQ>
__device__ __forceinline__ void mix_frag(const Args& a, int h, size_t row, int t, int d0, float (&x)[8], float (&cm)[8]) {
    typedef MixCfg<TYPE> C; constexpr int DK = C::DK; static_assert(ISQ, "query path only");
    unsigned char* ws = a.ws; const bf16* pr = (const bf16*)(ws + WS_PROJ) + row * NPROJ;
    if constexpr (TYPE != 2) {
        const v4u p = *(const v4u*)(pr + C::CQ + h * DK + d0); const unsigned pw[4] = {p.x, p.y, p.z, p.w};
        const v4u f = *(const v4u*)((const bf16*)(ws + WS_CUM) + row * NDV + C::COFF + h * DK + d0); const unsigned fw[4] = {f.x, f.y, f.z, f.w};
#pragma unroll
        for (int j = 0; j < 4; ++j) { x[2 * j] = __builtin_bit_cast(float, pw[j] << 16); x[2 * j + 1] = __builtin_bit_cast(float, pw[j] & 0xffff0000u); cm[2 * j] = __builtin_bit_cast(float, fw[j] << 16); cm[2 * j + 1] = __builtin_bit_cast(float, fw[j] & 0xffff0000u); }
        if constexpr (TYPE == 0) {
#pragma unroll
            for (int j = 0; j < 8; ++j) x[j] *= 0.14433756729740643f; }
    } else {
        const int f0 = (d0 < 24) ? d0 : d0 - 24, dp = (d0 < 24) ? d0 + 24 : d0 - 24; const float sg = (d0 < 24) ? -1.f : 1.f;
        const int cb = C_RQ + h * DK; const v4u p = *(const v4u*)(pr + cb + d0), pp = *(const v4u*)(pr + cb + dp); const unsigned pw[4] = {p.x, p.y, p.z, p.w}, qw[4] = {pp.x, pp.y, pp.z, pp.w};
        const float* rp = (const float*)(ws + WS_ROPE) + row * 48; const f32x4 cs0 = *(const f32x4*)(rp + f0), cs1 = *(const f32x4*)(rp + f0 + 4), sn0 = *(const f32x4*)(rp + 24 + f0), sn1 = *(const f32x4*)(rp + 24 + f0 + 4);
        const float cmv = (float)(t + 1) * ret_lg(h);
#pragma unroll
        for (int j = 0; j < 4; ++j) { const float xa = __builtin_bit_cast(float, pw[j] << 16), xb = __builtin_bit_cast(float, pw[j] & 0xffff0000u), ya = __builtin_bit_cast(float, qw[j] << 16), yb = __builtin_bit_cast(float, qw[j] & 0xffff0000u);
            const float ca = (j < 2) ? cs0[2 * j] : cs1[2 * j - 4], cb2 = (j < 2) ? cs0[2 * j + 1] : cs1[2 * j - 3], sa = (j < 2) ? sn0[2 * j] : sn1[2 * j - 4], sb = (j < 2) ? sn0[2 * j + 1] : sn1[2 * j - 3];
            x[2 * j] = (xa * ca + sg * ya * sa) * 0.14433756729740643f; x[2 * j + 1] = (xb * cb2 + sg * yb * sb) * 0.14433756729740643f; cm[2 * j] = cmv; cm[2 * j + 1] = cmv; }
    }
}

template <int TYPE> struct QRaw { v4u p[2], f[2]; f32x4 rp[2][4]; };
template <int TYPE>
__device__ __forceinline__ void q_issue(const Args& a, int h, size_t row, int g, QRaw<TYPE>& R) {
    typedef MixCfg<TYPE> C; constexpr int DK = C::DK; unsigned char* ws = a.ws; const bf16* pr = (const bf16*)(ws + WS_PROJ) + row * NPROJ;
#pragma unroll
    for (int s = 0; s < 2; ++s) { const int d0r = 32 * s + 8 * g; const int d0 = (d0r < DK) ? d0r : 0;
        if constexpr (TYPE != 2) { R.p[s] = *(const v4u*)(pr + C::CQ + h * DK + d0); R.f[s] = *(const v4u*)((const bf16*)(ws + WS_CUM) + row * NDV + C::COFF + h * DK + d0); }
        else { const int f0 = (d0 < 24) ? d0 : d0 - 24, dp = (d0 < 24) ? d0 + 24 : d0 - 24; const int cb = C_RQ + h * DK; R.p[s] = *(const v4u*)(pr + cb + d0); R.f[s] = *(const v4u*)(pr + cb + dp);
            const float* rp = (const float*)(ws + WS_ROPE) + row * 48; R.rp[s][0] = *(const f32x4*)(rp + f0); R.rp[s][1] = *(const f32x4*)(rp + f0 + 4); R.rp[s][2] = *(const f32x4*)(rp + 24 + f0); R.rp[s][3] = *(const f32x4*)(rp + 24 + f0 + 4); } }
}
template <int TYPE>
__device__ __forceinline__ void q_convert(const QRaw<TYPE>& R, int s, int h, int t, int d0, float (&x)[8], float (&cm)[8]) {
    const v4u p = R.p[s], f = R.f[s]; const unsigned pw[4] = {p.x, p.y, p.z, p.w}, fw[4] = {f.x, f.y, f.z, f.w};
    if constexpr (TYPE != 2) {
#pragma unroll
        for (int j = 0; j < 4; ++j) { x[2 * j] = __builtin_bit_cast(float, pw[j] << 16); x[2 * j + 1] = __builtin_bit_cast(float, pw[j] & 0xffff0000u); cm[2 * j] = __builtin_bit_cast(float, fw[j] << 16); cm[2 * j + 1] = __builtin_bit_cast(float, fw[j] & 0xffff0000u); }
        if constexpr (TYPE == 0) {
#pragma unroll
            for (int j = 0; j < 8; ++j) x[j] *= 0.14433756729740643f; }
    } else {
        const float sg = (d0 < 24) ? -1.f : 1.f; const f32x4 cs0 = R.rp[s][0], cs1 = R.rp[s][1], sn0 = R.rp[s][2], sn1 = R.rp[s][3];
        const float cmv = (float)(t + 1) * ret_lg(h);
#pragma unroll
        for (int j = 0; j < 4; ++j) { const float xa = __builtin_bit_cast(float, pw[j] << 16), xb = __builtin_bit_cast(float, pw[j] & 0xffff0000u), ya = __builtin_bit_cast(float, fw[j] << 16), yb = __builtin_bit_cast(float, fw[j] & 0xffff0000u);
            const float ca = (j < 2) ? cs0[2 * j] : cs1[2 * j - 4], cb2 = (j < 2) ? cs0[2 * j + 1] : cs1[2 * j - 3], sa = (j < 2) ? sn0[2 * j] : sn1[2 * j - 4], sb = (j < 2) ? sn0[2 * j + 1] : sn1[2 * j - 3];
            x[2 * j] = (xa * ca + sg * ya * sa) * 0.14433756729740643f; x[2 * j + 1] = (xb * cb2 + sg * yb * sb) * 0.14433756729740643f; cm[2 * j] = cmv; cm[2 * j + 1] = cmv; }
    }
}

template <int TYPE>
__device__ __forceinline__ void mixc_batch(const Args& a, int layer, int unit, LAS unsigned char* lds, int tid, int lane, int wave) {
    asm volatile("" : "+v"(tid), "+v"(lane));
    typedef MixCfg<TYPE> C; constexpr int DK = C::DK, DV = C::DV, NV = C::NV, TE = DV / 16;
    unsigned char* ws = a.ws; const bf16* PROJ = (const bf16*)(ws + WS_PROJ); bf16* MIX = (bf16*)(ws + WS_MIX);
    LAS bf16* VT = (LAS bf16*)(lds + LC_VT); LAS bf16* ST = (LAS bf16*)(lds + LC_ST); LAS bf16* AB = (LAS bf16*)(lds + LC_AB) + wave * 16 * OBP;
    const int row0 = unit * CH;
    const unsigned long long ts0_ = SUB_MASK ? rt_now() : 0ull;
    stage_vt<NV>(PROJ + (size_t)row0 * NPROJ + C::CV, VT, tid);
    SUBSTRETCH(3, ts0_);
    const unsigned long long ts3_ = SUB_MASK ? rt_now() : 0ull;
    { const bf16* SPu = (const bf16*)(ws + WS_SP) + (size_t)unit * ST_TOT + C::STOFF;
        constexpr int NIS = (NV * 8) / NTHR; static_assert((NV * 8) % NTHR == 0, "ST staging"); v4u sw[NIS];
#pragma unroll
        for (int it = 0; it < NIS; ++it) { const int idx = tid + NTHR * it, er = idx >> 3, ch = idx & 7; sw[it] = (v4u){0u, 0u, 0u, 0u}; if (ch * 8 < DK) sw[it] = *(const v4u*)(SPu + (size_t)er * DK + ch * 8); }
#pragma unroll
        for (int it = 0; it < NIS; ++it) { const int idx = tid + NTHR * it, er = idx >> 3, ch = idx & 7; *(LAS v4u*)(ST + er * BP + ch * 8) = sw[it]; } }
    SUBSTRETCH(4, ts3_);
    SUBSTRETCH(0, ts0_);
    if constexpr (TYPE != 2) { if (tid < C::NC) {
            const float* ep = (const float*)(ws + WS_CUM + 16 * MiB) + (size_t)unit * 4 * NDV + C::COFF + tid; const float ee[4] = {ep[0], ep[NDV], ep[2 * NDV], ep[3 * NDV]};
            LAS float* T = (LAS float*)(lds + LC_EC) + tid; LAS float* Q = (LAS float*)(lds + LC_EQ) + tid;
#pragma unroll
            for (int I = 0; I < 4; ++I) { const float sI = I ? ee[I ? I - 1 : 0] : 0.f;
#pragma unroll
                for (int J = 0; J <= I; ++J) T[(I * (I + 1) / 2 + J) * 256] = __expf(fminf(sI - ee[J], 80.f));
                if (I) Q[(I - 1) * 256] = __expf(sI); } } }
    __syncthreads();
    SUBSTRETCH(5, ts0_);
    const unsigned long long ts1_ = SUB_MASK ? rt_now() : 0ull;
    const int h = wave >> 1, hsel = wave & 1, r = lane & 15, g = lane >> 4;
    const LAS bf16* STh = ST + h * DV * BP; const LAS bf16* VTh = VT + h * DV * BP;
    constexpr int NCHK = DV / 8, NOC = (16 * NCHK) / 64;
    f32x4 wn[NOC][2];
#pragma unroll
    for (int i = 0; i < NOC; ++i) { const int cidx = lane + 64 * i, orow = cidx / NCHK, ch = cidx - orow * NCHK; wn[i][0] = (f32x4){1.f, 1.f, 1.f, 1.f}; wn[i][1] = wn[i][0];
        if constexpr (TYPE == 0) { const float* wp = a.gla_norm_w + layer * 384 + h * 96 + 8 * ch; wn[i][0] = *(const f32x4*)wp; wn[i][1] = *(const f32x4*)(wp + 4); }
        if constexpr (TYPE == 1) { const float* wp = a.hg_norm_w + layer * 256 + h * 64 + 8 * ch; wn[i][0] = *(const f32x4*)wp; wn[i][1] = *(const f32x4*)(wp + 4); } }
    QRaw<TYPE> R; v4u kf[4][2]; v4u gvn[NOC];
    auto issue = [&](int I) { q_issue<TYPE>(a, h, (size_t)(row0 + 16 * I + r), g, R);
#pragma unroll
        for (int J = 0; J < 4; ++J) { const int Jc = (J < I) ? J : I; const size_t rowJ = (size_t)(row0 + 16 * Jc + r);
#pragma unroll
            for (int s = 0; s < 2; ++s) { const int d0 = 32 * s + 8 * g; const int d0c = (d0 < DK) ? d0 : 0;
                kf[J][s] = *(const v4u*)((const bf16*)(ws + WS_KT) + rowJ * NKT + C::KOFF + h * DK + d0c); } }
#pragma unroll
        for (int i = 0; i < NOC; ++i) { const int cidx = lane + 64 * i, orow = cidx / NCHK, ch = cidx - orow * NCHK; gvn[i] = *(const v4u*)(PROJ + (size_t)(row0 + 16 * I + orow) * NPROJ + C::CG + h * DV + 8 * ch); } };
    issue(hsel);
#pragma unroll
    for (int ib = 0; ib < 2; ++ib) { const int I = ib ? 3 - hsel : hsel;
        pg8::bf16x8 qh[2], qt[2]; float refv[2][8], qhf[2][8];
#pragma unroll
        for (int s = 0; s < 2; ++s) { const int d0 = 32 * s + 8 * g; const bool valid = d0 < DK; const int d0c = valid ? d0 : 0;
            float x[8], cm[8]; q_convert<TYPE>(R, s, h, 16 * I + r, d0c, x, cm);
            if constexpr (TYPE == 2) {
#pragma unroll
                for (int j = 0; j < 8; ++j) refv[s][j] = (float)(16 * I) * ret_lg(h);
            } else { if (I > 0) { const LAS float* cp = (const LAS float*)(lds + LC_EQ) + (I - 1) * 256 + h * DK + d0c; const f32x4 c0 = *(const LAS f32x4*)cp, c1 = *(const LAS f32x4*)(cp + 4);
#pragma unroll
                    for (int j = 0; j < 4; ++j) { refv[s][j] = c0[j]; refv[s][4 + j] = c1[j]; } }
                else {
#pragma unroll
                    for (int j = 0; j < 8; ++j) refv[s][j] = 1.f; } }
            float xt[8];
#pragma unroll
            for (int j = 0; j < 8; ++j) { if constexpr (TYPE == 2) { qhf[s][j] = valid ? x[j] * __expf(cm[j] - refv[s][j]) : 0.f; xt[j] = valid ? x[j] * __expf(cm[j]) : 0.f; }
                else { qhf[s][j] = valid ? x[j] * cm[j] : 0.f; xt[j] = qhf[s][j] * refv[s][j]; } }
            qh[s] = pack8(qhf[s]); qt[s] = pack8(xt); }
#pragma unroll
        for (int J = 0; J < 4; ++J) { if (J <= I) { f32x4 acc = {0.f, 0.f, 0.f, 0.f};
#pragma unroll
            for (int s = 0; s < 2; ++s) { pg8::bf16x8 qop;
                { float xq[8], ej[8]; const int d0 = 32 * s + 8 * g; const int d0c = (d0 < DK) ? d0 : 0;
                    if constexpr (TYPE == 2) {
#pragma unroll
                        for (int j = 0; j < 8; ++j) ej[j] = (float)(16 * (J + 1)) * ret_lg(h); }
                    else { const LAS float* ep = (const LAS float*)(lds + LC_EC) + (I * (I + 1) / 2 + J) * 256 + h * DK + d0c; const f32x4 e0 = *(const LAS f32x4*)ep, e1 = *(const LAS f32x4*)(ep + 4);
#pragma unroll
                        for (int j = 0; j < 4; ++j) { ej[j] = e0[j]; ej[4 + j] = e1[j]; } }
#pragma unroll
                    for (int j = 0; j < 8; ++j) xq[j] = qhf[s][j] * ((TYPE == 2) ? __expf(fminf(refv[s][j] - ej[j], 80.f)) : ej[j]);
                    qop = pack8(xq); }
                acc = __builtin_amdgcn_mfma_f32_16x16x32_bf16(qop, __builtin_bit_cast(pg8::bf16x8, kf[J][s]), acc, 0, 0, 0); }
#pragma unroll
            for (int q = 0; q < 4; ++q) { const int i = 4 * g + q; const float v = (J < I || r <= i) ? acc[q] : 0.f; AB[i * BP + 16 * J + r] = (bf16)f2bf(v); } } }
        if ((I & 1) == 0) {
#pragma unroll
            for (int q = 0; q < 4; ++q) AB[(4 * g + q) * BP + 16 * (I + 1) + r] = (bf16)0; }
        v4u gvp[NOC];
#pragma unroll
        for (int i = 0; i < NOC; ++i) gvp[i] = gvn[i];
        if (ib == 0) issue(3 - hsel);
        asm volatile("s_waitcnt lgkmcnt(0)" ::: "memory");
        const pg8::bf16x8 ah0 = *(const LAS pg8::bf16x8*)(AB + r * BP + 8 * g), ah1 = *(const LAS pg8::bf16x8*)(AB + r * BP + 32 + 8 * g);
        f32x4 o[TE];
#pragma unroll
        for (int te = 0; te < TE; ++te) { f32x4 acc = {0.f, 0.f, 0.f, 0.f};
            acc = __builtin_amdgcn_mfma_f32_16x16x32_bf16(qt[0], ldfrag(STh, BP, te * 16, 0, lane), acc, 0, 0, 0);
            acc = __builtin_amdgcn_mfma_f32_16x16x32_bf16(qt[1], ldfrag(STh, BP, te * 16, 32, lane), acc, 0, 0, 0);
            acc = __builtin_amdgcn_mfma_f32_16x16x32_bf16(ah0, ldfrag(VTh, BP, te * 16, 0, lane), acc, 0, 0, 0);
            if (I >= 2) acc = __builtin_amdgcn_mfma_f32_16x16x32_bf16(ah1, ldfrag(VTh, BP, te * 16, 32, lane), acc, 0, 0, 0);
            o[te] = acc; }
        const unsigned long long ts2_ = SUB_MASK ? rt_now() : 0ull;
#pragma unroll
        for (int q = 0; q < 4; ++q) { float s1 = 0.f, s2 = 0.f;
#pragma unroll
            for (int te = 0; te < TE; ++te) { s1 += o[te][q]; s2 += o[te][q] * o[te][q]; }
#pragma unroll
            for (int m = 1; m < 16; m <<= 1) { s1 += __shfl_xor(s1, m); s2 += __shfl_xor(s2, m); }
            float mean = 0.f, rstd;
            if constexpr (TYPE == 2) { mean = s1 * (1.0f / DV); rstd = __builtin_amdgcn_rsqf(fmaxf(s2 * (1.0f / DV) - mean * mean, 0.f) + EPS); }
            else rstd = __builtin_amdgcn_rsqf(s2 * (1.0f / DV) + EPS);
#pragma unroll
            for (int te = 0; te < TE; ++te) AB[(4 * g + q) * OBP + te * 16 + r] = (bf16)f2bf((o[te][q] - mean) * rstd); }
        asm volatile("s_waitcnt lgkmcnt(0)" ::: "memory");
#pragma unroll
        for (int i = 0; i < NOC; ++i) { const int cidx = lane + 64 * i, orow = cidx / NCHK, ch = cidx - orow * NCHK; const size_t row = (size_t)(row0 + 16 * I + orow);
            const v4u ov = *(const LAS v4u*)(AB + orow * OBP + 8 * ch); const v4u gv = gvp[i];
            const unsigned ow[4] = {ov.x, ov.y, ov.z, ov.w}, gw[4] = {gv.x, gv.y, gv.z, gv.w}; float res[8];
            const f32x4 w0 = wn[i][0], w1 = wn[i][1];
#pragma unroll
            for (int j = 0; j < 4; ++j) { const float oa = __builtin_bit_cast(float, ow[j] << 16), ob = __builtin_bit_cast(float, ow[j] & 0xffff0000u), ga = __builtin_bit_cast(float, gw[j] << 16), gb = __builtin_bit_cast(float, gw[j] & 0xffff0000u);
                const float wa = (j < 2) ? w0[2 * j] : w1[2 * j - 4], wb = (j < 2) ? w0[2 * j + 1] : w1[2 * j - 3];
                const float sa = __builtin_amdgcn_rcpf(1.0f + __expf(-ga)), sb = __builtin_amdgcn_rcpf(1.0f + __expf(-gb));
                res[2 * j] = oa * wa * ((TYPE == 1) ? sa : ga * sa); res[2 * j + 1] = ob * wb * ((TYPE == 1) ? sb : gb * sb); }
            if (F8_OUT) { typedef int i32x2 __attribute__((ext_vector_type(2)));
                *(GAS i32x2*)((unsigned char*)MIX + row * D + C::MIXOFF + h * DV + 8 * ch) = (i32x2){pk4_fp8(res[0] * S8_M, res[1] * S8_M, res[2] * S8_M, res[3] * S8_M), pk4_fp8(res[4] * S8_M, res[5] * S8_M, res[6] * S8_M, res[7] * S8_M)}; }
            else { v4u w; w.x = pk2(res[0], res[1]); w.y = pk2(res[2], res[3]); w.z = pk2(res[4], res[5]); w.w = pk2(res[6], res[7]); *(GAS v4u*)(MIX + row * D + C::MIXOFF + h * DV + 8 * ch) = w; } }
        SUBSTRETCH(2, ts2_);
    }
    SUBSTRETCH(1, ts1_);
    const unsigned long long tsE_ = SUB_MASK ? rt_now() : 0ull;
    __syncthreads();
    SUBSTRETCH(6, tsE_);
}
__device__ __forceinline__ void p3c_outputs(const Args& a, int layer, LAS unsigned char* lds, int vcu, int G, int tid, int lane, int wave) {
    for (int unit = vcu; unit < NUNIT; unit += G) {
        mixc_batch<0>(a, layer, unit, lds, tid, lane, wave);
        mixc_batch<1>(a, layer, unit, lds, tid, lane, wave);
        mixc_batch<2>(a, layer, unit, lds, tid, lane, wave);
    }
}


constexpr int MW_ARGS = 800;
__device__ __forceinline__ const void* ld_argp(const volatile LAS unsigned* T, int i) {
    const unsigned lo = __builtin_amdgcn_readfirstlane(T[2 * i]), hi = __builtin_amdgcn_readfirstlane(T[2 * i + 1]);
    return (const void*)(((unsigned long long)hi << 32) | lo);
}
__device__ __forceinline__ Args load_args(LAS unsigned char* lds) {
    const volatile LAS unsigned* T = (const volatile LAS unsigned*)(lds + MISC_OFF) + MW_ARGS;
    Args a;
    a.x = (const float*)ld_argp(T, 0); a.c = (const float*)ld_argp(T, 1); a.pos = (const int*)ld_argp(T, 2); a.w_mod = (const float*)ld_argp(T, 3); a.b_mod = (const float*)ld_argp(T, 4);
    a.norm1_w = (const float*)ld_argp(T, 5); a.w_in = (const float*)ld_argp(T, 6); a.gla_wa2 = (const float*)ld_argp(T, 7); a.gla_ba2 = (const float*)ld_argp(T, 8); a.hg_lb = (const float*)ld_argp(T, 9);
    a.gla_norm_w = (const float*)ld_argp(T, 10); a.hg_norm_w = (const float*)ld_argp(T, 11); a.w_out = (const float*)ld_argp(T, 12); a.norm2_w = (const float*)ld_argp(T, 13); a.w_r = (const float*)ld_argp(T, 14);
    a.b_r = (const float*)ld_argp(T, 15); a.w_gu = (const float*)ld_argp(T, 16); a.b_gu = (const float*)ld_argp(T, 17); a.w_dn = (const float*)ld_argp(T, 18); a.b_dn = (const float*)ld_argp(T, 19);
    a.final_norm_w = (const float*)ld_argp(T, 20); a.out = (float*)ld_argp(T, 21); a.ws = (unsigned char*)ld_argp(T, 22); a.ph_lo = 0; a.ph_hi = 0;
    return a;
}
#define PH_CTX() { unsigned l_ = (unsigned)(size_t)lds; asm volatile("" : "+s"(l_)); lds = (LAS unsigned char*)(size_t)l_; } const Args args = load_args(lds); volatile LAS unsigned* MISC = (volatile LAS unsigned*)(lds + MISC_OFF); int tid_ = wv * 64 + (int)__builtin_amdgcn_mbcnt_hi(~0u, __builtin_amdgcn_mbcnt_lo(~0u, 0u)); asm volatile("" : "+v"(tid_)); const int tid = tid_, lane = tid & 63, wave = __builtin_amdgcn_readfirstlane(tid >> 6); \
    const int G = gridDim.x; const int bx = blockIdx.x; const int vcu = (G % 8 == 0) ? (bx % 8) * (G / 8) + bx / 8 : bx; unsigned char* ws = args.ws; gu32* ctl = (gu32*)(ws + WS_CTL); \
    (void)MISC; (void)lane; (void)wave; (void)vcu; (void)ctl; (void)bx; (void)tid
__device__ __forceinline__ void ph_p0(LAS unsigned char* lds, int wv) { PH_CTX(); p0_prologue(args, lds, vcu, G, tid, lane, wave); }
__device__ __forceinline__ void ph_p1(LAS unsigned char* lds, int wv, int layer_) { int layer = __builtin_amdgcn_readfirstlane(layer_); asm volatile("" : "+s"(layer)); PH_CTX();
    if (layer > 0) { moe_tables(ctl, layer - 1, MISC, tid); const int nrt = __builtin_amdgcn_readfirstlane((int)MISC[MW_NRT]);
        const int done = conv_t2(G) + conv_idle(nrt * 8, G) * NWAVES * CB7 + conv_idle(nrt * 4, G) * NWAVES * CB8; LAS float* scr = (LAS float*)(lds + wave * 16640);
        for (int it = done + vcu * NWAVES + wave; it < IT_LAYER; it += G * NWAVES) convert_item(args, layer, it, scr, lane);
        __syncthreads(); }
    rows_mfma<16>(args, layer, lds, MISC, ctl, vcu, G, tid, lane, wave); }
__device__ __forceinline__ void ph_p2(LAS unsigned char* lds, int wv, int layer_) { int layer = __builtin_amdgcn_readfirstlane(layer_); asm volatile("" : "+s"(layer)); PH_CTX();
    pg8::Gemm g{(const bf16*)(ws + WS_H), (const bf16*)(ws + WS_WIN + (size_t)layer * NPROJ * D * (F8_IN ? 1 : 2)), MTOK, NPROJ, F8_IN ? D / 2 : D}; pg8::StaticOrder S; S.init(MTOK, NPROJ, G, bx);
    pg8::EpiBf16Plain E{(bf16*)(ws + WS_PROJ), NPROJ, F8_IN ? 1.0f / (S8_H * S8_W) : 1.0f};
    pg8::gemm_phase<pg8::EpiBf16Plain, pg8::StaticOrder, true, true, F8_IN>(lds, g, S, E, tid);
    if (layer + 1 < DEPTH && G == 256 && bx >= 64) convert_range(args, layer + 1, ((bx - 64) * NWAVES + wave) * CB2, CB2, lds, lane, wave); }
__device__ __forceinline__ void ph_p3a(LAS unsigned char* lds, int wv, int layer_) { int layer = __builtin_amdgcn_readfirstlane(layer_); asm volatile("" : "+s"(layer)); PH_CTX(); p3a_summaries(args, layer, lds, vcu, G, tid, lane, wave); }
__device__ __forceinline__ void ph_p3b(LAS unsigned char* lds, int wv) { PH_CTX(); p3b_scan(args, vcu, G, tid); }
__device__ __forceinline__ void ph_p3c(LAS unsigned char* lds, int wv, int layer_) { int layer = __builtin_amdgcn_readfirstlane(layer_); asm volatile("" : "+s"(layer)); PH_CTX(); p3c_outputs(args, layer, lds, vcu, G, tid, lane, wave); }
__device__ __forceinline__ void ph_p4(LAS unsigned char* lds, int wv, int layer_) { int layer = __builtin_amdgcn_readfirstlane(layer_); asm volatile("" : "+s"(layer)); PH_CTX();
    pg8::Gemm g{(const bf16*)(ws + WS_MIX), (const bf16*)(ws + WS_WOUT + (size_t)layer * D * D * (F8_OUT ? 1 : 2)), MTOK, D, F8_OUT ? D / 2 : D}; pg8::StaticOrder S; S.init(MTOK, D, G, bx);
    pg8::EpiResGate E{(const bf16*)(ws + WS_X), (bf16*)(ws + WS_X), D, (const float*)(ws + WS_MOD) + (size_t)layer * 2 * 6144 + 2 * D, 6144, SEQ, F8_OUT ? 1.0f / (S8_M * S8_W) : 1.0f};
    pg8::gemm_phase<pg8::EpiResGate, pg8::StaticOrder, true, true, F8_OUT>(lds, g, S, E, tid); }
__device__ __forceinline__ void ph_p5(LAS unsigned char* lds, int wv, int layer_) { int layer = __builtin_amdgcn_readfirstlane(layer_); asm volatile("" : "+s"(layer)); PH_CTX(); rows_mfma<32>(args, layer, lds, MISC, ctl, vcu, G, tid, lane, wave); }
__device__ __forceinline__ void ph_p7(LAS unsigned char* lds, int wv, int layer_) { int layer = __builtin_amdgcn_readfirstlane(layer_); asm volatile("" : "+s"(layer)); PH_CTX();
    moe_tables(ctl, layer, MISC, tid);
    const int nrt = __builtin_amdgcn_readfirstlane((int)MISC[MW_NRT]);
    pg8::Gemm g{(const bf16*)(ws + WS_A1), (const bf16*)(ws + WS_WGU + (size_t)layer * NE * 2048 * D), nrt * 256, NE * 2048, D / 2};
    pg8::MoeOrder S{8, G, vcu, nrt * 8, (const LAS int*)(lds + MISC_OFF + 4 * MW_TILE)};
    pg8::EpiSwiglu E{ws + WS_ACT, FFN, args.b_gu + (size_t)layer * NE * 2048, 1.0f / (S8_H * S8_W), S8_A};
    pg8::gemm_phase<pg8::EpiSwiglu, pg8::MoeOrder, true, true, true>(lds, g, S, E, tid);
    { const int rem = (nrt * 8) % G; if (layer + 1 < DEPTH && rem != 0 && vcu >= rem) convert_range(args, layer + 1, conv_t2(G) + ((vcu - rem) * NWAVES + wave) * CB7, CB7, lds, lane, wave); } }
__device__ __forceinline__ void ph_p8(LAS unsigned char* lds, int wv, int layer_) { int layer = __builtin_amdgcn_readfirstlane(layer_); asm volatile("" : "+s"(layer)); PH_CTX();
    moe_tables(ctl, layer, MISC, tid);
    const int nrt = __builtin_amdgcn_readfirstlane((int)MISC[MW_NRT]);
    pg8::Gemm g{(const bf16*)(ws + WS_ACT), (const bf16*)(ws + WS_WDN + (size_t)layer * NE * D * FFN), nrt * 256, NE * D, FFN / 2};
    pg8::MoeOrder S{4, G, vcu, nrt * 4, (const LAS int*)(lds + MISC_OFF + 4 * MW_TILE)};
    if constexpr (Y8) { pg8::EpiFp8Bias E{ws + WS_Y, D, args.b_dn + (size_t)layer * NE * D, D, 1.0f / (S8_A * S8_W), S8_Y};
        pg8::gemm_phase<pg8::EpiFp8Bias, pg8::MoeOrder, true, true, true>(lds, g, S, E, tid); }
    else { pg8::EpiBf16Bias E{(bf16*)(ws + WS_Y), D, args.b_dn + (size_t)layer * NE * D, D, 1.0f / (S8_A * S8_W)};
        pg8::gemm_phase<pg8::EpiBf16Bias, pg8::MoeOrder, true, true, true>(lds, g, S, E, tid); }
    { const int rem = (nrt * 4) % G; if (layer + 1 < DEPTH && rem != 0 && vcu >= rem) convert_range(args, layer + 1, conv_t2(G) + conv_idle(nrt * 8, G) * NWAVES * CB7 + ((vcu - rem) * NWAVES + wave) * CB8, CB8, lds, lane, wave); } }
__device__ __forceinline__ void ph_final(LAS unsigned char* lds, int wv) { PH_CTX(); final_rows(args, lds, vcu, G, tid, lane); }

#ifndef DBL_MASK
#define DBL_MASK 0
#endif
#if DBL_MASK
#define RUN(bit, call) do { if ((DBL_MASK >> (bit)) & 1) { const unsigned long long t0_ = __builtin_amdgcn_s_memrealtime(); call; const unsigned long long t1_ = __builtin_amdgcn_s_memrealtime(); \
        while (__builtin_amdgcn_s_memrealtime() - t1_ < t1_ - t0_) __builtin_amdgcn_s_sleep(8); } else { call; } } while (0)
#else
#define RUN(bit, call) do { call; } while (0)
#endif
__global__ void __launch_bounds__(NTHR, 2) hybrid_fwd(Args args) {
    extern __shared__ __attribute__((aligned(16))) unsigned char lds_raw[];
    LAS unsigned char* lds = (LAS unsigned char*)lds_raw;
    volatile LAS unsigned* MISC = (volatile LAS unsigned*)(lds + MISC_OFF);
    const int tid = threadIdx.x; const int wv = __builtin_amdgcn_readfirstlane(tid >> 6);
    gu32* ctl = (gu32*)(args.ws + WS_CTL);
    for (int u = tid; u < (LDS_BYTES - MISC_OFF) / 4; u += NTHR) MISC[u] = 0u;
    __syncthreads();
    if (tid == 0) {
#define ST_ARG(i, p) do { const unsigned long long v_ = (unsigned long long)(p); MISC[MW_ARGS + 2 * (i)] = (unsigned)v_; MISC[MW_ARGS + 2 * (i) + 1] = (unsigned)(v_ >> 32); } while (0)
        ST_ARG(0, args.x); ST_ARG(1, args.c); ST_ARG(2, args.pos); ST_ARG(3, args.w_mod); ST_ARG(4, args.b_mod); ST_ARG(5, args.norm1_w); ST_ARG(6, args.w_in); ST_ARG(7, args.gla_wa2); ST_ARG(8, args.gla_ba2);
        ST_ARG(9, args.hg_lb); ST_ARG(10, args.gla_norm_w); ST_ARG(11, args.hg_norm_w); ST_ARG(12, args.w_out); ST_ARG(13, args.norm2_w); ST_ARG(14, args.w_r); ST_ARG(15, args.b_r); ST_ARG(16, args.w_gu);
        ST_ARG(17, args.b_gu); ST_ARG(18, args.w_dn); ST_ARG(19, args.b_dn); ST_ARG(20, args.final_norm_w); ST_ARG(21, args.out); ST_ARG(22, args.ws);
#undef ST_ARG
    }
    __syncthreads();
    const int lo = args.ph_lo, hi = args.ph_hi;
    const bool multi = (hi - lo) > 1;
    XcdBarrier bar; bar.bar = (unsigned*)(ctl + CW_BAR); bar.x = 0; bar.st = nullptr;
    if (multi) bar = xcd_barrier_post((unsigned*)(ctl + CW_BAR), MISC + MW_BAR);
#define IN(k) (lo <= (k) && (k) < hi)
#define SEAM(k) do { if (IN(k) && IN((k) + 1)) xcd_barrier(bar); } while (0)

    if (IN(0)) RUN(0, ph_p0(lds, wv));
    SEAM(0);
    for (int layer = 0; layer < DEPTH; ++layer) {
        const int pb = 1 + 9 * layer;
        if (IN(pb + 0)) RUN(1, ph_p1(lds, wv, layer));
        SEAM(pb + 0);
        if (IN(pb + 1)) RUN(2, ph_p2(lds, wv, layer));
        SEAM(pb + 1);
        if (IN(pb + 2)) RUN(3, ph_p3a(lds, wv, layer));
        SEAM(pb + 2);
        if (IN(pb + 3)) RUN(4, ph_p3b(lds, wv));
        SEAM(pb + 3);
        if (IN(pb + 4)) RUN(5, ph_p3c(lds, wv, layer));
        SEAM(pb + 4);
        if (IN(pb + 5)) RUN(6, ph_p4(lds, wv, layer));
        SEAM(pb + 5);
        if (IN(pb + 6)) RUN(7, ph_p5(lds, wv, layer));
        SEAM(pb + 6);
        if (IN(pb + 7)) RUN(9, ph_p7(lds, wv, layer));
        SEAM(pb + 7);
        if (IN(pb + 8)) RUN(10, ph_p8(lds, wv, layer));
        SEAM(pb + 8);
    }
    if (IN(NPHASE - 1)) RUN(11, ph_final(lds, wv));
#undef IN
#undef SEAM
}

#ifndef MK_SINGLE
#define MK_SINGLE 1
#endif
extern "C" void kernel_launch(void* const* d_in, const int* in_sizes, int n_in, void* d_out, int out_size, void* d_ws, size_t ws_size, hipStream_t stream) {
    static int grid = 0;
    if (grid == 0) {
        if (n_in != 21 || in_sizes[0] != MTOK * D || out_size != MTOK * D || ws_size < WS_END) { fprintf(stderr, "kernel_launch: unexpected problem shape (n_in %d, in0 %d, out %d, ws %zu)\n", n_in, n_in > 0 ? in_sizes[0] : -1, out_size, ws_size); grid = -1; return; }
        int dev = 0, cus = 0, per_cu = 0;
        if (hipGetDevice(&dev) != hipSuccess || hipDeviceGetAttribute(&cus, hipDeviceAttributeMultiprocessorCount, dev) != hipSuccess) { grid = -1; return; }
        if (hipFuncSetAttribute((const void*)hybrid_fwd, hipFuncAttributeMaxDynamicSharedMemorySize, LDS_BYTES) != hipSuccess) { fprintf(stderr, "kernel_launch: hipFuncSetAttribute failed\n"); grid = -1; return; }
        if (hipOccupancyMaxActiveBlocksPerMultiprocessor(&per_cu, (const void*)hybrid_fwd, NTHR, LDS_BYTES) != hipSuccess || per_cu < 1) fprintf(stderr, "kernel_launch: occupancy query says %d\n", per_cu);
        (void)hipGetLastError();
        grid = cus;
    }
    if (grid < 0) return;
    (void)hipMemsetAsync((char*)d_ws + WS_CTL, 0, CTL_ZERO_BYTES, stream);
    Args a{};
    a.x = (const float*)d_in[0]; a.c = (const float*)d_in[1]; a.pos = (const int*)d_in[2]; a.w_mod = (const float*)d_in[3]; a.b_mod = (const float*)d_in[4]; a.norm1_w = (const float*)d_in[5];
    a.w_in = (const float*)d_in[6]; a.gla_wa2 = (const float*)d_in[7]; a.gla_ba2 = (const float*)d_in[8]; a.hg_lb = (const float*)d_in[9]; a.gla_norm_w = (const float*)d_in[10]; a.hg_norm_w = (const float*)d_in[11];
    a.w_out = (const float*)d_in[12]; a.norm2_w = (const float*)d_in[13]; a.w_r = (const float*)d_in[14]; a.b_r = (const float*)d_in[15]; a.w_gu = (const float*)d_in[16]; a.b_gu = (const float*)d_in[17];
    a.w_dn = (const float*)d_in[18]; a.b_dn = (const float*)d_in[19]; a.final_norm_w = (const float*)d_in[20]; a.out = (float*)d_out; a.ws = (unsigned char*)d_ws;
#if MK_SINGLE
    a.ph_lo = 0; a.ph_hi = NPHASE;
    hipLaunchKernelGGL(hybrid_fwd, dim3(grid), dim3(NTHR), LDS_BYTES, stream, a);
#else
    for (int p = 0; p < NPHASE; ++p) { a.ph_lo = p; a.ph_hi = p + 1; hipLaunchKernelGGL(hybrid_fwd, dim3(grid), dim3(NTHR), LDS_BYTES, stream, a); }
#endif
}
```
